# Optimizing an MI355X kernel written in HIP

```python
import jax, jax.numpy as jnp
from jax import lax
import numpy as np

D_MODEL = 1024
BATCH = 4
SEQ = 4096
DEPTH = 4

GRID_W = 64
CTX_LEN = 256
N_MIXERS = 3
N_MOD = 6
NORM_EPS = 1e-6

D_RNN = D_MODEL
RG_BLOCKS = 8
RG_BW = D_RNN // RG_BLOCKS
CONV_W = 4
RG_C = 8.0

HEAD_DIM = 128
N_Q_HEADS = D_MODEL // HEAD_DIM
N_KV_HEADS = 2
GQA_GROUP = N_Q_HEADS // N_KV_HEADS
Q_BLOCK = 128
ROPE_THETA = 10000.0
AXIS_DIM = HEAD_DIM // 2
N_FREQ = AXIS_DIM // 2

CHUNK = 128
D_CM = 2 * D_MODEL
CM_GROUPS = 8
CM_GW = D_CM // CM_GROUPS

N_GROUPS = 4
EXPERTS_PER_GROUP = 8
N_EXPERTS = N_GROUPS * EXPERTS_PER_GROUP
TOP_K = 2
D_EXPERT = 512
MOE_BLOCK = 128

kernel_name = "hybrid_rglru_gqa_gmlp_hmoe_prefix_dit"


def rms_norm(x, g):
    xf = x.astype(jnp.float32)
    y = xf * lax.rsqrt(jnp.mean(xf * xf, axis=-1, keepdims=True) + NORM_EPS)
    return (y * g.astype(jnp.float32)).astype(x.dtype)


def layer_norm(x, g, b):
    xf = x.astype(jnp.float32)
    mu = jnp.mean(xf, axis=-1, keepdims=True)
    var = jnp.mean(jnp.square(xf - mu), axis=-1, keepdims=True)
    y = (xf - mu) * lax.rsqrt(var + NORM_EPS) * g.astype(jnp.float32) + b.astype(jnp.float32)
    return y.astype(x.dtype)


def modulate(h, shift, scale):
    return h * (1 + scale) + shift


def centred_dwconv(x, w, b):
    left = CONV_W // 2
    y = lax.conv_general_dilated(x, w[:, None, :].astype(x.dtype), (1,), [(left, CONV_W - 1 - left)],
                                 dimension_numbers=('NWC', 'WIO', 'NWC'),
                                 feature_group_count=x.shape[-1])
    return y + b


def _linear_combine(left, right):
    a_l, b_l = left
    a_r, b_r = right
    return a_l * a_r, a_r * b_l + b_r


def rglru_scan(xs, wa, ba, wi, bi, lam, h0):
    B, L, _ = xs.shape
    xb = xs.reshape(B, L, RG_BLOCKS, RG_BW)
    r = jax.nn.sigmoid((jnp.einsum('blnc,ncd->blnd', xb, wa).reshape(B, L, D_RNN) + ba).astype(jnp.float32))
    i = jax.nn.sigmoid((jnp.einsum('blnc,ncd->blnd', xb, wi).reshape(B, L, D_RNN) + bi).astype(jnp.float32))
    log_a = -RG_C * r * jax.nn.softplus(-lam.astype(jnp.float32))
    a = jnp.exp(log_a)
    b = jnp.sqrt(-jnp.expm1(2.0 * log_a)) * i * xs.astype(jnp.float32)
    a_cum, h = lax.associative_scan(_linear_combine, (a, b), axis=1)
    if h0 is not None:
        h = h + a_cum * h0[:, None, :]
    return h, h[:, -1]


def rglru_mixer(h_ctx, h_lat, w_in, conv_w, conv_b, wa, ba, wi, bi, lam, w_out, with_ctx):
    z_lat = h_lat @ w_in
    gate_lat, x_lat = z_lat[..., :D_RNN], z_lat[..., D_RNN:]
    if with_ctx:
        z_ctx = h_ctx @ w_in
        gate_ctx, x_ctx = z_ctx[..., :D_RNN], z_ctx[..., D_RNN:]
    else:
        x_ctx = h_ctx @ w_in[:, D_RNN:]
    x_lat = centred_dwconv(x_lat, conv_w, conv_b)
    x_ctx = centred_dwconv(x_ctx, conv_w, conv_b)
    hl_dirs, hc_dirs = [], []
    for d in range(2):
        flip = (lambda t: t[:, ::-1]) if d == 1 else (lambda t: t)
        hc, hc_last = rglru_scan(flip(x_ctx), wa[d], ba[d], wi[d], bi[d], lam[d], None)
        hl, _ = rglru_scan(flip(x_lat), wa[d], ba[d], wi[d], bi[d], lam[d], hc_last)
        hl_dirs.append(flip(hl))
        if with_ctx:
            hc_dirs.append(flip(hc))
    y_lat = (jax.nn.gelu(gate_lat) * (hl_dirs[0] + hl_dirs[1]).astype(h_lat.dtype)) @ w_out
    y_ctx = None
    if with_ctx:
        y_ctx = (jax.nn.gelu(gate_ctx) * (hc_dirs[0] + hc_dirs[1]).astype(h_ctx.dtype)) @ w_out
    return y_ctx, y_lat


def axial_rope_tables(rows):
    row = jnp.broadcast_to(jnp.arange(rows, dtype=jnp.float32)[:, None], (rows, GRID_W)).reshape(-1)
    col = jnp.broadcast_to(jnp.arange(GRID_W, dtype=jnp.float32)[None, :], (rows, GRID_W)).reshape(-1)
    inv = ROPE_THETA ** (-jnp.arange(N_FREQ, dtype=jnp.float32) * 2.0 / AXIS_DIM)
    ang = jnp.stack([row[:, None] * inv, col[:, None] * inv], axis=1)
    return jnp.cos(ang), jnp.sin(ang)


def apply_axial_rope(x, cos, sin):
    xf = x.astype(jnp.float32).reshape(*x.shape[:-1], 2, 2, N_FREQ)
    x1, x2 = xf[..., 0, :], xf[..., 1, :]
    out = jnp.stack([x1 * cos - x2 * sin, x2 * cos + x1 * sin], axis=-2)
    return out.reshape(x.shape).astype(x.dtype)


def _project_heads(h, w_qkv, q_g, k_g, need_q):
    B, L, _ = h.shape
    nq = N_Q_HEADS * HEAD_DIM
    nkv = N_KV_HEADS * HEAD_DIM
    kv = h @ w_qkv[:, nq:]
    k = kv[..., :nkv].reshape(B, L, N_KV_HEADS, HEAD_DIM).transpose(0, 2, 1, 3)
    v = kv[..., nkv:].reshape(B, L, N_KV_HEADS, HEAD_DIM).transpose(0, 2, 1, 3)
    q = None
    if need_q:
        q = (h @ w_qkv[:, :nq]).reshape(B, L, N_KV_HEADS, GQA_GROUP, HEAD_DIM).transpose(0, 2, 3, 1, 4)
        q = rms_norm(q, q_g)
    return q, rms_norm(k, k_g), v


def _attend(q, k, v):
    s = jnp.einsum('bkgqd,bknd->bkgqn', q, k, preferred_element_type=jnp.float32) * (HEAD_DIM ** -0.5)
    p = jax.nn.softmax(s, axis=-1)
    return jnp.einsum('bkgqn,bknd->bkgqd', p.astype(v.dtype), v)


def attention_mixer(h_ctx, h_lat, w_qkv, q_g, k_g, w_o, cos, sin, with_ctx):
    B, L, _ = h_lat.shape
    q_c, k_c, v_c = _project_heads(h_ctx, w_qkv, q_g, k_g, with_ctx)
    q_l, k_l, v_l = _project_heads(h_lat, w_qkv, q_g, k_g, True)
    q_l = apply_axial_rope(q_l, cos, sin)
    k_l = apply_axial_rope(k_l, cos, sin)
    k_all = jnp.concatenate([k_c, k_l], axis=2)
    v_all = jnp.concatenate([v_c, v_l], axis=2)
    nblk = L // Q_BLOCK
    q_blocks = q_l.reshape(B, N_KV_HEADS, GQA_GROUP, nblk, Q_BLOCK, HEAD_DIM).transpose(3, 0, 1, 2, 4, 5)
    o = lax.map(lambda qb: _attend(qb, k_all, v_all), q_blocks)
    o = o.transpose(1, 0, 4, 2, 3, 5).reshape(B, L, N_Q_HEADS * HEAD_DIM)
    y_lat = o @ w_o
    y_ctx = None
    if with_ctx:
        oc = _attend(q_c, k_c, v_c)
        oc = oc.transpose(0, 3, 1, 2, 4).reshape(B, h_ctx.shape[1], N_Q_HEADS * HEAD_DIM)
        y_ctx = oc @ w_o
    return y_ctx, y_lat


def chunk_mlp(h, w_in, ln_g, ln_b, w_s, b_s, w_out):
    B, L, _ = h.shape
    z = jax.nn.gelu(h @ w_in)
    u, v = z[..., :D_CM], z[..., D_CM:]
    v = layer_norm(v, ln_g, ln_b).reshape(B, L // CHUNK, CHUNK, CM_GROUPS, CM_GW)
    v = jnp.einsum('gpq,bnqgc->bnpgc', w_s, v) + b_s.T[:, :, None]
    return (u * v.reshape(B, L, D_CM)) @ w_out


def hier_moe(xt, w_group, b_group, w_router, b_router, w_gate, w_up, w_down):
    T, D = xt.shape
    gl = (xt @ w_group + b_group).astype(jnp.float32)
    gp = jax.nn.softmax(gl, axis=-1)
    _, g_sel = lax.top_k(gl, 1)
    gate_g = jnp.take_along_axis(gp, g_sel, axis=1)
    el = (jnp.einsum('td,dge->tge', xt, w_router) + b_router).astype(jnp.float32)
    el = jnp.take_along_axis(el, g_sel[:, :, None], axis=1)[:, 0]
    top_v, top_i = lax.top_k(el, TOP_K)
    weights = jax.nn.softmax(top_v, axis=-1) * gate_g
    expert = g_sel * EXPERTS_PER_GROUP + top_i
    A = T * TOP_K
    flat_e = expert.reshape(-1)
    flat_w = weights.reshape(-1)
    flat_tok = jnp.repeat(jnp.arange(T, dtype=jnp.int32), TOP_K)
    order = jnp.argsort(flat_e)
    se = flat_e[order]
    counts = jnp.bincount(flat_e, length=N_EXPERTS)
    padded = (counts + MOE_BLOCK - 1) // MOE_BLOCK * MOE_BLOCK
    pad_end = jnp.cumsum(padded)
    pad_start = pad_end - padded
    start = jnp.cumsum(counts) - counts
    dest = pad_start[se] + jnp.arange(A, dtype=jnp.int32) - start[se]
    R = -(-A // MOE_BLOCK) * MOE_BLOCK + N_EXPERTS * MOE_BLOCK
    n_blocks = R // MOE_BLOCK
    row_tok = jnp.full((R,), T, jnp.int32).at[dest].set(flat_tok[order])
    row_w = jnp.zeros((R,), jnp.float32).at[dest].set(flat_w[order])
    blk_e = jnp.minimum(jnp.searchsorted(pad_end, jnp.arange(n_blocks, dtype=jnp.int32) * MOE_BLOCK,
                                         side='right'), N_EXPERTS - 1)
    x_rows = jnp.concatenate([xt, jnp.zeros((1, D), xt.dtype)], axis=0)[row_tok]
    x_rows = x_rows.reshape(n_blocks, MOE_BLOCK, D)

    def expert_block(args):
        xb, e = args
        return (jax.nn.silu(xb @ w_gate[e]) * (xb @ w_up[e])) @ w_down[e]

    y_rows = lax.map(expert_block, (x_rows, blk_e)).reshape(R, D)
    y = jax.ops.segment_sum(y_rows * row_w[:, None].astype(y_rows.dtype), row_tok, num_segments=T + 1)
    return y[:T]


def setup_inputs(seed: int = 0) -> dict:
    key = jax.random.key(seed)
    keys = iter(jax.random.split(key, 48))
    f32 = jnp.float32

    def normal(shape, scale):
        return jax.random.normal(next(keys), shape, f32) * scale

    n_a = len(range(0, DEPTH, N_MIXERS))
    n_b = len(range(1, DEPTH, N_MIXERS))
    n_c = len(range(2, DEPTH, N_MIXERS))
    a0 = jax.random.uniform(next(keys), (n_a, 2, D_RNN), f32, 0.9, 0.999) ** (1.0 / RG_C)
    hd_all = N_Q_HEADS * HEAD_DIM
    return {
        "x": normal((BATCH, SEQ, D_MODEL), 1.0),
        "c": normal((BATCH, D_MODEL), 1.0),
        "ctx": normal((BATCH, CTX_LEN, D_MODEL), 1.0),
        "c_ctx": normal((D_MODEL,), 1.0),
        "ada_w": normal((DEPTH, D_MODEL, N_MOD * D_MODEL), 0.5 * D_MODEL ** -0.5),
        "ada_b": normal((DEPTH, N_MOD * D_MODEL), 0.02),
        "norm_mix_g": 1.0 + normal((DEPTH, D_MODEL), 0.02),
        "norm_ffn_g": 1.0 + normal((DEPTH, D_MODEL), 0.02),
        "rg_w_in": normal((n_a, D_MODEL, 2 * D_RNN), D_MODEL ** -0.5),
        "rg_conv_w": normal((n_a, CONV_W, D_RNN), CONV_W ** -0.5),
        "rg_conv_b": normal((n_a, D_RNN), 0.02),
        "rg_wa": normal((n_a, 2, RG_BLOCKS, RG_BW, RG_BW), RG_BW ** -0.5),
        "rg_ba": normal((n_a, 2, D_RNN), 0.02),
        "rg_wi": normal((n_a, 2, RG_BLOCKS, RG_BW, RG_BW), RG_BW ** -0.5),
        "rg_bi": normal((n_a, 2, D_RNN), 0.02),
        "rg_lambda": jnp.log(a0) - jnp.log1p(-a0),
        "rg_w_out": normal((n_a, D_RNN, D_MODEL), D_RNN ** -0.5),
        "at_w_qkv": normal((n_b, D_MODEL, (N_Q_HEADS + 2 * N_KV_HEADS) * HEAD_DIM), D_MODEL ** -0.5),
        "at_q_g": 1.0 + normal((n_b, HEAD_DIM), 0.02),
        "at_k_g": 1.0 + normal((n_b, HEAD_DIM), 0.02),
        "at_w_o": normal((n_b, hd_all, D_MODEL), hd_all ** -0.5),
        "cm_w_in": normal((n_c, D_MODEL, 2 * D_CM), D_MODEL ** -0.5),
        "cm_ln_g": 1.0 + normal((n_c, D_CM), 0.02),
        "cm_ln_b": normal((n_c, D_CM), 0.02),
        "cm_w_s": normal((n_c, CM_GROUPS, CHUNK, CHUNK), CHUNK ** -0.5),
        "cm_b_s": 1.0 + normal((n_c, CM_GROUPS, CHUNK), 0.02),
        "cm_w_out": normal((n_c, D_CM, D_MODEL), D_CM ** -0.5),
        "moe_w_group": normal((DEPTH, D_MODEL, N_GROUPS), D_MODEL ** -0.5),
        "moe_b_group": normal((DEPTH, N_GROUPS), 0.01),
        "moe_w_router": normal((DEPTH, D_MODEL, N_GROUPS, EXPERTS_PER_GROUP), D_MODEL ** -0.5),
        "moe_b_router": normal((DEPTH, N_GROUPS, EXPERTS_PER_GROUP), 0.01),
        "moe_w_gate": normal((DEPTH, N_EXPERTS, D_MODEL, D_EXPERT), D_MODEL ** -0.5),
        "moe_w_up": normal((DEPTH, N_EXPERTS, D_MODEL, D_EXPERT), D_MODEL ** -0.5),
        "moe_w_down": normal((DEPTH, N_EXPERTS, D_EXPERT, D_MODEL), D_EXPERT ** -0.5),
    }


def reference(x, c, ctx, c_ctx, ada_w, ada_b, norm_mix_g, norm_ffn_g,
              rg_w_in, rg_conv_w, rg_conv_b, rg_wa, rg_ba, rg_wi, rg_bi, rg_lambda, rg_w_out,
              at_w_qkv, at_q_g, at_k_g, at_w_o,
              cm_w_in, cm_ln_g, cm_ln_b, cm_w_s, cm_b_s, cm_w_out,
              moe_w_group, moe_b_group, moe_w_router, moe_b_router, moe_w_gate, moe_w_up, moe_w_down):
    B, S, D = x.shape
    rows = S // GRID_W
    cos, sin = axial_rope_tables(rows)
    c_act = jax.nn.silu(c)
    cc_act = jax.nn.silu(c_ctx)
    for l in range(DEPTH):
        kind = l % N_MIXERS
        j = l // N_MIXERS
        last = l == DEPTH - 1
        with_ctx = not last
        mod_l = (c_act @ ada_w[l] + ada_b[l]).reshape(B, N_MOD, 1, D)
        mod_c = (cc_act @ ada_w[l] + ada_b[l]).reshape(N_MOD, D)
        h_lat = modulate(rms_norm(x, norm_mix_g[l]), mod_l[:, 0], mod_l[:, 1])
        need_ctx_in = not (last and kind == 2)
        h_ctx = modulate(rms_norm(ctx, norm_mix_g[l]), mod_c[0], mod_c[1]) if need_ctx_in else None
        if kind == 0:
            y_ctx, y_lat = rglru_mixer(h_ctx, h_lat, rg_w_in[j], rg_conv_w[j], rg_conv_b[j], rg_wa[j], rg_ba[j],
                                       rg_wi[j], rg_bi[j], rg_lambda[j], rg_w_out[j], with_ctx)
        elif kind == 1:
            y_ctx, y_lat = attention_mixer(h_ctx, h_lat, at_w_qkv[j], at_q_g[j], at_k_g[j], at_w_o[j],
                                           cos, sin, with_ctx)
        else:
            y_lat = chunk_mlp(h_lat, cm_w_in[j], cm_ln_g[j], cm_ln_b[j], cm_w_s[j], cm_b_s[j], cm_w_out[j])
            y_ctx = None
            if with_ctx:
                y_ctx = chunk_mlp(h_ctx, cm_w_in[j], cm_ln_g[j], cm_ln_b[j], cm_w_s[j], cm_b_s[j], cm_w_out[j])
        x = x + mod_l[:, 2] * y_lat
        hf_l = modulate(rms_norm(x, norm_ffn_g[l]), mod_l[:, 3], mod_l[:, 4])
        if last:
            y = hier_moe(hf_l.reshape(-1, D), moe_w_group[l], moe_b_group[l], moe_w_router[l],
                         moe_b_router[l], moe_w_gate[l], moe_w_up[l], moe_w_down[l])
            x = x + mod_l[:, 5] * y.reshape(B, S, D)
        else:
            ctx = ctx + mod_c[2] * y_ctx
            hf_c = modulate(rms_norm(ctx, norm_ffn_g[l]), mod_c[3], mod_c[4])
            n_ctx_tok = hf_c.shape[0] * hf_c.shape[1]
            tokens = jnp.concatenate([hf_c.reshape(-1, D), hf_l.reshape(-1, D)], axis=0)
            y = hier_moe(tokens, moe_w_group[l], moe_b_group[l], moe_w_router[l], moe_b_router[l],
                         moe_w_gate[l], moe_w_up[l], moe_w_down[l])
            ctx = ctx + mod_c[5] * y[:n_ctx_tok].reshape(ctx.shape)
            x = x + mod_l[:, 5] * y[n_ctx_tok:].reshape(B, S, D)
    return x
```

```cpp
#include <hip/hip_runtime.h>
#include <hip/hip_bf16.h>
#include <cstdio>
#include <cstdint>

#ifndef MK_PER_PHASE
#define MK_PER_PHASE 1
#endif

#ifndef PHASE_MASK
#define PHASE_MASK 0xFFFFFFFFu
#endif
#define PM(i) if constexpr ((PHASE_MASK >> (i)) & 1u)
#define LAS __attribute__((address_space(3)))
#define GAS __attribute__((address_space(1)))
typedef unsigned char uchar;
typedef unsigned short bf16_t;
typedef short bf16x8 __attribute__((ext_vector_type(8)));
typedef short s16x4 __attribute__((ext_vector_type(4)));
typedef float f32x4 __attribute__((ext_vector_type(4)));
typedef float f32x2 __attribute__((ext_vector_type(2)));
typedef float f32x16 __attribute__((ext_vector_type(16)));
typedef unsigned u32x4 __attribute__((ext_vector_type(4)));
typedef unsigned u32x2 __attribute__((ext_vector_type(2)));
typedef GAS unsigned gu32;
#define RLX_AGENT __ATOMIC_RELAXED, __HIP_MEMORY_SCOPE_AGENT

constexpr int D = 1024, NB = 4, SEQ = 4096, CTX = 256, SB = SEQ + CTX, T = NB * SB, DEPTH = 4;
constexpr int NMODV = 6 * D;
constexpr int NEXP = 32, DEXP = 512;
constexpr int NCHUNK = SB / 64;
constexpr float NORM_EPS = 1e-6f;

constexpr size_t MiB = 1u << 20;
constexpr size_t WS_CTL = 0, CTL_BYTES = 1 * MiB;
constexpr size_t WS_MOD = 1 * MiB;
constexpr size_t WS_ROPE = 2 * MiB;
constexpr size_t WS_SPL = 2 * MiB + 65536;
constexpr size_t WS_TOT = 3 * MiB;
constexpr size_t WS_STATP = 8 * MiB;
constexpr size_t WS_BK = 13 * MiB;
constexpr size_t WS_TW = 15 * MiB + 512 * 1024;
constexpr size_t WS_W_RGIN = 16 * MiB, WS_W_RGG = 24 * MiB, WS_W_RGOUT = 26 * MiB, WS_W_QKV = 30 * MiB, WS_W_AO = 33 * MiB;
constexpr size_t WS_W_CMIN = 35 * MiB, WS_W_CMS = 43 * MiB, WS_W_CMOUT = 44 * MiB, WS_W_E1 = 48 * MiB, WS_W_E2 = 304 * MiB;
constexpr size_t WS_X = 432 * MiB, WS_Y1 = 500 * MiB, WS_H = 568 * MiB, WS_SCR = 602 * MiB;
constexpr size_t WS_GG = WS_SCR, WS_XB = WS_SCR + 34 * MiB, WS_XC = WS_SCR + 68 * MiB, WS_LA = WS_SCR + 102 * MiB, WS_BB = WS_SCR + 170 * MiB, WS_SA = WS_SCR + 238 * MiB;
constexpr size_t WS_QKV = WS_SCR, WS_AO = WS_SCR + 51 * MiB;
constexpr size_t WS_UVB = WS_SCR, WS_UV = WS_SCR + 136 * MiB;
constexpr size_t WS_H1 = WS_SCR;
constexpr size_t WS_END = WS_SCR + 272 * MiB;
constexpr int CW_TMO = 0, CW_BAR = 4096, CW_CNT = 16384;

constexpr int RING_BYTES = 131072;
constexpr int ROUTER_LDS = 36 * 1024 * 4;
constexpr int LDSCTL_OFF = 147456;
constexpr int LDS_BYTES = LDSCTL_OFF + 1024 + 8 * 4 * 40 * 4;

__device__ __forceinline__ unsigned f2bf(float f) { unsigned u = __builtin_bit_cast(unsigned, f); return (u + 0x7fffu + ((u >> 16) & 1u)) >> 16; }
__device__ __forceinline__ unsigned pk2(float lo, float hi) { return f2bf(lo) | (f2bf(hi) << 16); }
__device__ __forceinline__ float bf2f(unsigned short h) { return __builtin_bit_cast(float, (unsigned)h << 16); }
__device__ __forceinline__ float bflo(unsigned w) { return __builtin_bit_cast(float, w << 16); }
__device__ __forceinline__ float bfhi(unsigned w) { return __builtin_bit_cast(float, w & 0xffff0000u); }
__device__ __forceinline__ unsigned cvt_pk_bf16(float lo, float hi) { unsigned r; asm volatile("v_cvt_pk_bf16_f32 %0, %1, %2" : "=v"(r) : "v"(lo), "v"(hi)); return r; }
__device__ __forceinline__ float gelu_tanh(float x) { const float u = 0.7978845608028654f * (x + 0.044715f * x * x * x); const float e = __expf(2.f * u); const float t = 1.f - 2.f / (e + 1.f); return 0.5f * x * (1.f + t); }
__device__ __forceinline__ float sigmoidf_(float x) { return 1.f / (1.f + __expf(-x)); }
__device__ __forceinline__ float fast_sigmoid(float x) { return __builtin_amdgcn_rcpf(1.f + __expf(-x)); }
__device__ __forceinline__ float one_minus_exp(float y) {   const float p = y * (1.f - y * (0.5f - y * (0.16666667f - y * 0.041666667f))); const float q = 1.f - __expf(-y); return y < 0.0625f ? p : q; }
__device__ __forceinline__ int sidx_of_row(int row) { const int b = row / SB; return (row - b * SB) < CTX ? 4 : b; }

namespace pg8 {
constexpr int BM = 256, BK = 64, HALF = 128, HTB = HALF * BK * 2, NXCD = 8, WGM = 8;
__device__ __forceinline__ int lds_byte(int r, int c) { const int st = (r >> 4) * 2 + (c >> 5), rr = r & 15, cc = c & 31, ob = rr * 64 + cc * 2; return st * 1024 + (ob ^ (((ob >> 9) & 1) << 5)); }
__device__ __forceinline__ void stage_rc(int b, int& R, int& C) { const int st = b / 1024, sb = b % 1024, swz = sb ^ (((sb >> 9) & 1) << 5); R = (st >> 1) * 16 + swz / 64; C = (st & 1) * 32 + (swz % 64) / 2; }
__device__ __forceinline__ int perm32(int rho) { const int n = rho >> 4, i = rho & 15; return 8 * (i >> 2) + 4 * n + (i & 3); }
struct Unit { const char* a; const char* b; int pm, pn, aux0, aux1; };
__device__ __forceinline__ const char* uptr(const char* p) { const unsigned long long v = (unsigned long long)p; const unsigned lo = __builtin_amdgcn_readfirstlane((unsigned)v), hi = __builtin_amdgcn_readfirstlane((unsigned)(v >> 32)); return (const char*)(((unsigned long long)hi << 32) | lo); }
__device__ __forceinline__ int xcd_remap(int L, int nwg) { const int q = nwg / NXCD, r = nwg % NXCD, xcd = L % NXCD, off = L / NXCD; return (xcd < r ? xcd * (q + 1) : r * (q + 1) + (xcd - r) * q) + off; }

struct DenseOrder {
    static constexpr bool GATHER = false;
    const char* A; const char* B; int nM, nN, nwg, G, c; size_t tA, tB; int amask, acol;
    __device__ void init(const void* A_, int lda, const void* B_, int ldb, int M, int N, int G_, int c_, int amask_ = 0, int acol_ = 0) {
        A = (const char*)A_; B = (const char*)B_; nM = M / BM; nN = N / BM; nwg = nM * nN; G = G_; c = c_; tA = (size_t)BM * lda * 2; tB = (size_t)BM * ldb * 2; amask = amask_; acol = acol_; }
    __device__ bool next(int i, Unit& u) const {
        const long L = (long)i * G + c; if (L >= nwg) return false;
        const int wgid = xcd_remap((int)L, nwg);
        const int nig = WGM * nN, gid = wgid / nig, fm = gid * WGM, gsz = (nM - fm) < WGM ? (nM - fm) : WGM;
        u.pm = __builtin_amdgcn_readfirstlane(fm + ((wgid % nig) % gsz)); u.pn = __builtin_amdgcn_readfirstlane((wgid % nig) / gsz); u.aux0 = 0; u.aux1 = 0;
        u.a = uptr(A + (size_t)u.pm * tA + (size_t)(u.pn & amask) * acol); u.b = uptr(B + (size_t)u.pn * tB); return true; }
    __device__ unsigned goff(const Unit&, int) const { return 0u; }
};

#define PG8_SA(b, h) (((b) * 2 + (h)) * HTB)
#define PG8_SB(b, h) ((4 + (b) * 2 + (h)) * HTB)
#define PG8_GLDS(gp, ldsoff) __builtin_amdgcn_global_load_lds((const unsigned*)(gp), (LAS unsigned*)(lds + (ldsoff)), 16, 0, 0)
#define PG8_STAGE_B(bufoff, gbase) do { PG8_GLDS((const char*)(gbase) + voffB[0], (bufoff) + ldsw); PG8_GLDS((const char*)(gbase) + voffB[1], (bufoff) + ldsw + 8192); } while (0)
#define PG8_STAGE_A(bufoff, gbase, h, NX) do { if constexpr (Sched::GATHER) { \
        PG8_GLDS((const char*)(gbase) + ((NX) ? vAn[h][0] : vAc[h][0]), (bufoff) + ldsw); PG8_GLDS((const char*)(gbase) + ((NX) ? vAn[h][1] : vAc[h][1]), (bufoff) + ldsw + 8192); \
    } else { PG8_GLDS((const char*)(gbase) + (h) * hstepA + voffA[0], (bufoff) + ldsw); PG8_GLDS((const char*)(gbase) + (h) * hstepA + voffA[1], (bufoff) + ldsw + 8192); } } while (0)
#define PG8_LDA(dst, b, h) do { _Pragma("unroll") for (int m = 0; m < 4; ++m) _Pragma("unroll") for (int k = 0; k < 2; ++k) dst[m][k] = *(const LAS bf16x8*)(lds + PG8_SA(b, h) + aoff + m * 2048 + k * 1024); } while (0)
#define PG8_LDB(dst, b, h) do { _Pragma("unroll") for (int n = 0; n < 2; ++n) _Pragma("unroll") for (int k = 0; k < 2; ++k) dst[n][k] = *(const LAS bf16x8*)(lds + PG8_SB(b, h) + boff + n * 2048 + k * 1024); } while (0)
#define PG8_MMA(ai, bj, At, Bt) do { __builtin_amdgcn_s_setprio(1); _Pragma("unroll") for (int m = 0; m < 4; ++m) _Pragma("unroll") for (int n = 0; n < 2; ++n) _Pragma("unroll") for (int k = 0; k < 2; ++k) \
        acc[ai][bj][m][n] = __builtin_amdgcn_mfma_f32_16x16x32_bf16(Bt[n][k], At[m][k], acc[ai][bj][m][n], 0, 0, 0); __builtin_amdgcn_s_setprio(0); } while (0)
#define PG8_WAIT_V(n) asm volatile("s_waitcnt vmcnt(" #n ")" ::: "memory")
#define PG8_WAIT_L(n) asm volatile("s_waitcnt lgkmcnt(" #n ")" ::: "memory")
#define PG8_BAR __builtin_amdgcn_s_barrier()
#define PG8_SCHED __builtin_amdgcn_sched_barrier(0)

template <class Epi, class Sched>
__device__ __forceinline__ void gemm_phase(LAS uchar* lds, const Sched& S, const Epi& E, const int K, const int lda, const int ldb) {
    int tid = threadIdx.x; asm volatile("" : "+v"(tid));
    const int wid = __builtin_amdgcn_readfirstlane(tid >> 6), lane = tid & 63, wr = wid >> 2, wc = wid & 3; int fr = lane & 15, fq = lane >> 4;
    int nt = K / BK; asm volatile("" : "+s"(nt));
    unsigned voffA[2], voffB[2]; int Rs[2], Cs[2];
#pragma unroll
    for (int i = 0; i < 2; ++i) { int R, C; stage_rc(tid * 16 + i * 8192, R, C); const int Rb = Epi::PERM ? ((R & ~31) + perm32(R & 31)) : R;
        Rs[i] = R; Cs[i] = C; voffA[i] = (unsigned)(R * lda + C) * 2u; voffB[i] = (unsigned)(Rb * ldb + C) * 2u; }
    const size_t kstep = (size_t)(BK * 2);
    const size_t hstepA = (size_t)HALF * lda * 2, hstepB = (size_t)HALF * ldb * 2;
    const unsigned ldsw = (unsigned)wid * 1024u;
    const int aoff = lds_byte(wr * 64 + fr, fq * 8), boff = lds_byte(wc * 32 + fr, fq * 8);
    Unit cur, nxt; int ui = 0;
    if (!S.next(0, cur)) return;
    unsigned vAc[2][2], vAn[2][2];
#pragma unroll
    for (int h = 0; h < 2; ++h)
#pragma unroll
        for (int i = 0; i < 2; ++i) { vAc[h][i] = 0u; vAn[h][i] = 0u; }
    if constexpr (Sched::GATHER) {
#pragma unroll
        for (int h = 0; h < 2; ++h)
#pragma unroll
            for (int i = 0; i < 2; ++i) vAc[h][i] = S.goff(cur, h * HALF + Rs[i]) + (unsigned)Cs[i] * 2u;
    }
    f32x4 acc[2][2][4][2];
#pragma unroll
    for (int a = 0; a < 2; ++a)
#pragma unroll
        for (int b = 0; b < 2; ++b)
#pragma unroll
            for (int m = 0; m < 4; ++m)
#pragma unroll
                for (int n = 0; n < 2; ++n) acc[a][b][m][n] = (f32x4){0.f, 0.f, 0.f, 0.f};
    bf16x8 At[4][2], B0[2][2], B1[2][2];
    const char* cA = cur.a; const char* cB = cur.b;
    PG8_STAGE_B(PG8_SB(0, 0), cB); PG8_STAGE_B(PG8_SB(0, 1), cB + hstepB); PG8_STAGE_A(PG8_SA(0, 0), cA, 0, false); PG8_STAGE_A(PG8_SA(0, 1), cA, 1, false);
    if (wr == 1) PG8_BAR;
    PG8_WAIT_V(2); PG8_BAR;
    PG8_STAGE_B(PG8_SB(1, 0), cB + kstep); PG8_STAGE_A(PG8_SA(1, 0), cA + kstep, 0, false); PG8_STAGE_B(PG8_SB(1, 1), cB + hstepB + kstep);
    PG8_WAIT_V(6); PG8_BAR;
    for (;;) {
        const bool has_next = S.next(ui + 1, nxt);
        if constexpr (Sched::GATHER) { if (has_next) {
#pragma unroll
            for (int h = 0; h < 2; ++h)
#pragma unroll
                for (int i = 0; i < 2; ++i) vAn[h][i] = S.goff(nxt, h * HALF + Rs[i]) + (unsigned)Cs[i] * 2u; } }
        const char* nA = has_next ? nxt.a : cA; const char* nB = has_next ? nxt.b : cB;
        for (int t = 0; t < nt; t += 2) {
            const bool last = (t == nt - 2);
            const bool nx = last && has_next;
            const char* a1 = cA + (size_t)(t + 1) * kstep;
            const char* a2 = last ? nA : cA + (size_t)(t + 2) * kstep; const char* b2 = last ? nB : cB + (size_t)(t + 2) * kstep;
            const char* a3 = a2 + kstep; const char* b3 = b2 + kstep;
            PG8_LDB(B0, 0, 0); PG8_LDB(B1, 0, 1); PG8_SCHED; PG8_LDA(At, 0, 0); PG8_STAGE_A(PG8_SA(1, 1), a1, 1, false);
            PG8_WAIT_V(8); PG8_WAIT_L(0); PG8_BAR; PG8_MMA(0, 0, At, B0); PG8_MMA(0, 1, At, B1); PG8_BAR; PG8_SCHED;
            PG8_LDA(At, 0, 1); PG8_STAGE_B(PG8_SB(0, 0), b2); PG8_STAGE_B(PG8_SB(0, 1), b2 + hstepB); PG8_STAGE_A(PG8_SA(0, 0), a2, 0, nx);
            PG8_WAIT_V(8); PG8_WAIT_L(0); PG8_BAR; PG8_MMA(1, 0, At, B0); PG8_MMA(1, 1, At, B1); PG8_BAR; PG8_SCHED;
            PG8_LDB(B0, 1, 0); PG8_LDB(B1, 1, 1); PG8_SCHED; PG8_LDA(At, 1, 0); PG8_STAGE_A(PG8_SA(0, 1), a2, 1, nx);
            PG8_WAIT_V(8); PG8_WAIT_L(0); PG8_BAR; PG8_MMA(0, 0, At, B0); PG8_MMA(0, 1, At, B1); PG8_BAR; PG8_SCHED;
            PG8_LDA(At, 1, 1); PG8_STAGE_B(PG8_SB(1, 0), b3); PG8_STAGE_B(PG8_SB(1, 1), b3 + hstepB); PG8_STAGE_A(PG8_SA(1, 0), a3, 0, nx);
            PG8_WAIT_V(8); PG8_WAIT_L(0); PG8_BAR; PG8_MMA(1, 0, At, B0); PG8_MMA(1, 1, At, B1); PG8_BAR; PG8_SCHED;
        }
        if (wr == 0) PG8_BAR;
        E(acc, cur, wr, wc, fr, fq);
        if (!has_next) break;
#pragma unroll
        for (int a = 0; a < 2; ++a)
#pragma unroll
            for (int b = 0; b < 2; ++b)
#pragma unroll
                for (int m = 0; m < 4; ++m)
#pragma unroll
                    for (int n = 0; n < 2; ++n) acc[a][b][m][n] = (f32x4){0.f, 0.f, 0.f, 0.f};
        cur = nxt; cA = nA; cB = nB; ++ui;
        if constexpr (Sched::GATHER) {
#pragma unroll
            for (int h = 0; h < 2; ++h)
#pragma unroll
                for (int i = 0; i < 2; ++i) vAc[h][i] = vAn[h][i]; }
        if (wr == 1) PG8_BAR;
    }
    PG8_WAIT_V(0);
    PG8_BAR;
}
}

namespace att {
constexpr int NW = 8, QBLK = 32, KVBLK = 64;
constexpr float SCALE = 0.088388347648318440f;
constexpr float THR = 8.f;
constexpr int LDQ = 1536, LDK = 1536, LDO = 1024;
constexpr size_t SHM_V = KVBLK * 128 * 2, SHM_K = KVBLK * 128 * 2, SHM_ATTN = 2 * SHM_V + 2 * SHM_K + NW * 64 * 4;
#define KSWZ(row, colB) ((row) * 256 + ((colB) ^ (((row) & 7) << 4)))
#define SBAR() __builtin_amdgcn_sched_barrier(0)
__device__ __forceinline__ int crow(int r, int hi) { return (r & 3) + 8 * (r >> 2) + 4 * hi; }
__device__ __forceinline__ void partialSM(f32x16& p0, f32x16& p1, float& m_reg, float& mn, float& alpha) {
  constexpr float C = SCALE * 1.4426950408889634f;
  float pmax = p0[0];
#pragma unroll
  for (int r = 1; r < 16; ++r) pmax = fmaxf(pmax, p0[r]);
#pragma unroll
  for (int r = 0; r < 16; ++r) pmax = fmaxf(pmax, p1[r]);
  { auto rr = __builtin_amdgcn_permlane32_swap(__float_as_uint(pmax), __float_as_uint(pmax), false, false);
    pmax = fmaxf(__uint_as_float(rr[0]), __uint_as_float(rr[1])); }
  if (__builtin_expect(__all(pmax - m_reg <= THR / SCALE), 1)) { mn = m_reg; alpha = 1.f; }
  else { mn = fmaxf(m_reg, pmax); alpha = __builtin_amdgcn_exp2f((m_reg - mn) * C); m_reg = mn; }
  float mnC = -mn * C;
#pragma unroll
  for (int r = 0; r < 16; ++r) p0[r] = fmaf(p0[r], C, mnC);
#pragma unroll
  for (int r = 0; r < 16; ++r) p1[r] = fmaf(p1[r], C, mnC);
#pragma unroll
  for (int r = 0; r < 16; ++r) p0[r] = __builtin_amdgcn_exp2f(p0[r]);
}
__device__ __forceinline__ void finishSM(f32x16& p0, f32x16& p1, float alpha, float& l_reg, bf16x8& pa0, bf16x8& pa1, bf16x8& pa2, bf16x8& pa3) {
#pragma unroll
  for (int r = 0; r < 16; ++r) p1[r] = __builtin_amdgcn_exp2f(p1[r]);
  float ps = 0;
#pragma unroll
  for (int r = 0; r < 16; ++r) ps += p0[r];
#pragma unroll
  for (int r = 0; r < 16; ++r) ps += p1[r];
  { auto rr = __builtin_amdgcn_permlane32_swap(__float_as_uint(ps), __float_as_uint(ps), false, false);
    ps = __uint_as_float(rr[0]) + __uint_as_float(rr[1]); }
  l_reg = l_reg * alpha + ps;
#define PK4(P, BASE, OUT) do { unsigned a0 = cvt_pk_bf16(P[BASE + 0], P[BASE + 1]), a1 = cvt_pk_bf16(P[BASE + 2], P[BASE + 3]);   \
    unsigned b0 = cvt_pk_bf16(P[BASE + 4], P[BASE + 5]), b1 = cvt_pk_bf16(P[BASE + 6], P[BASE + 7]);                              \
    auto r0 = __builtin_amdgcn_permlane32_swap(a0, b0, false, false); auto r1 = __builtin_amdgcn_permlane32_swap(a1, b1, false, false); \
    u32x4 w = {r0[0], r1[0], r0[1], r1[1]}; OUT = __builtin_bit_cast(bf16x8, w); } while (0)
  PK4(p0, 0, pa0); PK4(p0, 8, pa1); PK4(p1, 0, pa2); PK4(p1, 8, pa3);
#undef PK4
}
__device__ __forceinline__ void qkt(f32x16& p0, f32x16& p1, const bf16_t* Ks, const bf16x8* qr, int r32, int hi) {
  p0 = f32x16{}; p1 = f32x16{};
#pragma unroll
  for (int d0 = 0; d0 < 8; ++d0) { int cb = (d0 * 16 + hi * 8) * 2;
    bf16x8 b0 = *reinterpret_cast<const bf16x8*>((const char*)Ks + KSWZ(r32, cb));
    bf16x8 b1 = *reinterpret_cast<const bf16x8*>((const char*)Ks + KSWZ(32 + r32, cb));
    p0 = __builtin_amdgcn_mfma_f32_32x32x16_bf16(b0, qr[d0], p0, 0, 0, 0);
    p1 = __builtin_amdgcn_mfma_f32_32x32x16_bf16(b1, qr[d0], p1, 0, 0, 0); }
}
__device__ __forceinline__ int v_st(int k, int c) { const int kk = (k & ~0xC) | ((k & 4) << 1) | ((k & 8) >> 1); return ((kk >> 3) * 4 + (c >> 5)) * 512 + ((kk & 7) * 32 + (c & 31)) * 2; }
__device__ __forceinline__ int v_rd_base(int lane) { return ((lane & 3) << 3) | (((lane >> 2) & 3) << 6) | (((lane >> 4) & 1) << 5) | (((lane >> 5) & 1) << 8); }
constexpr int v_rd_off(int d0, int ks, int half) { return d0 * 512 + ks * 4096 + half * 2048; }
template <int OFF> __device__ __forceinline__ s16x4 tr_read(int vb) {
  s16x4 r; asm volatile("ds_read_b64_tr_b16 %0, %1 offset:%2" : "=&v"(r) : "v"(vb), "i"(OFF) : "memory"); return r;
}
template <int D0> __device__ __forceinline__ void pv_one(f32x16& od, int vb, bf16x8 pa0, bf16x8 pa1, bf16x8 pa2, bf16x8 pa3) {
  const s16x4 l0 = tr_read<v_rd_off(D0, 0, 0)>(vb), h0 = tr_read<v_rd_off(D0, 0, 1)>(vb), l1 = tr_read<v_rd_off(D0, 1, 0)>(vb), h1 = tr_read<v_rd_off(D0, 1, 1)>(vb);
  const s16x4 l2 = tr_read<v_rd_off(D0, 2, 0)>(vb), h2 = tr_read<v_rd_off(D0, 2, 1)>(vb), l3 = tr_read<v_rd_off(D0, 3, 0)>(vb), h3 = tr_read<v_rd_off(D0, 3, 1)>(vb);
  asm volatile("s_waitcnt lgkmcnt(0)" ::: "memory"); SBAR();
#define PK(L, H) (bf16x8){L[0], L[1], L[2], L[3], H[0], H[1], H[2], H[3]}
  od = __builtin_amdgcn_mfma_f32_32x32x16_bf16(pa0, PK(l0, h0), od, 0, 0, 0);
  od = __builtin_amdgcn_mfma_f32_32x32x16_bf16(pa1, PK(l1, h1), od, 0, 0, 0);
  od = __builtin_amdgcn_mfma_f32_32x32x16_bf16(pa2, PK(l2, h2), od, 0, 0, 0);
  od = __builtin_amdgcn_mfma_f32_32x32x16_bf16(pa3, PK(l3, h3), od, 0, 0, 0);
#undef PK
}
__device__ __forceinline__ void pv_d0(f32x16* o, int vb, bf16x8 pa0, bf16x8 pa1, bf16x8 pa2, bf16x8 pa3) {
  pv_one<0>(o[0], vb, pa0, pa1, pa2, pa3); pv_one<1>(o[1], vb, pa0, pa1, pa2, pa3); pv_one<2>(o[2], vb, pa0, pa1, pa2, pa3); pv_one<3>(o[3], vb, pa0, pa1, pa2, pa3);
}
__device__ __forceinline__ void attn_dense_body(const bf16_t* Qb, const bf16_t* Kh, const bf16_t* Vh, bf16_t* Ob, int seq, char* lds, const int tid) {
  const int wid = tid >> 6, lane = tid & 63, r32 = lane & 31, hi = lane >> 5;
  bf16_t* V_lds = (bf16_t*)lds; bf16_t* K_lds = (bf16_t*)(lds + 2 * SHM_V);
  float* ws = (float*)(lds + 2 * SHM_V + 2 * SHM_K) + wid * 64; float* li_l = ws; float* al_l = ws + 32;
  float m_reg = -1e30f, l_reg = 0; f32x16 o[4] = {}; bf16x8 qr[8];
  const bf16_t* Qw = Qb + (long)(wid * QBLK + r32) * LDQ + hi * 8;
#pragma unroll
  for (int d0 = 0; d0 < 8; ++d0) qr[d0] = *reinterpret_cast<const bf16x8*>(Qw + d0 * 16);
  const int sr = tid >> 4, sc = (tid & 15) * 8, vst0 = v_st(sr, sc), vst1 = v_st(32 + sr, sc);
  const int vb0 = (int)(uintptr_t)V_lds + v_rd_base(lane);
  struct { bf16x8 vs0, vs1, ks0, ks1; } sr_[2];
  const unsigned vo0 = (unsigned)(sr * LDK + sc) * 2u, vo1 = (unsigned)((32 + sr) * LDK + sc) * 2u;
  const long vdelta = (const char*)Vh - (const char*)Kh;
#define SLOAD(i, k0) do { const char* kb_ = (const char*)Kh + (size_t)(k0) * (LDK * 2); const char* vb_ = kb_ + vdelta; \
    sr_[i].vs0 = *reinterpret_cast<const bf16x8*>(vb_ + vo0); sr_[i].vs1 = *reinterpret_cast<const bf16x8*>(vb_ + vo1); \
    sr_[i].ks0 = *reinterpret_cast<const bf16x8*>(kb_ + vo0); sr_[i].ks1 = *reinterpret_cast<const bf16x8*>(kb_ + vo1); } while (0)
#define SWRITE(b, i) do { *(bf16x8*)((char*)V_lds + (b) * SHM_V + vst0) = sr_[i].vs0;          \
    *(bf16x8*)((char*)V_lds + (b) * SHM_V + vst1) = sr_[i].vs1; int kc = sc * 2;               \
    *(bf16x8*)((char*)K_lds + (b) * SHM_K + KSWZ(sr, kc)) = sr_[i].ks0;                       \
    *(bf16x8*)((char*)K_lds + (b) * SHM_K + KSWZ(32 + sr, kc)) = sr_[i].ks1; } while (0)
#define SWAIT() asm volatile("s_waitcnt vmcnt(4)" ::: "memory")
#define RESC(a) do { if (__any((a) < 1.f)) { if (hi == 0) al_l[r32] = (a); asm volatile("s_waitcnt lgkmcnt(0)" ::: "memory"); \
    _Pragma("unroll") for (int d = 0; d < 4; ++d) _Pragma("unroll") for (int r = 0; r < 16; ++r) o[d][r] *= al_l[crow(r, hi)]; } } while (0)
  f32x16 pA0, pA1, pB0, pB1; float mnA, mnB, alA, alB; bf16x8 pa0, pa1, pa2, pa3; const int NT = seq / KVBLK;
  constexpr int SE = 0, SO = 1;
  SLOAD(SE, 0); asm volatile("s_waitcnt vmcnt(0)" ::: "memory"); SWRITE(0, SE); __syncthreads();
  qkt(pA0, pA1, K_lds, qr, r32, hi); partialSM(pA0, pA1, m_reg, mnA, alA);
  SLOAD(SO, KVBLK); if (2 < NT) SLOAD(SE, 2 * KVBLK);
  SWAIT(); SWRITE(1, SO); __syncthreads();
  for (int j = 1; j + 1 < NT; j += 2) {
    SBAR(); qkt(pB0, pB1, (bf16_t*)((char*)K_lds + SHM_K), qr, r32, hi);
    finishSM(pA0, pA1, alA, l_reg, pa0, pa1, pa2, pa3); SBAR();
    SLOAD(SO, (j + 2) * KVBLK); SBAR();
    pv_d0(o, vb0, pa0, pa1, pa2, pa3); partialSM(pB0, pB1, m_reg, mnB, alB);
    __syncthreads(); SWAIT(); SWRITE(0, SE);
    RESC(alB); __syncthreads();
    SBAR(); qkt(pA0, pA1, K_lds, qr, r32, hi);
    finishSM(pB0, pB1, alB, l_reg, pa0, pa1, pa2, pa3); SBAR();
    if (j + 3 < NT) SLOAD(SE, (j + 3) * KVBLK); SBAR();
    pv_d0(o, vb0 + (int)SHM_V, pa0, pa1, pa2, pa3); partialSM(pA0, pA1, m_reg, mnA, alA);
    __syncthreads(); SWAIT(); SWRITE(1, SO);
    RESC(alA); __syncthreads();
  }
  SBAR(); qkt(pB0, pB1, (bf16_t*)((char*)K_lds + SHM_K), qr, r32, hi);
  finishSM(pA0, pA1, alA, l_reg, pa0, pa1, pa2, pa3); SBAR();
  pv_d0(o, vb0, pa0, pa1, pa2, pa3); partialSM(pB0, pB1, m_reg, mnB, alB);
  __syncthreads(); RESC(alB);
  finishSM(pB0, pB1, alB, l_reg, pa0, pa1, pa2, pa3); SBAR();
  pv_d0(o, vb0 + (int)SHM_V, pa0, pa1, pa2, pa3);
  if (hi == 0) li_l[r32] = l_reg; asm volatile("s_waitcnt lgkmcnt(0)" ::: "memory");
  float rli[16];
#pragma unroll
  for (int r = 0; r < 16; ++r) rli[r] = __builtin_amdgcn_rcpf(li_l[crow(r, hi)]);
  bf16_t* Ow = Ob + (long)(wid * QBLK) * LDO;
#pragma unroll
  for (int r = 0; r < 16; ++r) { int orow = crow(r, hi);
#pragma unroll
    for (int d0 = 0; d0 < 4; ++d0) Ow[(long)orow * LDO + d0 * 32 + r32] = (bf16_t)f2bf(o[d0][r] * rli[r]); }
#undef SLOAD
#undef SWRITE
#undef SWAIT
#undef RESC
}
}

#define XB_TMO      128
#define XB_XCNT(j)  (256  + 64 * (j))
#define XB_XSUB(j)  (1280 + 64 * (j))
#define XB_XGEN(j)  (2304 + 64 * (j))
#define XB_TOP      3328
#define XB_TOPGEN   3392
#define XB_SPIN_CAP (1u << 22)
__device__ __forceinline__ unsigned xb_ld(unsigned* p)              { return __hip_atomic_load(p, __ATOMIC_RELAXED, __HIP_MEMORY_SCOPE_AGENT); }
__device__ __forceinline__ unsigned xb_add(unsigned* p, unsigned v) { return __hip_atomic_fetch_add(p, v, __ATOMIC_RELAXED, __HIP_MEMORY_SCOPE_AGENT); }
__device__ __forceinline__ unsigned xb_xcc_id() { return (unsigned)__builtin_amdgcn_s_getreg((3 << 11) | 20) & 0xFu; }
#define XB_SPIN(cond, bar) do { unsigned _sp = 0; while (cond) { __builtin_amdgcn_s_sleep(1); \
    if ((++_sp & 255u) == 0u) { if (xb_ld(&(bar)[XB_TMO])) break; if (_sp > XB_SPIN_CAP) { atomicAdd(&(bar)[XB_TMO], 1u); break; } } } } while (0)
struct XcdBarrier { unsigned* bar; unsigned x; volatile LAS unsigned* st; };
__device__ __forceinline__ XcdBarrier xcd_barrier_post(unsigned* bar, volatile LAS unsigned* st) {
    XcdBarrier b; b.bar = bar; b.x = xb_xcc_id(); b.st = st;
    if (threadIdx.x == 0) (void)xb_add(&bar[XB_XCNT(b.x)], 1u);
    return b;
}
__device__ __forceinline__ void xcd_barrier_complete(unsigned* bar, unsigned x, unsigned& nloc, unsigned& nx) {
    const unsigned G = gridDim.x * gridDim.y * gridDim.z;
    unsigned sum, cnt, mine, sp = 0u;
    for (;;) {
        sum = 0u; cnt = 0u; mine = 0u;
#pragma unroll
        for (unsigned j = 0; j < 16; ++j) { const unsigned c = xb_ld(&bar[XB_XCNT(j)]); sum += c; cnt += (c > 0u) ? 1u : 0u; mine = (j == x) ? c : mine; }
        if (sum == G) break;
        __builtin_amdgcn_s_sleep(1);
        if ((++sp & 255u) == 0u) { if (xb_ld(&bar[XB_TMO])) break; if (sp > XB_SPIN_CAP) { atomicAdd(&bar[XB_TMO], 1u); break; } }
    }
    nloc = mine > 0u ? mine : 1u; nx = cnt > 0u ? cnt : 1u;
}
__device__ __forceinline__ void xcd_barrier(const XcdBarrier& b_) {
    XcdBarrier b; b.bar = b_.bar; b.st = b_.st; b.x = xb_xcc_id();
    asm volatile("s_waitcnt vmcnt(0)" ::: "memory");
    __syncthreads();
    if (threadIdx.x == 0) {
        unsigned* bar = b.bar;
        __builtin_amdgcn_s_waitcnt(0);
        unsigned nloc = b.st[0], nx = b.st[1];
        if (nloc == 0u) { xcd_barrier_complete(bar, b.x, nloc, nx); b.st[0] = nloc; b.st[1] = nx; }
        const unsigned old = xb_add(&bar[XB_XSUB(b.x)], 1u);
        const unsigned gen = old / nloc;
        if (old + 1u == (gen + 1u) * nloc) {
            __builtin_amdgcn_fence(__ATOMIC_RELEASE, "agent");
            asm volatile("s_waitcnt vmcnt(0)" ::: "memory");
            const unsigned og = xb_add(&bar[XB_TOP], 1u);
            const unsigned tg = og / nx;
            if (og + 1u == (tg + 1u) * nx) xb_add(&bar[XB_TOPGEN], 1u);
            else XB_SPIN(xb_ld(&bar[XB_TOPGEN]) == tg, bar);
            __builtin_amdgcn_fence(__ATOMIC_ACQUIRE, "agent");
            xb_add(&bar[XB_XGEN(b.x)], 1u);
            asm volatile("s_waitcnt vmcnt(0)" ::: "memory");
        } else {
            XB_SPIN(xb_ld(&bar[XB_XGEN(b.x)]) == gen, bar);
            __builtin_amdgcn_fence(__ATOMIC_ACQUIRE, "agent");
            asm volatile("s_waitcnt vmcnt(0)" ::: "memory");
        }
    }
    __syncthreads();
}

struct Args { const float* in[34]; float* out; uchar* ws; int ph_lo, ph_hi; };
enum { I_X = 0, I_C, I_CTX, I_CCTX, I_ADAW, I_ADAB, I_NMG, I_NFG, I_RGWIN, I_RGCW, I_RGCB, I_RGWA, I_RGBA, I_RGWI, I_RGBI, I_RGLAM, I_RGWOUT,
       I_ATQKV, I_ATQG, I_ATKG, I_ATWO, I_CMWIN, I_CMLNG, I_CMLNB, I_CMWS, I_CMBS, I_CMWOUT, I_MWG, I_MBG, I_MWR, I_MBR, I_MWGATE, I_MWUP, I_MWDOWN };

__device__ __forceinline__ const void* opaque_uniform_ptr(const void* p) { const unsigned long long v = (unsigned long long)p; unsigned lo = (unsigned)v, hi = (unsigned)(v >> 32); asm volatile("" : "+v"(lo), "+v"(hi));
    lo = __builtin_amdgcn_readfirstlane(lo); hi = __builtin_amdgcn_readfirstlane(hi); return (const void*)(((unsigned long long)hi << 32) | lo); }
__device__ __forceinline__ int opaque_uniform_int(int x) { asm volatile("" : "+v"(x)); return __builtin_amdgcn_readfirstlane(x); }
struct Frame {
    LAS uchar* lds; char* ldsg;
    int tid, lane, wave, G, bid;
    uchar* ws; const float* const* in; float* out;
};
__device__ __forceinline__ float wave16_sum(float v) { v += __shfl_xor(v, 1); v += __shfl_xor(v, 2); v += __shfl_xor(v, 4); v += __shfl_xor(v, 8); return v; }

__device__ __forceinline__ void tr_item(const float* W, int ldw, bf16_t* WT, int ldt, int k0, int n0, int dstrow0, LAS float* scr, int lane) {
#pragma unroll 8
    for (int i = 0; i < 32; ++i) { const int kk = 2 * i + (lane >> 5); scr[kk * 33 + (lane & 31)] = W[(size_t)(k0 + kk) * ldw + n0 + (lane & 31)]; }
    asm volatile("s_waitcnt lgkmcnt(0)" ::: "memory");
    const int c = lane & 7;
#pragma unroll
    for (int j = 0; j < 4; ++j) { const int n = (lane >> 3) + 8 * j; const LAS float* s = scr + (8 * c) * 33 + n;
        u32x4 o; o.x = pk2(s[0 * 33], s[1 * 33]); o.y = pk2(s[2 * 33], s[3 * 33]); o.z = pk2(s[4 * 33], s[5 * 33]); o.w = pk2(s[6 * 33], s[7 * 33]);
        *(u32x4*)(WT + (size_t)(dstrow0 + n) * ldt + k0 + 8 * c) = o; }
    asm volatile("s_waitcnt lgkmcnt(0)" ::: "memory");
}
__device__ __forceinline__ bool tr_group(int& r, const float* W, int K, int N, int nmat, bf16_t* WT, int ldt, size_t dst_mat_stride, int mode, LAS float* scr, int lane) {
    const int per = (K / 64) * (N / 32), tot = per * nmat;
    if (r >= tot) { r -= tot; return false; }
    const int mat = r / per, it = r % per, nblk = N / 32, kb = it / nblk, nb = it % nblk, n0 = nb * 32;
    int drow = n0;
    if (mode == 1) drow = (n0 >> 7) * 256 + (n0 & 127);
    else if (mode == 2) drow = (n0 >> 7) * 256 + 128 + (n0 & 127);
    tr_item(W + (size_t)mat * K * N, N, WT + (size_t)mat * dst_mat_stride, ldt, kb * 64, n0, drow, scr, lane);
    return true;
}
__device__ __forceinline__ void p0_prologue(Frame& F) {
    const float* const* in = F.in; uchar* ws = F.ws;
    {
        LAS float* act = (LAS float*)(F.lds);
        LAS float* red = (LAS float*)(F.lds + 5 * 1024 * 4);
        bool have = false;
        for (int it = F.bid; it < DEPTH * 24; it += F.G) {
            if (!have) { for (int i = F.tid; i < 5 * 1024; i += 512) { const int s = i >> 10, k = i & 1023; const float v = s < 4 ? in[I_C][s * 1024 + k] : in[I_CCTX][k]; act[i] = v / (1.f + __expf(-v)); } have = true; __syncthreads(); }
            const int l = it / 24, cb = it % 24;
            const float* W = in[I_ADAW] + (size_t)l * 1024 * NMODV + cb * 256 + F.lane * 4;
            f32x4 a[5];
#pragma unroll
            for (int s = 0; s < 5; ++s) a[s] = (f32x4){0.f, 0.f, 0.f, 0.f};
            const int kbase = F.wave * 128;
#pragma unroll 8
            for (int k = 0; k < 128; ++k) { const f32x4 w = *(const f32x4*)(W + (size_t)(kbase + k) * NMODV);
#pragma unroll
                for (int s = 0; s < 5; ++s) a[s] += w * act[s * 1024 + kbase + k]; }
#pragma unroll
            for (int s = 0; s < 5; ++s) *(LAS f32x4*)(red + (F.wave * 5 + s) * 256 + F.lane * 4) = a[s];
            __syncthreads();
            for (int i = F.tid; i < 5 * 256; i += 512) { const int s = i >> 8, c = i & 255; float v = in[I_ADAB][l * NMODV + cb * 256 + c];
#pragma unroll
                for (int w = 0; w < 8; ++w) v += red[(w * 5 + s) * 256 + c];
                ((float*)(ws + WS_MOD))[(l * 5 + s) * NMODV + cb * 256 + c] = v; }
            __syncthreads();
        }
        __syncthreads();
    }
    {
        LAS float* scr = (LAS float*)(F.lds + F.wave * 16384);
        const int gw = F.bid * 8 + F.wave, NGW = F.G * 8;
        constexpr int NITEMS = 2048 + 512 + 1024 + 768 + 512 + 2048 + 1024 + 3 * 32768;
        for (int it = gw; it < NITEMS; it += NGW) {
            int r = it;
            if (tr_group(r, in[I_MWGATE], 1024, 512, 128, (bf16_t*)(ws + WS_W_E1), 1024, (size_t)1024 * 1024, 1, scr, F.lane)) continue;
            if (tr_group(r, in[I_MWUP], 1024, 512, 128, (bf16_t*)(ws + WS_W_E1), 1024, (size_t)1024 * 1024, 2, scr, F.lane)) continue;
            if (tr_group(r, in[I_MWDOWN], 512, 1024, 128, (bf16_t*)(ws + WS_W_E2), 512, (size_t)1024 * 512, 0, scr, F.lane)) continue;
            if (tr_group(r, in[I_RGWIN], 1024, 2048, 2, (bf16_t*)(ws + WS_W_RGIN), 1024, (size_t)2048 * 1024, 0, scr, F.lane)) continue;
            if (tr_group(r, in[I_CMWIN], 1024, 4096, 1, (bf16_t*)(ws + WS_W_CMIN), 1024, 0, 0, scr, F.lane)) continue;
            if (tr_group(r, in[I_RGWOUT], 1024, 1024, 2, (bf16_t*)(ws + WS_W_RGOUT), 1024, (size_t)1024 * 1024, 0, scr, F.lane)) continue;
            if (tr_group(r, in[I_CMWOUT], 2048, 1024, 1, (bf16_t*)(ws + WS_W_CMOUT), 2048, 0, 0, scr, F.lane)) continue;
            if (tr_group(r, in[I_ATQKV], 1024, 1536, 1, (bf16_t*)(ws + WS_W_QKV), 1024, 0, 0, scr, F.lane)) continue;
            if (tr_group(r, in[I_ATWO], 1024, 1024, 1, (bf16_t*)(ws + WS_W_AO), 1024, 0, 0, scr, F.lane)) continue;
            if (r < 256) { const int mat = r / 8, itx = r % 8, kb = itx / 4, nb = itx % 4;
                tr_item(in[I_RGWA] + (size_t)mat * 128 * 128, 128, (bf16_t*)(ws + WS_W_RGG) + (size_t)mat * 256 * 128, 128, kb * 64, nb * 32, nb * 32, scr, F.lane); continue; }
            r -= 256;
            { const int mat = r / 8, itx = r % 8, kb = itx / 4, nb = itx % 4;
                tr_item(in[I_RGWI] + (size_t)mat * 128 * 128, 128, (bf16_t*)(ws + WS_W_RGG) + (size_t)mat * 256 * 128, 128, kb * 64, nb * 32, 128 + nb * 32, scr, F.lane); }
        }
    }
    {
        const int gt = F.bid * 512 + F.tid, NGT = F.G * 512;
        for (int i = gt; i < T * 256; i += NGT) { const int row = i >> 8, c4 = i & 255, b = row / SB, s = row - b * SB;
            const float* src = s < CTX ? in[I_CTX] + ((size_t)(b * CTX + s) << 10) : in[I_X] + ((size_t)(b * SEQ + s - CTX) << 10);
            ((f32x4*)(ws + WS_X))[i] = ((const f32x4*)src)[c4]; }
        for (int i = gt; i < 8 * 128 * 128 / 4; i += NGT) { const f32x4 v = ((const f32x4*)in[I_CMWS])[i]; u32x2 o; o.x = pk2(v.x, v.y); o.y = pk2(v.z, v.w); ((u32x2*)(ws + WS_W_CMS))[i] = o; }
        for (int i = gt; i < 2 * 2 * D; i += NGT) ((float*)(ws + WS_SPL))[i] = -8.f * log1pf(expf(-in[I_RGLAM][i]));
        for (int i = gt; i < 64 * 32; i += NGT) { const int pos = i >> 5, f = i & 31; const float inv = powf(10000.f, -(float)f * 2.0f / 64.0f); const float ang = (float)pos * inv;
            ((f32x2*)(ws + WS_ROPE))[i] = (f32x2){cosf(ang), sinf(ang)}; }
    }
}

template <bool ROUTE>
__device__ __forceinline__ void norm_phase(Frame& F, int l, const float* gvec, int shift_i, bool addY, bool skip_ctx_route) {
    uchar* ws = F.ws;
    float* X = (float*)(ws + WS_X); const float* Y1 = (const float*)(ws + WS_Y1); bf16_t* H = (bf16_t*)(ws + WS_H);
    const float* MOD = (const float*)(ws + WS_MOD) + (size_t)l * 5 * NMODV;
    LAS float* wr = (LAS float*)F.lds;
    if constexpr (ROUTE) {
        const float* wg = F.in[I_MWG] + (size_t)l * 1024 * 4; const float* wrt = F.in[I_MWR] + (size_t)l * 1024 * 32;
        for (int idx = F.tid; idx < 1024 * 9; idx += 512) { const int k = idx / 9, q = idx - k * 9;
            const f32x4 v = q == 0 ? *(const f32x4*)(wg + k * 4) : *(const f32x4*)(wrt + k * 32 + (q - 1) * 4);
            wr[(4 * q + 0) * 1024 + k] = v.x; wr[(4 * q + 1) * 1024 + k] = v.y; wr[(4 * q + 2) * 1024 + k] = v.z; wr[(4 * q + 3) * 1024 + k] = v.w; }
        __syncthreads();
    }
    const int i16 = F.lane & 15, grp = F.lane >> 4;
    for (int tok = (F.bid * 8 + F.wave) * 4 + grp; tok < T; tok += F.G * 32) {
        const int sidx = sidx_of_row(tok);
        f32x4 x[16];
        float ss = 0.f;
#pragma unroll
        for (int j = 0; j < 16; ++j) { x[j] = *(const f32x4*)(X + (size_t)tok * D + 64 * j + 4 * i16);
            if (addY) { x[j] += *(const f32x4*)(Y1 + (size_t)tok * D + 64 * j + 4 * i16); *(f32x4*)(X + (size_t)tok * D + 64 * j + 4 * i16) = x[j]; }
            ss += x[j].x * x[j].x + x[j].y * x[j].y + x[j].z * x[j].z + x[j].w * x[j].w; }
        ss = wave16_sum(ss);
        const float rstd = rsqrtf(ss * (1.f / D) + NORM_EPS);
        const float* shp = MOD + (size_t)sidx * NMODV + shift_i * D; const float* scp = shp + D;
#pragma unroll
        for (int j = 0; j < 16; ++j) { const int c = 64 * j + 4 * i16; const f32x4 g = *(const f32x4*)(gvec + c), sh = *(const f32x4*)(shp + c), sc = *(const f32x4*)(scp + c);
            x[j] = x[j] * rstd * g * (sc + 1.f) + sh;
            u32x2 o; o.x = pk2(x[j].x, x[j].y); o.y = pk2(x[j].z, x[j].w); *(u32x2*)(H + (size_t)tok * D + c) = o; }
        if constexpr (ROUTE) {
            LAS float* lgs = (LAS float*)(F.lds + LDSCTL_OFF + 1024) + (F.wave * 4 + grp) * 40;
#pragma unroll 1
            for (int o = 0; o < 36; ++o) { float a = 0.f;
#pragma unroll
                for (int j = 0; j < 16; ++j) { const f32x4 w = *(const LAS f32x4*)(wr + o * 1024 + 64 * j + 4 * i16); a += x[j].x * w.x + x[j].y * w.y + x[j].z * w.z + x[j].w * w.w; }
                a = wave16_sum(a); if (i16 == 0) lgs[o] = a; }
            asm volatile("s_waitcnt lgkmcnt(0)" ::: "memory");
            const float* bg = F.in[I_MBG] + l * 4; const float* br = F.in[I_MBR] + l * 32;
            const float gl0 = lgs[0] + bg[0], gl1 = lgs[1] + bg[1], gl2 = lgs[2] + bg[2], gl3 = lgs[3] + bg[3];
            int gs = 0; float gm = gl0;
            if (gl1 > gm) { gm = gl1; gs = 1; }
            if (gl2 > gm) { gm = gl2; gs = 2; }
            if (gl3 > gm) { gm = gl3; gs = 3; }
            const float den = __expf(gl0 - gm) + __expf(gl1 - gm) + __expf(gl2 - gm) + __expf(gl3 - gm);
            const float pg = 1.f / den;
            float el[8];
#pragma unroll
            for (int e = 0; e < 8; ++e) el[e] = lgs[4 + gs * 8 + e] + br[gs * 8 + e];
            int i0 = 0; float v0 = el[0];
#pragma unroll
            for (int e = 1; e < 8; ++e) if (el[e] > v0) { v0 = el[e]; i0 = e; }
            int i1 = -1; float v1 = -3.0e38f;
#pragma unroll
            for (int e = 0; e < 8; ++e) if (e != i0 && el[e] > v1) { v1 = el[e]; i1 = e; }
            const float p0 = 1.f / (1.f + __expf(v1 - v0));
            const float w0 = p0 * pg, w1 = (1.f - p0) * pg;
            const bool do_route = !(skip_ctx_route && sidx == 4);
            if (i16 == 0 && do_route) {
                const int e0 = gs * 8 + i0, e1 = gs * 8 + i1;
                unsigned* cnt = (unsigned*)(ws + WS_CTL) + CW_CNT + l * 32 * 64;
                const unsigned q0 = atomicAdd(cnt + e0 * 64, 1u), q1 = atomicAdd(cnt + e1 * 64, 1u);
                int* BK = (int*)(ws + WS_BK); float* TW = (float*)(ws + WS_TW);
                BK[(size_t)e0 * T + q0] = tok * 2; BK[(size_t)e1 * T + q1] = tok * 2 + 1;
                TW[tok * 2] = w0; TW[tok * 2 + 1] = w1;
            }
        }
    }
}

__device__ __forceinline__ void st8(bf16_t* p, f32x4 v0, f32x4 v1) { u32x4 w; w.x = cvt_pk_bf16(v0[0], v0[1]); w.y = cvt_pk_bf16(v0[2], v0[3]); w.z = cvt_pk_bf16(v1[0], v1[1]); w.w = cvt_pk_bf16(v1[2], v1[3]); *(u32x4*)p = w; }
#define EPI_ROWS(ai, m) (u.pm * 256 + (ai) * 128 + wr * 64 + (m) * 16 + fr)

struct EpiRgIn { static constexpr bool PERM = true; bf16_t* GG; bf16_t* XB;
    __device__ __forceinline__ void operator()(const f32x4 (&acc)[2][2][4][2], const pg8::Unit& u, int wr, int wc, int fr, int fq) const {
        const bool isg = u.pn < 4; bf16_t* base = isg ? GG : XB; const int ct = (u.pn & 3) * 256 + wc * 32 + 8 * fq;
#pragma unroll
        for (int ai = 0; ai < 2; ++ai)
#pragma unroll
            for (int m = 0; m < 4; ++m) { bf16_t* rowp = base + (size_t)EPI_ROWS(ai, m) * D + ct;
#pragma unroll
                for (int bj = 0; bj < 2; ++bj) { f32x4 v0 = acc[ai][bj][m][0], v1 = acc[ai][bj][m][1];
                    if (isg) {
#pragma unroll
                        for (int e = 0; e < 4; ++e) { v0[e] = gelu_tanh(v0[e]); v1[e] = gelu_tanh(v1[e]); } }
                    st8(rowp + bj * 128, v0, v1); } }
    } };
struct EpiBf16 { static constexpr bool PERM = true; bf16_t* O; int ldc;
    __device__ __forceinline__ void operator()(const f32x4 (&acc)[2][2][4][2], const pg8::Unit& u, int wr, int wc, int fr, int fq) const {
        const int ct = u.pn * 256 + wc * 32 + 8 * fq;
#pragma unroll
        for (int ai = 0; ai < 2; ++ai)
#pragma unroll
            for (int m = 0; m < 4; ++m) { bf16_t* rowp = O + (size_t)EPI_ROWS(ai, m) * ldc + ct;
#pragma unroll
                for (int bj = 0; bj < 2; ++bj) st8(rowp + bj * 128, acc[ai][bj][m][0], acc[ai][bj][m][1]); }
    } };
struct EpiCmIn { static constexpr bool PERM = true; bf16_t* O; f32x2* statp;
    __device__ __forceinline__ void operator()(const f32x4 (&acc)[2][2][4][2], const pg8::Unit& u, int wr, int wc, int fr, int fq) const {
        const int ct = u.pn * 256 + wc * 32 + 8 * fq; const bool isv = u.pn >= 8;
#pragma unroll
        for (int ai = 0; ai < 2; ++ai)
#pragma unroll
            for (int m = 0; m < 4; ++m) { const int row = EPI_ROWS(ai, m); bf16_t* rowp = O + (size_t)row * 4096 + ct; float s = 0.f, q = 0.f;
#pragma unroll
                for (int bj = 0; bj < 2; ++bj) { f32x4 v0 = acc[ai][bj][m][0], v1 = acc[ai][bj][m][1];
#pragma unroll
                    for (int e = 0; e < 4; ++e) { v0[e] = gelu_tanh(v0[e]); v1[e] = gelu_tanh(v1[e]); }
                    u32x4 w; w.x = cvt_pk_bf16(v0[0], v0[1]); w.y = cvt_pk_bf16(v0[2], v0[3]); w.z = cvt_pk_bf16(v1[0], v1[1]); w.w = cvt_pk_bf16(v1[2], v1[3]);
                    *(u32x4*)(rowp + bj * 128) = w;
                    const float r0 = bflo(w.x), r1 = bfhi(w.x), r2 = bflo(w.y), r3 = bfhi(w.y), r4 = bflo(w.z), r5 = bfhi(w.z), r6 = bflo(w.w), r7 = bfhi(w.w);
                    s += ((r0 + r1) + (r2 + r3)) + ((r4 + r5) + (r6 + r7)); q += ((r0 * r0 + r1 * r1) + (r2 * r2 + r3 * r3)) + ((r4 * r4 + r5 * r5) + (r6 * r6 + r7 * r7)); }
                if (isv) { s += __shfl_xor(s, 16); s += __shfl_xor(s, 32); q += __shfl_xor(q, 16); q += __shfl_xor(q, 32);
                    if (fq == 0) statp[(size_t)row * 32 + (u.pn - 8) * 4 + wc] = (f32x2){s, q}; } }
    } };
struct EpiResid { static constexpr bool PERM = false; float* X; const float* gate  ;
    __device__ __forceinline__ void operator()(const f32x4 (&acc)[2][2][4][2], const pg8::Unit& u, int wr, int wc, int fr, int fq) const {
        const int sidx = sidx_of_row(u.pm * 256); const float* gp = gate + (size_t)sidx * NMODV; const int ct = u.pn * 256 + wc * 32 + 4 * fq;
        f32x4 gv[2][2];
#pragma unroll
        for (int bj = 0; bj < 2; ++bj)
#pragma unroll
            for (int n = 0; n < 2; ++n) gv[bj][n] = *(const f32x4*)(gp + ct + bj * 128 + n * 16);
#pragma unroll
        for (int ai = 0; ai < 2; ++ai)
#pragma unroll
            for (int m = 0; m < 4; ++m) { float* rowp = X + (size_t)EPI_ROWS(ai, m) * D + ct;
#pragma unroll
                for (int bj = 0; bj < 2; ++bj)
#pragma unroll
                    for (int n = 0; n < 2; ++n) { f32x4* p = (f32x4*)(rowp + bj * 128 + n * 16); *p = *p + gv[bj][n] * acc[ai][bj][m][n]; } }
    } };
struct EpiRgGate { static constexpr bool PERM = true; const bf16_t* XC; bf16_t* LA; bf16_t* BB; const float* ba; const float* bi; const float* lam;
    __device__ __forceinline__ void operator()(const f32x4 (&acc)[2][2][4][2], const pg8::Unit& u, int wr, int wc, int fr, int fq) const {
        const int d = u.pn >> 3, blk = u.pn & 7;
        asm volatile("" : "+v"(fr), "+v"(fq));
#pragma unroll
        for (int n = 0; n < 2; ++n) { const int ch = blk * 128 + wc * 32 + 8 * fq + 4 * n;
            const f32x4 bav = *(const f32x4*)(ba + d * D + ch), biv = *(const f32x4*)(bi + d * D + ch), spv = *(const f32x4*)(lam + d * D + ch);
#pragma unroll
            for (int ai = 0; ai < 2; ++ai)
#pragma unroll
                for (int m = 0; m < 4; ++m) { const size_t off = (size_t)EPI_ROWS(ai, m) * D + ch;
                    const u32x2 xw = *(const u32x2*)(XC + off);
                    const f32x4 xc = {bflo(xw.x), bfhi(xw.x), bflo(xw.y), bfhi(xw.y)};
                    f32x4 la, bb;
#pragma unroll
                    for (int e = 0; e < 4; ++e) { const float r = fast_sigmoid(acc[ai][0][m][n][e] + bav[e]), ig = fast_sigmoid(acc[ai][1][m][n][e] + biv[e]);
                        const float lga = r * spv[e]; la[e] = lga; bb[e] = __builtin_amdgcn_sqrtf(one_minus_exp(-2.f * lga)) * ig * xc[e]; }
                    u32x2 w; w.x = cvt_pk_bf16(la[0], la[1]); w.y = cvt_pk_bf16(la[2], la[3]);
                    *(u32x2*)(LA + (size_t)d * T * D + off) = w;
                    w.x = cvt_pk_bf16(bb[0], bb[1]); w.y = cvt_pk_bf16(bb[2], bb[3]);
                    *(u32x2*)(BB + (size_t)d * T * D + off) = w; __builtin_amdgcn_sched_barrier(0); }
            asm volatile("" ::: "memory"); }
    } };

template <bool G1>
struct MoeOrder {
    static constexpr bool GATHER = G1;
    const LAS int* tab; const char* A; const char* B; const int* BK; int G, c, nunits; size_t bstride;
    __device__ bool next(int i, pg8::Unit& u) const {
        const long L = (long)i * G + c; if (L >= nunits) return false;
        const int wgid = __builtin_amdgcn_readfirstlane(pg8::xcd_remap((int)L, nunits)); const int tau = wgid >> 2, pn = wgid & 3;
        int e = 0;
#pragma unroll 1
        for (int k = 1; k < 32; ++k) e = (tab[k] <= tau) ? k : e;
        e = __builtin_amdgcn_readfirstlane(e);
        u.pm = tau; u.pn = pn; u.aux0 = e; u.aux1 = __builtin_amdgcn_readfirstlane((tau - tab[e]) * 256);
        u.a = pg8::uptr(G1 ? A : A + (size_t)tau * 256 * DEXP * 2);
        u.b = pg8::uptr(B + (size_t)e * bstride + (size_t)pn * 256 * (G1 ? 1024 : DEXP) * 2);
        return true; }
    __device__ unsigned goff(const pg8::Unit& u, int row) const {
        const int pos = u.aux1 + row; const int cnt = tab[40 + u.aux0];
        int tok = 0; if (pos < cnt) tok = __builtin_nontemporal_load(BK + (size_t)u.aux0 * T + pos) >> 1;
        return (unsigned)tok * (unsigned)(D * 2); }
};
struct EpiMoe1 { static constexpr bool PERM = true; bf16_t* H1;
    __device__ __forceinline__ void operator()(const f32x4 (&acc)[2][2][4][2], const pg8::Unit& u, int wr, int wc, int fr, int fq) const {
        const int ct = u.pn * 128 + wc * 32 + 8 * fq;
#pragma unroll
        for (int ai = 0; ai < 2; ++ai)
#pragma unroll
            for (int m = 0; m < 4; ++m) { f32x4 h0, h1;
#pragma unroll
                for (int e = 0; e < 4; ++e) { const float g0 = acc[ai][0][m][0][e], g1 = acc[ai][0][m][1][e]; h0[e] = g0 * sigmoidf_(g0) * acc[ai][1][m][0][e]; h1[e] = g1 * sigmoidf_(g1) * acc[ai][1][m][1][e]; }
                st8(H1 + (size_t)EPI_ROWS(ai, m) * DEXP + ct, h0, h1); }
    } };
struct EpiMoe2 { static constexpr bool PERM = false; float* X; float* Y1; const float* gate; const int* BK; const float* TW; const LAS int* tab;
    __device__ __forceinline__ void operator()(const f32x4 (&acc)[2][2][4][2], const pg8::Unit& u, int wr, int wc, int fr, int fq) const {
        const int ct = u.pn * 256 + wc * 32 + 4 * fq; const int cnt = tab[40 + u.aux0];
#pragma unroll
        for (int ai = 0; ai < 2; ++ai)
#pragma unroll
            for (int m = 0; m < 4; ++m) { const int pos = u.aux1 + ai * 128 + wr * 64 + m * 16 + fr;
                if (pos < cnt) { const int ent = __builtin_nontemporal_load(BK + (size_t)u.aux0 * T + pos); const int tok = ent >> 1, slot = ent & 1; const float w = __builtin_nontemporal_load(TW + ent);
                    const float* gp = gate + (size_t)sidx_of_row(tok) * NMODV + ct; float* xp = (slot ? Y1 : X) + (size_t)tok * D + ct;
#pragma unroll
                    for (int bj = 0; bj < 2; ++bj)
#pragma unroll
                        for (int n = 0; n < 2; ++n) { const f32x4 g = *(const f32x4*)(gp + bj * 128 + n * 16); f32x4 v = g * w * acc[ai][bj][m][n]; f32x4* p = (f32x4*)(xp + bj * 128 + n * 16);
                            if (!slot) v += *p; *p = v; } } }
    } };
__device__ __forceinline__ int moe_table(Frame& F, int l, LAS int* tab) {
    __syncthreads();
    if (F.tid < 32) { const unsigned c = __hip_atomic_load((unsigned*)(F.ws + WS_CTL) + CW_CNT + (l * 32 + F.tid) * 64, RLX_AGENT); tab[40 + F.tid] = (int)c; }
    __syncthreads();
    if (F.tid == 0) { int s = 0; for (int e = 0; e < 32; ++e) { tab[e] = s; s += (tab[40 + e] + 255) >> 8; } tab[32] = s; }
    __syncthreads();
    return tab[32];
}

__device__ __forceinline__ void conv_phase(Frame& F, int j) {
    const bf16_t* XB = (const bf16_t*)(F.ws + WS_XB); bf16_t* XC = (bf16_t*)(F.ws + WS_XC);
    const float* cw = F.in[I_RGCW] + (size_t)j * 4 * D; const float* cb = F.in[I_RGCB] + (size_t)j * D;
    for (int i = F.bid * 512 + F.tid; i < T * 128; i += F.G * 512) { const int row = i >> 7, c = (i & 127) * 8; const int b = row / SB, s = row - b * SB;
        const int lo = s < CTX ? 0 : CTX, hi = s < CTX ? CTX : SB;
        float a[8];
#pragma unroll
        for (int e = 0; e < 8; ++e) a[e] = cb[c + e];
#pragma unroll
        for (int k = 0; k < 4; ++k) { const int ss = s + k - 2; if (ss >= lo && ss < hi) { const u32x4 xw = *(const u32x4*)(XB + (size_t)(b * SB + ss) * D + c);
                const f32x4 w0 = *(const f32x4*)(cw + k * D + c), w1 = *(const f32x4*)(cw + k * D + c + 4);
                a[0] += w0.x * bflo(xw.x); a[1] += w0.y * bfhi(xw.x); a[2] += w0.z * bflo(xw.y); a[3] += w0.w * bfhi(xw.y);
                a[4] += w1.x * bflo(xw.z); a[5] += w1.y * bfhi(xw.z); a[6] += w1.z * bflo(xw.w); a[7] += w1.w * bfhi(xw.w); } }
        u32x4 o; o.x = pk2(a[0], a[1]); o.y = pk2(a[2], a[3]); o.z = pk2(a[4], a[5]); o.w = pk2(a[6], a[7]);
        *(u32x4*)(XC + (size_t)row * D + c) = o; }
}
__device__ __forceinline__ void scan1_phase(Frame& F) {
    const bf16_t* LA = (const bf16_t*)(F.ws + WS_LA); const bf16_t* BB = (const bf16_t*)(F.ws + WS_BB); f32x2* TOT = (f32x2*)(F.ws + WS_TOT);
    for (int it = F.bid * 8 + F.wave; it < NB * 2 * NCHUNK * 16; it += F.G * 8) {
        const int cg = it & 15, rest = it >> 4, ck = rest % NCHUNK, bd = rest / NCHUNK, dir = bd & 1, b = bd >> 1;
        const int c = cg * 64 + F.lane; const size_t base = (size_t)dir * T * D + (size_t)(b * SB + ck * 64) * D + c;
        float sl = 0.f, h = 0.f;
#pragma unroll 16
        for (int t = 0; t < 64; ++t) { const int tt = dir ? 63 - t : t; const float la = bf2f(LA[base + (size_t)tt * D]), bb = bf2f(BB[base + (size_t)tt * D]);
            sl += la; h = __expf(la) * h + bb; }
        TOT[(size_t)(bd * NCHUNK + ck) * D + c] = (f32x2){sl, h};
    }
}
__device__ __forceinline__ void scan3_phase(Frame& F) {
    const bf16_t* LA = (const bf16_t*)(F.ws + WS_LA); const bf16_t* BB = (const bf16_t*)(F.ws + WS_BB); const f32x2* TOT = (const f32x2*)(F.ws + WS_TOT);
    const bf16_t* GG = (const bf16_t*)(F.ws + WS_GG); bf16_t* SA = (bf16_t*)(F.ws + WS_SA);
    LAS float* hb = (LAS float*)(F.lds + F.wave * 16384);
    for (int it = F.bid * 8 + F.wave; it < NB * NCHUNK * 16; it += F.G * 8) {
        const int cg = it & 15, rest = it >> 4, ck = rest % NCHUNK, b = rest / NCHUNK;
        const int c = cg * 64 + F.lane;
        const f32x2* tf = TOT + (size_t)((b * 2 + 0) * NCHUNK) * D + c; const f32x2* tb = TOT + (size_t)((b * 2 + 1) * NCHUNK) * D + c;
        float hf = 0.f, hbk = 0.f;
        for (int jj = 0; jj < ck; ++jj) { const f32x2 v = tf[(size_t)jj * D]; hf = __expf(v.x) * hf + v.y; }
        if (ck < 4) { for (int jj = 3; jj > ck; --jj) { const f32x2 v = tb[(size_t)jj * D]; hbk = __expf(v.x) * hbk + v.y; } }
        else { for (int jj = 3; jj >= 0; --jj) { const f32x2 v = tb[(size_t)jj * D]; hbk = __expf(v.x) * hbk + v.y; }
               for (int jj = NCHUNK - 1; jj > ck; --jj) { const f32x2 v = tb[(size_t)jj * D]; hbk = __expf(v.x) * hbk + v.y; } }
        const size_t rbase = (size_t)(b * SB + ck * 64) * D + c;
        const size_t b1 = (size_t)T * D + rbase;
#pragma unroll 16
        for (int t = 63; t >= 0; --t) { const float la = bf2f(LA[b1 + (size_t)t * D]), bb = bf2f(BB[b1 + (size_t)t * D]); hbk = __expf(la) * hbk + bb; hb[t * 64 + F.lane] = hbk; }
#pragma unroll 16
        for (int t = 0; t < 64; ++t) { const float la = bf2f(LA[rbase + (size_t)t * D]), bb = bf2f(BB[rbase + (size_t)t * D]); hf = __expf(la) * hf + bb;
            const float y = bf2f(GG[rbase + (size_t)t * D]) * (hf + hb[t * 64 + F.lane]); SA[rbase + (size_t)t * D] = (bf16_t)f2bf(y); }
    }
}

__device__ __forceinline__ void qknorm_phase(Frame& F) {
    bf16_t* QKV = (bf16_t*)(F.ws + WS_QKV); const f32x2* ROPE = (const f32x2*)(F.ws + WS_ROPE);
    const int i16 = F.lane & 15, grp = F.lane >> 4;
    for (int it = (F.bid * 8 + F.wave) * 4 + grp; it < T * 10; it += F.G * 32) {
        const int row = it / 10, hh = it - row * 10; const int b = row / SB, s = row - b * SB;
        bf16_t* p = QKV + (size_t)row * 1536 + hh * 128 + i16 * 8;
        const u32x4 xw = *(const u32x4*)p;
        float x[8] = {bflo(xw.x), bfhi(xw.x), bflo(xw.y), bfhi(xw.y), bflo(xw.z), bfhi(xw.z), bflo(xw.w), bfhi(xw.w)};
        float ss = 0.f;
#pragma unroll
        for (int e = 0; e < 8; ++e) ss += x[e] * x[e];
        ss = wave16_sum(ss);
        const float rstd = rsqrtf(ss * (1.f / 128.f) + NORM_EPS);
        const float* g = (hh < 8 ? F.in[I_ATQG] : F.in[I_ATKG]) + i16 * 8;
#pragma unroll
        for (int e = 0; e < 8; ++e) x[e] = x[e] * rstd * g[e];
        float y[8];
#pragma unroll
        for (int e = 0; e < 8; ++e) y[e] = __shfl_xor(x[e], 4);
        if (s >= CTX) { const int t = s - CTX; const int pos = (i16 >> 3) ? (t & 63) : (t >> 6); const bool half1 = (i16 >> 2) & 1;
#pragma unroll
            for (int e = 0; e < 8; ++e) { const f32x2 cs = ROPE[pos * 32 + (i16 & 3) * 8 + e];
                x[e] = half1 ? (x[e] * cs.x + y[e] * cs.y) : (x[e] * cs.x - y[e] * cs.y); } }
        u32x4 o; o.x = pk2(x[0], x[1]); o.y = pk2(x[2], x[3]); o.z = pk2(x[4], x[5]); o.w = pk2(x[6], x[7]);
        *(u32x4*)p = o;
    }
}
__device__ __forceinline__ void attn_phase(Frame& F) {
    const bf16_t* QKV = (const bf16_t*)(F.ws + WS_QKV); bf16_t* AO = (bf16_t*)(F.ws + WS_AO);
    for (int u = F.bid; u < 544; u += F.G) {
        int b, h, q0, k0, seq;
        if (u < 512) { const int qb = u & 15, hg = (u >> 4) & 3, kvh = (u >> 6) & 1; b = u >> 7; h = kvh * 4 + hg; q0 = b * SB + CTX + qb * 256; k0 = b * SB; seq = SB; }
        else { const int v = u - 512; b = v >> 3; h = v & 7; q0 = b * SB; k0 = b * SB; seq = CTX; }
        const int kvh = h >> 2;
        const bf16_t* Kp = (const bf16_t*)pg8::uptr((const char*)(QKV + (size_t)k0 * 1536 + 1024 + kvh * 128));
        att::attn_dense_body((const bf16_t*)pg8::uptr((const char*)(QKV + (size_t)q0 * 1536 + h * 128)), Kp, Kp + 256, (bf16_t*)pg8::uptr((const char*)(AO + (size_t)q0 * D + h * 128)), seq, F.ldsg, F.tid);
        __syncthreads();
    }
}

__device__ __forceinline__ void spatial_phase(Frame& F) {
    const bf16_t* UVB = (const bf16_t*)(F.ws + WS_UVB); bf16_t* UV = (bf16_t*)(F.ws + WS_UV); const f32x2* statp = (const f32x2*)(F.ws + WS_STATP);
    const bf16_t* Ws = (const bf16_t*)(F.ws + WS_W_CMS); const float* lng = F.in[I_CMLNG]; const float* lnb = F.in[I_CMLNB]; const float* bs = F.in[I_CMBS];
    LAS uchar* vl = F.lds;
    LAS f32x2* st = (LAS f32x2*)(F.lds + 65536);
    const int tid = F.tid, lane = F.lane, wid = F.wave, r32 = lane & 31, hi = lane >> 5, wm = wid & 3, wn = wid >> 2;
    const int sr = tid >> 4, sc = (tid & 15) * 8;
    for (int u = F.bid; u < 136 * 8; u += F.G) {
        const int chunk = u >> 3, g = u & 7; const int row0 = chunk * 128;
        __syncthreads();
        if (tid < 128) { const f32x2* sp = statp + (size_t)(row0 + tid) * 32; float s = 0.f, q = 0.f;
#pragma unroll 8
            for (int k = 0; k < 32; ++k) { const f32x2 v = sp[k]; s += v.x; q += v.y; }
            const float mean = s * (1.f / 2048.f); const float var = fmaxf(q * (1.f / 2048.f) - mean * mean, 0.f); st[tid] = (f32x2){mean, rsqrtf(var + NORM_EPS)}; }
        __syncthreads();
#pragma unroll
        for (int ch = 0; ch < 2; ++ch) { const int cg = g * 256 + ch * 128 + sc;
            const f32x4 g0 = *(const f32x4*)(lng + cg), g1 = *(const f32x4*)(lng + cg + 4), b0 = *(const f32x4*)(lnb + cg), b1 = *(const f32x4*)(lnb + cg + 4);
#pragma unroll
            for (int i = 0; i < 4; ++i) { const int q = sr + 32 * i; const u32x4 xw = *(const u32x4*)(UVB + (size_t)(row0 + q) * 4096 + 2048 + cg); const f32x2 ms = st[q];
                f32x4 v0 = {bflo(xw.x), bfhi(xw.x), bflo(xw.y), bfhi(xw.y)}, v1 = {bflo(xw.z), bfhi(xw.z), bflo(xw.w), bfhi(xw.w)};
                v0 = (v0 - ms.x) * ms.y * g0 + b0; v1 = (v1 - ms.x) * ms.y * g1 + b1;
                u32x4 o; o.x = pk2(v0.x, v0.y); o.y = pk2(v0.z, v0.w); o.z = pk2(v1.x, v1.y); o.w = pk2(v1.z, v1.w);
                *(LAS u32x4*)(vl + ((q >> 6) * 2 + ch) * 16384 + att::v_st(q & 63, sc)) = o; } }
        bf16x8 pa[2][4];
#pragma unroll
        for (int kt = 0; kt < 2; ++kt)
#pragma unroll
            for (int ks = 0; ks < 4; ++ks) pa[kt][ks] = *(const bf16x8*)(Ws + ((size_t)g * 128 + 32 * wm + r32) * 128 + 64 * kt + 16 * ks + 8 * hi);
        __syncthreads();
        f32x16 o[4] = {};
        const int vb = (int)(uintptr_t)(F.ldsg) + att::v_rd_base(lane) + wn * 16384;
        att::pv_d0(o, vb, pa[0][0], pa[0][1], pa[0][2], pa[0][3]);
        att::pv_d0(o, vb + 32768, pa[1][0], pa[1][1], pa[1][2], pa[1][3]);
#pragma unroll
        for (int r = 0; r < 16; ++r) { const int p = 32 * wm + att::crow(r, hi); const float bsv = bs[g * 128 + p]; const size_t rowoff = (size_t)(row0 + p);
#pragma unroll
            for (int d0 = 0; d0 < 4; ++d0) { const int c = g * 256 + 128 * wn + 32 * d0 + r32; const float uu = bf2f(UVB[rowoff * 4096 + c]);
                UV[rowoff * 2048 + c] = (bf16_t)f2bf((o[d0][r] + bsv) * uu); } }
    }
    __syncthreads();
}

__device__ __forceinline__ void final_phase(Frame& F) {
    const f32x4* X = (const f32x4*)(F.ws + WS_X); const f32x4* Y1 = (const f32x4*)(F.ws + WS_Y1); f32x4* out = (f32x4*)F.out;
    for (int i = F.bid * 512 + F.tid; i < NB * SEQ * 256; i += F.G * 512) { const int r = i >> 8, c4 = i & 255, b = r >> 12, t = r & 4095; const size_t src = ((size_t)(b * SB + CTX + t) << 8) + c4;
        out[i] = X[src] + Y1[src]; }
}

constexpr int NPHASE = 37;
__global__ void __launch_bounds__(512, 2) mk_fwd(Args args) {
    extern __shared__ __attribute__((aligned(16))) uchar lds[];
    Frame F; F.lds = (LAS uchar*)lds; F.ldsg = (char*)lds; F.tid = threadIdx.x; F.lane = F.tid & 63; F.wave = __builtin_amdgcn_readfirstlane(F.tid >> 6); F.G = gridDim.x; F.bid = blockIdx.x;
    F.ws = args.ws; F.in = args.in; F.out = args.out;
    uchar* ws0 = args.ws;
    volatile LAS unsigned* MISC = (volatile LAS unsigned*)(F.lds + LDSCTL_OFF);
    LAS int* tab = (LAS int*)(F.lds + LDSCTL_OFF + 256);
    for (int u = F.tid; u < (LDS_BYTES - LDSCTL_OFF) / 4; u += 512) ((LAS unsigned*)(F.lds + LDSCTL_OFF))[u] = 0u;
    __syncthreads();
    const int lo = args.ph_lo, hi = args.ph_hi;
    if (hi - lo > 1) (void)xcd_barrier_post((unsigned*)(ws0 + WS_CTL) + CW_BAR, MISC + 8);
    int ph = 0;
#define PH_BEGIN if (ph >= opaque_uniform_int(args.ph_lo) && ph < opaque_uniform_int(args.ph_hi)) { int t_ = threadIdx.x; F.G = opaque_uniform_int(gridDim.x); F.bid = opaque_uniform_int(blockIdx.x); const int cid = F.bid; (void)cid; \
        F.out = (float*)opaque_uniform_ptr(args.out); F.lds = (LAS uchar*)lds; F.ldsg = (char*)lds; \
        asm volatile("" : "+v"(t_)); F.tid = t_; F.lane = t_ & 63; F.wave = __builtin_amdgcn_readfirstlane(t_ >> 6); \
        uchar* ws = (uchar*)opaque_uniform_ptr(args.ws); F.ws = ws; \
        const float* MODl = (const float*)(ws + WS_MOD) + (size_t)l_ * 5 * NMODV; (void)MODl;
#define PH_END   if (ph + 1 < opaque_uniform_int(args.ph_hi)) { XcdBarrier bb_; bb_.bar = (unsigned*)(ws + WS_CTL) + CW_BAR; bb_.x = 0; bb_.st = (volatile LAS unsigned*)(F.lds + LDSCTL_OFF) + 8; xcd_barrier(bb_); } } ++ph;

    { const int l_ = 0; PH_BEGIN PM(0) p0_prologue(F); PH_END }

#pragma unroll 1
    for (int l = 0; l < DEPTH; ++l) {
        const int kind = l % 3, j = l / 3; const bool lastl = (l == DEPTH - 1); const int l_ = l;
        PH_BEGIN PM(1) norm_phase<false>(F, l, F.in[I_NMG] + l * D, 0, l > 0, false); PH_END
        if (kind == 0) {
            PH_BEGIN PM(2) { pg8::DenseOrder S; S.init(ws + WS_H, D, ws + WS_W_RGIN + (size_t)j * 2048 * 1024 * 2, D, T, 2048, F.G, cid);
                EpiRgIn E{(bf16_t*)(ws + WS_GG), (bf16_t*)(ws + WS_XB)}; pg8::gemm_phase(F.lds, S, E, D, D, D); } PH_END
            PH_BEGIN PM(3) conv_phase(F, j); PH_END
            PH_BEGIN PM(4) { pg8::DenseOrder S; S.init(ws + WS_XC, D, ws + WS_W_RGG + (size_t)j * 16 * 256 * 128 * 2, 128, T, 16 * 256, F.G, cid, 7, 256);
                EpiRgGate E{(const bf16_t*)(ws + WS_XC), (bf16_t*)(ws + WS_LA), (bf16_t*)(ws + WS_BB), F.in[I_RGBA] + (size_t)j * 2 * D, F.in[I_RGBI] + (size_t)j * 2 * D, (const float*)(ws + WS_SPL) + (size_t)j * 2 * D};
                pg8::gemm_phase(F.lds, S, E, 128, D, 128); } PH_END
            PH_BEGIN PM(5) scan1_phase(F); PH_END
            PH_BEGIN PM(6) scan3_phase(F); PH_END
            PH_BEGIN PM(7) { pg8::DenseOrder S; S.init(ws + WS_SA, D, ws + WS_W_RGOUT + (size_t)j * 1024 * 1024 * 2, D, T, D, F.G, cid);
                EpiResid E{(float*)(ws + WS_X), MODl + 2 * D}; pg8::gemm_phase(F.lds, S, E, D, D, D); } PH_END
        } else if (kind == 1) {
            PH_BEGIN PM(8) { pg8::DenseOrder S; S.init(ws + WS_H, D, ws + WS_W_QKV, D, T, 1536, F.G, cid);
                EpiBf16 E{(bf16_t*)(ws + WS_QKV), 1536}; pg8::gemm_phase(F.lds, S, E, D, D, D); } PH_END
            PH_BEGIN PM(9) qknorm_phase(F); PH_END
            PH_BEGIN PM(10) attn_phase(F); PH_END
            PH_BEGIN PM(11) { pg8::DenseOrder S; S.init(ws + WS_AO, D, ws + WS_W_AO, D, T, D, F.G, cid);
                EpiResid E{(float*)(ws + WS_X), MODl + 2 * D}; pg8::gemm_phase(F.lds, S, E, D, D, D); } PH_END
        } else {
            PH_BEGIN PM(12) { pg8::DenseOrder S; S.init(ws + WS_H, D, ws + WS_W_CMIN, D, T, 4096, F.G, cid);
                EpiCmIn E{(bf16_t*)(ws + WS_UVB), (f32x2*)(ws + WS_STATP)}; pg8::gemm_phase(F.lds, S, E, D, D, D); } PH_END
            PH_BEGIN PM(13) spatial_phase(F); PH_END
            PH_BEGIN PM(14) { pg8::DenseOrder S; S.init(ws + WS_UV, 2048, ws + WS_W_CMOUT, 2048, T, D, F.G, cid);
                EpiResid E{(float*)(ws + WS_X), MODl + 2 * D}; pg8::gemm_phase(F.lds, S, E, 2048, 2048, 2048); } PH_END
        }
        PH_BEGIN PM(15) norm_phase<true>(F, l, F.in[I_NFG] + l * D, 3, false, lastl); PH_END
        PH_BEGIN PM(16) { const int ntile = moe_table(F, l, tab);
            MoeOrder<true> S{tab, (const char*)(ws + WS_H), (const char*)(ws + WS_W_E1 + (size_t)l * 32 * 1024 * 1024 * 2), (const int*)(ws + WS_BK), F.G, cid, ntile * 4, (size_t)1024 * 1024 * 2};
            EpiMoe1 E{(bf16_t*)(ws + WS_H1)}; pg8::gemm_phase(F.lds, S, E, D, D, D); } PH_END
        PH_BEGIN PM(17) { const int ntile = moe_table(F, l, tab);
            MoeOrder<false> S{tab, (const char*)(ws + WS_H1), (const char*)(ws + WS_W_E2 + (size_t)l * 32 * 1024 * 512 * 2), (const int*)(ws + WS_BK), F.G, cid, ntile * 4, (size_t)1024 * 512 * 2};
            EpiMoe2 E{(float*)(ws + WS_X), (float*)(ws + WS_Y1), MODl + 5 * D, (const int*)(ws + WS_BK), (const float*)(ws + WS_TW), tab}; pg8::gemm_phase(F.lds, S, E, DEXP, DEXP, DEXP); } PH_END
    }
    { const int l_ = 0; PH_BEGIN PM(18) final_phase(F); PH_END }
#undef PH_BEGIN
#undef PH_END
}

extern "C" void kernel_launch(void* const* d_in, const int* in_sizes, int n_in, void* d_out, int out_size, void* d_ws, size_t ws_size, hipStream_t stream) {
    static int grid = 0;
    if (grid == 0) {
        if (n_in != 34 || out_size != NB * SEQ * D || ws_size < WS_END) { fprintf(stderr, "kernel_launch: bad shapes n_in %d out %d ws %zu (need %zu)\n", n_in, out_size, ws_size, (size_t)WS_END); grid = -1; return; }
        int dev = 0, cus = 0, per_cu = 0;
        if (hipGetDevice(&dev) != hipSuccess || hipDeviceGetAttribute(&cus, hipDeviceAttributeMultiprocessorCount, dev) != hipSuccess) { grid = -1; return; }
        if (hipFuncSetAttribute((const void*)mk_fwd, hipFuncAttributeMaxDynamicSharedMemorySize, LDS_BYTES) != hipSuccess) { fprintf(stderr, "kernel_launch: hipFuncSetAttribute failed\n"); grid = -1; return; }
        if (hipOccupancyMaxActiveBlocksPerMultiprocessor(&per_cu, (const void*)mk_fwd, 512, LDS_BYTES) != hipSuccess || per_cu < 1) { fprintf(stderr, "kernel_launch: occupancy query says %d\n", per_cu); (void)hipGetLastError(); grid = -1; return; }
        grid = cus;
    }
    if (grid < 0) return;
    (void)hipMemsetAsync((char*)d_ws + WS_CTL, 0, CTL_BYTES, stream);
    Args a{};
    for (int i = 0; i < 34; ++i) a.in[i] = (const float*)d_in[i];
    a.out = (float*)d_out; a.ws = (uchar*)d_ws;
#if MK_PER_PHASE
    for (int p = 0; p < NPHASE; ++p) { a.ph_lo = p; a.ph_hi = p + 1; hipLaunchKernelGGL(mk_fwd, dim3(grid), dim3(512), LDS_BYTES, stream, a); }
#else
    a.ph_lo = 0; a.ph_hi = NPHASE;
    void* kargs[] = {&a};
    hipError_t e = hipLaunchCooperativeKernel((const void*)mk_fwd, dim3(grid), dim3(512), kargs, LDS_BYTES, stream);
    if (e != hipSuccess) fprintf(stderr, "kernel_launch: cooperative launch failed: %s (grid %d)\n", hipGetErrorString(e), grid);
#endif
}
```

```cpp
#include <hip/hip_runtime.h>
#include <hip/hip_bf16.h>
#include <cstdio>
#include <cstdint>

#ifndef MK_PER_PHASE
#define MK_PER_PHASE 0
#endif

#ifndef PHASE_MASK
#define PHASE_MASK 0xFFFFFFFFu
#endif
#define PM(i) if constexpr ((PHASE_MASK >> (i)) & 1u)
#define LAS __attribute__((address_space(3)))
#define GAS __attribute__((address_space(1)))
typedef unsigned char uchar;
typedef unsigned short bf16_t;
typedef short bf16x8 __attribute__((ext_vector_type(8)));
typedef short s16x4 __attribute__((ext_vector_type(4)));
typedef float f32x4 __attribute__((ext_vector_type(4)));
typedef float f32x2 __attribute__((ext_vector_type(2)));
typedef float f32x16 __attribute__((ext_vector_type(16)));
typedef unsigned u32x4 __attribute__((ext_vector_type(4)));
typedef unsigned u32x2 __attribute__((ext_vector_type(2)));
typedef GAS unsigned gu32;
#define RLX_AGENT __ATOMIC_RELAXED, __HIP_MEMORY_SCOPE_AGENT

constexpr int D = 1024, NB = 4, SEQ = 4096, CTX = 256, SB = SEQ + CTX, T = NB * SB, DEPTH = 4;
constexpr int NMODV = 6 * D;
constexpr int NEXP = 32, DEXP = 512;
constexpr int NCHUNK = SB / 64;
constexpr float NORM_EPS = 1e-6f;

constexpr size_t MiB = 1u << 20;
constexpr size_t WS_CTL = 0, CTL_BYTES = 1 * MiB;
constexpr size_t WS_MOD = 1 * MiB;
constexpr size_t WS_ROPE = 2 * MiB;
constexpr size_t WS_SPL = 2 * MiB + 65536;
constexpr size_t WS_TOT = 3 * MiB;
constexpr size_t WS_STATP = 8 * MiB;
constexpr size_t WS_BK = 13 * MiB;
constexpr size_t WS_TW = 15 * MiB + 512 * 1024;
constexpr size_t WS_W_RGIN = 16 * MiB, WS_W_RGG = 24 * MiB, WS_W_RGOUT = 26 * MiB, WS_W_QKV = 30 * MiB, WS_W_AO = 33 * MiB;
constexpr size_t WS_W_CMIN = 35 * MiB, WS_W_CMS = 43 * MiB, WS_W_CMOUT = 44 * MiB, WS_W_E1 = 48 * MiB, WS_W_E2 = 304 * MiB;
constexpr size_t WS_X = 432 * MiB, WS_Y1 = 500 * MiB, WS_H = 568 * MiB, WS_SCR = 602 * MiB;
constexpr size_t WS_GG = WS_SCR, WS_XB = WS_SCR + 34 * MiB, WS_XC = WS_SCR + 68 * MiB, WS_LA = WS_SCR + 102 * MiB, WS_BB = WS_SCR + 170 * MiB, WS_SA = WS_SCR + 238 * MiB;
constexpr size_t WS_QKV = WS_SCR, WS_AO = WS_SCR + 51 * MiB;
constexpr size_t WS_UVB = WS_SCR, WS_UV = WS_SCR + 136 * MiB;
constexpr size_t WS_H1 = WS_SCR;
constexpr size_t WS_END = WS_SCR + 272 * MiB;
constexpr int CW_TMO = 0, CW_BAR = 4096, CW_CNT = 16384;

constexpr int RING_BYTES = 131072;
constexpr int ROUTER_LDS = 36 * 1024 * 4;
constexpr int LDSCTL_OFF = 147456;
constexpr int LDS_BYTES = LDSCTL_OFF + 1024 + 8 * 4 * 40 * 4;

__device__ __forceinline__ unsigned f2bf(float f) { unsigned u = __builtin_bit_cast(unsigned, f); return (u + 0x7fffu + ((u >> 16) & 1u)) >> 16; }
__device__ __forceinline__ unsigned pk2(float lo, float hi) { return f2bf(lo) | (f2bf(hi) << 16); }
__device__ __forceinline__ float bf2f(unsigned short h) { return __builtin_bit_cast(float, (unsigned)h << 16); }
__device__ __forceinline__ float bflo(unsigned w) { return __builtin_bit_cast(float, w << 16); }
__device__ __forceinline__ float bfhi(unsigned w) { return __builtin_bit_cast(float, w & 0xffff0000u); }
__device__ __forceinline__ unsigned cvt_pk_bf16(float lo, float hi) { unsigned r; asm volatile("v_cvt_pk_bf16_f32 %0, %1, %2" : "=v"(r) : "v"(lo), "v"(hi)); return r; }
__device__ __forceinline__ float gelu_tanh(float x) { const float u = 0.7978845608028654f * (x + 0.044715f * x * x * x); const float e = __expf(2.f * u); const float t = 1.f - 2.f / (e + 1.f); return 0.5f * x * (1.f + t); }
__device__ __forceinline__ float sigmoidf_(float x) { return 1.f / (1.f + __expf(-x)); }
__device__ __forceinline__ float fast_sigmoid(float x) { return __builtin_amdgcn_rcpf(1.f + __expf(-x)); }
__device__ __forceinline__ float one_minus_exp(float y) {   const float p = y * (1.f - y * (0.5f - y * (0.16666667f - y * 0.041666667f))); const float q = 1.f - __expf(-y); return y < 0.0625f ? p : q; }
__device__ __forceinline__ int sidx_of_row(int row) { const int b = row / SB; return (row - b * SB) < CTX ? 4 : b; }

namespace pg8 {
constexpr int BM = 256, BK = 64, HALF = 128, HTB = HALF * BK * 2, NXCD = 8, WGM = 8;
__device__ __forceinline__ int lds_byte(int r, int c) { const int st = (r >> 4) * 2 + (c >> 5), rr = r & 15, cc = c & 31, ob = rr * 64 + cc * 2; return st * 1024 + (ob ^ (((ob >> 9) & 1) << 5)); }
__device__ __forceinline__ void stage_rc(int b, int& R, int& C) { const int st = b / 1024, sb = b % 1024, swz = sb ^ (((sb >> 9) & 1) << 5); R = (st >> 1) * 16 + swz / 64; C = (st & 1) * 32 + (swz % 64) / 2; }
__device__ __forceinline__ int perm32(int rho) { const int n = rho >> 4, i = rho & 15; return 8 * (i >> 2) + 4 * n + (i & 3); }
struct Unit { const char* a; const char* b; int pm, pn, aux0, aux1; };
__device__ __forceinline__ const char* uptr(const char* p) { const unsigned long long v = (unsigned long long)p; const unsigned lo = __builtin_amdgcn_readfirstlane((unsigned)v), hi = __builtin_amdgcn_readfirstlane((unsigned)(v >> 32)); return (const char*)(((unsigned long long)hi << 32) | lo); }
__device__ __forceinline__ int xcd_remap(int L, int nwg) { const int q = nwg / NXCD, r = nwg % NXCD, xcd = L % NXCD, off = L / NXCD; return (xcd < r ? xcd * (q + 1) : r * (q + 1) + (xcd - r) * q) + off; }

struct DenseOrder {
    static constexpr bool GATHER = false;
    const char* A; const char* B; int nM, nN, nwg, G, c; size_t tA, tB; int amask, acol;
    __device__ void init(const void* A_, int lda, const void* B_, int ldb, int M, int N, int G_, int c_, int amask_ = 0, int acol_ = 0) {
        A = (const char*)A_; B = (const char*)B_; nM = M / BM; nN = N / BM; nwg = nM * nN; G = G_; c = c_; tA = (size_t)BM * lda * 2; tB = (size_t)BM * ldb * 2; amask = amask_; acol = acol_; }
    __device__ bool next(int i, Unit& u) const {
        const long L = (long)i * G + c; if (L >= nwg) return false;
        const int wgid = xcd_remap((int)L, nwg);
        const int nig = WGM * nN, gid = wgid / nig, fm = gid * WGM, gsz = (nM - fm) < WGM ? (nM - fm) : WGM;
        u.pm = __builtin_amdgcn_readfirstlane(fm + ((wgid % nig) % gsz)); u.pn = __builtin_amdgcn_readfirstlane((wgid % nig) / gsz); u.aux0 = 0; u.aux1 = 0;
        u.a = uptr(A + (size_t)u.pm * tA + (size_t)(u.pn & amask) * acol); u.b = uptr(B + (size_t)u.pn * tB); return true; }
    __device__ unsigned goff(const Unit&, int) const { return 0u; }
};

#define PG8_SA(b, h) (((b) * 2 + (h)) * HTB)
#define PG8_SB(b, h) ((4 + (b) * 2 + (h)) * HTB)
#define PG8_GLDS(gp, ldsoff) __builtin_amdgcn_global_load_lds((const unsigned*)(gp), (LAS unsigned*)(lds + (ldsoff)), 16, 0, 0)
#define PG8_STAGE_B(bufoff, gbase) do { PG8_GLDS((const char*)(gbase) + voffB[0], (bufoff) + ldsw); PG8_GLDS((const char*)(gbase) + voffB[1], (bufoff) + ldsw + 8192); } while (0)
#define PG8_STAGE_A(bufoff, gbase, h, NX) do { if constexpr (Sched::GATHER) { \
        PG8_GLDS((const char*)(gbase) + ((NX) ? vAn[h][0] : vAc[h][0]), (bufoff) + ldsw); PG8_GLDS((const char*)(gbase) + ((NX) ? vAn[h][1] : vAc[h][1]), (bufoff) + ldsw + 8192); \
    } else { PG8_GLDS((const char*)(gbase) + (h) * hstepA + voffA[0], (bufoff) + ldsw); PG8_GLDS((const char*)(gbase) + (h) * hstepA + voffA[1], (bufoff) + ldsw + 8192); } } while (0)
#define PG8_LDA(dst, b, h) do { _Pragma("unroll") for (int m = 0; m < 4; ++m) _Pragma("unroll") for (int k = 0; k < 2; ++k) dst[m][k] = *(const LAS bf16x8*)(lds + PG8_SA(b, h) + aoff + m * 2048 + k * 1024); } while (0)
#define PG8_LDB(dst, b, h) do { _Pragma("unroll") for (int n = 0; n < 2; ++n) _Pragma("unroll") for (int k = 0; k < 2; ++k) dst[n][k] = *(const LAS bf16x8*)(lds + PG8_SB(b, h) + boff + n * 2048 + k * 1024); } while (0)
#define PG8_MMA(ai, bj, At, Bt) do { __builtin_amdgcn_s_setprio(1); _Pragma("unroll") for (int m = 0; m < 4; ++m) _Pragma("unroll") for (int n = 0; n < 2; ++n) _Pragma("unroll") for (int k = 0; k < 2; ++k) \
        acc[ai][bj][m][n] = __builtin_amdgcn_mfma_f32_16x16x32_bf16(Bt[n][k], At[m][k], acc[ai][bj][m][n], 0, 0, 0); __builtin_amdgcn_s_setprio(0); } while (0)
#define PG8_WAIT_V(n) asm volatile("s_waitcnt vmcnt(" #n ")" ::: "memory")
#define PG8_WAIT_L(n) asm volatile("s_waitcnt lgkmcnt(" #n ")" ::: "memory")
#define PG8_BAR __builtin_amdgcn_s_barrier()
#define PG8_SCHED __builtin_amdgcn_sched_barrier(0)

template <class Epi, class Sched>
__device__ __forceinline__ void gemm_phase(LAS uchar* lds, const Sched& S, const Epi& E, const int K, const int lda, const int ldb) {
    int tid = threadIdx.x; asm volatile("" : "+v"(tid));
    const int wid = __builtin_amdgcn_readfirstlane(tid >> 6), lane = tid & 63, wr = wid >> 2, wc = wid & 3; int fr = lane & 15, fq = lane >> 4;
    int nt = K / BK; asm volatile("" : "+s"(nt));
    unsigned voffA[2], voffB[2]; int Rs[2], Cs[2];
#pragma unroll
    for (int i = 0; i < 2; ++i) { int R, C; stage_rc(tid * 16 + i * 8192, R, C); const int Rb = Epi::PERM ? ((R & ~31) + perm32(R & 31)) : R;
        Rs[i] = R; Cs[i] = C; voffA[i] = (unsigned)(R * lda + C) * 2u; voffB[i] = (unsigned)(Rb * ldb + C) * 2u; }
    const size_t kstep = (size_t)(BK * 2);
    const size_t hstepA = (size_t)HALF * lda * 2, hstepB = (size_t)HALF * ldb * 2;
    const unsigned ldsw = (unsigned)wid * 1024u;
    const int aoff = lds_byte(wr * 64 + fr, fq * 8), boff = lds_byte(wc * 32 + fr, fq * 8);
    Unit cur, nxt; int ui = 0;
    if (!S.next(0, cur)) return;
    unsigned vAc[2][2], vAn[2][2];
#pragma unroll
    for (int h = 0; h < 2; ++h)
#pragma unroll
        for (int i = 0; i < 2; ++i) { vAc[h][i] = 0u; vAn[h][i] = 0u; }
    if constexpr (Sched::GATHER) {
#pragma unroll
        for (int h = 0; h < 2; ++h)
#pragma unroll
            for (int i = 0; i < 2; ++i) vAc[h][i] = S.goff(cur, h * HALF + Rs[i]) + (unsigned)Cs[i] * 2u;
    }
    f32x4 acc[2][2][4][2];
#pragma unroll
    for (int a = 0; a < 2; ++a)
#pragma unroll
        for (int b = 0; b < 2; ++b)
#pragma unroll
            for (int m = 0; m < 4; ++m)
#pragma unroll
                for (int n = 0; n < 2; ++n) acc[a][b][m][n] = (f32x4){0.f, 0.f, 0.f, 0.f};
    bf16x8 At[4][2], B0[2][2], B1[2][2];
    const char* cA = cur.a; const char* cB = cur.b;
    PG8_STAGE_B(PG8_SB(0, 0), cB); PG8_STAGE_B(PG8_SB(0, 1), cB + hstepB); PG8_STAGE_A(PG8_SA(0, 0), cA, 0, false); PG8_STAGE_A(PG8_SA(0, 1), cA, 1, false);
    if (wr == 1) PG8_BAR;
    PG8_WAIT_V(2); PG8_BAR;
    PG8_STAGE_B(PG8_SB(1, 0), cB + kstep); PG8_STAGE_A(PG8_SA(1, 0), cA + kstep, 0, false); PG8_STAGE_B(PG8_SB(1, 1), cB + hstepB + kstep);
    PG8_WAIT_V(6); PG8_BAR;
    for (;;) {
        const bool has_next = S.next(ui + 1, nxt);
        if constexpr (Sched::GATHER) { if (has_next) {
#pragma unroll
            for (int h = 0; h < 2; ++h)
#pragma unroll
                for (int i = 0; i < 2; ++i) vAn[h][i] = S.goff(nxt, h * HALF + Rs[i]) + (unsigned)Cs[i] * 2u; } }
        const char* nA = has_next ? nxt.a : cA; const char* nB = has_next ? nxt.b : cB;
        for (int t = 0; t < nt; t += 2) {
            const bool last = (t == nt - 2);
            const bool nx = last && has_next;
            const char* a1 = cA + (size_t)(t + 1) * kstep;
            const char* a2 = last ? nA : cA + (size_t)(t + 2) * kstep; const char* b2 = last ? nB : cB + (size_t)(t + 2) * kstep;
            const char* a3 = a2 + kstep; const char* b3 = b2 + kstep;
            PG8_LDB(B0, 0, 0); PG8_LDB(B1, 0, 1); PG8_SCHED; PG8_LDA(At, 0, 0); PG8_STAGE_A(PG8_SA(1, 1), a1, 1, false);
            PG8_WAIT_V(8); PG8_WAIT_L(0); PG8_BAR; PG8_MMA(0, 0, At, B0); PG8_MMA(0, 1, At, B1); PG8_BAR; PG8_SCHED;
            PG8_LDA(At, 0, 1); PG8_STAGE_B(PG8_SB(0, 0), b2); PG8_STAGE_B(PG8_SB(0, 1), b2 + hstepB); PG8_STAGE_A(PG8_SA(0, 0), a2, 0, nx);
            PG8_WAIT_V(8); PG8_WAIT_L(0); PG8_BAR; PG8_MMA(1, 0, At, B0); PG8_MMA(1, 1, At, B1); PG8_BAR; PG8_SCHED;
            PG8_LDB(B0, 1, 0); PG8_LDB(B1, 1, 1); PG8_SCHED; PG8_LDA(At, 1, 0); PG8_STAGE_A(PG8_SA(0, 1), a2, 1, nx);
            PG8_WAIT_V(8); PG8_WAIT_L(0); PG8_BAR; PG8_MMA(0, 0, At, B0); PG8_MMA(0, 1, At, B1); PG8_BAR; PG8_SCHED;
            PG8_LDA(At, 1, 1); PG8_STAGE_B(PG8_SB(1, 0), b3); PG8_STAGE_B(PG8_SB(1, 1), b3 + hstepB); PG8_STAGE_A(PG8_SA(1, 0), a3, 0, nx);
            PG8_WAIT_V(8); PG8_WAIT_L(0); PG8_BAR; PG8_MMA(1, 0, At, B0); PG8_MMA(1, 1, At, B1); PG8_BAR; PG8_SCHED;
        }
        if (wr == 0) PG8_BAR;
        E(acc, cur, wr, wc, fr, fq);
        if (!has_next) break;
#pragma unroll
        for (int a = 0; a < 2; ++a)
#pragma unroll
            for (int b = 0; b < 2; ++b)
#pragma unroll
                for (int m = 0; m < 4; ++m)
#pragma unroll
                    for (int n = 0; n < 2; ++n) acc[a][b][m][n] = (f32x4){0.f, 0.f, 0.f, 0.f};
        cur = nxt; cA = nA; cB = nB; ++ui;
        if constexpr (Sched::GATHER) {
#pragma unroll
            for (int h = 0; h < 2; ++h)
#pragma unroll
                for (int i = 0; i < 2; ++i) vAc[h][i] = vAn[h][i]; }
        if (wr == 1) PG8_BAR;
    }
    PG8_WAIT_V(0);
    PG8_BAR;
}
}

namespace att {
constexpr int NW = 8, QBLK = 32, KVBLK = 64;
constexpr float SCALE = 0.088388347648318440f;
constexpr float THR = 8.f;
constexpr int LDQ = 1536, LDK = 1536, LDO = 1024;
constexpr size_t SHM_V = KVBLK * 128 * 2, SHM_K = KVBLK * 128 * 2, SHM_ATTN = 2 * SHM_V + 2 * SHM_K + NW * 64 * 4;
#define KSWZ(row, colB) ((row) * 256 + ((colB) ^ (((row) & 7) << 4)))
#define SBAR() __builtin_amdgcn_sched_barrier(0)
__device__ __forceinline__ int crow(int r, int hi) { return (r & 3) + 8 * (r >> 2) + 4 * hi; }
__device__ __forceinline__ void partialSM(f32x16& p0, f32x16& p1, float& m_reg, float& mn, float& alpha) {
  constexpr float C = SCALE * 1.4426950408889634f;
  float pmax = p0[0];
#pragma unroll
  for (int r = 1; r < 16; ++r) pmax = fmaxf(pmax, p0[r]);
#pragma unroll
  for (int r = 0; r < 16; ++r) pmax = fmaxf(pmax, p1[r]);
  { auto rr = __builtin_amdgcn_permlane32_swap(__float_as_uint(pmax), __float_as_uint(pmax), false, false);
    pmax = fmaxf(__uint_as_float(rr[0]), __uint_as_float(rr[1])); }
  if (__builtin_expect(__all(pmax - m_reg <= THR / SCALE), 1)) { mn = m_reg; alpha = 1.f; }
  else { mn = fmaxf(m_reg, pmax); alpha = __builtin_amdgcn_exp2f((m_reg - mn) * C); m_reg = mn; }
  float mnC = -mn * C;
#pragma unroll
  for (int r = 0; r < 16; ++r) p0[r] = fmaf(p0[r], C, mnC);
#pragma unroll
  for (int r = 0; r < 16; ++r) p1[r] = fmaf(p1[r], C, mnC);
#pragma unroll
  for (int r = 0; r < 16; ++r) p0[r] = __builtin_amdgcn_exp2f(p0[r]);
}
__device__ __forceinline__ void finishSM(f32x16& p0, f32x16& p1, float alpha, float& l_reg, bf16x8& pa0, bf16x8& pa1, bf16x8& pa2, bf16x8& pa3) {
#pragma unroll
  for (int r = 0; r < 16; ++r) p1[r] = __builtin_amdgcn_exp2f(p1[r]);
  float ps = 0;
#pragma unroll
  for (int r = 0; r < 16; ++r) ps += p0[r];
#pragma unroll
  for (int r = 0; r < 16; ++r) ps += p1[r];
  { auto rr = __builtin_amdgcn_permlane32_swap(__float_as_uint(ps), __float_as_uint(ps), false, false);
    ps = __uint_as_float(rr[0]) + __uint_as_float(rr[1]); }
  l_reg = l_reg * alpha + ps;
#define PK4(P, BASE, OUT) do { unsigned a0 = cvt_pk_bf16(P[BASE + 0], P[BASE + 1]), a1 = cvt_pk_bf16(P[BASE + 2], P[BASE + 3]);   \
    unsigned b0 = cvt_pk_bf16(P[BASE + 4], P[BASE + 5]), b1 = cvt_pk_bf16(P[BASE + 6], P[BASE + 7]);                              \
    auto r0 = __builtin_amdgcn_permlane32_swap(a0, b0, false, false); auto r1 = __builtin_amdgcn_permlane32_swap(a1, b1, false, false); \
    u32x4 w = {r0[0], r1[0], r0[1], r1[1]}; OUT = __builtin_bit_cast(bf16x8, w); } while (0)
  PK4(p0, 0, pa0); PK4(p0, 8, pa1); PK4(p1, 0, pa2); PK4(p1, 8, pa3);
#undef PK4
}
__device__ __forceinline__ void qkt(f32x16& p0, f32x16& p1, const bf16_t* Ks, const bf16x8* qr, int r32, int hi) {
  p0 = f32x16{}; p1 = f32x16{};
#pragma unroll
  for (int d0 = 0; d0 < 8; ++d0) { int cb = (d0 * 16 + hi * 8) * 2;
    bf16x8 b0 = *reinterpret_cast<const bf16x8*>((const char*)Ks + KSWZ(r32, cb));
    bf16x8 b1 = *reinterpret_cast<const bf16x8*>((const char*)Ks + KSWZ(32 + r32, cb));
    p0 = __builtin_amdgcn_mfma_f32_32x32x16_bf16(b0, qr[d0], p0, 0, 0, 0);
    p1 = __builtin_amdgcn_mfma_f32_32x32x16_bf16(b1, qr[d0], p1, 0, 0, 0); }
}
__device__ __forceinline__ int v_st(int k, int c) { const int kk = (k & ~0xC) | ((k & 4) << 1) | ((k & 8) >> 1); return ((kk >> 3) * 4 + (c >> 5)) * 512 + ((kk & 7) * 32 + (c & 31)) * 2; }
__device__ __forceinline__ int v_rd_base(int lane) { return ((lane & 3) << 3) | (((lane >> 2) & 3) << 6) | (((lane >> 4) & 1) << 5) | (((lane >> 5) & 1) << 8); }
constexpr int v_rd_off(int d0, int ks, int half) { return d0 * 512 + ks * 4096 + half * 2048; }
template <int OFF> __device__ __forceinline__ s16x4 tr_read(int vb) {
  s16x4 r; asm volatile("ds_read_b64_tr_b16 %0, %1 offset:%2" : "=&v"(r) : "v"(vb), "i"(OFF) : "memory"); return r;
}
template <int D0> __device__ __forceinline__ void pv_one(f32x16& od, int vb, bf16x8 pa0, bf16x8 pa1, bf16x8 pa2, bf16x8 pa3) {
  const s16x4 l0 = tr_read<v_rd_off(D0, 0, 0)>(vb), h0 = tr_read<v_rd_off(D0, 0, 1)>(vb), l1 = tr_read<v_rd_off(D0, 1, 0)>(vb), h1 = tr_read<v_rd_off(D0, 1, 1)>(vb);
  const s16x4 l2 = tr_read<v_rd_off(D0, 2, 0)>(vb), h2 = tr_read<v_rd_off(D0, 2, 1)>(vb), l3 = tr_read<v_rd_off(D0, 3, 0)>(vb), h3 = tr_read<v_rd_off(D0, 3, 1)>(vb);
  asm volatile("s_waitcnt lgkmcnt(0)" ::: "memory"); SBAR();
#define PK(L, H) (bf16x8){L[0], L[1], L[2], L[3], H[0], H[1], H[2], H[3]}
  od = __builtin_amdgcn_mfma_f32_32x32x16_bf16(pa0, PK(l0, h0), od, 0, 0, 0);
  od = __builtin_amdgcn_mfma_f32_32x32x16_bf16(pa1, PK(l1, h1), od, 0, 0, 0);
  od = __builtin_amdgcn_mfma_f32_32x32x16_bf16(pa2, PK(l2, h2), od, 0, 0, 0);
  od = __builtin_amdgcn_mfma_f32_32x32x16_bf16(pa3, PK(l3, h3), od, 0, 0, 0);
#undef PK
}
__device__ __forceinline__ void pv_d0(f32x16* o, int vb, bf16x8 pa0, bf16x8 pa1, bf16x8 pa2, bf16x8 pa3) {
  pv_one<0>(o[0], vb, pa0, pa1, pa2, pa3); pv_one<1>(o[1], vb, pa0, pa1, pa2, pa3); pv_one<2>(o[2], vb, pa0, pa1, pa2, pa3); pv_one<3>(o[3], vb, pa0, pa1, pa2, pa3);
}
__device__ __forceinline__ void attn_dense_body(const bf16_t* Qb, const bf16_t* Kh, const bf16_t* Vh, bf16_t* Ob, int seq, char* lds, const int tid) {
  const int wid = tid >> 6, lane = tid & 63, r32 = lane & 31, hi = lane >> 5;
  bf16_t* V_lds = (bf16_t*)lds; bf16_t* K_lds = (bf16_t*)(lds + 2 * SHM_V);
  float* ws = (float*)(lds + 2 * SHM_V + 2 * SHM_K) + wid * 64; float* li_l = ws; float* al_l = ws + 32;
  float m_reg = -1e30f, l_reg = 0; f32x16 o[4] = {}; bf16x8 qr[8];
  const bf16_t* Qw = Qb + (long)(wid * QBLK + r32) * LDQ + hi * 8;
#pragma unroll
  for (int d0 = 0; d0 < 8; ++d0) qr[d0] = *reinterpret_cast<const bf16x8*>(Qw + d0 * 16);
  const int sr = tid >> 4, sc = (tid & 15) * 8, vst0 = v_st(sr, sc), vst1 = v_st(32 + sr, sc);
  const int vb0 = (int)(uintptr_t)V_lds + v_rd_base(lane);
  struct { bf16x8 vs0, vs1, ks0, ks1; } sr_[2];
  const unsigned vo0 = (unsigned)(sr * LDK + sc) * 2u, vo1 = (unsigned)((32 + sr) * LDK + sc) * 2u;
  const long vdelta = (const char*)Vh - (const char*)Kh;
#define SLOAD(i, k0) do { const char* kb_ = (const char*)Kh + (size_t)(k0) * (LDK * 2); const char* vb_ = kb_ + vdelta; \
    sr_[i].vs0 = *reinterpret_cast<const bf16x8*>(vb_ + vo0); sr_[i].vs1 = *reinterpret_cast<const bf16x8*>(vb_ + vo1); \
    sr_[i].ks0 = *reinterpret_cast<const bf16x8*>(kb_ + vo0); sr_[i].ks1 = *reinterpret_cast<const bf16x8*>(kb_ + vo1); } while (0)
#define SWRITE(b, i) do { *(bf16x8*)((char*)V_lds + (b) * SHM_V + vst0) = sr_[i].vs0;          \
    *(bf16x8*)((char*)V_lds + (b) * SHM_V + vst1) = sr_[i].vs1; int kc = sc * 2;               \
    *(bf16x8*)((char*)K_lds + (b) * SHM_K + KSWZ(sr, kc)) = sr_[i].ks0;                       \
    *(bf16x8*)((char*)K_lds + (b) * SHM_K + KSWZ(32 + sr, kc)) = sr_[i].ks1; } while (0)
#define SWAIT() asm volatile("s_waitcnt vmcnt(4)" ::: "memory")
#define RESC(a) do { if (__any((a) < 1.f)) { if (hi == 0) al_l[r32] = (a); asm volatile("s_waitcnt lgkmcnt(0)" ::: "memory"); \
    _Pragma("unroll") for (int d = 0; d < 4; ++d) _Pragma("unroll") for (int r = 0; r < 16; ++r) o[d][r] *= al_l[crow(r, hi)]; } } while (0)
  f32x16 pA0, pA1, pB0, pB1; float mnA, mnB, alA, alB; bf16x8 pa0, pa1, pa2, pa3; const int NT = seq / KVBLK;
  constexpr int SE = 0, SO = 1;
  SLOAD(SE, 0); asm volatile("s_waitcnt vmcnt(0)" ::: "memory"); SWRITE(0, SE); __syncthreads();
  qkt(pA0, pA1, K_lds, qr, r32, hi); partialSM(pA0, pA1, m_reg, mnA, alA);
  SLOAD(SO, KVBLK); if (2 < NT) SLOAD(SE, 2 * KVBLK);
  SWAIT(); SWRITE(1, SO); __syncthreads();
  for (int j = 1; j + 1 < NT; j += 2) {
    SBAR(); qkt(pB0, pB1, (bf16_t*)((char*)K_lds + SHM_K), qr, r32, hi);
    finishSM(pA0, pA1, alA, l_reg, pa0, pa1, pa2, pa3); SBAR();
    SLOAD(SO, (j + 2) * KVBLK); SBAR();
    pv_d0(o, vb0, pa0, pa1, pa2, pa3); partialSM(pB0, pB1, m_reg, mnB, alB);
    __syncthreads(); SWAIT(); SWRITE(0, SE);
    RESC(alB); __syncthreads();
    SBAR(); qkt(pA0, pA1, K_lds, qr, r32, hi);
    finishSM(pB0, pB1, alB, l_reg, pa0, pa1, pa2, pa3); SBAR();
    if (j + 3 < NT) SLOAD(SE, (j + 3) * KVBLK); SBAR();
    pv_d0(o, vb0 + (int)SHM_V, pa0, pa1, pa2, pa3); partialSM(pA0, pA1, m_reg, mnA, alA);
    __syncthreads(); SWAIT(); SWRITE(1, SO);
    RESC(alA); __syncthreads();
  }
  SBAR(); qkt(pB0, pB1, (bf16_t*)((char*)K_lds + SHM_K), qr, r32, hi);
  finishSM(pA0, pA1, alA, l_reg, pa0, pa1, pa2, pa3); SBAR();
  pv_d0(o, vb0, pa0, pa1, pa2, pa3); partialSM(pB0, pB1, m_reg, mnB, alB);
  __syncthreads(); RESC(alB);
  finishSM(pB0, pB1, alB, l_reg, pa0, pa1, pa2, pa3); SBAR();
  pv_d0(o, vb0 + (int)SHM_V, pa0, pa1, pa2, pa3);
  if (hi == 0) li_l[r32] = l_reg; asm volatile("s_waitcnt lgkmcnt(0)" ::: "memory");
  float rli[16];
#pragma unroll
  for (int r = 0; r < 16; ++r) rli[r] = __builtin_amdgcn_rcpf(li_l[crow(r, hi)]);
  bf16_t* Ow = Ob + (long)(wid * QBLK) * LDO;
#pragma unroll
  for (int r = 0; r < 16; ++r) { int orow = crow(r, hi);
#pragma unroll
    for (int d0 = 0; d0 < 4; ++d0) Ow[(long)orow * LDO + d0 * 32 + r32] = (bf16_t)f2bf(o[d0][r] * rli[r]); }
#undef SLOAD
#undef SWRITE
#undef SWAIT
#undef RESC
}
}

#define XB_TMO      128
#define XB_XCNT(j)  (256  + 64 * (j))
#define XB_XSUB(j)  (1280 + 64 * (j))
#define XB_XGEN(j)  (2304 + 64 * (j))
#define XB_TOP      3328
#define XB_TOPGEN   3392
#define XB_SPIN_CAP (1u << 22)
__device__ __forceinline__ unsigned xb_ld(unsigned* p)              { return __hip_atomic_load(p, __ATOMIC_RELAXED, __HIP_MEMORY_SCOPE_AGENT); }
__device__ __forceinline__ unsigned xb_add(unsigned* p, unsigned v) { return __hip_atomic_fetch_add(p, v, __ATOMIC_RELAXED, __HIP_MEMORY_SCOPE_AGENT); }
__device__ __forceinline__ unsigned xb_xcc_id() { return (unsigned)__builtin_amdgcn_s_getreg((3 << 11) | 20) & 0xFu; }
#define XB_SPIN(cond, bar) do { unsigned _sp = 0; while (cond) { __builtin_amdgcn_s_sleep(1); \
    if ((++_sp & 255u) == 0u) { if (xb_ld(&(bar)[XB_TMO])) break; if (_sp > XB_SPIN_CAP) { atomicAdd(&(bar)[XB_TMO], 1u); break; } } } } while (0)
struct XcdBarrier { unsigned* bar; unsigned x; volatile LAS unsigned* st; };
__device__ __forceinline__ XcdBarrier xcd_barrier_post(unsigned* bar, volatile LAS unsigned* st) {
    XcdBarrier b; b.bar = bar; b.x = xb_xcc_id(); b.st = st;
    if (threadIdx.x == 0) (void)xb_add(&bar[XB_XCNT(b.x)], 1u);
    return b;
}
__device__ __forceinline__ void xcd_barrier_complete(unsigned* bar, unsigned x, unsigned& nloc, unsigned& nx) {
    const unsigned G = gridDim.x * gridDim.y * gridDim.z;
    unsigned sum, cnt, mine, sp = 0u;
    for (;;) {
        sum = 0u; cnt = 0u; mine = 0u;
#pragma unroll
        for (unsigned j = 0; j < 16; ++j) { const unsigned c = xb_ld(&bar[XB_XCNT(j)]); sum += c; cnt += (c > 0u) ? 1u : 0u; mine = (j == x) ? c : mine; }
        if (sum == G) break;
        __builtin_amdgcn_s_sleep(1);
        if ((++sp & 255u) == 0u) { if (xb_ld(&bar[XB_TMO])) break; if (sp > XB_SPIN_CAP) { atomicAdd(&bar[XB_TMO], 1u); break; } }
    }
    nloc = mine > 0u ? mine : 1u; nx = cnt > 0u ? cnt : 1u;
}
__device__ __forceinline__ void xcd_barrier(const XcdBarrier& b_) {
    XcdBarrier b; b.bar = b_.bar; b.st = b_.st; b.x = xb_xcc_id();
    asm volatile("s_waitcnt vmcnt(0)" ::: "memory");
    __syncthreads();
    if (threadIdx.x == 0) {
        unsigned* bar = b.bar;
        __builtin_amdgcn_s_waitcnt(0);
        unsigned nloc = b.st[0], nx = b.st[1];
        if (nloc == 0u) { xcd_barrier_complete(bar, b.x, nloc, nx); b.st[0] = nloc; b.st[1] = nx; }
        const unsigned old = xb_add(&bar[XB_XSUB(b.x)], 1u);
        const unsigned gen = old / nloc;
        if (old + 1u == (gen + 1u) * nloc) {
            __builtin_amdgcn_fence(__ATOMIC_RELEASE, "agent");
            asm volatile("s_waitcnt vmcnt(0)" ::: "memory");
            const unsigned og = xb_add(&bar[XB_TOP], 1u);
            const unsigned tg = og / nx;
            if (og + 1u == (tg + 1u) * nx) xb_add(&bar[XB_TOPGEN], 1u);
            else XB_SPIN(xb_ld(&bar[XB_TOPGEN]) == tg, bar);
            __builtin_amdgcn_fence(__ATOMIC_ACQUIRE, "agent");
            xb_add(&bar[XB_XGEN(b.x)], 1u);
            asm volatile("s_waitcnt vmcnt(0)" ::: "memory");
        } else {
            XB_SPIN(xb_ld(&bar[XB_XGEN(b.x)]) == gen, bar);
            __builtin_amdgcn_fence(__ATOMIC_ACQUIRE, "agent");
            asm volatile("s_waitcnt vmcnt(0)" ::: "memory");
        }
    }
    __syncthreads();
}

struct Args { const float* in[34]; float* out; uchar* ws; int ph_lo, ph_hi; };
enum { I_X = 0, I_C, I_CTX, I_CCTX, I_ADAW, I_ADAB, I_NMG, I_NFG, I_RGWIN, I_RGCW, I_RGCB, I_RGWA, I_RGBA, I_RGWI, I_RGBI, I_RGLAM, I_RGWOUT,
       I_ATQKV, I_ATQG, I_ATKG, I_ATWO, I_CMWIN, I_CMLNG, I_CMLNB, I_CMWS, I_CMBS, I_CMWOUT, I_MWG, I_MBG, I_MWR, I_MBR, I_MWGATE, I_MWUP, I_MWDOWN };

__device__ __forceinline__ const void* opaque_uniform_ptr(const void* p) { const unsigned long long v = (unsigned long long)p; unsigned lo = (unsigned)v, hi = (unsigned)(v >> 32); asm volatile("" : "+v"(lo), "+v"(hi));
    lo = __builtin_amdgcn_readfirstlane(lo); hi = __builtin_amdgcn_readfirstlane(hi); return (const void*)(((unsigned long long)hi << 32) | lo); }
__device__ __forceinline__ int opaque_uniform_int(int x) { asm volatile("" : "+v"(x)); return __builtin_amdgcn_readfirstlane(x); }
struct Frame {
    LAS uchar* lds; char* ldsg;
    int tid, lane, wave, G, bid;
    uchar* ws; const float* const* in; float* out;
};
__device__ __forceinline__ float wave16_sum(float v) { v += __shfl_xor(v, 1); v += __shfl_xor(v, 2); v += __shfl_xor(v, 4); v += __shfl_xor(v, 8); return v; }

__device__ __forceinline__ void tr_item(const float* W, int ldw, bf16_t* WT, int ldt, int k0, int n0, int dstrow0, LAS float* scr, int lane) {
#pragma unroll 8
    for (int i = 0; i < 32; ++i) { const int kk = 2 * i + (lane >> 5); scr[kk * 33 + (lane & 31)] = W[(size_t)(k0 + kk) * ldw + n0 + (lane & 31)]; }
    asm volatile("s_waitcnt lgkmcnt(0)" ::: "memory");
    const int c = lane & 7;
#pragma unroll
    for (int j = 0; j < 4; ++j) { const int n = (lane >> 3) + 8 * j; const LAS float* s = scr + (8 * c) * 33 + n;
        u32x4 o; o.x = pk2(s[0 * 33], s[1 * 33]); o.y = pk2(s[2 * 33], s[3 * 33]); o.z = pk2(s[4 * 33], s[5 * 33]); o.w = pk2(s[6 * 33], s[7 * 33]);
        *(u32x4*)(WT + (size_t)(dstrow0 + n) * ldt + k0 + 8 * c) = o; }
    asm volatile("s_waitcnt lgkmcnt(0)" ::: "memory");
}
__device__ __forceinline__ bool tr_group(int& r, const float* W, int K, int N, int nmat, bf16_t* WT, int ldt, size_t dst_mat_stride, int mode, LAS float* scr, int lane) {
    const int per = (K / 64) * (N / 32), tot = per * nmat;
    if (r >= tot) { r -= tot; return false; }
    const int mat = r / per, it = r % per, nblk = N / 32, kb = it / nblk, nb = it % nblk, n0 = nb * 32;
    int drow = n0;
    if (mode == 1) drow = (n0 >> 7) * 256 + (n0 & 127);
    else if (mode == 2) drow = (n0 >> 7) * 256 + 128 + (n0 & 127);
    tr_item(W + (size_t)mat * K * N, N, WT + (size_t)mat * dst_mat_stride, ldt, kb * 64, n0, drow, scr, lane);
    return true;
}
__device__ __forceinline__ void p0_prologue(Frame& F) {
    const float* const* in = F.in; uchar* ws = F.ws;
    {
        LAS float* act = (LAS float*)(F.lds);
        LAS float* red = (LAS float*)(F.lds + 5 * 1024 * 4);
        bool have = false;
        for (int it = F.bid; it < DEPTH * 24; it += F.G) {
            if (!have) { for (int i = F.tid; i < 5 * 1024; i += 512) { const int s = i >> 10, k = i & 1023; const float v = s < 4 ? in[I_C][s * 1024 + k] : in[I_CCTX][k]; act[i] = v / (1.f + __expf(-v)); } have = true; __syncthreads(); }
            const int l = it / 24, cb = it % 24;
            const float* W = in[I_ADAW] + (size_t)l * 1024 * NMODV + cb * 256 + F.lane * 4;
            f32x4 a[5];
#pragma unroll
            for (int s = 0; s < 5; ++s) a[s] = (f32x4){0.f, 0.f, 0.f, 0.f};
            const int kbase = F.wave * 128;
#pragma unroll 8
            for (int k = 0; k < 128; ++k) { const f32x4 w = *(const f32x4*)(W + (size_t)(kbase + k) * NMODV);
#pragma unroll
                for (int s = 0; s < 5; ++s) a[s] += w * act[s * 1024 + kbase + k]; }
#pragma unroll
            for (int s = 0; s < 5; ++s) *(LAS f32x4*)(red + (F.wave * 5 + s) * 256 + F.lane * 4) = a[s];
            __syncthreads();
            for (int i = F.tid; i < 5 * 256; i += 512) { const int s = i >> 8, c = i & 255; float v = in[I_ADAB][l * NMODV + cb * 256 + c];
#pragma unroll
                for (int w = 0; w < 8; ++w) v += red[(w * 5 + s) * 256 + c];
                ((float*)(ws + WS_MOD))[(l * 5 + s) * NMODV + cb * 256 + c] = v; }
            __syncthreads();
        }
        __syncthreads();
    }
    {
        LAS float* scr = (LAS float*)(F.lds + F.wave * 16384);
        const int gw = F.bid * 8 + F.wave, NGW = F.G * 8;
        constexpr int NITEMS = 2048 + 512 + 1024 + 768 + 512 + 2048 + 1024 + 3 * 32768;
        for (int it = gw; it < NITEMS; it += NGW) {
            int r = it;
            if (tr_group(r, in[I_MWGATE], 1024, 512, 128, (bf16_t*)(ws + WS_W_E1), 1024, (size_t)1024 * 1024, 1, scr, F.lane)) continue;
            if (tr_group(r, in[I_MWUP], 1024, 512, 128, (bf16_t*)(ws + WS_W_E1), 1024, (size_t)1024 * 1024, 2, scr, F.lane)) continue;
            if (tr_group(r, in[I_MWDOWN], 512, 1024, 128, (bf16_t*)(ws + WS_W_E2), 512, (size_t)1024 * 512, 0, scr, F.lane)) continue;
            if (tr_group(r, in[I_RGWIN], 1024, 2048, 2, (bf16_t*)(ws + WS_W_RGIN), 1024, (size_t)2048 * 1024, 0, scr, F.lane)) continue;
            if (tr_group(r, in[I_CMWIN], 1024, 4096, 1, (bf16_t*)(ws + WS_W_CMIN), 1024, 0, 0, scr, F.lane)) continue;
            if (tr_group(r, in[I_RGWOUT], 1024, 1024, 2, (bf16_t*)(ws + WS_W_RGOUT), 1024, (size_t)1024 * 1024, 0, scr, F.lane)) continue;
            if (tr_group(r, in[I_CMWOUT], 2048, 1024, 1, (bf16_t*)(ws + WS_W_CMOUT), 2048, 0, 0, scr, F.lane)) continue;
            if (tr_group(r, in[I_ATQKV], 1024, 1536, 1, (bf16_t*)(ws + WS_W_QKV), 1024, 0, 0, scr, F.lane)) continue;
            if (tr_group(r, in[I_ATWO], 1024, 1024, 1, (bf16_t*)(ws + WS_W_AO), 1024, 0, 0, scr, F.lane)) continue;
            if (r < 256) { const int mat = r / 8, itx = r % 8, kb = itx / 4, nb = itx % 4;
                tr_item(in[I_RGWA] + (size_t)mat * 128 * 128, 128, (bf16_t*)(ws + WS_W_RGG) + (size_t)mat * 256 * 128, 128, kb * 64, nb * 32, nb * 32, scr, F.lane); continue; }
            r -= 256;
            { const int mat = r / 8, itx = r % 8, kb = itx / 4, nb = itx % 4;
                tr_item(in[I_RGWI] + (size_t)mat * 128 * 128, 128, (bf16_t*)(ws + WS_W_RGG) + (size_t)mat * 256 * 128, 128, kb * 64, nb * 32, 128 + nb * 32, scr, F.lane); }
        }
    }
    {
        const int gt = F.bid * 512 + F.tid, NGT = F.G * 512;
        for (int i = gt; i < T * 256; i += NGT) { const int row = i >> 8, c4 = i & 255, b = row / SB, s = row - b * SB;
            const float* src = s < CTX ? in[I_CTX] + ((size_t)(b * CTX + s) << 10) : in[I_X] + ((size_t)(b * SEQ + s - CTX) << 10);
            ((f32x4*)(ws + WS_X))[i] = ((const f32x4*)src)[c4]; }
        for (int i = gt; i < 8 * 128 * 128 / 4; i += NGT) { const f32x4 v = ((const f32x4*)in[I_CMWS])[i]; u32x2 o; o.x = pk2(v.x, v.y); o.y = pk2(v.z, v.w); ((u32x2*)(ws + WS_W_CMS))[i] = o; }
        for (int i = gt; i < 2 * 2 * D; i += NGT) ((float*)(ws + WS_SPL))[i] = -8.f * log1pf(expf(-in[I_RGLAM][i]));
        for (int i = gt; i < 64 * 32; i += NGT) { const int pos = i >> 5, f = i & 31; const float inv = powf(10000.f, -(float)f * 2.0f / 64.0f); const float ang = (float)pos * inv;
            ((f32x2*)(ws + WS_ROPE))[i] = (f32x2){cosf(ang), sinf(ang)}; }
    }
}

template <bool ROUTE>
__device__ __forceinline__ void norm_phase(Frame& F, int l, const float* gvec, int shift_i, bool addY, bool skip_ctx_route) {
    uchar* ws = F.ws;
    float* X = (float*)(ws + WS_X); const float* Y1 = (const float*)(ws + WS_Y1); bf16_t* H = (bf16_t*)(ws + WS_H);
    const float* MOD = (const float*)(ws + WS_MOD) + (size_t)l * 5 * NMODV;
    LAS float* wr = (LAS float*)F.lds;
    if constexpr (ROUTE) {
        const float* wg = F.in[I_MWG] + (size_t)l * 1024 * 4; const float* wrt = F.in[I_MWR] + (size_t)l * 1024 * 32;
        for (int idx = F.tid; idx < 1024 * 9; idx += 512) { const int k = idx / 9, q = idx - k * 9;
            const f32x4 v = q == 0 ? *(const f32x4*)(wg + k * 4) : *(const f32x4*)(wrt + k * 32 + (q - 1) * 4);
            wr[(4 * q + 0) * 1024 + k] = v.x; wr[(4 * q + 1) * 1024 + k] = v.y; wr[(4 * q + 2) * 1024 + k] = v.z; wr[(4 * q + 3) * 1024 + k] = v.w; }
        __syncthreads();
    }
    const int i16 = F.lane & 15, grp = F.lane >> 4;
    for (int tok = (F.bid * 8 + F.wave) * 4 + grp; tok < T; tok += F.G * 32) {
        const int sidx = sidx_of_row(tok);
        f32x4 x[16];
        float ss = 0.f;
#pragma unroll
        for (int j = 0; j < 16; ++j) { x[j] = *(const f32x4*)(X + (size_t)tok * D + 64 * j + 4 * i16);
            if (addY) { x[j] += *(const f32x4*)(Y1 + (size_t)tok * D + 64 * j + 4 * i16); *(f32x4*)(X + (size_t)tok * D + 64 * j + 4 * i16) = x[j]; }
            ss += x[j].x * x[j].x + x[j].y * x[j].y + x[j].z * x[j].z + x[j].w * x[j].w; }
        ss = wave16_sum(ss);
        const float rstd = rsqrtf(ss * (1.f / D) + NORM_EPS);
        const float* shp = MOD + (size_t)sidx * NMODV + shift_i * D; const float* scp = shp + D;
#pragma unroll
        for (int j = 0; j < 16; ++j) { const int c = 64 * j + 4 * i16; const f32x4 g = *(const f32x4*)(gvec + c), sh = *(const f32x4*)(shp + c), sc = *(const f32x4*)(scp + c);
            x[j] = x[j] * rstd * g * (sc + 1.f) + sh;
            u32x2 o; o.x = pk2(x[j].x, x[j].y); o.y = pk2(x[j].z, x[j].w); *(u32x2*)(H + (size_t)tok * D + c) = o; }
        if constexpr (ROUTE) {
            LAS float* lgs = (LAS float*)(F.lds + LDSCTL_OFF + 1024) + (F.wave * 4 + grp) * 40;
#pragma unroll 1
            for (int o = 0; o < 36; ++o) { float a = 0.f;
#pragma unroll
                for (int j = 0; j < 16; ++j) { const f32x4 w = *(const LAS f32x4*)(wr + o * 1024 + 64 * j + 4 * i16); a += x[j].x * w.x + x[j].y * w.y + x[j].z * w.z + x[j].w * w.w; }
                a = wave16_sum(a); if (i16 == 0) lgs[o] = a; }
            asm volatile("s_waitcnt lgkmcnt(0)" ::: "memory");
            const float* bg = F.in[I_MBG] + l * 4; const float* br = F.in[I_MBR] + l * 32;
            const float gl0 = lgs[0] + bg[0], gl1 = lgs[1] + bg[1], gl2 = lgs[2] + bg[2], gl3 = lgs[3] + bg[3];
            int gs = 0; float gm = gl0;
            if (gl1 > gm) { gm = gl1; gs = 1; }
            if (gl2 > gm) { gm = gl2; gs = 2; }
            if (gl3 > gm) { gm = gl3; gs = 3; }
            const float den = __expf(gl0 - gm) + __expf(gl1 - gm) + __expf(gl2 - gm) + __expf(gl3 - gm);
            const float pg = 1.f / den;
            float el[8];
#pragma unroll
            for (int e = 0; e < 8; ++e) el[e] = lgs[4 + gs * 8 + e] + br[gs * 8 + e];
            int i0 = 0; float v0 = el[0];
#pragma unroll
            for (int e = 1; e < 8; ++e) if (el[e] > v0) { v0 = el[e]; i0 = e; }
            int i1 = -1; float v1 = -3.0e38f;
#pragma unroll
            for (int e = 0; e < 8; ++e) if (e != i0 && el[e] > v1) { v1 = el[e]; i1 = e; }
            const float p0 = 1.f / (1.f + __expf(v1 - v0));
            const float w0 = p0 * pg, w1 = (1.f - p0) * pg;
            const bool do_route = !(skip_ctx_route && sidx == 4);
            if (i16 == 0 && do_route) {
                const int e0 = gs * 8 + i0, e1 = gs * 8 + i1;
                unsigned* cnt = (unsigned*)(ws + WS_CTL) + CW_CNT + l * 32 * 64;
                const unsigned q0 = atomicAdd(cnt + e0 * 64, 1u), q1 = atomicAdd(cnt + e1 * 64, 1u);
                int* BK = (int*)(ws + WS_BK); float* TW = (float*)(ws + WS_TW);
                BK[(size_t)e0 * T + q0] = tok * 2; BK[(size_t)e1 * T + q1] = tok * 2 + 1;
                TW[tok * 2] = w0; TW[tok * 2 + 1] = w1;
            }
        }
    }
}

__device__ __forceinline__ void st8(bf16_t* p, f32x4 v0, f32x4 v1) { u32x4 w; w.x = cvt_pk_bf16(v0[0], v0[1]); w.y = cvt_pk_bf16(v0[2], v0[3]); w.z = cvt_pk_bf16(v1[0], v1[1]); w.w = cvt_pk_bf16(v1[2], v1[3]); *(u32x4*)p = w; }
#define EPI_ROWS(ai, m) (u.pm * 256 + (ai) * 128 + wr * 64 + (m) * 16 + fr)

struct EpiRgIn { static constexpr bool PERM = true; bf16_t* GG; bf16_t* XB;
    __device__ __forceinline__ void operator()(const f32x4 (&acc)[2][2][4][2], const pg8::Unit& u, int wr, int wc, int fr, int fq) const {
        const bool isg = u.pn < 4; bf16_t* base = isg ? GG : XB; const int ct = (u.pn & 3) * 256 + wc * 32 + 8 * fq;
#pragma unroll
        for (int ai = 0; ai < 2; ++ai)
#pragma unroll
            for (int m = 0; m < 4; ++m) { bf16_t* rowp = base + (size_t)EPI_ROWS(ai, m) * D + ct;
#pragma unroll
                for (int bj = 0; bj < 2; ++bj) { f32x4 v0 = acc[ai][bj][m][0], v1 = acc[ai][bj][m][1];
                    if (isg) {
#pragma unroll
                        for (int e = 0; e < 4; ++e) { v0[e] = gelu_tanh(v0[e]); v1[e] = gelu_tanh(v1[e]); } }
                    st8(rowp + bj * 128, v0, v1); } }
    } };
struct EpiBf16 { static constexpr bool PERM = true; bf16_t* O; int ldc;
    __device__ __forceinline__ void operator()(const f32x4 (&acc)[2][2][4][2], const pg8::Unit& u, int wr, int wc, int fr, int fq) const {
        const int ct = u.pn * 256 + wc * 32 + 8 * fq;
#pragma unroll
        for (int ai = 0; ai < 2; ++ai)
#pragma unroll
            for (int m = 0; m < 4; ++m) { bf16_t* rowp = O + (size_t)EPI_ROWS(ai, m) * ldc + ct;
#pragma unroll
                for (int bj = 0; bj < 2; ++bj) st8(rowp + bj * 128, acc[ai][bj][m][0], acc[ai][bj][m][1]); }
    } };
struct EpiCmIn { static constexpr bool PERM = true; bf16_t* O; f32x2* statp;
    __device__ __forceinline__ void operator()(const f32x4 (&acc)[2][2][4][2], const pg8::Unit& u, int wr, int wc, int fr, int fq) const {
        const int ct = u.pn * 256 + wc * 32 + 8 * fq; const bool isv = u.pn >= 8;
#pragma unroll
        for (int ai = 0; ai < 2; ++ai)
#pragma unroll
            for (int m = 0; m < 4; ++m) { const int row = EPI_ROWS(ai, m); bf16_t* rowp = O + (size_t)row * 4096 + ct; float s = 0.f, q = 0.f;
#pragma unroll
                for (int bj = 0; bj < 2; ++bj) { f32x4 v0 = acc[ai][bj][m][0], v1 = acc[ai][bj][m][1];
#pragma unroll
                    for (int e = 0; e < 4; ++e) { v0[e] = gelu_tanh(v0[e]); v1[e] = gelu_tanh(v1[e]); }
                    u32x4 w; w.x = cvt_pk_bf16(v0[0], v0[1]); w.y = cvt_pk_bf16(v0[2], v0[3]); w.z = cvt_pk_bf16(v1[0], v1[1]); w.w = cvt_pk_bf16(v1[2], v1[3]);
                    *(u32x4*)(rowp + bj * 128) = w;
                    const float r0 = bflo(w.x), r1 = bfhi(w.x), r2 = bflo(w.y), r3 = bfhi(w.y), r4 = bflo(w.z), r5 = bfhi(w.z), r6 = bflo(w.w), r7 = bfhi(w.w);
                    s += ((r0 + r1) + (r2 + r3)) + ((r4 + r5) + (r6 + r7)); q += ((r0 * r0 + r1 * r1) + (r2 * r2 + r3 * r3)) + ((r4 * r4 + r5 * r5) + (r6 * r6 + r7 * r7)); }
                if (isv) { s += __shfl_xor(s, 16); s += __shfl_xor(s, 32); q += __shfl_xor(q, 16); q += __shfl_xor(q, 32);
                    if (fq == 0) statp[(size_t)row * 32 + (u.pn - 8) * 4 + wc] = (f32x2){s, q}; } }
    } };
struct EpiResid { static constexpr bool PERM = false; float* X; const float* gate  ;
    __device__ __forceinline__ void operator()(const f32x4 (&acc)[2][2][4][2], const pg8::Unit& u, int wr, int wc, int fr, int fq) const {
        const int sidx = sidx_of_row(u.pm * 256); const float* gp = gate + (size_t)sidx * NMODV; const int ct = u.pn * 256 + wc * 32 + 4 * fq;
        f32x4 gv[2][2];
#pragma unroll
        for (int bj = 0; bj < 2; ++bj)
#pragma unroll
            for (int n = 0; n < 2; ++n) gv[bj][n] = *(const f32x4*)(gp + ct + bj * 128 + n * 16);
#pragma unroll
        for (int ai = 0; ai < 2; ++ai)
#pragma unroll
            for (int m = 0; m < 4; ++m) { float* rowp = X + (size_t)EPI_ROWS(ai, m) * D + ct;
#pragma unroll
                for (int bj = 0; bj < 2; ++bj)
#pragma unroll
                    for (int n = 0; n < 2; ++n) { f32x4* p = (f32x4*)(rowp + bj * 128 + n * 16); *p = *p + gv[bj][n] * acc[ai][bj][m][n]; } }
    } };
struct EpiRgGate { static constexpr bool PERM = true; const bf16_t* XC; bf16_t* LA; bf16_t* BB; const float* ba; const float* bi; const float* lam;
    __device__ __forceinline__ void operator()(const f32x4 (&acc)[2][2][4][2], const pg8::Unit& u, int wr, int wc, int fr, int fq) const {
        const int d = u.pn >> 3, blk = u.pn & 7;
        asm volatile("" : "+v"(fr), "+v"(fq));
#pragma unroll
        for (int n = 0; n < 2; ++n) { const int ch = blk * 128 + wc * 32 + 8 * fq + 4 * n;
            const f32x4 bav = *(const f32x4*)(ba + d * D + ch), biv = *(const f32x4*)(bi + d * D + ch), spv = *(const f32x4*)(lam + d * D + ch);
#pragma unroll
            for (int ai = 0; ai < 2; ++ai)
#pragma unroll
                for (int m = 0; m < 4; ++m) { const size_t off = (size_t)EPI_ROWS(ai, m) * D + ch;
                    const u32x2 xw = *(const u32x2*)(XC + off);
                    const f32x4 xc = {bflo(xw.x), bfhi(xw.x), bflo(xw.y), bfhi(xw.y)};
                    f32x4 la, bb;
#pragma unroll
                    for (int e = 0; e < 4; ++e) { const float r = fast_sigmoid(acc[ai][0][m][n][e] + bav[e]), ig = fast_sigmoid(acc[ai][1][m][n][e] + biv[e]);
                        const float lga = r * spv[e]; la[e] = lga; bb[e] = __builtin_amdgcn_sqrtf(one_minus_exp(-2.f * lga)) * ig * xc[e]; }
                    u32x2 w; w.x = cvt_pk_bf16(la[0], la[1]); w.y = cvt_pk_bf16(la[2], la[3]);
                    *(u32x2*)(LA + (size_t)d * T * D + off) = w;
                    w.x = cvt_pk_bf16(bb[0], bb[1]); w.y = cvt_pk_bf16(bb[2], bb[3]);
                    *(u32x2*)(BB + (size_t)d * T * D + off) = w; __builtin_amdgcn_sched_barrier(0); }
            asm volatile("" ::: "memory"); }
    } };

template <bool G1>
struct MoeOrder {
    static constexpr bool GATHER = G1;
    const LAS int* tab; const char* A; const char* B; const int* BK; int G, c, nunits; size_t bstride;
    __device__ bool next(int i, pg8::Unit& u) const {
        const long L = (long)i * G + c; if (L >= nunits) return false;
        const int wgid = __builtin_amdgcn_readfirstlane(pg8::xcd_remap((int)L, nunits)); const int tau = wgid >> 2, pn = wgid & 3;
        int e = 0;
#pragma unroll 1
        for (int k = 1; k < 32; ++k) e = (tab[k] <= tau) ? k : e;
        e = __builtin_amdgcn_readfirstlane(e);
        u.pm = tau; u.pn = pn; u.aux0 = e; u.aux1 = __builtin_amdgcn_readfirstlane((tau - tab[e]) * 256);
        u.a = pg8::uptr(G1 ? A : A + (size_t)tau * 256 * DEXP * 2);
        u.b = pg8::uptr(B + (size_t)e * bstride + (size_t)pn * 256 * (G1 ? 1024 : DEXP) * 2);
        return true; }
    __device__ unsigned goff(const pg8::Unit& u, int row) const {
        const int pos = u.aux1 + row; const int cnt = tab[40 + u.aux0];
        int tok = 0; if (pos < cnt) tok = __builtin_nontemporal_load(BK + (size_t)u.aux0 * T + pos) >> 1;
        return (unsigned)tok * (unsigned)(D * 2); }
};
struct EpiMoe1 { static constexpr bool PERM = true; bf16_t* H1;
    __device__ __forceinline__ void operator()(const f32x4 (&acc)[2][2][4][2], const pg8::Unit& u, int wr, int wc, int fr, int fq) const {
        const int ct = u.pn * 128 + wc * 32 + 8 * fq;
#pragma unroll
        for (int ai = 0; ai < 2; ++ai)
#pragma unroll
            for (int m = 0; m < 4; ++m) { f32x4 h0, h1;
#pragma unroll
                for (int e = 0; e < 4; ++e) { const float g0 = acc[ai][0][m][0][e], g1 = acc[ai][0][m][1][e]; h0[e] = g0 * sigmoidf_(g0) * acc[ai][1][m][0][e]; h1[e] = g1 * sigmoidf_(g1) * acc[ai][1][m][1][e]; }
                st8(H1 + (size_t)EPI_ROWS(ai, m) * DEXP + ct, h0, h1); }
    } };
struct EpiMoe2 { static constexpr bool PERM = false; float* X; float* Y1; const float* gate; const int* BK; const float* TW; const LAS int* tab;
    __device__ __forceinline__ void operator()(const f32x4 (&acc)[2][2][4][2], const pg8::Unit& u, int wr, int wc, int fr, int fq) const {
        const int ct = u.pn * 256 + wc * 32 + 4 * fq; const int cnt = tab[40 + u.aux0];
#pragma unroll
        for (int ai = 0; ai < 2; ++ai)
#pragma unroll
            for (int m = 0; m < 4; ++m) { const int pos = u.aux1 + ai * 128 + wr * 64 + m * 16 + fr;
                if (pos < cnt) { const int ent = __builtin_nontemporal_load(BK + (size_t)u.aux0 * T + pos); const int tok = ent >> 1, slot = ent & 1; const float w = __builtin_nontemporal_load(TW + ent);
                    const float* gp = gate + (size_t)sidx_of_row(tok) * NMODV + ct; float* xp = (slot ? Y1 : X) + (size_t)tok * D + ct;
#pragma unroll
                    for (int bj = 0; bj < 2; ++bj)
#pragma unroll
                        for (int n = 0; n < 2; ++n) { const f32x4 g = *(const f32x4*)(gp + bj * 128 + n * 16); f32x4 v = g * w * acc[ai][bj][m][n]; f32x4* p = (f32x4*)(xp + bj * 128 + n * 16);
                            if (!slot) v += *p; *p = v; } } }
    } };
__device__ __forceinline__ int moe_table(Frame& F, int l, LAS int* tab) {
    __syncthreads();
    if (F.tid < 32) { const unsigned c = __hip_atomic_load((unsigned*)(F.ws + WS_CTL) + CW_CNT + (l * 32 + F.tid) * 64, RLX_AGENT); tab[40 + F.tid] = (int)c; }
    __syncthreads();
    if (F.tid == 0) { int s = 0; for (int e = 0; e < 32; ++e) { tab[e] = s; s += (tab[40 + e] + 255) >> 8; } tab[32] = s; }
    __syncthreads();
    return tab[32];
}

__device__ __forceinline__ void conv_phase(Frame& F, int j) {
    const bf16_t* XB = (const bf16_t*)(F.ws + WS_XB); bf16_t* XC = (bf16_t*)(F.ws + WS_XC);
    const float* cw = F.in[I_RGCW] + (size_t)j * 4 * D; const float* cb = F.in[I_RGCB] + (size_t)j * D;
    for (int i = F.bid * 512 + F.tid; i < T * 128; i += F.G * 512) { const int row = i >> 7, c = (i & 127) * 8; const int b = row / SB, s = row - b * SB;
        const int lo = s < CTX ? 0 : CTX, hi = s < CTX ? CTX : SB;
        float a[8];
#pragma unroll
        for (int e = 0; e < 8; ++e) a[e] = cb[c + e];
#pragma unroll
        for (int k = 0; k < 4; ++k) { const int ss = s + k - 2; if (ss >= lo && ss < hi) { const u32x4 xw = *(const u32x4*)(XB + (size_t)(b * SB + ss) * D + c);
                const f32x4 w0 = *(const f32x4*)(cw + k * D + c), w1 = *(const f32x4*)(cw + k * D + c + 4);
                a[0] += w0.x * bflo(xw.x); a[1] += w0.y * bfhi(xw.x); a[2] += w0.z * bflo(xw.y); a[3] += w0.w * bfhi(xw.y);
                a[4] += w1.x * bflo(xw.z); a[5] += w1.y * bfhi(xw.z); a[6] += w1.z * bflo(xw.w); a[7] += w1.w * bfhi(xw.w); } }
        u32x4 o; o.x = pk2(a[0], a[1]); o.y = pk2(a[2], a[3]); o.z = pk2(a[4], a[5]); o.w = pk2(a[6], a[7]);
        *(u32x4*)(XC + (size_t)row * D + c) = o; }
}
__device__ __forceinline__ void scan1_phase(Frame& F) {
    const bf16_t* LA = (const bf16_t*)(F.ws + WS_LA); const bf16_t* BB = (const bf16_t*)(F.ws + WS_BB); f32x2* TOT = (f32x2*)(F.ws + WS_TOT);
    for (int it = F.bid * 8 + F.wave; it < NB * 2 * NCHUNK * 16; it += F.G * 8) {
        const int cg = it & 15, rest = it >> 4, ck = rest % NCHUNK, bd = rest / NCHUNK, dir = bd & 1, b = bd >> 1;
        const int c = cg * 64 + F.lane; const size_t base = (size_t)dir * T * D + (size_t)(b * SB + ck * 64) * D + c;
        float sl = 0.f, h = 0.f;
#pragma unroll 16
        for (int t = 0; t < 64; ++t) { const int tt = dir ? 63 - t : t; const float la = bf2f(LA[base + (size_t)tt * D]), bb = bf2f(BB[base + (size_t)tt * D]);
            sl += la; h = __expf(la) * h + bb; }
        TOT[(size_t)(bd * NCHUNK + ck) * D + c] = (f32x2){sl, h};
    }
}
__device__ __forceinline__ void scan3_phase(Frame& F) {
    const bf16_t* LA = (const bf16_t*)(F.ws + WS_LA); const bf16_t* BB = (const bf16_t*)(F.ws + WS_BB); const f32x2* TOT = (const f32x2*)(F.ws + WS_TOT);
    const bf16_t* GG = (const bf16_t*)(F.ws + WS_GG); bf16_t* SA = (bf16_t*)(F.ws + WS_SA);
    LAS float* hb = (LAS float*)(F.lds + F.wave * 16384);
    for (int it = F.bid * 8 + F.wave; it < NB * NCHUNK * 16; it += F.G * 8) {
        const int cg = it & 15, rest = it >> 4, ck = rest % NCHUNK, b = rest / NCHUNK;
        const int c = cg * 64 + F.lane;
        const f32x2* tf = TOT + (size_t)((b * 2 + 0) * NCHUNK) * D + c; const f32x2* tb = TOT + (size_t)((b * 2 + 1) * NCHUNK) * D + c;
        float hf = 0.f, hbk = 0.f;
        for (int jj = 0; jj < ck; ++jj) { const f32x2 v = tf[(size_t)jj * D]; hf = __expf(v.x) * hf + v.y; }
        if (ck < 4) { for (int jj = 3; jj > ck; --jj) { const f32x2 v = tb[(size_t)jj * D]; hbk = __expf(v.x) * hbk + v.y; } }
        else { for (int jj = 3; jj >= 0; --jj) { const f32x2 v = tb[(size_t)jj * D]; hbk = __expf(v.x) * hbk + v.y; }
               for (int jj = NCHUNK - 1; jj > ck; --jj) { const f32x2 v = tb[(size_t)jj * D]; hbk = __expf(v.x) * hbk + v.y; } }
        const size_t rbase = (size_t)(b * SB + ck * 64) * D + c;
        const size_t b1 = (size_t)T * D + rbase;
#pragma unroll 16
        for (int t = 63; t >= 0; --t) { const float la = bf2f(LA[b1 + (size_t)t * D]), bb = bf2f(BB[b1 + (size_t)t * D]); hbk = __expf(la) * hbk + bb; hb[t * 64 + F.lane] = hbk; }
#pragma unroll 16
        for (int t = 0; t < 64; ++t) { const float la = bf2f(LA[rbase + (size_t)t * D]), bb = bf2f(BB[rbase + (size_t)t * D]); hf = __expf(la) * hf + bb;
            const float y = bf2f(GG[rbase + (size_t)t * D]) * (hf + hb[t * 64 + F.lane]); SA[rbase + (size_t)t * D] = (bf16_t)f2bf(y); }
    }
}

__device__ __forceinline__ void qknorm_phase(Frame& F) {
    bf16_t* QKV = (bf16_t*)(F.ws + WS_QKV); const f32x2* ROPE = (const f32x2*)(F.ws + WS_ROPE);
    const int i16 = F.lane & 15, grp = F.lane >> 4;
    for (int it = (F.bid * 8 + F.wave) * 4 + grp; it < T * 10; it += F.G * 32) {
        const int row = it / 10, hh = it - row * 10; const int b = row / SB, s = row - b * SB;
        bf16_t* p = QKV + (size_t)row * 1536 + hh * 128 + i16 * 8;
        const u32x4 xw = *(const u32x4*)p;
        float x[8] = {bflo(xw.x), bfhi(xw.x), bflo(xw.y), bfhi(xw.y), bflo(xw.z), bfhi(xw.z), bflo(xw.w), bfhi(xw.w)};
        float ss = 0.f;
#pragma unroll
        for (int e = 0; e < 8; ++e) ss += x[e] * x[e];
        ss = wave16_sum(ss);
        const float rstd = rsqrtf(ss * (1.f / 128.f) + NORM_EPS);
        const float* g = (hh < 8 ? F.in[I_ATQG] : F.in[I_ATKG]) + i16 * 8;
#pragma unroll
        for (int e = 0; e < 8; ++e) x[e] = x[e] * rstd * g[e];
        float y[8];
#pragma unroll
        for (int e = 0; e < 8; ++e) y[e] = __shfl_xor(x[e], 4);
        if (s >= CTX) { const int t = s - CTX; const int pos = (i16 >> 3) ? (t & 63) : (t >> 6); const bool half1 = (i16 >> 2) & 1;
#pragma unroll
            for (int e = 0; e < 8; ++e) { const f32x2 cs = ROPE[pos * 32 + (i16 & 3) * 8 + e];
                x[e] = half1 ? (x[e] * cs.x + y[e] * cs.y) : (x[e] * cs.x - y[e] * cs.y); } }
        u32x4 o; o.x = pk2(x[0], x[1]); o.y = pk2(x[2], x[3]); o.z = pk2(x[4], x[5]); o.w = pk2(x[6], x[7]);
        *(u32x4*)p = o;
    }
}
__device__ __forceinline__ void attn_phase(Frame& F) {
    const bf16_t* QKV = (const bf16_t*)(F.ws + WS_QKV); bf16_t* AO = (bf16_t*)(F.ws + WS_AO);
    for (int u = F.bid; u < 544; u += F.G) {
        int b, h, q0, k0, seq;
        if (u < 512) { const int qb = u & 15, hg = (u >> 4) & 3, kvh = (u >> 6) & 1; b = u >> 7; h = kvh * 4 + hg; q0 = b * SB + CTX + qb * 256; k0 = b * SB; seq = SB; }
        else { const int v = u - 512; b = v >> 3; h = v & 7; q0 = b * SB; k0 = b * SB; seq = CTX; }
        const int kvh = h >> 2;
        const bf16_t* Kp = (const bf16_t*)pg8::uptr((const char*)(QKV + (size_t)k0 * 1536 + 1024 + kvh * 128));
        att::attn_dense_body((const bf16_t*)pg8::uptr((const char*)(QKV + (size_t)q0 * 1536 + h * 128)), Kp, Kp + 256, (bf16_t*)pg8::uptr((const char*)(AO + (size_t)q0 * D + h * 128)), seq, F.ldsg, F.tid);
        __syncthreads();
    }
}

__device__ __forceinline__ void spatial_phase(Frame& F) {
    const bf16_t* UVB = (const bf16_t*)(F.ws + WS_UVB); bf16_t* UV = (bf16_t*)(F.ws + WS_UV); const f32x2* statp = (const f32x2*)(F.ws + WS_STATP);
    const bf16_t* Ws = (const bf16_t*)(F.ws + WS_W_CMS); const float* lng = F.in[I_CMLNG]; const float* lnb = F.in[I_CMLNB]; const float* bs = F.in[I_CMBS];
    LAS uchar* vl = F.lds;
    LAS f32x2* st = (LAS f32x2*)(F.lds + 65536);
    const int tid = F.tid, lane = F.lane, wid = F.wave, r32 = lane & 31, hi = lane >> 5, wm = wid & 3, wn = wid >> 2;
    const int sr = tid >> 4, sc = (tid & 15) * 8;
    for (int u = F.bid; u < 136 * 8; u += F.G) {
        const int chunk = u >> 3, g = u & 7; const int row0 = chunk * 128;
        __syncthreads();
        if (tid < 128) { const f32x2* sp = statp + (size_t)(row0 + tid) * 32; float s = 0.f, q = 0.f;
#pragma unroll 8
            for (int k = 0; k < 32; ++k) { const f32x2 v = sp[k]; s += v.x; q += v.y; }
            const float mean = s * (1.f / 2048.f); const float var = fmaxf(q * (1.f / 2048.f) - mean * mean, 0.f); st[tid] = (f32x2){mean, rsqrtf(var + NORM_EPS)}; }
        __syncthreads();
#pragma unroll
        for (int ch = 0; ch < 2; ++ch) { const int cg = g * 256 + ch * 128 + sc;
            const f32x4 g0 = *(const f32x4*)(lng + cg), g1 = *(const f32x4*)(lng + cg + 4), b0 = *(const f32x4*)(lnb + cg), b1 = *(const f32x4*)(lnb + cg + 4);
#pragma unroll
            for (int i = 0; i < 4; ++i) { const int q = sr + 32 * i; const u32x4 xw = *(const u32x4*)(UVB + (size_t)(row0 + q) * 4096 + 2048 + cg); const f32x2 ms = st[q];
                f32x4 v0 = {bflo(xw.x), bfhi(xw.x), bflo(xw.y), bfhi(xw.y)}, v1 = {bflo(xw.z), bfhi(xw.z), bflo(xw.w), bfhi(xw.w)};
                v0 = (v0 - ms.x) * ms.y * g0 + b0; v1 = (v1 - ms.x) * ms.y * g1 + b1;
                u32x4 o; o.x = pk2(v0.x, v0.y); o.y = pk2(v0.z, v0.w); o.z = pk2(v1.x, v1.y); o.w = pk2(v1.z, v1.w);
                *(LAS u32x4*)(vl + ((q >> 6) * 2 + ch) * 16384 + att::v_st(q & 63, sc)) = o; } }
        bf16x8 pa[2][4];
#pragma unroll
        for (int kt = 0; kt < 2; ++kt)
#pragma unroll
            for (int ks = 0; ks < 4; ++ks) pa[kt][ks] = *(const bf16x8*)(Ws + ((size_t)g * 128 + 32 * wm + r32) * 128 + 64 * kt + 16 * ks + 8 * hi);
        __syncthreads();
        f32x16 o[4] = {};
        const int vb = (int)(uintptr_t)(F.ldsg) + att::v_rd_base(lane) + wn * 16384;
        att::pv_d0(o, vb, pa[0][0], pa[0][1], pa[0][2], pa[0][3]);
        att::pv_d0(o, vb + 32768, pa[1][0], pa[1][1], pa[1][2], pa[1][3]);
#pragma unroll
        for (int r = 0; r < 16; ++r) { const int p = 32 * wm + att::crow(r, hi); const float bsv = bs[g * 128 + p]; const size_t rowoff = (size_t)(row0 + p);
#pragma unroll
            for (int d0 = 0; d0 < 4; ++d0) { const int c = g * 256 + 128 * wn + 32 * d0 + r32; const float uu = bf2f(UVB[rowoff * 4096 + c]);
                UV[rowoff * 2048 + c] = (bf16_t)f2bf((o[d0][r] + bsv) * uu); } }
    }
    __syncthreads();
}

__device__ __forceinline__ void final_phase(Frame& F) {
    const f32x4* X = (const f32x4*)(F.ws + WS_X); const f32x4* Y1 = (const f32x4*)(F.ws + WS_Y1); f32x4* out = (f32x4*)F.out;
    for (int i = F.bid * 512 + F.tid; i < NB * SEQ * 256; i += F.G * 512) { const int r = i >> 8, c4 = i & 255, b = r >> 12, t = r & 4095; const size_t src = ((size_t)(b * SB + CTX + t) << 8) + c4;
        out[i] = X[src] + Y1[src]; }
}

constexpr int NPHASE = 37;
__global__ void __launch_bounds__(512, 2) mk_fwd(Args args) {
    extern __shared__ __attribute__((aligned(16))) uchar lds[];
    Frame F; F.lds = (LAS uchar*)lds; F.ldsg = (char*)lds; F.tid = threadIdx.x; F.lane = F.tid & 63; F.wave = __builtin_amdgcn_readfirstlane(F.tid >> 6); F.G = gridDim.x; F.bid = blockIdx.x;
    F.ws = args.ws; F.in = args.in; F.out = args.out;
    uchar* ws0 = args.ws;
    volatile LAS unsigned* MISC = (volatile LAS unsigned*)(F.lds + LDSCTL_OFF);
    LAS int* tab = (LAS int*)(F.lds + LDSCTL_OFF + 256);
    for (int u = F.tid; u < (LDS_BYTES - LDSCTL_OFF) / 4; u += 512) ((LAS unsigned*)(F.lds + LDSCTL_OFF))[u] = 0u;
    __syncthreads();
    const int lo = args.ph_lo, hi = args.ph_hi;
    if (hi - lo > 1) (void)xcd_barrier_post((unsigned*)(ws0 + WS_CTL) + CW_BAR, MISC + 8);
    int ph = 0;
#define PH_BEGIN if (ph >= opaque_uniform_int(args.ph_lo) && ph < opaque_uniform_int(args.ph_hi)) { int t_ = threadIdx.x; F.G = opaque_uniform_int(gridDim.x); F.bid = opaque_uniform_int(blockIdx.x); const int cid = F.bid; (void)cid; \
        F.out = (float*)opaque_uniform_ptr(args.out); F.lds = (LAS uchar*)lds; F.ldsg = (char*)lds; \
        asm volatile("" : "+v"(t_)); F.tid = t_; F.lane = t_ & 63; F.wave = __builtin_amdgcn_readfirstlane(t_ >> 6); \
        uchar* ws = (uchar*)opaque_uniform_ptr(args.ws); F.ws = ws; \
        const float* MODl = (const float*)(ws + WS_MOD) + (size_t)l_ * 5 * NMODV; (void)MODl;
#define PH_END   if (ph + 1 < opaque_uniform_int(args.ph_hi)) { XcdBarrier bb_; bb_.bar = (unsigned*)(ws + WS_CTL) + CW_BAR; bb_.x = 0; bb_.st = (volatile LAS unsigned*)(F.lds + LDSCTL_OFF) + 8; xcd_barrier(bb_); } } ++ph;

    { const int l_ = 0; PH_BEGIN PM(0) p0_prologue(F); PH_END }

#pragma unroll 1
    for (int l = 0; l < DEPTH; ++l) {
        const int kind = l % 3, j = l / 3; const bool lastl = (l == DEPTH - 1); const int l_ = l;
        PH_BEGIN PM(1) norm_phase<false>(F, l, F.in[I_NMG] + l * D, 0, l > 0, false); PH_END
        if (kind == 0) {
            PH_BEGIN PM(2) { pg8::DenseOrder S; S.init(ws + WS_H, D, ws + WS_W_RGIN + (size_t)j * 2048 * 1024 * 2, D, T, 2048, F.G, cid);
                EpiRgIn E{(bf16_t*)(ws + WS_GG), (bf16_t*)(ws + WS_XB)}; pg8::gemm_phase(F.lds, S, E, D, D, D); } PH_END
            PH_BEGIN PM(3) conv_phase(F, j); PH_END
            PH_BEGIN PM(4) { pg8::DenseOrder S; S.init(ws + WS_XC, D, ws + WS_W_RGG + (size_t)j * 16 * 256 * 128 * 2, 128, T, 16 * 256, F.G, cid, 7, 256);
                EpiRgGate E{(const bf16_t*)(ws + WS_XC), (bf16_t*)(ws + WS_LA), (bf16_t*)(ws + WS_BB), F.in[I_RGBA] + (size_t)j * 2 * D, F.in[I_RGBI] + (size_t)j * 2 * D, (const float*)(ws + WS_SPL) + (size_t)j * 2 * D};
                pg8::gemm_phase(F.lds, S, E, 128, D, 128); } PH_END
            PH_BEGIN PM(5) scan1_phase(F); PH_END
            PH_BEGIN PM(6) scan3_phase(F); PH_END
            PH_BEGIN PM(7) { pg8::DenseOrder S; S.init(ws + WS_SA, D, ws + WS_W_RGOUT + (size_t)j * 1024 * 1024 * 2, D, T, D, F.G, cid);
                EpiResid E{(float*)(ws + WS_X), MODl + 2 * D}; pg8::gemm_phase(F.lds, S, E, D, D, D); } PH_END
        } else if (kind == 1) {
            PH_BEGIN PM(8) { pg8::DenseOrder S; S.init(ws + WS_H, D, ws + WS_W_QKV, D, T, 1536, F.G, cid);
                EpiBf16 E{(bf16_t*)(ws + WS_QKV), 1536}; pg8::gemm_phase(F.lds, S, E, D, D, D); } PH_END
            PH_BEGIN PM(9) qknorm_phase(F); PH_END
            PH_BEGIN PM(10) attn_phase(F); PH_END
            PH_BEGIN PM(11) { pg8::DenseOrder S; S.init(ws + WS_AO, D, ws + WS_W_AO, D, T, D, F.G, cid);
                EpiResid E{(float*)(ws + WS_X), MODl + 2 * D}; pg8::gemm_phase(F.lds, S, E, D, D, D); } PH_END
        } else {
            PH_BEGIN PM(12) { pg8::DenseOrder S; S.init(ws + WS_H, D, ws + WS_W_CMIN, D, T, 4096, F.G, cid);
                EpiCmIn E{(bf16_t*)(ws + WS_UVB), (f32x2*)(ws + WS_STATP)}; pg8::gemm_phase(F.lds, S, E, D, D, D); } PH_END
            PH_BEGIN PM(13) spatial_phase(F); PH_END
            PH_BEGIN PM(14) { pg8::DenseOrder S; S.init(ws + WS_UV, 2048, ws + WS_W_CMOUT, 2048, T, D, F.G, cid);
                EpiResid E{(float*)(ws + WS_X), MODl + 2 * D}; pg8::gemm_phase(F.lds, S, E, 2048, 2048, 2048); } PH_END
        }
        PH_BEGIN PM(15) norm_phase<true>(F, l, F.in[I_NFG] + l * D, 3, false, lastl); PH_END
        PH_BEGIN PM(16) { const int ntile = moe_table(F, l, tab);
            MoeOrder<true> S{tab, (const char*)(ws + WS_H), (const char*)(ws + WS_W_E1 + (size_t)l * 32 * 1024 * 1024 * 2), (const int*)(ws + WS_BK), F.G, cid, ntile * 4, (size_t)1024 * 1024 * 2};
            EpiMoe1 E{(bf16_t*)(ws + WS_H1)}; pg8::gemm_phase(F.lds, S, E, D, D, D); } PH_END
        PH_BEGIN PM(17) { const int ntile = moe_table(F, l, tab);
            MoeOrder<false> S{tab, (const char*)(ws + WS_H1), (const char*)(ws + WS_W_E2 + (size_t)l * 32 * 1024 * 512 * 2), (const int*)(ws + WS_BK), F.G, cid, ntile * 4, (size_t)1024 * 512 * 2};
            EpiMoe2 E{(float*)(ws + WS_X), (float*)(ws + WS_Y1), MODl + 5 * D, (const int*)(ws + WS_BK), (const float*)(ws + WS_TW), tab}; pg8::gemm_phase(F.lds, S, E, DEXP, DEXP, DEXP); } PH_END
    }
    { const int l_ = 0; PH_BEGIN PM(18) final_phase(F); PH_END }
#undef PH_BEGIN
#undef PH_END
}

extern "C" void kernel_launch(void* const* d_in, const int* in_sizes, int n_in, void* d_out, int out_size, void* d_ws, size_t ws_size, hipStream_t stream) {
    static int grid = 0;
    if (grid == 0) {
        if (n_in != 34 || out_size != NB * SEQ * D || ws_size < WS_END) { fprintf(stderr, "kernel_launch: bad shapes n_in %d out %d ws %zu (need %zu)\n", n_in, out_size, ws_size, (size_t)WS_END); grid = -1; return; }
        int dev = 0, cus = 0, per_cu = 0;
        if (hipGetDevice(&dev) != hipSuccess || hipDeviceGetAttribute(&cus, hipDeviceAttributeMultiprocessorCount, dev) != hipSuccess) { grid = -1; return; }
        if (hipFuncSetAttribute((const void*)mk_fwd, hipFuncAttributeMaxDynamicSharedMemorySize, LDS_BYTES) != hipSuccess) { fprintf(stderr, "kernel_launch: hipFuncSetAttribute failed\n"); grid = -1; return; }
        if (hipOccupancyMaxActiveBlocksPerMultiprocessor(&per_cu, (const void*)mk_fwd, 512, LDS_BYTES) != hipSuccess || per_cu < 1) { fprintf(stderr, "kernel_launch: occupancy query says %d\n", per_cu); (void)hipGetLastError(); grid = -1; return; }
        grid = cus;
    }
    if (grid < 0) return;
    (void)hipMemsetAsync((char*)d_ws + WS_CTL, 0, CTL_BYTES, stream);
    Args a{};
    for (int i = 0; i < 34; ++i) a.in[i] = (const float*)d_in[i];
    a.out = (float*)d_out; a.ws = (uchar*)d_ws;
#if MK_PER_PHASE
    for (int p = 0; p < NPHASE; ++p) { a.ph_lo = p; a.ph_hi = p + 1; hipLaunchKernelGGL(mk_fwd, dim3(grid), dim3(512), LDS_BYTES, stream, a); }
#else
    a.ph_lo = 0; a.ph_hi = NPHASE;
    void* kargs[] = {&a};
    hipError_t e = hipLaunchCooperativeKernel((const void*)mk_fwd, dim3(grid), dim3(512), kargs, LDS_BYTES, stream);
    if (e != hipSuccess) fprintf(stderr, "kernel_launch: cooperative launch failed: %s (grid %d)\n", hipGetErrorString(e), grid);
#endif
}
```

```cpp
#include <hip/hip_runtime.h>
#include <hip/hip_bf16.h>
#include <cstdio>
#include <cstdint>

#ifndef MK_PER_PHASE
#define MK_PER_PHASE 0
#endif

#ifndef PHASE_MASK
#define PHASE_MASK 0xFFFFFFFFu
#endif
#ifndef REP_MASK
#define REP_MASK 0u
#endif
#define REPN(i) ((((REP_MASK) >> (i)) & 1u) ? 2 : 1)
#define PM(i) if constexpr ((PHASE_MASK >> (i)) & 1u) for (int rep_ = REPN(i); rep_ > 0; --rep_)
#define LAS __attribute__((address_space(3)))
#define GAS __attribute__((address_space(1)))
typedef unsigned char uchar;
typedef unsigned short bf16_t;
typedef short bf16x8 __attribute__((ext_vector_type(8)));
typedef short s16x4 __attribute__((ext_vector_type(4)));
typedef float f32x4 __attribute__((ext_vector_type(4)));
typedef float f32x2 __attribute__((ext_vector_type(2)));
typedef float f32x16 __attribute__((ext_vector_type(16)));
typedef unsigned u32x4 __attribute__((ext_vector_type(4)));
typedef unsigned u32x2 __attribute__((ext_vector_type(2)));
typedef GAS unsigned gu32;
#define RLX_AGENT __ATOMIC_RELAXED, __HIP_MEMORY_SCOPE_AGENT

constexpr int D = 1024, NB = 4, SEQ = 4096, CTX = 256, SB = SEQ + CTX, T = NB * SB, DEPTH = 4;
constexpr int NMODV = 6 * D;
constexpr int NEXP = 32, DEXP = 512;
constexpr int NCHUNK = SB / 64;
constexpr float NORM_EPS = 1e-6f;

constexpr size_t MiB = 1u << 20;
constexpr size_t WS_CTL = 0, CTL_BYTES = 1 * MiB;
constexpr size_t WS_MOD = 1 * MiB;
constexpr size_t WS_ROPE = 2 * MiB;
constexpr size_t WS_SPL = 2 * MiB + 65536;
constexpr size_t WS_TOT = 3 * MiB;
constexpr size_t WS_STATP = 8 * MiB;
constexpr size_t WS_BK = 13 * MiB;
constexpr size_t WS_TW = 15 * MiB + 512 * 1024;
constexpr size_t WS_W_RGIN = 16 * MiB, WS_W_RGG = 24 * MiB, WS_W_RGOUT = 26 * MiB, WS_W_QKV = 30 * MiB, WS_W_AO = 33 * MiB;
constexpr size_t WS_W_CMIN = 35 * MiB, WS_W_CMS = 43 * MiB, WS_W_CMOUT = 44 * MiB, WS_W_E1 = 48 * MiB, WS_W_E2 = 304 * MiB;
constexpr size_t WS_X = 432 * MiB, WS_Y1 = 500 * MiB, WS_H = 568 * MiB, WS_SCR = 602 * MiB;
constexpr size_t WS_GG = WS_SCR, WS_XB = WS_SCR + 34 * MiB, WS_XC = WS_SCR + 68 * MiB, WS_LA = WS_SCR + 102 * MiB, WS_BB = WS_SCR + 170 * MiB, WS_SA = WS_SCR + 238 * MiB;
constexpr size_t WS_QKV = WS_SCR, WS_AO = WS_SCR + 51 * MiB;
constexpr size_t WS_UVB = WS_SCR, WS_UV = WS_SCR + 136 * MiB;
constexpr size_t WS_H1 = WS_SCR;
constexpr size_t WS_END = WS_SCR + 272 * MiB;
constexpr int CW_TMO = 0, CW_BAR = 4096, CW_CNT = 16384;

constexpr int RING_BYTES = 131072;
constexpr int ROUTER_LDS = 36 * 1024 * 4;
constexpr int LDSCTL_OFF = 147456;
constexpr int LDS_BYTES = LDSCTL_OFF + 1024 + 8 * 4 * 40 * 4;

__device__ __forceinline__ unsigned f2bf(float f) { unsigned u = __builtin_bit_cast(unsigned, f); return (u + 0x7fffu + ((u >> 16) & 1u)) >> 16; }
__device__ __forceinline__ unsigned pk2(float lo, float hi) { return f2bf(lo) | (f2bf(hi) << 16); }
__device__ __forceinline__ float bf2f(unsigned short h) { return __builtin_bit_cast(float, (unsigned)h << 16); }
__device__ __forceinline__ float bflo(unsigned w) { return __builtin_bit_cast(float, w << 16); }
__device__ __forceinline__ float bfhi(unsigned w) { return __builtin_bit_cast(float, w & 0xffff0000u); }
__device__ __forceinline__ unsigned cvt_pk_bf16(float lo, float hi) { unsigned r; asm volatile("v_cvt_pk_bf16_f32 %0, %1, %2" : "=v"(r) : "v"(lo), "v"(hi)); return r; }
__device__ __forceinline__ float gelu_tanh(float x) { const float u = 0.7978845608028654f * (x + 0.044715f * x * x * x); const float e = __expf(2.f * u); const float t = 1.f - 2.f / (e + 1.f); return 0.5f * x * (1.f + t); }
__device__ __forceinline__ float sigmoidf_(float x) { return 1.f / (1.f + __expf(-x)); }
__device__ __forceinline__ float fast_sigmoid(float x) { return __builtin_amdgcn_rcpf(1.f + __expf(-x)); }
__device__ __forceinline__ float one_minus_exp(float y) {   const float p = y * (1.f - y * (0.5f - y * (0.16666667f - y * 0.041666667f))); const float q = 1.f - __expf(-y); return y < 0.0625f ? p : q; }
__device__ __forceinline__ int sidx_of_row(int row) { const int b = row / SB; return (row - b * SB) < CTX ? 4 : b; }

namespace pg8 {
constexpr int BM = 256, BK = 64, HALF = 128, HTB = HALF * BK * 2, NXCD = 8, WGM = 8;
__device__ __forceinline__ int lds_byte(int r, int c) { const int st = (r >> 4) * 2 + (c >> 5), rr = r & 15, cc = c & 31, ob = rr * 64 + cc * 2; return st * 1024 + (ob ^ (((ob >> 9) & 1) << 5)); }
__device__ __forceinline__ void stage_rc(int b, int& R, int& C) { const int st = b / 1024, sb = b % 1024, swz = sb ^ (((sb >> 9) & 1) << 5); R = (st >> 1) * 16 + swz / 64; C = (st & 1) * 32 + (swz % 64) / 2; }
__device__ __forceinline__ int perm32(int rho) { const int n = rho >> 4, i = rho & 15; return 8 * (i >> 2) + 4 * n + (i & 3); }
struct Unit { const char* a; const char* b; int pm, pn, aux0, aux1; };
__device__ __forceinline__ const char* uptr(const char* p) { const unsigned long long v = (unsigned long long)p; const unsigned lo = __builtin_amdgcn_readfirstlane((unsigned)v), hi = __builtin_amdgcn_readfirstlane((unsigned)(v >> 32)); return (const char*)(const GAS char*)(((unsigned long long)hi << 32) | lo); }
__device__ __forceinline__ int xcd_remap(int L, int nwg) { const int q = nwg / NXCD, r = nwg % NXCD, xcd = L % NXCD, off = L / NXCD; return (xcd < r ? xcd * (q + 1) : r * (q + 1) + (xcd - r) * q) + off; }

struct DenseOrder {
    static constexpr bool GATHER = false;
    const char* A; const char* B; int nM, nN, nwg, G, c; size_t tA, tB; int amask, acol;
    __device__ void init(const void* A_, int lda, const void* B_, int ldb, int M, int N, int G_, int c_, int amask_ = 0, int acol_ = 0) {
        A = (const char*)A_; B = (const char*)B_; nM = M / BM; nN = N / BM; nwg = nM * nN; G = G_; c = c_; tA = (size_t)BM * lda * 2; tB = (size_t)BM * ldb * 2; amask = amask_; acol = acol_; }
    __device__ bool next(int i, Unit& u) const {
        const long L = (long)i * G + c; if (L >= nwg) return false;
        const int wgid = xcd_remap((int)L, nwg);
        const int nig = WGM * nN, gid = wgid / nig, fm = gid * WGM, gsz = (nM - fm) < WGM ? (nM - fm) : WGM;
        u.pm = __builtin_amdgcn_readfirstlane(fm + ((wgid % nig) % gsz)); u.pn = __builtin_amdgcn_readfirstlane((wgid % nig) / gsz); u.aux0 = 0; u.aux1 = 0;
        u.a = uptr(A + (size_t)u.pm * tA + (size_t)(u.pn & amask) * acol); u.b = uptr(B + (size_t)u.pn * tB); return true; }
    __device__ unsigned goff(const Unit&, int) const { return 0u; }
};

#define PG8_SA(b, h) (((b) * 2 + (h)) * HTB)
#define PG8_SB(b, h) ((4 + (b) * 2 + (h)) * HTB)
__device__ __forceinline__ void glds16(const char* sbase, unsigned voff, unsigned ldsaddr) { unsigned keep;
    asm volatile("s_mov_b32 %0, m0\n\ts_mov_b32 m0, %3\n\ts_nop 0\n\tglobal_load_lds_dwordx4 %1, %2\n\ts_mov_b32 m0, %0" : "=&s"(keep) : "v"(voff), "s"(sbase), "s"(ldsaddr) : "memory"); }
#ifndef PG8_ASM_DMA
#define PG8_ASM_DMA 0
#endif
#if PG8_ASM_DMA
#define PG8_GLDS(gp, voff, ldsoff) glds16((const char*)(gp), (voff), ldsbase + (unsigned)(ldsoff))
#else
#define PG8_GLDS(gp, voff, ldsoff) __builtin_amdgcn_global_load_lds((const unsigned*)((const char*)(gp) + (voff)), (LAS unsigned*)(lds + (ldsoff)), 16, 0, 0)
#endif
#define PG8_STAGE_B(bufoff, gbase) do { PG8_GLDS(gbase, voffB[0], (bufoff) + ldsw); PG8_GLDS(gbase, voffB[1], (bufoff) + ldsw + 8192); } while (0)
#define PG8_STAGE_A(bufoff, gbase, h, NX) do { if constexpr (Sched::GATHER) { \
        PG8_GLDS(gbase, ((NX) ? vAn[h][0] : vAc[h][0]), (bufoff) + ldsw); PG8_GLDS(gbase, ((NX) ? vAn[h][1] : vAc[h][1]), (bufoff) + ldsw + 8192); \
    } else { PG8_GLDS((const char*)(gbase) + (h) * hstepA, voffA[0], (bufoff) + ldsw); PG8_GLDS((const char*)(gbase) + (h) * hstepA, voffA[1], (bufoff) + ldsw + 8192); } } while (0)
#define PG8_LDA(dst, b, h) do { _Pragma("unroll") for (int m = 0; m < 4; ++m) _Pragma("unroll") for (int k = 0; k < 2; ++k) dst[m][k] = *(const LAS bf16x8*)(lds + PG8_SA(b, h) + aoff + m * 2048 + k * 1024); } while (0)
#define PG8_LDB(dst, b, h) do { _Pragma("unroll") for (int n = 0; n < 2; ++n) _Pragma("unroll") for (int k = 0; k < 2; ++k) dst[n][k] = *(const LAS bf16x8*)(lds + PG8_SB(b, h) + boff + n * 2048 + k * 1024); } while (0)
#define PG8_MMA(ai, bj, At, Bt) do { __builtin_amdgcn_s_setprio(1); _Pragma("unroll") for (int m = 0; m < 4; ++m) _Pragma("unroll") for (int n = 0; n < 2; ++n) _Pragma("unroll") for (int k = 0; k < 2; ++k) \
        acc[ai][bj][m][n] = __builtin_amdgcn_mfma_f32_16x16x32_bf16(Bt[n][k], At[m][k], acc[ai][bj][m][n], 0, 0, 0); __builtin_amdgcn_s_setprio(0); } while (0)
#define PG8_WAIT_V(n) asm volatile("s_waitcnt vmcnt(" #n ")" ::: "memory")
#define PG8_WAIT_L(n) asm volatile("s_waitcnt lgkmcnt(" #n ")" ::: "memory")
#define PG8_BAR __builtin_amdgcn_s_barrier()
#define PG8_SCHED __builtin_amdgcn_sched_barrier(0)

template <class Epi, class Sched>
__device__ __forceinline__ void gemm_phase(LAS uchar* lds, const Sched& S, const Epi& E, const int K, const int lda, const int ldb) {
    int tid = threadIdx.x; asm volatile("" : "+v"(tid));
    const int wid = __builtin_amdgcn_readfirstlane(tid >> 6), lane = tid & 63, wr = wid >> 2, wc = wid & 3; int fr = lane & 15, fq = lane >> 4;
    int nt = K / BK; asm volatile("" : "+s"(nt));
    unsigned voffA[2], voffB[2]; int Rs[2], Cs[2];
#pragma unroll
    for (int i = 0; i < 2; ++i) { int R, C; stage_rc(tid * 16 + i * 8192, R, C); const int Rb = Epi::PERM ? ((R & ~31) + perm32(R & 31)) : R;
        Rs[i] = R; Cs[i] = C; voffA[i] = (unsigned)(R * lda + C) * 2u; voffB[i] = (unsigned)(Rb * ldb + C) * 2u; }
    const size_t kstep = (size_t)(BK * 2);
    const size_t hstepA = (size_t)HALF * lda * 2, hstepB = (size_t)HALF * ldb * 2;
    const unsigned ldsw = (unsigned)wid * 1024u;
    const unsigned ldsbase = (unsigned)(uintptr_t)lds;
    const int aoff = lds_byte(wr * 64 + fr, fq * 8), boff = lds_byte(wc * 32 + fr, fq * 8);
    Unit cur, nxt; int ui = 0;
    if (!S.next(0, cur)) return;
    unsigned vAc[2][2], vAn[2][2];
#pragma unroll
    for (int h = 0; h < 2; ++h)
#pragma unroll
        for (int i = 0; i < 2; ++i) { vAc[h][i] = 0u; vAn[h][i] = 0u; }
    if constexpr (Sched::GATHER) {
#pragma unroll
        for (int h = 0; h < 2; ++h)
#pragma unroll
            for (int i = 0; i < 2; ++i) vAc[h][i] = S.goff(cur, h * HALF + Rs[i]) + (unsigned)Cs[i] * 2u;
    }
    f32x4 acc[2][2][4][2];
#pragma unroll
    for (int a = 0; a < 2; ++a)
#pragma unroll
        for (int b = 0; b < 2; ++b)
#pragma unroll
            for (int m = 0; m < 4; ++m)
#pragma unroll
                for (int n = 0; n < 2; ++n) acc[a][b][m][n] = (f32x4){0.f, 0.f, 0.f, 0.f};
    bf16x8 At[4][2], B0[2][2], B1[2][2];
    const char* cA = cur.a; const char* cB = cur.b;
    PG8_STAGE_B(PG8_SB(0, 0), cB); PG8_STAGE_B(PG8_SB(0, 1), cB + hstepB); PG8_STAGE_A(PG8_SA(0, 0), cA, 0, false); PG8_STAGE_A(PG8_SA(0, 1), cA, 1, false);
    if (wr == 1) PG8_BAR;
    PG8_WAIT_V(2); PG8_BAR;
    PG8_STAGE_B(PG8_SB(1, 0), cB + kstep); PG8_STAGE_A(PG8_SA(1, 0), cA + kstep, 0, false); PG8_STAGE_B(PG8_SB(1, 1), cB + hstepB + kstep);
    PG8_WAIT_V(6); PG8_BAR;
    for (;;) {
        const bool has_next = S.next(ui + 1, nxt);
        if constexpr (Sched::GATHER) { if (has_next) {
#pragma unroll
            for (int h = 0; h < 2; ++h)
#pragma unroll
                for (int i = 0; i < 2; ++i) vAn[h][i] = S.goff(nxt, h * HALF + Rs[i]) + (unsigned)Cs[i] * 2u; } }
        const char* nA = has_next ? nxt.a : cA; const char* nB = has_next ? nxt.b : cB;
        for (int t = 0; t < nt; t += 2) {
            const bool last = (t == nt - 2);
            const bool nx = last && has_next;
            const char* a1 = cA + (size_t)(t + 1) * kstep;
            const char* a2 = last ? nA : cA + (size_t)(t + 2) * kstep; const char* b2 = last ? nB : cB + (size_t)(t + 2) * kstep;
            const char* a3 = a2 + kstep; const char* b3 = b2 + kstep;
            PG8_LDB(B0, 0, 0); PG8_LDB(B1, 0, 1); PG8_SCHED; PG8_LDA(At, 0, 0); PG8_STAGE_A(PG8_SA(1, 1), a1, 1, false);
            PG8_WAIT_V(8); PG8_WAIT_L(0); PG8_BAR; PG8_MMA(0, 0, At, B0); PG8_MMA(0, 1, At, B1); PG8_BAR; PG8_SCHED;
            PG8_LDA(At, 0, 1); PG8_STAGE_B(PG8_SB(0, 0), b2); PG8_STAGE_B(PG8_SB(0, 1), b2 + hstepB); PG8_STAGE_A(PG8_SA(0, 0), a2, 0, nx);
            PG8_WAIT_V(8); PG8_WAIT_L(0); PG8_BAR; PG8_MMA(1, 0, At, B0); PG8_MMA(1, 1, At, B1); PG8_BAR; PG8_SCHED;
            PG8_LDB(B0, 1, 0); PG8_LDB(B1, 1, 1); PG8_SCHED; PG8_LDA(At, 1, 0); PG8_STAGE_A(PG8_SA(0, 1), a2, 1, nx);
            PG8_WAIT_V(8); PG8_WAIT_L(0); PG8_BAR; PG8_MMA(0, 0, At, B0); PG8_MMA(0, 1, At, B1); PG8_BAR; PG8_SCHED;
            PG8_LDA(At, 1, 1); PG8_STAGE_B(PG8_SB(1, 0), b3); PG8_STAGE_B(PG8_SB(1, 1), b3 + hstepB); PG8_STAGE_A(PG8_SA(1, 0), a3, 0, nx);
            PG8_WAIT_V(8); PG8_WAIT_L(0); PG8_BAR; PG8_MMA(1, 0, At, B0); PG8_MMA(1, 1, At, B1); PG8_BAR; PG8_SCHED;
        }
        if (wr == 0) PG8_BAR;
        E(acc, cur, wr, wc, fr, fq);
        if (!has_next) break;
#pragma unroll
        for (int a = 0; a < 2; ++a)
#pragma unroll
            for (int b = 0; b < 2; ++b)
#pragma unroll
                for (int m = 0; m < 4; ++m)
#pragma unroll
                    for (int n = 0; n < 2; ++n) acc[a][b][m][n] = (f32x4){0.f, 0.f, 0.f, 0.f};
        cur = nxt; cA = nA; cB = nB; ++ui;
        if constexpr (Sched::GATHER) {
#pragma unroll
            for (int h = 0; h < 2; ++h)
#pragma unroll
                for (int i = 0; i < 2; ++i) vAc[h][i] = vAn[h][i]; }
        if (wr == 1) PG8_BAR;
    }
    PG8_WAIT_V(0);
    PG8_BAR;
}
}

#ifndef ATT_SDEPTH
#define ATT_SDEPTH 2
#endif
namespace att {
constexpr int NW = 8, QBLK = 32, KVBLK = 64;
constexpr float SCALE = 0.088388347648318440f;
constexpr float THR = 8.f;
constexpr int LDQ = 1536, LDK = 1536, LDO = 1024;
constexpr size_t SHM_V = KVBLK * 128 * 2, SHM_K = KVBLK * 128 * 2, SHM_ATTN = 2 * SHM_V + 2 * SHM_K + NW * 64 * 4;
#define KSWZ(row, colB) ((row) * 256 + ((colB) ^ (((row) & 7) << 4)))
#define SBAR() __builtin_amdgcn_sched_barrier(0)
__device__ __forceinline__ int crow(int r, int hi) { return (r & 3) + 8 * (r >> 2) + 4 * hi; }
__device__ __forceinline__ void partialSM(f32x16& p0, f32x16& p1, float& m_reg, float& mn, float& alpha) {
  constexpr float C = SCALE * 1.4426950408889634f;
  float pmax = p0[0];
#pragma unroll
  for (int r = 1; r < 16; ++r) pmax = fmaxf(pmax, p0[r]);
#pragma unroll
  for (int r = 0; r < 16; ++r) pmax = fmaxf(pmax, p1[r]);
  { auto rr = __builtin_amdgcn_permlane32_swap(__float_as_uint(pmax), __float_as_uint(pmax), false, false);
    pmax = fmaxf(__uint_as_float(rr[0]), __uint_as_float(rr[1])); }
  if (__builtin_expect(__all(pmax - m_reg <= THR / SCALE), 1)) { mn = m_reg; alpha = 1.f; }
  else { mn = fmaxf(m_reg, pmax); alpha = __builtin_amdgcn_exp2f((m_reg - mn) * C); m_reg = mn; }
  float mnC = -mn * C;
#pragma unroll
  for (int r = 0; r < 16; ++r) p0[r] = fmaf(p0[r], C, mnC);
#pragma unroll
  for (int r = 0; r < 16; ++r) p1[r] = fmaf(p1[r], C, mnC);
#pragma unroll
  for (int r = 0; r < 16; ++r) p0[r] = __builtin_amdgcn_exp2f(p0[r]);
}
__device__ __forceinline__ void finishSM(f32x16& p0, f32x16& p1, float alpha, float& l_reg, bf16x8& pa0, bf16x8& pa1, bf16x8& pa2, bf16x8& pa3) {
#pragma unroll
  for (int r = 0; r < 16; ++r) p1[r] = __builtin_amdgcn_exp2f(p1[r]);
  float ps = 0;
#pragma unroll
  for (int r = 0; r < 16; ++r) ps += p0[r];
#pragma unroll
  for (int r = 0; r < 16; ++r) ps += p1[r];
  { auto rr = __builtin_amdgcn_permlane32_swap(__float_as_uint(ps), __float_as_uint(ps), false, false);
    ps = __uint_as_float(rr[0]) + __uint_as_float(rr[1]); }
  l_reg = l_reg * alpha + ps;
#define PK4(P, BASE, OUT) do { unsigned a0 = cvt_pk_bf16(P[BASE + 0], P[BASE + 1]), a1 = cvt_pk_bf16(P[BASE + 2], P[BASE + 3]);   \
    unsigned b0 = cvt_pk_bf16(P[BASE + 4], P[BASE + 5]), b1 = cvt_pk_bf16(P[BASE + 6], P[BASE + 7]);                              \
    auto r0 = __builtin_amdgcn_permlane32_swap(a0, b0, false, false); auto r1 = __builtin_amdgcn_permlane32_swap(a1, b1, false, false); \
    u32x4 w = {r0[0], r1[0], r0[1], r1[1]}; OUT = __builtin_bit_cast(bf16x8, w); } while (0)
  PK4(p0, 0, pa0); PK4(p0, 8, pa1); PK4(p1, 0, pa2); PK4(p1, 8, pa3);
#undef PK4
}
__device__ __forceinline__ void qkt(f32x16& p0, f32x16& p1, const bf16_t* Ks, const bf16x8* qr, int r32, int hi) {
  p0 = f32x16{}; p1 = f32x16{};
#pragma unroll
  for (int d0 = 0; d0 < 8; ++d0) { int cb = (d0 * 16 + hi * 8) * 2;
    bf16x8 b0 = *reinterpret_cast<const bf16x8*>((const char*)Ks + KSWZ(r32, cb));
    bf16x8 b1 = *reinterpret_cast<const bf16x8*>((const char*)Ks + KSWZ(32 + r32, cb));
    p0 = __builtin_amdgcn_mfma_f32_32x32x16_bf16(b0, qr[d0], p0, 0, 0, 0);
    p1 = __builtin_amdgcn_mfma_f32_32x32x16_bf16(b1, qr[d0], p1, 0, 0, 0); }
}
__device__ __forceinline__ int v_st(int k, int c) { const int kk = (k & ~0xC) | ((k & 4) << 1) | ((k & 8) >> 1); return ((kk >> 3) * 4 + (c >> 5)) * 512 + ((kk & 7) * 32 + (c & 31)) * 2; }
__device__ __forceinline__ int v_rd_base(int lane) { return ((lane & 3) << 3) | (((lane >> 2) & 3) << 6) | (((lane >> 4) & 1) << 5) | (((lane >> 5) & 1) << 8); }
constexpr int v_rd_off(int d0, int ks, int half) { return d0 * 512 + ks * 4096 + half * 2048; }
template <int OFF> __device__ __forceinline__ s16x4 tr_read(int vb) {
  s16x4 r; asm volatile("ds_read_b64_tr_b16 %0, %1 offset:%2" : "=&v"(r) : "v"(vb), "i"(OFF) : "memory"); return r;
}
template <int D0> __device__ __forceinline__ void pv_one(f32x16& od, int vb, bf16x8 pa0, bf16x8 pa1, bf16x8 pa2, bf16x8 pa3) {
  const s16x4 l0 = tr_read<v_rd_off(D0, 0, 0)>(vb), h0 = tr_read<v_rd_off(D0, 0, 1)>(vb), l1 = tr_read<v_rd_off(D0, 1, 0)>(vb), h1 = tr_read<v_rd_off(D0, 1, 1)>(vb);
  const s16x4 l2 = tr_read<v_rd_off(D0, 2, 0)>(vb), h2 = tr_read<v_rd_off(D0, 2, 1)>(vb), l3 = tr_read<v_rd_off(D0, 3, 0)>(vb), h3 = tr_read<v_rd_off(D0, 3, 1)>(vb);
  asm volatile("s_waitcnt lgkmcnt(0)" ::: "memory"); SBAR();
#define PK(L, H) (bf16x8){L[0], L[1], L[2], L[3], H[0], H[1], H[2], H[3]}
  od = __builtin_amdgcn_mfma_f32_32x32x16_bf16(pa0, PK(l0, h0), od, 0, 0, 0);
  od = __builtin_amdgcn_mfma_f32_32x32x16_bf16(pa1, PK(l1, h1), od, 0, 0, 0);
  od = __builtin_amdgcn_mfma_f32_32x32x16_bf16(pa2, PK(l2, h2), od, 0, 0, 0);
  od = __builtin_amdgcn_mfma_f32_32x32x16_bf16(pa3, PK(l3, h3), od, 0, 0, 0);
#undef PK
}
__device__ __forceinline__ void pv_d0(f32x16* o, int vb, bf16x8 pa0, bf16x8 pa1, bf16x8 pa2, bf16x8 pa3) {
  pv_one<0>(o[0], vb, pa0, pa1, pa2, pa3); pv_one<1>(o[1], vb, pa0, pa1, pa2, pa3); pv_one<2>(o[2], vb, pa0, pa1, pa2, pa3); pv_one<3>(o[3], vb, pa0, pa1, pa2, pa3);
}
__device__ __forceinline__ void attn_dense_body(const bf16_t* Qb, const bf16_t* Kh, const bf16_t* Vh, bf16_t* Ob, int seq, char* lds, const int tid) {
  const int wid = tid >> 6, lane = tid & 63, r32 = lane & 31, hi = lane >> 5;
  bf16_t* V_lds = (bf16_t*)lds; bf16_t* K_lds = (bf16_t*)(lds + 2 * SHM_V);
  float* ws = (float*)(lds + 2 * SHM_V + 2 * SHM_K) + wid * 64; float* li_l = ws; float* al_l = ws + 32;
  float m_reg = -1e30f, l_reg = 0; f32x16 o[4] = {}; bf16x8 qr[8];
  const bf16_t* Qw = Qb + (long)(wid * QBLK + r32) * LDQ + hi * 8;
#pragma unroll
  for (int d0 = 0; d0 < 8; ++d0) qr[d0] = *reinterpret_cast<const bf16x8*>(Qw + d0 * 16);
  const int sr = tid >> 4, sc = (tid & 15) * 8, vst0 = v_st(sr, sc), vst1 = v_st(32 + sr, sc);
  const int vb0 = (int)(uintptr_t)V_lds + v_rd_base(lane);
  struct { bf16x8 vs0, vs1, ks0, ks1; } sr_[ATT_SDEPTH];
  const unsigned vo0 = (unsigned)(sr * LDK + sc) * 2u, vo1 = (unsigned)((32 + sr) * LDK + sc) * 2u;
  const long vdelta = (const char*)Vh - (const char*)Kh;
#define SLOAD(i, k0) do { const char* kb_ = (const char*)Kh + (size_t)(k0) * (LDK * 2); const char* vb_ = kb_ + vdelta; \
    sr_[i].vs0 = *reinterpret_cast<const bf16x8*>(vb_ + vo0); sr_[i].vs1 = *reinterpret_cast<const bf16x8*>(vb_ + vo1); \
    sr_[i].ks0 = *reinterpret_cast<const bf16x8*>(kb_ + vo0); sr_[i].ks1 = *reinterpret_cast<const bf16x8*>(kb_ + vo1); } while (0)
#define SWRITE(b, i) do { *(bf16x8*)((char*)V_lds + (b) * SHM_V + vst0) = sr_[i].vs0;          \
    *(bf16x8*)((char*)V_lds + (b) * SHM_V + vst1) = sr_[i].vs1; int kc = sc * 2;               \
    *(bf16x8*)((char*)K_lds + (b) * SHM_K + KSWZ(sr, kc)) = sr_[i].ks0;                       \
    *(bf16x8*)((char*)K_lds + (b) * SHM_K + KSWZ(32 + sr, kc)) = sr_[i].ks1; } while (0)
#define SWAIT() do { if constexpr (ATT_SDEPTH == 2) asm volatile("s_waitcnt vmcnt(4)" ::: "memory"); else asm volatile("s_waitcnt vmcnt(0)" ::: "memory"); } while (0)
#define RESC(a) do { if (__any((a) < 1.f)) { if (hi == 0) al_l[r32] = (a); asm volatile("s_waitcnt lgkmcnt(0)" ::: "memory"); \
    _Pragma("unroll") for (int d = 0; d < 4; ++d) _Pragma("unroll") for (int r = 0; r < 16; ++r) o[d][r] *= al_l[crow(r, hi)]; } } while (0)
  f32x16 pA0, pA1, pB0, pB1; float mnA, mnB, alA, alB; bf16x8 pa0, pa1, pa2, pa3; const int NT = seq / KVBLK;
  constexpr int SE = 0, SO = ATT_SDEPTH - 1;
  SLOAD(SE, 0); asm volatile("s_waitcnt vmcnt(0)" ::: "memory"); SWRITE(0, SE); __syncthreads();
  qkt(pA0, pA1, K_lds, qr, r32, hi); partialSM(pA0, pA1, m_reg, mnA, alA);
  SLOAD(SO, KVBLK); if constexpr (ATT_SDEPTH == 2) { if (2 < NT) SLOAD(SE, 2 * KVBLK); }
  SWAIT(); SWRITE(1, SO); __syncthreads();
  for (int j = 1; j + 1 < NT; j += 2) {
    SBAR(); qkt(pB0, pB1, (bf16_t*)((char*)K_lds + SHM_K), qr, r32, hi);
    finishSM(pA0, pA1, alA, l_reg, pa0, pa1, pa2, pa3); SBAR();
    SLOAD(SO, (j + ATT_SDEPTH) * KVBLK); SBAR();
    pv_d0(o, vb0, pa0, pa1, pa2, pa3); partialSM(pB0, pB1, m_reg, mnB, alB);
    __syncthreads(); SWAIT(); SWRITE(0, SE);
    RESC(alB); __syncthreads();
    SBAR(); qkt(pA0, pA1, K_lds, qr, r32, hi);
    finishSM(pB0, pB1, alB, l_reg, pa0, pa1, pa2, pa3); SBAR();
    if (ATT_SDEPTH == 1 || j + 3 < NT) SLOAD(SE, (j + 1 + ATT_SDEPTH) * KVBLK); SBAR();
    pv_d0(o, vb0 + (int)SHM_V, pa0, pa1, pa2, pa3); partialSM(pA0, pA1, m_reg, mnA, alA);
    __syncthreads(); SWAIT(); SWRITE(1, SO);
    RESC(alA); __syncthreads();
  }
  SBAR(); qkt(pB0, pB1, (bf16_t*)((char*)K_lds + SHM_K), qr, r32, hi);
  finishSM(pA0, pA1, alA, l_reg, pa0, pa1, pa2, pa3); SBAR();
  pv_d0(o, vb0, pa0, pa1, pa2, pa3); partialSM(pB0, pB1, m_reg, mnB, alB);
  __syncthreads(); RESC(alB);
  finishSM(pB0, pB1, alB, l_reg, pa0, pa1, pa2, pa3); SBAR();
  pv_d0(o, vb0 + (int)SHM_V, pa0, pa1, pa2, pa3);
  if (hi == 0) li_l[r32] = l_reg; asm volatile("s_waitcnt lgkmcnt(0)" ::: "memory");
  float rli[16];
#pragma unroll
  for (int r = 0; r < 16; ++r) rli[r] = __builtin_amdgcn_rcpf(li_l[crow(r, hi)]);
  bf16_t* Ow = Ob + (long)(wid * QBLK) * LDO;
#pragma unroll
  for (int r = 0; r < 16; ++r) { int orow = crow(r, hi);
#pragma unroll
    for (int d0 = 0; d0 < 4; ++d0) Ow[(long)orow * LDO + d0 * 32 + r32] = (bf16_t)f2bf(o[d0][r] * rli[r]); }
#undef SLOAD
#undef SWRITE
#undef SWAIT
#undef RESC
}
}

#define XB_TMO      128
#define XB_XCNT(j)  (256  + 64 * (j))
#define XB_XSUB(j)  (1280 + 64 * (j))
#define XB_XGEN(j)  (2304 + 64 * (j))
#define XB_TOP      3328
#define XB_TOPGEN   3392
#define XB_SPIN_CAP (1u << 22)
__device__ __forceinline__ unsigned xb_ld(unsigned* p)              { return __hip_atomic_load(p, __ATOMIC_RELAXED, __HIP_MEMORY_SCOPE_AGENT); }
__device__ __forceinline__ unsigned xb_add(unsigned* p, unsigned v) { return __hip_atomic_fetch_add(p, v, __ATOMIC_RELAXED, __HIP_MEMORY_SCOPE_AGENT); }
__device__ __forceinline__ unsigned xb_xcc_id() { return (unsigned)__builtin_amdgcn_s_getreg((3 << 11) | 20) & 0xFu; }
#define XB_SPIN(cond, bar) do { unsigned _sp = 0; while (cond) { __builtin_amdgcn_s_sleep(1); \
    if ((++_sp & 255u) == 0u) { if (xb_ld(&(bar)[XB_TMO])) break; if (_sp > XB_SPIN_CAP) { atomicAdd(&(bar)[XB_TMO], 1u); break; } } } } while (0)
struct XcdBarrier { unsigned* bar; unsigned x; volatile LAS unsigned* st; };
__device__ __forceinline__ XcdBarrier xcd_barrier_post(unsigned* bar, volatile LAS unsigned* st) {
    XcdBarrier b; b.bar = bar; b.x = xb_xcc_id(); b.st = st;
    if (threadIdx.x == 0) (void)xb_add(&bar[XB_XCNT(b.x)], 1u);
    return b;
}
__device__ __forceinline__ void xcd_barrier_complete(unsigned* bar, unsigned x, unsigned& nloc, unsigned& nx) {
    const unsigned G = gridDim.x * gridDim.y * gridDim.z;
    unsigned sum, cnt, mine, sp = 0u;
    for (;;) {
        sum = 0u; cnt = 0u; mine = 0u;
#pragma unroll
        for (unsigned j = 0; j < 16; ++j) { const unsigned c = xb_ld(&bar[XB_XCNT(j)]); sum += c; cnt += (c > 0u) ? 1u : 0u; mine = (j == x) ? c : mine; }
        if (sum == G) break;
        __builtin_amdgcn_s_sleep(1);
        if ((++sp & 255u) == 0u) { if (xb_ld(&bar[XB_TMO])) break; if (sp > XB_SPIN_CAP) { atomicAdd(&bar[XB_TMO], 1u); break; } }
    }
    nloc = mine > 0u ? mine : 1u; nx = cnt > 0u ? cnt : 1u;
}
__device__ __forceinline__ void xcd_barrier(const XcdBarrier& b_) {
    XcdBarrier b; b.bar = b_.bar; b.st = b_.st; b.x = xb_xcc_id();
    asm volatile("s_waitcnt vmcnt(0)" ::: "memory");
    __syncthreads();
    if (threadIdx.x == 0) {
        unsigned* bar = b.bar;
        __builtin_amdgcn_s_waitcnt(0);
        unsigned nloc = b.st[0], nx = b.st[1];
        if (nloc == 0u) { xcd_barrier_complete(bar, b.x, nloc, nx); b.st[0] = nloc; b.st[1] = nx; }
        const unsigned old = xb_add(&bar[XB_XSUB(b.x)], 1u);
        const unsigned gen = old / nloc;
        if (old + 1u == (gen + 1u) * nloc) {
            __builtin_amdgcn_fence(__ATOMIC_RELEASE, "agent");
            asm volatile("s_waitcnt vmcnt(0)" ::: "memory");
            const unsigned og = xb_add(&bar[XB_TOP], 1u);
            const unsigned tg = og / nx;
            if (og + 1u == (tg + 1u) * nx) xb_add(&bar[XB_TOPGEN], 1u);
            else XB_SPIN(xb_ld(&bar[XB_TOPGEN]) == tg, bar);
            __builtin_amdgcn_fence(__ATOMIC_ACQUIRE, "agent");
            xb_add(&bar[XB_XGEN(b.x)], 1u);
            asm volatile("s_waitcnt vmcnt(0)" ::: "memory");
        } else {
            XB_SPIN(xb_ld(&bar[XB_XGEN(b.x)]) == gen, bar);
            __builtin_amdgcn_fence(__ATOMIC_ACQUIRE, "agent");
            asm volatile("s_waitcnt vmcnt(0)" ::: "memory");
        }
    }
    __syncthreads();
}

struct Args { const float* in[34]; float* out; uchar* ws; int ph_lo, ph_hi; };
enum { I_X = 0, I_C, I_CTX, I_CCTX, I_ADAW, I_ADAB, I_NMG, I_NFG, I_RGWIN, I_RGCW, I_RGCB, I_RGWA, I_RGBA, I_RGWI, I_RGBI, I_RGLAM, I_RGWOUT,
       I_ATQKV, I_ATQG, I_ATKG, I_ATWO, I_CMWIN, I_CMLNG, I_CMLNB, I_CMWS, I_CMBS, I_CMWOUT, I_MWG, I_MBG, I_MWR, I_MBR, I_MWGATE, I_MWUP, I_MWDOWN };

__device__ __forceinline__ const void* opaque_uniform_ptr(const void* p) { const unsigned long long v = (unsigned long long)p; unsigned lo = (unsigned)v, hi = (unsigned)(v >> 32); asm volatile("" : "+v"(lo), "+v"(hi));
    lo = __builtin_amdgcn_readfirstlane(lo); hi = __builtin_amdgcn_readfirstlane(hi); return (const void*)(const GAS char*)(((unsigned long long)hi << 32) | lo); }
__device__ __forceinline__ int opaque_uniform_int(int x) { asm volatile("" : "+v"(x)); return __builtin_amdgcn_readfirstlane(x); }
struct Frame {
    LAS uchar* lds; char* ldsg;
    int tid, lane, wave, G, bid;
    uchar* ws; float* out;
};
__device__ __forceinline__ const float* inp(const Frame& F, int i) { const unsigned long long v = *(const LAS unsigned long long*)(F.lds + LDSCTL_OFF + 576 + i * 8);
    const unsigned lo = __builtin_amdgcn_readfirstlane((unsigned)v), hi = __builtin_amdgcn_readfirstlane((unsigned)(v >> 32)); return (const float*)(const GAS float*)(((unsigned long long)hi << 32) | lo); }
__device__ __forceinline__ float wave16_sum(float v) { v += __shfl_xor(v, 1); v += __shfl_xor(v, 2); v += __shfl_xor(v, 4); v += __shfl_xor(v, 8); return v; }

__device__ __forceinline__ void tr_item(const float* W, int ldw, bf16_t* WT, int ldt, int k0, int n0, int dstrow0, LAS float* scr, int lane) {
#pragma unroll 8
    for (int i = 0; i < 32; ++i) { const int kk = 2 * i + (lane >> 5); scr[kk * 33 + (lane & 31)] = W[(size_t)(k0 + kk) * ldw + n0 + (lane & 31)]; }
    asm volatile("s_waitcnt lgkmcnt(0)" ::: "memory");
    const int c = lane & 7;
#pragma unroll
    for (int j = 0; j < 4; ++j) { const int n = (lane >> 3) + 8 * j; const LAS float* s = scr + (8 * c) * 33 + n;
        u32x4 o; o.x = pk2(s[0 * 33], s[1 * 33]); o.y = pk2(s[2 * 33], s[3 * 33]); o.z = pk2(s[4 * 33], s[5 * 33]); o.w = pk2(s[6 * 33], s[7 * 33]);
        *(u32x4*)(WT + (size_t)(dstrow0 + n) * ldt + k0 + 8 * c) = o; }
    asm volatile("s_waitcnt lgkmcnt(0)" ::: "memory");
}
__device__ __forceinline__ bool tr_group(int& r, const float* W, int K, int N, int nmat, bf16_t* WT, int ldt, size_t dst_mat_stride, int mode, LAS float* scr, int lane) {
    const int per = (K / 64) * (N / 32), tot = per * nmat;
    if (r >= tot) { r -= tot; return false; }
    const int mat = r / per, it = r % per, nblk = N / 32, kb = it / nblk, nb = it % nblk, n0 = nb * 32;
    int drow = n0;
    if (mode == 1) drow = (n0 >> 7) * 256 + (n0 & 127);
    else if (mode == 2) drow = (n0 >> 7) * 256 + 128 + (n0 & 127);
    tr_item(W + (size_t)mat * K * N, N, WT + (size_t)mat * dst_mat_stride, ldt, kb * 64, n0, drow, scr, lane);
    return true;
}
__device__ __forceinline__ void p0_prologue(Frame& F) {
    uchar* ws = F.ws;
    {
        LAS float* act = (LAS float*)(F.lds);
        LAS float* red = (LAS float*)(F.lds + 5 * 1024 * 4);
        bool have = false; const float* pC = inp(F, I_C); const float* pCC = inp(F, I_CCTX); const float* pADAW = inp(F, I_ADAW); const float* pADAB = inp(F, I_ADAB);
        for (int it = F.bid; it < DEPTH * 24; it += F.G) {
            if (!have) { for (int i = F.tid; i < 5 * 1024; i += 512) { const int s = i >> 10, k = i & 1023; const float v = s < 4 ? pC[s * 1024 + k] : pCC[k]; act[i] = v / (1.f + __expf(-v)); } have = true; __syncthreads(); }
            const int l = it / 24, cb = it % 24;
            const float* W = pADAW + (size_t)l * 1024 * NMODV + cb * 256 + F.lane * 4;
            f32x4 a[5];
#pragma unroll
            for (int s = 0; s < 5; ++s) a[s] = (f32x4){0.f, 0.f, 0.f, 0.f};
            const int kbase = F.wave * 128;
#pragma unroll 8
            for (int k = 0; k < 128; ++k) { const f32x4 w = *(const f32x4*)(W + (size_t)(kbase + k) * NMODV);
#pragma unroll
                for (int s = 0; s < 5; ++s) a[s] += w * act[s * 1024 + kbase + k]; }
#pragma unroll
            for (int s = 0; s < 5; ++s) *(LAS f32x4*)(red + (F.wave * 5 + s) * 256 + F.lane * 4) = a[s];
            __syncthreads();
            for (int i = F.tid; i < 5 * 256; i += 512) { const int s = i >> 8, c = i & 255; float v = pADAB[l * NMODV + cb * 256 + c];
#pragma unroll
                for (int w = 0; w < 8; ++w) v += red[(w * 5 + s) * 256 + c];
                ((float*)(ws + WS_MOD))[(l * 5 + s) * NMODV + cb * 256 + c] = v; }
            __syncthreads();
        }
        __syncthreads();
    }
    {
        LAS float* scr = (LAS float*)(F.lds + F.wave * 16384);
        const int gw = F.bid * 8 + F.wave, NGW = F.G * 8;
        constexpr int NITEMS = 2048 + 512 + 1024 + 768 + 512 + 2048 + 1024 + 3 * 32768;
        const float* pMWGATE = inp(F, I_MWGATE); const float* pMWUP = inp(F, I_MWUP); const float* pMWDOWN = inp(F, I_MWDOWN); const float* pRGWIN = inp(F, I_RGWIN); const float* pCMWIN = inp(F, I_CMWIN);
        const float* pRGWOUT = inp(F, I_RGWOUT); const float* pCMWOUT = inp(F, I_CMWOUT); const float* pATQKV = inp(F, I_ATQKV); const float* pATWO = inp(F, I_ATWO); const float* pRGWA = inp(F, I_RGWA); const float* pRGWI = inp(F, I_RGWI);
        for (int it = gw; it < NITEMS; it += NGW) {
            int r = it;
            if (tr_group(r, pMWGATE, 1024, 512, 128, (bf16_t*)(ws + WS_W_E1), 1024, (size_t)1024 * 1024, 1, scr, F.lane)) continue;
            if (tr_group(r, pMWUP, 1024, 512, 128, (bf16_t*)(ws + WS_W_E1), 1024, (size_t)1024 * 1024, 2, scr, F.lane)) continue;
            if (tr_group(r, pMWDOWN, 512, 1024, 128, (bf16_t*)(ws + WS_W_E2), 512, (size_t)1024 * 512, 0, scr, F.lane)) continue;
            if (tr_group(r, pRGWIN, 1024, 2048, 2, (bf16_t*)(ws + WS_W_RGIN), 1024, (size_t)2048 * 1024, 0, scr, F.lane)) continue;
            if (tr_group(r, pCMWIN, 1024, 4096, 1, (bf16_t*)(ws + WS_W_CMIN), 1024, 0, 0, scr, F.lane)) continue;
            if (tr_group(r, pRGWOUT, 1024, 1024, 2, (bf16_t*)(ws + WS_W_RGOUT), 1024, (size_t)1024 * 1024, 0, scr, F.lane)) continue;
            if (tr_group(r, pCMWOUT, 2048, 1024, 1, (bf16_t*)(ws + WS_W_CMOUT), 2048, 0, 0, scr, F.lane)) continue;
            if (tr_group(r, pATQKV, 1024, 1536, 1, (bf16_t*)(ws + WS_W_QKV), 1024, 0, 0, scr, F.lane)) continue;
            if (tr_group(r, pATWO, 1024, 1024, 1, (bf16_t*)(ws + WS_W_AO), 1024, 0, 0, scr, F.lane)) continue;
            if (r < 256) { const int mat = r / 8, itx = r % 8, kb = itx / 4, nb = itx % 4;
                tr_item(pRGWA + (size_t)mat * 128 * 128, 128, (bf16_t*)(ws + WS_W_RGG) + (size_t)mat * 256 * 128, 128, kb * 64, nb * 32, nb * 32, scr, F.lane); continue; }
            r -= 256;
            { const int mat = r / 8, itx = r % 8, kb = itx / 4, nb = itx % 4;
                tr_item(pRGWI + (size_t)mat * 128 * 128, 128, (bf16_t*)(ws + WS_W_RGG) + (size_t)mat * 256 * 128, 128, kb * 64, nb * 32, 128 + nb * 32, scr, F.lane); }
        }
    }
    {
        const int gt = F.bid * 512 + F.tid, NGT = F.G * 512;
        { const float* pctx = inp(F, I_CTX); const float* px = inp(F, I_X);
          for (int i0 = gt; i0 < T * 256; i0 += 4 * NGT) { f32x4 v[4];
#pragma unroll
            for (int q = 0; q < 4; ++q) { const int i = i0 + q * NGT; if (i < T * 256) { const int row = i >> 8, c4 = i & 255, b = row / SB, s = row - b * SB;
                const float* src = s < CTX ? pctx + ((size_t)(b * CTX + s) << 10) : px + ((size_t)(b * SEQ + s - CTX) << 10); v[q] = ((const f32x4*)src)[c4]; } }
#pragma unroll
            for (int q = 0; q < 4; ++q) { const int i = i0 + q * NGT; if (i < T * 256) ((f32x4*)(ws + WS_X))[i] = v[q]; } } }
        for (int i = gt; i < 8 * 128 * 128 / 4; i += NGT) { const f32x4 v = ((const f32x4*)inp(F, I_CMWS))[i]; u32x2 o; o.x = pk2(v.x, v.y); o.y = pk2(v.z, v.w); ((u32x2*)(ws + WS_W_CMS))[i] = o; }
        for (int i = gt; i < 2 * 2 * D; i += NGT) { const float* plam = inp(F, I_RGLAM); ((float*)(ws + WS_SPL))[i] = -8.f * log1pf(expf(-plam[i])); }
        for (int i = gt; i < 64 * 32; i += NGT) { const int pos = i >> 5, f = i & 31; const float inv = powf(10000.f, -(float)f * 2.0f / 64.0f); const float ang = (float)pos * inv;
            ((f32x2*)(ws + WS_ROPE))[i] = (f32x2){cosf(ang), sinf(ang)}; }
    }
}

template <bool ROUTE>
__device__ __forceinline__ void norm_phase(Frame& F, int l, const float* gvec, int shift_i, bool addY, bool skip_ctx_route, bool dry) {
    uchar* ws = F.ws;
    float* X = (float*)(ws + WS_X); const float* Y1 = (const float*)(ws + WS_Y1); bf16_t* H = (bf16_t*)(ws + WS_H);
    const float* MOD = (const float*)(ws + WS_MOD) + (size_t)l * 5 * NMODV;
    LAS float* wr = (LAS float*)F.lds;
    if constexpr (ROUTE) {
        const float* wg = inp(F, I_MWG) + (size_t)l * 1024 * 4; const float* wrt = inp(F, I_MWR) + (size_t)l * 1024 * 32;
        for (int idx = F.tid; idx < 1024 * 9; idx += 512) { const int k = idx / 9, q = idx - k * 9;
            const f32x4 v = q == 0 ? *(const f32x4*)(wg + k * 4) : *(const f32x4*)(wrt + k * 32 + (q - 1) * 4);
            wr[(4 * q + 0) * 1024 + k] = v.x; wr[(4 * q + 1) * 1024 + k] = v.y; wr[(4 * q + 2) * 1024 + k] = v.z; wr[(4 * q + 3) * 1024 + k] = v.w; }
        __syncthreads();
    }
    const int i16 = F.lane & 15, grp = F.lane >> 4;
    const float* bg = nullptr; const float* br = nullptr; if constexpr (ROUTE) { bg = inp(F, I_MBG) + l * 4; br = inp(F, I_MBR) + l * 32; }
    for (int tok = (F.bid * 8 + F.wave) * 4 + grp; tok < T; tok += F.G * 32) {
        const int sidx = sidx_of_row(tok);
        f32x4 x[16];
        float ss = 0.f;
#pragma unroll
        for (int j = 0; j < 16; ++j) { x[j] = *(const f32x4*)(X + (size_t)tok * D + 64 * j + 4 * i16);
            if (addY) { x[j] += *(const f32x4*)(Y1 + (size_t)tok * D + 64 * j + 4 * i16); *(f32x4*)(X + (size_t)tok * D + 64 * j + 4 * i16) = x[j]; }
            ss += x[j].x * x[j].x + x[j].y * x[j].y + x[j].z * x[j].z + x[j].w * x[j].w; }
        ss = wave16_sum(ss);
        const float rstd = rsqrtf(ss * (1.f / D) + NORM_EPS);
        const float* shp = MOD + (size_t)sidx * NMODV + shift_i * D; const float* scp = shp + D;
#pragma unroll
        for (int j = 0; j < 16; ++j) { const int c = 64 * j + 4 * i16; const f32x4 g = *(const f32x4*)(gvec + c), sh = *(const f32x4*)(shp + c), sc = *(const f32x4*)(scp + c);
            x[j] = x[j] * rstd * g * (sc + 1.f) + sh;
            u32x2 o; o.x = pk2(x[j].x, x[j].y); o.y = pk2(x[j].z, x[j].w); *(u32x2*)(H + (size_t)tok * D + c) = o; }
        if constexpr (ROUTE) {
            LAS float* lgs = (LAS float*)(F.lds + LDSCTL_OFF + 1024) + (F.wave * 4 + grp) * 40;
#pragma unroll 1
            for (int o = 0; o < 36; ++o) { float a = 0.f;
#pragma unroll
                for (int j = 0; j < 16; ++j) { const f32x4 w = *(const LAS f32x4*)(wr + o * 1024 + 64 * j + 4 * i16); a += x[j].x * w.x + x[j].y * w.y + x[j].z * w.z + x[j].w * w.w; }
                a = wave16_sum(a); if (i16 == 0) lgs[o] = a; }
            asm volatile("s_waitcnt lgkmcnt(0)" ::: "memory");
            const float gl0 = lgs[0] + bg[0], gl1 = lgs[1] + bg[1], gl2 = lgs[2] + bg[2], gl3 = lgs[3] + bg[3];
            int gs = 0; float gm = gl0;
            if (gl1 > gm) { gm = gl1; gs = 1; }
            if (gl2 > gm) { gm = gl2; gs = 2; }
            if (gl3 > gm) { gm = gl3; gs = 3; }
            const float den = __expf(gl0 - gm) + __expf(gl1 - gm) + __expf(gl2 - gm) + __expf(gl3 - gm);
            const float pg = 1.f / den;
            float el[8];
#pragma unroll
            for (int e = 0; e < 8; ++e) el[e] = lgs[4 + gs * 8 + e] + br[gs * 8 + e];
            int i0 = 0; float v0 = el[0];
#pragma unroll
            for (int e = 1; e < 8; ++e) if (el[e] > v0) { v0 = el[e]; i0 = e; }
            int i1 = -1; float v1 = -3.0e38f;
#pragma unroll
            for (int e = 0; e < 8; ++e) if (e != i0 && el[e] > v1) { v1 = el[e]; i1 = e; }
            const float p0 = 1.f / (1.f + __expf(v1 - v0));
            const float w0 = p0 * pg, w1 = (1.f - p0) * pg;
            const bool do_route = !(skip_ctx_route && sidx == 4) && !dry;
            if (i16 == 0 && do_route) {
                const int e0 = gs * 8 + i0, e1 = gs * 8 + i1;
                unsigned* cnt = (unsigned*)(ws + WS_CTL) + CW_CNT + l * 32 * 64;
                const unsigned q0 = atomicAdd(cnt + e0 * 64, 1u), q1 = atomicAdd(cnt + e1 * 64, 1u);
                int* BK = (int*)(ws + WS_BK); float* TW = (float*)(ws + WS_TW);
                BK[(size_t)e0 * T + q0] = tok * 2; BK[(size_t)e1 * T + q1] = tok * 2 + 1;
                TW[tok * 2] = w0; TW[tok * 2 + 1] = w1;
            }
        }
    }
}

__device__ __forceinline__ void st8(bf16_t* p, f32x4 v0, f32x4 v1) { u32x4 w; w.x = cvt_pk_bf16(v0[0], v0[1]); w.y = cvt_pk_bf16(v0[2], v0[3]); w.z = cvt_pk_bf16(v1[0], v1[1]); w.w = cvt_pk_bf16(v1[2], v1[3]); *(u32x4*)p = w; }
#define EPI_ROWS(ai, m) (u.pm * 256 + (ai) * 128 + wr * 64 + (m) * 16 + fr)

struct EpiRgIn { static constexpr bool PERM = true; bf16_t* GG; bf16_t* XB;
    __device__ __forceinline__ void operator()(const f32x4 (&acc)[2][2][4][2], const pg8::Unit& u, int wr, int wc, int fr, int fq) const {
        const bool isg = u.pn < 4; bf16_t* base = isg ? GG : XB; const int ct = (u.pn & 3) * 256 + wc * 32 + 8 * fq;
#pragma unroll
        for (int ai = 0; ai < 2; ++ai)
#pragma unroll
            for (int m = 0; m < 4; ++m) { bf16_t* rowp = base + (size_t)EPI_ROWS(ai, m) * D + ct;
#pragma unroll
                for (int bj = 0; bj < 2; ++bj) { f32x4 v0 = acc[ai][bj][m][0], v1 = acc[ai][bj][m][1];
                    if (isg) {
#pragma unroll
                        for (int e = 0; e < 4; ++e) { v0[e] = gelu_tanh(v0[e]); v1[e] = gelu_tanh(v1[e]); } }
                    st8(rowp + bj * 128, v0, v1); } }
    } };
struct EpiBf16 { static constexpr bool PERM = true; bf16_t* O; int ldc;
    __device__ __forceinline__ void operator()(const f32x4 (&acc)[2][2][4][2], const pg8::Unit& u, int wr, int wc, int fr, int fq) const {
        const int ct = u.pn * 256 + wc * 32 + 8 * fq;
#pragma unroll
        for (int ai = 0; ai < 2; ++ai)
#pragma unroll
            for (int m = 0; m < 4; ++m) { bf16_t* rowp = O + (size_t)EPI_ROWS(ai, m) * ldc + ct;
#pragma unroll
                for (int bj = 0; bj < 2; ++bj) st8(rowp + bj * 128, acc[ai][bj][m][0], acc[ai][bj][m][1]); }
    } };
struct EpiCmIn { static constexpr bool PERM = true; bf16_t* O; f32x2* statp;
    __device__ __forceinline__ void operator()(const f32x4 (&acc)[2][2][4][2], const pg8::Unit& u, int wr, int wc, int fr, int fq) const {
        const int ct = u.pn * 256 + wc * 32 + 8 * fq; const bool isv = u.pn >= 8;
#pragma unroll
        for (int ai = 0; ai < 2; ++ai)
#pragma unroll
            for (int m = 0; m < 4; ++m) { const int row = EPI_ROWS(ai, m); bf16_t* rowp = O + (size_t)row * 4096 + ct; float s = 0.f, q = 0.f;
#pragma unroll
                for (int bj = 0; bj < 2; ++bj) { f32x4 v0 = acc[ai][bj][m][0], v1 = acc[ai][bj][m][1];
#pragma unroll
                    for (int e = 0; e < 4; ++e) { v0[e] = gelu_tanh(v0[e]); v1[e] = gelu_tanh(v1[e]); }
                    u32x4 w; w.x = cvt_pk_bf16(v0[0], v0[1]); w.y = cvt_pk_bf16(v0[2], v0[3]); w.z = cvt_pk_bf16(v1[0], v1[1]); w.w = cvt_pk_bf16(v1[2], v1[3]);
                    *(u32x4*)(rowp + bj * 128) = w;
                    const float r0 = bflo(w.x), r1 = bfhi(w.x), r2 = bflo(w.y), r3 = bfhi(w.y), r4 = bflo(w.z), r5 = bfhi(w.z), r6 = bflo(w.w), r7 = bfhi(w.w);
                    s += ((r0 + r1) + (r2 + r3)) + ((r4 + r5) + (r6 + r7)); q += ((r0 * r0 + r1 * r1) + (r2 * r2 + r3 * r3)) + ((r4 * r4 + r5 * r5) + (r6 * r6 + r7 * r7)); }
                if (isv) { s += __shfl_xor(s, 16); s += __shfl_xor(s, 32); q += __shfl_xor(q, 16); q += __shfl_xor(q, 32);
                    if (fq == 0) statp[(size_t)row * 32 + (u.pn - 8) * 4 + wc] = (f32x2){s, q}; } }
    } };
struct EpiResid { static constexpr bool PERM = false; float* X; const float* gate  ;
    __device__ __forceinline__ void operator()(const f32x4 (&acc)[2][2][4][2], const pg8::Unit& u, int wr, int wc, int fr, int fq) const {
        const int sidx = sidx_of_row(u.pm * 256); const float* gp = gate + (size_t)sidx * NMODV; const int ct = u.pn * 256 + wc * 32 + 4 * fq;
        f32x4 gv[2][2];
#pragma unroll
        for (int bj = 0; bj < 2; ++bj)
#pragma unroll
            for (int n = 0; n < 2; ++n) gv[bj][n] = *(const f32x4*)(gp + ct + bj * 128 + n * 16);
#pragma unroll
        for (int ai = 0; ai < 2; ++ai)
#pragma unroll
            for (int m = 0; m < 4; ++m) { float* rowp = X + (size_t)EPI_ROWS(ai, m) * D + ct;
#pragma unroll
                for (int bj = 0; bj < 2; ++bj)
#pragma unroll
                    for (int n = 0; n < 2; ++n) { f32x4* p = (f32x4*)(rowp + bj * 128 + n * 16); *p = *p + gv[bj][n] * acc[ai][bj][m][n]; } }
    } };
struct EpiRgGate { static constexpr bool PERM = true; const bf16_t* XC; bf16_t* LA; bf16_t* BB; const float* ba; const float* bi; const float* lam;
    __device__ __forceinline__ void operator()(const f32x4 (&acc)[2][2][4][2], const pg8::Unit& u, int wr, int wc, int fr, int fq) const {
        const int d = u.pn >> 3, blk = u.pn & 7;
        asm volatile("" : "+v"(fr), "+v"(fq));
#pragma unroll
        for (int n = 0; n < 2; ++n) { const int ch = blk * 128 + wc * 32 + 8 * fq + 4 * n;
            const f32x4 bav = *(const f32x4*)(ba + d * D + ch), biv = *(const f32x4*)(bi + d * D + ch), spv = *(const f32x4*)(lam + d * D + ch);
#pragma unroll
            for (int ai = 0; ai < 2; ++ai)
#pragma unroll
                for (int m = 0; m < 4; ++m) { const size_t off = (size_t)EPI_ROWS(ai, m) * D + ch;
                    const u32x2 xw = *(const u32x2*)(XC + off);
                    const f32x4 xc = {bflo(xw.x), bfhi(xw.x), bflo(xw.y), bfhi(xw.y)};
                    f32x4 la, bb;
#pragma unroll
                    for (int e = 0; e < 4; ++e) { const float r = fast_sigmoid(acc[ai][0][m][n][e] + bav[e]), ig = fast_sigmoid(acc[ai][1][m][n][e] + biv[e]);
                        const float lga = r * spv[e]; la[e] = lga; bb[e] = __builtin_amdgcn_sqrtf(one_minus_exp(-2.f * lga)) * ig * xc[e]; }
                    u32x2 w; w.x = cvt_pk_bf16(la[0], la[1]); w.y = cvt_pk_bf16(la[2], la[3]);
                    *(u32x2*)(LA + (size_t)d * T * D + off) = w;
                    w.x = cvt_pk_bf16(bb[0], bb[1]); w.y = cvt_pk_bf16(bb[2], bb[3]);
                    *(u32x2*)(BB + (size_t)d * T * D + off) = w; __builtin_amdgcn_sched_barrier(0); }
            asm volatile("" ::: "memory"); }
    } };

template <bool G1>
struct MoeOrder {
    static constexpr bool GATHER = G1;
    const LAS int* tab; const char* A; const char* B; const int* BK; int G, c, nunits; size_t bstride;
    __device__ bool next(int i, pg8::Unit& u) const {
        const long L = (long)i * G + c; if (L >= nunits) return false;
        const int wgid = __builtin_amdgcn_readfirstlane(pg8::xcd_remap((int)L, nunits)); const int tau = wgid >> 2, pn = wgid & 3;
        int e = 0;
#pragma unroll 1
        for (int k = 1; k < 32; ++k) e = (tab[k] <= tau) ? k : e;
        e = __builtin_amdgcn_readfirstlane(e);
        u.pm = tau; u.pn = pn; u.aux0 = e; u.aux1 = __builtin_amdgcn_readfirstlane((tau - tab[e]) * 256);
        u.a = pg8::uptr(G1 ? A : A + (size_t)tau * 256 * DEXP * 2);
        u.b = pg8::uptr(B + (size_t)e * bstride + (size_t)pn * 256 * (G1 ? 1024 : DEXP) * 2);
        return true; }
    __device__ unsigned goff(const pg8::Unit& u, int row) const {
        const int pos = u.aux1 + row; const int cnt = tab[40 + u.aux0];
        int tok = 0; if (pos < cnt) tok = __builtin_nontemporal_load(BK + (size_t)u.aux0 * T + pos) >> 1;
        return (unsigned)tok * (unsigned)(D * 2); }
};
struct EpiMoe1 { static constexpr bool PERM = true; bf16_t* H1;
    __device__ __forceinline__ void operator()(const f32x4 (&acc)[2][2][4][2], const pg8::Unit& u, int wr, int wc, int fr, int fq) const {
        const int ct = u.pn * 128 + wc * 32 + 8 * fq;
#pragma unroll
        for (int ai = 0; ai < 2; ++ai)
#pragma unroll
            for (int m = 0; m < 4; ++m) { f32x4 h0, h1;
#pragma unroll
                for (int e = 0; e < 4; ++e) { const float g0 = acc[ai][0][m][0][e], g1 = acc[ai][0][m][1][e]; h0[e] = g0 * sigmoidf_(g0) * acc[ai][1][m][0][e]; h1[e] = g1 * sigmoidf_(g1) * acc[ai][1][m][1][e]; }
                st8(H1 + (size_t)EPI_ROWS(ai, m) * DEXP + ct, h0, h1); }
    } };
struct EpiMoe2 { static constexpr bool PERM = false; float* X; float* Y1; const float* gate; const int* BK; const float* TW; const LAS int* tab;
    __device__ __forceinline__ void operator()(const f32x4 (&acc)[2][2][4][2], const pg8::Unit& u, int wr, int wc, int fr, int fq) const {
        const int ct = u.pn * 256 + wc * 32 + 4 * fq; const int cnt = tab[40 + u.aux0];
#pragma unroll
        for (int ai = 0; ai < 2; ++ai)
#pragma unroll
            for (int m = 0; m < 4; ++m) { const int pos = u.aux1 + ai * 128 + wr * 64 + m * 16 + fr;
                if (pos < cnt) { const int ent = __builtin_nontemporal_load(BK + (size_t)u.aux0 * T + pos); const int tok = ent >> 1, slot = ent & 1; const float w = __builtin_nontemporal_load(TW + ent);
                    const float* gp = gate + (size_t)sidx_of_row(tok) * NMODV + ct; float* xp = (slot ? Y1 : X) + (size_t)tok * D + ct;
#pragma unroll
                    for (int bj = 0; bj < 2; ++bj)
#pragma unroll
                        for (int n = 0; n < 2; ++n) { const f32x4 g = *(const f32x4*)(gp + bj * 128 + n * 16); f32x4 v = g * w * acc[ai][bj][m][n]; f32x4* p = (f32x4*)(xp + bj * 128 + n * 16);
                            if (!slot) v += *p; *p = v; } } }
    } };
__device__ __forceinline__ int moe_table(Frame& F, int l, LAS int* tab) {
    __syncthreads();
    if (F.tid < 32) { const unsigned c = __hip_atomic_load((unsigned*)(F.ws + WS_CTL) + CW_CNT + (l * 32 + F.tid) * 64, RLX_AGENT); tab[40 + F.tid] = (int)c; }
    __syncthreads();
    if (F.tid == 0) { int s = 0; for (int e = 0; e < 32; ++e) { tab[e] = s; s += (tab[40 + e] + 255) >> 8; } tab[32] = s; }
    __syncthreads();
    return tab[32];
}

__device__ __forceinline__ void conv_phase(Frame& F, int j) {
    const bf16_t* XB = (const bf16_t*)(F.ws + WS_XB); bf16_t* XC = (bf16_t*)(F.ws + WS_XC);
    const float* cw = inp(F, I_RGCW) + (size_t)j * 4 * D; const float* cb = inp(F, I_RGCB) + (size_t)j * D;
    for (int i = F.bid * 512 + F.tid; i < T * 128; i += F.G * 512) { const int row = i >> 7, c = (i & 127) * 8; const int b = row / SB, s = row - b * SB;
        const int lo = s < CTX ? 0 : CTX, hi = s < CTX ? CTX : SB;
        float a[8];
#pragma unroll
        for (int e = 0; e < 8; ++e) a[e] = cb[c + e];
#pragma unroll
        for (int k = 0; k < 4; ++k) { const int ss = s + k - 2; if (ss >= lo && ss < hi) { const u32x4 xw = *(const u32x4*)(XB + (size_t)(b * SB + ss) * D + c);
                const f32x4 w0 = *(const f32x4*)(cw + k * D + c), w1 = *(const f32x4*)(cw + k * D + c + 4);
                a[0] += w0.x * bflo(xw.x); a[1] += w0.y * bfhi(xw.x); a[2] += w0.z * bflo(xw.y); a[3] += w0.w * bfhi(xw.y);
                a[4] += w1.x * bflo(xw.z); a[5] += w1.y * bfhi(xw.z); a[6] += w1.z * bflo(xw.w); a[7] += w1.w * bfhi(xw.w); } }
        u32x4 o; o.x = pk2(a[0], a[1]); o.y = pk2(a[2], a[3]); o.z = pk2(a[4], a[5]); o.w = pk2(a[6], a[7]);
        *(u32x4*)(XC + (size_t)row * D + c) = o; }
}
__device__ __forceinline__ void scan1_phase(Frame& F) {
    const bf16_t* LA = (const bf16_t*)(F.ws + WS_LA); const bf16_t* BB = (const bf16_t*)(F.ws + WS_BB); f32x2* TOT = (f32x2*)(F.ws + WS_TOT);
    for (int it = F.bid * 8 + F.wave; it < NB * 2 * NCHUNK * 16; it += F.G * 8) {
        const int cg = it & 15, rest = it >> 4, ck = rest % NCHUNK, bd = rest / NCHUNK, dir = bd & 1, b = bd >> 1;
        const int c = cg * 64 + F.lane; const size_t base = (size_t)dir * T * D + (size_t)(b * SB + ck * 64) * D + c;
        float sl = 0.f, h = 0.f;
#pragma unroll 16
        for (int t = 0; t < 64; ++t) { const int tt = dir ? 63 - t : t; const float la = bf2f(LA[base + (size_t)tt * D]), bb = bf2f(BB[base + (size_t)tt * D]);
            sl += la; h = __expf(la) * h + bb; }
        TOT[(size_t)(bd * NCHUNK + ck) * D + c] = (f32x2){sl, h};
    }
}
__device__ __forceinline__ void scan3_phase(Frame& F) {
    const bf16_t* LA = (const bf16_t*)(F.ws + WS_LA); const bf16_t* BB = (const bf16_t*)(F.ws + WS_BB); const f32x2* TOT = (const f32x2*)(F.ws + WS_TOT);
    const bf16_t* GG = (const bf16_t*)(F.ws + WS_GG); bf16_t* SA = (bf16_t*)(F.ws + WS_SA);
    LAS float* hb = (LAS float*)(F.lds + F.wave * 16384);
    for (int it = F.bid * 8 + F.wave; it < NB * NCHUNK * 16; it += F.G * 8) {
        const int cg = it & 15, rest = it >> 4, ck = rest % NCHUNK, b = rest / NCHUNK;
        const int c = cg * 64 + F.lane;
        const f32x2* tf = TOT + (size_t)((b * 2 + 0) * NCHUNK) * D + c; const f32x2* tb = TOT + (size_t)((b * 2 + 1) * NCHUNK) * D + c;
        float hf = 0.f, hbk = 0.f;
        for (int jj = 0; jj < ck; ++jj) { const f32x2 v = tf[(size_t)jj * D]; hf = __expf(v.x) * hf + v.y; }
        if (ck < 4) { for (int jj = 3; jj > ck; --jj) { const f32x2 v = tb[(size_t)jj * D]; hbk = __expf(v.x) * hbk + v.y; } }
        else { for (int jj = 3; jj >= 0; --jj) { const f32x2 v = tb[(size_t)jj * D]; hbk = __expf(v.x) * hbk + v.y; }
               for (int jj = NCHUNK - 1; jj > ck; --jj) { const f32x2 v = tb[(size_t)jj * D]; hbk = __expf(v.x) * hbk + v.y; } }
        const size_t rbase = (size_t)(b * SB + ck * 64) * D + c;
        const size_t b1 = (size_t)T * D + rbase;
#pragma unroll 16
        for (int t = 63; t >= 0; --t) { const float la = bf2f(LA[b1 + (size_t)t * D]), bb = bf2f(BB[b1 + (size_t)t * D]); hbk = __expf(la) * hbk + bb; hb[t * 64 + F.lane] = hbk; }
#pragma unroll 16
        for (int t = 0; t < 64; ++t) { const float la = bf2f(LA[rbase + (size_t)t * D]), bb = bf2f(BB[rbase + (size_t)t * D]); hf = __expf(la) * hf + bb;
            const float y = bf2f(GG[rbase + (size_t)t * D]) * (hf + hb[t * 64 + F.lane]); SA[rbase + (size_t)t * D] = (bf16_t)f2bf(y); }
    }
}

__device__ __forceinline__ void qknorm_phase(Frame& F) {
    bf16_t* QKV = (bf16_t*)(F.ws + WS_QKV); const f32x2* ROPE = (const f32x2*)(F.ws + WS_ROPE);
    const int i16 = F.lane & 15, grp = F.lane >> 4; const float* pqg = inp(F, I_ATQG); const float* pkg = inp(F, I_ATKG);
    for (int it = (F.bid * 8 + F.wave) * 4 + grp; it < T * 10; it += F.G * 32) {
        const int row = it / 10, hh = it - row * 10; const int b = row / SB, s = row - b * SB;
        bf16_t* p = QKV + (size_t)row * 1536 + hh * 128 + i16 * 8;
        const u32x4 xw = *(const u32x4*)p;
        float x[8] = {bflo(xw.x), bfhi(xw.x), bflo(xw.y), bfhi(xw.y), bflo(xw.z), bfhi(xw.z), bflo(xw.w), bfhi(xw.w)};
        float ss = 0.f;
#pragma unroll
        for (int e = 0; e < 8; ++e) ss += x[e] * x[e];
        ss = wave16_sum(ss);
        const float rstd = rsqrtf(ss * (1.f / 128.f) + NORM_EPS);
        const float* g = (hh < 8 ? pqg : pkg) + i16 * 8;
#pragma unroll
        for (int e = 0; e < 8; ++e) x[e] = x[e] * rstd * g[e];
        float y[8];
#pragma unroll
        for (int e = 0; e < 8; ++e) y[e] = __shfl_xor(x[e], 4);
        if (s >= CTX) { const int t = s - CTX; const int pos = (i16 >> 3) ? (t & 63) : (t >> 6); const bool half1 = (i16 >> 2) & 1;
#pragma unroll
            for (int e = 0; e < 8; ++e) { const f32x2 cs = ROPE[pos * 32 + (i16 & 3) * 8 + e];
                x[e] = half1 ? (x[e] * cs.x + y[e] * cs.y) : (x[e] * cs.x - y[e] * cs.y); } }
        u32x4 o; o.x = pk2(x[0], x[1]); o.y = pk2(x[2], x[3]); o.z = pk2(x[4], x[5]); o.w = pk2(x[6], x[7]);
        *(u32x4*)p = o;
    }
}
__device__ __forceinline__ void attn_phase(Frame& F) {
    const bf16_t* QKV = (const bf16_t*)(F.ws + WS_QKV); bf16_t* AO = (bf16_t*)(F.ws + WS_AO);
    for (int u = F.bid; u < 544; u += F.G) {
        int b, h, q0, k0, seq;
        if (u < 512) { const int qb = u & 15, hg = (u >> 4) & 3, kvh = (u >> 6) & 1; b = u >> 7; h = kvh * 4 + hg; q0 = b * SB + CTX + qb * 256; k0 = b * SB; seq = SB; }
        else { const int v = u - 512; b = v >> 3; h = v & 7; q0 = b * SB; k0 = b * SB; seq = CTX; }
        const int kvh = h >> 2;
        const bf16_t* Kp = (const bf16_t*)pg8::uptr((const char*)(QKV + (size_t)k0 * 1536 + 1024 + kvh * 128));
        att::attn_dense_body((const bf16_t*)pg8::uptr((const char*)(QKV + (size_t)q0 * 1536 + h * 128)), Kp, Kp + 256, (bf16_t*)pg8::uptr((const char*)(AO + (size_t)q0 * D + h * 128)), seq, F.ldsg, F.tid);
        __syncthreads();
    }
}

__device__ __forceinline__ void spatial_phase(Frame& F) {
    const bf16_t* UVB = (const bf16_t*)(F.ws + WS_UVB); bf16_t* UV = (bf16_t*)(F.ws + WS_UV); const f32x2* statp = (const f32x2*)(F.ws + WS_STATP);
    const bf16_t* Ws = (const bf16_t*)(F.ws + WS_W_CMS); const float* lng = inp(F, I_CMLNG); const float* lnb = inp(F, I_CMLNB); const float* bs = inp(F, I_CMBS);
    LAS uchar* vl = F.lds;
    LAS f32x2* st = (LAS f32x2*)(F.lds + 65536);
    const int tid = F.tid, lane = F.lane, wid = F.wave, r32 = lane & 31, hi = lane >> 5, wm = wid & 3, wn = wid >> 2;
    const int sr = tid >> 4, sc = (tid & 15) * 8;
    for (int u = F.bid; u < 136 * 8; u += F.G) {
        const int chunk = u >> 3, g = u & 7; const int row0 = chunk * 128;
        __syncthreads();
        if (tid < 128) { const f32x2* sp = statp + (size_t)(row0 + tid) * 32; float s = 0.f, q = 0.f;
#pragma unroll 8
            for (int k = 0; k < 32; ++k) { const f32x2 v = sp[k]; s += v.x; q += v.y; }
            const float mean = s * (1.f / 2048.f); const float var = fmaxf(q * (1.f / 2048.f) - mean * mean, 0.f); st[tid] = (f32x2){mean, rsqrtf(var + NORM_EPS)}; }
        __syncthreads();
#pragma unroll
        for (int ch = 0; ch < 2; ++ch) { const int cg = g * 256 + ch * 128 + sc;
            const f32x4 g0 = *(const f32x4*)(lng + cg), g1 = *(const f32x4*)(lng + cg + 4), b0 = *(const f32x4*)(lnb + cg), b1 = *(const f32x4*)(lnb + cg + 4);
#pragma unroll
            for (int i = 0; i < 4; ++i) { const int q = sr + 32 * i; const u32x4 xw = *(const u32x4*)(UVB + (size_t)(row0 + q) * 4096 + 2048 + cg); const f32x2 ms = st[q];
                f32x4 v0 = {bflo(xw.x), bfhi(xw.x), bflo(xw.y), bfhi(xw.y)}, v1 = {bflo(xw.z), bfhi(xw.z), bflo(xw.w), bfhi(xw.w)};
                v0 = (v0 - ms.x) * ms.y * g0 + b0; v1 = (v1 - ms.x) * ms.y * g1 + b1;
                u32x4 o; o.x = pk2(v0.x, v0.y); o.y = pk2(v0.z, v0.w); o.z = pk2(v1.x, v1.y); o.w = pk2(v1.z, v1.w);
                *(LAS u32x4*)(vl + ((q >> 6) * 2 + ch) * 16384 + att::v_st(q & 63, sc)) = o; } }
        bf16x8 pa[2][4];
#pragma unroll
        for (int kt = 0; kt < 2; ++kt)
#pragma unroll
            for (int ks = 0; ks < 4; ++ks) pa[kt][ks] = *(const bf16x8*)(Ws + ((size_t)g * 128 + 32 * wm + r32) * 128 + 64 * kt + 16 * ks + 8 * hi);
        __syncthreads();
        f32x16 o[4] = {};
        const int vb = (int)(uintptr_t)(F.ldsg) + att::v_rd_base(lane) + wn * 16384;
        att::pv_d0(o, vb, pa[0][0], pa[0][1], pa[0][2], pa[0][3]);
        att::pv_d0(o, vb + 32768, pa[1][0], pa[1][1], pa[1][2], pa[1][3]);
#pragma unroll
        for (int r = 0; r < 16; ++r) { const int p = 32 * wm + att::crow(r, hi); const float bsv = bs[g * 128 + p]; const size_t rowoff = (size_t)(row0 + p);
#pragma unroll
            for (int d0 = 0; d0 < 4; ++d0) { const int c = g * 256 + 128 * wn + 32 * d0 + r32; const float uu = bf2f(UVB[rowoff * 4096 + c]);
                UV[rowoff * 2048 + c] = (bf16_t)f2bf((o[d0][r] + bsv) * uu); } }
    }
    __syncthreads();
}

__device__ __forceinline__ void final_phase(Frame& F) {
    const f32x4* X = (const f32x4*)(F.ws + WS_X); const f32x4* Y1 = (const f32x4*)(F.ws + WS_Y1); f32x4* out = (f32x4*)F.out;
    const int NGT = F.G * 512;
    for (int i0 = F.bid * 512 + F.tid; i0 < NB * SEQ * 256; i0 += 4 * NGT) { f32x4 a[4], y[4];
#pragma unroll
        for (int q = 0; q < 4; ++q) { const int i = i0 + q * NGT; if (i < NB * SEQ * 256) { const int r = i >> 8, c4 = i & 255, b = r >> 12, t = r & 4095; const size_t src = ((size_t)(b * SB + CTX + t) << 8) + c4; a[q] = X[src]; y[q] = Y1[src]; } }
#pragma unroll
        for (int q = 0; q < 4; ++q) { const int i = i0 + q * NGT; if (i < NB * SEQ * 256) out[i] = a[q] + y[q]; } }
}

constexpr int NPHASE = 37;
__global__ void __launch_bounds__(512, 2) mk_fwd(Args args) {
    extern __shared__ __attribute__((aligned(16))) uchar lds[];
    Frame F; F.lds = (LAS uchar*)lds; F.ldsg = (char*)lds; F.tid = threadIdx.x; F.lane = F.tid & 63; F.wave = __builtin_amdgcn_readfirstlane(F.tid >> 6); F.G = gridDim.x; F.bid = blockIdx.x;
    F.ws = args.ws; F.out = args.out;
    uchar* ws0 = args.ws;
    volatile LAS unsigned* MISC = (volatile LAS unsigned*)(F.lds + LDSCTL_OFF);
    LAS int* tab = (LAS int*)(F.lds + LDSCTL_OFF + 256);
    for (int u = F.tid; u < (LDS_BYTES - LDSCTL_OFF) / 4; u += 512) ((LAS unsigned*)(F.lds + LDSCTL_OFF))[u] = 0u;
    __syncthreads();
    if (F.tid == 0) {
#pragma unroll
        for (int i = 0; i < 34; ++i) *(LAS unsigned long long*)(F.lds + LDSCTL_OFF + 576 + i * 8) = (unsigned long long)args.in[i]; }
    __syncthreads();
    const int lo = args.ph_lo, hi = args.ph_hi;
    if (hi - lo > 1) (void)xcd_barrier_post((unsigned*)(ws0 + WS_CTL) + CW_BAR, MISC + 8);
    int ph = 0;
#define PH_BEGIN if (ph >= opaque_uniform_int(args.ph_lo) && ph < opaque_uniform_int(args.ph_hi)) { int t_ = threadIdx.x; F.G = opaque_uniform_int(gridDim.x); F.bid = opaque_uniform_int(blockIdx.x); const int cid = F.bid; (void)cid; \
        F.out = (float*)opaque_uniform_ptr(args.out); F.lds = (LAS uchar*)lds; F.ldsg = (char*)lds; \
        asm volatile("" : "+v"(t_)); F.tid = t_; F.lane = t_ & 63; F.wave = __builtin_amdgcn_readfirstlane(t_ >> 6); \
        uchar* ws = (uchar*)opaque_uniform_ptr(args.ws); F.ws = ws; \
        const float* MODl = (const float*)(ws + WS_MOD) + (size_t)l_ * 5 * NMODV; (void)MODl;
#define GRIDBAR  { XcdBarrier bb_; bb_.bar = (unsigned*)(ws + WS_CTL) + CW_BAR; bb_.x = 0; bb_.st = (volatile LAS unsigned*)(F.lds + LDSCTL_OFF) + 8; xcd_barrier(bb_); }
#define REPBAR   if (rep_ > 1) GRIDBAR
#define PH_END   if (ph + 1 < opaque_uniform_int(args.ph_hi)) GRIDBAR } ++ph;

    { const int l_ = 0; PH_BEGIN PM(0) { const bool dry = rep_ > 1; (void)dry;  p0_prologue(F);  REPBAR } PH_END }

#pragma unroll 1
    for (int l = 0; l < DEPTH; ++l) {
        const int kind = l % 3, j = l / 3; const bool lastl = (l == DEPTH - 1); const int l_ = l;
        PH_BEGIN PM(1) { const bool dry = rep_ > 1; (void)dry;  norm_phase<false>(F, l, inp(F, I_NMG) + l * D, 0, (l > 0) && (rep_ == REPN(1)), false, false);  REPBAR } PH_END
        if (kind == 0) {
            PH_BEGIN PM(2) { const bool dry = rep_ > 1; (void)dry;  { pg8::DenseOrder S; S.init(ws + WS_H, D, ws + WS_W_RGIN + (size_t)j * 2048 * 1024 * 2, D, T, 2048, F.G, cid);
                EpiRgIn E{(bf16_t*)(ws + WS_GG), (bf16_t*)(ws + WS_XB)}; pg8::gemm_phase(F.lds, S, E, D, D, D); }  REPBAR } PH_END
            PH_BEGIN PM(3) { const bool dry = rep_ > 1; (void)dry;  conv_phase(F, j);  REPBAR } PH_END
            PH_BEGIN PM(4) { const bool dry = rep_ > 1; (void)dry;  { pg8::DenseOrder S; S.init(ws + WS_XC, D, ws + WS_W_RGG + (size_t)j * 16 * 256 * 128 * 2, 128, T, 16 * 256, F.G, cid, 7, 256);
                EpiRgGate E{(const bf16_t*)(ws + WS_XC), (bf16_t*)(ws + WS_LA), (bf16_t*)(ws + WS_BB), inp(F, I_RGBA) + (size_t)j * 2 * D, inp(F, I_RGBI) + (size_t)j * 2 * D, (const float*)(ws + WS_SPL) + (size_t)j * 2 * D};
                pg8::gemm_phase(F.lds, S, E, 128, D, 128); }  REPBAR } PH_END
            PH_BEGIN PM(5) { const bool dry = rep_ > 1; (void)dry;  scan1_phase(F);  REPBAR } PH_END
            PH_BEGIN PM(6) { const bool dry = rep_ > 1; (void)dry;  scan3_phase(F);  REPBAR } PH_END
            PH_BEGIN PM(7) { const bool dry = rep_ > 1; (void)dry;  { pg8::DenseOrder S; S.init(ws + WS_SA, D, ws + WS_W_RGOUT + (size_t)j * 1024 * 1024 * 2, D, T, D, F.G, cid);
                EpiResid E{(float*)(ws + (dry ? WS_Y1 : WS_X)), MODl + 2 * D}; pg8::gemm_phase(F.lds, S, E, D, D, D); }  REPBAR } PH_END
        } else if (kind == 1) {
            PH_BEGIN PM(8) { const bool dry = rep_ > 1; (void)dry;  { pg8::DenseOrder S; S.init(ws + WS_H, D, ws + WS_W_QKV, D, T, 1536, F.G, cid);
                EpiBf16 E{(bf16_t*)(ws + WS_QKV), 1536}; pg8::gemm_phase(F.lds, S, E, D, D, D); }  REPBAR } PH_END
            PH_BEGIN PM(9) { const bool dry = rep_ > 1; (void)dry;  qknorm_phase(F);  REPBAR } PH_END
            PH_BEGIN PM(10) { const bool dry = rep_ > 1; (void)dry;  attn_phase(F);  REPBAR } PH_END
            PH_BEGIN PM(11) { const bool dry = rep_ > 1; (void)dry;  { pg8::DenseOrder S; S.init(ws + WS_AO, D, ws + WS_W_AO, D, T, D, F.G, cid);
                EpiResid E{(float*)(ws + (dry ? WS_Y1 : WS_X)), MODl + 2 * D}; pg8::gemm_phase(F.lds, S, E, D, D, D); }  REPBAR } PH_END
        } else {
            PH_BEGIN PM(12) { const bool dry = rep_ > 1; (void)dry;  { pg8::DenseOrder S; S.init(ws + WS_H, D, ws + WS_W_CMIN, D, T, 4096, F.G, cid);
                EpiCmIn E{(bf16_t*)(ws + WS_UVB), (f32x2*)(ws + WS_STATP)}; pg8::gemm_phase(F.lds, S, E, D, D, D); }  REPBAR } PH_END
            PH_BEGIN PM(13) { const bool dry = rep_ > 1; (void)dry;  spatial_phase(F);  REPBAR } PH_END
            PH_BEGIN PM(14) { const bool dry = rep_ > 1; (void)dry;  { pg8::DenseOrder S; S.init(ws + WS_UV, 2048, ws + WS_W_CMOUT, 2048, T, D, F.G, cid);
                EpiResid E{(float*)(ws + (dry ? WS_Y1 : WS_X)), MODl + 2 * D}; pg8::gemm_phase(F.lds, S, E, 2048, 2048, 2048); }  REPBAR } PH_END
        }
        PH_BEGIN PM(15) { const bool dry = rep_ > 1; (void)dry;  norm_phase<true>(F, l, inp(F, I_NFG) + l * D, 3, false, lastl, dry);  REPBAR } PH_END
        PH_BEGIN PM(16) { const bool dry = rep_ > 1; (void)dry;  { const int ntile = moe_table(F, l, tab);
            MoeOrder<true> S{tab, (const char*)(ws + WS_H), (const char*)(ws + WS_W_E1 + (size_t)l * 32 * 1024 * 1024 * 2), (const int*)(ws + WS_BK), F.G, cid, ntile * 4, (size_t)1024 * 1024 * 2};
            EpiMoe1 E{(bf16_t*)(ws + WS_H1)}; pg8::gemm_phase(F.lds, S, E, D, D, D); }  REPBAR } PH_END
        PH_BEGIN PM(17) { const bool dry = rep_ > 1; (void)dry;  { const int ntile = moe_table(F, l, tab);
            MoeOrder<false> S{tab, (const char*)(ws + WS_H1), (const char*)(ws + WS_W_E2 + (size_t)l * 32 * 1024 * 512 * 2), (const int*)(ws + WS_BK), F.G, cid, ntile * 4, (size_t)1024 * 512 * 2};
            EpiMoe2 E{(float*)(ws + (dry ? WS_SCR + 64 * MiB : WS_X)), (float*)(ws + (dry ? WS_SCR + 132 * MiB : WS_Y1)), MODl + 5 * D, (const int*)(ws + WS_BK), (const float*)(ws + WS_TW), tab}; pg8::gemm_phase(F.lds, S, E, DEXP, DEXP, DEXP); }  REPBAR } PH_END
    }
    { const int l_ = 0; PH_BEGIN PM(18) { const bool dry = rep_ > 1; (void)dry;  final_phase(F);  REPBAR if constexpr (((REP_MASK) >> 19) & 1u) { for (int k_ = 0; k_ < 20; ++k_) GRIDBAR } } PH_END }
#undef PH_BEGIN
#undef PH_END
}

extern "C" void kernel_launch(void* const* d_in, const int* in_sizes, int n_in, void* d_out, int out_size, void* d_ws, size_t ws_size, hipStream_t stream) {
    static int grid = 0;
    if (grid == 0) {
        if (n_in != 34 || out_size != NB * SEQ * D || ws_size < WS_END) { fprintf(stderr, "kernel_launch: bad shapes n_in %d out %d ws %zu (need %zu)\n", n_in, out_size, ws_size, (size_t)WS_END); grid = -1; return; }
        int dev = 0, cus = 0, per_cu = 0;
        if (hipGetDevice(&dev) != hipSuccess || hipDeviceGetAttribute(&cus, hipDeviceAttributeMultiprocessorCount, dev) != hipSuccess) { grid = -1; return; }
        if (hipFuncSetAttribute((const void*)mk_fwd, hipFuncAttributeMaxDynamicSharedMemorySize, LDS_BYTES) != hipSuccess) { fprintf(stderr, "kernel_launch: hipFuncSetAttribute failed\n"); grid = -1; return; }
        if (hipOccupancyMaxActiveBlocksPerMultiprocessor(&per_cu, (const void*)mk_fwd, 512, LDS_BYTES) != hipSuccess || per_cu < 1) { fprintf(stderr, "kernel_launch: occupancy query says %d\n", per_cu); (void)hipGetLastError(); grid = -1; return; }
        grid = cus;
    }
    if (grid < 0) return;
    (void)hipMemsetAsync((char*)d_ws + WS_CTL, 0, CTL_BYTES, stream);
    Args a{};
    for (int i = 0; i < 34; ++i) a.in[i] = (const float*)d_in[i];
    a.out = (float*)d_out; a.ws = (uchar*)d_ws;
#if MK_PER_PHASE
    for (int p = 0; p < NPHASE; ++p) { a.ph_lo = p; a.ph_hi = p + 1; hipLaunchKernelGGL(mk_fwd, dim3(grid), dim3(512), LDS_BYTES, stream, a); }
#else
    a.ph_lo = 0; a.ph_hi = NPHASE;
    void* kargs[] = {&a};
    hipError_t e = hipLaunchCooperativeKernel((const void*)mk_fwd, dim3(grid), dim3(512), kargs, LDS_BYTES, stream);
    if (e != hipSuccess) fprintf(stderr, "kernel_launch: cooperative launch failed: %s (grid %d)\n", hipGetErrorString(e), grid);
#endif
}
```

```cpp
#include <hip/hip_runtime.h>
#include <hip/hip_bf16.h>
#include <cstdio>
#include <cstdint>

#ifndef MK_PER_PHASE
#define MK_PER_PHASE 0
#endif

#ifndef PHASE_MASK
#define PHASE_MASK 0xFFFFFFFFu
#endif
#ifndef REP_MASK
#define REP_MASK 0u
#endif
#define REPN(i) ((((REP_MASK) >> (i)) & 1u) ? 2 : 1)
#define PM(i) if constexpr ((PHASE_MASK >> (i)) & 1u) for (int rep_ = REPN(i); rep_ > 0; --rep_)
#define LAS __attribute__((address_space(3)))
#define GAS __attribute__((address_space(1)))
typedef unsigned char uchar;
typedef unsigned short bf16_t;
typedef short bf16x8 __attribute__((ext_vector_type(8)));
typedef short s16x4 __attribute__((ext_vector_type(4)));
typedef float f32x4 __attribute__((ext_vector_type(4)));
typedef float f32x2 __attribute__((ext_vector_type(2)));
typedef float f32x16 __attribute__((ext_vector_type(16)));
typedef unsigned u32x4 __attribute__((ext_vector_type(4)));
typedef unsigned u32x2 __attribute__((ext_vector_type(2)));
typedef GAS unsigned gu32;
#define RLX_AGENT __ATOMIC_RELAXED, __HIP_MEMORY_SCOPE_AGENT

constexpr int D = 1024, NB = 4, SEQ = 4096, CTX = 256, SB = SEQ + CTX, T = NB * SB, DEPTH = 4;
constexpr int NMODV = 6 * D;
constexpr int NEXP = 32, DEXP = 512;
constexpr int NCH = SB / 16;
constexpr float NORM_EPS = 1e-6f;

constexpr size_t MiB = 1u << 20;
constexpr size_t WS_CTL = 0, CTL_BYTES = 1 * MiB;
constexpr size_t WS_MOD = 1 * MiB;
constexpr size_t WS_ROPE = 2 * MiB;
constexpr size_t WS_SPL = 2 * MiB + 65536;
constexpr size_t WS_TOT = 3 * MiB;
constexpr size_t WS_STATP = 8 * MiB;
constexpr size_t WS_BK = 13 * MiB;
constexpr size_t WS_TW = 15 * MiB + 512 * 1024;
constexpr size_t WS_W_RGIN = 16 * MiB, WS_W_RGG = 24 * MiB, WS_W_RGOUT = 26 * MiB, WS_W_QKV = 30 * MiB, WS_W_AO = 33 * MiB;
constexpr size_t WS_W_CMIN = 35 * MiB, WS_W_CMS = 43 * MiB, WS_W_CMOUT = 44 * MiB, WS_W_E1 = 48 * MiB, WS_W_E2 = 304 * MiB;
constexpr size_t WS_X = 432 * MiB, WS_Y1 = 500 * MiB, WS_H = 568 * MiB, WS_SCR = 602 * MiB;
constexpr size_t WS_GG = WS_SCR, WS_XB = WS_SCR + 34 * MiB, WS_XC = WS_SCR + 68 * MiB, WS_LA = WS_SCR + 102 * MiB, WS_BB = WS_SCR + 170 * MiB, WS_SA = WS_SCR + 238 * MiB;
constexpr size_t WS_QKV = WS_SCR, WS_AO = WS_SCR + 51 * MiB;
constexpr size_t WS_UVB = WS_SCR, WS_UV = WS_SCR + 136 * MiB;
constexpr size_t WS_H1 = WS_SCR;
constexpr size_t WS_TOTS = WS_SCR + 272 * MiB, WS_TOTH = WS_TOTS + 9 * MiB, WS_CARRY = WS_TOTH + 9 * MiB;
constexpr size_t WS_END = WS_CARRY + 9 * MiB;
constexpr int CW_TMO = 0, CW_BAR = 4096, CW_CNT = 16384;

constexpr int RING_BYTES = 131072;
constexpr int ROUTER_LDS = 36 * 1024 * 4;
constexpr int LDSCTL_OFF = 147456;
constexpr int LDS_BYTES = LDSCTL_OFF + 1024 + 8 * 4 * 40 * 4;

__device__ __forceinline__ unsigned f2bf(float f) { unsigned u = __builtin_bit_cast(unsigned, f); return (u + 0x7fffu + ((u >> 16) & 1u)) >> 16; }
__device__ __forceinline__ unsigned pk2(float lo, float hi) { return f2bf(lo) | (f2bf(hi) << 16); }
__device__ __forceinline__ float bf2f(unsigned short h) { return __builtin_bit_cast(float, (unsigned)h << 16); }
__device__ __forceinline__ float bflo(unsigned w) { return __builtin_bit_cast(float, w << 16); }
__device__ __forceinline__ float bfhi(unsigned w) { return __builtin_bit_cast(float, w & 0xffff0000u); }
__device__ __forceinline__ unsigned cvt_pk_bf16(float lo, float hi) { unsigned r; asm volatile("v_cvt_pk_bf16_f32 %0, %1, %2" : "=v"(r) : "v"(lo), "v"(hi)); return r; }
__device__ __forceinline__ float gelu_tanh(float x) { const float u = 0.7978845608028654f * (x + 0.044715f * x * x * x); const float e = __expf(2.f * u); const float t = 1.f - 2.f / (e + 1.f); return 0.5f * x * (1.f + t); }
__device__ __forceinline__ float sigmoidf_(float x) { return 1.f / (1.f + __expf(-x)); }
__device__ __forceinline__ float fast_sigmoid(float x) { return __builtin_amdgcn_rcpf(1.f + __expf(-x)); }
__device__ __forceinline__ float one_minus_exp(float y) {   const float p = y * (1.f - y * (0.5f - y * (0.16666667f - y * 0.041666667f))); const float q = 1.f - __expf(-y); return y < 0.0625f ? p : q; }
__device__ __forceinline__ int sidx_of_row(int row) { const int b = row / SB; return (row - b * SB) < CTX ? 4 : b; }

namespace pg8 {
constexpr int BM = 256, BK = 64, HALF = 128, HTB = HALF * BK * 2, NXCD = 8, WGM = 8;
__device__ __forceinline__ int lds_byte(int r, int c) { const int st = (r >> 4) * 2 + (c >> 5), rr = r & 15, cc = c & 31, ob = rr * 64 + cc * 2; return st * 1024 + (ob ^ (((ob >> 9) & 1) << 5)); }
__device__ __forceinline__ void stage_rc(int b, int& R, int& C) { const int st = b / 1024, sb = b % 1024, swz = sb ^ (((sb >> 9) & 1) << 5); R = (st >> 1) * 16 + swz / 64; C = (st & 1) * 32 + (swz % 64) / 2; }
__device__ __forceinline__ int perm32(int rho) { const int n = rho >> 4, i = rho & 15; return 8 * (i >> 2) + 4 * n + (i & 3); }
struct Unit { const char* a; const char* b; int pm, pn, aux0, aux1; };
__device__ __forceinline__ const char* uptr(const char* p) { const unsigned long long v = (unsigned long long)p; const unsigned lo = __builtin_amdgcn_readfirstlane((unsigned)v), hi = __builtin_amdgcn_readfirstlane((unsigned)(v >> 32)); return (const char*)(const GAS char*)(((unsigned long long)hi << 32) | lo); }
__device__ __forceinline__ int xcd_remap(int L, int nwg) { const int q = nwg / NXCD, r = nwg % NXCD, xcd = L % NXCD, off = L / NXCD; return (xcd < r ? xcd * (q + 1) : r * (q + 1) + (xcd - r) * q) + off; }

struct DenseOrder {
    static constexpr bool GATHER = false;
    const char* A; const char* B; int nM, nN, nwg, G, c; size_t tA, tB; int amask, acol;
    __device__ void init(const void* A_, int lda, const void* B_, int ldb, int M, int N, int G_, int c_, int amask_ = 0, int acol_ = 0) {
        A = (const char*)A_; B = (const char*)B_; nM = M / BM; nN = N / BM; nwg = nM * nN; G = G_; c = c_; tA = (size_t)BM * lda * 2; tB = (size_t)BM * ldb * 2; amask = amask_; acol = acol_; }
    __device__ bool next(int i, Unit& u) const {
        const long L = (long)i * G + c; if (L >= nwg) return false;
        const int wgid = xcd_remap((int)L, nwg);
        const int nig = WGM * nN, gid = wgid / nig, fm = gid * WGM, gsz = (nM - fm) < WGM ? (nM - fm) : WGM;
        u.pm = __builtin_amdgcn_readfirstlane(fm + ((wgid % nig) % gsz)); u.pn = __builtin_amdgcn_readfirstlane((wgid % nig) / gsz); u.aux0 = 0; u.aux1 = 0;
        u.a = uptr(A + (size_t)u.pm * tA + (size_t)(u.pn & amask) * acol); u.b = uptr(B + (size_t)u.pn * tB); return true; }
    __device__ unsigned goff(const Unit&, int) const { return 0u; }
};

#define PG8_SA(b, h) (((b) * 2 + (h)) * HTB)
#define PG8_SB(b, h) ((4 + (b) * 2 + (h)) * HTB)
__device__ __forceinline__ void glds16(const char* sbase, unsigned voff, unsigned ldsaddr) { unsigned keep;
    asm volatile("s_mov_b32 %0, m0\n\ts_mov_b32 m0, %3\n\ts_nop 0\n\tglobal_load_lds_dwordx4 %1, %2\n\ts_mov_b32 m0, %0" : "=&s"(keep) : "v"(voff), "s"(sbase), "s"(ldsaddr) : "memory"); }
#ifndef PG8_ASM_DMA
#define PG8_ASM_DMA 0
#endif
#if PG8_ASM_DMA
#define PG8_GLDS(gp, voff, ldsoff) glds16((const char*)(gp), (voff), ldsbase + (unsigned)(ldsoff))
#else
#define PG8_GLDS(gp, voff, ldsoff) __builtin_amdgcn_global_load_lds((const unsigned*)((const char*)(gp) + (voff)), (LAS unsigned*)(lds + (ldsoff)), 16, 0, 0)
#endif
#define PG8_STAGE_B(bufoff, gbase) do { PG8_GLDS(gbase, voffB[0], (bufoff) + ldsw); PG8_GLDS(gbase, voffB[1], (bufoff) + ldsw + 8192); } while (0)
#define PG8_STAGE_A(bufoff, gbase, h, NX) do { if constexpr (Sched::GATHER) { \
        PG8_GLDS(gbase, ((NX) ? vAn[h][0] : vAc[h][0]), (bufoff) + ldsw); PG8_GLDS(gbase, ((NX) ? vAn[h][1] : vAc[h][1]), (bufoff) + ldsw + 8192); \
    } else { PG8_GLDS((const char*)(gbase) + (h) * hstepA, voffA[0], (bufoff) + ldsw); PG8_GLDS((const char*)(gbase) + (h) * hstepA, voffA[1], (bufoff) + ldsw + 8192); } } while (0)
#define PG8_LDA(dst, b, h) do { _Pragma("unroll") for (int m = 0; m < 4; ++m) _Pragma("unroll") for (int k = 0; k < 2; ++k) dst[m][k] = *(const LAS bf16x8*)(lds + PG8_SA(b, h) + aoff + m * 2048 + k * 1024); } while (0)
#define PG8_LDB(dst, b, h) do { _Pragma("unroll") for (int n = 0; n < 2; ++n) _Pragma("unroll") for (int k = 0; k < 2; ++k) dst[n][k] = *(const LAS bf16x8*)(lds + PG8_SB(b, h) + boff + n * 2048 + k * 1024); } while (0)
#define PG8_MMA(ai, bj, At, Bt) do { __builtin_amdgcn_s_setprio(1); _Pragma("unroll") for (int m = 0; m < 4; ++m) _Pragma("unroll") for (int n = 0; n < 2; ++n) _Pragma("unroll") for (int k = 0; k < 2; ++k) \
        acc[ai][bj][m][n] = __builtin_amdgcn_mfma_f32_16x16x32_bf16(Bt[n][k], At[m][k], acc[ai][bj][m][n], 0, 0, 0); __builtin_amdgcn_s_setprio(0); } while (0)
#define PG8_WAIT_V(n) asm volatile("s_waitcnt vmcnt(" #n ")" ::: "memory")
#define PG8_WAIT_L(n) asm volatile("s_waitcnt lgkmcnt(" #n ")" ::: "memory")
#define PG8_BAR __builtin_amdgcn_s_barrier()
#define PG8_SCHED __builtin_amdgcn_sched_barrier(0)

template <class Epi, class Sched>
__device__ __forceinline__ void gemm_phase(LAS uchar* lds, const Sched& S, const Epi& E, const int K, const int lda, const int ldb) {
    int tid = threadIdx.x; asm volatile("" : "+v"(tid));
    const int wid = __builtin_amdgcn_readfirstlane(tid >> 6), lane = tid & 63, wr = wid >> 2, wc = wid & 3; int fr = lane & 15, fq = lane >> 4;
    int nt = K / BK; asm volatile("" : "+s"(nt));
    unsigned voffA[2], voffB[2]; int Rs[2], Cs[2];
#pragma unroll
    for (int i = 0; i < 2; ++i) { int R, C; stage_rc(tid * 16 + i * 8192, R, C); const int Rb = Epi::PERM ? ((R & ~31) + perm32(R & 31)) : R;
        Rs[i] = R; Cs[i] = C; voffA[i] = (unsigned)(R * lda + C) * 2u; voffB[i] = (unsigned)(Rb * ldb + C) * 2u; }
    const size_t kstep = (size_t)(BK * 2);
    const size_t hstepA = (size_t)HALF * lda * 2, hstepB = (size_t)HALF * ldb * 2;
    const unsigned ldsw = (unsigned)wid * 1024u;
    const unsigned ldsbase = (unsigned)(uintptr_t)lds;
    const int aoff = lds_byte(wr * 64 + fr, fq * 8), boff = lds_byte(wc * 32 + fr, fq * 8);
    Unit cur, nxt; int ui = 0;
    if (!S.next(0, cur)) return;
    unsigned vAc[2][2], vAn[2][2];
#pragma unroll
    for (int h = 0; h < 2; ++h)
#pragma unroll
        for (int i = 0; i < 2; ++i) { vAc[h][i] = 0u; vAn[h][i] = 0u; }
    if constexpr (Sched::GATHER) {
#pragma unroll
        for (int h = 0; h < 2; ++h)
#pragma unroll
            for (int i = 0; i < 2; ++i) vAc[h][i] = S.goff(cur, h * HALF + Rs[i]) + (unsigned)Cs[i] * 2u;
    }
    f32x4 acc[2][2][4][2];
#pragma unroll
    for (int a = 0; a < 2; ++a)
#pragma unroll
        for (int b = 0; b < 2; ++b)
#pragma unroll
            for (int m = 0; m < 4; ++m)
#pragma unroll
                for (int n = 0; n < 2; ++n) acc[a][b][m][n] = (f32x4){0.f, 0.f, 0.f, 0.f};
    bf16x8 At[4][2], B0[2][2], B1[2][2];
    const char* cA = cur.a; const char* cB = cur.b;
    PG8_STAGE_B(PG8_SB(0, 0), cB); PG8_STAGE_B(PG8_SB(0, 1), cB + hstepB); PG8_STAGE_A(PG8_SA(0, 0), cA, 0, false); PG8_STAGE_A(PG8_SA(0, 1), cA, 1, false);
    if (wr == 1) PG8_BAR;
    PG8_WAIT_V(2); PG8_BAR;
    PG8_STAGE_B(PG8_SB(1, 0), cB + kstep); PG8_STAGE_A(PG8_SA(1, 0), cA + kstep, 0, false); PG8_STAGE_B(PG8_SB(1, 1), cB + hstepB + kstep);
    PG8_WAIT_V(6); PG8_BAR;
    for (;;) {
        const bool has_next = S.next(ui + 1, nxt);
        if constexpr (Sched::GATHER) { if (has_next) {
#pragma unroll
            for (int h = 0; h < 2; ++h)
#pragma unroll
                for (int i = 0; i < 2; ++i) vAn[h][i] = S.goff(nxt, h * HALF + Rs[i]) + (unsigned)Cs[i] * 2u; } }
        const char* nA = has_next ? nxt.a : cA; const char* nB = has_next ? nxt.b : cB;
        for (int t = 0; t < nt; t += 2) {
            const bool last = (t == nt - 2);
            const bool nx = last && has_next;
            const char* a1 = cA + (size_t)(t + 1) * kstep;
            const char* a2 = last ? nA : cA + (size_t)(t + 2) * kstep; const char* b2 = last ? nB : cB + (size_t)(t + 2) * kstep;
            const char* a3 = a2 + kstep; const char* b3 = b2 + kstep;
            PG8_LDB(B0, 0, 0); PG8_LDB(B1, 0, 1); PG8_SCHED; PG8_LDA(At, 0, 0); PG8_STAGE_A(PG8_SA(1, 1), a1, 1, false);
            PG8_WAIT_V(8); PG8_WAIT_L(0); PG8_BAR; PG8_MMA(0, 0, At, B0); PG8_MMA(0, 1, At, B1); PG8_BAR; PG8_SCHED;
            PG8_LDA(At, 0, 1); PG8_STAGE_B(PG8_SB(0, 0), b2); PG8_STAGE_B(PG8_SB(0, 1), b2 + hstepB); PG8_STAGE_A(PG8_SA(0, 0), a2, 0, nx);
            PG8_WAIT_V(8); PG8_WAIT_L(0); PG8_BAR; PG8_MMA(1, 0, At, B0); PG8_MMA(1, 1, At, B1); PG8_BAR; PG8_SCHED;
            PG8_LDB(B0, 1, 0); PG8_LDB(B1, 1, 1); PG8_SCHED; PG8_LDA(At, 1, 0); PG8_STAGE_A(PG8_SA(0, 1), a2, 1, nx);
            PG8_WAIT_V(8); PG8_WAIT_L(0); PG8_BAR; PG8_MMA(0, 0, At, B0); PG8_MMA(0, 1, At, B1); PG8_BAR; PG8_SCHED;
            PG8_LDA(At, 1, 1); PG8_STAGE_B(PG8_SB(1, 0), b3); PG8_STAGE_B(PG8_SB(1, 1), b3 + hstepB); PG8_STAGE_A(PG8_SA(1, 0), a3, 0, nx);
            PG8_WAIT_V(8); PG8_WAIT_L(0); PG8_BAR; PG8_MMA(1, 0, At, B0); PG8_MMA(1, 1, At, B1); PG8_BAR; PG8_SCHED;
        }
        if (wr == 0) PG8_BAR;
        E(acc, cur, wr, wc, fr, fq);
        if (!has_next) break;
#pragma unroll
        for (int a = 0; a < 2; ++a)
#pragma unroll
            for (int b = 0; b < 2; ++b)
#pragma unroll
                for (int m = 0; m < 4; ++m)
#pragma unroll
                    for (int n = 0; n < 2; ++n) acc[a][b][m][n] = (f32x4){0.f, 0.f, 0.f, 0.f};
        cur = nxt; cA = nA; cB = nB; ++ui;
        if constexpr (Sched::GATHER) {
#pragma unroll
            for (int h = 0; h < 2; ++h)
#pragma unroll
                for (int i = 0; i < 2; ++i) vAc[h][i] = vAn[h][i]; }
        if (wr == 1) PG8_BAR;
    }
    PG8_WAIT_V(0);
    PG8_BAR;
}
}

#ifndef ATT_SDEPTH
#define ATT_SDEPTH 1
#endif
namespace att {
constexpr int NW = 8, QBLK = 32, KVBLK = 64;
constexpr float SCALE = 0.088388347648318440f;
constexpr float THR = 8.f;
constexpr int LDQ = 1536, LDK = 1536, LDO = 1024;
constexpr size_t SHM_V = KVBLK * 128 * 2, SHM_K = KVBLK * 128 * 2, SHM_ATTN = 2 * SHM_V + 2 * SHM_K + NW * 64 * 4;
#define KSWZ(row, colB) ((row) * 256 + ((colB) ^ (((row) & 7) << 4)))
#define SBAR() __builtin_amdgcn_sched_barrier(0)
__device__ __forceinline__ int crow(int r, int hi) { return (r & 3) + 8 * (r >> 2) + 4 * hi; }
__device__ __forceinline__ void partialSM(f32x16& p0, f32x16& p1, float& m_reg, float& mn, float& alpha) {
  constexpr float C = SCALE * 1.4426950408889634f;
  float pmax = p0[0];
#pragma unroll
  for (int r = 1; r < 16; ++r) pmax = fmaxf(pmax, p0[r]);
#pragma unroll
  for (int r = 0; r < 16; ++r) pmax = fmaxf(pmax, p1[r]);
  { auto rr = __builtin_amdgcn_permlane32_swap(__float_as_uint(pmax), __float_as_uint(pmax), false, false);
    pmax = fmaxf(__uint_as_float(rr[0]), __uint_as_float(rr[1])); }
  if (__builtin_expect(__all(pmax - m_reg <= THR / SCALE), 1)) { mn = m_reg; alpha = 1.f; }
  else { mn = fmaxf(m_reg, pmax); alpha = __builtin_amdgcn_exp2f((m_reg - mn) * C); m_reg = mn; }
  float mnC = -mn * C;
#pragma unroll
  for (int r = 0; r < 16; ++r) p0[r] = fmaf(p0[r], C, mnC);
#pragma unroll
  for (int r = 0; r < 16; ++r) p1[r] = fmaf(p1[r], C, mnC);
#pragma unroll
  for (int r = 0; r < 16; ++r) p0[r] = __builtin_amdgcn_exp2f(p0[r]);
}
__device__ __forceinline__ void finishSM(f32x16& p0, f32x16& p1, float alpha, float& l_reg, bf16x8& pa0, bf16x8& pa1, bf16x8& pa2, bf16x8& pa3) {
#pragma unroll
  for (int r = 0; r < 16; ++r) p1[r] = __builtin_amdgcn_exp2f(p1[r]);
  float ps = 0;
#pragma unroll
  for (int r = 0; r < 16; ++r) ps += p0[r];
#pragma unroll
  for (int r = 0; r < 16; ++r) ps += p1[r];
  { auto rr = __builtin_amdgcn_permlane32_swap(__float_as_uint(ps), __float_as_uint(ps), false, false);
    ps = __uint_as_float(rr[0]) + __uint_as_float(rr[1]); }
  l_reg = l_reg * alpha + ps;
#define PK4(P, BASE, OUT) do { unsigned a0 = cvt_pk_bf16(P[BASE + 0], P[BASE + 1]), a1 = cvt_pk_bf16(P[BASE + 2], P[BASE + 3]);   \
    unsigned b0 = cvt_pk_bf16(P[BASE + 4], P[BASE + 5]), b1 = cvt_pk_bf16(P[BASE + 6], P[BASE + 7]);                              \
    auto r0 = __builtin_amdgcn_permlane32_swap(a0, b0, false, false); auto r1 = __builtin_amdgcn_permlane32_swap(a1, b1, false, false); \
    u32x4 w = {r0[0], r1[0], r0[1], r1[1]}; OUT = __builtin_bit_cast(bf16x8, w); } while (0)
  PK4(p0, 0, pa0); PK4(p0, 8, pa1); PK4(p1, 0, pa2); PK4(p1, 8, pa3);
#undef PK4
}
__device__ __forceinline__ void qkt(f32x16& p0, f32x16& p1, const bf16_t* Ks, const bf16x8* qr, int r32, int hi) {
  p0 = f32x16{}; p1 = f32x16{};
#pragma unroll
  for (int d0 = 0; d0 < 8; ++d0) { int cb = (d0 * 16 + hi * 8) * 2;
    bf16x8 b0 = *reinterpret_cast<const bf16x8*>((const char*)Ks + KSWZ(r32, cb));
    bf16x8 b1 = *reinterpret_cast<const bf16x8*>((const char*)Ks + KSWZ(32 + r32, cb));
    p0 = __builtin_amdgcn_mfma_f32_32x32x16_bf16(b0, qr[d0], p0, 0, 0, 0);
    p1 = __builtin_amdgcn_mfma_f32_32x32x16_bf16(b1, qr[d0], p1, 0, 0, 0); }
}
__device__ __forceinline__ int v_st(int k, int c) { const int kk = (k & ~0xC) | ((k & 4) << 1) | ((k & 8) >> 1); return ((kk >> 3) * 4 + (c >> 5)) * 512 + ((kk & 7) * 32 + (c & 31)) * 2; }
__device__ __forceinline__ int v_rd_base(int lane) { return ((lane & 3) << 3) | (((lane >> 2) & 3) << 6) | (((lane >> 4) & 1) << 5) | (((lane >> 5) & 1) << 8); }
constexpr int v_rd_off(int d0, int ks, int half) { return d0 * 512 + ks * 4096 + half * 2048; }
template <int OFF> __device__ __forceinline__ s16x4 tr_read(int vb) {
  s16x4 r; asm volatile("ds_read_b64_tr_b16 %0, %1 offset:%2" : "=&v"(r) : "v"(vb), "i"(OFF) : "memory"); return r;
}
template <int D0> __device__ __forceinline__ void pv_one(f32x16& od, int vb, bf16x8 pa0, bf16x8 pa1, bf16x8 pa2, bf16x8 pa3) {
  const s16x4 l0 = tr_read<v_rd_off(D0, 0, 0)>(vb), h0 = tr_read<v_rd_off(D0, 0, 1)>(vb), l1 = tr_read<v_rd_off(D0, 1, 0)>(vb), h1 = tr_read<v_rd_off(D0, 1, 1)>(vb);
  const s16x4 l2 = tr_read<v_rd_off(D0, 2, 0)>(vb), h2 = tr_read<v_rd_off(D0, 2, 1)>(vb), l3 = tr_read<v_rd_off(D0, 3, 0)>(vb), h3 = tr_read<v_rd_off(D0, 3, 1)>(vb);
  asm volatile("s_waitcnt lgkmcnt(0)" ::: "memory"); SBAR();
#define PK(L, H) (bf16x8){L[0], L[1], L[2], L[3], H[0], H[1], H[2], H[3]}
  od = __builtin_amdgcn_mfma_f32_32x32x16_bf16(pa0, PK(l0, h0), od, 0, 0, 0);
  od = __builtin_amdgcn_mfma_f32_32x32x16_bf16(pa1, PK(l1, h1), od, 0, 0, 0);
  od = __builtin_amdgcn_mfma_f32_32x32x16_bf16(pa2, PK(l2, h2), od, 0, 0, 0);
  od = __builtin_amdgcn_mfma_f32_32x32x16_bf16(pa3, PK(l3, h3), od, 0, 0, 0);
#undef PK
}
__device__ __forceinline__ void pv_d0(f32x16* o, int vb, bf16x8 pa0, bf16x8 pa1, bf16x8 pa2, bf16x8 pa3) {
  pv_one<0>(o[0], vb, pa0, pa1, pa2, pa3); pv_one<1>(o[1], vb, pa0, pa1, pa2, pa3); pv_one<2>(o[2], vb, pa0, pa1, pa2, pa3); pv_one<3>(o[3], vb, pa0, pa1, pa2, pa3);
}
__device__ __forceinline__ void attn_dense_body(const bf16_t* Qb, const bf16_t* Kh, const bf16_t* Vh, bf16_t* Ob, int seq, char* lds, const int tid) {
  const int wid = tid >> 6, lane = tid & 63, r32 = lane & 31, hi = lane >> 5;
  bf16_t* V_lds = (bf16_t*)lds; bf16_t* K_lds = (bf16_t*)(lds + 2 * SHM_V);
  float* ws = (float*)(lds + 2 * SHM_V + 2 * SHM_K) + wid * 64; float* li_l = ws; float* al_l = ws + 32;
  float m_reg = -1e30f, l_reg = 0; f32x16 o[4] = {}; bf16x8 qr[8];
  const bf16_t* Qw = Qb + (long)(wid * QBLK + r32) * LDQ + hi * 8;
#pragma unroll
  for (int d0 = 0; d0 < 8; ++d0) qr[d0] = *reinterpret_cast<const bf16x8*>(Qw + d0 * 16);
  const int sr = tid >> 4, sc = (tid & 15) * 8, vst0 = v_st(sr, sc), vst1 = v_st(32 + sr, sc);
  const int vb0 = (int)(uintptr_t)V_lds + v_rd_base(lane);
  struct { bf16x8 vs0, vs1, ks0, ks1; } sr_[ATT_SDEPTH];
  const unsigned vo0 = (unsigned)(sr * LDK + sc) * 2u, vo1 = (unsigned)((32 + sr) * LDK + sc) * 2u;
  const long vdelta = (const char*)Vh - (const char*)Kh;
#define SLOAD(i, k0) do { const char* kb_ = (const char*)Kh + (size_t)(k0) * (LDK * 2); const char* vb_ = kb_ + vdelta; \
    sr_[i].vs0 = *reinterpret_cast<const bf16x8*>(vb_ + vo0); sr_[i].vs1 = *reinterpret_cast<const bf16x8*>(vb_ + vo1); \
    sr_[i].ks0 = *reinterpret_cast<const bf16x8*>(kb_ + vo0); sr_[i].ks1 = *reinterpret_cast<const bf16x8*>(kb_ + vo1); } while (0)
#define SWRITE(b, i) do { *(bf16x8*)((char*)V_lds + (b) * SHM_V + vst0) = sr_[i].vs0;          \
    *(bf16x8*)((char*)V_lds + (b) * SHM_V + vst1) = sr_[i].vs1; int kc = sc * 2;               \
    *(bf16x8*)((char*)K_lds + (b) * SHM_K + KSWZ(sr, kc)) = sr_[i].ks0;                       \
    *(bf16x8*)((char*)K_lds + (b) * SHM_K + KSWZ(32 + sr, kc)) = sr_[i].ks1; } while (0)
#define SWAIT() do { if constexpr (ATT_SDEPTH == 2) asm volatile("s_waitcnt vmcnt(4)" ::: "memory"); else asm volatile("s_waitcnt vmcnt(0)" ::: "memory"); } while (0)
#define RESC(a) do { if (__any((a) < 1.f)) { if (hi == 0) al_l[r32] = (a); asm volatile("s_waitcnt lgkmcnt(0)" ::: "memory"); \
    _Pragma("unroll") for (int d = 0; d < 4; ++d) _Pragma("unroll") for (int r = 0; r < 16; ++r) o[d][r] *= al_l[crow(r, hi)]; } } while (0)
  f32x16 pA0, pA1, pB0, pB1; float mnA, mnB, alA, alB; bf16x8 pa0, pa1, pa2, pa3; const int NT = seq / KVBLK;
  constexpr int SE = 0, SO = ATT_SDEPTH - 1;
  SLOAD(SE, 0); asm volatile("s_waitcnt vmcnt(0)" ::: "memory"); SWRITE(0, SE); __syncthreads();
  qkt(pA0, pA1, K_lds, qr, r32, hi); partialSM(pA0, pA1, m_reg, mnA, alA);
  SLOAD(SO, KVBLK); if constexpr (ATT_SDEPTH == 2) { if (2 < NT) SLOAD(SE, 2 * KVBLK); }
  SWAIT(); SWRITE(1, SO); __syncthreads();
  for (int j = 1; j + 1 < NT; j += 2) {
    SBAR(); qkt(pB0, pB1, (bf16_t*)((char*)K_lds + SHM_K), qr, r32, hi);
    finishSM(pA0, pA1, alA, l_reg, pa0, pa1, pa2, pa3); SBAR();
    SLOAD(SO, (j + ATT_SDEPTH) * KVBLK); SBAR();
    pv_d0(o, vb0, pa0, pa1, pa2, pa3); partialSM(pB0, pB1, m_reg, mnB, alB);
    __syncthreads(); SWAIT(); SWRITE(0, SE);
    RESC(alB); __syncthreads();
    SBAR(); qkt(pA0, pA1, K_lds, qr, r32, hi);
    finishSM(pB0, pB1, alB, l_reg, pa0, pa1, pa2, pa3); SBAR();
    if (ATT_SDEPTH == 1 || j + 3 < NT) SLOAD(SE, (j + 1 + ATT_SDEPTH) * KVBLK); SBAR();
    pv_d0(o, vb0 + (int)SHM_V, pa0, pa1, pa2, pa3); partialSM(pA0, pA1, m_reg, mnA, alA);
    __syncthreads(); SWAIT(); SWRITE(1, SO);
    RESC(alA); __syncthreads();
  }
  SBAR(); qkt(pB0, pB1, (bf16_t*)((char*)K_lds + SHM_K), qr, r32, hi);
  finishSM(pA0, pA1, alA, l_reg, pa0, pa1, pa2, pa3); SBAR();
  pv_d0(o, vb0, pa0, pa1, pa2, pa3); partialSM(pB0, pB1, m_reg, mnB, alB);
  __syncthreads(); RESC(alB);
  finishSM(pB0, pB1, alB, l_reg, pa0, pa1, pa2, pa3); SBAR();
  pv_d0(o, vb0 + (int)SHM_V, pa0, pa1, pa2, pa3);
  if (hi == 0) li_l[r32] = l_reg; asm volatile("s_waitcnt lgkmcnt(0)" ::: "memory");
  float rli[16];
#pragma unroll
  for (int r = 0; r < 16; ++r) rli[r] = __builtin_amdgcn_rcpf(li_l[crow(r, hi)]);
  bf16_t* Ow = Ob + (long)(wid * QBLK) * LDO;
#pragma unroll
  for (int r = 0; r < 16; ++r) { int orow = crow(r, hi);
#pragma unroll
    for (int d0 = 0; d0 < 4; ++d0) Ow[(long)orow * LDO + d0 * 32 + r32] = (bf16_t)f2bf(o[d0][r] * rli[r]); }
#undef SLOAD
#undef SWRITE
#undef SWAIT
#undef RESC
}
}

#define XB_TMO      128
#define XB_XCNT(j)  (256  + 64 * (j))
#define XB_XSUB(j)  (1280 + 64 * (j))
#define XB_XGEN(j)  (2304 + 64 * (j))
#define XB_TOP      3328
#define XB_TOPGEN   3392
#define XB_SPIN_CAP (1u << 22)
__device__ __forceinline__ unsigned xb_ld(unsigned* p)              { return __hip_atomic_load(p, __ATOMIC_RELAXED, __HIP_MEMORY_SCOPE_AGENT); }
__device__ __forceinline__ unsigned xb_add(unsigned* p, unsigned v) { return __hip_atomic_fetch_add(p, v, __ATOMIC_RELAXED, __HIP_MEMORY_SCOPE_AGENT); }
__device__ __forceinline__ unsigned xb_xcc_id() { return (unsigned)__builtin_amdgcn_s_getreg((3 << 11) | 20) & 0xFu; }
#define XB_SPIN(cond, bar) do { unsigned _sp = 0; while (cond) { __builtin_amdgcn_s_sleep(1); \
    if ((++_sp & 255u) == 0u) { if (xb_ld(&(bar)[XB_TMO])) break; if (_sp > XB_SPIN_CAP) { atomicAdd(&(bar)[XB_TMO], 1u); break; } } } } while (0)
struct XcdBarrier { unsigned* bar; unsigned x; volatile LAS unsigned* st; };
__device__ __forceinline__ XcdBarrier xcd_barrier_post(unsigned* bar, volatile LAS unsigned* st) {
    XcdBarrier b; b.bar = bar; b.x = xb_xcc_id(); b.st = st;
    if (threadIdx.x == 0) (void)xb_add(&bar[XB_XCNT(b.x)], 1u);
    return b;
}
__device__ __forceinline__ void xcd_barrier_complete(unsigned* bar, unsigned x, unsigned& nloc, unsigned& nx) {
    const unsigned G = gridDim.x * gridDim.y * gridDim.z;
    unsigned sum, cnt, mine, sp = 0u;
    for (;;) {
        sum = 0u; cnt = 0u; mine = 0u;
#pragma unroll
        for (unsigned j = 0; j < 16; ++j) { const unsigned c = xb_ld(&bar[XB_XCNT(j)]); sum += c; cnt += (c > 0u) ? 1u : 0u; mine = (j == x) ? c : mine; }
        if (sum == G) break;
        __builtin_amdgcn_s_sleep(1);
        if ((++sp & 255u) == 0u) { if (xb_ld(&bar[XB_TMO])) break; if (sp > XB_SPIN_CAP) { atomicAdd(&bar[XB_TMO], 1u); break; } }
    }
    nloc = mine > 0u ? mine : 1u; nx = cnt > 0u ? cnt : 1u;
}
__device__ __forceinline__ void xcd_barrier(const XcdBarrier& b_) {
    XcdBarrier b; b.bar = b_.bar; b.st = b_.st; b.x = xb_xcc_id();
    asm volatile("s_waitcnt vmcnt(0)" ::: "memory");
    __syncthreads();
    if (threadIdx.x == 0) {
        unsigned* bar = b.bar;
        __builtin_amdgcn_s_waitcnt(0);
        unsigned nloc = b.st[0], nx = b.st[1];
        if (nloc == 0u) { xcd_barrier_complete(bar, b.x, nloc, nx); b.st[0] = nloc; b.st[1] = nx; }
        const unsigned old = xb_add(&bar[XB_XSUB(b.x)], 1u);
        const unsigned gen = old / nloc;
        if (old + 1u == (gen + 1u) * nloc) {
            __builtin_amdgcn_fence(__ATOMIC_RELEASE, "agent");
            asm volatile("s_waitcnt vmcnt(0)" ::: "memory");
            const unsigned og = xb_add(&bar[XB_TOP], 1u);
            const unsigned tg = og / nx;
            if (og + 1u == (tg + 1u) * nx) xb_add(&bar[XB_TOPGEN], 1u);
            else XB_SPIN(xb_ld(&bar[XB_TOPGEN]) == tg, bar);
            __builtin_amdgcn_fence(__ATOMIC_ACQUIRE, "agent");
            xb_add(&bar[XB_XGEN(b.x)], 1u);
            asm volatile("s_waitcnt vmcnt(0)" ::: "memory");
        } else {
            XB_SPIN(xb_ld(&bar[XB_XGEN(b.x)]) == gen, bar);
            __builtin_amdgcn_fence(__ATOMIC_ACQUIRE, "agent");
            asm volatile("s_waitcnt vmcnt(0)" ::: "memory");
        }
    }
    __syncthreads();
}

struct Args { const float* in[34]; float* out; uchar* ws; int ph_lo, ph_hi; };
enum { I_X = 0, I_C, I_CTX, I_CCTX, I_ADAW, I_ADAB, I_NMG, I_NFG, I_RGWIN, I_RGCW, I_RGCB, I_RGWA, I_RGBA, I_RGWI, I_RGBI, I_RGLAM, I_RGWOUT,
       I_ATQKV, I_ATQG, I_ATKG, I_ATWO, I_CMWIN, I_CMLNG, I_CMLNB, I_CMWS, I_CMBS, I_CMWOUT, I_MWG, I_MBG, I_MWR, I_MBR, I_MWGATE, I_MWUP, I_MWDOWN };

__device__ __forceinline__ const void* opaque_uniform_ptr(const void* p) { const unsigned long long v = (unsigned long long)p; unsigned lo = (unsigned)v, hi = (unsigned)(v >> 32); asm volatile("" : "+v"(lo), "+v"(hi));
    lo = __builtin_amdgcn_readfirstlane(lo); hi = __builtin_amdgcn_readfirstlane(hi); return (const void*)(const GAS char*)(((unsigned long long)hi << 32) | lo); }
__device__ __forceinline__ int opaque_uniform_int(int x) { asm volatile("" : "+v"(x)); return __builtin_amdgcn_readfirstlane(x); }
struct Frame {
    LAS uchar* lds; char* ldsg;
    int tid, lane, wave, G, bid;
    uchar* ws; float* out;
};
__device__ __forceinline__ const float* inp(const Frame& F, int i) { const unsigned long long v = *(const LAS unsigned long long*)(F.lds + LDSCTL_OFF + 576 + i * 8);
    const unsigned lo = __builtin_amdgcn_readfirstlane((unsigned)v), hi = __builtin_amdgcn_readfirstlane((unsigned)(v >> 32)); return (const float*)(const GAS float*)(((unsigned long long)hi << 32) | lo); }
__device__ __forceinline__ float wave16_sum(float v) {
    v += __int_as_float(__builtin_amdgcn_update_dpp(0, __float_as_int(v), 0xB1, 0xF, 0xF, true));
    v += __int_as_float(__builtin_amdgcn_update_dpp(0, __float_as_int(v), 0x4E, 0xF, 0xF, true));
    v += __int_as_float(__builtin_amdgcn_update_dpp(0, __float_as_int(v), 0x141, 0xF, 0xF, true));
    v += __int_as_float(__builtin_amdgcn_update_dpp(0, __float_as_int(v), 0x140, 0xF, 0xF, true));
    return v; }

__device__ __forceinline__ void tr_item(const float* W, int ldw, bf16_t* WT, int ldt, int k0, int n0, int dstrow0, LAS uchar* scr, int lane) {
    const int kr = lane >> 4, nc = (lane & 15) * 4;
    const float* src = W + (size_t)(k0 + kr) * ldw + n0 + nc;
    f32x4 v[16];
#pragma unroll
    for (int i = 0; i < 16; ++i) v[i] = *(const f32x4*)(src + (size_t)(4 * i) * ldw);
#pragma unroll
    for (int i = 0; i < 16; ++i) { u32x2 o; o.x = pk2(v[i].x, v[i].y); o.y = pk2(v[i].z, v[i].w); *(LAS u32x2*)(scr + (4 * i + kr) * 128 + nc * 2) = o; }
    asm volatile("s_waitcnt lgkmcnt(0)" ::: "memory");
    const int g = lane >> 4, q = (lane >> 2) & 3, p = lane & 3;
    const int vb = (int)(uintptr_t)scr + q * 128 + g * 32 + p * 8;
    s16x4 t[16];
#define TRR(r) t[r] = att::tr_read<(r) * 512>(vb)
    TRR(0); TRR(1); TRR(2); TRR(3); TRR(4); TRR(5); TRR(6); TRR(7); TRR(8); TRR(9); TRR(10); TRR(11); TRR(12); TRR(13); TRR(14); TRR(15);
#undef TRR
    asm volatile("s_waitcnt lgkmcnt(0)" ::: "memory"); __builtin_amdgcn_sched_barrier(0);
    bf16_t* dst = WT + (size_t)(dstrow0 + g * 16 + (lane & 15)) * ldt + k0;
#pragma unroll
    for (int j = 0; j < 8; ++j) { const bf16x8 o = {t[2 * j][0], t[2 * j][1], t[2 * j][2], t[2 * j][3], t[2 * j + 1][0], t[2 * j + 1][1], t[2 * j + 1][2], t[2 * j + 1][3]}; *(bf16x8*)(dst + 8 * j) = o; }
}
__device__ __forceinline__ bool tr_group(int& r, const float* W, int K, int N, int nmat, bf16_t* WT, int ldt, size_t dst_mat_stride, int mode, LAS uchar* scr, int lane) {
    const int per = (K / 64) * (N / 64), tot = per * nmat;
    if (r >= tot) { r -= tot; return false; }
    const int mat = r / per, it = r % per, nblk = N / 64, kb = it / nblk, nb = it % nblk, n0 = nb * 64;
    int drow = n0;
    if (mode == 1) drow = (n0 >> 7) * 256 + (n0 & 127);
    else if (mode == 2) drow = (n0 >> 7) * 256 + 128 + (n0 & 127);
    tr_item(W + (size_t)mat * K * N, N, WT + (size_t)mat * dst_mat_stride, ldt, kb * 64, n0, drow, scr, lane);
    return true;
}
__device__ __forceinline__ void p0_prologue(Frame& F) {
    uchar* ws = F.ws;
    {
        LAS float* act = (LAS float*)(F.lds);
        LAS float* red = (LAS float*)(F.lds + 5 * 1024 * 4);
        bool have = false; const float* pC = inp(F, I_C); const float* pCC = inp(F, I_CCTX); const float* pADAW = inp(F, I_ADAW); const float* pADAB = inp(F, I_ADAB);
        for (int it = F.bid; it < DEPTH * 24; it += F.G) {
            if (!have) { for (int i = F.tid; i < 5 * 1024; i += 512) { const int s = i >> 10, k = i & 1023; const float v = s < 4 ? pC[s * 1024 + k] : pCC[k]; act[i] = v / (1.f + __expf(-v)); } have = true; __syncthreads(); }
            const int l = it / 24, cb = it % 24;
            const float* W = pADAW + (size_t)l * 1024 * NMODV + cb * 256 + F.lane * 4;
            f32x4 a[5];
#pragma unroll
            for (int s = 0; s < 5; ++s) a[s] = (f32x4){0.f, 0.f, 0.f, 0.f};
            const int kbase = F.wave * 128;
#pragma unroll 8
            for (int k = 0; k < 128; ++k) { const f32x4 w = *(const f32x4*)(W + (size_t)(kbase + k) * NMODV);
#pragma unroll
                for (int s = 0; s < 5; ++s) a[s] += w * act[s * 1024 + kbase + k]; }
#pragma unroll
            for (int s = 0; s < 5; ++s) *(LAS f32x4*)(red + (F.wave * 5 + s) * 256 + F.lane * 4) = a[s];
            __syncthreads();
            for (int i = F.tid; i < 5 * 256; i += 512) { const int s = i >> 8, c = i & 255; float v = pADAB[l * NMODV + cb * 256 + c];
#pragma unroll
                for (int w = 0; w < 8; ++w) v += red[(w * 5 + s) * 256 + c];
                ((float*)(ws + WS_MOD))[(l * 5 + s) * NMODV + cb * 256 + c] = v; }
            __syncthreads();
        }
        __syncthreads();
    }
    {
        LAS uchar* scr = F.lds + F.wave * 8192;
        const int gw = F.bid * 8 + F.wave, NGW = F.G * 8;
        constexpr int NITEMS = 3 * 16384 + 1024 + 1024 + 512 + 512 + 384 + 256 + 128 + 128;
        const float* pMWGATE = inp(F, I_MWGATE); const float* pMWUP = inp(F, I_MWUP); const float* pMWDOWN = inp(F, I_MWDOWN); const float* pRGWIN = inp(F, I_RGWIN); const float* pCMWIN = inp(F, I_CMWIN);
        const float* pRGWOUT = inp(F, I_RGWOUT); const float* pCMWOUT = inp(F, I_CMWOUT); const float* pATQKV = inp(F, I_ATQKV); const float* pATWO = inp(F, I_ATWO); const float* pRGWA = inp(F, I_RGWA); const float* pRGWI = inp(F, I_RGWI);
        for (int it = gw; it < NITEMS; it += NGW) {
            int r = it;
            if (tr_group(r, pMWGATE, 1024, 512, 128, (bf16_t*)(ws + WS_W_E1), 1024, (size_t)1024 * 1024, 1, scr, F.lane)) continue;
            if (tr_group(r, pMWUP, 1024, 512, 128, (bf16_t*)(ws + WS_W_E1), 1024, (size_t)1024 * 1024, 2, scr, F.lane)) continue;
            if (tr_group(r, pMWDOWN, 512, 1024, 128, (bf16_t*)(ws + WS_W_E2), 512, (size_t)1024 * 512, 0, scr, F.lane)) continue;
            if (tr_group(r, pRGWIN, 1024, 2048, 2, (bf16_t*)(ws + WS_W_RGIN), 1024, (size_t)2048 * 1024, 0, scr, F.lane)) continue;
            if (tr_group(r, pCMWIN, 1024, 4096, 1, (bf16_t*)(ws + WS_W_CMIN), 1024, 0, 0, scr, F.lane)) continue;
            if (tr_group(r, pRGWOUT, 1024, 1024, 2, (bf16_t*)(ws + WS_W_RGOUT), 1024, (size_t)1024 * 1024, 0, scr, F.lane)) continue;
            if (tr_group(r, pCMWOUT, 2048, 1024, 1, (bf16_t*)(ws + WS_W_CMOUT), 2048, 0, 0, scr, F.lane)) continue;
            if (tr_group(r, pATQKV, 1024, 1536, 1, (bf16_t*)(ws + WS_W_QKV), 1024, 0, 0, scr, F.lane)) continue;
            if (tr_group(r, pATWO, 1024, 1024, 1, (bf16_t*)(ws + WS_W_AO), 1024, 0, 0, scr, F.lane)) continue;
            if (r < 128) { const int mat = r / 4, itx = r % 4, kb = itx / 2, nb = itx % 2;
                tr_item(pRGWA + (size_t)mat * 128 * 128, 128, (bf16_t*)(ws + WS_W_RGG) + (size_t)mat * 256 * 128, 128, kb * 64, nb * 64, nb * 64, scr, F.lane); continue; }
            r -= 128;
            { const int mat = r / 4, itx = r % 4, kb = itx / 2, nb = itx % 2;
                tr_item(pRGWI + (size_t)mat * 128 * 128, 128, (bf16_t*)(ws + WS_W_RGG) + (size_t)mat * 256 * 128, 128, kb * 64, nb * 64, 128 + nb * 64, scr, F.lane); }
        }
    }
    {
        const int gt = F.bid * 512 + F.tid, NGT = F.G * 512;
        { const float* pctx = inp(F, I_CTX); const float* px = inp(F, I_X);
          for (int i0 = gt; i0 < T * 256; i0 += 4 * NGT) { f32x4 v[4];
#pragma unroll
            for (int q = 0; q < 4; ++q) { const int i = i0 + q * NGT; if (i < T * 256) { const int row = i >> 8, c4 = i & 255, b = row / SB, s = row - b * SB;
                const float* src = s < CTX ? pctx + ((size_t)(b * CTX + s) << 10) : px + ((size_t)(b * SEQ + s - CTX) << 10); v[q] = ((const f32x4*)src)[c4]; } }
#pragma unroll
            for (int q = 0; q < 4; ++q) { const int i = i0 + q * NGT; if (i < T * 256) ((f32x4*)(ws + WS_X))[i] = v[q]; } } }
        for (int i = gt; i < 8 * 128 * 128 / 4; i += NGT) { const f32x4 v = ((const f32x4*)inp(F, I_CMWS))[i]; u32x2 o; o.x = pk2(v.x, v.y); o.y = pk2(v.z, v.w); ((u32x2*)(ws + WS_W_CMS))[i] = o; }
        for (int i = gt; i < 2 * 2 * D; i += NGT) { const float* plam = inp(F, I_RGLAM); ((float*)(ws + WS_SPL))[i] = -8.f * log1pf(expf(-plam[i])); }
        for (int i = gt; i < 64 * 32; i += NGT) { const int pos = i >> 5, f = i & 31; const float inv = powf(10000.f, -(float)f * 2.0f / 64.0f); const float ang = (float)pos * inv;
            ((f32x2*)(ws + WS_ROPE))[i] = (f32x2){cosf(ang), sinf(ang)}; }
    }
}

template <bool ROUTE, bool addY>
__device__ __forceinline__ void norm_phase(Frame& F, int l, const float* gvec, int shift_i, bool skip_ctx_route, bool dry) {
    uchar* ws = F.ws;
    float* X = (float*)(ws + WS_X); const float* Y1 = (const float*)(ws + WS_Y1); bf16_t* H = (bf16_t*)(ws + WS_H);
    const float* MOD = (const float*)(ws + WS_MOD) + (size_t)l * 5 * NMODV;
    LAS float* wr = (LAS float*)F.lds;
    if constexpr (ROUTE) {
        const float* wg = inp(F, I_MWG) + (size_t)l * 1024 * 4; const float* wrt = inp(F, I_MWR) + (size_t)l * 1024 * 32;
        for (int i0 = F.tid; i0 < 1024 * 9; i0 += 512 * 6) { f32x4 v[6];
#pragma unroll
            for (int u = 0; u < 6; ++u) { const int idx = i0 + u * 512; const int k = idx / 9, q = idx - k * 9; v[u] = q == 0 ? *(const f32x4*)(wg + k * 4) : *(const f32x4*)(wrt + k * 32 + (q - 1) * 4); }
#pragma unroll
            for (int u = 0; u < 6; ++u) { const int idx = i0 + u * 512; const int k = idx / 9, q = idx - k * 9;
                wr[(4 * q + 0) * 1024 + k] = v[u].x; wr[(4 * q + 1) * 1024 + k] = v[u].y; wr[(4 * q + 2) * 1024 + k] = v[u].z; wr[(4 * q + 3) * 1024 + k] = v[u].w; } }
        __syncthreads();
    }
    const int i16 = F.lane & 15, grp = F.lane >> 4;
    const float* bg = nullptr; const float* br = nullptr; if constexpr (ROUTE) { bg = inp(F, I_MBG) + l * 4; br = inp(F, I_MBR) + l * 32; }
    for (int tok = (F.bid * 8 + F.wave) * 4 + grp; tok < T; tok += F.G * 32) {
        asm volatile("" ::: "memory");
        const int sidx = sidx_of_row(tok);
        f32x4 x[16];
        float ss = 0.f;
#pragma unroll
        for (int j = 0; j < 16; ++j) { x[j] = *(const f32x4*)(X + (size_t)tok * D + 64 * j + 4 * i16);
            if (addY) { x[j] += *(const f32x4*)(Y1 + (size_t)tok * D + 64 * j + 4 * i16); *(f32x4*)(X + (size_t)tok * D + 64 * j + 4 * i16) = x[j]; }
            ss += x[j].x * x[j].x + x[j].y * x[j].y + x[j].z * x[j].z + x[j].w * x[j].w; }
        ss = wave16_sum(ss);
        const float rstd = rsqrtf(ss * (1.f / D) + NORM_EPS);
        const float* shp = MOD + (size_t)sidx * NMODV + shift_i * D; const float* scp = shp + D;
#pragma unroll
        for (int j = 0; j < 16; ++j) { const int c = 64 * j + 4 * i16; const f32x4 g = *(const f32x4*)(gvec + c), sh = *(const f32x4*)(shp + c), sc = *(const f32x4*)(scp + c);
            x[j] = x[j] * rstd * g * (sc + 1.f) + sh;
            u32x2 o; o.x = pk2(x[j].x, x[j].y); o.y = pk2(x[j].z, x[j].w); *(u32x2*)(H + (size_t)tok * D + c) = o; }
        if constexpr (ROUTE) {
            LAS float* lgs = (LAS float*)(F.lds + LDSCTL_OFF + 1024) + (F.wave * 4 + grp) * 40;
#pragma unroll 1
            for (int o = 0; o < 36; ++o) { float a0 = 0.f, a1 = 0.f;
#pragma unroll
                for (int j = 0; j < 16; j += 2) { const f32x4 w0 = *(const LAS f32x4*)(wr + o * 1024 + 64 * j + 4 * i16), w1 = *(const LAS f32x4*)(wr + o * 1024 + 64 * j + 64 + 4 * i16);
                    a0 += x[j].x * w0.x + x[j].y * w0.y + x[j].z * w0.z + x[j].w * w0.w; a1 += x[j + 1].x * w1.x + x[j + 1].y * w1.y + x[j + 1].z * w1.z + x[j + 1].w * w1.w; }
                a0 = wave16_sum(a0 + a1); if (i16 == 0) lgs[o] = a0; }
            asm volatile("s_waitcnt lgkmcnt(0)" ::: "memory");
            const float gl0 = lgs[0] + bg[0], gl1 = lgs[1] + bg[1], gl2 = lgs[2] + bg[2], gl3 = lgs[3] + bg[3];
            int gs = 0; float gm = gl0;
            if (gl1 > gm) { gm = gl1; gs = 1; }
            if (gl2 > gm) { gm = gl2; gs = 2; }
            if (gl3 > gm) { gm = gl3; gs = 3; }
            const float den = __expf(gl0 - gm) + __expf(gl1 - gm) + __expf(gl2 - gm) + __expf(gl3 - gm);
            const float pg = 1.f / den;
            float el[8];
#pragma unroll
            for (int e = 0; e < 8; ++e) el[e] = lgs[4 + gs * 8 + e] + br[gs * 8 + e];
            int i0 = 0; float v0 = el[0];
#pragma unroll
            for (int e = 1; e < 8; ++e) if (el[e] > v0) { v0 = el[e]; i0 = e; }
            int i1 = -1; float v1 = -3.0e38f;
#pragma unroll
            for (int e = 0; e < 8; ++e) if (e != i0 && el[e] > v1) { v1 = el[e]; i1 = e; }
            const float p0 = 1.f / (1.f + __expf(v1 - v0));
            const float w0 = p0 * pg, w1 = (1.f - p0) * pg;
            const bool do_route = !(skip_ctx_route && sidx == 4) && !dry;
            if (i16 == 0 && do_route) {
                const int e0 = gs * 8 + i0, e1 = gs * 8 + i1;
                unsigned* cnt = (unsigned*)(ws + WS_CTL) + CW_CNT + l * 32 * 64;
                const unsigned q0 = atomicAdd(cnt + e0 * 64, 1u), q1 = atomicAdd(cnt + e1 * 64, 1u);
                int* BK = (int*)(ws + WS_BK); float* TW = (float*)(ws + WS_TW);
                BK[(size_t)e0 * T + q0] = tok * 2; BK[(size_t)e1 * T + q1] = tok * 2 + 1;
                TW[tok * 2] = w0; TW[tok * 2 + 1] = w1;
            }
        }
    }
}

__device__ __forceinline__ void st8(bf16_t* p, f32x4 v0, f32x4 v1) { u32x4 w; w.x = cvt_pk_bf16(v0[0], v0[1]); w.y = cvt_pk_bf16(v0[2], v0[3]); w.z = cvt_pk_bf16(v1[0], v1[1]); w.w = cvt_pk_bf16(v1[2], v1[3]); *(u32x4*)p = w; }
#define EPI_ROWS(ai, m) (u.pm * 256 + (ai) * 128 + wr * 64 + (m) * 16 + fr)

struct EpiRgIn { static constexpr bool PERM = true; bf16_t* GG; bf16_t* XB;
    __device__ __forceinline__ void operator()(const f32x4 (&acc)[2][2][4][2], const pg8::Unit& u, int wr, int wc, int fr, int fq) const {
        const bool isg = u.pn < 4; bf16_t* base = isg ? GG : XB; const int ct = (u.pn & 3) * 256 + wc * 32 + 8 * fq;
#pragma unroll
        for (int ai = 0; ai < 2; ++ai)
#pragma unroll
            for (int m = 0; m < 4; ++m) { bf16_t* rowp = base + (size_t)EPI_ROWS(ai, m) * D + ct;
#pragma unroll
                for (int bj = 0; bj < 2; ++bj) { f32x4 v0 = acc[ai][bj][m][0], v1 = acc[ai][bj][m][1];
                    if (isg) {
#pragma unroll
                        for (int e = 0; e < 4; ++e) { v0[e] = gelu_tanh(v0[e]); v1[e] = gelu_tanh(v1[e]); } }
                    st8(rowp + bj * 128, v0, v1); } }
    } };
struct EpiBf16 { static constexpr bool PERM = true; bf16_t* O; int ldc;
    __device__ __forceinline__ void operator()(const f32x4 (&acc)[2][2][4][2], const pg8::Unit& u, int wr, int wc, int fr, int fq) const {
        const int ct = u.pn * 256 + wc * 32 + 8 * fq;
#pragma unroll
        for (int ai = 0; ai < 2; ++ai)
#pragma unroll
            for (int m = 0; m < 4; ++m) { bf16_t* rowp = O + (size_t)EPI_ROWS(ai, m) * ldc + ct;
#pragma unroll
                for (int bj = 0; bj < 2; ++bj) st8(rowp + bj * 128, acc[ai][bj][m][0], acc[ai][bj][m][1]); }
    } };
struct EpiCmIn { static constexpr bool PERM = true; bf16_t* O; f32x2* statp;
    __device__ __forceinline__ void operator()(const f32x4 (&acc)[2][2][4][2], const pg8::Unit& u, int wr, int wc, int fr, int fq) const {
        const int ct = u.pn * 256 + wc * 32 + 8 * fq; const bool isv = u.pn >= 8;
#pragma unroll
        for (int ai = 0; ai < 2; ++ai)
#pragma unroll
            for (int m = 0; m < 4; ++m) { const int row = EPI_ROWS(ai, m); bf16_t* rowp = O + (size_t)row * 4096 + ct; float s = 0.f, q = 0.f;
#pragma unroll
                for (int bj = 0; bj < 2; ++bj) { f32x4 v0 = acc[ai][bj][m][0], v1 = acc[ai][bj][m][1];
#pragma unroll
                    for (int e = 0; e < 4; ++e) { v0[e] = gelu_tanh(v0[e]); v1[e] = gelu_tanh(v1[e]); }
                    u32x4 w; w.x = cvt_pk_bf16(v0[0], v0[1]); w.y = cvt_pk_bf16(v0[2], v0[3]); w.z = cvt_pk_bf16(v1[0], v1[1]); w.w = cvt_pk_bf16(v1[2], v1[3]);
                    *(u32x4*)(rowp + bj * 128) = w;
                    const float r0 = bflo(w.x), r1 = bfhi(w.x), r2 = bflo(w.y), r3 = bfhi(w.y), r4 = bflo(w.z), r5 = bfhi(w.z), r6 = bflo(w.w), r7 = bfhi(w.w);
                    s += ((r0 + r1) + (r2 + r3)) + ((r4 + r5) + (r6 + r7)); q += ((r0 * r0 + r1 * r1) + (r2 * r2 + r3 * r3)) + ((r4 * r4 + r5 * r5) + (r6 * r6 + r7 * r7)); }
                if (isv) { s += __shfl_xor(s, 16); s += __shfl_xor(s, 32); q += __shfl_xor(q, 16); q += __shfl_xor(q, 32);
                    if (fq == 0) statp[(size_t)row * 32 + (u.pn - 8) * 4 + wc] = (f32x2){s, q}; } }
    } };
struct EpiResid { static constexpr bool PERM = false; float* X; const float* gate  ;
    __device__ __forceinline__ void operator()(const f32x4 (&acc)[2][2][4][2], const pg8::Unit& u, int wr, int wc, int fr, int fq) const {
        const int sidx = sidx_of_row(u.pm * 256); const float* gp = gate + (size_t)sidx * NMODV; const int ct = u.pn * 256 + wc * 32 + 4 * fq;
        f32x4 gv[2][2];
#pragma unroll
        for (int bj = 0; bj < 2; ++bj)
#pragma unroll
            for (int n = 0; n < 2; ++n) gv[bj][n] = *(const f32x4*)(gp + ct + bj * 128 + n * 16);
#pragma unroll
        for (int ai = 0; ai < 2; ++ai)
#pragma unroll
            for (int m = 0; m < 4; ++m) { float* rowp = X + (size_t)EPI_ROWS(ai, m) * D + ct;
#pragma unroll
                for (int bj = 0; bj < 2; ++bj)
#pragma unroll
                    for (int n = 0; n < 2; ++n) { f32x4* p = (f32x4*)(rowp + bj * 128 + n * 16); *p = *p + gv[bj][n] * acc[ai][bj][m][n]; } }
    } };
struct EpiRgGate { static constexpr bool PERM = true; const bf16_t* XC; bf16_t* LA; bf16_t* BB; const float* ba; const float* bi; const float* lam;
    __device__ __forceinline__ void operator()(const f32x4 (&acc)[2][2][4][2], const pg8::Unit& u, int wr, int wc, int fr, int fq) const {
        const int d = u.pn >> 3, blk = u.pn & 7;
        asm volatile("" : "+v"(fr), "+v"(fq));
#pragma unroll
        for (int n = 0; n < 2; ++n) { const int ch = blk * 128 + wc * 32 + 8 * fq + 4 * n;
            const f32x4 bav = *(const f32x4*)(ba + d * D + ch), biv = *(const f32x4*)(bi + d * D + ch), spv = *(const f32x4*)(lam + d * D + ch);
#pragma unroll
            for (int ai = 0; ai < 2; ++ai)
#pragma unroll
                for (int m = 0; m < 4; ++m) { const size_t off = (size_t)EPI_ROWS(ai, m) * D + ch;
                    const u32x2 xw = *(const u32x2*)(XC + off);
                    const f32x4 xc = {bflo(xw.x), bfhi(xw.x), bflo(xw.y), bfhi(xw.y)};
                    f32x4 la, bb;
#pragma unroll
                    for (int e = 0; e < 4; ++e) { const float r = fast_sigmoid(acc[ai][0][m][n][e] + bav[e]), ig = fast_sigmoid(acc[ai][1][m][n][e] + biv[e]);
                        const float lga = r * spv[e]; la[e] = lga; bb[e] = __builtin_amdgcn_sqrtf(one_minus_exp(-2.f * lga)) * ig * xc[e]; }
                    u32x2 w; w.x = cvt_pk_bf16(la[0], la[1]); w.y = cvt_pk_bf16(la[2], la[3]);
                    *(u32x2*)(LA + (size_t)d * T * D + off) = w;
                    w.x = cvt_pk_bf16(bb[0], bb[1]); w.y = cvt_pk_bf16(bb[2], bb[3]);
                    *(u32x2*)(BB + (size_t)d * T * D + off) = w; __builtin_amdgcn_sched_barrier(0); }
            asm volatile("" ::: "memory"); }
    } };

template <bool G1>
struct MoeOrder {
    static constexpr bool GATHER = G1;
    const LAS int* tab; const char* A; const char* B; const int* BK; int G, c, nunits; size_t bstride;
    __device__ bool next(int i, pg8::Unit& u) const {
        const long L = (long)i * G + c; if (L >= nunits) return false;
        const int wgid = __builtin_amdgcn_readfirstlane(pg8::xcd_remap((int)L, nunits)); const int tau = wgid >> 2, pn = wgid & 3;
        int e = 0;
#pragma unroll 1
        for (int k = 1; k < 32; ++k) e = (tab[k] <= tau) ? k : e;
        e = __builtin_amdgcn_readfirstlane(e);
        u.pm = tau; u.pn = pn; u.aux0 = e; u.aux1 = __builtin_amdgcn_readfirstlane((tau - tab[e]) * 256);
        u.a = pg8::uptr(G1 ? A : A + (size_t)tau * 256 * DEXP * 2);
        u.b = pg8::uptr(B + (size_t)e * bstride + (size_t)pn * 256 * (G1 ? 1024 : DEXP) * 2);
        return true; }
    __device__ unsigned goff(const pg8::Unit& u, int row) const {
        const int pos = u.aux1 + row; const int cnt = tab[40 + u.aux0];
        int tok = 0; if (pos < cnt) tok = __builtin_nontemporal_load(BK + (size_t)u.aux0 * T + pos) >> 1;
        return (unsigned)tok * (unsigned)(D * 2); }
};
struct EpiMoe1 { static constexpr bool PERM = true; bf16_t* H1;
    __device__ __forceinline__ void operator()(const f32x4 (&acc)[2][2][4][2], const pg8::Unit& u, int wr, int wc, int fr, int fq) const {
        const int ct = u.pn * 128 + wc * 32 + 8 * fq;
#pragma unroll
        for (int ai = 0; ai < 2; ++ai)
#pragma unroll
            for (int m = 0; m < 4; ++m) { f32x4 h0, h1;
#pragma unroll
                for (int e = 0; e < 4; ++e) { const float g0 = acc[ai][0][m][0][e], g1 = acc[ai][0][m][1][e]; h0[e] = g0 * sigmoidf_(g0) * acc[ai][1][m][0][e]; h1[e] = g1 * sigmoidf_(g1) * acc[ai][1][m][1][e]; }
                st8(H1 + (size_t)EPI_ROWS(ai, m) * DEXP + ct, h0, h1); }
    } };
struct EpiMoe2 { static constexpr bool PERM = false; float* X; float* Y1; const float* gate; const int* BK; const float* TW; const LAS int* tab;
    __device__ __forceinline__ void operator()(const f32x4 (&acc)[2][2][4][2], const pg8::Unit& u, int wr, int wc, int fr, int fq) const {
        const int ct = u.pn * 256 + wc * 32 + 4 * fq; const int cnt = tab[40 + u.aux0]; const long dY = (char*)Y1 - (char*)X;
        typedef int i32x8_t __attribute__((ext_vector_type(8))); typedef float f32x8_t __attribute__((ext_vector_type(8))); i32x8_t ent; f32x8_t w8;
#pragma unroll
        for (int r = 0; r < 8; ++r) { const int pos = u.aux1 + (r >> 2) * 128 + wr * 64 + (r & 3) * 16 + fr; ent[r] = -1; if (pos < cnt) ent[r] = __builtin_nontemporal_load(BK + (size_t)u.aux0 * T + pos); }
#pragma unroll
        for (int r = 0; r < 8; ++r) { w8[r] = 0.f; if (ent[r] >= 0) w8[r] = __builtin_nontemporal_load(TW + ent[r]); }
#pragma unroll
        for (int rp = 0; rp < 8; rp += 2) {
            f32x4 xv[2][2][2];
#pragma unroll
            for (int m = 0; m < 2; ++m) { const int e_ = ent[rp + m]; const float* xp = X + (size_t)(e_ >> 1) * D + ct;
#pragma unroll
                for (int bj = 0; bj < 2; ++bj)
#pragma unroll
                    for (int n = 0; n < 2; ++n) { xv[m][bj][n] = (f32x4){0.f, 0.f, 0.f, 0.f}; if (e_ >= 0 && !(e_ & 1)) xv[m][bj][n] = *(const f32x4*)(xp + bj * 128 + n * 16); } }
#pragma unroll
            for (int m = 0; m < 2; ++m) { const int r = rp + m; const int e_ = ent[r];
                if (e_ >= 0) { const int tok = e_ >> 1, slot = e_ & 1; const float w = w8[r];
                    const float* gp = gate + (size_t)sidx_of_row(tok) * NMODV + ct; float* xp = (float*)((char*)X + (slot ? dY : 0l)) + (size_t)tok * D + ct;
#pragma unroll
                    for (int bj = 0; bj < 2; ++bj)
#pragma unroll
                        for (int n = 0; n < 2; ++n) { const f32x4 g = *(const f32x4*)(gp + bj * 128 + n * 16); *(f32x4*)(xp + bj * 128 + n * 16) = g * w * acc[r >> 2][bj][r & 3][n] + xv[m][bj][n]; } } }
        }
    } };
__device__ __forceinline__ int moe_table(Frame& F, int l, LAS int* tab) {
    __syncthreads();
    if (F.tid < 32) { const unsigned c = __hip_atomic_load((unsigned*)(F.ws + WS_CTL) + CW_CNT + (l * 32 + F.tid) * 64, RLX_AGENT); tab[40 + F.tid] = (int)c; }
    __syncthreads();
    if (F.tid == 0) { int s = 0; for (int e = 0; e < 32; ++e) { tab[e] = s; s += (tab[40 + e] + 255) >> 8; } tab[32] = s; }
    __syncthreads();
    return tab[32];
}

__device__ __forceinline__ void conv_phase(Frame& F, int j) {
    const bf16_t* XB = (const bf16_t*)(F.ws + WS_XB); bf16_t* XC = (bf16_t*)(F.ws + WS_XC);
    const float* cw = inp(F, I_RGCW) + (size_t)j * 4 * D; const float* cb = inp(F, I_RGCB) + (size_t)j * D;
    const int NGT = F.G * 512;
    for (int i0 = F.bid * 512 + F.tid; i0 < T * 128; i0 += 2 * NGT) {
        u32x4 xw[2][4];
#pragma unroll
        for (int q = 0; q < 2; ++q) { const int i = i0 + q * NGT; const int row = i >> 7, c = (i & 127) * 8; const int b = row / SB, s = row - b * SB; const int lo = s < CTX ? 0 : CTX, hi = s < CTX ? CTX : SB;
#pragma unroll
            for (int k = 0; k < 4; ++k) { const int ss = s + k - 2; xw[q][k] = (u32x4){0u, 0u, 0u, 0u}; if (i < T * 128 && ss >= lo && ss < hi) xw[q][k] = *(const u32x4*)(XB + (size_t)(b * SB + ss) * D + c); } }
#pragma unroll
        for (int q = 0; q < 2; ++q) { const int i = i0 + q * NGT; if (i < T * 128) { const int row = i >> 7, c = (i & 127) * 8;
            float a[8];
#pragma unroll
            for (int e = 0; e < 8; ++e) a[e] = cb[c + e];
#pragma unroll
            for (int k = 0; k < 4; ++k) { const f32x4 w0 = *(const f32x4*)(cw + k * D + c), w1 = *(const f32x4*)(cw + k * D + c + 4); const u32x4 x = xw[q][k];
                a[0] += w0.x * bflo(x.x); a[1] += w0.y * bfhi(x.x); a[2] += w0.z * bflo(x.y); a[3] += w0.w * bfhi(x.y);
                a[4] += w1.x * bflo(x.z); a[5] += w1.y * bfhi(x.z); a[6] += w1.z * bflo(x.w); a[7] += w1.w * bfhi(x.w); }
            u32x4 o; o.x = pk2(a[0], a[1]); o.y = pk2(a[2], a[3]); o.z = pk2(a[4], a[5]); o.w = pk2(a[6], a[7]);
            *(u32x4*)(XC + (size_t)row * D + c) = o; } }
    }
}
__device__ __forceinline__ void scan1_phase(Frame& F) {
    const bf16_t* LA = (const bf16_t*)(F.ws + WS_LA); const bf16_t* BB = (const bf16_t*)(F.ws + WS_BB); float* TS = (float*)(F.ws + WS_TOTS); float* TH = (float*)(F.ws + WS_TOTH);
    for (int it = F.bid * 8 + F.wave; it < NB * 2 * NCH * 4; it += F.G * 8) {
        const int cg = it & 3, rest = it >> 2, ck = rest % NCH, bd = rest / NCH, dir = bd & 1, b = bd >> 1;
        const int c = cg * 256 + F.lane * 4; const size_t base = (size_t)dir * T * D + (size_t)(b * SB + ck * 16) * D + c;
        u32x2 la[16], bb[16];
#pragma unroll
        for (int t = 0; t < 16; ++t) { const size_t o = base + (size_t)(dir ? 15 - t : t) * D; la[t] = *(const u32x2*)(LA + o); bb[t] = *(const u32x2*)(BB + o); }
        f32x4 sl = {0.f, 0.f, 0.f, 0.f}, h = {0.f, 0.f, 0.f, 0.f};
#pragma unroll
        for (int t = 0; t < 16; ++t) { const f32x4 l4 = {bflo(la[t].x), bfhi(la[t].x), bflo(la[t].y), bfhi(la[t].y)}, b4 = {bflo(bb[t].x), bfhi(bb[t].x), bflo(bb[t].y), bfhi(bb[t].y)};
            sl += l4; f32x4 a4 = {__expf(l4.x), __expf(l4.y), __expf(l4.z), __expf(l4.w)}; h = a4 * h + b4; }
        const size_t o = (size_t)(bd * NCH + ck) * D + c; *(f32x4*)(TS + o) = sl; *(f32x4*)(TH + o) = h;
    }
}
__device__ __forceinline__ void scan2_phase(Frame& F) {
    const float* TS = (const float*)(F.ws + WS_TOTS); const float* TH = (const float*)(F.ws + WS_TOTH); float* CY = (float*)(F.ws + WS_CARRY);
    for (int it = F.bid * 8 + F.wave; it < NB * 2 * 4; it += F.G * 8) {
        const int cg = it & 3, bd = it >> 2, dir = bd & 1; const int c = cg * 256 + F.lane * 4; const size_t base = (size_t)bd * NCH * D + c;
        f32x4 h = {0.f, 0.f, 0.f, 0.f};
        for (int s0 = 0; s0 < NCH; s0 += 8) { f32x4 sl[8], hl[8]; int ck[8];
#pragma unroll
            for (int q = 0; q < 8; ++q) { const int s = s0 + q; ck[q] = dir ? (s < 16 ? 15 - s : NCH + 15 - s) : s; sl[q] = *(const f32x4*)(TS + base + (size_t)ck[q] * D); hl[q] = *(const f32x4*)(TH + base + (size_t)ck[q] * D); }
#pragma unroll
            for (int q = 0; q < 8; ++q) { *(f32x4*)(CY + base + (size_t)ck[q] * D) = h; const f32x4 a4 = {__expf(sl[q].x), __expf(sl[q].y), __expf(sl[q].z), __expf(sl[q].w)}; h = a4 * h + hl[q]; } }
    }
}
__device__ __forceinline__ void scan3_phase(Frame& F) {
    const bf16_t* LA = (const bf16_t*)(F.ws + WS_LA); const bf16_t* BB = (const bf16_t*)(F.ws + WS_BB); const float* CY = (const float*)(F.ws + WS_CARRY);
    const bf16_t* GG = (const bf16_t*)(F.ws + WS_GG); bf16_t* SA = (bf16_t*)(F.ws + WS_SA);
    LAS f32x4* hb = (LAS f32x4*)(F.lds + F.wave * 16384);
    for (int it = F.bid * 8 + F.wave; it < NB * NCH * 4; it += F.G * 8) {
        const int cg = it & 3, rest = it >> 2, ck = rest % NCH, b = rest / NCH;
        const int c = cg * 256 + F.lane * 4;
        const size_t rbase = (size_t)(b * SB + ck * 16) * D + c, b1 = (size_t)T * D + rbase;
        f32x4 hbk = *(const f32x4*)(CY + (size_t)((b * 2 + 1) * NCH + ck) * D + c), hf = *(const f32x4*)(CY + (size_t)((b * 2 + 0) * NCH + ck) * D + c);
        { u32x2 la[16], bb[16];
#pragma unroll
          for (int t = 0; t < 16; ++t) { la[t] = *(const u32x2*)(LA + b1 + (size_t)(15 - t) * D); bb[t] = *(const u32x2*)(BB + b1 + (size_t)(15 - t) * D); }
#pragma unroll
          for (int t = 0; t < 16; ++t) { const f32x4 l4 = {bflo(la[t].x), bfhi(la[t].x), bflo(la[t].y), bfhi(la[t].y)}, b4 = {bflo(bb[t].x), bfhi(bb[t].x), bflo(bb[t].y), bfhi(bb[t].y)};
              const f32x4 a4 = {__expf(l4.x), __expf(l4.y), __expf(l4.z), __expf(l4.w)}; hbk = a4 * hbk + b4; hb[(15 - t) * 64 + F.lane] = hbk; } }
        { u32x2 la[16], bb[16], gg[16];
#pragma unroll
          for (int t = 0; t < 16; ++t) { la[t] = *(const u32x2*)(LA + rbase + (size_t)t * D); bb[t] = *(const u32x2*)(BB + rbase + (size_t)t * D); gg[t] = *(const u32x2*)(GG + rbase + (size_t)t * D); }
#pragma unroll
          for (int t = 0; t < 16; ++t) { const f32x4 l4 = {bflo(la[t].x), bfhi(la[t].x), bflo(la[t].y), bfhi(la[t].y)}, b4 = {bflo(bb[t].x), bfhi(bb[t].x), bflo(bb[t].y), bfhi(bb[t].y)};
              const f32x4 g4 = {bflo(gg[t].x), bfhi(gg[t].x), bflo(gg[t].y), bfhi(gg[t].y)};
              const f32x4 a4 = {__expf(l4.x), __expf(l4.y), __expf(l4.z), __expf(l4.w)}; hf = a4 * hf + b4; const f32x4 y = g4 * (hf + hb[t * 64 + F.lane]);
              u32x2 o; o.x = pk2(y.x, y.y); o.y = pk2(y.z, y.w); *(u32x2*)(SA + rbase + (size_t)t * D) = o; } }
    }
}

__device__ __forceinline__ void qknorm_phase(Frame& F) {
    bf16_t* QKV = (bf16_t*)(F.ws + WS_QKV); const f32x2* ROPE = (const f32x2*)(F.ws + WS_ROPE);
    const int i16 = F.lane & 15, grp = F.lane >> 4; const float* pqg = inp(F, I_ATQG); const float* pkg = inp(F, I_ATKG);
    const int ITS = F.G * 32;
    for (int it0 = (F.bid * 8 + F.wave) * 4 + grp; it0 < T * 10; it0 += 4 * ITS) {
        u32x4 xw4[4];
#pragma unroll
        for (int q = 0; q < 4; ++q) { const int it = it0 + q * ITS; xw4[q] = (u32x4){0u, 0u, 0u, 0u}; if (it < T * 10) { const int row = it / 10, hh = it - row * 10; xw4[q] = *(const u32x4*)(QKV + (size_t)row * 1536 + hh * 128 + i16 * 8); } }
#pragma unroll
        for (int q = 0; q < 4; ++q) { const int it = it0 + q * ITS; const bool valid = it < T * 10; const int itc = valid ? it : 0;
            const int row = itc / 10, hh = itc - row * 10; const int b = row / SB, s = row - b * SB;
            bf16_t* p = QKV + (size_t)row * 1536 + hh * 128 + i16 * 8;
            const u32x4 xw = xw4[q];
            float x[8] = {bflo(xw.x), bfhi(xw.x), bflo(xw.y), bfhi(xw.y), bflo(xw.z), bfhi(xw.z), bflo(xw.w), bfhi(xw.w)};
            float ss = 0.f;
#pragma unroll
            for (int e = 0; e < 8; ++e) ss += x[e] * x[e];
            ss = wave16_sum(ss);
            const float rstd = rsqrtf(ss * (1.f / 128.f) + NORM_EPS);
            const float* g = (hh < 8 ? pqg : pkg) + i16 * 8;
#pragma unroll
            for (int e = 0; e < 8; ++e) x[e] = x[e] * rstd * g[e];
            float y[8];
#pragma unroll
            for (int e = 0; e < 8; ++e) y[e] = __shfl_xor(x[e], 4);
            if (s >= CTX) { const int t = s - CTX; const int pos = (i16 >> 3) ? (t & 63) : (t >> 6); const bool half1 = (i16 >> 2) & 1;
#pragma unroll
                for (int e = 0; e < 8; ++e) { const f32x2 cs = ROPE[pos * 32 + (i16 & 3) * 8 + e];
                    x[e] = half1 ? (x[e] * cs.x + y[e] * cs.y) : (x[e] * cs.x - y[e] * cs.y); } }
            u32x4 o; o.x = pk2(x[0], x[1]); o.y = pk2(x[2], x[3]); o.z = pk2(x[4], x[5]); o.w = pk2(x[6], x[7]);
            if (valid) *(u32x4*)p = o;
        }
    }
}
__device__ __forceinline__ void attn_phase(Frame& F) {
    const bf16_t* QKV = (const bf16_t*)(F.ws + WS_QKV); bf16_t* AO = (bf16_t*)(F.ws + WS_AO);
    for (int u = F.bid; u < 544; u += F.G) {
        int b, h, q0, k0, seq;
        if (u < 512) { const int qb = u & 15, hg = (u >> 4) & 3, kvh = (u >> 6) & 1; b = u >> 7; h = kvh * 4 + hg; q0 = b * SB + CTX + qb * 256; k0 = b * SB; seq = SB; }
        else { const int v = u - 512; b = v >> 3; h = v & 7; q0 = b * SB; k0 = b * SB; seq = CTX; }
        const int kvh = h >> 2;
        const bf16_t* Kp = (const bf16_t*)pg8::uptr((const char*)(QKV + (size_t)k0 * 1536 + 1024 + kvh * 128));
        att::attn_dense_body((const bf16_t*)pg8::uptr((const char*)(QKV + (size_t)q0 * 1536 + h * 128)), Kp, Kp + 256, (bf16_t*)pg8::uptr((const char*)(AO + (size_t)q0 * D + h * 128)), seq, F.ldsg, F.tid);
        __syncthreads();
    }
}

__device__ __forceinline__ void spatial_phase(Frame& F) {
    const bf16_t* UVB = (const bf16_t*)(F.ws + WS_UVB); bf16_t* UV = (bf16_t*)(F.ws + WS_UV); const f32x2* statp = (const f32x2*)(F.ws + WS_STATP);
    const bf16_t* Ws = (const bf16_t*)(F.ws + WS_W_CMS); const float* lng = inp(F, I_CMLNG); const float* lnb = inp(F, I_CMLNB); const float* bs = inp(F, I_CMBS);
    LAS uchar* vl = F.lds;
    LAS f32x2* st = (LAS f32x2*)(F.lds + 65536);
    const int tid = F.tid, lane = F.lane, wid = F.wave, r32 = lane & 31, hi = lane >> 5, wm = wid & 3, wn = wid >> 2;
    const int sr = tid >> 4, sc = (tid & 15) * 8;
    for (int u = F.bid; u < 136 * 8; u += F.G) {
        const int chunk = u >> 3, g = u & 7; const int row0 = chunk * 128;
        __syncthreads();
        if (tid < 128) { const f32x2* sp = statp + (size_t)(row0 + tid) * 32; float s = 0.f, q = 0.f;
#pragma unroll 8
            for (int k = 0; k < 32; ++k) { const f32x2 v = sp[k]; s += v.x; q += v.y; }
            const float mean = s * (1.f / 2048.f); const float var = fmaxf(q * (1.f / 2048.f) - mean * mean, 0.f); st[tid] = (f32x2){mean, rsqrtf(var + NORM_EPS)}; }
        __syncthreads();
#pragma unroll
        for (int ch = 0; ch < 2; ++ch) { const int cg = g * 256 + ch * 128 + sc;
            const f32x4 g0 = *(const f32x4*)(lng + cg), g1 = *(const f32x4*)(lng + cg + 4), b0 = *(const f32x4*)(lnb + cg), b1 = *(const f32x4*)(lnb + cg + 4);
#pragma unroll
            for (int i = 0; i < 4; ++i) { const int q = sr + 32 * i; const u32x4 xw = *(const u32x4*)(UVB + (size_t)(row0 + q) * 4096 + 2048 + cg); const f32x2 ms = st[q];
                f32x4 v0 = {bflo(xw.x), bfhi(xw.x), bflo(xw.y), bfhi(xw.y)}, v1 = {bflo(xw.z), bfhi(xw.z), bflo(xw.w), bfhi(xw.w)};
                v0 = (v0 - ms.x) * ms.y * g0 + b0; v1 = (v1 - ms.x) * ms.y * g1 + b1;
                u32x4 o; o.x = pk2(v0.x, v0.y); o.y = pk2(v0.z, v0.w); o.z = pk2(v1.x, v1.y); o.w = pk2(v1.z, v1.w);
                *(LAS u32x4*)(vl + ((q >> 6) * 2 + ch) * 16384 + att::v_st(q & 63, sc)) = o; } }
        bf16x8 pa[2][4];
#pragma unroll
        for (int kt = 0; kt < 2; ++kt)
#pragma unroll
            for (int ks = 0; ks < 4; ++ks) pa[kt][ks] = *(const bf16x8*)(Ws + ((size_t)g * 128 + 32 * wm + r32) * 128 + 64 * kt + 16 * ks + 8 * hi);
        __syncthreads();
        f32x16 o[4] = {};
        const int vb = (int)(uintptr_t)(F.ldsg) + att::v_rd_base(lane) + wn * 16384;
        att::pv_d0(o, vb, pa[0][0], pa[0][1], pa[0][2], pa[0][3]);
        att::pv_d0(o, vb + 32768, pa[1][0], pa[1][1], pa[1][2], pa[1][3]);
#pragma unroll
        for (int r = 0; r < 16; ++r) { const int p = 32 * wm + att::crow(r, hi); const float bsv = bs[g * 128 + p]; const size_t rowoff = (size_t)(row0 + p);
#pragma unroll
            for (int d0 = 0; d0 < 4; ++d0) { const int c = g * 256 + 128 * wn + 32 * d0 + r32; const float uu = bf2f(UVB[rowoff * 4096 + c]);
                UV[rowoff * 2048 + c] = (bf16_t)f2bf((o[d0][r] + bsv) * uu); } }
    }
    __syncthreads();
}

__device__ __forceinline__ void final_phase(Frame& F) {
    const f32x4* X = (const f32x4*)(F.ws + WS_X); const f32x4* Y1 = (const f32x4*)(F.ws + WS_Y1); f32x4* out = (f32x4*)F.out;
    const int NGT = F.G * 512;
    for (int i0 = F.bid * 512 + F.tid; i0 < NB * SEQ * 256; i0 += 4 * NGT) { f32x4 a[4], y[4];
#pragma unroll
        for (int q = 0; q < 4; ++q) { const int i = i0 + q * NGT; if (i < NB * SEQ * 256) { const int r = i >> 8, c4 = i & 255, b = r >> 12, t = r & 4095; const size_t src = ((size_t)(b * SB + CTX + t) << 8) + c4; a[q] = X[src]; y[q] = Y1[src]; } }
#pragma unroll
        for (int q = 0; q < 4; ++q) { const int i = i0 + q * NGT; if (i < NB * SEQ * 256) out[i] = a[q] + y[q]; } }
}

constexpr int NPHASE = 39;
__global__ void __launch_bounds__(512, 2) mk_fwd(Args args) {
    extern __shared__ __attribute__((aligned(16))) uchar lds[];
    Frame F; F.lds = (LAS uchar*)lds; F.ldsg = (char*)lds; F.tid = threadIdx.x; F.lane = F.tid & 63; F.wave = __builtin_amdgcn_readfirstlane(F.tid >> 6); F.G = gridDim.x; F.bid = blockIdx.x;
    F.ws = args.ws; F.out = args.out;
    uchar* ws0 = args.ws;
    volatile LAS unsigned* MISC = (volatile LAS unsigned*)(F.lds + LDSCTL_OFF);
    LAS int* tab = (LAS int*)(F.lds + LDSCTL_OFF + 256);
    for (int u = F.tid; u < (LDS_BYTES - LDSCTL_OFF) / 4; u += 512) ((LAS unsigned*)(F.lds + LDSCTL_OFF))[u] = 0u;
    __syncthreads();
    if (F.tid == 0) {
#pragma unroll
        for (int i = 0; i < 34; ++i) *(LAS unsigned long long*)(F.lds + LDSCTL_OFF + 576 + i * 8) = (unsigned long long)args.in[i]; }
    __syncthreads();
    const int lo = args.ph_lo, hi = args.ph_hi;
    if (hi - lo > 1) (void)xcd_barrier_post((unsigned*)(ws0 + WS_CTL) + CW_BAR, MISC + 8);
    int ph = 0;
#define PH_BEGIN if (ph >= opaque_uniform_int(args.ph_lo) && ph < opaque_uniform_int(args.ph_hi)) { int t_ = threadIdx.x; F.G = opaque_uniform_int(gridDim.x); F.bid = opaque_uniform_int(blockIdx.x); const int cid = F.bid; (void)cid; \
        F.out = (float*)opaque_uniform_ptr(args.out); F.lds = (LAS uchar*)lds; F.ldsg = (char*)lds; \
        asm volatile("" : "+v"(t_)); F.tid = t_; F.lane = t_ & 63; F.wave = __builtin_amdgcn_readfirstlane(t_ >> 6); \
        uchar* ws = (uchar*)opaque_uniform_ptr(args.ws); F.ws = ws; \
        const float* MODl = (const float*)(ws + WS_MOD) + (size_t)l_ * 5 * NMODV; (void)MODl;
#define GRIDBAR  { XcdBarrier bb_; bb_.bar = (unsigned*)(ws + WS_CTL) + CW_BAR; bb_.x = 0; bb_.st = (volatile LAS unsigned*)(F.lds + LDSCTL_OFF) + 8; xcd_barrier(bb_); }
#define REPBAR   if (rep_ > 1) GRIDBAR
#define PH_END   if (ph + 1 < opaque_uniform_int(args.ph_hi)) GRIDBAR } ++ph;

    { const int l_ = 0; PH_BEGIN PM(0) { const bool dry = rep_ > 1; (void)dry;  p0_prologue(F);  REPBAR } PH_END }

#pragma unroll 1
    for (int l = 0; l < DEPTH; ++l) {
        const int kind = l % 3, j = l / 3; const bool lastl = (l == DEPTH - 1); const int l_ = l;
        PH_BEGIN PM(1) { const bool dry = rep_ > 1; (void)dry;  if ((l > 0) && (rep_ == REPN(1))) norm_phase<false, true>(F, l, inp(F, I_NMG) + l * D, 0, false, false); else norm_phase<false, false>(F, l, inp(F, I_NMG) + l * D, 0, false, false);  REPBAR } PH_END
        if (kind == 0) {
            PH_BEGIN PM(2) { const bool dry = rep_ > 1; (void)dry;  { pg8::DenseOrder S; S.init(ws + WS_H, D, ws + WS_W_RGIN + (size_t)j * 2048 * 1024 * 2, D, T, 2048, F.G, cid);
                EpiRgIn E{(bf16_t*)(ws + WS_GG), (bf16_t*)(ws + WS_XB)}; pg8::gemm_phase(F.lds, S, E, D, D, D); }  REPBAR } PH_END
            PH_BEGIN PM(3) { const bool dry = rep_ > 1; (void)dry;  conv_phase(F, j);  REPBAR } PH_END
            PH_BEGIN PM(4) { const bool dry = rep_ > 1; (void)dry;  { pg8::DenseOrder S; S.init(ws + WS_XC, D, ws + WS_W_RGG + (size_t)j * 16 * 256 * 128 * 2, 128, T, 16 * 256, F.G, cid, 7, 256);
                EpiRgGate E{(const bf16_t*)(ws + WS_XC), (bf16_t*)(ws + WS_LA), (bf16_t*)(ws + WS_BB), inp(F, I_RGBA) + (size_t)j * 2 * D, inp(F, I_RGBI) + (size_t)j * 2 * D, (const float*)(ws + WS_SPL) + (size_t)j * 2 * D};
                pg8::gemm_phase(F.lds, S, E, 128, D, 128); }  REPBAR } PH_END
            PH_BEGIN PM(5) { const bool dry = rep_ > 1; (void)dry;  scan1_phase(F);  REPBAR } PH_END
            PH_BEGIN PM(20) { const bool dry = rep_ > 1; (void)dry;  scan2_phase(F);  REPBAR } PH_END
            PH_BEGIN PM(6) { const bool dry = rep_ > 1; (void)dry;  scan3_phase(F);  REPBAR } PH_END
            PH_BEGIN PM(7) { const bool dry = rep_ > 1; (void)dry;  { pg8::DenseOrder S; S.init(ws + WS_SA, D, ws + WS_W_RGOUT + (size_t)j * 1024 * 1024 * 2, D, T, D, F.G, cid);
                EpiResid E{(float*)(ws + (dry ? WS_Y1 : WS_X)), MODl + 2 * D}; pg8::gemm_phase(F.lds, S, E, D, D, D); }  REPBAR } PH_END
        } else if (kind == 1) {
            PH_BEGIN PM(8) { const bool dry = rep_ > 1; (void)dry;  { pg8::DenseOrder S; S.init(ws + WS_H, D, ws + WS_W_QKV, D, T, 1536, F.G, cid);
                EpiBf16 E{(bf16_t*)(ws + WS_QKV), 1536}; pg8::gemm_phase(F.lds, S, E, D, D, D); }  REPBAR } PH_END
            PH_BEGIN PM(9) { const bool dry = rep_ > 1; (void)dry;  qknorm_phase(F);  REPBAR } PH_END
            PH_BEGIN PM(10) { const bool dry = rep_ > 1; (void)dry;  attn_phase(F);  REPBAR } PH_END
            PH_BEGIN PM(11) { const bool dry = rep_ > 1; (void)dry;  { pg8::DenseOrder S; S.init(ws + WS_AO, D, ws + WS_W_AO, D, T, D, F.G, cid);
                EpiResid E{(float*)(ws + (dry ? WS_Y1 : WS_X)), MODl + 2 * D}; pg8::gemm_phase(F.lds, S, E, D, D, D); }  REPBAR } PH_END
        } else {
            PH_BEGIN PM(12) { const bool dry = rep_ > 1; (void)dry;  { pg8::DenseOrder S; S.init(ws + WS_H, D, ws + WS_W_CMIN, D, T, 4096, F.G, cid);
                EpiCmIn E{(bf16_t*)(ws + WS_UVB), (f32x2*)(ws + WS_STATP)}; pg8::gemm_phase(F.lds, S, E, D, D, D); }  REPBAR } PH_END
            PH_BEGIN PM(13) { const bool dry = rep_ > 1; (void)dry;  spatial_phase(F);  REPBAR } PH_END
            PH_BEGIN PM(14) { const bool dry = rep_ > 1; (void)dry;  { pg8::DenseOrder S; S.init(ws + WS_UV, 2048, ws + WS_W_CMOUT, 2048, T, D, F.G, cid);
                EpiResid E{(float*)(ws + (dry ? WS_Y1 : WS_X)), MODl + 2 * D}; pg8::gemm_phase(F.lds, S, E, 2048, 2048, 2048); }  REPBAR } PH_END
        }
        PH_BEGIN PM(15) { const bool dry = rep_ > 1; (void)dry;  norm_phase<true, false>(F, l, inp(F, I_NFG) + l * D, 3, lastl, dry);  REPBAR } PH_END
        PH_BEGIN PM(16) { const bool dry = rep_ > 1; (void)dry;  { const int ntile = moe_table(F, l, tab);
            MoeOrder<true> S{tab, (const char*)(ws + WS_H), (const char*)(ws + WS_W_E1 + (size_t)l * 32 * 1024 * 1024 * 2), (const int*)(ws + WS_BK), F.G, cid, ntile * 4, (size_t)1024 * 1024 * 2};
            EpiMoe1 E{(bf16_t*)(ws + WS_H1)}; pg8::gemm_phase(F.lds, S, E, D, D, D); }  REPBAR } PH_END
        PH_BEGIN PM(17) { const bool dry = rep_ > 1; (void)dry;  { const int ntile = moe_table(F, l, tab);
            MoeOrder<false> S{tab, (const char*)(ws + WS_H1), (const char*)(ws + WS_W_E2 + (size_t)l * 32 * 1024 * 512 * 2), (const int*)(ws + WS_BK), F.G, cid, ntile * 4, (size_t)1024 * 512 * 2};
            EpiMoe2 E{(float*)(ws + (dry ? WS_SCR + 64 * MiB : WS_X)), (float*)(ws + (dry ? WS_SCR + 132 * MiB : WS_Y1)), MODl + 5 * D, (const int*)(ws + WS_BK), (const float*)(ws + WS_TW), tab}; pg8::gemm_phase(F.lds, S, E, DEXP, DEXP, DEXP); }  REPBAR } PH_END
    }
    { const int l_ = 0; PH_BEGIN PM(18) { const bool dry = rep_ > 1; (void)dry;  final_phase(F);  REPBAR if constexpr (((REP_MASK) >> 19) & 1u) { for (int k_ = 0; k_ < 20; ++k_) GRIDBAR } } PH_END }
#undef PH_BEGIN
#undef PH_END
}

extern "C" void kernel_launch(void* const* d_in, const int* in_sizes, int n_in, void* d_out, int out_size, void* d_ws, size_t ws_size, hipStream_t stream) {
    static int grid = 0;
    if (grid == 0) {
        if (n_in != 34 || out_size != NB * SEQ * D || ws_size < WS_END) { fprintf(stderr, "kernel_launch: bad shapes n_in %d out %d ws %zu (need %zu)\n", n_in, out_size, ws_size, (size_t)WS_END); grid = -1; return; }
        int dev = 0, cus = 0, per_cu = 0;
        if (hipGetDevice(&dev) != hipSuccess || hipDeviceGetAttribute(&cus, hipDeviceAttributeMultiprocessorCount, dev) != hipSuccess) { grid = -1; return; }
        if (hipFuncSetAttribute((const void*)mk_fwd, hipFuncAttributeMaxDynamicSharedMemorySize, LDS_BYTES) != hipSuccess) { fprintf(stderr, "kernel_launch: hipFuncSetAttribute failed\n"); grid = -1; return; }
        if (hipOccupancyMaxActiveBlocksPerMultiprocessor(&per_cu, (const void*)mk_fwd, 512, LDS_BYTES) != hipSuccess || per_cu < 1) { fprintf(stderr, "kernel_launch: occupancy query says %d\n", per_cu); (void)hipGetLastError(); grid = -1; return; }
        grid = cus;
    }
    if (grid < 0) return;
    (void)hipMemsetAsync((char*)d_ws + WS_CTL, 0, CTL_BYTES, stream);
    Args a{};
    for (int i = 0; i < 34; ++i) a.in[i] = (const float*)d_in[i];
    a.out = (float*)d_out; a.ws = (uchar*)d_ws;
#if MK_PER_PHASE
    for (int p = 0; p < NPHASE; ++p) { a.ph_lo = p; a.ph_hi = p + 1; hipLaunchKernelGGL(mk_fwd, dim3(grid), dim3(512), LDS_BYTES, stream, a); }
#else
    a.ph_lo = 0; a.ph_hi = NPHASE;
    void* kargs[] = {&a};
    hipError_t e = hipLaunchCooperativeKernel((const void*)mk_fwd, dim3(grid), dim3(512), kargs, LDS_BYTES, stream);
    if (e != hipSuccess) fprintf(stderr, "kernel_launch: cooperative launch failed: %s (grid %d)\n", hipGetErrorString(e), grid);
#endif
}
```

```cpp
#include <hip/hip_runtime.h>
#include <hip/hip_bf16.h>
#include <cstdio>
#include <cstdint>

#ifndef MK_PER_PHASE
#define MK_PER_PHASE 0
#endif

#ifndef PHASE_MASK
#define PHASE_MASK 0xFFFFFFFFu
#endif
#ifndef REP_MASK
#define REP_MASK 0u
#endif
#define REPN(i) ((((REP_MASK) >> (i)) & 1u) ? 2 : 1)
#define PM(i) if constexpr ((PHASE_MASK >> (i)) & 1u) for (int rep_ = REPN(i); rep_ > 0; --rep_)
#define LAS __attribute__((address_space(3)))
#define GAS __attribute__((address_space(1)))
typedef unsigned char uchar;
typedef unsigned short bf16_t;
typedef short bf16x8 __attribute__((ext_vector_type(8)));
typedef short s16x4 __attribute__((ext_vector_type(4)));
typedef float f32x4 __attribute__((ext_vector_type(4)));
typedef float f32x2 __attribute__((ext_vector_type(2)));
typedef float f32x16 __attribute__((ext_vector_type(16)));
typedef unsigned u32x4 __attribute__((ext_vector_type(4)));
typedef unsigned u32x2 __attribute__((ext_vector_type(2)));
typedef GAS unsigned gu32;
#define RLX_AGENT __ATOMIC_RELAXED, __HIP_MEMORY_SCOPE_AGENT

constexpr int D = 1024, NB = 4, SEQ = 4096, CTX = 256, SB = SEQ + CTX, T = NB * SB, DEPTH = 4;
constexpr int NMODV = 6 * D;
constexpr int NEXP = 32, DEXP = 512;
constexpr int NCH = SB / 16;
constexpr float NORM_EPS = 1e-6f;

constexpr size_t MiB = 1u << 20;
constexpr size_t WS_CTL = 0, CTL_BYTES = 1 * MiB;
constexpr size_t WS_MOD = 1 * MiB;
constexpr size_t WS_ROPE = 2 * MiB;
constexpr size_t WS_SPL = 2 * MiB + 65536;
constexpr size_t WS_TOT = 3 * MiB;
constexpr size_t WS_STATP = 8 * MiB;
constexpr size_t WS_BK = 13 * MiB;
constexpr size_t WS_TW = 15 * MiB + 512 * 1024;
constexpr size_t WS_W_RGIN = 16 * MiB, WS_W_RGG = 24 * MiB, WS_W_RGOUT = 26 * MiB, WS_W_QKV = 30 * MiB, WS_W_AO = 33 * MiB;
constexpr size_t WS_W_CMIN = 35 * MiB, WS_W_CMS = 43 * MiB, WS_W_CMOUT = 44 * MiB, WS_W_E1 = 48 * MiB, WS_W_E2 = 304 * MiB;
constexpr size_t WS_X = 432 * MiB, WS_Y1 = 500 * MiB, WS_H = 568 * MiB, WS_SCR = 602 * MiB;
constexpr size_t WS_GG = WS_SCR, WS_XB = WS_SCR + 34 * MiB, WS_XC = WS_SCR + 68 * MiB, WS_LA = WS_SCR + 102 * MiB, WS_BB = WS_SCR + 170 * MiB, WS_SA = WS_SCR + 238 * MiB;
constexpr size_t WS_QKV = WS_SCR, WS_AO = WS_SCR + 51 * MiB;
constexpr size_t WS_UVB = WS_SCR, WS_UV = WS_SCR + 136 * MiB;
constexpr size_t WS_H1 = WS_SCR;
constexpr size_t WS_TOTS = WS_SCR + 272 * MiB, WS_TOTH = WS_TOTS + 9 * MiB, WS_CARRY = WS_TOTH + 9 * MiB;
constexpr size_t WS_YM = WS_CARRY + 9 * MiB;
constexpr size_t WS_END = WS_YM + 34 * MiB;
constexpr int CW_TMO = 0, CW_BAR = 4096, CW_CNT = 16384;

constexpr int RING_BYTES = 131072;
constexpr int ROUTER_LDS = 36 * 1024 * 4;
constexpr int LDSCTL_OFF = 147456;
constexpr int LDS_BYTES = LDSCTL_OFF + 1024 + 8 * 4 * 40 * 4;

__device__ __forceinline__ unsigned f2bf(float f) { unsigned u = __builtin_bit_cast(unsigned, f); return (u + 0x7fffu + ((u >> 16) & 1u)) >> 16; }
__device__ __forceinline__ unsigned pk2(float lo, float hi) { return f2bf(lo) | (f2bf(hi) << 16); }
__device__ __forceinline__ float bf2f(unsigned short h) { return __builtin_bit_cast(float, (unsigned)h << 16); }
__device__ __forceinline__ float bflo(unsigned w) { return __builtin_bit_cast(float, w << 16); }
__device__ __forceinline__ float bfhi(unsigned w) { return __builtin_bit_cast(float, w & 0xffff0000u); }
__device__ __forceinline__ unsigned cvt_pk_bf16(float lo, float hi) { unsigned r; asm volatile("v_cvt_pk_bf16_f32 %0, %1, %2" : "=v"(r) : "v"(lo), "v"(hi)); return r; }
__device__ __forceinline__ float gelu_tanh(float x) { const float u = 0.7978845608028654f * (x + 0.044715f * x * x * x); const float e = __expf(2.f * u); const float t = 1.f - 2.f / (e + 1.f); return 0.5f * x * (1.f + t); }
__device__ __forceinline__ float sigmoidf_(float x) { return 1.f / (1.f + __expf(-x)); }
__device__ __forceinline__ float fast_sigmoid(float x) { return __builtin_amdgcn_rcpf(1.f + __expf(-x)); }
__device__ __forceinline__ float one_minus_exp(float y) {   const float p = y * (1.f - y * (0.5f - y * (0.16666667f - y * 0.041666667f))); const float q = 1.f - __expf(-y); return y < 0.0625f ? p : q; }
__device__ __forceinline__ int sidx_of_row(int row) { const int b = row / SB; return (row - b * SB) < CTX ? 4 : b; }

namespace pg8 {
constexpr int BM = 256, BK = 64, HALF = 128, HTB = HALF * BK * 2, NXCD = 8, WGM = 8;
__device__ __forceinline__ int lds_byte(int r, int c) { const int st = (r >> 4) * 2 + (c >> 5), rr = r & 15, cc = c & 31, ob = rr * 64 + cc * 2; return st * 1024 + (ob ^ (((ob >> 9) & 1) << 5)); }
__device__ __forceinline__ void stage_rc(int b, int& R, int& C) { const int st = b / 1024, sb = b % 1024, swz = sb ^ (((sb >> 9) & 1) << 5); R = (st >> 1) * 16 + swz / 64; C = (st & 1) * 32 + (swz % 64) / 2; }
__device__ __forceinline__ int perm32(int rho) { const int n = rho >> 4, i = rho & 15; return 8 * (i >> 2) + 4 * n + (i & 3); }
struct Unit { const char* a; const char* b; int pm, pn, aux0, aux1; };
__device__ __forceinline__ const char* uptr(const char* p) { const unsigned long long v = (unsigned long long)p; const unsigned lo = __builtin_amdgcn_readfirstlane((unsigned)v), hi = __builtin_amdgcn_readfirstlane((unsigned)(v >> 32)); return (const char*)(const GAS char*)(((unsigned long long)hi << 32) | lo); }
__device__ __forceinline__ int xcd_remap(int L, int nwg) { const int q = nwg / NXCD, r = nwg % NXCD, xcd = L % NXCD, off = L / NXCD; return (xcd < r ? xcd * (q + 1) : r * (q + 1) + (xcd - r) * q) + off; }

struct DenseOrder {
    static constexpr bool GATHER = false;
    const char* A; const char* B; int nM, nN, nwg, G, c; size_t tA, tB; int amask, acol;
    __device__ void init(const void* A_, int lda, const void* B_, int ldb, int M, int N, int G_, int c_, int amask_ = 0, int acol_ = 0) {
        A = (const char*)A_; B = (const char*)B_; nM = M / BM; nN = N / BM; nwg = nM * nN; G = G_; c = c_; tA = (size_t)BM * lda * 2; tB = (size_t)BM * ldb * 2; amask = amask_; acol = acol_; }
    __device__ bool next(int i, Unit& u) const {
        const long L = (long)i * G + c; if (c >= G || L >= nwg) return false;
        const int wgid = xcd_remap((int)L, nwg);
        const int nig = WGM * nN, gid = wgid / nig, fm = gid * WGM, gsz = (nM - fm) < WGM ? (nM - fm) : WGM;
        u.pm = __builtin_amdgcn_readfirstlane(fm + ((wgid % nig) % gsz)); u.pn = __builtin_amdgcn_readfirstlane((wgid % nig) / gsz); u.aux0 = 0; u.aux1 = 0;
        u.a = uptr(A + (size_t)u.pm * tA + (size_t)(u.pn & amask) * acol); u.b = uptr(B + (size_t)u.pn * tB); return true; }
    __device__ unsigned goff(const Unit&, int) const { return 0u; }
};

#define PG8_SA(b, h) (((b) * 2 + (h)) * HTB)
#define PG8_SB(b, h) ((4 + (b) * 2 + (h)) * HTB)
__device__ __forceinline__ void glds16(const char* sbase, unsigned voff, unsigned ldsaddr) { unsigned keep;
    asm volatile("s_mov_b32 %0, m0\n\ts_mov_b32 m0, %3\n\ts_nop 0\n\tglobal_load_lds_dwordx4 %1, %2\n\ts_mov_b32 m0, %0" : "=&s"(keep) : "v"(voff), "s"(sbase), "s"(ldsaddr) : "memory"); }
#ifndef PG8_ASM_DMA
#define PG8_ASM_DMA 0
#endif
#if PG8_ASM_DMA
#define PG8_GLDS(gp, voff, ldsoff) glds16((const char*)(gp), (voff), ldsbase + (unsigned)(ldsoff))
#else
#define PG8_GLDS(gp, voff, ldsoff) __builtin_amdgcn_global_load_lds((const unsigned*)((const char*)(gp) + (voff)), (LAS unsigned*)(lds + (ldsoff)), 16, 0, 0)
#endif
#define PG8_STAGE_B(bufoff, gbase) do { PG8_GLDS(gbase, voffB[0], (bufoff) + ldsw); PG8_GLDS(gbase, voffB[1], (bufoff) + ldsw + 8192); } while (0)
#define PG8_STAGE_A(bufoff, gbase, h, NX) do { if constexpr (Sched::GATHER) { \
        PG8_GLDS(gbase, ((NX) ? vAn[h][0] : vAc[h][0]), (bufoff) + ldsw); PG8_GLDS(gbase, ((NX) ? vAn[h][1] : vAc[h][1]), (bufoff) + ldsw + 8192); \
    } else { PG8_GLDS((const char*)(gbase) + (h) * hstepA, voffA[0], (bufoff) + ldsw); PG8_GLDS((const char*)(gbase) + (h) * hstepA, voffA[1], (bufoff) + ldsw + 8192); } } while (0)
#define PG8_LDA(dst, b, h) do { _Pragma("unroll") for (int m = 0; m < 4; ++m) _Pragma("unroll") for (int k = 0; k < 2; ++k) dst[m][k] = *(const LAS bf16x8*)(lds + PG8_SA(b, h) + aoff + m * 2048 + k * 1024); } while (0)
#define PG8_LDB(dst, b, h) do { _Pragma("unroll") for (int n = 0; n < 2; ++n) _Pragma("unroll") for (int k = 0; k < 2; ++k) dst[n][k] = *(const LAS bf16x8*)(lds + PG8_SB(b, h) + boff + n * 2048 + k * 1024); } while (0)
#define PG8_MMA(ai, bj, At, Bt) do { __builtin_amdgcn_s_setprio(1); _Pragma("unroll") for (int m = 0; m < 4; ++m) _Pragma("unroll") for (int n = 0; n < 2; ++n) _Pragma("unroll") for (int k = 0; k < 2; ++k) \
        acc[ai][bj][m][n] = __builtin_amdgcn_mfma_f32_16x16x32_bf16(Bt[n][k], At[m][k], acc[ai][bj][m][n], 0, 0, 0); __builtin_amdgcn_s_setprio(0); } while (0)
#define PG8_WAIT_V(n) asm volatile("s_waitcnt vmcnt(" #n ")" ::: "memory")
#define PG8_WAIT_L(n) asm volatile("s_waitcnt lgkmcnt(" #n ")" ::: "memory")
#define PG8_BAR __builtin_amdgcn_s_barrier()
#define PG8_SCHED __builtin_amdgcn_sched_barrier(0)

template <class Epi, class Sched>
__device__ __forceinline__ void gemm_phase(LAS uchar* lds, const Sched& S, const Epi& E, const int K, const int lda, const int ldb) {
    int tid = threadIdx.x; asm volatile("" : "+v"(tid));
    const int wid = __builtin_amdgcn_readfirstlane(tid >> 6), lane = tid & 63, wr = wid >> 2, wc = wid & 3; int fr = lane & 15, fq = lane >> 4;
    int nt = K / BK; asm volatile("" : "+s"(nt));
    unsigned voffA[2], voffB[2]; int Rs[2], Cs[2];
#pragma unroll
    for (int i = 0; i < 2; ++i) { int R, C; stage_rc(tid * 16 + i * 8192, R, C); const int Rb = Epi::PERM ? ((R & ~31) + perm32(R & 31)) : R;
        Rs[i] = R; Cs[i] = C; voffA[i] = (unsigned)(R * lda + C) * 2u; voffB[i] = (unsigned)(Rb * ldb + C) * 2u; }
    const size_t kstep = (size_t)(BK * 2);
    const size_t hstepA = (size_t)HALF * lda * 2, hstepB = (size_t)HALF * ldb * 2;
    const unsigned ldsw = (unsigned)wid * 1024u;
    const unsigned ldsbase = (unsigned)(uintptr_t)lds;
    const int aoff = lds_byte(wr * 64 + fr, fq * 8), boff = lds_byte(wc * 32 + fr, fq * 8);
    Unit cur, nxt; int ui = 0;
    if (!S.next(0, cur)) return;
    unsigned vAc[2][2], vAn[2][2];
#pragma unroll
    for (int h = 0; h < 2; ++h)
#pragma unroll
        for (int i = 0; i < 2; ++i) { vAc[h][i] = 0u; vAn[h][i] = 0u; }
    if constexpr (Sched::GATHER) {
#pragma unroll
        for (int h = 0; h < 2; ++h)
#pragma unroll
            for (int i = 0; i < 2; ++i) vAc[h][i] = S.goff(cur, h * HALF + Rs[i]) + (unsigned)Cs[i] * 2u;
    }
    f32x4 acc[2][2][4][2];
#pragma unroll
    for (int a = 0; a < 2; ++a)
#pragma unroll
        for (int b = 0; b < 2; ++b)
#pragma unroll
            for (int m = 0; m < 4; ++m)
#pragma unroll
                for (int n = 0; n < 2; ++n) acc[a][b][m][n] = (f32x4){0.f, 0.f, 0.f, 0.f};
    bf16x8 At[4][2], B0[2][2], B1[2][2];
    const char* cA = cur.a; const char* cB = cur.b;
    PG8_STAGE_B(PG8_SB(0, 0), cB); PG8_STAGE_B(PG8_SB(0, 1), cB + hstepB); PG8_STAGE_A(PG8_SA(0, 0), cA, 0, false); PG8_STAGE_A(PG8_SA(0, 1), cA, 1, false);
    if (wr == 1) PG8_BAR;
    PG8_WAIT_V(2); PG8_BAR;
    PG8_STAGE_B(PG8_SB(1, 0), cB + kstep); PG8_STAGE_A(PG8_SA(1, 0), cA + kstep, 0, false); PG8_STAGE_B(PG8_SB(1, 1), cB + hstepB + kstep);
    PG8_WAIT_V(6); PG8_BAR;
    for (;;) {
        const bool has_next = S.next(ui + 1, nxt);
        if constexpr (Sched::GATHER) { if (has_next) {
#pragma unroll
            for (int h = 0; h < 2; ++h)
#pragma unroll
                for (int i = 0; i < 2; ++i) vAn[h][i] = S.goff(nxt, h * HALF + Rs[i]) + (unsigned)Cs[i] * 2u; } }
        const char* nA = has_next ? nxt.a : cA; const char* nB = has_next ? nxt.b : cB;
        for (int t = 0; t < nt; t += 2) {
            const bool last = (t == nt - 2);
            const bool nx = last && has_next;
            const char* a1 = cA + (size_t)(t + 1) * kstep;
            const char* a2 = last ? nA : cA + (size_t)(t + 2) * kstep; const char* b2 = last ? nB : cB + (size_t)(t + 2) * kstep;
            const char* a3 = a2 + kstep; const char* b3 = b2 + kstep;
            PG8_LDB(B0, 0, 0); PG8_LDB(B1, 0, 1); PG8_SCHED; PG8_LDA(At, 0, 0); PG8_STAGE_A(PG8_SA(1, 1), a1, 1, false);
            PG8_WAIT_V(8); PG8_WAIT_L(0); PG8_BAR; PG8_MMA(0, 0, At, B0); PG8_MMA(0, 1, At, B1); PG8_BAR; PG8_SCHED;
            PG8_LDA(At, 0, 1); PG8_STAGE_B(PG8_SB(0, 0), b2); PG8_STAGE_B(PG8_SB(0, 1), b2 + hstepB); PG8_STAGE_A(PG8_SA(0, 0), a2, 0, nx);
            PG8_WAIT_V(8); PG8_WAIT_L(0); PG8_BAR; PG8_MMA(1, 0, At, B0); PG8_MMA(1, 1, At, B1); PG8_BAR; PG8_SCHED;
            PG8_LDB(B0, 1, 0); PG8_LDB(B1, 1, 1); PG8_SCHED; PG8_LDA(At, 1, 0); PG8_STAGE_A(PG8_SA(0, 1), a2, 1, nx);
            PG8_WAIT_V(8); PG8_WAIT_L(0); PG8_BAR; PG8_MMA(0, 0, At, B0); PG8_MMA(0, 1, At, B1); PG8_BAR; PG8_SCHED;
            PG8_LDA(At, 1, 1); PG8_STAGE_B(PG8_SB(1, 0), b3); PG8_STAGE_B(PG8_SB(1, 1), b3 + hstepB); PG8_STAGE_A(PG8_SA(1, 0), a3, 0, nx);
            PG8_WAIT_V(8); PG8_WAIT_L(0); PG8_BAR; PG8_MMA(1, 0, At, B0); PG8_MMA(1, 1, At, B1); PG8_BAR; PG8_SCHED;
        }
        if (wr == 0) PG8_BAR;
        E(acc, cur, wr, wc, fr, fq);
        if (!has_next) break;
#pragma unroll
        for (int a = 0; a < 2; ++a)
#pragma unroll
            for (int b = 0; b < 2; ++b)
#pragma unroll
                for (int m = 0; m < 4; ++m)
#pragma unroll
                    for (int n = 0; n < 2; ++n) acc[a][b][m][n] = (f32x4){0.f, 0.f, 0.f, 0.f};
        cur = nxt; cA = nA; cB = nB; ++ui;
        if constexpr (Sched::GATHER) {
#pragma unroll
            for (int h = 0; h < 2; ++h)
#pragma unroll
                for (int i = 0; i < 2; ++i) vAc[h][i] = vAn[h][i]; }
        if (wr == 1) PG8_BAR;
    }
    PG8_WAIT_V(0);
    PG8_BAR;
}
}

#ifndef ATT_SDEPTH
#define ATT_SDEPTH 1
#endif
namespace att {
constexpr int NW = 8, QBLK = 32, KVBLK = 64;
constexpr float SCALE = 0.088388347648318440f;
constexpr float THR = 8.f;
constexpr int LDQ = 1536, LDK = 1536, LDO = 1024;
constexpr size_t SHM_V = KVBLK * 128 * 2, SHM_K = KVBLK * 128 * 2, SHM_ATTN = 2 * SHM_V + 2 * SHM_K + NW * 64 * 4;
#define KSWZ(row, colB) ((row) * 256 + ((colB) ^ (((row) & 7) << 4)))
#define SBAR() __builtin_amdgcn_sched_barrier(0)
__device__ __forceinline__ int crow(int r, int hi) { return (r & 3) + 8 * (r >> 2) + 4 * hi; }
__device__ __forceinline__ void partialSM(f32x16& p0, f32x16& p1, float& m_reg, float& mn, float& alpha) {
  constexpr float C = SCALE * 1.4426950408889634f;
  float pmax = p0[0];
#pragma unroll
  for (int r = 1; r < 16; ++r) pmax = fmaxf(pmax, p0[r]);
#pragma unroll
  for (int r = 0; r < 16; ++r) pmax = fmaxf(pmax, p1[r]);
  { auto rr = __builtin_amdgcn_permlane32_swap(__float_as_uint(pmax), __float_as_uint(pmax), false, false);
    pmax = fmaxf(__uint_as_float(rr[0]), __uint_as_float(rr[1])); }
  if (__builtin_expect(__all(pmax - m_reg <= THR / SCALE), 1)) { mn = m_reg; alpha = 1.f; }
  else { mn = fmaxf(m_reg, pmax); alpha = __builtin_amdgcn_exp2f((m_reg - mn) * C); m_reg = mn; }
  float mnC = -mn * C;
#pragma unroll
  for (int r = 0; r < 16; ++r) p0[r] = fmaf(p0[r], C, mnC);
#pragma unroll
  for (int r = 0; r < 16; ++r) p1[r] = fmaf(p1[r], C, mnC);
#pragma unroll
  for (int r = 0; r < 16; ++r) p0[r] = __builtin_amdgcn_exp2f(p0[r]);
}
__device__ __forceinline__ void finishSM(f32x16& p0, f32x16& p1, float alpha, float& l_reg, bf16x8& pa0, bf16x8& pa1, bf16x8& pa2, bf16x8& pa3) {
#pragma unroll
  for (int r = 0; r < 16; ++r) p1[r] = __builtin_amdgcn_exp2f(p1[r]);
  float ps = 0;
#pragma unroll
  for (int r = 0; r < 16; ++r) ps += p0[r];
#pragma unroll
  for (int r = 0; r < 16; ++r) ps += p1[r];
  { auto rr = __builtin_amdgcn_permlane32_swap(__float_as_uint(ps), __float_as_uint(ps), false, false);
    ps = __uint_as_float(rr[0]) + __uint_as_float(rr[1]); }
  l_reg = l_reg * alpha + ps;
#define PK4(P, BASE, OUT) do { unsigned a0 = cvt_pk_bf16(P[BASE + 0], P[BASE + 1]), a1 = cvt_pk_bf16(P[BASE + 2], P[BASE + 3]);   \
    unsigned b0 = cvt_pk_bf16(P[BASE + 4], P[BASE + 5]), b1 = cvt_pk_bf16(P[BASE + 6], P[BASE + 7]);                              \
    auto r0 = __builtin_amdgcn_permlane32_swap(a0, b0, false, false); auto r1 = __builtin_amdgcn_permlane32_swap(a1, b1, false, false); \
    u32x4 w = {r0[0], r1[0], r0[1], r1[1]}; OUT = __builtin_bit_cast(bf16x8, w); } while (0)
  PK4(p0, 0, pa0); PK4(p0, 8, pa1); PK4(p1, 0, pa2); PK4(p1, 8, pa3);
#undef PK4
}
__device__ __forceinline__ void qkt(f32x16& p0, f32x16& p1, const bf16_t* Ks, const bf16x8* qr, int r32, int hi) {
  p0 = f32x16{}; p1 = f32x16{};
#pragma unroll
  for (int d0 = 0; d0 < 8; ++d0) { int cb = (d0 * 16 + hi * 8) * 2;
    bf16x8 b0 = *reinterpret_cast<const bf16x8*>((const char*)Ks + KSWZ(r32, cb));
    bf16x8 b1 = *reinterpret_cast<const bf16x8*>((const char*)Ks + KSWZ(32 + r32, cb));
    p0 = __builtin_amdgcn_mfma_f32_32x32x16_bf16(b0, qr[d0], p0, 0, 0, 0);
    p1 = __builtin_amdgcn_mfma_f32_32x32x16_bf16(b1, qr[d0], p1, 0, 0, 0); }
}
__device__ __forceinline__ int v_st(int k, int c) { const int kk = (k & ~0xC) | ((k & 4) << 1) | ((k & 8) >> 1); return ((kk >> 3) * 4 + (c >> 5)) * 512 + ((kk & 7) * 32 + (c & 31)) * 2; }
__device__ __forceinline__ int v_rd_base(int lane) { return ((lane & 3) << 3) | (((lane >> 2) & 3) << 6) | (((lane >> 4) & 1) << 5) | (((lane >> 5) & 1) << 8); }
constexpr int v_rd_off(int d0, int ks, int half) { return d0 * 512 + ks * 4096 + half * 2048; }
template <int OFF> __device__ __forceinline__ s16x4 tr_read(int vb) {
  s16x4 r; asm volatile("ds_read_b64_tr_b16 %0, %1 offset:%2" : "=&v"(r) : "v"(vb), "i"(OFF) : "memory"); return r;
}
template <int D0> __device__ __forceinline__ void pv_one(f32x16& od, int vb, bf16x8 pa0, bf16x8 pa1, bf16x8 pa2, bf16x8 pa3) {
  const s16x4 l0 = tr_read<v_rd_off(D0, 0, 0)>(vb), h0 = tr_read<v_rd_off(D0, 0, 1)>(vb), l1 = tr_read<v_rd_off(D0, 1, 0)>(vb), h1 = tr_read<v_rd_off(D0, 1, 1)>(vb);
  const s16x4 l2 = tr_read<v_rd_off(D0, 2, 0)>(vb), h2 = tr_read<v_rd_off(D0, 2, 1)>(vb), l3 = tr_read<v_rd_off(D0, 3, 0)>(vb), h3 = tr_read<v_rd_off(D0, 3, 1)>(vb);
  asm volatile("s_waitcnt lgkmcnt(0)" ::: "memory"); SBAR();
#define PK(L, H) (bf16x8){L[0], L[1], L[2], L[3], H[0], H[1], H[2], H[3]}
  od = __builtin_amdgcn_mfma_f32_32x32x16_bf16(pa0, PK(l0, h0), od, 0, 0, 0);
  od = __builtin_amdgcn_mfma_f32_32x32x16_bf16(pa1, PK(l1, h1), od, 0, 0, 0);
  od = __builtin_amdgcn_mfma_f32_32x32x16_bf16(pa2, PK(l2, h2), od, 0, 0, 0);
  od = __builtin_amdgcn_mfma_f32_32x32x16_bf16(pa3, PK(l3, h3), od, 0, 0, 0);
#undef PK
}
__device__ __forceinline__ void pv_d0(f32x16* o, int vb, bf16x8 pa0, bf16x8 pa1, bf16x8 pa2, bf16x8 pa3) {
  pv_one<0>(o[0], vb, pa0, pa1, pa2, pa3); pv_one<1>(o[1], vb, pa0, pa1, pa2, pa3); pv_one<2>(o[2], vb, pa0, pa1, pa2, pa3); pv_one<3>(o[3], vb, pa0, pa1, pa2, pa3);
}
__device__ __forceinline__ void attn_dense_body(const bf16_t* Qb, const bf16_t* Kh, const bf16_t* Vh, bf16_t* Ob, int seq, char* lds, const int tid) {
  const int wid = tid >> 6, lane = tid & 63, r32 = lane & 31, hi = lane >> 5;
  bf16_t* V_lds = (bf16_t*)lds; bf16_t* K_lds = (bf16_t*)(lds + 2 * SHM_V);
  float* ws = (float*)(lds + 2 * SHM_V + 2 * SHM_K) + wid * 64; float* li_l = ws; float* al_l = ws + 32;
  float m_reg = -1e30f, l_reg = 0; f32x16 o[4] = {}; bf16x8 qr[8];
  const bf16_t* Qw = Qb + (long)(wid * QBLK + r32) * LDQ + hi * 8;
#pragma unroll
  for (int d0 = 0; d0 < 8; ++d0) qr[d0] = *reinterpret_cast<const bf16x8*>(Qw + d0 * 16);
  const int sr = tid >> 4, sc = (tid & 15) * 8, vst0 = v_st(sr, sc), vst1 = v_st(32 + sr, sc);
  const int vb0 = (int)(uintptr_t)V_lds + v_rd_base(lane);
  struct { bf16x8 vs0, vs1, ks0, ks1; } sr_[ATT_SDEPTH];
  const unsigned vo0 = (unsigned)(sr * LDK + sc) * 2u, vo1 = (unsigned)((32 + sr) * LDK + sc) * 2u;
  const long vdelta = (const char*)Vh - (const char*)Kh;
#define SLOAD(i, k0) do { const char* kb_ = (const char*)Kh + (size_t)(k0) * (LDK * 2); const char* vb_ = kb_ + vdelta; \
    sr_[i].vs0 = *reinterpret_cast<const bf16x8*>(vb_ + vo0); sr_[i].vs1 = *reinterpret_cast<const bf16x8*>(vb_ + vo1); \
    sr_[i].ks0 = *reinterpret_cast<const bf16x8*>(kb_ + vo0); sr_[i].ks1 = *reinterpret_cast<const bf16x8*>(kb_ + vo1); } while (0)
#define SWRITE(b, i) do { *(bf16x8*)((char*)V_lds + (b) * SHM_V + vst0) = sr_[i].vs0;          \
    *(bf16x8*)((char*)V_lds + (b) * SHM_V + vst1) = sr_[i].vs1; int kc = sc * 2;               \
    *(bf16x8*)((char*)K_lds + (b) * SHM_K + KSWZ(sr, kc)) = sr_[i].ks0;                       \
    *(bf16x8*)((char*)K_lds + (b) * SHM_K + KSWZ(32 + sr, kc)) = sr_[i].ks1; } while (0)
#define SWAIT() do { if constexpr (ATT_SDEPTH == 2) asm volatile("s_waitcnt vmcnt(4)" ::: "memory"); else asm volatile("s_waitcnt vmcnt(0)" ::: "memory"); } while (0)
#define RESC(a) do { if (__any((a) < 1.f)) { if (hi == 0) al_l[r32] = (a); asm volatile("s_waitcnt lgkmcnt(0)" ::: "memory"); \
    _Pragma("unroll") for (int d = 0; d < 4; ++d) _Pragma("unroll") for (int r = 0; r < 16; ++r) o[d][r] *= al_l[crow(r, hi)]; } } while (0)
  f32x16 pA0, pA1, pB0, pB1; float mnA, mnB, alA, alB; bf16x8 pa0, pa1, pa2, pa3; const int NT = seq / KVBLK;
  constexpr int SE = 0, SO = ATT_SDEPTH - 1;
  SLOAD(SE, 0); asm volatile("s_waitcnt vmcnt(0)" ::: "memory"); SWRITE(0, SE); __syncthreads();
  qkt(pA0, pA1, K_lds, qr, r32, hi); partialSM(pA0, pA1, m_reg, mnA, alA);
  SLOAD(SO, KVBLK); if constexpr (ATT_SDEPTH == 2) { if (2 < NT) SLOAD(SE, 2 * KVBLK); }
  SWAIT(); SWRITE(1, SO); __syncthreads();
  for (int j = 1; j + 1 < NT; j += 2) {
    SBAR(); qkt(pB0, pB1, (bf16_t*)((char*)K_lds + SHM_K), qr, r32, hi);
    finishSM(pA0, pA1, alA, l_reg, pa0, pa1, pa2, pa3); SBAR();
    SLOAD(SO, (j + ATT_SDEPTH) * KVBLK); SBAR();
    pv_d0(o, vb0, pa0, pa1, pa2, pa3); partialSM(pB0, pB1, m_reg, mnB, alB);
    __syncthreads(); SWAIT(); SWRITE(0, SE);
    RESC(alB); __syncthreads();
    SBAR(); qkt(pA0, pA1, K_lds, qr, r32, hi);
    finishSM(pB0, pB1, alB, l_reg, pa0, pa1, pa2, pa3); SBAR();
    if (ATT_SDEPTH == 1 || j + 3 < NT) SLOAD(SE, (j + 1 + ATT_SDEPTH) * KVBLK); SBAR();
    pv_d0(o, vb0 + (int)SHM_V, pa0, pa1, pa2, pa3); partialSM(pA0, pA1, m_reg, mnA, alA);
    __syncthreads(); SWAIT(); SWRITE(1, SO);
    RESC(alA); __syncthreads();
  }
  SBAR(); qkt(pB0, pB1, (bf16_t*)((char*)K_lds + SHM_K), qr, r32, hi);
  finishSM(pA0, pA1, alA, l_reg, pa0, pa1, pa2, pa3); SBAR();
  pv_d0(o, vb0, pa0, pa1, pa2, pa3); partialSM(pB0, pB1, m_reg, mnB, alB);
  __syncthreads(); RESC(alB);
  finishSM(pB0, pB1, alB, l_reg, pa0, pa1, pa2, pa3); SBAR();
  pv_d0(o, vb0 + (int)SHM_V, pa0, pa1, pa2, pa3);
  if (hi == 0) li_l[r32] = l_reg; asm volatile("s_waitcnt lgkmcnt(0)" ::: "memory");
  float rli[16];
#pragma unroll
  for (int r = 0; r < 16; ++r) rli[r] = __builtin_amdgcn_rcpf(li_l[crow(r, hi)]);
  bf16_t* Ow = Ob + (long)(wid * QBLK) * LDO;
#pragma unroll
  for (int r = 0; r < 16; ++r) { int orow = crow(r, hi);
#pragma unroll
    for (int d0 = 0; d0 < 4; ++d0) Ow[(long)orow * LDO + d0 * 32 + r32] = (bf16_t)f2bf(o[d0][r] * rli[r]); }
#undef SLOAD
#undef SWRITE
#undef SWAIT
#undef RESC
}
}

#define XB_TMO      128
#define XB_XCNT(j)  (256  + 64 * (j))
#define XB_XSUB(j)  (1280 + 64 * (j))
#define XB_XGEN(j)  (2304 + 64 * (j))
#define XB_TOP      3328
#define XB_TOPGEN   3392
#define XB_SPIN_CAP (1u << 22)
__device__ __forceinline__ unsigned xb_ld(unsigned* p)              { return __hip_atomic_load(p, __ATOMIC_RELAXED, __HIP_MEMORY_SCOPE_AGENT); }
__device__ __forceinline__ unsigned xb_add(unsigned* p, unsigned v) { return __hip_atomic_fetch_add(p, v, __ATOMIC_RELAXED, __HIP_MEMORY_SCOPE_AGENT); }
__device__ __forceinline__ unsigned xb_xcc_id() { return (unsigned)__builtin_amdgcn_s_getreg((3 << 11) | 20) & 0xFu; }
#define XB_SPIN(cond, bar) do { unsigned _sp = 0; while (cond) { __builtin_amdgcn_s_sleep(1); \
    if ((++_sp & 255u) == 0u) { if (xb_ld(&(bar)[XB_TMO])) break; if (_sp > XB_SPIN_CAP) { atomicAdd(&(bar)[XB_TMO], 1u); break; } } } } while (0)
struct XcdBarrier { unsigned* bar; unsigned x; volatile LAS unsigned* st; };
__device__ __forceinline__ XcdBarrier xcd_barrier_post(unsigned* bar, volatile LAS unsigned* st) {
    XcdBarrier b; b.bar = bar; b.x = xb_xcc_id(); b.st = st;
    if (threadIdx.x == 0) (void)xb_add(&bar[XB_XCNT(b.x)], 1u);
    return b;
}
__device__ __forceinline__ void xcd_barrier_complete(unsigned* bar, unsigned x, unsigned& nloc, unsigned& nx) {
    const unsigned G = gridDim.x * gridDim.y * gridDim.z;
    unsigned sum, cnt, mine, sp = 0u;
    for (;;) {
        sum = 0u; cnt = 0u; mine = 0u;
#pragma unroll
        for (unsigned j = 0; j < 16; ++j) { const unsigned c = xb_ld(&bar[XB_XCNT(j)]); sum += c; cnt += (c > 0u) ? 1u : 0u; mine = (j == x) ? c : mine; }
        if (sum == G) break;
        __builtin_amdgcn_s_sleep(1);
        if ((++sp & 255u) == 0u) { if (xb_ld(&bar[XB_TMO])) break; if (sp > XB_SPIN_CAP) { atomicAdd(&bar[XB_TMO], 1u); break; } }
    }
    nloc = mine > 0u ? mine : 1u; nx = cnt > 0u ? cnt : 1u;
}
__device__ __forceinline__ void xcd_barrier(const XcdBarrier& b_) {
    XcdBarrier b; b.bar = b_.bar; b.st = b_.st; b.x = xb_xcc_id();
    asm volatile("s_waitcnt vmcnt(0)" ::: "memory");
    __syncthreads();
    if (threadIdx.x == 0) {
        unsigned* bar = b.bar;
        __builtin_amdgcn_s_waitcnt(0);
        unsigned nloc = b.st[0], nx = b.st[1];
        if (nloc == 0u) { xcd_barrier_complete(bar, b.x, nloc, nx); b.st[0] = nloc; b.st[1] = nx; }
        const unsigned old = xb_add(&bar[XB_XSUB(b.x)], 1u);
        const unsigned gen = old / nloc;
        if (old + 1u == (gen + 1u) * nloc) {
            __builtin_amdgcn_fence(__ATOMIC_RELEASE, "agent");
            asm volatile("s_waitcnt vmcnt(0)" ::: "memory");
            const unsigned og = xb_add(&bar[XB_TOP], 1u);
            const unsigned tg = og / nx;
            if (og + 1u == (tg + 1u) * nx) xb_add(&bar[XB_TOPGEN], 1u);
            else XB_SPIN(xb_ld(&bar[XB_TOPGEN]) == tg, bar);
            __builtin_amdgcn_fence(__ATOMIC_ACQUIRE, "agent");
            xb_add(&bar[XB_XGEN(b.x)], 1u);
            asm volatile("s_waitcnt vmcnt(0)" ::: "memory");
        } else {
            XB_SPIN(xb_ld(&bar[XB_XGEN(b.x)]) == gen, bar);
            __builtin_amdgcn_fence(__ATOMIC_ACQUIRE, "agent");
            asm volatile("s_waitcnt vmcnt(0)" ::: "memory");
        }
    }
    __syncthreads();
}

struct Args { const float* in[34]; float* out; uchar* ws; int ph_lo, ph_hi; };
enum { I_X = 0, I_C, I_CTX, I_CCTX, I_ADAW, I_ADAB, I_NMG, I_NFG, I_RGWIN, I_RGCW, I_RGCB, I_RGWA, I_RGBA, I_RGWI, I_RGBI, I_RGLAM, I_RGWOUT,
       I_ATQKV, I_ATQG, I_ATKG, I_ATWO, I_CMWIN, I_CMLNG, I_CMLNB, I_CMWS, I_CMBS, I_CMWOUT, I_MWG, I_MBG, I_MWR, I_MBR, I_MWGATE, I_MWUP, I_MWDOWN };

__device__ __forceinline__ const void* opaque_uniform_ptr(const void* p) { const unsigned long long v = (unsigned long long)p; unsigned lo = (unsigned)v, hi = (unsigned)(v >> 32); asm volatile("" : "+v"(lo), "+v"(hi));
    lo = __builtin_amdgcn_readfirstlane(lo); hi = __builtin_amdgcn_readfirstlane(hi); return (const void*)(const GAS char*)(((unsigned long long)hi << 32) | lo); }
__device__ __forceinline__ int opaque_uniform_int(int x) { asm volatile("" : "+v"(x)); return __builtin_amdgcn_readfirstlane(x); }
struct Frame {
    LAS uchar* lds; char* ldsg;
    int tid, lane, wave, G, bid;
    uchar* ws; float* out;
};
__device__ __forceinline__ const float* inp(const Frame& F, int i) { const unsigned long long v = *(const LAS unsigned long long*)(F.lds + LDSCTL_OFF + 576 + i * 8);
    const unsigned lo = __builtin_amdgcn_readfirstlane((unsigned)v), hi = __builtin_amdgcn_readfirstlane((unsigned)(v >> 32)); return (const float*)(const GAS float*)(((unsigned long long)hi << 32) | lo); }
__device__ __forceinline__ float wave16_sum(float v) {
    v += __int_as_float(__builtin_amdgcn_update_dpp(0, __float_as_int(v), 0xB1, 0xF, 0xF, true));
    v += __int_as_float(__builtin_amdgcn_update_dpp(0, __float_as_int(v), 0x4E, 0xF, 0xF, true));
    v += __int_as_float(__builtin_amdgcn_update_dpp(0, __float_as_int(v), 0x141, 0xF, 0xF, true));
    v += __int_as_float(__builtin_amdgcn_update_dpp(0, __float_as_int(v), 0x140, 0xF, 0xF, true));
    return v; }

struct ConvItem { const float* src; bf16_t* dst; int ldw; };
__device__ __forceinline__ void tr_load(const ConvItem& ci, f32x4 (&v)[16]) {
#pragma unroll
    for (int i = 0; i < 16; ++i) v[i] = __builtin_nontemporal_load((const f32x4*)(ci.src + (size_t)(4 * i) * ci.ldw));
}
__device__ __forceinline__ void tr_finish(const f32x4 (&v)[16], bf16_t* dst, LAS uchar* scr, int lane) {
    const int kr = lane >> 4, nc = (lane & 15) * 4;
#pragma unroll
    for (int i = 0; i < 16; ++i) { u32x2 o; o.x = pk2(v[i].x, v[i].y); o.y = pk2(v[i].z, v[i].w); *(LAS u32x2*)(scr + (4 * i + kr) * 128 + nc * 2) = o; }
    asm volatile("s_waitcnt lgkmcnt(0)" ::: "memory");
    const int g = lane >> 4, q = (lane >> 2) & 3, p = lane & 3;
    const int vb = (int)(uintptr_t)scr + q * 128 + g * 32 + p * 8;
    s16x4 t[16];
#define TRR(r) t[r] = att::tr_read<(r) * 512>(vb)
    TRR(0); TRR(1); TRR(2); TRR(3); TRR(4); TRR(5); TRR(6); TRR(7); TRR(8); TRR(9); TRR(10); TRR(11); TRR(12); TRR(13); TRR(14); TRR(15);
#undef TRR
    asm volatile("s_waitcnt lgkmcnt(0)" ::: "memory"); __builtin_amdgcn_sched_barrier(0);
#pragma unroll
    for (int j = 0; j < 8; ++j) { const bf16x8 o = {t[2 * j][0], t[2 * j][1], t[2 * j][2], t[2 * j][3], t[2 * j + 1][0], t[2 * j + 1][1], t[2 * j + 1][2], t[2 * j + 1][3]}; *(bf16x8*)(dst + 8 * j) = o; }
}
struct Job { int g, lo, hi; };
__device__ __forceinline__ ConvItem conv_decode(Frame& F, int g, int it) {
    uchar* ws = F.ws; const float* W; int K = 1024, N = 1024, ldt = 1024, mode = 0; size_t dms = 0; bf16_t* WT;
    switch (g) {
        case 0:  W = inp(F, I_MWGATE); N = 512; WT = (bf16_t*)(ws + WS_W_E1); dms = (size_t)1024 * 1024; mode = 1; break;
        case 1:  W = inp(F, I_MWUP);   N = 512; WT = (bf16_t*)(ws + WS_W_E1); dms = (size_t)1024 * 1024; mode = 2; break;
        case 2:  W = inp(F, I_MWDOWN); K = 512; WT = (bf16_t*)(ws + WS_W_E2); ldt = 512; dms = (size_t)1024 * 512; break;
        case 3:  W = inp(F, I_RGWIN);  N = 2048; WT = (bf16_t*)(ws + WS_W_RGIN); dms = (size_t)2048 * 1024; break;
        case 4:  W = inp(F, I_CMWIN);  N = 4096; WT = (bf16_t*)(ws + WS_W_CMIN); break;
        case 5:  W = inp(F, I_RGWOUT); WT = (bf16_t*)(ws + WS_W_RGOUT); dms = (size_t)1024 * 1024; break;
        case 6:  W = inp(F, I_CMWOUT); K = 2048; WT = (bf16_t*)(ws + WS_W_CMOUT); ldt = 2048; break;
        case 7:  W = inp(F, I_ATQKV);  N = 1536; WT = (bf16_t*)(ws + WS_W_QKV); break;
        case 8:  W = inp(F, I_ATWO);   WT = (bf16_t*)(ws + WS_W_AO); break;
        case 9:  W = inp(F, I_RGWA);   K = 128; N = 128; WT = (bf16_t*)(ws + WS_W_RGG); ldt = 128; dms = (size_t)256 * 128; break;
        default: W = inp(F, I_RGWI);   K = 128; N = 128; WT = (bf16_t*)(ws + WS_W_RGG); ldt = 128; dms = (size_t)256 * 128; mode = 3; break;
    }
    const int nblk = N / 64, per = (K / 64) * nblk, mat = it / per, r = it - mat * per, kb = r / nblk, nb = r - kb * nblk, n0 = nb * 64;
    int drow = n0;
    if (mode == 1) drow = (n0 >> 7) * 256 + (n0 & 127); else if (mode == 2) drow = (n0 >> 7) * 256 + 128 + (n0 & 127); else if (mode == 3) drow = 128 + n0;
    const int lane = F.lane;
    ConvItem ci; ci.ldw = N; ci.src = W + (size_t)mat * K * N + (size_t)(kb * 64 + (lane >> 4)) * N + n0 + (lane & 15) * 4;
    ci.dst = WT + (size_t)mat * dms + (size_t)(drow + (lane >> 4) * 16 + (lane & 15)) * ldt + kb * 64;
    return ci;
}
template <int NJ>
__device__ __forceinline__ ConvItem conv_find(Frame& F, int v, const Job (&jobs)[NJ]) { int r = v, g = jobs[0].g, it = 0; bool found = false;
#pragma unroll
    for (int q = 0; q < NJ; ++q) { const int n = jobs[q].hi - jobs[q].lo; if (!found) { if (r < n) { g = jobs[q].g; it = jobs[q].lo + r; found = true; } else r -= n; } }
    return conv_decode(F, g, it); }
template <int NJ>
__device__ __forceinline__ void conv_tail(Frame& F, int nblk0, const Job (&jobs)[NJ]) {
    if (nblk0 >= F.G) nblk0 = 0;
    if (F.bid < nblk0) return;
    LAS uchar* scr = F.lds + F.wave * 8192;
    int total = 0;
#pragma unroll
    for (int q = 0; q < NJ; ++q) total += jobs[q].hi - jobs[q].lo;
    const int nw = (F.G - nblk0) * 8;
    int v0 = (F.bid - nblk0) * 8 + F.wave;
    f32x4 va[16], vb[16]; ConvItem c0, c1; c0.dst = nullptr; c1.dst = nullptr;
    if (v0 < total) { c0 = conv_find(F, v0, jobs); tr_load(c0, va); }
    for (; v0 < total; v0 += 2 * nw) {
        const int v1 = v0 + nw, v2 = v1 + nw;
        if (v1 < total) { c1 = conv_find(F, v1, jobs); tr_load(c1, vb); }
        tr_finish(va, c0.dst, scr, F.lane);
        if (v2 < total) { c0 = conv_find(F, v2, jobs); tr_load(c0, va); }
        if (v1 < total) tr_finish(vb, c1.dst, scr, F.lane);
    }
}
__device__ __forceinline__ void p0_prologue(Frame& F) {
    uchar* ws = F.ws;
    {
        LAS float* act = (LAS float*)(F.lds);
        LAS float* red = (LAS float*)(F.lds + 5 * 1024 * 4);
        bool have = false; const float* pC = inp(F, I_C); const float* pCC = inp(F, I_CCTX); const float* pADAW = inp(F, I_ADAW); const float* pADAB = inp(F, I_ADAB);
        for (int it = F.bid; it < DEPTH * 24; it += F.G) {
            if (!have) { for (int i = F.tid; i < 5 * 1024; i += 512) { const int s = i >> 10, k = i & 1023; const float v = s < 4 ? pC[s * 1024 + k] : pCC[k]; act[i] = v / (1.f + __expf(-v)); } have = true; __syncthreads(); }
            const int l = it / 24, cb = it % 24;
            const float* W = pADAW + (size_t)l * 1024 * NMODV + cb * 256 + F.lane * 4;
            f32x4 a[5];
#pragma unroll
            for (int s = 0; s < 5; ++s) a[s] = (f32x4){0.f, 0.f, 0.f, 0.f};
            const int kbase = F.wave * 128;
#pragma unroll 8
            for (int k = 0; k < 128; ++k) { const f32x4 w = *(const f32x4*)(W + (size_t)(kbase + k) * NMODV);
#pragma unroll
                for (int s = 0; s < 5; ++s) a[s] += w * act[s * 1024 + kbase + k]; }
#pragma unroll
            for (int s = 0; s < 5; ++s) *(LAS f32x4*)(red + (F.wave * 5 + s) * 256 + F.lane * 4) = a[s];
            __syncthreads();
            for (int i = F.tid; i < 5 * 256; i += 512) { const int s = i >> 8, c = i & 255; float v = pADAB[l * NMODV + cb * 256 + c];
#pragma unroll
                for (int w = 0; w < 8; ++w) v += red[(w * 5 + s) * 256 + c];
                ((float*)(ws + WS_MOD))[(l * 5 + s) * NMODV + cb * 256 + c] = v; }
            __syncthreads();
        }
        __syncthreads();
    }
    { const Job jobs[11] = {{0, 0, 16384}, {1, 0, 16384}, {2, 0, 16384}, {3, 0, 1024}, {4, 0, 1024}, {5, 0, 512}, {6, 0, 512}, {7, 0, 384}, {8, 0, 256}, {9, 0, 128}, {10, 0, 128}}; conv_tail(F, 0, jobs); }
    {
        const int gt = F.bid * 512 + F.tid, NGT = F.G * 512;
        { const float* pctx = inp(F, I_CTX); const float* px = inp(F, I_X);
          for (int i0 = gt; i0 < T * 256; i0 += 4 * NGT) { f32x4 v[4];
#pragma unroll
            for (int q = 0; q < 4; ++q) { const int i = i0 + q * NGT; if (i < T * 256) { const int row = i >> 8, c4 = i & 255, b = row / SB, s = row - b * SB;
                const float* src = s < CTX ? pctx + ((size_t)(b * CTX + s) << 10) : px + ((size_t)(b * SEQ + s - CTX) << 10); v[q] = ((const f32x4*)src)[c4]; } }
#pragma unroll
            for (int q = 0; q < 4; ++q) { const int i = i0 + q * NGT; if (i < T * 256) ((f32x4*)(ws + WS_X))[i] = v[q]; } } }
        for (int i = gt; i < 8 * 128 * 128 / 4; i += NGT) { const f32x4 v = ((const f32x4*)inp(F, I_CMWS))[i]; u32x2 o; o.x = pk2(v.x, v.y); o.y = pk2(v.z, v.w); ((u32x2*)(ws + WS_W_CMS))[i] = o; }
        for (int i = gt; i < 2 * 2 * D; i += NGT) { const float* plam = inp(F, I_RGLAM); ((float*)(ws + WS_SPL))[i] = -8.f * log1pf(expf(-plam[i])); }
        for (int i = gt; i < 64 * 32; i += NGT) { const int pos = i >> 5, f = i & 31; const float inv = powf(10000.f, -(float)f * 2.0f / 64.0f); const float ang = (float)pos * inv;
            ((f32x2*)(ws + WS_ROPE))[i] = (f32x2){cosf(ang), sinf(ang)}; }
    }
}

template <bool ROUTE, int NADD>
__device__ __forceinline__ void norm_phase(Frame& F, int l, const float* gvec, int shift_i, bool skip_ctx_route, bool dry) {
    uchar* ws = F.ws;
    float* X = (float*)(ws + WS_X); const bf16_t* YS = (const bf16_t*)(ws + WS_Y1); const bf16_t* YM = (const bf16_t*)(ws + WS_YM); bf16_t* H = (bf16_t*)(ws + WS_H);
    const float* MOD = (const float*)(ws + WS_MOD) + (size_t)l * 5 * NMODV;
    LAS float* wr = (LAS float*)F.lds;
    if constexpr (ROUTE) {
        const float* wg = inp(F, I_MWG) + (size_t)l * 1024 * 4; const float* wrt = inp(F, I_MWR) + (size_t)l * 1024 * 32;
        for (int i0 = F.tid; i0 < 1024 * 9; i0 += 512 * 6) { f32x4 v[6];
#pragma unroll
            for (int u = 0; u < 6; ++u) { const int idx = i0 + u * 512; const int k = idx / 9, q = idx - k * 9; v[u] = q == 0 ? *(const f32x4*)(wg + k * 4) : *(const f32x4*)(wrt + k * 32 + (q - 1) * 4); }
#pragma unroll
            for (int u = 0; u < 6; ++u) { const int idx = i0 + u * 512; const int k = idx / 9, q = idx - k * 9;
                wr[(4 * q + 0) * 1024 + k] = v[u].x; wr[(4 * q + 1) * 1024 + k] = v[u].y; wr[(4 * q + 2) * 1024 + k] = v[u].z; wr[(4 * q + 3) * 1024 + k] = v[u].w; } }
        __syncthreads();
    }
    const int i16 = F.lane & 15, grp = F.lane >> 4;
    const float* bg = nullptr; const float* br = nullptr; if constexpr (ROUTE) { bg = inp(F, I_MBG) + l * 4; br = inp(F, I_MBR) + l * 32; }
    for (int tok = (F.bid * 8 + F.wave) * 4 + grp; tok < T; tok += F.G * 32) {
        asm volatile("" ::: "memory");
        const int sidx = sidx_of_row(tok);
        f32x4 x[16];
        float ss = 0.f;
#pragma unroll
        for (int j = 0; j < 16; ++j) { x[j] = *(const f32x4*)(X + (size_t)tok * D + 64 * j + 4 * i16);
            if constexpr (NADD >= 1) { const u32x2 ym = *(const u32x2*)(YM + (size_t)tok * D + 64 * j + 4 * i16); x[j] += (f32x4){bflo(ym.x), bfhi(ym.x), bflo(ym.y), bfhi(ym.y)}; }
            if constexpr (NADD == 3) { const u32x2 y0 = *(const u32x2*)(YS + (size_t)tok * D + 64 * j + 4 * i16), y1 = *(const u32x2*)(YS + ((size_t)T + tok) * D + 64 * j + 4 * i16);
                x[j] += (f32x4){bflo(y0.x) + bflo(y1.x), bfhi(y0.x) + bfhi(y1.x), bflo(y0.y) + bflo(y1.y), bfhi(y0.y) + bfhi(y1.y)}; *(f32x4*)(X + (size_t)tok * D + 64 * j + 4 * i16) = x[j]; }
            ss += x[j].x * x[j].x + x[j].y * x[j].y + x[j].z * x[j].z + x[j].w * x[j].w; }
        ss = wave16_sum(ss);
        const float rstd = rsqrtf(ss * (1.f / D) + NORM_EPS);
        const float* shp = MOD + (size_t)sidx * NMODV + shift_i * D; const float* scp = shp + D;
#pragma unroll
        for (int j = 0; j < 16; ++j) { const int c = 64 * j + 4 * i16; const f32x4 g = *(const f32x4*)(gvec + c), sh = *(const f32x4*)(shp + c), sc = *(const f32x4*)(scp + c);
            x[j] = x[j] * rstd * g * (sc + 1.f) + sh;
            u32x2 o; o.x = pk2(x[j].x, x[j].y); o.y = pk2(x[j].z, x[j].w); *(u32x2*)(H + (size_t)tok * D + c) = o; }
        if constexpr (ROUTE) {
            LAS float* lgs = (LAS float*)(F.lds + LDSCTL_OFF + 1024) + (F.wave * 4 + grp) * 40;
#pragma unroll 1
            for (int o = 0; o < 36; ++o) { f32x4 v0 = {0.f, 0.f, 0.f, 0.f}, v1 = {0.f, 0.f, 0.f, 0.f};
#pragma unroll
                for (int j = 0; j < 16; j += 2) { const f32x4 w0 = *(const LAS f32x4*)(wr + o * 1024 + 64 * j + 4 * i16), w1 = *(const LAS f32x4*)(wr + o * 1024 + 64 * j + 64 + 4 * i16);
                    v0 += x[j] * w0; v1 += x[j + 1] * w1; }
                v0 += v1; float a0 = wave16_sum((v0.x + v0.y) + (v0.z + v0.w)); if (i16 == 0) lgs[o] = a0; }
            asm volatile("s_waitcnt lgkmcnt(0)" ::: "memory");
            const float gl0 = lgs[0] + bg[0], gl1 = lgs[1] + bg[1], gl2 = lgs[2] + bg[2], gl3 = lgs[3] + bg[3];
            int gs = 0; float gm = gl0;
            if (gl1 > gm) { gm = gl1; gs = 1; }
            if (gl2 > gm) { gm = gl2; gs = 2; }
            if (gl3 > gm) { gm = gl3; gs = 3; }
            const float den = __expf(gl0 - gm) + __expf(gl1 - gm) + __expf(gl2 - gm) + __expf(gl3 - gm);
            const float pg = 1.f / den;
            float el[8];
#pragma unroll
            for (int e = 0; e < 8; ++e) el[e] = lgs[4 + gs * 8 + e] + br[gs * 8 + e];
            int i0 = 0; float v0 = el[0];
#pragma unroll
            for (int e = 1; e < 8; ++e) if (el[e] > v0) { v0 = el[e]; i0 = e; }
            int i1 = -1; float v1 = -3.0e38f;
#pragma unroll
            for (int e = 0; e < 8; ++e) if (e != i0 && el[e] > v1) { v1 = el[e]; i1 = e; }
            const float p0 = 1.f / (1.f + __expf(v1 - v0));
            const float w0 = p0 * pg, w1 = (1.f - p0) * pg;
            const bool do_route = !(skip_ctx_route && sidx == 4) && !dry;
            if (i16 == 0 && do_route) {
                const int e0 = gs * 8 + i0, e1 = gs * 8 + i1;
                unsigned* cnt = (unsigned*)(ws + WS_CTL) + CW_CNT + l * 32 * 64;
                const unsigned q0 = atomicAdd(cnt + e0 * 64, 1u), q1 = atomicAdd(cnt + e1 * 64, 1u);
                int* BK = (int*)(ws + WS_BK); float* TW = (float*)(ws + WS_TW);
                BK[(size_t)e0 * T + q0] = tok * 2; BK[(size_t)e1 * T + q1] = tok * 2 + 1;
                TW[tok * 2] = w0; TW[tok * 2 + 1] = w1;
            }
        }
    }
}

__device__ __forceinline__ void st8(bf16_t* p, f32x4 v0, f32x4 v1) { u32x4 w; w.x = cvt_pk_bf16(v0[0], v0[1]); w.y = cvt_pk_bf16(v0[2], v0[3]); w.z = cvt_pk_bf16(v1[0], v1[1]); w.w = cvt_pk_bf16(v1[2], v1[3]); *(u32x4*)p = w; }
#define EPI_ROWS(ai, m) (u.pm * 256 + (ai) * 128 + wr * 64 + (m) * 16 + fr)

struct EpiRgIn { static constexpr bool PERM = true; bf16_t* GG; bf16_t* XB;
    __device__ __forceinline__ void operator()(const f32x4 (&acc)[2][2][4][2], const pg8::Unit& u, int wr, int wc, int fr, int fq) const {
        const bool isg = u.pn < 4; bf16_t* base = isg ? GG : XB; const int ct = (u.pn & 3) * 256 + wc * 32 + 8 * fq;
#pragma unroll
        for (int ai = 0; ai < 2; ++ai)
#pragma unroll
            for (int m = 0; m < 4; ++m) { bf16_t* rowp = base + (size_t)EPI_ROWS(ai, m) * D + ct;
#pragma unroll
                for (int bj = 0; bj < 2; ++bj) { f32x4 v0 = acc[ai][bj][m][0], v1 = acc[ai][bj][m][1];
                    if (isg) {
#pragma unroll
                        for (int e = 0; e < 4; ++e) { v0[e] = gelu_tanh(v0[e]); v1[e] = gelu_tanh(v1[e]); } }
                    st8(rowp + bj * 128, v0, v1); } }
    } };
struct EpiBf16 { static constexpr bool PERM = true; bf16_t* O; int ldc;
    __device__ __forceinline__ void operator()(const f32x4 (&acc)[2][2][4][2], const pg8::Unit& u, int wr, int wc, int fr, int fq) const {
        const int ct = u.pn * 256 + wc * 32 + 8 * fq;
#pragma unroll
        for (int ai = 0; ai < 2; ++ai)
#pragma unroll
            for (int m = 0; m < 4; ++m) { bf16_t* rowp = O + (size_t)EPI_ROWS(ai, m) * ldc + ct;
#pragma unroll
                for (int bj = 0; bj < 2; ++bj) st8(rowp + bj * 128, acc[ai][bj][m][0], acc[ai][bj][m][1]); }
    } };
struct EpiCmIn { static constexpr bool PERM = true; bf16_t* O; f32x2* statp;
    __device__ __forceinline__ void operator()(const f32x4 (&acc)[2][2][4][2], const pg8::Unit& u, int wr, int wc, int fr, int fq) const {
        const int ct = u.pn * 256 + wc * 32 + 8 * fq; const bool isv = u.pn >= 8;
#pragma unroll
        for (int ai = 0; ai < 2; ++ai)
#pragma unroll
            for (int m = 0; m < 4; ++m) { const int row = EPI_ROWS(ai, m); bf16_t* rowp = O + (size_t)row * 4096 + ct; float s = 0.f, q = 0.f;
#pragma unroll
                for (int bj = 0; bj < 2; ++bj) { f32x4 v0 = acc[ai][bj][m][0], v1 = acc[ai][bj][m][1];
#pragma unroll
                    for (int e = 0; e < 4; ++e) { v0[e] = gelu_tanh(v0[e]); v1[e] = gelu_tanh(v1[e]); }
                    u32x4 w; w.x = cvt_pk_bf16(v0[0], v0[1]); w.y = cvt_pk_bf16(v0[2], v0[3]); w.z = cvt_pk_bf16(v1[0], v1[1]); w.w = cvt_pk_bf16(v1[2], v1[3]);
                    *(u32x4*)(rowp + bj * 128) = w;
                    const float r0 = bflo(w.x), r1 = bfhi(w.x), r2 = bflo(w.y), r3 = bfhi(w.y), r4 = bflo(w.z), r5 = bfhi(w.z), r6 = bflo(w.w), r7 = bfhi(w.w);
                    s += ((r0 + r1) + (r2 + r3)) + ((r4 + r5) + (r6 + r7)); q += ((r0 * r0 + r1 * r1) + (r2 * r2 + r3 * r3)) + ((r4 * r4 + r5 * r5) + (r6 * r6 + r7 * r7)); }
                if (isv) { s += __shfl_xor(s, 16); s += __shfl_xor(s, 32); q += __shfl_xor(q, 16); q += __shfl_xor(q, 32);
                    if (fq == 0) statp[(size_t)row * 32 + (u.pn - 8) * 4 + wc] = (f32x2){s, q}; } }
    } };
struct EpiResid { static constexpr bool PERM = true; bf16_t* YM; const float* gate  ;
    __device__ __forceinline__ void operator()(const f32x4 (&acc)[2][2][4][2], const pg8::Unit& u, int wr, int wc, int fr, int fq) const {
        const int sidx = sidx_of_row(u.pm * 256); const float* gp = gate + (size_t)sidx * NMODV; const int ct = u.pn * 256 + wc * 32 + 8 * fq;
        f32x4 gv[2][2];
#pragma unroll
        for (int bj = 0; bj < 2; ++bj)
#pragma unroll
            for (int n = 0; n < 2; ++n) gv[bj][n] = *(const f32x4*)(gp + ct + bj * 128 + n * 4);
#pragma unroll
        for (int ai = 0; ai < 2; ++ai)
#pragma unroll
            for (int m = 0; m < 4; ++m) { bf16_t* rowp = YM + (size_t)EPI_ROWS(ai, m) * D + ct;
#pragma unroll
                for (int bj = 0; bj < 2; ++bj) st8(rowp + bj * 128, gv[bj][0] * acc[ai][bj][m][0], gv[bj][1] * acc[ai][bj][m][1]); }
    } };
struct EpiRgGate { static constexpr bool PERM = true; const bf16_t* XC; bf16_t* LA; bf16_t* BB; const float* ba; const float* bi; const float* lam;
    __device__ __forceinline__ void operator()(const f32x4 (&acc)[2][2][4][2], const pg8::Unit& u, int wr, int wc, int fr, int fq) const {
        const int d = u.pn >> 3, blk = u.pn & 7;
        asm volatile("" : "+v"(fr), "+v"(fq));
#pragma unroll
        for (int n = 0; n < 2; ++n) { const int ch = blk * 128 + wc * 32 + 8 * fq + 4 * n;
            const f32x4 bav = *(const f32x4*)(ba + d * D + ch), biv = *(const f32x4*)(bi + d * D + ch), spv = *(const f32x4*)(lam + d * D + ch);
#pragma unroll
            for (int ai = 0; ai < 2; ++ai)
#pragma unroll
                for (int m = 0; m < 4; ++m) { const size_t off = (size_t)EPI_ROWS(ai, m) * D + ch;
                    const u32x2 xw = *(const u32x2*)(XC + off);
                    const f32x4 xc = {bflo(xw.x), bfhi(xw.x), bflo(xw.y), bfhi(xw.y)};
                    f32x4 la, bb;
#pragma unroll
                    for (int e = 0; e < 4; ++e) { const float r = fast_sigmoid(acc[ai][0][m][n][e] + bav[e]), ig = fast_sigmoid(acc[ai][1][m][n][e] + biv[e]);
                        const float lga = r * spv[e]; la[e] = lga; bb[e] = __builtin_amdgcn_sqrtf(one_minus_exp(-2.f * lga)) * ig * xc[e]; }
                    u32x2 w; w.x = cvt_pk_bf16(la[0], la[1]); w.y = cvt_pk_bf16(la[2], la[3]);
                    *(u32x2*)(LA + (size_t)d * T * D + off) = w;
                    w.x = cvt_pk_bf16(bb[0], bb[1]); w.y = cvt_pk_bf16(bb[2], bb[3]);
                    *(u32x2*)(BB + (size_t)d * T * D + off) = w; __builtin_amdgcn_sched_barrier(0); }
            asm volatile("" ::: "memory"); }
    } };

template <bool G1>
struct MoeOrder {
    static constexpr bool GATHER = G1;
    const LAS int* tab; const char* A; const char* B; const int* BK; int G, c, nunits; size_t bstride;
    __device__ bool next(int i, pg8::Unit& u) const {
        const long L = (long)i * G + c; if (c >= G || L >= nunits) return false;
        const int wgid = __builtin_amdgcn_readfirstlane(pg8::xcd_remap((int)L, nunits)); const int tau = wgid >> 2, pn = wgid & 3;
        int e = 0;
#pragma unroll 1
        for (int k = 1; k < 32; ++k) e = (tab[k] <= tau) ? k : e;
        e = __builtin_amdgcn_readfirstlane(e);
        u.pm = tau; u.pn = pn; u.aux0 = e; u.aux1 = __builtin_amdgcn_readfirstlane((tau - tab[e]) * 256);
        u.a = pg8::uptr(G1 ? A : A + (size_t)tau * 256 * DEXP * 2);
        u.b = pg8::uptr(B + (size_t)e * bstride + (size_t)pn * 256 * (G1 ? 1024 : DEXP) * 2);
        return true; }
    __device__ unsigned goff(const pg8::Unit& u, int row) const {
        const int pos = u.aux1 + row; const int cnt = tab[40 + u.aux0];
        int tok = 0; if (pos < cnt) tok = __builtin_nontemporal_load(BK + (size_t)u.aux0 * T + pos) >> 1;
        return (unsigned)tok * (unsigned)(D * 2); }
};
struct EpiMoe1 { static constexpr bool PERM = true; bf16_t* H1;
    __device__ __forceinline__ void operator()(const f32x4 (&acc)[2][2][4][2], const pg8::Unit& u, int wr, int wc, int fr, int fq) const {
        const int ct = u.pn * 128 + wc * 32 + 8 * fq;
#pragma unroll
        for (int ai = 0; ai < 2; ++ai)
#pragma unroll
            for (int m = 0; m < 4; ++m) { f32x4 h0, h1;
#pragma unroll
                for (int e = 0; e < 4; ++e) { const float g0 = acc[ai][0][m][0][e], g1 = acc[ai][0][m][1][e]; h0[e] = g0 * sigmoidf_(g0) * acc[ai][1][m][0][e]; h1[e] = g1 * sigmoidf_(g1) * acc[ai][1][m][1][e]; }
                st8(H1 + (size_t)EPI_ROWS(ai, m) * DEXP + ct, h0, h1); }
    } };
struct EpiMoe2 { static constexpr bool PERM = true; bf16_t* YS; const float* gate; const int* BK; const float* TW; const LAS int* tab;
    __device__ __forceinline__ void operator()(const f32x4 (&acc)[2][2][4][2], const pg8::Unit& u, int wr, int wc, int fr, int fq) const {
        const int ct = u.pn * 256 + wc * 32 + 8 * fq; const int cnt = tab[40 + u.aux0];
        typedef int i32x8_t __attribute__((ext_vector_type(8))); typedef float f32x8_t __attribute__((ext_vector_type(8))); i32x8_t ent; f32x8_t w8;
#pragma unroll
        for (int r = 0; r < 8; ++r) { const int pos = u.aux1 + (r >> 2) * 128 + wr * 64 + (r & 3) * 16 + fr; ent[r] = -1; if (pos < cnt) ent[r] = __builtin_nontemporal_load(BK + (size_t)u.aux0 * T + pos); }
#pragma unroll
        for (int r = 0; r < 8; ++r) { w8[r] = 0.f; if (ent[r] >= 0) w8[r] = __builtin_nontemporal_load(TW + ent[r]); }
#pragma unroll
        for (int r = 0; r < 8; ++r) { const int e_ = ent[r];
            if (e_ >= 0) { const int tok = e_ >> 1, slot = e_ & 1; const float w = w8[r];
                const float* gp = gate + (size_t)sidx_of_row(tok) * NMODV + ct; bf16_t* yp = YS + ((size_t)slot * T + tok) * D + ct;
#pragma unroll
                for (int bj = 0; bj < 2; ++bj) { const f32x4 g0 = *(const f32x4*)(gp + bj * 128), g1 = *(const f32x4*)(gp + bj * 128 + 4);
                    st8(yp + bj * 128, g0 * w * acc[r >> 2][bj][r & 3][0], g1 * w * acc[r >> 2][bj][r & 3][1]); } } }
    } };
__device__ __forceinline__ int moe_table(Frame& F, int l, LAS int* tab) {
    __syncthreads();
    if (F.tid < 32) { const unsigned c = __hip_atomic_load((unsigned*)(F.ws + WS_CTL) + CW_CNT + (l * 32 + F.tid) * 64, RLX_AGENT); tab[40 + F.tid] = (int)c; }
    __syncthreads();
    if (F.tid == 0) { int s = 0; for (int e = 0; e < 32; ++e) { tab[e] = s; s += (tab[40 + e] + 255) >> 8; } tab[32] = s; }
    __syncthreads();
    return tab[32];
}

__device__ __forceinline__ void conv_phase(Frame& F, int j) {
    const bf16_t* XB = (const bf16_t*)(F.ws + WS_XB); bf16_t* XC = (bf16_t*)(F.ws + WS_XC);
    const float* cw = inp(F, I_RGCW) + (size_t)j * 4 * D; const float* cb = inp(F, I_RGCB) + (size_t)j * D;
    const int NGT = F.G * 512;
    for (int i0 = F.bid * 512 + F.tid; i0 < T * 128; i0 += 2 * NGT) {
        u32x4 xw[2][4];
#pragma unroll
        for (int q = 0; q < 2; ++q) { const int i = i0 + q * NGT; const int row = i >> 7, c = (i & 127) * 8; const int b = row / SB, s = row - b * SB; const int lo = s < CTX ? 0 : CTX, hi = s < CTX ? CTX : SB;
#pragma unroll
            for (int k = 0; k < 4; ++k) { const int ss = s + k - 2; xw[q][k] = (u32x4){0u, 0u, 0u, 0u}; if (i < T * 128 && ss >= lo && ss < hi) xw[q][k] = *(const u32x4*)(XB + (size_t)(b * SB + ss) * D + c); } }
#pragma unroll
        for (int q = 0; q < 2; ++q) { const int i = i0 + q * NGT; if (i < T * 128) { const int row = i >> 7, c = (i & 127) * 8;
            float a[8];
#pragma unroll
            for (int e = 0; e < 8; ++e) a[e] = cb[c + e];
#pragma unroll
            for (int k = 0; k < 4; ++k) { const f32x4 w0 = *(const f32x4*)(cw + k * D + c), w1 = *(const f32x4*)(cw + k * D + c + 4); const u32x4 x = xw[q][k];
                a[0] += w0.x * bflo(x.x); a[1] += w0.y * bfhi(x.x); a[2] += w0.z * bflo(x.y); a[3] += w0.w * bfhi(x.y);
                a[4] += w1.x * bflo(x.z); a[5] += w1.y * bfhi(x.z); a[6] += w1.z * bflo(x.w); a[7] += w1.w * bfhi(x.w); }
            u32x4 o; o.x = pk2(a[0], a[1]); o.y = pk2(a[2], a[3]); o.z = pk2(a[4], a[5]); o.w = pk2(a[6], a[7]);
            *(u32x4*)(XC + (size_t)row * D + c) = o; } }
    }
}
__device__ __forceinline__ void scan1_phase(Frame& F) {
    const bf16_t* LA = (const bf16_t*)(F.ws + WS_LA); const bf16_t* BB = (const bf16_t*)(F.ws + WS_BB); float* TS = (float*)(F.ws + WS_TOTS); float* TH = (float*)(F.ws + WS_TOTH);
    for (int it = F.bid * 8 + F.wave; it < NB * 2 * NCH * 4; it += F.G * 8) {
        const int cg = it & 3, rest = it >> 2, ck = rest % NCH, bd = rest / NCH, dir = bd & 1, b = bd >> 1;
        const int c = cg * 256 + F.lane * 4; const size_t base = (size_t)dir * T * D + (size_t)(b * SB + ck * 16) * D + c;
        u32x2 la[16], bb[16];
#pragma unroll
        for (int t = 0; t < 16; ++t) { const size_t o = base + (size_t)(dir ? 15 - t : t) * D; la[t] = *(const u32x2*)(LA + o); bb[t] = *(const u32x2*)(BB + o); }
        f32x4 sl = {0.f, 0.f, 0.f, 0.f}, h = {0.f, 0.f, 0.f, 0.f};
#pragma unroll
        for (int t = 0; t < 16; ++t) { const f32x4 l4 = {bflo(la[t].x), bfhi(la[t].x), bflo(la[t].y), bfhi(la[t].y)}, b4 = {bflo(bb[t].x), bfhi(bb[t].x), bflo(bb[t].y), bfhi(bb[t].y)};
            sl += l4; f32x4 a4 = {__expf(l4.x), __expf(l4.y), __expf(l4.z), __expf(l4.w)}; h = a4 * h + b4; }
        const size_t o = (size_t)(bd * NCH + ck) * D + c; *(f32x4*)(TS + o) = sl; *(f32x4*)(TH + o) = h;
    }
}
__device__ __forceinline__ void scan2_phase(Frame& F) {
    const float* TS = (const float*)(F.ws + WS_TOTS); const float* TH = (const float*)(F.ws + WS_TOTH); float* CY = (float*)(F.ws + WS_CARRY);
    for (int it = F.bid * 8 + F.wave; it < NB * 2 * 4; it += F.G * 8) {
        const int cg = it & 3, bd = it >> 2, dir = bd & 1; const int c = cg * 256 + F.lane * 4; const size_t base = (size_t)bd * NCH * D + c;
        f32x4 h = {0.f, 0.f, 0.f, 0.f};
        for (int s0 = 0; s0 < NCH; s0 += 8) { f32x4 sl[8], hl[8]; int ck[8];
#pragma unroll
            for (int q = 0; q < 8; ++q) { const int s = s0 + q; ck[q] = dir ? (s < 16 ? 15 - s : NCH + 15 - s) : s; sl[q] = *(const f32x4*)(TS + base + (size_t)ck[q] * D); hl[q] = *(const f32x4*)(TH + base + (size_t)ck[q] * D); }
#pragma unroll
            for (int q = 0; q < 8; ++q) { *(f32x4*)(CY + base + (size_t)ck[q] * D) = h; const f32x4 a4 = {__expf(sl[q].x), __expf(sl[q].y), __expf(sl[q].z), __expf(sl[q].w)}; h = a4 * h + hl[q]; } }
    }
}
__device__ __forceinline__ void scan3_phase(Frame& F) {
    const bf16_t* LA = (const bf16_t*)(F.ws + WS_LA); const bf16_t* BB = (const bf16_t*)(F.ws + WS_BB); const float* CY = (const float*)(F.ws + WS_CARRY);
    const bf16_t* GG = (const bf16_t*)(F.ws + WS_GG); bf16_t* SA = (bf16_t*)(F.ws + WS_SA);
    LAS f32x4* hb = (LAS f32x4*)(F.lds + F.wave * 16384);
    for (int it = F.bid * 8 + F.wave; it < NB * NCH * 4; it += F.G * 8) {
        const int cg = it & 3, rest = it >> 2, ck = rest % NCH, b = rest / NCH;
        const int c = cg * 256 + F.lane * 4;
        const size_t rbase = (size_t)(b * SB + ck * 16) * D + c, b1 = (size_t)T * D + rbase;
        f32x4 hbk = *(const f32x4*)(CY + (size_t)((b * 2 + 1) * NCH + ck) * D + c), hf = *(const f32x4*)(CY + (size_t)((b * 2 + 0) * NCH + ck) * D + c);
        { u32x2 la[16], bb[16];
#pragma unroll
          for (int t = 0; t < 16; ++t) { la[t] = *(const u32x2*)(LA + b1 + (size_t)(15 - t) * D); bb[t] = *(const u32x2*)(BB + b1 + (size_t)(15 - t) * D); }
#pragma unroll
          for (int t = 0; t < 16; ++t) { const f32x4 l4 = {bflo(la[t].x), bfhi(la[t].x), bflo(la[t].y), bfhi(la[t].y)}, b4 = {bflo(bb[t].x), bfhi(bb[t].x), bflo(bb[t].y), bfhi(bb[t].y)};
              const f32x4 a4 = {__expf(l4.x), __expf(l4.y), __expf(l4.z), __expf(l4.w)}; hbk = a4 * hbk + b4; hb[(15 - t) * 64 + F.lane] = hbk; } }
        { u32x2 la[16], bb[16], gg[16];
#pragma unroll
          for (int t = 0; t < 16; ++t) { la[t] = *(const u32x2*)(LA + rbase + (size_t)t * D); bb[t] = *(const u32x2*)(BB + rbase + (size_t)t * D); gg[t] = *(const u32x2*)(GG + rbase + (size_t)t * D); }
#pragma unroll
          for (int t = 0; t < 16; ++t) { const f32x4 l4 = {bflo(la[t].x), bfhi(la[t].x), bflo(la[t].y), bfhi(la[t].y)}, b4 = {bflo(bb[t].x), bfhi(bb[t].x), bflo(bb[t].y), bfhi(bb[t].y)};
              const f32x4 g4 = {bflo(gg[t].x), bfhi(gg[t].x), bflo(gg[t].y), bfhi(gg[t].y)};
              const f32x4 a4 = {__expf(l4.x), __expf(l4.y), __expf(l4.z), __expf(l4.w)}; hf = a4 * hf + b4; const f32x4 y = g4 * (hf + hb[t * 64 + F.lane]);
              u32x2 o; o.x = pk2(y.x, y.y); o.y = pk2(y.z, y.w); *(u32x2*)(SA + rbase + (size_t)t * D) = o; } }
    }
}

__device__ __forceinline__ void qknorm_phase(Frame& F) {
    bf16_t* QKV = (bf16_t*)(F.ws + WS_QKV); const f32x2* ROPE = (const f32x2*)(F.ws + WS_ROPE);
    const int i16 = F.lane & 15, grp = F.lane >> 4; const float* pqg = inp(F, I_ATQG); const float* pkg = inp(F, I_ATKG);
    const int ITS = F.G * 32;
    for (int it0 = (F.bid * 8 + F.wave) * 4 + grp; it0 < T * 10; it0 += 4 * ITS) {
        u32x4 xw4[4];
#pragma unroll
        for (int q = 0; q < 4; ++q) { const int it = it0 + q * ITS; xw4[q] = (u32x4){0u, 0u, 0u, 0u}; if (it < T * 10) { const int row = it / 10, hh = it - row * 10; xw4[q] = *(const u32x4*)(QKV + (size_t)row * 1536 + hh * 128 + i16 * 8); } }
#pragma unroll
        for (int q = 0; q < 4; ++q) { const int it = it0 + q * ITS; const bool valid = it < T * 10; const int itc = valid ? it : 0;
            const int row = itc / 10, hh = itc - row * 10; const int b = row / SB, s = row - b * SB;
            bf16_t* p = QKV + (size_t)row * 1536 + hh * 128 + i16 * 8;
            const u32x4 xw = xw4[q];
            float x[8] = {bflo(xw.x), bfhi(xw.x), bflo(xw.y), bfhi(xw.y), bflo(xw.z), bfhi(xw.z), bflo(xw.w), bfhi(xw.w)};
            float ss = 0.f;
#pragma unroll
            for (int e = 0; e < 8; ++e) ss += x[e] * x[e];
            ss = wave16_sum(ss);
            const float rstd = rsqrtf(ss * (1.f / 128.f) + NORM_EPS);
            const float* g = (hh < 8 ? pqg : pkg) + i16 * 8;
#pragma unroll
            for (int e = 0; e < 8; ++e) x[e] = x[e] * rstd * g[e];
            float y[8];
#pragma unroll
            for (int e = 0; e < 8; ++e) y[e] = __shfl_xor(x[e], 4);
            if (s >= CTX) { const int t = s - CTX; const int pos = (i16 >> 3) ? (t & 63) : (t >> 6); const bool half1 = (i16 >> 2) & 1;
#pragma unroll
                for (int e = 0; e < 8; ++e) { const f32x2 cs = ROPE[pos * 32 + (i16 & 3) * 8 + e];
                    x[e] = half1 ? (x[e] * cs.x + y[e] * cs.y) : (x[e] * cs.x - y[e] * cs.y); } }
            u32x4 o; o.x = pk2(x[0], x[1]); o.y = pk2(x[2], x[3]); o.z = pk2(x[4], x[5]); o.w = pk2(x[6], x[7]);
            if (valid) *(u32x4*)p = o;
        }
    }
}
__device__ __forceinline__ void attn_phase(Frame& F) {
    const bf16_t* QKV = (const bf16_t*)(F.ws + WS_QKV); bf16_t* AO = (bf16_t*)(F.ws + WS_AO);
    for (int u = F.bid; u < 544; u += F.G) {
        int b, h, q0, k0, seq;
        if (u < 512) { const int qb = u & 15, hg = (u >> 4) & 3, kvh = (u >> 6) & 1; b = u >> 7; h = kvh * 4 + hg; q0 = b * SB + CTX + qb * 256; k0 = b * SB; seq = SB; }
        else { const int v = u - 512; b = v >> 3; h = v & 7; q0 = b * SB; k0 = b * SB; seq = CTX; }
        const int kvh = h >> 2;
        const bf16_t* Kp = (const bf16_t*)pg8::uptr((const char*)(QKV + (size_t)k0 * 1536 + 1024 + kvh * 128));
        att::attn_dense_body((const bf16_t*)pg8::uptr((const char*)(QKV + (size_t)q0 * 1536 + h * 128)), Kp, Kp + 256, (bf16_t*)pg8::uptr((const char*)(AO + (size_t)q0 * D + h * 128)), seq, F.ldsg, F.tid);
        __syncthreads();
    }
}

__device__ __forceinline__ void spatial_phase(Frame& F) {
    const bf16_t* UVB = (const bf16_t*)(F.ws + WS_UVB); bf16_t* UV = (bf16_t*)(F.ws + WS_UV); const f32x2* statp = (const f32x2*)(F.ws + WS_STATP);
    const bf16_t* Ws = (const bf16_t*)(F.ws + WS_W_CMS); const float* lng = inp(F, I_CMLNG); const float* lnb = inp(F, I_CMLNB); const float* bs = inp(F, I_CMBS);
    LAS uchar* vl = F.lds;
    LAS f32x2* st = (LAS f32x2*)(F.lds + 65536);
    const int tid = F.tid, lane = F.lane, wid = F.wave, r32 = lane & 31, hi = lane >> 5, wm = wid & 3, wn = wid >> 2;
    const int sr = tid >> 4, sc = (tid & 15) * 8;
    for (int u = F.bid; u < 136 * 8; u += F.G) {
        const int chunk = u >> 3, g = u & 7; const int row0 = chunk * 128;
        __syncthreads();
        if (tid < 128) { const f32x2* sp = statp + (size_t)(row0 + tid) * 32; float s = 0.f, q = 0.f;
#pragma unroll 8
            for (int k = 0; k < 32; ++k) { const f32x2 v = sp[k]; s += v.x; q += v.y; }
            const float mean = s * (1.f / 2048.f); const float var = fmaxf(q * (1.f / 2048.f) - mean * mean, 0.f); st[tid] = (f32x2){mean, rsqrtf(var + NORM_EPS)}; }
        __syncthreads();
#pragma unroll
        for (int ch = 0; ch < 2; ++ch) { const int cg = g * 256 + ch * 128 + sc;
            const f32x4 g0 = *(const f32x4*)(lng + cg), g1 = *(const f32x4*)(lng + cg + 4), b0 = *(const f32x4*)(lnb + cg), b1 = *(const f32x4*)(lnb + cg + 4);
#pragma unroll
            for (int i = 0; i < 4; ++i) { const int q = sr + 32 * i; const u32x4 xw = *(const u32x4*)(UVB + (size_t)(row0 + q) * 4096 + 2048 + cg); const f32x2 ms = st[q];
                f32x4 v0 = {bflo(xw.x), bfhi(xw.x), bflo(xw.y), bfhi(xw.y)}, v1 = {bflo(xw.z), bfhi(xw.z), bflo(xw.w), bfhi(xw.w)};
                v0 = (v0 - ms.x) * ms.y * g0 + b0; v1 = (v1 - ms.x) * ms.y * g1 + b1;
                u32x4 o; o.x = pk2(v0.x, v0.y); o.y = pk2(v0.z, v0.w); o.z = pk2(v1.x, v1.y); o.w = pk2(v1.z, v1.w);
                *(LAS u32x4*)(vl + ((q >> 6) * 2 + ch) * 16384 + att::v_st(q & 63, sc)) = o; } }
        bf16x8 pa[2][4];
#pragma unroll
        for (int kt = 0; kt < 2; ++kt)
#pragma unroll
            for (int ks = 0; ks < 4; ++ks) pa[kt][ks] = *(const bf16x8*)(Ws + ((size_t)g * 128 + 32 * wm + r32) * 128 + 64 * kt + 16 * ks + 8 * hi);
        __syncthreads();
        f32x16 o[4] = {};
        const int vb = (int)(uintptr_t)(F.ldsg) + att::v_rd_base(lane) + wn * 16384;
        att::pv_d0(o, vb, pa[0][0], pa[0][1], pa[0][2], pa[0][3]);
        att::pv_d0(o, vb + 32768, pa[1][0], pa[1][1], pa[1][2], pa[1][3]);
        u32x4 uu[8];
#pragma unroll
        for (int i = 0; i < 8; ++i) { const int id = tid + 512 * i, row = id >> 5, ch = id & 31; uu[i] = *(const u32x4*)(UVB + (size_t)(row0 + row) * 4096 + g * 256 + ch * 8); }
        __syncthreads();
#pragma unroll
        for (int r = 0; r < 16; ++r) { const int p = 32 * wm + att::crow(r, hi); const float bsv = bs[g * 128 + p];
#pragma unroll
            for (int d0 = 0; d0 < 4; ++d0) *(LAS bf16_t*)(vl + p * 512 + (128 * wn + 32 * d0 + r32) * 2) = (bf16_t)f2bf(o[d0][r] + bsv); }
        __syncthreads();
#pragma unroll
        for (int i = 0; i < 8; ++i) { const int id = tid + 512 * i, row = id >> 5, ch = id & 31; const u32x4 v = *(const LAS u32x4*)(vl + row * 512 + ch * 16); const u32x4 w = uu[i];
            u32x4 o4; o4.x = pk2(bflo(v.x) * bflo(w.x), bfhi(v.x) * bfhi(w.x)); o4.y = pk2(bflo(v.y) * bflo(w.y), bfhi(v.y) * bfhi(w.y)); o4.z = pk2(bflo(v.z) * bflo(w.z), bfhi(v.z) * bfhi(w.z)); o4.w = pk2(bflo(v.w) * bflo(w.w), bfhi(v.w) * bfhi(w.w));
            *(u32x4*)(UV + (size_t)(row0 + row) * 2048 + g * 256 + ch * 8) = o4; }
    }
    __syncthreads();
}

__device__ __forceinline__ void final_phase(Frame& F) {
    const f32x4* X = (const f32x4*)(F.ws + WS_X); const u32x2* YS = (const u32x2*)(F.ws + WS_Y1); const u32x2* YM = (const u32x2*)(F.ws + WS_YM); f32x4* out = (f32x4*)F.out;
    const int NGT = F.G * 512;
    for (int i0 = F.bid * 512 + F.tid; i0 < NB * SEQ * 256; i0 += 4 * NGT) { f32x4 a[4]; u32x2 y0[4], y1[4], ym[4];
#pragma unroll
        for (int q = 0; q < 4; ++q) { const int i = i0 + q * NGT; if (i < NB * SEQ * 256) { const int r = i >> 8, c4 = i & 255, b = r >> 12, t = r & 4095; const size_t src = ((size_t)(b * SB + CTX + t) << 8) + c4; a[q] = X[src]; y0[q] = YS[src]; y1[q] = YS[src + (size_t)T * 256]; ym[q] = YM[src]; } }
#pragma unroll
        for (int q = 0; q < 4; ++q) { const int i = i0 + q * NGT; if (i < NB * SEQ * 256) out[i] = a[q] + (f32x4){bflo(y0[q].x) + bflo(y1[q].x) + bflo(ym[q].x), bfhi(y0[q].x) + bfhi(y1[q].x) + bfhi(ym[q].x), bflo(y0[q].y) + bflo(y1[q].y) + bflo(ym[q].y), bfhi(y0[q].y) + bfhi(y1[q].y) + bfhi(ym[q].y)}; } }
}

constexpr int NPHASE = 39;
__global__ void __launch_bounds__(512, 2) mk_fwd(Args args) {
    extern __shared__ __attribute__((aligned(16))) uchar lds[];
    Frame F; F.lds = (LAS uchar*)lds; F.ldsg = (char*)lds; F.tid = threadIdx.x; F.lane = F.tid & 63; F.wave = __builtin_amdgcn_readfirstlane(F.tid >> 6); F.G = gridDim.x; F.bid = blockIdx.x;
    F.ws = args.ws; F.out = args.out;
    uchar* ws0 = args.ws;
    volatile LAS unsigned* MISC = (volatile LAS unsigned*)(F.lds + LDSCTL_OFF);
    LAS int* tab = (LAS int*)(F.lds + LDSCTL_OFF + 256);
    for (int u = F.tid; u < (LDS_BYTES - LDSCTL_OFF) / 4; u += 512) ((LAS unsigned*)(F.lds + LDSCTL_OFF))[u] = 0u;
    __syncthreads();
    if (F.tid == 0) {
#pragma unroll
        for (int i = 0; i < 34; ++i) *(LAS unsigned long long*)(F.lds + LDSCTL_OFF + 576 + i * 8) = (unsigned long long)args.in[i]; }
    __syncthreads();
    const int lo = args.ph_lo, hi = args.ph_hi;
    if (hi - lo > 1) (void)xcd_barrier_post((unsigned*)(ws0 + WS_CTL) + CW_BAR, MISC + 8);
    int ph = 0;
#define PH_BEGIN if (ph >= opaque_uniform_int(args.ph_lo) && ph < opaque_uniform_int(args.ph_hi)) { int t_ = threadIdx.x; F.G = opaque_uniform_int(gridDim.x); F.bid = opaque_uniform_int(blockIdx.x); const int cid = F.bid; (void)cid; \
        F.out = (float*)opaque_uniform_ptr(args.out); F.lds = (LAS uchar*)lds; F.ldsg = (char*)lds; \
        asm volatile("" : "+v"(t_)); F.tid = t_; F.lane = t_ & 63; F.wave = __builtin_amdgcn_readfirstlane(t_ >> 6); \
        uchar* ws = (uchar*)opaque_uniform_ptr(args.ws); F.ws = ws; \
        const float* MODl = (const float*)(ws + WS_MOD) + (size_t)l_ * 5 * NMODV; (void)MODl;
#define GRIDBAR  { XcdBarrier bb_; bb_.bar = (unsigned*)(ws + WS_CTL) + CW_BAR; bb_.x = 0; bb_.st = (volatile LAS unsigned*)(F.lds + LDSCTL_OFF) + 8; xcd_barrier(bb_); }
#define REPBAR   if (rep_ > 1) GRIDBAR
#define PH_END   if (ph + 1 < opaque_uniform_int(args.ph_hi)) GRIDBAR } ++ph;

    { const int l_ = 0; PH_BEGIN PM(0) { const bool dry = rep_ > 1; (void)dry;  p0_prologue(F);  REPBAR } PH_END }

#pragma unroll 1
    for (int l = 0; l < DEPTH; ++l) {
        const int kind = l % 3, j = l / 3; const bool lastl = (l == DEPTH - 1); const int l_ = l;
        PH_BEGIN PM(1) { const bool dry = rep_ > 1; (void)dry;  if ((l > 0) && (rep_ == REPN(1))) norm_phase<false, 3>(F, l, inp(F, I_NMG) + l * D, 0, false, false); else norm_phase<false, 0>(F, l, inp(F, I_NMG) + l * D, 0, false, false);  REPBAR } PH_END
        if (kind == 0) {
            PH_BEGIN PM(2) { const bool dry = rep_ > 1; (void)dry;  { pg8::DenseOrder S; S.init(ws + WS_H, D, ws + WS_W_RGIN + (size_t)j * 2048 * 1024 * 2, D, T, 2048, F.G, cid);
                EpiRgIn E{(bf16_t*)(ws + WS_GG), (bf16_t*)(ws + WS_XB)}; pg8::gemm_phase(F.lds, S, E, D, D, D); }  REPBAR } PH_END
            PH_BEGIN PM(3) { const bool dry = rep_ > 1; (void)dry;  conv_phase(F, j);  REPBAR } PH_END
            PH_BEGIN PM(4) { const bool dry = rep_ > 1; (void)dry;  { pg8::DenseOrder S; S.init(ws + WS_XC, D, ws + WS_W_RGG + (size_t)j * 16 * 256 * 128 * 2, 128, T, 16 * 256, F.G, cid, 7, 256);
                EpiRgGate E{(const bf16_t*)(ws + WS_XC), (bf16_t*)(ws + WS_LA), (bf16_t*)(ws + WS_BB), inp(F, I_RGBA) + (size_t)j * 2 * D, inp(F, I_RGBI) + (size_t)j * 2 * D, (const float*)(ws + WS_SPL) + (size_t)j * 2 * D};
                pg8::gemm_phase(F.lds, S, E, 128, D, 128); }  REPBAR } PH_END
            PH_BEGIN PM(5) { const bool dry = rep_ > 1; (void)dry;  scan1_phase(F);  REPBAR } PH_END
            PH_BEGIN PM(20) { const bool dry = rep_ > 1; (void)dry;  scan2_phase(F);  REPBAR } PH_END
            PH_BEGIN PM(6) { const bool dry = rep_ > 1; (void)dry;  scan3_phase(F);  REPBAR } PH_END
            PH_BEGIN PM(7) { const bool dry = rep_ > 1; (void)dry;  { pg8::DenseOrder S; S.init(ws + WS_SA, D, ws + WS_W_RGOUT + (size_t)j * 1024 * 1024 * 2, D, T, D, F.G, cid);
                EpiResid E{(bf16_t*)(ws + (dry ? WS_Y1 : WS_YM)), MODl + 2 * D}; pg8::gemm_phase(F.lds, S, E, D, D, D); }  REPBAR } PH_END
        } else if (kind == 1) {
            PH_BEGIN PM(8) { const bool dry = rep_ > 1; (void)dry;  { pg8::DenseOrder S; S.init(ws + WS_H, D, ws + WS_W_QKV, D, T, 1536, F.G, cid);
                EpiBf16 E{(bf16_t*)(ws + WS_QKV), 1536}; pg8::gemm_phase(F.lds, S, E, D, D, D); }  REPBAR } PH_END
            PH_BEGIN PM(9) { const bool dry = rep_ > 1; (void)dry;  qknorm_phase(F);  REPBAR } PH_END
            PH_BEGIN PM(10) { const bool dry = rep_ > 1; (void)dry;  attn_phase(F);  REPBAR } PH_END
            PH_BEGIN PM(11) { const bool dry = rep_ > 1; (void)dry;  { pg8::DenseOrder S; S.init(ws + WS_AO, D, ws + WS_W_AO, D, T, D, F.G, cid);
                EpiResid E{(bf16_t*)(ws + (dry ? WS_Y1 : WS_YM)), MODl + 2 * D}; pg8::gemm_phase(F.lds, S, E, D, D, D); }  REPBAR } PH_END
        } else {
            PH_BEGIN PM(12) { const bool dry = rep_ > 1; (void)dry;  { pg8::DenseOrder S; S.init(ws + WS_H, D, ws + WS_W_CMIN, D, T, 4096, F.G, cid);
                EpiCmIn E{(bf16_t*)(ws + WS_UVB), (f32x2*)(ws + WS_STATP)}; pg8::gemm_phase(F.lds, S, E, D, D, D); }  REPBAR } PH_END
            PH_BEGIN PM(13) { const bool dry = rep_ > 1; (void)dry;  spatial_phase(F);  REPBAR } PH_END
            PH_BEGIN PM(14) { const bool dry = rep_ > 1; (void)dry;  { pg8::DenseOrder S; S.init(ws + WS_UV, 2048, ws + WS_W_CMOUT, 2048, T, D, F.G, cid);
                EpiResid E{(bf16_t*)(ws + (dry ? WS_Y1 : WS_YM)), MODl + 2 * D}; pg8::gemm_phase(F.lds, S, E, 2048, 2048, 2048); }  REPBAR } PH_END
        }
        PH_BEGIN PM(15) { const bool dry = rep_ > 1; (void)dry;  norm_phase<true, 1>(F, l, inp(F, I_NFG) + l * D, 3, lastl, dry);  REPBAR } PH_END
        PH_BEGIN PM(16) { const bool dry = rep_ > 1; (void)dry;  { const int ntile = moe_table(F, l, tab);
            const int units = ntile * 4, rounds = (units + F.G - 1) / F.G; int geff = F.G; if (false && rounds > 0) { geff = (((units + rounds - 1) / rounds) + 7) & ~7; if (geff > F.G) geff = F.G; }
            MoeOrder<true> S{tab, (const char*)(ws + WS_H), (const char*)(ws + WS_W_E1 + (size_t)l * 32 * 1024 * 1024 * 2), (const int*)(ws + WS_BK), geff, cid, units, (size_t)1024 * 1024 * 2};
            EpiMoe1 E{(bf16_t*)(ws + WS_H1)}; pg8::gemm_phase(F.lds, S, E, D, D, D); }  REPBAR } PH_END
        PH_BEGIN PM(17) { const bool dry = rep_ > 1; (void)dry;  { const int ntile = moe_table(F, l, tab);
            const int units = ntile * 4, rounds = (units + F.G - 1) / F.G; int geff = F.G; if (false && rounds > 0) { geff = (((units + rounds - 1) / rounds) + 7) & ~7; if (geff > F.G) geff = F.G; }
            MoeOrder<false> S{tab, (const char*)(ws + WS_H1), (const char*)(ws + WS_W_E2 + (size_t)l * 32 * 1024 * 512 * 2), (const int*)(ws + WS_BK), geff, cid, units, (size_t)1024 * 512 * 2};
            EpiMoe2 E{(bf16_t*)(ws + (dry ? WS_SCR + 64 * MiB : WS_Y1)), MODl + 5 * D, (const int*)(ws + WS_BK), (const float*)(ws + WS_TW), tab}; pg8::gemm_phase(F.lds, S, E, DEXP, DEXP, DEXP); }  REPBAR } PH_END
    }
    { const int l_ = 0; PH_BEGIN PM(18) { const bool dry = rep_ > 1; (void)dry;  final_phase(F);  REPBAR if constexpr (((REP_MASK) >> 19) & 1u) { for (int k_ = 0; k_ < 20; ++k_) GRIDBAR } } PH_END }
#undef PH_BEGIN
#undef PH_END
}

extern "C" void kernel_launch(void* const* d_in, const int* in_sizes, int n_in, void* d_out, int out_size, void* d_ws, size_t ws_size, hipStream_t stream) {
    static int grid = 0;
    if (grid == 0) {
        if (n_in != 34 || out_size != NB * SEQ * D || ws_size < WS_END) { fprintf(stderr, "kernel_launch: bad shapes n_in %d out %d ws %zu (need %zu)\n", n_in, out_size, ws_size, (size_t)WS_END); grid = -1; return; }
        int dev = 0, cus = 0, per_cu = 0;
        if (hipGetDevice(&dev) != hipSuccess || hipDeviceGetAttribute(&cus, hipDeviceAttributeMultiprocessorCount, dev) != hipSuccess) { grid = -1; return; }
        if (hipFuncSetAttribute((const void*)mk_fwd, hipFuncAttributeMaxDynamicSharedMemorySize, LDS_BYTES) != hipSuccess) { fprintf(stderr, "kernel_launch: hipFuncSetAttribute failed\n"); grid = -1; return; }
        if (hipOccupancyMaxActiveBlocksPerMultiprocessor(&per_cu, (const void*)mk_fwd, 512, LDS_BYTES) != hipSuccess || per_cu < 1) { fprintf(stderr, "kernel_launch: occupancy query says %d\n", per_cu); (void)hipGetLastError(); grid = -1; return; }
        grid = cus;
    }
    if (grid < 0) return;
    (void)hipMemsetAsync((char*)d_ws + WS_CTL, 0, CTL_BYTES, stream);
    Args a{};
    for (int i = 0; i < 34; ++i) a.in[i] = (const float*)d_in[i];
    a.out = (float*)d_out; a.ws = (uchar*)d_ws;
#if MK_PER_PHASE
    for (int p = 0; p < NPHASE; ++p) { a.ph_lo = p; a.ph_hi = p + 1; hipLaunchKernelGGL(mk_fwd, dim3(grid), dim3(512), LDS_BYTES, stream, a); }
#else
    a.ph_lo = 0; a.ph_hi = NPHASE;
    void* kargs[] = {&a};
    hipError_t e = hipLaunchCooperativeKernel((const void*)mk_fwd, dim3(grid), dim3(512), kargs, LDS_BYTES, stream);
    if (e != hipSuccess) fprintf(stderr, "kernel_launch: cooperative launch failed: %s (grid %d)\n", hipGetErrorString(e), grid);
#endif
}
```

```cpp
#include <hip/hip_runtime.h>
#include <hip/hip_bf16.h>
#include <cstdio>
#include <cstdint>

#ifndef MOE_FP8
#define MOE_FP8 1
#endif
#ifndef MK_PER_PHASE
#define MK_PER_PHASE 0
#endif

#ifndef PHASE_MASK
#define PHASE_MASK 0xFFFFFFFFu
#endif
#ifndef REP_MASK
#define REP_MASK 0u
#endif
#define REPN(i) ((((REP_MASK) >> (i)) & 1u) ? 2 : 1)
#define PM(i) if constexpr ((PHASE_MASK >> (i)) & 1u) for (int rep_ = REPN(i); rep_ > 0; --rep_)
#define LAS __attribute__((address_space(3)))
#define GAS __attribute__((address_space(1)))
typedef unsigned char uchar;
typedef unsigned short bf16_t;
typedef short bf16x8 __attribute__((ext_vector_type(8)));
typedef short s16x4 __attribute__((ext_vector_type(4)));
typedef float f32x4 __attribute__((ext_vector_type(4)));
typedef float f32x2 __attribute__((ext_vector_type(2)));
typedef float f32x16 __attribute__((ext_vector_type(16)));
typedef unsigned u32x4 __attribute__((ext_vector_type(4)));
typedef unsigned u32x2 __attribute__((ext_vector_type(2)));
typedef GAS unsigned gu32;
#define RLX_AGENT __ATOMIC_RELAXED, __HIP_MEMORY_SCOPE_AGENT

constexpr int D = 1024, NB = 4, SEQ = 4096, CTX = 256, SB = SEQ + CTX, T = NB * SB, DEPTH = 4;
constexpr int NMODV = 6 * D;
constexpr int NEXP = 32, DEXP = 512;
constexpr int NCH = SB / 16;
constexpr float NORM_EPS = 1e-6f;

constexpr size_t MiB = 1u << 20;
constexpr size_t WS_CTL = 0, CTL_BYTES = 1 * MiB;
constexpr size_t WS_MOD = 1 * MiB;
constexpr size_t WS_ROPE = 2 * MiB;
constexpr size_t WS_SPL = 2 * MiB + 65536;
constexpr size_t WS_TOT = 3 * MiB;
constexpr size_t WS_STATP = 8 * MiB;
constexpr size_t WS_BK = 13 * MiB;
constexpr size_t WS_TW = 15 * MiB + 512 * 1024;
constexpr size_t WS_W_RGIN = 16 * MiB, WS_W_RGG = 24 * MiB, WS_W_RGOUT = 26 * MiB, WS_W_QKV = 30 * MiB, WS_W_AO = 33 * MiB;
constexpr size_t WS_W_CMIN = 35 * MiB, WS_W_CMS = 43 * MiB, WS_W_CMOUT = 44 * MiB, WS_W_E1 = 48 * MiB, WS_W_E2 = 304 * MiB;
constexpr size_t WS_X = 432 * MiB, WS_Y1 = 500 * MiB, WS_H = 568 * MiB, WS_SCR = 602 * MiB;
constexpr size_t WS_GG = WS_SCR, WS_XB = WS_SCR + 34 * MiB, WS_XC = WS_SCR + 68 * MiB, WS_LA = WS_SCR + 102 * MiB, WS_BB = WS_SCR + 170 * MiB, WS_SA = WS_SCR + 238 * MiB;
constexpr size_t WS_QKV = WS_SCR, WS_AO = WS_SCR + 51 * MiB;
constexpr size_t WS_UVB = WS_SCR, WS_UV = WS_SCR + 136 * MiB;
constexpr size_t WS_H1 = WS_SCR;
constexpr size_t WS_TOTS = WS_SCR + 272 * MiB, WS_TOTH = WS_TOTS + 9 * MiB, WS_CARRY = WS_TOTH + 9 * MiB;
constexpr size_t WS_YM = WS_CARRY + 9 * MiB;
constexpr size_t WS_END = WS_YM + 34 * MiB;
constexpr int CW_TMO = 0, CW_BAR = 4096, CW_CNT = 16384;

constexpr int RING_BYTES = 131072;
constexpr int ROUTER_LDS = 36 * 1024 * 4;
constexpr int LDSCTL_OFF = 147456;
constexpr int LDS_BYTES = LDSCTL_OFF + 1024 + 8 * 4 * 40 * 4;

__device__ __forceinline__ unsigned f2bf(float f) { unsigned u = __builtin_bit_cast(unsigned, f); return (u + 0x7fffu + ((u >> 16) & 1u)) >> 16; }
__device__ __forceinline__ unsigned pk2(float lo, float hi) { return f2bf(lo) | (f2bf(hi) << 16); }
__device__ __forceinline__ float bf2f(unsigned short h) { return __builtin_bit_cast(float, (unsigned)h << 16); }
__device__ __forceinline__ float bflo(unsigned w) { return __builtin_bit_cast(float, w << 16); }
__device__ __forceinline__ float bfhi(unsigned w) { return __builtin_bit_cast(float, w & 0xffff0000u); }
__device__ __forceinline__ unsigned cvt_pk_bf16(float lo, float hi) { unsigned r; asm volatile("v_cvt_pk_bf16_f32 %0, %1, %2" : "=v"(r) : "v"(lo), "v"(hi)); return r; }
__device__ __forceinline__ float gelu_tanh(float x) { const float u = 0.7978845608028654f * (x + 0.044715f * x * x * x); const float e = __expf(2.f * u); const float t = 1.f - 2.f / (e + 1.f); return 0.5f * x * (1.f + t); }
__device__ __forceinline__ float sigmoidf_(float x) { return 1.f / (1.f + __expf(-x)); }
__device__ __forceinline__ float fast_sigmoid(float x) { return __builtin_amdgcn_rcpf(1.f + __expf(-x)); }
__device__ __forceinline__ float one_minus_exp(float y) {   const float p = y * (1.f - y * (0.5f - y * (0.16666667f - y * 0.041666667f))); const float q = 1.f - __expf(-y); return y < 0.0625f ? p : q; }
__device__ __forceinline__ int sidx_of_row(int row) { const int b = row / SB; return (row - b * SB) < CTX ? 4 : b; }

namespace pg8 {
constexpr int BM = 256, BK = 64, HALF = 128, HTB = HALF * BK * 2, NXCD = 8, WGM = 8;
__device__ __forceinline__ int lds_byte(int r, int c) { const int st = (r >> 4) * 2 + (c >> 5), rr = r & 15, cc = c & 31, ob = rr * 64 + cc * 2; return st * 1024 + (ob ^ (((ob >> 9) & 1) << 5)); }
__device__ __forceinline__ void stage_rc(int b, int& R, int& C) { const int st = b / 1024, sb = b % 1024, swz = sb ^ (((sb >> 9) & 1) << 5); R = (st >> 1) * 16 + swz / 64; C = (st & 1) * 32 + (swz % 64) / 2; }
__device__ __forceinline__ int perm32(int rho) { const int n = rho >> 4, i = rho & 15; return 8 * (i >> 2) + 4 * n + (i & 3); }
struct Unit { const char* a; const char* b; int pm, pn, aux0, aux1; };
__device__ __forceinline__ const char* uptr(const char* p) { const unsigned long long v = (unsigned long long)p; const unsigned lo = __builtin_amdgcn_readfirstlane((unsigned)v), hi = __builtin_amdgcn_readfirstlane((unsigned)(v >> 32)); return (const char*)(const GAS char*)(((unsigned long long)hi << 32) | lo); }
__device__ __forceinline__ int xcd_remap(int L, int nwg) { const int q = nwg / NXCD, r = nwg % NXCD, xcd = L % NXCD, off = L / NXCD; return (xcd < r ? xcd * (q + 1) : r * (q + 1) + (xcd - r) * q) + off; }

struct DenseOrder {
    static constexpr bool GATHER = false;
    const char* A; const char* B; int nM, nN, nwg, G, c; size_t tA, tB; int amask, acol;
    __device__ void init(const void* A_, int lda, const void* B_, int ldb, int M, int N, int G_, int c_, int amask_ = 0, int acol_ = 0) {
        A = (const char*)A_; B = (const char*)B_; nM = M / BM; nN = N / BM; nwg = nM * nN; G = G_; c = c_; tA = (size_t)BM * lda * 2; tB = (size_t)BM * ldb * 2; amask = amask_; acol = acol_; }
    __device__ bool next(int i, Unit& u) const {
        const long L = (long)i * G + c; if (c >= G || L >= nwg) return false;
        const int wgid = xcd_remap((int)L, nwg);
        const int nig = WGM * nN, gid = wgid / nig, fm = gid * WGM, gsz = (nM - fm) < WGM ? (nM - fm) : WGM;
        u.pm = __builtin_amdgcn_readfirstlane(fm + ((wgid % nig) % gsz)); u.pn = __builtin_amdgcn_readfirstlane((wgid % nig) / gsz); u.aux0 = 0; u.aux1 = 0;
        u.a = uptr(A + (size_t)u.pm * tA + (size_t)(u.pn & amask) * acol); u.b = uptr(B + (size_t)u.pn * tB); return true; }
    __device__ unsigned goff(const Unit&, int) const { return 0u; }
};

#define PG8_SA(b, h) (((b) * 2 + (h)) * HTB)
#define PG8_SB(b, h) ((4 + (b) * 2 + (h)) * HTB)
__device__ __forceinline__ void glds16(const char* sbase, unsigned voff, unsigned ldsaddr) { unsigned keep;
    asm volatile("s_mov_b32 %0, m0\n\ts_mov_b32 m0, %3\n\ts_nop 0\n\tglobal_load_lds_dwordx4 %1, %2\n\ts_mov_b32 m0, %0" : "=&s"(keep) : "v"(voff), "s"(sbase), "s"(ldsaddr) : "memory"); }
#ifndef PG8_ASM_DMA
#define PG8_ASM_DMA 1
#endif
#if PG8_ASM_DMA
#define PG8_GLDS(gp, voff, ldsoff) glds16((const char*)(gp), (voff), ldsbase + (unsigned)(ldsoff))
#else
#define PG8_GLDS(gp, voff, ldsoff) __builtin_amdgcn_global_load_lds((const unsigned*)((const char*)(gp) + (voff)), (LAS unsigned*)(lds + (ldsoff)), 16, 0, 0)
#endif
#define PG8_STAGE_B(bufoff, gbase) do { PG8_GLDS(gbase, voffB[0], (bufoff) + ldsw); PG8_GLDS(gbase, voffB[1], (bufoff) + ldsw + 8192); } while (0)
#define PG8_STAGE_A(bufoff, gbase, h, NX) do { if constexpr (Sched::GATHER) { \
        PG8_GLDS(gbase, ((NX) ? vAn[h][0] : vAc[h][0]), (bufoff) + ldsw); PG8_GLDS(gbase, ((NX) ? vAn[h][1] : vAc[h][1]), (bufoff) + ldsw + 8192); \
    } else { PG8_GLDS((const char*)(gbase) + (h) * hstepA, voffA[0], (bufoff) + ldsw); PG8_GLDS((const char*)(gbase) + (h) * hstepA, voffA[1], (bufoff) + ldsw + 8192); } } while (0)
#define PG8_LDA(dst, b, h) do { _Pragma("unroll") for (int m = 0; m < 4; ++m) _Pragma("unroll") for (int k = 0; k < 2; ++k) dst[m][k] = *(const LAS bf16x8*)(lds + PG8_SA(b, h) + aoff + m * 2048 + k * 1024); } while (0)
#define PG8_LDB(dst, b, h) do { _Pragma("unroll") for (int n = 0; n < 2; ++n) _Pragma("unroll") for (int k = 0; k < 2; ++k) dst[n][k] = *(const LAS bf16x8*)(lds + PG8_SB(b, h) + boff + n * 2048 + k * 1024); } while (0)
typedef int i32x8 __attribute__((ext_vector_type(8))); typedef int i32x4v __attribute__((ext_vector_type(4)));
__device__ __forceinline__ i32x8 cat8(bf16x8 lo, bf16x8 hi) { return __builtin_shufflevector(__builtin_bit_cast(i32x4v, lo), __builtin_bit_cast(i32x4v, hi), 0, 1, 2, 3, 4, 5, 6, 7); }
#define PG8_MMA(ai, bj, At, Bt) do { __builtin_amdgcn_s_setprio(1); _Pragma("unroll") for (int m = 0; m < 4; ++m) _Pragma("unroll") for (int n = 0; n < 2; ++n) { \
        if constexpr (Epi::FP8) { asm volatile("v_mfma_scale_f32_16x16x128_f8f6f4 %0, %1, %2, %0, %3, %3 op_sel_hi:[0,0,0]" : "+v"(acc[ai][bj][m][n]) : "v"(cat8(Bt[n][0], Bt[n][1])), "v"(cat8(At[m][0], At[m][1])), "v"(0x7F7F7F7F)); } \
        else { _Pragma("unroll") for (int k = 0; k < 2; ++k) acc[ai][bj][m][n] = __builtin_amdgcn_mfma_f32_16x16x32_bf16(Bt[n][k], At[m][k], acc[ai][bj][m][n], 0, 0, 0); } } __builtin_amdgcn_s_setprio(0); } while (0)
#define PG8_WAIT_V(n) asm volatile("s_waitcnt vmcnt(" #n ")" ::: "memory")
#define PG8_WAIT_L(n) asm volatile("s_waitcnt lgkmcnt(" #n ")" ::: "memory")
#define PG8_BAR __builtin_amdgcn_s_barrier()
#define PG8_SCHED __builtin_amdgcn_sched_barrier(0)

template <class Epi, class Sched>
__device__ __forceinline__ void gemm_phase(LAS uchar* lds, const Sched& S, const Epi& E, const int K, const int lda, const int ldb) {
    int tid = threadIdx.x; asm volatile("" : "+v"(tid));
    const int wid = __builtin_amdgcn_readfirstlane(tid >> 6), lane = tid & 63, wr = wid >> 2, wc = wid & 3; int fr = lane & 15, fq = lane >> 4;
    int nt = K / BK; asm volatile("" : "+s"(nt));
    unsigned voffA[2], voffB[2];
#pragma unroll
    for (int i = 0; i < 2; ++i) { int R, C; stage_rc(tid * 16 + i * 8192, R, C); const int Rb = Epi::PERM ? ((R & ~31) + perm32(R & 31)) : R;
        voffA[i] = (unsigned)(R * lda + C) * 2u; voffB[i] = (unsigned)(Rb * ldb + C) * 2u; }
    const size_t kstep = (size_t)(BK * 2);
    const size_t hstepA = (size_t)HALF * lda * 2, hstepB = (size_t)HALF * ldb * 2;
    const unsigned ldsw = (unsigned)wid * 1024u;
    const unsigned ldsbase = (unsigned)(uintptr_t)lds;
    const int aoff = lds_byte(wr * 64 + fr, fq * 8), boff = lds_byte(wc * 32 + fr, fq * 8);
    Unit cur, nxt; int ui = 0;
    if (!S.next(0, cur)) return;
    unsigned vAc[2][2], vAn[2][2];
#pragma unroll
    for (int h = 0; h < 2; ++h)
#pragma unroll
        for (int i = 0; i < 2; ++i) { vAc[h][i] = 0u; vAn[h][i] = 0u; }
    if constexpr (Sched::GATHER) {
#pragma unroll
        for (int h = 0; h < 2; ++h)
#pragma unroll
            for (int i = 0; i < 2; ++i) { int R, C; stage_rc(tid * 16 + i * 8192, R, C); vAc[h][i] = S.goff(cur, h * HALF + R) + (unsigned)C * 2u; }
    }
    f32x4 acc[2][2][4][2];
#pragma unroll
    for (int a = 0; a < 2; ++a)
#pragma unroll
        for (int b = 0; b < 2; ++b)
#pragma unroll
            for (int m = 0; m < 4; ++m)
#pragma unroll
                for (int n = 0; n < 2; ++n) acc[a][b][m][n] = (f32x4){0.f, 0.f, 0.f, 0.f};
    bf16x8 At[4][2], B0[2][2], B1[2][2];
    const char* cA = cur.a; const char* cB = cur.b;
    PG8_STAGE_B(PG8_SB(0, 0), cB); PG8_STAGE_B(PG8_SB(0, 1), cB + hstepB); PG8_STAGE_A(PG8_SA(0, 0), cA, 0, false); PG8_STAGE_A(PG8_SA(0, 1), cA, 1, false);
    if (wr == 1) PG8_BAR;
    PG8_WAIT_V(2); PG8_BAR;
    PG8_STAGE_B(PG8_SB(1, 0), cB + kstep); PG8_STAGE_A(PG8_SA(1, 0), cA + kstep, 0, false); PG8_STAGE_B(PG8_SB(1, 1), cB + hstepB + kstep);
    PG8_WAIT_V(6); PG8_BAR;
    for (;;) {
        const bool has_next = S.next(ui + 1, nxt);
        if constexpr (Sched::GATHER) { if (has_next) {
#pragma unroll
            for (int h = 0; h < 2; ++h)
#pragma unroll
                for (int i = 0; i < 2; ++i) { int R, C; int t2 = tid; asm volatile("" : "+v"(t2)); stage_rc(t2 * 16 + i * 8192, R, C); vAn[h][i] = S.goff(nxt, h * HALF + R) + (unsigned)C * 2u; }
            *(LAS u32x4*)(lds + 131072 + tid * 16) = (u32x4){vAn[0][0], vAn[0][1], vAn[1][0], vAn[1][1]}; } }
        const char* nA = has_next ? nxt.a : cA; const char* nB = has_next ? nxt.b : cB;
        for (int t = 0; t < nt; t += 2) {
            const bool last = (t == nt - 2);
            const bool nx = last && has_next;
            if constexpr (Sched::GATHER) { if (nx) { const u32x4 pk_ = *(const LAS u32x4*)(lds + 131072 + tid * 16); vAn[0][0] = pk_.x; vAn[0][1] = pk_.y; vAn[1][0] = pk_.z; vAn[1][1] = pk_.w; } }
            const char* a1 = cA + (size_t)(t + 1) * kstep;
            const char* a2 = last ? nA : cA + (size_t)(t + 2) * kstep; const char* b2 = last ? nB : cB + (size_t)(t + 2) * kstep;
            const char* a3 = a2 + kstep; const char* b3 = b2 + kstep;
            PG8_LDB(B0, 0, 0); PG8_LDB(B1, 0, 1); PG8_SCHED; PG8_LDA(At, 0, 0); PG8_STAGE_A(PG8_SA(1, 1), a1, 1, false);
            PG8_WAIT_V(8); PG8_WAIT_L(0); PG8_BAR; PG8_MMA(0, 0, At, B0); PG8_MMA(0, 1, At, B1); PG8_BAR; PG8_SCHED;
            PG8_LDA(At, 0, 1); PG8_STAGE_B(PG8_SB(0, 0), b2); PG8_STAGE_B(PG8_SB(0, 1), b2 + hstepB); PG8_STAGE_A(PG8_SA(0, 0), a2, 0, nx);
            PG8_WAIT_V(8); PG8_WAIT_L(0); PG8_BAR; PG8_MMA(1, 0, At, B0); PG8_MMA(1, 1, At, B1); PG8_BAR; PG8_SCHED;
            PG8_LDB(B0, 1, 0); PG8_LDB(B1, 1, 1); PG8_SCHED; PG8_LDA(At, 1, 0); PG8_STAGE_A(PG8_SA(0, 1), a2, 1, nx);
            PG8_WAIT_V(8); PG8_WAIT_L(0); PG8_BAR; PG8_MMA(0, 0, At, B0); PG8_MMA(0, 1, At, B1); PG8_BAR; PG8_SCHED;
            PG8_LDA(At, 1, 1); PG8_STAGE_B(PG8_SB(1, 0), b3); PG8_STAGE_B(PG8_SB(1, 1), b3 + hstepB); PG8_STAGE_A(PG8_SA(1, 0), a3, 0, nx);
            PG8_WAIT_V(8); PG8_WAIT_L(0); PG8_BAR; PG8_MMA(1, 0, At, B0); PG8_MMA(1, 1, At, B1); PG8_BAR; PG8_SCHED;
        }
        if (wr == 0) PG8_BAR;
        if constexpr (Epi::FP8) asm volatile("s_nop 15\n\ts_nop 15" ::: "memory");
        E(acc, cur, wr, wc, fr, fq);
        if (!has_next) break;
#pragma unroll
        for (int a = 0; a < 2; ++a)
#pragma unroll
            for (int b = 0; b < 2; ++b)
#pragma unroll
                for (int m = 0; m < 4; ++m)
#pragma unroll
                    for (int n = 0; n < 2; ++n) acc[a][b][m][n] = (f32x4){0.f, 0.f, 0.f, 0.f};
        cur = nxt; cA = nA; cB = nB; ++ui;
        if constexpr (Sched::GATHER) {
#pragma unroll
            for (int h = 0; h < 2; ++h)
#pragma unroll
                for (int i = 0; i < 2; ++i) vAc[h][i] = vAn[h][i]; }
        if (wr == 1) PG8_BAR;
    }
    PG8_WAIT_V(0);
    PG8_BAR;
}
}

#ifndef ATT_SDEPTH
#define ATT_SDEPTH 1
#endif
namespace att {
constexpr int NW = 8, QBLK = 32, KVBLK = 64;
constexpr float SCALE = 0.088388347648318440f;
constexpr float THR = 8.f;
constexpr int LDQ = 1536, LDK = 1536, LDO = 1024;
constexpr size_t SHM_V = KVBLK * 128 * 2, SHM_K = KVBLK * 128 * 2, SHM_ATTN = 2 * SHM_V + 2 * SHM_K + NW * 64 * 4;
#define KSWZ(row, colB) ((row) * 256 + ((colB) ^ (((row) & 7) << 4)))
#define SBAR() __builtin_amdgcn_sched_barrier(0)
__device__ __forceinline__ int crow(int r, int hi) { return (r & 3) + 8 * (r >> 2) + 4 * hi; }
__device__ __forceinline__ void partialSM(f32x16& p0, f32x16& p1, float& m_reg, float& mn, float& alpha) {
  constexpr float C = SCALE * 1.4426950408889634f;
  float pmax = p0[0];
#pragma unroll
  for (int r = 1; r < 16; ++r) pmax = fmaxf(pmax, p0[r]);
#pragma unroll
  for (int r = 0; r < 16; ++r) pmax = fmaxf(pmax, p1[r]);
  { auto rr = __builtin_amdgcn_permlane32_swap(__float_as_uint(pmax), __float_as_uint(pmax), false, false);
    pmax = fmaxf(__uint_as_float(rr[0]), __uint_as_float(rr[1])); }
  if (__builtin_expect(__all(pmax - m_reg <= THR / SCALE), 1)) { mn = m_reg; alpha = 1.f; }
  else { mn = fmaxf(m_reg, pmax); alpha = __builtin_amdgcn_exp2f((m_reg - mn) * C); m_reg = mn; }
  float mnC = -mn * C;
#pragma unroll
  for (int r = 0; r < 16; ++r) p0[r] = fmaf(p0[r], C, mnC);
#pragma unroll
  for (int r = 0; r < 16; ++r) p1[r] = fmaf(p1[r], C, mnC);
#pragma unroll
  for (int r = 0; r < 16; ++r) p0[r] = __builtin_amdgcn_exp2f(p0[r]);
}
__device__ __forceinline__ void finishSM(f32x16& p0, f32x16& p1, float alpha, float& l_reg, bf16x8& pa0, bf16x8& pa1, bf16x8& pa2, bf16x8& pa3) {
#pragma unroll
  for (int r = 0; r < 16; ++r) p1[r] = __builtin_amdgcn_exp2f(p1[r]);
  float ps = 0;
#pragma unroll
  for (int r = 0; r < 16; ++r) ps += p0[r];
#pragma unroll
  for (int r = 0; r < 16; ++r) ps += p1[r];
  { auto rr = __builtin_amdgcn_permlane32_swap(__float_as_uint(ps), __float_as_uint(ps), false, false);
    ps = __uint_as_float(rr[0]) + __uint_as_float(rr[1]); }
  l_reg = l_reg * alpha + ps;
#define PK4(P, BASE, OUT) do { unsigned a0 = cvt_pk_bf16(P[BASE + 0], P[BASE + 1]), a1 = cvt_pk_bf16(P[BASE + 2], P[BASE + 3]);   \
    unsigned b0 = cvt_pk_bf16(P[BASE + 4], P[BASE + 5]), b1 = cvt_pk_bf16(P[BASE + 6], P[BASE + 7]);                              \
    auto r0 = __builtin_amdgcn_permlane32_swap(a0, b0, false, false); auto r1 = __builtin_amdgcn_permlane32_swap(a1, b1, false, false); \
    u32x4 w = {r0[0], r1[0], r0[1], r1[1]}; OUT = __builtin_bit_cast(bf16x8, w); } while (0)
  PK4(p0, 0, pa0); PK4(p0, 8, pa1); PK4(p1, 0, pa2); PK4(p1, 8, pa3);
#undef PK4
}
__device__ __forceinline__ void qkt(f32x16& p0, f32x16& p1, const bf16_t* Ks, const bf16x8* qr, int r32, int hi) {
  p0 = f32x16{}; p1 = f32x16{};
#pragma unroll
  for (int d0 = 0; d0 < 8; ++d0) { int cb = (d0 * 16 + hi * 8) * 2;
    bf16x8 b0 = *reinterpret_cast<const bf16x8*>((const char*)Ks + KSWZ(r32, cb));
    bf16x8 b1 = *reinterpret_cast<const bf16x8*>((const char*)Ks + KSWZ(32 + r32, cb));
    p0 = __builtin_amdgcn_mfma_f32_32x32x16_bf16(b0, qr[d0], p0, 0, 0, 0);
    p1 = __builtin_amdgcn_mfma_f32_32x32x16_bf16(b1, qr[d0], p1, 0, 0, 0); }
}
__device__ __forceinline__ int v_st(int k, int c) { const int kk = (k & ~0xC) | ((k & 4) << 1) | ((k & 8) >> 1); return ((kk >> 3) * 4 + (c >> 5)) * 512 + ((kk & 7) * 32 + (c & 31)) * 2; }
__device__ __forceinline__ int v_rd_base(int lane) { return ((lane & 3) << 3) | (((lane >> 2) & 3) << 6) | (((lane >> 4) & 1) << 5) | (((lane >> 5) & 1) << 8); }
constexpr int v_rd_off(int d0, int ks, int half) { return d0 * 512 + ks * 4096 + half * 2048; }
template <int OFF> __device__ __forceinline__ s16x4 tr_read(int vb) {
  s16x4 r; asm volatile("ds_read_b64_tr_b16 %0, %1 offset:%2" : "=&v"(r) : "v"(vb), "i"(OFF) : "memory"); return r;
}
template <int D0> __device__ __forceinline__ void pv_one(f32x16& od, int vb, bf16x8 pa0, bf16x8 pa1, bf16x8 pa2, bf16x8 pa3) {
  const s16x4 l0 = tr_read<v_rd_off(D0, 0, 0)>(vb), h0 = tr_read<v_rd_off(D0, 0, 1)>(vb), l1 = tr_read<v_rd_off(D0, 1, 0)>(vb), h1 = tr_read<v_rd_off(D0, 1, 1)>(vb);
  const s16x4 l2 = tr_read<v_rd_off(D0, 2, 0)>(vb), h2 = tr_read<v_rd_off(D0, 2, 1)>(vb), l3 = tr_read<v_rd_off(D0, 3, 0)>(vb), h3 = tr_read<v_rd_off(D0, 3, 1)>(vb);
  asm volatile("s_waitcnt lgkmcnt(0)" ::: "memory"); SBAR();
#define PK(L, H) (bf16x8){L[0], L[1], L[2], L[3], H[0], H[1], H[2], H[3]}
  od = __builtin_amdgcn_mfma_f32_32x32x16_bf16(pa0, PK(l0, h0), od, 0, 0, 0);
  od = __builtin_amdgcn_mfma_f32_32x32x16_bf16(pa1, PK(l1, h1), od, 0, 0, 0);
  od = __builtin_amdgcn_mfma_f32_32x32x16_bf16(pa2, PK(l2, h2), od, 0, 0, 0);
  od = __builtin_amdgcn_mfma_f32_32x32x16_bf16(pa3, PK(l3, h3), od, 0, 0, 0);
#undef PK
}
__device__ __forceinline__ void pv_d0(f32x16* o, int vb, bf16x8 pa0, bf16x8 pa1, bf16x8 pa2, bf16x8 pa3) {
  pv_one<0>(o[0], vb, pa0, pa1, pa2, pa3); pv_one<1>(o[1], vb, pa0, pa1, pa2, pa3); pv_one<2>(o[2], vb, pa0, pa1, pa2, pa3); pv_one<3>(o[3], vb, pa0, pa1, pa2, pa3);
}
__device__ __forceinline__ void attn_dense_body(const bf16_t* Qb, const bf16_t* Kh, const bf16_t* Vh, bf16_t* Ob, int seq, char* lds, const int tid) {
  const int wid = tid >> 6, lane = tid & 63, r32 = lane & 31, hi = lane >> 5;
  bf16_t* V_lds = (bf16_t*)lds; bf16_t* K_lds = (bf16_t*)(lds + 2 * SHM_V);
  float* ws = (float*)(lds + 2 * SHM_V + 2 * SHM_K) + wid * 64; float* li_l = ws; float* al_l = ws + 32;
  float m_reg = -1e30f, l_reg = 0; f32x16 o[4] = {}; bf16x8 qr[8];
  const bf16_t* Qw = Qb + (long)(wid * QBLK + r32) * LDQ + hi * 8;
#pragma unroll
  for (int d0 = 0; d0 < 8; ++d0) qr[d0] = *reinterpret_cast<const bf16x8*>(Qw + d0 * 16);
  const int sr = tid >> 4, sc = (tid & 15) * 8, vst0 = v_st(sr, sc), vst1 = v_st(32 + sr, sc);
  const int vb0 = (int)(uintptr_t)V_lds + v_rd_base(lane);
  struct { bf16x8 vs0, vs1, ks0, ks1; } sr_[ATT_SDEPTH];
  const unsigned vo0 = (unsigned)(sr * LDK + sc) * 2u, vo1 = (unsigned)((32 + sr) * LDK + sc) * 2u;
  const long vdelta = (const char*)Vh - (const char*)Kh;
#define SLOAD(i, k0) do { const char* kb_ = (const char*)Kh + (size_t)(k0) * (LDK * 2); const char* vb_ = kb_ + vdelta; \
    sr_[i].vs0 = *reinterpret_cast<const bf16x8*>(vb_ + vo0); sr_[i].vs1 = *reinterpret_cast<const bf16x8*>(vb_ + vo1); \
    sr_[i].ks0 = *reinterpret_cast<const bf16x8*>(kb_ + vo0); sr_[i].ks1 = *reinterpret_cast<const bf16x8*>(kb_ + vo1); } while (0)
#define SWRITE(b, i) do { *(bf16x8*)((char*)V_lds + (b) * SHM_V + vst0) = sr_[i].vs0;          \
    *(bf16x8*)((char*)V_lds + (b) * SHM_V + vst1) = sr_[i].vs1; int kc = sc * 2;               \
    *(bf16x8*)((char*)K_lds + (b) * SHM_K + KSWZ(sr, kc)) = sr_[i].ks0;                       \
    *(bf16x8*)((char*)K_lds + (b) * SHM_K + KSWZ(32 + sr, kc)) = sr_[i].ks1; } while (0)
#define SWAIT() do { if constexpr (ATT_SDEPTH == 2) asm volatile("s_waitcnt vmcnt(4)" ::: "memory"); else asm volatile("s_waitcnt vmcnt(0)" ::: "memory"); } while (0)
#define RESC(a) do { if (__any((a) < 1.f)) { if (hi == 0) al_l[r32] = (a); asm volatile("s_waitcnt lgkmcnt(0)" ::: "memory"); \
    _Pragma("unroll") for (int d = 0; d < 4; ++d) _Pragma("unroll") for (int r = 0; r < 16; ++r) o[d][r] *= al_l[crow(r, hi)]; } } while (0)
  f32x16 pA0, pA1, pB0, pB1; float mnA, mnB, alA, alB; bf16x8 pa0, pa1, pa2, pa3; const int NT = seq / KVBLK;
  constexpr int SE = 0, SO = ATT_SDEPTH - 1;
  SLOAD(SE, 0); asm volatile("s_waitcnt vmcnt(0)" ::: "memory"); SWRITE(0, SE); __syncthreads();
  qkt(pA0, pA1, K_lds, qr, r32, hi); partialSM(pA0, pA1, m_reg, mnA, alA);
  SLOAD(SO, KVBLK); if constexpr (ATT_SDEPTH == 2) { if (2 < NT) SLOAD(SE, 2 * KVBLK); }
  SWAIT(); SWRITE(1, SO); __syncthreads();
  for (int j = 1; j + 1 < NT; j += 2) {
    SBAR(); qkt(pB0, pB1, (bf16_t*)((char*)K_lds + SHM_K), qr, r32, hi);
    finishSM(pA0, pA1, alA, l_reg, pa0, pa1, pa2, pa3); SBAR();
    SLOAD(SO, (j + ATT_SDEPTH) * KVBLK); SBAR();
    pv_d0(o, vb0, pa0, pa1, pa2, pa3); partialSM(pB0, pB1, m_reg, mnB, alB);
    __syncthreads(); SWAIT(); SWRITE(0, SE);
    RESC(alB); __syncthreads();
    SBAR(); qkt(pA0, pA1, K_lds, qr, r32, hi);
    finishSM(pB0, pB1, alB, l_reg, pa0, pa1, pa2, pa3); SBAR();
    if (ATT_SDEPTH == 1 || j + 3 < NT) SLOAD(SE, (j + 1 + ATT_SDEPTH) * KVBLK); SBAR();
    pv_d0(o, vb0 + (int)SHM_V, pa0, pa1, pa2, pa3); partialSM(pA0, pA1, m_reg, mnA, alA);
    __syncthreads(); SWAIT(); SWRITE(1, SO);
    RESC(alA); __syncthreads();
  }
  SBAR(); qkt(pB0, pB1, (bf16_t*)((char*)K_lds + SHM_K), qr, r32, hi);
  finishSM(pA0, pA1, alA, l_reg, pa0, pa1, pa2, pa3); SBAR();
  pv_d0(o, vb0, pa0, pa1, pa2, pa3); partialSM(pB0, pB1, m_reg, mnB, alB);
  __syncthreads(); RESC(alB);
  finishSM(pB0, pB1, alB, l_reg, pa0, pa1, pa2, pa3); SBAR();
  pv_d0(o, vb0 + (int)SHM_V, pa0, pa1, pa2, pa3);
  if (hi == 0) li_l[r32] = l_reg; asm volatile("s_waitcnt lgkmcnt(0)" ::: "memory");
  float rli[16];
#pragma unroll
  for (int r = 0; r < 16; ++r) rli[r] = __builtin_amdgcn_rcpf(li_l[crow(r, hi)]);
  bf16_t* Ow = Ob + (long)(wid * QBLK) * LDO;
#pragma unroll
  for (int r = 0; r < 16; ++r) { int orow = crow(r, hi);
#pragma unroll
    for (int d0 = 0; d0 < 4; ++d0) Ow[(long)orow * LDO + d0 * 32 + r32] = (bf16_t)f2bf(o[d0][r] * rli[r]); }
#undef SLOAD
#undef SWRITE
#undef SWAIT
#undef RESC
}
}

#define XB_TMO      128
#define XB_XCNT(j)  (256  + 64 * (j))
#define XB_XSUB(j)  (1280 + 64 * (j))
#define XB_XGEN(j)  (2304 + 64 * (j))
#define XB_TOP      3328
#define XB_TOPGEN   3392
#define XB_SPIN_CAP (1u << 22)
__device__ __forceinline__ unsigned xb_ld(unsigned* p)              { return __hip_atomic_load(p, __ATOMIC_RELAXED, __HIP_MEMORY_SCOPE_AGENT); }
__device__ __forceinline__ unsigned xb_add(unsigned* p, unsigned v) { return __hip_atomic_fetch_add(p, v, __ATOMIC_RELAXED, __HIP_MEMORY_SCOPE_AGENT); }
__device__ __forceinline__ unsigned xb_xcc_id() { return (unsigned)__builtin_amdgcn_s_getreg((3 << 11) | 20) & 0xFu; }
#define XB_SPIN(cond, bar) do { unsigned _sp = 0; while (cond) { __builtin_amdgcn_s_sleep(1); \
    if ((++_sp & 255u) == 0u) { if (xb_ld(&(bar)[XB_TMO])) break; if (_sp > XB_SPIN_CAP) { atomicAdd(&(bar)[XB_TMO], 1u); break; } } } } while (0)
struct XcdBarrier { unsigned* bar; unsigned x; volatile LAS unsigned* st; };
__device__ __forceinline__ XcdBarrier xcd_barrier_post(unsigned* bar, volatile LAS unsigned* st) {
    XcdBarrier b; b.bar = bar; b.x = xb_xcc_id(); b.st = st;
    if (threadIdx.x == 0) (void)xb_add(&bar[XB_XCNT(b.x)], 1u);
    return b;
}
__device__ __forceinline__ void xcd_barrier_complete(unsigned* bar, unsigned x, unsigned& nloc, unsigned& nx) {
    const unsigned G = gridDim.x * gridDim.y * gridDim.z;
    unsigned sum, cnt, mine, sp = 0u;
    for (;;) {
        sum = 0u; cnt = 0u; mine = 0u;
#pragma unroll
        for (unsigned j = 0; j < 16; ++j) { const unsigned c = xb_ld(&bar[XB_XCNT(j)]); sum += c; cnt += (c > 0u) ? 1u : 0u; mine = (j == x) ? c : mine; }
        if (sum == G) break;
        __builtin_amdgcn_s_sleep(1);
        if ((++sp & 255u) == 0u) { if (xb_ld(&bar[XB_TMO])) break; if (sp > XB_SPIN_CAP) { atomicAdd(&bar[XB_TMO], 1u); break; } }
    }
    nloc = mine > 0u ? mine : 1u; nx = cnt > 0u ? cnt : 1u;
}
__device__ __forceinline__ void xcd_barrier(const XcdBarrier& b_) {
    XcdBarrier b; b.bar = b_.bar; b.st = b_.st; b.x = xb_xcc_id();
    asm volatile("s_waitcnt vmcnt(0)" ::: "memory");
    __syncthreads();
    if (threadIdx.x == 0) {
        unsigned* bar = b.bar;
        __builtin_amdgcn_s_waitcnt(0);
        unsigned nloc = b.st[0], nx = b.st[1];
        if (nloc == 0u) { xcd_barrier_complete(bar, b.x, nloc, nx); b.st[0] = nloc; b.st[1] = nx; }
        const unsigned old = xb_add(&bar[XB_XSUB(b.x)], 1u);
        const unsigned gen = old / nloc;
        if (old + 1u == (gen + 1u) * nloc) {
            __builtin_amdgcn_fence(__ATOMIC_RELEASE, "agent");
            asm volatile("s_waitcnt vmcnt(0)" ::: "memory");
            const unsigned og = xb_add(&bar[XB_TOP], 1u);
            const unsigned tg = og / nx;
            if (og + 1u == (tg + 1u) * nx) xb_add(&bar[XB_TOPGEN], 1u);
            else XB_SPIN(xb_ld(&bar[XB_TOPGEN]) == tg, bar);
            __builtin_amdgcn_fence(__ATOMIC_ACQUIRE, "agent");
            xb_add(&bar[XB_XGEN(b.x)], 1u);
            asm volatile("s_waitcnt vmcnt(0)" ::: "memory");
        } else {
            XB_SPIN(xb_ld(&bar[XB_XGEN(b.x)]) == gen, bar);
            __builtin_amdgcn_fence(__ATOMIC_ACQUIRE, "agent");
            asm volatile("s_waitcnt vmcnt(0)" ::: "memory");
        }
    }
    __syncthreads();
}

struct Args { const float* in[34]; float* out; uchar* ws; int ph_lo, ph_hi; };
enum { I_X = 0, I_C, I_CTX, I_CCTX, I_ADAW, I_ADAB, I_NMG, I_NFG, I_RGWIN, I_RGCW, I_RGCB, I_RGWA, I_RGBA, I_RGWI, I_RGBI, I_RGLAM, I_RGWOUT,
       I_ATQKV, I_ATQG, I_ATKG, I_ATWO, I_CMWIN, I_CMLNG, I_CMLNB, I_CMWS, I_CMBS, I_CMWOUT, I_MWG, I_MBG, I_MWR, I_MBR, I_MWGATE, I_MWUP, I_MWDOWN };

__device__ __forceinline__ const void* opaque_uniform_ptr(const void* p) { const unsigned long long v = (unsigned long long)p; unsigned lo = (unsigned)v, hi = (unsigned)(v >> 32); asm volatile("" : "+v"(lo), "+v"(hi));
    lo = __builtin_amdgcn_readfirstlane(lo); hi = __builtin_amdgcn_readfirstlane(hi); return (const void*)(const GAS char*)(((unsigned long long)hi << 32) | lo); }
__device__ __forceinline__ int opaque_uniform_int(int x) { asm volatile("" : "+v"(x)); return __builtin_amdgcn_readfirstlane(x); }
struct Frame {
    LAS uchar* lds; char* ldsg;
    int tid, lane, wave, G, bid;
    uchar* ws; float* out;
};
__device__ __forceinline__ const float* inp(const Frame& F, int i) { const unsigned long long v = *(const LAS unsigned long long*)(F.lds + LDSCTL_OFF + 576 + i * 8);
    const unsigned lo = __builtin_amdgcn_readfirstlane((unsigned)v), hi = __builtin_amdgcn_readfirstlane((unsigned)(v >> 32)); return (const float*)(const GAS float*)(((unsigned long long)hi << 32) | lo); }
__device__ __forceinline__ float wave16_sum(float v) {
    v += __int_as_float(__builtin_amdgcn_update_dpp(0, __float_as_int(v), 0xB1, 0xF, 0xF, true));
    v += __int_as_float(__builtin_amdgcn_update_dpp(0, __float_as_int(v), 0x4E, 0xF, 0xF, true));
    v += __int_as_float(__builtin_amdgcn_update_dpp(0, __float_as_int(v), 0x141, 0xF, 0xF, true));
    v += __int_as_float(__builtin_amdgcn_update_dpp(0, __float_as_int(v), 0x140, 0xF, 0xF, true));
    return v; }

struct ConvItem { const float* src; uchar* dst; int ldw; bool f8; };
__device__ __forceinline__ void tr_load(const ConvItem& ci, f32x4 (&v)[16]) {
    if (ci.f8) {
#pragma unroll
        for (int i = 0; i < 8; ++i) { v[2 * i] = __builtin_nontemporal_load((const f32x4*)(ci.src + (size_t)(8 * i) * ci.ldw)); v[2 * i + 1] = __builtin_nontemporal_load((const f32x4*)(ci.src + (size_t)(8 * i + 1) * ci.ldw)); }
    } else {
#pragma unroll
        for (int i = 0; i < 16; ++i) v[i] = __builtin_nontemporal_load((const f32x4*)(ci.src + (size_t)(4 * i) * ci.ldw));
    }
}
__device__ __forceinline__ void tr_finish(const f32x4 (&v)[16], const ConvItem& ci, LAS uchar* scr, int lane) {
    const int kr = lane >> 4, nc = (lane & 15) * 4;
    const int g = lane >> 4, q = (lane >> 2) & 3, p = lane & 3;
    const int vb = (int)(uintptr_t)scr + q * 128 + g * 32 + p * 8;
    if (ci.f8) {
#pragma unroll
        for (int i = 0; i < 8; ++i) { const f32x4 a = v[2 * i] * 32.f, b = v[2 * i + 1] * 32.f;
            int r0 = __builtin_amdgcn_cvt_pk_fp8_f32(a.x, b.x, 0, false); r0 = __builtin_amdgcn_cvt_pk_fp8_f32(a.y, b.y, r0, true);
            int r1 = __builtin_amdgcn_cvt_pk_fp8_f32(a.z, b.z, 0, false); r1 = __builtin_amdgcn_cvt_pk_fp8_f32(a.w, b.w, r1, true);
            *(LAS u32x2*)(scr + (4 * i + kr) * 128 + nc * 2) = (u32x2){(unsigned)r0, (unsigned)r1}; }
        asm volatile("s_waitcnt lgkmcnt(0)" ::: "memory");
        s16x4 t[8];
#define TRR(r) t[r] = att::tr_read<(r) * 512>(vb)
        TRR(0); TRR(1); TRR(2); TRR(3); TRR(4); TRR(5); TRR(6); TRR(7);
#undef TRR
        asm volatile("s_waitcnt lgkmcnt(0)" ::: "memory"); __builtin_amdgcn_sched_barrier(0);
#pragma unroll
        for (int j = 0; j < 4; ++j) { const bf16x8 o = {t[2 * j][0], t[2 * j][1], t[2 * j][2], t[2 * j][3], t[2 * j + 1][0], t[2 * j + 1][1], t[2 * j + 1][2], t[2 * j + 1][3]}; *(bf16x8*)(ci.dst + 16 * j) = o; }
    } else {
#pragma unroll
        for (int i = 0; i < 16; ++i) { u32x2 o; o.x = pk2(v[i].x, v[i].y); o.y = pk2(v[i].z, v[i].w); *(LAS u32x2*)(scr + (4 * i + kr) * 128 + nc * 2) = o; }
        asm volatile("s_waitcnt lgkmcnt(0)" ::: "memory");
        s16x4 t[16];
#define TRR(r) t[r] = att::tr_read<(r) * 512>(vb)
        TRR(0); TRR(1); TRR(2); TRR(3); TRR(4); TRR(5); TRR(6); TRR(7); TRR(8); TRR(9); TRR(10); TRR(11); TRR(12); TRR(13); TRR(14); TRR(15);
#undef TRR
        asm volatile("s_waitcnt lgkmcnt(0)" ::: "memory"); __builtin_amdgcn_sched_barrier(0);
#pragma unroll
        for (int j = 0; j < 8; ++j) { const bf16x8 o = {t[2 * j][0], t[2 * j][1], t[2 * j][2], t[2 * j][3], t[2 * j + 1][0], t[2 * j + 1][1], t[2 * j + 1][2], t[2 * j + 1][3]}; *(bf16x8*)(ci.dst + 16 * j) = o; }
    }
}
struct Job { int g, lo, hi; };
__device__ __forceinline__ ConvItem conv_decode(Frame& F, int g, int it) {
    uchar* ws = F.ws; const float* W; int K = 1024, N = 1024, ldt = 1024, mode = 0; size_t dms = 0; bf16_t* WT;
    switch (g) {
        case 0:  W = inp(F, I_MWGATE); N = 512; WT = (bf16_t*)(ws + WS_W_E1); dms = (size_t)1024 * 1024; mode = 1; break;
        case 1:  W = inp(F, I_MWUP);   N = 512; WT = (bf16_t*)(ws + WS_W_E1); dms = (size_t)1024 * 1024; mode = 2; break;
        case 2:  W = inp(F, I_MWDOWN); K = 512; WT = (bf16_t*)(ws + WS_W_E2); ldt = 512; dms = (size_t)1024 * 512; break;
        case 3:  W = inp(F, I_RGWIN);  N = 2048; WT = (bf16_t*)(ws + WS_W_RGIN); dms = (size_t)2048 * 1024; break;
        case 4:  W = inp(F, I_CMWIN);  N = 4096; WT = (bf16_t*)(ws + WS_W_CMIN); break;
        case 5:  W = inp(F, I_RGWOUT); WT = (bf16_t*)(ws + WS_W_RGOUT); dms = (size_t)1024 * 1024; break;
        case 6:  W = inp(F, I_CMWOUT); K = 2048; WT = (bf16_t*)(ws + WS_W_CMOUT); ldt = 2048; break;
        case 7:  W = inp(F, I_ATQKV);  N = 1536; WT = (bf16_t*)(ws + WS_W_QKV); break;
        case 8:  W = inp(F, I_ATWO);   WT = (bf16_t*)(ws + WS_W_AO); break;
        case 9:  W = inp(F, I_RGWA);   K = 128; N = 128; WT = (bf16_t*)(ws + WS_W_RGG); ldt = 128; dms = (size_t)256 * 128; break;
        default: W = inp(F, I_RGWI);   K = 128; N = 128; WT = (bf16_t*)(ws + WS_W_RGG); ldt = 128; dms = (size_t)256 * 128; mode = 3; break;
    }
    const int nblk = N / 64, per = (K / 64) * nblk, mat = it / per, r = it - mat * per, kb = r / nblk, nb = r - kb * nblk, n0 = nb * 64;
    int drow = n0;
    if (mode == 1) drow = (n0 >> 7) * 256 + (n0 & 127); else if (mode == 2) drow = (n0 >> 7) * 256 + 128 + (n0 & 127); else if (mode == 3) drow = 128 + n0;
    const int lane = F.lane;
    const bool f8 = (MOE_FP8 != 0) && g < 3; const int eb = f8 ? 1 : 2;
    ConvItem ci; ci.ldw = N; ci.f8 = f8; ci.src = W + (size_t)mat * K * N + (size_t)(kb * 64 + (f8 ? 2 : 1) * (lane >> 4)) * N + n0 + (lane & 15) * 4;
    ci.dst = (uchar*)WT + ((size_t)mat * dms + (size_t)(drow + (lane >> 4) * 16 + (lane & 15)) * ldt + kb * 64) * eb;
    return ci;
}
template <int NJ>
__device__ __forceinline__ ConvItem conv_find(Frame& F, int v, const Job (&jobs)[NJ]) { int r = v, g = jobs[0].g, it = 0; bool found = false;
#pragma unroll
    for (int q = 0; q < NJ; ++q) { const int n = jobs[q].hi - jobs[q].lo; if (!found) { if (r < n) { g = jobs[q].g; it = jobs[q].lo + r; found = true; } else r -= n; } }
    return conv_decode(F, g, it); }
template <int NJ>
__device__ __forceinline__ void conv_tail(Frame& F, int nblk0, const Job (&jobs)[NJ]) {
    if (nblk0 >= F.G) nblk0 = 0;
    if (F.bid < nblk0) return;
    LAS uchar* scr = F.lds + F.wave * 8192;
    int total = 0;
#pragma unroll
    for (int q = 0; q < NJ; ++q) total += jobs[q].hi - jobs[q].lo;
    const int nw = (F.G - nblk0) * 8;
    int v0 = (F.bid - nblk0) * 8 + F.wave;
    f32x4 va[16], vb[16]; ConvItem c0, c1; c0.dst = nullptr; c1.dst = nullptr; c0.f8 = false; c1.f8 = false; c0.src = nullptr; c1.src = nullptr; c0.ldw = 0; c1.ldw = 0;
    if (v0 < total) { c0 = conv_find(F, v0, jobs); tr_load(c0, va); }
    for (; v0 < total; v0 += 2 * nw) {
        const int v1 = v0 + nw, v2 = v1 + nw;
        if (v1 < total) { c1 = conv_find(F, v1, jobs); tr_load(c1, vb); }
        tr_finish(va, c0, scr, F.lane);
        if (v2 < total) { c0 = conv_find(F, v2, jobs); tr_load(c0, va); }
        if (v1 < total) tr_finish(vb, c1, scr, F.lane);
    }
}
__device__ __forceinline__ void p0_prologue(Frame& F) {
    uchar* ws = F.ws;
    {
        LAS float* act = (LAS float*)(F.lds);
        LAS float* red = (LAS float*)(F.lds + 5 * 1024 * 4);
        bool have = false; const float* pC = inp(F, I_C); const float* pCC = inp(F, I_CCTX); const float* pADAW = inp(F, I_ADAW); const float* pADAB = inp(F, I_ADAB);
        for (int it = F.bid; it < DEPTH * 24; it += F.G) {
            if (!have) { for (int i = F.tid; i < 5 * 1024; i += 512) { const int s = i >> 10, k = i & 1023; const float v = s < 4 ? pC[s * 1024 + k] : pCC[k]; act[i] = v / (1.f + __expf(-v)); } have = true; __syncthreads(); }
            const int l = it / 24, cb = it % 24;
            const float* W = pADAW + (size_t)l * 1024 * NMODV + cb * 256 + F.lane * 4;
            f32x4 a[5];
#pragma unroll
            for (int s = 0; s < 5; ++s) a[s] = (f32x4){0.f, 0.f, 0.f, 0.f};
            const int kbase = F.wave * 128;
#pragma unroll 8
            for (int k = 0; k < 128; ++k) { const f32x4 w = *(const f32x4*)(W + (size_t)(kbase + k) * NMODV);
#pragma unroll
                for (int s = 0; s < 5; ++s) a[s] += w * act[s * 1024 + kbase + k]; }
#pragma unroll
            for (int s = 0; s < 5; ++s) *(LAS f32x4*)(red + (F.wave * 5 + s) * 256 + F.lane * 4) = a[s];
            __syncthreads();
            for (int i = F.tid; i < 5 * 256; i += 512) { const int s = i >> 8, c = i & 255; float v = pADAB[l * NMODV + cb * 256 + c];
#pragma unroll
                for (int w = 0; w < 8; ++w) v += red[(w * 5 + s) * 256 + c];
                ((float*)(ws + WS_MOD))[(l * 5 + s) * NMODV + cb * 256 + c] = v; }
            __syncthreads();
        }
        __syncthreads();
    }
    { const Job jobs[11] = {{0, 0, 16384}, {1, 0, 16384}, {2, 0, 16384}, {3, 0, 1024}, {4, 0, 1024}, {5, 0, 512}, {6, 0, 512}, {7, 0, 384}, {8, 0, 256}, {9, 0, 128}, {10, 0, 128}}; conv_tail(F, 0, jobs); }
    {
        const int gt = F.bid * 512 + F.tid, NGT = F.G * 512;
        { const float* pctx = inp(F, I_CTX); const float* px = inp(F, I_X);
          for (int i0 = gt; i0 < T * 256; i0 += 4 * NGT) { f32x4 v[4];
#pragma unroll
            for (int q = 0; q < 4; ++q) { const int i = i0 + q * NGT; if (i < T * 256) { const int row = i >> 8, c4 = i & 255, b = row / SB, s = row - b * SB;
                const float* src = s < CTX ? pctx + ((size_t)(b * CTX + s) << 10) : px + ((size_t)(b * SEQ + s - CTX) << 10); v[q] = ((const f32x4*)src)[c4]; } }
#pragma unroll
            for (int q = 0; q < 4; ++q) { const int i = i0 + q * NGT; if (i < T * 256) ((f32x4*)(ws + WS_X))[i] = v[q]; } } }
        for (int i = gt; i < 8 * 128 * 128 / 4; i += NGT) { const f32x4 v = ((const f32x4*)inp(F, I_CMWS))[i]; u32x2 o; o.x = pk2(v.x, v.y); o.y = pk2(v.z, v.w); ((u32x2*)(ws + WS_W_CMS))[i] = o; }
        for (int i = gt; i < 2 * 2 * D; i += NGT) { const float* plam = inp(F, I_RGLAM); ((float*)(ws + WS_SPL))[i] = -8.f * log1pf(expf(-plam[i])); }
        for (int i = gt; i < 64 * 32; i += NGT) { const int pos = i >> 5, f = i & 31; const float inv = powf(10000.f, -(float)f * 2.0f / 64.0f); const float ang = (float)pos * inv;
            ((f32x2*)(ws + WS_ROPE))[i] = (f32x2){cosf(ang), sinf(ang)}; }
    }
}

template <bool ROUTE, int NADD>
__device__ __forceinline__ void norm_phase(Frame& F, int l, const float* gvec, int shift_i, bool skip_ctx_route, bool dry) {
    uchar* ws = F.ws;
    float* X = (float*)(ws + WS_X); const bf16_t* YS = (const bf16_t*)(ws + WS_Y1); const bf16_t* YM = (const bf16_t*)(ws + WS_YM); bf16_t* H = (bf16_t*)(ws + WS_H);
    const float* MOD = (const float*)(ws + WS_MOD) + (size_t)l * 5 * NMODV;
    LAS float* wr = (LAS float*)F.lds;
    if constexpr (ROUTE) {
        const float* wg = inp(F, I_MWG) + (size_t)l * 1024 * 4; const float* wrt = inp(F, I_MWR) + (size_t)l * 1024 * 32;
        for (int i0 = F.tid; i0 < 1024 * 9; i0 += 512 * 6) { f32x4 v[6];
#pragma unroll
            for (int u = 0; u < 6; ++u) { const int idx = i0 + u * 512; const int k = idx / 9, q = idx - k * 9; v[u] = q == 0 ? *(const f32x4*)(wg + k * 4) : *(const f32x4*)(wrt + k * 32 + (q - 1) * 4); }
#pragma unroll
            for (int u = 0; u < 6; ++u) { const int idx = i0 + u * 512; const int k = idx / 9, q = idx - k * 9;
                wr[(4 * q + 0) * 1024 + k] = v[u].x; wr[(4 * q + 1) * 1024 + k] = v[u].y; wr[(4 * q + 2) * 1024 + k] = v[u].z; wr[(4 * q + 3) * 1024 + k] = v[u].w; } }
        __syncthreads();
    }
    const int i16 = F.lane & 15, grp = F.lane >> 4;
    const float* bg = nullptr; const float* br = nullptr; if constexpr (ROUTE) { bg = inp(F, I_MBG) + l * 4; br = inp(F, I_MBR) + l * 32; }
    for (int tok = (F.bid * 8 + F.wave) * 4 + grp; tok < T; tok += F.G * 32) {
        asm volatile("" ::: "memory");
        const int sidx = sidx_of_row(tok);
        f32x4 x[16];
        float ss = 0.f;
#pragma unroll
        for (int j = 0; j < 16; ++j) { x[j] = *(const f32x4*)(X + (size_t)tok * D + 64 * j + 4 * i16);
            if constexpr (NADD >= 1) { const u32x2 ym = *(const u32x2*)(YM + (size_t)tok * D + 64 * j + 4 * i16); x[j] += (f32x4){bflo(ym.x), bfhi(ym.x), bflo(ym.y), bfhi(ym.y)}; }
            if constexpr (NADD == 3) { const u32x2 y0 = *(const u32x2*)(YS + (size_t)tok * D + 64 * j + 4 * i16), y1 = *(const u32x2*)(YS + ((size_t)T + tok) * D + 64 * j + 4 * i16);
                x[j] += (f32x4){bflo(y0.x) + bflo(y1.x), bfhi(y0.x) + bfhi(y1.x), bflo(y0.y) + bflo(y1.y), bfhi(y0.y) + bfhi(y1.y)}; *(f32x4*)(X + (size_t)tok * D + 64 * j + 4 * i16) = x[j]; }
            ss += x[j].x * x[j].x + x[j].y * x[j].y + x[j].z * x[j].z + x[j].w * x[j].w; }
        ss = wave16_sum(ss);
        const float rstd = rsqrtf(ss * (1.f / D) + NORM_EPS);
        const float* shp = MOD + (size_t)sidx * NMODV + shift_i * D; const float* scp = shp + D;
#pragma unroll
        for (int j = 0; j < 16; ++j) { const int c = 64 * j + 4 * i16; const f32x4 g = *(const f32x4*)(gvec + c), sh = *(const f32x4*)(shp + c), sc = *(const f32x4*)(scp + c);
            x[j] = x[j] * rstd * g * (sc + 1.f) + sh;
            if constexpr (ROUTE && MOE_FP8) { int r8 = __builtin_amdgcn_cvt_pk_fp8_f32(x[j].x, x[j].y, 0, false); r8 = __builtin_amdgcn_cvt_pk_fp8_f32(x[j].z, x[j].w, r8, true); *(int*)((uchar*)H + (size_t)tok * D + c) = r8; }
            else { u32x2 o; o.x = pk2(x[j].x, x[j].y); o.y = pk2(x[j].z, x[j].w); *(u32x2*)(H + (size_t)tok * D + c) = o; } }
        if constexpr (ROUTE) {
            LAS float* lgs = (LAS float*)(F.lds + LDSCTL_OFF + 1024) + (F.wave * 4 + grp) * 40;
#pragma unroll 1
            for (int o = 0; o < 36; ++o) { f32x4 v0 = {0.f, 0.f, 0.f, 0.f}, v1 = {0.f, 0.f, 0.f, 0.f};
#pragma unroll
                for (int j = 0; j < 16; j += 2) { const f32x4 w0 = *(const LAS f32x4*)(wr + o * 1024 + 64 * j + 4 * i16), w1 = *(const LAS f32x4*)(wr + o * 1024 + 64 * j + 64 + 4 * i16);
                    v0 += x[j] * w0; v1 += x[j + 1] * w1; }
                v0 += v1; float a0 = wave16_sum((v0.x + v0.y) + (v0.z + v0.w)); if (i16 == 0) lgs[o] = a0; }
            asm volatile("s_waitcnt lgkmcnt(0)" ::: "memory");
            const float gl0 = lgs[0] + bg[0], gl1 = lgs[1] + bg[1], gl2 = lgs[2] + bg[2], gl3 = lgs[3] + bg[3];
            int gs = 0; float gm = gl0;
            if (gl1 > gm) { gm = gl1; gs = 1; }
            if (gl2 > gm) { gm = gl2; gs = 2; }
            if (gl3 > gm) { gm = gl3; gs = 3; }
            const float den = __expf(gl0 - gm) + __expf(gl1 - gm) + __expf(gl2 - gm) + __expf(gl3 - gm);
            const float pg = 1.f / den;
            float el[8];
#pragma unroll
            for (int e = 0; e < 8; ++e) el[e] = lgs[4 + gs * 8 + e] + br[gs * 8 + e];
            int i0 = 0; float v0 = el[0];
#pragma unroll
            for (int e = 1; e < 8; ++e) if (el[e] > v0) { v0 = el[e]; i0 = e; }
            int i1 = -1; float v1 = -3.0e38f;
#pragma unroll
            for (int e = 0; e < 8; ++e) if (e != i0 && el[e] > v1) { v1 = el[e]; i1 = e; }
            const float p0 = 1.f / (1.f + __expf(v1 - v0));
            const float w0 = p0 * pg, w1 = (1.f - p0) * pg;
            const bool do_route = !(skip_ctx_route && sidx == 4) && !dry;
            if (i16 == 0 && do_route) {
                const int e0 = gs * 8 + i0, e1 = gs * 8 + i1;
                unsigned* cnt = (unsigned*)(ws + WS_CTL) + CW_CNT + l * 32 * 64;
                const unsigned q0 = atomicAdd(cnt + e0 * 64, 1u), q1 = atomicAdd(cnt + e1 * 64, 1u);
                int* BK = (int*)(ws + WS_BK); float* TW = (float*)(ws + WS_TW);
                BK[(size_t)e0 * T + q0] = tok * 2; BK[(size_t)e1 * T + q1] = tok * 2 + 1;
                TW[tok * 2] = w0; TW[tok * 2 + 1] = w1;
            }
        }
    }
}

__device__ __forceinline__ void st8(bf16_t* p, f32x4 v0, f32x4 v1) { u32x4 w; w.x = cvt_pk_bf16(v0[0], v0[1]); w.y = cvt_pk_bf16(v0[2], v0[3]); w.z = cvt_pk_bf16(v1[0], v1[1]); w.w = cvt_pk_bf16(v1[2], v1[3]); *(u32x4*)p = w; }
#define EPI_ROWS(ai, m) (u.pm * 256 + (ai) * 128 + wr * 64 + (m) * 16 + fr)

struct EpiRgIn { static constexpr bool PERM = true, FP8 = false; bf16_t* GG; bf16_t* XB;
    __device__ __forceinline__ void operator()(const f32x4 (&acc)[2][2][4][2], const pg8::Unit& u, int wr, int wc, int fr, int fq) const {
        const bool isg = u.pn < 4; bf16_t* base = isg ? GG : XB; const int ct = (u.pn & 3) * 256 + wc * 32 + 8 * fq;
#pragma unroll
        for (int ai = 0; ai < 2; ++ai)
#pragma unroll
            for (int m = 0; m < 4; ++m) { bf16_t* rowp = base + (size_t)EPI_ROWS(ai, m) * D + ct;
#pragma unroll
                for (int bj = 0; bj < 2; ++bj) { f32x4 v0 = acc[ai][bj][m][0], v1 = acc[ai][bj][m][1];
                    if (isg) {
#pragma unroll
                        for (int e = 0; e < 4; ++e) { v0[e] = gelu_tanh(v0[e]); v1[e] = gelu_tanh(v1[e]); } }
                    st8(rowp + bj * 128, v0, v1); } }
    } };
struct EpiBf16 { static constexpr bool PERM = true, FP8 = false; bf16_t* O; int ldc;
    __device__ __forceinline__ void operator()(const f32x4 (&acc)[2][2][4][2], const pg8::Unit& u, int wr, int wc, int fr, int fq) const {
        const int ct = u.pn * 256 + wc * 32 + 8 * fq;
#pragma unroll
        for (int ai = 0; ai < 2; ++ai)
#pragma unroll
            for (int m = 0; m < 4; ++m) { bf16_t* rowp = O + (size_t)EPI_ROWS(ai, m) * ldc + ct;
#pragma unroll
                for (int bj = 0; bj < 2; ++bj) st8(rowp + bj * 128, acc[ai][bj][m][0], acc[ai][bj][m][1]); }
    } };
struct EpiCmIn { static constexpr bool PERM = true, FP8 = false; bf16_t* O; f32x2* statp;
    __device__ __forceinline__ void operator()(const f32x4 (&acc)[2][2][4][2], const pg8::Unit& u, int wr, int wc, int fr, int fq) const {
        const int ct = u.pn * 256 + wc * 32 + 8 * fq; const bool isv = u.pn >= 8;
#pragma unroll
        for (int ai = 0; ai < 2; ++ai)
#pragma unroll
            for (int m = 0; m < 4; ++m) { const int row = EPI_ROWS(ai, m); bf16_t* rowp = O + (size_t)row * 4096 + ct; float s = 0.f, q = 0.f;
#pragma unroll
                for (int bj = 0; bj < 2; ++bj) { f32x4 v0 = acc[ai][bj][m][0], v1 = acc[ai][bj][m][1];
#pragma unroll
                    for (int e = 0; e < 4; ++e) { v0[e] = gelu_tanh(v0[e]); v1[e] = gelu_tanh(v1[e]); }
                    u32x4 w; w.x = cvt_pk_bf16(v0[0], v0[1]); w.y = cvt_pk_bf16(v0[2], v0[3]); w.z = cvt_pk_bf16(v1[0], v1[1]); w.w = cvt_pk_bf16(v1[2], v1[3]);
                    *(u32x4*)(rowp + bj * 128) = w;
                    const float r0 = bflo(w.x), r1 = bfhi(w.x), r2 = bflo(w.y), r3 = bfhi(w.y), r4 = bflo(w.z), r5 = bfhi(w.z), r6 = bflo(w.w), r7 = bfhi(w.w);
                    s += ((r0 + r1) + (r2 + r3)) + ((r4 + r5) + (r6 + r7)); q += ((r0 * r0 + r1 * r1) + (r2 * r2 + r3 * r3)) + ((r4 * r4 + r5 * r5) + (r6 * r6 + r7 * r7)); }
                if (isv) { s += __shfl_xor(s, 16); s += __shfl_xor(s, 32); q += __shfl_xor(q, 16); q += __shfl_xor(q, 32);
                    if (fq == 0) statp[(size_t)row * 32 + (u.pn - 8) * 4 + wc] = (f32x2){s, q}; } }
    } };
struct EpiResid { static constexpr bool PERM = true, FP8 = false; bf16_t* YM; const float* gate  ;
    __device__ __forceinline__ void operator()(const f32x4 (&acc)[2][2][4][2], const pg8::Unit& u, int wr, int wc, int fr, int fq) const {
        const int sidx = sidx_of_row(u.pm * 256); const float* gp = gate + (size_t)sidx * NMODV; const int ct = u.pn * 256 + wc * 32 + 8 * fq;
        f32x4 gv[2][2];
#pragma unroll
        for (int bj = 0; bj < 2; ++bj)
#pragma unroll
            for (int n = 0; n < 2; ++n) gv[bj][n] = *(const f32x4*)(gp + ct + bj * 128 + n * 4);
#pragma unroll
        for (int ai = 0; ai < 2; ++ai)
#pragma unroll
            for (int m = 0; m < 4; ++m) { bf16_t* rowp = YM + (size_t)EPI_ROWS(ai, m) * D + ct;
#pragma unroll
                for (int bj = 0; bj < 2; ++bj) st8(rowp + bj * 128, gv[bj][0] * acc[ai][bj][m][0], gv[bj][1] * acc[ai][bj][m][1]); }
    } };
struct EpiRgGate { static constexpr bool PERM = true, FP8 = false; const bf16_t* XC; bf16_t* LA; bf16_t* BB; const float* ba; const float* bi; const float* lam;
    __device__ __forceinline__ void operator()(const f32x4 (&acc)[2][2][4][2], const pg8::Unit& u, int wr, int wc, int fr, int fq) const {
        const int d = u.pn >> 3, blk = u.pn & 7;
        asm volatile("" : "+v"(fr), "+v"(fq));
#pragma unroll
        for (int n = 0; n < 2; ++n) { const int ch = blk * 128 + wc * 32 + 8 * fq + 4 * n;
            const f32x4 bav = *(const f32x4*)(ba + d * D + ch), biv = *(const f32x4*)(bi + d * D + ch), spv = *(const f32x4*)(lam + d * D + ch);
#pragma unroll
            for (int ai = 0; ai < 2; ++ai)
#pragma unroll
                for (int m = 0; m < 4; ++m) { const size_t off = (size_t)EPI_ROWS(ai, m) * D + ch;
                    const u32x2 xw = *(const u32x2*)(XC + off);
                    const f32x4 xc = {bflo(xw.x), bfhi(xw.x), bflo(xw.y), bfhi(xw.y)};
                    f32x4 la, bb;
#pragma unroll
                    for (int e = 0; e < 4; ++e) { const float r = fast_sigmoid(acc[ai][0][m][n][e] + bav[e]), ig = fast_sigmoid(acc[ai][1][m][n][e] + biv[e]);
                        const float lga = r * spv[e]; la[e] = lga; bb[e] = __builtin_amdgcn_sqrtf(one_minus_exp(-2.f * lga)) * ig * xc[e]; }
                    u32x2 w; w.x = cvt_pk_bf16(la[0], la[1]); w.y = cvt_pk_bf16(la[2], la[3]);
                    *(u32x2*)(LA + (size_t)d * T * D + off) = w;
                    w.x = cvt_pk_bf16(bb[0], bb[1]); w.y = cvt_pk_bf16(bb[2], bb[3]);
                    *(u32x2*)(BB + (size_t)d * T * D + off) = w; __builtin_amdgcn_sched_barrier(0); }
            asm volatile("" ::: "memory"); }
    } };

template <bool G1>
struct MoeOrder {
    static constexpr bool GATHER = G1;
    const LAS int* tab; const char* A; const char* B; const int* BK; int G, c, nunits; size_t bstride; int arow, brow;
    __device__ bool next(int i, pg8::Unit& u) const {
        const long L = (long)i * G + c; if (c >= G || L >= nunits) return false;
        const int wgid = __builtin_amdgcn_readfirstlane(pg8::xcd_remap((int)L, nunits)); const int tau = wgid >> 2, pn = wgid & 3;
        int e = 0;
#pragma unroll 1
        for (int k = 1; k < 32; ++k) e = (tab[k] <= tau) ? k : e;
        e = __builtin_amdgcn_readfirstlane(e);
        u.pm = tau; u.pn = pn; u.aux0 = e; u.aux1 = __builtin_amdgcn_readfirstlane((tau - tab[e]) * 256);
        u.a = pg8::uptr(G1 ? A : A + (size_t)tau * 256 * arow);
        u.b = pg8::uptr(B + (size_t)e * bstride + (size_t)pn * 256 * brow);
        return true; }
    __device__ unsigned goff(const pg8::Unit& u, int row) const {
        const int pos = u.aux1 + row; const int cnt = tab[40 + u.aux0];
        int tok = 0; if (pos < cnt) tok = __builtin_nontemporal_load(BK + (size_t)u.aux0 * T + pos) >> 1;
        return (unsigned)tok * (unsigned)arow; }
};
struct EpiMoe1 { static constexpr bool PERM = true, FP8 = (MOE_FP8 != 0); uchar* H1;
    __device__ __forceinline__ void operator()(const f32x4 (&acc)[2][2][4][2], const pg8::Unit& u, int wr, int wc, int fr, int fq) const {
        const int ct = u.pn * 128 + wc * 32 + 8 * fq;
#pragma unroll
        for (int ai = 0; ai < 2; ++ai)
#pragma unroll
            for (int m = 0; m < 4; ++m) { f32x4 h0, h1;
#pragma unroll
                for (int e = 0; e < 4; ++e) { constexpr float WS_ = FP8 ? (1.f / 32.f) : 1.f;
                    const float g0 = acc[ai][0][m][0][e] * WS_, g1 = acc[ai][0][m][1][e] * WS_; h0[e] = g0 * sigmoidf_(g0) * (acc[ai][1][m][0][e] * WS_); h1[e] = g1 * sigmoidf_(g1) * (acc[ai][1][m][1][e] * WS_); }
                if constexpr (FP8) { int r0 = __builtin_amdgcn_cvt_pk_fp8_f32(h0[0], h0[1], 0, false); r0 = __builtin_amdgcn_cvt_pk_fp8_f32(h0[2], h0[3], r0, true);
                    int r1 = __builtin_amdgcn_cvt_pk_fp8_f32(h1[0], h1[1], 0, false); r1 = __builtin_amdgcn_cvt_pk_fp8_f32(h1[2], h1[3], r1, true);
                    *(u32x2*)(H1 + (size_t)EPI_ROWS(ai, m) * DEXP + ct) = (u32x2){(unsigned)r0, (unsigned)r1}; }
                else st8((bf16_t*)H1 + (size_t)EPI_ROWS(ai, m) * DEXP + ct, h0, h1); }
    } };
struct EpiMoe2 { static constexpr bool PERM = true, FP8 = (MOE_FP8 != 0); bf16_t* YS; const float* gate; const int* BK; const float* TW; const LAS int* tab;
    __device__ __forceinline__ void operator()(const f32x4 (&acc)[2][2][4][2], const pg8::Unit& u, int wr, int wc, int fr, int fq) const {
        const int ct = u.pn * 256 + wc * 32 + 8 * fq; const int cnt = tab[40 + u.aux0];
        typedef int i32x8_t __attribute__((ext_vector_type(8))); typedef float f32x8_t __attribute__((ext_vector_type(8))); i32x8_t ent; f32x8_t w8;
#pragma unroll
        for (int r = 0; r < 8; ++r) { const int pos = u.aux1 + (r >> 2) * 128 + wr * 64 + (r & 3) * 16 + fr; ent[r] = -1; if (pos < cnt) ent[r] = __builtin_nontemporal_load(BK + (size_t)u.aux0 * T + pos); }
#pragma unroll
        for (int r = 0; r < 8; ++r) { w8[r] = 0.f; if (ent[r] >= 0) w8[r] = __builtin_nontemporal_load(TW + ent[r]); }
#pragma unroll
        for (int r = 0; r < 8; ++r) { const int e_ = ent[r];
            if (e_ >= 0) { const int tok = e_ >> 1, slot = e_ & 1; const float w = w8[r] * (FP8 ? (1.f / 32.f) : 1.f);
                const float* gp = gate + (size_t)sidx_of_row(tok) * NMODV + ct; bf16_t* yp = YS + ((size_t)slot * T + tok) * D + ct;
#pragma unroll
                for (int bj = 0; bj < 2; ++bj) { const f32x4 g0 = *(const f32x4*)(gp + bj * 128), g1 = *(const f32x4*)(gp + bj * 128 + 4);
                    st8(yp + bj * 128, g0 * w * acc[r >> 2][bj][r & 3][0], g1 * w * acc[r >> 2][bj][r & 3][1]); } } }
    } };
__device__ __forceinline__ int moe_table(Frame& F, int l, LAS int* tab) {
    __syncthreads();
    if (F.tid < 32) { const unsigned c = __hip_atomic_load((unsigned*)(F.ws + WS_CTL) + CW_CNT + (l * 32 + F.tid) * 64, RLX_AGENT); tab[40 + F.tid] = (int)c; }
    __syncthreads();
    if (F.tid == 0) { int s = 0;
#pragma unroll 1
        for (int e = 0; e < 32; ++e) { tab[e] = s; s += (tab[40 + e] + 255) >> 8; } tab[32] = s; }
    __syncthreads();
    return tab[32];
}

__device__ __forceinline__ void conv_phase(Frame& F, int j) {
    const bf16_t* XB = (const bf16_t*)(F.ws + WS_XB); bf16_t* XC = (bf16_t*)(F.ws + WS_XC);
    const float* cw = inp(F, I_RGCW) + (size_t)j * 4 * D; const float* cb = inp(F, I_RGCB) + (size_t)j * D;
    const int NGT = F.G * 512;
    for (int i0 = F.bid * 512 + F.tid; i0 < T * 128; i0 += 2 * NGT) {
        u32x4 xw[2][4];
#pragma unroll
        for (int q = 0; q < 2; ++q) { const int i = i0 + q * NGT; const int row = i >> 7, c = (i & 127) * 8; const int b = row / SB, s = row - b * SB; const int lo = s < CTX ? 0 : CTX, hi = s < CTX ? CTX : SB;
#pragma unroll
            for (int k = 0; k < 4; ++k) { const int ss = s + k - 2; xw[q][k] = (u32x4){0u, 0u, 0u, 0u}; if (i < T * 128 && ss >= lo && ss < hi) xw[q][k] = *(const u32x4*)(XB + (size_t)(b * SB + ss) * D + c); } }
#pragma unroll
        for (int q = 0; q < 2; ++q) { const int i = i0 + q * NGT; if (i < T * 128) { const int row = i >> 7, c = (i & 127) * 8;
            float a[8];
#pragma unroll
            for (int e = 0; e < 8; ++e) a[e] = cb[c + e];
#pragma unroll
            for (int k = 0; k < 4; ++k) { const f32x4 w0 = *(const f32x4*)(cw + k * D + c), w1 = *(const f32x4*)(cw + k * D + c + 4); const u32x4 x = xw[q][k];
                a[0] += w0.x * bflo(x.x); a[1] += w0.y * bfhi(x.x); a[2] += w0.z * bflo(x.y); a[3] += w0.w * bfhi(x.y);
                a[4] += w1.x * bflo(x.z); a[5] += w1.y * bfhi(x.z); a[6] += w1.z * bflo(x.w); a[7] += w1.w * bfhi(x.w); }
            u32x4 o; o.x = pk2(a[0], a[1]); o.y = pk2(a[2], a[3]); o.z = pk2(a[4], a[5]); o.w = pk2(a[6], a[7]);
            *(u32x4*)(XC + (size_t)row * D + c) = o; } }
    }
}
__device__ __forceinline__ void scan1_phase(Frame& F) {
    const bf16_t* LA = (const bf16_t*)(F.ws + WS_LA); const bf16_t* BB = (const bf16_t*)(F.ws + WS_BB); float* TS = (float*)(F.ws + WS_TOTS); float* TH = (float*)(F.ws + WS_TOTH);
    for (int it = F.bid * 8 + F.wave; it < NB * 2 * NCH * 4; it += F.G * 8) {
        const int cg = it & 3, rest = it >> 2, ck = rest % NCH, bd = rest / NCH, dir = bd & 1, b = bd >> 1;
        const int c = cg * 256 + F.lane * 4; const size_t base = (size_t)dir * T * D + (size_t)(b * SB + ck * 16) * D + c;
        u32x2 la[16], bb[16];
#pragma unroll
        for (int t = 0; t < 16; ++t) { const size_t o = base + (size_t)(dir ? 15 - t : t) * D; la[t] = *(const u32x2*)(LA + o); bb[t] = *(const u32x2*)(BB + o); }
        f32x4 sl = {0.f, 0.f, 0.f, 0.f}, h = {0.f, 0.f, 0.f, 0.f};
#pragma unroll
        for (int t = 0; t < 16; ++t) { const f32x4 l4 = {bflo(la[t].x), bfhi(la[t].x), bflo(la[t].y), bfhi(la[t].y)}, b4 = {bflo(bb[t].x), bfhi(bb[t].x), bflo(bb[t].y), bfhi(bb[t].y)};
            sl += l4; f32x4 a4 = {__expf(l4.x), __expf(l4.y), __expf(l4.z), __expf(l4.w)}; h = a4 * h + b4; }
        const size_t o = (size_t)(bd * NCH + ck) * D + c; *(f32x4*)(TS + o) = sl; *(f32x4*)(TH + o) = h;
    }
}
__device__ __forceinline__ void scan2_phase(Frame& F) {
    const float* TS = (const float*)(F.ws + WS_TOTS); const float* TH = (const float*)(F.ws + WS_TOTH); float* CY = (float*)(F.ws + WS_CARRY);
    for (int it = F.bid * 8 + F.wave; it < NB * 2 * 4; it += F.G * 8) {
        const int cg = it & 3, bd = it >> 2, dir = bd & 1; const int c = cg * 256 + F.lane * 4; const size_t base = (size_t)bd * NCH * D + c;
        f32x4 h = {0.f, 0.f, 0.f, 0.f};
        for (int s0 = 0; s0 < NCH; s0 += 8) { f32x4 sl[8], hl[8]; int ck[8];
#pragma unroll
            for (int q = 0; q < 8; ++q) { const int s = s0 + q; ck[q] = dir ? (s < 16 ? 15 - s : NCH + 15 - s) : s; sl[q] = *(const f32x4*)(TS + base + (size_t)ck[q] * D); hl[q] = *(const f32x4*)(TH + base + (size_t)ck[q] * D); }
#pragma unroll
            for (int q = 0; q < 8; ++q) { *(f32x4*)(CY + base + (size_t)ck[q] * D) = h; const f32x4 a4 = {__expf(sl[q].x), __expf(sl[q].y), __expf(sl[q].z), __expf(sl[q].w)}; h = a4 * h + hl[q]; } }
    }
}
__device__ __forceinline__ void scan3_phase(Frame& F) {
    const bf16_t* LA = (const bf16_t*)(F.ws + WS_LA); const bf16_t* BB = (const bf16_t*)(F.ws + WS_BB); const float* CY = (const float*)(F.ws + WS_CARRY);
    const bf16_t* GG = (const bf16_t*)(F.ws + WS_GG); bf16_t* SA = (bf16_t*)(F.ws + WS_SA);
    LAS f32x4* hb = (LAS f32x4*)(F.lds + F.wave * 16384);
    for (int it = F.bid * 8 + F.wave; it < NB * NCH * 4; it += F.G * 8) {
        const int cg = it & 3, rest = it >> 2, ck = rest % NCH, b = rest / NCH;
        const int c = cg * 256 + F.lane * 4;
        const size_t rbase = (size_t)(b * SB + ck * 16) * D + c, b1 = (size_t)T * D + rbase;
        f32x4 hbk = *(const f32x4*)(CY + (size_t)((b * 2 + 1) * NCH + ck) * D + c), hf = *(const f32x4*)(CY + (size_t)((b * 2 + 0) * NCH + ck) * D + c);
        { u32x2 la[16], bb[16];
#pragma unroll
          for (int t = 0; t < 16; ++t) { la[t] = *(const u32x2*)(LA + b1 + (size_t)(15 - t) * D); bb[t] = *(const u32x2*)(BB + b1 + (size_t)(15 - t) * D); }
#pragma unroll
          for (int t = 0; t < 16; ++t) { const f32x4 l4 = {bflo(la[t].x), bfhi(la[t].x), bflo(la[t].y), bfhi(la[t].y)}, b4 = {bflo(bb[t].x), bfhi(bb[t].x), bflo(bb[t].y), bfhi(bb[t].y)};
              const f32x4 a4 = {__expf(l4.x), __expf(l4.y), __expf(l4.z), __expf(l4.w)}; hbk = a4 * hbk + b4; hb[(15 - t) * 64 + F.lane] = hbk; } }
        { u32x2 la[16], bb[16], gg[16];
#pragma unroll
          for (int t = 0; t < 16; ++t) { la[t] = *(const u32x2*)(LA + rbase + (size_t)t * D); bb[t] = *(const u32x2*)(BB + rbase + (size_t)t * D); gg[t] = *(const u32x2*)(GG + rbase + (size_t)t * D); }
#pragma unroll
          for (int t = 0; t < 16; ++t) { const f32x4 l4 = {bflo(la[t].x), bfhi(la[t].x), bflo(la[t].y), bfhi(la[t].y)}, b4 = {bflo(bb[t].x), bfhi(bb[t].x), bflo(bb[t].y), bfhi(bb[t].y)};
              const f32x4 g4 = {bflo(gg[t].x), bfhi(gg[t].x), bflo(gg[t].y), bfhi(gg[t].y)};
              const f32x4 a4 = {__expf(l4.x), __expf(l4.y), __expf(l4.z), __expf(l4.w)}; hf = a4 * hf + b4; const f32x4 y = g4 * (hf + hb[t * 64 + F.lane]);
              u32x2 o; o.x = pk2(y.x, y.y); o.y = pk2(y.z, y.w); *(u32x2*)(SA + rbase + (size_t)t * D) = o; } }
    }
}

__device__ __forceinline__ void qknorm_phase(Frame& F) {
    bf16_t* QKV = (bf16_t*)(F.ws + WS_QKV); const f32x2* ROPE = (const f32x2*)(F.ws + WS_ROPE);
    const int i16 = F.lane & 15, grp = F.lane >> 4; const float* pqg = inp(F, I_ATQG); const float* pkg = inp(F, I_ATKG);
    const int ITS = F.G * 32;
    for (int it0 = (F.bid * 8 + F.wave) * 4 + grp; it0 < T * 10; it0 += 4 * ITS) {
        u32x4 xw4[4];
#pragma unroll
        for (int q = 0; q < 4; ++q) { const int it = it0 + q * ITS; xw4[q] = (u32x4){0u, 0u, 0u, 0u}; if (it < T * 10) { const int row = it / 10, hh = it - row * 10; xw4[q] = *(const u32x4*)(QKV + (size_t)row * 1536 + hh * 128 + i16 * 8); } }
#pragma unroll
        for (int q = 0; q < 4; ++q) { const int it = it0 + q * ITS; const bool valid = it < T * 10; const int itc = valid ? it : 0;
            const int row = itc / 10, hh = itc - row * 10; const int b = row / SB, s = row - b * SB;
            bf16_t* p = QKV + (size_t)row * 1536 + hh * 128 + i16 * 8;
            const u32x4 xw = xw4[q];
            float x[8] = {bflo(xw.x), bfhi(xw.x), bflo(xw.y), bfhi(xw.y), bflo(xw.z), bfhi(xw.z), bflo(xw.w), bfhi(xw.w)};
            float ss = 0.f;
#pragma unroll
            for (int e = 0; e < 8; ++e) ss += x[e] * x[e];
            ss = wave16_sum(ss);
            const float rstd = rsqrtf(ss * (1.f / 128.f) + NORM_EPS);
            const float* g = (hh < 8 ? pqg : pkg) + i16 * 8;
#pragma unroll
            for (int e = 0; e < 8; ++e) x[e] = x[e] * rstd * g[e];
            float y[8];
#pragma unroll
            for (int e = 0; e < 8; ++e) y[e] = __shfl_xor(x[e], 4);
            if (s >= CTX) { const int t = s - CTX; const int pos = (i16 >> 3) ? (t & 63) : (t >> 6); const bool half1 = (i16 >> 2) & 1;
#pragma unroll
                for (int e = 0; e < 8; ++e) { const f32x2 cs = ROPE[pos * 32 + (i16 & 3) * 8 + e];
                    x[e] = half1 ? (x[e] * cs.x + y[e] * cs.y) : (x[e] * cs.x - y[e] * cs.y); } }
            u32x4 o; o.x = pk2(x[0], x[1]); o.y = pk2(x[2], x[3]); o.z = pk2(x[4], x[5]); o.w = pk2(x[6], x[7]);
            if (valid) *(u32x4*)p = o;
        }
    }
}
__device__ __forceinline__ void attn_phase(Frame& F) {
    const bf16_t* QKV = (const bf16_t*)(F.ws + WS_QKV); bf16_t* AO = (bf16_t*)(F.ws + WS_AO);
    for (int u = F.bid; u < 544; u += F.G) {
        int b, h, q0, k0, seq;
        if (u < 512) { const int qb = u & 15, hg = (u >> 4) & 3, kvh = (u >> 6) & 1; b = u >> 7; h = kvh * 4 + hg; q0 = b * SB + CTX + qb * 256; k0 = b * SB; seq = SB; }
        else { const int v = u - 512; b = v >> 3; h = v & 7; q0 = b * SB; k0 = b * SB; seq = CTX; }
        const int kvh = h >> 2;
        const bf16_t* Kp = (const bf16_t*)pg8::uptr((const char*)(QKV + (size_t)k0 * 1536 + 1024 + kvh * 128));
        att::attn_dense_body((const bf16_t*)pg8::uptr((const char*)(QKV + (size_t)q0 * 1536 + h * 128)), Kp, Kp + 256, (bf16_t*)pg8::uptr((const char*)(AO + (size_t)q0 * D + h * 128)), seq, F.ldsg, F.tid);
        __syncthreads();
    }
}

__device__ __forceinline__ void spatial_phase(Frame& F) {
    const bf16_t* UVB = (const bf16_t*)(F.ws + WS_UVB); bf16_t* UV = (bf16_t*)(F.ws + WS_UV); const f32x2* statp = (const f32x2*)(F.ws + WS_STATP);
    const bf16_t* Ws = (const bf16_t*)(F.ws + WS_W_CMS); const float* lng = inp(F, I_CMLNG); const float* lnb = inp(F, I_CMLNB); const float* bs = inp(F, I_CMBS);
    LAS uchar* vl = F.lds;
    LAS f32x2* st = (LAS f32x2*)(F.lds + 65536);
    const int tid = F.tid, lane = F.lane, wid = F.wave, r32 = lane & 31, hi = lane >> 5, wm = wid & 3, wn = wid >> 2;
    const int sr = tid >> 4, sc = (tid & 15) * 8;
    for (int u = F.bid; u < 136 * 8; u += F.G) {
        const int chunk = u >> 3, g = u & 7; const int row0 = chunk * 128;
        __syncthreads();
        if (tid < 128) { const f32x2* sp = statp + (size_t)(row0 + tid) * 32; float s = 0.f, q = 0.f;
#pragma unroll 8
            for (int k = 0; k < 32; ++k) { const f32x2 v = sp[k]; s += v.x; q += v.y; }
            const float mean = s * (1.f / 2048.f); const float var = fmaxf(q * (1.f / 2048.f) - mean * mean, 0.f); st[tid] = (f32x2){mean, rsqrtf(var + NORM_EPS)}; }
        __syncthreads();
#pragma unroll
        for (int ch = 0; ch < 2; ++ch) { const int cg = g * 256 + ch * 128 + sc;
            const f32x4 g0 = *(const f32x4*)(lng + cg), g1 = *(const f32x4*)(lng + cg + 4), b0 = *(const f32x4*)(lnb + cg), b1 = *(const f32x4*)(lnb + cg + 4);
#pragma unroll
            for (int i = 0; i < 4; ++i) { const int q = sr + 32 * i; const u32x4 xw = *(const u32x4*)(UVB + (size_t)(row0 + q) * 4096 + 2048 + cg); const f32x2 ms = st[q];
                f32x4 v0 = {bflo(xw.x), bfhi(xw.x), bflo(xw.y), bfhi(xw.y)}, v1 = {bflo(xw.z), bfhi(xw.z), bflo(xw.w), bfhi(xw.w)};
                v0 = (v0 - ms.x) * ms.y * g0 + b0; v1 = (v1 - ms.x) * ms.y * g1 + b1;
                u32x4 o; o.x = pk2(v0.x, v0.y); o.y = pk2(v0.z, v0.w); o.z = pk2(v1.x, v1.y); o.w = pk2(v1.z, v1.w);
                *(LAS u32x4*)(vl + ((q >> 6) * 2 + ch) * 16384 + att::v_st(q & 63, sc)) = o; } }
        bf16x8 pa[2][4];
#pragma unroll
        for (int kt = 0; kt < 2; ++kt)
#pragma unroll
            for (int ks = 0; ks < 4; ++ks) pa[kt][ks] = *(const bf16x8*)(Ws + ((size_t)g * 128 + 32 * wm + r32) * 128 + 64 * kt + 16 * ks + 8 * hi);
        __syncthreads();
        f32x16 o[4] = {};
        const int vb = (int)(uintptr_t)(F.ldsg) + att::v_rd_base(lane) + wn * 16384;
        att::pv_d0(o, vb, pa[0][0], pa[0][1], pa[0][2], pa[0][3]);
        att::pv_d0(o, vb + 32768, pa[1][0], pa[1][1], pa[1][2], pa[1][3]);
        u32x4 uu[8];
#pragma unroll
        for (int i = 0; i < 8; ++i) { const int id = tid + 512 * i, row = id >> 5, ch = id & 31; uu[i] = *(const u32x4*)(UVB + (size_t)(row0 + row) * 4096 + g * 256 + ch * 8); }
        __syncthreads();
#pragma unroll
        for (int r = 0; r < 16; ++r) { const int p = 32 * wm + att::crow(r, hi); const float bsv = bs[g * 128 + p];
#pragma unroll
            for (int d0 = 0; d0 < 4; ++d0) *(LAS bf16_t*)(vl + p * 512 + (128 * wn + 32 * d0 + r32) * 2) = (bf16_t)f2bf(o[d0][r] + bsv); }
        __syncthreads();
#pragma unroll
        for (int i = 0; i < 8; ++i) { const int id = tid + 512 * i, row = id >> 5, ch = id & 31; const u32x4 v = *(const LAS u32x4*)(vl + row * 512 + ch * 16); const u32x4 w = uu[i];
            u32x4 o4; o4.x = pk2(bflo(v.x) * bflo(w.x), bfhi(v.x) * bfhi(w.x)); o4.y = pk2(bflo(v.y) * bflo(w.y), bfhi(v.y) * bfhi(w.y)); o4.z = pk2(bflo(v.z) * bflo(w.z), bfhi(v.z) * bfhi(w.z)); o4.w = pk2(bflo(v.w) * bflo(w.w), bfhi(v.w) * bfhi(w.w));
            *(u32x4*)(UV + (size_t)(row0 + row) * 2048 + g * 256 + ch * 8) = o4; }
    }
    __syncthreads();
}

__device__ __forceinline__ void final_phase(Frame& F) {
    const f32x4* X = (const f32x4*)(F.ws + WS_X); const u32x2* YS = (const u32x2*)(F.ws + WS_Y1); const u32x2* YM = (const u32x2*)(F.ws + WS_YM); f32x4* out = (f32x4*)F.out;
    const int NGT = F.G * 512;
    for (int i0 = F.bid * 512 + F.tid; i0 < NB * SEQ * 256; i0 += 4 * NGT) { f32x4 a[4]; u32x2 y0[4], y1[4], ym[4];
#pragma unroll
        for (int q = 0; q < 4; ++q) { const int i = i0 + q * NGT; if (i < NB * SEQ * 256) { const int r = i >> 8, c4 = i & 255, b = r >> 12, t = r & 4095; const size_t src = ((size_t)(b * SB + CTX + t) << 8) + c4; a[q] = X[src]; y0[q] = YS[src]; y1[q] = YS[src + (size_t)T * 256]; ym[q] = YM[src]; } }
#pragma unroll
        for (int q = 0; q < 4; ++q) { const int i = i0 + q * NGT; if (i < NB * SEQ * 256) out[i] = a[q] + (f32x4){bflo(y0[q].x) + bflo(y1[q].x) + bflo(ym[q].x), bfhi(y0[q].x) + bfhi(y1[q].x) + bfhi(ym[q].x), bflo(y0[q].y) + bflo(y1[q].y) + bflo(ym[q].y), bfhi(y0[q].y) + bfhi(y1[q].y) + bfhi(ym[q].y)}; } }
}

constexpr int NPHASE = 39;
__global__ void __launch_bounds__(512, 2) mk_fwd(Args args) {
    extern __shared__ __attribute__((aligned(16))) uchar lds[];
    Frame F; F.lds = (LAS uchar*)lds; F.ldsg = (char*)lds; F.tid = threadIdx.x; F.lane = F.tid & 63; F.wave = __builtin_amdgcn_readfirstlane(F.tid >> 6); F.G = gridDim.x; F.bid = blockIdx.x;
    F.ws = args.ws; F.out = args.out;
    uchar* ws0 = args.ws;
    volatile LAS unsigned* MISC = (volatile LAS unsigned*)(F.lds + LDSCTL_OFF);
    LAS int* tab = (LAS int*)(F.lds + LDSCTL_OFF + 256);
    for (int u = F.tid; u < (LDS_BYTES - LDSCTL_OFF) / 4; u += 512) ((LAS unsigned*)(F.lds + LDSCTL_OFF))[u] = 0u;
    __syncthreads();
    if (F.tid == 0) {
#pragma unroll
        for (int i = 0; i < 34; ++i) *(LAS unsigned long long*)(F.lds + LDSCTL_OFF + 576 + i * 8) = (unsigned long long)args.in[i]; }
    __syncthreads();
    const int lo = args.ph_lo, hi = args.ph_hi;
    if (hi - lo > 1) (void)xcd_barrier_post((unsigned*)(ws0 + WS_CTL) + CW_BAR, MISC + 8);
    int ph = 0;
#define PH_BEGIN if (ph >= opaque_uniform_int(args.ph_lo) && ph < opaque_uniform_int(args.ph_hi)) { int t_ = threadIdx.x; F.G = opaque_uniform_int(gridDim.x); F.bid = opaque_uniform_int(blockIdx.x); const int cid = F.bid; (void)cid; \
        F.out = (float*)opaque_uniform_ptr(args.out); F.lds = (LAS uchar*)lds; F.ldsg = (char*)lds; \
        asm volatile("" : "+v"(t_)); F.tid = t_; F.lane = t_ & 63; F.wave = __builtin_amdgcn_readfirstlane(t_ >> 6); \
        uchar* ws = (uchar*)opaque_uniform_ptr(args.ws); F.ws = ws; \
        const float* MODl = (const float*)(ws + WS_MOD) + (size_t)l_ * 5 * NMODV; (void)MODl;
#define GRIDBAR  { XcdBarrier bb_; bb_.bar = (unsigned*)(ws + WS_CTL) + CW_BAR; bb_.x = 0; bb_.st = (volatile LAS unsigned*)(F.lds + LDSCTL_OFF) + 8; xcd_barrier(bb_); }
#define REPBAR   if (rep_ > 1) GRIDBAR
#define PH_END   if (ph + 1 < opaque_uniform_int(args.ph_hi)) GRIDBAR } ++ph;

    { const int l_ = 0; PH_BEGIN PM(0) { const bool dry = rep_ > 1; (void)dry;  p0_prologue(F);  REPBAR } PH_END }

#pragma unroll 1
    for (int l = 0; l < DEPTH; ++l) {
        const int kind = l % 3, j = l / 3; const bool lastl = (l == DEPTH - 1); const int l_ = l;
        PH_BEGIN PM(1) { const bool dry = rep_ > 1; (void)dry;  if ((l > 0) && (rep_ == REPN(1))) norm_phase<false, 3>(F, l, inp(F, I_NMG) + l * D, 0, false, false); else norm_phase<false, 0>(F, l, inp(F, I_NMG) + l * D, 0, false, false);  REPBAR } PH_END
        if (kind == 0) {
            PH_BEGIN PM(2) { const bool dry = rep_ > 1; (void)dry;  { pg8::DenseOrder S; S.init(ws + WS_H, D, ws + WS_W_RGIN + (size_t)j * 2048 * 1024 * 2, D, T, 2048, F.G, cid);
                EpiRgIn E{(bf16_t*)(ws + WS_GG), (bf16_t*)(ws + WS_XB)}; pg8::gemm_phase(F.lds, S, E, D, D, D); }  REPBAR } PH_END
            PH_BEGIN PM(3) { const bool dry = rep_ > 1; (void)dry;  conv_phase(F, j);  REPBAR } PH_END
            PH_BEGIN PM(4) { const bool dry = rep_ > 1; (void)dry;  { pg8::DenseOrder S; S.init(ws + WS_XC, D, ws + WS_W_RGG + (size_t)j * 16 * 256 * 128 * 2, 128, T, 16 * 256, F.G, cid, 7, 256);
                EpiRgGate E{(const bf16_t*)(ws + WS_XC), (bf16_t*)(ws + WS_LA), (bf16_t*)(ws + WS_BB), inp(F, I_RGBA) + (size_t)j * 2 * D, inp(F, I_RGBI) + (size_t)j * 2 * D, (const float*)(ws + WS_SPL) + (size_t)j * 2 * D};
                pg8::gemm_phase(F.lds, S, E, 128, D, 128); }  REPBAR } PH_END
            PH_BEGIN PM(5) { const bool dry = rep_ > 1; (void)dry;  scan1_phase(F);  REPBAR } PH_END
            PH_BEGIN PM(20) { const bool dry = rep_ > 1; (void)dry;  scan2_phase(F);  REPBAR } PH_END
            PH_BEGIN PM(6) { const bool dry = rep_ > 1; (void)dry;  scan3_phase(F);  REPBAR } PH_END
            PH_BEGIN PM(7) { const bool dry = rep_ > 1; (void)dry;  { pg8::DenseOrder S; S.init(ws + WS_SA, D, ws + WS_W_RGOUT + (size_t)j * 1024 * 1024 * 2, D, T, D, F.G, cid);
                EpiResid E{(bf16_t*)(ws + (dry ? WS_Y1 : WS_YM)), MODl + 2 * D}; pg8::gemm_phase(F.lds, S, E, D, D, D); }  REPBAR } PH_END
        } else if (kind == 1) {
            PH_BEGIN PM(8) { const bool dry = rep_ > 1; (void)dry;  { pg8::DenseOrder S; S.init(ws + WS_H, D, ws + WS_W_QKV, D, T, 1536, F.G, cid);
                EpiBf16 E{(bf16_t*)(ws + WS_QKV), 1536}; pg8::gemm_phase(F.lds, S, E, D, D, D); }  REPBAR } PH_END
            PH_BEGIN PM(9) { const bool dry = rep_ > 1; (void)dry;  qknorm_phase(F);  REPBAR } PH_END
            PH_BEGIN PM(10) { const bool dry = rep_ > 1; (void)dry;  attn_phase(F);  REPBAR } PH_END
            PH_BEGIN PM(11) { const bool dry = rep_ > 1; (void)dry;  { pg8::DenseOrder S; S.init(ws + WS_AO, D, ws + WS_W_AO, D, T, D, F.G, cid);
                EpiResid E{(bf16_t*)(ws + (dry ? WS_Y1 : WS_YM)), MODl + 2 * D}; pg8::gemm_phase(F.lds, S, E, D, D, D); }  REPBAR } PH_END
        } else {
            PH_BEGIN PM(12) { const bool dry = rep_ > 1; (void)dry;  { pg8::DenseOrder S; S.init(ws + WS_H, D, ws + WS_W_CMIN, D, T, 4096, F.G, cid);
                EpiCmIn E{(bf16_t*)(ws + WS_UVB), (f32x2*)(ws + WS_STATP)}; pg8::gemm_phase(F.lds, S, E, D, D, D); }  REPBAR } PH_END
            PH_BEGIN PM(13) { const bool dry = rep_ > 1; (void)dry;  spatial_phase(F);  REPBAR } PH_END
            PH_BEGIN PM(14) { const bool dry = rep_ > 1; (void)dry;  { pg8::DenseOrder S; S.init(ws + WS_UV, 2048, ws + WS_W_CMOUT, 2048, T, D, F.G, cid);
                EpiResid E{(bf16_t*)(ws + (dry ? WS_Y1 : WS_YM)), MODl + 2 * D}; pg8::gemm_phase(F.lds, S, E, 2048, 2048, 2048); }  REPBAR } PH_END
        }
        PH_BEGIN PM(15) { const bool dry = rep_ > 1; (void)dry;  norm_phase<true, 1>(F, l, inp(F, I_NFG) + l * D, 3, lastl, dry);  REPBAR } PH_END
        PH_BEGIN PM(16) { const bool dry = rep_ > 1; (void)dry;  { const int ntile = moe_table(F, l, tab);
            const int units = ntile * 4, rounds = (units + F.G - 1) / F.G; int geff = F.G; if (false && rounds > 0) { geff = (((units + rounds - 1) / rounds) + 7) & ~7; if (geff > F.G) geff = F.G; }
            constexpr int EB = MOE_FP8 ? 1 : 2;
            MoeOrder<true> S{tab, (const char*)(ws + WS_H), (const char*)(ws + WS_W_E1 + (size_t)l * 32 * 1024 * 1024 * EB), (const int*)(ws + WS_BK), geff, cid, units, (size_t)1024 * 1024 * EB, 1024 * EB, 1024 * EB};
            EpiMoe1 E{ws + WS_H1}; pg8::gemm_phase(F.lds, S, E, D * EB / 2, D * EB / 2, D * EB / 2); }  REPBAR } PH_END
        PH_BEGIN PM(17) { const bool dry = rep_ > 1; (void)dry;  { const int ntile = moe_table(F, l, tab);
            const int units = ntile * 4, rounds = (units + F.G - 1) / F.G; int geff = F.G; if (false && rounds > 0) { geff = (((units + rounds - 1) / rounds) + 7) & ~7; if (geff > F.G) geff = F.G; }
            constexpr int EB = MOE_FP8 ? 1 : 2;
            MoeOrder<false> S{tab, (const char*)(ws + WS_H1), (const char*)(ws + WS_W_E2 + (size_t)l * 32 * 1024 * 512 * EB), (const int*)(ws + WS_BK), geff, cid, units, (size_t)1024 * 512 * EB, 512 * EB, 512 * EB};
            EpiMoe2 E{(bf16_t*)(ws + (dry ? WS_SCR + 64 * MiB : WS_Y1)), MODl + 5 * D, (const int*)(ws + WS_BK), (const float*)(ws + WS_TW), tab}; pg8::gemm_phase(F.lds, S, E, DEXP * EB / 2, DEXP * EB / 2, DEXP * EB / 2); }  REPBAR } PH_END
    }
    { const int l_ = 0; PH_BEGIN PM(18) { const bool dry = rep_ > 1; (void)dry;  final_phase(F);  REPBAR if constexpr (((REP_MASK) >> 19) & 1u) { for (int k_ = 0; k_ < 20; ++k_) GRIDBAR } } PH_END }
#undef PH_BEGIN
#undef PH_END
}

extern "C" void kernel_launch(void* const* d_in, const int* in_sizes, int n_in, void* d_out, int out_size, void* d_ws, size_t ws_size, hipStream_t stream) {
    static int grid = 0;
    if (grid == 0) {
        if (n_in != 34 || out_size != NB * SEQ * D || ws_size < WS_END) { fprintf(stderr, "kernel_launch: bad shapes n_in %d out %d ws %zu (need %zu)\n", n_in, out_size, ws_size, (size_t)WS_END); grid = -1; return; }
        int dev = 0, cus = 0, per_cu = 0;
        if (hipGetDevice(&dev) != hipSuccess || hipDeviceGetAttribute(&cus, hipDeviceAttributeMultiprocessorCount, dev) != hipSuccess) { grid = -1; return; }
        if (hipFuncSetAttribute((const void*)mk_fwd, hipFuncAttributeMaxDynamicSharedMemorySize, LDS_BYTES) != hipSuccess) { fprintf(stderr, "kernel_launch: hipFuncSetAttribute failed\n"); grid = -1; return; }
        if (hipOccupancyMaxActiveBlocksPerMultiprocessor(&per_cu, (const void*)mk_fwd, 512, LDS_BYTES) != hipSuccess || per_cu < 1) { fprintf(stderr, "kernel_launch: occupancy query says %d\n", per_cu); (void)hipGetLastError(); grid = -1; return; }
        grid = cus;
    }
    if (grid < 0) return;
    (void)hipMemsetAsync((char*)d_ws + WS_CTL, 0, CTL_BYTES, stream);
    Args a{};
    for (int i = 0; i < 34; ++i) a.in[i] = (const float*)d_in[i];
    a.out = (float*)d_out; a.ws = (uchar*)d_ws;
#if MK_PER_PHASE
    for (int p = 0; p < NPHASE; ++p) { a.ph_lo = p; a.ph_hi = p + 1; hipLaunchKernelGGL(mk_fwd, dim3(grid), dim3(512), LDS_BYTES, stream, a); }
#else
    a.ph_lo = 0; a.ph_hi = NPHASE;
    void* kargs[] = {&a};
    hipError_t e = hipLaunchCooperativeKernel((const void*)mk_fwd, dim3(grid), dim3(512), kargs, LDS_BYTES, stream);
    if (e != hipSuccess) fprintf(stderr, "kernel_launch: cooperative launch failed: %s (grid %d)\n", hipGetErrorString(e), grid);
#endif
}
```

```cpp
#include <hip/hip_runtime.h>
#include <hip/hip_bf16.h>
#include <cstdio>
#include <cstdint>

#ifndef MOE_FP8
#define MOE_FP8 1
#endif
#ifndef MK_PER_PHASE
#define MK_PER_PHASE 0
#endif

#ifndef PHASE_MASK
#define PHASE_MASK 0xFFFFFFFFu
#endif
#ifndef REP_MASK
#define REP_MASK 0u
#endif
#define REPN(i) ((((REP_MASK) >> (i)) & 1u) ? 2 : 1)
#define PM(i) if constexpr ((PHASE_MASK >> (i)) & 1u) for (int rep_ = REPN(i); rep_ > 0; --rep_)
#define LAS __attribute__((address_space(3)))
#define GAS __attribute__((address_space(1)))
typedef unsigned char uchar;
typedef unsigned short bf16_t;
typedef short bf16x8 __attribute__((ext_vector_type(8)));
typedef short s16x4 __attribute__((ext_vector_type(4)));
typedef float f32x4 __attribute__((ext_vector_type(4)));
typedef float f32x2 __attribute__((ext_vector_type(2)));
typedef float f32x16 __attribute__((ext_vector_type(16)));
typedef unsigned u32x4 __attribute__((ext_vector_type(4)));
typedef unsigned u32x2 __attribute__((ext_vector_type(2)));
typedef GAS unsigned gu32;
#define RLX_AGENT __ATOMIC_RELAXED, __HIP_MEMORY_SCOPE_AGENT

constexpr int D = 1024, NB = 4, SEQ = 4096, CTX = 256, SB = SEQ + CTX, T = NB * SB, DEPTH = 4;
constexpr int NMODV = 6 * D;
constexpr int NEXP = 32, DEXP = 512;
constexpr int NCH = SB / 16;
constexpr float NORM_EPS = 1e-6f;

constexpr size_t MiB = 1u << 20;
constexpr size_t WS_CTL = 0, CTL_BYTES = 1 * MiB;
constexpr size_t WS_MOD = 1 * MiB;
constexpr size_t WS_ROPE = 2 * MiB;
constexpr size_t WS_SPL = 2 * MiB + 65536;
constexpr size_t WS_TOT = 3 * MiB;
constexpr size_t WS_STATP = 8 * MiB;
constexpr size_t WS_BK = 13 * MiB;
constexpr size_t WS_TW = 15 * MiB + 512 * 1024;
constexpr size_t WS_W_RGIN = 16 * MiB, WS_W_RGG = 24 * MiB, WS_W_RGOUT = 26 * MiB, WS_W_QKV = 30 * MiB, WS_W_AO = 33 * MiB;
constexpr size_t WS_W_CMIN = 35 * MiB, WS_W_CMS = 43 * MiB, WS_W_CMOUT = 44 * MiB, WS_W_E1 = 48 * MiB, WS_W_E2 = 304 * MiB;
constexpr size_t WS_X = 432 * MiB, WS_Y1 = 500 * MiB, WS_H = 568 * MiB, WS_SCR = 602 * MiB;
constexpr size_t WS_GG = WS_SCR, WS_XB = WS_SCR + 34 * MiB, WS_XC = WS_SCR + 68 * MiB, WS_LA = WS_SCR + 102 * MiB, WS_BB = WS_SCR + 170 * MiB, WS_SA = WS_SCR + 238 * MiB;
constexpr size_t WS_QKV = WS_SCR, WS_AO = WS_SCR + 51 * MiB;
constexpr size_t WS_UVB = WS_SCR, WS_UV = WS_SCR + 136 * MiB;
constexpr size_t WS_H1 = WS_SCR;
constexpr size_t WS_TOTS = WS_SCR + 272 * MiB, WS_TOTH = WS_TOTS + 9 * MiB, WS_CARRY = WS_TOTH + 9 * MiB;
constexpr size_t WS_YM = WS_CARRY + 9 * MiB;
constexpr size_t WS_END = WS_YM + 34 * MiB;
constexpr int CW_TMO = 0, CW_BAR = 4096, CW_CNT = 16384;

constexpr int RING_BYTES = 131072;
constexpr int ROUTER_LDS = 36 * 1024 * 4;
constexpr int LDSCTL_OFF = 147456;
constexpr int LDS_BYTES = LDSCTL_OFF + 1024 + 8 * 4 * 40 * 4;

__device__ __forceinline__ unsigned f2bf(float f) { unsigned u = __builtin_bit_cast(unsigned, f); return (u + 0x7fffu + ((u >> 16) & 1u)) >> 16; }
__device__ __forceinline__ unsigned pk2(float lo, float hi) { return f2bf(lo) | (f2bf(hi) << 16); }
__device__ __forceinline__ float bf2f(unsigned short h) { return __builtin_bit_cast(float, (unsigned)h << 16); }
__device__ __forceinline__ float bflo(unsigned w) { return __builtin_bit_cast(float, w << 16); }
__device__ __forceinline__ float bfhi(unsigned w) { return __builtin_bit_cast(float, w & 0xffff0000u); }
__device__ __forceinline__ unsigned cvt_pk_bf16(float lo, float hi) { unsigned r; asm volatile("v_cvt_pk_bf16_f32 %0, %1, %2" : "=v"(r) : "v"(lo), "v"(hi)); return r; }
__device__ __forceinline__ float gelu_tanh(float x) { const float u = 0.7978845608028654f * (x + 0.044715f * x * x * x); const float e = __expf(2.f * u); const float t = 1.f - 2.f / (e + 1.f); return 0.5f * x * (1.f + t); }
__device__ __forceinline__ float sigmoidf_(float x) { return 1.f / (1.f + __expf(-x)); }
__device__ __forceinline__ float fast_sigmoid(float x) { return __builtin_amdgcn_rcpf(1.f + __expf(-x)); }
__device__ __forceinline__ float one_minus_exp(float y) {   const float p = y * (1.f - y * (0.5f - y * (0.16666667f - y * 0.041666667f))); const float q = 1.f - __expf(-y); return y < 0.0625f ? p : q; }
__device__ __forceinline__ int sidx_of_row(int row) { const int b = row / SB; return (row - b * SB) < CTX ? 4 : b; }

namespace pg8 {
constexpr int BM = 256, BK = 64, HALF = 128, HTB = HALF * BK * 2, NXCD = 8, WGM = 8;
__device__ __forceinline__ int lds_byte(int r, int c) { const int st = (r >> 4) * 2 + (c >> 5), rr = r & 15, cc = c & 31, ob = rr * 64 + cc * 2; return st * 1024 + (ob ^ (((ob >> 9) & 1) << 5)); }
__device__ __forceinline__ void stage_rc(int b, int& R, int& C) { const int st = b / 1024, sb = b % 1024, swz = sb ^ (((sb >> 9) & 1) << 5); R = (st >> 1) * 16 + swz / 64; C = (st & 1) * 32 + (swz % 64) / 2; }
__device__ __forceinline__ int perm32(int rho) { const int n = rho >> 4, i = rho & 15; return 8 * (i >> 2) + 4 * n + (i & 3); }
struct Unit { const char* a; const char* b; int pm, pn, aux0, aux1; };
__device__ __forceinline__ const char* uptr(const char* p) { const unsigned long long v = (unsigned long long)p; const unsigned lo = __builtin_amdgcn_readfirstlane((unsigned)v), hi = __builtin_amdgcn_readfirstlane((unsigned)(v >> 32)); return (const char*)(const GAS char*)(((unsigned long long)hi << 32) | lo); }
__device__ __forceinline__ int xcd_remap(int L, int nwg) { const int q = nwg / NXCD, r = nwg % NXCD, xcd = L % NXCD, off = L / NXCD; return (xcd < r ? xcd * (q + 1) : r * (q + 1) + (xcd - r) * q) + off; }

struct DenseOrder {
    static constexpr bool GATHER = false;
    const char* A; const char* B; int nM, nN, nwg, G, c; size_t tA, tB; int amask, acol;
    __device__ void init(const void* A_, int lda, const void* B_, int ldb, int M, int N, int G_, int c_, int amask_ = 0, int acol_ = 0) {
        A = (const char*)A_; B = (const char*)B_; nM = M / BM; nN = N / BM; nwg = nM * nN; G = G_; c = c_; tA = (size_t)BM * lda * 2; tB = (size_t)BM * ldb * 2; amask = amask_; acol = acol_; }
    __device__ bool next(int i, Unit& u) const {
        const long L = (long)i * G + c; if (c >= G || L >= nwg) return false;
        const int wgid = xcd_remap((int)L, nwg);
        const int nig = WGM * nN, gid = wgid / nig, fm = gid * WGM, gsz = (nM - fm) < WGM ? (nM - fm) : WGM;
        u.pm = __builtin_amdgcn_readfirstlane(fm + ((wgid % nig) % gsz)); u.pn = __builtin_amdgcn_readfirstlane((wgid % nig) / gsz); u.aux0 = 0; u.aux1 = 0;
        u.a = uptr(A + (size_t)u.pm * tA + (size_t)(u.pn & amask) * acol); u.b = uptr(B + (size_t)u.pn * tB); return true; }
    __device__ unsigned goff(const Unit&, int) const { return 0u; }
};

#define PG8_SA(b, h) (((b) * 2 + (h)) * HTB)
#define PG8_SB(b, h) ((4 + (b) * 2 + (h)) * HTB)
__device__ __forceinline__ void glds16(const char* sbase, unsigned voff, unsigned ldsaddr) { unsigned keep;
    asm volatile("s_mov_b32 %0, m0\n\ts_mov_b32 m0, %3\n\ts_nop 0\n\tglobal_load_lds_dwordx4 %1, %2\n\ts_mov_b32 m0, %0" : "=&s"(keep) : "v"(voff), "s"(sbase), "s"(ldsaddr) : "memory"); }
#ifndef PG8_ASM_DMA
#define PG8_ASM_DMA 1
#endif
#if PG8_ASM_DMA
#define PG8_GLDS(gp, voff, ldsoff) glds16((const char*)(gp), (voff), ldsbase + (unsigned)(ldsoff))
#else
#define PG8_GLDS(gp, voff, ldsoff) __builtin_amdgcn_global_load_lds((const unsigned*)((const char*)(gp) + (voff)), (LAS unsigned*)(lds + (ldsoff)), 16, 0, 0)
#endif
#define PG8_STAGE_B(bufoff, gbase) do { PG8_GLDS(gbase, voffB[0], (bufoff) + ldsw); PG8_GLDS(gbase, voffB[1], (bufoff) + ldsw + 8192); } while (0)
#define PG8_STAGE_A(bufoff, gbase, h, NX) do { if constexpr (Sched::GATHER) { \
        PG8_GLDS(gbase, ((NX) ? vAn[h][0] : vAc[h][0]), (bufoff) + ldsw); PG8_GLDS(gbase, ((NX) ? vAn[h][1] : vAc[h][1]), (bufoff) + ldsw + 8192); \
    } else { PG8_GLDS((const char*)(gbase) + (h) * hstepA, voffA[0], (bufoff) + ldsw); PG8_GLDS((const char*)(gbase) + (h) * hstepA, voffA[1], (bufoff) + ldsw + 8192); } } while (0)
#define PG8_LDA(dst, b, h) do { _Pragma("unroll") for (int m = 0; m < 4; ++m) _Pragma("unroll") for (int k = 0; k < 2; ++k) dst[m][k] = *(const LAS bf16x8*)(lds + PG8_SA(b, h) + aoff + m * 2048 + k * 1024); } while (0)
#define PG8_LDB(dst, b, h) do { _Pragma("unroll") for (int n = 0; n < 2; ++n) _Pragma("unroll") for (int k = 0; k < 2; ++k) dst[n][k] = *(const LAS bf16x8*)(lds + PG8_SB(b, h) + boff + n * 2048 + k * 1024); } while (0)
typedef int i32x8 __attribute__((ext_vector_type(8))); typedef int i32x4v __attribute__((ext_vector_type(4)));
__device__ __forceinline__ i32x8 cat8(bf16x8 lo, bf16x8 hi) { return __builtin_shufflevector(__builtin_bit_cast(i32x4v, lo), __builtin_bit_cast(i32x4v, hi), 0, 1, 2, 3, 4, 5, 6, 7); }
#define PG8_MMA(ai, bj, At, Bt) do { __builtin_amdgcn_s_setprio(1); _Pragma("unroll") for (int m = 0; m < 4; ++m) _Pragma("unroll") for (int n = 0; n < 2; ++n) { \
        if constexpr (Epi::FP8) { asm volatile("v_mfma_scale_f32_16x16x128_f8f6f4 %0, %1, %2, %0, %3, %3 op_sel_hi:[0,0,0]" : "+v"(acc[ai][bj][m][n]) : "v"(cat8(Bt[n][0], Bt[n][1])), "v"(cat8(At[m][0], At[m][1])), "v"(0x7F7F7F7F)); } \
        else { _Pragma("unroll") for (int k = 0; k < 2; ++k) acc[ai][bj][m][n] = __builtin_amdgcn_mfma_f32_16x16x32_bf16(Bt[n][k], At[m][k], acc[ai][bj][m][n], 0, 0, 0); } } __builtin_amdgcn_s_setprio(0); } while (0)
#define PG8_WAIT_V(n) asm volatile("s_waitcnt vmcnt(" #n ")" ::: "memory")
#define PG8_WAIT_L(n) asm volatile("s_waitcnt lgkmcnt(" #n ")" ::: "memory")
#define PG8_BAR __builtin_amdgcn_s_barrier()
#define PG8_SCHED __builtin_amdgcn_sched_barrier(0)

template <class Epi, class Sched>
__device__ __forceinline__ void gemm_phase(LAS uchar* lds, const Sched& S, const Epi& E, const int K, const int lda, const int ldb) {
    int tid = threadIdx.x; asm volatile("" : "+v"(tid));
    const int wid = __builtin_amdgcn_readfirstlane(tid >> 6), lane = tid & 63, wr = wid >> 2, wc = wid & 3; int fr = lane & 15, fq = lane >> 4;
    int nt = K / BK; asm volatile("" : "+s"(nt));
    unsigned voffA[2], voffB[2];
#pragma unroll
    for (int i = 0; i < 2; ++i) { int R, C; stage_rc(tid * 16 + i * 8192, R, C); const int Rb = Epi::PERM ? ((R & ~31) + perm32(R & 31)) : R;
        voffA[i] = (unsigned)(R * lda + C) * 2u; voffB[i] = (unsigned)(Rb * ldb + C) * 2u; }
    const size_t kstep = (size_t)(BK * 2);
    const size_t hstepA = (size_t)HALF * lda * 2, hstepB = (size_t)HALF * ldb * 2;
    const unsigned ldsw = (unsigned)wid * 1024u;
    const unsigned ldsbase = (unsigned)(uintptr_t)lds;
    const int aoff = lds_byte(wr * 64 + fr, fq * 8), boff = lds_byte(wc * 32 + fr, fq * 8);
    Unit cur, nxt; int ui = 0;
    if (!S.next(0, cur)) return;
    unsigned vAc[2][2], vAn[2][2];
#pragma unroll
    for (int h = 0; h < 2; ++h)
#pragma unroll
        for (int i = 0; i < 2; ++i) { vAc[h][i] = 0u; vAn[h][i] = 0u; }
    if constexpr (Sched::GATHER) {
#pragma unroll
        for (int h = 0; h < 2; ++h)
#pragma unroll
            for (int i = 0; i < 2; ++i) { int R, C; stage_rc(tid * 16 + i * 8192, R, C); vAc[h][i] = S.goff(cur, h * HALF + R) + (unsigned)C * 2u; }
    }
    f32x4 acc[2][2][4][2];
#pragma unroll
    for (int a = 0; a < 2; ++a)
#pragma unroll
        for (int b = 0; b < 2; ++b)
#pragma unroll
            for (int m = 0; m < 4; ++m)
#pragma unroll
                for (int n = 0; n < 2; ++n) acc[a][b][m][n] = (f32x4){0.f, 0.f, 0.f, 0.f};
    bf16x8 At[4][2], B0[2][2], B1[2][2];
    const char* cA = cur.a; const char* cB = cur.b;
    PG8_STAGE_B(PG8_SB(0, 0), cB); PG8_STAGE_B(PG8_SB(0, 1), cB + hstepB); PG8_STAGE_A(PG8_SA(0, 0), cA, 0, false); PG8_STAGE_A(PG8_SA(0, 1), cA, 1, false);
    if (wr == 1) PG8_BAR;
    PG8_WAIT_V(2); PG8_BAR;
    PG8_STAGE_B(PG8_SB(1, 0), cB + kstep); PG8_STAGE_A(PG8_SA(1, 0), cA + kstep, 0, false); PG8_STAGE_B(PG8_SB(1, 1), cB + hstepB + kstep);
    PG8_WAIT_V(6); PG8_BAR;
    for (;;) {
        const bool has_next = S.next(ui + 1, nxt);
        if constexpr (Sched::GATHER) { if (has_next) {
#pragma unroll
            for (int h = 0; h < 2; ++h)
#pragma unroll
                for (int i = 0; i < 2; ++i) { int R, C; int t2 = tid; asm volatile("" : "+v"(t2)); stage_rc(t2 * 16 + i * 8192, R, C); vAn[h][i] = S.goff(nxt, h * HALF + R) + (unsigned)C * 2u; }
            *(LAS u32x4*)(lds + 131072 + tid * 16) = (u32x4){vAn[0][0], vAn[0][1], vAn[1][0], vAn[1][1]}; } }
        const char* nA = has_next ? nxt.a : cA; const char* nB = has_next ? nxt.b : cB;
        for (int t = 0; t < nt; t += 2) {
            const bool last = (t == nt - 2);
            const bool nx = last && has_next;
            if constexpr (Sched::GATHER) { if (nx) { const u32x4 pk_ = *(const LAS u32x4*)(lds + 131072 + tid * 16); vAn[0][0] = pk_.x; vAn[0][1] = pk_.y; vAn[1][0] = pk_.z; vAn[1][1] = pk_.w; } }
            const char* a1 = cA + (size_t)(t + 1) * kstep;
            const char* a2 = last ? nA : cA + (size_t)(t + 2) * kstep; const char* b2 = last ? nB : cB + (size_t)(t + 2) * kstep;
            const char* a3 = a2 + kstep; const char* b3 = b2 + kstep;
            PG8_LDB(B0, 0, 0); PG8_LDB(B1, 0, 1); PG8_SCHED; PG8_LDA(At, 0, 0); PG8_STAGE_A(PG8_SA(1, 1), a1, 1, false);
            PG8_WAIT_V(8); PG8_WAIT_L(0); PG8_BAR; PG8_MMA(0, 0, At, B0); PG8_MMA(0, 1, At, B1); PG8_BAR; PG8_SCHED;
            PG8_LDA(At, 0, 1); PG8_STAGE_B(PG8_SB(0, 0), b2); PG8_STAGE_B(PG8_SB(0, 1), b2 + hstepB); PG8_STAGE_A(PG8_SA(0, 0), a2, 0, nx);
            PG8_WAIT_V(8); PG8_WAIT_L(0); PG8_BAR; PG8_MMA(1, 0, At, B0); PG8_MMA(1, 1, At, B1); PG8_BAR; PG8_SCHED;
            PG8_LDB(B0, 1, 0); PG8_LDB(B1, 1, 1); PG8_SCHED; PG8_LDA(At, 1, 0); PG8_STAGE_A(PG8_SA(0, 1), a2, 1, nx);
            PG8_WAIT_V(8); PG8_WAIT_L(0); PG8_BAR; PG8_MMA(0, 0, At, B0); PG8_MMA(0, 1, At, B1); PG8_BAR; PG8_SCHED;
            PG8_LDA(At, 1, 1); PG8_STAGE_B(PG8_SB(1, 0), b3); PG8_STAGE_B(PG8_SB(1, 1), b3 + hstepB); PG8_STAGE_A(PG8_SA(1, 0), a3, 0, nx);
            PG8_WAIT_V(8); PG8_WAIT_L(0); PG8_BAR; PG8_MMA(1, 0, At, B0); PG8_MMA(1, 1, At, B1); PG8_BAR; PG8_SCHED;
        }
        if (wr == 0) PG8_BAR;
        if constexpr (Epi::FP8) asm volatile("s_nop 15\n\ts_nop 15" ::: "memory");
        E(acc, cur, wr, wc, fr, fq);
        if (!has_next) break;
#pragma unroll
        for (int a = 0; a < 2; ++a)
#pragma unroll
            for (int b = 0; b < 2; ++b)
#pragma unroll
                for (int m = 0; m < 4; ++m)
#pragma unroll
                    for (int n = 0; n < 2; ++n) acc[a][b][m][n] = (f32x4){0.f, 0.f, 0.f, 0.f};
        cur = nxt; cA = nA; cB = nB; ++ui;
        if constexpr (Sched::GATHER) {
#pragma unroll
            for (int h = 0; h < 2; ++h)
#pragma unroll
                for (int i = 0; i < 2; ++i) vAc[h][i] = vAn[h][i]; }
        if (wr == 1) PG8_BAR;
    }
    PG8_WAIT_V(0);
    PG8_BAR;
}
}

#ifndef ATT_SDEPTH
#define ATT_SDEPTH 1
#endif
namespace att {
constexpr int NW = 8, QBLK = 32, KVBLK = 64;
constexpr float SCALE = 0.088388347648318440f;
constexpr float THR = 8.f;
constexpr int LDQ = 1536, LDK = 1536, LDO = 1024;
constexpr size_t SHM_V = KVBLK * 128 * 2, SHM_K = KVBLK * 128 * 2, SHM_ATTN = 2 * SHM_V + 2 * SHM_K + NW * 64 * 4;
#define KSWZ(row, colB) ((row) * 256 + ((colB) ^ (((row) & 7) << 4)))
#define SBAR() __builtin_amdgcn_sched_barrier(0)
__device__ __forceinline__ int crow(int r, int hi) { return (r & 3) + 8 * (r >> 2) + 4 * hi; }
__device__ __forceinline__ void partialSM(f32x16& p0, f32x16& p1, float& m_reg, float& mn, float& alpha) {
  constexpr float C = SCALE * 1.4426950408889634f;
  float pmax = p0[0];
#pragma unroll
  for (int r = 1; r < 16; ++r) pmax = fmaxf(pmax, p0[r]);
#pragma unroll
  for (int r = 0; r < 16; ++r) pmax = fmaxf(pmax, p1[r]);
  { auto rr = __builtin_amdgcn_permlane32_swap(__float_as_uint(pmax), __float_as_uint(pmax), false, false);
    pmax = fmaxf(__uint_as_float(rr[0]), __uint_as_float(rr[1])); }
  if (__builtin_expect(__all(pmax - m_reg <= THR / SCALE), 1)) { mn = m_reg; alpha = 1.f; }
  else { mn = fmaxf(m_reg, pmax); alpha = __builtin_amdgcn_exp2f((m_reg - mn) * C); m_reg = mn; }
  float mnC = -mn * C;
#pragma unroll
  for (int r = 0; r < 16; ++r) p0[r] = fmaf(p0[r], C, mnC);
#pragma unroll
  for (int r = 0; r < 16; ++r) p1[r] = fmaf(p1[r], C, mnC);
#pragma unroll
  for (int r = 0; r < 16; ++r) p0[r] = __builtin_amdgcn_exp2f(p0[r]);
}
__device__ __forceinline__ void finishSM(f32x16& p0, f32x16& p1, float alpha, float& l_reg, bf16x8& pa0, bf16x8& pa1, bf16x8& pa2, bf16x8& pa3) {
#pragma unroll
  for (int r = 0; r < 16; ++r) p1[r] = __builtin_amdgcn_exp2f(p1[r]);
  float ps = 0;
#pragma unroll
  for (int r = 0; r < 16; ++r) ps += p0[r];
#pragma unroll
  for (int r = 0; r < 16; ++r) ps += p1[r];
  { auto rr = __builtin_amdgcn_permlane32_swap(__float_as_uint(ps), __float_as_uint(ps), false, false);
    ps = __uint_as_float(rr[0]) + __uint_as_float(rr[1]); }
  l_reg = l_reg * alpha + ps;
#define PK4(P, BASE, OUT) do { unsigned a0 = cvt_pk_bf16(P[BASE + 0], P[BASE + 1]), a1 = cvt_pk_bf16(P[BASE + 2], P[BASE + 3]);   \
    unsigned b0 = cvt_pk_bf16(P[BASE + 4], P[BASE + 5]), b1 = cvt_pk_bf16(P[BASE + 6], P[BASE + 7]);                              \
    auto r0 = __builtin_amdgcn_permlane32_swap(a0, b0, false, false); auto r1 = __builtin_amdgcn_permlane32_swap(a1, b1, false, false); \
    u32x4 w = {r0[0], r1[0], r0[1], r1[1]}; OUT = __builtin_bit_cast(bf16x8, w); } while (0)
  PK4(p0, 0, pa0); PK4(p0, 8, pa1); PK4(p1, 0, pa2); PK4(p1, 8, pa3);
#undef PK4
}
__device__ __forceinline__ void qkt(f32x16& p0, f32x16& p1, const bf16_t* Ks, const bf16x8* qr, int r32, int hi) {
  p0 = f32x16{}; p1 = f32x16{};
#pragma unroll
  for (int d0 = 0; d0 < 8; ++d0) { int cb = (d0 * 16 + hi * 8) * 2;
    bf16x8 b0 = *reinterpret_cast<const bf16x8*>((const char*)Ks + KSWZ(r32, cb));
    bf16x8 b1 = *reinterpret_cast<const bf16x8*>((const char*)Ks + KSWZ(32 + r32, cb));
    p0 = __builtin_amdgcn_mfma_f32_32x32x16_bf16(b0, qr[d0], p0, 0, 0, 0);
    p1 = __builtin_amdgcn_mfma_f32_32x32x16_bf16(b1, qr[d0], p1, 0, 0, 0); }
}
__device__ __forceinline__ int v_st(int k, int c) { const int kk = (k & ~0xC) | ((k & 4) << 1) | ((k & 8) >> 1); return ((kk >> 3) * 4 + (c >> 5)) * 512 + ((kk & 7) * 32 + (c & 31)) * 2; }
__device__ __forceinline__ int v_rd_base(int lane) { return ((lane & 3) << 3) | (((lane >> 2) & 3) << 6) | (((lane >> 4) & 1) << 5) | (((lane >> 5) & 1) << 8); }
constexpr int v_rd_off(int d0, int ks, int half) { return d0 * 512 + ks * 4096 + half * 2048; }
template <int OFF> __device__ __forceinline__ s16x4 tr_read(int vb) {
  s16x4 r; asm volatile("ds_read_b64_tr_b16 %0, %1 offset:%2" : "=&v"(r) : "v"(vb), "i"(OFF) : "memory"); return r;
}
template <int D0> __device__ __forceinline__ void pv_one(f32x16& od, int vb, bf16x8 pa0, bf16x8 pa1, bf16x8 pa2, bf16x8 pa3) {
  const s16x4 l0 = tr_read<v_rd_off(D0, 0, 0)>(vb), h0 = tr_read<v_rd_off(D0, 0, 1)>(vb), l1 = tr_read<v_rd_off(D0, 1, 0)>(vb), h1 = tr_read<v_rd_off(D0, 1, 1)>(vb);
  const s16x4 l2 = tr_read<v_rd_off(D0, 2, 0)>(vb), h2 = tr_read<v_rd_off(D0, 2, 1)>(vb), l3 = tr_read<v_rd_off(D0, 3, 0)>(vb), h3 = tr_read<v_rd_off(D0, 3, 1)>(vb);
  asm volatile("s_waitcnt lgkmcnt(0)" ::: "memory"); SBAR();
#define PK(L, H) (bf16x8){L[0], L[1], L[2], L[3], H[0], H[1], H[2], H[3]}
  od = __builtin_amdgcn_mfma_f32_32x32x16_bf16(pa0, PK(l0, h0), od, 0, 0, 0);
  od = __builtin_amdgcn_mfma_f32_32x32x16_bf16(pa1, PK(l1, h1), od, 0, 0, 0);
  od = __builtin_amdgcn_mfma_f32_32x32x16_bf16(pa2, PK(l2, h2), od, 0, 0, 0);
  od = __builtin_amdgcn_mfma_f32_32x32x16_bf16(pa3, PK(l3, h3), od, 0, 0, 0);
#undef PK
}
__device__ __forceinline__ void pv_d0(f32x16* o, int vb, bf16x8 pa0, bf16x8 pa1, bf16x8 pa2, bf16x8 pa3) {
  pv_one<0>(o[0], vb, pa0, pa1, pa2, pa3); pv_one<1>(o[1], vb, pa0, pa1, pa2, pa3); pv_one<2>(o[2], vb, pa0, pa1, pa2, pa3); pv_one<3>(o[3], vb, pa0, pa1, pa2, pa3);
}
__device__ __forceinline__ void attn_dense_body(const bf16_t* Qb, const bf16_t* Kh, const bf16_t* Vh, bf16_t* Ob, int seq, char* lds, const int tid) {
  const int wid = tid >> 6, lane = tid & 63, r32 = lane & 31, hi = lane >> 5;
  bf16_t* V_lds = (bf16_t*)lds; bf16_t* K_lds = (bf16_t*)(lds + 2 * SHM_V);
  float* ws = (float*)(lds + 2 * SHM_V + 2 * SHM_K) + wid * 64; float* li_l = ws; float* al_l = ws + 32;
  float m_reg = -1e30f, l_reg = 0; f32x16 o[4] = {}; bf16x8 qr[8];
  const bf16_t* Qw = Qb + (long)(wid * QBLK + r32) * LDQ + hi * 8;
#pragma unroll
  for (int d0 = 0; d0 < 8; ++d0) qr[d0] = *reinterpret_cast<const bf16x8*>(Qw + d0 * 16);
  const int sr = tid >> 4, sc = (tid & 15) * 8, vst0 = v_st(sr, sc), vst1 = v_st(32 + sr, sc);
  const int vb0 = (int)(uintptr_t)V_lds + v_rd_base(lane);
  struct { bf16x8 vs0, vs1, ks0, ks1; } sr_[ATT_SDEPTH];
  const unsigned vo0 = (unsigned)(sr * LDK + sc) * 2u, vo1 = (unsigned)((32 + sr) * LDK + sc) * 2u;
  const long vdelta = (const char*)Vh - (const char*)Kh;
#define SLOAD(i, k0) do { const char* kb_ = (const char*)Kh + (size_t)(k0) * (LDK * 2); const char* vb_ = kb_ + vdelta; \
    sr_[i].vs0 = *reinterpret_cast<const bf16x8*>(vb_ + vo0); sr_[i].vs1 = *reinterpret_cast<const bf16x8*>(vb_ + vo1); \
    sr_[i].ks0 = *reinterpret_cast<const bf16x8*>(kb_ + vo0); sr_[i].ks1 = *reinterpret_cast<const bf16x8*>(kb_ + vo1); } while (0)
#define SWRITE(b, i) do { *(bf16x8*)((char*)V_lds + (b) * SHM_V + vst0) = sr_[i].vs0;          \
    *(bf16x8*)((char*)V_lds + (b) * SHM_V + vst1) = sr_[i].vs1; int kc = sc * 2;               \
    *(bf16x8*)((char*)K_lds + (b) * SHM_K + KSWZ(sr, kc)) = sr_[i].ks0;                       \
    *(bf16x8*)((char*)K_lds + (b) * SHM_K + KSWZ(32 + sr, kc)) = sr_[i].ks1; } while (0)
#define SWAIT() do { if constexpr (ATT_SDEPTH == 2) asm volatile("s_waitcnt vmcnt(4)" ::: "memory"); else asm volatile("s_waitcnt vmcnt(0)" ::: "memory"); } while (0)
#define RESC(a) do { if (__any((a) < 1.f)) { if (hi == 0) al_l[r32] = (a); asm volatile("s_waitcnt lgkmcnt(0)" ::: "memory"); \
    _Pragma("unroll") for (int d = 0; d < 4; ++d) _Pragma("unroll") for (int r = 0; r < 16; ++r) o[d][r] *= al_l[crow(r, hi)]; } } while (0)
  f32x16 pA0, pA1, pB0, pB1; float mnA, mnB, alA, alB; bf16x8 pa0, pa1, pa2, pa3; const int NT = seq / KVBLK;
  constexpr int SE = 0, SO = ATT_SDEPTH - 1;
  SLOAD(SE, 0); asm volatile("s_waitcnt vmcnt(0)" ::: "memory"); SWRITE(0, SE); __syncthreads();
  qkt(pA0, pA1, K_lds, qr, r32, hi); partialSM(pA0, pA1, m_reg, mnA, alA);
  SLOAD(SO, KVBLK); if constexpr (ATT_SDEPTH == 2) { if (2 < NT) SLOAD(SE, 2 * KVBLK); }
  SWAIT(); SWRITE(1, SO); __syncthreads();
  for (int j = 1; j + 1 < NT; j += 2) {
    SBAR(); qkt(pB0, pB1, (bf16_t*)((char*)K_lds + SHM_K), qr, r32, hi);
    finishSM(pA0, pA1, alA, l_reg, pa0, pa1, pa2, pa3); SBAR();
    SLOAD(SO, (j + ATT_SDEPTH) * KVBLK); SBAR();
    pv_d0(o, vb0, pa0, pa1, pa2, pa3); partialSM(pB0, pB1, m_reg, mnB, alB);
    __syncthreads(); SWAIT(); SWRITE(0, SE);
    RESC(alB); __syncthreads();
    SBAR(); qkt(pA0, pA1, K_lds, qr, r32, hi);
    finishSM(pB0, pB1, alB, l_reg, pa0, pa1, pa2, pa3); SBAR();
    if (ATT_SDEPTH == 1 || j + 3 < NT) SLOAD(SE, (j + 1 + ATT_SDEPTH) * KVBLK); SBAR();
    pv_d0(o, vb0 + (int)SHM_V, pa0, pa1, pa2, pa3); partialSM(pA0, pA1, m_reg, mnA, alA);
    __syncthreads(); SWAIT(); SWRITE(1, SO);
    RESC(alA); __syncthreads();
  }
  SBAR(); qkt(pB0, pB1, (bf16_t*)((char*)K_lds + SHM_K), qr, r32, hi);
  finishSM(pA0, pA1, alA, l_reg, pa0, pa1, pa2, pa3); SBAR();
  pv_d0(o, vb0, pa0, pa1, pa2, pa3); partialSM(pB0, pB1, m_reg, mnB, alB);
  __syncthreads(); RESC(alB);
  finishSM(pB0, pB1, alB, l_reg, pa0, pa1, pa2, pa3); SBAR();
  pv_d0(o, vb0 + (int)SHM_V, pa0, pa1, pa2, pa3);
  if (hi == 0) li_l[r32] = l_reg; asm volatile("s_waitcnt lgkmcnt(0)" ::: "memory");
  float rli[16];
#pragma unroll
  for (int r = 0; r < 16; ++r) rli[r] = __builtin_amdgcn_rcpf(li_l[crow(r, hi)]);
  bf16_t* Ow = Ob + (long)(wid * QBLK) * LDO;
#pragma unroll
  for (int r = 0; r < 16; ++r) { int orow = crow(r, hi);
#pragma unroll
    for (int d0 = 0; d0 < 4; ++d0) Ow[(long)orow * LDO + d0 * 32 + r32] = (bf16_t)f2bf(o[d0][r] * rli[r]); }
#undef SLOAD
#undef SWRITE
#undef SWAIT
#undef RESC
}
}

#define XB_TMO      128
#define XB_XCNT(j)  (256  + 64 * (j))
#define XB_XSUB(j)  (1280 + 64 * (j))
#define XB_XGEN(j)  (2304 + 64 * (j))
#define XB_TOP      3328
#define XB_TOPGEN   3392
#define XB_SPIN_CAP (1u << 22)
__device__ __forceinline__ unsigned xb_ld(unsigned* p)              { return __hip_atomic_load(p, __ATOMIC_RELAXED, __HIP_MEMORY_SCOPE_AGENT); }
__device__ __forceinline__ unsigned xb_add(unsigned* p, unsigned v) { return __hip_atomic_fetch_add(p, v, __ATOMIC_RELAXED, __HIP_MEMORY_SCOPE_AGENT); }
__device__ __forceinline__ unsigned xb_xcc_id() { return (unsigned)__builtin_amdgcn_s_getreg((3 << 11) | 20) & 0xFu; }
#define XB_SPIN(cond, bar) do { unsigned _sp = 0; while (cond) { __builtin_amdgcn_s_sleep(1); \
    if ((++_sp & 255u) == 0u) { if (xb_ld(&(bar)[XB_TMO])) break; if (_sp > XB_SPIN_CAP) { atomicAdd(&(bar)[XB_TMO], 1u); break; } } } } while (0)
struct XcdBarrier { unsigned* bar; unsigned x; volatile LAS unsigned* st; };
__device__ __forceinline__ XcdBarrier xcd_barrier_post(unsigned* bar, volatile LAS unsigned* st) {
    XcdBarrier b; b.bar = bar; b.x = xb_xcc_id(); b.st = st;
    if (threadIdx.x == 0) (void)xb_add(&bar[XB_XCNT(b.x)], 1u);
    return b;
}
__device__ __forceinline__ void xcd_barrier_complete(unsigned* bar, unsigned x, unsigned& nloc, unsigned& nx) {
    const unsigned G = gridDim.x * gridDim.y * gridDim.z;
    unsigned sum, cnt, mine, sp = 0u;
    for (;;) {
        sum = 0u; cnt = 0u; mine = 0u;
#pragma unroll
        for (unsigned j = 0; j < 16; ++j) { const unsigned c = xb_ld(&bar[XB_XCNT(j)]); sum += c; cnt += (c > 0u) ? 1u : 0u; mine = (j == x) ? c : mine; }
        if (sum == G) break;
        __builtin_amdgcn_s_sleep(1);
        if ((++sp & 255u) == 0u) { if (xb_ld(&bar[XB_TMO])) break; if (sp > XB_SPIN_CAP) { atomicAdd(&bar[XB_TMO], 1u); break; } }
    }
    nloc = mine > 0u ? mine : 1u; nx = cnt > 0u ? cnt : 1u;
}
__device__ __forceinline__ void xcd_barrier(const XcdBarrier& b_) {
    XcdBarrier b; b.bar = b_.bar; b.st = b_.st; b.x = xb_xcc_id();
    asm volatile("s_waitcnt vmcnt(0)" ::: "memory");
    __syncthreads();
    if (threadIdx.x == 0) {
        unsigned* bar = b.bar;
        __builtin_amdgcn_s_waitcnt(0);
        unsigned nloc = b.st[0], nx = b.st[1];
        if (nloc == 0u) { xcd_barrier_complete(bar, b.x, nloc, nx); b.st[0] = nloc; b.st[1] = nx; }
        const unsigned old = xb_add(&bar[XB_XSUB(b.x)], 1u);
        const unsigned gen = old / nloc;
        if (old + 1u == (gen + 1u) * nloc) {
            __builtin_amdgcn_fence(__ATOMIC_RELEASE, "agent");
            asm volatile("s_waitcnt vmcnt(0)" ::: "memory");
            const unsigned og = xb_add(&bar[XB_TOP], 1u);
            const unsigned tg = og / nx;
            if (og + 1u == (tg + 1u) * nx) xb_add(&bar[XB_TOPGEN], 1u);
            else XB_SPIN(xb_ld(&bar[XB_TOPGEN]) == tg, bar);
            __builtin_amdgcn_fence(__ATOMIC_ACQUIRE, "agent");
            xb_add(&bar[XB_XGEN(b.x)], 1u);
            asm volatile("s_waitcnt vmcnt(0)" ::: "memory");
        } else {
            XB_SPIN(xb_ld(&bar[XB_XGEN(b.x)]) == gen, bar);
            __builtin_amdgcn_fence(__ATOMIC_ACQUIRE, "agent");
            asm volatile("s_waitcnt vmcnt(0)" ::: "memory");
        }
    }
    __syncthreads();
}

struct Args { const float* in[34]; float* out; uchar* ws; int ph_lo, ph_hi; };
enum { I_X = 0, I_C, I_CTX, I_CCTX, I_ADAW, I_ADAB, I_NMG, I_NFG, I_RGWIN, I_RGCW, I_RGCB, I_RGWA, I_RGBA, I_RGWI, I_RGBI, I_RGLAM, I_RGWOUT,
       I_ATQKV, I_ATQG, I_ATKG, I_ATWO, I_CMWIN, I_CMLNG, I_CMLNB, I_CMWS, I_CMBS, I_CMWOUT, I_MWG, I_MBG, I_MWR, I_MBR, I_MWGATE, I_MWUP, I_MWDOWN };

__device__ __forceinline__ const void* opaque_uniform_ptr(const void* p) { const unsigned long long v = (unsigned long long)p; unsigned lo = (unsigned)v, hi = (unsigned)(v >> 32); asm volatile("" : "+v"(lo), "+v"(hi));
    lo = __builtin_amdgcn_readfirstlane(lo); hi = __builtin_amdgcn_readfirstlane(hi); return (const void*)(const GAS char*)(((unsigned long long)hi << 32) | lo); }
__device__ __forceinline__ int opaque_uniform_int(int x) { asm volatile("" : "+v"(x)); return __builtin_amdgcn_readfirstlane(x); }
struct Frame {
    LAS uchar* lds; char* ldsg;
    int tid, lane, wave, G, bid;
    uchar* ws; float* out;
};
__device__ __forceinline__ const float* inp(const Frame& F, int i) { const unsigned long long v = *(const LAS unsigned long long*)(F.lds + LDSCTL_OFF + 576 + i * 8);
    const unsigned lo = __builtin_amdgcn_readfirstlane((unsigned)v), hi = __builtin_amdgcn_readfirstlane((unsigned)(v >> 32)); return (const float*)(const GAS float*)(((unsigned long long)hi << 32) | lo); }
__device__ __forceinline__ float wave16_sum(float v) {
    v += __int_as_float(__builtin_amdgcn_update_dpp(0, __float_as_int(v), 0xB1, 0xF, 0xF, true));
    v += __int_as_float(__builtin_amdgcn_update_dpp(0, __float_as_int(v), 0x4E, 0xF, 0xF, true));
    v += __int_as_float(__builtin_amdgcn_update_dpp(0, __float_as_int(v), 0x141, 0xF, 0xF, true));
    v += __int_as_float(__builtin_amdgcn_update_dpp(0, __float_as_int(v), 0x140, 0xF, 0xF, true));
    return v; }

struct ConvItem { const float* src; uchar* dst; int ldw; bool f8; };
__device__ __forceinline__ void tr_load(const ConvItem& ci, f32x4 (&v)[16]) {
    if (ci.f8) {
#pragma unroll
        for (int i = 0; i < 8; ++i) { v[2 * i] = __builtin_nontemporal_load((const f32x4*)(ci.src + (size_t)(8 * i) * ci.ldw)); v[2 * i + 1] = __builtin_nontemporal_load((const f32x4*)(ci.src + (size_t)(8 * i + 1) * ci.ldw)); }
    } else {
#pragma unroll
        for (int i = 0; i < 16; ++i) v[i] = __builtin_nontemporal_load((const f32x4*)(ci.src + (size_t)(4 * i) * ci.ldw));
    }
}
__device__ __forceinline__ void tr_finish(const f32x4 (&v)[16], const ConvItem& ci, LAS uchar* scr, int lane) {
    const int kr = lane >> 4, nc = (lane & 15) * 4;
    const int g = lane >> 4, q = (lane >> 2) & 3, p = lane & 3;
    const int vb = (int)(uintptr_t)scr + q * 128 + g * 32 + p * 8;
    if (ci.f8) {
#pragma unroll
        for (int i = 0; i < 8; ++i) { const f32x4 a = v[2 * i] * 32.f, b = v[2 * i + 1] * 32.f;
            int r0 = __builtin_amdgcn_cvt_pk_fp8_f32(a.x, b.x, 0, false); r0 = __builtin_amdgcn_cvt_pk_fp8_f32(a.y, b.y, r0, true);
            int r1 = __builtin_amdgcn_cvt_pk_fp8_f32(a.z, b.z, 0, false); r1 = __builtin_amdgcn_cvt_pk_fp8_f32(a.w, b.w, r1, true);
            *(LAS u32x2*)(scr + (4 * i + kr) * 128 + nc * 2) = (u32x2){(unsigned)r0, (unsigned)r1}; }
        asm volatile("s_waitcnt lgkmcnt(0)" ::: "memory");
        s16x4 t[8];
#define TRR(r) t[r] = att::tr_read<(r) * 512>(vb)
        TRR(0); TRR(1); TRR(2); TRR(3); TRR(4); TRR(5); TRR(6); TRR(7);
#undef TRR
        asm volatile("s_waitcnt lgkmcnt(0)" ::: "memory"); __builtin_amdgcn_sched_barrier(0);
#pragma unroll
        for (int j = 0; j < 4; ++j) { const bf16x8 o = {t[2 * j][0], t[2 * j][1], t[2 * j][2], t[2 * j][3], t[2 * j + 1][0], t[2 * j + 1][1], t[2 * j + 1][2], t[2 * j + 1][3]}; *(bf16x8*)(ci.dst + 16 * j) = o; }
    } else {
#pragma unroll
        for (int i = 0; i < 16; ++i) { u32x2 o; o.x = pk2(v[i].x, v[i].y); o.y = pk2(v[i].z, v[i].w); *(LAS u32x2*)(scr + (4 * i + kr) * 128 + nc * 2) = o; }
        asm volatile("s_waitcnt lgkmcnt(0)" ::: "memory");
        s16x4 t[16];
#define TRR(r) t[r] = att::tr_read<(r) * 512>(vb)
        TRR(0); TRR(1); TRR(2); TRR(3); TRR(4); TRR(5); TRR(6); TRR(7); TRR(8); TRR(9); TRR(10); TRR(11); TRR(12); TRR(13); TRR(14); TRR(15);
#undef TRR
        asm volatile("s_waitcnt lgkmcnt(0)" ::: "memory"); __builtin_amdgcn_sched_barrier(0);
#pragma unroll
        for (int j = 0; j < 8; ++j) { const bf16x8 o = {t[2 * j][0], t[2 * j][1], t[2 * j][2], t[2 * j][3], t[2 * j + 1][0], t[2 * j + 1][1], t[2 * j + 1][2], t[2 * j + 1][3]}; *(bf16x8*)(ci.dst + 16 * j) = o; }
    }
}
struct Job { int g, lo, hi; };
__device__ __forceinline__ ConvItem conv_decode(Frame& F, int g, int it) {
    uchar* ws = F.ws; const float* W; int K = 1024, N = 1024, ldt = 1024, mode = 0; size_t dms = 0; bf16_t* WT;
    switch (g) {
        case 0:  W = inp(F, I_MWGATE); N = 512; WT = (bf16_t*)(ws + WS_W_E1); dms = (size_t)1024 * 1024; mode = 1; break;
        case 1:  W = inp(F, I_MWUP);   N = 512; WT = (bf16_t*)(ws + WS_W_E1); dms = (size_t)1024 * 1024; mode = 2; break;
        case 2:  W = inp(F, I_MWDOWN); K = 512; WT = (bf16_t*)(ws + WS_W_E2); ldt = 512; dms = (size_t)1024 * 512; break;
        case 3:  W = inp(F, I_RGWIN);  N = 2048; WT = (bf16_t*)(ws + WS_W_RGIN); dms = (size_t)2048 * 1024; break;
        case 4:  W = inp(F, I_CMWIN);  N = 4096; WT = (bf16_t*)(ws + WS_W_CMIN); break;
        case 5:  W = inp(F, I_RGWOUT); WT = (bf16_t*)(ws + WS_W_RGOUT); dms = (size_t)1024 * 1024; break;
        case 6:  W = inp(F, I_CMWOUT); K = 2048; WT = (bf16_t*)(ws + WS_W_CMOUT); ldt = 2048; break;
        case 7:  W = inp(F, I_ATQKV);  N = 1536; WT = (bf16_t*)(ws + WS_W_QKV); break;
        case 8:  W = inp(F, I_ATWO);   WT = (bf16_t*)(ws + WS_W_AO); break;
        case 9:  W = inp(F, I_RGWA);   K = 128; N = 128; WT = (bf16_t*)(ws + WS_W_RGG); ldt = 128; dms = (size_t)256 * 128; break;
        default: W = inp(F, I_RGWI);   K = 128; N = 128; WT = (bf16_t*)(ws + WS_W_RGG); ldt = 128; dms = (size_t)256 * 128; mode = 3; break;
    }
    const int nblk = N / 64, per = (K / 64) * nblk, mat = it / per, r = it - mat * per, kb = r / nblk, nb = r - kb * nblk, n0 = nb * 64;
    int drow = n0;
    if (mode == 1) drow = (n0 >> 7) * 256 + (n0 & 127); else if (mode == 2) drow = (n0 >> 7) * 256 + 128 + (n0 & 127); else if (mode == 3) drow = 128 + n0;
    const int lane = F.lane;
    const bool f8 = (MOE_FP8 != 0) && g < 3; const int eb = f8 ? 1 : 2;
    ConvItem ci; ci.ldw = N; ci.f8 = f8; ci.src = W + (size_t)mat * K * N + (size_t)(kb * 64 + (f8 ? 2 : 1) * (lane >> 4)) * N + n0 + (lane & 15) * 4;
    ci.dst = (uchar*)WT + ((size_t)mat * dms + (size_t)(drow + (lane >> 4) * 16 + (lane & 15)) * ldt + kb * 64) * eb;
    return ci;
}
template <int NJ>
__device__ __forceinline__ ConvItem conv_find(Frame& F, int v, const Job (&jobs)[NJ]) { int r = v, g = jobs[0].g, it = 0; bool found = false;
#pragma unroll
    for (int q = 0; q < NJ; ++q) { const int n = jobs[q].hi - jobs[q].lo; if (!found) { if (r < n) { g = jobs[q].g; it = jobs[q].lo + r; found = true; } else r -= n; } }
    return conv_decode(F, g, it); }
template <int NJ>
__device__ __forceinline__ void conv_tail(Frame& F, int nblk0, const Job (&jobs)[NJ]) {
    if (nblk0 >= F.G) nblk0 = 0;
    if (F.bid < nblk0) return;
    LAS uchar* scr = F.lds + F.wave * 8192;
    int total = 0;
#pragma unroll
    for (int q = 0; q < NJ; ++q) total += jobs[q].hi - jobs[q].lo;
    const int nw = (F.G - nblk0) * 8;
    int v0 = (F.bid - nblk0) * 8 + F.wave;
    f32x4 va[16], vb[16]; ConvItem c0, c1; c0.dst = nullptr; c1.dst = nullptr; c0.f8 = false; c1.f8 = false; c0.src = nullptr; c1.src = nullptr; c0.ldw = 0; c1.ldw = 0;
    if (v0 < total) { c0 = conv_find(F, v0, jobs); tr_load(c0, va); }
    for (; v0 < total; v0 += 2 * nw) {
        const int v1 = v0 + nw, v2 = v1 + nw;
        if (v1 < total) { c1 = conv_find(F, v1, jobs); tr_load(c1, vb); }
        tr_finish(va, c0, scr, F.lane);
        if (v2 < total) { c0 = conv_find(F, v2, jobs); tr_load(c0, va); }
        if (v1 < total) tr_finish(vb, c1, scr, F.lane);
    }
}
__device__ __forceinline__ void p0_prologue(Frame& F) {
    uchar* ws = F.ws;
    {
        LAS float* act = (LAS float*)(F.lds);
        LAS float* red = (LAS float*)(F.lds + 5 * 1024 * 4);
        bool have = false; const float* pC = inp(F, I_C); const float* pCC = inp(F, I_CCTX); const float* pADAW = inp(F, I_ADAW); const float* pADAB = inp(F, I_ADAB);
        for (int it = F.bid; it < DEPTH * 24; it += F.G) {
            if (!have) { for (int i = F.tid; i < 5 * 1024; i += 512) { const int s = i >> 10, k = i & 1023; const float v = s < 4 ? pC[s * 1024 + k] : pCC[k]; act[i] = v / (1.f + __expf(-v)); } have = true; __syncthreads(); }
            const int l = it / 24, cb = it % 24;
            const float* W = pADAW + (size_t)l * 1024 * NMODV + cb * 256 + F.lane * 4;
            f32x4 a[5];
#pragma unroll
            for (int s = 0; s < 5; ++s) a[s] = (f32x4){0.f, 0.f, 0.f, 0.f};
            const int kbase = F.wave * 128;
#pragma unroll 8
            for (int k = 0; k < 128; ++k) { const f32x4 w = *(const f32x4*)(W + (size_t)(kbase + k) * NMODV);
#pragma unroll
                for (int s = 0; s < 5; ++s) a[s] += w * act[s * 1024 + kbase + k]; }
#pragma unroll
            for (int s = 0; s < 5; ++s) *(LAS f32x4*)(red + (F.wave * 5 + s) * 256 + F.lane * 4) = a[s];
            __syncthreads();
            for (int i = F.tid; i < 5 * 256; i += 512) { const int s = i >> 8, c = i & 255; float v = pADAB[l * NMODV + cb * 256 + c];
#pragma unroll
                for (int w = 0; w < 8; ++w) v += red[(w * 5 + s) * 256 + c];
                ((float*)(ws + WS_MOD))[(l * 5 + s) * NMODV + cb * 256 + c] = v; }
            __syncthreads();
        }
        __syncthreads();
    }
    { const Job jobsA[8] = {{3, 0, 1024}, {4, 0, 1024}, {5, 0, 512}, {6, 0, 512}, {7, 0, 384}, {8, 0, 256}, {9, 0, 128}, {10, 0, 128}}; conv_tail(F, DEPTH * 24, jobsA);
      const Job jobsB[3] = {{0, 0, 16384}, {1, 0, 16384}, {2, 0, 16384}}; conv_tail(F, 0, jobsB); }
    {
        const int gt = F.bid * 512 + F.tid, NGT = F.G * 512;
        { const float* pctx = inp(F, I_CTX); const float* px = inp(F, I_X);
          for (int i0 = gt; i0 < T * 256; i0 += 4 * NGT) { f32x4 v[4];
#pragma unroll
            for (int q = 0; q < 4; ++q) { const int i = i0 + q * NGT; if (i < T * 256) { const int row = i >> 8, c4 = i & 255, b = row / SB, s = row - b * SB;
                const float* src = s < CTX ? pctx + ((size_t)(b * CTX + s) << 10) : px + ((size_t)(b * SEQ + s - CTX) << 10); v[q] = ((const f32x4*)src)[c4]; } }
#pragma unroll
            for (int q = 0; q < 4; ++q) { const int i = i0 + q * NGT; if (i < T * 256) ((f32x4*)(ws + WS_X))[i] = v[q]; } } }
        for (int i = gt; i < 8 * 128 * 128 / 4; i += NGT) { const f32x4 v = ((const f32x4*)inp(F, I_CMWS))[i]; u32x2 o; o.x = pk2(v.x, v.y); o.y = pk2(v.z, v.w); ((u32x2*)(ws + WS_W_CMS))[i] = o; }
        for (int i = gt; i < 2 * 2 * D; i += NGT) { const float* plam = inp(F, I_RGLAM); ((float*)(ws + WS_SPL))[i] = -8.f * log1pf(expf(-plam[i])); }
        for (int i = gt; i < 64 * 32; i += NGT) { const int pos = i >> 5, f = i & 31; const float inv = powf(10000.f, -(float)f * 2.0f / 64.0f); const float ang = (float)pos * inv;
            ((f32x2*)(ws + WS_ROPE))[i] = (f32x2){cosf(ang), sinf(ang)}; }
    }
}

template <bool ROUTE, int NADD>
__device__ __forceinline__ void norm_phase(Frame& F, int l, const float* gvec, int shift_i, bool skip_ctx_route, bool dry) {
    uchar* ws = F.ws;
    float* X = (float*)(ws + WS_X); const bf16_t* YS = (const bf16_t*)(ws + WS_Y1); const bf16_t* YM = (const bf16_t*)(ws + WS_YM); bf16_t* H = (bf16_t*)(ws + WS_H);
    const float* MOD = (const float*)(ws + WS_MOD) + (size_t)l * 5 * NMODV;
    LAS float* wr = (LAS float*)F.lds;
    if constexpr (ROUTE) {
        const float* wg = inp(F, I_MWG) + (size_t)l * 1024 * 4; const float* wrt = inp(F, I_MWR) + (size_t)l * 1024 * 32;
        for (int i0 = F.tid; i0 < 1024 * 9; i0 += 512 * 6) { f32x4 v[6];
#pragma unroll
            for (int u = 0; u < 6; ++u) { const int idx = i0 + u * 512; const int k = idx / 9, q = idx - k * 9; v[u] = q == 0 ? *(const f32x4*)(wg + k * 4) : *(const f32x4*)(wrt + k * 32 + (q - 1) * 4); }
#pragma unroll
            for (int u = 0; u < 6; ++u) { const int idx = i0 + u * 512; const int k = idx / 9, q = idx - k * 9;
                wr[(4 * q + 0) * 1024 + k] = v[u].x; wr[(4 * q + 1) * 1024 + k] = v[u].y; wr[(4 * q + 2) * 1024 + k] = v[u].z; wr[(4 * q + 3) * 1024 + k] = v[u].w; } }
        __syncthreads();
    }
    const int i16 = F.lane & 15, grp = F.lane >> 4;
    const float* bg = nullptr; const float* br = nullptr; if constexpr (ROUTE) { bg = inp(F, I_MBG) + l * 4; br = inp(F, I_MBR) + l * 32; }
    for (int tok = (F.bid * 8 + F.wave) * 4 + grp; tok < T; tok += F.G * 32) {
        asm volatile("" ::: "memory");
        const int sidx = sidx_of_row(tok);
        f32x4 x[16];
        float ss = 0.f;
#pragma unroll
        for (int j = 0; j < 16; ++j) { x[j] = *(const f32x4*)(X + (size_t)tok * D + 64 * j + 4 * i16);
            if constexpr (NADD >= 1) { const u32x2 ym = *(const u32x2*)(YM + (size_t)tok * D + 64 * j + 4 * i16); x[j] += (f32x4){bflo(ym.x), bfhi(ym.x), bflo(ym.y), bfhi(ym.y)}; }
            if constexpr (NADD == 3) { const u32x2 y0 = *(const u32x2*)(YS + (size_t)tok * D + 64 * j + 4 * i16), y1 = *(const u32x2*)(YS + ((size_t)T + tok) * D + 64 * j + 4 * i16);
                x[j] += (f32x4){bflo(y0.x) + bflo(y1.x), bfhi(y0.x) + bfhi(y1.x), bflo(y0.y) + bflo(y1.y), bfhi(y0.y) + bfhi(y1.y)}; *(f32x4*)(X + (size_t)tok * D + 64 * j + 4 * i16) = x[j]; }
            ss += x[j].x * x[j].x + x[j].y * x[j].y + x[j].z * x[j].z + x[j].w * x[j].w; }
        ss = wave16_sum(ss);
        const float rstd = rsqrtf(ss * (1.f / D) + NORM_EPS);
        const float* shp = MOD + (size_t)sidx * NMODV + shift_i * D; const float* scp = shp + D;
#pragma unroll
        for (int j = 0; j < 16; ++j) { const int c = 64 * j + 4 * i16; const f32x4 g = *(const f32x4*)(gvec + c), sh = *(const f32x4*)(shp + c), sc = *(const f32x4*)(scp + c);
            x[j] = x[j] * rstd * g * (sc + 1.f) + sh;
            if constexpr (ROUTE && MOE_FP8) { int r8 = __builtin_amdgcn_cvt_pk_fp8_f32(x[j].x, x[j].y, 0, false); r8 = __builtin_amdgcn_cvt_pk_fp8_f32(x[j].z, x[j].w, r8, true); *(int*)((uchar*)H + (size_t)tok * D + c) = r8; }
            else { u32x2 o; o.x = pk2(x[j].x, x[j].y); o.y = pk2(x[j].z, x[j].w); *(u32x2*)(H + (size_t)tok * D + c) = o; } }
        if constexpr (ROUTE) {
            LAS float* lgs = (LAS float*)(F.lds + LDSCTL_OFF + 1024) + (F.wave * 4 + grp) * 40;
#pragma unroll 1
            for (int o = 0; o < 36; ++o) { f32x4 v0 = {0.f, 0.f, 0.f, 0.f}, v1 = {0.f, 0.f, 0.f, 0.f};
#pragma unroll
                for (int j = 0; j < 16; j += 2) { const f32x4 w0 = *(const LAS f32x4*)(wr + o * 1024 + 64 * j + 4 * i16), w1 = *(const LAS f32x4*)(wr + o * 1024 + 64 * j + 64 + 4 * i16);
                    v0 += x[j] * w0; v1 += x[j + 1] * w1; }
                v0 += v1; float a0 = wave16_sum((v0.x + v0.y) + (v0.z + v0.w)); if (i16 == 0) lgs[o] = a0; }
            asm volatile("s_waitcnt lgkmcnt(0)" ::: "memory");
            const float gl0 = lgs[0] + bg[0], gl1 = lgs[1] + bg[1], gl2 = lgs[2] + bg[2], gl3 = lgs[3] + bg[3];
            int gs = 0; float gm = gl0;
            if (gl1 > gm) { gm = gl1; gs = 1; }
            if (gl2 > gm) { gm = gl2; gs = 2; }
            if (gl3 > gm) { gm = gl3; gs = 3; }
            const float den = __expf(gl0 - gm) + __expf(gl1 - gm) + __expf(gl2 - gm) + __expf(gl3 - gm);
            const float pg = 1.f / den;
            float el[8];
#pragma unroll
            for (int e = 0; e < 8; ++e) el[e] = lgs[4 + gs * 8 + e] + br[gs * 8 + e];
            int i0 = 0; float v0 = el[0];
#pragma unroll
            for (int e = 1; e < 8; ++e) if (el[e] > v0) { v0 = el[e]; i0 = e; }
            int i1 = -1; float v1 = -3.0e38f;
#pragma unroll
            for (int e = 0; e < 8; ++e) if (e != i0 && el[e] > v1) { v1 = el[e]; i1 = e; }
            const float p0 = 1.f / (1.f + __expf(v1 - v0));
            const float w0 = p0 * pg, w1 = (1.f - p0) * pg;
            const bool do_route = !(skip_ctx_route && sidx == 4) && !dry;
            if (i16 == 0 && do_route) {
                const int e0 = gs * 8 + i0, e1 = gs * 8 + i1;
                unsigned* cnt = (unsigned*)(ws + WS_CTL) + CW_CNT + l * 32 * 64;
                const unsigned q0 = atomicAdd(cnt + e0 * 64, 1u), q1 = atomicAdd(cnt + e1 * 64, 1u);
                int* BK = (int*)(ws + WS_BK); float* TW = (float*)(ws + WS_TW);
                BK[(size_t)e0 * T + q0] = tok * 2; BK[(size_t)e1 * T + q1] = tok * 2 + 1;
                TW[tok * 2] = w0; TW[tok * 2 + 1] = w1;
            }
        }
    }
}

__device__ __forceinline__ void st8(bf16_t* p, f32x4 v0, f32x4 v1) { u32x4 w; w.x = cvt_pk_bf16(v0[0], v0[1]); w.y = cvt_pk_bf16(v0[2], v0[3]); w.z = cvt_pk_bf16(v1[0], v1[1]); w.w = cvt_pk_bf16(v1[2], v1[3]); *(u32x4*)p = w; }
#define EPI_ROWS(ai, m) (u.pm * 256 + (ai) * 128 + wr * 64 + (m) * 16 + fr)

struct EpiRgIn { static constexpr bool PERM = true, FP8 = false; bf16_t* GG; bf16_t* XB;
    __device__ __forceinline__ void operator()(const f32x4 (&acc)[2][2][4][2], const pg8::Unit& u, int wr, int wc, int fr, int fq) const {
        const bool isg = u.pn < 4; bf16_t* base = isg ? GG : XB; const int ct = (u.pn & 3) * 256 + wc * 32 + 8 * fq;
#pragma unroll
        for (int ai = 0; ai < 2; ++ai)
#pragma unroll
            for (int m = 0; m < 4; ++m) { bf16_t* rowp = base + (size_t)EPI_ROWS(ai, m) * D + ct;
#pragma unroll
                for (int bj = 0; bj < 2; ++bj) { f32x4 v0 = acc[ai][bj][m][0], v1 = acc[ai][bj][m][1];
                    if (isg) {
#pragma unroll
                        for (int e = 0; e < 4; ++e) { v0[e] = gelu_tanh(v0[e]); v1[e] = gelu_tanh(v1[e]); } }
                    st8(rowp + bj * 128, v0, v1); } }
    } };
struct EpiBf16 { static constexpr bool PERM = true, FP8 = false; bf16_t* O; int ldc;
    __device__ __forceinline__ void operator()(const f32x4 (&acc)[2][2][4][2], const pg8::Unit& u, int wr, int wc, int fr, int fq) const {
        const int ct = u.pn * 256 + wc * 32 + 8 * fq;
#pragma unroll
        for (int ai = 0; ai < 2; ++ai)
#pragma unroll
            for (int m = 0; m < 4; ++m) { bf16_t* rowp = O + (size_t)EPI_ROWS(ai, m) * ldc + ct;
#pragma unroll
                for (int bj = 0; bj < 2; ++bj) st8(rowp + bj * 128, acc[ai][bj][m][0], acc[ai][bj][m][1]); }
    } };
struct EpiCmIn { static constexpr bool PERM = true, FP8 = false; bf16_t* O; f32x2* statp;
    __device__ __forceinline__ void operator()(const f32x4 (&acc)[2][2][4][2], const pg8::Unit& u, int wr, int wc, int fr, int fq) const {
        const int ct = u.pn * 256 + wc * 32 + 8 * fq; const bool isv = u.pn >= 8;
#pragma unroll
        for (int ai = 0; ai < 2; ++ai)
#pragma unroll
            for (int m = 0; m < 4; ++m) { const int row = EPI_ROWS(ai, m); bf16_t* rowp = O + (size_t)row * 4096 + ct; float s = 0.f, q = 0.f;
#pragma unroll
                for (int bj = 0; bj < 2; ++bj) { f32x4 v0 = acc[ai][bj][m][0], v1 = acc[ai][bj][m][1];
#pragma unroll
                    for (int e = 0; e < 4; ++e) { v0[e] = gelu_tanh(v0[e]); v1[e] = gelu_tanh(v1[e]); }
                    u32x4 w; w.x = cvt_pk_bf16(v0[0], v0[1]); w.y = cvt_pk_bf16(v0[2], v0[3]); w.z = cvt_pk_bf16(v1[0], v1[1]); w.w = cvt_pk_bf16(v1[2], v1[3]);
                    *(u32x4*)(rowp + bj * 128) = w;
                    const float r0 = bflo(w.x), r1 = bfhi(w.x), r2 = bflo(w.y), r3 = bfhi(w.y), r4 = bflo(w.z), r5 = bfhi(w.z), r6 = bflo(w.w), r7 = bfhi(w.w);
                    s += ((r0 + r1) + (r2 + r3)) + ((r4 + r5) + (r6 + r7)); q += ((r0 * r0 + r1 * r1) + (r2 * r2 + r3 * r3)) + ((r4 * r4 + r5 * r5) + (r6 * r6 + r7 * r7)); }
                if (isv) { s += __shfl_xor(s, 16); s += __shfl_xor(s, 32); q += __shfl_xor(q, 16); q += __shfl_xor(q, 32);
                    if (fq == 0) statp[(size_t)row * 32 + (u.pn - 8) * 4 + wc] = (f32x2){s, q}; } }
    } };
struct EpiResid { static constexpr bool PERM = true, FP8 = false; bf16_t* YM; const float* gate  ;
    __device__ __forceinline__ void operator()(const f32x4 (&acc)[2][2][4][2], const pg8::Unit& u, int wr, int wc, int fr, int fq) const {
        const int sidx = sidx_of_row(u.pm * 256); const float* gp = gate + (size_t)sidx * NMODV; const int ct = u.pn * 256 + wc * 32 + 8 * fq;
        f32x4 gv[2][2];
#pragma unroll
        for (int bj = 0; bj < 2; ++bj)
#pragma unroll
            for (int n = 0; n < 2; ++n) gv[bj][n] = *(const f32x4*)(gp + ct + bj * 128 + n * 4);
#pragma unroll
        for (int ai = 0; ai < 2; ++ai)
#pragma unroll
            for (int m = 0; m < 4; ++m) { bf16_t* rowp = YM + (size_t)EPI_ROWS(ai, m) * D + ct;
#pragma unroll
                for (int bj = 0; bj < 2; ++bj) st8(rowp + bj * 128, gv[bj][0] * acc[ai][bj][m][0], gv[bj][1] * acc[ai][bj][m][1]); }
    } };
struct EpiRgGate { static constexpr bool PERM = true, FP8 = false; const bf16_t* XC; bf16_t* LA; bf16_t* BB; const float* ba; const float* bi; const float* lam;
    __device__ __forceinline__ void operator()(const f32x4 (&acc)[2][2][4][2], const pg8::Unit& u, int wr, int wc, int fr, int fq) const {
        const int d = u.pn >> 3, blk = u.pn & 7;
        asm volatile("" : "+v"(fr), "+v"(fq));
#pragma unroll
        for (int n = 0; n < 2; ++n) { const int ch = blk * 128 + wc * 32 + 8 * fq + 4 * n;
            const f32x4 bav = *(const f32x4*)(ba + d * D + ch), biv = *(const f32x4*)(bi + d * D + ch), spv = *(const f32x4*)(lam + d * D + ch);
#pragma unroll
            for (int ai = 0; ai < 2; ++ai)
#pragma unroll
                for (int m = 0; m < 4; ++m) { const size_t off = (size_t)EPI_ROWS(ai, m) * D + ch;
                    const u32x2 xw = *(const u32x2*)(XC + off);
                    const f32x4 xc = {bflo(xw.x), bfhi(xw.x), bflo(xw.y), bfhi(xw.y)};
                    f32x4 la, bb;
#pragma unroll
                    for (int e = 0; e < 4; ++e) { const float r = fast_sigmoid(acc[ai][0][m][n][e] + bav[e]), ig = fast_sigmoid(acc[ai][1][m][n][e] + biv[e]);
                        const float lga = r * spv[e]; la[e] = lga; bb[e] = __builtin_amdgcn_sqrtf(one_minus_exp(-2.f * lga)) * ig * xc[e]; }
                    u32x2 w; w.x = cvt_pk_bf16(la[0], la[1]); w.y = cvt_pk_bf16(la[2], la[3]);
                    *(u32x2*)(LA + (size_t)d * T * D + off) = w;
                    w.x = cvt_pk_bf16(bb[0], bb[1]); w.y = cvt_pk_bf16(bb[2], bb[3]);
                    *(u32x2*)(BB + (size_t)d * T * D + off) = w; __builtin_amdgcn_sched_barrier(0); }
            asm volatile("" ::: "memory"); }
    } };

template <bool G1>
struct MoeOrder {
    static constexpr bool GATHER = G1;
    const LAS int* tab; const char* A; const char* B; const int* BK; int G, c, nunits; size_t bstride; int arow, brow;
    __device__ bool next(int i, pg8::Unit& u) const {
        const long L = (long)i * G + c; if (c >= G || L >= nunits) return false;
        const int wgid = __builtin_amdgcn_readfirstlane(pg8::xcd_remap((int)L, nunits)); const int tau = wgid >> 2, pn = wgid & 3;
        int e = 0;
#pragma unroll 1
        for (int k = 1; k < 32; ++k) e = (tab[k] <= tau) ? k : e;
        e = __builtin_amdgcn_readfirstlane(e);
        u.pm = tau; u.pn = pn; u.aux0 = e; u.aux1 = __builtin_amdgcn_readfirstlane((tau - tab[e]) * 256);
        u.a = pg8::uptr(G1 ? A : A + (size_t)tau * 256 * arow);
        u.b = pg8::uptr(B + (size_t)e * bstride + (size_t)pn * 256 * brow);
        return true; }
    __device__ unsigned goff(const pg8::Unit& u, int row) const {
        const int pos = u.aux1 + row; const int cnt = tab[40 + u.aux0];
        int tok = 0; if (pos < cnt) tok = __builtin_nontemporal_load(BK + (size_t)u.aux0 * T + pos) >> 1;
        return (unsigned)tok * (unsigned)arow; }
};
struct EpiMoe1 { static constexpr bool PERM = true, FP8 = (MOE_FP8 != 0); uchar* H1;
    __device__ __forceinline__ void operator()(const f32x4 (&acc)[2][2][4][2], const pg8::Unit& u, int wr, int wc, int fr, int fq) const {
        const int ct = u.pn * 128 + wc * 32 + 8 * fq;
#pragma unroll
        for (int ai = 0; ai < 2; ++ai)
#pragma unroll
            for (int m = 0; m < 4; ++m) { f32x4 h0, h1;
#pragma unroll
                for (int e = 0; e < 4; ++e) { constexpr float WS_ = FP8 ? (1.f / 32.f) : 1.f;
                    const float g0 = acc[ai][0][m][0][e] * WS_, g1 = acc[ai][0][m][1][e] * WS_; h0[e] = g0 * sigmoidf_(g0) * (acc[ai][1][m][0][e] * WS_); h1[e] = g1 * sigmoidf_(g1) * (acc[ai][1][m][1][e] * WS_); }
                if constexpr (FP8) { int r0 = __builtin_amdgcn_cvt_pk_fp8_f32(h0[0], h0[1], 0, false); r0 = __builtin_amdgcn_cvt_pk_fp8_f32(h0[2], h0[3], r0, true);
                    int r1 = __builtin_amdgcn_cvt_pk_fp8_f32(h1[0], h1[1], 0, false); r1 = __builtin_amdgcn_cvt_pk_fp8_f32(h1[2], h1[3], r1, true);
                    *(u32x2*)(H1 + (size_t)EPI_ROWS(ai, m) * DEXP + ct) = (u32x2){(unsigned)r0, (unsigned)r1}; }
                else st8((bf16_t*)H1 + (size_t)EPI_ROWS(ai, m) * DEXP + ct, h0, h1); }
    } };
struct EpiMoe2 { static constexpr bool PERM = true, FP8 = (MOE_FP8 != 0); bf16_t* YS; const float* gate; const int* BK; const float* TW; const LAS int* tab;
    __device__ __forceinline__ void operator()(const f32x4 (&acc)[2][2][4][2], const pg8::Unit& u, int wr, int wc, int fr, int fq) const {
        const int ct = u.pn * 256 + wc * 32 + 8 * fq; const int cnt = tab[40 + u.aux0];
        typedef int i32x8_t __attribute__((ext_vector_type(8))); typedef float f32x8_t __attribute__((ext_vector_type(8))); i32x8_t ent; f32x8_t w8;
#pragma unroll
        for (int r = 0; r < 8; ++r) { const int pos = u.aux1 + (r >> 2) * 128 + wr * 64 + (r & 3) * 16 + fr; ent[r] = -1; if (pos < cnt) ent[r] = __builtin_nontemporal_load(BK + (size_t)u.aux0 * T + pos); }
#pragma unroll
        for (int r = 0; r < 8; ++r) { w8[r] = 0.f; if (ent[r] >= 0) w8[r] = __builtin_nontemporal_load(TW + ent[r]); }
#pragma unroll
        for (int r = 0; r < 8; ++r) { const int e_ = ent[r];
            if (e_ >= 0) { const int tok = e_ >> 1, slot = e_ & 1; const float w = w8[r] * (FP8 ? (1.f / 32.f) : 1.f);
                const float* gp = gate + (size_t)sidx_of_row(tok) * NMODV + ct; bf16_t* yp = YS + ((size_t)slot * T + tok) * D + ct;
#pragma unroll
                for (int bj = 0; bj < 2; ++bj) { const f32x4 g0 = *(const f32x4*)(gp + bj * 128), g1 = *(const f32x4*)(gp + bj * 128 + 4);
                    st8(yp + bj * 128, g0 * w * acc[r >> 2][bj][r & 3][0], g1 * w * acc[r >> 2][bj][r & 3][1]); } } }
    } };
__device__ __forceinline__ int moe_table(Frame& F, int l, LAS int* tab) {
    __syncthreads();
    if (F.tid < 32) { const unsigned c = __hip_atomic_load((unsigned*)(F.ws + WS_CTL) + CW_CNT + (l * 32 + F.tid) * 64, RLX_AGENT); tab[40 + F.tid] = (int)c; }
    __syncthreads();
    if (F.tid == 0) { int s = 0;
#pragma unroll 1
        for (int e = 0; e < 32; ++e) { tab[e] = s; s += (tab[40 + e] + 255) >> 8; } tab[32] = s; }
    __syncthreads();
    return tab[32];
}

__device__ __forceinline__ void conv_phase(Frame& F, int j) {
    const bf16_t* XB = (const bf16_t*)(F.ws + WS_XB); bf16_t* XC = (bf16_t*)(F.ws + WS_XC);
    const float* cw = inp(F, I_RGCW) + (size_t)j * 4 * D; const float* cb = inp(F, I_RGCB) + (size_t)j * D;
    const int NGT = F.G * 512;
    for (int i0 = F.bid * 512 + F.tid; i0 < T * 128; i0 += 2 * NGT) {
        u32x4 xw[2][4];
#pragma unroll
        for (int q = 0; q < 2; ++q) { const int i = i0 + q * NGT; const int row = i >> 7, c = (i & 127) * 8; const int b = row / SB, s = row - b * SB; const int lo = s < CTX ? 0 : CTX, hi = s < CTX ? CTX : SB;
#pragma unroll
            for (int k = 0; k < 4; ++k) { const int ss = s + k - 2; xw[q][k] = (u32x4){0u, 0u, 0u, 0u}; if (i < T * 128 && ss >= lo && ss < hi) xw[q][k] = *(const u32x4*)(XB + (size_t)(b * SB + ss) * D + c); } }
#pragma unroll
        for (int q = 0; q < 2; ++q) { const int i = i0 + q * NGT; if (i < T * 128) { const int row = i >> 7, c = (i & 127) * 8;
            float a[8];
#pragma unroll
            for (int e = 0; e < 8; ++e) a[e] = cb[c + e];
#pragma unroll
            for (int k = 0; k < 4; ++k) { const f32x4 w0 = *(const f32x4*)(cw + k * D + c), w1 = *(const f32x4*)(cw + k * D + c + 4); const u32x4 x = xw[q][k];
                a[0] += w0.x * bflo(x.x); a[1] += w0.y * bfhi(x.x); a[2] += w0.z * bflo(x.y); a[3] += w0.w * bfhi(x.y);
                a[4] += w1.x * bflo(x.z); a[5] += w1.y * bfhi(x.z); a[6] += w1.z * bflo(x.w); a[7] += w1.w * bfhi(x.w); }
            u32x4 o; o.x = pk2(a[0], a[1]); o.y = pk2(a[2], a[3]); o.z = pk2(a[4], a[5]); o.w = pk2(a[6], a[7]);
            *(u32x4*)(XC + (size_t)row * D + c) = o; } }
    }
}
__device__ __forceinline__ void scan1_phase(Frame& F) {
    const bf16_t* LA = (const bf16_t*)(F.ws + WS_LA); const bf16_t* BB = (const bf16_t*)(F.ws + WS_BB); float* TS = (float*)(F.ws + WS_TOTS); float* TH = (float*)(F.ws + WS_TOTH);
    for (int it = F.bid * 8 + F.wave; it < NB * 2 * NCH * 4; it += F.G * 8) {
        const int cg = it & 3, rest = it >> 2, ck = rest % NCH, bd = rest / NCH, dir = bd & 1, b = bd >> 1;
        const int c = cg * 256 + F.lane * 4; const size_t base = (size_t)dir * T * D + (size_t)(b * SB + ck * 16) * D + c;
        u32x2 la[16], bb[16];
#pragma unroll
        for (int t = 0; t < 16; ++t) { const size_t o = base + (size_t)(dir ? 15 - t : t) * D; la[t] = *(const u32x2*)(LA + o); bb[t] = *(const u32x2*)(BB + o); }
        f32x4 sl = {0.f, 0.f, 0.f, 0.f}, h = {0.f, 0.f, 0.f, 0.f};
#pragma unroll
        for (int t = 0; t < 16; ++t) { const f32x4 l4 = {bflo(la[t].x), bfhi(la[t].x), bflo(la[t].y), bfhi(la[t].y)}, b4 = {bflo(bb[t].x), bfhi(bb[t].x), bflo(bb[t].y), bfhi(bb[t].y)};
            sl += l4; f32x4 a4 = {__expf(l4.x), __expf(l4.y), __expf(l4.z), __expf(l4.w)}; h = a4 * h + b4; }
        const size_t o = (size_t)(bd * NCH + ck) * D + c; *(f32x4*)(TS + o) = sl; *(f32x4*)(TH + o) = h;
    }
}
__device__ __forceinline__ void scan2_phase(Frame& F) {
    const float* TS = (const float*)(F.ws + WS_TOTS); const float* TH = (const float*)(F.ws + WS_TOTH); float* CY = (float*)(F.ws + WS_CARRY);
    LAS float* wt = (LAS float*)F.lds;
    for (int it = F.bid; it < NB * 2 * 16; it += F.G) {
        const int cg = it & 15, bd = it >> 4, dir = bd & 1; const int c = cg * 64 + F.lane; const size_t base = (size_t)bd * NCH * D + c;
        const int s0 = F.wave * 34;
        float P = 0.f, H = 0.f;
#pragma unroll 1
        for (int sb = 0; sb < 34; sb += 17) { float sl[17], hl[17];
#pragma unroll
            for (int q = 0; q < 17; ++q) { const int s = s0 + sb + q; const int ck = dir ? (s < 16 ? 15 - s : NCH + 15 - s) : s; sl[q] = TS[base + (size_t)ck * D]; hl[q] = TH[base + (size_t)ck * D]; }
#pragma unroll
            for (int q = 0; q < 17; ++q) { P += sl[q]; H = __expf(sl[q]) * H + hl[q]; } }
        __syncthreads();
        wt[(F.wave * 2 + 0) * 64 + F.lane] = P; wt[(F.wave * 2 + 1) * 64 + F.lane] = H;
        __syncthreads();
        float h = 0.f;
        for (int w = 0; w < F.wave; ++w) h = __expf(wt[(w * 2 + 0) * 64 + F.lane]) * h + wt[(w * 2 + 1) * 64 + F.lane];
#pragma unroll 1
        for (int sb = 0; sb < 34; sb += 17) { float sl[17], hl[17]; int ckk[17];
#pragma unroll
            for (int q = 0; q < 17; ++q) { const int s = s0 + sb + q; ckk[q] = dir ? (s < 16 ? 15 - s : NCH + 15 - s) : s; sl[q] = TS[base + (size_t)ckk[q] * D]; hl[q] = TH[base + (size_t)ckk[q] * D]; }
#pragma unroll
            for (int q = 0; q < 17; ++q) { CY[base + (size_t)ckk[q] * D] = h; h = __expf(sl[q]) * h + hl[q]; } }
    }
    __syncthreads();
}
__device__ __forceinline__ void scan3_phase(Frame& F) {
    const bf16_t* LA = (const bf16_t*)(F.ws + WS_LA); const bf16_t* BB = (const bf16_t*)(F.ws + WS_BB); const float* CY = (const float*)(F.ws + WS_CARRY);
    const bf16_t* GG = (const bf16_t*)(F.ws + WS_GG); bf16_t* SA = (bf16_t*)(F.ws + WS_SA);
    LAS f32x4* hb = (LAS f32x4*)(F.lds + F.wave * 16384);
    for (int it = F.bid * 8 + F.wave; it < NB * NCH * 4; it += F.G * 8) {
        const int cg = it & 3, rest = it >> 2, ck = rest % NCH, b = rest / NCH;
        const int c = cg * 256 + F.lane * 4;
        const size_t rbase = (size_t)(b * SB + ck * 16) * D + c, b1 = (size_t)T * D + rbase;
        f32x4 hbk = *(const f32x4*)(CY + (size_t)((b * 2 + 1) * NCH + ck) * D + c), hf = *(const f32x4*)(CY + (size_t)((b * 2 + 0) * NCH + ck) * D + c);
        { u32x2 la[16], bb[16];
#pragma unroll
          for (int t = 0; t < 16; ++t) { la[t] = *(const u32x2*)(LA + b1 + (size_t)(15 - t) * D); bb[t] = *(const u32x2*)(BB + b1 + (size_t)(15 - t) * D); }
#pragma unroll
          for (int t = 0; t < 16; ++t) { const f32x4 l4 = {bflo(la[t].x), bfhi(la[t].x), bflo(la[t].y), bfhi(la[t].y)}, b4 = {bflo(bb[t].x), bfhi(bb[t].x), bflo(bb[t].y), bfhi(bb[t].y)};
              const f32x4 a4 = {__expf(l4.x), __expf(l4.y), __expf(l4.z), __expf(l4.w)}; hbk = a4 * hbk + b4; hb[(15 - t) * 64 + F.lane] = hbk; } }
        { u32x2 la[16], bb[16], gg[16];
#pragma unroll
          for (int t = 0; t < 16; ++t) { la[t] = *(const u32x2*)(LA + rbase + (size_t)t * D); bb[t] = *(const u32x2*)(BB + rbase + (size_t)t * D); gg[t] = *(const u32x2*)(GG + rbase + (size_t)t * D); }
#pragma unroll
          for (int t = 0; t < 16; ++t) { const f32x4 l4 = {bflo(la[t].x), bfhi(la[t].x), bflo(la[t].y), bfhi(la[t].y)}, b4 = {bflo(bb[t].x), bfhi(bb[t].x), bflo(bb[t].y), bfhi(bb[t].y)};
              const f32x4 g4 = {bflo(gg[t].x), bfhi(gg[t].x), bflo(gg[t].y), bfhi(gg[t].y)};
              const f32x4 a4 = {__expf(l4.x), __expf(l4.y), __expf(l4.z), __expf(l4.w)}; hf = a4 * hf + b4; const f32x4 y = g4 * (hf + hb[t * 64 + F.lane]);
              u32x2 o; o.x = pk2(y.x, y.y); o.y = pk2(y.z, y.w); *(u32x2*)(SA + rbase + (size_t)t * D) = o; } }
    }
}

__device__ __forceinline__ void qknorm_phase(Frame& F) {
    bf16_t* QKV = (bf16_t*)(F.ws + WS_QKV); const f32x2* ROPE = (const f32x2*)(F.ws + WS_ROPE);
    const int i16 = F.lane & 15, grp = F.lane >> 4; const float* pqg = inp(F, I_ATQG); const float* pkg = inp(F, I_ATKG);
    const int ITS = F.G * 32;
    for (int it0 = (F.bid * 8 + F.wave) * 4 + grp; it0 < T * 10; it0 += 4 * ITS) {
        u32x4 xw4[4];
#pragma unroll
        for (int q = 0; q < 4; ++q) { const int it = it0 + q * ITS; xw4[q] = (u32x4){0u, 0u, 0u, 0u}; if (it < T * 10) { const int row = it / 10, hh = it - row * 10; xw4[q] = *(const u32x4*)(QKV + (size_t)row * 1536 + hh * 128 + i16 * 8); } }
#pragma unroll
        for (int q = 0; q < 4; ++q) { const int it = it0 + q * ITS; const bool valid = it < T * 10; const int itc = valid ? it : 0;
            const int row = itc / 10, hh = itc - row * 10; const int b = row / SB, s = row - b * SB;
            bf16_t* p = QKV + (size_t)row * 1536 + hh * 128 + i16 * 8;
            const u32x4 xw = xw4[q];
            float x[8] = {bflo(xw.x), bfhi(xw.x), bflo(xw.y), bfhi(xw.y), bflo(xw.z), bfhi(xw.z), bflo(xw.w), bfhi(xw.w)};
            float ss = 0.f;
#pragma unroll
            for (int e = 0; e < 8; ++e) ss += x[e] * x[e];
            ss = wave16_sum(ss);
            const float rstd = rsqrtf(ss * (1.f / 128.f) + NORM_EPS);
            const float* g = (hh < 8 ? pqg : pkg) + i16 * 8;
#pragma unroll
            for (int e = 0; e < 8; ++e) x[e] = x[e] * rstd * g[e];
            float y[8];
#pragma unroll
            for (int e = 0; e < 8; ++e) y[e] = __shfl_xor(x[e], 4);
            if (s >= CTX) { const int t = s - CTX; const int pos = (i16 >> 3) ? (t & 63) : (t >> 6); const bool half1 = (i16 >> 2) & 1;
#pragma unroll
                for (int e = 0; e < 8; ++e) { const f32x2 cs = ROPE[pos * 32 + (i16 & 3) * 8 + e];
                    x[e] = half1 ? (x[e] * cs.x + y[e] * cs.y) : (x[e] * cs.x - y[e] * cs.y); } }
            u32x4 o; o.x = pk2(x[0], x[1]); o.y = pk2(x[2], x[3]); o.z = pk2(x[4], x[5]); o.w = pk2(x[6], x[7]);
            if (valid) *(u32x4*)p = o;
        }
    }
}
__device__ __forceinline__ void attn_phase(Frame& F) {
    const bf16_t* QKV = (const bf16_t*)(F.ws + WS_QKV); bf16_t* AO = (bf16_t*)(F.ws + WS_AO);
    for (int u = F.bid; u < 544; u += F.G) {
        int b, h, q0, k0, seq;
        if (u < 512) { const int qb = u & 15, hg = (u >> 4) & 3, kvh = (u >> 6) & 1; b = u >> 7; h = kvh * 4 + hg; q0 = b * SB + CTX + qb * 256; k0 = b * SB; seq = SB; }
        else { const int v = u - 512; b = v >> 3; h = v & 7; q0 = b * SB; k0 = b * SB; seq = CTX; }
        const int kvh = h >> 2;
        const bf16_t* Kp = (const bf16_t*)pg8::uptr((const char*)(QKV + (size_t)k0 * 1536 + 1024 + kvh * 128));
        att::attn_dense_body((const bf16_t*)pg8::uptr((const char*)(QKV + (size_t)q0 * 1536 + h * 128)), Kp, Kp + 256, (bf16_t*)pg8::uptr((const char*)(AO + (size_t)q0 * D + h * 128)), seq, F.ldsg, F.tid);
        __syncthreads();
    }
}

__device__ __forceinline__ void spatial_phase(Frame& F) {
    const bf16_t* UVB = (const bf16_t*)(F.ws + WS_UVB); bf16_t* UV = (bf16_t*)(F.ws + WS_UV); const f32x2* statp = (const f32x2*)(F.ws + WS_STATP);
    const bf16_t* Ws = (const bf16_t*)(F.ws + WS_W_CMS); const float* lng = inp(F, I_CMLNG); const float* lnb = inp(F, I_CMLNB); const float* bs = inp(F, I_CMBS);
    LAS uchar* vl = F.lds;
    LAS f32x2* st = (LAS f32x2*)(F.lds + 65536);
    const int tid = F.tid, lane = F.lane, wid = F.wave, r32 = lane & 31, hi = lane >> 5, wm = wid & 3, wn = wid >> 2;
    const int sr = tid >> 4, sc = (tid & 15) * 8;
    for (int u = F.bid; u < 136 * 8; u += F.G) {
        const int chunk = u >> 3, g = u & 7; const int row0 = chunk * 128;
        __syncthreads();
        if (tid < 128) { const f32x2* sp = statp + (size_t)(row0 + tid) * 32; float s = 0.f, q = 0.f;
#pragma unroll 8
            for (int k = 0; k < 32; ++k) { const f32x2 v = sp[k]; s += v.x; q += v.y; }
            const float mean = s * (1.f / 2048.f); const float var = fmaxf(q * (1.f / 2048.f) - mean * mean, 0.f); st[tid] = (f32x2){mean, rsqrtf(var + NORM_EPS)}; }
        __syncthreads();
#pragma unroll
        for (int ch = 0; ch < 2; ++ch) { const int cg = g * 256 + ch * 128 + sc;
            const f32x4 g0 = *(const f32x4*)(lng + cg), g1 = *(const f32x4*)(lng + cg + 4), b0 = *(const f32x4*)(lnb + cg), b1 = *(const f32x4*)(lnb + cg + 4);
#pragma unroll
            for (int i = 0; i < 4; ++i) { const int q = sr + 32 * i; const u32x4 xw = *(const u32x4*)(UVB + (size_t)(row0 + q) * 4096 + 2048 + cg); const f32x2 ms = st[q];
                f32x4 v0 = {bflo(xw.x), bfhi(xw.x), bflo(xw.y), bfhi(xw.y)}, v1 = {bflo(xw.z), bfhi(xw.z), bflo(xw.w), bfhi(xw.w)};
                v0 = (v0 - ms.x) * ms.y * g0 + b0; v1 = (v1 - ms.x) * ms.y * g1 + b1;
                u32x4 o; o.x = pk2(v0.x, v0.y); o.y = pk2(v0.z, v0.w); o.z = pk2(v1.x, v1.y); o.w = pk2(v1.z, v1.w);
                *(LAS u32x4*)(vl + ((q >> 6) * 2 + ch) * 16384 + att::v_st(q & 63, sc)) = o; } }
        bf16x8 pa[2][4];
#pragma unroll
        for (int kt = 0; kt < 2; ++kt)
#pragma unroll
            for (int ks = 0; ks < 4; ++ks) pa[kt][ks] = *(const bf16x8*)(Ws + ((size_t)g * 128 + 32 * wm + r32) * 128 + 64 * kt + 16 * ks + 8 * hi);
        __syncthreads();
        f32x16 o[4] = {};
        const int vb = (int)(uintptr_t)(F.ldsg) + att::v_rd_base(lane) + wn * 16384;
        att::pv_d0(o, vb, pa[0][0], pa[0][1], pa[0][2], pa[0][3]);
        att::pv_d0(o, vb + 32768, pa[1][0], pa[1][1], pa[1][2], pa[1][3]);
        u32x4 uu[8];
#pragma unroll
        for (int i = 0; i < 8; ++i) { const int id = tid + 512 * i, row = id >> 5, ch = id & 31; uu[i] = *(const u32x4*)(UVB + (size_t)(row0 + row) * 4096 + g * 256 + ch * 8); }
        __syncthreads();
#pragma unroll
        for (int r = 0; r < 16; ++r) { const int p = 32 * wm + att::crow(r, hi); const float bsv = bs[g * 128 + p];
#pragma unroll
            for (int d0 = 0; d0 < 4; ++d0) *(LAS bf16_t*)(vl + p * 512 + (128 * wn + 32 * d0 + r32) * 2) = (bf16_t)f2bf(o[d0][r] + bsv); }
        __syncthreads();
#pragma unroll
        for (int i = 0; i < 8; ++i) { const int id = tid + 512 * i, row = id >> 5, ch = id & 31; const u32x4 v = *(const LAS u32x4*)(vl + row * 512 + ch * 16); const u32x4 w = uu[i];
            u32x4 o4; o4.x = pk2(bflo(v.x) * bflo(w.x), bfhi(v.x) * bfhi(w.x)); o4.y = pk2(bflo(v.y) * bflo(w.y), bfhi(v.y) * bfhi(w.y)); o4.z = pk2(bflo(v.z) * bflo(w.z), bfhi(v.z) * bfhi(w.z)); o4.w = pk2(bflo(v.w) * bflo(w.w), bfhi(v.w) * bfhi(w.w));
            *(u32x4*)(UV + (size_t)(row0 + row) * 2048 + g * 256 + ch * 8) = o4; }
    }
    __syncthreads();
}

__device__ __forceinline__ void final_phase(Frame& F) {
    const f32x4* X = (const f32x4*)(F.ws + WS_X); const u32x2* YS = (const u32x2*)(F.ws + WS_Y1); const u32x2* YM = (const u32x2*)(F.ws + WS_YM); f32x4* out = (f32x4*)F.out;
    const int NGT = F.G * 512;
    for (int i0 = F.bid * 512 + F.tid; i0 < NB * SEQ * 256; i0 += 4 * NGT) { f32x4 a[4]; u32x2 y0[4], y1[4], ym[4];
#pragma unroll
        for (int q = 0; q < 4; ++q) { const int i = i0 + q * NGT; if (i < NB * SEQ * 256) { const int r = i >> 8, c4 = i & 255, b = r >> 12, t = r & 4095; const size_t src = ((size_t)(b * SB + CTX + t) << 8) + c4; a[q] = X[src]; y0[q] = YS[src]; y1[q] = YS[src + (size_t)T * 256]; ym[q] = YM[src]; } }
#pragma unroll
        for (int q = 0; q < 4; ++q) { const int i = i0 + q * NGT; if (i < NB * SEQ * 256) out[i] = a[q] + (f32x4){bflo(y0[q].x) + bflo(y1[q].x) + bflo(ym[q].x), bfhi(y0[q].x) + bfhi(y1[q].x) + bfhi(ym[q].x), bflo(y0[q].y) + bflo(y1[q].y) + bflo(ym[q].y), bfhi(y0[q].y) + bfhi(y1[q].y) + bfhi(ym[q].y)}; } }
}

constexpr int NPHASE = 39;
__global__ void __launch_bounds__(512, 2) mk_fwd(Args args) {
    extern __shared__ __attribute__((aligned(16))) uchar lds[];
    Frame F; F.lds = (LAS uchar*)lds; F.ldsg = (char*)lds; F.tid = threadIdx.x; F.lane = F.tid & 63; F.wave = __builtin_amdgcn_readfirstlane(F.tid >> 6); F.G = gridDim.x; F.bid = blockIdx.x;
    F.ws = args.ws; F.out = args.out;
    uchar* ws0 = args.ws;
    volatile LAS unsigned* MISC = (volatile LAS unsigned*)(F.lds + LDSCTL_OFF);
    LAS int* tab = (LAS int*)(F.lds + LDSCTL_OFF + 256);
    for (int u = F.tid; u < (LDS_BYTES - LDSCTL_OFF) / 4; u += 512) ((LAS unsigned*)(F.lds + LDSCTL_OFF))[u] = 0u;
    __syncthreads();
    if (F.tid == 0) {
#pragma unroll
        for (int i = 0; i < 34; ++i) *(LAS unsigned long long*)(F.lds + LDSCTL_OFF + 576 + i * 8) = (unsigned long long)args.in[i]; }
    __syncthreads();
    const int lo = args.ph_lo, hi = args.ph_hi;
    if (hi - lo > 1) (void)xcd_barrier_post((unsigned*)(ws0 + WS_CTL) + CW_BAR, MISC + 8);
    int ph = 0;
#define PH_BEGIN if (ph >= opaque_uniform_int(args.ph_lo) && ph < opaque_uniform_int(args.ph_hi)) { int t_ = threadIdx.x; F.G = opaque_uniform_int(gridDim.x); F.bid = opaque_uniform_int(blockIdx.x); const int cid = F.bid; (void)cid; \
        F.out = (float*)opaque_uniform_ptr(args.out); F.lds = (LAS uchar*)lds; F.ldsg = (char*)lds; \
        asm volatile("" : "+v"(t_)); F.tid = t_; F.lane = t_ & 63; F.wave = __builtin_amdgcn_readfirstlane(t_ >> 6); \
        uchar* ws = (uchar*)opaque_uniform_ptr(args.ws); F.ws = ws; \
        const float* MODl = (const float*)(ws + WS_MOD) + (size_t)l_ * 5 * NMODV; (void)MODl;
#define GRIDBAR  { XcdBarrier bb_; bb_.bar = (unsigned*)(ws + WS_CTL) + CW_BAR; bb_.x = 0; bb_.st = (volatile LAS unsigned*)(F.lds + LDSCTL_OFF) + 8; xcd_barrier(bb_); }
#define REPBAR   if (rep_ > 1) GRIDBAR
#define PH_END   if (ph + 1 < opaque_uniform_int(args.ph_hi)) GRIDBAR } ++ph;

    { const int l_ = 0; PH_BEGIN PM(0) { const bool dry = rep_ > 1; (void)dry;  p0_prologue(F);  REPBAR } PH_END }

#pragma unroll 1
    for (int l = 0; l < DEPTH; ++l) {
        const int kind = l % 3, j = l / 3; const bool lastl = (l == DEPTH - 1); const int l_ = l;
        PH_BEGIN PM(1) { const bool dry = rep_ > 1; (void)dry;  if ((l > 0) && (rep_ == REPN(1))) norm_phase<false, 3>(F, l, inp(F, I_NMG) + l * D, 0, false, false); else norm_phase<false, 0>(F, l, inp(F, I_NMG) + l * D, 0, false, false);  REPBAR } PH_END
        if (kind == 0) {
            PH_BEGIN PM(2) { const bool dry = rep_ > 1; (void)dry;  { pg8::DenseOrder S; S.init(ws + WS_H, D, ws + WS_W_RGIN + (size_t)j * 2048 * 1024 * 2, D, T, 2048, F.G, cid);
                EpiRgIn E{(bf16_t*)(ws + WS_GG), (bf16_t*)(ws + WS_XB)}; pg8::gemm_phase(F.lds, S, E, D, D, D); }  REPBAR } PH_END
            PH_BEGIN PM(3) { const bool dry = rep_ > 1; (void)dry;  conv_phase(F, j);  REPBAR } PH_END
            PH_BEGIN PM(4) { const bool dry = rep_ > 1; (void)dry;  { pg8::DenseOrder S; S.init(ws + WS_XC, D, ws + WS_W_RGG + (size_t)j * 16 * 256 * 128 * 2, 128, T, 16 * 256, F.G, cid, 7, 256);
                EpiRgGate E{(const bf16_t*)(ws + WS_XC), (bf16_t*)(ws + WS_LA), (bf16_t*)(ws + WS_BB), inp(F, I_RGBA) + (size_t)j * 2 * D, inp(F, I_RGBI) + (size_t)j * 2 * D, (const float*)(ws + WS_SPL) + (size_t)j * 2 * D};
                pg8::gemm_phase(F.lds, S, E, 128, D, 128); }  REPBAR } PH_END
            PH_BEGIN PM(5) { const bool dry = rep_ > 1; (void)dry;  scan1_phase(F);  REPBAR } PH_END
            PH_BEGIN PM(20) { const bool dry = rep_ > 1; (void)dry;  scan2_phase(F);  REPBAR } PH_END
            PH_BEGIN PM(6) { const bool dry = rep_ > 1; (void)dry;  scan3_phase(F);  REPBAR } PH_END
            PH_BEGIN PM(7) { const bool dry = rep_ > 1; (void)dry;  { pg8::DenseOrder S; S.init(ws + WS_SA, D, ws + WS_W_RGOUT + (size_t)j * 1024 * 1024 * 2, D, T, D, F.G, cid);
                EpiResid E{(bf16_t*)(ws + (dry ? WS_Y1 : WS_YM)), MODl + 2 * D}; pg8::gemm_phase(F.lds, S, E, D, D, D); }  REPBAR } PH_END
        } else if (kind == 1) {
            PH_BEGIN PM(8) { const bool dry = rep_ > 1; (void)dry;  { pg8::DenseOrder S; S.init(ws + WS_H, D, ws + WS_W_QKV, D, T, 1536, F.G, cid);
                EpiBf16 E{(bf16_t*)(ws + WS_QKV), 1536}; pg8::gemm_phase(F.lds, S, E, D, D, D); }  REPBAR } PH_END
            PH_BEGIN PM(9) { const bool dry = rep_ > 1; (void)dry;  qknorm_phase(F);  REPBAR } PH_END
            PH_BEGIN PM(10) { const bool dry = rep_ > 1; (void)dry;  attn_phase(F);  REPBAR } PH_END
            PH_BEGIN PM(11) { const bool dry = rep_ > 1; (void)dry;  { pg8::DenseOrder S; S.init(ws + WS_AO, D, ws + WS_W_AO, D, T, D, F.G, cid);
                EpiResid E{(bf16_t*)(ws + (dry ? WS_Y1 : WS_YM)), MODl + 2 * D}; pg8::gemm_phase(F.lds, S, E, D, D, D); }  REPBAR } PH_END
        } else {
            PH_BEGIN PM(12) { const bool dry = rep_ > 1; (void)dry;  { pg8::DenseOrder S; S.init(ws + WS_H, D, ws + WS_W_CMIN, D, T, 4096, F.G, cid);
                EpiCmIn E{(bf16_t*)(ws + WS_UVB), (f32x2*)(ws + WS_STATP)}; pg8::gemm_phase(F.lds, S, E, D, D, D); }  REPBAR } PH_END
            PH_BEGIN PM(13) { const bool dry = rep_ > 1; (void)dry;  spatial_phase(F);  REPBAR } PH_END
            PH_BEGIN PM(14) { const bool dry = rep_ > 1; (void)dry;  { pg8::DenseOrder S; S.init(ws + WS_UV, 2048, ws + WS_W_CMOUT, 2048, T, D, F.G, cid);
                EpiResid E{(bf16_t*)(ws + (dry ? WS_Y1 : WS_YM)), MODl + 2 * D}; pg8::gemm_phase(F.lds, S, E, 2048, 2048, 2048); }  REPBAR } PH_END
        }
        PH_BEGIN PM(15) { const bool dry = rep_ > 1; (void)dry;  norm_phase<true, 1>(F, l, inp(F, I_NFG) + l * D, 3, lastl, dry);  REPBAR } PH_END
        PH_BEGIN PM(16) { const bool dry = rep_ > 1; (void)dry;  { const int ntile = moe_table(F, l, tab);
            const int units = ntile * 4, rounds = (units + F.G - 1) / F.G; int geff = F.G; if (false && rounds > 0) { geff = (((units + rounds - 1) / rounds) + 7) & ~7; if (geff > F.G) geff = F.G; }
            constexpr int EB = MOE_FP8 ? 1 : 2;
            MoeOrder<true> S{tab, (const char*)(ws + WS_H), (const char*)(ws + WS_W_E1 + (size_t)l * 32 * 1024 * 1024 * EB), (const int*)(ws + WS_BK), geff, cid, units, (size_t)1024 * 1024 * EB, 1024 * EB, 1024 * EB};
            EpiMoe1 E{ws + WS_H1}; pg8::gemm_phase(F.lds, S, E, D * EB / 2, D * EB / 2, D * EB / 2); }  REPBAR } PH_END
        PH_BEGIN PM(17) { const bool dry = rep_ > 1; (void)dry;  { const int ntile = moe_table(F, l, tab);
            const int units = ntile * 4, rounds = (units + F.G - 1) / F.G; int geff = F.G; if (false && rounds > 0) { geff = (((units + rounds - 1) / rounds) + 7) & ~7; if (geff > F.G) geff = F.G; }
            constexpr int EB = MOE_FP8 ? 1 : 2;
            MoeOrder<false> S{tab, (const char*)(ws + WS_H1), (const char*)(ws + WS_W_E2 + (size_t)l * 32 * 1024 * 512 * EB), (const int*)(ws + WS_BK), geff, cid, units, (size_t)1024 * 512 * EB, 512 * EB, 512 * EB};
            EpiMoe2 E{(bf16_t*)(ws + (dry ? WS_SCR + 64 * MiB : WS_Y1)), MODl + 5 * D, (const int*)(ws + WS_BK), (const float*)(ws + WS_TW), tab}; pg8::gemm_phase(F.lds, S, E, DEXP * EB / 2, DEXP * EB / 2, DEXP * EB / 2); }  REPBAR } PH_END
    }
    { const int l_ = 0; PH_BEGIN PM(18) { const bool dry = rep_ > 1; (void)dry;  final_phase(F);  REPBAR if constexpr (((REP_MASK) >> 19) & 1u) { for (int k_ = 0; k_ < 20; ++k_) GRIDBAR } } PH_END }
#undef PH_BEGIN
#undef PH_END
}

extern "C" void kernel_launch(void* const* d_in, const int* in_sizes, int n_in, void* d_out, int out_size, void* d_ws, size_t ws_size, hipStream_t stream) {
    static int grid = 0;
    if (grid == 0) {
        if (n_in != 34 || out_size != NB * SEQ * D || ws_size < WS_END) { fprintf(stderr, "kernel_launch: bad shapes n_in %d out %d ws %zu (need %zu)\n", n_in, out_size, ws_size, (size_t)WS_END); grid = -1; return; }
        int dev = 0, cus = 0, per_cu = 0;
        if (hipGetDevice(&dev) != hipSuccess || hipDeviceGetAttribute(&cus, hipDeviceAttributeMultiprocessorCount, dev) != hipSuccess) { grid = -1; return; }
        if (hipFuncSetAttribute((const void*)mk_fwd, hipFuncAttributeMaxDynamicSharedMemorySize, LDS_BYTES) != hipSuccess) { fprintf(stderr, "kernel_launch: hipFuncSetAttribute failed\n"); grid = -1; return; }
        if (hipOccupancyMaxActiveBlocksPerMultiprocessor(&per_cu, (const void*)mk_fwd, 512, LDS_BYTES) != hipSuccess || per_cu < 1) { fprintf(stderr, "kernel_launch: occupancy query says %d\n", per_cu); (void)hipGetLastError(); grid = -1; return; }
        grid = cus;
    }
    if (grid < 0) return;
    (void)hipMemsetAsync((char*)d_ws + WS_CTL, 0, CTL_BYTES, stream);
    Args a{};
    for (int i = 0; i < 34; ++i) a.in[i] = (const float*)d_in[i];
    a.out = (float*)d_out; a.ws = (uchar*)d_ws;
#if MK_PER_PHASE
    for (int p = 0; p < NPHASE; ++p) { a.ph_lo = p; a.ph_hi = p + 1; hipLaunchKernelGGL(mk_fwd, dim3(grid), dim3(512), LDS_BYTES, stream, a); }
#else
    a.ph_lo = 0; a.ph_hi = NPHASE;
    void* kargs[] = {&a};
    hipError_t e = hipLaunchCooperativeKernel((const void*)mk_fwd, dim3(grid), dim3(512), kargs, LDS_BYTES, stream);
    if (e != hipSuccess) fprintf(stderr, "kernel_launch: cooperative launch failed: %s (grid %d)\n", hipGetErrorString(e), grid);
#endif
}
```

```cpp
#include <hip/hip_runtime.h>
#include <hip/hip_bf16.h>
#include <cstdio>
#include <cstdint>

#ifndef MOE_FP8
#define MOE_FP8 1
#endif
#ifndef MK_PER_PHASE
#define MK_PER_PHASE 0
#endif

#ifndef PHASE_MASK
#define PHASE_MASK 0xFFFFFFFFu
#endif
#ifndef REP_MASK
#define REP_MASK 0u
#endif
#define REPN(i) ((((REP_MASK) >> (i)) & 1u) ? 2 : 1)
#define PM(i) if constexpr ((PHASE_MASK >> (i)) & 1u) for (int rep_ = REPN(i); rep_ > 0; --rep_)
#define LAS __attribute__((address_space(3)))
#define GAS __attribute__((address_space(1)))
typedef unsigned char uchar;
typedef unsigned short bf16_t;
typedef short bf16x8 __attribute__((ext_vector_type(8)));
typedef short s16x4 __attribute__((ext_vector_type(4)));
typedef float f32x4 __attribute__((ext_vector_type(4)));
typedef float f32x2 __attribute__((ext_vector_type(2)));
typedef float f32x16 __attribute__((ext_vector_type(16)));
typedef unsigned u32x4 __attribute__((ext_vector_type(4)));
typedef unsigned u32x2 __attribute__((ext_vector_type(2)));
typedef GAS unsigned gu32;
#define RLX_AGENT __ATOMIC_RELAXED, __HIP_MEMORY_SCOPE_AGENT

constexpr int D = 1024, NB = 4, SEQ = 4096, CTX = 256, SB = SEQ + CTX, T = NB * SB, DEPTH = 4;
constexpr int NMODV = 6 * D;
constexpr int NEXP = 32, DEXP = 512;
constexpr int NCH = SB / 16;
constexpr float NORM_EPS = 1e-6f;

constexpr size_t MiB = 1u << 20;
constexpr size_t WS_CTL = 0, CTL_BYTES = 1 * MiB;
constexpr size_t WS_MOD = 1 * MiB;
constexpr size_t WS_ROPE = 2 * MiB;
constexpr size_t WS_SPL = 2 * MiB + 65536;
constexpr size_t WS_BK2 = 3 * MiB;
constexpr size_t WS_TOT = 3 * MiB;
constexpr size_t WS_STATP = 8 * MiB;
constexpr size_t WS_BK = 13 * MiB;
constexpr size_t WS_TW = 15 * MiB + 512 * 1024;
constexpr size_t WS_W_RGIN = 16 * MiB, WS_W_RGG = 24 * MiB, WS_W_RGOUT = 26 * MiB, WS_W_QKV = 30 * MiB, WS_W_AO = 33 * MiB;
constexpr size_t WS_W_CMIN = 35 * MiB, WS_W_CMS = 43 * MiB, WS_W_CMOUT = 44 * MiB, WS_W_E1 = 48 * MiB, WS_W_E2 = 304 * MiB;
constexpr size_t WS_X = 432 * MiB, WS_Y1 = 500 * MiB, WS_H = 568 * MiB, WS_SCR = 602 * MiB;
constexpr size_t WS_GG = WS_SCR, WS_XB = WS_SCR + 34 * MiB, WS_XC = WS_SCR + 68 * MiB, WS_LA = WS_SCR + 102 * MiB, WS_BB = WS_SCR + 170 * MiB, WS_SA = WS_SCR + 238 * MiB;
constexpr size_t WS_QKV = WS_SCR, WS_AO = WS_SCR + 51 * MiB;
constexpr size_t WS_UVB = WS_SCR, WS_UV = WS_SCR + 136 * MiB;
constexpr size_t WS_H1 = WS_SCR;
constexpr size_t WS_TOTS = WS_SCR + 272 * MiB, WS_TOTH = WS_TOTS + 9 * MiB, WS_CARRY = WS_TOTH + 9 * MiB;
constexpr size_t WS_YM = WS_CARRY + 9 * MiB;
constexpr size_t WS_END = WS_YM + 34 * MiB;
constexpr int CW_TMO = 0, CW_BAR = 4096, CW_CNT = 16384;

constexpr int RING_BYTES = 131072;
constexpr int ROUTER_LDS = 36 * 1024 * 4;
constexpr int LDSCTL_OFF = 147456;
constexpr int LDS_BYTES = LDSCTL_OFF + 1024 + 8 * 4 * 40 * 4;

__device__ __forceinline__ unsigned f2bf(float f) { unsigned u = __builtin_bit_cast(unsigned, f); return (u + 0x7fffu + ((u >> 16) & 1u)) >> 16; }
__device__ __forceinline__ unsigned pk2(float lo, float hi) { return f2bf(lo) | (f2bf(hi) << 16); }
__device__ __forceinline__ float bf2f(unsigned short h) { return __builtin_bit_cast(float, (unsigned)h << 16); }
__device__ __forceinline__ float bflo(unsigned w) { return __builtin_bit_cast(float, w << 16); }
__device__ __forceinline__ float bfhi(unsigned w) { return __builtin_bit_cast(float, w & 0xffff0000u); }
__device__ __forceinline__ unsigned cvt_pk_bf16(float lo, float hi) { unsigned r; asm volatile("v_cvt_pk_bf16_f32 %0, %1, %2" : "=v"(r) : "v"(lo), "v"(hi)); return r; }
__device__ __forceinline__ float gelu_tanh(float x) { const float u = 0.7978845608028654f * (x + 0.044715f * x * x * x); const float e = __expf(2.f * u); const float t = 1.f - 2.f / (e + 1.f); return 0.5f * x * (1.f + t); }
__device__ __forceinline__ float sigmoidf_(float x) { return 1.f / (1.f + __expf(-x)); }
__device__ __forceinline__ float fast_sigmoid(float x) { return __builtin_amdgcn_rcpf(1.f + __expf(-x)); }
__device__ __forceinline__ float one_minus_exp(float y) {   const float p = y * (1.f - y * (0.5f - y * (0.16666667f - y * 0.041666667f))); const float q = 1.f - __expf(-y); return y < 0.0625f ? p : q; }
__device__ __forceinline__ int sidx_of_row(int row) { const int b = row / SB; return (row - b * SB) < CTX ? 4 : b; }

namespace pg8 {
constexpr int BM = 256, BK = 64, HALF = 128, HTB = HALF * BK * 2, NXCD = 8, WGM = 8;
__device__ __forceinline__ int lds_byte(int r, int c) { const int st = (r >> 4) * 2 + (c >> 5), rr = r & 15, cc = c & 31, ob = rr * 64 + cc * 2; return st * 1024 + (ob ^ (((ob >> 9) & 1) << 5)); }
__device__ __forceinline__ void stage_rc(int b, int& R, int& C) { const int st = b / 1024, sb = b % 1024, swz = sb ^ (((sb >> 9) & 1) << 5); R = (st >> 1) * 16 + swz / 64; C = (st & 1) * 32 + (swz % 64) / 2; }
__device__ __forceinline__ int perm32(int rho) { const int n = rho >> 4, i = rho & 15; return 8 * (i >> 2) + 4 * n + (i & 3); }
struct Unit { const char* a; const char* b; int pm, pn, aux0, aux1, hm; };
__device__ __forceinline__ const char* uptr(const char* p) { const unsigned long long v = (unsigned long long)p; const unsigned lo = __builtin_amdgcn_readfirstlane((unsigned)v), hi = __builtin_amdgcn_readfirstlane((unsigned)(v >> 32)); return (const char*)(const GAS char*)(((unsigned long long)hi << 32) | lo); }
__device__ __forceinline__ bool unit_slot(int i, int c, int G, int nwg, int& L, int& hm) {
    if (c >= G) return false;
    const int nfull = nwg / G, rem = nwg - nfull * G;
    if (i < nfull) { L = i * G + c; hm = 0xF; return true; }
    if (i > nfull || rem == 0) return false;
    if (rem * 2 <= G) { if (c >= 2 * rem) return false; L = nfull * G + (c >> 1); hm = (c & 1) ? 0xC : 0x3; return true; }
    if (c >= rem) return false; L = nfull * G + c; hm = 0xF; return true; }
__device__ __forceinline__ int xcd_remap(int L, int nwg) { const int q = nwg / NXCD, r = nwg % NXCD, xcd = L % NXCD, off = L / NXCD; return (xcd < r ? xcd * (q + 1) : r * (q + 1) + (xcd - r) * q) + off; }

struct DenseOrder {
    static constexpr bool GATHER = false;
    const char* A; const char* B; int nM, nN, nwg, G, c; size_t tA, tB; int amask, acol;
    __device__ void init(const void* A_, int lda, const void* B_, int ldb, int M, int N, int G_, int c_, int amask_ = 0, int acol_ = 0) {
        A = (const char*)A_; B = (const char*)B_; nM = M / BM; nN = N / BM; nwg = nM * nN; G = G_; c = c_; tA = (size_t)BM * lda * 2; tB = (size_t)BM * ldb * 2; amask = amask_; acol = acol_; }
    __device__ bool next(int i, Unit& u) const {
        int L, hm; if (!unit_slot(i, c, G, nwg, L, hm)) return false; u.hm = __builtin_amdgcn_readfirstlane(hm);
        const int wgid = xcd_remap(L, nwg);
        const int nig = WGM * nN, gid = wgid / nig, fm = gid * WGM, gsz = (nM - fm) < WGM ? (nM - fm) : WGM;
        u.pm = __builtin_amdgcn_readfirstlane(fm + ((wgid % nig) % gsz)); u.pn = __builtin_amdgcn_readfirstlane((wgid % nig) / gsz); u.aux0 = 0; u.aux1 = 0;
        u.a = uptr(A + (size_t)u.pm * tA + (size_t)(u.pn & amask) * acol); u.b = uptr(B + (size_t)u.pn * tB); return true; }
    __device__ unsigned goff(const Unit&, int) const { return 0u; }
};

#define PG8_SA(b, h) (((b) * 2 + (h)) * HTB)
#define PG8_SB(b, h) ((4 + (b) * 2 + (h)) * HTB)
__device__ __forceinline__ void glds16(const char* sbase, unsigned voff, unsigned ldsaddr) { unsigned keep;
    asm volatile("s_mov_b32 %0, m0\n\ts_mov_b32 m0, %3\n\ts_nop 0\n\tglobal_load_lds_dwordx4 %1, %2\n\ts_mov_b32 m0, %0" : "=&s"(keep) : "v"(voff), "s"(sbase), "s"(ldsaddr) : "memory"); }
#ifndef PG8_ASM_DMA
#define PG8_ASM_DMA 1
#endif
#if PG8_ASM_DMA
#define PG8_GLDS(gp, voff, ldsoff) glds16((const char*)(gp), (voff), ldsbase + (unsigned)(ldsoff))
#else
#define PG8_GLDS(gp, voff, ldsoff) __builtin_amdgcn_global_load_lds((const unsigned*)((const char*)(gp) + (voff)), (LAS unsigned*)(lds + (ldsoff)), 16, 0, 0)
#endif
#define PG8_STAGE_B(bufoff, gbase) do { PG8_GLDS(gbase, voffB[0], (bufoff) + ldsw); PG8_GLDS(gbase, voffB[1], (bufoff) + ldsw + 8192); } while (0)
#define PG8_STAGE_A(bufoff, gbase, h, NX) do { if constexpr (Sched::GATHER) { \
        PG8_GLDS(gbase, ((NX) ? vAn[h][0] : vAc[h][0]), (bufoff) + ldsw); PG8_GLDS(gbase, ((NX) ? vAn[h][1] : vAc[h][1]), (bufoff) + ldsw + 8192); \
    } else { PG8_GLDS((const char*)(gbase) + (h) * hstepA, voffA[0], (bufoff) + ldsw); PG8_GLDS((const char*)(gbase) + (h) * hstepA, voffA[1], (bufoff) + ldsw + 8192); } } while (0)
#define PG8_LDA(dst, b, h) do { _Pragma("unroll") for (int m = 0; m < 4; ++m) _Pragma("unroll") for (int k = 0; k < 2; ++k) dst[m][k] = *(const LAS bf16x8*)(lds + PG8_SA(b, h) + aoff + m * 2048 + k * 1024); } while (0)
#define PG8_LDB(dst, b, h) do { _Pragma("unroll") for (int n = 0; n < 2; ++n) _Pragma("unroll") for (int k = 0; k < 2; ++k) dst[n][k] = *(const LAS bf16x8*)(lds + PG8_SB(b, h) + boff + n * 2048 + k * 1024); } while (0)
typedef int i32x8 __attribute__((ext_vector_type(8))); typedef int i32x4v __attribute__((ext_vector_type(4)));
__device__ __forceinline__ i32x8 cat8(bf16x8 lo, bf16x8 hi) { return __builtin_shufflevector(__builtin_bit_cast(i32x4v, lo), __builtin_bit_cast(i32x4v, hi), 0, 1, 2, 3, 4, 5, 6, 7); }
#define PG8_MMA(ai, bj, At, Bt) do { __builtin_amdgcn_s_setprio(1); _Pragma("unroll") for (int m = 0; m < 4; ++m) _Pragma("unroll") for (int n = 0; n < 2; ++n) { \
        if constexpr (Epi::FP8) { asm volatile("v_mfma_scale_f32_16x16x128_f8f6f4 %0, %1, %2, %0, %3, %3 op_sel_hi:[0,0,0]" : "+v"(acc[ai][bj][m][n]) : "v"(cat8(Bt[n][0], Bt[n][1])), "v"(cat8(At[m][0], At[m][1])), "v"(0x7F7F7F7F)); } \
        else { _Pragma("unroll") for (int k = 0; k < 2; ++k) acc[ai][bj][m][n] = __builtin_amdgcn_mfma_f32_16x16x32_bf16(Bt[n][k], At[m][k], acc[ai][bj][m][n], 0, 0, 0); } } __builtin_amdgcn_s_setprio(0); } while (0)
#define PG8_WAIT_V(n) asm volatile("s_waitcnt vmcnt(" #n ")" ::: "memory")
#define PG8_WAIT_L(n) asm volatile("s_waitcnt lgkmcnt(" #n ")" ::: "memory")
#define PG8_BAR __builtin_amdgcn_s_barrier()
#define PG8_SCHED __builtin_amdgcn_sched_barrier(0)

template <class Epi, class Sched>
__device__ __forceinline__ void gemm_phase(LAS uchar* lds, const Sched& S, const Epi& E, const int K, const int lda, const int ldb) {
    int tid = threadIdx.x; asm volatile("" : "+v"(tid));
    const int wid = __builtin_amdgcn_readfirstlane(tid >> 6), lane = tid & 63, wr = wid >> 2, wc = wid & 3; int fr = lane & 15, fq = lane >> 4;
    int nt = K / BK; asm volatile("" : "+s"(nt));
    unsigned voffA[2], voffB[2];
#pragma unroll
    for (int i = 0; i < 2; ++i) { int R, C; stage_rc(tid * 16 + i * 8192, R, C); const int Rb = Epi::PERM ? ((R & ~31) + perm32(R & 31)) : R;
        voffA[i] = (unsigned)(R * lda + C) * 2u; voffB[i] = (unsigned)(Rb * ldb + C) * 2u; }
    const size_t kstep = (size_t)(BK * 2);
    const size_t hstepA = (size_t)HALF * lda * 2, hstepB = (size_t)HALF * ldb * 2;
    const unsigned ldsw = (unsigned)wid * 1024u;
    const unsigned ldsbase = (unsigned)(uintptr_t)lds;
    const int aoff = lds_byte(wr * 64 + fr, fq * 8), boff = lds_byte(wc * 32 + fr, fq * 8);
    Unit cur, nxt; int ui = 0;
    if (!S.next(0, cur)) return;
    unsigned vAc[2][2], vAn[2][2];
#pragma unroll
    for (int h = 0; h < 2; ++h)
#pragma unroll
        for (int i = 0; i < 2; ++i) { vAc[h][i] = 0u; vAn[h][i] = 0u; }
    if constexpr (Sched::GATHER) {
#pragma unroll
        for (int h = 0; h < 2; ++h)
#pragma unroll
            for (int i = 0; i < 2; ++i) { int R, C; stage_rc(tid * 16 + i * 8192, R, C); vAc[h][i] = S.goff(cur, h * HALF + R) + (unsigned)C * 2u; }
    }
    f32x4 acc[2][2][4][2];
#pragma unroll
    for (int a = 0; a < 2; ++a)
#pragma unroll
        for (int b = 0; b < 2; ++b)
#pragma unroll
            for (int m = 0; m < 4; ++m)
#pragma unroll
                for (int n = 0; n < 2; ++n) acc[a][b][m][n] = (f32x4){0.f, 0.f, 0.f, 0.f};
    bf16x8 At[4][2], B0[2][2], B1[2][2];
    typedef int pre_t __attribute__((ext_vector_type(16))); pre_t pre = {};
    if constexpr (Epi::PREFETCH) pre = E.prefetch(cur, wr, fr);
    const char* cA = cur.a; const char* cB = cur.b;
    PG8_STAGE_B(PG8_SB(0, 0), cB); PG8_STAGE_B(PG8_SB(0, 1), cB + hstepB); PG8_STAGE_A(PG8_SA(0, 0), cA, 0, false); PG8_STAGE_A(PG8_SA(0, 1), cA, 1, false);
    if (wr == 1) PG8_BAR;
    PG8_WAIT_V(2); PG8_BAR;
    PG8_STAGE_B(PG8_SB(1, 0), cB + kstep); PG8_STAGE_A(PG8_SA(1, 0), cA + kstep, 0, false); PG8_STAGE_B(PG8_SB(1, 1), cB + hstepB + kstep);
    PG8_WAIT_V(6); PG8_BAR;
    for (;;) {
        const bool has_next = S.next(ui + 1, nxt);
        if constexpr (Sched::GATHER) { if (has_next) {
#pragma unroll
            for (int h = 0; h < 2; ++h)
#pragma unroll
                for (int i = 0; i < 2; ++i) { int R, C; int t2 = tid; asm volatile("" : "+v"(t2)); stage_rc(t2 * 16 + i * 8192, R, C); vAn[h][i] = S.goff(nxt, h * HALF + R) + (unsigned)C * 2u; }
            *(LAS u32x4*)(lds + 131072 + tid * 16) = (u32x4){vAn[0][0], vAn[0][1], vAn[1][0], vAn[1][1]}; } }
        const char* nA = has_next ? nxt.a : cA; const char* nB = has_next ? nxt.b : cB;
        for (int t = 0; t < nt; t += 2) {
            const bool last = (t == nt - 2);
            const bool nx = last && has_next;
            if constexpr (Sched::GATHER) { if (nx) { const u32x4 pk_ = *(const LAS u32x4*)(lds + 131072 + tid * 16); vAn[0][0] = pk_.x; vAn[0][1] = pk_.y; vAn[1][0] = pk_.z; vAn[1][1] = pk_.w; } }
            const char* a1 = cA + (size_t)(t + 1) * kstep;
            const char* a2 = last ? nA : cA + (size_t)(t + 2) * kstep; const char* b2 = last ? nB : cB + (size_t)(t + 2) * kstep;
            const char* a3 = a2 + kstep; const char* b3 = b2 + kstep;
            PG8_LDB(B0, 0, 0); PG8_LDB(B1, 0, 1); PG8_SCHED; PG8_LDA(At, 0, 0); PG8_STAGE_A(PG8_SA(1, 1), a1, 1, false);
            PG8_WAIT_V(8); PG8_WAIT_L(0); PG8_BAR; if (cur.hm & 1) { PG8_MMA(0, 0, At, B0); PG8_MMA(0, 1, At, B1); } PG8_BAR; PG8_SCHED;
            PG8_LDA(At, 0, 1); PG8_STAGE_B(PG8_SB(0, 0), b2); PG8_STAGE_B(PG8_SB(0, 1), b2 + hstepB); PG8_STAGE_A(PG8_SA(0, 0), a2, 0, nx);
            PG8_WAIT_V(8); PG8_WAIT_L(0); PG8_BAR; if (cur.hm & 4) { PG8_MMA(1, 0, At, B0); PG8_MMA(1, 1, At, B1); } PG8_BAR; PG8_SCHED;
            PG8_LDB(B0, 1, 0); PG8_LDB(B1, 1, 1); PG8_SCHED; PG8_LDA(At, 1, 0); PG8_STAGE_A(PG8_SA(0, 1), a2, 1, nx);
            PG8_WAIT_V(8); PG8_WAIT_L(0); PG8_BAR; if (cur.hm & 1) { PG8_MMA(0, 0, At, B0); PG8_MMA(0, 1, At, B1); } PG8_BAR; PG8_SCHED;
            PG8_LDA(At, 1, 1); PG8_STAGE_B(PG8_SB(1, 0), b3); PG8_STAGE_B(PG8_SB(1, 1), b3 + hstepB); PG8_STAGE_A(PG8_SA(1, 0), a3, 0, nx);
            PG8_WAIT_V(8); PG8_WAIT_L(0); PG8_BAR; if (cur.hm & 4) { PG8_MMA(1, 0, At, B0); PG8_MMA(1, 1, At, B1); } PG8_BAR; PG8_SCHED;
        }
        if (wr == 0) PG8_BAR;
        if constexpr (Epi::FP8) asm volatile("s_nop 15\n\ts_nop 15" ::: "memory");
        if constexpr (Epi::PREFETCH) E(acc, cur, wr, wc, fr, fq, pre); else E(acc, cur, wr, wc, fr, fq);
        if (!has_next) break;
#pragma unroll
        for (int a = 0; a < 2; ++a)
#pragma unroll
            for (int b = 0; b < 2; ++b)
#pragma unroll
                for (int m = 0; m < 4; ++m)
#pragma unroll
                    for (int n = 0; n < 2; ++n) acc[a][b][m][n] = (f32x4){0.f, 0.f, 0.f, 0.f};
        cur = nxt; cA = nA; cB = nB; ++ui;
        if constexpr (Epi::PREFETCH) pre = E.prefetch(cur, wr, fr);
        if constexpr (Sched::GATHER) {
#pragma unroll
            for (int h = 0; h < 2; ++h)
#pragma unroll
                for (int i = 0; i < 2; ++i) vAc[h][i] = vAn[h][i]; }
        if (wr == 1) PG8_BAR;
    }
    PG8_WAIT_V(0);
    PG8_BAR;
}
}

#ifndef ATT_SDEPTH
#define ATT_SDEPTH 1
#endif
namespace att {
constexpr int NW = 8, QBLK = 32, KVBLK = 64;
constexpr float SCALE = 0.088388347648318440f;
constexpr float THR = 8.f;
constexpr int LDQ = 1536, LDK = 1536, LDO = 1024;
constexpr size_t SHM_V = KVBLK * 128 * 2, SHM_K = KVBLK * 128 * 2, SHM_ATTN = 2 * SHM_V + 2 * SHM_K + NW * 64 * 4;
#define KSWZ(row, colB) ((row) * 256 + ((colB) ^ (((row) & 7) << 4)))
#define SBAR() __builtin_amdgcn_sched_barrier(0)
__device__ __forceinline__ int crow(int r, int hi) { return (r & 3) + 8 * (r >> 2) + 4 * hi; }
__device__ __forceinline__ void partialSM(f32x16& p0, f32x16& p1, float& m_reg, float& mn, float& alpha) {
  constexpr float C = SCALE * 1.4426950408889634f;
  float pmax = p0[0];
#pragma unroll
  for (int r = 1; r < 16; ++r) pmax = fmaxf(pmax, p0[r]);
#pragma unroll
  for (int r = 0; r < 16; ++r) pmax = fmaxf(pmax, p1[r]);
  { auto rr = __builtin_amdgcn_permlane32_swap(__float_as_uint(pmax), __float_as_uint(pmax), false, false);
    pmax = fmaxf(__uint_as_float(rr[0]), __uint_as_float(rr[1])); }
  if (__builtin_expect(__all(pmax - m_reg <= THR / SCALE), 1)) { mn = m_reg; alpha = 1.f; }
  else { mn = fmaxf(m_reg, pmax); alpha = __builtin_amdgcn_exp2f((m_reg - mn) * C); m_reg = mn; }
  float mnC = -mn * C;
#pragma unroll
  for (int r = 0; r < 16; ++r) p0[r] = fmaf(p0[r], C, mnC);
#pragma unroll
  for (int r = 0; r < 16; ++r) p1[r] = fmaf(p1[r], C, mnC);
#pragma unroll
  for (int r = 0; r < 16; ++r) p0[r] = __builtin_amdgcn_exp2f(p0[r]);
}
__device__ __forceinline__ void finishSM(f32x16& p0, f32x16& p1, float alpha, float& l_reg, bf16x8& pa0, bf16x8& pa1, bf16x8& pa2, bf16x8& pa3) {
#pragma unroll
  for (int r = 0; r < 16; ++r) p1[r] = __builtin_amdgcn_exp2f(p1[r]);
  float ps = 0;
#pragma unroll
  for (int r = 0; r < 16; ++r) ps += p0[r];
#pragma unroll
  for (int r = 0; r < 16; ++r) ps += p1[r];
  { auto rr = __builtin_amdgcn_permlane32_swap(__float_as_uint(ps), __float_as_uint(ps), false, false);
    ps = __uint_as_float(rr[0]) + __uint_as_float(rr[1]); }
  l_reg = l_reg * alpha + ps;
#define PK4(P, BASE, OUT) do { unsigned a0 = cvt_pk_bf16(P[BASE + 0], P[BASE + 1]), a1 = cvt_pk_bf16(P[BASE + 2], P[BASE + 3]);   \
    unsigned b0 = cvt_pk_bf16(P[BASE + 4], P[BASE + 5]), b1 = cvt_pk_bf16(P[BASE + 6], P[BASE + 7]);                              \
    auto r0 = __builtin_amdgcn_permlane32_swap(a0, b0, false, false); auto r1 = __builtin_amdgcn_permlane32_swap(a1, b1, false, false); \
    u32x4 w = {r0[0], r1[0], r0[1], r1[1]}; OUT = __builtin_bit_cast(bf16x8, w); } while (0)
  PK4(p0, 0, pa0); PK4(p0, 8, pa1); PK4(p1, 0, pa2); PK4(p1, 8, pa3);
#undef PK4
}
__device__ __forceinline__ void qkt(f32x16& p0, f32x16& p1, const bf16_t* Ks, const bf16x8* qr, int r32, int hi) {
  p0 = f32x16{}; p1 = f32x16{};
#pragma unroll
  for (int d0 = 0; d0 < 8; ++d0) { int cb = (d0 * 16 + hi * 8) * 2;
    bf16x8 b0 = *reinterpret_cast<const bf16x8*>((const char*)Ks + KSWZ(r32, cb));
    bf16x8 b1 = *reinterpret_cast<const bf16x8*>((const char*)Ks + KSWZ(32 + r32, cb));
    p0 = __builtin_amdgcn_mfma_f32_32x32x16_bf16(b0, qr[d0], p0, 0, 0, 0);
    p1 = __builtin_amdgcn_mfma_f32_32x32x16_bf16(b1, qr[d0], p1, 0, 0, 0); }
}
__device__ __forceinline__ int v_st(int k, int c) { const int kk = (k & ~0xC) | ((k & 4) << 1) | ((k & 8) >> 1); return ((kk >> 3) * 4 + (c >> 5)) * 512 + ((kk & 7) * 32 + (c & 31)) * 2; }
__device__ __forceinline__ int v_rd_base(int lane) { return ((lane & 3) << 3) | (((lane >> 2) & 3) << 6) | (((lane >> 4) & 1) << 5) | (((lane >> 5) & 1) << 8); }
constexpr int v_rd_off(int d0, int ks, int half) { return d0 * 512 + ks * 4096 + half * 2048; }
template <int OFF> __device__ __forceinline__ s16x4 tr_read(int vb) {
  s16x4 r; asm volatile("ds_read_b64_tr_b16 %0, %1 offset:%2" : "=&v"(r) : "v"(vb), "i"(OFF) : "memory"); return r;
}
template <int D0> __device__ __forceinline__ void pv_one(f32x16& od, int vb, bf16x8 pa0, bf16x8 pa1, bf16x8 pa2, bf16x8 pa3) {
  const s16x4 l0 = tr_read<v_rd_off(D0, 0, 0)>(vb), h0 = tr_read<v_rd_off(D0, 0, 1)>(vb), l1 = tr_read<v_rd_off(D0, 1, 0)>(vb), h1 = tr_read<v_rd_off(D0, 1, 1)>(vb);
  const s16x4 l2 = tr_read<v_rd_off(D0, 2, 0)>(vb), h2 = tr_read<v_rd_off(D0, 2, 1)>(vb), l3 = tr_read<v_rd_off(D0, 3, 0)>(vb), h3 = tr_read<v_rd_off(D0, 3, 1)>(vb);
  asm volatile("s_waitcnt lgkmcnt(0)" ::: "memory"); SBAR();
#define PK(L, H) (bf16x8){L[0], L[1], L[2], L[3], H[0], H[1], H[2], H[3]}
  od = __builtin_amdgcn_mfma_f32_32x32x16_bf16(pa0, PK(l0, h0), od, 0, 0, 0);
  od = __builtin_amdgcn_mfma_f32_32x32x16_bf16(pa1, PK(l1, h1), od, 0, 0, 0);
  od = __builtin_amdgcn_mfma_f32_32x32x16_bf16(pa2, PK(l2, h2), od, 0, 0, 0);
  od = __builtin_amdgcn_mfma_f32_32x32x16_bf16(pa3, PK(l3, h3), od, 0, 0, 0);
#undef PK
}
__device__ __forceinline__ void pv_d0(f32x16* o, int vb, bf16x8 pa0, bf16x8 pa1, bf16x8 pa2, bf16x8 pa3) {
  pv_one<0>(o[0], vb, pa0, pa1, pa2, pa3); pv_one<1>(o[1], vb, pa0, pa1, pa2, pa3); pv_one<2>(o[2], vb, pa0, pa1, pa2, pa3); pv_one<3>(o[3], vb, pa0, pa1, pa2, pa3);
}
__device__ __forceinline__ void attn_dense_body(const bf16_t* Qb, const bf16_t* Kh, const bf16_t* Vh, bf16_t* Ob, int seq, char* lds, const int tid) {
  const int wid = tid >> 6, lane = tid & 63, r32 = lane & 31, hi = lane >> 5;
  bf16_t* V_lds = (bf16_t*)lds; bf16_t* K_lds = (bf16_t*)(lds + 2 * SHM_V);
  float* ws = (float*)(lds + 2 * SHM_V + 2 * SHM_K) + wid * 64; float* li_l = ws; float* al_l = ws + 32;
  float m_reg = -1e30f, l_reg = 0; f32x16 o[4] = {}; bf16x8 qr[8];
  const bf16_t* Qw = Qb + (long)(wid * QBLK + r32) * LDQ + hi * 8;
#pragma unroll
  for (int d0 = 0; d0 < 8; ++d0) qr[d0] = *reinterpret_cast<const bf16x8*>(Qw + d0 * 16);
  const int sr = tid >> 4, sc = (tid & 15) * 8, vst0 = v_st(sr, sc), vst1 = v_st(32 + sr, sc);
  const int vb0 = (int)(uintptr_t)V_lds + v_rd_base(lane);
  struct { bf16x8 vs0, vs1, ks0, ks1; } sr_[ATT_SDEPTH];
  const unsigned vo0 = (unsigned)(sr * LDK + sc) * 2u, vo1 = (unsigned)((32 + sr) * LDK + sc) * 2u;
  const long vdelta = (const char*)Vh - (const char*)Kh;
#define SLOAD(i, k0) do { const char* kb_ = (const char*)Kh + (size_t)(k0) * (LDK * 2); const char* vb_ = kb_ + vdelta; \
    sr_[i].vs0 = *reinterpret_cast<const bf16x8*>(vb_ + vo0); sr_[i].vs1 = *reinterpret_cast<const bf16x8*>(vb_ + vo1); \
    sr_[i].ks0 = *reinterpret_cast<const bf16x8*>(kb_ + vo0); sr_[i].ks1 = *reinterpret_cast<const bf16x8*>(kb_ + vo1); } while (0)
#define SWRITE(b, i) do { *(bf16x8*)((char*)V_lds + (b) * SHM_V + vst0) = sr_[i].vs0;          \
    *(bf16x8*)((char*)V_lds + (b) * SHM_V + vst1) = sr_[i].vs1; int kc = sc * 2;               \
    *(bf16x8*)((char*)K_lds + (b) * SHM_K + KSWZ(sr, kc)) = sr_[i].ks0;                       \
    *(bf16x8*)((char*)K_lds + (b) * SHM_K + KSWZ(32 + sr, kc)) = sr_[i].ks1; } while (0)
#define SWAIT() do { if constexpr (ATT_SDEPTH == 2) asm volatile("s_waitcnt vmcnt(4)" ::: "memory"); else asm volatile("s_waitcnt vmcnt(0)" ::: "memory"); } while (0)
#define RESC(a) do { if (__any((a) < 1.f)) { if (hi == 0) al_l[r32] = (a); asm volatile("s_waitcnt lgkmcnt(0)" ::: "memory"); \
    _Pragma("unroll") for (int d = 0; d < 4; ++d) _Pragma("unroll") for (int r = 0; r < 16; ++r) o[d][r] *= al_l[crow(r, hi)]; } } while (0)
  f32x16 pA0, pA1, pB0, pB1; float mnA, mnB, alA, alB; bf16x8 pa0, pa1, pa2, pa3; const int NT = seq / KVBLK;
  constexpr int SE = 0, SO = ATT_SDEPTH - 1;
  SLOAD(SE, 0); asm volatile("s_waitcnt vmcnt(0)" ::: "memory"); SWRITE(0, SE); __syncthreads();
  qkt(pA0, pA1, K_lds, qr, r32, hi); partialSM(pA0, pA1, m_reg, mnA, alA);
  SLOAD(SO, KVBLK); if constexpr (ATT_SDEPTH == 2) { if (2 < NT) SLOAD(SE, 2 * KVBLK); }
  SWAIT(); SWRITE(1, SO); __syncthreads();
  for (int j = 1; j + 1 < NT; j += 2) {
    SBAR(); qkt(pB0, pB1, (bf16_t*)((char*)K_lds + SHM_K), qr, r32, hi);
    finishSM(pA0, pA1, alA, l_reg, pa0, pa1, pa2, pa3); SBAR();
    SLOAD(SO, (j + ATT_SDEPTH) * KVBLK); SBAR();
    pv_d0(o, vb0, pa0, pa1, pa2, pa3); partialSM(pB0, pB1, m_reg, mnB, alB);
    __syncthreads(); SWAIT(); SWRITE(0, SE);
    RESC(alB); __syncthreads();
    SBAR(); qkt(pA0, pA1, K_lds, qr, r32, hi);
    finishSM(pB0, pB1, alB, l_reg, pa0, pa1, pa2, pa3); SBAR();
    if (ATT_SDEPTH == 1 || j + 3 < NT) SLOAD(SE, (j + 1 + ATT_SDEPTH) * KVBLK); SBAR();
    pv_d0(o, vb0 + (int)SHM_V, pa0, pa1, pa2, pa3); partialSM(pA0, pA1, m_reg, mnA, alA);
    __syncthreads(); SWAIT(); SWRITE(1, SO);
    RESC(alA); __syncthreads();
  }
  SBAR(); qkt(pB0, pB1, (bf16_t*)((char*)K_lds + SHM_K), qr, r32, hi);
  finishSM(pA0, pA1, alA, l_reg, pa0, pa1, pa2, pa3); SBAR();
  pv_d0(o, vb0, pa0, pa1, pa2, pa3); partialSM(pB0, pB1, m_reg, mnB, alB);
  __syncthreads(); RESC(alB);
  finishSM(pB0, pB1, alB, l_reg, pa0, pa1, pa2, pa3); SBAR();
  pv_d0(o, vb0 + (int)SHM_V, pa0, pa1, pa2, pa3);
  if (hi == 0) li_l[r32] = l_reg; asm volatile("s_waitcnt lgkmcnt(0)" ::: "memory");
  float rli[16];
#pragma unroll
  for (int r = 0; r < 16; ++r) rli[r] = __builtin_amdgcn_rcpf(li_l[crow(r, hi)]);
  bf16_t* Ow = Ob + (long)(wid * QBLK) * LDO;
#pragma unroll
  for (int r = 0; r < 16; ++r) { int orow = crow(r, hi);
#pragma unroll
    for (int d0 = 0; d0 < 4; ++d0) Ow[(long)orow * LDO + d0 * 32 + r32] = (bf16_t)f2bf(o[d0][r] * rli[r]); }
#undef SLOAD
#undef SWRITE
#undef SWAIT
#undef RESC
}
}

#define XB_TMO      128
#define XB_XCNT(j)  (256  + 64 * (j))
#define XB_XSUB(j)  (1280 + 64 * (j))
#define XB_XGEN(j)  (2304 + 64 * (j))
#define XB_TOP      3328
#define XB_TOPGEN   3392
#define XB_SPIN_CAP (1u << 22)
__device__ __forceinline__ unsigned xb_ld(unsigned* p)              { return __hip_atomic_load(p, __ATOMIC_RELAXED, __HIP_MEMORY_SCOPE_AGENT); }
__device__ __forceinline__ unsigned xb_add(unsigned* p, unsigned v) { return __hip_atomic_fetch_add(p, v, __ATOMIC_RELAXED, __HIP_MEMORY_SCOPE_AGENT); }
__device__ __forceinline__ unsigned xb_xcc_id() { return (unsigned)__builtin_amdgcn_s_getreg((3 << 11) | 20) & 0xFu; }
#define XB_SPIN(cond, bar) do { unsigned _sp = 0; while (cond) { __builtin_amdgcn_s_sleep(1); \
    if ((++_sp & 255u) == 0u) { if (xb_ld(&(bar)[XB_TMO])) break; if (_sp > XB_SPIN_CAP) { atomicAdd(&(bar)[XB_TMO], 1u); break; } } } } while (0)
struct XcdBarrier { unsigned* bar; unsigned x; volatile LAS unsigned* st; };
__device__ __forceinline__ XcdBarrier xcd_barrier_post(unsigned* bar, volatile LAS unsigned* st) {
    XcdBarrier b; b.bar = bar; b.x = xb_xcc_id(); b.st = st;
    if (threadIdx.x == 0) (void)xb_add(&bar[XB_XCNT(b.x)], 1u);
    return b;
}
__device__ __forceinline__ void xcd_barrier_complete(unsigned* bar, unsigned x, unsigned& nloc, unsigned& nx) {
    const unsigned G = gridDim.x * gridDim.y * gridDim.z;
    unsigned sum, cnt, mine, sp = 0u;
    for (;;) {
        sum = 0u; cnt = 0u; mine = 0u;
#pragma unroll
        for (unsigned j = 0; j < 16; ++j) { const unsigned c = xb_ld(&bar[XB_XCNT(j)]); sum += c; cnt += (c > 0u) ? 1u : 0u; mine = (j == x) ? c : mine; }
        if (sum == G) break;
        __builtin_amdgcn_s_sleep(1);
        if ((++sp & 255u) == 0u) { if (xb_ld(&bar[XB_TMO])) break; if (sp > XB_SPIN_CAP) { atomicAdd(&bar[XB_TMO], 1u); break; } }
    }
    nloc = mine > 0u ? mine : 1u; nx = cnt > 0u ? cnt : 1u;
}
__device__ __forceinline__ void xcd_barrier(const XcdBarrier& b_) {
    XcdBarrier b; b.bar = b_.bar; b.st = b_.st; b.x = xb_xcc_id();
    asm volatile("s_waitcnt vmcnt(0)" ::: "memory");
    __syncthreads();
    if (threadIdx.x == 0) {
        unsigned* bar = b.bar;
        __builtin_amdgcn_s_waitcnt(0);
        unsigned nloc = b.st[0], nx = b.st[1];
        if (nloc == 0u) { xcd_barrier_complete(bar, b.x, nloc, nx); b.st[0] = nloc; b.st[1] = nx; }
        const unsigned old = xb_add(&bar[XB_XSUB(b.x)], 1u);
        const unsigned gen = old / nloc;
        if (old + 1u == (gen + 1u) * nloc) {
            __builtin_amdgcn_fence(__ATOMIC_RELEASE, "agent");
            asm volatile("s_waitcnt vmcnt(0)" ::: "memory");
            const unsigned og = xb_add(&bar[XB_TOP], 1u);
            const unsigned tg = og / nx;
            if (og + 1u == (tg + 1u) * nx) xb_add(&bar[XB_TOPGEN], 1u);
            else XB_SPIN(xb_ld(&bar[XB_TOPGEN]) == tg, bar);
            __builtin_amdgcn_fence(__ATOMIC_ACQUIRE, "agent");
            xb_add(&bar[XB_XGEN(b.x)], 1u);
            asm volatile("s_waitcnt vmcnt(0)" ::: "memory");
        } else {
            XB_SPIN(xb_ld(&bar[XB_XGEN(b.x)]) == gen, bar);
            __builtin_amdgcn_fence(__ATOMIC_ACQUIRE, "agent");
            asm volatile("s_waitcnt vmcnt(0)" ::: "memory");
        }
    }
    __syncthreads();
}

struct Args { const float* in[34]; float* out; uchar* ws; int ph_lo, ph_hi; };
enum { I_X = 0, I_C, I_CTX, I_CCTX, I_ADAW, I_ADAB, I_NMG, I_NFG, I_RGWIN, I_RGCW, I_RGCB, I_RGWA, I_RGBA, I_RGWI, I_RGBI, I_RGLAM, I_RGWOUT,
       I_ATQKV, I_ATQG, I_ATKG, I_ATWO, I_CMWIN, I_CMLNG, I_CMLNB, I_CMWS, I_CMBS, I_CMWOUT, I_MWG, I_MBG, I_MWR, I_MBR, I_MWGATE, I_MWUP, I_MWDOWN };

__device__ __forceinline__ const void* opaque_uniform_ptr(const void* p) { const unsigned long long v = (unsigned long long)p; unsigned lo = (unsigned)v, hi = (unsigned)(v >> 32); asm volatile("" : "+v"(lo), "+v"(hi));
    lo = __builtin_amdgcn_readfirstlane(lo); hi = __builtin_amdgcn_readfirstlane(hi); return (const void*)(const GAS char*)(((unsigned long long)hi << 32) | lo); }
__device__ __forceinline__ int opaque_uniform_int(int x) { asm volatile("" : "+v"(x)); return __builtin_amdgcn_readfirstlane(x); }
struct Frame {
    LAS uchar* lds; char* ldsg;
    int tid, lane, wave, G, bid;
    uchar* ws; float* out;
};
__device__ __forceinline__ const float* inp(const Frame& F, int i) { const unsigned long long v = *(const LAS unsigned long long*)(F.lds + LDSCTL_OFF + 576 + i * 8);
    const unsigned lo = __builtin_amdgcn_readfirstlane((unsigned)v), hi = __builtin_amdgcn_readfirstlane((unsigned)(v >> 32)); return (const float*)(const GAS float*)(((unsigned long long)hi << 32) | lo); }
__device__ __forceinline__ float wave16_sum(float v) {
    v += __int_as_float(__builtin_amdgcn_update_dpp(0, __float_as_int(v), 0xB1, 0xF, 0xF, true));
    v += __int_as_float(__builtin_amdgcn_update_dpp(0, __float_as_int(v), 0x4E, 0xF, 0xF, true));
    v += __int_as_float(__builtin_amdgcn_update_dpp(0, __float_as_int(v), 0x141, 0xF, 0xF, true));
    v += __int_as_float(__builtin_amdgcn_update_dpp(0, __float_as_int(v), 0x140, 0xF, 0xF, true));
    return v; }

struct ConvItem { const float* src; uchar* dst; int ldw; bool f8; };
__device__ __forceinline__ void tr_load(const ConvItem& ci, f32x4 (&v)[16]) {
    if (ci.f8) {
#pragma unroll
        for (int i = 0; i < 8; ++i) { v[2 * i] = __builtin_nontemporal_load((const f32x4*)(ci.src + (size_t)(8 * i) * ci.ldw)); v[2 * i + 1] = __builtin_nontemporal_load((const f32x4*)(ci.src + (size_t)(8 * i + 1) * ci.ldw)); }
    } else {
#pragma unroll
        for (int i = 0; i < 16; ++i) v[i] = __builtin_nontemporal_load((const f32x4*)(ci.src + (size_t)(4 * i) * ci.ldw));
    }
}
__device__ __forceinline__ void tr_finish(const f32x4 (&v)[16], const ConvItem& ci, LAS uchar* scr, int lane) {
    const int kr = lane >> 4, nc = (lane & 15) * 4;
    const int g = lane >> 4, q = (lane >> 2) & 3, p = lane & 3;
    const int vb = (int)(uintptr_t)scr + q * 128 + g * 32 + p * 8;
    if (ci.f8) {
#pragma unroll
        for (int i = 0; i < 8; ++i) { const f32x4 a = v[2 * i] * 32.f, b = v[2 * i + 1] * 32.f;
            int r0 = __builtin_amdgcn_cvt_pk_fp8_f32(a.x, b.x, 0, false); r0 = __builtin_amdgcn_cvt_pk_fp8_f32(a.y, b.y, r0, true);
            int r1 = __builtin_amdgcn_cvt_pk_fp8_f32(a.z, b.z, 0, false); r1 = __builtin_amdgcn_cvt_pk_fp8_f32(a.w, b.w, r1, true);
            *(LAS u32x2*)(scr + (4 * i + kr) * 128 + nc * 2) = (u32x2){(unsigned)r0, (unsigned)r1}; }
        asm volatile("s_waitcnt lgkmcnt(0)" ::: "memory");
        s16x4 t[8];
#define TRR(r) t[r] = att::tr_read<(r) * 512>(vb)
        TRR(0); TRR(1); TRR(2); TRR(3); TRR(4); TRR(5); TRR(6); TRR(7);
#undef TRR
        asm volatile("s_waitcnt lgkmcnt(0)" ::: "memory"); __builtin_amdgcn_sched_barrier(0);
#pragma unroll
        for (int j = 0; j < 4; ++j) { const bf16x8 o = {t[2 * j][0], t[2 * j][1], t[2 * j][2], t[2 * j][3], t[2 * j + 1][0], t[2 * j + 1][1], t[2 * j + 1][2], t[2 * j + 1][3]}; *(bf16x8*)(ci.dst + 16 * j) = o; }
    } else {
#pragma unroll
        for (int i = 0; i < 16; ++i) { u32x2 o; o.x = pk2(v[i].x, v[i].y); o.y = pk2(v[i].z, v[i].w); *(LAS u32x2*)(scr + (4 * i + kr) * 128 + nc * 2) = o; }
        asm volatile("s_waitcnt lgkmcnt(0)" ::: "memory");
        s16x4 t[16];
#define TRR(r) t[r] = att::tr_read<(r) * 512>(vb)
        TRR(0); TRR(1); TRR(2); TRR(3); TRR(4); TRR(5); TRR(6); TRR(7); TRR(8); TRR(9); TRR(10); TRR(11); TRR(12); TRR(13); TRR(14); TRR(15);
#undef TRR
        asm volatile("s_waitcnt lgkmcnt(0)" ::: "memory"); __builtin_amdgcn_sched_barrier(0);
#pragma unroll
        for (int j = 0; j < 8; ++j) { const bf16x8 o = {t[2 * j][0], t[2 * j][1], t[2 * j][2], t[2 * j][3], t[2 * j + 1][0], t[2 * j + 1][1], t[2 * j + 1][2], t[2 * j + 1][3]}; *(bf16x8*)(ci.dst + 16 * j) = o; }
    }
}
struct Job { int g, lo, hi; };
__device__ __forceinline__ ConvItem conv_decode(Frame& F, int g, int it) {
    uchar* ws = F.ws; const float* W; int K = 1024, N = 1024, ldt = 1024, mode = 0; size_t dms = 0; bf16_t* WT;
    switch (g) {
        case 0:  W = inp(F, I_MWGATE); N = 512; WT = (bf16_t*)(ws + WS_W_E1); dms = (size_t)1024 * 1024; mode = 1; break;
        case 1:  W = inp(F, I_MWUP);   N = 512; WT = (bf16_t*)(ws + WS_W_E1); dms = (size_t)1024 * 1024; mode = 2; break;
        case 2:  W = inp(F, I_MWDOWN); K = 512; WT = (bf16_t*)(ws + WS_W_E2); ldt = 512; dms = (size_t)1024 * 512; break;
        case 3:  W = inp(F, I_RGWIN);  N = 2048; WT = (bf16_t*)(ws + WS_W_RGIN); dms = (size_t)2048 * 1024; break;
        case 4:  W = inp(F, I_CMWIN);  N = 4096; WT = (bf16_t*)(ws + WS_W_CMIN); break;
        case 5:  W = inp(F, I_RGWOUT); WT = (bf16_t*)(ws + WS_W_RGOUT); dms = (size_t)1024 * 1024; break;
        case 6:  W = inp(F, I_CMWOUT); K = 2048; WT = (bf16_t*)(ws + WS_W_CMOUT); ldt = 2048; break;
        case 7:  W = inp(F, I_ATQKV);  N = 1536; WT = (bf16_t*)(ws + WS_W_QKV); break;
        case 8:  W = inp(F, I_ATWO);   WT = (bf16_t*)(ws + WS_W_AO); break;
        case 9:  W = inp(F, I_RGWA);   K = 128; N = 128; WT = (bf16_t*)(ws + WS_W_RGG); ldt = 128; dms = (size_t)256 * 128; break;
        default: W = inp(F, I_RGWI);   K = 128; N = 128; WT = (bf16_t*)(ws + WS_W_RGG); ldt = 128; dms = (size_t)256 * 128; mode = 3; break;
    }
    const int nblk = N / 64, per = (K / 64) * nblk, mat = it / per, r = it - mat * per, kb = r / nblk, nb = r - kb * nblk, n0 = nb * 64;
    int drow = n0;
    if (mode == 1) drow = (n0 >> 7) * 256 + (n0 & 127); else if (mode == 2) drow = (n0 >> 7) * 256 + 128 + (n0 & 127); else if (mode == 3) drow = 128 + n0;
    const int lane = F.lane;
    const bool f8 = (MOE_FP8 != 0) && g < 3; const int eb = f8 ? 1 : 2;
    ConvItem ci; ci.ldw = N; ci.f8 = f8; ci.src = W + (size_t)mat * K * N + (size_t)(kb * 64 + (f8 ? 2 : 1) * (lane >> 4)) * N + n0 + (lane & 15) * 4;
    ci.dst = (uchar*)WT + ((size_t)mat * dms + (size_t)(drow + (lane >> 4) * 16 + (lane & 15)) * ldt + kb * 64) * eb;
    return ci;
}
template <int NJ>
__device__ __forceinline__ ConvItem conv_find(Frame& F, int v, const Job (&jobs)[NJ]) { int r = v, g = jobs[0].g, it = 0; bool found = false;
#pragma unroll
    for (int q = 0; q < NJ; ++q) { const int n = jobs[q].hi - jobs[q].lo; if (!found) { if (r < n) { g = jobs[q].g; it = jobs[q].lo + r; found = true; } else r -= n; } }
    return conv_decode(F, g, it); }
template <int NJ>
__device__ __forceinline__ void conv_tail(Frame& F, int nblk0, const Job (&jobs)[NJ]) {
    if (nblk0 >= F.G) nblk0 = 0;
    if (F.bid < nblk0) return;
    LAS uchar* scr = F.lds + F.wave * 8192;
    int total = 0;
#pragma unroll
    for (int q = 0; q < NJ; ++q) total += jobs[q].hi - jobs[q].lo;
    const int nw = (F.G - nblk0) * 8;
    int v0 = (F.bid - nblk0) * 8 + F.wave;
    f32x4 va[16], vb[16]; ConvItem c0, c1; c0.dst = nullptr; c1.dst = nullptr; c0.f8 = false; c1.f8 = false; c0.src = nullptr; c1.src = nullptr; c0.ldw = 0; c1.ldw = 0;
    if (v0 < total) { c0 = conv_find(F, v0, jobs); tr_load(c0, va); }
    for (; v0 < total; v0 += 2 * nw) {
        const int v1 = v0 + nw, v2 = v1 + nw;
        if (v1 < total) { c1 = conv_find(F, v1, jobs); tr_load(c1, vb); }
        tr_finish(va, c0, scr, F.lane);
        if (v2 < total) { c0 = conv_find(F, v2, jobs); tr_load(c0, va); }
        if (v1 < total) tr_finish(vb, c1, scr, F.lane);
    }
}
__device__ __forceinline__ void p0_prologue(Frame& F) {
    uchar* ws = F.ws;
    {
        LAS float* act = (LAS float*)(F.lds);
        LAS float* red = (LAS float*)(F.lds + 5 * 1024 * 4);
        bool have = false; const float* pC = inp(F, I_C); const float* pCC = inp(F, I_CCTX); const float* pADAW = inp(F, I_ADAW); const float* pADAB = inp(F, I_ADAB);
        for (int it = F.bid; it < DEPTH * 24; it += F.G) {
            if (!have) { for (int i = F.tid; i < 5 * 1024; i += 512) { const int s = i >> 10, k = i & 1023; const float v = s < 4 ? pC[s * 1024 + k] : pCC[k]; act[i] = v / (1.f + __expf(-v)); } have = true; __syncthreads(); }
            const int l = it / 24, cb = it % 24;
            const float* W = pADAW + (size_t)l * 1024 * NMODV + cb * 256 + F.lane * 4;
            f32x4 a[5];
#pragma unroll
            for (int s = 0; s < 5; ++s) a[s] = (f32x4){0.f, 0.f, 0.f, 0.f};
            const int kbase = F.wave * 128;
#pragma unroll 8
            for (int k = 0; k < 128; ++k) { const f32x4 w = *(const f32x4*)(W + (size_t)(kbase + k) * NMODV);
#pragma unroll
                for (int s = 0; s < 5; ++s) a[s] += w * act[s * 1024 + kbase + k]; }
#pragma unroll
            for (int s = 0; s < 5; ++s) *(LAS f32x4*)(red + (F.wave * 5 + s) * 256 + F.lane * 4) = a[s];
            __syncthreads();
            for (int i = F.tid; i < 5 * 256; i += 512) { const int s = i >> 8, c = i & 255; float v = pADAB[l * NMODV + cb * 256 + c];
#pragma unroll
                for (int w = 0; w < 8; ++w) v += red[(w * 5 + s) * 256 + c];
                ((float*)(ws + WS_MOD))[(l * 5 + s) * NMODV + cb * 256 + c] = v; }
            __syncthreads();
        }
        __syncthreads();
    }
    { const Job jobsA[8] = {{3, 0, 1024}, {4, 0, 1024}, {5, 0, 512}, {6, 0, 512}, {7, 0, 384}, {8, 0, 256}, {9, 0, 128}, {10, 0, 128}}; conv_tail(F, DEPTH * 24, jobsA);
      const Job jobsB[3] = {{0, 0, 16384}, {1, 0, 16384}, {2, 0, 16384}}; conv_tail(F, 0, jobsB); }
    {
        const int gt = F.bid * 512 + F.tid, NGT = F.G * 512;
        for (int i = gt; i < 8 * 128 * 128 / 4; i += NGT) { const f32x4 v = ((const f32x4*)inp(F, I_CMWS))[i]; u32x2 o; o.x = pk2(v.x, v.y); o.y = pk2(v.z, v.w); ((u32x2*)(ws + WS_W_CMS))[i] = o; }
        for (int i = gt; i < 2 * 2 * D; i += NGT) { const float* plam = inp(F, I_RGLAM); ((float*)(ws + WS_SPL))[i] = -8.f * log1pf(expf(-plam[i])); }
        for (int i = gt; i < 64 * 32; i += NGT) { const int pos = i >> 5, f = i & 31; const float inv = powf(10000.f, -(float)f * 2.0f / 64.0f); const float ang = (float)pos * inv;
            ((f32x2*)(ws + WS_ROPE))[i] = (f32x2){cosf(ang), sinf(ang)}; }
    }
}

__device__ __forceinline__ void router_fill(Frame& F, int l) {
    LAS float* wr = (LAS float*)F.lds;
    const float* wg = inp(F, I_MWG) + (size_t)l * 1024 * 4; const float* wrt = inp(F, I_MWR) + (size_t)l * 1024 * 32;
    __syncthreads();
    for (int i0 = F.tid; i0 < 1024 * 9; i0 += 512 * 6) { f32x4 v[6];
#pragma unroll
        for (int u = 0; u < 6; ++u) { const int idx = i0 + u * 512; const int k = idx / 9, q = idx - k * 9; v[u] = q == 0 ? *(const f32x4*)(wg + k * 4) : *(const f32x4*)(wrt + k * 32 + (q - 1) * 4); }
#pragma unroll
        for (int u = 0; u < 6; ++u) { const int idx = i0 + u * 512; const int k = idx / 9, q = idx - k * 9;
            wr[(4 * q + 0) * 1024 + k] = v[u].x; wr[(4 * q + 1) * 1024 + k] = v[u].y; wr[(4 * q + 2) * 1024 + k] = v[u].z; wr[(4 * q + 3) * 1024 + k] = v[u].w; } }
    __syncthreads();
}
template <bool ROUTE, int NADD, bool SRCIN>
__device__ __forceinline__ void norm_phase(Frame& F, int l, const float* gvec, int shift_i, bool skip_ctx_route, bool dry) {
    uchar* ws = F.ws;
    float* X = (float*)(ws + WS_X); const bf16_t* YS = (const bf16_t*)(ws + WS_Y1); const bf16_t* YM = (const bf16_t*)(ws + WS_YM); bf16_t* H = (bf16_t*)(ws + WS_H);
    const float* MOD = (const float*)(ws + WS_MOD) + (size_t)l * 5 * NMODV;
    LAS float* wr = (LAS float*)F.lds;
    const int i16 = F.lane & 15, grp = F.lane >> 4;
    const float* bg = nullptr; const float* br = nullptr; if constexpr (ROUTE) { bg = inp(F, I_MBG) + l * 4; br = inp(F, I_MBR) + l * 32; }
    const float* pctx = nullptr; const float* px = nullptr; if constexpr (SRCIN) { pctx = inp(F, I_CTX); px = inp(F, I_X); }
    for (int tok = (F.bid * 8 + F.wave) * 4 + grp; tok < T; tok += F.G * 32) {
        asm volatile("" ::: "memory");
        const int sidx = sidx_of_row(tok);
        f32x4 x[16];
        float ss = 0.f;
        const float* xrow = X + (size_t)tok * D;
        if constexpr (SRCIN) { const int b_ = tok / SB, s_ = tok - b_ * SB; xrow = s_ < CTX ? pctx + ((size_t)(b_ * CTX + s_) << 10) : px + ((size_t)(b_ * SEQ + s_ - CTX) << 10); }
#pragma unroll
        for (int j = 0; j < 16; ++j) { x[j] = *(const f32x4*)(xrow + 64 * j + 4 * i16);
            if constexpr (NADD >= 1) { const u32x2 ym = *(const u32x2*)(YM + (size_t)tok * D + 64 * j + 4 * i16); x[j] += (f32x4){bflo(ym.x), bfhi(ym.x), bflo(ym.y), bfhi(ym.y)}; }
            if constexpr (NADD == 3) { const u32x2 y0 = *(const u32x2*)(YS + (size_t)tok * D + 64 * j + 4 * i16), y1 = *(const u32x2*)(YS + ((size_t)T + tok) * D + 64 * j + 4 * i16);
                const f32x4 g5 = *(const f32x4*)(MOD - (size_t)5 * NMODV + (size_t)sidx * NMODV + 5 * D + 64 * j + 4 * i16);
                x[j] += g5 * (f32x4){bflo(y0.x) + bflo(y1.x), bfhi(y0.x) + bfhi(y1.x), bflo(y0.y) + bflo(y1.y), bfhi(y0.y) + bfhi(y1.y)}; *(f32x4*)(X + (size_t)tok * D + 64 * j + 4 * i16) = x[j]; }
            ss += x[j].x * x[j].x + x[j].y * x[j].y + x[j].z * x[j].z + x[j].w * x[j].w; }
        ss = wave16_sum(ss);
        const float rstd = rsqrtf(ss * (1.f / D) + NORM_EPS);
        const float* shp = MOD + (size_t)sidx * NMODV + shift_i * D; const float* scp = shp + D;
#pragma unroll
        for (int j = 0; j < 16; ++j) { const int c = 64 * j + 4 * i16; const f32x4 g = *(const f32x4*)(gvec + c), sh = *(const f32x4*)(shp + c), sc = *(const f32x4*)(scp + c);
            x[j] = x[j] * rstd * g * (sc + 1.f) + sh;
            if constexpr (ROUTE && MOE_FP8) { int r8 = __builtin_amdgcn_cvt_pk_fp8_f32(x[j].x, x[j].y, 0, false); r8 = __builtin_amdgcn_cvt_pk_fp8_f32(x[j].z, x[j].w, r8, true); *(int*)((uchar*)H + (size_t)tok * D + c) = r8; }
            else { u32x2 o; o.x = pk2(x[j].x, x[j].y); o.y = pk2(x[j].z, x[j].w); *(u32x2*)(H + (size_t)tok * D + c) = o; } }
        if constexpr (ROUTE) {
            LAS float* lgs = (LAS float*)(F.lds + LDSCTL_OFF + 1024) + (F.wave * 4 + grp) * 40;
#pragma unroll 1
            for (int o = 0; o < 36; ++o) { f32x4 v0 = {0.f, 0.f, 0.f, 0.f}, v1 = {0.f, 0.f, 0.f, 0.f};
#pragma unroll
                for (int j = 0; j < 16; j += 2) { const f32x4 w0 = *(const LAS f32x4*)(wr + o * 1024 + 64 * j + 4 * i16), w1 = *(const LAS f32x4*)(wr + o * 1024 + 64 * j + 64 + 4 * i16);
                    v0 += x[j] * w0; v1 += x[j + 1] * w1; }
                v0 += v1; float a0 = wave16_sum((v0.x + v0.y) + (v0.z + v0.w)); if (i16 == 0) lgs[o] = a0; }
            asm volatile("s_waitcnt lgkmcnt(0)" ::: "memory");
            const float gl0 = lgs[0] + bg[0], gl1 = lgs[1] + bg[1], gl2 = lgs[2] + bg[2], gl3 = lgs[3] + bg[3];
            int gs = 0; float gm = gl0;
            if (gl1 > gm) { gm = gl1; gs = 1; }
            if (gl2 > gm) { gm = gl2; gs = 2; }
            if (gl3 > gm) { gm = gl3; gs = 3; }
            const float den = __expf(gl0 - gm) + __expf(gl1 - gm) + __expf(gl2 - gm) + __expf(gl3 - gm);
            const float pg = 1.f / den;
            float el[8];
#pragma unroll
            for (int e = 0; e < 8; ++e) el[e] = lgs[4 + gs * 8 + e] + br[gs * 8 + e];
            int i0 = 0; float v0 = el[0];
#pragma unroll
            for (int e = 1; e < 8; ++e) if (el[e] > v0) { v0 = el[e]; i0 = e; }
            int i1 = -1; float v1 = -3.0e38f;
#pragma unroll
            for (int e = 0; e < 8; ++e) if (e != i0 && el[e] > v1) { v1 = el[e]; i1 = e; }
            const float p0 = 1.f / (1.f + __expf(v1 - v0));
            const float w0 = p0 * pg, w1 = (1.f - p0) * pg;
            const bool do_route = !(skip_ctx_route && sidx == 4) && !dry;
            if (i16 == 0 && do_route) {
                const int e0 = gs * 8 + i0, e1 = gs * 8 + i1;
                unsigned* cnt = (unsigned*)(ws + WS_CTL) + CW_CNT + l * 32 * 64;
                const unsigned q0 = atomicAdd(cnt + e0 * 64, 1u), q1 = atomicAdd(cnt + e1 * 64, 1u);
                u32x2* BK = (u32x2*)(ws + WS_BK2);
                BK[(size_t)e0 * T + q0] = (u32x2){(unsigned)(tok * 2), __float_as_uint(w0)}; BK[(size_t)e1 * T + q1] = (u32x2){(unsigned)(tok * 2 + 1), __float_as_uint(w1)};
            }
        }
    }
}

__device__ __forceinline__ void st8(bf16_t* p, f32x4 v0, f32x4 v1) { u32x4 w; w.x = cvt_pk_bf16(v0[0], v0[1]); w.y = cvt_pk_bf16(v0[2], v0[3]); w.z = cvt_pk_bf16(v1[0], v1[1]); w.w = cvt_pk_bf16(v1[2], v1[3]); *(u32x4*)p = w; }
#define EPI_ROWS(ai, m) (u.pm * 256 + (ai) * 128 + wr * 64 + (m) * 16 + fr)

struct EpiRgIn { static constexpr bool PERM = true, FP8 = false, PREFETCH = false; bf16_t* GG; bf16_t* XB;
    __device__ __forceinline__ void operator()(const f32x4 (&acc)[2][2][4][2], const pg8::Unit& u, int wr, int wc, int fr, int fq) const {
        const bool isg = u.pn < 4; bf16_t* base = isg ? GG : XB; const int ct = (u.pn & 3) * 256 + wc * 32 + 8 * fq;
#pragma unroll
        for (int ai = 0; ai < 2; ++ai)
#pragma unroll
            for (int m = 0; m < 4; ++m) { if (!((u.hm >> (2 * ai)) & 1)) continue; bf16_t* rowp = base + (size_t)EPI_ROWS(ai, m) * D + ct;
#pragma unroll
                for (int bj = 0; bj < 2; ++bj) { f32x4 v0 = acc[ai][bj][m][0], v1 = acc[ai][bj][m][1];
                    if (isg) {
#pragma unroll
                        for (int e = 0; e < 4; ++e) { v0[e] = gelu_tanh(v0[e]); v1[e] = gelu_tanh(v1[e]); } }
                    st8(rowp + bj * 128, v0, v1); } }
    } };
struct EpiBf16 { static constexpr bool PERM = true, FP8 = false, PREFETCH = false; bf16_t* O; int ldc;
    __device__ __forceinline__ void operator()(const f32x4 (&acc)[2][2][4][2], const pg8::Unit& u, int wr, int wc, int fr, int fq) const {
        const int ct = u.pn * 256 + wc * 32 + 8 * fq;
#pragma unroll
        for (int ai = 0; ai < 2; ++ai)
#pragma unroll
            for (int m = 0; m < 4; ++m) { if (!((u.hm >> (2 * ai)) & 1)) continue; bf16_t* rowp = O + (size_t)EPI_ROWS(ai, m) * ldc + ct;
#pragma unroll
                for (int bj = 0; bj < 2; ++bj) st8(rowp + bj * 128, acc[ai][bj][m][0], acc[ai][bj][m][1]); }
    } };
struct EpiCmIn { static constexpr bool PERM = true, FP8 = false, PREFETCH = false; bf16_t* O; f32x2* statp;
    __device__ __forceinline__ void operator()(const f32x4 (&acc)[2][2][4][2], const pg8::Unit& u, int wr, int wc, int fr, int fq) const {
        const int ct = u.pn * 256 + wc * 32 + 8 * fq; const bool isv = u.pn >= 8;
#pragma unroll
        for (int ai = 0; ai < 2; ++ai)
#pragma unroll
            for (int m = 0; m < 4; ++m) { if (!((u.hm >> (2 * ai)) & 1)) continue; const int row = EPI_ROWS(ai, m); bf16_t* rowp = O + (size_t)row * 4096 + ct; float s = 0.f, q = 0.f;
#pragma unroll
                for (int bj = 0; bj < 2; ++bj) { f32x4 v0 = acc[ai][bj][m][0], v1 = acc[ai][bj][m][1];
#pragma unroll
                    for (int e = 0; e < 4; ++e) { v0[e] = gelu_tanh(v0[e]); v1[e] = gelu_tanh(v1[e]); }
                    u32x4 w; w.x = cvt_pk_bf16(v0[0], v0[1]); w.y = cvt_pk_bf16(v0[2], v0[3]); w.z = cvt_pk_bf16(v1[0], v1[1]); w.w = cvt_pk_bf16(v1[2], v1[3]);
                    *(u32x4*)(rowp + bj * 128) = w;
                    const float r0 = bflo(w.x), r1 = bfhi(w.x), r2 = bflo(w.y), r3 = bfhi(w.y), r4 = bflo(w.z), r5 = bfhi(w.z), r6 = bflo(w.w), r7 = bfhi(w.w);
                    s += ((r0 + r1) + (r2 + r3)) + ((r4 + r5) + (r6 + r7)); q += ((r0 * r0 + r1 * r1) + (r2 * r2 + r3 * r3)) + ((r4 * r4 + r5 * r5) + (r6 * r6 + r7 * r7)); }
                if (isv) { s += __shfl_xor(s, 16); s += __shfl_xor(s, 32); q += __shfl_xor(q, 16); q += __shfl_xor(q, 32);
                    if (fq == 0) statp[(size_t)row * 32 + (u.pn - 8) * 4 + wc] = (f32x2){s, q}; } }
    } };
struct EpiResid { static constexpr bool PERM = true, FP8 = false, PREFETCH = false; bf16_t* YM; const float* gate  ;
    __device__ __forceinline__ void operator()(const f32x4 (&acc)[2][2][4][2], const pg8::Unit& u, int wr, int wc, int fr, int fq) const {
        const int sidx = sidx_of_row(u.pm * 256); const float* gp = gate + (size_t)sidx * NMODV; const int ct = u.pn * 256 + wc * 32 + 8 * fq;
        f32x4 gv[2][2];
#pragma unroll
        for (int bj = 0; bj < 2; ++bj)
#pragma unroll
            for (int n = 0; n < 2; ++n) gv[bj][n] = *(const f32x4*)(gp + ct + bj * 128 + n * 4);
#pragma unroll
        for (int ai = 0; ai < 2; ++ai)
#pragma unroll
            for (int m = 0; m < 4; ++m) { if (!((u.hm >> (2 * ai)) & 1)) continue; bf16_t* rowp = YM + (size_t)EPI_ROWS(ai, m) * D + ct;
#pragma unroll
                for (int bj = 0; bj < 2; ++bj) st8(rowp + bj * 128, gv[bj][0] * acc[ai][bj][m][0], gv[bj][1] * acc[ai][bj][m][1]); }
    } };
struct EpiRgGate { static constexpr bool PERM = true, FP8 = false, PREFETCH = false; const bf16_t* XC; bf16_t* LA; bf16_t* BB; const float* ba; const float* bi; const float* lam;
    __device__ __forceinline__ void operator()(const f32x4 (&acc)[2][2][4][2], const pg8::Unit& u, int wr, int wc, int fr, int fq) const {
        const int d = u.pn >> 3, blk = u.pn & 7;
        asm volatile("" : "+v"(fr), "+v"(fq));
#pragma unroll
        for (int n = 0; n < 2; ++n) { const int ch = blk * 128 + wc * 32 + 8 * fq + 4 * n;
            const f32x4 bav = *(const f32x4*)(ba + d * D + ch), biv = *(const f32x4*)(bi + d * D + ch), spv = *(const f32x4*)(lam + d * D + ch);
#pragma unroll
            for (int ai = 0; ai < 2; ++ai)
#pragma unroll
                for (int m = 0; m < 4; ++m) { if (!((u.hm >> (2 * ai)) & 1)) continue; const size_t off = (size_t)EPI_ROWS(ai, m) * D + ch;
                    const u32x2 xw = *(const u32x2*)(XC + off);
                    const f32x4 xc = {bflo(xw.x), bfhi(xw.x), bflo(xw.y), bfhi(xw.y)};
                    f32x4 la, bb;
#pragma unroll
                    for (int e = 0; e < 4; ++e) { const float r = fast_sigmoid(acc[ai][0][m][n][e] + bav[e]), ig = fast_sigmoid(acc[ai][1][m][n][e] + biv[e]);
                        const float lga = r * spv[e]; la[e] = lga; bb[e] = __builtin_amdgcn_sqrtf(one_minus_exp(-2.f * lga)) * ig * xc[e]; }
                    u32x2 w; w.x = cvt_pk_bf16(la[0], la[1]); w.y = cvt_pk_bf16(la[2], la[3]);
                    *(u32x2*)(LA + (size_t)d * T * D + off) = w;
                    w.x = cvt_pk_bf16(bb[0], bb[1]); w.y = cvt_pk_bf16(bb[2], bb[3]);
                    *(u32x2*)(BB + (size_t)d * T * D + off) = w; __builtin_amdgcn_sched_barrier(0); }
            asm volatile("" ::: "memory"); }
    } };

template <bool G1>
struct MoeOrder {
    static constexpr bool GATHER = G1;
    const LAS int* tab; const char* A; const char* B; const int* BK; int G, c, nunits; size_t bstride; int arow, brow;
    __device__ bool next(int i, pg8::Unit& u) const {
        int L, hm; if (!pg8::unit_slot(i, c, G, nunits, L, hm)) return false; u.hm = __builtin_amdgcn_readfirstlane(hm);
        const int wgid = __builtin_amdgcn_readfirstlane(pg8::xcd_remap(L, nunits)); const int tau = wgid >> 2, pn = wgid & 3;
        int e = 0;
#pragma unroll 1
        for (int k = 1; k < 32; ++k) e = (tab[k] <= tau) ? k : e;
        e = __builtin_amdgcn_readfirstlane(e);
        u.pm = tau; u.pn = pn; u.aux0 = e; u.aux1 = __builtin_amdgcn_readfirstlane((tau - tab[e]) * 256);
        u.a = pg8::uptr(G1 ? A : A + (size_t)tau * 256 * arow);
        u.b = pg8::uptr(B + (size_t)e * bstride + (size_t)pn * 256 * brow);
        return true; }
    __device__ unsigned goff(const pg8::Unit& u, int row) const {
        const int pos = u.aux1 + row; const int cnt = tab[40 + u.aux0];
        int tok = 0; if (pos < cnt) tok = __builtin_nontemporal_load(BK + ((size_t)u.aux0 * T + pos) * 2) >> 1;
        return (unsigned)tok * (unsigned)arow; }
};
struct EpiMoe1 { static constexpr bool PERM = true, FP8 = (MOE_FP8 != 0), PREFETCH = false; uchar* H1;
    __device__ __forceinline__ void operator()(const f32x4 (&acc)[2][2][4][2], const pg8::Unit& u, int wr, int wc, int fr, int fq) const {
        const int ct = u.pn * 128 + wc * 32 + 8 * fq;
#pragma unroll
        for (int ai = 0; ai < 2; ++ai)
#pragma unroll
            for (int m = 0; m < 4; ++m) { if (!((u.hm >> (2 * ai)) & 1)) continue; f32x4 h0, h1;
#pragma unroll
                for (int e = 0; e < 4; ++e) { constexpr float WS_ = FP8 ? (1.f / 32.f) : 1.f;
                    const float g0 = acc[ai][0][m][0][e] * WS_, g1 = acc[ai][0][m][1][e] * WS_; h0[e] = g0 * sigmoidf_(g0) * (acc[ai][1][m][0][e] * WS_); h1[e] = g1 * sigmoidf_(g1) * (acc[ai][1][m][1][e] * WS_); }
                if constexpr (FP8) { int r0 = __builtin_amdgcn_cvt_pk_fp8_f32(h0[0], h0[1], 0, false); r0 = __builtin_amdgcn_cvt_pk_fp8_f32(h0[2], h0[3], r0, true);
                    int r1 = __builtin_amdgcn_cvt_pk_fp8_f32(h1[0], h1[1], 0, false); r1 = __builtin_amdgcn_cvt_pk_fp8_f32(h1[2], h1[3], r1, true);
                    *(u32x2*)(H1 + (size_t)EPI_ROWS(ai, m) * DEXP + ct) = (u32x2){(unsigned)r0, (unsigned)r1}; }
                else st8((bf16_t*)H1 + (size_t)EPI_ROWS(ai, m) * DEXP + ct, h0, h1); }
    } };
struct EpiMoe2 { static constexpr bool PERM = true, FP8 = (MOE_FP8 != 0), PREFETCH = true; bf16_t* YS; const int* BK; const LAS int* tab;
    typedef int pre_t __attribute__((ext_vector_type(16)));
    __device__ __forceinline__ pre_t prefetch(const pg8::Unit& u, int wr, int fr) const { pre_t p; const int cnt = tab[40 + u.aux0];
#pragma unroll
        for (int r = 0; r < 8; ++r) { const int pos = u.aux1 + (r >> 2) * 128 + wr * 64 + (r & 3) * 16 + fr; u32x2 v = {0xffffffffu, 0u}; if (pos < cnt) v = __builtin_nontemporal_load((const u32x2*)BK + (size_t)u.aux0 * T + pos); p[2 * r] = (int)v.x; p[2 * r + 1] = (int)v.y; }
        return p; }
    __device__ __forceinline__ void operator()(const f32x4 (&acc)[2][2][4][2], const pg8::Unit& u, int wr, int wc, int fr, int fq, const pre_t& pre) const {
        const int ct = u.pn * 256 + wc * 32 + 8 * fq;
#pragma unroll
        for (int r = 0; r < 8; ++r) { const int e_ = pre[2 * r];
            if (e_ >= 0 && ((u.hm >> (2 * (r >> 2))) & 1)) { const int tok = e_ >> 1, slot = e_ & 1; const float w = __int_as_float(pre[2 * r + 1]) * (FP8 ? (1.f / 32.f) : 1.f);
                bf16_t* yp = YS + ((size_t)slot * T + tok) * D + ct;
#pragma unroll
                for (int bj = 0; bj < 2; ++bj) st8(yp + bj * 128, acc[r >> 2][bj][r & 3][0] * w, acc[r >> 2][bj][r & 3][1] * w); } }
    } };
__device__ __forceinline__ int moe_table(Frame& F, int l, LAS int* tab) {
    __syncthreads();
    if (F.tid < 32) { const unsigned c = __hip_atomic_load((unsigned*)(F.ws + WS_CTL) + CW_CNT + (l * 32 + F.tid) * 64, RLX_AGENT); tab[40 + F.tid] = (int)c; }
    __syncthreads();
    if (F.tid == 0) { int s = 0;
#pragma unroll 1
        for (int e = 0; e < 32; ++e) { tab[e] = s; s += (tab[40 + e] + 255) >> 8; } tab[32] = s; }
    __syncthreads();
    return tab[32];
}

__device__ __forceinline__ void conv_phase(Frame& F, int j) {
    const bf16_t* XB = (const bf16_t*)(F.ws + WS_XB); bf16_t* XC = (bf16_t*)(F.ws + WS_XC);
    const float* cw = inp(F, I_RGCW) + (size_t)j * 4 * D; const float* cb = inp(F, I_RGCB) + (size_t)j * D;
    const int NGT = F.G * 512;
    for (int i0 = F.bid * 512 + F.tid; i0 < T * 128; i0 += 2 * NGT) {
        u32x4 xw[2][4];
#pragma unroll
        for (int q = 0; q < 2; ++q) { const int i = i0 + q * NGT; const int row = i >> 7, c = (i & 127) * 8; const int b = row / SB, s = row - b * SB; const int lo = s < CTX ? 0 : CTX, hi = s < CTX ? CTX : SB;
#pragma unroll
            for (int k = 0; k < 4; ++k) { const int ss = s + k - 2; xw[q][k] = (u32x4){0u, 0u, 0u, 0u}; if (i < T * 128 && ss >= lo && ss < hi) xw[q][k] = *(const u32x4*)(XB + (size_t)(b * SB + ss) * D + c); } }
#pragma unroll
        for (int q = 0; q < 2; ++q) { const int i = i0 + q * NGT; if (i < T * 128) { const int row = i >> 7, c = (i & 127) * 8;
            float a[8];
#pragma unroll
            for (int e = 0; e < 8; ++e) a[e] = cb[c + e];
#pragma unroll
            for (int k = 0; k < 4; ++k) { const f32x4 w0 = *(const f32x4*)(cw + k * D + c), w1 = *(const f32x4*)(cw + k * D + c + 4); const u32x4 x = xw[q][k];
                a[0] += w0.x * bflo(x.x); a[1] += w0.y * bfhi(x.x); a[2] += w0.z * bflo(x.y); a[3] += w0.w * bfhi(x.y);
                a[4] += w1.x * bflo(x.z); a[5] += w1.y * bfhi(x.z); a[6] += w1.z * bflo(x.w); a[7] += w1.w * bfhi(x.w); }
            u32x4 o; o.x = pk2(a[0], a[1]); o.y = pk2(a[2], a[3]); o.z = pk2(a[4], a[5]); o.w = pk2(a[6], a[7]);
            *(u32x4*)(XC + (size_t)row * D + c) = o; } }
    }
}
__device__ __forceinline__ void scan1_phase(Frame& F) {
    const bf16_t* LA = (const bf16_t*)(F.ws + WS_LA); const bf16_t* BB = (const bf16_t*)(F.ws + WS_BB); float* TS = (float*)(F.ws + WS_TOTS); float* TH = (float*)(F.ws + WS_TOTH);
    for (int it = F.bid * 8 + F.wave; it < NB * 2 * NCH * 4; it += F.G * 8) {
        const int cg = it & 3, rest = it >> 2, ck = rest % NCH, bd = rest / NCH, dir = bd & 1, b = bd >> 1;
        const int c = cg * 256 + F.lane * 4; const size_t base = (size_t)dir * T * D + (size_t)(b * SB + ck * 16) * D + c;
        u32x2 la[16], bb[16];
#pragma unroll
        for (int t = 0; t < 16; ++t) { const size_t o = base + (size_t)(dir ? 15 - t : t) * D; la[t] = *(const u32x2*)(LA + o); bb[t] = *(const u32x2*)(BB + o); }
        f32x4 sl = {0.f, 0.f, 0.f, 0.f}, h = {0.f, 0.f, 0.f, 0.f};
#pragma unroll
        for (int t = 0; t < 16; ++t) { const f32x4 l4 = {bflo(la[t].x), bfhi(la[t].x), bflo(la[t].y), bfhi(la[t].y)}, b4 = {bflo(bb[t].x), bfhi(bb[t].x), bflo(bb[t].y), bfhi(bb[t].y)};
            sl += l4; f32x4 a4 = {__expf(l4.x), __expf(l4.y), __expf(l4.z), __expf(l4.w)}; h = a4 * h + b4; }
        const size_t o = (size_t)(bd * NCH + ck) * D + c; *(f32x4*)(TS + o) = sl; *(f32x4*)(TH + o) = h;
    }
}
__device__ __forceinline__ void scan2_phase(Frame& F) {
    const float* TS = (const float*)(F.ws + WS_TOTS); const float* TH = (const float*)(F.ws + WS_TOTH); float* CY = (float*)(F.ws + WS_CARRY);
    LAS float* wt = (LAS float*)F.lds;
    for (int it = F.bid; it < NB * 2 * 16; it += F.G) {
        const int cg = it & 15, bd = it >> 4, dir = bd & 1; const int c = cg * 64 + F.lane; const size_t base = (size_t)bd * NCH * D + c;
        const int s0 = F.wave * 34;
        float P = 0.f, H = 0.f;
#pragma unroll 1
        for (int sb = 0; sb < 34; sb += 17) { float sl[17], hl[17];
#pragma unroll
            for (int q = 0; q < 17; ++q) { const int s = s0 + sb + q; const int ck = dir ? (s < 16 ? 15 - s : NCH + 15 - s) : s; sl[q] = TS[base + (size_t)ck * D]; hl[q] = TH[base + (size_t)ck * D]; }
#pragma unroll
            for (int q = 0; q < 17; ++q) { P += sl[q]; H = __expf(sl[q]) * H + hl[q]; } }
        __syncthreads();
        wt[(F.wave * 2 + 0) * 64 + F.lane] = P; wt[(F.wave * 2 + 1) * 64 + F.lane] = H;
        __syncthreads();
        float h = 0.f;
        for (int w = 0; w < F.wave; ++w) h = __expf(wt[(w * 2 + 0) * 64 + F.lane]) * h + wt[(w * 2 + 1) * 64 + F.lane];
#pragma unroll 1
        for (int sb = 0; sb < 34; sb += 17) { float sl[17], hl[17]; int ckk[17];
#pragma unroll
            for (int q = 0; q < 17; ++q) { const int s = s0 + sb + q; ckk[q] = dir ? (s < 16 ? 15 - s : NCH + 15 - s) : s; sl[q] = TS[base + (size_t)ckk[q] * D]; hl[q] = TH[base + (size_t)ckk[q] * D]; }
#pragma unroll
            for (int q = 0; q < 17; ++q) { CY[base + (size_t)ckk[q] * D] = h; h = __expf(sl[q]) * h + hl[q]; } }
    }
    __syncthreads();
}
__device__ __forceinline__ void scan3_phase(Frame& F) {
    const bf16_t* LA = (const bf16_t*)(F.ws + WS_LA); const bf16_t* BB = (const bf16_t*)(F.ws + WS_BB); const float* CY = (const float*)(F.ws + WS_CARRY);
    const bf16_t* GG = (const bf16_t*)(F.ws + WS_GG); bf16_t* SA = (bf16_t*)(F.ws + WS_SA);
    LAS f32x4* hb = (LAS f32x4*)(F.lds + F.wave * 16384);
    for (int it = F.bid * 8 + F.wave; it < NB * NCH * 4; it += F.G * 8) {
        const int cg = it & 3, rest = it >> 2, ck = rest % NCH, b = rest / NCH;
        const int c = cg * 256 + F.lane * 4;
        const size_t rbase = (size_t)(b * SB + ck * 16) * D + c, b1 = (size_t)T * D + rbase;
        f32x4 hbk = *(const f32x4*)(CY + (size_t)((b * 2 + 1) * NCH + ck) * D + c), hf = *(const f32x4*)(CY + (size_t)((b * 2 + 0) * NCH + ck) * D + c);
        { u32x2 la[16], bb[16];
#pragma unroll
          for (int t = 0; t < 16; ++t) { la[t] = *(const u32x2*)(LA + b1 + (size_t)(15 - t) * D); bb[t] = *(const u32x2*)(BB + b1 + (size_t)(15 - t) * D); }
#pragma unroll
          for (int t = 0; t < 16; ++t) { const f32x4 l4 = {bflo(la[t].x), bfhi(la[t].x), bflo(la[t].y), bfhi(la[t].y)}, b4 = {bflo(bb[t].x), bfhi(bb[t].x), bflo(bb[t].y), bfhi(bb[t].y)};
              const f32x4 a4 = {__expf(l4.x), __expf(l4.y), __expf(l4.z), __expf(l4.w)}; hbk = a4 * hbk + b4; hb[(15 - t) * 64 + F.lane] = hbk; } }
        { u32x2 la[16], bb[16], gg[16];
#pragma unroll
          for (int t = 0; t < 16; ++t) { la[t] = *(const u32x2*)(LA + rbase + (size_t)t * D); bb[t] = *(const u32x2*)(BB + rbase + (size_t)t * D); gg[t] = *(const u32x2*)(GG + rbase + (size_t)t * D); }
#pragma unroll
          for (int t = 0; t < 16; ++t) { const f32x4 l4 = {bflo(la[t].x), bfhi(la[t].x), bflo(la[t].y), bfhi(la[t].y)}, b4 = {bflo(bb[t].x), bfhi(bb[t].x), bflo(bb[t].y), bfhi(bb[t].y)};
              const f32x4 g4 = {bflo(gg[t].x), bfhi(gg[t].x), bflo(gg[t].y), bfhi(gg[t].y)};
              const f32x4 a4 = {__expf(l4.x), __expf(l4.y), __expf(l4.z), __expf(l4.w)}; hf = a4 * hf + b4; const f32x4 y = g4 * (hf + hb[t * 64 + F.lane]);
              u32x2 o; o.x = pk2(y.x, y.y); o.y = pk2(y.z, y.w); *(u32x2*)(SA + rbase + (size_t)t * D) = o; } }
    }
}

__device__ __forceinline__ void qknorm_phase(Frame& F) {
    bf16_t* QKV = (bf16_t*)(F.ws + WS_QKV); const f32x2* ROPE = (const f32x2*)(F.ws + WS_ROPE);
    const int i16 = F.lane & 15, grp = F.lane >> 4; const float* pqg = inp(F, I_ATQG); const float* pkg = inp(F, I_ATKG);
    const int ITS = F.G * 32;
    for (int it0 = (F.bid * 8 + F.wave) * 4 + grp; it0 < T * 10; it0 += 4 * ITS) {
        u32x4 xw4[4];
#pragma unroll
        for (int q = 0; q < 4; ++q) { const int it = it0 + q * ITS; xw4[q] = (u32x4){0u, 0u, 0u, 0u}; if (it < T * 10) { const int row = it / 10, hh = it - row * 10; xw4[q] = *(const u32x4*)(QKV + (size_t)row * 1536 + hh * 128 + i16 * 8); } }
#pragma unroll
        for (int q = 0; q < 4; ++q) { const int it = it0 + q * ITS; const bool valid = it < T * 10; const int itc = valid ? it : 0;
            const int row = itc / 10, hh = itc - row * 10; const int b = row / SB, s = row - b * SB;
            bf16_t* p = QKV + (size_t)row * 1536 + hh * 128 + i16 * 8;
            const u32x4 xw = xw4[q];
            float x[8] = {bflo(xw.x), bfhi(xw.x), bflo(xw.y), bfhi(xw.y), bflo(xw.z), bfhi(xw.z), bflo(xw.w), bfhi(xw.w)};
            float ss = 0.f;
#pragma unroll
            for (int e = 0; e < 8; ++e) ss += x[e] * x[e];
            ss = wave16_sum(ss);
            const float rstd = rsqrtf(ss * (1.f / 128.f) + NORM_EPS);
            const float* g = (hh < 8 ? pqg : pkg) + i16 * 8;
#pragma unroll
            for (int e = 0; e < 8; ++e) x[e] = x[e] * rstd * g[e];
            float y[8];
#pragma unroll
            for (int e = 0; e < 8; ++e) y[e] = __shfl_xor(x[e], 4);
            if (s >= CTX) { const int t = s - CTX; const int pos = (i16 >> 3) ? (t & 63) : (t >> 6); const bool half1 = (i16 >> 2) & 1;
#pragma unroll
                for (int e = 0; e < 8; ++e) { const f32x2 cs = ROPE[pos * 32 + (i16 & 3) * 8 + e];
                    x[e] = half1 ? (x[e] * cs.x + y[e] * cs.y) : (x[e] * cs.x - y[e] * cs.y); } }
            u32x4 o; o.x = pk2(x[0], x[1]); o.y = pk2(x[2], x[3]); o.z = pk2(x[4], x[5]); o.w = pk2(x[6], x[7]);
            if (valid) *(u32x4*)p = o;
        }
    }
}
__device__ __forceinline__ void attn_phase(Frame& F) {
    const bf16_t* QKV = (const bf16_t*)(F.ws + WS_QKV); bf16_t* AO = (bf16_t*)(F.ws + WS_AO);
    for (int u = F.bid; u < 544; u += F.G) {
        int b, h, q0, k0, seq;
        if (u < 512) { const int qb = u & 15, hg = (u >> 4) & 3, kvh = (u >> 6) & 1; b = u >> 7; h = kvh * 4 + hg; q0 = b * SB + CTX + qb * 256; k0 = b * SB; seq = SB; }
        else { const int v = u - 512; b = v >> 3; h = v & 7; q0 = b * SB; k0 = b * SB; seq = CTX; }
        const int kvh = h >> 2;
        const bf16_t* Kp = (const bf16_t*)pg8::uptr((const char*)(QKV + (size_t)k0 * 1536 + 1024 + kvh * 128));
        att::attn_dense_body((const bf16_t*)pg8::uptr((const char*)(QKV + (size_t)q0 * 1536 + h * 128)), Kp, Kp + 256, (bf16_t*)pg8::uptr((const char*)(AO + (size_t)q0 * D + h * 128)), seq, F.ldsg, F.tid);
        __syncthreads();
    }
}

__device__ __forceinline__ void spatial_phase(Frame& F) {
    const bf16_t* UVB = (const bf16_t*)(F.ws + WS_UVB); bf16_t* UV = (bf16_t*)(F.ws + WS_UV); const f32x2* statp = (const f32x2*)(F.ws + WS_STATP);
    const bf16_t* Ws = (const bf16_t*)(F.ws + WS_W_CMS); const float* lng = inp(F, I_CMLNG); const float* lnb = inp(F, I_CMLNB); const float* bs = inp(F, I_CMBS);
    LAS uchar* vl = F.lds;
    LAS f32x2* st = (LAS f32x2*)(F.lds + 65536);
    const int tid = F.tid, lane = F.lane, wid = F.wave, r32 = lane & 31, hi = lane >> 5, wm = wid & 3, wn = wid >> 2;
    const int sr = tid >> 4, sc = (tid & 15) * 8;
    for (int u = F.bid; u < 136 * 8; u += F.G) {
        const int chunk = u >> 3, g = u & 7; const int row0 = chunk * 128;
        __syncthreads();
        if (tid < 128) { const f32x2* sp = statp + (size_t)(row0 + tid) * 32; float s = 0.f, q = 0.f;
#pragma unroll 8
            for (int k = 0; k < 32; ++k) { const f32x2 v = sp[k]; s += v.x; q += v.y; }
            const float mean = s * (1.f / 2048.f); const float var = fmaxf(q * (1.f / 2048.f) - mean * mean, 0.f); st[tid] = (f32x2){mean, rsqrtf(var + NORM_EPS)}; }
        __syncthreads();
#pragma unroll
        for (int ch = 0; ch < 2; ++ch) { const int cg = g * 256 + ch * 128 + sc;
            const f32x4 g0 = *(const f32x4*)(lng + cg), g1 = *(const f32x4*)(lng + cg + 4), b0 = *(const f32x4*)(lnb + cg), b1 = *(const f32x4*)(lnb + cg + 4);
#pragma unroll
            for (int i = 0; i < 4; ++i) { const int q = sr + 32 * i; const u32x4 xw = *(const u32x4*)(UVB + (size_t)(row0 + q) * 4096 + 2048 + cg); const f32x2 ms = st[q];
                f32x4 v0 = {bflo(xw.x), bfhi(xw.x), bflo(xw.y), bfhi(xw.y)}, v1 = {bflo(xw.z), bfhi(xw.z), bflo(xw.w), bfhi(xw.w)};
                v0 = (v0 - ms.x) * ms.y * g0 + b0; v1 = (v1 - ms.x) * ms.y * g1 + b1;
                u32x4 o; o.x = pk2(v0.x, v0.y); o.y = pk2(v0.z, v0.w); o.z = pk2(v1.x, v1.y); o.w = pk2(v1.z, v1.w);
                *(LAS u32x4*)(vl + ((q >> 6) * 2 + ch) * 16384 + att::v_st(q & 63, sc)) = o; } }
        bf16x8 pa[2][4];
#pragma unroll
        for (int kt = 0; kt < 2; ++kt)
#pragma unroll
            for (int ks = 0; ks < 4; ++ks) pa[kt][ks] = *(const bf16x8*)(Ws + ((size_t)g * 128 + 32 * wm + r32) * 128 + 64 * kt + 16 * ks + 8 * hi);
        __syncthreads();
        f32x16 o[4] = {};
        const int vb = (int)(uintptr_t)(F.ldsg) + att::v_rd_base(lane) + wn * 16384;
        att::pv_d0(o, vb, pa[0][0], pa[0][1], pa[0][2], pa[0][3]);
        att::pv_d0(o, vb + 32768, pa[1][0], pa[1][1], pa[1][2], pa[1][3]);
        u32x4 uu[8];
#pragma unroll
        for (int i = 0; i < 8; ++i) { const int id = tid + 512 * i, row = id >> 5, ch = id & 31; uu[i] = *(const u32x4*)(UVB + (size_t)(row0 + row) * 4096 + g * 256 + ch * 8); }
        __syncthreads();
#pragma unroll
        for (int r = 0; r < 16; ++r) { const int p = 32 * wm + att::crow(r, hi); const float bsv = bs[g * 128 + p];
#pragma unroll
            for (int d0 = 0; d0 < 4; ++d0) *(LAS bf16_t*)(vl + p * 512 + (128 * wn + 32 * d0 + r32) * 2) = (bf16_t)f2bf(o[d0][r] + bsv); }
        __syncthreads();
#pragma unroll
        for (int i = 0; i < 8; ++i) { const int id = tid + 512 * i, row = id >> 5, ch = id & 31; const u32x4 v = *(const LAS u32x4*)(vl + row * 512 + ch * 16); const u32x4 w = uu[i];
            u32x4 o4; o4.x = pk2(bflo(v.x) * bflo(w.x), bfhi(v.x) * bfhi(w.x)); o4.y = pk2(bflo(v.y) * bflo(w.y), bfhi(v.y) * bfhi(w.y)); o4.z = pk2(bflo(v.z) * bflo(w.z), bfhi(v.z) * bfhi(w.z)); o4.w = pk2(bflo(v.w) * bflo(w.w), bfhi(v.w) * bfhi(w.w));
            *(u32x4*)(UV + (size_t)(row0 + row) * 2048 + g * 256 + ch * 8) = o4; }
    }
    __syncthreads();
}

__device__ __forceinline__ void final_phase(Frame& F) {
    const f32x4* X = (const f32x4*)(F.ws + WS_X); const u32x2* YS = (const u32x2*)(F.ws + WS_Y1); const u32x2* YM = (const u32x2*)(F.ws + WS_YM); f32x4* out = (f32x4*)F.out;
    const f32x4* G5 = (const f32x4*)((const float*)(F.ws + WS_MOD) + (size_t)(DEPTH - 1) * 5 * NMODV + 5 * D);
    const int NGT = F.G * 512;
    for (int i0 = F.bid * 512 + F.tid; i0 < NB * SEQ * 256; i0 += 4 * NGT) { f32x4 a[4]; u32x2 y0[4], y1[4], ym[4];
#pragma unroll
        for (int q = 0; q < 4; ++q) { const int i = i0 + q * NGT; if (i < NB * SEQ * 256) { const int r = i >> 8, c4 = i & 255, b = r >> 12, t = r & 4095; const size_t src = ((size_t)(b * SB + CTX + t) << 8) + c4; a[q] = X[src]; y0[q] = YS[src]; y1[q] = YS[src + (size_t)T * 256]; ym[q] = YM[src]; } }
#pragma unroll
        for (int q = 0; q < 4; ++q) { const int i = i0 + q * NGT; if (i < NB * SEQ * 256) { const int r = i >> 8, c4 = i & 255, b = r >> 12; const f32x4 g5 = G5[(size_t)b * (NMODV / 4) + c4];
            out[i] = a[q] + (f32x4){bflo(ym[q].x), bfhi(ym[q].x), bflo(ym[q].y), bfhi(ym[q].y)} + g5 * (f32x4){bflo(y0[q].x) + bflo(y1[q].x), bfhi(y0[q].x) + bfhi(y1[q].x), bflo(y0[q].y) + bflo(y1[q].y), bfhi(y0[q].y) + bfhi(y1[q].y)}; } } }
}

constexpr int NPHASE = 39;
__global__ void __launch_bounds__(512, 2) mk_fwd(Args args) {
    extern __shared__ __attribute__((aligned(16))) uchar lds[];
    Frame F; F.lds = (LAS uchar*)lds; F.ldsg = (char*)lds; F.tid = threadIdx.x; F.lane = F.tid & 63; F.wave = __builtin_amdgcn_readfirstlane(F.tid >> 6); F.G = gridDim.x; F.bid = blockIdx.x;
    F.ws = args.ws; F.out = args.out;
    uchar* ws0 = args.ws;
    volatile LAS unsigned* MISC = (volatile LAS unsigned*)(F.lds + LDSCTL_OFF);
    LAS int* tab = (LAS int*)(F.lds + LDSCTL_OFF + 256);
    for (int u = F.tid; u < (LDS_BYTES - LDSCTL_OFF) / 4; u += 512) ((LAS unsigned*)(F.lds + LDSCTL_OFF))[u] = 0u;
    __syncthreads();
    if (F.tid == 0) {
#pragma unroll
        for (int i = 0; i < 34; ++i) *(LAS unsigned long long*)(F.lds + LDSCTL_OFF + 576 + i * 8) = (unsigned long long)args.in[i]; }
    __syncthreads();
    const int lo = args.ph_lo, hi = args.ph_hi;
    if (hi - lo > 1) (void)xcd_barrier_post((unsigned*)(ws0 + WS_CTL) + CW_BAR, MISC + 8);
    int ph = 0;
#define PH_BEGIN if (ph >= opaque_uniform_int(args.ph_lo) && ph < opaque_uniform_int(args.ph_hi)) { int t_ = threadIdx.x; F.G = opaque_uniform_int(gridDim.x); F.bid = opaque_uniform_int(blockIdx.x); const int cid = F.bid; (void)cid; \
        F.out = (float*)opaque_uniform_ptr(args.out); F.lds = (LAS uchar*)lds; F.ldsg = (char*)lds; \
        asm volatile("" : "+v"(t_)); F.tid = t_; F.lane = t_ & 63; F.wave = __builtin_amdgcn_readfirstlane(t_ >> 6); \
        uchar* ws = (uchar*)opaque_uniform_ptr(args.ws); F.ws = ws; \
        const float* MODl = (const float*)(ws + WS_MOD) + (size_t)l_ * 5 * NMODV; (void)MODl;
#define GRIDBAR  { XcdBarrier bb_; bb_.bar = (unsigned*)(ws + WS_CTL) + CW_BAR; bb_.x = 0; bb_.st = (volatile LAS unsigned*)(F.lds + LDSCTL_OFF) + 8; xcd_barrier(bb_); }
#define REPBAR   if (rep_ > 1) GRIDBAR
#define PH_END   if (ph + 1 < opaque_uniform_int(args.ph_hi)) GRIDBAR } ++ph;

    { const int l_ = 0; PH_BEGIN PM(0) { const bool dry = rep_ > 1; (void)dry;  p0_prologue(F);  REPBAR } PH_END }

#pragma unroll 1
    for (int l = 0; l < DEPTH; ++l) {
        const int kind = l % 3, j = l / 3; const bool lastl = (l == DEPTH - 1); const int l_ = l;
        PH_BEGIN PM(1) { const bool dry = rep_ > 1; (void)dry;  const float* gv_ = inp(F, I_NMG) + l * D;
            if (l == 0) norm_phase<false, 0, true>(F, l, gv_, 0, false, false);
            else if (rep_ != REPN(1)) norm_phase<false, 0, false>(F, l, gv_, 0, false, false);
            else if (l == 1) norm_phase<false, 3, true>(F, l, gv_, 0, false, false);
            else norm_phase<false, 3, false>(F, l, gv_, 0, false, false);  REPBAR } PH_END
        if (kind == 0) {
            PH_BEGIN PM(2) { const bool dry = rep_ > 1; (void)dry;  { pg8::DenseOrder S; S.init(ws + WS_H, D, ws + WS_W_RGIN + (size_t)j * 2048 * 1024 * 2, D, T, 2048, F.G, cid);
                EpiRgIn E{(bf16_t*)(ws + WS_GG), (bf16_t*)(ws + WS_XB)}; pg8::gemm_phase(F.lds, S, E, D, D, D); }  REPBAR } PH_END
            PH_BEGIN PM(3) { const bool dry = rep_ > 1; (void)dry;  conv_phase(F, j);  REPBAR } PH_END
            PH_BEGIN PM(4) { const bool dry = rep_ > 1; (void)dry;  { pg8::DenseOrder S; S.init(ws + WS_XC, D, ws + WS_W_RGG + (size_t)j * 16 * 256 * 128 * 2, 128, T, 16 * 256, F.G, cid, 7, 256);
                EpiRgGate E{(const bf16_t*)(ws + WS_XC), (bf16_t*)(ws + WS_LA), (bf16_t*)(ws + WS_BB), inp(F, I_RGBA) + (size_t)j * 2 * D, inp(F, I_RGBI) + (size_t)j * 2 * D, (const float*)(ws + WS_SPL) + (size_t)j * 2 * D};
                pg8::gemm_phase(F.lds, S, E, 128, D, 128); }  REPBAR } PH_END
            PH_BEGIN PM(5) { const bool dry = rep_ > 1; (void)dry;  scan1_phase(F);  REPBAR } PH_END
            PH_BEGIN PM(20) { const bool dry = rep_ > 1; (void)dry;  scan2_phase(F);  REPBAR } PH_END
            PH_BEGIN PM(6) { const bool dry = rep_ > 1; (void)dry;  scan3_phase(F);  REPBAR } PH_END
            PH_BEGIN PM(7) { const bool dry = rep_ > 1; (void)dry;  { pg8::DenseOrder S; S.init(ws + WS_SA, D, ws + WS_W_RGOUT + (size_t)j * 1024 * 1024 * 2, D, T, D, F.G, cid);
                EpiResid E{(bf16_t*)(ws + (dry ? WS_Y1 : WS_YM)), MODl + 2 * D}; pg8::gemm_phase(F.lds, S, E, D, D, D); router_fill(F, l); }  REPBAR } PH_END
        } else if (kind == 1) {
            PH_BEGIN PM(8) { const bool dry = rep_ > 1; (void)dry;  { pg8::DenseOrder S; S.init(ws + WS_H, D, ws + WS_W_QKV, D, T, 1536, F.G, cid);
                EpiBf16 E{(bf16_t*)(ws + WS_QKV), 1536}; pg8::gemm_phase(F.lds, S, E, D, D, D); }  REPBAR } PH_END
            PH_BEGIN PM(9) { const bool dry = rep_ > 1; (void)dry;  qknorm_phase(F);  REPBAR } PH_END
            PH_BEGIN PM(10) { const bool dry = rep_ > 1; (void)dry;  attn_phase(F);  REPBAR } PH_END
            PH_BEGIN PM(11) { const bool dry = rep_ > 1; (void)dry;  { pg8::DenseOrder S; S.init(ws + WS_AO, D, ws + WS_W_AO, D, T, D, F.G, cid);
                EpiResid E{(bf16_t*)(ws + (dry ? WS_Y1 : WS_YM)), MODl + 2 * D}; pg8::gemm_phase(F.lds, S, E, D, D, D); router_fill(F, l); }  REPBAR } PH_END
        } else {
            PH_BEGIN PM(12) { const bool dry = rep_ > 1; (void)dry;  { pg8::DenseOrder S; S.init(ws + WS_H, D, ws + WS_W_CMIN, D, T, 4096, F.G, cid);
                EpiCmIn E{(bf16_t*)(ws + WS_UVB), (f32x2*)(ws + WS_STATP)}; pg8::gemm_phase(F.lds, S, E, D, D, D); }  REPBAR } PH_END
            PH_BEGIN PM(13) { const bool dry = rep_ > 1; (void)dry;  spatial_phase(F);  REPBAR } PH_END
            PH_BEGIN PM(14) { const bool dry = rep_ > 1; (void)dry;  { pg8::DenseOrder S; S.init(ws + WS_UV, 2048, ws + WS_W_CMOUT, 2048, T, D, F.G, cid);
                EpiResid E{(bf16_t*)(ws + (dry ? WS_Y1 : WS_YM)), MODl + 2 * D}; pg8::gemm_phase(F.lds, S, E, 2048, 2048, 2048); router_fill(F, l); }  REPBAR } PH_END
        }
        PH_BEGIN PM(15) { const bool dry = rep_ > 1; (void)dry;  if (l == 0) norm_phase<true, 1, true>(F, l, inp(F, I_NFG) + l * D, 3, lastl, dry); else norm_phase<true, 1, false>(F, l, inp(F, I_NFG) + l * D, 3, lastl, dry);  REPBAR } PH_END
        PH_BEGIN PM(16) { const bool dry = rep_ > 1; (void)dry;  { const int ntile = moe_table(F, l, tab);
            const int units = ntile * 4, rounds = (units + F.G - 1) / F.G; int geff = F.G; if (false && rounds > 0) { geff = (((units + rounds - 1) / rounds) + 7) & ~7; if (geff > F.G) geff = F.G; }
            constexpr int EB = MOE_FP8 ? 1 : 2;
            MoeOrder<true> S{tab, (const char*)(ws + WS_H), (const char*)(ws + WS_W_E1 + (size_t)l * 32 * 1024 * 1024 * EB), (const int*)(ws + WS_BK2), geff, cid, units, (size_t)1024 * 1024 * EB, 1024 * EB, 1024 * EB};
            EpiMoe1 E{ws + WS_H1}; pg8::gemm_phase(F.lds, S, E, D * EB / 2, D * EB / 2, D * EB / 2); }  REPBAR } PH_END
        PH_BEGIN PM(17) { const bool dry = rep_ > 1; (void)dry;  { const int ntile = moe_table(F, l, tab);
            const int units = ntile * 4, rounds = (units + F.G - 1) / F.G; int geff = F.G; if (false && rounds > 0) { geff = (((units + rounds - 1) / rounds) + 7) & ~7; if (geff > F.G) geff = F.G; }
            constexpr int EB = MOE_FP8 ? 1 : 2;
            MoeOrder<false> S{tab, (const char*)(ws + WS_H1), (const char*)(ws + WS_W_E2 + (size_t)l * 32 * 1024 * 512 * EB), (const int*)(ws + WS_BK2), geff, cid, units, (size_t)1024 * 512 * EB, 512 * EB, 512 * EB};
            EpiMoe2 E{(bf16_t*)(ws + (dry ? WS_SCR + 64 * MiB : WS_Y1)), (const int*)(ws + WS_BK2), tab}; pg8::gemm_phase(F.lds, S, E, DEXP * EB / 2, DEXP * EB / 2, DEXP * EB / 2); }  REPBAR } PH_END
    }
    { const int l_ = 0; PH_BEGIN PM(18) { const bool dry = rep_ > 1; (void)dry;  final_phase(F);  REPBAR if constexpr (((REP_MASK) >> 19) & 1u) { for (int k_ = 0; k_ < 20; ++k_) GRIDBAR } } PH_END }
#undef PH_BEGIN
#undef PH_END
}

extern "C" void kernel_launch(void* const* d_in, const int* in_sizes, int n_in, void* d_out, int out_size, void* d_ws, size_t ws_size, hipStream_t stream) {
    static int grid = 0;
    if (grid == 0) {
        if (n_in != 34 || out_size != NB * SEQ * D || ws_size < WS_END) { fprintf(stderr, "kernel_launch: bad shapes n_in %d out %d ws %zu (need %zu)\n", n_in, out_size, ws_size, (size_t)WS_END); grid = -1; return; }
        int dev = 0, cus = 0, per_cu = 0;
        if (hipGetDevice(&dev) != hipSuccess || hipDeviceGetAttribute(&cus, hipDeviceAttributeMultiprocessorCount, dev) != hipSuccess) { grid = -1; return; }
        if (hipFuncSetAttribute((const void*)mk_fwd, hipFuncAttributeMaxDynamicSharedMemorySize, LDS_BYTES) != hipSuccess) { fprintf(stderr, "kernel_launch: hipFuncSetAttribute failed\n"); grid = -1; return; }
        if (hipOccupancyMaxActiveBlocksPerMultiprocessor(&per_cu, (const void*)mk_fwd, 512, LDS_BYTES) != hipSuccess || per_cu < 1) { fprintf(stderr, "kernel_launch: occupancy query says %d\n", per_cu); (void)hipGetLastError(); grid = -1; return; }
        grid = cus;
    }
    if (grid < 0) return;
    (void)hipMemsetAsync((char*)d_ws + WS_CTL, 0, CTL_BYTES, stream);
    Args a{};
    for (int i = 0; i < 34; ++i) a.in[i] = (const float*)d_in[i];
    a.out = (float*)d_out; a.ws = (uchar*)d_ws;
#if MK_PER_PHASE
    for (int p = 0; p < NPHASE; ++p) { a.ph_lo = p; a.ph_hi = p + 1; hipLaunchKernelGGL(mk_fwd, dim3(grid), dim3(512), LDS_BYTES, stream, a); }
#else
    a.ph_lo = 0; a.ph_hi = NPHASE;
    void* kargs[] = {&a};
    hipError_t e = hipLaunchCooperativeKernel((const void*)mk_fwd, dim3(grid), dim3(512), kargs, LDS_BYTES, stream);
    if (e != hipSuccess) fprintf(stderr, "kernel_launch: cooperative launch failed: %s (grid %d)\n", hipGetErrorString(e), grid);
#endif
}
```

```cpp
#include <hip/hip_runtime.h>
#include <hip/hip_bf16.h>
#include <cstdio>
#include <cstdint>

#ifndef MOE_FP8
#define MOE_FP8 1
#endif
#ifndef MK_PER_PHASE
#define MK_PER_PHASE 0
#endif

#ifndef PHASE_MASK
#define PHASE_MASK 0xFFFFFFFFu
#endif
#ifndef REP_MASK
#define REP_MASK 0u
#endif
#define REPN(i) ((((REP_MASK) >> (i)) & 1u) ? 2 : 1)
#define PM(i) if constexpr ((PHASE_MASK >> (i)) & 1u) for (int rep_ = REPN(i); rep_ > 0; --rep_)
#define LAS __attribute__((address_space(3)))
#define GAS __attribute__((address_space(1)))
typedef unsigned char uchar;
typedef unsigned short bf16_t;
typedef short bf16x8 __attribute__((ext_vector_type(8)));
typedef short s16x4 __attribute__((ext_vector_type(4)));
typedef float f32x4 __attribute__((ext_vector_type(4)));
typedef float f32x2 __attribute__((ext_vector_type(2)));
typedef float f32x16 __attribute__((ext_vector_type(16)));
typedef unsigned u32x4 __attribute__((ext_vector_type(4)));
typedef unsigned u32x2 __attribute__((ext_vector_type(2)));
typedef GAS unsigned gu32;
#define RLX_AGENT __ATOMIC_RELAXED, __HIP_MEMORY_SCOPE_AGENT

constexpr int D = 1024, NB = 4, SEQ = 4096, CTX = 256, SB = SEQ + CTX, T = NB * SB, DEPTH = 4;
constexpr int NMODV = 6 * D;
constexpr int NEXP = 32, DEXP = 512;
constexpr int NCH = SB / 16;
constexpr float NORM_EPS = 1e-6f;

constexpr size_t MiB = 1u << 20;
constexpr size_t WS_CTL = 0, CTL_BYTES = 1 * MiB;
constexpr size_t WS_MOD = 1 * MiB;
constexpr size_t WS_ROPE = 2 * MiB;
constexpr size_t WS_SPL = 2 * MiB + 65536;
constexpr size_t WS_BK2 = 3 * MiB;
constexpr size_t WS_TOT = 3 * MiB;
constexpr size_t WS_STATP = 8 * MiB;
constexpr size_t WS_BK = 13 * MiB;
constexpr size_t WS_TW = 15 * MiB + 512 * 1024;
constexpr size_t WS_W_RGIN = 16 * MiB, WS_W_RGG = 24 * MiB, WS_W_RGOUT = 26 * MiB, WS_W_QKV = 30 * MiB, WS_W_AO = 33 * MiB;
constexpr size_t WS_W_CMIN = 35 * MiB, WS_W_CMS = 43 * MiB, WS_W_CMOUT = 44 * MiB, WS_W_E1 = 48 * MiB, WS_W_E2 = 304 * MiB;
constexpr size_t WS_X = 432 * MiB, WS_Y1 = 500 * MiB, WS_H = 568 * MiB, WS_SCR = 602 * MiB;
constexpr size_t WS_GG = WS_SCR, WS_XB = WS_SCR + 34 * MiB, WS_XC = WS_SCR + 68 * MiB, WS_LA = WS_SCR + 102 * MiB, WS_BB = WS_SCR + 170 * MiB, WS_SA = WS_SCR + 238 * MiB;
constexpr size_t WS_QKV = WS_SCR, WS_AO = WS_SCR + 51 * MiB;
constexpr size_t WS_UVB = WS_SCR, WS_UV = WS_SCR + 136 * MiB;
constexpr size_t WS_H1 = WS_SCR;
constexpr size_t WS_TOTS = WS_SCR + 272 * MiB, WS_TOTH = WS_TOTS + 9 * MiB, WS_CARRY = WS_TOTH + 9 * MiB;
constexpr size_t WS_YM = WS_CARRY + 9 * MiB;
constexpr size_t WS_END = WS_YM + 34 * MiB;
constexpr int CW_TMO = 0, CW_BAR = 4096, CW_CNT = 16384;

constexpr int RING_BYTES = 131072;
constexpr int ROUTER_LDS = 36 * 1024 * 4;
constexpr int LDSCTL_OFF = 147456;
constexpr int LDS_BYTES = LDSCTL_OFF + 1024 + 8 * 4 * 40 * 4;

__device__ __forceinline__ unsigned f2bf(float f) { unsigned u = __builtin_bit_cast(unsigned, f); return (u + 0x7fffu + ((u >> 16) & 1u)) >> 16; }
__device__ __forceinline__ unsigned pk2(float lo, float hi) { return f2bf(lo) | (f2bf(hi) << 16); }
__device__ __forceinline__ float bf2f(unsigned short h) { return __builtin_bit_cast(float, (unsigned)h << 16); }
__device__ __forceinline__ float bflo(unsigned w) { return __builtin_bit_cast(float, w << 16); }
__device__ __forceinline__ float bfhi(unsigned w) { return __builtin_bit_cast(float, w & 0xffff0000u); }
__device__ __forceinline__ unsigned cvt_pk_bf16(float lo, float hi) { unsigned r; asm volatile("v_cvt_pk_bf16_f32 %0, %1, %2" : "=v"(r) : "v"(lo), "v"(hi)); return r; }
__device__ __forceinline__ float gelu_tanh(float x) { const float u = 0.7978845608028654f * (x + 0.044715f * x * x * x); const float e = __expf(2.f * u); const float t = 1.f - 2.f / (e + 1.f); return 0.5f * x * (1.f + t); }
__device__ __forceinline__ float sigmoidf_(float x) { return 1.f / (1.f + __expf(-x)); }
__device__ __forceinline__ float fast_sigmoid(float x) { return __builtin_amdgcn_rcpf(1.f + __expf(-x)); }
__device__ __forceinline__ float one_minus_exp(float y) {   const float p = y * (1.f - y * (0.5f - y * (0.16666667f - y * 0.041666667f))); const float q = 1.f - __expf(-y); return y < 0.0625f ? p : q; }
__device__ __forceinline__ int sidx_of_row(int row) { const int b = row / SB; return (row - b * SB) < CTX ? 4 : b; }

namespace pg8 {
constexpr int BM = 256, BK = 64, HALF = 128, HTB = HALF * BK * 2, NXCD = 8, WGM = 8;
__device__ __forceinline__ int lds_byte(int r, int c) { const int st = (r >> 4) * 2 + (c >> 5), rr = r & 15, cc = c & 31, ob = rr * 64 + cc * 2; return st * 1024 + (ob ^ (((ob >> 9) & 1) << 5)); }
__device__ __forceinline__ void stage_rc(int b, int& R, int& C) { const int st = b / 1024, sb = b % 1024, swz = sb ^ (((sb >> 9) & 1) << 5); R = (st >> 1) * 16 + swz / 64; C = (st & 1) * 32 + (swz % 64) / 2; }
__device__ __forceinline__ int perm32(int rho) { const int n = rho >> 4, i = rho & 15; return 8 * (i >> 2) + 4 * n + (i & 3); }
struct Unit { const char* a; const char* b; int pm, pn, aux0, aux1, hm; };
__device__ __forceinline__ const char* uptr(const char* p) { const unsigned long long v = (unsigned long long)p; const unsigned lo = __builtin_amdgcn_readfirstlane((unsigned)v), hi = __builtin_amdgcn_readfirstlane((unsigned)(v >> 32)); return (const char*)(const GAS char*)(((unsigned long long)hi << 32) | lo); }
__device__ __forceinline__ bool unit_slot(int i, int c, int G, int nwg, int& L, int& hm) {
    if (c >= G) return false;
    const int nfull = nwg / G, rem = nwg - nfull * G;
    if (i < nfull) { L = i * G + c; hm = 0xF; return true; }
    if (i > nfull || rem == 0) return false;
    if (rem * 2 <= G) { if (c >= 2 * rem) return false; L = nfull * G + (c >> 1); hm = (c & 1) ? 0xC : 0x3; return true; }
    if (c >= rem) return false; L = nfull * G + c; hm = 0xF; return true; }
__device__ __forceinline__ int xcd_remap(int L, int nwg) { const int q = nwg / NXCD, r = nwg % NXCD, xcd = L % NXCD, off = L / NXCD; return (xcd < r ? xcd * (q + 1) : r * (q + 1) + (xcd - r) * q) + off; }

struct DenseOrder {
    static constexpr bool GATHER = false;
    const char* A; const char* B; int nM, nN, nwg, G, c; size_t tA, tB; int amask, acol;
    __device__ void init(const void* A_, int lda, const void* B_, int ldb, int M, int N, int G_, int c_, int amask_ = 0, int acol_ = 0) {
        A = (const char*)A_; B = (const char*)B_; nM = M / BM; nN = N / BM; nwg = nM * nN; G = G_; c = c_; tA = (size_t)BM * lda * 2; tB = (size_t)BM * ldb * 2; amask = amask_; acol = acol_; }
    __device__ bool next(int i, Unit& u) const {
        int L, hm; if (!unit_slot(i, c, G, nwg, L, hm)) return false; u.hm = __builtin_amdgcn_readfirstlane(hm);
        const int wgid = xcd_remap(L, nwg);
        const int nig = WGM * nN, gid = wgid / nig, fm = gid * WGM, gsz = (nM - fm) < WGM ? (nM - fm) : WGM;
        u.pm = __builtin_amdgcn_readfirstlane(fm + ((wgid % nig) % gsz)); u.pn = __builtin_amdgcn_readfirstlane((wgid % nig) / gsz); u.aux0 = 0; u.aux1 = 0;
        u.a = uptr(A + (size_t)u.pm * tA + (size_t)(u.pn & amask) * acol); u.b = uptr(B + (size_t)u.pn * tB); return true; }
    __device__ unsigned goff(const Unit&, int) const { return 0u; }
};

#define PG8_SA(b, h) (((b) * 2 + (h)) * HTB)
#define PG8_SB(b, h) ((4 + (b) * 2 + (h)) * HTB)
__device__ __forceinline__ void glds16(const char* sbase, unsigned voff, unsigned ldsaddr) { unsigned keep;
    asm volatile("s_mov_b32 %0, m0\n\ts_mov_b32 m0, %3\n\ts_nop 0\n\tglobal_load_lds_dwordx4 %1, %2\n\ts_mov_b32 m0, %0" : "=&s"(keep) : "v"(voff), "s"(sbase), "s"(ldsaddr) : "memory"); }
#ifndef PG8_ASM_DMA
#define PG8_ASM_DMA 1
#endif
#if PG8_ASM_DMA
#define PG8_GLDS(gp, voff, ldsoff) glds16((const char*)(gp), (voff), ldsbase + (unsigned)(ldsoff))
#else
#define PG8_GLDS(gp, voff, ldsoff) __builtin_amdgcn_global_load_lds((const unsigned*)((const char*)(gp) + (voff)), (LAS unsigned*)(lds + (ldsoff)), 16, 0, 0)
#endif
#define PG8_STAGE_B(bufoff, gbase) do { PG8_GLDS(gbase, voffB[0], (bufoff) + ldsw); PG8_GLDS(gbase, voffB[1], (bufoff) + ldsw + 8192); } while (0)
#define PG8_STAGE_A(bufoff, gbase, h, NX) do { if constexpr (Sched::GATHER) { \
        PG8_GLDS(gbase, ((NX) ? vAn[h][0] : vAc[h][0]), (bufoff) + ldsw); PG8_GLDS(gbase, ((NX) ? vAn[h][1] : vAc[h][1]), (bufoff) + ldsw + 8192); \
    } else { PG8_GLDS((const char*)(gbase) + (h) * hstepA, voffA[0], (bufoff) + ldsw); PG8_GLDS((const char*)(gbase) + (h) * hstepA, voffA[1], (bufoff) + ldsw + 8192); } } while (0)
#define PG8_LDA(dst, b, h) do { _Pragma("unroll") for (int m = 0; m < 4; ++m) _Pragma("unroll") for (int k = 0; k < 2; ++k) dst[m][k] = *(const LAS bf16x8*)(lds + PG8_SA(b, h) + aoff + m * 2048 + k * 1024); } while (0)
#define PG8_LDB(dst, b, h) do { _Pragma("unroll") for (int n = 0; n < 2; ++n) _Pragma("unroll") for (int k = 0; k < 2; ++k) dst[n][k] = *(const LAS bf16x8*)(lds + PG8_SB(b, h) + boff + n * 2048 + k * 1024); } while (0)
typedef int i32x8 __attribute__((ext_vector_type(8))); typedef int i32x4v __attribute__((ext_vector_type(4)));
__device__ __forceinline__ i32x8 cat8(bf16x8 lo, bf16x8 hi) { return __builtin_shufflevector(__builtin_bit_cast(i32x4v, lo), __builtin_bit_cast(i32x4v, hi), 0, 1, 2, 3, 4, 5, 6, 7); }
#define PG8_MMA(ai, bj, At, Bt) do { __builtin_amdgcn_s_setprio(1); _Pragma("unroll") for (int m = 0; m < 4; ++m) _Pragma("unroll") for (int n = 0; n < 2; ++n) { \
        if constexpr (Epi::FP8) { asm volatile("v_mfma_scale_f32_16x16x128_f8f6f4 %0, %1, %2, %0, %3, %3 op_sel_hi:[0,0,0]" : "+v"(acc[ai][bj][m][n]) : "v"(cat8(Bt[n][0], Bt[n][1])), "v"(cat8(At[m][0], At[m][1])), "v"(0x7F7F7F7F)); } \
        else { _Pragma("unroll") for (int k = 0; k < 2; ++k) acc[ai][bj][m][n] = __builtin_amdgcn_mfma_f32_16x16x32_bf16(Bt[n][k], At[m][k], acc[ai][bj][m][n], 0, 0, 0); } } __builtin_amdgcn_s_setprio(0); } while (0)
#define PG8_WAIT_V(n) asm volatile("s_waitcnt vmcnt(" #n ")" ::: "memory")
#define PG8_WAIT_L(n) asm volatile("s_waitcnt lgkmcnt(" #n ")" ::: "memory")
#define PG8_BAR __builtin_amdgcn_s_barrier()
#define PG8_SCHED __builtin_amdgcn_sched_barrier(0)

template <class Epi, class Sched>
__device__ __forceinline__ void gemm_phase(LAS uchar* lds, const Sched& S, const Epi& E, const int K, const int lda, const int ldb) {
    int tid = threadIdx.x; asm volatile("" : "+v"(tid));
    const int wid = __builtin_amdgcn_readfirstlane(tid >> 6), lane = tid & 63, wr = wid >> 2, wc = wid & 3; int fr = lane & 15, fq = lane >> 4;
    int nt = K / BK; asm volatile("" : "+s"(nt));
    unsigned voffA[2], voffB[2];
#pragma unroll
    for (int i = 0; i < 2; ++i) { int R, C; stage_rc(tid * 16 + i * 8192, R, C); const int Rb = Epi::PERM ? ((R & ~31) + perm32(R & 31)) : R;
        voffA[i] = (unsigned)(R * lda + C) * 2u; voffB[i] = (unsigned)(Rb * ldb + C) * 2u; }
    const size_t kstep = (size_t)(BK * 2);
    const size_t hstepA = (size_t)HALF * lda * 2, hstepB = (size_t)HALF * ldb * 2;
    const unsigned ldsw = (unsigned)wid * 1024u;
    const unsigned ldsbase = (unsigned)(uintptr_t)lds;
    const int aoff = lds_byte(wr * 64 + fr, fq * 8), boff = lds_byte(wc * 32 + fr, fq * 8);
    Unit cur, nxt; int ui = 0;
    if (!S.next(0, cur)) return;
    unsigned vAc[2][2], vAn[2][2];
#pragma unroll
    for (int h = 0; h < 2; ++h)
#pragma unroll
        for (int i = 0; i < 2; ++i) { vAc[h][i] = 0u; vAn[h][i] = 0u; }
    if constexpr (Sched::GATHER) {
#pragma unroll
        for (int h = 0; h < 2; ++h)
#pragma unroll
            for (int i = 0; i < 2; ++i) { int R, C; stage_rc(tid * 16 + i * 8192, R, C); vAc[h][i] = S.goff(cur, h * HALF + R) + (unsigned)C * 2u; }
    }
    f32x4 acc[2][2][4][2];
#pragma unroll
    for (int a = 0; a < 2; ++a)
#pragma unroll
        for (int b = 0; b < 2; ++b)
#pragma unroll
            for (int m = 0; m < 4; ++m)
#pragma unroll
                for (int n = 0; n < 2; ++n) acc[a][b][m][n] = (f32x4){0.f, 0.f, 0.f, 0.f};
    bf16x8 At[4][2], B0[2][2], B1[2][2];
    typedef int pre_t __attribute__((ext_vector_type(16))); pre_t pre = {};
    if constexpr (Epi::PREFETCH) pre = E.prefetch(cur, wr, fr);
    const char* cA = cur.a; const char* cB = cur.b;
    PG8_STAGE_B(PG8_SB(0, 0), cB); PG8_STAGE_B(PG8_SB(0, 1), cB + hstepB); PG8_STAGE_A(PG8_SA(0, 0), cA, 0, false); PG8_STAGE_A(PG8_SA(0, 1), cA, 1, false);
    if (wr == 1) PG8_BAR;
    PG8_WAIT_V(2); PG8_BAR;
    PG8_STAGE_B(PG8_SB(1, 0), cB + kstep); PG8_STAGE_A(PG8_SA(1, 0), cA + kstep, 0, false); PG8_STAGE_B(PG8_SB(1, 1), cB + hstepB + kstep);
    PG8_WAIT_V(6); PG8_BAR;
    for (;;) {
        const bool has_next = S.next(ui + 1, nxt);
        if constexpr (Sched::GATHER) { if (has_next) {
#pragma unroll
            for (int h = 0; h < 2; ++h)
#pragma unroll
                for (int i = 0; i < 2; ++i) { int R, C; int t2 = tid; asm volatile("" : "+v"(t2)); stage_rc(t2 * 16 + i * 8192, R, C); vAn[h][i] = S.goff(nxt, h * HALF + R) + (unsigned)C * 2u; }
            *(LAS u32x4*)(lds + 131072 + tid * 16) = (u32x4){vAn[0][0], vAn[0][1], vAn[1][0], vAn[1][1]}; } }
        const char* nA = has_next ? nxt.a : cA; const char* nB = has_next ? nxt.b : cB;
        for (int t = 0; t < nt; t += 2) {
            const bool last = (t == nt - 2);
            const bool nx = last && has_next;
            if constexpr (Sched::GATHER) { if (nx) { const u32x4 pk_ = *(const LAS u32x4*)(lds + 131072 + tid * 16); vAn[0][0] = pk_.x; vAn[0][1] = pk_.y; vAn[1][0] = pk_.z; vAn[1][1] = pk_.w; } }
            const char* a1 = cA + (size_t)(t + 1) * kstep;
            const char* a2 = last ? nA : cA + (size_t)(t + 2) * kstep; const char* b2 = last ? nB : cB + (size_t)(t + 2) * kstep;
            const char* a3 = a2 + kstep; const char* b3 = b2 + kstep;
            PG8_LDB(B0, 0, 0); PG8_LDB(B1, 0, 1); PG8_SCHED; PG8_LDA(At, 0, 0); PG8_STAGE_A(PG8_SA(1, 1), a1, 1, false);
            PG8_WAIT_V(8); PG8_WAIT_L(0); PG8_BAR; if (cur.hm & 1) { PG8_MMA(0, 0, At, B0); PG8_MMA(0, 1, At, B1); } PG8_BAR; PG8_SCHED;
            PG8_LDA(At, 0, 1); PG8_STAGE_B(PG8_SB(0, 0), b2); PG8_STAGE_B(PG8_SB(0, 1), b2 + hstepB); PG8_STAGE_A(PG8_SA(0, 0), a2, 0, nx);
            PG8_WAIT_V(8); PG8_WAIT_L(0); PG8_BAR; if (cur.hm & 4) { PG8_MMA(1, 0, At, B0); PG8_MMA(1, 1, At, B1); } PG8_BAR; PG8_SCHED;
            PG8_LDB(B0, 1, 0); PG8_LDB(B1, 1, 1); PG8_SCHED; PG8_LDA(At, 1, 0); PG8_STAGE_A(PG8_SA(0, 1), a2, 1, nx);
            PG8_WAIT_V(8); PG8_WAIT_L(0); PG8_BAR; if (cur.hm & 1) { PG8_MMA(0, 0, At, B0); PG8_MMA(0, 1, At, B1); } PG8_BAR; PG8_SCHED;
            PG8_LDA(At, 1, 1); PG8_STAGE_B(PG8_SB(1, 0), b3); PG8_STAGE_B(PG8_SB(1, 1), b3 + hstepB); PG8_STAGE_A(PG8_SA(1, 0), a3, 0, nx);
            PG8_WAIT_V(8); PG8_WAIT_L(0); PG8_BAR; if (cur.hm & 4) { PG8_MMA(1, 0, At, B0); PG8_MMA(1, 1, At, B1); } PG8_BAR; PG8_SCHED;
        }
        if (wr == 0) PG8_BAR;
        if constexpr (Epi::FP8) asm volatile("s_nop 15\n\ts_nop 15" ::: "memory");
        if constexpr (Epi::PREFETCH) E(acc, cur, wr, wc, fr, fq, pre); else E(acc, cur, wr, wc, fr, fq);
        if (!has_next) break;
#pragma unroll
        for (int a = 0; a < 2; ++a)
#pragma unroll
            for (int b = 0; b < 2; ++b)
#pragma unroll
                for (int m = 0; m < 4; ++m)
#pragma unroll
                    for (int n = 0; n < 2; ++n) acc[a][b][m][n] = (f32x4){0.f, 0.f, 0.f, 0.f};
        cur = nxt; cA = nA; cB = nB; ++ui;
        if constexpr (Epi::PREFETCH) pre = E.prefetch(cur, wr, fr);
        if constexpr (Sched::GATHER) {
#pragma unroll
            for (int h = 0; h < 2; ++h)
#pragma unroll
                for (int i = 0; i < 2; ++i) vAc[h][i] = vAn[h][i]; }
        if (wr == 1) PG8_BAR;
    }
    PG8_WAIT_V(0);
    PG8_BAR;
}
}

#ifndef ATT_SDEPTH
#define ATT_SDEPTH 1
#endif
namespace att {
constexpr int NW = 8, QBLK = 32, KVBLK = 64;
constexpr float SCALE = 0.088388347648318440f;
constexpr float THR = 8.f;
constexpr int LDQ = 1536, LDK = 1536, LDO = 1024;
constexpr size_t SHM_V = KVBLK * 128 * 2, SHM_K = KVBLK * 128 * 2, SHM_ATTN = 2 * SHM_V + 2 * SHM_K + NW * 64 * 4;
#define KSWZ(row, colB) ((row) * 256 + ((colB) ^ (((row) & 7) << 4)))
#define SBAR() __builtin_amdgcn_sched_barrier(0)
__device__ __forceinline__ int crow(int r, int hi) { return (r & 3) + 8 * (r >> 2) + 4 * hi; }
__device__ __forceinline__ void partialSM(f32x16& p0, f32x16& p1, float& m_reg, float& mn, float& alpha) {
  constexpr float C = SCALE * 1.4426950408889634f;
  float pmax = p0[0];
#pragma unroll
  for (int r = 1; r < 16; ++r) pmax = fmaxf(pmax, p0[r]);
#pragma unroll
  for (int r = 0; r < 16; ++r) pmax = fmaxf(pmax, p1[r]);
  { auto rr = __builtin_amdgcn_permlane32_swap(__float_as_uint(pmax), __float_as_uint(pmax), false, false);
    pmax = fmaxf(__uint_as_float(rr[0]), __uint_as_float(rr[1])); }
  if (__builtin_expect(__all(pmax - m_reg <= THR / SCALE), 1)) { mn = m_reg; alpha = 1.f; }
  else { mn = fmaxf(m_reg, pmax); alpha = __builtin_amdgcn_exp2f((m_reg - mn) * C); m_reg = mn; }
  float mnC = -mn * C;
#pragma unroll
  for (int r = 0; r < 16; ++r) p0[r] = fmaf(p0[r], C, mnC);
#pragma unroll
  for (int r = 0; r < 16; ++r) p1[r] = fmaf(p1[r], C, mnC);
#pragma unroll
  for (int r = 0; r < 16; ++r) p0[r] = __builtin_amdgcn_exp2f(p0[r]);
}
__device__ __forceinline__ void finishSM(f32x16& p0, f32x16& p1, float alpha, float& l_reg, bf16x8& pa0, bf16x8& pa1, bf16x8& pa2, bf16x8& pa3) {
#pragma unroll
  for (int r = 0; r < 16; ++r) p1[r] = __builtin_amdgcn_exp2f(p1[r]);
  float ps = 0;
#pragma unroll
  for (int r = 0; r < 16; ++r) ps += p0[r];
#pragma unroll
  for (int r = 0; r < 16; ++r) ps += p1[r];
  { auto rr = __builtin_amdgcn_permlane32_swap(__float_as_uint(ps), __float_as_uint(ps), false, false);
    ps = __uint_as_float(rr[0]) + __uint_as_float(rr[1]); }
  l_reg = l_reg * alpha + ps;
#define PK4(P, BASE, OUT) do { unsigned a0 = cvt_pk_bf16(P[BASE + 0], P[BASE + 1]), a1 = cvt_pk_bf16(P[BASE + 2], P[BASE + 3]);   \
    unsigned b0 = cvt_pk_bf16(P[BASE + 4], P[BASE + 5]), b1 = cvt_pk_bf16(P[BASE + 6], P[BASE + 7]);                              \
    auto r0 = __builtin_amdgcn_permlane32_swap(a0, b0, false, false); auto r1 = __builtin_amdgcn_permlane32_swap(a1, b1, false, false); \
    u32x4 w = {r0[0], r1[0], r0[1], r1[1]}; OUT = __builtin_bit_cast(bf16x8, w); } while (0)
  PK4(p0, 0, pa0); PK4(p0, 8, pa1); PK4(p1, 0, pa2); PK4(p1, 8, pa3);
#undef PK4
}
__device__ __forceinline__ void qkt(f32x16& p0, f32x16& p1, const bf16_t* Ks, const bf16x8* qr, int r32, int hi) {
  p0 = f32x16{}; p1 = f32x16{};
#pragma unroll
  for (int d0 = 0; d0 < 8; ++d0) { int cb = (d0 * 16 + hi * 8) * 2;
    bf16x8 b0 = *reinterpret_cast<const bf16x8*>((const char*)Ks + KSWZ(r32, cb));
    bf16x8 b1 = *reinterpret_cast<const bf16x8*>((const char*)Ks + KSWZ(32 + r32, cb));
    p0 = __builtin_amdgcn_mfma_f32_32x32x16_bf16(b0, qr[d0], p0, 0, 0, 0);
    p1 = __builtin_amdgcn_mfma_f32_32x32x16_bf16(b1, qr[d0], p1, 0, 0, 0); }
}
__device__ __forceinline__ int v_st(int k, int c) { const int kk = (k & ~0xC) | ((k & 4) << 1) | ((k & 8) >> 1); return ((kk >> 3) * 4 + (c >> 5)) * 512 + ((kk & 7) * 32 + (c & 31)) * 2; }
__device__ __forceinline__ int v_rd_base(int lane) { return ((lane & 3) << 3) | (((lane >> 2) & 3) << 6) | (((lane >> 4) & 1) << 5) | (((lane >> 5) & 1) << 8); }
constexpr int v_rd_off(int d0, int ks, int half) { return d0 * 512 + ks * 4096 + half * 2048; }
template <int OFF> __device__ __forceinline__ s16x4 tr_read(int vb) {
  s16x4 r; asm volatile("ds_read_b64_tr_b16 %0, %1 offset:%2" : "=&v"(r) : "v"(vb), "i"(OFF) : "memory"); return r;
}
template <int D0> __device__ __forceinline__ void pv_one(f32x16& od, int vb, bf16x8 pa0, bf16x8 pa1, bf16x8 pa2, bf16x8 pa3) {
  const s16x4 l0 = tr_read<v_rd_off(D0, 0, 0)>(vb), h0 = tr_read<v_rd_off(D0, 0, 1)>(vb), l1 = tr_read<v_rd_off(D0, 1, 0)>(vb), h1 = tr_read<v_rd_off(D0, 1, 1)>(vb);
  const s16x4 l2 = tr_read<v_rd_off(D0, 2, 0)>(vb), h2 = tr_read<v_rd_off(D0, 2, 1)>(vb), l3 = tr_read<v_rd_off(D0, 3, 0)>(vb), h3 = tr_read<v_rd_off(D0, 3, 1)>(vb);
  asm volatile("s_waitcnt lgkmcnt(0)" ::: "memory"); SBAR();
#define PK(L, H) (bf16x8){L[0], L[1], L[2], L[3], H[0], H[1], H[2], H[3]}
  od = __builtin_amdgcn_mfma_f32_32x32x16_bf16(pa0, PK(l0, h0), od, 0, 0, 0);
  od = __builtin_amdgcn_mfma_f32_32x32x16_bf16(pa1, PK(l1, h1), od, 0, 0, 0);
  od = __builtin_amdgcn_mfma_f32_32x32x16_bf16(pa2, PK(l2, h2), od, 0, 0, 0);
  od = __builtin_amdgcn_mfma_f32_32x32x16_bf16(pa3, PK(l3, h3), od, 0, 0, 0);
#undef PK
}
__device__ __forceinline__ void pv_d0(f32x16* o, int vb, bf16x8 pa0, bf16x8 pa1, bf16x8 pa2, bf16x8 pa3) {
  pv_one<0>(o[0], vb, pa0, pa1, pa2, pa3); pv_one<1>(o[1], vb, pa0, pa1, pa2, pa3); pv_one<2>(o[2], vb, pa0, pa1, pa2, pa3); pv_one<3>(o[3], vb, pa0, pa1, pa2, pa3);
}
__device__ __forceinline__ void attn_dense_body(const bf16_t* Qb, const bf16_t* Kh, const bf16_t* Vh, bf16_t* Ob, int seq, char* lds, const int tid) {
  const int wid = tid >> 6, lane = tid & 63, r32 = lane & 31, hi = lane >> 5;
  bf16_t* V_lds = (bf16_t*)lds; bf16_t* K_lds = (bf16_t*)(lds + 2 * SHM_V);
  float* ws = (float*)(lds + 2 * SHM_V + 2 * SHM_K) + wid * 64; float* li_l = ws; float* al_l = ws + 32;
  float m_reg = -1e30f, l_reg = 0; f32x16 o[4] = {}; bf16x8 qr[8];
  const bf16_t* Qw = Qb + (long)(wid * QBLK + r32) * LDQ + hi * 8;
#pragma unroll
  for (int d0 = 0; d0 < 8; ++d0) qr[d0] = *reinterpret_cast<const bf16x8*>(Qw + d0 * 16);
  const int sr = tid >> 4, sc = (tid & 15) * 8, vst0 = v_st(sr, sc), vst1 = v_st(32 + sr, sc);
  const int vb0 = (int)(uintptr_t)V_lds + v_rd_base(lane);
  struct { bf16x8 vs0, vs1, ks0, ks1; } sr_[ATT_SDEPTH];
  const unsigned vo0 = (unsigned)(sr * LDK + sc) * 2u, vo1 = (unsigned)((32 + sr) * LDK + sc) * 2u;
  const long vdelta = (const char*)Vh - (const char*)Kh;
#define SLOAD(i, k0) do { const char* kb_ = (const char*)Kh + (size_t)(k0) * (LDK * 2); const char* vb_ = kb_ + vdelta; \
    sr_[i].vs0 = *reinterpret_cast<const bf16x8*>(vb_ + vo0); sr_[i].vs1 = *reinterpret_cast<const bf16x8*>(vb_ + vo1); \
    sr_[i].ks0 = *reinterpret_cast<const bf16x8*>(kb_ + vo0); sr_[i].ks1 = *reinterpret_cast<const bf16x8*>(kb_ + vo1); } while (0)
#define SWRITE(b, i) do { *(bf16x8*)((char*)V_lds + (b) * SHM_V + vst0) = sr_[i].vs0;          \
    *(bf16x8*)((char*)V_lds + (b) * SHM_V + vst1) = sr_[i].vs1; int kc = sc * 2;               \
    *(bf16x8*)((char*)K_lds + (b) * SHM_K + KSWZ(sr, kc)) = sr_[i].ks0;                       \
    *(bf16x8*)((char*)K_lds + (b) * SHM_K + KSWZ(32 + sr, kc)) = sr_[i].ks1; } while (0)
#define SWAIT() do { if constexpr (ATT_SDEPTH == 2) asm volatile("s_waitcnt vmcnt(4)" ::: "memory"); else asm volatile("s_waitcnt vmcnt(0)" ::: "memory"); } while (0)
#define RESC(a) do { if (__any((a) < 1.f)) { if (hi == 0) al_l[r32] = (a); asm volatile("s_waitcnt lgkmcnt(0)" ::: "memory"); \
    _Pragma("unroll") for (int d = 0; d < 4; ++d) _Pragma("unroll") for (int r = 0; r < 16; ++r) o[d][r] *= al_l[crow(r, hi)]; } } while (0)
  f32x16 pA0, pA1, pB0, pB1; float mnA, mnB, alA, alB; bf16x8 pa0, pa1, pa2, pa3; const int NT = seq / KVBLK;
  constexpr int SE = 0, SO = ATT_SDEPTH - 1;
  SLOAD(SE, 0); asm volatile("s_waitcnt vmcnt(0)" ::: "memory"); SWRITE(0, SE); __syncthreads();
  qkt(pA0, pA1, K_lds, qr, r32, hi); partialSM(pA0, pA1, m_reg, mnA, alA);
  SLOAD(SO, KVBLK); if constexpr (ATT_SDEPTH == 2) { if (2 < NT) SLOAD(SE, 2 * KVBLK); }
  SWAIT(); SWRITE(1, SO); __syncthreads();
  for (int j = 1; j + 1 < NT; j += 2) {
    SBAR(); qkt(pB0, pB1, (bf16_t*)((char*)K_lds + SHM_K), qr, r32, hi);
    finishSM(pA0, pA1, alA, l_reg, pa0, pa1, pa2, pa3); SBAR();
    SLOAD(SO, (j + ATT_SDEPTH) * KVBLK); SBAR();
    pv_d0(o, vb0, pa0, pa1, pa2, pa3); partialSM(pB0, pB1, m_reg, mnB, alB);
    __syncthreads(); SWAIT(); SWRITE(0, SE);
    RESC(alB); __syncthreads();
    SBAR(); qkt(pA0, pA1, K_lds, qr, r32, hi);
    finishSM(pB0, pB1, alB, l_reg, pa0, pa1, pa2, pa3); SBAR();
    if (ATT_SDEPTH == 1 || j + 3 < NT) SLOAD(SE, (j + 1 + ATT_SDEPTH) * KVBLK); SBAR();
    pv_d0(o, vb0 + (int)SHM_V, pa0, pa1, pa2, pa3); partialSM(pA0, pA1, m_reg, mnA, alA);
    __syncthreads(); SWAIT(); SWRITE(1, SO);
    RESC(alA); __syncthreads();
  }
  SBAR(); qkt(pB0, pB1, (bf16_t*)((char*)K_lds + SHM_K), qr, r32, hi);
  finishSM(pA0, pA1, alA, l_reg, pa0, pa1, pa2, pa3); SBAR();
  pv_d0(o, vb0, pa0, pa1, pa2, pa3); partialSM(pB0, pB1, m_reg, mnB, alB);
  __syncthreads(); RESC(alB);
  finishSM(pB0, pB1, alB, l_reg, pa0, pa1, pa2, pa3); SBAR();
  pv_d0(o, vb0 + (int)SHM_V, pa0, pa1, pa2, pa3);
  if (hi == 0) li_l[r32] = l_reg; asm volatile("s_waitcnt lgkmcnt(0)" ::: "memory");
  float rli[16];
#pragma unroll
  for (int r = 0; r < 16; ++r) rli[r] = __builtin_amdgcn_rcpf(li_l[crow(r, hi)]);
  bf16_t* Ow = Ob + (long)(wid * QBLK) * LDO;
#pragma unroll
  for (int r = 0; r < 16; ++r) { int orow = crow(r, hi);
#pragma unroll
    for (int d0 = 0; d0 < 4; ++d0) Ow[(long)orow * LDO + d0 * 32 + r32] = (bf16_t)f2bf(o[d0][r] * rli[r]); }
#undef SLOAD
#undef SWRITE
#undef SWAIT
#undef RESC
}
}

#define XB_TMO      128
#define XB_XCNT(j)  (256  + 64 * (j))
#define XB_XSUB(j)  (1280 + 64 * (j))
#define XB_XGEN(j)  (2304 + 64 * (j))
#define XB_TOP      3328
#define XB_TOPGEN   3392
#define XB_SPIN_CAP (1u << 22)
__device__ __forceinline__ unsigned xb_ld(unsigned* p)              { return __hip_atomic_load(p, __ATOMIC_RELAXED, __HIP_MEMORY_SCOPE_AGENT); }
__device__ __forceinline__ unsigned xb_add(unsigned* p, unsigned v) { return __hip_atomic_fetch_add(p, v, __ATOMIC_RELAXED, __HIP_MEMORY_SCOPE_AGENT); }
__device__ __forceinline__ unsigned xb_xcc_id() { return (unsigned)__builtin_amdgcn_s_getreg((3 << 11) | 20) & 0xFu; }
#define XB_SPIN(cond, bar) do { unsigned _sp = 0; while (cond) { __builtin_amdgcn_s_sleep(1); \
    if ((++_sp & 255u) == 0u) { if (xb_ld(&(bar)[XB_TMO])) break; if (_sp > XB_SPIN_CAP) { atomicAdd(&(bar)[XB_TMO], 1u); break; } } } } while (0)
struct XcdBarrier { unsigned* bar; unsigned x; volatile LAS unsigned* st; };
__device__ __forceinline__ XcdBarrier xcd_barrier_post(unsigned* bar, volatile LAS unsigned* st) {
    XcdBarrier b; b.bar = bar; b.x = xb_xcc_id(); b.st = st;
    if (threadIdx.x == 0) (void)xb_add(&bar[XB_XCNT(b.x)], 1u);
    return b;
}
__device__ __forceinline__ void xcd_barrier_complete(unsigned* bar, unsigned x, unsigned& nloc, unsigned& nx) {
    const unsigned G = gridDim.x * gridDim.y * gridDim.z;
    unsigned sum, cnt, mine, sp = 0u;
    for (;;) {
        sum = 0u; cnt = 0u; mine = 0u;
#pragma unroll
        for (unsigned j = 0; j < 16; ++j) { const unsigned c = xb_ld(&bar[XB_XCNT(j)]); sum += c; cnt += (c > 0u) ? 1u : 0u; mine = (j == x) ? c : mine; }
        if (sum == G) break;
        __builtin_amdgcn_s_sleep(1);
        if ((++sp & 255u) == 0u) { if (xb_ld(&bar[XB_TMO])) break; if (sp > XB_SPIN_CAP) { atomicAdd(&bar[XB_TMO], 1u); break; } }
    }
    nloc = mine > 0u ? mine : 1u; nx = cnt > 0u ? cnt : 1u;
}
__device__ __forceinline__ void xcd_barrier(const XcdBarrier& b_) {
    XcdBarrier b; b.bar = b_.bar; b.st = b_.st; b.x = xb_xcc_id();
    asm volatile("s_waitcnt vmcnt(0)" ::: "memory");
    __syncthreads();
    if (threadIdx.x == 0) {
        unsigned* bar = b.bar;
        __builtin_amdgcn_s_waitcnt(0);
        unsigned nloc = b.st[0], nx = b.st[1];
        if (nloc == 0u) { xcd_barrier_complete(bar, b.x, nloc, nx); b.st[0] = nloc; b.st[1] = nx; }
        const unsigned old = xb_add(&bar[XB_XSUB(b.x)], 1u);
        const unsigned gen = old / nloc;
        if (old + 1u == (gen + 1u) * nloc) {
            __builtin_amdgcn_fence(__ATOMIC_RELEASE, "agent");
            asm volatile("s_waitcnt vmcnt(0)" ::: "memory");
            const unsigned og = xb_add(&bar[XB_TOP], 1u);
            const unsigned tg = og / nx;
            if (og + 1u == (tg + 1u) * nx) xb_add(&bar[XB_TOPGEN], 1u);
            else XB_SPIN(xb_ld(&bar[XB_TOPGEN]) == tg, bar);
            __builtin_amdgcn_fence(__ATOMIC_ACQUIRE, "agent");
            xb_add(&bar[XB_XGEN(b.x)], 1u);
            asm volatile("s_waitcnt vmcnt(0)" ::: "memory");
        } else {
            XB_SPIN(xb_ld(&bar[XB_XGEN(b.x)]) == gen, bar);
            __builtin_amdgcn_fence(__ATOMIC_ACQUIRE, "agent");
            asm volatile("s_waitcnt vmcnt(0)" ::: "memory");
        }
    }
    __syncthreads();
}

struct Args { const float* in[34]; float* out; uchar* ws; int ph_lo, ph_hi; };
enum { I_X = 0, I_C, I_CTX, I_CCTX, I_ADAW, I_ADAB, I_NMG, I_NFG, I_RGWIN, I_RGCW, I_RGCB, I_RGWA, I_RGBA, I_RGWI, I_RGBI, I_RGLAM, I_RGWOUT,
       I_ATQKV, I_ATQG, I_ATKG, I_ATWO, I_CMWIN, I_CMLNG, I_CMLNB, I_CMWS, I_CMBS, I_CMWOUT, I_MWG, I_MBG, I_MWR, I_MBR, I_MWGATE, I_MWUP, I_MWDOWN };

__device__ __forceinline__ const void* opaque_uniform_ptr(const void* p) { const unsigned long long v = (unsigned long long)p; unsigned lo = (unsigned)v, hi = (unsigned)(v >> 32); asm volatile("" : "+v"(lo), "+v"(hi));
    lo = __builtin_amdgcn_readfirstlane(lo); hi = __builtin_amdgcn_readfirstlane(hi); return (const void*)(const GAS char*)(((unsigned long long)hi << 32) | lo); }
__device__ __forceinline__ int opaque_uniform_int(int x) { asm volatile("" : "+v"(x)); return __builtin_amdgcn_readfirstlane(x); }
struct Frame {
    LAS uchar* lds; char* ldsg;
    int tid, lane, wave, G, bid;
    uchar* ws; float* out;
};
__device__ __forceinline__ const float* inp(const Frame& F, int i) { const unsigned long long v = *(const LAS unsigned long long*)(F.lds + LDSCTL_OFF + 576 + i * 8);
    const unsigned lo = __builtin_amdgcn_readfirstlane((unsigned)v), hi = __builtin_amdgcn_readfirstlane((unsigned)(v >> 32)); return (const float*)(const GAS float*)(((unsigned long long)hi << 32) | lo); }
__device__ __forceinline__ float wave16_sum(float v) {
    v += __int_as_float(__builtin_amdgcn_update_dpp(0, __float_as_int(v), 0xB1, 0xF, 0xF, true));
    v += __int_as_float(__builtin_amdgcn_update_dpp(0, __float_as_int(v), 0x4E, 0xF, 0xF, true));
    v += __int_as_float(__builtin_amdgcn_update_dpp(0, __float_as_int(v), 0x141, 0xF, 0xF, true));
    v += __int_as_float(__builtin_amdgcn_update_dpp(0, __float_as_int(v), 0x140, 0xF, 0xF, true));
    return v; }

struct ConvItem { const float* src; uchar* dst; int ldw; bool f8; };
__device__ __forceinline__ void tr_load(const ConvItem& ci, f32x4 (&v)[16]) {
    if (ci.f8) {
#pragma unroll
        for (int i = 0; i < 8; ++i) { v[2 * i] = __builtin_nontemporal_load((const f32x4*)(ci.src + (size_t)(8 * i) * ci.ldw)); v[2 * i + 1] = __builtin_nontemporal_load((const f32x4*)(ci.src + (size_t)(8 * i + 1) * ci.ldw)); }
    } else {
#pragma unroll
        for (int i = 0; i < 16; ++i) v[i] = __builtin_nontemporal_load((const f32x4*)(ci.src + (size_t)(4 * i) * ci.ldw));
    }
}
__device__ __forceinline__ void tr_finish(const f32x4 (&v)[16], const ConvItem& ci, LAS uchar* scr, int lane) {
    const int kr = lane >> 4, nc = (lane & 15) * 4;
    const int g = lane >> 4, q = (lane >> 2) & 3, p = lane & 3;
    const int vb = (int)(uintptr_t)scr + q * 128 + g * 32 + p * 8;
    if (ci.f8) {
#pragma unroll
        for (int i = 0; i < 8; ++i) { const f32x4 a = v[2 * i] * 32.f, b = v[2 * i + 1] * 32.f;
            int r0 = __builtin_amdgcn_cvt_pk_fp8_f32(a.x, b.x, 0, false); r0 = __builtin_amdgcn_cvt_pk_fp8_f32(a.y, b.y, r0, true);
            int r1 = __builtin_amdgcn_cvt_pk_fp8_f32(a.z, b.z, 0, false); r1 = __builtin_amdgcn_cvt_pk_fp8_f32(a.w, b.w, r1, true);
            *(LAS u32x2*)(scr + (4 * i + kr) * 128 + nc * 2) = (u32x2){(unsigned)r0, (unsigned)r1}; }
        asm volatile("s_waitcnt lgkmcnt(0)" ::: "memory");
        s16x4 t[8];
#define TRR(r) t[r] = att::tr_read<(r) * 512>(vb)
        TRR(0); TRR(1); TRR(2); TRR(3); TRR(4); TRR(5); TRR(6); TRR(7);
#undef TRR
        asm volatile("s_waitcnt lgkmcnt(0)" ::: "memory"); __builtin_amdgcn_sched_barrier(0);
#pragma unroll
        for (int j = 0; j < 4; ++j) { const bf16x8 o = {t[2 * j][0], t[2 * j][1], t[2 * j][2], t[2 * j][3], t[2 * j + 1][0], t[2 * j + 1][1], t[2 * j + 1][2], t[2 * j + 1][3]}; *(bf16x8*)(ci.dst + 16 * j) = o; }
    } else {
#pragma unroll
        for (int i = 0; i < 16; ++i) { u32x2 o; o.x = pk2(v[i].x, v[i].y); o.y = pk2(v[i].z, v[i].w); *(LAS u32x2*)(scr + (4 * i + kr) * 128 + nc * 2) = o; }
        asm volatile("s_waitcnt lgkmcnt(0)" ::: "memory");
        s16x4 t[16];
#define TRR(r) t[r] = att::tr_read<(r) * 512>(vb)
        TRR(0); TRR(1); TRR(2); TRR(3); TRR(4); TRR(5); TRR(6); TRR(7); TRR(8); TRR(9); TRR(10); TRR(11); TRR(12); TRR(13); TRR(14); TRR(15);
#undef TRR
        asm volatile("s_waitcnt lgkmcnt(0)" ::: "memory"); __builtin_amdgcn_sched_barrier(0);
#pragma unroll
        for (int j = 0; j < 8; ++j) { const bf16x8 o = {t[2 * j][0], t[2 * j][1], t[2 * j][2], t[2 * j][3], t[2 * j + 1][0], t[2 * j + 1][1], t[2 * j + 1][2], t[2 * j + 1][3]}; *(bf16x8*)(ci.dst + 16 * j) = o; }
    }
}
struct Job { int g, lo, hi; };
__device__ __forceinline__ ConvItem conv_decode(Frame& F, int g, int it) {
    uchar* ws = F.ws; const float* W; int K = 1024, N = 1024, ldt = 1024, mode = 0; size_t dms = 0; bf16_t* WT;
    switch (g) {
        case 0:  W = inp(F, I_MWGATE); N = 512; WT = (bf16_t*)(ws + WS_W_E1); dms = (size_t)1024 * 1024; mode = 1; break;
        case 1:  W = inp(F, I_MWUP);   N = 512; WT = (bf16_t*)(ws + WS_W_E1); dms = (size_t)1024 * 1024; mode = 2; break;
        case 2:  W = inp(F, I_MWDOWN); K = 512; WT = (bf16_t*)(ws + WS_W_E2); ldt = 512; dms = (size_t)1024 * 512; break;
        case 3:  W = inp(F, I_RGWIN);  N = 2048; WT = (bf16_t*)(ws + WS_W_RGIN); dms = (size_t)2048 * 1024; break;
        case 4:  W = inp(F, I_CMWIN);  N = 4096; WT = (bf16_t*)(ws + WS_W_CMIN); break;
        case 5:  W = inp(F, I_RGWOUT); WT = (bf16_t*)(ws + WS_W_RGOUT); dms = (size_t)1024 * 1024; break;
        case 6:  W = inp(F, I_CMWOUT); K = 2048; WT = (bf16_t*)(ws + WS_W_CMOUT); ldt = 2048; break;
        case 7:  W = inp(F, I_ATQKV);  N = 1536; WT = (bf16_t*)(ws + WS_W_QKV); break;
        case 8:  W = inp(F, I_ATWO);   WT = (bf16_t*)(ws + WS_W_AO); break;
        case 9:  W = inp(F, I_RGWA);   K = 128; N = 128; WT = (bf16_t*)(ws + WS_W_RGG); ldt = 128; dms = (size_t)256 * 128; break;
        default: W = inp(F, I_RGWI);   K = 128; N = 128; WT = (bf16_t*)(ws + WS_W_RGG); ldt = 128; dms = (size_t)256 * 128; mode = 3; break;
    }
    const int nblk = N / 64, per = (K / 64) * nblk, mat = it / per, r = it - mat * per, kb = r / nblk, nb = r - kb * nblk, n0 = nb * 64;
    int drow = n0;
    if (mode == 1) drow = (n0 >> 7) * 256 + (n0 & 127); else if (mode == 2) drow = (n0 >> 7) * 256 + 128 + (n0 & 127); else if (mode == 3) drow = 128 + n0;
    const int lane = F.lane;
    const bool f8 = (MOE_FP8 != 0) && g < 3; const int eb = f8 ? 1 : 2;
    ConvItem ci; ci.ldw = N; ci.f8 = f8; ci.src = W + (size_t)mat * K * N + (size_t)(kb * 64 + (f8 ? 2 : 1) * (lane >> 4)) * N + n0 + (lane & 15) * 4;
    int nl = (lane >> 4) * 16 + (lane & 15);
    if (g == 7 && n0 < 1280) { const int half = nl >> 5, f = nl & 31; nl = 32 * (f >> 4) + 8 * ((f >> 2) & 3) + 4 * half + (f & 3); }
    ci.dst = (uchar*)WT + ((size_t)mat * dms + (size_t)(drow + nl) * ldt + kb * 64) * eb;
    return ci;
}
template <int NJ>
__device__ __forceinline__ ConvItem conv_find(Frame& F, int v, const Job (&jobs)[NJ]) { int r = v, g = jobs[0].g, it = 0; bool found = false;
#pragma unroll
    for (int q = 0; q < NJ; ++q) { const int n = jobs[q].hi - jobs[q].lo; if (!found) { if (r < n) { g = jobs[q].g; it = jobs[q].lo + r; found = true; } else r -= n; } }
    return conv_decode(F, g, it); }
template <int NJ>
__device__ __forceinline__ void conv_tail(Frame& F, int nblk0, const Job (&jobs)[NJ]) {
    if (nblk0 >= F.G) nblk0 = 0;
    if (F.bid < nblk0) return;
    LAS uchar* scr = F.lds + F.wave * 8192;
    int total = 0;
#pragma unroll
    for (int q = 0; q < NJ; ++q) total += jobs[q].hi - jobs[q].lo;
    const int nw = (F.G - nblk0) * 8;
    int v0 = (F.bid - nblk0) * 8 + F.wave;
    f32x4 va[16], vb[16]; ConvItem c0, c1; c0.dst = nullptr; c1.dst = nullptr; c0.f8 = false; c1.f8 = false; c0.src = nullptr; c1.src = nullptr; c0.ldw = 0; c1.ldw = 0;
    if (v0 < total) { c0 = conv_find(F, v0, jobs); tr_load(c0, va); }
    for (; v0 < total; v0 += 2 * nw) {
        const int v1 = v0 + nw, v2 = v1 + nw;
        if (v1 < total) { c1 = conv_find(F, v1, jobs); tr_load(c1, vb); }
        tr_finish(va, c0, scr, F.lane);
        if (v2 < total) { c0 = conv_find(F, v2, jobs); tr_load(c0, va); }
        if (v1 < total) tr_finish(vb, c1, scr, F.lane);
    }
}
__device__ __forceinline__ void p0_prologue(Frame& F) {
    uchar* ws = F.ws;
    {
        LAS float* act = (LAS float*)(F.lds);
        LAS float* red = (LAS float*)(F.lds + 5 * 1024 * 4);
        bool have = false; const float* pC = inp(F, I_C); const float* pCC = inp(F, I_CCTX); const float* pADAW = inp(F, I_ADAW); const float* pADAB = inp(F, I_ADAB);
        for (int it = F.bid; it < DEPTH * 24; it += F.G) {
            if (!have) { for (int i = F.tid; i < 5 * 1024; i += 512) { const int s = i >> 10, k = i & 1023; const float v = s < 4 ? pC[s * 1024 + k] : pCC[k]; act[i] = v / (1.f + __expf(-v)); } have = true; __syncthreads(); }
            const int l = it / 24, cb = it % 24;
            const float* W = pADAW + (size_t)l * 1024 * NMODV + cb * 256 + F.lane * 4;
            f32x4 a[5];
#pragma unroll
            for (int s = 0; s < 5; ++s) a[s] = (f32x4){0.f, 0.f, 0.f, 0.f};
            const int kbase = F.wave * 128;
#pragma unroll 8
            for (int k = 0; k < 128; ++k) { const f32x4 w = *(const f32x4*)(W + (size_t)(kbase + k) * NMODV);
#pragma unroll
                for (int s = 0; s < 5; ++s) a[s] += w * act[s * 1024 + kbase + k]; }
#pragma unroll
            for (int s = 0; s < 5; ++s) *(LAS f32x4*)(red + (F.wave * 5 + s) * 256 + F.lane * 4) = a[s];
            __syncthreads();
            for (int i = F.tid; i < 5 * 256; i += 512) { const int s = i >> 8, c = i & 255; float v = pADAB[l * NMODV + cb * 256 + c];
#pragma unroll
                for (int w = 0; w < 8; ++w) v += red[(w * 5 + s) * 256 + c];
                ((float*)(ws + WS_MOD))[(l * 5 + s) * NMODV + cb * 256 + c] = v; }
            __syncthreads();
        }
        __syncthreads();
    }
    { const Job jobsA[8] = {{3, 0, 1024}, {4, 0, 1024}, {5, 0, 512}, {6, 0, 512}, {7, 0, 384}, {8, 0, 256}, {9, 0, 128}, {10, 0, 128}}; conv_tail(F, DEPTH * 24, jobsA);
      const Job jobsB[3] = {{0, 0, 16384}, {1, 0, 16384}, {2, 0, 16384}}; conv_tail(F, 0, jobsB); }
    {
        const int gt = F.bid * 512 + F.tid, NGT = F.G * 512;
        for (int i = gt; i < 8 * 128 * 128 / 4; i += NGT) { const f32x4 v = ((const f32x4*)inp(F, I_CMWS))[i]; u32x2 o; o.x = pk2(v.x, v.y); o.y = pk2(v.z, v.w); ((u32x2*)(ws + WS_W_CMS))[i] = o; }
        for (int i = gt; i < 2 * 2 * D; i += NGT) { const float* plam = inp(F, I_RGLAM); ((float*)(ws + WS_SPL))[i] = -8.f * log1pf(expf(-plam[i])); }
        for (int i = gt; i < 64 * 32; i += NGT) { const int pos = i >> 5, f = i & 31; const float inv = powf(10000.f, -(float)f * 2.0f / 64.0f); const float ang = (float)pos * inv;
            ((f32x2*)(ws + WS_ROPE))[i] = (f32x2){cosf(ang), sinf(ang)}; }
    }
}

__device__ __forceinline__ void router_fill(Frame& F, int l) {
    LAS float* wr = (LAS float*)F.lds;
    const float* wg = inp(F, I_MWG) + (size_t)l * 1024 * 4; const float* wrt = inp(F, I_MWR) + (size_t)l * 1024 * 32;
    __syncthreads();
    for (int i0 = F.tid; i0 < 1024 * 9; i0 += 512 * 6) { f32x4 v[6];
#pragma unroll
        for (int u = 0; u < 6; ++u) { const int idx = i0 + u * 512; const int k = idx / 9, q = idx - k * 9; v[u] = q == 0 ? *(const f32x4*)(wg + k * 4) : *(const f32x4*)(wrt + k * 32 + (q - 1) * 4); }
#pragma unroll
        for (int u = 0; u < 6; ++u) { const int idx = i0 + u * 512; const int k = idx / 9, q = idx - k * 9;
            wr[(4 * q + 0) * 1024 + k] = v[u].x; wr[(4 * q + 1) * 1024 + k] = v[u].y; wr[(4 * q + 2) * 1024 + k] = v[u].z; wr[(4 * q + 3) * 1024 + k] = v[u].w; } }
    __syncthreads();
}
template <bool ROUTE, int NADD, bool SRCIN>
__device__ __forceinline__ void norm_phase(Frame& F, int l, const float* gvec, int shift_i, bool skip_ctx_route, bool dry) {
    uchar* ws = F.ws;
    float* X = (float*)(ws + WS_X); const bf16_t* YS = (const bf16_t*)(ws + WS_Y1); const bf16_t* YM = (const bf16_t*)(ws + WS_YM); bf16_t* H = (bf16_t*)(ws + WS_H);
    const float* MOD = (const float*)(ws + WS_MOD) + (size_t)l * 5 * NMODV;
    LAS float* wr = (LAS float*)F.lds;
    const int i16 = F.lane & 15, grp = F.lane >> 4;
    const float* bg = nullptr; const float* br = nullptr; if constexpr (ROUTE) { bg = inp(F, I_MBG) + l * 4; br = inp(F, I_MBR) + l * 32; }
    const float* pctx = nullptr; const float* px = nullptr; if constexpr (SRCIN) { pctx = inp(F, I_CTX); px = inp(F, I_X); }
    for (int tok = (F.bid * 8 + F.wave) * 4 + grp; tok < T; tok += F.G * 32) {
        asm volatile("" ::: "memory");
        const int sidx = sidx_of_row(tok);
        f32x4 x[16];
        float ss = 0.f;
        const float* xrow = X + (size_t)tok * D;
        if constexpr (SRCIN) { const int b_ = tok / SB, s_ = tok - b_ * SB; xrow = s_ < CTX ? pctx + ((size_t)(b_ * CTX + s_) << 10) : px + ((size_t)(b_ * SEQ + s_ - CTX) << 10); }
#pragma unroll
        for (int j = 0; j < 16; ++j) x[j] = *(const f32x4*)(xrow + 64 * j + 4 * i16);
        if constexpr (NADD >= 1) {
#pragma unroll
            for (int j = 0; j < 16; ++j) { const u32x2 ym = *(const u32x2*)(YM + (size_t)tok * D + 64 * j + 4 * i16); x[j] += (f32x4){bflo(ym.x), bfhi(ym.x), bflo(ym.y), bfhi(ym.y)}; } }
        if constexpr (NADD == 3) {
#pragma unroll
            for (int j = 0; j < 16; ++j) { const u32x2 y0 = *(const u32x2*)(YS + (size_t)tok * D + 64 * j + 4 * i16), y1 = *(const u32x2*)(YS + ((size_t)T + tok) * D + 64 * j + 4 * i16);
                const f32x4 g5 = *(const f32x4*)(MOD - (size_t)5 * NMODV + (size_t)sidx * NMODV + 5 * D + 64 * j + 4 * i16);
                x[j] += g5 * (f32x4){bflo(y0.x) + bflo(y1.x), bfhi(y0.x) + bfhi(y1.x), bflo(y0.y) + bflo(y1.y), bfhi(y0.y) + bfhi(y1.y)}; }
#pragma unroll
            for (int j = 0; j < 16; ++j) *(f32x4*)(X + (size_t)tok * D + 64 * j + 4 * i16) = x[j]; }
#pragma unroll
        for (int j = 0; j < 16; ++j) ss += x[j].x * x[j].x + x[j].y * x[j].y + x[j].z * x[j].z + x[j].w * x[j].w;
        ss = wave16_sum(ss);
        const float rstd = rsqrtf(ss * (1.f / D) + NORM_EPS);
        const float* shp = MOD + (size_t)sidx * NMODV + shift_i * D; const float* scp = shp + D;
#pragma unroll
        for (int j = 0; j < 16; ++j) { const int c = 64 * j + 4 * i16; const f32x4 g = *(const f32x4*)(gvec + c), sh = *(const f32x4*)(shp + c), sc = *(const f32x4*)(scp + c);
            x[j] = x[j] * rstd * g * (sc + 1.f) + sh; }
#pragma unroll
        for (int j = 0; j < 16; ++j) { const int c = 64 * j + 4 * i16;
            if constexpr (ROUTE && MOE_FP8) { int r8 = __builtin_amdgcn_cvt_pk_fp8_f32(x[j].x, x[j].y, 0, false); r8 = __builtin_amdgcn_cvt_pk_fp8_f32(x[j].z, x[j].w, r8, true); *(int*)((uchar*)H + (size_t)tok * D + c) = r8; }
            else { u32x2 o; o.x = pk2(x[j].x, x[j].y); o.y = pk2(x[j].z, x[j].w); *(u32x2*)(H + (size_t)tok * D + c) = o; } }
        if constexpr (ROUTE) {
            LAS float* lgs = (LAS float*)(F.lds + LDSCTL_OFF + 1024) + (F.wave * 4 + grp) * 40;
#pragma unroll 1
            for (int o = 0; o < 36; ++o) { f32x4 w[16];
#pragma unroll
                for (int j = 0; j < 16; ++j) w[j] = *(const LAS f32x4*)(wr + o * 1024 + 64 * j + 4 * i16);
                __builtin_amdgcn_sched_barrier(0);
                f32x4 v0 = x[0] * w[0], v1 = x[1] * w[1];
#pragma unroll
                for (int j = 2; j < 16; j += 2) { v0 += x[j] * w[j]; v1 += x[j + 1] * w[j + 1]; }
                v0 += v1; float a0 = wave16_sum((v0.x + v0.y) + (v0.z + v0.w)); if (i16 == 0) lgs[o] = a0; }
            asm volatile("s_waitcnt lgkmcnt(0)" ::: "memory");
            const float gl0 = lgs[0] + bg[0], gl1 = lgs[1] + bg[1], gl2 = lgs[2] + bg[2], gl3 = lgs[3] + bg[3];
            int gs = 0; float gm = gl0;
            if (gl1 > gm) { gm = gl1; gs = 1; }
            if (gl2 > gm) { gm = gl2; gs = 2; }
            if (gl3 > gm) { gm = gl3; gs = 3; }
            const float den = __expf(gl0 - gm) + __expf(gl1 - gm) + __expf(gl2 - gm) + __expf(gl3 - gm);
            const float pg = 1.f / den;
            float el[8];
#pragma unroll
            for (int e = 0; e < 8; ++e) el[e] = lgs[4 + gs * 8 + e] + br[gs * 8 + e];
            int i0 = 0; float v0 = el[0];
#pragma unroll
            for (int e = 1; e < 8; ++e) if (el[e] > v0) { v0 = el[e]; i0 = e; }
            int i1 = -1; float v1 = -3.0e38f;
#pragma unroll
            for (int e = 0; e < 8; ++e) if (e != i0 && el[e] > v1) { v1 = el[e]; i1 = e; }
            const float p0 = 1.f / (1.f + __expf(v1 - v0));
            const float w0 = p0 * pg, w1 = (1.f - p0) * pg;
            const bool do_route = !(skip_ctx_route && sidx == 4) && !dry;
            if (i16 == 0 && do_route) {
                const int e0 = gs * 8 + i0, e1 = gs * 8 + i1;
                unsigned* cnt = (unsigned*)(ws + WS_CTL) + CW_CNT + l * 32 * 64;
                const unsigned q0 = atomicAdd(cnt + e0 * 64, 1u), q1 = atomicAdd(cnt + e1 * 64, 1u);
                u32x2* BK = (u32x2*)(ws + WS_BK2);
                BK[(size_t)e0 * T + q0] = (u32x2){(unsigned)(tok * 2), __float_as_uint(w0)}; BK[(size_t)e1 * T + q1] = (u32x2){(unsigned)(tok * 2 + 1), __float_as_uint(w1)};
            }
        }
    }
}

__device__ __forceinline__ void st8(bf16_t* p, f32x4 v0, f32x4 v1) { u32x4 w; w.x = cvt_pk_bf16(v0[0], v0[1]); w.y = cvt_pk_bf16(v0[2], v0[3]); w.z = cvt_pk_bf16(v1[0], v1[1]); w.w = cvt_pk_bf16(v1[2], v1[3]); *(u32x4*)p = w; }
#define EPI_ROWS(ai, m) (u.pm * 256 + (ai) * 128 + wr * 64 + (m) * 16 + fr)

struct EpiRgIn { static constexpr bool PERM = true, FP8 = false, PREFETCH = false; bf16_t* GG; bf16_t* XB;
    __device__ __forceinline__ void operator()(const f32x4 (&acc)[2][2][4][2], const pg8::Unit& u, int wr, int wc, int fr, int fq) const {
        const bool isg = u.pn < 4; bf16_t* base = isg ? GG : XB; const int ct = (u.pn & 3) * 256 + wc * 32 + 8 * fq;
#pragma unroll
        for (int ai = 0; ai < 2; ++ai)
#pragma unroll
            for (int m = 0; m < 4; ++m) { if (!((u.hm >> (2 * ai)) & 1)) continue; bf16_t* rowp = base + (size_t)EPI_ROWS(ai, m) * D + ct;
#pragma unroll
                for (int bj = 0; bj < 2; ++bj) { f32x4 v0 = acc[ai][bj][m][0], v1 = acc[ai][bj][m][1];
                    if (isg) {
#pragma unroll
                        for (int e = 0; e < 4; ++e) { v0[e] = gelu_tanh(v0[e]); v1[e] = gelu_tanh(v1[e]); } }
                    st8(rowp + bj * 128, v0, v1); } }
    } };
struct EpiBf16 { static constexpr bool PERM = true, FP8 = false, PREFETCH = false; bf16_t* O; int ldc;
    __device__ __forceinline__ void operator()(const f32x4 (&acc)[2][2][4][2], const pg8::Unit& u, int wr, int wc, int fr, int fq) const {
        const int ct = u.pn * 256 + wc * 32 + 8 * fq;
#pragma unroll
        for (int ai = 0; ai < 2; ++ai)
#pragma unroll
            for (int m = 0; m < 4; ++m) { if (!((u.hm >> (2 * ai)) & 1)) continue; bf16_t* rowp = O + (size_t)EPI_ROWS(ai, m) * ldc + ct;
#pragma unroll
                for (int bj = 0; bj < 2; ++bj) st8(rowp + bj * 128, acc[ai][bj][m][0], acc[ai][bj][m][1]); }
    } };
struct EpiQKV { static constexpr bool PERM = true, FP8 = false, PREFETCH = false; bf16_t* O; const float* qg; const float* kg; const float* rope; LAS float* xch;
    __device__ __forceinline__ void operator()(const f32x4 (&acc)[2][2][4][2], const pg8::Unit& u, int wr, int wc, int fr, int fq) const {
        if (u.pn == 5) {
            const int ct = u.pn * 256 + wc * 32 + 8 * fq;
#pragma unroll
            for (int ai = 0; ai < 2; ++ai)
#pragma unroll
                for (int m = 0; m < 4; ++m) { if (!((u.hm >> (2 * ai)) & 1)) continue; bf16_t* rowp = O + (size_t)EPI_ROWS(ai, m) * 1536 + ct;
#pragma unroll
                    for (int bj = 0; bj < 2; ++bj) st8(rowp + bj * 128, acc[ai][bj][m][0], acc[ai][bj][m][1]); }
            return; }
        const bool lat = (u.pm % 17) != 0; const float* gv = u.pn < 4 ? qg : kg; const int a = wc >> 1, f0 = 16 * (wc & 1) + 4 * fq;
        const f32x4 g1 = *(const f32x4*)(gv + 64 * a + f0), g2 = *(const f32x4*)(gv + 64 * a + 32 + f0);
        f32x4 cvs[4], svs[4];
        { const int t0 = ((u.pm % 17) - 1) * 256;
#pragma unroll
          for (int q = 0; q < 4; ++q) { cvs[q] = (f32x4){1.f, 1.f, 1.f, 1.f}; svs[q] = (f32x4){0.f, 0.f, 0.f, 0.f};
            if (lat) { const int pos = a ? (16 * q + fr) : ((t0 >> 6) + 2 * (q & 1) + wr); const f32x4 cs0 = *(const f32x4*)(rope + (pos * 32 + f0) * 2), cs1 = *(const f32x4*)(rope + (pos * 32 + f0) * 2 + 4);
                cvs[q] = (f32x4){cs0.x, cs0.z, cs1.x, cs1.z}; svs[q] = (f32x4){cs0.y, cs0.w, cs1.y, cs1.w}; } } }
#pragma unroll
        for (int ai = 0; ai < 2; ++ai)
#pragma unroll
            for (int m = 0; m < 4; ++m)
#pragma unroll
                for (int bj = 0; bj < 2; ++bj) { const f32x4 v0 = acc[ai][bj][m][0], v1 = acc[ai][bj][m][1];
                    float sq = ((v0.x * v0.x + v0.y * v0.y) + (v0.z * v0.z + v0.w * v0.w)) + ((v1.x * v1.x + v1.y * v1.y) + (v1.z * v1.z + v1.w * v1.w));
                    sq += __shfl_xor(sq, 16); sq += __shfl_xor(sq, 32);
                    if (fq == 0) xch[((ai * 128 + wr * 64 + m * 16 + fr) * 2 + bj) * 4 + wc] = sq; }
        asm volatile("s_waitcnt lgkmcnt(0)" ::: "memory"); __builtin_amdgcn_s_barrier(); asm volatile("" ::: "memory");
#pragma unroll
        for (int ai = 0; ai < 2; ++ai)
#pragma unroll
            for (int m = 0; m < 4; ++m) { if (!((u.hm >> (2 * ai)) & 1)) continue; const int row = EPI_ROWS(ai, m);
                const f32x4 cv = a ? cvs[m] : cvs[ai], sv = a ? svs[m] : svs[ai];
#pragma unroll
                for (int bj = 0; bj < 2; ++bj) { const f32x4 p4 = *(const LAS f32x4*)(xch + ((ai * 128 + wr * 64 + m * 16 + fr) * 2 + bj) * 4);
                    const float rstd = rsqrtf(((p4.x + p4.y) + (p4.z + p4.w)) * (1.f / 128.f) + NORM_EPS);
                    const f32x4 x1 = acc[ai][bj][m][0] * rstd * g1, x2 = acc[ai][bj][m][1] * rstd * g2;
                    const f32x4 o1 = x1 * cv - x2 * sv, o2 = x2 * cv + x1 * sv;
                    bf16_t* p = O + (size_t)row * 1536 + u.pn * 256 + bj * 128 + 64 * a + f0;
                    u32x2 w1, w2; w1.x = cvt_pk_bf16(o1.x, o1.y); w1.y = cvt_pk_bf16(o1.z, o1.w); w2.x = cvt_pk_bf16(o2.x, o2.y); w2.y = cvt_pk_bf16(o2.z, o2.w);
                    *(u32x2*)p = w1; *(u32x2*)(p + 32) = w2; } }
    } };
struct EpiCmIn { static constexpr bool PERM = true, FP8 = false, PREFETCH = false; bf16_t* O; f32x2* statp;
    __device__ __forceinline__ void operator()(const f32x4 (&acc)[2][2][4][2], const pg8::Unit& u, int wr, int wc, int fr, int fq) const {
        const int ct = u.pn * 256 + wc * 32 + 8 * fq; const bool isv = u.pn >= 8;
#pragma unroll
        for (int ai = 0; ai < 2; ++ai)
#pragma unroll
            for (int m = 0; m < 4; ++m) { if (!((u.hm >> (2 * ai)) & 1)) continue; const int row = EPI_ROWS(ai, m); bf16_t* rowp = O + (size_t)row * 4096 + ct; float s = 0.f, q = 0.f;
#pragma unroll
                for (int bj = 0; bj < 2; ++bj) { f32x4 v0 = acc[ai][bj][m][0], v1 = acc[ai][bj][m][1];
#pragma unroll
                    for (int e = 0; e < 4; ++e) { v0[e] = gelu_tanh(v0[e]); v1[e] = gelu_tanh(v1[e]); }
                    u32x4 w; w.x = cvt_pk_bf16(v0[0], v0[1]); w.y = cvt_pk_bf16(v0[2], v0[3]); w.z = cvt_pk_bf16(v1[0], v1[1]); w.w = cvt_pk_bf16(v1[2], v1[3]);
                    *(u32x4*)(rowp + bj * 128) = w;
                    const float r0 = bflo(w.x), r1 = bfhi(w.x), r2 = bflo(w.y), r3 = bfhi(w.y), r4 = bflo(w.z), r5 = bfhi(w.z), r6 = bflo(w.w), r7 = bfhi(w.w);
                    s += ((r0 + r1) + (r2 + r3)) + ((r4 + r5) + (r6 + r7)); q += ((r0 * r0 + r1 * r1) + (r2 * r2 + r3 * r3)) + ((r4 * r4 + r5 * r5) + (r6 * r6 + r7 * r7)); }
                if (isv) { s += __shfl_xor(s, 16); s += __shfl_xor(s, 32); q += __shfl_xor(q, 16); q += __shfl_xor(q, 32);
                    if (fq == 0) statp[(size_t)row * 32 + (u.pn - 8) * 4 + wc] = (f32x2){s, q}; } }
    } };
struct EpiResid { static constexpr bool PERM = true, FP8 = false, PREFETCH = false; bf16_t* YM; const float* gate  ;
    __device__ __forceinline__ void operator()(const f32x4 (&acc)[2][2][4][2], const pg8::Unit& u, int wr, int wc, int fr, int fq) const {
        const int sidx = sidx_of_row(u.pm * 256); const float* gp = gate + (size_t)sidx * NMODV; const int ct = u.pn * 256 + wc * 32 + 8 * fq;
        f32x4 gv[2][2];
#pragma unroll
        for (int bj = 0; bj < 2; ++bj)
#pragma unroll
            for (int n = 0; n < 2; ++n) gv[bj][n] = *(const f32x4*)(gp + ct + bj * 128 + n * 4);
#pragma unroll
        for (int ai = 0; ai < 2; ++ai)
#pragma unroll
            for (int m = 0; m < 4; ++m) { if (!((u.hm >> (2 * ai)) & 1)) continue; bf16_t* rowp = YM + (size_t)EPI_ROWS(ai, m) * D + ct;
#pragma unroll
                for (int bj = 0; bj < 2; ++bj) st8(rowp + bj * 128, gv[bj][0] * acc[ai][bj][m][0], gv[bj][1] * acc[ai][bj][m][1]); }
    } };
struct EpiRgGate { static constexpr bool PERM = true, FP8 = false, PREFETCH = false; const bf16_t* XC; bf16_t* LA; bf16_t* BB; const float* ba; const float* bi; const float* lam;
    __device__ __forceinline__ void operator()(const f32x4 (&acc)[2][2][4][2], const pg8::Unit& u, int wr, int wc, int fr, int fq) const {
        const int d = u.pn >> 3, blk = u.pn & 7;
        asm volatile("" : "+v"(fr), "+v"(fq));
        const int ch = blk * 128 + wc * 32 + 8 * fq;
        u32x4 xw[8];
#pragma unroll
        for (int r = 0; r < 8; ++r) xw[r] = *(const u32x4*)(XC + (size_t)EPI_ROWS(r >> 2, r & 3) * D + ch);
        f32x4 bav[2], biv[2], spv[2];
#pragma unroll
        for (int n = 0; n < 2; ++n) { bav[n] = *(const f32x4*)(ba + d * D + ch + 4 * n); biv[n] = *(const f32x4*)(bi + d * D + ch + 4 * n); spv[n] = *(const f32x4*)(lam + d * D + ch + 4 * n); }
#pragma unroll
        for (int r = 0; r < 8; ++r) { const int ai = r >> 2, m = r & 3; if (!((u.hm >> (2 * ai)) & 1)) continue;
            const size_t off = (size_t)EPI_ROWS(ai, m) * D + ch;
            const float xc[8] = {bflo(xw[r].x), bfhi(xw[r].x), bflo(xw[r].y), bfhi(xw[r].y), bflo(xw[r].z), bfhi(xw[r].z), bflo(xw[r].w), bfhi(xw[r].w)};
            float la[8], bb[8];
#pragma unroll
            for (int n = 0; n < 2; ++n)
#pragma unroll
                for (int e = 0; e < 4; ++e) { const float rg = fast_sigmoid(acc[ai][0][m][n][e] + bav[n][e]), ig = fast_sigmoid(acc[ai][1][m][n][e] + biv[n][e]);
                    const float lga = rg * spv[n][e]; la[4 * n + e] = lga; bb[4 * n + e] = __builtin_amdgcn_sqrtf(one_minus_exp(-2.f * lga)) * ig * xc[4 * n + e]; }
            u32x4 w; w.x = cvt_pk_bf16(la[0], la[1]); w.y = cvt_pk_bf16(la[2], la[3]); w.z = cvt_pk_bf16(la[4], la[5]); w.w = cvt_pk_bf16(la[6], la[7]);
            *(u32x4*)(LA + (size_t)d * T * D + off) = w;
            w.x = cvt_pk_bf16(bb[0], bb[1]); w.y = cvt_pk_bf16(bb[2], bb[3]); w.z = cvt_pk_bf16(bb[4], bb[5]); w.w = cvt_pk_bf16(bb[6], bb[7]);
            *(u32x4*)(BB + (size_t)d * T * D + off) = w; }
    } };

template <bool G1>
struct MoeOrder {
    static constexpr bool GATHER = G1;
    const LAS int* tab; const char* A; const char* B; const int* BK; int G, c, nunits; size_t bstride; int arow, brow;
    __device__ bool next(int i, pg8::Unit& u) const {
        int L, hm; if (!pg8::unit_slot(i, c, G, nunits, L, hm)) return false; u.hm = __builtin_amdgcn_readfirstlane(hm);
        const int wgid = __builtin_amdgcn_readfirstlane(pg8::xcd_remap(L, nunits)); const int tau = wgid >> 2, pn = wgid & 3;
        const int e = __builtin_amdgcn_readfirstlane(tab[192 + tau]);
        u.pm = tau; u.pn = pn; u.aux0 = e; u.aux1 = __builtin_amdgcn_readfirstlane((tau - tab[e]) * 256);
        u.a = pg8::uptr(G1 ? A : A + (size_t)tau * 256 * arow);
        u.b = pg8::uptr(B + (size_t)e * bstride + (size_t)pn * 256 * brow);
        return true; }
    __device__ unsigned goff(const pg8::Unit& u, int row) const {
        const int pos = u.aux1 + row; const int cnt = tab[40 + u.aux0];
        int tok = 0; if (pos < cnt) tok = __builtin_nontemporal_load(BK + ((size_t)u.aux0 * T + pos) * 2) >> 1;
        return (unsigned)tok * (unsigned)arow; }
};
struct EpiMoe1 { static constexpr bool PERM = true, FP8 = (MOE_FP8 != 0), PREFETCH = false; uchar* H1;
    __device__ __forceinline__ void operator()(const f32x4 (&acc)[2][2][4][2], const pg8::Unit& u, int wr, int wc, int fr, int fq) const {
        const int ct = u.pn * 128 + wc * 32 + 8 * fq;
#pragma unroll
        for (int ai = 0; ai < 2; ++ai)
#pragma unroll
            for (int m = 0; m < 4; ++m) { if (!((u.hm >> (2 * ai)) & 1)) continue; f32x4 h0, h1;
#pragma unroll
                for (int e = 0; e < 4; ++e) { constexpr float WS_ = FP8 ? (1.f / 32.f) : 1.f;
                    const float g0 = acc[ai][0][m][0][e] * WS_, g1 = acc[ai][0][m][1][e] * WS_; h0[e] = g0 * sigmoidf_(g0) * (acc[ai][1][m][0][e] * WS_); h1[e] = g1 * sigmoidf_(g1) * (acc[ai][1][m][1][e] * WS_); }
                if constexpr (FP8) { int r0 = __builtin_amdgcn_cvt_pk_fp8_f32(h0[0], h0[1], 0, false); r0 = __builtin_amdgcn_cvt_pk_fp8_f32(h0[2], h0[3], r0, true);
                    int r1 = __builtin_amdgcn_cvt_pk_fp8_f32(h1[0], h1[1], 0, false); r1 = __builtin_amdgcn_cvt_pk_fp8_f32(h1[2], h1[3], r1, true);
                    *(u32x2*)(H1 + (size_t)EPI_ROWS(ai, m) * DEXP + ct) = (u32x2){(unsigned)r0, (unsigned)r1}; }
                else st8((bf16_t*)H1 + (size_t)EPI_ROWS(ai, m) * DEXP + ct, h0, h1); }
    } };
struct EpiMoe2 { static constexpr bool PERM = true, FP8 = (MOE_FP8 != 0), PREFETCH = true; bf16_t* YS; const int* BK; const LAS int* tab;
    typedef int pre_t __attribute__((ext_vector_type(16)));
    __device__ __forceinline__ pre_t prefetch(const pg8::Unit& u, int wr, int fr) const { pre_t p; const int cnt = tab[40 + u.aux0];
#pragma unroll
        for (int r = 0; r < 8; ++r) { const int pos = u.aux1 + (r >> 2) * 128 + wr * 64 + (r & 3) * 16 + fr; u32x2 v = {0xffffffffu, 0u}; if (pos < cnt) v = __builtin_nontemporal_load((const u32x2*)BK + (size_t)u.aux0 * T + pos); p[2 * r] = (int)v.x; p[2 * r + 1] = (int)v.y; }
        return p; }
    __device__ __forceinline__ void operator()(const f32x4 (&acc)[2][2][4][2], const pg8::Unit& u, int wr, int wc, int fr, int fq, const pre_t& pre) const {
        const int ct = u.pn * 256 + wc * 32 + 8 * fq;
#pragma unroll
        for (int r = 0; r < 8; ++r) { const int e_ = pre[2 * r];
            if (e_ >= 0 && ((u.hm >> (2 * (r >> 2))) & 1)) { const int tok = e_ >> 1, slot = e_ & 1; const float w = __int_as_float(pre[2 * r + 1]) * (FP8 ? (1.f / 32.f) : 1.f);
                bf16_t* yp = YS + ((size_t)slot * T + tok) * D + ct;
#pragma unroll
                for (int bj = 0; bj < 2; ++bj) st8(yp + bj * 128, acc[r >> 2][bj][r & 3][0] * w, acc[r >> 2][bj][r & 3][1] * w); } }
    } };
__device__ __forceinline__ int moe_table(Frame& F, int l, LAS int* tab) {
    __syncthreads();
    if (F.tid < 32) { const unsigned c = __hip_atomic_load((unsigned*)(F.ws + WS_CTL) + CW_CNT + (l * 32 + F.tid) * 64, RLX_AGENT); tab[40 + F.tid] = (int)c; }
    __syncthreads();
    if (F.tid == 0) { int s = 0;
#pragma unroll 1
        for (int e = 0; e < 32; ++e) { tab[e] = s; s += (tab[40 + e] + 255) >> 8; } tab[32] = s; }
    __syncthreads();
    const int ntile_ = tab[32];
    for (int tau = F.tid; tau < ntile_; tau += 512) { int e = 0;
#pragma unroll 1
        for (int k = 1; k < 32; ++k) e = (tab[k] <= tau) ? k : e;
        tab[192 + tau] = e; }
    __syncthreads();
    return ntile_;
}

__device__ __forceinline__ void conv_phase(Frame& F, int j) {
    const bf16_t* XB = (const bf16_t*)(F.ws + WS_XB); bf16_t* XC = (bf16_t*)(F.ws + WS_XC);
    const float* cw = inp(F, I_RGCW) + (size_t)j * 4 * D; const float* cb = inp(F, I_RGCB) + (size_t)j * D;
    const int NGT = F.G * 512;
    for (int i0 = F.bid * 512 + F.tid; i0 < T * 128; i0 += 2 * NGT) {
        u32x4 xw[2][4];
#pragma unroll
        for (int q = 0; q < 2; ++q) { const int i = i0 + q * NGT; const int row = i >> 7, c = (i & 127) * 8; const int b = row / SB, s = row - b * SB; const int lo = s < CTX ? 0 : CTX, hi = s < CTX ? CTX : SB;
#pragma unroll
            for (int k = 0; k < 4; ++k) { const int ss = s + k - 2; xw[q][k] = (u32x4){0u, 0u, 0u, 0u}; if (i < T * 128 && ss >= lo && ss < hi) xw[q][k] = *(const u32x4*)(XB + (size_t)(b * SB + ss) * D + c); } }
#pragma unroll
        for (int q = 0; q < 2; ++q) { const int i = i0 + q * NGT; if (i < T * 128) { const int row = i >> 7, c = (i & 127) * 8;
            float a[8];
#pragma unroll
            for (int e = 0; e < 8; ++e) a[e] = cb[c + e];
#pragma unroll
            for (int k = 0; k < 4; ++k) { const f32x4 w0 = *(const f32x4*)(cw + k * D + c), w1 = *(const f32x4*)(cw + k * D + c + 4); const u32x4 x = xw[q][k];
                a[0] += w0.x * bflo(x.x); a[1] += w0.y * bfhi(x.x); a[2] += w0.z * bflo(x.y); a[3] += w0.w * bfhi(x.y);
                a[4] += w1.x * bflo(x.z); a[5] += w1.y * bfhi(x.z); a[6] += w1.z * bflo(x.w); a[7] += w1.w * bfhi(x.w); }
            u32x4 o; o.x = pk2(a[0], a[1]); o.y = pk2(a[2], a[3]); o.z = pk2(a[4], a[5]); o.w = pk2(a[6], a[7]);
            *(u32x4*)(XC + (size_t)row * D + c) = o; } }
    }
}
__device__ __forceinline__ void scan1_phase(Frame& F) {
    const bf16_t* LA = (const bf16_t*)(F.ws + WS_LA); const bf16_t* BB = (const bf16_t*)(F.ws + WS_BB); float* TS = (float*)(F.ws + WS_TOTS); float* TH = (float*)(F.ws + WS_TOTH);
    for (int it = F.bid * 8 + F.wave; it < NB * 2 * NCH * 4; it += F.G * 8) {
        const int cg = it & 3, rest = it >> 2, ck = rest % NCH, bd = rest / NCH, dir = bd & 1, b = bd >> 1;
        const int c = cg * 256 + F.lane * 4; const size_t base = (size_t)dir * T * D + (size_t)(b * SB + ck * 16) * D + c;
        u32x2 la[16], bb[16];
#pragma unroll
        for (int t = 0; t < 16; ++t) { const size_t o = base + (size_t)(dir ? 15 - t : t) * D; la[t] = *(const u32x2*)(LA + o); bb[t] = *(const u32x2*)(BB + o); }
        f32x4 sl = {0.f, 0.f, 0.f, 0.f}, h = {0.f, 0.f, 0.f, 0.f};
#pragma unroll
        for (int t = 0; t < 16; ++t) { const f32x4 l4 = {bflo(la[t].x), bfhi(la[t].x), bflo(la[t].y), bfhi(la[t].y)}, b4 = {bflo(bb[t].x), bfhi(bb[t].x), bflo(bb[t].y), bfhi(bb[t].y)};
            sl += l4; f32x4 a4 = {__expf(l4.x), __expf(l4.y), __expf(l4.z), __expf(l4.w)}; h = a4 * h + b4; }
        const size_t o = (size_t)(bd * NCH + ck) * D + c; *(f32x4*)(TS + o) = sl; *(f32x4*)(TH + o) = h;
    }
}
__device__ __forceinline__ void scan2_phase(Frame& F) {
    const float* TS = (const float*)(F.ws + WS_TOTS); const float* TH = (const float*)(F.ws + WS_TOTH); float* CY = (float*)(F.ws + WS_CARRY);
    LAS float* wt = (LAS float*)F.lds;
    for (int it = F.bid; it < NB * 2 * 16; it += F.G) {
        const int cg = it & 15, bd = it >> 4, dir = bd & 1; const int c = cg * 64 + F.lane; const size_t base = (size_t)bd * NCH * D + c;
        const int s0 = F.wave * 34;
        float P = 0.f, H = 0.f;
#pragma unroll 1
        for (int sb = 0; sb < 34; sb += 17) { float sl[17], hl[17];
#pragma unroll
            for (int q = 0; q < 17; ++q) { const int s = s0 + sb + q; const int ck = dir ? (s < 16 ? 15 - s : NCH + 15 - s) : s; sl[q] = TS[base + (size_t)ck * D]; hl[q] = TH[base + (size_t)ck * D]; }
#pragma unroll
            for (int q = 0; q < 17; ++q) { P += sl[q]; H = __expf(sl[q]) * H + hl[q]; } }
        __syncthreads();
        wt[(F.wave * 2 + 0) * 64 + F.lane] = P; wt[(F.wave * 2 + 1) * 64 + F.lane] = H;
        __syncthreads();
        float h = 0.f;
        for (int w = 0; w < F.wave; ++w) h = __expf(wt[(w * 2 + 0) * 64 + F.lane]) * h + wt[(w * 2 + 1) * 64 + F.lane];
#pragma unroll 1
        for (int sb = 0; sb < 34; sb += 17) { float sl[17], hl[17]; int ckk[17];
#pragma unroll
            for (int q = 0; q < 17; ++q) { const int s = s0 + sb + q; ckk[q] = dir ? (s < 16 ? 15 - s : NCH + 15 - s) : s; sl[q] = TS[base + (size_t)ckk[q] * D]; hl[q] = TH[base + (size_t)ckk[q] * D]; }
#pragma unroll
            for (int q = 0; q < 17; ++q) { CY[base + (size_t)ckk[q] * D] = h; h = __expf(sl[q]) * h + hl[q]; } }
    }
    __syncthreads();
}
__device__ __forceinline__ void scan3_phase(Frame& F) {
    const bf16_t* LA = (const bf16_t*)(F.ws + WS_LA); const bf16_t* BB = (const bf16_t*)(F.ws + WS_BB); const float* CY = (const float*)(F.ws + WS_CARRY);
    const bf16_t* GG = (const bf16_t*)(F.ws + WS_GG); bf16_t* SA = (bf16_t*)(F.ws + WS_SA);
    LAS f32x4* hb = (LAS f32x4*)(F.lds + F.wave * 16384);
    for (int it = F.bid * 8 + F.wave; it < NB * NCH * 4; it += F.G * 8) {
        const int cg = it & 3, rest = it >> 2, ck = rest % NCH, b = rest / NCH;
        const int c = cg * 256 + F.lane * 4;
        const size_t rbase = (size_t)(b * SB + ck * 16) * D + c, b1 = (size_t)T * D + rbase;
        f32x4 hbk = *(const f32x4*)(CY + (size_t)((b * 2 + 1) * NCH + ck) * D + c), hf = *(const f32x4*)(CY + (size_t)((b * 2 + 0) * NCH + ck) * D + c);
        { u32x2 la[16], bb[16];
#pragma unroll
          for (int t = 0; t < 16; ++t) { la[t] = *(const u32x2*)(LA + b1 + (size_t)(15 - t) * D); bb[t] = *(const u32x2*)(BB + b1 + (size_t)(15 - t) * D); }
#pragma unroll
          for (int t = 0; t < 16; ++t) { const f32x4 l4 = {bflo(la[t].x), bfhi(la[t].x), bflo(la[t].y), bfhi(la[t].y)}, b4 = {bflo(bb[t].x), bfhi(bb[t].x), bflo(bb[t].y), bfhi(bb[t].y)};
              const f32x4 a4 = {__expf(l4.x), __expf(l4.y), __expf(l4.z), __expf(l4.w)}; hbk = a4 * hbk + b4; hb[(15 - t) * 64 + F.lane] = hbk; } }
        { u32x2 la[16], bb[16], gg[16];
#pragma unroll
          for (int t = 0; t < 16; ++t) { la[t] = *(const u32x2*)(LA + rbase + (size_t)t * D); bb[t] = *(const u32x2*)(BB + rbase + (size_t)t * D); gg[t] = *(const u32x2*)(GG + rbase + (size_t)t * D); }
#pragma unroll
          for (int t = 0; t < 16; ++t) { const f32x4 l4 = {bflo(la[t].x), bfhi(la[t].x), bflo(la[t].y), bfhi(la[t].y)}, b4 = {bflo(bb[t].x), bfhi(bb[t].x), bflo(bb[t].y), bfhi(bb[t].y)};
              const f32x4 g4 = {bflo(gg[t].x), bfhi(gg[t].x), bflo(gg[t].y), bfhi(gg[t].y)};
              const f32x4 a4 = {__expf(l4.x), __expf(l4.y), __expf(l4.z), __expf(l4.w)}; hf = a4 * hf + b4; const f32x4 y = g4 * (hf + hb[t * 64 + F.lane]);
              u32x2 o; o.x = pk2(y.x, y.y); o.y = pk2(y.z, y.w); *(u32x2*)(SA + rbase + (size_t)t * D) = o; } }
    }
}

__device__ __forceinline__ void qknorm_phase(Frame& F) {
    bf16_t* QKV = (bf16_t*)(F.ws + WS_QKV); const f32x2* ROPE = (const f32x2*)(F.ws + WS_ROPE);
    const int i16 = F.lane & 15, grp = F.lane >> 4; const float* pqg = inp(F, I_ATQG); const float* pkg = inp(F, I_ATKG);
    const int ITS = F.G * 32;
    for (int it0 = (F.bid * 8 + F.wave) * 4 + grp; it0 < T * 10; it0 += 4 * ITS) {
        u32x4 xw4[4];
#pragma unroll
        for (int q = 0; q < 4; ++q) { const int it = it0 + q * ITS; xw4[q] = (u32x4){0u, 0u, 0u, 0u}; if (it < T * 10) { const int row = it / 10, hh = it - row * 10; xw4[q] = *(const u32x4*)(QKV + (size_t)row * 1536 + hh * 128 + i16 * 8); } }
#pragma unroll
        for (int q = 0; q < 4; ++q) { const int it = it0 + q * ITS; const bool valid = it < T * 10; const int itc = valid ? it : 0;
            const int row = itc / 10, hh = itc - row * 10; const int b = row / SB, s = row - b * SB;
            bf16_t* p = QKV + (size_t)row * 1536 + hh * 128 + i16 * 8;
            const u32x4 xw = xw4[q];
            float x[8] = {bflo(xw.x), bfhi(xw.x), bflo(xw.y), bfhi(xw.y), bflo(xw.z), bfhi(xw.z), bflo(xw.w), bfhi(xw.w)};
            float ss = 0.f;
#pragma unroll
            for (int e = 0; e < 8; ++e) ss += x[e] * x[e];
            ss = wave16_sum(ss);
            const float rstd = rsqrtf(ss * (1.f / 128.f) + NORM_EPS);
            const float* g = (hh < 8 ? pqg : pkg) + i16 * 8;
#pragma unroll
            for (int e = 0; e < 8; ++e) x[e] = x[e] * rstd * g[e];
            float y[8];
#pragma unroll
            for (int e = 0; e < 8; ++e) y[e] = __shfl_xor(x[e], 4);
            if (s >= CTX) { const int t = s - CTX; const int pos = (i16 >> 3) ? (t & 63) : (t >> 6); const bool half1 = (i16 >> 2) & 1;
#pragma unroll
                for (int e = 0; e < 8; ++e) { const f32x2 cs = ROPE[pos * 32 + (i16 & 3) * 8 + e];
                    x[e] = half1 ? (x[e] * cs.x + y[e] * cs.y) : (x[e] * cs.x - y[e] * cs.y); } }
            u32x4 o; o.x = pk2(x[0], x[1]); o.y = pk2(x[2], x[3]); o.z = pk2(x[4], x[5]); o.w = pk2(x[6], x[7]);
            if (valid) *(u32x4*)p = o;
        }
    }
}
__device__ __forceinline__ void attn_phase(Frame& F) {
    const bf16_t* QKV = (const bf16_t*)(F.ws + WS_QKV); bf16_t* AO = (bf16_t*)(F.ws + WS_AO);
    for (int u = F.bid; u < 544; u += F.G) {
        int b, h, q0, k0, seq;
        if (u < 512) { const int qb = u & 15, hg = (u >> 4) & 3, kvh = (u >> 6) & 1; b = u >> 7; h = kvh * 4 + hg; q0 = b * SB + CTX + qb * 256; k0 = b * SB; seq = SB; }
        else { const int v = u - 512; b = v >> 3; h = v & 7; q0 = b * SB; k0 = b * SB; seq = CTX; }
        const int kvh = h >> 2;
        const bf16_t* Kp = (const bf16_t*)pg8::uptr((const char*)(QKV + (size_t)k0 * 1536 + 1024 + kvh * 128));
        att::attn_dense_body((const bf16_t*)pg8::uptr((const char*)(QKV + (size_t)q0 * 1536 + h * 128)), Kp, Kp + 256, (bf16_t*)pg8::uptr((const char*)(AO + (size_t)q0 * D + h * 128)), seq, F.ldsg, F.tid);
        __syncthreads();
    }
}

__device__ __forceinline__ void spatial_phase(Frame& F) {
    const bf16_t* UVB = (const bf16_t*)(F.ws + WS_UVB); bf16_t* UV = (bf16_t*)(F.ws + WS_UV); const f32x2* statp = (const f32x2*)(F.ws + WS_STATP);
    const bf16_t* Ws = (const bf16_t*)(F.ws + WS_W_CMS); const float* lng = inp(F, I_CMLNG); const float* lnb = inp(F, I_CMLNB); const float* bs = inp(F, I_CMBS);
    LAS uchar* vl = F.lds;
    LAS f32x2* st = (LAS f32x2*)(F.lds + 65536);
    const int tid = F.tid, lane = F.lane, wid = F.wave, r32 = lane & 31, hi = lane >> 5, wm = wid & 3, wn = wid >> 2;
    const int sr = tid >> 4, sc = (tid & 15) * 8;
    for (int u = F.bid; u < 136 * 8; u += F.G) {
        const int chunk = u >> 3, g = u & 7; const int row0 = chunk * 128;
        float s_ = 0.f, q_ = 0.f;
        { const f32x2* sp = statp + (size_t)(row0 + (tid >> 2)) * 32 + (tid & 3) * 8; f32x2 pv[8];
#pragma unroll
          for (int k = 0; k < 8; ++k) pv[k] = sp[k];
#pragma unroll
          for (int k = 0; k < 8; ++k) { s_ += pv[k].x; q_ += pv[k].y; } }
        u32x4 xw[2][4]; f32x4 lg0[2], lg1[2], lb0[2], lb1[2];
#pragma unroll
        for (int ch = 0; ch < 2; ++ch) { const int cg = g * 256 + ch * 128 + sc;
            lg0[ch] = *(const f32x4*)(lng + cg); lg1[ch] = *(const f32x4*)(lng + cg + 4); lb0[ch] = *(const f32x4*)(lnb + cg); lb1[ch] = *(const f32x4*)(lnb + cg + 4);
#pragma unroll
            for (int i = 0; i < 4; ++i) xw[ch][i] = *(const u32x4*)(UVB + (size_t)(row0 + sr + 32 * i) * 4096 + 2048 + cg); }
        bf16x8 pa[2][4];
#pragma unroll
        for (int kt = 0; kt < 2; ++kt)
#pragma unroll
            for (int ks = 0; ks < 4; ++ks) pa[kt][ks] = *(const bf16x8*)(Ws + ((size_t)g * 128 + 32 * wm + r32) * 128 + 64 * kt + 16 * ks + 8 * hi);
        u32x4 uu[8];
#pragma unroll
        for (int i = 0; i < 8; ++i) { const int id = tid + 512 * i, row = id >> 5, ch = id & 31; uu[i] = *(const u32x4*)(UVB + (size_t)(row0 + row) * 4096 + g * 256 + ch * 8); }
        s_ += __int_as_float(__builtin_amdgcn_update_dpp(0, __float_as_int(s_), 0xB1, 0xF, 0xF, true)); s_ += __int_as_float(__builtin_amdgcn_update_dpp(0, __float_as_int(s_), 0x4E, 0xF, 0xF, true));
        q_ += __int_as_float(__builtin_amdgcn_update_dpp(0, __float_as_int(q_), 0xB1, 0xF, 0xF, true)); q_ += __int_as_float(__builtin_amdgcn_update_dpp(0, __float_as_int(q_), 0x4E, 0xF, 0xF, true));
        __syncthreads();
        if ((tid & 3) == 0) { const float mean = s_ * (1.f / 2048.f); const float var = fmaxf(q_ * (1.f / 2048.f) - mean * mean, 0.f); st[tid >> 2] = (f32x2){mean, rsqrtf(var + NORM_EPS)}; }
        __syncthreads();
#pragma unroll
        for (int ch = 0; ch < 2; ++ch) {
#pragma unroll
            for (int i = 0; i < 4; ++i) { const int q = sr + 32 * i; const u32x4 x_ = xw[ch][i]; const f32x2 ms = st[q];
                f32x4 v0 = {bflo(x_.x), bfhi(x_.x), bflo(x_.y), bfhi(x_.y)}, v1 = {bflo(x_.z), bfhi(x_.z), bflo(x_.w), bfhi(x_.w)};
                v0 = (v0 - ms.x) * ms.y * lg0[ch] + lb0[ch]; v1 = (v1 - ms.x) * ms.y * lg1[ch] + lb1[ch];
                u32x4 o; o.x = pk2(v0.x, v0.y); o.y = pk2(v0.z, v0.w); o.z = pk2(v1.x, v1.y); o.w = pk2(v1.z, v1.w);
                *(LAS u32x4*)(vl + ((q >> 6) * 2 + ch) * 16384 + att::v_st(q & 63, sc)) = o; } }
        __syncthreads();
        f32x16 o[4] = {};
        const int vb = (int)(uintptr_t)(F.ldsg) + att::v_rd_base(lane) + wn * 16384;
        att::pv_d0(o, vb, pa[0][0], pa[0][1], pa[0][2], pa[0][3]);
        att::pv_d0(o, vb + 32768, pa[1][0], pa[1][1], pa[1][2], pa[1][3]);
        __syncthreads();
#pragma unroll
        for (int r = 0; r < 16; ++r) { const int p = 32 * wm + att::crow(r, hi); const float bsv = bs[g * 128 + p];
#pragma unroll
            for (int d0 = 0; d0 < 4; ++d0) *(LAS bf16_t*)(vl + p * 512 + (128 * wn + 32 * d0 + r32) * 2) = (bf16_t)f2bf(o[d0][r] + bsv); }
        __syncthreads();
#pragma unroll
        for (int i = 0; i < 8; ++i) { const int id = tid + 512 * i, row = id >> 5, ch = id & 31; const u32x4 v = *(const LAS u32x4*)(vl + row * 512 + ch * 16); const u32x4 w = uu[i];
            u32x4 o4; o4.x = pk2(bflo(v.x) * bflo(w.x), bfhi(v.x) * bfhi(w.x)); o4.y = pk2(bflo(v.y) * bflo(w.y), bfhi(v.y) * bfhi(w.y)); o4.z = pk2(bflo(v.z) * bflo(w.z), bfhi(v.z) * bfhi(w.z)); o4.w = pk2(bflo(v.w) * bflo(w.w), bfhi(v.w) * bfhi(w.w));
            *(u32x4*)(UV + (size_t)(row0 + row) * 2048 + g * 256 + ch * 8) = o4; }
    }
    __syncthreads();
}

__device__ __forceinline__ void final_phase(Frame& F) {
    const f32x4* X = (const f32x4*)(F.ws + WS_X); const u32x2* YS = (const u32x2*)(F.ws + WS_Y1); const u32x2* YM = (const u32x2*)(F.ws + WS_YM); f32x4* out = (f32x4*)F.out;
    const f32x4* G5 = (const f32x4*)((const float*)(F.ws + WS_MOD) + (size_t)(DEPTH - 1) * 5 * NMODV + 5 * D);
    const int NGT = F.G * 512;
    for (int i0 = F.bid * 512 + F.tid; i0 < NB * SEQ * 256; i0 += 4 * NGT) { f32x4 a[4]; u32x2 y0[4], y1[4], ym[4];
#pragma unroll
        for (int q = 0; q < 4; ++q) { const int i = i0 + q * NGT; if (i < NB * SEQ * 256) { const int r = i >> 8, c4 = i & 255, b = r >> 12, t = r & 4095; const size_t src = ((size_t)(b * SB + CTX + t) << 8) + c4; a[q] = X[src]; y0[q] = YS[src]; y1[q] = YS[src + (size_t)T * 256]; ym[q] = YM[src]; } }
#pragma unroll
        for (int q = 0; q < 4; ++q) { const int i = i0 + q * NGT; if (i < NB * SEQ * 256) { const int r = i >> 8, c4 = i & 255, b = r >> 12; const f32x4 g5 = G5[(size_t)b * (NMODV / 4) + c4];
            out[i] = a[q] + (f32x4){bflo(ym[q].x), bfhi(ym[q].x), bflo(ym[q].y), bfhi(ym[q].y)} + g5 * (f32x4){bflo(y0[q].x) + bflo(y1[q].x), bfhi(y0[q].x) + bfhi(y1[q].x), bflo(y0[q].y) + bflo(y1[q].y), bfhi(y0[q].y) + bfhi(y1[q].y)}; } } }
}

constexpr int NPHASE = 38;
__global__ void __launch_bounds__(512, 2) mk_fwd(Args args) {
    extern __shared__ __attribute__((aligned(16))) uchar lds[];
    Frame F; F.lds = (LAS uchar*)lds; F.ldsg = (char*)lds; F.tid = threadIdx.x; F.lane = F.tid & 63; F.wave = __builtin_amdgcn_readfirstlane(F.tid >> 6); F.G = gridDim.x; F.bid = blockIdx.x;
    F.ws = args.ws; F.out = args.out;
    uchar* ws0 = args.ws;
    volatile LAS unsigned* MISC = (volatile LAS unsigned*)(F.lds + LDSCTL_OFF);
    LAS int* tab = (LAS int*)(F.lds + LDSCTL_OFF + 256);
    for (int u = F.tid; u < (LDS_BYTES - LDSCTL_OFF) / 4; u += 512) ((LAS unsigned*)(F.lds + LDSCTL_OFF))[u] = 0u;
    __syncthreads();
    if (F.tid == 0) {
#pragma unroll
        for (int i = 0; i < 34; ++i) *(LAS unsigned long long*)(F.lds + LDSCTL_OFF + 576 + i * 8) = (unsigned long long)args.in[i]; }
    __syncthreads();
    const int lo = args.ph_lo, hi = args.ph_hi;
    if (hi - lo > 1) (void)xcd_barrier_post((unsigned*)(ws0 + WS_CTL) + CW_BAR, MISC + 8);
    int ph = 0;
#define PH_BEGIN if (ph >= opaque_uniform_int(args.ph_lo) && ph < opaque_uniform_int(args.ph_hi)) { int t_ = threadIdx.x; F.G = opaque_uniform_int(gridDim.x); F.bid = opaque_uniform_int(blockIdx.x); const int cid = F.bid; (void)cid; \
        F.out = (float*)opaque_uniform_ptr(args.out); F.lds = (LAS uchar*)lds; F.ldsg = (char*)lds; \
        asm volatile("" : "+v"(t_)); F.tid = t_; F.lane = t_ & 63; F.wave = __builtin_amdgcn_readfirstlane(t_ >> 6); \
        uchar* ws = (uchar*)opaque_uniform_ptr(args.ws); F.ws = ws; \
        const float* MODl = (const float*)(ws + WS_MOD) + (size_t)l_ * 5 * NMODV; (void)MODl;
#define GRIDBAR  { XcdBarrier bb_; bb_.bar = (unsigned*)(ws + WS_CTL) + CW_BAR; bb_.x = 0; bb_.st = (volatile LAS unsigned*)(F.lds + LDSCTL_OFF) + 8; xcd_barrier(bb_); }
#define REPBAR   if (rep_ > 1) GRIDBAR
#define PH_END   if (ph + 1 < opaque_uniform_int(args.ph_hi)) GRIDBAR } ++ph;

    { const int l_ = 0; PH_BEGIN PM(0) { const bool dry = rep_ > 1; (void)dry;  p0_prologue(F);  REPBAR } PH_END }

#pragma unroll 1
    for (int l = 0; l < DEPTH; ++l) {
        const int kind = l % 3, j = l / 3; const bool lastl = (l == DEPTH - 1); const int l_ = l;
        PH_BEGIN PM(1) { const bool dry = rep_ > 1; (void)dry;  const float* gv_ = inp(F, I_NMG) + l * D;
            if (l == 0) norm_phase<false, 0, true>(F, l, gv_, 0, false, false);
            else if (rep_ != REPN(1)) norm_phase<false, 0, false>(F, l, gv_, 0, false, false);
            else if (l == 1) norm_phase<false, 3, true>(F, l, gv_, 0, false, false);
            else norm_phase<false, 3, false>(F, l, gv_, 0, false, false);  REPBAR } PH_END
        if (kind == 0) {
            PH_BEGIN PM(2) { const bool dry = rep_ > 1; (void)dry;  { pg8::DenseOrder S; S.init(ws + WS_H, D, ws + WS_W_RGIN + (size_t)j * 2048 * 1024 * 2, D, T, 2048, F.G, cid);
                EpiRgIn E{(bf16_t*)(ws + WS_GG), (bf16_t*)(ws + WS_XB)}; pg8::gemm_phase(F.lds, S, E, D, D, D); }  REPBAR } PH_END
            PH_BEGIN PM(3) { const bool dry = rep_ > 1; (void)dry;  conv_phase(F, j);  REPBAR } PH_END
            PH_BEGIN PM(4) { const bool dry = rep_ > 1; (void)dry;  { pg8::DenseOrder S; S.init(ws + WS_XC, D, ws + WS_W_RGG + (size_t)j * 16 * 256 * 128 * 2, 128, T, 16 * 256, F.G, cid, 7, 256);
                EpiRgGate E{(const bf16_t*)(ws + WS_XC), (bf16_t*)(ws + WS_LA), (bf16_t*)(ws + WS_BB), inp(F, I_RGBA) + (size_t)j * 2 * D, inp(F, I_RGBI) + (size_t)j * 2 * D, (const float*)(ws + WS_SPL) + (size_t)j * 2 * D};
                pg8::gemm_phase(F.lds, S, E, 128, D, 128); }  REPBAR } PH_END
            PH_BEGIN PM(5) { const bool dry = rep_ > 1; (void)dry;  scan1_phase(F);  REPBAR } PH_END
            PH_BEGIN PM(20) { const bool dry = rep_ > 1; (void)dry;  scan2_phase(F);  REPBAR } PH_END
            PH_BEGIN PM(6) { const bool dry = rep_ > 1; (void)dry;  scan3_phase(F);  REPBAR } PH_END
            PH_BEGIN PM(7) { const bool dry = rep_ > 1; (void)dry;  { pg8::DenseOrder S; S.init(ws + WS_SA, D, ws + WS_W_RGOUT + (size_t)j * 1024 * 1024 * 2, D, T, D, F.G, cid);
                EpiResid E{(bf16_t*)(ws + (dry ? WS_Y1 : WS_YM)), MODl + 2 * D}; pg8::gemm_phase(F.lds, S, E, D, D, D); router_fill(F, l); }  REPBAR } PH_END
        } else if (kind == 1) {
            PH_BEGIN PM(8) { const bool dry = rep_ > 1; (void)dry;  { pg8::DenseOrder S; S.init(ws + WS_H, D, ws + WS_W_QKV, D, T, 1536, F.G, cid);
                EpiQKV E{(bf16_t*)(ws + WS_QKV), inp(F, I_ATQG), inp(F, I_ATKG), (const float*)(ws + WS_ROPE), (LAS float*)(F.lds + RING_BYTES)}; pg8::gemm_phase(F.lds, S, E, D, D, D); }  REPBAR } PH_END
            PH_BEGIN PM(10) { const bool dry = rep_ > 1; (void)dry;  attn_phase(F);  REPBAR } PH_END
            PH_BEGIN PM(11) { const bool dry = rep_ > 1; (void)dry;  { pg8::DenseOrder S; S.init(ws + WS_AO, D, ws + WS_W_AO, D, T, D, F.G, cid);
                EpiResid E{(bf16_t*)(ws + (dry ? WS_Y1 : WS_YM)), MODl + 2 * D}; pg8::gemm_phase(F.lds, S, E, D, D, D); router_fill(F, l); }  REPBAR } PH_END
        } else {
            PH_BEGIN PM(12) { const bool dry = rep_ > 1; (void)dry;  { pg8::DenseOrder S; S.init(ws + WS_H, D, ws + WS_W_CMIN, D, T, 4096, F.G, cid);
                EpiCmIn E{(bf16_t*)(ws + WS_UVB), (f32x2*)(ws + WS_STATP)}; pg8::gemm_phase(F.lds, S, E, D, D, D); }  REPBAR } PH_END
            PH_BEGIN PM(13) { const bool dry = rep_ > 1; (void)dry;  spatial_phase(F);  REPBAR } PH_END
            PH_BEGIN PM(14) { const bool dry = rep_ > 1; (void)dry;  { pg8::DenseOrder S; S.init(ws + WS_UV, 2048, ws + WS_W_CMOUT, 2048, T, D, F.G, cid);
                EpiResid E{(bf16_t*)(ws + (dry ? WS_Y1 : WS_YM)), MODl + 2 * D}; pg8::gemm_phase(F.lds, S, E, 2048, 2048, 2048); router_fill(F, l); }  REPBAR } PH_END
        }
        PH_BEGIN PM(15) { const bool dry = rep_ > 1; (void)dry;  if (l == 0) norm_phase<true, 1, true>(F, l, inp(F, I_NFG) + l * D, 3, lastl, dry); else norm_phase<true, 1, false>(F, l, inp(F, I_NFG) + l * D, 3, lastl, dry);  REPBAR } PH_END
        PH_BEGIN PM(16) { const bool dry = rep_ > 1; (void)dry;  { const int ntile = moe_table(F, l, tab);
            const int units = ntile * 4, rounds = (units + F.G - 1) / F.G; int geff = F.G; if (false && rounds > 0) { geff = (((units + rounds - 1) / rounds) + 7) & ~7; if (geff > F.G) geff = F.G; }
            constexpr int EB = MOE_FP8 ? 1 : 2;
            MoeOrder<true> S{tab, (const char*)(ws + WS_H), (const char*)(ws + WS_W_E1 + (size_t)l * 32 * 1024 * 1024 * EB), (const int*)(ws + WS_BK2), geff, cid, units, (size_t)1024 * 1024 * EB, 1024 * EB, 1024 * EB};
            EpiMoe1 E{ws + WS_H1}; pg8::gemm_phase(F.lds, S, E, D * EB / 2, D * EB / 2, D * EB / 2); }  REPBAR } PH_END
        PH_BEGIN PM(17) { const bool dry = rep_ > 1; (void)dry;  { const int ntile = moe_table(F, l, tab);
            const int units = ntile * 4, rounds = (units + F.G - 1) / F.G; int geff = F.G; if (false && rounds > 0) { geff = (((units + rounds - 1) / rounds) + 7) & ~7; if (geff > F.G) geff = F.G; }
            constexpr int EB = MOE_FP8 ? 1 : 2;
            MoeOrder<false> S{tab, (const char*)(ws + WS_H1), (const char*)(ws + WS_W_E2 + (size_t)l * 32 * 1024 * 512 * EB), (const int*)(ws + WS_BK2), geff, cid, units, (size_t)1024 * 512 * EB, 512 * EB, 512 * EB};
            EpiMoe2 E{(bf16_t*)(ws + (dry ? WS_SCR + 64 * MiB : WS_Y1)), (const int*)(ws + WS_BK2), tab}; pg8::gemm_phase(F.lds, S, E, DEXP * EB / 2, DEXP * EB / 2, DEXP * EB / 2); }  REPBAR } PH_END
    }
    { const int l_ = 0; PH_BEGIN PM(18) { const bool dry = rep_ > 1; (void)dry;  final_phase(F);  REPBAR if constexpr (((REP_MASK) >> 19) & 1u) { for (int k_ = 0; k_ < 20; ++k_) GRIDBAR } } PH_END }
#undef PH_BEGIN
#undef PH_END
}

extern "C" void kernel_launch(void* const* d_in, const int* in_sizes, int n_in, void* d_out, int out_size, void* d_ws, size_t ws_size, hipStream_t stream) {
    static int grid = 0;
    if (grid == 0) {
        if (n_in != 34 || out_size != NB * SEQ * D || ws_size < WS_END) { fprintf(stderr, "kernel_launch: bad shapes n_in %d out %d ws %zu (need %zu)\n", n_in, out_size, ws_size, (size_t)WS_END); grid = -1; return; }
        int dev = 0, cus = 0, per_cu = 0;
        if (hipGetDevice(&dev) != hipSuccess || hipDeviceGetAttribute(&cus, hipDeviceAttributeMultiprocessorCount, dev) != hipSuccess) { grid = -1; return; }
        if (hipFuncSetAttribute((const void*)mk_fwd, hipFuncAttributeMaxDynamicSharedMemorySize, LDS_BYTES) != hipSuccess) { fprintf(stderr, "kernel_launch: hipFuncSetAttribute failed\n"); grid = -1; return; }
        if (hipOccupancyMaxActiveBlocksPerMultiprocessor(&per_cu, (const void*)mk_fwd, 512, LDS_BYTES) != hipSuccess || per_cu < 1) { fprintf(stderr, "kernel_launch: occupancy query says %d\n", per_cu); (void)hipGetLastError(); grid = -1; return; }
        grid = cus;
    }
    if (grid < 0) return;
    (void)hipMemsetAsync((char*)d_ws + WS_CTL, 0, CTL_BYTES, stream);
    Args a{};
    for (int i = 0; i < 34; ++i) a.in[i] = (const float*)d_in[i];
    a.out = (float*)d_out; a.ws = (uchar*)d_ws;
#if MK_PER_PHASE
    for (int p = 0; p < NPHASE; ++p) { a.ph_lo = p; a.ph_hi = p + 1; hipLaunchKernelGGL(mk_fwd, dim3(grid), dim3(512), LDS_BYTES, stream, a); }
#else
    a.ph_lo = 0; a.ph_hi = NPHASE;
    void* kargs[] = {&a};
    hipError_t e = hipLaunchCooperativeKernel((const void*)mk_fwd, dim3(grid), dim3(512), kargs, LDS_BYTES, stream);
    if (e != hipSuccess) fprintf(stderr, "kernel_launch: cooperative launch failed: %s (grid %d)\n", hipGetErrorString(e), grid);
#endif
}
```

```cpp
#include <hip/hip_runtime.h>
#include <hip/hip_bf16.h>
#include <cstdio>
#include <cstdint>

#ifndef MOE_FP8
#define MOE_FP8 1
#endif
#ifndef MK_PER_PHASE
#define MK_PER_PHASE 0
#endif

#ifndef PHASE_MASK
#define PHASE_MASK 0xFFFFFFFFu
#endif
#ifndef REP_MASK
#define REP_MASK 0u
#endif
#define REPN(i) ((((REP_MASK) >> (i)) & 1u) ? 2 : 1)
#define PM(i) if constexpr ((PHASE_MASK >> (i)) & 1u) for (int rep_ = REPN(i); rep_ > 0; --rep_)
#define LAS __attribute__((address_space(3)))
#define GAS __attribute__((address_space(1)))
typedef unsigned char uchar;
typedef unsigned short bf16_t;
typedef short bf16x8 __attribute__((ext_vector_type(8)));
typedef short s16x4 __attribute__((ext_vector_type(4)));
typedef float f32x4 __attribute__((ext_vector_type(4)));
typedef float f32x2 __attribute__((ext_vector_type(2)));
typedef float f32x16 __attribute__((ext_vector_type(16)));
typedef unsigned u32x4 __attribute__((ext_vector_type(4)));
typedef unsigned u32x2 __attribute__((ext_vector_type(2)));
typedef GAS unsigned gu32;
#define RLX_AGENT __ATOMIC_RELAXED, __HIP_MEMORY_SCOPE_AGENT

constexpr int D = 1024, NB = 4, SEQ = 4096, CTX = 256, SB = SEQ + CTX, T = NB * SB, DEPTH = 4;
constexpr int NMODV = 6 * D;
constexpr int NEXP = 32, DEXP = 512;
constexpr int NCH = SB / 16;
constexpr float NORM_EPS = 1e-6f;

constexpr size_t MiB = 1u << 20;
constexpr size_t WS_CTL = 0, CTL_BYTES = 1 * MiB;
constexpr size_t WS_MOD = 1 * MiB;
constexpr size_t WS_ROPE = 2 * MiB;
constexpr size_t WS_SPL = 2 * MiB + 65536;
constexpr size_t WS_BK2 = 3 * MiB;
constexpr size_t WS_TOT = 3 * MiB;
constexpr size_t WS_STATP = 8 * MiB;
constexpr size_t WS_BK = 13 * MiB;
constexpr size_t WS_TW = 15 * MiB + 512 * 1024;
constexpr size_t WS_W_RGIN = 16 * MiB, WS_W_RGG = 24 * MiB, WS_W_RGOUT = 26 * MiB, WS_W_QKV = 30 * MiB, WS_W_AO = 33 * MiB;
constexpr size_t WS_W_CMIN = 35 * MiB, WS_W_CMS = 43 * MiB, WS_W_CMOUT = 44 * MiB, WS_W_E1 = 48 * MiB, WS_W_E2 = 304 * MiB;
constexpr size_t WS_X = 432 * MiB, WS_Y1 = 500 * MiB, WS_H = 568 * MiB, WS_SCR = 602 * MiB;
constexpr size_t WS_GG = WS_SCR, WS_XB = WS_SCR + 34 * MiB, WS_XC = WS_SCR + 68 * MiB, WS_LA = WS_SCR + 102 * MiB, WS_BB = WS_SCR + 170 * MiB, WS_SA = WS_SCR + 238 * MiB;
constexpr size_t WS_QKV = WS_SCR, WS_AO = WS_SCR + 51 * MiB;
constexpr size_t WS_UVB = WS_SCR, WS_UV = WS_SCR + 136 * MiB;
constexpr size_t WS_H1 = WS_SCR;
constexpr size_t WS_TOTS = WS_SCR + 272 * MiB, WS_TOTH = WS_TOTS + 9 * MiB, WS_CARRY = WS_TOTH + 9 * MiB;
constexpr size_t WS_YM = WS_CARRY + 9 * MiB;
constexpr size_t WS_END = WS_YM + 34 * MiB;
constexpr int CW_TMO = 0, CW_BAR = 4096, CW_CNT = 16384;

constexpr int RING_BYTES = 131072;
constexpr int ROUTER_LDS = 36 * 1024 * 4;
constexpr int LDSCTL_OFF = 147456;
constexpr int LDS_BYTES = LDSCTL_OFF + 1024 + 8 * 4 * 40 * 4;

typedef float f32x2_t_ __attribute__((ext_vector_type(2))); typedef __bf16 bf16x2_t_ __attribute__((ext_vector_type(2)));
__device__ __forceinline__ unsigned pk2(float lo, float hi) { const f32x2_t_ v = {lo, hi}; const bf16x2_t_ b = __builtin_convertvector(v, bf16x2_t_); return __builtin_bit_cast(unsigned, b); }
__device__ __forceinline__ unsigned f2bf(float f) { return pk2(f, 0.f) & 0xffffu; }
__device__ __forceinline__ float bf2f(unsigned short h) { return __builtin_bit_cast(float, (unsigned)h << 16); }
__device__ __forceinline__ float bflo(unsigned w) { return __builtin_bit_cast(float, w << 16); }
__device__ __forceinline__ float bfhi(unsigned w) { return __builtin_bit_cast(float, w & 0xffff0000u); }
__device__ __forceinline__ unsigned cvt_pk_bf16(float lo, float hi) { return pk2(lo, hi); }
__device__ __forceinline__ float gelu_tanh(float x) { const float u = 0.7978845608028654f * (x + 0.044715f * x * x * x); const float e = __expf(2.f * u); const float t = 1.f - 2.f * __builtin_amdgcn_rcpf(e + 1.f); return 0.5f * x * (1.f + t); }
__device__ __forceinline__ float sigmoidf_(float x) { return 1.f / (1.f + __expf(-x)); }
__device__ __forceinline__ float fast_sigmoid(float x) { return __builtin_amdgcn_rcpf(1.f + __expf(-x)); }
__device__ __forceinline__ float one_minus_exp(float y) {   const float p = y * (1.f - y * (0.5f - y * (0.16666667f - y * 0.041666667f))); const float q = 1.f - __expf(-y); return y < 0.0625f ? p : q; }
__device__ __forceinline__ int sidx_of_row(int row) { const int b = row / SB; return (row - b * SB) < CTX ? 4 : b; }

namespace pg8 {
constexpr int BM = 256, BK = 64, HALF = 128, HTB = HALF * BK * 2, NXCD = 8, WGM = 8;
__device__ __forceinline__ int lds_byte(int r, int c) { const int st = (r >> 4) * 2 + (c >> 5), rr = r & 15, cc = c & 31, ob = rr * 64 + cc * 2; return st * 1024 + (ob ^ (((ob >> 9) & 1) << 5)); }
__device__ __forceinline__ void stage_rc(int b, int& R, int& C) { const int st = b / 1024, sb = b % 1024, swz = sb ^ (((sb >> 9) & 1) << 5); R = (st >> 1) * 16 + swz / 64; C = (st & 1) * 32 + (swz % 64) / 2; }
__device__ __forceinline__ int perm32(int rho) { const int n = rho >> 4, i = rho & 15; return 8 * (i >> 2) + 4 * n + (i & 3); }
struct Unit { const char* a; const char* b; int pm, pn, aux0, aux1, hm; };
__device__ __forceinline__ const char* uptr(const char* p) { const unsigned long long v = (unsigned long long)p; const unsigned lo = __builtin_amdgcn_readfirstlane((unsigned)v), hi = __builtin_amdgcn_readfirstlane((unsigned)(v >> 32)); return (const char*)(const GAS char*)(((unsigned long long)hi << 32) | lo); }
__device__ __forceinline__ bool unit_slot(int i, int c, int G, int nwg, int& L, int& hm) {
    if (c >= G) return false;
    const int nfull = nwg / G, rem = nwg - nfull * G;
    if (i < nfull) { L = i * G + c; hm = 0xF; return true; }
    if (i > nfull || rem == 0) return false;
    if (rem * 2 <= G) { if (c >= 2 * rem) return false; L = nfull * G + (c >> 1); hm = (c & 1) ? 0xC : 0x3; return true; }
    if (c >= rem) return false; L = nfull * G + c; hm = 0xF; return true; }
__device__ __forceinline__ int xcd_remap(int L, int nwg) { const int q = nwg / NXCD, r = nwg % NXCD, xcd = L % NXCD, off = L / NXCD; return (xcd < r ? xcd * (q + 1) : r * (q + 1) + (xcd - r) * q) + off; }

struct DenseOrder {
    static constexpr bool GATHER = false;
    const char* A; const char* B; int nM, nN, nwg, G, c; size_t tA, tB; int amask, acol;
    __device__ void init(const void* A_, int lda, const void* B_, int ldb, int M, int N, int G_, int c_, int amask_ = 0, int acol_ = 0) {
        A = (const char*)A_; B = (const char*)B_; nM = M / BM; nN = N / BM; nwg = nM * nN; G = G_; c = c_; tA = (size_t)BM * lda * 2; tB = (size_t)BM * ldb * 2; amask = amask_; acol = acol_; }
    __device__ bool next(int i, Unit& u) const {
        int L, hm; if (!unit_slot(i, c, G, nwg, L, hm)) return false; u.hm = __builtin_amdgcn_readfirstlane(hm);
        const int wgid = xcd_remap(L, nwg);
        const int nig = WGM * nN, gid = wgid / nig, fm = gid * WGM, gsz = (nM - fm) < WGM ? (nM - fm) : WGM;
        u.pm = __builtin_amdgcn_readfirstlane(fm + ((wgid % nig) % gsz)); u.pn = __builtin_amdgcn_readfirstlane((wgid % nig) / gsz); u.aux0 = 0; u.aux1 = 0;
        u.a = uptr(A + (size_t)u.pm * tA + (size_t)(u.pn & amask) * acol); u.b = uptr(B + (size_t)u.pn * tB); return true; }
    __device__ unsigned goff(const Unit&, int) const { return 0u; }
};

#define PG8_SA(b, h) (((b) * 2 + (h)) * HTB)
#define PG8_SB(b, h) ((4 + (b) * 2 + (h)) * HTB)
__device__ __forceinline__ void glds16(const char* sbase, unsigned voff, unsigned ldsaddr) { unsigned keep;
    asm volatile("s_mov_b32 %0, m0\n\ts_mov_b32 m0, %3\n\ts_nop 0\n\tglobal_load_lds_dwordx4 %1, %2\n\ts_mov_b32 m0, %0" : "=&s"(keep) : "v"(voff), "s"(sbase), "s"(ldsaddr) : "memory"); }
#ifndef PG8_ASM_DMA
#define PG8_ASM_DMA 1
#endif
#if PG8_ASM_DMA
#define PG8_GLDS(gp, voff, ldsoff) glds16((const char*)(gp), (voff), ldsbase + (unsigned)(ldsoff))
#else
#define PG8_GLDS(gp, voff, ldsoff) __builtin_amdgcn_global_load_lds((const unsigned*)((const char*)(gp) + (voff)), (LAS unsigned*)(lds + (ldsoff)), 16, 0, 0)
#endif
#define PG8_STAGE_B(bufoff, gbase) do { PG8_GLDS(gbase, voffB[0], (bufoff) + ldsw); PG8_GLDS(gbase, voffB[1], (bufoff) + ldsw + 8192); } while (0)
#define PG8_STAGE_A(bufoff, gbase, h, NX) do { if constexpr (Sched::GATHER) { \
        PG8_GLDS(gbase, ((NX) ? vAn[h][0] : vAc[h][0]), (bufoff) + ldsw); PG8_GLDS(gbase, ((NX) ? vAn[h][1] : vAc[h][1]), (bufoff) + ldsw + 8192); \
    } else { PG8_GLDS((const char*)(gbase) + (h) * hstepA, voffA[0], (bufoff) + ldsw); PG8_GLDS((const char*)(gbase) + (h) * hstepA, voffA[1], (bufoff) + ldsw + 8192); } } while (0)
#define PG8_LDA(dst, b, h) do { _Pragma("unroll") for (int m = 0; m < 4; ++m) _Pragma("unroll") for (int k = 0; k < 2; ++k) dst[m][k] = *(const LAS bf16x8*)(lds + PG8_SA(b, h) + aoff + m * 2048 + k * 1024); } while (0)
#define PG8_LDB(dst, b, h) do { _Pragma("unroll") for (int n = 0; n < 2; ++n) _Pragma("unroll") for (int k = 0; k < 2; ++k) dst[n][k] = *(const LAS bf16x8*)(lds + PG8_SB(b, h) + boff + n * 2048 + k * 1024); } while (0)
typedef int i32x8 __attribute__((ext_vector_type(8))); typedef int i32x4v __attribute__((ext_vector_type(4)));
__device__ __forceinline__ i32x8 cat8(bf16x8 lo, bf16x8 hi) { return __builtin_shufflevector(__builtin_bit_cast(i32x4v, lo), __builtin_bit_cast(i32x4v, hi), 0, 1, 2, 3, 4, 5, 6, 7); }
#define PG8_MMA(ai, bj, At, Bt) do { __builtin_amdgcn_s_setprio(1); _Pragma("unroll") for (int m = 0; m < 4; ++m) _Pragma("unroll") for (int n = 0; n < 2; ++n) { \
        if constexpr (Epi::FP8) { asm volatile("v_mfma_scale_f32_16x16x128_f8f6f4 %0, %1, %2, %0, %3, %3 op_sel_hi:[0,0,0]" : "+v"(acc[ai][bj][m][n]) : "v"(cat8(Bt[n][0], Bt[n][1])), "v"(cat8(At[m][0], At[m][1])), "v"(0x7F7F7F7F)); } \
        else { _Pragma("unroll") for (int k = 0; k < 2; ++k) acc[ai][bj][m][n] = __builtin_amdgcn_mfma_f32_16x16x32_bf16(Bt[n][k], At[m][k], acc[ai][bj][m][n], 0, 0, 0); } } __builtin_amdgcn_s_setprio(0); } while (0)
#define PG8_WAIT_V(n) asm volatile("s_waitcnt vmcnt(" #n ")" ::: "memory")
#define PG8_WAIT_L(n) asm volatile("s_waitcnt lgkmcnt(" #n ")" ::: "memory")
#define PG8_BAR __builtin_amdgcn_s_barrier()
#define PG8_SCHED __builtin_amdgcn_sched_barrier(0)

template <class Epi, class Sched>
__device__ __forceinline__ void gemm_phase(LAS uchar* lds, const Sched& S, const Epi& E, const int K, const int lda, const int ldb) {
    int tid = threadIdx.x; asm volatile("" : "+v"(tid));
    const int wid = __builtin_amdgcn_readfirstlane(tid >> 6), lane = tid & 63, wr = wid >> 2, wc = wid & 3; int fr = lane & 15, fq = lane >> 4;
    int nt = K / BK; asm volatile("" : "+s"(nt));
    unsigned voffA[2], voffB[2];
#pragma unroll
    for (int i = 0; i < 2; ++i) { int R, C; stage_rc(tid * 16 + i * 8192, R, C); const int Rb = Epi::PERM ? ((R & ~31) + perm32(R & 31)) : R;
        voffA[i] = (unsigned)(R * lda + C) * 2u; voffB[i] = (unsigned)(Rb * ldb + C) * 2u; }
    const size_t kstep = (size_t)(BK * 2);
    const size_t hstepA = (size_t)HALF * lda * 2, hstepB = (size_t)HALF * ldb * 2;
    const unsigned ldsw = (unsigned)wid * 1024u;
    const unsigned ldsbase = (unsigned)(uintptr_t)lds;
    const int aoff = lds_byte(wr * 64 + fr, fq * 8), boff = lds_byte(wc * 32 + fr, fq * 8);
    Unit cur, nxt; int ui = 0;
    if (!S.next(0, cur)) return;
    unsigned vAc[2][2], vAn[2][2];
#pragma unroll
    for (int h = 0; h < 2; ++h)
#pragma unroll
        for (int i = 0; i < 2; ++i) { vAc[h][i] = 0u; vAn[h][i] = 0u; }
    if constexpr (Sched::GATHER) {
#pragma unroll
        for (int h = 0; h < 2; ++h)
#pragma unroll
            for (int i = 0; i < 2; ++i) { int R, C; stage_rc(tid * 16 + i * 8192, R, C); vAc[h][i] = S.goff(cur, h * HALF + R) + (unsigned)C * 2u; }
    }
    f32x4 acc[2][2][4][2];
#pragma unroll
    for (int a = 0; a < 2; ++a)
#pragma unroll
        for (int b = 0; b < 2; ++b)
#pragma unroll
            for (int m = 0; m < 4; ++m)
#pragma unroll
                for (int n = 0; n < 2; ++n) acc[a][b][m][n] = (f32x4){0.f, 0.f, 0.f, 0.f};
    bf16x8 At[4][2], B0[2][2], B1[2][2];
    typedef int pre_t __attribute__((ext_vector_type(16))); pre_t pre = {};
    if constexpr (Epi::PREFETCH) pre = E.prefetch(cur, wr, fr);
    const char* cA = cur.a; const char* cB = cur.b;
    PG8_STAGE_B(PG8_SB(0, 0), cB); PG8_STAGE_B(PG8_SB(0, 1), cB + hstepB); PG8_STAGE_A(PG8_SA(0, 0), cA, 0, false); PG8_STAGE_A(PG8_SA(0, 1), cA, 1, false);
    if (wr == 1) PG8_BAR;
    PG8_WAIT_V(2); PG8_BAR;
    PG8_STAGE_B(PG8_SB(1, 0), cB + kstep); PG8_STAGE_A(PG8_SA(1, 0), cA + kstep, 0, false); PG8_STAGE_B(PG8_SB(1, 1), cB + hstepB + kstep);
    PG8_WAIT_V(6); PG8_BAR;
    for (;;) {
        const bool has_next = S.next(ui + 1, nxt);
        if constexpr (Sched::GATHER) { if (has_next) {
#pragma unroll
            for (int h = 0; h < 2; ++h)
#pragma unroll
                for (int i = 0; i < 2; ++i) { int R, C; int t2 = tid; asm volatile("" : "+v"(t2)); stage_rc(t2 * 16 + i * 8192, R, C); vAn[h][i] = S.goff(nxt, h * HALF + R) + (unsigned)C * 2u; }
            *(LAS u32x4*)(lds + 131072 + tid * 16) = (u32x4){vAn[0][0], vAn[0][1], vAn[1][0], vAn[1][1]}; } }
        const char* nA = has_next ? nxt.a : cA; const char* nB = has_next ? nxt.b : cB;
        for (int t = 0; t < nt; t += 2) {
            const bool last = (t == nt - 2);
            const bool nx = last && has_next;
            if constexpr (Sched::GATHER) { if (nx) { const u32x4 pk_ = *(const LAS u32x4*)(lds + 131072 + tid * 16); vAn[0][0] = pk_.x; vAn[0][1] = pk_.y; vAn[1][0] = pk_.z; vAn[1][1] = pk_.w; } }
            const char* a1 = cA + (size_t)(t + 1) * kstep;
            const char* a2 = last ? nA : cA + (size_t)(t + 2) * kstep; const char* b2 = last ? nB : cB + (size_t)(t + 2) * kstep;
            const char* a3 = a2 + kstep; const char* b3 = b2 + kstep;
            PG8_LDB(B0, 0, 0); PG8_LDB(B1, 0, 1); PG8_SCHED; PG8_LDA(At, 0, 0); PG8_STAGE_A(PG8_SA(1, 1), a1, 1, false);
            PG8_WAIT_V(8); PG8_WAIT_L(0); PG8_BAR; if (cur.hm & 1) { PG8_MMA(0, 0, At, B0); PG8_MMA(0, 1, At, B1); } PG8_BAR; PG8_SCHED;
            PG8_LDA(At, 0, 1); PG8_STAGE_B(PG8_SB(0, 0), b2); PG8_STAGE_B(PG8_SB(0, 1), b2 + hstepB); PG8_STAGE_A(PG8_SA(0, 0), a2, 0, nx);
            PG8_WAIT_V(8); PG8_WAIT_L(0); PG8_BAR; if (cur.hm & 4) { PG8_MMA(1, 0, At, B0); PG8_MMA(1, 1, At, B1); } PG8_BAR; PG8_SCHED;
            PG8_LDB(B0, 1, 0); PG8_LDB(B1, 1, 1); PG8_SCHED; PG8_LDA(At, 1, 0); PG8_STAGE_A(PG8_SA(0, 1), a2, 1, nx);
            PG8_WAIT_V(8); PG8_WAIT_L(0); PG8_BAR; if (cur.hm & 1) { PG8_MMA(0, 0, At, B0); PG8_MMA(0, 1, At, B1); } PG8_BAR; PG8_SCHED;
            PG8_LDA(At, 1, 1); PG8_STAGE_B(PG8_SB(1, 0), b3); PG8_STAGE_B(PG8_SB(1, 1), b3 + hstepB); PG8_STAGE_A(PG8_SA(1, 0), a3, 0, nx);
            PG8_WAIT_V(8); PG8_WAIT_L(0); PG8_BAR; if (cur.hm & 4) { PG8_MMA(1, 0, At, B0); PG8_MMA(1, 1, At, B1); } PG8_BAR; PG8_SCHED;
        }
        if (wr == 0) PG8_BAR;
        if constexpr (Epi::FP8) asm volatile("s_nop 15\n\ts_nop 15" ::: "memory");
        if constexpr (Epi::PREFETCH) E(acc, cur, wr, wc, fr, fq, pre); else E(acc, cur, wr, wc, fr, fq);
        if (!has_next) break;
#pragma unroll
        for (int a = 0; a < 2; ++a)
#pragma unroll
            for (int b = 0; b < 2; ++b)
#pragma unroll
                for (int m = 0; m < 4; ++m)
#pragma unroll
                    for (int n = 0; n < 2; ++n) acc[a][b][m][n] = (f32x4){0.f, 0.f, 0.f, 0.f};
        cur = nxt; cA = nA; cB = nB; ++ui;
        if constexpr (Epi::PREFETCH) pre = E.prefetch(cur, wr, fr);
        if constexpr (Sched::GATHER) {
#pragma unroll
            for (int h = 0; h < 2; ++h)
#pragma unroll
                for (int i = 0; i < 2; ++i) vAc[h][i] = vAn[h][i]; }
        if (wr == 1) PG8_BAR;
    }
    PG8_WAIT_V(0);
    PG8_BAR;
}
}

#ifndef ATT_SDEPTH
#define ATT_SDEPTH 1
#endif
namespace att {
constexpr int NW = 8, QBLK = 32, KVBLK = 64;
constexpr float SCALE = 0.088388347648318440f;
constexpr float THR = 8.f;
constexpr int LDQ = 1536, LDK = 1536, LDO = 1024;
constexpr size_t SHM_V = KVBLK * 128 * 2, SHM_K = KVBLK * 128 * 2, SHM_ATTN = 2 * SHM_V + 2 * SHM_K + NW * 64 * 4;
#define KSWZ(row, colB) ((row) * 256 + ((colB) ^ (((row) & 7) << 4)))
#define SBAR() __builtin_amdgcn_sched_barrier(0)
__device__ __forceinline__ int crow(int r, int hi) { return (r & 3) + 8 * (r >> 2) + 4 * hi; }
__device__ __forceinline__ void partialSM(f32x16& p0, f32x16& p1, float& m_reg, float& mn, float& alpha) {
  constexpr float C = SCALE * 1.4426950408889634f;
  float pmax = p0[0];
#pragma unroll
  for (int r = 1; r < 16; ++r) pmax = fmaxf(pmax, p0[r]);
#pragma unroll
  for (int r = 0; r < 16; ++r) pmax = fmaxf(pmax, p1[r]);
  { auto rr = __builtin_amdgcn_permlane32_swap(__float_as_uint(pmax), __float_as_uint(pmax), false, false);
    pmax = fmaxf(__uint_as_float(rr[0]), __uint_as_float(rr[1])); }
  if (__builtin_expect(__all(pmax - m_reg <= THR / SCALE), 1)) { mn = m_reg; alpha = 1.f; }
  else { mn = fmaxf(m_reg, pmax); alpha = __builtin_amdgcn_exp2f((m_reg - mn) * C); m_reg = mn; }
  float mnC = -mn * C;
#pragma unroll
  for (int r = 0; r < 16; ++r) p0[r] = fmaf(p0[r], C, mnC);
#pragma unroll
  for (int r = 0; r < 16; ++r) p1[r] = fmaf(p1[r], C, mnC);
#pragma unroll
  for (int r = 0; r < 16; ++r) p0[r] = __builtin_amdgcn_exp2f(p0[r]);
}
__device__ __forceinline__ void finishSM(f32x16& p0, f32x16& p1, float alpha, float& l_reg, bf16x8& pa0, bf16x8& pa1, bf16x8& pa2, bf16x8& pa3) {
#pragma unroll
  for (int r = 0; r < 16; ++r) p1[r] = __builtin_amdgcn_exp2f(p1[r]);
  float ps = 0;
#pragma unroll
  for (int r = 0; r < 16; ++r) ps += p0[r];
#pragma unroll
  for (int r = 0; r < 16; ++r) ps += p1[r];
  { auto rr = __builtin_amdgcn_permlane32_swap(__float_as_uint(ps), __float_as_uint(ps), false, false);
    ps = __uint_as_float(rr[0]) + __uint_as_float(rr[1]); }
  l_reg = l_reg * alpha + ps;
#define PK4(P, BASE, OUT) do { unsigned a0 = cvt_pk_bf16(P[BASE + 0], P[BASE + 1]), a1 = cvt_pk_bf16(P[BASE + 2], P[BASE + 3]);   \
    unsigned b0 = cvt_pk_bf16(P[BASE + 4], P[BASE + 5]), b1 = cvt_pk_bf16(P[BASE + 6], P[BASE + 7]);                              \
    auto r0 = __builtin_amdgcn_permlane32_swap(a0, b0, false, false); auto r1 = __builtin_amdgcn_permlane32_swap(a1, b1, false, false); \
    u32x4 w = {r0[0], r1[0], r0[1], r1[1]}; OUT = __builtin_bit_cast(bf16x8, w); } while (0)
  PK4(p0, 0, pa0); PK4(p0, 8, pa1); PK4(p1, 0, pa2); PK4(p1, 8, pa3);
#undef PK4
}
__device__ __forceinline__ void qkt(f32x16& p0, f32x16& p1, const bf16_t* Ks, const bf16x8* qr, int r32, int hi) {
  p0 = f32x16{}; p1 = f32x16{};
#pragma unroll
  for (int d0 = 0; d0 < 8; ++d0) { int cb = (d0 * 16 + hi * 8) * 2;
    bf16x8 b0 = *reinterpret_cast<const bf16x8*>((const char*)Ks + KSWZ(r32, cb));
    bf16x8 b1 = *reinterpret_cast<const bf16x8*>((const char*)Ks + KSWZ(32 + r32, cb));
    p0 = __builtin_amdgcn_mfma_f32_32x32x16_bf16(b0, qr[d0], p0, 0, 0, 0);
    p1 = __builtin_amdgcn_mfma_f32_32x32x16_bf16(b1, qr[d0], p1, 0, 0, 0); }
}
__device__ __forceinline__ int v_st(int k, int c) { const int kk = (k & ~0xC) | ((k & 4) << 1) | ((k & 8) >> 1); return ((kk >> 3) * 4 + (c >> 5)) * 512 + ((kk & 7) * 32 + (c & 31)) * 2; }
__device__ __forceinline__ int v_rd_base(int lane) { return ((lane & 3) << 3) | (((lane >> 2) & 3) << 6) | (((lane >> 4) & 1) << 5) | (((lane >> 5) & 1) << 8); }
constexpr int v_rd_off(int d0, int ks, int half) { return d0 * 512 + ks * 4096 + half * 2048; }
template <int OFF> __device__ __forceinline__ s16x4 tr_read(int vb) {
  s16x4 r; asm volatile("ds_read_b64_tr_b16 %0, %1 offset:%2" : "=&v"(r) : "v"(vb), "i"(OFF) : "memory"); return r;
}
template <int D0> __device__ __forceinline__ void pv_one(f32x16& od, int vb, bf16x8 pa0, bf16x8 pa1, bf16x8 pa2, bf16x8 pa3) {
  const s16x4 l0 = tr_read<v_rd_off(D0, 0, 0)>(vb), h0 = tr_read<v_rd_off(D0, 0, 1)>(vb), l1 = tr_read<v_rd_off(D0, 1, 0)>(vb), h1 = tr_read<v_rd_off(D0, 1, 1)>(vb);
  const s16x4 l2 = tr_read<v_rd_off(D0, 2, 0)>(vb), h2 = tr_read<v_rd_off(D0, 2, 1)>(vb), l3 = tr_read<v_rd_off(D0, 3, 0)>(vb), h3 = tr_read<v_rd_off(D0, 3, 1)>(vb);
  asm volatile("s_waitcnt lgkmcnt(0)" ::: "memory"); SBAR();
#define PK(L, H) (bf16x8){L[0], L[1], L[2], L[3], H[0], H[1], H[2], H[3]}
  od = __builtin_amdgcn_mfma_f32_32x32x16_bf16(pa0, PK(l0, h0), od, 0, 0, 0);
  od = __builtin_amdgcn_mfma_f32_32x32x16_bf16(pa1, PK(l1, h1), od, 0, 0, 0);
  od = __builtin_amdgcn_mfma_f32_32x32x16_bf16(pa2, PK(l2, h2), od, 0, 0, 0);
  od = __builtin_amdgcn_mfma_f32_32x32x16_bf16(pa3, PK(l3, h3), od, 0, 0, 0);
#undef PK
}
__device__ __forceinline__ void pv_d0(f32x16* o, int vb, bf16x8 pa0, bf16x8 pa1, bf16x8 pa2, bf16x8 pa3) {
  pv_one<0>(o[0], vb, pa0, pa1, pa2, pa3); pv_one<1>(o[1], vb, pa0, pa1, pa2, pa3); pv_one<2>(o[2], vb, pa0, pa1, pa2, pa3); pv_one<3>(o[3], vb, pa0, pa1, pa2, pa3);
}
__device__ __forceinline__ void attn_dense_body(const bf16_t* Qb, const bf16_t* Kh, const bf16_t* Vh, bf16_t* Ob, int seq, char* lds, const int tid) {
  const int wid = tid >> 6, lane = tid & 63, r32 = lane & 31, hi = lane >> 5;
  bf16_t* V_lds = (bf16_t*)lds; bf16_t* K_lds = (bf16_t*)(lds + 2 * SHM_V);
  float* ws = (float*)(lds + 2 * SHM_V + 2 * SHM_K) + wid * 64; float* li_l = ws; float* al_l = ws + 32;
  float m_reg = -1e30f, l_reg = 0; f32x16 o[4] = {}; bf16x8 qr[8];
  const bf16_t* Qw = Qb + (long)(wid * QBLK + r32) * LDQ + hi * 8;
#pragma unroll
  for (int d0 = 0; d0 < 8; ++d0) qr[d0] = *reinterpret_cast<const bf16x8*>(Qw + d0 * 16);
  const int sr = tid >> 4, sc = (tid & 15) * 8, vst0 = v_st(sr, sc), vst1 = v_st(32 + sr, sc);
  const int vb0 = (int)(uintptr_t)V_lds + v_rd_base(lane);
  struct { bf16x8 vs0, vs1, ks0, ks1; } sr_[ATT_SDEPTH];
  const unsigned vo0 = (unsigned)(sr * LDK + sc) * 2u, vo1 = (unsigned)((32 + sr) * LDK + sc) * 2u;
  const long vdelta = (const char*)Vh - (const char*)Kh;
#define SLOAD(i, k0) do { const char* kb_ = (const char*)Kh + (size_t)(k0) * (LDK * 2); const char* vb_ = kb_ + vdelta; \
    sr_[i].vs0 = *reinterpret_cast<const bf16x8*>(vb_ + vo0); sr_[i].vs1 = *reinterpret_cast<const bf16x8*>(vb_ + vo1); \
    sr_[i].ks0 = *reinterpret_cast<const bf16x8*>(kb_ + vo0); sr_[i].ks1 = *reinterpret_cast<const bf16x8*>(kb_ + vo1); } while (0)
#define SWRITE(b, i) do { *(bf16x8*)((char*)V_lds + (b) * SHM_V + vst0) = sr_[i].vs0;          \
    *(bf16x8*)((char*)V_lds + (b) * SHM_V + vst1) = sr_[i].vs1; int kc = sc * 2;               \
    *(bf16x8*)((char*)K_lds + (b) * SHM_K + KSWZ(sr, kc)) = sr_[i].ks0;                       \
    *(bf16x8*)((char*)K_lds + (b) * SHM_K + KSWZ(32 + sr, kc)) = sr_[i].ks1; } while (0)
#define SWAIT() do { if constexpr (ATT_SDEPTH == 2) asm volatile("s_waitcnt vmcnt(4)" ::: "memory"); else asm volatile("s_waitcnt vmcnt(0)" ::: "memory"); } while (0)
#define RESC(a) do { if (__any((a) < 1.f)) { if (hi == 0) al_l[r32] = (a); asm volatile("s_waitcnt lgkmcnt(0)" ::: "memory"); \
    _Pragma("unroll") for (int d = 0; d < 4; ++d) _Pragma("unroll") for (int r = 0; r < 16; ++r) o[d][r] *= al_l[crow(r, hi)]; } } while (0)
  f32x16 pA0, pA1, pB0, pB1; float mnA, mnB, alA, alB; bf16x8 pa0, pa1, pa2, pa3; const int NT = seq / KVBLK;
  constexpr int SE = 0, SO = ATT_SDEPTH - 1;
  SLOAD(SE, 0); asm volatile("s_waitcnt vmcnt(0)" ::: "memory"); SWRITE(0, SE); __syncthreads();
  qkt(pA0, pA1, K_lds, qr, r32, hi); partialSM(pA0, pA1, m_reg, mnA, alA);
  SLOAD(SO, KVBLK); if constexpr (ATT_SDEPTH == 2) { if (2 < NT) SLOAD(SE, 2 * KVBLK); }
  SWAIT(); SWRITE(1, SO); __syncthreads();
  for (int j = 1; j + 1 < NT; j += 2) {
    SBAR(); qkt(pB0, pB1, (bf16_t*)((char*)K_lds + SHM_K), qr, r32, hi);
    finishSM(pA0, pA1, alA, l_reg, pa0, pa1, pa2, pa3); SBAR();
    SLOAD(SO, (j + ATT_SDEPTH) * KVBLK); SBAR();
    pv_d0(o, vb0, pa0, pa1, pa2, pa3); partialSM(pB0, pB1, m_reg, mnB, alB);
    __syncthreads(); SWAIT(); SWRITE(0, SE);
    RESC(alB); __syncthreads();
    SBAR(); qkt(pA0, pA1, K_lds, qr, r32, hi);
    finishSM(pB0, pB1, alB, l_reg, pa0, pa1, pa2, pa3); SBAR();
    if (ATT_SDEPTH == 1 || j + 3 < NT) SLOAD(SE, (j + 1 + ATT_SDEPTH) * KVBLK); SBAR();
    pv_d0(o, vb0 + (int)SHM_V, pa0, pa1, pa2, pa3); partialSM(pA0, pA1, m_reg, mnA, alA);
    __syncthreads(); SWAIT(); SWRITE(1, SO);
    RESC(alA); __syncthreads();
  }
  SBAR(); qkt(pB0, pB1, (bf16_t*)((char*)K_lds + SHM_K), qr, r32, hi);
  finishSM(pA0, pA1, alA, l_reg, pa0, pa1, pa2, pa3); SBAR();
  pv_d0(o, vb0, pa0, pa1, pa2, pa3); partialSM(pB0, pB1, m_reg, mnB, alB);
  __syncthreads(); RESC(alB);
  finishSM(pB0, pB1, alB, l_reg, pa0, pa1, pa2, pa3); SBAR();
  pv_d0(o, vb0 + (int)SHM_V, pa0, pa1, pa2, pa3);
  if (hi == 0) li_l[r32] = l_reg; asm volatile("s_waitcnt lgkmcnt(0)" ::: "memory");
  float rli[16];
#pragma unroll
  for (int r = 0; r < 16; ++r) rli[r] = __builtin_amdgcn_rcpf(li_l[crow(r, hi)]);
  bf16_t* Ow = Ob + (long)(wid * QBLK) * LDO;
#pragma unroll
  for (int r = 0; r < 16; ++r) { int orow = crow(r, hi);
#pragma unroll
    for (int d0 = 0; d0 < 4; ++d0) Ow[(long)orow * LDO + d0 * 32 + r32] = (bf16_t)f2bf(o[d0][r] * rli[r]); }
#undef SLOAD
#undef SWRITE
#undef SWAIT
#undef RESC
}
}

#define XB_TMO      128
#define XB_XCNT(j)  (256  + 64 * (j))
#define XB_XSUB(j)  (1280 + 64 * (j))
#define XB_XGEN(j)  (2304 + 64 * (j))
#define XB_TOP      3328
#define XB_TOPGEN   3392
#define XB_SPIN_CAP (1u << 22)
__device__ __forceinline__ unsigned xb_ld(unsigned* p)              { return __hip_atomic_load(p, __ATOMIC_RELAXED, __HIP_MEMORY_SCOPE_AGENT); }
__device__ __forceinline__ unsigned xb_add(unsigned* p, unsigned v) { return __hip_atomic_fetch_add(p, v, __ATOMIC_RELAXED, __HIP_MEMORY_SCOPE_AGENT); }
__device__ __forceinline__ unsigned xb_xcc_id() { return (unsigned)__builtin_amdgcn_s_getreg((3 << 11) | 20) & 0xFu; }
#define XB_SPIN(cond, bar) do { unsigned _sp = 0; while (cond) { __builtin_amdgcn_s_sleep(1); \
    if ((++_sp & 255u) == 0u) { if (xb_ld(&(bar)[XB_TMO])) break; if (_sp > XB_SPIN_CAP) { atomicAdd(&(bar)[XB_TMO], 1u); break; } } } } while (0)
struct XcdBarrier { unsigned* bar; unsigned x; volatile LAS unsigned* st; };
__device__ __forceinline__ XcdBarrier xcd_barrier_post(unsigned* bar, volatile LAS unsigned* st) {
    XcdBarrier b; b.bar = bar; b.x = xb_xcc_id(); b.st = st;
    if (threadIdx.x == 0) (void)xb_add(&bar[XB_XCNT(b.x)], 1u);
    return b;
}
__device__ __forceinline__ void xcd_barrier_complete(unsigned* bar, unsigned x, unsigned& nloc, unsigned& nx) {
    const unsigned G = gridDim.x * gridDim.y * gridDim.z;
    unsigned sum, cnt, mine, sp = 0u;
    for (;;) {
        sum = 0u; cnt = 0u; mine = 0u;
#pragma unroll
        for (unsigned j = 0; j < 16; ++j) { const unsigned c = xb_ld(&bar[XB_XCNT(j)]); sum += c; cnt += (c > 0u) ? 1u : 0u; mine = (j == x) ? c : mine; }
        if (sum == G) break;
        __builtin_amdgcn_s_sleep(1);
        if ((++sp & 255u) == 0u) { if (xb_ld(&bar[XB_TMO])) break; if (sp > XB_SPIN_CAP) { atomicAdd(&bar[XB_TMO], 1u); break; } }
    }
    nloc = mine > 0u ? mine : 1u; nx = cnt > 0u ? cnt : 1u;
}
__device__ __forceinline__ void xcd_barrier(const XcdBarrier& b_) {
    XcdBarrier b; b.bar = b_.bar; b.st = b_.st; b.x = xb_xcc_id();
    asm volatile("s_waitcnt vmcnt(0)" ::: "memory");
    __syncthreads();
    if (threadIdx.x == 0) {
        unsigned* bar = b.bar;
        __builtin_amdgcn_s_waitcnt(0);
        unsigned nloc = b.st[0], nx = b.st[1];
        if (nloc == 0u) { xcd_barrier_complete(bar, b.x, nloc, nx); b.st[0] = nloc; b.st[1] = nx; }
        const unsigned old = xb_add(&bar[XB_XSUB(b.x)], 1u);
        const unsigned gen = old / nloc;
        if (old + 1u == (gen + 1u) * nloc) {
            __builtin_amdgcn_fence(__ATOMIC_RELEASE, "agent");
            asm volatile("s_waitcnt vmcnt(0)" ::: "memory");
            const unsigned og = xb_add(&bar[XB_TOP], 1u);
            const unsigned tg = og / nx;
            if (og + 1u == (tg + 1u) * nx) xb_add(&bar[XB_TOPGEN], 1u);
            else XB_SPIN(xb_ld(&bar[XB_TOPGEN]) == tg, bar);
            __builtin_amdgcn_fence(__ATOMIC_ACQUIRE, "agent");
            xb_add(&bar[XB_XGEN(b.x)], 1u);
            asm volatile("s_waitcnt vmcnt(0)" ::: "memory");
        } else {
            XB_SPIN(xb_ld(&bar[XB_XGEN(b.x)]) == gen, bar);
            __builtin_amdgcn_fence(__ATOMIC_ACQUIRE, "agent");
            asm volatile("s_waitcnt vmcnt(0)" ::: "memory");
        }
    }
    __syncthreads();
}

struct Args { const float* in[34]; float* out; uchar* ws; int ph_lo, ph_hi; };
enum { I_X = 0, I_C, I_CTX, I_CCTX, I_ADAW, I_ADAB, I_NMG, I_NFG, I_RGWIN, I_RGCW, I_RGCB, I_RGWA, I_RGBA, I_RGWI, I_RGBI, I_RGLAM, I_RGWOUT,
       I_ATQKV, I_ATQG, I_ATKG, I_ATWO, I_CMWIN, I_CMLNG, I_CMLNB, I_CMWS, I_CMBS, I_CMWOUT, I_MWG, I_MBG, I_MWR, I_MBR, I_MWGATE, I_MWUP, I_MWDOWN };

__device__ __forceinline__ const void* opaque_uniform_ptr(const void* p) { const unsigned long long v = (unsigned long long)p; unsigned lo = (unsigned)v, hi = (unsigned)(v >> 32); asm volatile("" : "+v"(lo), "+v"(hi));
    lo = __builtin_amdgcn_readfirstlane(lo); hi = __builtin_amdgcn_readfirstlane(hi); return (const void*)(const GAS char*)(((unsigned long long)hi << 32) | lo); }
__device__ __forceinline__ int opaque_uniform_int(int x) { asm volatile("" : "+v"(x)); return __builtin_amdgcn_readfirstlane(x); }
struct Frame {
    LAS uchar* lds; char* ldsg;
    int tid, lane, wave, G, bid;
    uchar* ws; float* out;
};
__device__ __forceinline__ const float* inp(const Frame& F, int i) { const unsigned long long v = *(const LAS unsigned long long*)(F.lds + LDSCTL_OFF + 576 + i * 8);
    const unsigned lo = __builtin_amdgcn_readfirstlane((unsigned)v), hi = __builtin_amdgcn_readfirstlane((unsigned)(v >> 32)); return (const float*)(const GAS float*)(((unsigned long long)hi << 32) | lo); }
__device__ __forceinline__ float wave16_sum(float v) {
    v += __int_as_float(__builtin_amdgcn_update_dpp(0, __float_as_int(v), 0xB1, 0xF, 0xF, true));
    v += __int_as_float(__builtin_amdgcn_update_dpp(0, __float_as_int(v), 0x4E, 0xF, 0xF, true));
    v += __int_as_float(__builtin_amdgcn_update_dpp(0, __float_as_int(v), 0x141, 0xF, 0xF, true));
    v += __int_as_float(__builtin_amdgcn_update_dpp(0, __float_as_int(v), 0x140, 0xF, 0xF, true));
    return v; }

struct ConvItem { const float* src; uchar* dst; int ldw; bool f8; };
__device__ __forceinline__ void tr_load(const ConvItem& ci, f32x4 (&v)[16]) {
    if (ci.f8) {
#pragma unroll
        for (int i = 0; i < 8; ++i) { v[2 * i] = __builtin_nontemporal_load((const f32x4*)(ci.src + (size_t)(8 * i) * ci.ldw)); v[2 * i + 1] = __builtin_nontemporal_load((const f32x4*)(ci.src + (size_t)(8 * i + 1) * ci.ldw)); }
    } else {
#pragma unroll
        for (int i = 0; i < 16; ++i) v[i] = __builtin_nontemporal_load((const f32x4*)(ci.src + (size_t)(4 * i) * ci.ldw));
    }
}
__device__ __forceinline__ void tr_finish(const f32x4 (&v)[16], const ConvItem& ci, LAS uchar* scr, int lane) {
    const int kr = lane >> 4, nc = (lane & 15) * 4;
    const int g = lane >> 4, q = (lane >> 2) & 3, p = lane & 3;
    const int vb = (int)(uintptr_t)scr + q * 128 + g * 32 + p * 8;
    if (ci.f8) {
#pragma unroll
        for (int i = 0; i < 8; ++i) { const f32x4 a = v[2 * i] * 32.f, b = v[2 * i + 1] * 32.f;
            int r0 = __builtin_amdgcn_cvt_pk_fp8_f32(a.x, b.x, 0, false); r0 = __builtin_amdgcn_cvt_pk_fp8_f32(a.y, b.y, r0, true);
            int r1 = __builtin_amdgcn_cvt_pk_fp8_f32(a.z, b.z, 0, false); r1 = __builtin_amdgcn_cvt_pk_fp8_f32(a.w, b.w, r1, true);
            *(LAS u32x2*)(scr + (4 * i + kr) * 128 + nc * 2) = (u32x2){(unsigned)r0, (unsigned)r1}; }
        asm volatile("s_waitcnt lgkmcnt(0)" ::: "memory");
        s16x4 t[8];
#define TRR(r) t[r] = att::tr_read<(r) * 512>(vb)
        TRR(0); TRR(1); TRR(2); TRR(3); TRR(4); TRR(5); TRR(6); TRR(7);
#undef TRR
        asm volatile("s_waitcnt lgkmcnt(0)" ::: "memory"); __builtin_amdgcn_sched_barrier(0);
#pragma unroll
        for (int j = 0; j < 4; ++j) { const bf16x8 o = {t[2 * j][0], t[2 * j][1], t[2 * j][2], t[2 * j][3], t[2 * j + 1][0], t[2 * j + 1][1], t[2 * j + 1][2], t[2 * j + 1][3]}; *(bf16x8*)(ci.dst + 16 * j) = o; }
    } else {
#pragma unroll
        for (int i = 0; i < 16; ++i) { u32x2 o; o.x = pk2(v[i].x, v[i].y); o.y = pk2(v[i].z, v[i].w); *(LAS u32x2*)(scr + (4 * i + kr) * 128 + nc * 2) = o; }
        asm volatile("s_waitcnt lgkmcnt(0)" ::: "memory");
        s16x4 t[16];
#define TRR(r) t[r] = att::tr_read<(r) * 512>(vb)
        TRR(0); TRR(1); TRR(2); TRR(3); TRR(4); TRR(5); TRR(6); TRR(7); TRR(8); TRR(9); TRR(10); TRR(11); TRR(12); TRR(13); TRR(14); TRR(15);
#undef TRR
        asm volatile("s_waitcnt lgkmcnt(0)" ::: "memory"); __builtin_amdgcn_sched_barrier(0);
#pragma unroll
        for (int j = 0; j < 8; ++j) { const bf16x8 o = {t[2 * j][0], t[2 * j][1], t[2 * j][2], t[2 * j][3], t[2 * j + 1][0], t[2 * j + 1][1], t[2 * j + 1][2], t[2 * j + 1][3]}; *(bf16x8*)(ci.dst + 16 * j) = o; }
    }
}
struct Job { int g, lo, hi; };
__device__ __forceinline__ ConvItem conv_decode(Frame& F, int g, int it) {
    uchar* ws = F.ws; const float* W; int K = 1024, N = 1024, ldt = 1024, mode = 0; size_t dms = 0; bf16_t* WT;
    switch (g) {
        case 0:  W = inp(F, I_MWGATE); N = 512; WT = (bf16_t*)(ws + WS_W_E1); dms = (size_t)1024 * 1024; mode = 1; break;
        case 1:  W = inp(F, I_MWUP);   N = 512; WT = (bf16_t*)(ws + WS_W_E1); dms = (size_t)1024 * 1024; mode = 2; break;
        case 2:  W = inp(F, I_MWDOWN); K = 512; WT = (bf16_t*)(ws + WS_W_E2); ldt = 512; dms = (size_t)1024 * 512; break;
        case 3:  W = inp(F, I_RGWIN);  N = 2048; WT = (bf16_t*)(ws + WS_W_RGIN); dms = (size_t)2048 * 1024; break;
        case 4:  W = inp(F, I_CMWIN);  N = 4096; WT = (bf16_t*)(ws + WS_W_CMIN); break;
        case 5:  W = inp(F, I_RGWOUT); WT = (bf16_t*)(ws + WS_W_RGOUT); dms = (size_t)1024 * 1024; break;
        case 6:  W = inp(F, I_CMWOUT); K = 2048; WT = (bf16_t*)(ws + WS_W_CMOUT); ldt = 2048; break;
        case 7:  W = inp(F, I_ATQKV);  N = 1536; WT = (bf16_t*)(ws + WS_W_QKV); break;
        case 8:  W = inp(F, I_ATWO);   WT = (bf16_t*)(ws + WS_W_AO); break;
        case 9:  W = inp(F, I_RGWA);   K = 128; N = 128; WT = (bf16_t*)(ws + WS_W_RGG); ldt = 128; dms = (size_t)256 * 128; break;
        default: W = inp(F, I_RGWI);   K = 128; N = 128; WT = (bf16_t*)(ws + WS_W_RGG); ldt = 128; dms = (size_t)256 * 128; mode = 3; break;
    }
    const int nblk = N / 64, per = (K / 64) * nblk, mat = it / per, r = it - mat * per, kb = r / nblk, nb = r - kb * nblk, n0 = nb * 64;
    int drow = n0;
    if (mode == 1) drow = (n0 >> 7) * 256 + (n0 & 127); else if (mode == 2) drow = (n0 >> 7) * 256 + 128 + (n0 & 127); else if (mode == 3) drow = 128 + n0;
    const int lane = F.lane;
    const bool f8 = (MOE_FP8 != 0) && g < 3; const int eb = f8 ? 1 : 2;
    ConvItem ci; ci.ldw = N; ci.f8 = f8; ci.src = W + (size_t)mat * K * N + (size_t)(kb * 64 + (f8 ? 2 : 1) * (lane >> 4)) * N + n0 + (lane & 15) * 4;
    int nl = (lane >> 4) * 16 + (lane & 15);
    if (g == 7 && n0 < 1280) { const int half = nl >> 5, f = nl & 31; nl = 32 * (f >> 4) + 8 * ((f >> 2) & 3) + 4 * half + (f & 3); }
    ci.dst = (uchar*)WT + ((size_t)mat * dms + (size_t)(drow + nl) * ldt + kb * 64) * eb;
    return ci;
}
template <int NJ>
__device__ __forceinline__ ConvItem conv_find(Frame& F, int v, const Job (&jobs)[NJ]) { int r = v, g = jobs[0].g, it = 0; bool found = false;
#pragma unroll
    for (int q = 0; q < NJ; ++q) { const int n = jobs[q].hi - jobs[q].lo; if (!found) { if (r < n) { g = jobs[q].g; it = jobs[q].lo + r; found = true; } else r -= n; } }
    return conv_decode(F, g, it); }
template <int NJ>
__device__ __forceinline__ void conv_tail(Frame& F, int nblk0, const Job (&jobs)[NJ]) {
    if (nblk0 >= F.G) nblk0 = 0;
    if (F.bid < nblk0) return;
    LAS uchar* scr = F.lds + F.wave * 8192;
    int total = 0;
#pragma unroll
    for (int q = 0; q < NJ; ++q) total += jobs[q].hi - jobs[q].lo;
    const int nw = (F.G - nblk0) * 8;
    int v0 = (F.bid - nblk0) * 8 + F.wave;
    f32x4 va[16], vb[16]; ConvItem c0, c1; c0.dst = nullptr; c1.dst = nullptr; c0.f8 = false; c1.f8 = false; c0.src = nullptr; c1.src = nullptr; c0.ldw = 0; c1.ldw = 0;
    if (v0 < total) { c0 = conv_find(F, v0, jobs); tr_load(c0, va); }
    for (; v0 < total; v0 += 2 * nw) {
        const int v1 = v0 + nw, v2 = v1 + nw;
        if (v1 < total) { c1 = conv_find(F, v1, jobs); tr_load(c1, vb); }
        tr_finish(va, c0, scr, F.lane);
        if (v2 < total) { c0 = conv_find(F, v2, jobs); tr_load(c0, va); }
        if (v1 < total) tr_finish(vb, c1, scr, F.lane);
    }
}
__device__ __forceinline__ void p0_prologue(Frame& F) {
    uchar* ws = F.ws;
    {
        LAS float* act = (LAS float*)(F.lds);
        LAS float* red = (LAS float*)(F.lds + 5 * 1024 * 4);
        bool have = false; const float* pC = inp(F, I_C); const float* pCC = inp(F, I_CCTX); const float* pADAW = inp(F, I_ADAW); const float* pADAB = inp(F, I_ADAB);
        for (int it = F.bid; it < DEPTH * 24; it += F.G) {
            if (!have) { for (int i = F.tid; i < 5 * 1024; i += 512) { const int s = i >> 10, k = i & 1023; const float v = s < 4 ? pC[s * 1024 + k] : pCC[k]; act[i] = v / (1.f + __expf(-v)); } have = true; __syncthreads(); }
            const int l = it / 24, cb = it % 24;
            const float* W = pADAW + (size_t)l * 1024 * NMODV + cb * 256 + F.lane * 4;
            f32x4 a[5];
#pragma unroll
            for (int s = 0; s < 5; ++s) a[s] = (f32x4){0.f, 0.f, 0.f, 0.f};
            const int kbase = F.wave * 128;
#pragma unroll 8
            for (int k = 0; k < 128; ++k) { const f32x4 w = *(const f32x4*)(W + (size_t)(kbase + k) * NMODV);
#pragma unroll
                for (int s = 0; s < 5; ++s) a[s] += w * act[s * 1024 + kbase + k]; }
#pragma unroll
            for (int s = 0; s < 5; ++s) *(LAS f32x4*)(red + (F.wave * 5 + s) * 256 + F.lane * 4) = a[s];
            __syncthreads();
            for (int i = F.tid; i < 5 * 256; i += 512) { const int s = i >> 8, c = i & 255; float v = pADAB[l * NMODV + cb * 256 + c];
#pragma unroll
                for (int w = 0; w < 8; ++w) v += red[(w * 5 + s) * 256 + c];
                ((float*)(ws + WS_MOD))[(l * 5 + s) * NMODV + cb * 256 + c] = v; }
            __syncthreads();
        }
        __syncthreads();
    }
    { const Job jobsA[8] = {{3, 0, 1024}, {4, 0, 1024}, {5, 0, 512}, {6, 0, 512}, {7, 0, 384}, {8, 0, 256}, {9, 0, 128}, {10, 0, 128}}; conv_tail(F, DEPTH * 24, jobsA);
      const Job jobsB[3] = {{0, 0, 16384}, {1, 0, 16384}, {2, 0, 16384}}; conv_tail(F, 0, jobsB); }
    {
        const int gt = F.bid * 512 + F.tid, NGT = F.G * 512;
        for (int i = gt; i < 8 * 128 * 128 / 4; i += NGT) { const f32x4 v = ((const f32x4*)inp(F, I_CMWS))[i]; u32x2 o; o.x = pk2(v.x, v.y); o.y = pk2(v.z, v.w); ((u32x2*)(ws + WS_W_CMS))[i] = o; }
        for (int i = gt; i < 2 * 2 * D; i += NGT) { const float* plam = inp(F, I_RGLAM); ((float*)(ws + WS_SPL))[i] = -8.f * log1pf(expf(-plam[i])); }
        for (int i = gt; i < 64 * 32; i += NGT) { const int pos = i >> 5, f = i & 31; const float inv = powf(10000.f, -(float)f * 2.0f / 64.0f); const float ang = (float)pos * inv;
            ((f32x2*)(ws + WS_ROPE))[i] = (f32x2){cosf(ang), sinf(ang)}; }
    }
}

__device__ __forceinline__ void router_fill(Frame& F, int l) {
    LAS float* wr = (LAS float*)F.lds;
    const float* wg = inp(F, I_MWG) + (size_t)l * 1024 * 4; const float* wrt = inp(F, I_MWR) + (size_t)l * 1024 * 32;
    __syncthreads();
    for (int i0 = F.tid; i0 < 1024 * 9; i0 += 512 * 6) { f32x4 v[6];
#pragma unroll
        for (int u = 0; u < 6; ++u) { const int idx = i0 + u * 512; const int k = idx / 9, q = idx - k * 9; v[u] = q == 0 ? *(const f32x4*)(wg + k * 4) : *(const f32x4*)(wrt + k * 32 + (q - 1) * 4); }
#pragma unroll
        for (int u = 0; u < 6; ++u) { const int idx = i0 + u * 512; const int k = idx / 9, q = idx - k * 9;
            wr[(4 * q + 0) * 1024 + k] = v[u].x; wr[(4 * q + 1) * 1024 + k] = v[u].y; wr[(4 * q + 2) * 1024 + k] = v[u].z; wr[(4 * q + 3) * 1024 + k] = v[u].w; } }
    __syncthreads();
}
template <bool ROUTE, int NADD, bool SRCIN>
__device__ __forceinline__ void norm_phase(Frame& F, int l, const float* gvec, int shift_i, bool skip_ctx_route, bool dry) {
    uchar* ws = F.ws;
    float* X = (float*)(ws + WS_X); const bf16_t* YS = (const bf16_t*)(ws + WS_Y1); const bf16_t* YM = (const bf16_t*)(ws + WS_YM); bf16_t* H = (bf16_t*)(ws + WS_H);
    const float* MOD = (const float*)(ws + WS_MOD) + (size_t)l * 5 * NMODV;
    LAS float* wr = (LAS float*)F.lds;
    const int i16 = F.lane & 15, grp = F.lane >> 4;
    const float* bg = nullptr; const float* br = nullptr; if constexpr (ROUTE) { bg = inp(F, I_MBG) + l * 4; br = inp(F, I_MBR) + l * 32; }
    const float* pctx = nullptr; const float* px = nullptr; if constexpr (SRCIN) { pctx = inp(F, I_CTX); px = inp(F, I_X); }
    for (int tok = (F.bid * 8 + F.wave) * 4 + grp; tok < T; tok += F.G * 32) {
        asm volatile("" ::: "memory");
        const int sidx = sidx_of_row(tok);
        f32x4 x[16];
        float ss = 0.f;
        const float* xrow = X + (size_t)tok * D;
        if constexpr (SRCIN) { const int b_ = tok / SB, s_ = tok - b_ * SB; xrow = s_ < CTX ? pctx + ((size_t)(b_ * CTX + s_) << 10) : px + ((size_t)(b_ * SEQ + s_ - CTX) << 10); }
#pragma unroll
        for (int j = 0; j < 16; ++j) x[j] = *(const f32x4*)(xrow + 64 * j + 4 * i16);
        if constexpr (NADD >= 1) {
#pragma unroll
            for (int j = 0; j < 16; ++j) { const u32x2 ym = *(const u32x2*)(YM + (size_t)tok * D + 64 * j + 4 * i16); x[j] += (f32x4){bflo(ym.x), bfhi(ym.x), bflo(ym.y), bfhi(ym.y)}; } }
        if constexpr (NADD == 3) {
#pragma unroll
            for (int j = 0; j < 16; ++j) { const u32x2 y0 = *(const u32x2*)(YS + (size_t)tok * D + 64 * j + 4 * i16), y1 = *(const u32x2*)(YS + ((size_t)T + tok) * D + 64 * j + 4 * i16);
                const f32x4 g5 = *(const f32x4*)(MOD - (size_t)5 * NMODV + (size_t)sidx * NMODV + 5 * D + 64 * j + 4 * i16);
                x[j] += g5 * (f32x4){bflo(y0.x) + bflo(y1.x), bfhi(y0.x) + bfhi(y1.x), bflo(y0.y) + bflo(y1.y), bfhi(y0.y) + bfhi(y1.y)}; }
#pragma unroll
            for (int j = 0; j < 16; ++j) *(f32x4*)(X + (size_t)tok * D + 64 * j + 4 * i16) = x[j]; }
#pragma unroll
        for (int j = 0; j < 16; ++j) ss += x[j].x * x[j].x + x[j].y * x[j].y + x[j].z * x[j].z + x[j].w * x[j].w;
        ss = wave16_sum(ss);
        const float rstd = rsqrtf(ss * (1.f / D) + NORM_EPS);
        const float* shp = MOD + (size_t)sidx * NMODV + shift_i * D; const float* scp = shp + D;
#pragma unroll
        for (int j = 0; j < 16; ++j) { const int c = 64 * j + 4 * i16; const f32x4 g = *(const f32x4*)(gvec + c), sh = *(const f32x4*)(shp + c), sc = *(const f32x4*)(scp + c);
            x[j] = x[j] * rstd * g * (sc + 1.f) + sh; }
#pragma unroll
        for (int j = 0; j < 16; ++j) { const int c = 64 * j + 4 * i16;
            if constexpr (ROUTE && MOE_FP8) { int r8 = __builtin_amdgcn_cvt_pk_fp8_f32(x[j].x, x[j].y, 0, false); r8 = __builtin_amdgcn_cvt_pk_fp8_f32(x[j].z, x[j].w, r8, true); *(int*)((uchar*)H + (size_t)tok * D + c) = r8; }
            else { u32x2 o; o.x = pk2(x[j].x, x[j].y); o.y = pk2(x[j].z, x[j].w); *(u32x2*)(H + (size_t)tok * D + c) = o; } }
        if constexpr (ROUTE) {
            LAS float* lgs = (LAS float*)(F.lds + LDSCTL_OFF + 1024) + (F.wave * 4 + grp) * 40;
#pragma unroll 1
            for (int o = 0; o < 36; ++o) { f32x4 w[16];
#pragma unroll
                for (int j = 0; j < 16; ++j) w[j] = *(const LAS f32x4*)(wr + o * 1024 + 64 * j + 4 * i16);
                __builtin_amdgcn_sched_barrier(0);
                f32x4 v0 = x[0] * w[0], v1 = x[1] * w[1];
#pragma unroll
                for (int j = 2; j < 16; j += 2) { v0 += x[j] * w[j]; v1 += x[j + 1] * w[j + 1]; }
                v0 += v1; float a0 = wave16_sum((v0.x + v0.y) + (v0.z + v0.w)); if (i16 == 0) lgs[o] = a0; }
            asm volatile("s_waitcnt lgkmcnt(0)" ::: "memory");
            const float gl0 = lgs[0] + bg[0], gl1 = lgs[1] + bg[1], gl2 = lgs[2] + bg[2], gl3 = lgs[3] + bg[3];
            int gs = 0; float gm = gl0;
            if (gl1 > gm) { gm = gl1; gs = 1; }
            if (gl2 > gm) { gm = gl2; gs = 2; }
            if (gl3 > gm) { gm = gl3; gs = 3; }
            const float den = __expf(gl0 - gm) + __expf(gl1 - gm) + __expf(gl2 - gm) + __expf(gl3 - gm);
            const float pg = 1.f / den;
            float el[8];
#pragma unroll
            for (int e = 0; e < 8; ++e) el[e] = lgs[4 + gs * 8 + e] + br[gs * 8 + e];
            int i0 = 0; float v0 = el[0];
#pragma unroll
            for (int e = 1; e < 8; ++e) if (el[e] > v0) { v0 = el[e]; i0 = e; }
            int i1 = -1; float v1 = -3.0e38f;
#pragma unroll
            for (int e = 0; e < 8; ++e) if (e != i0 && el[e] > v1) { v1 = el[e]; i1 = e; }
            const float p0 = 1.f / (1.f + __expf(v1 - v0));
            const float w0 = p0 * pg, w1 = (1.f - p0) * pg;
            const bool do_route = !(skip_ctx_route && sidx == 4) && !dry;
            if (i16 == 0 && do_route) {
                const int e0 = gs * 8 + i0, e1 = gs * 8 + i1;
                unsigned* cnt = (unsigned*)(ws + WS_CTL) + CW_CNT + l * 32 * 64;
                const unsigned q0 = atomicAdd(cnt + e0 * 64, 1u), q1 = atomicAdd(cnt + e1 * 64, 1u);
                u32x2* BK = (u32x2*)(ws + WS_BK2);
                BK[(size_t)e0 * T + q0] = (u32x2){(unsigned)(tok * 2), __float_as_uint(w0)}; BK[(size_t)e1 * T + q1] = (u32x2){(unsigned)(tok * 2 + 1), __float_as_uint(w1)};
            }
        }
    }
}

__device__ __forceinline__ void st8(bf16_t* p, f32x4 v0, f32x4 v1) { u32x4 w; w.x = cvt_pk_bf16(v0[0], v0[1]); w.y = cvt_pk_bf16(v0[2], v0[3]); w.z = cvt_pk_bf16(v1[0], v1[1]); w.w = cvt_pk_bf16(v1[2], v1[3]); *(u32x4*)p = w; }
#define EPI_ROWS(ai, m) (u.pm * 256 + (ai) * 128 + wr * 64 + (m) * 16 + fr)

struct EpiRgIn { static constexpr bool PERM = true, FP8 = false, PREFETCH = false; bf16_t* GG; bf16_t* XB;
    __device__ __forceinline__ void operator()(const f32x4 (&acc)[2][2][4][2], const pg8::Unit& u, int wr, int wc, int fr, int fq) const {
        const bool isg = u.pn < 4; bf16_t* base = isg ? GG : XB; const int ct = (u.pn & 3) * 256 + wc * 32 + 8 * fq;
#pragma unroll
        for (int ai = 0; ai < 2; ++ai)
#pragma unroll
            for (int m = 0; m < 4; ++m) { if (!((u.hm >> (2 * ai)) & 1)) continue; bf16_t* rowp = base + (size_t)EPI_ROWS(ai, m) * D + ct;
#pragma unroll
                for (int bj = 0; bj < 2; ++bj) { f32x4 v0 = acc[ai][bj][m][0], v1 = acc[ai][bj][m][1];
                    if (isg) {
#pragma unroll
                        for (int e = 0; e < 4; ++e) { v0[e] = gelu_tanh(v0[e]); v1[e] = gelu_tanh(v1[e]); } }
                    st8(rowp + bj * 128, v0, v1); } }
    } };
struct EpiBf16 { static constexpr bool PERM = true, FP8 = false, PREFETCH = false; bf16_t* O; int ldc;
    __device__ __forceinline__ void operator()(const f32x4 (&acc)[2][2][4][2], const pg8::Unit& u, int wr, int wc, int fr, int fq) const {
        const int ct = u.pn * 256 + wc * 32 + 8 * fq;
#pragma unroll
        for (int ai = 0; ai < 2; ++ai)
#pragma unroll
            for (int m = 0; m < 4; ++m) { if (!((u.hm >> (2 * ai)) & 1)) continue; bf16_t* rowp = O + (size_t)EPI_ROWS(ai, m) * ldc + ct;
#pragma unroll
                for (int bj = 0; bj < 2; ++bj) st8(rowp + bj * 128, acc[ai][bj][m][0], acc[ai][bj][m][1]); }
    } };
struct EpiQKV { static constexpr bool PERM = true, FP8 = false, PREFETCH = false; bf16_t* O; const float* qg; const float* kg; const float* rope; LAS float* xch;
    __device__ __forceinline__ void operator()(const f32x4 (&acc)[2][2][4][2], const pg8::Unit& u, int wr, int wc, int fr, int fq) const {
        if (u.pn == 5) {
            const int ct = u.pn * 256 + wc * 32 + 8 * fq;
#pragma unroll
            for (int ai = 0; ai < 2; ++ai)
#pragma unroll
                for (int m = 0; m < 4; ++m) { if (!((u.hm >> (2 * ai)) & 1)) continue; bf16_t* rowp = O + (size_t)EPI_ROWS(ai, m) * 1536 + ct;
#pragma unroll
                    for (int bj = 0; bj < 2; ++bj) st8(rowp + bj * 128, acc[ai][bj][m][0], acc[ai][bj][m][1]); }
            return; }
        const bool lat = (u.pm % 17) != 0; const float* gv = u.pn < 4 ? qg : kg; const int a = wc >> 1, f0 = 16 * (wc & 1) + 4 * fq;
        const f32x4 g1 = *(const f32x4*)(gv + 64 * a + f0), g2 = *(const f32x4*)(gv + 64 * a + 32 + f0);
        f32x4 cvs[4], svs[4];
        { const int t0 = ((u.pm % 17) - 1) * 256;
#pragma unroll
          for (int q = 0; q < 4; ++q) { cvs[q] = (f32x4){1.f, 1.f, 1.f, 1.f}; svs[q] = (f32x4){0.f, 0.f, 0.f, 0.f};
            if (lat) { const int pos = a ? (16 * q + fr) : ((t0 >> 6) + 2 * (q & 1) + wr); const f32x4 cs0 = *(const f32x4*)(rope + (pos * 32 + f0) * 2), cs1 = *(const f32x4*)(rope + (pos * 32 + f0) * 2 + 4);
                cvs[q] = (f32x4){cs0.x, cs0.z, cs1.x, cs1.z}; svs[q] = (f32x4){cs0.y, cs0.w, cs1.y, cs1.w}; } } }
#pragma unroll
        for (int ai = 0; ai < 2; ++ai)
#pragma unroll
            for (int m = 0; m < 4; ++m)
#pragma unroll
                for (int bj = 0; bj < 2; ++bj) { const f32x4 v0 = acc[ai][bj][m][0], v1 = acc[ai][bj][m][1];
                    float sq = ((v0.x * v0.x + v0.y * v0.y) + (v0.z * v0.z + v0.w * v0.w)) + ((v1.x * v1.x + v1.y * v1.y) + (v1.z * v1.z + v1.w * v1.w));
                    sq += __shfl_xor(sq, 16); sq += __shfl_xor(sq, 32);
                    if (fq == 0) xch[((ai * 128 + wr * 64 + m * 16 + fr) * 2 + bj) * 4 + wc] = sq; }
        asm volatile("s_waitcnt lgkmcnt(0)" ::: "memory"); __builtin_amdgcn_s_barrier(); asm volatile("" ::: "memory");
#pragma unroll
        for (int ai = 0; ai < 2; ++ai)
#pragma unroll
            for (int m = 0; m < 4; ++m) { if (!((u.hm >> (2 * ai)) & 1)) continue; const int row = EPI_ROWS(ai, m);
                const f32x4 cv = a ? cvs[m] : cvs[ai], sv = a ? svs[m] : svs[ai];
#pragma unroll
                for (int bj = 0; bj < 2; ++bj) { const f32x4 p4 = *(const LAS f32x4*)(xch + ((ai * 128 + wr * 64 + m * 16 + fr) * 2 + bj) * 4);
                    const float rstd = rsqrtf(((p4.x + p4.y) + (p4.z + p4.w)) * (1.f / 128.f) + NORM_EPS);
                    const f32x4 x1 = acc[ai][bj][m][0] * rstd * g1, x2 = acc[ai][bj][m][1] * rstd * g2;
                    const f32x4 o1 = x1 * cv - x2 * sv, o2 = x2 * cv + x1 * sv;
                    bf16_t* p = O + (size_t)row * 1536 + u.pn * 256 + bj * 128 + 64 * a + f0;
                    u32x2 w1, w2; w1.x = cvt_pk_bf16(o1.x, o1.y); w1.y = cvt_pk_bf16(o1.z, o1.w); w2.x = cvt_pk_bf16(o2.x, o2.y); w2.y = cvt_pk_bf16(o2.z, o2.w);
                    *(u32x2*)p = w1; *(u32x2*)(p + 32) = w2; } }
    } };
struct EpiCmIn { static constexpr bool PERM = true, FP8 = false, PREFETCH = false; bf16_t* O; f32x2* statp;
    __device__ __forceinline__ void operator()(const f32x4 (&acc)[2][2][4][2], const pg8::Unit& u, int wr, int wc, int fr, int fq) const {
        const int ct = u.pn * 256 + wc * 32 + 8 * fq; const bool isv = u.pn >= 8;
#pragma unroll
        for (int ai = 0; ai < 2; ++ai)
#pragma unroll
            for (int m = 0; m < 4; ++m) { if (!((u.hm >> (2 * ai)) & 1)) continue; const int row = EPI_ROWS(ai, m); bf16_t* rowp = O + (size_t)row * 4096 + ct; float s = 0.f, q = 0.f;
#pragma unroll
                for (int bj = 0; bj < 2; ++bj) { f32x4 v0 = acc[ai][bj][m][0], v1 = acc[ai][bj][m][1];
#pragma unroll
                    for (int e = 0; e < 4; ++e) { v0[e] = gelu_tanh(v0[e]); v1[e] = gelu_tanh(v1[e]); }
                    u32x4 w; w.x = cvt_pk_bf16(v0[0], v0[1]); w.y = cvt_pk_bf16(v0[2], v0[3]); w.z = cvt_pk_bf16(v1[0], v1[1]); w.w = cvt_pk_bf16(v1[2], v1[3]);
                    *(u32x4*)(rowp + bj * 128) = w;
                    const float r0 = bflo(w.x), r1 = bfhi(w.x), r2 = bflo(w.y), r3 = bfhi(w.y), r4 = bflo(w.z), r5 = bfhi(w.z), r6 = bflo(w.w), r7 = bfhi(w.w);
                    s += ((r0 + r1) + (r2 + r3)) + ((r4 + r5) + (r6 + r7)); q += ((r0 * r0 + r1 * r1) + (r2 * r2 + r3 * r3)) + ((r4 * r4 + r5 * r5) + (r6 * r6 + r7 * r7)); }
                if (isv) { s += __shfl_xor(s, 16); s += __shfl_xor(s, 32); q += __shfl_xor(q, 16); q += __shfl_xor(q, 32);
                    if (fq == 0) statp[(size_t)row * 32 + (u.pn - 8) * 4 + wc] = (f32x2){s, q}; } }
    } };
struct EpiResid { static constexpr bool PERM = true, FP8 = false, PREFETCH = false; bf16_t* YM; const float* gate  ;
    __device__ __forceinline__ void operator()(const f32x4 (&acc)[2][2][4][2], const pg8::Unit& u, int wr, int wc, int fr, int fq) const {
        const int sidx = sidx_of_row(u.pm * 256); const float* gp = gate + (size_t)sidx * NMODV; const int ct = u.pn * 256 + wc * 32 + 8 * fq;
        f32x4 gv[2][2];
#pragma unroll
        for (int bj = 0; bj < 2; ++bj)
#pragma unroll
            for (int n = 0; n < 2; ++n) gv[bj][n] = *(const f32x4*)(gp + ct + bj * 128 + n * 4);
#pragma unroll
        for (int ai = 0; ai < 2; ++ai)
#pragma unroll
            for (int m = 0; m < 4; ++m) { if (!((u.hm >> (2 * ai)) & 1)) continue; bf16_t* rowp = YM + (size_t)EPI_ROWS(ai, m) * D + ct;
#pragma unroll
                for (int bj = 0; bj < 2; ++bj) st8(rowp + bj * 128, gv[bj][0] * acc[ai][bj][m][0], gv[bj][1] * acc[ai][bj][m][1]); }
    } };
struct EpiRgGate { static constexpr bool PERM = true, FP8 = false, PREFETCH = false; const bf16_t* XC; bf16_t* LA; bf16_t* BB; const float* ba; const float* bi; const float* lam;
    __device__ __forceinline__ void operator()(const f32x4 (&acc)[2][2][4][2], const pg8::Unit& u, int wr, int wc, int fr, int fq) const {
        const int d = u.pn >> 3, blk = u.pn & 7;
        asm volatile("" : "+v"(fr), "+v"(fq));
        const int ch = blk * 128 + wc * 32 + 8 * fq;
        u32x4 xw[8];
#pragma unroll
        for (int r = 0; r < 8; ++r) xw[r] = *(const u32x4*)(XC + (size_t)EPI_ROWS(r >> 2, r & 3) * D + ch);
        f32x4 bav[2], biv[2], spv[2];
#pragma unroll
        for (int n = 0; n < 2; ++n) { bav[n] = *(const f32x4*)(ba + d * D + ch + 4 * n); biv[n] = *(const f32x4*)(bi + d * D + ch + 4 * n); spv[n] = *(const f32x4*)(lam + d * D + ch + 4 * n); }
#pragma unroll
        for (int r = 0; r < 8; ++r) { const int ai = r >> 2, m = r & 3; if (!((u.hm >> (2 * ai)) & 1)) continue;
            const size_t off = (size_t)EPI_ROWS(ai, m) * D + ch;
            const float xc[8] = {bflo(xw[r].x), bfhi(xw[r].x), bflo(xw[r].y), bfhi(xw[r].y), bflo(xw[r].z), bfhi(xw[r].z), bflo(xw[r].w), bfhi(xw[r].w)};
            float la[8], bb[8];
#pragma unroll
            for (int n = 0; n < 2; ++n)
#pragma unroll
                for (int e = 0; e < 4; ++e) { const float rg = fast_sigmoid(acc[ai][0][m][n][e] + bav[n][e]), ig = fast_sigmoid(acc[ai][1][m][n][e] + biv[n][e]);
                    const float lga = rg * spv[n][e]; la[4 * n + e] = lga; bb[4 * n + e] = __builtin_amdgcn_sqrtf(one_minus_exp(-2.f * lga)) * ig * xc[4 * n + e]; }
            u32x4 w; w.x = cvt_pk_bf16(la[0], la[1]); w.y = cvt_pk_bf16(la[2], la[3]); w.z = cvt_pk_bf16(la[4], la[5]); w.w = cvt_pk_bf16(la[6], la[7]);
            *(u32x4*)(LA + (size_t)d * T * D + off) = w;
            w.x = cvt_pk_bf16(bb[0], bb[1]); w.y = cvt_pk_bf16(bb[2], bb[3]); w.z = cvt_pk_bf16(bb[4], bb[5]); w.w = cvt_pk_bf16(bb[6], bb[7]);
            *(u32x4*)(BB + (size_t)d * T * D + off) = w; }
    } };

template <bool G1>
struct MoeOrder {
    static constexpr bool GATHER = G1;
    const LAS int* tab; const char* A; const char* B; const int* BK; int G, c, nunits; size_t bstride; int arow, brow;
    __device__ bool next(int i, pg8::Unit& u) const {
        int L, hm; if (!pg8::unit_slot(i, c, G, nunits, L, hm)) return false; u.hm = __builtin_amdgcn_readfirstlane(hm);
        const int wgid = __builtin_amdgcn_readfirstlane(pg8::xcd_remap(L, nunits)); const int tau = wgid >> 2, pn = wgid & 3;
        const int e = __builtin_amdgcn_readfirstlane(tab[192 + tau]);
        u.pm = tau; u.pn = pn; u.aux0 = e; u.aux1 = __builtin_amdgcn_readfirstlane((tau - tab[e]) * 256);
        u.a = pg8::uptr(G1 ? A : A + (size_t)tau * 256 * arow);
        u.b = pg8::uptr(B + (size_t)e * bstride + (size_t)pn * 256 * brow);
        return true; }
    __device__ unsigned goff(const pg8::Unit& u, int row) const {
        const int pos = u.aux1 + row; const int cnt = tab[40 + u.aux0];
        int tok = 0; if (pos < cnt) tok = __builtin_nontemporal_load(BK + ((size_t)u.aux0 * T + pos) * 2) >> 1;
        return (unsigned)tok * (unsigned)arow; }
};
struct EpiMoe1 { static constexpr bool PERM = true, FP8 = (MOE_FP8 != 0), PREFETCH = false; uchar* H1;
    __device__ __forceinline__ void operator()(const f32x4 (&acc)[2][2][4][2], const pg8::Unit& u, int wr, int wc, int fr, int fq) const {
        const int ct = u.pn * 128 + wc * 32 + 8 * fq;
#pragma unroll
        for (int ai = 0; ai < 2; ++ai)
#pragma unroll
            for (int m = 0; m < 4; ++m) { if (!((u.hm >> (2 * ai)) & 1)) continue; f32x4 h0, h1;
#pragma unroll
                for (int e = 0; e < 4; ++e) { constexpr float WS_ = FP8 ? (1.f / 32.f) : 1.f;
                    const float g0 = acc[ai][0][m][0][e] * WS_, g1 = acc[ai][0][m][1][e] * WS_; h0[e] = g0 * fast_sigmoid(g0) * (acc[ai][1][m][0][e] * WS_); h1[e] = g1 * fast_sigmoid(g1) * (acc[ai][1][m][1][e] * WS_); }
                if constexpr (FP8) { int r0 = __builtin_amdgcn_cvt_pk_fp8_f32(h0[0], h0[1], 0, false); r0 = __builtin_amdgcn_cvt_pk_fp8_f32(h0[2], h0[3], r0, true);
                    int r1 = __builtin_amdgcn_cvt_pk_fp8_f32(h1[0], h1[1], 0, false); r1 = __builtin_amdgcn_cvt_pk_fp8_f32(h1[2], h1[3], r1, true);
                    *(u32x2*)(H1 + (size_t)EPI_ROWS(ai, m) * DEXP + ct) = (u32x2){(unsigned)r0, (unsigned)r1}; }
                else st8((bf16_t*)H1 + (size_t)EPI_ROWS(ai, m) * DEXP + ct, h0, h1); }
    } };
struct EpiMoe2 { static constexpr bool PERM = true, FP8 = (MOE_FP8 != 0), PREFETCH = true; bf16_t* YS; const int* BK; const LAS int* tab;
    typedef int pre_t __attribute__((ext_vector_type(16)));
    __device__ __forceinline__ pre_t prefetch(const pg8::Unit& u, int wr, int fr) const { pre_t p; const int cnt = tab[40 + u.aux0];
#pragma unroll
        for (int r = 0; r < 8; ++r) { const int pos = u.aux1 + (r >> 2) * 128 + wr * 64 + (r & 3) * 16 + fr; u32x2 v = {0xffffffffu, 0u}; if (pos < cnt) v = __builtin_nontemporal_load((const u32x2*)BK + (size_t)u.aux0 * T + pos); p[2 * r] = (int)v.x; p[2 * r + 1] = (int)v.y; }
        return p; }
    __device__ __forceinline__ void operator()(const f32x4 (&acc)[2][2][4][2], const pg8::Unit& u, int wr, int wc, int fr, int fq, const pre_t& pre) const {
        const int ct = u.pn * 256 + wc * 32 + 8 * fq;
#pragma unroll
        for (int r = 0; r < 8; ++r) { const int e_ = pre[2 * r];
            if (e_ >= 0 && ((u.hm >> (2 * (r >> 2))) & 1)) { const int tok = e_ >> 1, slot = e_ & 1; const float w = __int_as_float(pre[2 * r + 1]) * (FP8 ? (1.f / 32.f) : 1.f);
                bf16_t* yp = YS + ((size_t)slot * T + tok) * D + ct;
#pragma unroll
                for (int bj = 0; bj < 2; ++bj) st8(yp + bj * 128, acc[r >> 2][bj][r & 3][0] * w, acc[r >> 2][bj][r & 3][1] * w); } }
    } };
__device__ __forceinline__ int moe_table(Frame& F, int l, LAS int* tab) {
    __syncthreads();
    if (F.tid < 32) { const unsigned c = __hip_atomic_load((unsigned*)(F.ws + WS_CTL) + CW_CNT + (l * 32 + F.tid) * 64, RLX_AGENT); tab[40 + F.tid] = (int)c; }
    __syncthreads();
    if (F.tid == 0) { int s = 0;
#pragma unroll 1
        for (int e = 0; e < 32; ++e) { tab[e] = s; s += (tab[40 + e] + 255) >> 8; } tab[32] = s; }
    __syncthreads();
    const int ntile_ = tab[32];
    for (int tau = F.tid; tau < ntile_; tau += 512) { int e = 0;
#pragma unroll 1
        for (int k = 1; k < 32; ++k) e = (tab[k] <= tau) ? k : e;
        tab[192 + tau] = e; }
    __syncthreads();
    return ntile_;
}

__device__ __forceinline__ void conv_phase(Frame& F, int j) {
    const bf16_t* XB = (const bf16_t*)(F.ws + WS_XB); bf16_t* XC = (bf16_t*)(F.ws + WS_XC);
    const float* cw = inp(F, I_RGCW) + (size_t)j * 4 * D; const float* cb = inp(F, I_RGCB) + (size_t)j * D;
    const int NGT = F.G * 512;
    for (int i0 = F.bid * 512 + F.tid; i0 < T * 128; i0 += 2 * NGT) {
        u32x4 xw[2][4];
#pragma unroll
        for (int q = 0; q < 2; ++q) { const int i = i0 + q * NGT; const int row = i >> 7, c = (i & 127) * 8; const int b = row / SB, s = row - b * SB; const int lo = s < CTX ? 0 : CTX, hi = s < CTX ? CTX : SB;
#pragma unroll
            for (int k = 0; k < 4; ++k) { const int ss = s + k - 2; xw[q][k] = (u32x4){0u, 0u, 0u, 0u}; if (i < T * 128 && ss >= lo && ss < hi) xw[q][k] = *(const u32x4*)(XB + (size_t)(b * SB + ss) * D + c); } }
#pragma unroll
        for (int q = 0; q < 2; ++q) { const int i = i0 + q * NGT; if (i < T * 128) { const int row = i >> 7, c = (i & 127) * 8;
            float a[8];
#pragma unroll
            for (int e = 0; e < 8; ++e) a[e] = cb[c + e];
#pragma unroll
            for (int k = 0; k < 4; ++k) { const f32x4 w0 = *(const f32x4*)(cw + k * D + c), w1 = *(const f32x4*)(cw + k * D + c + 4); const u32x4 x = xw[q][k];
                a[0] += w0.x * bflo(x.x); a[1] += w0.y * bfhi(x.x); a[2] += w0.z * bflo(x.y); a[3] += w0.w * bfhi(x.y);
                a[4] += w1.x * bflo(x.z); a[5] += w1.y * bfhi(x.z); a[6] += w1.z * bflo(x.w); a[7] += w1.w * bfhi(x.w); }
            u32x4 o; o.x = pk2(a[0], a[1]); o.y = pk2(a[2], a[3]); o.z = pk2(a[4], a[5]); o.w = pk2(a[6], a[7]);
            *(u32x4*)(XC + (size_t)row * D + c) = o; } }
    }
}
__device__ __forceinline__ void scan1_phase(Frame& F) {
    const bf16_t* LA = (const bf16_t*)(F.ws + WS_LA); const bf16_t* BB = (const bf16_t*)(F.ws + WS_BB); float* TS = (float*)(F.ws + WS_TOTS); float* TH = (float*)(F.ws + WS_TOTH);
    for (int it = F.bid * 8 + F.wave; it < NB * 2 * NCH * 4; it += F.G * 8) {
        const int cg = it & 3, rest = it >> 2, ck = rest % NCH, bd = rest / NCH, dir = bd & 1, b = bd >> 1;
        const int c = cg * 256 + F.lane * 4; const size_t base = (size_t)dir * T * D + (size_t)(b * SB + ck * 16) * D + c;
        u32x2 la[16], bb[16];
#pragma unroll
        for (int t = 0; t < 16; ++t) { const size_t o = base + (size_t)(dir ? 15 - t : t) * D; la[t] = *(const u32x2*)(LA + o); bb[t] = *(const u32x2*)(BB + o); }
        f32x4 sl = {0.f, 0.f, 0.f, 0.f}, h = {0.f, 0.f, 0.f, 0.f};
#pragma unroll
        for (int t = 0; t < 16; ++t) { const f32x4 l4 = {bflo(la[t].x), bfhi(la[t].x), bflo(la[t].y), bfhi(la[t].y)}, b4 = {bflo(bb[t].x), bfhi(bb[t].x), bflo(bb[t].y), bfhi(bb[t].y)};
            sl += l4; f32x4 a4 = {__expf(l4.x), __expf(l4.y), __expf(l4.z), __expf(l4.w)}; h = a4 * h + b4; }
        const size_t o = (size_t)(bd * NCH + ck) * D + c; *(f32x4*)(TS + o) = sl; *(f32x4*)(TH + o) = h;
    }
}
__device__ __forceinline__ void scan2_phase(Frame& F) {
    const float* TS = (const float*)(F.ws + WS_TOTS); const float* TH = (const float*)(F.ws + WS_TOTH); float* CY = (float*)(F.ws + WS_CARRY);
    LAS float* wt = (LAS float*)F.lds;
    for (int it = F.bid; it < NB * 2 * 16; it += F.G) {
        const int cg = it & 15, bd = it >> 4, dir = bd & 1; const int c = cg * 64 + F.lane; const size_t base = (size_t)bd * NCH * D + c;
        const int s0 = F.wave * 34;
        float P = 0.f, H = 0.f;
#pragma unroll 1
        for (int sb = 0; sb < 34; sb += 17) { float sl[17], hl[17];
#pragma unroll
            for (int q = 0; q < 17; ++q) { const int s = s0 + sb + q; const int ck = dir ? (s < 16 ? 15 - s : NCH + 15 - s) : s; sl[q] = TS[base + (size_t)ck * D]; hl[q] = TH[base + (size_t)ck * D]; }
#pragma unroll
            for (int q = 0; q < 17; ++q) { P += sl[q]; H = __expf(sl[q]) * H + hl[q]; } }
        __syncthreads();
        wt[(F.wave * 2 + 0) * 64 + F.lane] = P; wt[(F.wave * 2 + 1) * 64 + F.lane] = H;
        __syncthreads();
        float h = 0.f;
        for (int w = 0; w < F.wave; ++w) h = __expf(wt[(w * 2 + 0) * 64 + F.lane]) * h + wt[(w * 2 + 1) * 64 + F.lane];
#pragma unroll 1
        for (int sb = 0; sb < 34; sb += 17) { float sl[17], hl[17]; int ckk[17];
#pragma unroll
            for (int q = 0; q < 17; ++q) { const int s = s0 + sb + q; ckk[q] = dir ? (s < 16 ? 15 - s : NCH + 15 - s) : s; sl[q] = TS[base + (size_t)ckk[q] * D]; hl[q] = TH[base + (size_t)ckk[q] * D]; }
#pragma unroll
            for (int q = 0; q < 17; ++q) { CY[base + (size_t)ckk[q] * D] = h; h = __expf(sl[q]) * h + hl[q]; } }
    }
    __syncthreads();
}
__device__ __forceinline__ void scan3_phase(Frame& F) {
    const bf16_t* LA = (const bf16_t*)(F.ws + WS_LA); const bf16_t* BB = (const bf16_t*)(F.ws + WS_BB); const float* CY = (const float*)(F.ws + WS_CARRY);
    const bf16_t* GG = (const bf16_t*)(F.ws + WS_GG); bf16_t* SA = (bf16_t*)(F.ws + WS_SA);
    LAS f32x4* hb = (LAS f32x4*)(F.lds + F.wave * 16384);
    for (int it = F.bid * 8 + F.wave; it < NB * NCH * 4; it += F.G * 8) {
        const int cg = it & 3, rest = it >> 2, ck = rest % NCH, b = rest / NCH;
        const int c = cg * 256 + F.lane * 4;
        const size_t rbase = (size_t)(b * SB + ck * 16) * D + c, b1 = (size_t)T * D + rbase;
        f32x4 hbk = *(const f32x4*)(CY + (size_t)((b * 2 + 1) * NCH + ck) * D + c), hf = *(const f32x4*)(CY + (size_t)((b * 2 + 0) * NCH + ck) * D + c);
        { u32x2 la[16], bb[16];
#pragma unroll
          for (int t = 0; t < 16; ++t) { la[t] = *(const u32x2*)(LA + b1 + (size_t)(15 - t) * D); bb[t] = *(const u32x2*)(BB + b1 + (size_t)(15 - t) * D); }
#pragma unroll
          for (int t = 0; t < 16; ++t) { const f32x4 l4 = {bflo(la[t].x), bfhi(la[t].x), bflo(la[t].y), bfhi(la[t].y)}, b4 = {bflo(bb[t].x), bfhi(bb[t].x), bflo(bb[t].y), bfhi(bb[t].y)};
              const f32x4 a4 = {__expf(l4.x), __expf(l4.y), __expf(l4.z), __expf(l4.w)}; hbk = a4 * hbk + b4; hb[(15 - t) * 64 + F.lane] = hbk; } }
        { u32x2 la[16], bb[16], gg[16];
#pragma unroll
          for (int t = 0; t < 16; ++t) { la[t] = *(const u32x2*)(LA + rbase + (size_t)t * D); bb[t] = *(const u32x2*)(BB + rbase + (size_t)t * D); gg[t] = *(const u32x2*)(GG + rbase + (size_t)t * D); }
#pragma unroll
          for (int t = 0; t < 16; ++t) { const f32x4 l4 = {bflo(la[t].x), bfhi(la[t].x), bflo(la[t].y), bfhi(la[t].y)}, b4 = {bflo(bb[t].x), bfhi(bb[t].x), bflo(bb[t].y), bfhi(bb[t].y)};
              const f32x4 g4 = {bflo(gg[t].x), bfhi(gg[t].x), bflo(gg[t].y), bfhi(gg[t].y)};
              const f32x4 a4 = {__expf(l4.x), __expf(l4.y), __expf(l4.z), __expf(l4.w)}; hf = a4 * hf + b4; const f32x4 y = g4 * (hf + hb[t * 64 + F.lane]);
              u32x2 o; o.x = pk2(y.x, y.y); o.y = pk2(y.z, y.w); *(u32x2*)(SA + rbase + (size_t)t * D) = o; } }
    }
}

__device__ __forceinline__ void qknorm_phase(Frame& F) {
    bf16_t* QKV = (bf16_t*)(F.ws + WS_QKV); const f32x2* ROPE = (const f32x2*)(F.ws + WS_ROPE);
    const int i16 = F.lane & 15, grp = F.lane >> 4; const float* pqg = inp(F, I_ATQG); const float* pkg = inp(F, I_ATKG);
    const int ITS = F.G * 32;
    for (int it0 = (F.bid * 8 + F.wave) * 4 + grp; it0 < T * 10; it0 += 4 * ITS) {
        u32x4 xw4[4];
#pragma unroll
        for (int q = 0; q < 4; ++q) { const int it = it0 + q * ITS; xw4[q] = (u32x4){0u, 0u, 0u, 0u}; if (it < T * 10) { const int row = it / 10, hh = it - row * 10; xw4[q] = *(const u32x4*)(QKV + (size_t)row * 1536 + hh * 128 + i16 * 8); } }
#pragma unroll
        for (int q = 0; q < 4; ++q) { const int it = it0 + q * ITS; const bool valid = it < T * 10; const int itc = valid ? it : 0;
            const int row = itc / 10, hh = itc - row * 10; const int b = row / SB, s = row - b * SB;
            bf16_t* p = QKV + (size_t)row * 1536 + hh * 128 + i16 * 8;
            const u32x4 xw = xw4[q];
            float x[8] = {bflo(xw.x), bfhi(xw.x), bflo(xw.y), bfhi(xw.y), bflo(xw.z), bfhi(xw.z), bflo(xw.w), bfhi(xw.w)};
            float ss = 0.f;
#pragma unroll
            for (int e = 0; e < 8; ++e) ss += x[e] * x[e];
            ss = wave16_sum(ss);
            const float rstd = rsqrtf(ss * (1.f / 128.f) + NORM_EPS);
            const float* g = (hh < 8 ? pqg : pkg) + i16 * 8;
#pragma unroll
            for (int e = 0; e < 8; ++e) x[e] = x[e] * rstd * g[e];
            float y[8];
#pragma unroll
            for (int e = 0; e < 8; ++e) y[e] = __shfl_xor(x[e], 4);
            if (s >= CTX) { const int t = s - CTX; const int pos = (i16 >> 3) ? (t & 63) : (t >> 6); const bool half1 = (i16 >> 2) & 1;
#pragma unroll
                for (int e = 0; e < 8; ++e) { const f32x2 cs = ROPE[pos * 32 + (i16 & 3) * 8 + e];
                    x[e] = half1 ? (x[e] * cs.x + y[e] * cs.y) : (x[e] * cs.x - y[e] * cs.y); } }
            u32x4 o; o.x = pk2(x[0], x[1]); o.y = pk2(x[2], x[3]); o.z = pk2(x[4], x[5]); o.w = pk2(x[6], x[7]);
            if (valid) *(u32x4*)p = o;
        }
    }
}
__device__ __forceinline__ void attn_phase(Frame& F) {
    const bf16_t* QKV = (const bf16_t*)(F.ws + WS_QKV); bf16_t* AO = (bf16_t*)(F.ws + WS_AO);
    for (int u = F.bid; u < 544; u += F.G) {
        int b, h, q0, k0, seq;
        if (u < 512) { const int qb = u & 15, hg = (u >> 4) & 3, kvh = (u >> 6) & 1; b = u >> 7; h = kvh * 4 + hg; q0 = b * SB + CTX + qb * 256; k0 = b * SB; seq = SB; }
        else { const int v = u - 512; b = v >> 3; h = v & 7; q0 = b * SB; k0 = b * SB; seq = CTX; }
        const int kvh = h >> 2;
        const bf16_t* Kp = (const bf16_t*)pg8::uptr((const char*)(QKV + (size_t)k0 * 1536 + 1024 + kvh * 128));
        att::attn_dense_body((const bf16_t*)pg8::uptr((const char*)(QKV + (size_t)q0 * 1536 + h * 128)), Kp, Kp + 256, (bf16_t*)pg8::uptr((const char*)(AO + (size_t)q0 * D + h * 128)), seq, F.ldsg, F.tid);
        __syncthreads();
    }
}

__device__ __forceinline__ void spatial_phase(Frame& F) {
    const bf16_t* UVB = (const bf16_t*)(F.ws + WS_UVB); bf16_t* UV = (bf16_t*)(F.ws + WS_UV); const f32x2* statp = (const f32x2*)(F.ws + WS_STATP);
    const bf16_t* Ws = (const bf16_t*)(F.ws + WS_W_CMS); const float* lng = inp(F, I_CMLNG); const float* lnb = inp(F, I_CMLNB); const float* bs = inp(F, I_CMBS);
    LAS uchar* vl = F.lds;
    LAS f32x2* st = (LAS f32x2*)(F.lds + 65536);
    const int tid = F.tid, lane = F.lane, wid = F.wave, r32 = lane & 31, hi = lane >> 5, wm = wid & 3, wn = wid >> 2;
    const int sr = tid >> 4, sc = (tid & 15) * 8;
    for (int u = F.bid; u < 136 * 8; u += F.G) {
        const int chunk = u >> 3, g = u & 7; const int row0 = chunk * 128;
        float s_ = 0.f, q_ = 0.f;
        { const f32x2* sp = statp + (size_t)(row0 + (tid >> 2)) * 32 + (tid & 3) * 8; f32x2 pv[8];
#pragma unroll
          for (int k = 0; k < 8; ++k) pv[k] = sp[k];
#pragma unroll
          for (int k = 0; k < 8; ++k) { s_ += pv[k].x; q_ += pv[k].y; } }
        u32x4 xw[2][4]; f32x4 lg0[2], lg1[2], lb0[2], lb1[2];
#pragma unroll
        for (int ch = 0; ch < 2; ++ch) { const int cg = g * 256 + ch * 128 + sc;
            lg0[ch] = *(const f32x4*)(lng + cg); lg1[ch] = *(const f32x4*)(lng + cg + 4); lb0[ch] = *(const f32x4*)(lnb + cg); lb1[ch] = *(const f32x4*)(lnb + cg + 4);
#pragma unroll
            for (int i = 0; i < 4; ++i) xw[ch][i] = *(const u32x4*)(UVB + (size_t)(row0 + sr + 32 * i) * 4096 + 2048 + cg); }
        bf16x8 pa[2][4];
#pragma unroll
        for (int kt = 0; kt < 2; ++kt)
#pragma unroll
            for (int ks = 0; ks < 4; ++ks) pa[kt][ks] = *(const bf16x8*)(Ws + ((size_t)g * 128 + 32 * wm + r32) * 128 + 64 * kt + 16 * ks + 8 * hi);
        u32x4 uu[8];
#pragma unroll
        for (int i = 0; i < 8; ++i) { const int id = tid + 512 * i, row = id >> 5, ch = id & 31; uu[i] = *(const u32x4*)(UVB + (size_t)(row0 + row) * 4096 + g * 256 + ch * 8); }
        s_ += __int_as_float(__builtin_amdgcn_update_dpp(0, __float_as_int(s_), 0xB1, 0xF, 0xF, true)); s_ += __int_as_float(__builtin_amdgcn_update_dpp(0, __float_as_int(s_), 0x4E, 0xF, 0xF, true));
        q_ += __int_as_float(__builtin_amdgcn_update_dpp(0, __float_as_int(q_), 0xB1, 0xF, 0xF, true)); q_ += __int_as_float(__builtin_amdgcn_update_dpp(0, __float_as_int(q_), 0x4E, 0xF, 0xF, true));
        __syncthreads();
        if ((tid & 3) == 0) { const float mean = s_ * (1.f / 2048.f); const float var = fmaxf(q_ * (1.f / 2048.f) - mean * mean, 0.f); st[tid >> 2] = (f32x2){mean, rsqrtf(var + NORM_EPS)}; }
        __syncthreads();
#pragma unroll
        for (int ch = 0; ch < 2; ++ch) {
#pragma unroll
            for (int i = 0; i < 4; ++i) { const int q = sr + 32 * i; const u32x4 x_ = xw[ch][i]; const f32x2 ms = st[q];
                f32x4 v0 = {bflo(x_.x), bfhi(x_.x), bflo(x_.y), bfhi(x_.y)}, v1 = {bflo(x_.z), bfhi(x_.z), bflo(x_.w), bfhi(x_.w)};
                v0 = (v0 - ms.x) * ms.y * lg0[ch] + lb0[ch]; v1 = (v1 - ms.x) * ms.y * lg1[ch] + lb1[ch];
                u32x4 o; o.x = pk2(v0.x, v0.y); o.y = pk2(v0.z, v0.w); o.z = pk2(v1.x, v1.y); o.w = pk2(v1.z, v1.w);
                *(LAS u32x4*)(vl + ((q >> 6) * 2 + ch) * 16384 + att::v_st(q & 63, sc)) = o; } }
        __syncthreads();
        f32x16 o[4] = {};
        const int vb = (int)(uintptr_t)(F.ldsg) + att::v_rd_base(lane) + wn * 16384;
        att::pv_d0(o, vb, pa[0][0], pa[0][1], pa[0][2], pa[0][3]);
        att::pv_d0(o, vb + 32768, pa[1][0], pa[1][1], pa[1][2], pa[1][3]);
        __syncthreads();
#pragma unroll
        for (int r = 0; r < 16; ++r) { const int p = 32 * wm + att::crow(r, hi); const float bsv = bs[g * 128 + p];
#pragma unroll
            for (int d0 = 0; d0 < 4; ++d0) *(LAS bf16_t*)(vl + p * 512 + (128 * wn + 32 * d0 + r32) * 2) = (bf16_t)f2bf(o[d0][r] + bsv); }
        __syncthreads();
#pragma unroll
        for (int i = 0; i < 8; ++i) { const int id = tid + 512 * i, row = id >> 5, ch = id & 31; const u32x4 v = *(const LAS u32x4*)(vl + row * 512 + ch * 16); const u32x4 w = uu[i];
            u32x4 o4; o4.x = pk2(bflo(v.x) * bflo(w.x), bfhi(v.x) * bfhi(w.x)); o4.y = pk2(bflo(v.y) * bflo(w.y), bfhi(v.y) * bfhi(w.y)); o4.z = pk2(bflo(v.z) * bflo(w.z), bfhi(v.z) * bfhi(w.z)); o4.w = pk2(bflo(v.w) * bflo(w.w), bfhi(v.w) * bfhi(w.w));
            *(u32x4*)(UV + (size_t)(row0 + row) * 2048 + g * 256 + ch * 8) = o4; }
    }
    __syncthreads();
}

__device__ __forceinline__ void final_phase(Frame& F) {
    const f32x4* X = (const f32x4*)(F.ws + WS_X); const u32x2* YS = (const u32x2*)(F.ws + WS_Y1); const u32x2* YM = (const u32x2*)(F.ws + WS_YM); f32x4* out = (f32x4*)F.out;
    const f32x4* G5 = (const f32x4*)((const float*)(F.ws + WS_MOD) + (size_t)(DEPTH - 1) * 5 * NMODV + 5 * D);
    const int NGT = F.G * 512;
    for (int i0 = F.bid * 512 + F.tid; i0 < NB * SEQ * 256; i0 += 4 * NGT) { f32x4 a[4]; u32x2 y0[4], y1[4], ym[4];
#pragma unroll
        for (int q = 0; q < 4; ++q) { const int i = i0 + q * NGT; if (i < NB * SEQ * 256) { const int r = i >> 8, c4 = i & 255, b = r >> 12, t = r & 4095; const size_t src = ((size_t)(b * SB + CTX + t) << 8) + c4; a[q] = X[src]; y0[q] = YS[src]; y1[q] = YS[src + (size_t)T * 256]; ym[q] = YM[src]; } }
#pragma unroll
        for (int q = 0; q < 4; ++q) { const int i = i0 + q * NGT; if (i < NB * SEQ * 256) { const int r = i >> 8, c4 = i & 255, b = r >> 12; const f32x4 g5 = G5[(size_t)b * (NMODV / 4) + c4];
            out[i] = a[q] + (f32x4){bflo(ym[q].x), bfhi(ym[q].x), bflo(ym[q].y), bfhi(ym[q].y)} + g5 * (f32x4){bflo(y0[q].x) + bflo(y1[q].x), bfhi(y0[q].x) + bfhi(y1[q].x), bflo(y0[q].y) + bflo(y1[q].y), bfhi(y0[q].y) + bfhi(y1[q].y)}; } } }
}

constexpr int NPHASE = 38;
__global__ void __launch_bounds__(512, 2) mk_fwd(Args args) {
    extern __shared__ __attribute__((aligned(16))) uchar lds[];
    Frame F; F.lds = (LAS uchar*)lds; F.ldsg = (char*)lds; F.tid = threadIdx.x; F.lane = F.tid & 63; F.wave = __builtin_amdgcn_readfirstlane(F.tid >> 6); F.G = gridDim.x; F.bid = blockIdx.x;
    F.ws = args.ws; F.out = args.out;
    uchar* ws0 = args.ws;
    volatile LAS unsigned* MISC = (volatile LAS unsigned*)(F.lds + LDSCTL_OFF);
    LAS int* tab = (LAS int*)(F.lds + LDSCTL_OFF + 256);
    for (int u = F.tid; u < (LDS_BYTES - LDSCTL_OFF) / 4; u += 512) ((LAS unsigned*)(F.lds + LDSCTL_OFF))[u] = 0u;
    __syncthreads();
    if (F.tid == 0) {
#pragma unroll
        for (int i = 0; i < 34; ++i) *(LAS unsigned long long*)(F.lds + LDSCTL_OFF + 576 + i * 8) = (unsigned long long)args.in[i]; }
    __syncthreads();
    const int lo = args.ph_lo, hi = args.ph_hi;
    if (hi - lo > 1) (void)xcd_barrier_post((unsigned*)(ws0 + WS_CTL) + CW_BAR, MISC + 8);
    int ph = 0;
#define PH_BEGIN if (ph >= opaque_uniform_int(args.ph_lo) && ph < opaque_uniform_int(args.ph_hi)) { int t_ = threadIdx.x; F.G = opaque_uniform_int(gridDim.x); F.bid = opaque_uniform_int(blockIdx.x); const int cid = F.bid; (void)cid; \
        F.out = (float*)opaque_uniform_ptr(args.out); F.lds = (LAS uchar*)lds; F.ldsg = (char*)lds; \
        asm volatile("" : "+v"(t_)); F.tid = t_; F.lane = t_ & 63; F.wave = __builtin_amdgcn_readfirstlane(t_ >> 6); \
        uchar* ws = (uchar*)opaque_uniform_ptr(args.ws); F.ws = ws; \
        const float* MODl = (const float*)(ws + WS_MOD) + (size_t)l_ * 5 * NMODV; (void)MODl;
#define GRIDBAR  { XcdBarrier bb_; bb_.bar = (unsigned*)(ws + WS_CTL) + CW_BAR; bb_.x = 0; bb_.st = (volatile LAS unsigned*)(F.lds + LDSCTL_OFF) + 8; xcd_barrier(bb_); }
#define REPBAR   if (rep_ > 1) GRIDBAR
#define PH_END   if (ph + 1 < opaque_uniform_int(args.ph_hi)) GRIDBAR } ++ph;

    { const int l_ = 0; PH_BEGIN PM(0) { const bool dry = rep_ > 1; (void)dry;  p0_prologue(F);  REPBAR } PH_END }

#pragma unroll 1
    for (int l = 0; l < DEPTH; ++l) {
        const int kind = l % 3, j = l / 3; const bool lastl = (l == DEPTH - 1); const int l_ = l;
        PH_BEGIN PM(1) { const bool dry = rep_ > 1; (void)dry;  const float* gv_ = inp(F, I_NMG) + l * D;
            if (l == 0) norm_phase<false, 0, true>(F, l, gv_, 0, false, false);
            else if (rep_ != REPN(1)) norm_phase<false, 0, false>(F, l, gv_, 0, false, false);
            else if (l == 1) norm_phase<false, 3, true>(F, l, gv_, 0, false, false);
            else norm_phase<false, 3, false>(F, l, gv_, 0, false, false);  REPBAR } PH_END
        if (kind == 0) {
            PH_BEGIN PM(2) { const bool dry = rep_ > 1; (void)dry;  { pg8::DenseOrder S; S.init(ws + WS_H, D, ws + WS_W_RGIN + (size_t)j * 2048 * 1024 * 2, D, T, 2048, F.G, cid);
                EpiRgIn E{(bf16_t*)(ws + WS_GG), (bf16_t*)(ws + WS_XB)}; pg8::gemm_phase(F.lds, S, E, D, D, D); }  REPBAR } PH_END
            PH_BEGIN PM(3) { const bool dry = rep_ > 1; (void)dry;  conv_phase(F, j);  REPBAR } PH_END
            PH_BEGIN PM(4) { const bool dry = rep_ > 1; (void)dry;  { pg8::DenseOrder S; S.init(ws + WS_XC, D, ws + WS_W_RGG + (size_t)j * 16 * 256 * 128 * 2, 128, T, 16 * 256, F.G, cid, 7, 256);
                EpiRgGate E{(const bf16_t*)(ws + WS_XC), (bf16_t*)(ws + WS_LA), (bf16_t*)(ws + WS_BB), inp(F, I_RGBA) + (size_t)j * 2 * D, inp(F, I_RGBI) + (size_t)j * 2 * D, (const float*)(ws + WS_SPL) + (size_t)j * 2 * D};
                pg8::gemm_phase(F.lds, S, E, 128, D, 128); }  REPBAR } PH_END
            PH_BEGIN PM(5) { const bool dry = rep_ > 1; (void)dry;  scan1_phase(F);  REPBAR } PH_END
            PH_BEGIN PM(20) { const bool dry = rep_ > 1; (void)dry;  scan2_phase(F);  REPBAR } PH_END
            PH_BEGIN PM(6) { const bool dry = rep_ > 1; (void)dry;  scan3_phase(F);  REPBAR } PH_END
            PH_BEGIN PM(7) { const bool dry = rep_ > 1; (void)dry;  { pg8::DenseOrder S; S.init(ws + WS_SA, D, ws + WS_W_RGOUT + (size_t)j * 1024 * 1024 * 2, D, T, D, F.G, cid);
                EpiResid E{(bf16_t*)(ws + (dry ? WS_Y1 : WS_YM)), MODl + 2 * D}; pg8::gemm_phase(F.lds, S, E, D, D, D); router_fill(F, l); }  REPBAR } PH_END
        } else if (kind == 1) {
            PH_BEGIN PM(8) { const bool dry = rep_ > 1; (void)dry;  { pg8::DenseOrder S; S.init(ws + WS_H, D, ws + WS_W_QKV, D, T, 1536, F.G, cid);
                EpiQKV E{(bf16_t*)(ws + WS_QKV), inp(F, I_ATQG), inp(F, I_ATKG), (const float*)(ws + WS_ROPE), (LAS float*)(F.lds + RING_BYTES)}; pg8::gemm_phase(F.lds, S, E, D, D, D); }  REPBAR } PH_END
            PH_BEGIN PM(10) { const bool dry = rep_ > 1; (void)dry;  attn_phase(F);  REPBAR } PH_END
            PH_BEGIN PM(11) { const bool dry = rep_ > 1; (void)dry;  { pg8::DenseOrder S; S.init(ws + WS_AO, D, ws + WS_W_AO, D, T, D, F.G, cid);
                EpiResid E{(bf16_t*)(ws + (dry ? WS_Y1 : WS_YM)), MODl + 2 * D}; pg8::gemm_phase(F.lds, S, E, D, D, D); router_fill(F, l); }  REPBAR } PH_END
        } else {
            PH_BEGIN PM(12) { const bool dry = rep_ > 1; (void)dry;  { pg8::DenseOrder S; S.init(ws + WS_H, D, ws + WS_W_CMIN, D, T, 4096, F.G, cid);
                EpiCmIn E{(bf16_t*)(ws + WS_UVB), (f32x2*)(ws + WS_STATP)}; pg8::gemm_phase(F.lds, S, E, D, D, D); }  REPBAR } PH_END
            PH_BEGIN PM(13) { const bool dry = rep_ > 1; (void)dry;  spatial_phase(F);  REPBAR } PH_END
            PH_BEGIN PM(14) { const bool dry = rep_ > 1; (void)dry;  { pg8::DenseOrder S; S.init(ws + WS_UV, 2048, ws + WS_W_CMOUT, 2048, T, D, F.G, cid);
                EpiResid E{(bf16_t*)(ws + (dry ? WS_Y1 : WS_YM)), MODl + 2 * D}; pg8::gemm_phase(F.lds, S, E, 2048, 2048, 2048); router_fill(F, l); }  REPBAR } PH_END
        }
        PH_BEGIN PM(15) { const bool dry = rep_ > 1; (void)dry;  if (l == 0) norm_phase<true, 1, true>(F, l, inp(F, I_NFG) + l * D, 3, lastl, dry); else norm_phase<true, 1, false>(F, l, inp(F, I_NFG) + l * D, 3, lastl, dry);  REPBAR } PH_END
        PH_BEGIN PM(16) { const bool dry = rep_ > 1; (void)dry;  { const int ntile = moe_table(F, l, tab);
            const int units = ntile * 4, rounds = (units + F.G - 1) / F.G; int geff = F.G; if (false && rounds > 0) { geff = (((units + rounds - 1) / rounds) + 7) & ~7; if (geff > F.G) geff = F.G; }
            constexpr int EB = MOE_FP8 ? 1 : 2;
            MoeOrder<true> S{tab, (const char*)(ws + WS_H), (const char*)(ws + WS_W_E1 + (size_t)l * 32 * 1024 * 1024 * EB), (const int*)(ws + WS_BK2), geff, cid, units, (size_t)1024 * 1024 * EB, 1024 * EB, 1024 * EB};
            EpiMoe1 E{ws + WS_H1}; pg8::gemm_phase(F.lds, S, E, D * EB / 2, D * EB / 2, D * EB / 2); }  REPBAR } PH_END
        PH_BEGIN PM(17) { const bool dry = rep_ > 1; (void)dry;  { const int ntile = moe_table(F, l, tab);
            const int units = ntile * 4, rounds = (units + F.G - 1) / F.G; int geff = F.G; if (false && rounds > 0) { geff = (((units + rounds - 1) / rounds) + 7) & ~7; if (geff > F.G) geff = F.G; }
            constexpr int EB = MOE_FP8 ? 1 : 2;
            MoeOrder<false> S{tab, (const char*)(ws + WS_H1), (const char*)(ws + WS_W_E2 + (size_t)l * 32 * 1024 * 512 * EB), (const int*)(ws + WS_BK2), geff, cid, units, (size_t)1024 * 512 * EB, 512 * EB, 512 * EB};
            EpiMoe2 E{(bf16_t*)(ws + (dry ? WS_SCR + 64 * MiB : WS_Y1)), (const int*)(ws + WS_BK2), tab}; pg8::gemm_phase(F.lds, S, E, DEXP * EB / 2, DEXP * EB / 2, DEXP * EB / 2); }  REPBAR } PH_END
    }
    { const int l_ = 0; PH_BEGIN PM(18) { const bool dry = rep_ > 1; (void)dry;  final_phase(F);  REPBAR if constexpr (((REP_MASK) >> 19) & 1u) { for (int k_ = 0; k_ < 20; ++k_) GRIDBAR } } PH_END }
#undef PH_BEGIN
#undef PH_END
}

extern "C" void kernel_launch(void* const* d_in, const int* in_sizes, int n_in, void* d_out, int out_size, void* d_ws, size_t ws_size, hipStream_t stream) {
    static int grid = 0;
    if (grid == 0) {
        if (n_in != 34 || out_size != NB * SEQ * D || ws_size < WS_END) { fprintf(stderr, "kernel_launch: bad shapes n_in %d out %d ws %zu (need %zu)\n", n_in, out_size, ws_size, (size_t)WS_END); grid = -1; return; }
        int dev = 0, cus = 0, per_cu = 0;
        if (hipGetDevice(&dev) != hipSuccess || hipDeviceGetAttribute(&cus, hipDeviceAttributeMultiprocessorCount, dev) != hipSuccess) { grid = -1; return; }
        if (hipFuncSetAttribute((const void*)mk_fwd, hipFuncAttributeMaxDynamicSharedMemorySize, LDS_BYTES) != hipSuccess) { fprintf(stderr, "kernel_launch: hipFuncSetAttribute failed\n"); grid = -1; return; }
        if (hipOccupancyMaxActiveBlocksPerMultiprocessor(&per_cu, (const void*)mk_fwd, 512, LDS_BYTES) != hipSuccess || per_cu < 1) { fprintf(stderr, "kernel_launch: occupancy query says %d\n", per_cu); (void)hipGetLastError(); grid = -1; return; }
        grid = cus;
    }
    if (grid < 0) return;
    (void)hipMemsetAsync((char*)d_ws + WS_CTL, 0, CTL_BYTES, stream);
    Args a{};
    for (int i = 0; i < 34; ++i) a.in[i] = (const float*)d_in[i];
    a.out = (float*)d_out; a.ws = (uchar*)d_ws;
#if MK_PER_PHASE
    for (int p = 0; p < NPHASE; ++p) { a.ph_lo = p; a.ph_hi = p + 1; hipLaunchKernelGGL(mk_fwd, dim3(grid), dim3(512), LDS_BYTES, stream, a); }
#else
    a.ph_lo = 0; a.ph_hi = NPHASE;
    void* kargs[] = {&a};
    hipError_t e = hipLaunchCooperativeKernel((const void*)mk_fwd, dim3(grid), dim3(512), kargs, LDS_BYTES, stream);
    if (e != hipSuccess) fprintf(stderr, "kernel_launch: cooperative launch failed: %s (grid %d)\n", hipGetErrorString(e), grid);
#endif
}
```

```cpp
#include <hip/hip_runtime.h>
#include <hip/hip_bf16.h>
#include <cstdio>
#include <cstdint>

#ifndef X_BF16
#define X_BF16 1
#endif
#ifndef MOE_FP8
#define MOE_FP8 1
#endif
#ifndef MK_PER_PHASE
#define MK_PER_PHASE 0
#endif

#ifndef PHASE_MASK
#define PHASE_MASK 0xFFFFFFFFu
#endif
#ifndef REP_MASK
#define REP_MASK 0u
#endif
#define REPN(i) ((((REP_MASK) >> (i)) & 1u) ? 2 : 1)
#define PM(i) if constexpr ((PHASE_MASK >> (i)) & 1u) for (int rep_ = REPN(i); rep_ > 0; --rep_)
#define LAS __attribute__((address_space(3)))
#define GAS __attribute__((address_space(1)))
typedef unsigned char uchar;
typedef unsigned short bf16_t;
typedef short bf16x8 __attribute__((ext_vector_type(8)));
typedef short s16x4 __attribute__((ext_vector_type(4)));
typedef float f32x4 __attribute__((ext_vector_type(4)));
typedef float f32x2 __attribute__((ext_vector_type(2)));
typedef float f32x16 __attribute__((ext_vector_type(16)));
typedef unsigned u32x4 __attribute__((ext_vector_type(4)));
typedef unsigned u32x2 __attribute__((ext_vector_type(2)));
typedef GAS unsigned gu32;
#define RLX_AGENT __ATOMIC_RELAXED, __HIP_MEMORY_SCOPE_AGENT

constexpr int D = 1024, NB = 4, SEQ = 4096, CTX = 256, SB = SEQ + CTX, T = NB * SB, DEPTH = 4;
constexpr int NMODV = 6 * D;
constexpr int NEXP = 32, DEXP = 512;
constexpr int NCH = SB / 16;
constexpr float NORM_EPS = 1e-6f;

constexpr size_t MiB = 1u << 20;
constexpr size_t WS_CTL = 0, CTL_BYTES = 1 * MiB;
constexpr size_t WS_MOD = 1 * MiB;
constexpr size_t WS_ROPE = 2 * MiB;
constexpr size_t WS_SPL = 2 * MiB + 65536;
constexpr size_t WS_BK2 = 3 * MiB;
constexpr size_t WS_TOT = 3 * MiB;
constexpr size_t WS_STATP = 8 * MiB;
constexpr size_t WS_BK = 13 * MiB;
constexpr size_t WS_TW = 15 * MiB + 512 * 1024;
constexpr size_t WS_W_RGIN = 16 * MiB, WS_W_RGG = 24 * MiB, WS_W_RGOUT = 26 * MiB, WS_W_QKV = 30 * MiB, WS_W_AO = 33 * MiB;
constexpr size_t WS_W_CMIN = 35 * MiB, WS_W_CMS = 43 * MiB, WS_W_CMOUT = 44 * MiB, WS_W_E1 = 48 * MiB, WS_W_E2 = 304 * MiB;
constexpr size_t WS_X = 432 * MiB, WS_Y1 = 500 * MiB, WS_H = 568 * MiB, WS_SCR = 602 * MiB;
constexpr size_t WS_GG = WS_SCR, WS_XB = WS_SCR + 34 * MiB, WS_XC = WS_SCR + 68 * MiB, WS_LA = WS_SCR + 102 * MiB, WS_BB = WS_SCR + 170 * MiB, WS_SA = WS_SCR + 238 * MiB;
constexpr size_t WS_QKV = WS_SCR, WS_AO = WS_SCR + 51 * MiB;
constexpr size_t WS_UVB = WS_SCR, WS_UV = WS_SCR + 136 * MiB;
constexpr size_t WS_H1 = WS_SCR;
constexpr size_t WS_TOTS = WS_SCR + 272 * MiB, WS_TOTH = WS_TOTS + 9 * MiB, WS_CARRY = WS_TOTH + 9 * MiB;
constexpr size_t WS_YM = WS_CARRY + 9 * MiB;
constexpr size_t WS_END = WS_YM + 34 * MiB;
constexpr int CW_TMO = 0, CW_BAR = 4096, CW_CNT = 16384;

constexpr int RING_BYTES = 131072;
constexpr int ROUTER_LDS = 36 * 1024 * 4;
constexpr int LDSCTL_OFF = 147456;
constexpr int LDS_BYTES = LDSCTL_OFF + 1024 + 8 * 4 * 40 * 4;

typedef float f32x2_t_ __attribute__((ext_vector_type(2))); typedef __bf16 bf16x2_t_ __attribute__((ext_vector_type(2)));
__device__ __forceinline__ unsigned pk2(float lo, float hi) { const f32x2_t_ v = {lo, hi}; const bf16x2_t_ b = __builtin_convertvector(v, bf16x2_t_); return __builtin_bit_cast(unsigned, b); }
__device__ __forceinline__ unsigned f2bf(float f) { return pk2(f, 0.f) & 0xffffu; }
__device__ __forceinline__ float bf2f(unsigned short h) { return __builtin_bit_cast(float, (unsigned)h << 16); }
__device__ __forceinline__ float bflo(unsigned w) { return __builtin_bit_cast(float, w << 16); }
__device__ __forceinline__ float bfhi(unsigned w) { return __builtin_bit_cast(float, w & 0xffff0000u); }
__device__ __forceinline__ unsigned cvt_pk_bf16(float lo, float hi) { return pk2(lo, hi); }
__device__ __forceinline__ float gelu_tanh(float x) { const float u2 = (-2.f * 0.7978845608028654f) * (x + 0.044715f * x * x * x); return x * __builtin_amdgcn_rcpf(1.f + __expf(u2)); }
__device__ __forceinline__ float sigmoidf_(float x) { return 1.f / (1.f + __expf(-x)); }
__device__ __forceinline__ float fast_sigmoid(float x) { return __builtin_amdgcn_rcpf(1.f + __expf(-x)); }
__device__ __forceinline__ float one_minus_exp(float y) {   const float p = y * (1.f - y * (0.5f - y * (0.16666667f - y * 0.041666667f))); const float q = 1.f - __expf(-y); return y < 0.0625f ? p : q; }
__device__ __forceinline__ int sidx_of_row(int row) { const int b = row / SB; return (row - b * SB) < CTX ? 4 : b; }

namespace pg8 {
constexpr int BM = 256, BK = 64, HALF = 128, HTB = HALF * BK * 2, NXCD = 8, WGM = 8;
__device__ __forceinline__ int lds_byte(int r, int c) { const int st = (r >> 4) * 2 + (c >> 5), rr = r & 15, cc = c & 31, ob = rr * 64 + cc * 2; return st * 1024 + (ob ^ (((ob >> 9) & 1) << 5)); }
__device__ __forceinline__ void stage_rc(int b, int& R, int& C) { const int st = b / 1024, sb = b % 1024, swz = sb ^ (((sb >> 9) & 1) << 5); R = (st >> 1) * 16 + swz / 64; C = (st & 1) * 32 + (swz % 64) / 2; }
__device__ __forceinline__ int perm32(int rho) { const int n = rho >> 4, i = rho & 15; return 8 * (i >> 2) + 4 * n + (i & 3); }
struct Unit { const char* a; const char* b; int pm, pn, aux0, aux1, hm; };
__device__ __forceinline__ const char* uptr(const char* p) { const unsigned long long v = (unsigned long long)p; const unsigned lo = __builtin_amdgcn_readfirstlane((unsigned)v), hi = __builtin_amdgcn_readfirstlane((unsigned)(v >> 32)); return (const char*)(const GAS char*)(((unsigned long long)hi << 32) | lo); }
__device__ __forceinline__ bool unit_slot(int i, int c, int G, int nwg, int& L, int& hm) {
    if (c >= G) return false;
    const int nfull = nwg / G, rem = nwg - nfull * G;
    if (i < nfull) { L = i * G + c; hm = 0xF; return true; }
    if (i > nfull || rem == 0) return false;
    if (rem * 2 <= G) { if (c >= 2 * rem) return false; L = nfull * G + (c >> 1); hm = (c & 1) ? 0xC : 0x3; return true; }
    if (c >= rem) return false; L = nfull * G + c; hm = 0xF; return true; }
__device__ __forceinline__ int xcd_remap(int L, int nwg) { const int q = nwg / NXCD, r = nwg % NXCD, xcd = L % NXCD, off = L / NXCD; return (xcd < r ? xcd * (q + 1) : r * (q + 1) + (xcd - r) * q) + off; }

template <bool LATENT>
struct DenseOrderT {
    static constexpr bool GATHER = false;
    const char* A; const char* B; int nM, nN, nwg, G, c; size_t tA, tB; int amask, acol;
    __device__ void init(const void* A_, int lda, const void* B_, int ldb, int M, int N, int G_, int c_, int amask_ = 0, int acol_ = 0) {
        A = (const char*)A_; B = (const char*)B_; nM = LATENT ? 64 : M / BM; nN = N / BM; nwg = nM * nN; G = G_; c = c_; tA = (size_t)BM * lda * 2; tB = (size_t)BM * ldb * 2; amask = amask_; acol = acol_; }
    __device__ bool next(int i, Unit& u) const {
        int L, hm; if (!unit_slot(i, c, G, nwg, L, hm)) return false; u.hm = __builtin_amdgcn_readfirstlane(hm);
        const int wgid = xcd_remap(L, nwg);
        const int nig = WGM * nN, gid = wgid / nig, fm = gid * WGM, gsz = (nM - fm) < WGM ? (nM - fm) : WGM;
        int pm_ = fm + ((wgid % nig) % gsz); if constexpr (LATENT) pm_ = (pm_ >> 4) * 17 + 1 + (pm_ & 15);
        u.pm = __builtin_amdgcn_readfirstlane(pm_); u.pn = __builtin_amdgcn_readfirstlane((wgid % nig) / gsz); u.aux0 = 0; u.aux1 = 0;
        u.a = uptr(A + (size_t)u.pm * tA + (size_t)(u.pn & amask) * acol); u.b = uptr(B + (size_t)u.pn * tB); return true; }
    __device__ unsigned goff(const Unit&, int) const { return 0u; }
};
typedef DenseOrderT<false> DenseOrder;

#define PG8_SA(b, h) (((b) * 2 + (h)) * HTB)
#define PG8_SB(b, h) ((4 + (b) * 2 + (h)) * HTB)
__device__ __forceinline__ void glds16(const char* sbase, unsigned voff, unsigned ldsaddr) { unsigned keep;
    asm volatile("s_mov_b32 %0, m0\n\ts_mov_b32 m0, %3\n\ts_nop 0\n\tglobal_load_lds_dwordx4 %1, %2\n\ts_mov_b32 m0, %0" : "=&s"(keep) : "v"(voff), "s"(sbase), "s"(ldsaddr) : "memory"); }
#ifndef PG8_ASM_DMA
#define PG8_ASM_DMA 1
#endif
#if PG8_ASM_DMA
#define PG8_GLDS(gp, voff, ldsoff) glds16((const char*)(gp), (voff), ldsbase + (unsigned)(ldsoff))
#else
#define PG8_GLDS(gp, voff, ldsoff) __builtin_amdgcn_global_load_lds((const unsigned*)((const char*)(gp) + (voff)), (LAS unsigned*)(lds + (ldsoff)), 16, 0, 0)
#endif
#define PG8_STAGE_B(bufoff, gbase) do { PG8_GLDS(gbase, voffB[0], (bufoff) + ldsw); PG8_GLDS(gbase, voffB[1], (bufoff) + ldsw + 8192); } while (0)
#define PG8_STAGE_A(bufoff, gbase, h, NX) do { if constexpr (Sched::GATHER) { \
        PG8_GLDS(gbase, ((NX) ? vAn[h][0] : vAc[h][0]), (bufoff) + ldsw); PG8_GLDS(gbase, ((NX) ? vAn[h][1] : vAc[h][1]), (bufoff) + ldsw + 8192); \
    } else { PG8_GLDS((const char*)(gbase) + (h) * hstepA, voffA[0], (bufoff) + ldsw); PG8_GLDS((const char*)(gbase) + (h) * hstepA, voffA[1], (bufoff) + ldsw + 8192); } } while (0)
#define PG8_LDA(dst, b, h) do { _Pragma("unroll") for (int m = 0; m < 4; ++m) _Pragma("unroll") for (int k = 0; k < 2; ++k) dst[m][k] = *(const LAS bf16x8*)(lds + PG8_SA(b, h) + aoff + m * 2048 + k * 1024); } while (0)
#define PG8_LDB(dst, b, h) do { _Pragma("unroll") for (int n = 0; n < 2; ++n) _Pragma("unroll") for (int k = 0; k < 2; ++k) dst[n][k] = *(const LAS bf16x8*)(lds + PG8_SB(b, h) + boff + n * 2048 + k * 1024); } while (0)
typedef int i32x8 __attribute__((ext_vector_type(8))); typedef int i32x4v __attribute__((ext_vector_type(4)));
__device__ __forceinline__ i32x8 cat8(bf16x8 lo, bf16x8 hi) { return __builtin_shufflevector(__builtin_bit_cast(i32x4v, lo), __builtin_bit_cast(i32x4v, hi), 0, 1, 2, 3, 4, 5, 6, 7); }
#define PG8_MMA(ai, bj, At, Bt) do { __builtin_amdgcn_s_setprio(1); _Pragma("unroll") for (int m = 0; m < 4; ++m) _Pragma("unroll") for (int n = 0; n < 2; ++n) { \
        if constexpr (Epi::FP8) { asm volatile("v_mfma_scale_f32_16x16x128_f8f6f4 %0, %1, %2, %0, %3, %3 op_sel_hi:[0,0,0]" : "+v"(acc[ai][bj][m][n]) : "v"(cat8(Bt[n][0], Bt[n][1])), "v"(cat8(At[m][0], At[m][1])), "v"(0x7F7F7F7F)); } \
        else { _Pragma("unroll") for (int k = 0; k < 2; ++k) acc[ai][bj][m][n] = __builtin_amdgcn_mfma_f32_16x16x32_bf16(Bt[n][k], At[m][k], acc[ai][bj][m][n], 0, 0, 0); } } __builtin_amdgcn_s_setprio(0); } while (0)
#define PG8_WAIT_V(n) asm volatile("s_waitcnt vmcnt(" #n ")" ::: "memory")
#define PG8_WAIT_L(n) asm volatile("s_waitcnt lgkmcnt(" #n ")" ::: "memory")
#define PG8_BAR __builtin_amdgcn_s_barrier()
#define PG8_SCHED __builtin_amdgcn_sched_barrier(0)

template <class Epi, class Sched>
__device__ __forceinline__ void gemm_phase(LAS uchar* lds, const Sched& S, const Epi& E, const int K, const int lda, const int ldb) {
    int tid = threadIdx.x; asm volatile("" : "+v"(tid));
    const int wid = __builtin_amdgcn_readfirstlane(tid >> 6), lane = tid & 63, wr = wid >> 2, wc = wid & 3; int fr = lane & 15, fq = lane >> 4;
    int nt = K / BK; asm volatile("" : "+s"(nt));
    unsigned voffA[2], voffB[2];
#pragma unroll
    for (int i = 0; i < 2; ++i) { int R, C; stage_rc(tid * 16 + i * 8192, R, C); const int Rb = Epi::PERM ? ((R & ~31) + perm32(R & 31)) : R;
        voffA[i] = (unsigned)(R * lda + C) * 2u; voffB[i] = (unsigned)(Rb * ldb + C) * 2u; }
    const size_t kstep = (size_t)(BK * 2);
    const size_t hstepA = (size_t)HALF * lda * 2, hstepB = (size_t)HALF * ldb * 2;
    const unsigned ldsw = (unsigned)wid * 1024u;
    const unsigned ldsbase = (unsigned)(uintptr_t)lds;
    const int aoff = lds_byte(wr * 64 + fr, fq * 8), boff = lds_byte(wc * 32 + fr, fq * 8);
    Unit cur, nxt; int ui = 0;
    if (!S.next(0, cur)) return;
    unsigned vAc[2][2], vAn[2][2];
#pragma unroll
    for (int h = 0; h < 2; ++h)
#pragma unroll
        for (int i = 0; i < 2; ++i) { vAc[h][i] = 0u; vAn[h][i] = 0u; }
    if constexpr (Sched::GATHER) {
#pragma unroll
        for (int h = 0; h < 2; ++h)
#pragma unroll
            for (int i = 0; i < 2; ++i) { int R, C; stage_rc(tid * 16 + i * 8192, R, C); vAc[h][i] = S.goff(cur, h * HALF + R) + (unsigned)C * 2u; }
    }
    f32x4 acc[2][2][4][2];
#pragma unroll
    for (int a = 0; a < 2; ++a)
#pragma unroll
        for (int b = 0; b < 2; ++b)
#pragma unroll
            for (int m = 0; m < 4; ++m)
#pragma unroll
                for (int n = 0; n < 2; ++n) acc[a][b][m][n] = (f32x4){0.f, 0.f, 0.f, 0.f};
    bf16x8 At[4][2], B0[2][2], B1[2][2];
    typedef int pre_t __attribute__((ext_vector_type(16))); pre_t pre = {};
    if constexpr (Epi::PREFETCH) pre = E.prefetch(cur, wr, fr);
    const char* cA = cur.a; const char* cB = cur.b;
    PG8_STAGE_B(PG8_SB(0, 0), cB); PG8_STAGE_B(PG8_SB(0, 1), cB + hstepB); PG8_STAGE_A(PG8_SA(0, 0), cA, 0, false); PG8_STAGE_A(PG8_SA(0, 1), cA, 1, false);
    if (wr == 1) PG8_BAR;
    PG8_WAIT_V(2); PG8_BAR;
    PG8_STAGE_B(PG8_SB(1, 0), cB + kstep); PG8_STAGE_A(PG8_SA(1, 0), cA + kstep, 0, false); PG8_STAGE_B(PG8_SB(1, 1), cB + hstepB + kstep);
    PG8_WAIT_V(6); PG8_BAR;
    for (;;) {
        const bool has_next = S.next(ui + 1, nxt);
        if constexpr (Sched::GATHER) { if (has_next) {
#pragma unroll
            for (int h = 0; h < 2; ++h)
#pragma unroll
                for (int i = 0; i < 2; ++i) { int R, C; int t2 = tid; asm volatile("" : "+v"(t2)); stage_rc(t2 * 16 + i * 8192, R, C); vAn[h][i] = S.goff(nxt, h * HALF + R) + (unsigned)C * 2u; }
            *(LAS u32x4*)(lds + 131072 + tid * 16) = (u32x4){vAn[0][0], vAn[0][1], vAn[1][0], vAn[1][1]}; } }
        const char* nA = has_next ? nxt.a : cA; const char* nB = has_next ? nxt.b : cB;
        for (int t = 0; t < nt; t += 2) {
            const bool last = (t == nt - 2);
            const bool nx = last && has_next;
            if constexpr (Sched::GATHER) { if (nx) { const u32x4 pk_ = *(const LAS u32x4*)(lds + 131072 + tid * 16); vAn[0][0] = pk_.x; vAn[0][1] = pk_.y; vAn[1][0] = pk_.z; vAn[1][1] = pk_.w; } }
            const char* a1 = cA + (size_t)(t + 1) * kstep;
            const char* a2 = last ? nA : cA + (size_t)(t + 2) * kstep; const char* b2 = last ? nB : cB + (size_t)(t + 2) * kstep;
            const char* a3 = a2 + kstep; const char* b3 = b2 + kstep;
            PG8_LDB(B0, 0, 0); PG8_LDB(B1, 0, 1); PG8_SCHED; PG8_LDA(At, 0, 0); PG8_STAGE_A(PG8_SA(1, 1), a1, 1, false);
            PG8_WAIT_V(8); PG8_WAIT_L(0); PG8_BAR; if (cur.hm & 1) { PG8_MMA(0, 0, At, B0); PG8_MMA(0, 1, At, B1); } PG8_BAR; PG8_SCHED;
            PG8_LDA(At, 0, 1); PG8_STAGE_B(PG8_SB(0, 0), b2); PG8_STAGE_B(PG8_SB(0, 1), b2 + hstepB); PG8_STAGE_A(PG8_SA(0, 0), a2, 0, nx);
            PG8_WAIT_V(8); PG8_WAIT_L(0); PG8_BAR; if (cur.hm & 4) { PG8_MMA(1, 0, At, B0); PG8_MMA(1, 1, At, B1); } PG8_BAR; PG8_SCHED;
            PG8_LDB(B0, 1, 0); PG8_LDB(B1, 1, 1); PG8_SCHED; PG8_LDA(At, 1, 0); PG8_STAGE_A(PG8_SA(0, 1), a2, 1, nx);
            PG8_WAIT_V(8); PG8_WAIT_L(0); PG8_BAR; if (cur.hm & 1) { PG8_MMA(0, 0, At, B0); PG8_MMA(0, 1, At, B1); } PG8_BAR; PG8_SCHED;
            PG8_LDA(At, 1, 1); PG8_STAGE_B(PG8_SB(1, 0), b3); PG8_STAGE_B(PG8_SB(1, 1), b3 + hstepB); PG8_STAGE_A(PG8_SA(1, 0), a3, 0, nx);
            PG8_WAIT_V(8); PG8_WAIT_L(0); PG8_BAR; if (cur.hm & 4) { PG8_MMA(1, 0, At, B0); PG8_MMA(1, 1, At, B1); } PG8_BAR; PG8_SCHED;
        }
        if (wr == 0) PG8_BAR;
        if constexpr (Epi::FP8) asm volatile("s_nop 15\n\ts_nop 15" ::: "memory");
        if constexpr (Epi::PREFETCH) E(acc, cur, wr, wc, fr, fq, pre); else E(acc, cur, wr, wc, fr, fq);
        if (!has_next) break;
#pragma unroll
        for (int a = 0; a < 2; ++a)
#pragma unroll
            for (int b = 0; b < 2; ++b)
#pragma unroll
                for (int m = 0; m < 4; ++m)
#pragma unroll
                    for (int n = 0; n < 2; ++n) acc[a][b][m][n] = (f32x4){0.f, 0.f, 0.f, 0.f};
        cur = nxt; cA = nA; cB = nB; ++ui;
        if constexpr (Epi::PREFETCH) pre = E.prefetch(cur, wr, fr);
        if constexpr (Sched::GATHER) {
#pragma unroll
            for (int h = 0; h < 2; ++h)
#pragma unroll
                for (int i = 0; i < 2; ++i) vAc[h][i] = vAn[h][i]; }
        if (wr == 1) PG8_BAR;
    }
    PG8_WAIT_V(0);
    PG8_BAR;
}
}

#ifndef ATT_SDEPTH
#define ATT_SDEPTH 1
#endif
namespace att {
constexpr int NW = 8, QBLK = 32, KVBLK = 64;
constexpr float SCALE = 0.088388347648318440f;
constexpr float THR = 8.f;
constexpr int LDQ = 1536, LDK = 1536, LDO = 1024;
constexpr size_t SHM_V = KVBLK * 128 * 2, SHM_K = KVBLK * 128 * 2, SHM_ATTN = 2 * SHM_V + 2 * SHM_K + NW * 64 * 4;
#define KSWZ(row, colB) ((row) * 256 + ((colB) ^ (((row) & 7) << 4)))
#define SBAR() __builtin_amdgcn_sched_barrier(0)
__device__ __forceinline__ int crow(int r, int hi) { return (r & 3) + 8 * (r >> 2) + 4 * hi; }
__device__ __forceinline__ void partialSM(f32x16& p0, f32x16& p1, float& m_reg, float& mn, float& alpha) {
  constexpr float C = SCALE * 1.4426950408889634f;
  float pmax = p0[0];
#pragma unroll
  for (int r = 1; r < 16; ++r) pmax = fmaxf(pmax, p0[r]);
#pragma unroll
  for (int r = 0; r < 16; ++r) pmax = fmaxf(pmax, p1[r]);
  { auto rr = __builtin_amdgcn_permlane32_swap(__float_as_uint(pmax), __float_as_uint(pmax), false, false);
    pmax = fmaxf(__uint_as_float(rr[0]), __uint_as_float(rr[1])); }
  if (__builtin_expect(__all(pmax - m_reg <= THR / SCALE), 1)) { mn = m_reg; alpha = 1.f; }
  else { mn = fmaxf(m_reg, pmax); alpha = __builtin_amdgcn_exp2f((m_reg - mn) * C); m_reg = mn; }
  float mnC = -mn * C;
#pragma unroll
  for (int r = 0; r < 16; ++r) p0[r] = fmaf(p0[r], C, mnC);
#pragma unroll
  for (int r = 0; r < 16; ++r) p1[r] = fmaf(p1[r], C, mnC);
#pragma unroll
  for (int r = 0; r < 16; ++r) p0[r] = __builtin_amdgcn_exp2f(p0[r]);
}
__device__ __forceinline__ void finishSM(f32x16& p0, f32x16& p1, float alpha, float& l_reg, bf16x8& pa0, bf16x8& pa1, bf16x8& pa2, bf16x8& pa3) {
#pragma unroll
  for (int r = 0; r < 16; ++r) p1[r] = __builtin_amdgcn_exp2f(p1[r]);
  float ps = 0;
#pragma unroll
  for (int r = 0; r < 16; ++r) ps += p0[r];
#pragma unroll
  for (int r = 0; r < 16; ++r) ps += p1[r];
  { auto rr = __builtin_amdgcn_permlane32_swap(__float_as_uint(ps), __float_as_uint(ps), false, false);
    ps = __uint_as_float(rr[0]) + __uint_as_float(rr[1]); }
  l_reg = l_reg * alpha + ps;
#define PK4(P, BASE, OUT) do { unsigned a0 = cvt_pk_bf16(P[BASE + 0], P[BASE + 1]), a1 = cvt_pk_bf16(P[BASE + 2], P[BASE + 3]);   \
    unsigned b0 = cvt_pk_bf16(P[BASE + 4], P[BASE + 5]), b1 = cvt_pk_bf16(P[BASE + 6], P[BASE + 7]);                              \
    auto r0 = __builtin_amdgcn_permlane32_swap(a0, b0, false, false); auto r1 = __builtin_amdgcn_permlane32_swap(a1, b1, false, false); \
    u32x4 w = {r0[0], r1[0], r0[1], r1[1]}; OUT = __builtin_bit_cast(bf16x8, w); } while (0)
  PK4(p0, 0, pa0); PK4(p0, 8, pa1); PK4(p1, 0, pa2); PK4(p1, 8, pa3);
#undef PK4
}
__device__ __forceinline__ void qkt(f32x16& p0, f32x16& p1, const bf16_t* Ks, const bf16x8* qr, int r32, int hi) {
  p0 = f32x16{}; p1 = f32x16{};
#pragma unroll
  for (int d0 = 0; d0 < 8; ++d0) { int cb = (d0 * 16 + hi * 8) * 2;
    bf16x8 b0 = *reinterpret_cast<const bf16x8*>((const char*)Ks + KSWZ(r32, cb));
    bf16x8 b1 = *reinterpret_cast<const bf16x8*>((const char*)Ks + KSWZ(32 + r32, cb));
    p0 = __builtin_amdgcn_mfma_f32_32x32x16_bf16(b0, qr[d0], p0, 0, 0, 0);
    p1 = __builtin_amdgcn_mfma_f32_32x32x16_bf16(b1, qr[d0], p1, 0, 0, 0); }
}
__device__ __forceinline__ int v_st(int k, int c) { const int kk = (k & ~0xC) | ((k & 4) << 1) | ((k & 8) >> 1); return ((kk >> 3) * 4 + (c >> 5)) * 512 + ((kk & 7) * 32 + (c & 31)) * 2; }
__device__ __forceinline__ int v_rd_base(int lane) { return ((lane & 3) << 3) | (((lane >> 2) & 3) << 6) | (((lane >> 4) & 1) << 5) | (((lane >> 5) & 1) << 8); }
constexpr int v_rd_off(int d0, int ks, int half) { return d0 * 512 + ks * 4096 + half * 2048; }
template <int OFF> __device__ __forceinline__ s16x4 tr_read(int vb) {
  s16x4 r; asm volatile("ds_read_b64_tr_b16 %0, %1 offset:%2" : "=&v"(r) : "v"(vb), "i"(OFF) : "memory"); return r;
}
template <int D0> __device__ __forceinline__ void pv_one(f32x16& od, int vb, bf16x8 pa0, bf16x8 pa1, bf16x8 pa2, bf16x8 pa3) {
  const s16x4 l0 = tr_read<v_rd_off(D0, 0, 0)>(vb), h0 = tr_read<v_rd_off(D0, 0, 1)>(vb), l1 = tr_read<v_rd_off(D0, 1, 0)>(vb), h1 = tr_read<v_rd_off(D0, 1, 1)>(vb);
  const s16x4 l2 = tr_read<v_rd_off(D0, 2, 0)>(vb), h2 = tr_read<v_rd_off(D0, 2, 1)>(vb), l3 = tr_read<v_rd_off(D0, 3, 0)>(vb), h3 = tr_read<v_rd_off(D0, 3, 1)>(vb);
  asm volatile("s_waitcnt lgkmcnt(0)" ::: "memory"); SBAR();
#define PK(L, H) (bf16x8){L[0], L[1], L[2], L[3], H[0], H[1], H[2], H[3]}
  od = __builtin_amdgcn_mfma_f32_32x32x16_bf16(pa0, PK(l0, h0), od, 0, 0, 0);
  od = __builtin_amdgcn_mfma_f32_32x32x16_bf16(pa1, PK(l1, h1), od, 0, 0, 0);
  od = __builtin_amdgcn_mfma_f32_32x32x16_bf16(pa2, PK(l2, h2), od, 0, 0, 0);
  od = __builtin_amdgcn_mfma_f32_32x32x16_bf16(pa3, PK(l3, h3), od, 0, 0, 0);
#undef PK
}
__device__ __forceinline__ void pv_d0(f32x16* o, int vb, bf16x8 pa0, bf16x8 pa1, bf16x8 pa2, bf16x8 pa3) {
  pv_one<0>(o[0], vb, pa0, pa1, pa2, pa3); pv_one<1>(o[1], vb, pa0, pa1, pa2, pa3); pv_one<2>(o[2], vb, pa0, pa1, pa2, pa3); pv_one<3>(o[3], vb, pa0, pa1, pa2, pa3);
}
__device__ __forceinline__ void attn_dense_body(const bf16_t* Qb, const bf16_t* Kh, const bf16_t* Vh, bf16_t* Ob, int seq, char* lds, const int tid) {
  const int wid = tid >> 6, lane = tid & 63, r32 = lane & 31, hi = lane >> 5;
  bf16_t* V_lds = (bf16_t*)lds; bf16_t* K_lds = (bf16_t*)(lds + 2 * SHM_V);
  float* ws = (float*)(lds + 2 * SHM_V + 2 * SHM_K) + wid * 64; float* li_l = ws; float* al_l = ws + 32;
  float m_reg = -1e30f, l_reg = 0; f32x16 o[4] = {}; bf16x8 qr[8];
  const bf16_t* Qw = Qb + (long)(wid * QBLK + r32) * LDQ + hi * 8;
#pragma unroll
  for (int d0 = 0; d0 < 8; ++d0) qr[d0] = *reinterpret_cast<const bf16x8*>(Qw + d0 * 16);
  const int sr = tid >> 4, sc = (tid & 15) * 8, vst0 = v_st(sr, sc), vst1 = v_st(32 + sr, sc);
  const int vb0 = (int)(uintptr_t)V_lds + v_rd_base(lane);
  struct { bf16x8 vs0, vs1, ks0, ks1; } sr_[ATT_SDEPTH];
  const unsigned vo0 = (unsigned)(sr * LDK + sc) * 2u, vo1 = (unsigned)((32 + sr) * LDK + sc) * 2u;
  const long vdelta = (const char*)Vh - (const char*)Kh;
#define SLOAD(i, k0) do { const char* kb_ = (const char*)Kh + (size_t)(k0) * (LDK * 2); const char* vb_ = kb_ + vdelta; \
    sr_[i].vs0 = *reinterpret_cast<const bf16x8*>(vb_ + vo0); sr_[i].vs1 = *reinterpret_cast<const bf16x8*>(vb_ + vo1); \
    sr_[i].ks0 = *reinterpret_cast<const bf16x8*>(kb_ + vo0); sr_[i].ks1 = *reinterpret_cast<const bf16x8*>(kb_ + vo1); } while (0)
#define SWRITE(b, i) do { *(bf16x8*)((char*)V_lds + (b) * SHM_V + vst0) = sr_[i].vs0;          \
    *(bf16x8*)((char*)V_lds + (b) * SHM_V + vst1) = sr_[i].vs1; int kc = sc * 2;               \
    *(bf16x8*)((char*)K_lds + (b) * SHM_K + KSWZ(sr, kc)) = sr_[i].ks0;                       \
    *(bf16x8*)((char*)K_lds + (b) * SHM_K + KSWZ(32 + sr, kc)) = sr_[i].ks1; } while (0)
#define SWAIT() do { if constexpr (ATT_SDEPTH == 2) asm volatile("s_waitcnt vmcnt(4)" ::: "memory"); else asm volatile("s_waitcnt vmcnt(0)" ::: "memory"); } while (0)
#define RESC(a) do { if (__any((a) < 1.f)) { if (hi == 0) al_l[r32] = (a); asm volatile("s_waitcnt lgkmcnt(0)" ::: "memory"); \
    _Pragma("unroll") for (int d = 0; d < 4; ++d) _Pragma("unroll") for (int r = 0; r < 16; ++r) o[d][r] *= al_l[crow(r, hi)]; } } while (0)
  f32x16 pA0, pA1, pB0, pB1; float mnA, mnB, alA, alB; bf16x8 pa0, pa1, pa2, pa3; const int NT = seq / KVBLK;
  constexpr int SE = 0, SO = ATT_SDEPTH - 1;
  SLOAD(SE, 0); asm volatile("s_waitcnt vmcnt(0)" ::: "memory"); SWRITE(0, SE); __syncthreads();
  qkt(pA0, pA1, K_lds, qr, r32, hi); partialSM(pA0, pA1, m_reg, mnA, alA);
  SLOAD(SO, KVBLK); if constexpr (ATT_SDEPTH == 2) { if (2 < NT) SLOAD(SE, 2 * KVBLK); }
  SWAIT(); SWRITE(1, SO); __syncthreads();
  for (int j = 1; j + 1 < NT; j += 2) {
    SBAR(); qkt(pB0, pB1, (bf16_t*)((char*)K_lds + SHM_K), qr, r32, hi);
    finishSM(pA0, pA1, alA, l_reg, pa0, pa1, pa2, pa3); SBAR();
    SLOAD(SO, (j + ATT_SDEPTH) * KVBLK); SBAR();
    pv_d0(o, vb0, pa0, pa1, pa2, pa3); partialSM(pB0, pB1, m_reg, mnB, alB);
    __syncthreads(); SWAIT(); SWRITE(0, SE);
    RESC(alB); __syncthreads();
    SBAR(); qkt(pA0, pA1, K_lds, qr, r32, hi);
    finishSM(pB0, pB1, alB, l_reg, pa0, pa1, pa2, pa3); SBAR();
    if (ATT_SDEPTH == 1 || j + 3 < NT) SLOAD(SE, (j + 1 + ATT_SDEPTH) * KVBLK); SBAR();
    pv_d0(o, vb0 + (int)SHM_V, pa0, pa1, pa2, pa3); partialSM(pA0, pA1, m_reg, mnA, alA);
    __syncthreads(); SWAIT(); SWRITE(1, SO);
    RESC(alA); __syncthreads();
  }
  SBAR(); qkt(pB0, pB1, (bf16_t*)((char*)K_lds + SHM_K), qr, r32, hi);
  finishSM(pA0, pA1, alA, l_reg, pa0, pa1, pa2, pa3); SBAR();
  pv_d0(o, vb0, pa0, pa1, pa2, pa3); partialSM(pB0, pB1, m_reg, mnB, alB);
  __syncthreads(); RESC(alB);
  finishSM(pB0, pB1, alB, l_reg, pa0, pa1, pa2, pa3); SBAR();
  pv_d0(o, vb0 + (int)SHM_V, pa0, pa1, pa2, pa3);
  if (hi == 0) li_l[r32] = l_reg; asm volatile("s_waitcnt lgkmcnt(0)" ::: "memory");
  float rli[16];
#pragma unroll
  for (int r = 0; r < 16; ++r) rli[r] = __builtin_amdgcn_rcpf(li_l[crow(r, hi)]);
  bf16_t* Ow = Ob + (long)(wid * QBLK) * LDO;
#pragma unroll
  for (int r = 0; r < 16; ++r) { int orow = crow(r, hi);
#pragma unroll
    for (int d0 = 0; d0 < 4; ++d0) Ow[(long)orow * LDO + d0 * 32 + r32] = (bf16_t)f2bf(o[d0][r] * rli[r]); }
#undef SLOAD
#undef SWRITE
#undef SWAIT
#undef RESC
}
}

#define XB_TMO      128
#define XB_XCNT(j)  (256  + 64 * (j))
#define XB_XSUB(j)  (1280 + 64 * (j))
#define XB_XGEN(j)  (2304 + 64 * (j))
#define XB_TOP      3328
#define XB_TOPGEN   3392
#define XB_SPIN_CAP (1u << 22)
__device__ __forceinline__ unsigned xb_ld(unsigned* p)              { return __hip_atomic_load(p, __ATOMIC_RELAXED, __HIP_MEMORY_SCOPE_AGENT); }
__device__ __forceinline__ unsigned xb_add(unsigned* p, unsigned v) { return __hip_atomic_fetch_add(p, v, __ATOMIC_RELAXED, __HIP_MEMORY_SCOPE_AGENT); }
__device__ __forceinline__ unsigned xb_xcc_id() { return (unsigned)__builtin_amdgcn_s_getreg((3 << 11) | 20) & 0xFu; }
#define XB_SPIN(cond, bar) do { unsigned _sp = 0; while (cond) { __builtin_amdgcn_s_sleep(1); \
    if ((++_sp & 255u) == 0u) { if (xb_ld(&(bar)[XB_TMO])) break; if (_sp > XB_SPIN_CAP) { atomicAdd(&(bar)[XB_TMO], 1u); break; } } } } while (0)
struct XcdBarrier { unsigned* bar; unsigned x; volatile LAS unsigned* st; };
__device__ __forceinline__ XcdBarrier xcd_barrier_post(unsigned* bar, volatile LAS unsigned* st) {
    XcdBarrier b; b.bar = bar; b.x = xb_xcc_id(); b.st = st;
    if (threadIdx.x == 0) (void)xb_add(&bar[XB_XCNT(b.x)], 1u);
    return b;
}
__device__ __forceinline__ void xcd_barrier_complete(unsigned* bar, unsigned x, unsigned& nloc, unsigned& nx) {
    const unsigned G = gridDim.x * gridDim.y * gridDim.z;
    unsigned sum, cnt, mine, sp = 0u;
    for (;;) {
        sum = 0u; cnt = 0u; mine = 0u;
#pragma unroll
        for (unsigned j = 0; j < 16; ++j) { const unsigned c = xb_ld(&bar[XB_XCNT(j)]); sum += c; cnt += (c > 0u) ? 1u : 0u; mine = (j == x) ? c : mine; }
        if (sum == G) break;
        __builtin_amdgcn_s_sleep(1);
        if ((++sp & 255u) == 0u) { if (xb_ld(&bar[XB_TMO])) break; if (sp > XB_SPIN_CAP) { atomicAdd(&bar[XB_TMO], 1u); break; } }
    }
    nloc = mine > 0u ? mine : 1u; nx = cnt > 0u ? cnt : 1u;
}
__device__ __forceinline__ void xcd_barrier(const XcdBarrier& b_) {
    XcdBarrier b; b.bar = b_.bar; b.st = b_.st; b.x = xb_xcc_id();
    asm volatile("s_waitcnt vmcnt(0)" ::: "memory");
    __syncthreads();
    if (threadIdx.x == 0) {
        unsigned* bar = b.bar;
        __builtin_amdgcn_s_waitcnt(0);
        unsigned nloc = b.st[0], nx = b.st[1];
        if (nloc == 0u) { xcd_barrier_complete(bar, b.x, nloc, nx); b.st[0] = nloc; b.st[1] = nx; }
        const unsigned old = xb_add(&bar[XB_XSUB(b.x)], 1u);
        const unsigned gen = old / nloc;
        if (old + 1u == (gen + 1u) * nloc) {
            __builtin_amdgcn_fence(__ATOMIC_RELEASE, "agent");
            asm volatile("s_waitcnt vmcnt(0)" ::: "memory");
            const unsigned og = xb_add(&bar[XB_TOP], 1u);
            const unsigned tg = og / nx;
            if (og + 1u == (tg + 1u) * nx) xb_add(&bar[XB_TOPGEN], 1u);
            else XB_SPIN(xb_ld(&bar[XB_TOPGEN]) == tg, bar);
            __builtin_amdgcn_fence(__ATOMIC_ACQUIRE, "agent");
            xb_add(&bar[XB_XGEN(b.x)], 1u);
            asm volatile("s_waitcnt vmcnt(0)" ::: "memory");
        } else {
            XB_SPIN(xb_ld(&bar[XB_XGEN(b.x)]) == gen, bar);
            __builtin_amdgcn_fence(__ATOMIC_ACQUIRE, "agent");
            asm volatile("s_waitcnt vmcnt(0)" ::: "memory");
        }
    }
    __syncthreads();
}

struct Args { const float* in[34]; float* out; uchar* ws; int ph_lo, ph_hi; };
enum { I_X = 0, I_C, I_CTX, I_CCTX, I_ADAW, I_ADAB, I_NMG, I_NFG, I_RGWIN, I_RGCW, I_RGCB, I_RGWA, I_RGBA, I_RGWI, I_RGBI, I_RGLAM, I_RGWOUT,
       I_ATQKV, I_ATQG, I_ATKG, I_ATWO, I_CMWIN, I_CMLNG, I_CMLNB, I_CMWS, I_CMBS, I_CMWOUT, I_MWG, I_MBG, I_MWR, I_MBR, I_MWGATE, I_MWUP, I_MWDOWN };

__device__ __forceinline__ const void* opaque_uniform_ptr(const void* p) { const unsigned long long v = (unsigned long long)p; unsigned lo = (unsigned)v, hi = (unsigned)(v >> 32); asm volatile("" : "+v"(lo), "+v"(hi));
    lo = __builtin_amdgcn_readfirstlane(lo); hi = __builtin_amdgcn_readfirstlane(hi); return (const void*)(const GAS char*)(((unsigned long long)hi << 32) | lo); }
__device__ __forceinline__ int opaque_uniform_int(int x) { asm volatile("" : "+v"(x)); return __builtin_amdgcn_readfirstlane(x); }
struct Frame {
    LAS uchar* lds; char* ldsg;
    int tid, lane, wave, G, bid;
    uchar* ws; float* out;
};
__device__ __forceinline__ const float* inp(const Frame& F, int i) { const unsigned long long v = *(const LAS unsigned long long*)(F.lds + LDSCTL_OFF + 576 + i * 8);
    const unsigned lo = __builtin_amdgcn_readfirstlane((unsigned)v), hi = __builtin_amdgcn_readfirstlane((unsigned)(v >> 32)); return (const float*)(const GAS float*)(((unsigned long long)hi << 32) | lo); }
__device__ __forceinline__ float wave16_sum(float v) {
    v += __int_as_float(__builtin_amdgcn_update_dpp(0, __float_as_int(v), 0xB1, 0xF, 0xF, true));
    v += __int_as_float(__builtin_amdgcn_update_dpp(0, __float_as_int(v), 0x4E, 0xF, 0xF, true));
    v += __int_as_float(__builtin_amdgcn_update_dpp(0, __float_as_int(v), 0x141, 0xF, 0xF, true));
    v += __int_as_float(__builtin_amdgcn_update_dpp(0, __float_as_int(v), 0x140, 0xF, 0xF, true));
    return v; }

struct ConvItem { const float* src; uchar* dst; int ldw; bool f8; };
__device__ __forceinline__ void tr_load(const ConvItem& ci, f32x4 (&v)[16]) {
    if (ci.f8) {
#pragma unroll
        for (int i = 0; i < 8; ++i) { v[2 * i] = __builtin_nontemporal_load((const f32x4*)(ci.src + (size_t)(8 * i) * ci.ldw)); v[2 * i + 1] = __builtin_nontemporal_load((const f32x4*)(ci.src + (size_t)(8 * i + 1) * ci.ldw)); }
    } else {
#pragma unroll
        for (int i = 0; i < 16; ++i) v[i] = __builtin_nontemporal_load((const f32x4*)(ci.src + (size_t)(4 * i) * ci.ldw));
    }
}
__device__ __forceinline__ void tr_finish(const f32x4 (&v)[16], const ConvItem& ci, LAS uchar* scr, int lane) {
    const int kr = lane >> 4, nc = (lane & 15) * 4;
    const int g = lane >> 4, q = (lane >> 2) & 3, p = lane & 3;
    const int vb = (int)(uintptr_t)scr + q * 128 + g * 32 + p * 8;
    if (ci.f8) {
#pragma unroll
        for (int i = 0; i < 8; ++i) { const f32x4 a = v[2 * i] * 32.f, b = v[2 * i + 1] * 32.f;
            int r0 = __builtin_amdgcn_cvt_pk_fp8_f32(a.x, b.x, 0, false); r0 = __builtin_amdgcn_cvt_pk_fp8_f32(a.y, b.y, r0, true);
            int r1 = __builtin_amdgcn_cvt_pk_fp8_f32(a.z, b.z, 0, false); r1 = __builtin_amdgcn_cvt_pk_fp8_f32(a.w, b.w, r1, true);
            *(LAS u32x2*)(scr + (4 * i + kr) * 128 + nc * 2) = (u32x2){(unsigned)r0, (unsigned)r1}; }
        asm volatile("s_waitcnt lgkmcnt(0)" ::: "memory");
        s16x4 t[8];
#define TRR(r) t[r] = att::tr_read<(r) * 512>(vb)
        TRR(0); TRR(1); TRR(2); TRR(3); TRR(4); TRR(5); TRR(6); TRR(7);
#undef TRR
        asm volatile("s_waitcnt lgkmcnt(0)" ::: "memory"); __builtin_amdgcn_sched_barrier(0);
#pragma unroll
        for (int j = 0; j < 4; ++j) { const bf16x8 o = {t[2 * j][0], t[2 * j][1], t[2 * j][2], t[2 * j][3], t[2 * j + 1][0], t[2 * j + 1][1], t[2 * j + 1][2], t[2 * j + 1][3]}; *(bf16x8*)(ci.dst + 16 * j) = o; }
    } else {
#pragma unroll
        for (int i = 0; i < 16; ++i) { u32x2 o; o.x = pk2(v[i].x, v[i].y); o.y = pk2(v[i].z, v[i].w); *(LAS u32x2*)(scr + (4 * i + kr) * 128 + nc * 2) = o; }
        asm volatile("s_waitcnt lgkmcnt(0)" ::: "memory");
        s16x4 t[16];
#define TRR(r) t[r] = att::tr_read<(r) * 512>(vb)
        TRR(0); TRR(1); TRR(2); TRR(3); TRR(4); TRR(5); TRR(6); TRR(7); TRR(8); TRR(9); TRR(10); TRR(11); TRR(12); TRR(13); TRR(14); TRR(15);
#undef TRR
        asm volatile("s_waitcnt lgkmcnt(0)" ::: "memory"); __builtin_amdgcn_sched_barrier(0);
#pragma unroll
        for (int j = 0; j < 8; ++j) { const bf16x8 o = {t[2 * j][0], t[2 * j][1], t[2 * j][2], t[2 * j][3], t[2 * j + 1][0], t[2 * j + 1][1], t[2 * j + 1][2], t[2 * j + 1][3]}; *(bf16x8*)(ci.dst + 16 * j) = o; }
    }
}
struct Job { int g, lo, hi; };
__device__ __forceinline__ ConvItem conv_decode(Frame& F, int g, int it) {
    uchar* ws = F.ws; const float* W; int K = 1024, N = 1024, ldt = 1024, mode = 0; size_t dms = 0; bf16_t* WT;
    switch (g) {
        case 0:  W = inp(F, I_MWGATE); N = 512; WT = (bf16_t*)(ws + WS_W_E1); dms = (size_t)1024 * 1024; mode = 1; break;
        case 1:  W = inp(F, I_MWUP);   N = 512; WT = (bf16_t*)(ws + WS_W_E1); dms = (size_t)1024 * 1024; mode = 2; break;
        case 2:  W = inp(F, I_MWDOWN); K = 512; WT = (bf16_t*)(ws + WS_W_E2); ldt = 512; dms = (size_t)1024 * 512; break;
        case 3:  W = inp(F, I_RGWIN);  N = 2048; WT = (bf16_t*)(ws + WS_W_RGIN); dms = (size_t)2048 * 1024; break;
        case 4:  W = inp(F, I_CMWIN);  N = 4096; WT = (bf16_t*)(ws + WS_W_CMIN); break;
        case 5:  W = inp(F, I_RGWOUT); WT = (bf16_t*)(ws + WS_W_RGOUT); dms = (size_t)1024 * 1024; break;
        case 6:  W = inp(F, I_CMWOUT); K = 2048; WT = (bf16_t*)(ws + WS_W_CMOUT); ldt = 2048; break;
        case 7:  W = inp(F, I_ATQKV);  N = 1536; WT = (bf16_t*)(ws + WS_W_QKV); break;
        case 8:  W = inp(F, I_ATWO);   WT = (bf16_t*)(ws + WS_W_AO); break;
        case 9:  W = inp(F, I_RGWA);   K = 128; N = 128; WT = (bf16_t*)(ws + WS_W_RGG); ldt = 128; dms = (size_t)256 * 128; break;
        default: W = inp(F, I_RGWI);   K = 128; N = 128; WT = (bf16_t*)(ws + WS_W_RGG); ldt = 128; dms = (size_t)256 * 128; mode = 3; break;
    }
    const int nblk = N / 64, per = (K / 64) * nblk, mat = it / per, r = it - mat * per, kb = r / nblk, nb = r - kb * nblk, n0 = nb * 64;
    int drow = n0;
    if (mode == 1) drow = (n0 >> 7) * 256 + (n0 & 127); else if (mode == 2) drow = (n0 >> 7) * 256 + 128 + (n0 & 127); else if (mode == 3) drow = 128 + n0;
    const int lane = F.lane;
    const bool f8 = (MOE_FP8 != 0) && g < 3; const int eb = f8 ? 1 : 2;
    ConvItem ci; ci.ldw = N; ci.f8 = f8; ci.src = W + (size_t)mat * K * N + (size_t)(kb * 64 + (f8 ? 2 : 1) * (lane >> 4)) * N + n0 + (lane & 15) * 4;
    int nl = (lane >> 4) * 16 + (lane & 15);
    if (g == 7 && n0 < 1280) { const int half = nl >> 5, f = nl & 31; nl = 32 * (f >> 4) + 8 * ((f >> 2) & 3) + 4 * half + (f & 3); }
    ci.dst = (uchar*)WT + ((size_t)mat * dms + (size_t)(drow + nl) * ldt + kb * 64) * eb;
    return ci;
}
template <int NJ>
__device__ __forceinline__ ConvItem conv_find(Frame& F, int v, const Job (&jobs)[NJ]) { int r = v, g = jobs[0].g, it = 0; bool found = false;
#pragma unroll
    for (int q = 0; q < NJ; ++q) { const int n = jobs[q].hi - jobs[q].lo; if (!found) { if (r < n) { g = jobs[q].g; it = jobs[q].lo + r; found = true; } else r -= n; } }
    return conv_decode(F, g, it); }
template <int NJ>
__device__ __forceinline__ void conv_tail(Frame& F, int nblk0, const Job (&jobs)[NJ]) {
    if (nblk0 >= F.G) nblk0 = 0;
    if (F.bid < nblk0) return;
    LAS uchar* scr = F.lds + F.wave * 8192;
    int total = 0;
#pragma unroll
    for (int q = 0; q < NJ; ++q) total += jobs[q].hi - jobs[q].lo;
    const int nw = (F.G - nblk0) * 8;
    int v0 = (F.bid - nblk0) * 8 + F.wave;
    f32x4 va[16], vb[16]; ConvItem c0, c1; c0.dst = nullptr; c1.dst = nullptr; c0.f8 = false; c1.f8 = false; c0.src = nullptr; c1.src = nullptr; c0.ldw = 0; c1.ldw = 0;
    if (v0 < total) { c0 = conv_find(F, v0, jobs); tr_load(c0, va); }
    for (; v0 < total; v0 += 2 * nw) {
        const int v1 = v0 + nw, v2 = v1 + nw;
        if (v1 < total) { c1 = conv_find(F, v1, jobs); tr_load(c1, vb); }
        tr_finish(va, c0, scr, F.lane);
        if (v2 < total) { c0 = conv_find(F, v2, jobs); tr_load(c0, va); }
        if (v1 < total) tr_finish(vb, c1, scr, F.lane);
    }
}
__device__ __forceinline__ void p0_prologue(Frame& F) {
    uchar* ws = F.ws;
    {
        LAS float* act = (LAS float*)(F.lds);
        LAS float* red = (LAS float*)(F.lds + 5 * 1024 * 4);
        bool have = false; const float* pC = inp(F, I_C); const float* pCC = inp(F, I_CCTX); const float* pADAW = inp(F, I_ADAW); const float* pADAB = inp(F, I_ADAB);
        for (int it = F.bid; it < DEPTH * 24; it += F.G) {
            if (!have) { for (int i = F.tid; i < 5 * 1024; i += 512) { const int s = i >> 10, k = i & 1023; const float v = s < 4 ? pC[s * 1024 + k] : pCC[k]; act[i] = v / (1.f + __expf(-v)); } have = true; __syncthreads(); }
            const int l = it / 24, cb = it % 24;
            const float* W = pADAW + (size_t)l * 1024 * NMODV + cb * 256 + F.lane * 4;
            f32x4 a[5];
#pragma unroll
            for (int s = 0; s < 5; ++s) a[s] = (f32x4){0.f, 0.f, 0.f, 0.f};
            const int kbase = F.wave * 128;
#pragma unroll 8
            for (int k = 0; k < 128; ++k) { const f32x4 w = *(const f32x4*)(W + (size_t)(kbase + k) * NMODV);
#pragma unroll
                for (int s = 0; s < 5; ++s) a[s] += w * act[s * 1024 + kbase + k]; }
#pragma unroll
            for (int s = 0; s < 5; ++s) *(LAS f32x4*)(red + (F.wave * 5 + s) * 256 + F.lane * 4) = a[s];
            __syncthreads();
            for (int i = F.tid; i < 5 * 256; i += 512) { const int s = i >> 8, c = i & 255; float v = pADAB[l * NMODV + cb * 256 + c];
#pragma unroll
                for (int w = 0; w < 8; ++w) v += red[(w * 5 + s) * 256 + c];
                ((float*)(ws + WS_MOD))[(l * 5 + s) * NMODV + cb * 256 + c] = v; }
            __syncthreads();
        }
        __syncthreads();
    }
    { const Job jobsA[8] = {{3, 0, 1024}, {4, 0, 1024}, {5, 0, 512}, {6, 0, 512}, {7, 0, 384}, {8, 0, 256}, {9, 0, 128}, {10, 0, 128}}; conv_tail(F, DEPTH * 24, jobsA);
      const Job jobsB[3] = {{0, 0, 16384}, {1, 0, 16384}, {2, 0, 16384}}; conv_tail(F, 0, jobsB); }
    {
        const int gt = F.bid * 512 + F.tid, NGT = F.G * 512;
        for (int i = gt; i < 8 * 128 * 128 / 4; i += NGT) { const f32x4 v = ((const f32x4*)inp(F, I_CMWS))[i]; u32x2 o; o.x = pk2(v.x, v.y); o.y = pk2(v.z, v.w); ((u32x2*)(ws + WS_W_CMS))[i] = o; }
        for (int i = gt; i < 2 * 2 * D; i += NGT) { const float* plam = inp(F, I_RGLAM); ((float*)(ws + WS_SPL))[i] = -8.f * log1pf(expf(-plam[i])); }
        for (int i = gt; i < 64 * 32; i += NGT) { const int pos = i >> 5, f = i & 31; const float inv = powf(10000.f, -(float)f * 2.0f / 64.0f); const float ang = (float)pos * inv;
            ((f32x2*)(ws + WS_ROPE))[i] = (f32x2){cosf(ang), sinf(ang)}; }
    }
}

__device__ __forceinline__ void router_fill(Frame& F, int l) {
    LAS float* wr = (LAS float*)F.lds;
    const float* wg = inp(F, I_MWG) + (size_t)l * 1024 * 4; const float* wrt = inp(F, I_MWR) + (size_t)l * 1024 * 32;
    __syncthreads();
    for (int i0 = F.tid; i0 < 1024 * 9; i0 += 512 * 6) { f32x4 v[6];
#pragma unroll
        for (int u = 0; u < 6; ++u) { const int idx = i0 + u * 512; const int k = idx / 9, q = idx - k * 9; v[u] = q == 0 ? *(const f32x4*)(wg + k * 4) : *(const f32x4*)(wrt + k * 32 + (q - 1) * 4); }
#pragma unroll
        for (int u = 0; u < 6; ++u) { const int idx = i0 + u * 512; const int k = idx / 9, q = idx - k * 9;
            wr[(4 * q + 0) * 1024 + k] = v[u].x; wr[(4 * q + 1) * 1024 + k] = v[u].y; wr[(4 * q + 2) * 1024 + k] = v[u].z; wr[(4 * q + 3) * 1024 + k] = v[u].w; } }
    __syncthreads();
}
template <bool ROUTE, int NADD, bool SRCIN>
__device__ __forceinline__ void norm_phase(Frame& F, int l, const float* gvec, int shift_i, bool skip_ctx_route, bool dry) {
    uchar* ws = F.ws;
    float* X = (float*)(ws + WS_X); const bf16_t* YS = (const bf16_t*)(ws + WS_Y1); const bf16_t* YM = (const bf16_t*)(ws + WS_YM); bf16_t* H = (bf16_t*)(ws + WS_H);
    const float* MOD = (const float*)(ws + WS_MOD) + (size_t)l * 5 * NMODV;
    LAS float* wr = (LAS float*)F.lds;
    const int i16 = F.lane & 15, grp = F.lane >> 4;
    const float* bg = nullptr; const float* br = nullptr; if constexpr (ROUTE) { bg = inp(F, I_MBG) + l * 4; br = inp(F, I_MBR) + l * 32; }
    const float* pctx = nullptr; const float* px = nullptr; if constexpr (SRCIN) { pctx = inp(F, I_CTX); px = inp(F, I_X); }
    for (int tok = (F.bid * 8 + F.wave) * 4 + grp; tok < T; tok += F.G * 32) {
        asm volatile("" ::: "memory");
        const int sidx = sidx_of_row(tok);
        f32x4 x[16];
        float ss = 0.f;
        const float* xrow = X + (size_t)tok * D;
        if constexpr (SRCIN) { const int b_ = tok / SB, s_ = tok - b_ * SB; xrow = s_ < CTX ? pctx + ((size_t)(b_ * CTX + s_) << 10) : px + ((size_t)(b_ * SEQ + s_ - CTX) << 10); }
#pragma unroll
        for (int j = 0; j < 16; ++j) { if constexpr (X_BF16 && !SRCIN) { const u32x2 xb = *(const u32x2*)((const bf16_t*)X + (size_t)tok * D + 64 * j + 4 * i16); x[j] = (f32x4){bflo(xb.x), bfhi(xb.x), bflo(xb.y), bfhi(xb.y)}; }
            else x[j] = *(const f32x4*)(xrow + 64 * j + 4 * i16); }
        if constexpr (NADD >= 1) {
#pragma unroll
            for (int j = 0; j < 16; ++j) { const u32x2 ym = *(const u32x2*)(YM + (size_t)tok * D + 64 * j + 4 * i16); x[j] += (f32x4){bflo(ym.x), bfhi(ym.x), bflo(ym.y), bfhi(ym.y)}; } }
        if constexpr (NADD == 3) {
#pragma unroll
            for (int j = 0; j < 16; ++j) { const u32x2 y0 = *(const u32x2*)(YS + (size_t)tok * D + 64 * j + 4 * i16), y1 = *(const u32x2*)(YS + ((size_t)T + tok) * D + 64 * j + 4 * i16);
                const f32x4 g5 = *(const f32x4*)(MOD - (size_t)5 * NMODV + (size_t)sidx * NMODV + 5 * D + 64 * j + 4 * i16);
                x[j] += g5 * (f32x4){bflo(y0.x) + bflo(y1.x), bfhi(y0.x) + bfhi(y1.x), bflo(y0.y) + bflo(y1.y), bfhi(y0.y) + bfhi(y1.y)}; }
#pragma unroll
            for (int j = 0; j < 16; ++j) { if constexpr (X_BF16) { u32x2 o; o.x = pk2(x[j].x, x[j].y); o.y = pk2(x[j].z, x[j].w); *(u32x2*)((bf16_t*)X + (size_t)tok * D + 64 * j + 4 * i16) = o; }
                else *(f32x4*)(X + (size_t)tok * D + 64 * j + 4 * i16) = x[j]; } }
#pragma unroll
        for (int j = 0; j < 16; ++j) ss += x[j].x * x[j].x + x[j].y * x[j].y + x[j].z * x[j].z + x[j].w * x[j].w;
        ss = wave16_sum(ss);
        const float rstd = rsqrtf(ss * (1.f / D) + NORM_EPS);
        const float* shp = MOD + (size_t)sidx * NMODV + shift_i * D; const float* scp = shp + D;
#pragma unroll
        for (int j = 0; j < 16; ++j) { const int c = 64 * j + 4 * i16; const f32x4 g = *(const f32x4*)(gvec + c), sh = *(const f32x4*)(shp + c), sc = *(const f32x4*)(scp + c);
            x[j] = x[j] * rstd * g * (sc + 1.f) + sh; }
#pragma unroll
        for (int j = 0; j < 16; ++j) { const int c = 64 * j + 4 * i16;
            if constexpr (ROUTE && MOE_FP8) { int r8 = __builtin_amdgcn_cvt_pk_fp8_f32(x[j].x, x[j].y, 0, false); r8 = __builtin_amdgcn_cvt_pk_fp8_f32(x[j].z, x[j].w, r8, true); *(int*)((uchar*)H + (size_t)tok * D + c) = r8; }
            else { u32x2 o; o.x = pk2(x[j].x, x[j].y); o.y = pk2(x[j].z, x[j].w); *(u32x2*)(H + (size_t)tok * D + c) = o; } }
        if constexpr (ROUTE) {
            LAS float* lgs = (LAS float*)(F.lds + LDSCTL_OFF + 1024) + (F.wave * 4 + grp) * 40;
#pragma unroll 1
            for (int o = 0; o < 36; ++o) { f32x4 w[16];
#pragma unroll
                for (int j = 0; j < 16; ++j) w[j] = *(const LAS f32x4*)(wr + o * 1024 + 64 * j + 4 * i16);
                __builtin_amdgcn_sched_barrier(0);
                f32x4 v0 = x[0] * w[0], v1 = x[1] * w[1];
#pragma unroll
                for (int j = 2; j < 16; j += 2) { v0 += x[j] * w[j]; v1 += x[j + 1] * w[j + 1]; }
                v0 += v1; float a0 = wave16_sum((v0.x + v0.y) + (v0.z + v0.w)); if (i16 == 0) lgs[o] = a0; }
            asm volatile("s_waitcnt lgkmcnt(0)" ::: "memory");
            const float gl0 = lgs[0] + bg[0], gl1 = lgs[1] + bg[1], gl2 = lgs[2] + bg[2], gl3 = lgs[3] + bg[3];
            int gs = 0; float gm = gl0;
            if (gl1 > gm) { gm = gl1; gs = 1; }
            if (gl2 > gm) { gm = gl2; gs = 2; }
            if (gl3 > gm) { gm = gl3; gs = 3; }
            const float den = __expf(gl0 - gm) + __expf(gl1 - gm) + __expf(gl2 - gm) + __expf(gl3 - gm);
            const float pg = 1.f / den;
            float el[8];
#pragma unroll
            for (int e = 0; e < 8; ++e) el[e] = lgs[4 + gs * 8 + e] + br[gs * 8 + e];
            int i0 = 0; float v0 = el[0];
#pragma unroll
            for (int e = 1; e < 8; ++e) if (el[e] > v0) { v0 = el[e]; i0 = e; }
            int i1 = -1; float v1 = -3.0e38f;
#pragma unroll
            for (int e = 0; e < 8; ++e) if (e != i0 && el[e] > v1) { v1 = el[e]; i1 = e; }
            const float p0 = 1.f / (1.f + __expf(v1 - v0));
            const float w0 = p0 * pg, w1 = (1.f - p0) * pg;
            const bool do_route = !(skip_ctx_route && sidx == 4) && !dry;
            if (i16 == 0 && do_route) {
                const int e0 = gs * 8 + i0, e1 = gs * 8 + i1;
                unsigned* cnt = (unsigned*)(ws + WS_CTL) + CW_CNT + l * 32 * 64;
                const unsigned q0 = atomicAdd(cnt + e0 * 64, 1u), q1 = atomicAdd(cnt + e1 * 64, 1u);
                u32x2* BK = (u32x2*)(ws + WS_BK2);
                BK[(size_t)e0 * T + q0] = (u32x2){(unsigned)(tok * 2), __float_as_uint(w0)}; BK[(size_t)e1 * T + q1] = (u32x2){(unsigned)(tok * 2 + 1), __float_as_uint(w1)};
            }
        }
    }
}

__device__ __forceinline__ void st8(bf16_t* p, f32x4 v0, f32x4 v1) { u32x4 w; w.x = cvt_pk_bf16(v0[0], v0[1]); w.y = cvt_pk_bf16(v0[2], v0[3]); w.z = cvt_pk_bf16(v1[0], v1[1]); w.w = cvt_pk_bf16(v1[2], v1[3]); *(u32x4*)p = w; }
#define EPI_ROWS(ai, m) (u.pm * 256 + (ai) * 128 + wr * 64 + (m) * 16 + fr)

struct EpiRgIn { static constexpr bool PERM = true, FP8 = false, PREFETCH = false; bf16_t* GG; bf16_t* XB;
    __device__ __forceinline__ void operator()(const f32x4 (&acc)[2][2][4][2], const pg8::Unit& u, int wr, int wc, int fr, int fq) const {
        const bool isg = u.pn < 4; bf16_t* base = isg ? GG : XB; const int ct = (u.pn & 3) * 256 + wc * 32 + 8 * fq;
#pragma unroll
        for (int ai = 0; ai < 2; ++ai)
#pragma unroll
            for (int m = 0; m < 4; ++m) { if (!((u.hm >> (2 * ai)) & 1)) continue; bf16_t* rowp = base + (size_t)EPI_ROWS(ai, m) * D + ct;
#pragma unroll
                for (int bj = 0; bj < 2; ++bj) { f32x4 v0 = acc[ai][bj][m][0], v1 = acc[ai][bj][m][1];
                    if (isg) {
#pragma unroll
                        for (int e = 0; e < 4; ++e) { v0[e] = gelu_tanh(v0[e]); v1[e] = gelu_tanh(v1[e]); } }
                    st8(rowp + bj * 128, v0, v1); } }
    } };
struct EpiBf16 { static constexpr bool PERM = true, FP8 = false, PREFETCH = false; bf16_t* O; int ldc;
    __device__ __forceinline__ void operator()(const f32x4 (&acc)[2][2][4][2], const pg8::Unit& u, int wr, int wc, int fr, int fq) const {
        const int ct = u.pn * 256 + wc * 32 + 8 * fq;
#pragma unroll
        for (int ai = 0; ai < 2; ++ai)
#pragma unroll
            for (int m = 0; m < 4; ++m) { if (!((u.hm >> (2 * ai)) & 1)) continue; bf16_t* rowp = O + (size_t)EPI_ROWS(ai, m) * ldc + ct;
#pragma unroll
                for (int bj = 0; bj < 2; ++bj) st8(rowp + bj * 128, acc[ai][bj][m][0], acc[ai][bj][m][1]); }
    } };
struct EpiQKV { static constexpr bool PERM = true, FP8 = false, PREFETCH = false; bf16_t* O; const float* qg; const float* kg; const float* rope; LAS float* xch;
    __device__ __forceinline__ void operator()(const f32x4 (&acc)[2][2][4][2], const pg8::Unit& u, int wr, int wc, int fr, int fq) const {
        if (u.pn == 5) {
            const int ct = u.pn * 256 + wc * 32 + 8 * fq;
#pragma unroll
            for (int ai = 0; ai < 2; ++ai)
#pragma unroll
                for (int m = 0; m < 4; ++m) { if (!((u.hm >> (2 * ai)) & 1)) continue; bf16_t* rowp = O + (size_t)EPI_ROWS(ai, m) * 1536 + ct;
#pragma unroll
                    for (int bj = 0; bj < 2; ++bj) st8(rowp + bj * 128, acc[ai][bj][m][0], acc[ai][bj][m][1]); }
            return; }
        const bool lat = (u.pm % 17) != 0; const float* gv = u.pn < 4 ? qg : kg; const int a = wc >> 1, f0 = 16 * (wc & 1) + 4 * fq;
        const f32x4 g1 = *(const f32x4*)(gv + 64 * a + f0), g2 = *(const f32x4*)(gv + 64 * a + 32 + f0);
        f32x4 cvs[4], svs[4];
        { const int t0 = ((u.pm % 17) - 1) * 256;
#pragma unroll
          for (int q = 0; q < 4; ++q) { cvs[q] = (f32x4){1.f, 1.f, 1.f, 1.f}; svs[q] = (f32x4){0.f, 0.f, 0.f, 0.f};
            if (lat) { const int pos = a ? (16 * q + fr) : ((t0 >> 6) + 2 * (q & 1) + wr); const f32x4 cs0 = *(const f32x4*)(rope + (pos * 32 + f0) * 2), cs1 = *(const f32x4*)(rope + (pos * 32 + f0) * 2 + 4);
                cvs[q] = (f32x4){cs0.x, cs0.z, cs1.x, cs1.z}; svs[q] = (f32x4){cs0.y, cs0.w, cs1.y, cs1.w}; } } }
#pragma unroll
        for (int ai = 0; ai < 2; ++ai)
#pragma unroll
            for (int m = 0; m < 4; ++m)
#pragma unroll
                for (int bj = 0; bj < 2; ++bj) { const f32x4 v0 = acc[ai][bj][m][0], v1 = acc[ai][bj][m][1];
                    float sq = ((v0.x * v0.x + v0.y * v0.y) + (v0.z * v0.z + v0.w * v0.w)) + ((v1.x * v1.x + v1.y * v1.y) + (v1.z * v1.z + v1.w * v1.w));
                    sq += __shfl_xor(sq, 16); sq += __shfl_xor(sq, 32);
                    if (fq == 0) xch[((ai * 128 + wr * 64 + m * 16 + fr) * 2 + bj) * 4 + wc] = sq; }
        asm volatile("s_waitcnt lgkmcnt(0)" ::: "memory"); __builtin_amdgcn_s_barrier(); asm volatile("" ::: "memory");
#pragma unroll
        for (int ai = 0; ai < 2; ++ai)
#pragma unroll
            for (int m = 0; m < 4; ++m) { if (!((u.hm >> (2 * ai)) & 1)) continue; const int row = EPI_ROWS(ai, m);
                const f32x4 cv = a ? cvs[m] : cvs[ai], sv = a ? svs[m] : svs[ai];
#pragma unroll
                for (int bj = 0; bj < 2; ++bj) { const f32x4 p4 = *(const LAS f32x4*)(xch + ((ai * 128 + wr * 64 + m * 16 + fr) * 2 + bj) * 4);
                    const float rstd = rsqrtf(((p4.x + p4.y) + (p4.z + p4.w)) * (1.f / 128.f) + NORM_EPS);
                    const f32x4 x1 = acc[ai][bj][m][0] * rstd * g1, x2 = acc[ai][bj][m][1] * rstd * g2;
                    const f32x4 o1 = x1 * cv - x2 * sv, o2 = x2 * cv + x1 * sv;
                    bf16_t* p = O + (size_t)row * 1536 + u.pn * 256 + bj * 128 + 64 * a + f0;
                    u32x2 w1, w2; w1.x = cvt_pk_bf16(o1.x, o1.y); w1.y = cvt_pk_bf16(o1.z, o1.w); w2.x = cvt_pk_bf16(o2.x, o2.y); w2.y = cvt_pk_bf16(o2.z, o2.w);
                    *(u32x2*)p = w1; *(u32x2*)(p + 32) = w2; } }
    } };
struct EpiCmIn { static constexpr bool PERM = true, FP8 = false, PREFETCH = false; bf16_t* O; f32x2* statp;
    __device__ __forceinline__ void operator()(const f32x4 (&acc)[2][2][4][2], const pg8::Unit& u, int wr, int wc, int fr, int fq) const {
        const int ct = u.pn * 256 + wc * 32 + 8 * fq; const bool isv = u.pn >= 8;
#pragma unroll
        for (int ai = 0; ai < 2; ++ai)
#pragma unroll
            for (int m = 0; m < 4; ++m) { if (!((u.hm >> (2 * ai)) & 1)) continue; const int row = EPI_ROWS(ai, m); bf16_t* rowp = O + (size_t)row * 4096 + ct; float s = 0.f, q = 0.f;
#pragma unroll
                for (int bj = 0; bj < 2; ++bj) { f32x4 v0 = acc[ai][bj][m][0], v1 = acc[ai][bj][m][1];
#pragma unroll
                    for (int e = 0; e < 4; ++e) { v0[e] = gelu_tanh(v0[e]); v1[e] = gelu_tanh(v1[e]); }
                    u32x4 w; w.x = cvt_pk_bf16(v0[0], v0[1]); w.y = cvt_pk_bf16(v0[2], v0[3]); w.z = cvt_pk_bf16(v1[0], v1[1]); w.w = cvt_pk_bf16(v1[2], v1[3]);
                    *(u32x4*)(rowp + bj * 128) = w;
                    const float r0 = bflo(w.x), r1 = bfhi(w.x), r2 = bflo(w.y), r3 = bfhi(w.y), r4 = bflo(w.z), r5 = bfhi(w.z), r6 = bflo(w.w), r7 = bfhi(w.w);
                    s += ((r0 + r1) + (r2 + r3)) + ((r4 + r5) + (r6 + r7)); q += ((r0 * r0 + r1 * r1) + (r2 * r2 + r3 * r3)) + ((r4 * r4 + r5 * r5) + (r6 * r6 + r7 * r7)); }
                if (isv) { s += __shfl_xor(s, 16); s += __shfl_xor(s, 32); q += __shfl_xor(q, 16); q += __shfl_xor(q, 32);
                    if (fq == 0) statp[(size_t)row * 32 + (u.pn - 8) * 4 + wc] = (f32x2){s, q}; } }
    } };
struct EpiResid { static constexpr bool PERM = true, FP8 = false, PREFETCH = false; bf16_t* YM; const float* gate  ;
    __device__ __forceinline__ void operator()(const f32x4 (&acc)[2][2][4][2], const pg8::Unit& u, int wr, int wc, int fr, int fq) const {
        const int sidx = sidx_of_row(u.pm * 256); const float* gp = gate + (size_t)sidx * NMODV; const int ct = u.pn * 256 + wc * 32 + 8 * fq;
        f32x4 gv[2][2];
#pragma unroll
        for (int bj = 0; bj < 2; ++bj)
#pragma unroll
            for (int n = 0; n < 2; ++n) gv[bj][n] = *(const f32x4*)(gp + ct + bj * 128 + n * 4);
#pragma unroll
        for (int ai = 0; ai < 2; ++ai)
#pragma unroll
            for (int m = 0; m < 4; ++m) { if (!((u.hm >> (2 * ai)) & 1)) continue; bf16_t* rowp = YM + (size_t)EPI_ROWS(ai, m) * D + ct;
#pragma unroll
                for (int bj = 0; bj < 2; ++bj) st8(rowp + bj * 128, gv[bj][0] * acc[ai][bj][m][0], gv[bj][1] * acc[ai][bj][m][1]); }
    } };
struct EpiRgGate { static constexpr bool PERM = true, FP8 = false, PREFETCH = false; const bf16_t* XC; bf16_t* LA; bf16_t* BB; const float* ba; const float* bi; const float* lam;
    __device__ __forceinline__ void operator()(const f32x4 (&acc)[2][2][4][2], const pg8::Unit& u, int wr, int wc, int fr, int fq) const {
        const int d = u.pn >> 3, blk = u.pn & 7;
        asm volatile("" : "+v"(fr), "+v"(fq));
        const int ch = blk * 128 + wc * 32 + 8 * fq;
        u32x4 xw[8];
#pragma unroll
        for (int r = 0; r < 8; ++r) xw[r] = *(const u32x4*)(XC + (size_t)EPI_ROWS(r >> 2, r & 3) * D + ch);
        f32x4 bav[2], biv[2], spv[2];
#pragma unroll
        for (int n = 0; n < 2; ++n) { bav[n] = *(const f32x4*)(ba + d * D + ch + 4 * n); biv[n] = *(const f32x4*)(bi + d * D + ch + 4 * n); spv[n] = *(const f32x4*)(lam + d * D + ch + 4 * n); }
#pragma unroll
        for (int r = 0; r < 8; ++r) { const int ai = r >> 2, m = r & 3; if (!((u.hm >> (2 * ai)) & 1)) continue;
            const size_t off = (size_t)EPI_ROWS(ai, m) * D + ch;
            const float xc[8] = {bflo(xw[r].x), bfhi(xw[r].x), bflo(xw[r].y), bfhi(xw[r].y), bflo(xw[r].z), bfhi(xw[r].z), bflo(xw[r].w), bfhi(xw[r].w)};
            float la[8], bb[8];
#pragma unroll
            for (int n = 0; n < 2; ++n)
#pragma unroll
                for (int e = 0; e < 4; ++e) { const float rg = fast_sigmoid(acc[ai][0][m][n][e] + bav[n][e]), ig = fast_sigmoid(acc[ai][1][m][n][e] + biv[n][e]);
                    const float lga = rg * spv[n][e]; la[4 * n + e] = lga; bb[4 * n + e] = __builtin_amdgcn_sqrtf(one_minus_exp(-2.f * lga)) * ig * xc[4 * n + e]; }
            u32x4 w; w.x = cvt_pk_bf16(la[0], la[1]); w.y = cvt_pk_bf16(la[2], la[3]); w.z = cvt_pk_bf16(la[4], la[5]); w.w = cvt_pk_bf16(la[6], la[7]);
            *(u32x4*)(LA + (size_t)d * T * D + off) = w;
            w.x = cvt_pk_bf16(bb[0], bb[1]); w.y = cvt_pk_bf16(bb[2], bb[3]); w.z = cvt_pk_bf16(bb[4], bb[5]); w.w = cvt_pk_bf16(bb[6], bb[7]);
            *(u32x4*)(BB + (size_t)d * T * D + off) = w; }
    } };

template <bool G1>
struct MoeOrder {
    static constexpr bool GATHER = G1;
    const LAS int* tab; const char* A; const char* B; const int* BK; int G, c, nunits; size_t bstride; int arow, brow;
    __device__ bool next(int i, pg8::Unit& u) const {
        int L, hm; if (!pg8::unit_slot(i, c, G, nunits, L, hm)) return false; u.hm = __builtin_amdgcn_readfirstlane(hm);
        const int wgid = __builtin_amdgcn_readfirstlane(pg8::xcd_remap(L, nunits)); const int tau = wgid >> 2, pn = wgid & 3;
        const int e = __builtin_amdgcn_readfirstlane(tab[192 + tau]);
        u.pm = tau; u.pn = pn; u.aux0 = e; u.aux1 = __builtin_amdgcn_readfirstlane((tau - tab[e]) * 256);
        u.a = pg8::uptr(G1 ? A : A + (size_t)tau * 256 * arow);
        u.b = pg8::uptr(B + (size_t)e * bstride + (size_t)pn * 256 * brow);
        return true; }
    __device__ unsigned goff(const pg8::Unit& u, int row) const {
        const int pos = u.aux1 + row; const int cnt = tab[40 + u.aux0];
        int tok = 0; if (pos < cnt) tok = __builtin_nontemporal_load(BK + ((size_t)u.aux0 * T + pos) * 2) >> 1;
        return (unsigned)tok * (unsigned)arow; }
};
struct EpiMoe1 { static constexpr bool PERM = true, FP8 = (MOE_FP8 != 0), PREFETCH = false; uchar* H1;
    __device__ __forceinline__ void operator()(const f32x4 (&acc)[2][2][4][2], const pg8::Unit& u, int wr, int wc, int fr, int fq) const {
        const int ct = u.pn * 128 + wc * 32 + 8 * fq;
#pragma unroll
        for (int ai = 0; ai < 2; ++ai)
#pragma unroll
            for (int m = 0; m < 4; ++m) { if (!((u.hm >> (2 * ai)) & 1)) continue; f32x4 h0, h1;
#pragma unroll
                for (int e = 0; e < 4; ++e) { constexpr float WS_ = FP8 ? (1.f / 32.f) : 1.f;
                    const float g0 = acc[ai][0][m][0][e] * WS_, g1 = acc[ai][0][m][1][e] * WS_; h0[e] = g0 * fast_sigmoid(g0) * (acc[ai][1][m][0][e] * WS_); h1[e] = g1 * fast_sigmoid(g1) * (acc[ai][1][m][1][e] * WS_); }
                if constexpr (FP8) { int r0 = __builtin_amdgcn_cvt_pk_fp8_f32(h0[0], h0[1], 0, false); r0 = __builtin_amdgcn_cvt_pk_fp8_f32(h0[2], h0[3], r0, true);
                    int r1 = __builtin_amdgcn_cvt_pk_fp8_f32(h1[0], h1[1], 0, false); r1 = __builtin_amdgcn_cvt_pk_fp8_f32(h1[2], h1[3], r1, true);
                    *(u32x2*)(H1 + (size_t)EPI_ROWS(ai, m) * DEXP + ct) = (u32x2){(unsigned)r0, (unsigned)r1}; }
                else st8((bf16_t*)H1 + (size_t)EPI_ROWS(ai, m) * DEXP + ct, h0, h1); }
    } };
struct EpiMoe2 { static constexpr bool PERM = true, FP8 = (MOE_FP8 != 0), PREFETCH = true; bf16_t* YS; const int* BK; const LAS int* tab;
    typedef int pre_t __attribute__((ext_vector_type(16)));
    __device__ __forceinline__ pre_t prefetch(const pg8::Unit& u, int wr, int fr) const { pre_t p; const int cnt = tab[40 + u.aux0];
#pragma unroll
        for (int r = 0; r < 8; ++r) { const int pos = u.aux1 + (r >> 2) * 128 + wr * 64 + (r & 3) * 16 + fr; u32x2 v = {0xffffffffu, 0u}; if (pos < cnt) v = __builtin_nontemporal_load((const u32x2*)BK + (size_t)u.aux0 * T + pos); p[2 * r] = (int)v.x; p[2 * r + 1] = (int)v.y; }
        return p; }
    __device__ __forceinline__ void operator()(const f32x4 (&acc)[2][2][4][2], const pg8::Unit& u, int wr, int wc, int fr, int fq, const pre_t& pre) const {
        const int ct = u.pn * 256 + wc * 32 + 8 * fq;
#pragma unroll
        for (int r = 0; r < 8; ++r) { const int e_ = pre[2 * r];
            if (e_ >= 0 && ((u.hm >> (2 * (r >> 2))) & 1)) { const int tok = e_ >> 1, slot = e_ & 1; const float w = __int_as_float(pre[2 * r + 1]) * (FP8 ? (1.f / 32.f) : 1.f);
                bf16_t* yp = YS + ((size_t)slot * T + tok) * D + ct;
#pragma unroll
                for (int bj = 0; bj < 2; ++bj) st8(yp + bj * 128, acc[r >> 2][bj][r & 3][0] * w, acc[r >> 2][bj][r & 3][1] * w); } }
    } };
__device__ __forceinline__ int moe_table(Frame& F, int l, LAS int* tab) {
    __syncthreads();
    if (F.tid < 32) { const unsigned c = __hip_atomic_load((unsigned*)(F.ws + WS_CTL) + CW_CNT + (l * 32 + F.tid) * 64, RLX_AGENT); tab[40 + F.tid] = (int)c; }
    __syncthreads();
    if (F.tid == 0) { int s = 0;
#pragma unroll 1
        for (int e = 0; e < 32; ++e) { tab[e] = s; s += (tab[40 + e] + 255) >> 8; } tab[32] = s; }
    __syncthreads();
    const int ntile_ = tab[32];
    for (int tau = F.tid; tau < ntile_; tau += 512) { int e = 0;
#pragma unroll 1
        for (int k = 1; k < 32; ++k) e = (tab[k] <= tau) ? k : e;
        tab[192 + tau] = e; }
    __syncthreads();
    return ntile_;
}

__device__ __forceinline__ void conv_phase(Frame& F, int j) {
    const bf16_t* XB = (const bf16_t*)(F.ws + WS_XB); bf16_t* XC = (bf16_t*)(F.ws + WS_XC);
    const float* cw = inp(F, I_RGCW) + (size_t)j * 4 * D; const float* cb = inp(F, I_RGCB) + (size_t)j * D;
    const int NGT = F.G * 512;
    for (int i0 = F.bid * 512 + F.tid; i0 < T * 128; i0 += 2 * NGT) {
        u32x4 xw[2][4];
#pragma unroll
        for (int q = 0; q < 2; ++q) { const int i = i0 + q * NGT; const int row = i >> 7, c = (i & 127) * 8; const int b = row / SB, s = row - b * SB; const int lo = s < CTX ? 0 : CTX, hi = s < CTX ? CTX : SB;
#pragma unroll
            for (int k = 0; k < 4; ++k) { const int ss = s + k - 2; xw[q][k] = (u32x4){0u, 0u, 0u, 0u}; if (i < T * 128 && ss >= lo && ss < hi) xw[q][k] = *(const u32x4*)(XB + (size_t)(b * SB + ss) * D + c); } }
#pragma unroll
        for (int q = 0; q < 2; ++q) { const int i = i0 + q * NGT; if (i < T * 128) { const int row = i >> 7, c = (i & 127) * 8;
            float a[8];
#pragma unroll
            for (int e = 0; e < 8; ++e) a[e] = cb[c + e];
#pragma unroll
            for (int k = 0; k < 4; ++k) { const f32x4 w0 = *(const f32x4*)(cw + k * D + c), w1 = *(const f32x4*)(cw + k * D + c + 4); const u32x4 x = xw[q][k];
                a[0] += w0.x * bflo(x.x); a[1] += w0.y * bfhi(x.x); a[2] += w0.z * bflo(x.y); a[3] += w0.w * bfhi(x.y);
                a[4] += w1.x * bflo(x.z); a[5] += w1.y * bfhi(x.z); a[6] += w1.z * bflo(x.w); a[7] += w1.w * bfhi(x.w); }
            u32x4 o; o.x = pk2(a[0], a[1]); o.y = pk2(a[2], a[3]); o.z = pk2(a[4], a[5]); o.w = pk2(a[6], a[7]);
            *(u32x4*)(XC + (size_t)row * D + c) = o; } }
    }
}
__device__ __forceinline__ void scan1_phase(Frame& F) {
    const bf16_t* LA = (const bf16_t*)(F.ws + WS_LA); const bf16_t* BB = (const bf16_t*)(F.ws + WS_BB); float* TS = (float*)(F.ws + WS_TOTS); float* TH = (float*)(F.ws + WS_TOTH);
    for (int it = F.bid * 8 + F.wave; it < NB * 2 * NCH * 4; it += F.G * 8) {
        const int cg = it & 3, rest = it >> 2, ck = rest % NCH, bd = rest / NCH, dir = bd & 1, b = bd >> 1;
        const int c = cg * 256 + F.lane * 4; const size_t base = (size_t)dir * T * D + (size_t)(b * SB + ck * 16) * D + c;
        u32x2 la[16], bb[16];
#pragma unroll
        for (int t = 0; t < 16; ++t) { const size_t o = base + (size_t)(dir ? 15 - t : t) * D; la[t] = *(const u32x2*)(LA + o); bb[t] = *(const u32x2*)(BB + o); }
        f32x4 sl = {0.f, 0.f, 0.f, 0.f}, h = {0.f, 0.f, 0.f, 0.f};
#pragma unroll
        for (int t = 0; t < 16; ++t) { const f32x4 l4 = {bflo(la[t].x), bfhi(la[t].x), bflo(la[t].y), bfhi(la[t].y)}, b4 = {bflo(bb[t].x), bfhi(bb[t].x), bflo(bb[t].y), bfhi(bb[t].y)};
            sl += l4; f32x4 a4 = {__expf(l4.x), __expf(l4.y), __expf(l4.z), __expf(l4.w)}; h = a4 * h + b4; }
        const size_t o = (size_t)(bd * NCH + ck) * D + c; *(f32x4*)(TS + o) = sl; *(f32x4*)(TH + o) = h;
    }
}
__device__ __forceinline__ void scan2_phase(Frame& F) {
    const float* TS = (const float*)(F.ws + WS_TOTS); const float* TH = (const float*)(F.ws + WS_TOTH); float* CY = (float*)(F.ws + WS_CARRY);
    LAS float* wt = (LAS float*)F.lds;
    for (int it = F.bid; it < NB * 2 * 16; it += F.G) {
        const int cg = it & 15, bd = it >> 4, dir = bd & 1; const int c = cg * 64 + F.lane; const size_t base = (size_t)bd * NCH * D + c;
        const int s0 = F.wave * 34;
        float P = 0.f, H = 0.f;
#pragma unroll 1
        for (int sb = 0; sb < 34; sb += 17) { float sl[17], hl[17];
#pragma unroll
            for (int q = 0; q < 17; ++q) { const int s = s0 + sb + q; const int ck = dir ? (s < 16 ? 15 - s : NCH + 15 - s) : s; sl[q] = TS[base + (size_t)ck * D]; hl[q] = TH[base + (size_t)ck * D]; }
#pragma unroll
            for (int q = 0; q < 17; ++q) { P += sl[q]; H = __expf(sl[q]) * H + hl[q]; } }
        __syncthreads();
        wt[(F.wave * 2 + 0) * 64 + F.lane] = P; wt[(F.wave * 2 + 1) * 64 + F.lane] = H;
        __syncthreads();
        float h = 0.f;
        for (int w = 0; w < F.wave; ++w) h = __expf(wt[(w * 2 + 0) * 64 + F.lane]) * h + wt[(w * 2 + 1) * 64 + F.lane];
#pragma unroll 1
        for (int sb = 0; sb < 34; sb += 17) { float sl[17], hl[17]; int ckk[17];
#pragma unroll
            for (int q = 0; q < 17; ++q) { const int s = s0 + sb + q; ckk[q] = dir ? (s < 16 ? 15 - s : NCH + 15 - s) : s; sl[q] = TS[base + (size_t)ckk[q] * D]; hl[q] = TH[base + (size_t)ckk[q] * D]; }
#pragma unroll
            for (int q = 0; q < 17; ++q) { CY[base + (size_t)ckk[q] * D] = h; h = __expf(sl[q]) * h + hl[q]; } }
    }
    __syncthreads();
}
__device__ __forceinline__ void scan3_phase(Frame& F) {
    const bf16_t* LA = (const bf16_t*)(F.ws + WS_LA); const bf16_t* BB = (const bf16_t*)(F.ws + WS_BB); const float* CY = (const float*)(F.ws + WS_CARRY);
    const bf16_t* GG = (const bf16_t*)(F.ws + WS_GG); bf16_t* SA = (bf16_t*)(F.ws + WS_SA);
    LAS f32x4* hb = (LAS f32x4*)(F.lds + F.wave * 16384);
    for (int it = F.bid * 8 + F.wave; it < NB * NCH * 4; it += F.G * 8) {
        const int cg = it & 3, rest = it >> 2, ck = rest % NCH, b = rest / NCH;
        const int c = cg * 256 + F.lane * 4;
        const size_t rbase = (size_t)(b * SB + ck * 16) * D + c, b1 = (size_t)T * D + rbase;
        f32x4 hbk = *(const f32x4*)(CY + (size_t)((b * 2 + 1) * NCH + ck) * D + c), hf = *(const f32x4*)(CY + (size_t)((b * 2 + 0) * NCH + ck) * D + c);
        { u32x2 la[16], bb[16];
#pragma unroll
          for (int t = 0; t < 16; ++t) { la[t] = *(const u32x2*)(LA + b1 + (size_t)(15 - t) * D); bb[t] = *(const u32x2*)(BB + b1 + (size_t)(15 - t) * D); }
#pragma unroll
          for (int t = 0; t < 16; ++t) { const f32x4 l4 = {bflo(la[t].x), bfhi(la[t].x), bflo(la[t].y), bfhi(la[t].y)}, b4 = {bflo(bb[t].x), bfhi(bb[t].x), bflo(bb[t].y), bfhi(bb[t].y)};
              const f32x4 a4 = {__expf(l4.x), __expf(l4.y), __expf(l4.z), __expf(l4.w)}; hbk = a4 * hbk + b4; hb[(15 - t) * 64 + F.lane] = hbk; } }
        { u32x2 la[16], bb[16], gg[16];
#pragma unroll
          for (int t = 0; t < 16; ++t) { la[t] = *(const u32x2*)(LA + rbase + (size_t)t * D); bb[t] = *(const u32x2*)(BB + rbase + (size_t)t * D); gg[t] = *(const u32x2*)(GG + rbase + (size_t)t * D); }
#pragma unroll
          for (int t = 0; t < 16; ++t) { const f32x4 l4 = {bflo(la[t].x), bfhi(la[t].x), bflo(la[t].y), bfhi(la[t].y)}, b4 = {bflo(bb[t].x), bfhi(bb[t].x), bflo(bb[t].y), bfhi(bb[t].y)};
              const f32x4 g4 = {bflo(gg[t].x), bfhi(gg[t].x), bflo(gg[t].y), bfhi(gg[t].y)};
              const f32x4 a4 = {__expf(l4.x), __expf(l4.y), __expf(l4.z), __expf(l4.w)}; hf = a4 * hf + b4; const f32x4 y = g4 * (hf + hb[t * 64 + F.lane]);
              u32x2 o; o.x = pk2(y.x, y.y); o.y = pk2(y.z, y.w); *(u32x2*)(SA + rbase + (size_t)t * D) = o; } }
    }
}

__device__ __forceinline__ void qknorm_phase(Frame& F) {
    bf16_t* QKV = (bf16_t*)(F.ws + WS_QKV); const f32x2* ROPE = (const f32x2*)(F.ws + WS_ROPE);
    const int i16 = F.lane & 15, grp = F.lane >> 4; const float* pqg = inp(F, I_ATQG); const float* pkg = inp(F, I_ATKG);
    const int ITS = F.G * 32;
    for (int it0 = (F.bid * 8 + F.wave) * 4 + grp; it0 < T * 10; it0 += 4 * ITS) {
        u32x4 xw4[4];
#pragma unroll
        for (int q = 0; q < 4; ++q) { const int it = it0 + q * ITS; xw4[q] = (u32x4){0u, 0u, 0u, 0u}; if (it < T * 10) { const int row = it / 10, hh = it - row * 10; xw4[q] = *(const u32x4*)(QKV + (size_t)row * 1536 + hh * 128 + i16 * 8); } }
#pragma unroll
        for (int q = 0; q < 4; ++q) { const int it = it0 + q * ITS; const bool valid = it < T * 10; const int itc = valid ? it : 0;
            const int row = itc / 10, hh = itc - row * 10; const int b = row / SB, s = row - b * SB;
            bf16_t* p = QKV + (size_t)row * 1536 + hh * 128 + i16 * 8;
            const u32x4 xw = xw4[q];
            float x[8] = {bflo(xw.x), bfhi(xw.x), bflo(xw.y), bfhi(xw.y), bflo(xw.z), bfhi(xw.z), bflo(xw.w), bfhi(xw.w)};
            float ss = 0.f;
#pragma unroll
            for (int e = 0; e < 8; ++e) ss += x[e] * x[e];
            ss = wave16_sum(ss);
            const float rstd = rsqrtf(ss * (1.f / 128.f) + NORM_EPS);
            const float* g = (hh < 8 ? pqg : pkg) + i16 * 8;
#pragma unroll
            for (int e = 0; e < 8; ++e) x[e] = x[e] * rstd * g[e];
            float y[8];
#pragma unroll
            for (int e = 0; e < 8; ++e) y[e] = __shfl_xor(x[e], 4);
            if (s >= CTX) { const int t = s - CTX; const int pos = (i16 >> 3) ? (t & 63) : (t >> 6); const bool half1 = (i16 >> 2) & 1;
#pragma unroll
                for (int e = 0; e < 8; ++e) { const f32x2 cs = ROPE[pos * 32 + (i16 & 3) * 8 + e];
                    x[e] = half1 ? (x[e] * cs.x + y[e] * cs.y) : (x[e] * cs.x - y[e] * cs.y); } }
            u32x4 o; o.x = pk2(x[0], x[1]); o.y = pk2(x[2], x[3]); o.z = pk2(x[4], x[5]); o.w = pk2(x[6], x[7]);
            if (valid) *(u32x4*)p = o;
        }
    }
}
__device__ __forceinline__ void attn_phase(Frame& F) {
    const bf16_t* QKV = (const bf16_t*)(F.ws + WS_QKV); bf16_t* AO = (bf16_t*)(F.ws + WS_AO);
    for (int u = F.bid; u < 544; u += F.G) {
        int b, h, q0, k0, seq;
        if (u < 512) { const int qb = u & 15, hg = (u >> 4) & 3, kvh = (u >> 6) & 1; b = u >> 7; h = kvh * 4 + hg; q0 = b * SB + CTX + qb * 256; k0 = b * SB; seq = SB; }
        else { const int v = u - 512; b = v >> 3; h = v & 7; q0 = b * SB; k0 = b * SB; seq = CTX; }
        const int kvh = h >> 2;
        const bf16_t* Kp = (const bf16_t*)pg8::uptr((const char*)(QKV + (size_t)k0 * 1536 + 1024 + kvh * 128));
        att::attn_dense_body((const bf16_t*)pg8::uptr((const char*)(QKV + (size_t)q0 * 1536 + h * 128)), Kp, Kp + 256, (bf16_t*)pg8::uptr((const char*)(AO + (size_t)q0 * D + h * 128)), seq, F.ldsg, F.tid);
        __syncthreads();
    }
}

__device__ __forceinline__ void spatial_phase(Frame& F) {
    const bf16_t* UVB = (const bf16_t*)(F.ws + WS_UVB); bf16_t* UV = (bf16_t*)(F.ws + WS_UV); const f32x2* statp = (const f32x2*)(F.ws + WS_STATP);
    const bf16_t* Ws = (const bf16_t*)(F.ws + WS_W_CMS); const float* lng = inp(F, I_CMLNG); const float* lnb = inp(F, I_CMLNB); const float* bs = inp(F, I_CMBS);
    LAS uchar* vl = F.lds;
    LAS f32x2* st = (LAS f32x2*)(F.lds + 65536);
    const int tid = F.tid, lane = F.lane, wid = F.wave, r32 = lane & 31, hi = lane >> 5, wm = wid & 3, wn = wid >> 2;
    const int sr = tid >> 4, sc = (tid & 15) * 8;
    for (int u = F.bid; u < 136 * 8; u += F.G) {
        const int chunk = u >> 3, g = u & 7; const int row0 = chunk * 128;
        float s_ = 0.f, q_ = 0.f;
        { const f32x2* sp = statp + (size_t)(row0 + (tid >> 2)) * 32 + (tid & 3) * 8; f32x2 pv[8];
#pragma unroll
          for (int k = 0; k < 8; ++k) pv[k] = sp[k];
#pragma unroll
          for (int k = 0; k < 8; ++k) { s_ += pv[k].x; q_ += pv[k].y; } }
        u32x4 xw[2][4]; f32x4 lg0[2], lg1[2], lb0[2], lb1[2];
#pragma unroll
        for (int ch = 0; ch < 2; ++ch) { const int cg = g * 256 + ch * 128 + sc;
            lg0[ch] = *(const f32x4*)(lng + cg); lg1[ch] = *(const f32x4*)(lng + cg + 4); lb0[ch] = *(const f32x4*)(lnb + cg); lb1[ch] = *(const f32x4*)(lnb + cg + 4);
#pragma unroll
            for (int i = 0; i < 4; ++i) xw[ch][i] = *(const u32x4*)(UVB + (size_t)(row0 + sr + 32 * i) * 4096 + 2048 + cg); }
        bf16x8 pa[2][4];
#pragma unroll
        for (int kt = 0; kt < 2; ++kt)
#pragma unroll
            for (int ks = 0; ks < 4; ++ks) pa[kt][ks] = *(const bf16x8*)(Ws + ((size_t)g * 128 + 32 * wm + r32) * 128 + 64 * kt + 16 * ks + 8 * hi);
        u32x4 uu[8];
#pragma unroll
        for (int i = 0; i < 8; ++i) { const int id = tid + 512 * i, row = id >> 5, ch = id & 31; uu[i] = *(const u32x4*)(UVB + (size_t)(row0 + row) * 4096 + g * 256 + ch * 8); }
        s_ += __int_as_float(__builtin_amdgcn_update_dpp(0, __float_as_int(s_), 0xB1, 0xF, 0xF, true)); s_ += __int_as_float(__builtin_amdgcn_update_dpp(0, __float_as_int(s_), 0x4E, 0xF, 0xF, true));
        q_ += __int_as_float(__builtin_amdgcn_update_dpp(0, __float_as_int(q_), 0xB1, 0xF, 0xF, true)); q_ += __int_as_float(__builtin_amdgcn_update_dpp(0, __float_as_int(q_), 0x4E, 0xF, 0xF, true));
        __syncthreads();
        if ((tid & 3) == 0) { const float mean = s_ * (1.f / 2048.f); const float var = fmaxf(q_ * (1.f / 2048.f) - mean * mean, 0.f); st[tid >> 2] = (f32x2){mean, rsqrtf(var + NORM_EPS)}; }
        __syncthreads();
#pragma unroll
        for (int ch = 0; ch < 2; ++ch) {
#pragma unroll
            for (int i = 0; i < 4; ++i) { const int q = sr + 32 * i; const u32x4 x_ = xw[ch][i]; const f32x2 ms = st[q];
                f32x4 v0 = {bflo(x_.x), bfhi(x_.x), bflo(x_.y), bfhi(x_.y)}, v1 = {bflo(x_.z), bfhi(x_.z), bflo(x_.w), bfhi(x_.w)};
                v0 = (v0 - ms.x) * ms.y * lg0[ch] + lb0[ch]; v1 = (v1 - ms.x) * ms.y * lg1[ch] + lb1[ch];
                u32x4 o; o.x = pk2(v0.x, v0.y); o.y = pk2(v0.z, v0.w); o.z = pk2(v1.x, v1.y); o.w = pk2(v1.z, v1.w);
                *(LAS u32x4*)(vl + ((q >> 6) * 2 + ch) * 16384 + att::v_st(q & 63, sc)) = o; } }
        __syncthreads();
        f32x16 o[4] = {};
        const int vb = (int)(uintptr_t)(F.ldsg) + att::v_rd_base(lane) + wn * 16384;
        att::pv_d0(o, vb, pa[0][0], pa[0][1], pa[0][2], pa[0][3]);
        att::pv_d0(o, vb + 32768, pa[1][0], pa[1][1], pa[1][2], pa[1][3]);
        __syncthreads();
#pragma unroll
        for (int r = 0; r < 16; ++r) { const int p = 32 * wm + att::crow(r, hi); const float bsv = bs[g * 128 + p];
#pragma unroll
            for (int d0 = 0; d0 < 4; ++d0) *(LAS bf16_t*)(vl + p * 512 + (128 * wn + 32 * d0 + r32) * 2) = (bf16_t)f2bf(o[d0][r] + bsv); }
        __syncthreads();
#pragma unroll
        for (int i = 0; i < 8; ++i) { const int id = tid + 512 * i, row = id >> 5, ch = id & 31; const u32x4 v = *(const LAS u32x4*)(vl + row * 512 + ch * 16); const u32x4 w = uu[i];
            u32x4 o4; o4.x = pk2(bflo(v.x) * bflo(w.x), bfhi(v.x) * bfhi(w.x)); o4.y = pk2(bflo(v.y) * bflo(w.y), bfhi(v.y) * bfhi(w.y)); o4.z = pk2(bflo(v.z) * bflo(w.z), bfhi(v.z) * bfhi(w.z)); o4.w = pk2(bflo(v.w) * bflo(w.w), bfhi(v.w) * bfhi(w.w));
            *(u32x4*)(UV + (size_t)(row0 + row) * 2048 + g * 256 + ch * 8) = o4; }
    }
    __syncthreads();
}

__device__ __forceinline__ void final_phase(Frame& F) {
    const f32x4* X = (const f32x4*)(F.ws + WS_X); const u32x2* YS = (const u32x2*)(F.ws + WS_Y1); const u32x2* YM = (const u32x2*)(F.ws + WS_YM); f32x4* out = (f32x4*)F.out;
    const f32x4* G5 = (const f32x4*)((const float*)(F.ws + WS_MOD) + (size_t)(DEPTH - 1) * 5 * NMODV + 5 * D);
    const int NGT = F.G * 512;
    for (int i0 = F.bid * 512 + F.tid; i0 < NB * SEQ * 256; i0 += 4 * NGT) { f32x4 a[4]; u32x2 y0[4], y1[4], ym[4];
#pragma unroll
        for (int q = 0; q < 4; ++q) { const int i = i0 + q * NGT; if (i < NB * SEQ * 256) { const int r = i >> 8, c4 = i & 255, b = r >> 12, t = r & 4095; const size_t src = ((size_t)(b * SB + CTX + t) << 8) + c4; if constexpr (X_BF16) { const u32x2 xb = ((const u32x2*)X)[src]; a[q] = (f32x4){bflo(xb.x), bfhi(xb.x), bflo(xb.y), bfhi(xb.y)}; } else a[q] = X[src]; y0[q] = YS[src]; y1[q] = YS[src + (size_t)T * 256]; ym[q] = YM[src]; } }
#pragma unroll
        for (int q = 0; q < 4; ++q) { const int i = i0 + q * NGT; if (i < NB * SEQ * 256) { const int r = i >> 8, c4 = i & 255, b = r >> 12; const f32x4 g5 = G5[(size_t)b * (NMODV / 4) + c4];
            out[i] = a[q] + (f32x4){bflo(ym[q].x), bfhi(ym[q].x), bflo(ym[q].y), bfhi(ym[q].y)} + g5 * (f32x4){bflo(y0[q].x) + bflo(y1[q].x), bfhi(y0[q].x) + bfhi(y1[q].x), bflo(y0[q].y) + bflo(y1[q].y), bfhi(y0[q].y) + bfhi(y1[q].y)}; } } }
}

constexpr int NPHASE = 38;
__global__ void __launch_bounds__(512, 2) mk_fwd(Args args) {
    extern __shared__ __attribute__((aligned(16))) uchar lds[];
    Frame F; F.lds = (LAS uchar*)lds; F.ldsg = (char*)lds; F.tid = threadIdx.x; F.lane = F.tid & 63; F.wave = __builtin_amdgcn_readfirstlane(F.tid >> 6); F.G = gridDim.x; F.bid = blockIdx.x;
    F.ws = args.ws; F.out = args.out;
    uchar* ws0 = args.ws;
    volatile LAS unsigned* MISC = (volatile LAS unsigned*)(F.lds + LDSCTL_OFF);
    LAS int* tab = (LAS int*)(F.lds + LDSCTL_OFF + 256);
    for (int u = F.tid; u < (LDS_BYTES - LDSCTL_OFF) / 4; u += 512) ((LAS unsigned*)(F.lds + LDSCTL_OFF))[u] = 0u;
    __syncthreads();
    if (F.tid == 0) {
#pragma unroll
        for (int i = 0; i < 34; ++i) *(LAS unsigned long long*)(F.lds + LDSCTL_OFF + 576 + i * 8) = (unsigned long long)args.in[i]; }
    __syncthreads();
    const int lo = args.ph_lo, hi = args.ph_hi;
    if (hi - lo > 1) (void)xcd_barrier_post((unsigned*)(ws0 + WS_CTL) + CW_BAR, MISC + 8);
    int ph = 0;
#define PH_BEGIN if (ph >= opaque_uniform_int(args.ph_lo) && ph < opaque_uniform_int(args.ph_hi)) { int t_ = threadIdx.x; F.G = opaque_uniform_int(gridDim.x); F.bid = opaque_uniform_int(blockIdx.x); const int cid = F.bid; (void)cid; \
        F.out = (float*)opaque_uniform_ptr(args.out); F.lds = (LAS uchar*)lds; F.ldsg = (char*)lds; \
        asm volatile("" : "+v"(t_)); F.tid = t_; F.lane = t_ & 63; F.wave = __builtin_amdgcn_readfirstlane(t_ >> 6); \
        uchar* ws = (uchar*)opaque_uniform_ptr(args.ws); F.ws = ws; \
        const float* MODl = (const float*)(ws + WS_MOD) + (size_t)l_ * 5 * NMODV; (void)MODl;
#define GRIDBAR  { XcdBarrier bb_; bb_.bar = (unsigned*)(ws + WS_CTL) + CW_BAR; bb_.x = 0; bb_.st = (volatile LAS unsigned*)(F.lds + LDSCTL_OFF) + 8; xcd_barrier(bb_); }
#define REPBAR   if (rep_ > 1) GRIDBAR
#define PH_END   if (ph + 1 < opaque_uniform_int(args.ph_hi)) GRIDBAR } ++ph;

    { const int l_ = 0; PH_BEGIN PM(0) { const bool dry = rep_ > 1; (void)dry;  p0_prologue(F);  REPBAR } PH_END }

#pragma unroll 1
    for (int l = 0; l < DEPTH; ++l) {
        const int kind = l % 3, j = l / 3; const bool lastl = (l == DEPTH - 1); const int l_ = l;
        PH_BEGIN PM(1) { const bool dry = rep_ > 1; (void)dry;  const float* gv_ = inp(F, I_NMG) + l * D;
            if (l == 0) norm_phase<false, 0, true>(F, l, gv_, 0, false, false);
            else if (rep_ != REPN(1)) norm_phase<false, 0, false>(F, l, gv_, 0, false, false);
            else if (l == 1) norm_phase<false, 3, true>(F, l, gv_, 0, false, false);
            else norm_phase<false, 3, false>(F, l, gv_, 0, false, false);  REPBAR } PH_END
        if (kind == 0) {
            PH_BEGIN PM(2) { const bool dry = rep_ > 1; (void)dry;  { pg8::DenseOrder S; S.init(ws + WS_H, D, ws + WS_W_RGIN + (size_t)j * 2048 * 1024 * 2, D, T, 2048, F.G, cid);
                EpiRgIn E{(bf16_t*)(ws + WS_GG), (bf16_t*)(ws + WS_XB)}; pg8::gemm_phase(F.lds, S, E, D, D, D); }  REPBAR } PH_END
            PH_BEGIN PM(3) { const bool dry = rep_ > 1; (void)dry;  conv_phase(F, j);  REPBAR } PH_END
            PH_BEGIN PM(4) { const bool dry = rep_ > 1; (void)dry;  { pg8::DenseOrder S; S.init(ws + WS_XC, D, ws + WS_W_RGG + (size_t)j * 16 * 256 * 128 * 2, 128, T, 16 * 256, F.G, cid, 7, 256);
                EpiRgGate E{(const bf16_t*)(ws + WS_XC), (bf16_t*)(ws + WS_LA), (bf16_t*)(ws + WS_BB), inp(F, I_RGBA) + (size_t)j * 2 * D, inp(F, I_RGBI) + (size_t)j * 2 * D, (const float*)(ws + WS_SPL) + (size_t)j * 2 * D};
                pg8::gemm_phase(F.lds, S, E, 128, D, 128); }  REPBAR } PH_END
            PH_BEGIN PM(5) { const bool dry = rep_ > 1; (void)dry;  scan1_phase(F);  REPBAR } PH_END
            PH_BEGIN PM(20) { const bool dry = rep_ > 1; (void)dry;  scan2_phase(F);  REPBAR } PH_END
            PH_BEGIN PM(6) { const bool dry = rep_ > 1; (void)dry;  scan3_phase(F);  REPBAR } PH_END
            PH_BEGIN PM(7) { const bool dry = rep_ > 1; (void)dry;  { EpiResid E{(bf16_t*)(ws + (dry ? WS_Y1 : WS_YM)), MODl + 2 * D};
                if (lastl) { pg8::DenseOrderT<true> S; S.init(ws + WS_SA, D, ws + WS_W_RGOUT + (size_t)j * 1024 * 1024 * 2, D, T, D, F.G, cid); pg8::gemm_phase(F.lds, S, E, D, D, D); }
                else { pg8::DenseOrder S; S.init(ws + WS_SA, D, ws + WS_W_RGOUT + (size_t)j * 1024 * 1024 * 2, D, T, D, F.G, cid); pg8::gemm_phase(F.lds, S, E, D, D, D); }
                router_fill(F, l); }  REPBAR } PH_END
        } else if (kind == 1) {
            PH_BEGIN PM(8) { const bool dry = rep_ > 1; (void)dry;  { pg8::DenseOrder S; S.init(ws + WS_H, D, ws + WS_W_QKV, D, T, 1536, F.G, cid);
                EpiQKV E{(bf16_t*)(ws + WS_QKV), inp(F, I_ATQG), inp(F, I_ATKG), (const float*)(ws + WS_ROPE), (LAS float*)(F.lds + RING_BYTES)}; pg8::gemm_phase(F.lds, S, E, D, D, D); }  REPBAR } PH_END
            PH_BEGIN PM(10) { const bool dry = rep_ > 1; (void)dry;  attn_phase(F);  REPBAR } PH_END
            PH_BEGIN PM(11) { const bool dry = rep_ > 1; (void)dry;  { pg8::DenseOrder S; S.init(ws + WS_AO, D, ws + WS_W_AO, D, T, D, F.G, cid);
                EpiResid E{(bf16_t*)(ws + (dry ? WS_Y1 : WS_YM)), MODl + 2 * D}; pg8::gemm_phase(F.lds, S, E, D, D, D); router_fill(F, l); }  REPBAR } PH_END
        } else {
            PH_BEGIN PM(12) { const bool dry = rep_ > 1; (void)dry;  { pg8::DenseOrder S; S.init(ws + WS_H, D, ws + WS_W_CMIN, D, T, 4096, F.G, cid);
                EpiCmIn E{(bf16_t*)(ws + WS_UVB), (f32x2*)(ws + WS_STATP)}; pg8::gemm_phase(F.lds, S, E, D, D, D); }  REPBAR } PH_END
            PH_BEGIN PM(13) { const bool dry = rep_ > 1; (void)dry;  spatial_phase(F);  REPBAR } PH_END
            PH_BEGIN PM(14) { const bool dry = rep_ > 1; (void)dry;  { pg8::DenseOrder S; S.init(ws + WS_UV, 2048, ws + WS_W_CMOUT, 2048, T, D, F.G, cid);
                EpiResid E{(bf16_t*)(ws + (dry ? WS_Y1 : WS_YM)), MODl + 2 * D}; pg8::gemm_phase(F.lds, S, E, 2048, 2048, 2048); router_fill(F, l); }  REPBAR } PH_END
        }
        PH_BEGIN PM(15) { const bool dry = rep_ > 1; (void)dry;  if (l == 0) norm_phase<true, 1, true>(F, l, inp(F, I_NFG) + l * D, 3, lastl, dry); else norm_phase<true, 1, false>(F, l, inp(F, I_NFG) + l * D, 3, lastl, dry);  REPBAR } PH_END
        PH_BEGIN PM(16) { const bool dry = rep_ > 1; (void)dry;  { const int ntile = moe_table(F, l, tab);
            const int units = ntile * 4, rounds = (units + F.G - 1) / F.G; int geff = F.G; if (false && rounds > 0) { geff = (((units + rounds - 1) / rounds) + 7) & ~7; if (geff > F.G) geff = F.G; }
            constexpr int EB = MOE_FP8 ? 1 : 2;
            MoeOrder<true> S{tab, (const char*)(ws + WS_H), (const char*)(ws + WS_W_E1 + (size_t)l * 32 * 1024 * 1024 * EB), (const int*)(ws + WS_BK2), geff, cid, units, (size_t)1024 * 1024 * EB, 1024 * EB, 1024 * EB};
            EpiMoe1 E{ws + WS_H1}; pg8::gemm_phase(F.lds, S, E, D * EB / 2, D * EB / 2, D * EB / 2); }  REPBAR } PH_END
        PH_BEGIN PM(17) { const bool dry = rep_ > 1; (void)dry;  { const int ntile = tab[32];
            const int units = ntile * 4, rounds = (units + F.G - 1) / F.G; int geff = F.G; if (false && rounds > 0) { geff = (((units + rounds - 1) / rounds) + 7) & ~7; if (geff > F.G) geff = F.G; }
            constexpr int EB = MOE_FP8 ? 1 : 2;
            MoeOrder<false> S{tab, (const char*)(ws + WS_H1), (const char*)(ws + WS_W_E2 + (size_t)l * 32 * 1024 * 512 * EB), (const int*)(ws + WS_BK2), geff, cid, units, (size_t)1024 * 512 * EB, 512 * EB, 512 * EB};
            EpiMoe2 E{(bf16_t*)(ws + (dry ? WS_SCR + 64 * MiB : WS_Y1)), (const int*)(ws + WS_BK2), tab}; pg8::gemm_phase(F.lds, S, E, DEXP * EB / 2, DEXP * EB / 2, DEXP * EB / 2); }  REPBAR } PH_END
    }
    { const int l_ = 0; PH_BEGIN PM(18) { const bool dry = rep_ > 1; (void)dry;  final_phase(F);  REPBAR if constexpr (((REP_MASK) >> 19) & 1u) { for (int k_ = 0; k_ < 20; ++k_) GRIDBAR } } PH_END }
#undef PH_BEGIN
#undef PH_END
}

extern "C" void kernel_launch(void* const* d_in, const int* in_sizes, int n_in, void* d_out, int out_size, void* d_ws, size_t ws_size, hipStream_t stream) {
    static int grid = 0;
    if (grid == 0) {
        if (n_in != 34 || out_size != NB * SEQ * D || ws_size < WS_END) { fprintf(stderr, "kernel_launch: bad shapes n_in %d out %d ws %zu (need %zu)\n", n_in, out_size, ws_size, (size_t)WS_END); grid = -1; return; }
        int dev = 0, cus = 0, per_cu = 0;
        if (hipGetDevice(&dev) != hipSuccess || hipDeviceGetAttribute(&cus, hipDeviceAttributeMultiprocessorCount, dev) != hipSuccess) { grid = -1; return; }
        if (hipFuncSetAttribute((const void*)mk_fwd, hipFuncAttributeMaxDynamicSharedMemorySize, LDS_BYTES) != hipSuccess) { fprintf(stderr, "kernel_launch: hipFuncSetAttribute failed\n"); grid = -1; return; }
        if (hipOccupancyMaxActiveBlocksPerMultiprocessor(&per_cu, (const void*)mk_fwd, 512, LDS_BYTES) != hipSuccess || per_cu < 1) { fprintf(stderr, "kernel_launch: occupancy query says %d\n", per_cu); (void)hipGetLastError(); grid = -1; return; }
        grid = cus;
    }
    if (grid < 0) return;
    (void)hipMemsetAsync((char*)d_ws + WS_CTL, 0, CTL_BYTES, stream);
    Args a{};
    for (int i = 0; i < 34; ++i) a.in[i] = (const float*)d_in[i];
    a.out = (float*)d_out; a.ws = (uchar*)d_ws;
#if MK_PER_PHASE
    for (int p = 0; p < NPHASE; ++p) { a.ph_lo = p; a.ph_hi = p + 1; hipLaunchKernelGGL(mk_fwd, dim3(grid), dim3(512), LDS_BYTES, stream, a); }
#else
    a.ph_lo = 0; a.ph_hi = NPHASE;
    void* kargs[] = {&a};
    hipError_t e = hipLaunchCooperativeKernel((const void*)mk_fwd, dim3(grid), dim3(512), kargs, LDS_BYTES, stream);
    if (e != hipSuccess) fprintf(stderr, "kernel_launch: cooperative launch failed: %s (grid %d)\n", hipGetErrorString(e), grid);
#endif
}
```

```cpp
#include <hip/hip_runtime.h>
#include <hip/hip_bf16.h>
#include <cstdio>
#include <cstdint>

#ifndef X_BF16
#define X_BF16 1
#endif
#ifndef Y_FP8
#define Y_FP8 1
#endif
#ifndef MOE_FP8
#define MOE_FP8 1
#endif
#ifndef MK_PER_PHASE
#define MK_PER_PHASE 0
#endif

#ifndef PHASE_MASK
#define PHASE_MASK 0xFFFFFFFFu
#endif
#ifndef REP_MASK
#define REP_MASK 0u
#endif
#define REPN(i) ((((REP_MASK) >> (i)) & 1u) ? 2 : 1)
#define PM(i) if constexpr ((PHASE_MASK >> (i)) & 1u) for (int rep_ = REPN(i); rep_ > 0; --rep_)
#define LAS __attribute__((address_space(3)))
#define GAS __attribute__((address_space(1)))
typedef unsigned char uchar;
typedef unsigned short bf16_t;
typedef short bf16x8 __attribute__((ext_vector_type(8)));
typedef short s16x4 __attribute__((ext_vector_type(4)));
typedef float f32x4 __attribute__((ext_vector_type(4)));
typedef float f32x2 __attribute__((ext_vector_type(2)));
typedef float f32x16 __attribute__((ext_vector_type(16)));
typedef unsigned u32x4 __attribute__((ext_vector_type(4)));
typedef unsigned u32x2 __attribute__((ext_vector_type(2)));
typedef GAS unsigned gu32;
#define RLX_AGENT __ATOMIC_RELAXED, __HIP_MEMORY_SCOPE_AGENT

constexpr int D = 1024, NB = 4, SEQ = 4096, CTX = 256, SB = SEQ + CTX, T = NB * SB, DEPTH = 4;
constexpr int NMODV = 6 * D;
constexpr int NEXP = 32, DEXP = 512;
constexpr int NCH = SB / 16;
constexpr float NORM_EPS = 1e-6f;

constexpr size_t MiB = 1u << 20;
constexpr size_t WS_CTL = 0, CTL_BYTES = 1 * MiB;
constexpr size_t WS_MOD = 1 * MiB;
constexpr size_t WS_ROPE = 2 * MiB;
constexpr size_t WS_SPL = 2 * MiB + 65536;
constexpr size_t WS_BK2 = 3 * MiB;
constexpr size_t WS_TOT = 3 * MiB;
constexpr size_t WS_STATP = 8 * MiB;
constexpr size_t WS_BK = 13 * MiB;
constexpr size_t WS_TW = 15 * MiB + 512 * 1024;
constexpr size_t WS_W_RGIN = 16 * MiB, WS_W_RGG = 24 * MiB, WS_W_RGOUT = 26 * MiB, WS_W_QKV = 30 * MiB, WS_W_AO = 33 * MiB;
constexpr size_t WS_W_CMIN = 35 * MiB, WS_W_CMS = 43 * MiB, WS_W_CMOUT = 44 * MiB, WS_W_E1 = 48 * MiB, WS_W_E2 = 304 * MiB;
constexpr size_t WS_X = 432 * MiB, WS_Y1 = 500 * MiB, WS_H = 568 * MiB, WS_SCR = 602 * MiB;
constexpr size_t WS_GG = WS_SCR, WS_XB = WS_SCR + 34 * MiB, WS_XC = WS_SCR + 68 * MiB, WS_LA = WS_SCR + 102 * MiB, WS_BB = WS_SCR + 170 * MiB, WS_SA = WS_SCR + 238 * MiB;
constexpr size_t WS_QKV = WS_SCR, WS_AO = WS_SCR + 51 * MiB;
constexpr size_t WS_UVB = WS_SCR, WS_UV = WS_SCR + 136 * MiB;
constexpr size_t WS_H1 = WS_SCR;
constexpr size_t WS_TOTS = WS_SCR + 272 * MiB, WS_TOTH = WS_TOTS + 9 * MiB, WS_CARRY = WS_TOTH + 9 * MiB;
constexpr size_t WS_YM = WS_CARRY + 9 * MiB;
constexpr size_t WS_END = WS_YM + 34 * MiB;
constexpr int CW_TMO = 0, CW_BAR = 4096, CW_CNT = 16384;

constexpr int RING_BYTES = 131072;
constexpr int ROUTER_LDS = 36 * 1024 * 4;
constexpr int LDSCTL_OFF = 147456;
constexpr int LDS_BYTES = LDSCTL_OFF + 1024 + 8 * 4 * 40 * 4;

typedef float f32x2_t_ __attribute__((ext_vector_type(2))); typedef __bf16 bf16x2_t_ __attribute__((ext_vector_type(2)));
__device__ __forceinline__ unsigned pk2(float lo, float hi) { const f32x2_t_ v = {lo, hi}; const bf16x2_t_ b = __builtin_convertvector(v, bf16x2_t_); return __builtin_bit_cast(unsigned, b); }
__device__ __forceinline__ unsigned f2bf(float f) { return pk2(f, 0.f) & 0xffffu; }
__device__ __forceinline__ float bf2f(unsigned short h) { return __builtin_bit_cast(float, (unsigned)h << 16); }
__device__ __forceinline__ float bflo(unsigned w) { return __builtin_bit_cast(float, w << 16); }
__device__ __forceinline__ float bfhi(unsigned w) { return __builtin_bit_cast(float, w & 0xffff0000u); }
__device__ __forceinline__ unsigned cvt_pk_bf16(float lo, float hi) { return pk2(lo, hi); }
__device__ __forceinline__ f32x4 fp8x4_to_f32(unsigned w) { const f32x2 lo = __builtin_amdgcn_cvt_pk_f32_fp8((int)w, false), hi = __builtin_amdgcn_cvt_pk_f32_fp8((int)w, true); return (f32x4){lo.x, lo.y, hi.x, hi.y}; }
__device__ __forceinline__ float gelu_tanh(float x) { const float u2 = (-2.f * 0.7978845608028654f) * (x + 0.044715f * x * x * x); return x * __builtin_amdgcn_rcpf(1.f + __expf(u2)); }
__device__ __forceinline__ float sigmoidf_(float x) { return 1.f / (1.f + __expf(-x)); }
__device__ __forceinline__ float fast_sigmoid(float x) { return __builtin_amdgcn_rcpf(1.f + __expf(-x)); }
__device__ __forceinline__ float one_minus_exp(float y) {   const float p = y * (1.f - y * (0.5f - y * (0.16666667f - y * 0.041666667f))); const float q = 1.f - __expf(-y); return y < 0.0625f ? p : q; }
__device__ __forceinline__ int sidx_of_row(int row) { const int b = row / SB; return (row - b * SB) < CTX ? 4 : b; }

namespace pg8 {
constexpr int BM = 256, BK = 64, HALF = 128, HTB = HALF * BK * 2, NXCD = 8, WGM = 8;
__device__ __forceinline__ int lds_byte(int r, int c) { const int st = (r >> 4) * 2 + (c >> 5), rr = r & 15, cc = c & 31, ob = rr * 64 + cc * 2; return st * 1024 + (ob ^ (((ob >> 9) & 1) << 5)); }
__device__ __forceinline__ void stage_rc(int b, int& R, int& C) { const int st = b / 1024, sb = b % 1024, swz = sb ^ (((sb >> 9) & 1) << 5); R = (st >> 1) * 16 + swz / 64; C = (st & 1) * 32 + (swz % 64) / 2; }
__device__ __forceinline__ int perm32(int rho) { const int n = rho >> 4, i = rho & 15; return 8 * (i >> 2) + 4 * n + (i & 3); }
struct Unit { const char* a; const char* b; int pm, pn, aux0, aux1, hm; };
__device__ __forceinline__ const char* uptr(const char* p) { const unsigned long long v = (unsigned long long)p; const unsigned lo = __builtin_amdgcn_readfirstlane((unsigned)v), hi = __builtin_amdgcn_readfirstlane((unsigned)(v >> 32)); return (const char*)(const GAS char*)(((unsigned long long)hi << 32) | lo); }
__device__ __forceinline__ bool unit_slot(int i, int c, int G, int nwg, int& L, int& hm) {
    if (c >= G) return false;
    const int nfull = nwg / G, rem = nwg - nfull * G;
    if (i < nfull) { L = i * G + c; hm = 0xF; return true; }
    if (i > nfull || rem == 0) return false;
    if (rem * 2 <= G) { if (c >= 2 * rem) return false; L = nfull * G + (c >> 1); hm = (c & 1) ? 0xC : 0x3; return true; }
    if (c >= rem) return false; L = nfull * G + c; hm = 0xF; return true; }
__device__ __forceinline__ int xcd_remap(int L, int nwg) { const int q = nwg / NXCD, r = nwg % NXCD, xcd = L % NXCD, off = L / NXCD; return (xcd < r ? xcd * (q + 1) : r * (q + 1) + (xcd - r) * q) + off; }

template <bool LATENT>
struct DenseOrderT {
    static constexpr bool GATHER = false;
    const char* A; const char* B; int nM, nN, nwg, G, c; size_t tA, tB; int amask, acol;
    __device__ void init(const void* A_, int lda, const void* B_, int ldb, int M, int N, int G_, int c_, int amask_ = 0, int acol_ = 0) {
        A = (const char*)A_; B = (const char*)B_; nM = LATENT ? 64 : M / BM; nN = N / BM; nwg = nM * nN; G = G_; c = c_; tA = (size_t)BM * lda * 2; tB = (size_t)BM * ldb * 2; amask = amask_; acol = acol_; }
    __device__ bool next(int i, Unit& u) const {
        int L, hm; if (!unit_slot(i, c, G, nwg, L, hm)) return false; u.hm = __builtin_amdgcn_readfirstlane(hm);
        const int wgid = xcd_remap(L, nwg);
        const int nig = WGM * nN, gid = wgid / nig, fm = gid * WGM, gsz = (nM - fm) < WGM ? (nM - fm) : WGM;
        int pm_ = fm + ((wgid % nig) % gsz); if constexpr (LATENT) pm_ = (pm_ >> 4) * 17 + 1 + (pm_ & 15);
        u.pm = __builtin_amdgcn_readfirstlane(pm_); u.pn = __builtin_amdgcn_readfirstlane((wgid % nig) / gsz); u.aux0 = 0; u.aux1 = 0;
        u.a = uptr(A + (size_t)u.pm * tA + (size_t)(u.pn & amask) * acol); u.b = uptr(B + (size_t)u.pn * tB); return true; }
    __device__ unsigned goff(const Unit&, int) const { return 0u; }
};
typedef DenseOrderT<false> DenseOrder;

#define PG8_SA(b, h) (((b) * 2 + (h)) * HTB)
#define PG8_SB(b, h) ((4 + (b) * 2 + (h)) * HTB)
__device__ __forceinline__ void glds16(const char* sbase, unsigned voff, unsigned ldsaddr) { unsigned keep;
    asm volatile("s_mov_b32 %0, m0\n\ts_mov_b32 m0, %3\n\ts_nop 0\n\tglobal_load_lds_dwordx4 %1, %2\n\ts_mov_b32 m0, %0" : "=&s"(keep) : "v"(voff), "s"(sbase), "s"(ldsaddr) : "memory"); }
#ifndef PG8_ASM_DMA
#define PG8_ASM_DMA 1
#endif
#if PG8_ASM_DMA
#define PG8_GLDS(gp, voff, ldsoff) glds16((const char*)(gp), (voff), ldsbase + (unsigned)(ldsoff))
#else
#define PG8_GLDS(gp, voff, ldsoff) __builtin_amdgcn_global_load_lds((const unsigned*)((const char*)(gp) + (voff)), (LAS unsigned*)(lds + (ldsoff)), 16, 0, 0)
#endif
#define PG8_STAGE_B(bufoff, gbase) do { PG8_GLDS(gbase, voffB[0], (bufoff) + ldsw); PG8_GLDS(gbase, voffB[1], (bufoff) + ldsw + 8192); } while (0)
#define PG8_STAGE_A(bufoff, gbase, h, NX) do { if constexpr (Sched::GATHER) { \
        PG8_GLDS(gbase, ((NX) ? vAn[h][0] : vAc[h][0]), (bufoff) + ldsw); PG8_GLDS(gbase, ((NX) ? vAn[h][1] : vAc[h][1]), (bufoff) + ldsw + 8192); \
    } else { PG8_GLDS((const char*)(gbase) + (h) * hstepA, voffA[0], (bufoff) + ldsw); PG8_GLDS((const char*)(gbase) + (h) * hstepA, voffA[1], (bufoff) + ldsw + 8192); } } while (0)
#define PG8_LDA(dst, b, h) do { _Pragma("unroll") for (int m = 0; m < 4; ++m) _Pragma("unroll") for (int k = 0; k < 2; ++k) dst[m][k] = *(const LAS bf16x8*)(lds + PG8_SA(b, h) + aoff + m * 2048 + k * 1024); } while (0)
#define PG8_LDB(dst, b, h) do { _Pragma("unroll") for (int n = 0; n < 2; ++n) _Pragma("unroll") for (int k = 0; k < 2; ++k) dst[n][k] = *(const LAS bf16x8*)(lds + PG8_SB(b, h) + boff + n * 2048 + k * 1024); } while (0)
typedef int i32x8 __attribute__((ext_vector_type(8))); typedef int i32x4v __attribute__((ext_vector_type(4)));
__device__ __forceinline__ i32x8 cat8(bf16x8 lo, bf16x8 hi) { return __builtin_shufflevector(__builtin_bit_cast(i32x4v, lo), __builtin_bit_cast(i32x4v, hi), 0, 1, 2, 3, 4, 5, 6, 7); }
#define PG8_MMA(ai, bj, At, Bt) do { __builtin_amdgcn_s_setprio(1); _Pragma("unroll") for (int m = 0; m < 4; ++m) _Pragma("unroll") for (int n = 0; n < 2; ++n) { \
        if constexpr (Epi::FP8) { asm volatile("v_mfma_scale_f32_16x16x128_f8f6f4 %0, %1, %2, %0, %3, %3 op_sel_hi:[0,0,0]" : "+v"(acc[ai][bj][m][n]) : "v"(cat8(Bt[n][0], Bt[n][1])), "v"(cat8(At[m][0], At[m][1])), "v"(0x7F7F7F7F)); } \
        else { _Pragma("unroll") for (int k = 0; k < 2; ++k) acc[ai][bj][m][n] = __builtin_amdgcn_mfma_f32_16x16x32_bf16(Bt[n][k], At[m][k], acc[ai][bj][m][n], 0, 0, 0); } } __builtin_amdgcn_s_setprio(0); } while (0)
#define PG8_WAIT_V(n) asm volatile("s_waitcnt vmcnt(" #n ")" ::: "memory")
#define PG8_WAIT_L(n) asm volatile("s_waitcnt lgkmcnt(" #n ")" ::: "memory")
#define PG8_BAR __builtin_amdgcn_s_barrier()
#define PG8_SCHED __builtin_amdgcn_sched_barrier(0)

template <class Epi, class Sched>
__device__ __forceinline__ void gemm_phase(LAS uchar* lds, const Sched& S, const Epi& E, const int K, const int lda, const int ldb) {
    int tid = threadIdx.x; asm volatile("" : "+v"(tid));
    const int wid = __builtin_amdgcn_readfirstlane(tid >> 6), lane = tid & 63, wr = wid >> 2, wc = wid & 3; int fr = lane & 15, fq = lane >> 4;
    int nt = K / BK; asm volatile("" : "+s"(nt));
    unsigned voffA[2], voffB[2];
#pragma unroll
    for (int i = 0; i < 2; ++i) { int R, C; stage_rc(tid * 16 + i * 8192, R, C); const int Rb = Epi::PERM ? ((R & ~31) + perm32(R & 31)) : R;
        voffA[i] = (unsigned)(R * lda + C) * 2u; voffB[i] = (unsigned)(Rb * ldb + C) * 2u; }
    const size_t kstep = (size_t)(BK * 2);
    const size_t hstepA = (size_t)HALF * lda * 2, hstepB = (size_t)HALF * ldb * 2;
    const unsigned ldsw = (unsigned)wid * 1024u;
    const unsigned ldsbase = (unsigned)(uintptr_t)lds;
    const int aoff = lds_byte(wr * 64 + fr, fq * 8), boff = lds_byte(wc * 32 + fr, fq * 8);
    Unit cur, nxt; int ui = 0;
    if (!S.next(0, cur)) return;
    unsigned vAc[2][2], vAn[2][2];
#pragma unroll
    for (int h = 0; h < 2; ++h)
#pragma unroll
        for (int i = 0; i < 2; ++i) { vAc[h][i] = 0u; vAn[h][i] = 0u; }
    if constexpr (Sched::GATHER) {
#pragma unroll
        for (int h = 0; h < 2; ++h)
#pragma unroll
            for (int i = 0; i < 2; ++i) { int R, C; stage_rc(tid * 16 + i * 8192, R, C); vAc[h][i] = S.goff(cur, h * HALF + R) + (unsigned)C * 2u; }
    }
    f32x4 acc[2][2][4][2];
#pragma unroll
    for (int a = 0; a < 2; ++a)
#pragma unroll
        for (int b = 0; b < 2; ++b)
#pragma unroll
            for (int m = 0; m < 4; ++m)
#pragma unroll
                for (int n = 0; n < 2; ++n) acc[a][b][m][n] = (f32x4){0.f, 0.f, 0.f, 0.f};
    bf16x8 At[4][2], B0[2][2], B1[2][2];
    typedef int pre_t __attribute__((ext_vector_type(16))); pre_t pre = {};
    if constexpr (Epi::PREFETCH) pre = E.prefetch(cur, wr, fr);
    const char* cA = cur.a; const char* cB = cur.b;
    PG8_STAGE_B(PG8_SB(0, 0), cB); PG8_STAGE_B(PG8_SB(0, 1), cB + hstepB); PG8_STAGE_A(PG8_SA(0, 0), cA, 0, false); PG8_STAGE_A(PG8_SA(0, 1), cA, 1, false);
    if (wr == 1) PG8_BAR;
    PG8_WAIT_V(2); PG8_BAR;
    PG8_STAGE_B(PG8_SB(1, 0), cB + kstep); PG8_STAGE_A(PG8_SA(1, 0), cA + kstep, 0, false); PG8_STAGE_B(PG8_SB(1, 1), cB + hstepB + kstep);
    PG8_WAIT_V(6); PG8_BAR;
    for (;;) {
        const bool has_next = S.next(ui + 1, nxt);
        if constexpr (Sched::GATHER) { if (has_next) {
#pragma unroll
            for (int h = 0; h < 2; ++h)
#pragma unroll
                for (int i = 0; i < 2; ++i) { int R, C; int t2 = tid; asm volatile("" : "+v"(t2)); stage_rc(t2 * 16 + i * 8192, R, C); vAn[h][i] = S.goff(nxt, h * HALF + R) + (unsigned)C * 2u; }
            *(LAS u32x4*)(lds + 131072 + tid * 16) = (u32x4){vAn[0][0], vAn[0][1], vAn[1][0], vAn[1][1]}; } }
        const char* nA = has_next ? nxt.a : cA; const char* nB = has_next ? nxt.b : cB;
        for (int t = 0; t < nt; t += 2) {
            const bool last = (t == nt - 2);
            const bool nx = last && has_next;
            if constexpr (Sched::GATHER) { if (nx) { const u32x4 pk_ = *(const LAS u32x4*)(lds + 131072 + tid * 16); vAn[0][0] = pk_.x; vAn[0][1] = pk_.y; vAn[1][0] = pk_.z; vAn[1][1] = pk_.w; } }
            const char* a1 = cA + (size_t)(t + 1) * kstep;
            const char* a2 = last ? nA : cA + (size_t)(t + 2) * kstep; const char* b2 = last ? nB : cB + (size_t)(t + 2) * kstep;
            const char* a3 = a2 + kstep; const char* b3 = b2 + kstep;
            PG8_LDB(B0, 0, 0); PG8_LDB(B1, 0, 1); PG8_SCHED; PG8_LDA(At, 0, 0); PG8_STAGE_A(PG8_SA(1, 1), a1, 1, false);
            PG8_WAIT_V(8); PG8_WAIT_L(0); PG8_BAR; if (cur.hm & 1) { PG8_MMA(0, 0, At, B0); PG8_MMA(0, 1, At, B1); } PG8_BAR; PG8_SCHED;
            PG8_LDA(At, 0, 1); PG8_STAGE_B(PG8_SB(0, 0), b2); PG8_STAGE_B(PG8_SB(0, 1), b2 + hstepB); PG8_STAGE_A(PG8_SA(0, 0), a2, 0, nx);
            PG8_WAIT_V(8); PG8_WAIT_L(0); PG8_BAR; if (cur.hm & 4) { PG8_MMA(1, 0, At, B0); PG8_MMA(1, 1, At, B1); } PG8_BAR; PG8_SCHED;
            PG8_LDB(B0, 1, 0); PG8_LDB(B1, 1, 1); PG8_SCHED; PG8_LDA(At, 1, 0); PG8_STAGE_A(PG8_SA(0, 1), a2, 1, nx);
            PG8_WAIT_V(8); PG8_WAIT_L(0); PG8_BAR; if (cur.hm & 1) { PG8_MMA(0, 0, At, B0); PG8_MMA(0, 1, At, B1); } PG8_BAR; PG8_SCHED;
            PG8_LDA(At, 1, 1); PG8_STAGE_B(PG8_SB(1, 0), b3); PG8_STAGE_B(PG8_SB(1, 1), b3 + hstepB); PG8_STAGE_A(PG8_SA(1, 0), a3, 0, nx);
            PG8_WAIT_V(8); PG8_WAIT_L(0); PG8_BAR; if (cur.hm & 4) { PG8_MMA(1, 0, At, B0); PG8_MMA(1, 1, At, B1); } PG8_BAR; PG8_SCHED;
        }
        if (wr == 0) PG8_BAR;
        if constexpr (Epi::FP8) asm volatile("s_nop 15\n\ts_nop 15" ::: "memory");
        if constexpr (Epi::PREFETCH) E(acc, cur, wr, wc, fr, fq, pre); else E(acc, cur, wr, wc, fr, fq);
        if (!has_next) break;
#pragma unroll
        for (int a = 0; a < 2; ++a)
#pragma unroll
            for (int b = 0; b < 2; ++b)
#pragma unroll
                for (int m = 0; m < 4; ++m)
#pragma unroll
                    for (int n = 0; n < 2; ++n) acc[a][b][m][n] = (f32x4){0.f, 0.f, 0.f, 0.f};
        cur = nxt; cA = nA; cB = nB; ++ui;
        if constexpr (Epi::PREFETCH) pre = E.prefetch(cur, wr, fr);
        if constexpr (Sched::GATHER) {
#pragma unroll
            for (int h = 0; h < 2; ++h)
#pragma unroll
                for (int i = 0; i < 2; ++i) vAc[h][i] = vAn[h][i]; }
        if (wr == 1) PG8_BAR;
    }
    PG8_WAIT_V(0);
    PG8_BAR;
}
}

#ifndef ATT_SDEPTH
#define ATT_SDEPTH 1
#endif
namespace att {
constexpr int NW = 8, QBLK = 32, KVBLK = 64;
constexpr float SCALE = 0.088388347648318440f;
constexpr float THR = 8.f;
constexpr int LDQ = 1536, LDK = 1536, LDO = 1024;
constexpr size_t SHM_V = KVBLK * 128 * 2, SHM_K = KVBLK * 128 * 2, SHM_ATTN = 2 * SHM_V + 2 * SHM_K + NW * 64 * 4;
#define KSWZ(row, colB) ((row) * 256 + ((colB) ^ (((row) & 7) << 4)))
#define SBAR() __builtin_amdgcn_sched_barrier(0)
__device__ __forceinline__ int crow(int r, int hi) { return (r & 3) + 8 * (r >> 2) + 4 * hi; }
__device__ __forceinline__ void partialSM(f32x16& p0, f32x16& p1, float& m_reg, float& mn, float& alpha) {
  constexpr float C = SCALE * 1.4426950408889634f;
  float pmax = p0[0];
#pragma unroll
  for (int r = 1; r < 16; ++r) pmax = fmaxf(pmax, p0[r]);
#pragma unroll
  for (int r = 0; r < 16; ++r) pmax = fmaxf(pmax, p1[r]);
  { auto rr = __builtin_amdgcn_permlane32_swap(__float_as_uint(pmax), __float_as_uint(pmax), false, false);
    pmax = fmaxf(__uint_as_float(rr[0]), __uint_as_float(rr[1])); }
  if (__builtin_expect(__all(pmax - m_reg <= THR / SCALE), 1)) { mn = m_reg; alpha = 1.f; }
  else { mn = fmaxf(m_reg, pmax); alpha = __builtin_amdgcn_exp2f((m_reg - mn) * C); m_reg = mn; }
  float mnC = -mn * C;
#pragma unroll
  for (int r = 0; r < 16; ++r) p0[r] = fmaf(p0[r], C, mnC);
#pragma unroll
  for (int r = 0; r < 16; ++r) p1[r] = fmaf(p1[r], C, mnC);
#pragma unroll
  for (int r = 0; r < 16; ++r) p0[r] = __builtin_amdgcn_exp2f(p0[r]);
}
__device__ __forceinline__ void finishSM(f32x16& p0, f32x16& p1, float alpha, float& l_reg, bf16x8& pa0, bf16x8& pa1, bf16x8& pa2, bf16x8& pa3) {
#pragma unroll
  for (int r = 0; r < 16; ++r) p1[r] = __builtin_amdgcn_exp2f(p1[r]);
  float ps = 0;
#pragma unroll
  for (int r = 0; r < 16; ++r) ps += p0[r];
#pragma unroll
  for (int r = 0; r < 16; ++r) ps += p1[r];
  { auto rr = __builtin_amdgcn_permlane32_swap(__float_as_uint(ps), __float_as_uint(ps), false, false);
    ps = __uint_as_float(rr[0]) + __uint_as_float(rr[1]); }
  l_reg = l_reg * alpha + ps;
#define PK4(P, BASE, OUT) do { unsigned a0 = cvt_pk_bf16(P[BASE + 0], P[BASE + 1]), a1 = cvt_pk_bf16(P[BASE + 2], P[BASE + 3]);   \
    unsigned b0 = cvt_pk_bf16(P[BASE + 4], P[BASE + 5]), b1 = cvt_pk_bf16(P[BASE + 6], P[BASE + 7]);                              \
    auto r0 = __builtin_amdgcn_permlane32_swap(a0, b0, false, false); auto r1 = __builtin_amdgcn_permlane32_swap(a1, b1, false, false); \
    u32x4 w = {r0[0], r1[0], r0[1], r1[1]}; OUT = __builtin_bit_cast(bf16x8, w); } while (0)
  PK4(p0, 0, pa0); PK4(p0, 8, pa1); PK4(p1, 0, pa2); PK4(p1, 8, pa3);
#undef PK4
}
__device__ __forceinline__ void qkt(f32x16& p0, f32x16& p1, const bf16_t* Ks, const bf16x8* qr, int r32, int hi) {
  p0 = f32x16{}; p1 = f32x16{};
#pragma unroll
  for (int d0 = 0; d0 < 8; ++d0) { int cb = (d0 * 16 + hi * 8) * 2;
    bf16x8 b0 = *reinterpret_cast<const bf16x8*>((const char*)Ks + KSWZ(r32, cb));
    bf16x8 b1 = *reinterpret_cast<const bf16x8*>((const char*)Ks + KSWZ(32 + r32, cb));
    p0 = __builtin_amdgcn_mfma_f32_32x32x16_bf16(b0, qr[d0], p0, 0, 0, 0);
    p1 = __builtin_amdgcn_mfma_f32_32x32x16_bf16(b1, qr[d0], p1, 0, 0, 0); }
}
__device__ __forceinline__ int v_st(int k, int c) { const int kk = (k & ~0xC) | ((k & 4) << 1) | ((k & 8) >> 1); return ((kk >> 3) * 4 + (c >> 5)) * 512 + ((kk & 7) * 32 + (c & 31)) * 2; }
__device__ __forceinline__ int v_rd_base(int lane) { return ((lane & 3) << 3) | (((lane >> 2) & 3) << 6) | (((lane >> 4) & 1) << 5) | (((lane >> 5) & 1) << 8); }
constexpr int v_rd_off(int d0, int ks, int half) { return d0 * 512 + ks * 4096 + half * 2048; }
template <int OFF> __device__ __forceinline__ s16x4 tr_read(int vb) {
  s16x4 r; asm volatile("ds_read_b64_tr_b16 %0, %1 offset:%2" : "=&v"(r) : "v"(vb), "i"(OFF) : "memory"); return r;
}
template <int D0> __device__ __forceinline__ void pv_one(f32x16& od, int vb, bf16x8 pa0, bf16x8 pa1, bf16x8 pa2, bf16x8 pa3) {
  const s16x4 l0 = tr_read<v_rd_off(D0, 0, 0)>(vb), h0 = tr_read<v_rd_off(D0, 0, 1)>(vb), l1 = tr_read<v_rd_off(D0, 1, 0)>(vb), h1 = tr_read<v_rd_off(D0, 1, 1)>(vb);
  const s16x4 l2 = tr_read<v_rd_off(D0, 2, 0)>(vb), h2 = tr_read<v_rd_off(D0, 2, 1)>(vb), l3 = tr_read<v_rd_off(D0, 3, 0)>(vb), h3 = tr_read<v_rd_off(D0, 3, 1)>(vb);
  asm volatile("s_waitcnt lgkmcnt(0)" ::: "memory"); SBAR();
#define PK(L, H) (bf16x8){L[0], L[1], L[2], L[3], H[0], H[1], H[2], H[3]}
  od = __builtin_amdgcn_mfma_f32_32x32x16_bf16(pa0, PK(l0, h0), od, 0, 0, 0);
  od = __builtin_amdgcn_mfma_f32_32x32x16_bf16(pa1, PK(l1, h1), od, 0, 0, 0);
  od = __builtin_amdgcn_mfma_f32_32x32x16_bf16(pa2, PK(l2, h2), od, 0, 0, 0);
  od = __builtin_amdgcn_mfma_f32_32x32x16_bf16(pa3, PK(l3, h3), od, 0, 0, 0);
#undef PK
}
__device__ __forceinline__ void pv_d0(f32x16* o, int vb, bf16x8 pa0, bf16x8 pa1, bf16x8 pa2, bf16x8 pa3) {
  pv_one<0>(o[0], vb, pa0, pa1, pa2, pa3); pv_one<1>(o[1], vb, pa0, pa1, pa2, pa3); pv_one<2>(o[2], vb, pa0, pa1, pa2, pa3); pv_one<3>(o[3], vb, pa0, pa1, pa2, pa3);
}
__device__ __forceinline__ void attn_dense_body(const bf16_t* Qb, const bf16_t* Kh, const bf16_t* Vh, bf16_t* Ob, int seq, char* lds, const int tid) {
  const int wid = tid >> 6, lane = tid & 63, r32 = lane & 31, hi = lane >> 5;
  bf16_t* V_lds = (bf16_t*)lds; bf16_t* K_lds = (bf16_t*)(lds + 2 * SHM_V);
  float* ws = (float*)(lds + 2 * SHM_V + 2 * SHM_K) + wid * 64; float* li_l = ws; float* al_l = ws + 32;
  float m_reg = -1e30f, l_reg = 0; f32x16 o[4] = {}; bf16x8 qr[8];
  const bf16_t* Qw = Qb + (long)(wid * QBLK + r32) * LDQ + hi * 8;
#pragma unroll
  for (int d0 = 0; d0 < 8; ++d0) qr[d0] = *reinterpret_cast<const bf16x8*>(Qw + d0 * 16);
  const int sr = tid >> 4, sc = (tid & 15) * 8, vst0 = v_st(sr, sc), vst1 = v_st(32 + sr, sc);
  const int vb0 = (int)(uintptr_t)V_lds + v_rd_base(lane);
  struct { bf16x8 vs0, vs1, ks0, ks1; } sr_[ATT_SDEPTH];
  const unsigned vo0 = (unsigned)(sr * LDK + sc) * 2u, vo1 = (unsigned)((32 + sr) * LDK + sc) * 2u;
  const long vdelta = (const char*)Vh - (const char*)Kh;
#define SLOAD(i, k0) do { const char* kb_ = (const char*)Kh + (size_t)(k0) * (LDK * 2); const char* vb_ = kb_ + vdelta; \
    sr_[i].vs0 = *reinterpret_cast<const bf16x8*>(vb_ + vo0); sr_[i].vs1 = *reinterpret_cast<const bf16x8*>(vb_ + vo1); \
    sr_[i].ks0 = *reinterpret_cast<const bf16x8*>(kb_ + vo0); sr_[i].ks1 = *reinterpret_cast<const bf16x8*>(kb_ + vo1); } while (0)
#define SWRITE(b, i) do { *(bf16x8*)((char*)V_lds + (b) * SHM_V + vst0) = sr_[i].vs0;          \
    *(bf16x8*)((char*)V_lds + (b) * SHM_V + vst1) = sr_[i].vs1; int kc = sc * 2;               \
    *(bf16x8*)((char*)K_lds + (b) * SHM_K + KSWZ(sr, kc)) = sr_[i].ks0;                       \
    *(bf16x8*)((char*)K_lds + (b) * SHM_K + KSWZ(32 + sr, kc)) = sr_[i].ks1; } while (0)
#define SWAIT() do { if constexpr (ATT_SDEPTH == 2) asm volatile("s_waitcnt vmcnt(4)" ::: "memory"); else asm volatile("s_waitcnt vmcnt(0)" ::: "memory"); } while (0)
#define RESC(a) do { if (__any((a) < 1.f)) { if (hi == 0) al_l[r32] = (a); asm volatile("s_waitcnt lgkmcnt(0)" ::: "memory"); \
    _Pragma("unroll") for (int d = 0; d < 4; ++d) _Pragma("unroll") for (int r = 0; r < 16; ++r) o[d][r] *= al_l[crow(r, hi)]; } } while (0)
  f32x16 pA0, pA1, pB0, pB1; float mnA, mnB, alA, alB; bf16x8 pa0, pa1, pa2, pa3; const int NT = seq / KVBLK;
  constexpr int SE = 0, SO = ATT_SDEPTH - 1;
  SLOAD(SE, 0); asm volatile("s_waitcnt vmcnt(0)" ::: "memory"); SWRITE(0, SE); __syncthreads();
  qkt(pA0, pA1, K_lds, qr, r32, hi); partialSM(pA0, pA1, m_reg, mnA, alA);
  SLOAD(SO, KVBLK); if constexpr (ATT_SDEPTH == 2) { if (2 < NT) SLOAD(SE, 2 * KVBLK); }
  SWAIT(); SWRITE(1, SO); __syncthreads();
  for (int j = 1; j + 1 < NT; j += 2) {
    SBAR(); qkt(pB0, pB1, (bf16_t*)((char*)K_lds + SHM_K), qr, r32, hi);
    finishSM(pA0, pA1, alA, l_reg, pa0, pa1, pa2, pa3); SBAR();
    SLOAD(SO, (j + ATT_SDEPTH) * KVBLK); SBAR();
    pv_d0(o, vb0, pa0, pa1, pa2, pa3); partialSM(pB0, pB1, m_reg, mnB, alB);
    __syncthreads(); SWAIT(); SWRITE(0, SE);
    RESC(alB); __syncthreads();
    SBAR(); qkt(pA0, pA1, K_lds, qr, r32, hi);
    finishSM(pB0, pB1, alB, l_reg, pa0, pa1, pa2, pa3); SBAR();
    if (ATT_SDEPTH == 1 || j + 3 < NT) SLOAD(SE, (j + 1 + ATT_SDEPTH) * KVBLK); SBAR();
    pv_d0(o, vb0 + (int)SHM_V, pa0, pa1, pa2, pa3); partialSM(pA0, pA1, m_reg, mnA, alA);
    __syncthreads(); SWAIT(); SWRITE(1, SO);
    RESC(alA); __syncthreads();
  }
  SBAR(); qkt(pB0, pB1, (bf16_t*)((char*)K_lds + SHM_K), qr, r32, hi);
  finishSM(pA0, pA1, alA, l_reg, pa0, pa1, pa2, pa3); SBAR();
  pv_d0(o, vb0, pa0, pa1, pa2, pa3); partialSM(pB0, pB1, m_reg, mnB, alB);
  __syncthreads(); RESC(alB);
  finishSM(pB0, pB1, alB, l_reg, pa0, pa1, pa2, pa3); SBAR();
  pv_d0(o, vb0 + (int)SHM_V, pa0, pa1, pa2, pa3);
  if (hi == 0) li_l[r32] = l_reg; asm volatile("s_waitcnt lgkmcnt(0)" ::: "memory");
  float rli[16];
#pragma unroll
  for (int r = 0; r < 16; ++r) rli[r] = __builtin_amdgcn_rcpf(li_l[crow(r, hi)]);
  bf16_t* Ow = Ob + (long)(wid * QBLK) * LDO;
#pragma unroll
  for (int r = 0; r < 16; ++r) { int orow = crow(r, hi);
#pragma unroll
    for (int d0 = 0; d0 < 4; ++d0) Ow[(long)orow * LDO + d0 * 32 + r32] = (bf16_t)f2bf(o[d0][r] * rli[r]); }
#undef SLOAD
#undef SWRITE
#undef SWAIT
#undef RESC
}
}

#define XB_TMO      128
#define XB_XCNT(j)  (256  + 64 * (j))
#define XB_XSUB(j)  (1280 + 64 * (j))
#define XB_XGEN(j)  (2304 + 64 * (j))
#define XB_TOP      3328
#define XB_TOPGEN   3392
#define XB_SPIN_CAP (1u << 22)
__device__ __forceinline__ unsigned xb_ld(unsigned* p)              { return __hip_atomic_load(p, __ATOMIC_RELAXED, __HIP_MEMORY_SCOPE_AGENT); }
__device__ __forceinline__ unsigned xb_add(unsigned* p, unsigned v) { return __hip_atomic_fetch_add(p, v, __ATOMIC_RELAXED, __HIP_MEMORY_SCOPE_AGENT); }
__device__ __forceinline__ unsigned xb_xcc_id() { return (unsigned)__builtin_amdgcn_s_getreg((3 << 11) | 20) & 0xFu; }
#define XB_SPIN(cond, bar) do { unsigned _sp = 0; while (cond) { __builtin_amdgcn_s_sleep(1); \
    if ((++_sp & 255u) == 0u) { if (xb_ld(&(bar)[XB_TMO])) break; if (_sp > XB_SPIN_CAP) { atomicAdd(&(bar)[XB_TMO], 1u); break; } } } } while (0)
struct XcdBarrier { unsigned* bar; unsigned x; volatile LAS unsigned* st; };
__device__ __forceinline__ XcdBarrier xcd_barrier_post(unsigned* bar, volatile LAS unsigned* st) {
    XcdBarrier b; b.bar = bar; b.x = xb_xcc_id(); b.st = st;
    if (threadIdx.x == 0) (void)xb_add(&bar[XB_XCNT(b.x)], 1u);
    return b;
}
__device__ __forceinline__ void xcd_barrier_complete(unsigned* bar, unsigned x, unsigned& nloc, unsigned& nx) {
    const unsigned G = gridDim.x * gridDim.y * gridDim.z;
    unsigned sum, cnt, mine, sp = 0u;
    for (;;) {
        sum = 0u; cnt = 0u; mine = 0u;
#pragma unroll
        for (unsigned j = 0; j < 16; ++j) { const unsigned c = xb_ld(&bar[XB_XCNT(j)]); sum += c; cnt += (c > 0u) ? 1u : 0u; mine = (j == x) ? c : mine; }
        if (sum == G) break;
        __builtin_amdgcn_s_sleep(1);
        if ((++sp & 255u) == 0u) { if (xb_ld(&bar[XB_TMO])) break; if (sp > XB_SPIN_CAP) { atomicAdd(&bar[XB_TMO], 1u); break; } }
    }
    nloc = mine > 0u ? mine : 1u; nx = cnt > 0u ? cnt : 1u;
}
__device__ __forceinline__ void xcd_barrier(const XcdBarrier& b_) {
    XcdBarrier b; b.bar = b_.bar; b.st = b_.st; b.x = xb_xcc_id();
    asm volatile("s_waitcnt vmcnt(0)" ::: "memory");
    __syncthreads();
    if (threadIdx.x == 0) {
        unsigned* bar = b.bar;
        __builtin_amdgcn_s_waitcnt(0);
        unsigned nloc = b.st[0], nx = b.st[1];
        if (nloc == 0u) { xcd_barrier_complete(bar, b.x, nloc, nx); b.st[0] = nloc; b.st[1] = nx; }
        const unsigned old = xb_add(&bar[XB_XSUB(b.x)], 1u);
        const unsigned gen = old / nloc;
        if (old + 1u == (gen + 1u) * nloc) {
            __builtin_amdgcn_fence(__ATOMIC_RELEASE, "agent");
            asm volatile("s_waitcnt vmcnt(0)" ::: "memory");
            const unsigned og = xb_add(&bar[XB_TOP], 1u);
            const unsigned tg = og / nx;
            if (og + 1u == (tg + 1u) * nx) xb_add(&bar[XB_TOPGEN], 1u);
            else XB_SPIN(xb_ld(&bar[XB_TOPGEN]) == tg, bar);
            __builtin_amdgcn_fence(__ATOMIC_ACQUIRE, "agent");
            xb_add(&bar[XB_XGEN(b.x)], 1u);
            asm volatile("s_waitcnt vmcnt(0)" ::: "memory");
        } else {
            XB_SPIN(xb_ld(&bar[XB_XGEN(b.x)]) == gen, bar);
            __builtin_amdgcn_fence(__ATOMIC_ACQUIRE, "agent");
            asm volatile("s_waitcnt vmcnt(0)" ::: "memory");
        }
    }
    __syncthreads();
}

struct Args { const float* in[34]; float* out; uchar* ws; int ph_lo, ph_hi; };
enum { I_X = 0, I_C, I_CTX, I_CCTX, I_ADAW, I_ADAB, I_NMG, I_NFG, I_RGWIN, I_RGCW, I_RGCB, I_RGWA, I_RGBA, I_RGWI, I_RGBI, I_RGLAM, I_RGWOUT,
       I_ATQKV, I_ATQG, I_ATKG, I_ATWO, I_CMWIN, I_CMLNG, I_CMLNB, I_CMWS, I_CMBS, I_CMWOUT, I_MWG, I_MBG, I_MWR, I_MBR, I_MWGATE, I_MWUP, I_MWDOWN };

__device__ __forceinline__ const void* opaque_uniform_ptr(const void* p) { const unsigned long long v = (unsigned long long)p; unsigned lo = (unsigned)v, hi = (unsigned)(v >> 32); asm volatile("" : "+v"(lo), "+v"(hi));
    lo = __builtin_amdgcn_readfirstlane(lo); hi = __builtin_amdgcn_readfirstlane(hi); return (const void*)(const GAS char*)(((unsigned long long)hi << 32) | lo); }
__device__ __forceinline__ int opaque_uniform_int(int x) { asm volatile("" : "+v"(x)); return __builtin_amdgcn_readfirstlane(x); }
struct Frame {
    LAS uchar* lds; char* ldsg;
    int tid, lane, wave, G, bid;
    uchar* ws; float* out;
};
__device__ __forceinline__ const float* inp(const Frame& F, int i) { const unsigned long long v = *(const LAS unsigned long long*)(F.lds + LDSCTL_OFF + 576 + i * 8);
    const unsigned lo = __builtin_amdgcn_readfirstlane((unsigned)v), hi = __builtin_amdgcn_readfirstlane((unsigned)(v >> 32)); return (const float*)(const GAS float*)(((unsigned long long)hi << 32) | lo); }
__device__ __forceinline__ float wave16_sum(float v) {
    v += __int_as_float(__builtin_amdgcn_update_dpp(0, __float_as_int(v), 0xB1, 0xF, 0xF, true));
    v += __int_as_float(__builtin_amdgcn_update_dpp(0, __float_as_int(v), 0x4E, 0xF, 0xF, true));
    v += __int_as_float(__builtin_amdgcn_update_dpp(0, __float_as_int(v), 0x141, 0xF, 0xF, true));
    v += __int_as_float(__builtin_amdgcn_update_dpp(0, __float_as_int(v), 0x140, 0xF, 0xF, true));
    return v; }

struct ConvItem { const float* src; uchar* dst; int ldw; bool f8; };
__device__ __forceinline__ void tr_load(const ConvItem& ci, f32x4 (&v)[16]) {
    if (ci.f8) {
#pragma unroll
        for (int i = 0; i < 8; ++i) { v[2 * i] = __builtin_nontemporal_load((const f32x4*)(ci.src + (size_t)(8 * i) * ci.ldw)); v[2 * i + 1] = __builtin_nontemporal_load((const f32x4*)(ci.src + (size_t)(8 * i + 1) * ci.ldw)); }
    } else {
#pragma unroll
        for (int i = 0; i < 16; ++i) v[i] = __builtin_nontemporal_load((const f32x4*)(ci.src + (size_t)(4 * i) * ci.ldw));
    }
}
__device__ __forceinline__ void tr_finish(const f32x4 (&v)[16], const ConvItem& ci, LAS uchar* scr, int lane) {
    const int kr = lane >> 4, nc = (lane & 15) * 4;
    const int g = lane >> 4, q = (lane >> 2) & 3, p = lane & 3;
    const int vb = (int)(uintptr_t)scr + q * 128 + g * 32 + p * 8;
    if (ci.f8) {
#pragma unroll
        for (int i = 0; i < 8; ++i) { const f32x4 a = v[2 * i] * 32.f, b = v[2 * i + 1] * 32.f;
            int r0 = __builtin_amdgcn_cvt_pk_fp8_f32(a.x, b.x, 0, false); r0 = __builtin_amdgcn_cvt_pk_fp8_f32(a.y, b.y, r0, true);
            int r1 = __builtin_amdgcn_cvt_pk_fp8_f32(a.z, b.z, 0, false); r1 = __builtin_amdgcn_cvt_pk_fp8_f32(a.w, b.w, r1, true);
            *(LAS u32x2*)(scr + (4 * i + kr) * 128 + nc * 2) = (u32x2){(unsigned)r0, (unsigned)r1}; }
        asm volatile("s_waitcnt lgkmcnt(0)" ::: "memory");
        s16x4 t[8];
#define TRR(r) t[r] = att::tr_read<(r) * 512>(vb)
        TRR(0); TRR(1); TRR(2); TRR(3); TRR(4); TRR(5); TRR(6); TRR(7);
#undef TRR
        asm volatile("s_waitcnt lgkmcnt(0)" ::: "memory"); __builtin_amdgcn_sched_barrier(0);
#pragma unroll
        for (int j = 0; j < 4; ++j) { const bf16x8 o = {t[2 * j][0], t[2 * j][1], t[2 * j][2], t[2 * j][3], t[2 * j + 1][0], t[2 * j + 1][1], t[2 * j + 1][2], t[2 * j + 1][3]}; *(bf16x8*)(ci.dst + 16 * j) = o; }
    } else {
#pragma unroll
        for (int i = 0; i < 16; ++i) { u32x2 o; o.x = pk2(v[i].x, v[i].y); o.y = pk2(v[i].z, v[i].w); *(LAS u32x2*)(scr + (4 * i + kr) * 128 + nc * 2) = o; }
        asm volatile("s_waitcnt lgkmcnt(0)" ::: "memory");
        s16x4 t[16];
#define TRR(r) t[r] = att::tr_read<(r) * 512>(vb)
        TRR(0); TRR(1); TRR(2); TRR(3); TRR(4); TRR(5); TRR(6); TRR(7); TRR(8); TRR(9); TRR(10); TRR(11); TRR(12); TRR(13); TRR(14); TRR(15);
#undef TRR
        asm volatile("s_waitcnt lgkmcnt(0)" ::: "memory"); __builtin_amdgcn_sched_barrier(0);
#pragma unroll
        for (int j = 0; j < 8; ++j) { const bf16x8 o = {t[2 * j][0], t[2 * j][1], t[2 * j][2], t[2 * j][3], t[2 * j + 1][0], t[2 * j + 1][1], t[2 * j + 1][2], t[2 * j + 1][3]}; *(bf16x8*)(ci.dst + 16 * j) = o; }
    }
}
struct Job { int g, lo, hi; };
__device__ __forceinline__ ConvItem conv_decode(Frame& F, int g, int it) {
    uchar* ws = F.ws; const float* W; int K = 1024, N = 1024, ldt = 1024, mode = 0; size_t dms = 0; bf16_t* WT;
    switch (g) {
        case 0:  W = inp(F, I_MWGATE); N = 512; WT = (bf16_t*)(ws + WS_W_E1); dms = (size_t)1024 * 1024; mode = 1; break;
        case 1:  W = inp(F, I_MWUP);   N = 512; WT = (bf16_t*)(ws + WS_W_E1); dms = (size_t)1024 * 1024; mode = 2; break;
        case 2:  W = inp(F, I_MWDOWN); K = 512; WT = (bf16_t*)(ws + WS_W_E2); ldt = 512; dms = (size_t)1024 * 512; break;
        case 3:  W = inp(F, I_RGWIN);  N = 2048; WT = (bf16_t*)(ws + WS_W_RGIN); dms = (size_t)2048 * 1024; break;
        case 4:  W = inp(F, I_CMWIN);  N = 4096; WT = (bf16_t*)(ws + WS_W_CMIN); break;
        case 5:  W = inp(F, I_RGWOUT); WT = (bf16_t*)(ws + WS_W_RGOUT); dms = (size_t)1024 * 1024; break;
        case 6:  W = inp(F, I_CMWOUT); K = 2048; WT = (bf16_t*)(ws + WS_W_CMOUT); ldt = 2048; break;
        case 7:  W = inp(F, I_ATQKV);  N = 1536; WT = (bf16_t*)(ws + WS_W_QKV); break;
        case 8:  W = inp(F, I_ATWO);   WT = (bf16_t*)(ws + WS_W_AO); break;
        case 9:  W = inp(F, I_RGWA);   K = 128; N = 128; WT = (bf16_t*)(ws + WS_W_RGG); ldt = 128; dms = (size_t)256 * 128; break;
        default: W = inp(F, I_RGWI);   K = 128; N = 128; WT = (bf16_t*)(ws + WS_W_RGG); ldt = 128; dms = (size_t)256 * 128; mode = 3; break;
    }
    const int nblk = N / 64, nkb = K / 64, per = nkb * nblk, mat = it / per, r = it - mat * per, kb = (r & 1) + 2 * (r / (2 * nblk)), nb = (r >> 1) % nblk, n0 = nb * 64;
    int drow = n0;
    if (mode == 1) drow = (n0 >> 7) * 256 + (n0 & 127); else if (mode == 2) drow = (n0 >> 7) * 256 + 128 + (n0 & 127); else if (mode == 3) drow = 128 + n0;
    const int lane = F.lane;
    const bool f8 = (MOE_FP8 != 0) && g < 3; const int eb = f8 ? 1 : 2;
    ConvItem ci; ci.ldw = N; ci.f8 = f8; ci.src = W + (size_t)mat * K * N + (size_t)(kb * 64 + (f8 ? 2 : 1) * (lane >> 4)) * N + n0 + (lane & 15) * 4;
    int nl = (lane >> 4) * 16 + (lane & 15);
    if (g == 7 && n0 < 1280) { const int half = nl >> 5, f = nl & 31; nl = 32 * (f >> 4) + 8 * ((f >> 2) & 3) + 4 * half + (f & 3); }
    ci.dst = (uchar*)WT + ((size_t)mat * dms + (size_t)(drow + nl) * ldt + kb * 64) * eb;
    return ci;
}
template <int NJ>
__device__ __forceinline__ ConvItem conv_find(Frame& F, int v, const Job (&jobs)[NJ]) { int r = v, g = jobs[0].g, it = 0; bool found = false;
#pragma unroll
    for (int q = 0; q < NJ; ++q) { const int n = jobs[q].hi - jobs[q].lo; if (!found) { if (r < n) { g = jobs[q].g; it = jobs[q].lo + r; found = true; } else r -= n; } }
    return conv_decode(F, g, it); }
template <int NJ>
__device__ __forceinline__ void conv_tail(Frame& F, int nblk0, const Job (&jobs)[NJ]) {
    if (nblk0 >= F.G) nblk0 = 0;
    if (F.bid < nblk0) return;
    LAS uchar* scr = F.lds + F.wave * 8192;
    int total = 0;
#pragma unroll
    for (int q = 0; q < NJ; ++q) total += jobs[q].hi - jobs[q].lo;
    const int nw = (F.G - nblk0) * 8;
    int v0 = (F.bid - nblk0) * 8 + F.wave;
    f32x4 va[16], vb[16]; ConvItem c0, c1; c0.dst = nullptr; c1.dst = nullptr; c0.f8 = false; c1.f8 = false; c0.src = nullptr; c1.src = nullptr; c0.ldw = 0; c1.ldw = 0;
    if (v0 < total) { c0 = conv_find(F, v0, jobs); tr_load(c0, va); }
    for (; v0 < total; v0 += 2 * nw) {
        const int v1 = v0 + nw, v2 = v1 + nw;
        if (v1 < total) { c1 = conv_find(F, v1, jobs); tr_load(c1, vb); }
        tr_finish(va, c0, scr, F.lane);
        if (v2 < total) { c0 = conv_find(F, v2, jobs); tr_load(c0, va); }
        if (v1 < total) tr_finish(vb, c1, scr, F.lane);
    }
}
__device__ __forceinline__ void p0_prologue(Frame& F) {
    uchar* ws = F.ws;
    {
        LAS float* act = (LAS float*)(F.lds);
        LAS float* red = (LAS float*)(F.lds + 5 * 1024 * 4);
        bool have = false; const float* pC = inp(F, I_C); const float* pCC = inp(F, I_CCTX); const float* pADAW = inp(F, I_ADAW); const float* pADAB = inp(F, I_ADAB);
        for (int it = F.bid; it < DEPTH * 24; it += F.G) {
            if (!have) { for (int i = F.tid; i < 5 * 1024; i += 512) { const int s = i >> 10, k = i & 1023; const float v = s < 4 ? pC[s * 1024 + k] : pCC[k]; act[i] = v / (1.f + __expf(-v)); } have = true; __syncthreads(); }
            const int l = it / 24, cb = it % 24;
            const float* W = pADAW + (size_t)l * 1024 * NMODV + cb * 256 + F.lane * 4;
            f32x4 a[5];
#pragma unroll
            for (int s = 0; s < 5; ++s) a[s] = (f32x4){0.f, 0.f, 0.f, 0.f};
            const int kbase = F.wave * 128;
#pragma unroll 8
            for (int k = 0; k < 128; ++k) { const f32x4 w = *(const f32x4*)(W + (size_t)(kbase + k) * NMODV);
#pragma unroll
                for (int s = 0; s < 5; ++s) a[s] += w * act[s * 1024 + kbase + k]; }
#pragma unroll
            for (int s = 0; s < 5; ++s) *(LAS f32x4*)(red + (F.wave * 5 + s) * 256 + F.lane * 4) = a[s];
            __syncthreads();
            for (int i = F.tid; i < 5 * 256; i += 512) { const int s = i >> 8, c = i & 255; float v = pADAB[l * NMODV + cb * 256 + c];
#pragma unroll
                for (int w = 0; w < 8; ++w) v += red[(w * 5 + s) * 256 + c];
                ((float*)(ws + WS_MOD))[(l * 5 + s) * NMODV + cb * 256 + c] = v; }
            __syncthreads();
        }
        __syncthreads();
    }
    { const Job jobsA[8] = {{3, 0, 1024}, {4, 0, 1024}, {5, 0, 512}, {6, 0, 512}, {7, 0, 384}, {8, 0, 256}, {9, 0, 128}, {10, 0, 128}}; conv_tail(F, DEPTH * 24, jobsA);
      const Job jobsB[3] = {{0, 0, 16384}, {1, 0, 16384}, {2, 0, 16384}}; conv_tail(F, 0, jobsB); }
    {
        const int gt = F.bid * 512 + F.tid, NGT = F.G * 512;
        for (int i = gt; i < 8 * 128 * 128 / 4; i += NGT) { const f32x4 v = ((const f32x4*)inp(F, I_CMWS))[i]; u32x2 o; o.x = pk2(v.x, v.y); o.y = pk2(v.z, v.w); ((u32x2*)(ws + WS_W_CMS))[i] = o; }
        for (int i = gt; i < 2 * 2 * D; i += NGT) { const float* plam = inp(F, I_RGLAM); ((float*)(ws + WS_SPL))[i] = -8.f * log1pf(expf(-plam[i])); }
        for (int i = gt; i < 64 * 32; i += NGT) { const int pos = i >> 5, f = i & 31; const float inv = powf(10000.f, -(float)f * 2.0f / 64.0f); const float ang = (float)pos * inv;
            ((f32x2*)(ws + WS_ROPE))[i] = (f32x2){cosf(ang), sinf(ang)}; }
    }
}

__device__ __forceinline__ void router_fill(Frame& F, int l) {
    LAS float* wr = (LAS float*)F.lds;
    const float* wg = inp(F, I_MWG) + (size_t)l * 1024 * 4; const float* wrt = inp(F, I_MWR) + (size_t)l * 1024 * 32;
    __syncthreads();
    for (int i0 = F.tid; i0 < 1024 * 9; i0 += 512 * 6) { f32x4 v[6];
#pragma unroll
        for (int u = 0; u < 6; ++u) { const int idx = i0 + u * 512; const int k = idx / 9, q = idx - k * 9; v[u] = q == 0 ? *(const f32x4*)(wg + k * 4) : *(const f32x4*)(wrt + k * 32 + (q - 1) * 4); }
#pragma unroll
        for (int u = 0; u < 6; ++u) { const int idx = i0 + u * 512; const int k = idx / 9, q = idx - k * 9;
            wr[(4 * q + 0) * 1024 + k] = v[u].x; wr[(4 * q + 1) * 1024 + k] = v[u].y; wr[(4 * q + 2) * 1024 + k] = v[u].z; wr[(4 * q + 3) * 1024 + k] = v[u].w; } }
    __syncthreads();
}
template <bool ROUTE, int NADD, bool SRCIN>
__device__ __forceinline__ void norm_phase(Frame& F, int l, const float* gvec, int shift_i, bool skip_ctx_route, bool dry) {
    uchar* ws = F.ws;
    float* X = (float*)(ws + WS_X); const bf16_t* YS = (const bf16_t*)(ws + WS_Y1); const bf16_t* YM = (const bf16_t*)(ws + WS_YM); bf16_t* H = (bf16_t*)(ws + WS_H);
    const float* MOD = (const float*)(ws + WS_MOD) + (size_t)l * 5 * NMODV;
    LAS float* wr = (LAS float*)F.lds;
    const int i16 = F.lane & 15, grp = F.lane >> 4;
    const float* bg = nullptr; const float* br = nullptr; if constexpr (ROUTE) { bg = inp(F, I_MBG) + l * 4; br = inp(F, I_MBR) + l * 32; }
    const float* pctx = nullptr; const float* px = nullptr; if constexpr (SRCIN) { pctx = inp(F, I_CTX); px = inp(F, I_X); }
    for (int tok = (F.bid * 8 + F.wave) * 4 + grp; tok < T; tok += F.G * 32) {
        asm volatile("" ::: "memory");
        const int sidx = sidx_of_row(tok);
        f32x4 x[16];
        float ss = 0.f;
        const float* xrow = X + (size_t)tok * D;
        if constexpr (SRCIN) { const int b_ = tok / SB, s_ = tok - b_ * SB; xrow = s_ < CTX ? pctx + ((size_t)(b_ * CTX + s_) << 10) : px + ((size_t)(b_ * SEQ + s_ - CTX) << 10); }
#pragma unroll
        for (int j = 0; j < 16; ++j) { if constexpr (X_BF16 && !SRCIN) { const u32x2 xb = *(const u32x2*)((const bf16_t*)X + (size_t)tok * D + 64 * j + 4 * i16); x[j] = (f32x4){bflo(xb.x), bfhi(xb.x), bflo(xb.y), bfhi(xb.y)}; }
            else x[j] = *(const f32x4*)(xrow + 64 * j + 4 * i16); }
        if constexpr (NADD >= 1) {
#pragma unroll
            for (int j = 0; j < 16; ++j) { const u32x2 ym = *(const u32x2*)(YM + (size_t)tok * D + 64 * j + 4 * i16); x[j] += (f32x4){bflo(ym.x), bfhi(ym.x), bflo(ym.y), bfhi(ym.y)}; } }
        if constexpr (NADD == 3) {
#pragma unroll
            for (int j = 0; j < 16; ++j) { const f32x4 g5 = *(const f32x4*)(MOD - (size_t)5 * NMODV + (size_t)sidx * NMODV + 5 * D + 64 * j + 4 * i16);
                if constexpr (Y_FP8) { const unsigned y0 = *(const unsigned*)((const uchar*)YS + (size_t)tok * D + 64 * j + 4 * i16), y1 = *(const unsigned*)((const uchar*)YS + ((size_t)T + tok) * D + 64 * j + 4 * i16);
                    x[j] += g5 * ((fp8x4_to_f32(y0) + fp8x4_to_f32(y1)) * (1.f / 16.f)); }
                else { const u32x2 y0 = *(const u32x2*)(YS + (size_t)tok * D + 64 * j + 4 * i16), y1 = *(const u32x2*)(YS + ((size_t)T + tok) * D + 64 * j + 4 * i16);
                    x[j] += g5 * (f32x4){bflo(y0.x) + bflo(y1.x), bfhi(y0.x) + bfhi(y1.x), bflo(y0.y) + bflo(y1.y), bfhi(y0.y) + bfhi(y1.y)}; } }
#pragma unroll
            for (int j = 0; j < 16; ++j) { if constexpr (X_BF16) { u32x2 o; o.x = pk2(x[j].x, x[j].y); o.y = pk2(x[j].z, x[j].w); *(u32x2*)((bf16_t*)X + (size_t)tok * D + 64 * j + 4 * i16) = o; }
                else *(f32x4*)(X + (size_t)tok * D + 64 * j + 4 * i16) = x[j]; } }
#pragma unroll
        for (int j = 0; j < 16; ++j) ss += x[j].x * x[j].x + x[j].y * x[j].y + x[j].z * x[j].z + x[j].w * x[j].w;
        ss = wave16_sum(ss);
        const float rstd = rsqrtf(ss * (1.f / D) + NORM_EPS);
        const float* shp = MOD + (size_t)sidx * NMODV + shift_i * D; const float* scp = shp + D;
#pragma unroll
        for (int j = 0; j < 16; ++j) { const int c = 64 * j + 4 * i16; const f32x4 g = *(const f32x4*)(gvec + c), sh = *(const f32x4*)(shp + c), sc = *(const f32x4*)(scp + c);
            x[j] = x[j] * rstd * g * (sc + 1.f) + sh; }
#pragma unroll
        for (int j = 0; j < 16; ++j) { const int c = 64 * j + 4 * i16;
            if constexpr (ROUTE && MOE_FP8) { int r8 = __builtin_amdgcn_cvt_pk_fp8_f32(x[j].x, x[j].y, 0, false); r8 = __builtin_amdgcn_cvt_pk_fp8_f32(x[j].z, x[j].w, r8, true); *(int*)((uchar*)H + (size_t)tok * D + c) = r8; }
            else { u32x2 o; o.x = pk2(x[j].x, x[j].y); o.y = pk2(x[j].z, x[j].w); *(u32x2*)(H + (size_t)tok * D + c) = o; } }
        if constexpr (ROUTE) {
            LAS float* lgs = (LAS float*)(F.lds + LDSCTL_OFF + 1024) + (F.wave * 4 + grp) * 40;
#pragma unroll 1
            for (int o = 0; o < 36; ++o) { f32x4 w[16];
#pragma unroll
                for (int j = 0; j < 16; ++j) w[j] = *(const LAS f32x4*)(wr + o * 1024 + 64 * j + 4 * i16);
                __builtin_amdgcn_sched_barrier(0);
                f32x4 v0 = x[0] * w[0], v1 = x[1] * w[1];
#pragma unroll
                for (int j = 2; j < 16; j += 2) { v0 += x[j] * w[j]; v1 += x[j + 1] * w[j + 1]; }
                v0 += v1; float a0 = wave16_sum((v0.x + v0.y) + (v0.z + v0.w)); if (i16 == 0) lgs[o] = a0; }
            asm volatile("s_waitcnt lgkmcnt(0)" ::: "memory");
            const float gl0 = lgs[0] + bg[0], gl1 = lgs[1] + bg[1], gl2 = lgs[2] + bg[2], gl3 = lgs[3] + bg[3];
            int gs = 0; float gm = gl0;
            if (gl1 > gm) { gm = gl1; gs = 1; }
            if (gl2 > gm) { gm = gl2; gs = 2; }
            if (gl3 > gm) { gm = gl3; gs = 3; }
            const float den = __expf(gl0 - gm) + __expf(gl1 - gm) + __expf(gl2 - gm) + __expf(gl3 - gm);
            const float pg = 1.f / den;
            float el[8];
#pragma unroll
            for (int e = 0; e < 8; ++e) el[e] = lgs[4 + gs * 8 + e] + br[gs * 8 + e];
            int i0 = 0; float v0 = el[0];
#pragma unroll
            for (int e = 1; e < 8; ++e) if (el[e] > v0) { v0 = el[e]; i0 = e; }
            int i1 = -1; float v1 = -3.0e38f;
#pragma unroll
            for (int e = 0; e < 8; ++e) if (e != i0 && el[e] > v1) { v1 = el[e]; i1 = e; }
            const float p0 = 1.f / (1.f + __expf(v1 - v0));
            const float w0 = p0 * pg, w1 = (1.f - p0) * pg;
            const bool do_route = !(skip_ctx_route && sidx == 4) && !dry;
            if (i16 == 0 && do_route) {
                const int e0 = gs * 8 + i0, e1 = gs * 8 + i1;
                unsigned* cnt = (unsigned*)(ws + WS_CTL) + CW_CNT + l * 32 * 64;
                const unsigned q0 = atomicAdd(cnt + e0 * 64, 1u), q1 = atomicAdd(cnt + e1 * 64, 1u);
                u32x2* BK = (u32x2*)(ws + WS_BK2);
                BK[(size_t)e0 * T + q0] = (u32x2){(unsigned)(tok * 2), __float_as_uint(w0)}; BK[(size_t)e1 * T + q1] = (u32x2){(unsigned)(tok * 2 + 1), __float_as_uint(w1)};
            }
        }
    }
}

__device__ __forceinline__ void st8(bf16_t* p, f32x4 v0, f32x4 v1) { u32x4 w; w.x = cvt_pk_bf16(v0[0], v0[1]); w.y = cvt_pk_bf16(v0[2], v0[3]); w.z = cvt_pk_bf16(v1[0], v1[1]); w.w = cvt_pk_bf16(v1[2], v1[3]); *(u32x4*)p = w; }
#define EPI_ROWS(ai, m) (u.pm * 256 + (ai) * 128 + wr * 64 + (m) * 16 + fr)

struct EpiRgIn { static constexpr bool PERM = true, FP8 = false, PREFETCH = false; bf16_t* GG; bf16_t* XB;
    __device__ __forceinline__ void operator()(const f32x4 (&acc)[2][2][4][2], const pg8::Unit& u, int wr, int wc, int fr, int fq) const {
        const bool isg = u.pn < 4; bf16_t* base = isg ? GG : XB; const int ct = (u.pn & 3) * 256 + wc * 32 + 8 * fq;
#pragma unroll
        for (int ai = 0; ai < 2; ++ai)
#pragma unroll
            for (int m = 0; m < 4; ++m) { if (!((u.hm >> (2 * ai)) & 1)) continue; bf16_t* rowp = base + (size_t)EPI_ROWS(ai, m) * D + ct;
#pragma unroll
                for (int bj = 0; bj < 2; ++bj) { f32x4 v0 = acc[ai][bj][m][0], v1 = acc[ai][bj][m][1];
                    if (isg) {
#pragma unroll
                        for (int e = 0; e < 4; ++e) { v0[e] = gelu_tanh(v0[e]); v1[e] = gelu_tanh(v1[e]); } }
                    st8(rowp + bj * 128, v0, v1); } }
    } };
struct EpiBf16 { static constexpr bool PERM = true, FP8 = false, PREFETCH = false; bf16_t* O; int ldc;
    __device__ __forceinline__ void operator()(const f32x4 (&acc)[2][2][4][2], const pg8::Unit& u, int wr, int wc, int fr, int fq) const {
        const int ct = u.pn * 256 + wc * 32 + 8 * fq;
#pragma unroll
        for (int ai = 0; ai < 2; ++ai)
#pragma unroll
            for (int m = 0; m < 4; ++m) { if (!((u.hm >> (2 * ai)) & 1)) continue; bf16_t* rowp = O + (size_t)EPI_ROWS(ai, m) * ldc + ct;
#pragma unroll
                for (int bj = 0; bj < 2; ++bj) st8(rowp + bj * 128, acc[ai][bj][m][0], acc[ai][bj][m][1]); }
    } };
struct EpiQKV { static constexpr bool PERM = true, FP8 = false, PREFETCH = false; bf16_t* O; const float* qg; const float* kg; const float* rope; LAS float* xch;
    __device__ __forceinline__ void operator()(const f32x4 (&acc)[2][2][4][2], const pg8::Unit& u, int wr, int wc, int fr, int fq) const {
        if (u.pn == 5) {
            const int ct = u.pn * 256 + wc * 32 + 8 * fq;
#pragma unroll
            for (int ai = 0; ai < 2; ++ai)
#pragma unroll
                for (int m = 0; m < 4; ++m) { if (!((u.hm >> (2 * ai)) & 1)) continue; bf16_t* rowp = O + (size_t)EPI_ROWS(ai, m) * 1536 + ct;
#pragma unroll
                    for (int bj = 0; bj < 2; ++bj) st8(rowp + bj * 128, acc[ai][bj][m][0], acc[ai][bj][m][1]); }
            return; }
        const bool lat = (u.pm % 17) != 0; const float* gv = u.pn < 4 ? qg : kg; const int a = wc >> 1, f0 = 16 * (wc & 1) + 4 * fq;
        const f32x4 g1 = *(const f32x4*)(gv + 64 * a + f0), g2 = *(const f32x4*)(gv + 64 * a + 32 + f0);
        f32x4 cvs[4], svs[4];
        { const int t0 = ((u.pm % 17) - 1) * 256;
#pragma unroll
          for (int q = 0; q < 4; ++q) { cvs[q] = (f32x4){1.f, 1.f, 1.f, 1.f}; svs[q] = (f32x4){0.f, 0.f, 0.f, 0.f};
            if (lat) { const int pos = a ? (16 * q + fr) : ((t0 >> 6) + 2 * (q & 1) + wr); const f32x4 cs0 = *(const f32x4*)(rope + (pos * 32 + f0) * 2), cs1 = *(const f32x4*)(rope + (pos * 32 + f0) * 2 + 4);
                cvs[q] = (f32x4){cs0.x, cs0.z, cs1.x, cs1.z}; svs[q] = (f32x4){cs0.y, cs0.w, cs1.y, cs1.w}; } } }
#pragma unroll
        for (int ai = 0; ai < 2; ++ai)
#pragma unroll
            for (int m = 0; m < 4; ++m)
#pragma unroll
                for (int bj = 0; bj < 2; ++bj) { const f32x4 v0 = acc[ai][bj][m][0], v1 = acc[ai][bj][m][1];
                    float sq = ((v0.x * v0.x + v0.y * v0.y) + (v0.z * v0.z + v0.w * v0.w)) + ((v1.x * v1.x + v1.y * v1.y) + (v1.z * v1.z + v1.w * v1.w));
                    sq += __shfl_xor(sq, 16); sq += __shfl_xor(sq, 32);
                    if (fq == 0) xch[((ai * 128 + wr * 64 + m * 16 + fr) * 2 + bj) * 4 + wc] = sq; }
        asm volatile("s_waitcnt lgkmcnt(0)" ::: "memory"); __builtin_amdgcn_s_barrier(); asm volatile("" ::: "memory");
#pragma unroll
        for (int ai = 0; ai < 2; ++ai)
#pragma unroll
            for (int m = 0; m < 4; ++m) { if (!((u.hm >> (2 * ai)) & 1)) continue; const int row = EPI_ROWS(ai, m);
                const f32x4 cv = a ? cvs[m] : cvs[ai], sv = a ? svs[m] : svs[ai];
#pragma unroll
                for (int bj = 0; bj < 2; ++bj) { const f32x4 p4 = *(const LAS f32x4*)(xch + ((ai * 128 + wr * 64 + m * 16 + fr) * 2 + bj) * 4);
                    const float rstd = rsqrtf(((p4.x + p4.y) + (p4.z + p4.w)) * (1.f / 128.f) + NORM_EPS);
                    const f32x4 x1 = acc[ai][bj][m][0] * rstd * g1, x2 = acc[ai][bj][m][1] * rstd * g2;
                    const f32x4 o1 = x1 * cv - x2 * sv, o2 = x2 * cv + x1 * sv;
                    bf16_t* p = O + (size_t)row * 1536 + u.pn * 256 + bj * 128 + 64 * a + f0;
                    u32x2 w1, w2; w1.x = cvt_pk_bf16(o1.x, o1.y); w1.y = cvt_pk_bf16(o1.z, o1.w); w2.x = cvt_pk_bf16(o2.x, o2.y); w2.y = cvt_pk_bf16(o2.z, o2.w);
                    *(u32x2*)p = w1; *(u32x2*)(p + 32) = w2; } }
    } };
struct EpiCmIn { static constexpr bool PERM = true, FP8 = false, PREFETCH = false; bf16_t* O; f32x2* statp;
    __device__ __forceinline__ void operator()(const f32x4 (&acc)[2][2][4][2], const pg8::Unit& u, int wr, int wc, int fr, int fq) const {
        const int ct = u.pn * 256 + wc * 32 + 8 * fq; const bool isv = u.pn >= 8;
#pragma unroll
        for (int ai = 0; ai < 2; ++ai)
#pragma unroll
            for (int m = 0; m < 4; ++m) { if (!((u.hm >> (2 * ai)) & 1)) continue; const int row = EPI_ROWS(ai, m); bf16_t* rowp = O + (size_t)row * 4096 + ct; float s = 0.f, q = 0.f;
#pragma unroll
                for (int bj = 0; bj < 2; ++bj) { f32x4 v0 = acc[ai][bj][m][0], v1 = acc[ai][bj][m][1];
#pragma unroll
                    for (int e = 0; e < 4; ++e) { v0[e] = gelu_tanh(v0[e]); v1[e] = gelu_tanh(v1[e]); }
                    u32x4 w; w.x = cvt_pk_bf16(v0[0], v0[1]); w.y = cvt_pk_bf16(v0[2], v0[3]); w.z = cvt_pk_bf16(v1[0], v1[1]); w.w = cvt_pk_bf16(v1[2], v1[3]);
                    *(u32x4*)(rowp + bj * 128) = w;
                    const float r0 = bflo(w.x), r1 = bfhi(w.x), r2 = bflo(w.y), r3 = bfhi(w.y), r4 = bflo(w.z), r5 = bfhi(w.z), r6 = bflo(w.w), r7 = bfhi(w.w);
                    s += ((r0 + r1) + (r2 + r3)) + ((r4 + r5) + (r6 + r7)); q += ((r0 * r0 + r1 * r1) + (r2 * r2 + r3 * r3)) + ((r4 * r4 + r5 * r5) + (r6 * r6 + r7 * r7)); }
                if (isv) { s += __shfl_xor(s, 16); s += __shfl_xor(s, 32); q += __shfl_xor(q, 16); q += __shfl_xor(q, 32);
                    if (fq == 0) statp[(size_t)row * 32 + (u.pn - 8) * 4 + wc] = (f32x2){s, q}; } }
    } };
struct EpiResid { static constexpr bool PERM = true, FP8 = false, PREFETCH = false; bf16_t* YM; const float* gate  ;
    __device__ __forceinline__ void operator()(const f32x4 (&acc)[2][2][4][2], const pg8::Unit& u, int wr, int wc, int fr, int fq) const {
        const int sidx = sidx_of_row(u.pm * 256); const float* gp = gate + (size_t)sidx * NMODV; const int ct = u.pn * 256 + wc * 32 + 8 * fq;
        f32x4 gv[2][2];
#pragma unroll
        for (int bj = 0; bj < 2; ++bj)
#pragma unroll
            for (int n = 0; n < 2; ++n) gv[bj][n] = *(const f32x4*)(gp + ct + bj * 128 + n * 4);
#pragma unroll
        for (int ai = 0; ai < 2; ++ai)
#pragma unroll
            for (int m = 0; m < 4; ++m) { if (!((u.hm >> (2 * ai)) & 1)) continue; bf16_t* rowp = YM + (size_t)EPI_ROWS(ai, m) * D + ct;
#pragma unroll
                for (int bj = 0; bj < 2; ++bj) st8(rowp + bj * 128, gv[bj][0] * acc[ai][bj][m][0], gv[bj][1] * acc[ai][bj][m][1]); }
    } };
struct EpiRgGate { static constexpr bool PERM = true, FP8 = false, PREFETCH = false; const bf16_t* XC; bf16_t* LA; bf16_t* BB; const float* ba; const float* bi; const float* lam;
    __device__ __forceinline__ void operator()(const f32x4 (&acc)[2][2][4][2], const pg8::Unit& u, int wr, int wc, int fr, int fq) const {
        const int d = u.pn >> 3, blk = u.pn & 7;
        asm volatile("" : "+v"(fr), "+v"(fq));
        const int ch = blk * 128 + wc * 32 + 8 * fq;
        u32x4 xw[8];
#pragma unroll
        for (int r = 0; r < 8; ++r) xw[r] = *(const u32x4*)(XC + (size_t)EPI_ROWS(r >> 2, r & 3) * D + ch);
        f32x4 bav[2], biv[2], spv[2];
#pragma unroll
        for (int n = 0; n < 2; ++n) { bav[n] = *(const f32x4*)(ba + d * D + ch + 4 * n); biv[n] = *(const f32x4*)(bi + d * D + ch + 4 * n); spv[n] = *(const f32x4*)(lam + d * D + ch + 4 * n); }
#pragma unroll
        for (int r = 0; r < 8; ++r) { const int ai = r >> 2, m = r & 3; if (!((u.hm >> (2 * ai)) & 1)) continue;
            const size_t off = (size_t)EPI_ROWS(ai, m) * D + ch;
            const float xc[8] = {bflo(xw[r].x), bfhi(xw[r].x), bflo(xw[r].y), bfhi(xw[r].y), bflo(xw[r].z), bfhi(xw[r].z), bflo(xw[r].w), bfhi(xw[r].w)};
            float la[8], bb[8];
#pragma unroll
            for (int n = 0; n < 2; ++n)
#pragma unroll
                for (int e = 0; e < 4; ++e) { const float rg = fast_sigmoid(acc[ai][0][m][n][e] + bav[n][e]), ig = fast_sigmoid(acc[ai][1][m][n][e] + biv[n][e]);
                    const float lga = rg * spv[n][e]; la[4 * n + e] = lga; bb[4 * n + e] = __builtin_amdgcn_sqrtf(one_minus_exp(-2.f * lga)) * ig * xc[4 * n + e]; }
            u32x4 w; w.x = cvt_pk_bf16(la[0], la[1]); w.y = cvt_pk_bf16(la[2], la[3]); w.z = cvt_pk_bf16(la[4], la[5]); w.w = cvt_pk_bf16(la[6], la[7]);
            *(u32x4*)(LA + (size_t)d * T * D + off) = w;
            w.x = cvt_pk_bf16(bb[0], bb[1]); w.y = cvt_pk_bf16(bb[2], bb[3]); w.z = cvt_pk_bf16(bb[4], bb[5]); w.w = cvt_pk_bf16(bb[6], bb[7]);
            *(u32x4*)(BB + (size_t)d * T * D + off) = w; }
    } };

template <bool G1>
struct MoeOrder {
    static constexpr bool GATHER = G1;
    const LAS int* tab; const char* A; const char* B; const int* BK; int G, c, nunits; size_t bstride; int arow, brow;
    __device__ bool next(int i, pg8::Unit& u) const {
        int L, hm; if (!pg8::unit_slot(i, c, G, nunits, L, hm)) return false; u.hm = __builtin_amdgcn_readfirstlane(hm);
        const int wgid = __builtin_amdgcn_readfirstlane(pg8::xcd_remap(L, nunits)); const int tau = wgid >> 2, pn = wgid & 3;
        const int e = __builtin_amdgcn_readfirstlane(tab[192 + tau]);
        u.pm = tau; u.pn = pn; u.aux0 = e; u.aux1 = __builtin_amdgcn_readfirstlane((tau - tab[e]) * 256);
        u.a = pg8::uptr(G1 ? A : A + (size_t)tau * 256 * arow);
        u.b = pg8::uptr(B + (size_t)e * bstride + (size_t)pn * 256 * brow);
        return true; }
    __device__ unsigned goff(const pg8::Unit& u, int row) const {
        const int pos = u.aux1 + row; const int cnt = tab[40 + u.aux0];
        int tok = 0; if (pos < cnt) tok = __builtin_nontemporal_load(BK + ((size_t)u.aux0 * T + pos) * 2) >> 1;
        return (unsigned)tok * (unsigned)arow; }
};
struct EpiMoe1 { static constexpr bool PERM = true, FP8 = (MOE_FP8 != 0), PREFETCH = false; uchar* H1;
    __device__ __forceinline__ void operator()(const f32x4 (&acc)[2][2][4][2], const pg8::Unit& u, int wr, int wc, int fr, int fq) const {
        const int ct = u.pn * 128 + wc * 32 + 8 * fq;
#pragma unroll
        for (int ai = 0; ai < 2; ++ai)
#pragma unroll
            for (int m = 0; m < 4; ++m) { if (!((u.hm >> (2 * ai)) & 1)) continue; f32x4 h0, h1;
#pragma unroll
                for (int e = 0; e < 4; ++e) { constexpr float WS_ = FP8 ? (1.f / 32.f) : 1.f;
                    const float g0 = acc[ai][0][m][0][e] * WS_, g1 = acc[ai][0][m][1][e] * WS_; h0[e] = g0 * fast_sigmoid(g0) * (acc[ai][1][m][0][e] * WS_); h1[e] = g1 * fast_sigmoid(g1) * (acc[ai][1][m][1][e] * WS_); }
                if constexpr (FP8) { int r0 = __builtin_amdgcn_cvt_pk_fp8_f32(h0[0], h0[1], 0, false); r0 = __builtin_amdgcn_cvt_pk_fp8_f32(h0[2], h0[3], r0, true);
                    int r1 = __builtin_amdgcn_cvt_pk_fp8_f32(h1[0], h1[1], 0, false); r1 = __builtin_amdgcn_cvt_pk_fp8_f32(h1[2], h1[3], r1, true);
                    *(u32x2*)(H1 + (size_t)EPI_ROWS(ai, m) * DEXP + ct) = (u32x2){(unsigned)r0, (unsigned)r1}; }
                else st8((bf16_t*)H1 + (size_t)EPI_ROWS(ai, m) * DEXP + ct, h0, h1); }
    } };
struct EpiMoe2 { static constexpr bool PERM = true, FP8 = (MOE_FP8 != 0), PREFETCH = true; bf16_t* YS; const int* BK; const LAS int* tab;
    typedef int pre_t __attribute__((ext_vector_type(16)));
    __device__ __forceinline__ pre_t prefetch(const pg8::Unit& u, int wr, int fr) const { pre_t p; const int cnt = tab[40 + u.aux0];
#pragma unroll
        for (int r = 0; r < 8; ++r) { const int pos = u.aux1 + (r >> 2) * 128 + wr * 64 + (r & 3) * 16 + fr; u32x2 v = {0xffffffffu, 0u}; if (pos < cnt) v = __builtin_nontemporal_load((const u32x2*)BK + (size_t)u.aux0 * T + pos); p[2 * r] = (int)v.x; p[2 * r + 1] = (int)v.y; }
        return p; }
    __device__ __forceinline__ void operator()(const f32x4 (&acc)[2][2][4][2], const pg8::Unit& u, int wr, int wc, int fr, int fq, const pre_t& pre) const {
        const int ct = u.pn * 256 + wc * 32 + 8 * fq;
#pragma unroll
        for (int r = 0; r < 8; ++r) { const int e_ = pre[2 * r];
            if (e_ >= 0 && ((u.hm >> (2 * (r >> 2))) & 1)) { const int tok = e_ >> 1, slot = e_ & 1; const float w = __int_as_float(pre[2 * r + 1]) * (FP8 ? (1.f / 32.f) : 1.f);
                if constexpr (Y_FP8) { uchar* yp = (uchar*)YS + ((size_t)slot * T + tok) * D + ct; const float w16 = w * 16.f;
#pragma unroll
                    for (int bj = 0; bj < 2; ++bj) { const f32x4 a0 = acc[r >> 2][bj][r & 3][0] * w16, a1 = acc[r >> 2][bj][r & 3][1] * w16;
                        int r0 = __builtin_amdgcn_cvt_pk_fp8_f32(a0.x, a0.y, 0, false); r0 = __builtin_amdgcn_cvt_pk_fp8_f32(a0.z, a0.w, r0, true);
                        int r1 = __builtin_amdgcn_cvt_pk_fp8_f32(a1.x, a1.y, 0, false); r1 = __builtin_amdgcn_cvt_pk_fp8_f32(a1.z, a1.w, r1, true);
                        *(u32x2*)(yp + bj * 128) = (u32x2){(unsigned)r0, (unsigned)r1}; } }
                else { bf16_t* yp = YS + ((size_t)slot * T + tok) * D + ct;
#pragma unroll
                    for (int bj = 0; bj < 2; ++bj) st8(yp + bj * 128, acc[r >> 2][bj][r & 3][0] * w, acc[r >> 2][bj][r & 3][1] * w); } } }
    } };
__device__ __forceinline__ int moe_table(Frame& F, int l, LAS int* tab) {
    __syncthreads();
    if (F.tid < 32) { const unsigned c = __hip_atomic_load((unsigned*)(F.ws + WS_CTL) + CW_CNT + (l * 32 + F.tid) * 64, RLX_AGENT); tab[40 + F.tid] = (int)c; }
    __syncthreads();
    if (F.tid == 0) { int s = 0;
#pragma unroll 1
        for (int e = 0; e < 32; ++e) { tab[e] = s; s += (tab[40 + e] + 255) >> 8; } tab[32] = s; }
    __syncthreads();
    const int ntile_ = tab[32];
    for (int tau = F.tid; tau < ntile_; tau += 512) { int e = 0;
#pragma unroll 1
        for (int k = 1; k < 32; ++k) e = (tab[k] <= tau) ? k : e;
        tab[192 + tau] = e; }
    __syncthreads();
    return ntile_;
}

__device__ __forceinline__ void conv_phase(Frame& F, int j) {
    const bf16_t* XB = (const bf16_t*)(F.ws + WS_XB); bf16_t* XC = (bf16_t*)(F.ws + WS_XC);
    const float* cw = inp(F, I_RGCW) + (size_t)j * 4 * D; const float* cb = inp(F, I_RGCB) + (size_t)j * D;
    const int NGT = F.G * 512;
    for (int i0 = F.bid * 512 + F.tid; i0 < T * 128; i0 += 2 * NGT) {
        u32x4 xw[2][4];
#pragma unroll
        for (int q = 0; q < 2; ++q) { const int i = i0 + q * NGT; const int row = i >> 7, c = (i & 127) * 8; const int b = row / SB, s = row - b * SB; const int lo = s < CTX ? 0 : CTX, hi = s < CTX ? CTX : SB;
#pragma unroll
            for (int k = 0; k < 4; ++k) { const int ss = s + k - 2; xw[q][k] = (u32x4){0u, 0u, 0u, 0u}; if (i < T * 128 && ss >= lo && ss < hi) xw[q][k] = *(const u32x4*)(XB + (size_t)(b * SB + ss) * D + c); } }
#pragma unroll
        for (int q = 0; q < 2; ++q) { const int i = i0 + q * NGT; if (i < T * 128) { const int row = i >> 7, c = (i & 127) * 8;
            float a[8];
#pragma unroll
            for (int e = 0; e < 8; ++e) a[e] = cb[c + e];
#pragma unroll
            for (int k = 0; k < 4; ++k) { const f32x4 w0 = *(const f32x4*)(cw + k * D + c), w1 = *(const f32x4*)(cw + k * D + c + 4); const u32x4 x = xw[q][k];
                a[0] += w0.x * bflo(x.x); a[1] += w0.y * bfhi(x.x); a[2] += w0.z * bflo(x.y); a[3] += w0.w * bfhi(x.y);
                a[4] += w1.x * bflo(x.z); a[5] += w1.y * bfhi(x.z); a[6] += w1.z * bflo(x.w); a[7] += w1.w * bfhi(x.w); }
            u32x4 o; o.x = pk2(a[0], a[1]); o.y = pk2(a[2], a[3]); o.z = pk2(a[4], a[5]); o.w = pk2(a[6], a[7]);
            *(u32x4*)(XC + (size_t)row * D + c) = o; } }
    }
}
__device__ __forceinline__ void scan1_phase(Frame& F) {
    const bf16_t* LA = (const bf16_t*)(F.ws + WS_LA); const bf16_t* BB = (const bf16_t*)(F.ws + WS_BB); float* TS = (float*)(F.ws + WS_TOTS); float* TH = (float*)(F.ws + WS_TOTH);
    for (int it = F.bid * 8 + F.wave; it < NB * 2 * NCH * 4; it += F.G * 8) {
        const int cg = it & 3, rest = it >> 2, ck = rest % NCH, bd = rest / NCH, dir = bd & 1, b = bd >> 1;
        const int c = cg * 256 + F.lane * 4; const size_t base = (size_t)dir * T * D + (size_t)(b * SB + ck * 16) * D + c;
        u32x2 la[16], bb[16];
#pragma unroll
        for (int t = 0; t < 16; ++t) { const size_t o = base + (size_t)(dir ? 15 - t : t) * D; la[t] = *(const u32x2*)(LA + o); bb[t] = *(const u32x2*)(BB + o); }
        f32x4 sl = {0.f, 0.f, 0.f, 0.f}, h = {0.f, 0.f, 0.f, 0.f};
#pragma unroll
        for (int t = 0; t < 16; ++t) { const f32x4 l4 = {bflo(la[t].x), bfhi(la[t].x), bflo(la[t].y), bfhi(la[t].y)}, b4 = {bflo(bb[t].x), bfhi(bb[t].x), bflo(bb[t].y), bfhi(bb[t].y)};
            sl += l4; f32x4 a4 = {__expf(l4.x), __expf(l4.y), __expf(l4.z), __expf(l4.w)}; h = a4 * h + b4; }
        const size_t o = (size_t)(bd * NCH + ck) * D + c; *(f32x4*)(TS + o) = sl; *(f32x4*)(TH + o) = h;
    }
}
__device__ __forceinline__ void scan2_phase(Frame& F) {
    const float* TS = (const float*)(F.ws + WS_TOTS); const float* TH = (const float*)(F.ws + WS_TOTH); float* CY = (float*)(F.ws + WS_CARRY);
    LAS float* wt = (LAS float*)F.lds;
    for (int it = F.bid; it < NB * 2 * 16; it += F.G) {
        const int cg = it & 15, bd = it >> 4, dir = bd & 1; const int c = cg * 64 + F.lane; const size_t base = (size_t)bd * NCH * D + c;
        const int s0 = F.wave * 34;
        float P = 0.f, H = 0.f;
#pragma unroll 1
        for (int sb = 0; sb < 34; sb += 17) { float sl[17], hl[17];
#pragma unroll
            for (int q = 0; q < 17; ++q) { const int s = s0 + sb + q; const int ck = dir ? (s < 16 ? 15 - s : NCH + 15 - s) : s; sl[q] = TS[base + (size_t)ck * D]; hl[q] = TH[base + (size_t)ck * D]; }
#pragma unroll
            for (int q = 0; q < 17; ++q) { P += sl[q]; H = __expf(sl[q]) * H + hl[q]; } }
        __syncthreads();
        wt[(F.wave * 2 + 0) * 64 + F.lane] = P; wt[(F.wave * 2 + 1) * 64 + F.lane] = H;
        __syncthreads();
        float h = 0.f;
        for (int w = 0; w < F.wave; ++w) h = __expf(wt[(w * 2 + 0) * 64 + F.lane]) * h + wt[(w * 2 + 1) * 64 + F.lane];
#pragma unroll 1
        for (int sb = 0; sb < 34; sb += 17) { float sl[17], hl[17]; int ckk[17];
#pragma unroll
            for (int q = 0; q < 17; ++q) { const int s = s0 + sb + q; ckk[q] = dir ? (s < 16 ? 15 - s : NCH + 15 - s) : s; sl[q] = TS[base + (size_t)ckk[q] * D]; hl[q] = TH[base + (size_t)ckk[q] * D]; }
#pragma unroll
            for (int q = 0; q < 17; ++q) { CY[base + (size_t)ckk[q] * D] = h; h = __expf(sl[q]) * h + hl[q]; } }
    }
    __syncthreads();
}
__device__ __forceinline__ void scan3_phase(Frame& F) {
    const bf16_t* LA = (const bf16_t*)(F.ws + WS_LA); const bf16_t* BB = (const bf16_t*)(F.ws + WS_BB); const float* CY = (const float*)(F.ws + WS_CARRY);
    const bf16_t* GG = (const bf16_t*)(F.ws + WS_GG); bf16_t* SA = (bf16_t*)(F.ws + WS_SA);
    LAS f32x4* hb = (LAS f32x4*)(F.lds + F.wave * 16384);
    for (int it = F.bid * 8 + F.wave; it < NB * NCH * 4; it += F.G * 8) {
        const int cg = it & 3, rest = it >> 2, ck = rest % NCH, b = rest / NCH;
        const int c = cg * 256 + F.lane * 4;
        const size_t rbase = (size_t)(b * SB + ck * 16) * D + c, b1 = (size_t)T * D + rbase;
        f32x4 hbk = *(const f32x4*)(CY + (size_t)((b * 2 + 1) * NCH + ck) * D + c), hf = *(const f32x4*)(CY + (size_t)((b * 2 + 0) * NCH + ck) * D + c);
        { u32x2 la[16], bb[16];
#pragma unroll
          for (int t = 0; t < 16; ++t) { la[t] = *(const u32x2*)(LA + b1 + (size_t)(15 - t) * D); bb[t] = *(const u32x2*)(BB + b1 + (size_t)(15 - t) * D); }
#pragma unroll
          for (int t = 0; t < 16; ++t) { const f32x4 l4 = {bflo(la[t].x), bfhi(la[t].x), bflo(la[t].y), bfhi(la[t].y)}, b4 = {bflo(bb[t].x), bfhi(bb[t].x), bflo(bb[t].y), bfhi(bb[t].y)};
              const f32x4 a4 = {__expf(l4.x), __expf(l4.y), __expf(l4.z), __expf(l4.w)}; hbk = a4 * hbk + b4; hb[(15 - t) * 64 + F.lane] = hbk; } }
        { u32x2 la[16], bb[16], gg[16];
#pragma unroll
          for (int t = 0; t < 16; ++t) { la[t] = *(const u32x2*)(LA + rbase + (size_t)t * D); bb[t] = *(const u32x2*)(BB + rbase + (size_t)t * D); gg[t] = *(const u32x2*)(GG + rbase + (size_t)t * D); }
#pragma unroll
          for (int t = 0; t < 16; ++t) { const f32x4 l4 = {bflo(la[t].x), bfhi(la[t].x), bflo(la[t].y), bfhi(la[t].y)}, b4 = {bflo(bb[t].x), bfhi(bb[t].x), bflo(bb[t].y), bfhi(bb[t].y)};
              const f32x4 g4 = {bflo(gg[t].x), bfhi(gg[t].x), bflo(gg[t].y), bfhi(gg[t].y)};
              const f32x4 a4 = {__expf(l4.x), __expf(l4.y), __expf(l4.z), __expf(l4.w)}; hf = a4 * hf + b4; const f32x4 y = g4 * (hf + hb[t * 64 + F.lane]);
              u32x2 o; o.x = pk2(y.x, y.y); o.y = pk2(y.z, y.w); *(u32x2*)(SA + rbase + (size_t)t * D) = o; } }
    }
}

__device__ __forceinline__ void qknorm_phase(Frame& F) {
    bf16_t* QKV = (bf16_t*)(F.ws + WS_QKV); const f32x2* ROPE = (const f32x2*)(F.ws + WS_ROPE);
    const int i16 = F.lane & 15, grp = F.lane >> 4; const float* pqg = inp(F, I_ATQG); const float* pkg = inp(F, I_ATKG);
    const int ITS = F.G * 32;
    for (int it0 = (F.bid * 8 + F.wave) * 4 + grp; it0 < T * 10; it0 += 4 * ITS) {
        u32x4 xw4[4];
#pragma unroll
        for (int q = 0; q < 4; ++q) { const int it = it0 + q * ITS; xw4[q] = (u32x4){0u, 0u, 0u, 0u}; if (it < T * 10) { const int row = it / 10, hh = it - row * 10; xw4[q] = *(const u32x4*)(QKV + (size_t)row * 1536 + hh * 128 + i16 * 8); } }
#pragma unroll
        for (int q = 0; q < 4; ++q) { const int it = it0 + q * ITS; const bool valid = it < T * 10; const int itc = valid ? it : 0;
            const int row = itc / 10, hh = itc - row * 10; const int b = row / SB, s = row - b * SB;
            bf16_t* p = QKV + (size_t)row * 1536 + hh * 128 + i16 * 8;
            const u32x4 xw = xw4[q];
            float x[8] = {bflo(xw.x), bfhi(xw.x), bflo(xw.y), bfhi(xw.y), bflo(xw.z), bfhi(xw.z), bflo(xw.w), bfhi(xw.w)};
            float ss = 0.f;
#pragma unroll
            for (int e = 0; e < 8; ++e) ss += x[e] * x[e];
            ss = wave16_sum(ss);
            const float rstd = rsqrtf(ss * (1.f / 128.f) + NORM_EPS);
            const float* g = (hh < 8 ? pqg : pkg) + i16 * 8;
#pragma unroll
            for (int e = 0; e < 8; ++e) x[e] = x[e] * rstd * g[e];
            float y[8];
#pragma unroll
            for (int e = 0; e < 8; ++e) y[e] = __shfl_xor(x[e], 4);
            if (s >= CTX) { const int t = s - CTX; const int pos = (i16 >> 3) ? (t & 63) : (t >> 6); const bool half1 = (i16 >> 2) & 1;
#pragma unroll
                for (int e = 0; e < 8; ++e) { const f32x2 cs = ROPE[pos * 32 + (i16 & 3) * 8 + e];
                    x[e] = half1 ? (x[e] * cs.x + y[e] * cs.y) : (x[e] * cs.x - y[e] * cs.y); } }
            u32x4 o; o.x = pk2(x[0], x[1]); o.y = pk2(x[2], x[3]); o.z = pk2(x[4], x[5]); o.w = pk2(x[6], x[7]);
            if (valid) *(u32x4*)p = o;
        }
    }
}
__device__ __forceinline__ void attn_phase(Frame& F) {
    const bf16_t* QKV = (const bf16_t*)(F.ws + WS_QKV); bf16_t* AO = (bf16_t*)(F.ws + WS_AO);
    for (int u = F.bid; u < 544; u += F.G) {
        int b, h, q0, k0, seq;
        if (u < 512) { const int qb = u & 15, hg = (u >> 4) & 3, kvh = (u >> 6) & 1; b = u >> 7; h = kvh * 4 + hg; q0 = b * SB + CTX + qb * 256; k0 = b * SB; seq = SB; }
        else { const int v = u - 512; b = v >> 3; h = v & 7; q0 = b * SB; k0 = b * SB; seq = CTX; }
        const int kvh = h >> 2;
        const bf16_t* Kp = (const bf16_t*)pg8::uptr((const char*)(QKV + (size_t)k0 * 1536 + 1024 + kvh * 128));
        att::attn_dense_body((const bf16_t*)pg8::uptr((const char*)(QKV + (size_t)q0 * 1536 + h * 128)), Kp, Kp + 256, (bf16_t*)pg8::uptr((const char*)(AO + (size_t)q0 * D + h * 128)), seq, F.ldsg, F.tid);
        __syncthreads();
    }
}

__device__ __forceinline__ void spatial_phase(Frame& F) {
    const bf16_t* UVB = (const bf16_t*)(F.ws + WS_UVB); bf16_t* UV = (bf16_t*)(F.ws + WS_UV); const f32x2* statp = (const f32x2*)(F.ws + WS_STATP);
    const bf16_t* Ws = (const bf16_t*)(F.ws + WS_W_CMS); const float* lng = inp(F, I_CMLNG); const float* lnb = inp(F, I_CMLNB); const float* bs = inp(F, I_CMBS);
    LAS uchar* vl = F.lds;
    LAS f32x2* st = (LAS f32x2*)(F.lds + 65536);
    const int tid = F.tid, lane = F.lane, wid = F.wave, r32 = lane & 31, hi = lane >> 5, wm = wid & 3, wn = wid >> 2;
    const int sr = tid >> 4, sc = (tid & 15) * 8;
    for (int u = F.bid; u < 136 * 8; u += F.G) {
        const int chunk = u >> 3, g = u & 7; const int row0 = chunk * 128;
        float s_ = 0.f, q_ = 0.f;
        { const f32x2* sp = statp + (size_t)(row0 + (tid >> 2)) * 32 + (tid & 3) * 8; f32x2 pv[8];
#pragma unroll
          for (int k = 0; k < 8; ++k) pv[k] = sp[k];
#pragma unroll
          for (int k = 0; k < 8; ++k) { s_ += pv[k].x; q_ += pv[k].y; } }
        u32x4 xw[2][4]; f32x4 lg0[2], lg1[2], lb0[2], lb1[2];
#pragma unroll
        for (int ch = 0; ch < 2; ++ch) { const int cg = g * 256 + ch * 128 + sc;
            lg0[ch] = *(const f32x4*)(lng + cg); lg1[ch] = *(const f32x4*)(lng + cg + 4); lb0[ch] = *(const f32x4*)(lnb + cg); lb1[ch] = *(const f32x4*)(lnb + cg + 4);
#pragma unroll
            for (int i = 0; i < 4; ++i) xw[ch][i] = *(const u32x4*)(UVB + (size_t)(row0 + sr + 32 * i) * 4096 + 2048 + cg); }
        bf16x8 pa[2][4];
#pragma unroll
        for (int kt = 0; kt < 2; ++kt)
#pragma unroll
            for (int ks = 0; ks < 4; ++ks) pa[kt][ks] = *(const bf16x8*)(Ws + ((size_t)g * 128 + 32 * wm + r32) * 128 + 64 * kt + 16 * ks + 8 * hi);
        u32x4 uu[8];
#pragma unroll
        for (int i = 0; i < 8; ++i) { const int id = tid + 512 * i, row = id >> 5, ch = id & 31; uu[i] = *(const u32x4*)(UVB + (size_t)(row0 + row) * 4096 + g * 256 + ch * 8); }
        s_ += __int_as_float(__builtin_amdgcn_update_dpp(0, __float_as_int(s_), 0xB1, 0xF, 0xF, true)); s_ += __int_as_float(__builtin_amdgcn_update_dpp(0, __float_as_int(s_), 0x4E, 0xF, 0xF, true));
        q_ += __int_as_float(__builtin_amdgcn_update_dpp(0, __float_as_int(q_), 0xB1, 0xF, 0xF, true)); q_ += __int_as_float(__builtin_amdgcn_update_dpp(0, __float_as_int(q_), 0x4E, 0xF, 0xF, true));
        __syncthreads();
        if ((tid & 3) == 0) { const float mean = s_ * (1.f / 2048.f); const float var = fmaxf(q_ * (1.f / 2048.f) - mean * mean, 0.f); st[tid >> 2] = (f32x2){mean, rsqrtf(var + NORM_EPS)}; }
        __syncthreads();
#pragma unroll
        for (int ch = 0; ch < 2; ++ch) {
#pragma unroll
            for (int i = 0; i < 4; ++i) { const int q = sr + 32 * i; const u32x4 x_ = xw[ch][i]; const f32x2 ms = st[q];
                f32x4 v0 = {bflo(x_.x), bfhi(x_.x), bflo(x_.y), bfhi(x_.y)}, v1 = {bflo(x_.z), bfhi(x_.z), bflo(x_.w), bfhi(x_.w)};
                v0 = (v0 - ms.x) * ms.y * lg0[ch] + lb0[ch]; v1 = (v1 - ms.x) * ms.y * lg1[ch] + lb1[ch];
                u32x4 o; o.x = pk2(v0.x, v0.y); o.y = pk2(v0.z, v0.w); o.z = pk2(v1.x, v1.y); o.w = pk2(v1.z, v1.w);
                *(LAS u32x4*)(vl + ((q >> 6) * 2 + ch) * 16384 + att::v_st(q & 63, sc)) = o; } }
        __syncthreads();
        f32x16 o[4] = {};
        const int vb = (int)(uintptr_t)(F.ldsg) + att::v_rd_base(lane) + wn * 16384;
        att::pv_d0(o, vb, pa[0][0], pa[0][1], pa[0][2], pa[0][3]);
        att::pv_d0(o, vb + 32768, pa[1][0], pa[1][1], pa[1][2], pa[1][3]);
        __syncthreads();
#pragma unroll
        for (int r = 0; r < 16; ++r) { const int p = 32 * wm + att::crow(r, hi); const float bsv = bs[g * 128 + p];
#pragma unroll
            for (int d0 = 0; d0 < 4; ++d0) *(LAS bf16_t*)(vl + p * 512 + (128 * wn + 32 * d0 + r32) * 2) = (bf16_t)f2bf(o[d0][r] + bsv); }
        __syncthreads();
#pragma unroll
        for (int i = 0; i < 8; ++i) { const int id = tid + 512 * i, row = id >> 5, ch = id & 31; const u32x4 v = *(const LAS u32x4*)(vl + row * 512 + ch * 16); const u32x4 w = uu[i];
            u32x4 o4; o4.x = pk2(bflo(v.x) * bflo(w.x), bfhi(v.x) * bfhi(w.x)); o4.y = pk2(bflo(v.y) * bflo(w.y), bfhi(v.y) * bfhi(w.y)); o4.z = pk2(bflo(v.z) * bflo(w.z), bfhi(v.z) * bfhi(w.z)); o4.w = pk2(bflo(v.w) * bflo(w.w), bfhi(v.w) * bfhi(w.w));
            *(u32x4*)(UV + (size_t)(row0 + row) * 2048 + g * 256 + ch * 8) = o4; }
    }
    __syncthreads();
}

__device__ __forceinline__ void final_phase(Frame& F) {
    const uchar* Xb = F.ws + WS_X; const uchar* YSb = F.ws + WS_Y1; const u32x2* YM = (const u32x2*)(F.ws + WS_YM); f32x4* out = (f32x4*)F.out;
    const f32x4* G5 = (const f32x4*)((const float*)(F.ws + WS_MOD) + (size_t)(DEPTH - 1) * 5 * NMODV + 5 * D);
    const int NGT = F.G * 512;
    for (int i0 = F.bid * 512 + F.tid; i0 < NB * SEQ * 256; i0 += 4 * NGT) { f32x4 a[4], ysum[4]; u32x2 ym[4];
#pragma unroll
        for (int q = 0; q < 4; ++q) { const int i = i0 + q * NGT; if (i < NB * SEQ * 256) { const int r = i >> 8, c4 = i & 255, b = r >> 12, t = r & 4095; const size_t src = ((size_t)(b * SB + CTX + t) << 8) + c4;
            if constexpr (X_BF16) { const u32x2 xb = ((const u32x2*)Xb)[src]; a[q] = (f32x4){bflo(xb.x), bfhi(xb.x), bflo(xb.y), bfhi(xb.y)}; } else a[q] = ((const f32x4*)Xb)[src];
            if constexpr (Y_FP8) { const unsigned y0 = ((const unsigned*)YSb)[src], y1 = ((const unsigned*)YSb)[src + (size_t)T * 256]; ysum[q] = (fp8x4_to_f32(y0) + fp8x4_to_f32(y1)) * (1.f / 16.f); }
            else { const u32x2 y0 = ((const u32x2*)YSb)[src], y1 = ((const u32x2*)YSb)[src + (size_t)T * 256]; ysum[q] = (f32x4){bflo(y0.x) + bflo(y1.x), bfhi(y0.x) + bfhi(y1.x), bflo(y0.y) + bflo(y1.y), bfhi(y0.y) + bfhi(y1.y)}; }
            ym[q] = YM[src]; } }
#pragma unroll
        for (int q = 0; q < 4; ++q) { const int i = i0 + q * NGT; if (i < NB * SEQ * 256) { const int r = i >> 8, c4 = i & 255, b = r >> 12; const f32x4 g5 = G5[(size_t)b * (NMODV / 4) + c4];
            out[i] = a[q] + (f32x4){bflo(ym[q].x), bfhi(ym[q].x), bflo(ym[q].y), bfhi(ym[q].y)} + g5 * ysum[q]; } } }
}

constexpr int NPHASE = 38;
__global__ void __launch_bounds__(512, 2) mk_fwd(Args args) {
    extern __shared__ __attribute__((aligned(16))) uchar lds[];
    Frame F; F.lds = (LAS uchar*)lds; F.ldsg = (char*)lds; F.tid = threadIdx.x; F.lane = F.tid & 63; F.wave = __builtin_amdgcn_readfirstlane(F.tid >> 6); F.G = gridDim.x; F.bid = blockIdx.x;
    F.ws = args.ws; F.out = args.out;
    uchar* ws0 = args.ws;
    volatile LAS unsigned* MISC = (volatile LAS unsigned*)(F.lds + LDSCTL_OFF);
    LAS int* tab = (LAS int*)(F.lds + LDSCTL_OFF + 256);
    for (int u = F.tid; u < (LDS_BYTES - LDSCTL_OFF) / 4; u += 512) ((LAS unsigned*)(F.lds + LDSCTL_OFF))[u] = 0u;
    __syncthreads();
    if (F.tid == 0) {
#pragma unroll
        for (int i = 0; i < 34; ++i) *(LAS unsigned long long*)(F.lds + LDSCTL_OFF + 576 + i * 8) = (unsigned long long)args.in[i]; }
    __syncthreads();
    const int lo = args.ph_lo, hi = args.ph_hi;
    if (hi - lo > 1) (void)xcd_barrier_post((unsigned*)(ws0 + WS_CTL) + CW_BAR, MISC + 8);
    int ph = 0;
#define PH_BEGIN if (ph >= opaque_uniform_int(args.ph_lo) && ph < opaque_uniform_int(args.ph_hi)) { int t_ = threadIdx.x; F.G = opaque_uniform_int(gridDim.x); F.bid = opaque_uniform_int(blockIdx.x); const int cid = F.bid; (void)cid; \
        F.out = (float*)opaque_uniform_ptr(args.out); F.lds = (LAS uchar*)lds; F.ldsg = (char*)lds; \
        asm volatile("" : "+v"(t_)); F.tid = t_; F.lane = t_ & 63; F.wave = __builtin_amdgcn_readfirstlane(t_ >> 6); \
        uchar* ws = (uchar*)opaque_uniform_ptr(args.ws); F.ws = ws; \
        const float* MODl = (const float*)(ws + WS_MOD) + (size_t)l_ * 5 * NMODV; (void)MODl;
#define GRIDBAR  { XcdBarrier bb_; bb_.bar = (unsigned*)(ws + WS_CTL) + CW_BAR; bb_.x = 0; bb_.st = (volatile LAS unsigned*)(F.lds + LDSCTL_OFF) + 8; xcd_barrier(bb_); }
#define REPBAR   if (rep_ > 1) GRIDBAR
#define PH_END   if (ph + 1 < opaque_uniform_int(args.ph_hi)) GRIDBAR } ++ph;

    { const int l_ = 0; PH_BEGIN PM(0) { const bool dry = rep_ > 1; (void)dry;  p0_prologue(F);  REPBAR } PH_END }

#pragma unroll 1
    for (int l = 0; l < DEPTH; ++l) {
        const int kind = l % 3, j = l / 3; const bool lastl = (l == DEPTH - 1); const int l_ = l;
        PH_BEGIN PM(1) { const bool dry = rep_ > 1; (void)dry;  const float* gv_ = inp(F, I_NMG) + l * D;
            if (l == 0) norm_phase<false, 0, true>(F, l, gv_, 0, false, false);
            else if (rep_ != REPN(1)) norm_phase<false, 0, false>(F, l, gv_, 0, false, false);
            else if (l == 1) norm_phase<false, 3, true>(F, l, gv_, 0, false, false);
            else norm_phase<false, 3, false>(F, l, gv_, 0, false, false);  REPBAR } PH_END
        if (kind == 0) {
            PH_BEGIN PM(2) { const bool dry = rep_ > 1; (void)dry;  { pg8::DenseOrder S; S.init(ws + WS_H, D, ws + WS_W_RGIN + (size_t)j * 2048 * 1024 * 2, D, T, 2048, F.G, cid);
                EpiRgIn E{(bf16_t*)(ws + WS_GG), (bf16_t*)(ws + WS_XB)}; pg8::gemm_phase(F.lds, S, E, D, D, D); }  REPBAR } PH_END
            PH_BEGIN PM(3) { const bool dry = rep_ > 1; (void)dry;  conv_phase(F, j);  REPBAR } PH_END
            PH_BEGIN PM(4) { const bool dry = rep_ > 1; (void)dry;  { pg8::DenseOrder S; S.init(ws + WS_XC, D, ws + WS_W_RGG + (size_t)j * 16 * 256 * 128 * 2, 128, T, 16 * 256, F.G, cid, 7, 256);
                EpiRgGate E{(const bf16_t*)(ws + WS_XC), (bf16_t*)(ws + WS_LA), (bf16_t*)(ws + WS_BB), inp(F, I_RGBA) + (size_t)j * 2 * D, inp(F, I_RGBI) + (size_t)j * 2 * D, (const float*)(ws + WS_SPL) + (size_t)j * 2 * D};
                pg8::gemm_phase(F.lds, S, E, 128, D, 128); }  REPBAR } PH_END
            PH_BEGIN PM(5) { const bool dry = rep_ > 1; (void)dry;  scan1_phase(F);  REPBAR } PH_END
            PH_BEGIN PM(20) { const bool dry = rep_ > 1; (void)dry;  scan2_phase(F);  REPBAR } PH_END
            PH_BEGIN PM(6) { const bool dry = rep_ > 1; (void)dry;  scan3_phase(F);  REPBAR } PH_END
            PH_BEGIN PM(7) { const bool dry = rep_ > 1; (void)dry;  { EpiResid E{(bf16_t*)(ws + (dry ? WS_Y1 : WS_YM)), MODl + 2 * D};
                if (lastl) { pg8::DenseOrderT<true> S; S.init(ws + WS_SA, D, ws + WS_W_RGOUT + (size_t)j * 1024 * 1024 * 2, D, T, D, F.G, cid); pg8::gemm_phase(F.lds, S, E, D, D, D); }
                else { pg8::DenseOrder S; S.init(ws + WS_SA, D, ws + WS_W_RGOUT + (size_t)j * 1024 * 1024 * 2, D, T, D, F.G, cid); pg8::gemm_phase(F.lds, S, E, D, D, D); }
                router_fill(F, l); }  REPBAR } PH_END
        } else if (kind == 1) {
            PH_BEGIN PM(8) { const bool dry = rep_ > 1; (void)dry;  { pg8::DenseOrder S; S.init(ws + WS_H, D, ws + WS_W_QKV, D, T, 1536, F.G, cid);
                EpiQKV E{(bf16_t*)(ws + WS_QKV), inp(F, I_ATQG), inp(F, I_ATKG), (const float*)(ws + WS_ROPE), (LAS float*)(F.lds + RING_BYTES)}; pg8::gemm_phase(F.lds, S, E, D, D, D); }  REPBAR } PH_END
            PH_BEGIN PM(10) { const bool dry = rep_ > 1; (void)dry;  attn_phase(F);  REPBAR } PH_END
            PH_BEGIN PM(11) { const bool dry = rep_ > 1; (void)dry;  { pg8::DenseOrder S; S.init(ws + WS_AO, D, ws + WS_W_AO, D, T, D, F.G, cid);
                EpiResid E{(bf16_t*)(ws + (dry ? WS_Y1 : WS_YM)), MODl + 2 * D}; pg8::gemm_phase(F.lds, S, E, D, D, D); router_fill(F, l); }  REPBAR } PH_END
        } else {
            PH_BEGIN PM(12) { const bool dry = rep_ > 1; (void)dry;  { pg8::DenseOrder S; S.init(ws + WS_H, D, ws + WS_W_CMIN, D, T, 4096, F.G, cid);
                EpiCmIn E{(bf16_t*)(ws + WS_UVB), (f32x2*)(ws + WS_STATP)}; pg8::gemm_phase(F.lds, S, E, D, D, D); }  REPBAR } PH_END
            PH_BEGIN PM(13) { const bool dry = rep_ > 1; (void)dry;  spatial_phase(F);  REPBAR } PH_END
            PH_BEGIN PM(14) { const bool dry = rep_ > 1; (void)dry;  { pg8::DenseOrder S; S.init(ws + WS_UV, 2048, ws + WS_W_CMOUT, 2048, T, D, F.G, cid);
                EpiResid E{(bf16_t*)(ws + (dry ? WS_Y1 : WS_YM)), MODl + 2 * D}; pg8::gemm_phase(F.lds, S, E, 2048, 2048, 2048); router_fill(F, l); }  REPBAR } PH_END
        }
        PH_BEGIN PM(15) { const bool dry = rep_ > 1; (void)dry;  if (l == 0) norm_phase<true, 1, true>(F, l, inp(F, I_NFG) + l * D, 3, lastl, dry); else norm_phase<true, 1, false>(F, l, inp(F, I_NFG) + l * D, 3, lastl, dry);  REPBAR } PH_END
        PH_BEGIN PM(16) { const bool dry = rep_ > 1; (void)dry;  { const int ntile = moe_table(F, l, tab);
            const int units = ntile * 4, rounds = (units + F.G - 1) / F.G; int geff = F.G; if (false && rounds > 0) { geff = (((units + rounds - 1) / rounds) + 7) & ~7; if (geff > F.G) geff = F.G; }
            constexpr int EB = MOE_FP8 ? 1 : 2;
            MoeOrder<true> S{tab, (const char*)(ws + WS_H), (const char*)(ws + WS_W_E1 + (size_t)l * 32 * 1024 * 1024 * EB), (const int*)(ws + WS_BK2), geff, cid, units, (size_t)1024 * 1024 * EB, 1024 * EB, 1024 * EB};
            EpiMoe1 E{ws + WS_H1}; pg8::gemm_phase(F.lds, S, E, D * EB / 2, D * EB / 2, D * EB / 2); }  REPBAR } PH_END
        PH_BEGIN PM(17) { const bool dry = rep_ > 1; (void)dry;  { const int ntile = tab[32];
            const int units = ntile * 4, rounds = (units + F.G - 1) / F.G; int geff = F.G; if (false && rounds > 0) { geff = (((units + rounds - 1) / rounds) + 7) & ~7; if (geff > F.G) geff = F.G; }
            constexpr int EB = MOE_FP8 ? 1 : 2;
            MoeOrder<false> S{tab, (const char*)(ws + WS_H1), (const char*)(ws + WS_W_E2 + (size_t)l * 32 * 1024 * 512 * EB), (const int*)(ws + WS_BK2), geff, cid, units, (size_t)1024 * 512 * EB, 512 * EB, 512 * EB};
            EpiMoe2 E{(bf16_t*)(ws + (dry ? WS_SCR + 64 * MiB : WS_Y1)), (const int*)(ws + WS_BK2), tab}; pg8::gemm_phase(F.lds, S, E, DEXP * EB / 2, DEXP * EB / 2, DEXP * EB / 2); }  REPBAR } PH_END
    }
    { const int l_ = 0; PH_BEGIN PM(18) { const bool dry = rep_ > 1; (void)dry;  final_phase(F);  REPBAR if constexpr (((REP_MASK) >> 19) & 1u) { for (int k_ = 0; k_ < 20; ++k_) GRIDBAR } } PH_END }
#undef PH_BEGIN
#undef PH_END
}

extern "C" void kernel_launch(void* const* d_in, const int* in_sizes, int n_in, void* d_out, int out_size, void* d_ws, size_t ws_size, hipStream_t stream) {
    static int grid = 0;
    if (grid == 0) {
        if (n_in != 34 || out_size != NB * SEQ * D || ws_size < WS_END) { fprintf(stderr, "kernel_launch: bad shapes n_in %d out %d ws %zu (need %zu)\n", n_in, out_size, ws_size, (size_t)WS_END); grid = -1; return; }
        int dev = 0, cus = 0, per_cu = 0;
        if (hipGetDevice(&dev) != hipSuccess || hipDeviceGetAttribute(&cus, hipDeviceAttributeMultiprocessorCount, dev) != hipSuccess) { grid = -1; return; }
        if (hipFuncSetAttribute((const void*)mk_fwd, hipFuncAttributeMaxDynamicSharedMemorySize, LDS_BYTES) != hipSuccess) { fprintf(stderr, "kernel_launch: hipFuncSetAttribute failed\n"); grid = -1; return; }
        if (hipOccupancyMaxActiveBlocksPerMultiprocessor(&per_cu, (const void*)mk_fwd, 512, LDS_BYTES) != hipSuccess || per_cu < 1) { fprintf(stderr, "kernel_launch: occupancy query says %d\n", per_cu); (void)hipGetLastError(); grid = -1; return; }
        grid = cus;
    }
    if (grid < 0) return;
    (void)hipMemsetAsync((char*)d_ws + WS_CTL, 0, CTL_BYTES, stream);
    Args a{};
    for (int i = 0; i < 34; ++i) a.in[i] = (const float*)d_in[i];
    a.out = (float*)d_out; a.ws = (uchar*)d_ws;
#if MK_PER_PHASE
    for (int p = 0; p < NPHASE; ++p) { a.ph_lo = p; a.ph_hi = p + 1; hipLaunchKernelGGL(mk_fwd, dim3(grid), dim3(512), LDS_BYTES, stream, a); }
#else
    a.ph_lo = 0; a.ph_hi = NPHASE;
    void* kargs[] = {&a};
    hipError_t e = hipLaunchCooperativeKernel((const void*)mk_fwd, dim3(grid), dim3(512), kargs, LDS_BYTES, stream);
    if (e != hipSuccess) fprintf(stderr, "kernel_launch: cooperative launch failed: %s (grid %d)\n", hipGetErrorString(e), grid);
#endif
}
```

```cpp
#include <hip/hip_runtime.h>
#include <hip/hip_bf16.h>
#include <cstdio>
#include <cstdint>

#ifndef X_BF16
#define X_BF16 1
#endif
#ifndef Y_FP8
#define Y_FP8 1
#endif
#ifndef MOE_FP8
#define MOE_FP8 1
#endif
#ifndef MK_PER_PHASE
#define MK_PER_PHASE 0
#endif

#ifndef PHASE_MASK
#define PHASE_MASK 0xFFFFFFFFu
#endif
#ifndef REP_MASK
#define REP_MASK 0u
#endif
#define REPN(i) ((((REP_MASK) >> (i)) & 1u) ? 2 : 1)
#define PM(i) if constexpr ((PHASE_MASK >> (i)) & 1u) for (int rep_ = REPN(i); rep_ > 0; --rep_)
#define LAS __attribute__((address_space(3)))
#define GAS __attribute__((address_space(1)))
typedef unsigned char uchar;
typedef unsigned short bf16_t;
typedef short bf16x8 __attribute__((ext_vector_type(8)));
typedef short s16x4 __attribute__((ext_vector_type(4)));
typedef float f32x4 __attribute__((ext_vector_type(4)));
typedef float f32x2 __attribute__((ext_vector_type(2)));
typedef float f32x16 __attribute__((ext_vector_type(16)));
typedef unsigned u32x4 __attribute__((ext_vector_type(4)));
typedef unsigned u32x2 __attribute__((ext_vector_type(2)));
typedef GAS unsigned gu32;
#define RLX_AGENT __ATOMIC_RELAXED, __HIP_MEMORY_SCOPE_AGENT

constexpr int D = 1024, NB = 4, SEQ = 4096, CTX = 256, SB = SEQ + CTX, T = NB * SB, DEPTH = 4;
constexpr int NMODV = 6 * D;
constexpr int NEXP = 32, DEXP = 512;
constexpr int NCH = SB / 16;
constexpr float NORM_EPS = 1e-6f;

constexpr size_t MiB = 1u << 20;
constexpr size_t WS_CTL = 0, CTL_BYTES = 1 * MiB;
constexpr size_t WS_MOD = 1 * MiB;
constexpr size_t WS_ROPE = 2 * MiB;
constexpr size_t WS_SPL = 2 * MiB + 65536;
constexpr size_t WS_BK2 = 3 * MiB;
constexpr size_t WS_TOT = 3 * MiB;
constexpr size_t WS_STATP = 8 * MiB;
constexpr size_t WS_BK = 13 * MiB;
constexpr size_t WS_TW = 15 * MiB + 512 * 1024;
constexpr size_t WS_W_RGIN = 16 * MiB, WS_W_RGG = 24 * MiB, WS_W_RGOUT = 26 * MiB, WS_W_QKV = 30 * MiB, WS_W_AO = 33 * MiB;
constexpr size_t WS_W_CMIN = 35 * MiB, WS_W_CMS = 43 * MiB, WS_W_CMOUT = 44 * MiB, WS_W_E1 = 48 * MiB, WS_W_E2 = 304 * MiB;
constexpr size_t WS_X = 432 * MiB, WS_Y1 = 500 * MiB, WS_H = 568 * MiB, WS_SCR = 602 * MiB;
constexpr size_t WS_GG = WS_SCR, WS_XB = WS_SCR + 34 * MiB, WS_XC = WS_SCR + 68 * MiB, WS_LA = WS_SCR + 102 * MiB, WS_BB = WS_SCR + 170 * MiB, WS_SA = WS_SCR + 238 * MiB;
constexpr size_t WS_QKV = WS_SCR, WS_AO = WS_SCR + 51 * MiB;
constexpr size_t WS_UVB = WS_SCR, WS_UV = WS_SCR + 136 * MiB;
constexpr size_t WS_H1 = WS_SCR;
constexpr size_t WS_TOTS = WS_SCR + 272 * MiB, WS_TOTH = WS_TOTS + 9 * MiB, WS_CARRY = WS_TOTH + 9 * MiB;
constexpr size_t WS_YM = WS_CARRY + 9 * MiB;
constexpr size_t WS_END = WS_YM + 34 * MiB;
constexpr int CW_TMO = 0, CW_BAR = 4096, CW_CNT = 16384;

constexpr int RING_BYTES = 131072;
constexpr int ROUTER_LDS = 36 * 1024 * 4;
constexpr int LDSCTL_OFF = 147456;
constexpr int LDS_BYTES = LDSCTL_OFF + 1024 + 8 * 4 * 40 * 4;

typedef float f32x2_t_ __attribute__((ext_vector_type(2))); typedef __bf16 bf16x2_t_ __attribute__((ext_vector_type(2)));
__device__ __forceinline__ unsigned pk2(float lo, float hi) { const f32x2_t_ v = {lo, hi}; const bf16x2_t_ b = __builtin_convertvector(v, bf16x2_t_); return __builtin_bit_cast(unsigned, b); }
__device__ __forceinline__ unsigned f2bf(float f) { return pk2(f, 0.f) & 0xffffu; }
__device__ __forceinline__ float bf2f(unsigned short h) { return __builtin_bit_cast(float, (unsigned)h << 16); }
__device__ __forceinline__ float bflo(unsigned w) { return __builtin_bit_cast(float, w << 16); }
__device__ __forceinline__ float bfhi(unsigned w) { return __builtin_bit_cast(float, w & 0xffff0000u); }
__device__ __forceinline__ unsigned cvt_pk_bf16(float lo, float hi) { return pk2(lo, hi); }
__device__ __forceinline__ f32x4 fp8x4_to_f32(unsigned w) { const f32x2 lo = __builtin_amdgcn_cvt_pk_f32_fp8((int)w, false), hi = __builtin_amdgcn_cvt_pk_f32_fp8((int)w, true); return (f32x4){lo.x, lo.y, hi.x, hi.y}; }
__device__ __forceinline__ float gelu_tanh(float x) { const float u2 = (-2.f * 0.7978845608028654f) * (x + 0.044715f * x * x * x); return x * __builtin_amdgcn_rcpf(1.f + __expf(u2)); }
__device__ __forceinline__ float sigmoidf_(float x) { return 1.f / (1.f + __expf(-x)); }
__device__ __forceinline__ float fast_sigmoid(float x) { return __builtin_amdgcn_rcpf(1.f + __expf(-x)); }
__device__ __forceinline__ float one_minus_exp(float y) {   const float p = y * (1.f - y * (0.5f - y * (0.16666667f - y * 0.041666667f))); const float q = 1.f - __expf(-y); return y < 0.0625f ? p : q; }
__device__ __forceinline__ int sidx_of_row(int row) { const int b = row / SB; return (row - b * SB) < CTX ? 4 : b; }

namespace pg8 {
constexpr int BM = 256, BK = 64, HALF = 128, HTB = HALF * BK * 2, NXCD = 8, WGM = 8;
__device__ __forceinline__ int lds_byte(int r, int c) { const int st = (r >> 4) * 2 + (c >> 5), rr = r & 15, cc = c & 31, ob = rr * 64 + cc * 2; return st * 1024 + (ob ^ (((ob >> 9) & 1) << 5)); }
__device__ __forceinline__ void stage_rc(int b, int& R, int& C) { const int st = b / 1024, sb = b % 1024, swz = sb ^ (((sb >> 9) & 1) << 5); R = (st >> 1) * 16 + swz / 64; C = (st & 1) * 32 + (swz % 64) / 2; }
__device__ __forceinline__ int perm32(int rho) { const int n = rho >> 4, i = rho & 15; return 8 * (i >> 2) + 4 * n + (i & 3); }
struct Unit { const char* a; const char* b; int pm, pn, aux0, aux1, hm; };
__device__ __forceinline__ const char* uptr(const char* p) { const unsigned long long v = (unsigned long long)p; const unsigned lo = __builtin_amdgcn_readfirstlane((unsigned)v), hi = __builtin_amdgcn_readfirstlane((unsigned)(v >> 32)); return (const char*)(const GAS char*)(((unsigned long long)hi << 32) | lo); }
__device__ __forceinline__ bool unit_slot(int i, int c, int G, int nwg, int& L, int& hm) {
    if (c >= G) return false;
    const int nfull = nwg / G, rem = nwg - nfull * G;
    if (i < nfull) { L = i * G + c; hm = 0xF; return true; }
    if (i > nfull || rem == 0) return false;
    if (rem * 2 <= G) { if (c >= 2 * rem) return false; L = nfull * G + (c >> 1); hm = (c & 1) ? 0xC : 0x3; return true; }
    if (c >= rem) return false; L = nfull * G + c; hm = 0xF; return true; }
__device__ __forceinline__ int xcd_remap(int L, int nwg) { const int q = nwg / NXCD, r = nwg % NXCD, xcd = L % NXCD, off = L / NXCD; return (xcd < r ? xcd * (q + 1) : r * (q + 1) + (xcd - r) * q) + off; }

template <bool LATENT>
struct DenseOrderT {
    static constexpr bool GATHER = false;
    const char* A; const char* B; int nM, nN, nwg, G, c; size_t tA, tB; int amask, acol;
    __device__ void init(const void* A_, int lda, const void* B_, int ldb, int M, int N, int G_, int c_, int amask_ = 0, int acol_ = 0) {
        A = (const char*)A_; B = (const char*)B_; nM = LATENT ? 64 : M / BM; nN = N / BM; nwg = nM * nN; G = G_; c = c_; tA = (size_t)BM * lda * 2; tB = (size_t)BM * ldb * 2; amask = amask_; acol = acol_; }
    __device__ bool next(int i, Unit& u) const {
        int L, hm; if (!unit_slot(i, c, G, nwg, L, hm)) return false; u.hm = __builtin_amdgcn_readfirstlane(hm);
        const int wgid = xcd_remap(L, nwg);
        const int nig = WGM * nN, gid = wgid / nig, fm = gid * WGM, gsz = (nM - fm) < WGM ? (nM - fm) : WGM;
        int pm_ = fm + ((wgid % nig) % gsz); if constexpr (LATENT) pm_ = (pm_ >> 4) * 17 + 1 + (pm_ & 15);
        u.pm = __builtin_amdgcn_readfirstlane(pm_); u.pn = __builtin_amdgcn_readfirstlane((wgid % nig) / gsz); u.aux0 = 0; u.aux1 = 0;
        u.a = uptr(A + (size_t)u.pm * tA + (size_t)(u.pn & amask) * acol); u.b = uptr(B + (size_t)u.pn * tB); return true; }
    __device__ unsigned goff(const Unit&, int) const { return 0u; }
};
typedef DenseOrderT<false> DenseOrder;

#define PG8_SA(b, h) (((b) * 2 + (h)) * HTB)
#define PG8_SB(b, h) ((4 + (b) * 2 + (h)) * HTB)
__device__ __forceinline__ void glds16(const char* sbase, unsigned voff, unsigned ldsaddr) { unsigned keep;
    asm volatile("s_mov_b32 %0, m0\n\ts_mov_b32 m0, %3\n\ts_nop 0\n\tglobal_load_lds_dwordx4 %1, %2\n\ts_mov_b32 m0, %0" : "=&s"(keep) : "v"(voff), "s"(sbase), "s"(ldsaddr) : "memory"); }
#ifndef PG8_ASM_DMA
#define PG8_ASM_DMA 1
#endif
#if PG8_ASM_DMA
#define PG8_GLDS(gp, voff, ldsoff) glds16((const char*)(gp), (voff), ldsbase + (unsigned)(ldsoff))
#else
#define PG8_GLDS(gp, voff, ldsoff) __builtin_amdgcn_global_load_lds((const unsigned*)((const char*)(gp) + (voff)), (LAS unsigned*)(lds + (ldsoff)), 16, 0, 0)
#endif
#define PG8_STAGE_B(bufoff, gbase) do { PG8_GLDS(gbase, voffB[0], (bufoff) + ldsw); PG8_GLDS(gbase, voffB[1], (bufoff) + ldsw + 8192); } while (0)
#define PG8_STAGE_A(bufoff, gbase, h, NX) do { if constexpr (Sched::GATHER) { \
        PG8_GLDS(gbase, ((NX) ? vAn[h][0] : vAc[h][0]), (bufoff) + ldsw); PG8_GLDS(gbase, ((NX) ? vAn[h][1] : vAc[h][1]), (bufoff) + ldsw + 8192); \
    } else { PG8_GLDS((const char*)(gbase) + (h) * hstepA, voffA[0], (bufoff) + ldsw); PG8_GLDS((const char*)(gbase) + (h) * hstepA, voffA[1], (bufoff) + ldsw + 8192); } } while (0)
#define PG8_LDA(dst, b, h) do { _Pragma("unroll") for (int m = 0; m < 4; ++m) _Pragma("unroll") for (int k = 0; k < 2; ++k) dst[m][k] = *(const LAS bf16x8*)(lds + PG8_SA(b, h) + aoff + m * 2048 + k * 1024); } while (0)
#define PG8_LDB(dst, b, h) do { _Pragma("unroll") for (int n = 0; n < 2; ++n) _Pragma("unroll") for (int k = 0; k < 2; ++k) dst[n][k] = *(const LAS bf16x8*)(lds + PG8_SB(b, h) + boff + n * 2048 + k * 1024); } while (0)
typedef int i32x8 __attribute__((ext_vector_type(8))); typedef int i32x4v __attribute__((ext_vector_type(4)));
__device__ __forceinline__ i32x8 cat8(bf16x8 lo, bf16x8 hi) { return __builtin_shufflevector(__builtin_bit_cast(i32x4v, lo), __builtin_bit_cast(i32x4v, hi), 0, 1, 2, 3, 4, 5, 6, 7); }
#define PG8_MMA(ai, bj, At, Bt) do { __builtin_amdgcn_s_setprio(1); _Pragma("unroll") for (int m = 0; m < 4; ++m) _Pragma("unroll") for (int n = 0; n < 2; ++n) { \
        if constexpr (Epi::FP8) { asm volatile("v_mfma_scale_f32_16x16x128_f8f6f4 %0, %1, %2, %0, %3, %3 op_sel_hi:[0,0,0]" : "+v"(acc[ai][bj][m][n]) : "v"(cat8(Bt[n][0], Bt[n][1])), "v"(cat8(At[m][0], At[m][1])), "v"(0x7F7F7F7F)); } \
        else { _Pragma("unroll") for (int k = 0; k < 2; ++k) acc[ai][bj][m][n] = __builtin_amdgcn_mfma_f32_16x16x32_bf16(Bt[n][k], At[m][k], acc[ai][bj][m][n], 0, 0, 0); } } __builtin_amdgcn_s_setprio(0); } while (0)
#define PG8_WAIT_V(n) asm volatile("s_waitcnt vmcnt(" #n ")" ::: "memory")
#define PG8_WAIT_L(n) asm volatile("s_waitcnt lgkmcnt(" #n ")" ::: "memory")
#define PG8_BAR __builtin_amdgcn_s_barrier()
#define PG8_SCHED __builtin_amdgcn_sched_barrier(0)

template <class Epi, class Sched>
__device__ __forceinline__ void gemm_phase(LAS uchar* lds, const Sched& S, const Epi& E, const int K, const int lda, const int ldb) {
    int tid = threadIdx.x; asm volatile("" : "+v"(tid));
    const int wid = __builtin_amdgcn_readfirstlane(tid >> 6), lane = tid & 63, wr = wid >> 2, wc = wid & 3; int fr = lane & 15, fq = lane >> 4;
    int nt = K / BK; asm volatile("" : "+s"(nt));
    unsigned voffA[2], voffB[2];
#pragma unroll
    for (int i = 0; i < 2; ++i) { int R, C; stage_rc(tid * 16 + i * 8192, R, C); const int Rb = Epi::PERM ? ((R & ~31) + perm32(R & 31)) : R;
        voffA[i] = (unsigned)(R * lda + C) * 2u; voffB[i] = (unsigned)(Rb * ldb + C) * 2u; }
    const size_t kstep = (size_t)(BK * 2);
    const size_t hstepA = (size_t)HALF * lda * 2, hstepB = (size_t)HALF * ldb * 2;
    const unsigned ldsw = (unsigned)wid * 1024u;
    const unsigned ldsbase = (unsigned)(uintptr_t)lds;
    const int aoff = lds_byte(wr * 64 + fr, fq * 8), boff = lds_byte(wc * 32 + fr, fq * 8);
    Unit cur, nxt; int ui = 0;
    if (!S.next(0, cur)) return;
    unsigned vAc[2][2], vAn[2][2];
#pragma unroll
    for (int h = 0; h < 2; ++h)
#pragma unroll
        for (int i = 0; i < 2; ++i) { vAc[h][i] = 0u; vAn[h][i] = 0u; }
    if constexpr (Sched::GATHER) {
#pragma unroll
        for (int h = 0; h < 2; ++h)
#pragma unroll
            for (int i = 0; i < 2; ++i) { int R, C; stage_rc(tid * 16 + i * 8192, R, C); vAc[h][i] = S.goff(cur, h * HALF + R) + (unsigned)C * 2u; }
    }
    f32x4 acc[2][2][4][2];
#pragma unroll
    for (int a = 0; a < 2; ++a)
#pragma unroll
        for (int b = 0; b < 2; ++b)
#pragma unroll
            for (int m = 0; m < 4; ++m)
#pragma unroll
                for (int n = 0; n < 2; ++n) acc[a][b][m][n] = (f32x4){0.f, 0.f, 0.f, 0.f};
    bf16x8 At[4][2], B0[2][2], B1[2][2];
    typedef int pre_t __attribute__((ext_vector_type(16))); pre_t pre = {};
    if constexpr (Epi::PREFETCH) pre = E.prefetch(cur, wr, fr);
    const char* cA = cur.a; const char* cB = cur.b;
    PG8_STAGE_B(PG8_SB(0, 0), cB); PG8_STAGE_B(PG8_SB(0, 1), cB + hstepB); PG8_STAGE_A(PG8_SA(0, 0), cA, 0, false); PG8_STAGE_A(PG8_SA(0, 1), cA, 1, false);
    if (wr == 1) PG8_BAR;
    PG8_WAIT_V(2); PG8_BAR;
    PG8_STAGE_B(PG8_SB(1, 0), cB + kstep); PG8_STAGE_A(PG8_SA(1, 0), cA + kstep, 0, false); PG8_STAGE_B(PG8_SB(1, 1), cB + hstepB + kstep);
    PG8_WAIT_V(6); PG8_BAR;
    for (;;) {
        const bool has_next = S.next(ui + 1, nxt);
        if constexpr (Sched::GATHER) { if (has_next) {
#pragma unroll
            for (int h = 0; h < 2; ++h)
#pragma unroll
                for (int i = 0; i < 2; ++i) { int R, C; int t2 = tid; asm volatile("" : "+v"(t2)); stage_rc(t2 * 16 + i * 8192, R, C); vAn[h][i] = S.goff(nxt, h * HALF + R) + (unsigned)C * 2u; }
            *(LAS u32x4*)(lds + 131072 + tid * 16) = (u32x4){vAn[0][0], vAn[0][1], vAn[1][0], vAn[1][1]}; } }
        const char* nA = has_next ? nxt.a : cA; const char* nB = has_next ? nxt.b : cB;
        for (int t = 0; t < nt; t += 2) {
            const bool last = (t == nt - 2);
            const bool nx = last && has_next;
            if constexpr (Sched::GATHER) { if (nx) { const u32x4 pk_ = *(const LAS u32x4*)(lds + 131072 + tid * 16); vAn[0][0] = pk_.x; vAn[0][1] = pk_.y; vAn[1][0] = pk_.z; vAn[1][1] = pk_.w; } }
            const char* a1 = cA + (size_t)(t + 1) * kstep;
            const char* a2 = last ? nA : cA + (size_t)(t + 2) * kstep; const char* b2 = last ? nB : cB + (size_t)(t + 2) * kstep;
            const char* a3 = a2 + kstep; const char* b3 = b2 + kstep;
            PG8_LDB(B0, 0, 0); PG8_LDB(B1, 0, 1); PG8_SCHED; PG8_LDA(At, 0, 0); PG8_STAGE_A(PG8_SA(1, 1), a1, 1, false);
            PG8_WAIT_V(8); PG8_WAIT_L(0); PG8_BAR; if (cur.hm & 1) { PG8_MMA(0, 0, At, B0); PG8_MMA(0, 1, At, B1); } PG8_BAR; PG8_SCHED;
            PG8_LDA(At, 0, 1); PG8_STAGE_B(PG8_SB(0, 0), b2); PG8_STAGE_B(PG8_SB(0, 1), b2 + hstepB); PG8_STAGE_A(PG8_SA(0, 0), a2, 0, nx);
            PG8_WAIT_V(8); PG8_WAIT_L(0); PG8_BAR; if (cur.hm & 4) { PG8_MMA(1, 0, At, B0); PG8_MMA(1, 1, At, B1); } PG8_BAR; PG8_SCHED;
            PG8_LDB(B0, 1, 0); PG8_LDB(B1, 1, 1); PG8_SCHED; PG8_LDA(At, 1, 0); PG8_STAGE_A(PG8_SA(0, 1), a2, 1, nx);
            PG8_WAIT_V(8); PG8_WAIT_L(0); PG8_BAR; if (cur.hm & 1) { PG8_MMA(0, 0, At, B0); PG8_MMA(0, 1, At, B1); } PG8_BAR; PG8_SCHED;
            PG8_LDA(At, 1, 1); PG8_STAGE_B(PG8_SB(1, 0), b3); PG8_STAGE_B(PG8_SB(1, 1), b3 + hstepB); PG8_STAGE_A(PG8_SA(1, 0), a3, 0, nx);
            PG8_WAIT_V(8); PG8_WAIT_L(0); PG8_BAR; if (cur.hm & 4) { PG8_MMA(1, 0, At, B0); PG8_MMA(1, 1, At, B1); } PG8_BAR; PG8_SCHED;
        }
        if (wr == 0) PG8_BAR;
        if constexpr (Epi::FP8) asm volatile("s_nop 15\n\ts_nop 15" ::: "memory");
        if constexpr (Epi::PREFETCH) E(acc, cur, wr, wc, fr, fq, pre); else E(acc, cur, wr, wc, fr, fq);
        if (!has_next) break;
#pragma unroll
        for (int a = 0; a < 2; ++a)
#pragma unroll
            for (int b = 0; b < 2; ++b)
#pragma unroll
                for (int m = 0; m < 4; ++m)
#pragma unroll
                    for (int n = 0; n < 2; ++n) acc[a][b][m][n] = (f32x4){0.f, 0.f, 0.f, 0.f};
        cur = nxt; cA = nA; cB = nB; ++ui;
        if constexpr (Epi::PREFETCH) pre = E.prefetch(cur, wr, fr);
        if constexpr (Sched::GATHER) {
#pragma unroll
            for (int h = 0; h < 2; ++h)
#pragma unroll
                for (int i = 0; i < 2; ++i) vAc[h][i] = vAn[h][i]; }
        if (wr == 1) PG8_BAR;
    }
    PG8_WAIT_V(0);
    PG8_BAR;
}
}

#ifndef ATT_SDEPTH
#define ATT_SDEPTH 1
#endif
namespace att {
constexpr int NW = 8, QBLK = 32, KVBLK = 64;
constexpr float SCALE = 0.088388347648318440f;
constexpr float THR = 8.f;
constexpr int LDQ = 1536, LDK = 1536, LDO = 1024;
constexpr size_t SHM_V = KVBLK * 128 * 2, SHM_K = KVBLK * 128 * 2, SHM_ATTN = 2 * SHM_V + 2 * SHM_K + NW * 64 * 4;
#define KSWZ(row, colB) ((row) * 256 + ((colB) ^ (((row) & 7) << 4)))
#define SBAR() __builtin_amdgcn_sched_barrier(0)
__device__ __forceinline__ int crow(int r, int hi) { return (r & 3) + 8 * (r >> 2) + 4 * hi; }
__device__ __forceinline__ void partialSM(f32x16& p0, f32x16& p1, float& m_reg, float& mn, float& alpha) {
  constexpr float C = SCALE * 1.4426950408889634f;
  float pmax = p0[0];
#pragma unroll
  for (int r = 1; r < 16; ++r) pmax = fmaxf(pmax, p0[r]);
#pragma unroll
  for (int r = 0; r < 16; ++r) pmax = fmaxf(pmax, p1[r]);
  { auto rr = __builtin_amdgcn_permlane32_swap(__float_as_uint(pmax), __float_as_uint(pmax), false, false);
    pmax = fmaxf(__uint_as_float(rr[0]), __uint_as_float(rr[1])); }
  if (__builtin_expect(__all(pmax - m_reg <= THR / SCALE), 1)) { mn = m_reg; alpha = 1.f; }
  else { mn = fmaxf(m_reg, pmax); alpha = __builtin_amdgcn_exp2f((m_reg - mn) * C); m_reg = mn; }
  float mnC = -mn * C;
#pragma unroll
  for (int r = 0; r < 16; ++r) p0[r] = fmaf(p0[r], C, mnC);
#pragma unroll
  for (int r = 0; r < 16; ++r) p1[r] = fmaf(p1[r], C, mnC);
#pragma unroll
  for (int r = 0; r < 16; ++r) p0[r] = __builtin_amdgcn_exp2f(p0[r]);
}
__device__ __forceinline__ void finishSM(f32x16& p0, f32x16& p1, float alpha, float& l_reg, bf16x8& pa0, bf16x8& pa1, bf16x8& pa2, bf16x8& pa3) {
#pragma unroll
  for (int r = 0; r < 16; ++r) p1[r] = __builtin_amdgcn_exp2f(p1[r]);
  float ps = 0;
#pragma unroll
  for (int r = 0; r < 16; ++r) ps += p0[r];
#pragma unroll
  for (int r = 0; r < 16; ++r) ps += p1[r];
  { auto rr = __builtin_amdgcn_permlane32_swap(__float_as_uint(ps), __float_as_uint(ps), false, false);
    ps = __uint_as_float(rr[0]) + __uint_as_float(rr[1]); }
  l_reg = l_reg * alpha + ps;
#define PK4(P, BASE, OUT) do { unsigned a0 = cvt_pk_bf16(P[BASE + 0], P[BASE + 1]), a1 = cvt_pk_bf16(P[BASE + 2], P[BASE + 3]);   \
    unsigned b0 = cvt_pk_bf16(P[BASE + 4], P[BASE + 5]), b1 = cvt_pk_bf16(P[BASE + 6], P[BASE + 7]);                              \
    auto r0 = __builtin_amdgcn_permlane32_swap(a0, b0, false, false); auto r1 = __builtin_amdgcn_permlane32_swap(a1, b1, false, false); \
    u32x4 w = {r0[0], r1[0], r0[1], r1[1]}; OUT = __builtin_bit_cast(bf16x8, w); } while (0)
  PK4(p0, 0, pa0); PK4(p0, 8, pa1); PK4(p1, 0, pa2); PK4(p1, 8, pa3);
#undef PK4
}
__device__ __forceinline__ void qkt(f32x16& p0, f32x16& p1, const bf16_t* Ks, const bf16x8* qr, int r32, int hi) {
  p0 = f32x16{}; p1 = f32x16{};
#pragma unroll
  for (int d0 = 0; d0 < 8; ++d0) { int cb = (d0 * 16 + hi * 8) * 2;
    bf16x8 b0 = *reinterpret_cast<const bf16x8*>((const char*)Ks + KSWZ(r32, cb));
    bf16x8 b1 = *reinterpret_cast<const bf16x8*>((const char*)Ks + KSWZ(32 + r32, cb));
    p0 = __builtin_amdgcn_mfma_f32_32x32x16_bf16(b0, qr[d0], p0, 0, 0, 0);
    p1 = __builtin_amdgcn_mfma_f32_32x32x16_bf16(b1, qr[d0], p1, 0, 0, 0); }
}
__device__ __forceinline__ int v_st(int k, int c) { const int kk = (k & ~0xC) | ((k & 4) << 1) | ((k & 8) >> 1); return ((kk >> 3) * 4 + (c >> 5)) * 512 + ((kk & 7) * 32 + (c & 31)) * 2; }
__device__ __forceinline__ int v_rd_base(int lane) { return ((lane & 3) << 3) | (((lane >> 2) & 3) << 6) | (((lane >> 4) & 1) << 5) | (((lane >> 5) & 1) << 8); }
constexpr int v_rd_off(int d0, int ks, int half) { return d0 * 512 + ks * 4096 + half * 2048; }
template <int OFF> __device__ __forceinline__ s16x4 tr_read(int vb) {
  s16x4 r; asm volatile("ds_read_b64_tr_b16 %0, %1 offset:%2" : "=&v"(r) : "v"(vb), "i"(OFF) : "memory"); return r;
}
template <int D0> __device__ __forceinline__ void pv_one(f32x16& od, int vb, bf16x8 pa0, bf16x8 pa1, bf16x8 pa2, bf16x8 pa3) {
  const s16x4 l0 = tr_read<v_rd_off(D0, 0, 0)>(vb), h0 = tr_read<v_rd_off(D0, 0, 1)>(vb), l1 = tr_read<v_rd_off(D0, 1, 0)>(vb), h1 = tr_read<v_rd_off(D0, 1, 1)>(vb);
  const s16x4 l2 = tr_read<v_rd_off(D0, 2, 0)>(vb), h2 = tr_read<v_rd_off(D0, 2, 1)>(vb), l3 = tr_read<v_rd_off(D0, 3, 0)>(vb), h3 = tr_read<v_rd_off(D0, 3, 1)>(vb);
  asm volatile("s_waitcnt lgkmcnt(0)" ::: "memory"); SBAR();
#define PK(L, H) (bf16x8){L[0], L[1], L[2], L[3], H[0], H[1], H[2], H[3]}
  od = __builtin_amdgcn_mfma_f32_32x32x16_bf16(pa0, PK(l0, h0), od, 0, 0, 0);
  od = __builtin_amdgcn_mfma_f32_32x32x16_bf16(pa1, PK(l1, h1), od, 0, 0, 0);
  od = __builtin_amdgcn_mfma_f32_32x32x16_bf16(pa2, PK(l2, h2), od, 0, 0, 0);
  od = __builtin_amdgcn_mfma_f32_32x32x16_bf16(pa3, PK(l3, h3), od, 0, 0, 0);
#undef PK
}
__device__ __forceinline__ void pv_d0(f32x16* o, int vb, bf16x8 pa0, bf16x8 pa1, bf16x8 pa2, bf16x8 pa3) {
  pv_one<0>(o[0], vb, pa0, pa1, pa2, pa3); pv_one<1>(o[1], vb, pa0, pa1, pa2, pa3); pv_one<2>(o[2], vb, pa0, pa1, pa2, pa3); pv_one<3>(o[3], vb, pa0, pa1, pa2, pa3);
}
__device__ __forceinline__ void attn_dense_body(const bf16_t* Qb, const bf16_t* Kh, const bf16_t* Vh, bf16_t* Ob, int seq, char* lds, const int tid) {
  const int wid = tid >> 6, lane = tid & 63, r32 = lane & 31, hi = lane >> 5;
  bf16_t* V_lds = (bf16_t*)lds; bf16_t* K_lds = (bf16_t*)(lds + 2 * SHM_V);
  float* ws = (float*)(lds + 2 * SHM_V + 2 * SHM_K) + wid * 64; float* li_l = ws; float* al_l = ws + 32;
  float m_reg = -1e30f, l_reg = 0; f32x16 o[4] = {}; bf16x8 qr[8];
  const bf16_t* Qw = Qb + (long)(wid * QBLK + r32) * LDQ + hi * 8;
#pragma unroll
  for (int d0 = 0; d0 < 8; ++d0) qr[d0] = *reinterpret_cast<const bf16x8*>(Qw + d0 * 16);
  const int sr = tid >> 4, sc = (tid & 15) * 8, vst0 = v_st(sr, sc), vst1 = v_st(32 + sr, sc);
  const int vb0 = (int)(uintptr_t)V_lds + v_rd_base(lane);
  struct { bf16x8 vs0, vs1, ks0, ks1; } sr_[ATT_SDEPTH];
  const unsigned vo0 = (unsigned)(sr * LDK + sc) * 2u, vo1 = (unsigned)((32 + sr) * LDK + sc) * 2u;
  const long vdelta = (const char*)Vh - (const char*)Kh;
#define SLOAD(i, k0) do { const char* kb_ = (const char*)Kh + (size_t)(k0) * (LDK * 2); const char* vb_ = kb_ + vdelta; \
    sr_[i].vs0 = *reinterpret_cast<const bf16x8*>(vb_ + vo0); sr_[i].vs1 = *reinterpret_cast<const bf16x8*>(vb_ + vo1); \
    sr_[i].ks0 = *reinterpret_cast<const bf16x8*>(kb_ + vo0); sr_[i].ks1 = *reinterpret_cast<const bf16x8*>(kb_ + vo1); } while (0)
#define SWRITE(b, i) do { *(bf16x8*)((char*)V_lds + (b) * SHM_V + vst0) = sr_[i].vs0;          \
    *(bf16x8*)((char*)V_lds + (b) * SHM_V + vst1) = sr_[i].vs1; int kc = sc * 2;               \
    *(bf16x8*)((char*)K_lds + (b) * SHM_K + KSWZ(sr, kc)) = sr_[i].ks0;                       \
    *(bf16x8*)((char*)K_lds + (b) * SHM_K + KSWZ(32 + sr, kc)) = sr_[i].ks1; } while (0)
#define SWAIT() do { if constexpr (ATT_SDEPTH == 2) asm volatile("s_waitcnt vmcnt(4)" ::: "memory"); else asm volatile("s_waitcnt vmcnt(0)" ::: "memory"); } while (0)
#define RESC(a) do { if (__any((a) < 1.f)) { if (hi == 0) al_l[r32] = (a); asm volatile("s_waitcnt lgkmcnt(0)" ::: "memory"); \
    _Pragma("unroll") for (int d = 0; d < 4; ++d) _Pragma("unroll") for (int r = 0; r < 16; ++r) o[d][r] *= al_l[crow(r, hi)]; } } while (0)
  f32x16 pA0, pA1, pB0, pB1; float mnA, mnB, alA, alB; bf16x8 pa0, pa1, pa2, pa3; const int NT = seq / KVBLK;
  constexpr int SE = 0, SO = ATT_SDEPTH - 1;
  SLOAD(SE, 0); asm volatile("s_waitcnt vmcnt(0)" ::: "memory"); SWRITE(0, SE); __syncthreads();
  qkt(pA0, pA1, K_lds, qr, r32, hi); partialSM(pA0, pA1, m_reg, mnA, alA);
  SLOAD(SO, KVBLK); if constexpr (ATT_SDEPTH == 2) { if (2 < NT) SLOAD(SE, 2 * KVBLK); }
  SWAIT(); SWRITE(1, SO); __syncthreads();
  for (int j = 1; j + 1 < NT; j += 2) {
    SBAR(); qkt(pB0, pB1, (bf16_t*)((char*)K_lds + SHM_K), qr, r32, hi);
    finishSM(pA0, pA1, alA, l_reg, pa0, pa1, pa2, pa3); SBAR();
    SLOAD(SO, (j + ATT_SDEPTH) * KVBLK); SBAR();
    pv_d0(o, vb0, pa0, pa1, pa2, pa3); partialSM(pB0, pB1, m_reg, mnB, alB);
    __syncthreads(); SWAIT(); SWRITE(0, SE);
    RESC(alB); __syncthreads();
    SBAR(); qkt(pA0, pA1, K_lds, qr, r32, hi);
    finishSM(pB0, pB1, alB, l_reg, pa0, pa1, pa2, pa3); SBAR();
    if (ATT_SDEPTH == 1 || j + 3 < NT) SLOAD(SE, (j + 1 + ATT_SDEPTH) * KVBLK); SBAR();
    pv_d0(o, vb0 + (int)SHM_V, pa0, pa1, pa2, pa3); partialSM(pA0, pA1, m_reg, mnA, alA);
    __syncthreads(); SWAIT(); SWRITE(1, SO);
    RESC(alA); __syncthreads();
  }
  SBAR(); qkt(pB0, pB1, (bf16_t*)((char*)K_lds + SHM_K), qr, r32, hi);
  finishSM(pA0, pA1, alA, l_reg, pa0, pa1, pa2, pa3); SBAR();
  pv_d0(o, vb0, pa0, pa1, pa2, pa3); partialSM(pB0, pB1, m_reg, mnB, alB);
  __syncthreads(); RESC(alB);
  finishSM(pB0, pB1, alB, l_reg, pa0, pa1, pa2, pa3); SBAR();
  pv_d0(o, vb0 + (int)SHM_V, pa0, pa1, pa2, pa3);
  if (hi == 0) li_l[r32] = l_reg; asm volatile("s_waitcnt lgkmcnt(0)" ::: "memory");
  float rli[16];
#pragma unroll
  for (int r = 0; r < 16; ++r) rli[r] = __builtin_amdgcn_rcpf(li_l[crow(r, hi)]);
  bf16_t* Ow = Ob + (long)(wid * QBLK) * LDO;
#pragma unroll
  for (int r = 0; r < 16; ++r) { int orow = crow(r, hi);
#pragma unroll
    for (int d0 = 0; d0 < 4; ++d0) Ow[(long)orow * LDO + d0 * 32 + r32] = (bf16_t)f2bf(o[d0][r] * rli[r]); }
#undef SLOAD
#undef SWRITE
#undef SWAIT
#undef RESC
}
}

#define XB_TMO      128
#define XB_XCNT(j)  (256  + 64 * (j))
#define XB_XSUB(j)  (1280 + 64 * (j))
#define XB_XGEN(j)  (2304 + 64 * (j))
#define XB_TOP      3328
#define XB_TOPGEN   3392
#define XB_SPIN_CAP (1u << 22)
__device__ __forceinline__ unsigned xb_ld(unsigned* p)              { return __hip_atomic_load(p, __ATOMIC_RELAXED, __HIP_MEMORY_SCOPE_AGENT); }
__device__ __forceinline__ unsigned xb_add(unsigned* p, unsigned v) { return __hip_atomic_fetch_add(p, v, __ATOMIC_RELAXED, __HIP_MEMORY_SCOPE_AGENT); }
__device__ __forceinline__ unsigned xb_xcc_id() { return (unsigned)__builtin_amdgcn_s_getreg((3 << 11) | 20) & 0xFu; }
#define XB_SPIN(cond, bar) do { unsigned _sp = 0; while (cond) { __builtin_amdgcn_s_sleep(1); \
    if ((++_sp & 255u) == 0u) { if (xb_ld(&(bar)[XB_TMO])) break; if (_sp > XB_SPIN_CAP) { atomicAdd(&(bar)[XB_TMO], 1u); break; } } } } while (0)
struct XcdBarrier { unsigned* bar; unsigned x; volatile LAS unsigned* st; };
__device__ __forceinline__ XcdBarrier xcd_barrier_post(unsigned* bar, volatile LAS unsigned* st) {
    XcdBarrier b; b.bar = bar; b.x = xb_xcc_id(); b.st = st;
    if (threadIdx.x == 0) (void)xb_add(&bar[XB_XCNT(b.x)], 1u);
    return b;
}
__device__ __forceinline__ void xcd_barrier_complete(unsigned* bar, unsigned x, unsigned& nloc, unsigned& nx) {
    const unsigned G = gridDim.x * gridDim.y * gridDim.z;
    unsigned sum, cnt, mine, sp = 0u;
    for (;;) {
        sum = 0u; cnt = 0u; mine = 0u;
#pragma unroll
        for (unsigned j = 0; j < 16; ++j) { const unsigned c = xb_ld(&bar[XB_XCNT(j)]); sum += c; cnt += (c > 0u) ? 1u : 0u; mine = (j == x) ? c : mine; }
        if (sum == G) break;
        __builtin_amdgcn_s_sleep(1);
        if ((++sp & 255u) == 0u) { if (xb_ld(&bar[XB_TMO])) break; if (sp > XB_SPIN_CAP) { atomicAdd(&bar[XB_TMO], 1u); break; } }
    }
    nloc = mine > 0u ? mine : 1u; nx = cnt > 0u ? cnt : 1u;
}
__device__ __forceinline__ void xcd_barrier(const XcdBarrier& b_) {
    XcdBarrier b; b.bar = b_.bar; b.st = b_.st; b.x = xb_xcc_id();
    asm volatile("s_waitcnt vmcnt(0)" ::: "memory");
    __syncthreads();
    if (threadIdx.x == 0) {
        unsigned* bar = b.bar;
        __builtin_amdgcn_s_waitcnt(0);
        unsigned nloc = b.st[0], nx = b.st[1];
        if (nloc == 0u) { xcd_barrier_complete(bar, b.x, nloc, nx); b.st[0] = nloc; b.st[1] = nx; }
        const unsigned old = xb_add(&bar[XB_XSUB(b.x)], 1u);
        const unsigned gen = old / nloc;
        if (old + 1u == (gen + 1u) * nloc) {
            __builtin_amdgcn_fence(__ATOMIC_RELEASE, "agent");
            asm volatile("s_waitcnt vmcnt(0)" ::: "memory");
            const unsigned og = xb_add(&bar[XB_TOP], 1u);
            const unsigned tg = og / nx;
            if (og + 1u == (tg + 1u) * nx) xb_add(&bar[XB_TOPGEN], 1u);
            else XB_SPIN(xb_ld(&bar[XB_TOPGEN]) == tg, bar);
            __builtin_amdgcn_fence(__ATOMIC_ACQUIRE, "agent");
            xb_add(&bar[XB_XGEN(b.x)], 1u);
            asm volatile("s_waitcnt vmcnt(0)" ::: "memory");
        } else {
            XB_SPIN(xb_ld(&bar[XB_XGEN(b.x)]) == gen, bar);
            __builtin_amdgcn_fence(__ATOMIC_ACQUIRE, "agent");
            asm volatile("s_waitcnt vmcnt(0)" ::: "memory");
        }
    }
    __syncthreads();
}

struct Args { const float* in[34]; float* out; uchar* ws; int ph_lo, ph_hi; };
enum { I_X = 0, I_C, I_CTX, I_CCTX, I_ADAW, I_ADAB, I_NMG, I_NFG, I_RGWIN, I_RGCW, I_RGCB, I_RGWA, I_RGBA, I_RGWI, I_RGBI, I_RGLAM, I_RGWOUT,
       I_ATQKV, I_ATQG, I_ATKG, I_ATWO, I_CMWIN, I_CMLNG, I_CMLNB, I_CMWS, I_CMBS, I_CMWOUT, I_MWG, I_MBG, I_MWR, I_MBR, I_MWGATE, I_MWUP, I_MWDOWN };

__device__ __forceinline__ const void* opaque_uniform_ptr(const void* p) { const unsigned long long v = (unsigned long long)p; unsigned lo = (unsigned)v, hi = (unsigned)(v >> 32); asm volatile("" : "+v"(lo), "+v"(hi));
    lo = __builtin_amdgcn_readfirstlane(lo); hi = __builtin_amdgcn_readfirstlane(hi); return (const void*)(const GAS char*)(((unsigned long long)hi << 32) | lo); }
__device__ __forceinline__ int opaque_uniform_int(int x) { asm volatile("" : "+v"(x)); return __builtin_amdgcn_readfirstlane(x); }
struct Frame {
    LAS uchar* lds; char* ldsg;
    int tid, lane, wave, G, bid;
    uchar* ws; float* out;
};
__device__ __forceinline__ const float* inp(const Frame& F, int i) { const unsigned long long v = *(const LAS unsigned long long*)(F.lds + LDSCTL_OFF + 576 + i * 8);
    const unsigned lo = __builtin_amdgcn_readfirstlane((unsigned)v), hi = __builtin_amdgcn_readfirstlane((unsigned)(v >> 32)); return (const float*)(const GAS float*)(((unsigned long long)hi << 32) | lo); }
__device__ __forceinline__ float wave16_sum(float v) {
    v += __int_as_float(__builtin_amdgcn_update_dpp(0, __float_as_int(v), 0xB1, 0xF, 0xF, true));
    v += __int_as_float(__builtin_amdgcn_update_dpp(0, __float_as_int(v), 0x4E, 0xF, 0xF, true));
    v += __int_as_float(__builtin_amdgcn_update_dpp(0, __float_as_int(v), 0x141, 0xF, 0xF, true));
    v += __int_as_float(__builtin_amdgcn_update_dpp(0, __float_as_int(v), 0x140, 0xF, 0xF, true));
    return v; }

struct ConvItem { const float* src; uchar* dst; int ldw, rowb; bool f8, perm; };
__device__ __forceinline__ void tr_load(const ConvItem& ci, f32x4 (&v)[16]) {
    if (ci.f8) {
#pragma unroll
        for (int i = 0; i < 8; ++i) { v[2 * i] = __builtin_nontemporal_load((const f32x4*)(ci.src + (size_t)(8 * i) * ci.ldw)); v[2 * i + 1] = __builtin_nontemporal_load((const f32x4*)(ci.src + (size_t)(8 * i + 1) * ci.ldw)); }
    } else {
#pragma unroll
        for (int i = 0; i < 16; ++i) v[i] = __builtin_nontemporal_load((const f32x4*)(ci.src + (size_t)(4 * i) * ci.ldw));
    }
}
__device__ __forceinline__ void tr_finish(const f32x4 (&v)[16], const ConvItem& ci, LAS uchar* scr, int lane, const int half) {
    LAS uchar* row2 = scr + 8192 + lane * 128; const int sw2 = lane & 7;
    const int kr = lane >> 4, nc = (lane & 15) * 4;
    const int g = lane >> 4, q = (lane >> 2) & 3, p = lane & 3;
    const int vb = (int)(uintptr_t)scr + q * 128 + g * 32 + p * 8;
    if (ci.f8) {
#pragma unroll
        for (int i = 0; i < 8; ++i) { const f32x4 a = v[2 * i] * 32.f, b = v[2 * i + 1] * 32.f;
            int r0 = __builtin_amdgcn_cvt_pk_fp8_f32(a.x, b.x, 0, false); r0 = __builtin_amdgcn_cvt_pk_fp8_f32(a.y, b.y, r0, true);
            int r1 = __builtin_amdgcn_cvt_pk_fp8_f32(a.z, b.z, 0, false); r1 = __builtin_amdgcn_cvt_pk_fp8_f32(a.w, b.w, r1, true);
            *(LAS u32x2*)(scr + (4 * i + kr) * 128 + nc * 2) = (u32x2){(unsigned)r0, (unsigned)r1}; }
        asm volatile("s_waitcnt lgkmcnt(0)" ::: "memory");
        s16x4 t[8];
#define TRR(r) t[r] = att::tr_read<(r) * 512>(vb)
        TRR(0); TRR(1); TRR(2); TRR(3); TRR(4); TRR(5); TRR(6); TRR(7);
#undef TRR
        asm volatile("s_waitcnt lgkmcnt(0)" ::: "memory"); __builtin_amdgcn_sched_barrier(0);
#pragma unroll
        for (int j = 0; j < 4; ++j) { const bf16x8 o = {t[2 * j][0], t[2 * j][1], t[2 * j][2], t[2 * j][3], t[2 * j + 1][0], t[2 * j + 1][1], t[2 * j + 1][2], t[2 * j + 1][3]}; *(LAS bf16x8*)(row2 + (((half * 4 + j) ^ sw2) * 16)) = o; }
    } else {
#pragma unroll
        for (int i = 0; i < 16; ++i) { u32x2 o; o.x = pk2(v[i].x, v[i].y); o.y = pk2(v[i].z, v[i].w); *(LAS u32x2*)(scr + (4 * i + kr) * 128 + nc * 2) = o; }
        asm volatile("s_waitcnt lgkmcnt(0)" ::: "memory");
        s16x4 t[16];
#define TRR(r) t[r] = att::tr_read<(r) * 512>(vb)
        TRR(0); TRR(1); TRR(2); TRR(3); TRR(4); TRR(5); TRR(6); TRR(7); TRR(8); TRR(9); TRR(10); TRR(11); TRR(12); TRR(13); TRR(14); TRR(15);
#undef TRR
        asm volatile("s_waitcnt lgkmcnt(0)" ::: "memory"); __builtin_amdgcn_sched_barrier(0);
#pragma unroll
        for (int j = 0; j < 8; ++j) { const bf16x8 o = {t[2 * j][0], t[2 * j][1], t[2 * j][2], t[2 * j][3], t[2 * j + 1][0], t[2 * j + 1][1], t[2 * j + 1][2], t[2 * j + 1][3]}; *(LAS bf16x8*)(row2 + ((j ^ sw2) * 16)) = o; }
    }
}
__device__ __forceinline__ void tr_flush(const ConvItem& ci, LAS uchar* scr, int lane) {
    const int r8 = lane >> 3, pc = lane & 7; const LAS uchar* p2 = scr + 8192 + r8 * 128 + ((pc ^ r8) * 16);
    u32x4 w[8];
#pragma unroll
    for (int j = 0; j < 8; ++j) w[j] = *(const LAS u32x4*)(p2 + j * 1024);
#pragma unroll
    for (int j = 0; j < 8; ++j) { int r = r8 + 8 * j;
        if (ci.perm) { const int hf = r >> 5, f = r & 31; r = 32 * (f >> 4) + 8 * ((f >> 2) & 3) + 4 * hf + (f & 3); }
        *(u32x4*)(ci.dst + (size_t)r * ci.rowb + pc * 16) = w[j]; }
}
struct Job { int g, lo, hi; };
__device__ __forceinline__ ConvItem conv_decode(Frame& F, int g, int it) {
    uchar* ws = F.ws; const float* W; int K = 1024, N = 1024, ldt = 1024, mode = 0; size_t dms = 0; bf16_t* WT;
    switch (g) {
        case 0:  W = inp(F, I_MWGATE); N = 512; WT = (bf16_t*)(ws + WS_W_E1); dms = (size_t)1024 * 1024; mode = 1; break;
        case 1:  W = inp(F, I_MWUP);   N = 512; WT = (bf16_t*)(ws + WS_W_E1); dms = (size_t)1024 * 1024; mode = 2; break;
        case 2:  W = inp(F, I_MWDOWN); K = 512; WT = (bf16_t*)(ws + WS_W_E2); ldt = 512; dms = (size_t)1024 * 512; break;
        case 3:  W = inp(F, I_RGWIN);  N = 2048; WT = (bf16_t*)(ws + WS_W_RGIN); dms = (size_t)2048 * 1024; break;
        case 4:  W = inp(F, I_CMWIN);  N = 4096; WT = (bf16_t*)(ws + WS_W_CMIN); break;
        case 5:  W = inp(F, I_RGWOUT); WT = (bf16_t*)(ws + WS_W_RGOUT); dms = (size_t)1024 * 1024; break;
        case 6:  W = inp(F, I_CMWOUT); K = 2048; WT = (bf16_t*)(ws + WS_W_CMOUT); ldt = 2048; break;
        case 7:  W = inp(F, I_ATQKV);  N = 1536; WT = (bf16_t*)(ws + WS_W_QKV); break;
        case 8:  W = inp(F, I_ATWO);   WT = (bf16_t*)(ws + WS_W_AO); break;
        case 9:  W = inp(F, I_RGWA);   K = 128; N = 128; WT = (bf16_t*)(ws + WS_W_RGG); ldt = 128; dms = (size_t)256 * 128; break;
        default: W = inp(F, I_RGWI);   K = 128; N = 128; WT = (bf16_t*)(ws + WS_W_RGG); ldt = 128; dms = (size_t)256 * 128; mode = 3; break;
    }
    const int nblk = N / 64, nkb = K / 64, per = nkb * nblk, mat = it / per, r = it - mat * per, kb = r % nkb, nb = r / nkb, n0 = nb * 64;
    int drow = n0;
    if (mode == 1) drow = (n0 >> 7) * 256 + (n0 & 127); else if (mode == 2) drow = (n0 >> 7) * 256 + 128 + (n0 & 127); else if (mode == 3) drow = 128 + n0;
    const int lane = F.lane;
    const bool f8 = (MOE_FP8 != 0) && g < 3; const int eb = f8 ? 1 : 2;
    ConvItem ci; ci.ldw = N; ci.f8 = f8; ci.src = W + (size_t)mat * K * N + (size_t)(kb * 64 + (f8 ? 2 : 1) * (lane >> 4)) * N + n0 + (lane & 15) * 4;
    ci.perm = (g == 7 && n0 < 1280);
    ci.rowb = ldt * eb;
    ci.dst = (uchar*)WT + ((size_t)mat * dms + (size_t)drow * ldt + (f8 ? (kb & ~1) : kb) * 64) * eb;
    return ci;
}
template <int NJ>
__device__ __forceinline__ ConvItem conv_find(Frame& F, int v, const Job (&jobs)[NJ]) { int r = v, g = jobs[0].g, it = 0; bool found = false;
#pragma unroll
    for (int q = 0; q < NJ; ++q) { const int n = jobs[q].hi - jobs[q].lo; if (!found) { if (r < n) { g = jobs[q].g; it = jobs[q].lo + r; found = true; } else r -= n; } }
    return conv_decode(F, g, it); }
template <int NJ>
__device__ __forceinline__ void conv_tail(Frame& F, int nblk0, const Job (&jobs)[NJ]) {
    if (nblk0 >= F.G) nblk0 = 0;
    if (F.bid < nblk0) return;
    LAS uchar* scr = F.lds + F.wave * 16384;
    int total = 0;
#pragma unroll
    for (int q = 0; q < NJ; ++q) total += jobs[q].hi - jobs[q].lo;
    const int npair = total >> 1, nw = (F.G - nblk0) * 8;
    int u = (F.bid - nblk0) * 8 + F.wave;
    f32x4 va[16], vb[16]; ConvItem c0, c1; c0.dst = nullptr; c1.dst = nullptr; c0.f8 = false; c1.f8 = false; c0.src = nullptr; c1.src = nullptr; c0.ldw = 0; c1.ldw = 0; c0.rowb = 0; c1.rowb = 0; c0.perm = false; c1.perm = false;
    if (u < npair) { c0 = conv_find(F, 2 * u, jobs); tr_load(c0, va); c1 = conv_find(F, 2 * u + 1, jobs); tr_load(c1, vb); }
    for (; u < npair; u += nw) {
        const int un = u + nw;
        tr_finish(va, c0, scr, F.lane, 0);
        if (!c0.f8) tr_flush(c0, scr, F.lane);
        if (un < npair) { c0 = conv_find(F, 2 * un, jobs); tr_load(c0, va); }
        tr_finish(vb, c1, scr, F.lane, 1);
        tr_flush(c1, scr, F.lane);
        if (un < npair) { c1 = conv_find(F, 2 * un + 1, jobs); tr_load(c1, vb); }
    }
}
__device__ __forceinline__ void p0_prologue(Frame& F) {
    uchar* ws = F.ws;
    {
        LAS float* act = (LAS float*)(F.lds);
        LAS float* red = (LAS float*)(F.lds + 5 * 1024 * 4);
        bool have = false; const float* pC = inp(F, I_C); const float* pCC = inp(F, I_CCTX); const float* pADAW = inp(F, I_ADAW); const float* pADAB = inp(F, I_ADAB);
        for (int it = F.bid; it < DEPTH * 32; it += F.G) {
            if (!have) { for (int i = F.tid; i < 5 * 1024; i += 512) { const int s = i >> 10, k = i & 1023; const float v = s < 4 ? pC[s * 1024 + k] : pCC[k]; act[i] = v / (1.f + __expf(-v)); } have = true; __syncthreads(); }
            const int l = it >> 5, cb = it & 31; const int ln = F.lane < 48 ? F.lane : 47;
            const float* W = pADAW + (size_t)l * 1024 * NMODV + cb * 192 + ln * 4;
            f32x4 a[5];
#pragma unroll
            for (int s = 0; s < 5; ++s) a[s] = (f32x4){0.f, 0.f, 0.f, 0.f};
            const int kbase = F.wave * 128;
#pragma unroll 8
            for (int k = 0; k < 128; ++k) { const f32x4 w = *(const f32x4*)(W + (size_t)(kbase + k) * NMODV);
#pragma unroll
                for (int s = 0; s < 5; ++s) a[s] += w * act[s * 1024 + kbase + k]; }
            if (F.lane < 48) {
#pragma unroll
                for (int s = 0; s < 5; ++s) *(LAS f32x4*)(red + (F.wave * 5 + s) * 192 + F.lane * 4) = a[s]; }
            __syncthreads();
            for (int i = F.tid; i < 5 * 192; i += 512) { const int s = i / 192, c = i - s * 192; float v = pADAB[l * NMODV + cb * 192 + c];
#pragma unroll
                for (int w = 0; w < 8; ++w) v += red[(w * 5 + s) * 192 + c];
                ((float*)(ws + WS_MOD))[(l * 5 + s) * NMODV + cb * 192 + c] = v; }
            __syncthreads();
        }
        __syncthreads();
    }
    { const Job jobsA[8] = {{3, 0, 1024}, {4, 0, 1024}, {5, 0, 512}, {6, 0, 512}, {7, 0, 384}, {8, 0, 256}, {9, 0, 128}, {10, 0, 128}}; conv_tail(F, DEPTH * 32, jobsA);
      const Job jobsB[3] = {{0, 0, 16384}, {1, 0, 16384}, {2, 0, 16384}}; conv_tail(F, 0, jobsB); }
    {
        const int gt = F.bid * 512 + F.tid, NGT = F.G * 512;
        for (int i = gt; i < 8 * 128 * 128 / 4; i += NGT) { const f32x4 v = ((const f32x4*)inp(F, I_CMWS))[i]; u32x2 o; o.x = pk2(v.x, v.y); o.y = pk2(v.z, v.w); ((u32x2*)(ws + WS_W_CMS))[i] = o; }
        for (int i = gt; i < 2 * 2 * D; i += NGT) { const float* plam = inp(F, I_RGLAM); ((float*)(ws + WS_SPL))[i] = -8.f * log1pf(expf(-plam[i])); }
        for (int i = gt; i < 64 * 32; i += NGT) { const int pos = i >> 5, f = i & 31; const float inv = powf(10000.f, -(float)f * 2.0f / 64.0f); const float ang = (float)pos * inv;
            ((f32x2*)(ws + WS_ROPE))[i] = (f32x2){cosf(ang), sinf(ang)}; }
    }
}

__device__ __forceinline__ void router_fill(Frame& F, int l) {
    LAS float* wr = (LAS float*)F.lds;
    const float* wg = inp(F, I_MWG) + (size_t)l * 1024 * 4; const float* wrt = inp(F, I_MWR) + (size_t)l * 1024 * 32;
    __syncthreads();
    for (int i0 = F.tid; i0 < 1024 * 9; i0 += 512 * 6) { f32x4 v[6];
#pragma unroll
        for (int u = 0; u < 6; ++u) { const int idx = i0 + u * 512; const int k = idx / 9, q = idx - k * 9; v[u] = q == 0 ? *(const f32x4*)(wg + k * 4) : *(const f32x4*)(wrt + k * 32 + (q - 1) * 4); }
#pragma unroll
        for (int u = 0; u < 6; ++u) { const int idx = i0 + u * 512; const int k = idx / 9, q = idx - k * 9;
            wr[(4 * q + 0) * 1024 + k] = v[u].x; wr[(4 * q + 1) * 1024 + k] = v[u].y; wr[(4 * q + 2) * 1024 + k] = v[u].z; wr[(4 * q + 3) * 1024 + k] = v[u].w; } }
    __syncthreads();
}
template <bool ROUTE, int NADD, bool SRCIN>
__device__ __forceinline__ void norm_phase(Frame& F, int l, const float* gvec, int shift_i, bool skip_ctx_route, bool dry) {
    uchar* ws = F.ws;
    float* X = (float*)(ws + WS_X); const bf16_t* YS = (const bf16_t*)(ws + WS_Y1); const bf16_t* YM = (const bf16_t*)(ws + WS_YM); bf16_t* H = (bf16_t*)(ws + WS_H);
    const float* MOD = (const float*)(ws + WS_MOD) + (size_t)l * 5 * NMODV;
    LAS float* wr = (LAS float*)F.lds;
    const int i16 = F.lane & 15, grp = F.lane >> 4;
    const float* bg = nullptr; const float* br = nullptr; if constexpr (ROUTE) { bg = inp(F, I_MBG) + l * 4; br = inp(F, I_MBR) + l * 32; }
    const float* pctx = nullptr; const float* px = nullptr; if constexpr (SRCIN) { pctx = inp(F, I_CTX); px = inp(F, I_X); }
    for (int tok = (F.bid * 8 + F.wave) * 4 + grp; tok < T; tok += F.G * 32) {
        asm volatile("" ::: "memory");
        const int sidx = sidx_of_row(tok);
        f32x4 x[16];
        float ss = 0.f;
        const float* xrow = X + (size_t)tok * D;
        if constexpr (SRCIN) { const int b_ = tok / SB, s_ = tok - b_ * SB; xrow = s_ < CTX ? pctx + ((size_t)(b_ * CTX + s_) << 10) : px + ((size_t)(b_ * SEQ + s_ - CTX) << 10); }
#pragma unroll
        for (int j = 0; j < 16; ++j) { if constexpr (X_BF16 && !SRCIN) { const u32x2 xb = *(const u32x2*)((const bf16_t*)X + (size_t)tok * D + 64 * j + 4 * i16); x[j] = (f32x4){bflo(xb.x), bfhi(xb.x), bflo(xb.y), bfhi(xb.y)}; }
            else x[j] = *(const f32x4*)(xrow + 64 * j + 4 * i16); }
        if constexpr (NADD >= 1) {
#pragma unroll
            for (int j = 0; j < 16; ++j) { const u32x2 ym = *(const u32x2*)(YM + (size_t)tok * D + 64 * j + 4 * i16); x[j] += (f32x4){bflo(ym.x), bfhi(ym.x), bflo(ym.y), bfhi(ym.y)}; } }
        if constexpr (NADD == 3) {
#pragma unroll
            for (int j = 0; j < 16; ++j) { const f32x4 g5 = *(const f32x4*)(MOD - (size_t)5 * NMODV + (size_t)sidx * NMODV + 5 * D + 64 * j + 4 * i16);
                if constexpr (Y_FP8) { const unsigned y0 = *(const unsigned*)((const uchar*)YS + (size_t)tok * D + 64 * j + 4 * i16), y1 = *(const unsigned*)((const uchar*)YS + ((size_t)T + tok) * D + 64 * j + 4 * i16);
                    x[j] += g5 * ((fp8x4_to_f32(y0) + fp8x4_to_f32(y1)) * (1.f / 16.f)); }
                else { const u32x2 y0 = *(const u32x2*)(YS + (size_t)tok * D + 64 * j + 4 * i16), y1 = *(const u32x2*)(YS + ((size_t)T + tok) * D + 64 * j + 4 * i16);
                    x[j] += g5 * (f32x4){bflo(y0.x) + bflo(y1.x), bfhi(y0.x) + bfhi(y1.x), bflo(y0.y) + bflo(y1.y), bfhi(y0.y) + bfhi(y1.y)}; } }
#pragma unroll
            for (int j = 0; j < 16; ++j) { if constexpr (X_BF16) { u32x2 o; o.x = pk2(x[j].x, x[j].y); o.y = pk2(x[j].z, x[j].w); *(u32x2*)((bf16_t*)X + (size_t)tok * D + 64 * j + 4 * i16) = o; }
                else *(f32x4*)(X + (size_t)tok * D + 64 * j + 4 * i16) = x[j]; } }
#pragma unroll
        for (int j = 0; j < 16; ++j) ss += x[j].x * x[j].x + x[j].y * x[j].y + x[j].z * x[j].z + x[j].w * x[j].w;
        ss = wave16_sum(ss);
        const float rstd = rsqrtf(ss * (1.f / D) + NORM_EPS);
        const float* shp = MOD + (size_t)sidx * NMODV + shift_i * D; const float* scp = shp + D;
#pragma unroll
        for (int j = 0; j < 16; ++j) { const int c = 64 * j + 4 * i16; const f32x4 g = *(const f32x4*)(gvec + c), sh = *(const f32x4*)(shp + c), sc = *(const f32x4*)(scp + c);
            x[j] = x[j] * rstd * g * (sc + 1.f) + sh; }
#pragma unroll
        for (int j = 0; j < 16; ++j) { const int c = 64 * j + 4 * i16;
            if constexpr (ROUTE && MOE_FP8) { int r8 = __builtin_amdgcn_cvt_pk_fp8_f32(x[j].x, x[j].y, 0, false); r8 = __builtin_amdgcn_cvt_pk_fp8_f32(x[j].z, x[j].w, r8, true); *(int*)((uchar*)H + (size_t)tok * D + c) = r8; }
            else { u32x2 o; o.x = pk2(x[j].x, x[j].y); o.y = pk2(x[j].z, x[j].w); *(u32x2*)(H + (size_t)tok * D + c) = o; } }
        if constexpr (ROUTE) {
            LAS float* lgs = (LAS float*)(F.lds + LDSCTL_OFF + 1024) + (F.wave * 4 + grp) * 40;
#pragma unroll 1
            for (int o = 0; o < 36; ++o) { f32x4 w[16];
#pragma unroll
                for (int j = 0; j < 16; ++j) w[j] = *(const LAS f32x4*)(wr + o * 1024 + 64 * j + 4 * i16);
                __builtin_amdgcn_sched_barrier(0);
                f32x4 v0 = x[0] * w[0], v1 = x[1] * w[1];
#pragma unroll
                for (int j = 2; j < 16; j += 2) { v0 += x[j] * w[j]; v1 += x[j + 1] * w[j + 1]; }
                v0 += v1; float a0 = wave16_sum((v0.x + v0.y) + (v0.z + v0.w)); if (i16 == 0) lgs[o] = a0; }
            asm volatile("s_waitcnt lgkmcnt(0)" ::: "memory");
            const float gl0 = lgs[0] + bg[0], gl1 = lgs[1] + bg[1], gl2 = lgs[2] + bg[2], gl3 = lgs[3] + bg[3];
            int gs = 0; float gm = gl0;
            if (gl1 > gm) { gm = gl1; gs = 1; }
            if (gl2 > gm) { gm = gl2; gs = 2; }
            if (gl3 > gm) { gm = gl3; gs = 3; }
            const float den = __expf(gl0 - gm) + __expf(gl1 - gm) + __expf(gl2 - gm) + __expf(gl3 - gm);
            const float pg = 1.f / den;
            float el[8];
#pragma unroll
            for (int e = 0; e < 8; ++e) el[e] = lgs[4 + gs * 8 + e] + br[gs * 8 + e];
            int i0 = 0; float v0 = el[0];
#pragma unroll
            for (int e = 1; e < 8; ++e) if (el[e] > v0) { v0 = el[e]; i0 = e; }
            int i1 = -1; float v1 = -3.0e38f;
#pragma unroll
            for (int e = 0; e < 8; ++e) if (e != i0 && el[e] > v1) { v1 = el[e]; i1 = e; }
            const float p0 = 1.f / (1.f + __expf(v1 - v0));
            const float w0 = p0 * pg, w1 = (1.f - p0) * pg;
            const bool do_route = !(skip_ctx_route && sidx == 4) && !dry;
            if (i16 == 0 && do_route) {
                const int e0 = gs * 8 + i0, e1 = gs * 8 + i1;
                unsigned* cnt = (unsigned*)(ws + WS_CTL) + CW_CNT + l * 32 * 64;
                const unsigned q0 = atomicAdd(cnt + e0 * 64, 1u), q1 = atomicAdd(cnt + e1 * 64, 1u);
                u32x2* BK = (u32x2*)(ws + WS_BK2);
                BK[(size_t)e0 * T + q0] = (u32x2){(unsigned)(tok * 2), __float_as_uint(w0)}; BK[(size_t)e1 * T + q1] = (u32x2){(unsigned)(tok * 2 + 1), __float_as_uint(w1)};
            }
        }
    }
}

__device__ __forceinline__ void st8(bf16_t* p, f32x4 v0, f32x4 v1) { u32x4 w; w.x = cvt_pk_bf16(v0[0], v0[1]); w.y = cvt_pk_bf16(v0[2], v0[3]); w.z = cvt_pk_bf16(v1[0], v1[1]); w.w = cvt_pk_bf16(v1[2], v1[3]); *(u32x4*)p = w; }
#define EPI_ROWS(ai, m) (u.pm * 256 + (ai) * 128 + wr * 64 + (m) * 16 + fr)

struct EpiRgIn { static constexpr bool PERM = true, FP8 = false, PREFETCH = false; bf16_t* GG; bf16_t* XB;
    __device__ __forceinline__ void operator()(const f32x4 (&acc)[2][2][4][2], const pg8::Unit& u, int wr, int wc, int fr, int fq) const {
        const bool isg = u.pn < 4; bf16_t* base = isg ? GG : XB; const int ct = (u.pn & 3) * 256 + wc * 32 + 8 * fq;
#pragma unroll
        for (int ai = 0; ai < 2; ++ai)
#pragma unroll
            for (int m = 0; m < 4; ++m) { if (!((u.hm >> (2 * ai)) & 1)) continue; bf16_t* rowp = base + (size_t)EPI_ROWS(ai, m) * D + ct;
#pragma unroll
                for (int bj = 0; bj < 2; ++bj) { f32x4 v0 = acc[ai][bj][m][0], v1 = acc[ai][bj][m][1];
                    if (isg) {
#pragma unroll
                        for (int e = 0; e < 4; ++e) { v0[e] = gelu_tanh(v0[e]); v1[e] = gelu_tanh(v1[e]); } }
                    st8(rowp + bj * 128, v0, v1); } }
    } };
struct EpiBf16 { static constexpr bool PERM = true, FP8 = false, PREFETCH = false; bf16_t* O; int ldc;
    __device__ __forceinline__ void operator()(const f32x4 (&acc)[2][2][4][2], const pg8::Unit& u, int wr, int wc, int fr, int fq) const {
        const int ct = u.pn * 256 + wc * 32 + 8 * fq;
#pragma unroll
        for (int ai = 0; ai < 2; ++ai)
#pragma unroll
            for (int m = 0; m < 4; ++m) { if (!((u.hm >> (2 * ai)) & 1)) continue; bf16_t* rowp = O + (size_t)EPI_ROWS(ai, m) * ldc + ct;
#pragma unroll
                for (int bj = 0; bj < 2; ++bj) st8(rowp + bj * 128, acc[ai][bj][m][0], acc[ai][bj][m][1]); }
    } };
struct EpiQKV { static constexpr bool PERM = true, FP8 = false, PREFETCH = false; bf16_t* O; const float* qg; const float* kg; const float* rope; LAS float* xch;
    __device__ __forceinline__ void operator()(const f32x4 (&acc)[2][2][4][2], const pg8::Unit& u, int wr, int wc, int fr, int fq) const {
        if (u.pn == 5) {
            const int ct = u.pn * 256 + wc * 32 + 8 * fq;
#pragma unroll
            for (int ai = 0; ai < 2; ++ai)
#pragma unroll
                for (int m = 0; m < 4; ++m) { if (!((u.hm >> (2 * ai)) & 1)) continue; bf16_t* rowp = O + (size_t)EPI_ROWS(ai, m) * 1536 + ct;
#pragma unroll
                    for (int bj = 0; bj < 2; ++bj) st8(rowp + bj * 128, acc[ai][bj][m][0], acc[ai][bj][m][1]); }
            return; }
        const bool lat = (u.pm % 17) != 0; const float* gv = u.pn < 4 ? qg : kg; const int a = wc >> 1, f0 = 16 * (wc & 1) + 4 * fq;
        const f32x4 g1 = *(const f32x4*)(gv + 64 * a + f0), g2 = *(const f32x4*)(gv + 64 * a + 32 + f0);
        f32x4 cvs[4], svs[4];
        { const int t0 = ((u.pm % 17) - 1) * 256;
#pragma unroll
          for (int q = 0; q < 4; ++q) { cvs[q] = (f32x4){1.f, 1.f, 1.f, 1.f}; svs[q] = (f32x4){0.f, 0.f, 0.f, 0.f};
            if (lat) { const int pos = a ? (16 * q + fr) : ((t0 >> 6) + 2 * (q & 1) + wr); const f32x4 cs0 = *(const f32x4*)(rope + (pos * 32 + f0) * 2), cs1 = *(const f32x4*)(rope + (pos * 32 + f0) * 2 + 4);
                cvs[q] = (f32x4){cs0.x, cs0.z, cs1.x, cs1.z}; svs[q] = (f32x4){cs0.y, cs0.w, cs1.y, cs1.w}; } } }
#pragma unroll
        for (int ai = 0; ai < 2; ++ai)
#pragma unroll
            for (int m = 0; m < 4; ++m)
#pragma unroll
                for (int bj = 0; bj < 2; ++bj) { const f32x4 v0 = acc[ai][bj][m][0], v1 = acc[ai][bj][m][1];
                    float sq = ((v0.x * v0.x + v0.y * v0.y) + (v0.z * v0.z + v0.w * v0.w)) + ((v1.x * v1.x + v1.y * v1.y) + (v1.z * v1.z + v1.w * v1.w));
                    sq += __shfl_xor(sq, 16); sq += __shfl_xor(sq, 32);
                    if (fq == 0) xch[((ai * 128 + wr * 64 + m * 16 + fr) * 2 + bj) * 4 + wc] = sq; }
        asm volatile("s_waitcnt lgkmcnt(0)" ::: "memory"); __builtin_amdgcn_s_barrier(); asm volatile("" ::: "memory");
#pragma unroll
        for (int ai = 0; ai < 2; ++ai)
#pragma unroll
            for (int m = 0; m < 4; ++m) { if (!((u.hm >> (2 * ai)) & 1)) continue; const int row = EPI_ROWS(ai, m);
                const f32x4 cv = a ? cvs[m] : cvs[ai], sv = a ? svs[m] : svs[ai];
#pragma unroll
                for (int bj = 0; bj < 2; ++bj) { const f32x4 p4 = *(const LAS f32x4*)(xch + ((ai * 128 + wr * 64 + m * 16 + fr) * 2 + bj) * 4);
                    const float rstd = rsqrtf(((p4.x + p4.y) + (p4.z + p4.w)) * (1.f / 128.f) + NORM_EPS);
                    const f32x4 x1 = acc[ai][bj][m][0] * rstd * g1, x2 = acc[ai][bj][m][1] * rstd * g2;
                    const f32x4 o1 = x1 * cv - x2 * sv, o2 = x2 * cv + x1 * sv;
                    bf16_t* p = O + (size_t)row * 1536 + u.pn * 256 + bj * 128 + 64 * a + f0;
                    u32x2 w1, w2; w1.x = cvt_pk_bf16(o1.x, o1.y); w1.y = cvt_pk_bf16(o1.z, o1.w); w2.x = cvt_pk_bf16(o2.x, o2.y); w2.y = cvt_pk_bf16(o2.z, o2.w);
                    *(u32x2*)p = w1; *(u32x2*)(p + 32) = w2; } }
    } };
struct EpiCmIn { static constexpr bool PERM = true, FP8 = false, PREFETCH = false; bf16_t* O; f32x2* statp;
    __device__ __forceinline__ void operator()(const f32x4 (&acc)[2][2][4][2], const pg8::Unit& u, int wr, int wc, int fr, int fq) const {
        const int ct = u.pn * 256 + wc * 32 + 8 * fq; const bool isv = u.pn >= 8;
#pragma unroll
        for (int ai = 0; ai < 2; ++ai)
#pragma unroll
            for (int m = 0; m < 4; ++m) { if (!((u.hm >> (2 * ai)) & 1)) continue; const int row = EPI_ROWS(ai, m); bf16_t* rowp = O + (size_t)row * 4096 + ct; float s = 0.f, q = 0.f;
#pragma unroll
                for (int bj = 0; bj < 2; ++bj) { f32x4 v0 = acc[ai][bj][m][0], v1 = acc[ai][bj][m][1];
#pragma unroll
                    for (int e = 0; e < 4; ++e) { v0[e] = gelu_tanh(v0[e]); v1[e] = gelu_tanh(v1[e]); }
                    u32x4 w; w.x = cvt_pk_bf16(v0[0], v0[1]); w.y = cvt_pk_bf16(v0[2], v0[3]); w.z = cvt_pk_bf16(v1[0], v1[1]); w.w = cvt_pk_bf16(v1[2], v1[3]);
                    *(u32x4*)(rowp + bj * 128) = w;
                    const float r0 = bflo(w.x), r1 = bfhi(w.x), r2 = bflo(w.y), r3 = bfhi(w.y), r4 = bflo(w.z), r5 = bfhi(w.z), r6 = bflo(w.w), r7 = bfhi(w.w);
                    s += ((r0 + r1) + (r2 + r3)) + ((r4 + r5) + (r6 + r7)); q += ((r0 * r0 + r1 * r1) + (r2 * r2 + r3 * r3)) + ((r4 * r4 + r5 * r5) + (r6 * r6 + r7 * r7)); }
                if (isv) { s += __shfl_xor(s, 16); s += __shfl_xor(s, 32); q += __shfl_xor(q, 16); q += __shfl_xor(q, 32);
                    if (fq == 0) statp[(size_t)row * 32 + (u.pn - 8) * 4 + wc] = (f32x2){s, q}; } }
    } };
struct EpiResid { static constexpr bool PERM = true, FP8 = false, PREFETCH = false; bf16_t* YM; const float* gate  ;
    __device__ __forceinline__ void operator()(const f32x4 (&acc)[2][2][4][2], const pg8::Unit& u, int wr, int wc, int fr, int fq) const {
        const int sidx = sidx_of_row(u.pm * 256); const float* gp = gate + (size_t)sidx * NMODV; const int ct = u.pn * 256 + wc * 32 + 8 * fq;
        f32x4 gv[2][2];
#pragma unroll
        for (int bj = 0; bj < 2; ++bj)
#pragma unroll
            for (int n = 0; n < 2; ++n) gv[bj][n] = *(const f32x4*)(gp + ct + bj * 128 + n * 4);
#pragma unroll
        for (int ai = 0; ai < 2; ++ai)
#pragma unroll
            for (int m = 0; m < 4; ++m) { if (!((u.hm >> (2 * ai)) & 1)) continue; bf16_t* rowp = YM + (size_t)EPI_ROWS(ai, m) * D + ct;
#pragma unroll
                for (int bj = 0; bj < 2; ++bj) st8(rowp + bj * 128, gv[bj][0] * acc[ai][bj][m][0], gv[bj][1] * acc[ai][bj][m][1]); }
    } };
struct EpiRgGate { static constexpr bool PERM = true, FP8 = false, PREFETCH = false; const bf16_t* XC; bf16_t* LA; bf16_t* BB; const float* ba; const float* bi; const float* lam;
    __device__ __forceinline__ void operator()(const f32x4 (&acc)[2][2][4][2], const pg8::Unit& u, int wr, int wc, int fr, int fq) const {
        const int d = u.pn >> 3, blk = u.pn & 7;
        asm volatile("" : "+v"(fr), "+v"(fq));
        const int ch = blk * 128 + wc * 32 + 8 * fq;
        u32x4 xw[8];
#pragma unroll
        for (int r = 0; r < 8; ++r) xw[r] = *(const u32x4*)(XC + (size_t)EPI_ROWS(r >> 2, r & 3) * D + ch);
        f32x4 bav[2], biv[2], spv[2];
#pragma unroll
        for (int n = 0; n < 2; ++n) { bav[n] = *(const f32x4*)(ba + d * D + ch + 4 * n); biv[n] = *(const f32x4*)(bi + d * D + ch + 4 * n); spv[n] = *(const f32x4*)(lam + d * D + ch + 4 * n); }
#pragma unroll
        for (int r = 0; r < 8; ++r) { const int ai = r >> 2, m = r & 3; if (!((u.hm >> (2 * ai)) & 1)) continue;
            const size_t off = (size_t)EPI_ROWS(ai, m) * D + ch;
            const float xc[8] = {bflo(xw[r].x), bfhi(xw[r].x), bflo(xw[r].y), bfhi(xw[r].y), bflo(xw[r].z), bfhi(xw[r].z), bflo(xw[r].w), bfhi(xw[r].w)};
            float la[8], bb[8];
#pragma unroll
            for (int n = 0; n < 2; ++n)
#pragma unroll
                for (int e = 0; e < 4; ++e) { const float rg = fast_sigmoid(acc[ai][0][m][n][e] + bav[n][e]), ig = fast_sigmoid(acc[ai][1][m][n][e] + biv[n][e]);
                    const float lga = rg * spv[n][e]; la[4 * n + e] = lga; bb[4 * n + e] = __builtin_amdgcn_sqrtf(one_minus_exp(-2.f * lga)) * ig * xc[4 * n + e]; }
            u32x4 w; w.x = cvt_pk_bf16(la[0], la[1]); w.y = cvt_pk_bf16(la[2], la[3]); w.z = cvt_pk_bf16(la[4], la[5]); w.w = cvt_pk_bf16(la[6], la[7]);
            *(u32x4*)(LA + (size_t)d * T * D + off) = w;
            w.x = cvt_pk_bf16(bb[0], bb[1]); w.y = cvt_pk_bf16(bb[2], bb[3]); w.z = cvt_pk_bf16(bb[4], bb[5]); w.w = cvt_pk_bf16(bb[6], bb[7]);
            *(u32x4*)(BB + (size_t)d * T * D + off) = w; }
    } };

template <bool G1>
struct MoeOrder {
    static constexpr bool GATHER = G1;
    const LAS int* tab; const char* A; const char* B; const int* BK; int G, c, nunits; size_t bstride; int arow, brow;
    __device__ bool next(int i, pg8::Unit& u) const {
        int L, hm; if (!pg8::unit_slot(i, c, G, nunits, L, hm)) return false; u.hm = __builtin_amdgcn_readfirstlane(hm);
        const int wgid = __builtin_amdgcn_readfirstlane(pg8::xcd_remap(L, nunits)); const int tau = wgid >> 2, pn = wgid & 3;
        const int e = __builtin_amdgcn_readfirstlane(tab[192 + tau]);
        u.pm = tau; u.pn = pn; u.aux0 = e; u.aux1 = __builtin_amdgcn_readfirstlane((tau - tab[e]) * 256);
        u.a = pg8::uptr(G1 ? A : A + (size_t)tau * 256 * arow);
        u.b = pg8::uptr(B + (size_t)e * bstride + (size_t)pn * 256 * brow);
        return true; }
    __device__ unsigned goff(const pg8::Unit& u, int row) const {
        const int pos = u.aux1 + row; const int cnt = tab[40 + u.aux0];
        int tok = 0; if (pos < cnt) tok = __builtin_nontemporal_load(BK + ((size_t)u.aux0 * T + pos) * 2) >> 1;
        return (unsigned)tok * (unsigned)arow; }
};
struct EpiMoe1 { static constexpr bool PERM = true, FP8 = (MOE_FP8 != 0), PREFETCH = false; uchar* H1;
    __device__ __forceinline__ void operator()(const f32x4 (&acc)[2][2][4][2], const pg8::Unit& u, int wr, int wc, int fr, int fq) const {
        const int ct = u.pn * 128 + wc * 32 + 8 * fq;
#pragma unroll
        for (int ai = 0; ai < 2; ++ai)
#pragma unroll
            for (int m = 0; m < 4; ++m) { if (!((u.hm >> (2 * ai)) & 1)) continue; f32x4 h0, h1;
#pragma unroll
                for (int e = 0; e < 4; ++e) { constexpr float WS_ = FP8 ? (1.f / 32.f) : 1.f;
                    const float g0 = acc[ai][0][m][0][e] * WS_, g1 = acc[ai][0][m][1][e] * WS_; h0[e] = g0 * fast_sigmoid(g0) * (acc[ai][1][m][0][e] * WS_); h1[e] = g1 * fast_sigmoid(g1) * (acc[ai][1][m][1][e] * WS_); }
                if constexpr (FP8) { int r0 = __builtin_amdgcn_cvt_pk_fp8_f32(h0[0], h0[1], 0, false); r0 = __builtin_amdgcn_cvt_pk_fp8_f32(h0[2], h0[3], r0, true);
                    int r1 = __builtin_amdgcn_cvt_pk_fp8_f32(h1[0], h1[1], 0, false); r1 = __builtin_amdgcn_cvt_pk_fp8_f32(h1[2], h1[3], r1, true);
                    *(u32x2*)(H1 + (size_t)EPI_ROWS(ai, m) * DEXP + ct) = (u32x2){(unsigned)r0, (unsigned)r1}; }
                else st8((bf16_t*)H1 + (size_t)EPI_ROWS(ai, m) * DEXP + ct, h0, h1); }
    } };
struct EpiMoe2 { static constexpr bool PERM = true, FP8 = (MOE_FP8 != 0), PREFETCH = true; bf16_t* YS; const int* BK; const LAS int* tab;
    typedef int pre_t __attribute__((ext_vector_type(16)));
    __device__ __forceinline__ pre_t prefetch(const pg8::Unit& u, int wr, int fr) const { pre_t p; const int cnt = tab[40 + u.aux0];
#pragma unroll
        for (int r = 0; r < 8; ++r) { const int pos = u.aux1 + (r >> 2) * 128 + wr * 64 + (r & 3) * 16 + fr; u32x2 v = {0xffffffffu, 0u}; if (pos < cnt) v = __builtin_nontemporal_load((const u32x2*)BK + (size_t)u.aux0 * T + pos); p[2 * r] = (int)v.x; p[2 * r + 1] = (int)v.y; }
        return p; }
    __device__ __forceinline__ void operator()(const f32x4 (&acc)[2][2][4][2], const pg8::Unit& u, int wr, int wc, int fr, int fq, const pre_t& pre) const {
        const int ct = u.pn * 256 + wc * 32 + 8 * fq;
#pragma unroll
        for (int r = 0; r < 8; ++r) { const int e_ = pre[2 * r];
            if (e_ >= 0 && ((u.hm >> (2 * (r >> 2))) & 1)) { const int tok = e_ >> 1, slot = e_ & 1; const float w = __int_as_float(pre[2 * r + 1]) * (FP8 ? (1.f / 32.f) : 1.f);
                if constexpr (Y_FP8) { uchar* yp = (uchar*)YS + ((size_t)slot * T + tok) * D + ct; const float w16 = w * 16.f;
#pragma unroll
                    for (int bj = 0; bj < 2; ++bj) { const f32x4 a0 = acc[r >> 2][bj][r & 3][0] * w16, a1 = acc[r >> 2][bj][r & 3][1] * w16;
                        int r0 = __builtin_amdgcn_cvt_pk_fp8_f32(a0.x, a0.y, 0, false); r0 = __builtin_amdgcn_cvt_pk_fp8_f32(a0.z, a0.w, r0, true);
                        int r1 = __builtin_amdgcn_cvt_pk_fp8_f32(a1.x, a1.y, 0, false); r1 = __builtin_amdgcn_cvt_pk_fp8_f32(a1.z, a1.w, r1, true);
                        *(u32x2*)(yp + bj * 128) = (u32x2){(unsigned)r0, (unsigned)r1}; } }
                else { bf16_t* yp = YS + ((size_t)slot * T + tok) * D + ct;
#pragma unroll
                    for (int bj = 0; bj < 2; ++bj) st8(yp + bj * 128, acc[r >> 2][bj][r & 3][0] * w, acc[r >> 2][bj][r & 3][1] * w); } } }
    } };
__device__ __forceinline__ int moe_table(Frame& F, int l, LAS int* tab) {
    __syncthreads();
    if (F.tid < 32) { const unsigned c = __hip_atomic_load((unsigned*)(F.ws + WS_CTL) + CW_CNT + (l * 32 + F.tid) * 64, RLX_AGENT); tab[40 + F.tid] = (int)c; }
    __syncthreads();
    if (F.tid == 0) { int s = 0;
#pragma unroll 1
        for (int e = 0; e < 32; ++e) { tab[e] = s; s += (tab[40 + e] + 255) >> 8; } tab[32] = s; }
    __syncthreads();
    const int ntile_ = tab[32];
    for (int tau = F.tid; tau < ntile_; tau += 512) { int e = 0;
#pragma unroll 1
        for (int k = 1; k < 32; ++k) e = (tab[k] <= tau) ? k : e;
        tab[192 + tau] = e; }
    __syncthreads();
    return ntile_;
}

__device__ __forceinline__ void conv_phase(Frame& F, int j) {
    const bf16_t* XB = (const bf16_t*)(F.ws + WS_XB); bf16_t* XC = (bf16_t*)(F.ws + WS_XC);
    const float* cw = inp(F, I_RGCW) + (size_t)j * 4 * D; const float* cb = inp(F, I_RGCB) + (size_t)j * D;
    const int NGT = F.G * 512;
    for (int i0 = F.bid * 512 + F.tid; i0 < T * 128; i0 += 2 * NGT) {
        u32x4 xw[2][4];
#pragma unroll
        for (int q = 0; q < 2; ++q) { const int i = i0 + q * NGT; const int row = i >> 7, c = (i & 127) * 8; const int b = row / SB, s = row - b * SB; const int lo = s < CTX ? 0 : CTX, hi = s < CTX ? CTX : SB;
#pragma unroll
            for (int k = 0; k < 4; ++k) { const int ss = s + k - 2; xw[q][k] = (u32x4){0u, 0u, 0u, 0u}; if (i < T * 128 && ss >= lo && ss < hi) xw[q][k] = *(const u32x4*)(XB + (size_t)(b * SB + ss) * D + c); } }
#pragma unroll
        for (int q = 0; q < 2; ++q) { const int i = i0 + q * NGT; if (i < T * 128) { const int row = i >> 7, c = (i & 127) * 8;
            float a[8];
#pragma unroll
            for (int e = 0; e < 8; ++e) a[e] = cb[c + e];
#pragma unroll
            for (int k = 0; k < 4; ++k) { const f32x4 w0 = *(const f32x4*)(cw + k * D + c), w1 = *(const f32x4*)(cw + k * D + c + 4); const u32x4 x = xw[q][k];
                a[0] += w0.x * bflo(x.x); a[1] += w0.y * bfhi(x.x); a[2] += w0.z * bflo(x.y); a[3] += w0.w * bfhi(x.y);
                a[4] += w1.x * bflo(x.z); a[5] += w1.y * bfhi(x.z); a[6] += w1.z * bflo(x.w); a[7] += w1.w * bfhi(x.w); }
            u32x4 o; o.x = pk2(a[0], a[1]); o.y = pk2(a[2], a[3]); o.z = pk2(a[4], a[5]); o.w = pk2(a[6], a[7]);
            *(u32x4*)(XC + (size_t)row * D + c) = o; } }
    }
}
__device__ __forceinline__ void scan1_phase(Frame& F) {
    const bf16_t* LA = (const bf16_t*)(F.ws + WS_LA); const bf16_t* BB = (const bf16_t*)(F.ws + WS_BB); float* TS = (float*)(F.ws + WS_TOTS); float* TH = (float*)(F.ws + WS_TOTH);
    for (int it = F.bid * 8 + F.wave; it < NB * 2 * NCH * 4; it += F.G * 8) {
        const int cg = it & 3, rest = it >> 2, ck = rest % NCH, bd = rest / NCH, dir = bd & 1, b = bd >> 1;
        const int c = cg * 256 + F.lane * 4; const size_t base = (size_t)dir * T * D + (size_t)(b * SB + ck * 16) * D + c;
        u32x2 la[16], bb[16];
#pragma unroll
        for (int t = 0; t < 16; ++t) { const size_t o = base + (size_t)(dir ? 15 - t : t) * D; la[t] = *(const u32x2*)(LA + o); bb[t] = *(const u32x2*)(BB + o); }
        f32x4 sl = {0.f, 0.f, 0.f, 0.f}, h = {0.f, 0.f, 0.f, 0.f};
#pragma unroll
        for (int t = 0; t < 16; ++t) { const f32x4 l4 = {bflo(la[t].x), bfhi(la[t].x), bflo(la[t].y), bfhi(la[t].y)}, b4 = {bflo(bb[t].x), bfhi(bb[t].x), bflo(bb[t].y), bfhi(bb[t].y)};
            sl += l4; f32x4 a4 = {__expf(l4.x), __expf(l4.y), __expf(l4.z), __expf(l4.w)}; h = a4 * h + b4; }
        const size_t o = (size_t)(bd * NCH + ck) * D + c; *(f32x4*)(TS + o) = sl; *(f32x4*)(TH + o) = h;
    }
}
__device__ __forceinline__ void scan2_phase(Frame& F) {
    const float* TS = (const float*)(F.ws + WS_TOTS); const float* TH = (const float*)(F.ws + WS_TOTH); float* CY = (float*)(F.ws + WS_CARRY);
    LAS float* wt = (LAS float*)F.lds;
    for (int it = F.bid; it < NB * 2 * 16; it += F.G) {
        const int cg = it & 15, bd = it >> 4, dir = bd & 1; const int c = cg * 64 + F.lane; const size_t base = (size_t)bd * NCH * D + c;
        const int s0 = F.wave * 34;
        float P = 0.f, H = 0.f;
#pragma unroll 1
        for (int sb = 0; sb < 34; sb += 17) { float sl[17], hl[17];
#pragma unroll
            for (int q = 0; q < 17; ++q) { const int s = s0 + sb + q; const int ck = dir ? (s < 16 ? 15 - s : NCH + 15 - s) : s; sl[q] = TS[base + (size_t)ck * D]; hl[q] = TH[base + (size_t)ck * D]; }
#pragma unroll
            for (int q = 0; q < 17; ++q) { P += sl[q]; H = __expf(sl[q]) * H + hl[q]; } }
        __syncthreads();
        wt[(F.wave * 2 + 0) * 64 + F.lane] = P; wt[(F.wave * 2 + 1) * 64 + F.lane] = H;
        __syncthreads();
        float h = 0.f;
        for (int w = 0; w < F.wave; ++w) h = __expf(wt[(w * 2 + 0) * 64 + F.lane]) * h + wt[(w * 2 + 1) * 64 + F.lane];
#pragma unroll 1
        for (int sb = 0; sb < 34; sb += 17) { float sl[17], hl[17]; int ckk[17];
#pragma unroll
            for (int q = 0; q < 17; ++q) { const int s = s0 + sb + q; ckk[q] = dir ? (s < 16 ? 15 - s : NCH + 15 - s) : s; sl[q] = TS[base + (size_t)ckk[q] * D]; hl[q] = TH[base + (size_t)ckk[q] * D]; }
#pragma unroll
            for (int q = 0; q < 17; ++q) { CY[base + (size_t)ckk[q] * D] = h; h = __expf(sl[q]) * h + hl[q]; } }
    }
    __syncthreads();
}
__device__ __forceinline__ void scan3_phase(Frame& F) {
    const bf16_t* LA = (const bf16_t*)(F.ws + WS_LA); const bf16_t* BB = (const bf16_t*)(F.ws + WS_BB); const float* CY = (const float*)(F.ws + WS_CARRY);
    const bf16_t* GG = (const bf16_t*)(F.ws + WS_GG); bf16_t* SA = (bf16_t*)(F.ws + WS_SA);
    LAS f32x4* hb = (LAS f32x4*)(F.lds + F.wave * 16384);
    for (int it = F.bid * 8 + F.wave; it < NB * NCH * 4; it += F.G * 8) {
        const int cg = it & 3, rest = it >> 2, ck = rest % NCH, b = rest / NCH;
        const int c = cg * 256 + F.lane * 4;
        const size_t rbase = (size_t)(b * SB + ck * 16) * D + c, b1 = (size_t)T * D + rbase;
        f32x4 hbk = *(const f32x4*)(CY + (size_t)((b * 2 + 1) * NCH + ck) * D + c), hf = *(const f32x4*)(CY + (size_t)((b * 2 + 0) * NCH + ck) * D + c);
        { u32x2 la[16], bb[16];
#pragma unroll
          for (int t = 0; t < 16; ++t) { la[t] = *(const u32x2*)(LA + b1 + (size_t)(15 - t) * D); bb[t] = *(const u32x2*)(BB + b1 + (size_t)(15 - t) * D); }
#pragma unroll
          for (int t = 0; t < 16; ++t) { const f32x4 l4 = {bflo(la[t].x), bfhi(la[t].x), bflo(la[t].y), bfhi(la[t].y)}, b4 = {bflo(bb[t].x), bfhi(bb[t].x), bflo(bb[t].y), bfhi(bb[t].y)};
              const f32x4 a4 = {__expf(l4.x), __expf(l4.y), __expf(l4.z), __expf(l4.w)}; hbk = a4 * hbk + b4; hb[(15 - t) * 64 + F.lane] = hbk; } }
        { u32x2 la[16], bb[16], gg[16];
#pragma unroll
          for (int t = 0; t < 16; ++t) { la[t] = *(const u32x2*)(LA + rbase + (size_t)t * D); bb[t] = *(const u32x2*)(BB + rbase + (size_t)t * D); gg[t] = *(const u32x2*)(GG + rbase + (size_t)t * D); }
#pragma unroll
          for (int t = 0; t < 16; ++t) { const f32x4 l4 = {bflo(la[t].x), bfhi(la[t].x), bflo(la[t].y), bfhi(la[t].y)}, b4 = {bflo(bb[t].x), bfhi(bb[t].x), bflo(bb[t].y), bfhi(bb[t].y)};
              const f32x4 g4 = {bflo(gg[t].x), bfhi(gg[t].x), bflo(gg[t].y), bfhi(gg[t].y)};
              const f32x4 a4 = {__expf(l4.x), __expf(l4.y), __expf(l4.z), __expf(l4.w)}; hf = a4 * hf + b4; const f32x4 y = g4 * (hf + hb[t * 64 + F.lane]);
              u32x2 o; o.x = pk2(y.x, y.y); o.y = pk2(y.z, y.w); *(u32x2*)(SA + rbase + (size_t)t * D) = o; } }
    }
}

__device__ __forceinline__ void qknorm_phase(Frame& F) {
    bf16_t* QKV = (bf16_t*)(F.ws + WS_QKV); const f32x2* ROPE = (const f32x2*)(F.ws + WS_ROPE);
    const int i16 = F.lane & 15, grp = F.lane >> 4; const float* pqg = inp(F, I_ATQG); const float* pkg = inp(F, I_ATKG);
    const int ITS = F.G * 32;
    for (int it0 = (F.bid * 8 + F.wave) * 4 + grp; it0 < T * 10; it0 += 4 * ITS) {
        u32x4 xw4[4];
#pragma unroll
        for (int q = 0; q < 4; ++q) { const int it = it0 + q * ITS; xw4[q] = (u32x4){0u, 0u, 0u, 0u}; if (it < T * 10) { const int row = it / 10, hh = it - row * 10; xw4[q] = *(const u32x4*)(QKV + (size_t)row * 1536 + hh * 128 + i16 * 8); } }
#pragma unroll
        for (int q = 0; q < 4; ++q) { const int it = it0 + q * ITS; const bool valid = it < T * 10; const int itc = valid ? it : 0;
            const int row = itc / 10, hh = itc - row * 10; const int b = row / SB, s = row - b * SB;
            bf16_t* p = QKV + (size_t)row * 1536 + hh * 128 + i16 * 8;
            const u32x4 xw = xw4[q];
            float x[8] = {bflo(xw.x), bfhi(xw.x), bflo(xw.y), bfhi(xw.y), bflo(xw.z), bfhi(xw.z), bflo(xw.w), bfhi(xw.w)};
            float ss = 0.f;
#pragma unroll
            for (int e = 0; e < 8; ++e) ss += x[e] * x[e];
            ss = wave16_sum(ss);
            const float rstd = rsqrtf(ss * (1.f / 128.f) + NORM_EPS);
            const float* g = (hh < 8 ? pqg : pkg) + i16 * 8;
#pragma unroll
            for (int e = 0; e < 8; ++e) x[e] = x[e] * rstd * g[e];
            float y[8];
#pragma unroll
            for (int e = 0; e < 8; ++e) y[e] = __shfl_xor(x[e], 4);
            if (s >= CTX) { const int t = s - CTX; const int pos = (i16 >> 3) ? (t & 63) : (t >> 6); const bool half1 = (i16 >> 2) & 1;
#pragma unroll
                for (int e = 0; e < 8; ++e) { const f32x2 cs = ROPE[pos * 32 + (i16 & 3) * 8 + e];
                    x[e] = half1 ? (x[e] * cs.x + y[e] * cs.y) : (x[e] * cs.x - y[e] * cs.y); } }
            u32x4 o; o.x = pk2(x[0], x[1]); o.y = pk2(x[2], x[3]); o.z = pk2(x[4], x[5]); o.w = pk2(x[6], x[7]);
            if (valid) *(u32x4*)p = o;
        }
    }
}
__device__ __forceinline__ void attn_phase(Frame& F) {
    const bf16_t* QKV = (const bf16_t*)(F.ws + WS_QKV); bf16_t* AO = (bf16_t*)(F.ws + WS_AO);
    for (int u = F.bid; u < 544; u += F.G) {
        int b, h, q0, k0, seq;
        if (u < 512) { const int qb = u & 15, hg = (u >> 4) & 3, kvh = (u >> 6) & 1; b = u >> 7; h = kvh * 4 + hg; q0 = b * SB + CTX + qb * 256; k0 = b * SB; seq = SB; }
        else { const int v = u - 512; b = v >> 3; h = v & 7; q0 = b * SB; k0 = b * SB; seq = CTX; }
        const int kvh = h >> 2;
        const bf16_t* Kp = (const bf16_t*)pg8::uptr((const char*)(QKV + (size_t)k0 * 1536 + 1024 + kvh * 128));
        att::attn_dense_body((const bf16_t*)pg8::uptr((const char*)(QKV + (size_t)q0 * 1536 + h * 128)), Kp, Kp + 256, (bf16_t*)pg8::uptr((const char*)(AO + (size_t)q0 * D + h * 128)), seq, F.ldsg, F.tid);
        __syncthreads();
    }
}

__device__ __forceinline__ void spatial_phase(Frame& F) {
    const bf16_t* UVB = (const bf16_t*)(F.ws + WS_UVB); bf16_t* UV = (bf16_t*)(F.ws + WS_UV); const f32x2* statp = (const f32x2*)(F.ws + WS_STATP);
    const bf16_t* Ws = (const bf16_t*)(F.ws + WS_W_CMS); const float* lng = inp(F, I_CMLNG); const float* lnb = inp(F, I_CMLNB); const float* bs = inp(F, I_CMBS);
    LAS uchar* vl = F.lds;
    LAS f32x2* st = (LAS f32x2*)(F.lds + 65536);
    const int tid = F.tid, lane = F.lane, wid = F.wave, r32 = lane & 31, hi = lane >> 5, wm = wid & 3, wn = wid >> 2;
    const int sr = tid >> 4, sc = (tid & 15) * 8;
    for (int u = F.bid; u < 136 * 8; u += F.G) {
        const int chunk = u >> 3, g = u & 7; const int row0 = chunk * 128;
        float s_ = 0.f, q_ = 0.f;
        { const f32x2* sp = statp + (size_t)(row0 + (tid >> 2)) * 32 + (tid & 3) * 8; f32x2 pv[8];
#pragma unroll
          for (int k = 0; k < 8; ++k) pv[k] = sp[k];
#pragma unroll
          for (int k = 0; k < 8; ++k) { s_ += pv[k].x; q_ += pv[k].y; } }
        u32x4 xw[2][4]; f32x4 lg0[2], lg1[2], lb0[2], lb1[2];
#pragma unroll
        for (int ch = 0; ch < 2; ++ch) { const int cg = g * 256 + ch * 128 + sc;
            lg0[ch] = *(const f32x4*)(lng + cg); lg1[ch] = *(const f32x4*)(lng + cg + 4); lb0[ch] = *(const f32x4*)(lnb + cg); lb1[ch] = *(const f32x4*)(lnb + cg + 4);
#pragma unroll
            for (int i = 0; i < 4; ++i) xw[ch][i] = *(const u32x4*)(UVB + (size_t)(row0 + sr + 32 * i) * 4096 + 2048 + cg); }
        bf16x8 pa[2][4];
#pragma unroll
        for (int kt = 0; kt < 2; ++kt)
#pragma unroll
            for (int ks = 0; ks < 4; ++ks) pa[kt][ks] = *(const bf16x8*)(Ws + ((size_t)g * 128 + 32 * wm + r32) * 128 + 64 * kt + 16 * ks + 8 * hi);
        u32x4 uu[8];
#pragma unroll
        for (int i = 0; i < 8; ++i) { const int id = tid + 512 * i, row = id >> 5, ch = id & 31; uu[i] = *(const u32x4*)(UVB + (size_t)(row0 + row) * 4096 + g * 256 + ch * 8); }
        s_ += __int_as_float(__builtin_amdgcn_update_dpp(0, __float_as_int(s_), 0xB1, 0xF, 0xF, true)); s_ += __int_as_float(__builtin_amdgcn_update_dpp(0, __float_as_int(s_), 0x4E, 0xF, 0xF, true));
        q_ += __int_as_float(__builtin_amdgcn_update_dpp(0, __float_as_int(q_), 0xB1, 0xF, 0xF, true)); q_ += __int_as_float(__builtin_amdgcn_update_dpp(0, __float_as_int(q_), 0x4E, 0xF, 0xF, true));
        __syncthreads();
        if ((tid & 3) == 0) { const float mean = s_ * (1.f / 2048.f); const float var = fmaxf(q_ * (1.f / 2048.f) - mean * mean, 0.f); st[tid >> 2] = (f32x2){mean, rsqrtf(var + NORM_EPS)}; }
        __syncthreads();
#pragma unroll
        for (int ch = 0; ch < 2; ++ch) {
#pragma unroll
            for (int i = 0; i < 4; ++i) { const int q = sr + 32 * i; const u32x4 x_ = xw[ch][i]; const f32x2 ms = st[q];
                f32x4 v0 = {bflo(x_.x), bfhi(x_.x), bflo(x_.y), bfhi(x_.y)}, v1 = {bflo(x_.z), bfhi(x_.z), bflo(x_.w), bfhi(x_.w)};
                v0 = (v0 - ms.x) * ms.y * lg0[ch] + lb0[ch]; v1 = (v1 - ms.x) * ms.y * lg1[ch] + lb1[ch];
                u32x4 o; o.x = pk2(v0.x, v0.y); o.y = pk2(v0.z, v0.w); o.z = pk2(v1.x, v1.y); o.w = pk2(v1.z, v1.w);
                *(LAS u32x4*)(vl + ((q >> 6) * 2 + ch) * 16384 + att::v_st(q & 63, sc)) = o; } }
        __syncthreads();
        f32x16 o[4] = {};
        const int vb = (int)(uintptr_t)(F.ldsg) + att::v_rd_base(lane) + wn * 16384;
        att::pv_d0(o, vb, pa[0][0], pa[0][1], pa[0][2], pa[0][3]);
        att::pv_d0(o, vb + 32768, pa[1][0], pa[1][1], pa[1][2], pa[1][3]);
        __syncthreads();
#pragma unroll
        for (int r = 0; r < 16; ++r) { const int p = 32 * wm + att::crow(r, hi); const float bsv = bs[g * 128 + p];
#pragma unroll
            for (int d0 = 0; d0 < 4; ++d0) *(LAS bf16_t*)(vl + p * 512 + (128 * wn + 32 * d0 + r32) * 2) = (bf16_t)f2bf(o[d0][r] + bsv); }
        __syncthreads();
#pragma unroll
        for (int i = 0; i < 8; ++i) { const int id = tid + 512 * i, row = id >> 5, ch = id & 31; const u32x4 v = *(const LAS u32x4*)(vl + row * 512 + ch * 16); const u32x4 w = uu[i];
            u32x4 o4; o4.x = pk2(bflo(v.x) * bflo(w.x), bfhi(v.x) * bfhi(w.x)); o4.y = pk2(bflo(v.y) * bflo(w.y), bfhi(v.y) * bfhi(w.y)); o4.z = pk2(bflo(v.z) * bflo(w.z), bfhi(v.z) * bfhi(w.z)); o4.w = pk2(bflo(v.w) * bflo(w.w), bfhi(v.w) * bfhi(w.w));
            *(u32x4*)(UV + (size_t)(row0 + row) * 2048 + g * 256 + ch * 8) = o4; }
    }
    __syncthreads();
}

__device__ __forceinline__ void final_phase(Frame& F) {
    const uchar* Xb = F.ws + WS_X; const uchar* YSb = F.ws + WS_Y1; const u32x2* YM = (const u32x2*)(F.ws + WS_YM); f32x4* out = (f32x4*)F.out;
    const f32x4* G5 = (const f32x4*)((const float*)(F.ws + WS_MOD) + (size_t)(DEPTH - 1) * 5 * NMODV + 5 * D);
    const int NGT = F.G * 512;
    for (int i0 = F.bid * 512 + F.tid; i0 < NB * SEQ * 256; i0 += 4 * NGT) { f32x4 a[4], ysum[4]; u32x2 ym[4];
#pragma unroll
        for (int q = 0; q < 4; ++q) { const int i = i0 + q * NGT; if (i < NB * SEQ * 256) { const int r = i >> 8, c4 = i & 255, b = r >> 12, t = r & 4095; const size_t src = ((size_t)(b * SB + CTX + t) << 8) + c4;
            if constexpr (X_BF16) { const u32x2 xb = ((const u32x2*)Xb)[src]; a[q] = (f32x4){bflo(xb.x), bfhi(xb.x), bflo(xb.y), bfhi(xb.y)}; } else a[q] = ((const f32x4*)Xb)[src];
            if constexpr (Y_FP8) { const unsigned y0 = ((const unsigned*)YSb)[src], y1 = ((const unsigned*)YSb)[src + (size_t)T * 256]; ysum[q] = (fp8x4_to_f32(y0) + fp8x4_to_f32(y1)) * (1.f / 16.f); }
            else { const u32x2 y0 = ((const u32x2*)YSb)[src], y1 = ((const u32x2*)YSb)[src + (size_t)T * 256]; ysum[q] = (f32x4){bflo(y0.x) + bflo(y1.x), bfhi(y0.x) + bfhi(y1.x), bflo(y0.y) + bflo(y1.y), bfhi(y0.y) + bfhi(y1.y)}; }
            ym[q] = YM[src]; } }
#pragma unroll
        for (int q = 0; q < 4; ++q) { const int i = i0 + q * NGT; if (i < NB * SEQ * 256) { const int r = i >> 8, c4 = i & 255, b = r >> 12; const f32x4 g5 = G5[(size_t)b * (NMODV / 4) + c4];
            out[i] = a[q] + (f32x4){bflo(ym[q].x), bfhi(ym[q].x), bflo(ym[q].y), bfhi(ym[q].y)} + g5 * ysum[q]; } } }
}

constexpr int NPHASE = 38;
__global__ void __launch_bounds__(512, 2) mk_fwd(Args args) {
    extern __shared__ __attribute__((aligned(16))) uchar lds[];
    Frame F; F.lds = (LAS uchar*)lds; F.ldsg = (char*)lds; F.tid = threadIdx.x; F.lane = F.tid & 63; F.wave = __builtin_amdgcn_readfirstlane(F.tid >> 6); F.G = gridDim.x; F.bid = blockIdx.x;
    F.ws = args.ws; F.out = args.out;
    uchar* ws0 = args.ws;
    volatile LAS unsigned* MISC = (volatile LAS unsigned*)(F.lds + LDSCTL_OFF);
    LAS int* tab = (LAS int*)(F.lds + LDSCTL_OFF + 256);
    for (int u = F.tid; u < (LDS_BYTES - LDSCTL_OFF) / 4; u += 512) ((LAS unsigned*)(F.lds + LDSCTL_OFF))[u] = 0u;
    __syncthreads();
    if (F.tid == 0) {
#pragma unroll
        for (int i = 0; i < 34; ++i) *(LAS unsigned long long*)(F.lds + LDSCTL_OFF + 576 + i * 8) = (unsigned long long)args.in[i]; }
    __syncthreads();
    const int lo = args.ph_lo, hi = args.ph_hi;
    if (hi - lo > 1) (void)xcd_barrier_post((unsigned*)(ws0 + WS_CTL) + CW_BAR, MISC + 8);
    int ph = 0;
#define PH_BEGIN if (ph >= opaque_uniform_int(args.ph_lo) && ph < opaque_uniform_int(args.ph_hi)) { int t_ = threadIdx.x; F.G = opaque_uniform_int(gridDim.x); F.bid = opaque_uniform_int(blockIdx.x); const int cid = F.bid; (void)cid; \
        F.out = (float*)opaque_uniform_ptr(args.out); F.lds = (LAS uchar*)lds; F.ldsg = (char*)lds; \
        asm volatile("" : "+v"(t_)); F.tid = t_; F.lane = t_ & 63; F.wave = __builtin_amdgcn_readfirstlane(t_ >> 6); \
        uchar* ws = (uchar*)opaque_uniform_ptr(args.ws); F.ws = ws; \
        const float* MODl = (const float*)(ws + WS_MOD) + (size_t)l_ * 5 * NMODV; (void)MODl;
#define GRIDBAR  { XcdBarrier bb_; bb_.bar = (unsigned*)(ws + WS_CTL) + CW_BAR; bb_.x = 0; bb_.st = (volatile LAS unsigned*)(F.lds + LDSCTL_OFF) + 8; xcd_barrier(bb_); }
#define REPBAR   if (rep_ > 1) GRIDBAR
#define PH_END   if (ph + 1 < opaque_uniform_int(args.ph_hi)) GRIDBAR } ++ph;

    { const int l_ = 0; PH_BEGIN PM(0) { const bool dry = rep_ > 1; (void)dry;  p0_prologue(F);  REPBAR } PH_END }

#pragma unroll 1
    for (int l = 0; l < DEPTH; ++l) {
        const int kind = l % 3, j = l / 3; const bool lastl = (l == DEPTH - 1); const int l_ = l;
        PH_BEGIN PM(1) { const bool dry = rep_ > 1; (void)dry;  const float* gv_ = inp(F, I_NMG) + l * D;
            if (l == 0) norm_phase<false, 0, true>(F, l, gv_, 0, false, false);
            else if (rep_ != REPN(1)) norm_phase<false, 0, false>(F, l, gv_, 0, false, false);
            else if (l == 1) norm_phase<false, 3, true>(F, l, gv_, 0, false, false);
            else norm_phase<false, 3, false>(F, l, gv_, 0, false, false);  REPBAR } PH_END
        if (kind == 0) {
            PH_BEGIN PM(2) { const bool dry = rep_ > 1; (void)dry;  { pg8::DenseOrder S; S.init(ws + WS_H, D, ws + WS_W_RGIN + (size_t)j * 2048 * 1024 * 2, D, T, 2048, F.G, cid);
                EpiRgIn E{(bf16_t*)(ws + WS_GG), (bf16_t*)(ws + WS_XB)}; pg8::gemm_phase(F.lds, S, E, D, D, D); }  REPBAR } PH_END
            PH_BEGIN PM(3) { const bool dry = rep_ > 1; (void)dry;  conv_phase(F, j);  REPBAR } PH_END
            PH_BEGIN PM(4) { const bool dry = rep_ > 1; (void)dry;  { pg8::DenseOrder S; S.init(ws + WS_XC, D, ws + WS_W_RGG + (size_t)j * 16 * 256 * 128 * 2, 128, T, 16 * 256, F.G, cid, 7, 256);
                EpiRgGate E{(const bf16_t*)(ws + WS_XC), (bf16_t*)(ws + WS_LA), (bf16_t*)(ws + WS_BB), inp(F, I_RGBA) + (size_t)j * 2 * D, inp(F, I_RGBI) + (size_t)j * 2 * D, (const float*)(ws + WS_SPL) + (size_t)j * 2 * D};
                pg8::gemm_phase(F.lds, S, E, 128, D, 128); }  REPBAR } PH_END
            PH_BEGIN PM(5) { const bool dry = rep_ > 1; (void)dry;  scan1_phase(F);  REPBAR } PH_END
            PH_BEGIN PM(20) { const bool dry = rep_ > 1; (void)dry;  scan2_phase(F);  REPBAR } PH_END
            PH_BEGIN PM(6) { const bool dry = rep_ > 1; (void)dry;  scan3_phase(F);  REPBAR } PH_END
            PH_BEGIN PM(7) { const bool dry = rep_ > 1; (void)dry;  { EpiResid E{(bf16_t*)(ws + (dry ? WS_Y1 : WS_YM)), MODl + 2 * D};
                if (lastl) { pg8::DenseOrderT<true> S; S.init(ws + WS_SA, D, ws + WS_W_RGOUT + (size_t)j * 1024 * 1024 * 2, D, T, D, F.G, cid); pg8::gemm_phase(F.lds, S, E, D, D, D); }
                else { pg8::DenseOrder S; S.init(ws + WS_SA, D, ws + WS_W_RGOUT + (size_t)j * 1024 * 1024 * 2, D, T, D, F.G, cid); pg8::gemm_phase(F.lds, S, E, D, D, D); }
                router_fill(F, l); }  REPBAR } PH_END
        } else if (kind == 1) {
            PH_BEGIN PM(8) { const bool dry = rep_ > 1; (void)dry;  { pg8::DenseOrder S; S.init(ws + WS_H, D, ws + WS_W_QKV, D, T, 1536, F.G, cid);
                EpiQKV E{(bf16_t*)(ws + WS_QKV), inp(F, I_ATQG), inp(F, I_ATKG), (const float*)(ws + WS_ROPE), (LAS float*)(F.lds + RING_BYTES)}; pg8::gemm_phase(F.lds, S, E, D, D, D); }  REPBAR } PH_END
            PH_BEGIN PM(10) { const bool dry = rep_ > 1; (void)dry;  attn_phase(F);  REPBAR } PH_END
            PH_BEGIN PM(11) { const bool dry = rep_ > 1; (void)dry;  { pg8::DenseOrder S; S.init(ws + WS_AO, D, ws + WS_W_AO, D, T, D, F.G, cid);
                EpiResid E{(bf16_t*)(ws + (dry ? WS_Y1 : WS_YM)), MODl + 2 * D}; pg8::gemm_phase(F.lds, S, E, D, D, D); router_fill(F, l); }  REPBAR } PH_END
        } else {
            PH_BEGIN PM(12) { const bool dry = rep_ > 1; (void)dry;  { pg8::DenseOrder S; S.init(ws + WS_H, D, ws + WS_W_CMIN, D, T, 4096, F.G, cid);
                EpiCmIn E{(bf16_t*)(ws + WS_UVB), (f32x2*)(ws + WS_STATP)}; pg8::gemm_phase(F.lds, S, E, D, D, D); }  REPBAR } PH_END
            PH_BEGIN PM(13) { const bool dry = rep_ > 1; (void)dry;  spatial_phase(F);  REPBAR } PH_END
            PH_BEGIN PM(14) { const bool dry = rep_ > 1; (void)dry;  { pg8::DenseOrder S; S.init(ws + WS_UV, 2048, ws + WS_W_CMOUT, 2048, T, D, F.G, cid);
                EpiResid E{(bf16_t*)(ws + (dry ? WS_Y1 : WS_YM)), MODl + 2 * D}; pg8::gemm_phase(F.lds, S, E, 2048, 2048, 2048); router_fill(F, l); }  REPBAR } PH_END
        }
        PH_BEGIN PM(15) { const bool dry = rep_ > 1; (void)dry;  if (l == 0) norm_phase<true, 1, true>(F, l, inp(F, I_NFG) + l * D, 3, lastl, dry); else norm_phase<true, 1, false>(F, l, inp(F, I_NFG) + l * D, 3, lastl, dry);  REPBAR } PH_END
        PH_BEGIN PM(16) { const bool dry = rep_ > 1; (void)dry;  { const int ntile = moe_table(F, l, tab);
            const int units = ntile * 4, rounds = (units + F.G - 1) / F.G; int geff = F.G; if (false && rounds > 0) { geff = (((units + rounds - 1) / rounds) + 7) & ~7; if (geff > F.G) geff = F.G; }
            constexpr int EB = MOE_FP8 ? 1 : 2;
            MoeOrder<true> S{tab, (const char*)(ws + WS_H), (const char*)(ws + WS_W_E1 + (size_t)l * 32 * 1024 * 1024 * EB), (const int*)(ws + WS_BK2), geff, cid, units, (size_t)1024 * 1024 * EB, 1024 * EB, 1024 * EB};
            EpiMoe1 E{ws + WS_H1}; pg8::gemm_phase(F.lds, S, E, D * EB / 2, D * EB / 2, D * EB / 2); }  REPBAR } PH_END
        PH_BEGIN PM(17) { const bool dry = rep_ > 1; (void)dry;  { const int ntile = tab[32];
            const int units = ntile * 4, rounds = (units + F.G - 1) / F.G; int geff = F.G; if (false && rounds > 0) { geff = (((units + rounds - 1) / rounds) + 7) & ~7; if (geff > F.G) geff = F.G; }
            constexpr int EB = MOE_FP8 ? 1 : 2;
            MoeOrder<false> S{tab, (const char*)(ws + WS_H1), (const char*)(ws + WS_W_E2 + (size_t)l * 32 * 1024 * 512 * EB), (const int*)(ws + WS_BK2), geff, cid, units, (size_t)1024 * 512 * EB, 512 * EB, 512 * EB};
            EpiMoe2 E{(bf16_t*)(ws + (dry ? WS_SCR + 64 * MiB : WS_Y1)), (const int*)(ws + WS_BK2), tab}; pg8::gemm_phase(F.lds, S, E, DEXP * EB / 2, DEXP * EB / 2, DEXP * EB / 2); }  REPBAR } PH_END
    }
    { const int l_ = 0; PH_BEGIN PM(18) { const bool dry = rep_ > 1; (void)dry;  final_phase(F);  REPBAR if constexpr (((REP_MASK) >> 19) & 1u) { for (int k_ = 0; k_ < 20; ++k_) GRIDBAR } } PH_END }
#undef PH_BEGIN
#undef PH_END
}

extern "C" void kernel_launch(void* const* d_in, const int* in_sizes, int n_in, void* d_out, int out_size, void* d_ws, size_t ws_size, hipStream_t stream) {
    static int grid = 0;
    if (grid == 0) {
        if (n_in != 34 || out_size != NB * SEQ * D || ws_size < WS_END) { fprintf(stderr, "kernel_launch: bad shapes n_in %d out %d ws %zu (need %zu)\n", n_in, out_size, ws_size, (size_t)WS_END); grid = -1; return; }
        int dev = 0, cus = 0, per_cu = 0;
        if (hipGetDevice(&dev) != hipSuccess || hipDeviceGetAttribute(&cus, hipDeviceAttributeMultiprocessorCount, dev) != hipSuccess) { grid = -1; return; }
        if (hipFuncSetAttribute((const void*)mk_fwd, hipFuncAttributeMaxDynamicSharedMemorySize, LDS_BYTES) != hipSuccess) { fprintf(stderr, "kernel_launch: hipFuncSetAttribute failed\n"); grid = -1; return; }
        if (hipOccupancyMaxActiveBlocksPerMultiprocessor(&per_cu, (const void*)mk_fwd, 512, LDS_BYTES) != hipSuccess || per_cu < 1) { fprintf(stderr, "kernel_launch: occupancy query says %d\n", per_cu); (void)hipGetLastError(); grid = -1; return; }
        grid = cus;
    }
    if (grid < 0) return;
    (void)hipMemsetAsync((char*)d_ws + WS_CTL, 0, CTL_BYTES, stream);
    Args a{};
    for (int i = 0; i < 34; ++i) a.in[i] = (const float*)d_in[i];
    a.out = (float*)d_out; a.ws = (uchar*)d_ws;
#if MK_PER_PHASE
    for (int p = 0; p < NPHASE; ++p) { a.ph_lo = p; a.ph_hi = p + 1; hipLaunchKernelGGL(mk_fwd, dim3(grid), dim3(512), LDS_BYTES, stream, a); }
#else
    a.ph_lo = 0; a.ph_hi = NPHASE;
    void* kargs[] = {&a};
    hipError_t e = hipLaunchCooperativeKernel((const void*)mk_fwd, dim3(grid), dim3(512), kargs, LDS_BYTES, stream);
    if (e != hipSuccess) fprintf(stderr, "kernel_launch: cooperative launch failed: %s (grid %d)\n", hipGetErrorString(e), grid);
#endif
}
```

```cpp
#include <hip/hip_runtime.h>
#include <hip/hip_bf16.h>
#include <cstdio>
#include <cstdint>

#ifndef X_BF16
#define X_BF16 1
#endif
#ifndef Y_FP8
#define Y_FP8 1
#endif
#ifndef MOE_FP8
#define MOE_FP8 1
#endif
#ifndef MK_PER_PHASE
#define MK_PER_PHASE 0
#endif

#ifndef PHASE_MASK
#define PHASE_MASK 0xFFFFFFFFu
#endif
#ifndef REP_MASK
#define REP_MASK 0u
#endif
#define REPN(i) ((((REP_MASK) >> (i)) & 1u) ? 2 : 1)
#define PM(i) if constexpr ((PHASE_MASK >> (i)) & 1u) for (int rep_ = REPN(i); rep_ > 0; --rep_)
#define LAS __attribute__((address_space(3)))
#define GAS __attribute__((address_space(1)))
typedef unsigned char uchar;
typedef unsigned short bf16_t;
typedef short bf16x8 __attribute__((ext_vector_type(8)));
typedef short s16x4 __attribute__((ext_vector_type(4)));
typedef float f32x4 __attribute__((ext_vector_type(4)));
typedef float f32x2 __attribute__((ext_vector_type(2)));
typedef float f32x16 __attribute__((ext_vector_type(16)));
typedef unsigned u32x4 __attribute__((ext_vector_type(4)));
typedef unsigned u32x2 __attribute__((ext_vector_type(2)));
typedef GAS unsigned gu32;
#define RLX_AGENT __ATOMIC_RELAXED, __HIP_MEMORY_SCOPE_AGENT

constexpr int D = 1024, NB = 4, SEQ = 4096, CTX = 256, SB = SEQ + CTX, T = NB * SB, DEPTH = 4;
constexpr int NMODV = 6 * D;
constexpr int NEXP = 32, DEXP = 512;
constexpr int NCH = SB / 16;
constexpr float NORM_EPS = 1e-6f;

constexpr size_t MiB = 1u << 20;
constexpr size_t WS_CTL = 0, CTL_BYTES = 1 * MiB;
constexpr size_t WS_MOD = 1 * MiB;
constexpr size_t WS_ROPE = 2 * MiB;
constexpr size_t WS_SPL = 2 * MiB + 65536;
constexpr size_t WS_BK2 = 3 * MiB;
constexpr size_t WS_TOT = 3 * MiB;
constexpr size_t WS_STATP = 8 * MiB;
constexpr size_t WS_BK = 13 * MiB;
constexpr size_t WS_TW = 15 * MiB + 512 * 1024;
constexpr size_t WS_W_RGIN = 16 * MiB, WS_W_RGG = 24 * MiB, WS_W_RGOUT = 26 * MiB, WS_W_QKV = 30 * MiB, WS_W_AO = 33 * MiB;
constexpr size_t WS_W_CMIN = 35 * MiB, WS_W_CMS = 43 * MiB, WS_W_CMOUT = 44 * MiB, WS_W_E1 = 48 * MiB, WS_W_E2 = 304 * MiB;
constexpr size_t WS_X = 432 * MiB, WS_Y1 = 500 * MiB, WS_H = 568 * MiB, WS_SCR = 602 * MiB;
constexpr size_t WS_GG = WS_SCR, WS_XB = WS_SCR + 34 * MiB, WS_XC = WS_SCR + 68 * MiB, WS_LA = WS_SCR + 102 * MiB, WS_BB = WS_SCR + 170 * MiB, WS_SA = WS_SCR + 238 * MiB;
constexpr size_t WS_QKV = WS_SCR, WS_AO = WS_SCR + 51 * MiB;
constexpr size_t WS_UVB = WS_SCR, WS_UV = WS_SCR + 136 * MiB;
constexpr size_t WS_H1 = WS_SCR;
constexpr size_t WS_TOTS = WS_SCR + 272 * MiB, WS_TOTH = WS_TOTS + 9 * MiB, WS_CARRY = WS_TOTH + 9 * MiB;
constexpr size_t WS_YM = WS_CARRY + 9 * MiB;
constexpr size_t WS_END = WS_YM + 34 * MiB;
constexpr int CW_TMO = 0, CW_BAR = 4096, CW_CNT = 16384;

constexpr int RING_BYTES = 131072;
constexpr int ROUTER_LDS = 36 * 1024 * 4;
constexpr int LDSCTL_OFF = 147456;
constexpr int LDS_BYTES = LDSCTL_OFF + 1024 + 8 * 4 * 80 * 4;

typedef float f32x2_t_ __attribute__((ext_vector_type(2))); typedef __bf16 bf16x2_t_ __attribute__((ext_vector_type(2)));
__device__ __forceinline__ unsigned pk2(float lo, float hi) { const f32x2_t_ v = {lo, hi}; const bf16x2_t_ b = __builtin_convertvector(v, bf16x2_t_); return __builtin_bit_cast(unsigned, b); }
__device__ __forceinline__ unsigned f2bf(float f) { return pk2(f, 0.f) & 0xffffu; }
__device__ __forceinline__ float bf2f(unsigned short h) { return __builtin_bit_cast(float, (unsigned)h << 16); }
__device__ __forceinline__ float bflo(unsigned w) { return __builtin_bit_cast(float, w << 16); }
__device__ __forceinline__ float bfhi(unsigned w) { return __builtin_bit_cast(float, w & 0xffff0000u); }
__device__ __forceinline__ unsigned cvt_pk_bf16(float lo, float hi) { return pk2(lo, hi); }
__device__ __forceinline__ f32x4 fp8x4_to_f32(unsigned w) { const f32x2 lo = __builtin_amdgcn_cvt_pk_f32_fp8((int)w, false), hi = __builtin_amdgcn_cvt_pk_f32_fp8((int)w, true); return (f32x4){lo.x, lo.y, hi.x, hi.y}; }
__device__ __forceinline__ float gelu_tanh(float x) { const float u2 = (-2.f * 0.7978845608028654f) * (x + 0.044715f * x * x * x); return x * __builtin_amdgcn_rcpf(1.f + __expf(u2)); }
__device__ __forceinline__ float sigmoidf_(float x) { return 1.f / (1.f + __expf(-x)); }
__device__ __forceinline__ float fast_sigmoid(float x) { return __builtin_amdgcn_rcpf(1.f + __expf(-x)); }
__device__ __forceinline__ float one_minus_exp(float y) {   const float p = y * (1.f - y * (0.5f - y * (0.16666667f - y * 0.041666667f))); const float q = 1.f - __expf(-y); return y < 0.0625f ? p : q; }
__device__ __forceinline__ int sidx_of_row(int row) { const int b = row / SB; return (row - b * SB) < CTX ? 4 : b; }

namespace pg8 {
constexpr int BM = 256, BK = 64, HALF = 128, HTB = HALF * BK * 2, NXCD = 8, WGM = 8;
__device__ __forceinline__ int lds_byte(int r, int c) { const int st = (r >> 4) * 2 + (c >> 5), rr = r & 15, cc = c & 31, ob = rr * 64 + cc * 2; return st * 1024 + (ob ^ (((ob >> 9) & 1) << 5)); }
__device__ __forceinline__ void stage_rc(int b, int& R, int& C) { const int st = b / 1024, sb = b % 1024, swz = sb ^ (((sb >> 9) & 1) << 5); R = (st >> 1) * 16 + swz / 64; C = (st & 1) * 32 + (swz % 64) / 2; }
__device__ __forceinline__ int perm32(int rho) { const int n = rho >> 4, i = rho & 15; return 8 * (i >> 2) + 4 * n + (i & 3); }
struct Unit { const char* a; const char* b; int pm, pn, aux0, aux1, hm; };
__device__ __forceinline__ const char* uptr(const char* p) { const unsigned long long v = (unsigned long long)p; const unsigned lo = __builtin_amdgcn_readfirstlane((unsigned)v), hi = __builtin_amdgcn_readfirstlane((unsigned)(v >> 32)); return (const char*)(const GAS char*)(((unsigned long long)hi << 32) | lo); }
__device__ __forceinline__ bool unit_slot(int i, int c, int G, int nwg, int& L, int& hm) {
    if (c >= G) return false;
    const int nfull = nwg / G, rem = nwg - nfull * G;
    if (i < nfull) { L = i * G + c; hm = 0xF; return true; }
    if (i > nfull || rem == 0) return false;
    if (rem * 2 <= G) { if (c >= 2 * rem) return false; L = nfull * G + (c >> 1); hm = (c & 1) ? 0xC : 0x3; return true; }
    if (c >= rem) return false; L = nfull * G + c; hm = 0xF; return true; }
__device__ __forceinline__ int xcd_remap(int L, int nwg) { const int q = nwg / NXCD, r = nwg % NXCD, xcd = L % NXCD, off = L / NXCD; return (xcd < r ? xcd * (q + 1) : r * (q + 1) + (xcd - r) * q) + off; }

template <bool LATENT>
struct DenseOrderT {
    static constexpr bool GATHER = false;
    const char* A; const char* B; int nM, nN, nwg, G, c; size_t tA, tB; int amask, acol;
    __device__ void init(const void* A_, int lda, const void* B_, int ldb, int M, int N, int G_, int c_, int amask_ = 0, int acol_ = 0) {
        A = (const char*)A_; B = (const char*)B_; nM = LATENT ? 64 : M / BM; nN = N / BM; nwg = nM * nN; G = G_; c = c_; tA = (size_t)BM * lda * 2; tB = (size_t)BM * ldb * 2; amask = amask_; acol = acol_; }
    __device__ bool next(int i, Unit& u) const {
        int L, hm; if (!unit_slot(i, c, G, nwg, L, hm)) return false; u.hm = __builtin_amdgcn_readfirstlane(hm);
        const int wgid = xcd_remap(L, nwg);
        const int nig = WGM * nN, gid = wgid / nig, fm = gid * WGM, gsz = (nM - fm) < WGM ? (nM - fm) : WGM;
        int pm_ = fm + ((wgid % nig) % gsz); if constexpr (LATENT) pm_ = (pm_ >> 4) * 17 + 1 + (pm_ & 15);
        u.pm = __builtin_amdgcn_readfirstlane(pm_); u.pn = __builtin_amdgcn_readfirstlane((wgid % nig) / gsz); u.aux0 = 0; u.aux1 = 0;
        u.a = uptr(A + (size_t)u.pm * tA + (size_t)(u.pn & amask) * acol); u.b = uptr(B + (size_t)u.pn * tB); return true; }
    __device__ unsigned goff(const Unit&, int) const { return 0u; }
};
typedef DenseOrderT<false> DenseOrder;

#define PG8_SA(b, h) (((b) * 2 + (h)) * HTB)
#define PG8_SB(b, h) ((4 + (b) * 2 + (h)) * HTB)
__device__ __forceinline__ void glds16(const char* sbase, unsigned voff, unsigned ldsaddr) { unsigned keep;
    asm volatile("s_mov_b32 %0, m0\n\ts_mov_b32 m0, %3\n\ts_nop 0\n\tglobal_load_lds_dwordx4 %1, %2\n\ts_mov_b32 m0, %0" : "=&s"(keep) : "v"(voff), "s"(sbase), "s"(ldsaddr) : "memory"); }
#ifndef PG8_ASM_DMA
#define PG8_ASM_DMA 1
#endif
#if PG8_ASM_DMA
#define PG8_GLDS(gp, voff, ldsoff) glds16((const char*)(gp), (voff), ldsbase + (unsigned)(ldsoff))
#else
#define PG8_GLDS(gp, voff, ldsoff) __builtin_amdgcn_global_load_lds((const unsigned*)((const char*)(gp) + (voff)), (LAS unsigned*)(lds + (ldsoff)), 16, 0, 0)
#endif
#define PG8_STAGE_B(bufoff, gbase) do { PG8_GLDS(gbase, voffB[0], (bufoff) + ldsw); PG8_GLDS(gbase, voffB[1], (bufoff) + ldsw + 8192); } while (0)
#define PG8_STAGE_A(bufoff, gbase, h, NX) do { if constexpr (Sched::GATHER) { \
        PG8_GLDS(gbase, ((NX) ? vAn[h][0] : vAc[h][0]), (bufoff) + ldsw); PG8_GLDS(gbase, ((NX) ? vAn[h][1] : vAc[h][1]), (bufoff) + ldsw + 8192); \
    } else { PG8_GLDS((const char*)(gbase) + (h) * hstepA, voffA[0], (bufoff) + ldsw); PG8_GLDS((const char*)(gbase) + (h) * hstepA, voffA[1], (bufoff) + ldsw + 8192); } } while (0)
#define PG8_LDA(dst, b, h) do { _Pragma("unroll") for (int m = 0; m < 4; ++m) _Pragma("unroll") for (int k = 0; k < 2; ++k) dst[m][k] = *(const LAS bf16x8*)(lds + PG8_SA(b, h) + aoff + m * 2048 + k * 1024); } while (0)
#define PG8_LDB(dst, b, h) do { _Pragma("unroll") for (int n = 0; n < 2; ++n) _Pragma("unroll") for (int k = 0; k < 2; ++k) dst[n][k] = *(const LAS bf16x8*)(lds + PG8_SB(b, h) + boff + n * 2048 + k * 1024); } while (0)
typedef int i32x8 __attribute__((ext_vector_type(8))); typedef int i32x4v __attribute__((ext_vector_type(4)));
__device__ __forceinline__ i32x8 cat8(bf16x8 lo, bf16x8 hi) { return __builtin_shufflevector(__builtin_bit_cast(i32x4v, lo), __builtin_bit_cast(i32x4v, hi), 0, 1, 2, 3, 4, 5, 6, 7); }
#define PG8_MMA(ai, bj, At, Bt) do { __builtin_amdgcn_s_setprio(1); _Pragma("unroll") for (int m = 0; m < 4; ++m) _Pragma("unroll") for (int n = 0; n < 2; ++n) { \
        if constexpr (Epi::FP8) { asm volatile("v_mfma_scale_f32_16x16x128_f8f6f4 %0, %1, %2, %0, %3, %3 op_sel_hi:[0,0,0]" : "+v"(acc[ai][bj][m][n]) : "v"(cat8(Bt[n][0], Bt[n][1])), "v"(cat8(At[m][0], At[m][1])), "v"(0x7F7F7F7F)); } \
        else { _Pragma("unroll") for (int k = 0; k < 2; ++k) acc[ai][bj][m][n] = __builtin_amdgcn_mfma_f32_16x16x32_bf16(Bt[n][k], At[m][k], acc[ai][bj][m][n], 0, 0, 0); } } __builtin_amdgcn_s_setprio(0); } while (0)
#define PG8_WAIT_V(n) asm volatile("s_waitcnt vmcnt(" #n ")" ::: "memory")
#define PG8_WAIT_L(n) asm volatile("s_waitcnt lgkmcnt(" #n ")" ::: "memory")
#define PG8_BAR __builtin_amdgcn_s_barrier()
#define PG8_SCHED __builtin_amdgcn_sched_barrier(0)

template <class Epi, class Sched>
__device__ __forceinline__ void gemm_phase(LAS uchar* lds, const Sched& S, const Epi& E, const int K, const int lda, const int ldb) {
    int tid = threadIdx.x; asm volatile("" : "+v"(tid));
    const int wid = __builtin_amdgcn_readfirstlane(tid >> 6), lane = tid & 63, wr = wid >> 2, wc = wid & 3; int fr = lane & 15, fq = lane >> 4;
    int nt = K / BK; asm volatile("" : "+s"(nt));
    unsigned voffA[2], voffB[2];
#pragma unroll
    for (int i = 0; i < 2; ++i) { int R, C; stage_rc(tid * 16 + i * 8192, R, C); const int Rb = Epi::PERM ? ((R & ~31) + perm32(R & 31)) : R;
        voffA[i] = (unsigned)(R * lda + C) * 2u; voffB[i] = (unsigned)(Rb * ldb + C) * 2u; }
    const size_t kstep = (size_t)(BK * 2);
    const size_t hstepA = (size_t)HALF * lda * 2, hstepB = (size_t)HALF * ldb * 2;
    const unsigned ldsw = (unsigned)wid * 1024u;
    const unsigned ldsbase = (unsigned)(uintptr_t)lds;
    const int aoff = lds_byte(wr * 64 + fr, fq * 8), boff = lds_byte(wc * 32 + fr, fq * 8);
    Unit cur, nxt; int ui = 0;
    if (!S.next(0, cur)) return;
    unsigned vAc[2][2], vAn[2][2];
#pragma unroll
    for (int h = 0; h < 2; ++h)
#pragma unroll
        for (int i = 0; i < 2; ++i) { vAc[h][i] = 0u; vAn[h][i] = 0u; }
    if constexpr (Sched::GATHER) {
#pragma unroll
        for (int h = 0; h < 2; ++h)
#pragma unroll
            for (int i = 0; i < 2; ++i) { int R, C; stage_rc(tid * 16 + i * 8192, R, C); vAc[h][i] = S.goff(cur, h * HALF + R) + (unsigned)C * 2u; }
    }
    f32x4 acc[2][2][4][2];
#pragma unroll
    for (int a = 0; a < 2; ++a)
#pragma unroll
        for (int b = 0; b < 2; ++b)
#pragma unroll
            for (int m = 0; m < 4; ++m)
#pragma unroll
                for (int n = 0; n < 2; ++n) acc[a][b][m][n] = (f32x4){0.f, 0.f, 0.f, 0.f};
    bf16x8 At[4][2], B0[2][2], B1[2][2];
    typedef int pre_t __attribute__((ext_vector_type(16))); pre_t pre = {};
    if constexpr (Epi::PREFETCH) pre = E.prefetch(cur, wr, fr);
    const char* cA = cur.a; const char* cB = cur.b;
    PG8_STAGE_B(PG8_SB(0, 0), cB); PG8_STAGE_B(PG8_SB(0, 1), cB + hstepB); PG8_STAGE_A(PG8_SA(0, 0), cA, 0, false); PG8_STAGE_A(PG8_SA(0, 1), cA, 1, false);
    if (wr == 1) PG8_BAR;
    PG8_WAIT_V(2); PG8_BAR;
    PG8_STAGE_B(PG8_SB(1, 0), cB + kstep); PG8_STAGE_A(PG8_SA(1, 0), cA + kstep, 0, false); PG8_STAGE_B(PG8_SB(1, 1), cB + hstepB + kstep);
    PG8_WAIT_V(6); PG8_BAR;
    for (;;) {
        const bool has_next = S.next(ui + 1, nxt);
        if constexpr (Sched::GATHER) { if (has_next) {
#pragma unroll
            for (int h = 0; h < 2; ++h)
#pragma unroll
                for (int i = 0; i < 2; ++i) { int R, C; int t2 = tid; asm volatile("" : "+v"(t2)); stage_rc(t2 * 16 + i * 8192, R, C); vAn[h][i] = S.goff(nxt, h * HALF + R) + (unsigned)C * 2u; }
            *(LAS u32x4*)(lds + 131072 + tid * 16) = (u32x4){vAn[0][0], vAn[0][1], vAn[1][0], vAn[1][1]}; } }
        const char* nA = has_next ? nxt.a : cA; const char* nB = has_next ? nxt.b : cB;
        for (int t = 0; t < nt; t += 2) {
            const bool last = (t == nt - 2);
            const bool nx = last && has_next;
            if constexpr (Sched::GATHER) { if (nx) { const u32x4 pk_ = *(const LAS u32x4*)(lds + 131072 + tid * 16); vAn[0][0] = pk_.x; vAn[0][1] = pk_.y; vAn[1][0] = pk_.z; vAn[1][1] = pk_.w; } }
            const char* a1 = cA + (size_t)(t + 1) * kstep;
            const char* a2 = last ? nA : cA + (size_t)(t + 2) * kstep; const char* b2 = last ? nB : cB + (size_t)(t + 2) * kstep;
            const char* a3 = a2 + kstep; const char* b3 = b2 + kstep;
            PG8_LDB(B0, 0, 0); PG8_LDB(B1, 0, 1); PG8_SCHED; PG8_LDA(At, 0, 0); PG8_STAGE_A(PG8_SA(1, 1), a1, 1, false);
            PG8_WAIT_V(8); PG8_WAIT_L(0); PG8_BAR; if (cur.hm & 1) { PG8_MMA(0, 0, At, B0); PG8_MMA(0, 1, At, B1); } PG8_BAR; PG8_SCHED;
            PG8_LDA(At, 0, 1); PG8_STAGE_B(PG8_SB(0, 0), b2); PG8_STAGE_B(PG8_SB(0, 1), b2 + hstepB); PG8_STAGE_A(PG8_SA(0, 0), a2, 0, nx);
            PG8_WAIT_V(8); PG8_WAIT_L(0); PG8_BAR; if (cur.hm & 4) { PG8_MMA(1, 0, At, B0); PG8_MMA(1, 1, At, B1); } PG8_BAR; PG8_SCHED;
            PG8_LDB(B0, 1, 0); PG8_LDB(B1, 1, 1); PG8_SCHED; PG8_LDA(At, 1, 0); PG8_STAGE_A(PG8_SA(0, 1), a2, 1, nx);
            PG8_WAIT_V(8); PG8_WAIT_L(0); PG8_BAR; if (cur.hm & 1) { PG8_MMA(0, 0, At, B0); PG8_MMA(0, 1, At, B1); } PG8_BAR; PG8_SCHED;
            PG8_LDA(At, 1, 1); PG8_STAGE_B(PG8_SB(1, 0), b3); PG8_STAGE_B(PG8_SB(1, 1), b3 + hstepB); PG8_STAGE_A(PG8_SA(1, 0), a3, 0, nx);
            PG8_WAIT_V(8); PG8_WAIT_L(0); PG8_BAR; if (cur.hm & 4) { PG8_MMA(1, 0, At, B0); PG8_MMA(1, 1, At, B1); } PG8_BAR; PG8_SCHED;
        }
        if (wr == 0) PG8_BAR;
        if constexpr (Epi::FP8) asm volatile("s_nop 15\n\ts_nop 15" ::: "memory");
        if constexpr (Epi::PREFETCH) E(acc, cur, wr, wc, fr, fq, pre); else E(acc, cur, wr, wc, fr, fq);
        if (!has_next) break;
#pragma unroll
        for (int a = 0; a < 2; ++a)
#pragma unroll
            for (int b = 0; b < 2; ++b)
#pragma unroll
                for (int m = 0; m < 4; ++m)
#pragma unroll
                    for (int n = 0; n < 2; ++n) acc[a][b][m][n] = (f32x4){0.f, 0.f, 0.f, 0.f};
        cur = nxt; cA = nA; cB = nB; ++ui;
        if constexpr (Epi::PREFETCH) pre = E.prefetch(cur, wr, fr);
        if constexpr (Sched::GATHER) {
#pragma unroll
            for (int h = 0; h < 2; ++h)
#pragma unroll
                for (int i = 0; i < 2; ++i) vAc[h][i] = vAn[h][i]; }
        if (wr == 1) PG8_BAR;
    }
    PG8_WAIT_V(0);
    PG8_BAR;
}
}

#ifndef ATT_SDEPTH
#define ATT_SDEPTH 1
#endif
namespace att {
constexpr int NW = 8, QBLK = 32, KVBLK = 64;
constexpr float SCALE = 0.088388347648318440f;
constexpr float THR = 8.f;
constexpr int LDQ = 1536, LDK = 1536, LDO = 1024;
constexpr size_t SHM_V = KVBLK * 128 * 2, SHM_K = KVBLK * 128 * 2, SHM_ATTN = 2 * SHM_V + 2 * SHM_K + NW * 64 * 4;
#define KSWZ(row, colB) ((row) * 256 + ((colB) ^ (((row) & 7) << 4)))
#define SBAR() __builtin_amdgcn_sched_barrier(0)
__device__ __forceinline__ int crow(int r, int hi) { return (r & 3) + 8 * (r >> 2) + 4 * hi; }
__device__ __forceinline__ void partialSM(f32x16& p0, f32x16& p1, float& m_reg, float& mn, float& alpha) {
  constexpr float C = SCALE * 1.4426950408889634f;
  float pmax = p0[0];
#pragma unroll
  for (int r = 1; r < 16; ++r) pmax = fmaxf(pmax, p0[r]);
#pragma unroll
  for (int r = 0; r < 16; ++r) pmax = fmaxf(pmax, p1[r]);
  { auto rr = __builtin_amdgcn_permlane32_swap(__float_as_uint(pmax), __float_as_uint(pmax), false, false);
    pmax = fmaxf(__uint_as_float(rr[0]), __uint_as_float(rr[1])); }
  if (__builtin_expect(__all(pmax - m_reg <= THR / SCALE), 1)) { mn = m_reg; alpha = 1.f; }
  else { mn = fmaxf(m_reg, pmax); alpha = __builtin_amdgcn_exp2f((m_reg - mn) * C); m_reg = mn; }
  float mnC = -mn * C;
#pragma unroll
  for (int r = 0; r < 16; ++r) p0[r] = fmaf(p0[r], C, mnC);
#pragma unroll
  for (int r = 0; r < 16; ++r) p1[r] = fmaf(p1[r], C, mnC);
#pragma unroll
  for (int r = 0; r < 16; ++r) p0[r] = __builtin_amdgcn_exp2f(p0[r]);
}
__device__ __forceinline__ void finishSM(f32x16& p0, f32x16& p1, float alpha, float& l_reg, bf16x8& pa0, bf16x8& pa1, bf16x8& pa2, bf16x8& pa3) {
#pragma unroll
  for (int r = 0; r < 16; ++r) p1[r] = __builtin_amdgcn_exp2f(p1[r]);
  float ps = 0;
#pragma unroll
  for (int r = 0; r < 16; ++r) ps += p0[r];
#pragma unroll
  for (int r = 0; r < 16; ++r) ps += p1[r];
  { auto rr = __builtin_amdgcn_permlane32_swap(__float_as_uint(ps), __float_as_uint(ps), false, false);
    ps = __uint_as_float(rr[0]) + __uint_as_float(rr[1]); }
  l_reg = l_reg * alpha + ps;
#define PK4(P, BASE, OUT) do { unsigned a0 = cvt_pk_bf16(P[BASE + 0], P[BASE + 1]), a1 = cvt_pk_bf16(P[BASE + 2], P[BASE + 3]);   \
    unsigned b0 = cvt_pk_bf16(P[BASE + 4], P[BASE + 5]), b1 = cvt_pk_bf16(P[BASE + 6], P[BASE + 7]);                              \
    auto r0 = __builtin_amdgcn_permlane32_swap(a0, b0, false, false); auto r1 = __builtin_amdgcn_permlane32_swap(a1, b1, false, false); \
    u32x4 w = {r0[0], r1[0], r0[1], r1[1]}; OUT = __builtin_bit_cast(bf16x8, w); } while (0)
  PK4(p0, 0, pa0); PK4(p0, 8, pa1); PK4(p1, 0, pa2); PK4(p1, 8, pa3);
#undef PK4
}
__device__ __forceinline__ void qkt(f32x16& p0, f32x16& p1, const bf16_t* Ks, const bf16x8* qr, int r32, int hi) {
  p0 = f32x16{}; p1 = f32x16{};
#pragma unroll
  for (int d0 = 0; d0 < 8; ++d0) { int cb = (d0 * 16 + hi * 8) * 2;
    bf16x8 b0 = *reinterpret_cast<const bf16x8*>((const char*)Ks + KSWZ(r32, cb));
    bf16x8 b1 = *reinterpret_cast<const bf16x8*>((const char*)Ks + KSWZ(32 + r32, cb));
    p0 = __builtin_amdgcn_mfma_f32_32x32x16_bf16(b0, qr[d0], p0, 0, 0, 0);
    p1 = __builtin_amdgcn_mfma_f32_32x32x16_bf16(b1, qr[d0], p1, 0, 0, 0); }
}
__device__ __forceinline__ int v_st(int k, int c) { const int kk = (k & ~0xC) | ((k & 4) << 1) | ((k & 8) >> 1); return ((kk >> 3) * 4 + (c >> 5)) * 512 + ((kk & 7) * 32 + (c & 31)) * 2; }
__device__ __forceinline__ int v_rd_base(int lane) { return ((lane & 3) << 3) | (((lane >> 2) & 3) << 6) | (((lane >> 4) & 1) << 5) | (((lane >> 5) & 1) << 8); }
constexpr int v_rd_off(int d0, int ks, int half) { return d0 * 512 + ks * 4096 + half * 2048; }
template <int OFF> __device__ __forceinline__ s16x4 tr_read(int vb) {
  s16x4 r; asm volatile("ds_read_b64_tr_b16 %0, %1 offset:%2" : "=&v"(r) : "v"(vb), "i"(OFF) : "memory"); return r;
}
template <int D0> __device__ __forceinline__ void pv_one(f32x16& od, int vb, bf16x8 pa0, bf16x8 pa1, bf16x8 pa2, bf16x8 pa3) {
  const s16x4 l0 = tr_read<v_rd_off(D0, 0, 0)>(vb), h0 = tr_read<v_rd_off(D0, 0, 1)>(vb), l1 = tr_read<v_rd_off(D0, 1, 0)>(vb), h1 = tr_read<v_rd_off(D0, 1, 1)>(vb);
  const s16x4 l2 = tr_read<v_rd_off(D0, 2, 0)>(vb), h2 = tr_read<v_rd_off(D0, 2, 1)>(vb), l3 = tr_read<v_rd_off(D0, 3, 0)>(vb), h3 = tr_read<v_rd_off(D0, 3, 1)>(vb);
  asm volatile("s_waitcnt lgkmcnt(0)" ::: "memory"); SBAR();
#define PK(L, H) (bf16x8){L[0], L[1], L[2], L[3], H[0], H[1], H[2], H[3]}
  od = __builtin_amdgcn_mfma_f32_32x32x16_bf16(pa0, PK(l0, h0), od, 0, 0, 0);
  od = __builtin_amdgcn_mfma_f32_32x32x16_bf16(pa1, PK(l1, h1), od, 0, 0, 0);
  od = __builtin_amdgcn_mfma_f32_32x32x16_bf16(pa2, PK(l2, h2), od, 0, 0, 0);
  od = __builtin_amdgcn_mfma_f32_32x32x16_bf16(pa3, PK(l3, h3), od, 0, 0, 0);
#undef PK
}
__device__ __forceinline__ void pv_d0(f32x16* o, int vb, bf16x8 pa0, bf16x8 pa1, bf16x8 pa2, bf16x8 pa3) {
  pv_one<0>(o[0], vb, pa0, pa1, pa2, pa3); pv_one<1>(o[1], vb, pa0, pa1, pa2, pa3); pv_one<2>(o[2], vb, pa0, pa1, pa2, pa3); pv_one<3>(o[3], vb, pa0, pa1, pa2, pa3);
}
__device__ __forceinline__ void attn_dense_body(const bf16_t* Qb, const bf16_t* Kh, const bf16_t* Vh, bf16_t* Ob, int seq, char* lds, const int tid) {
  const int wid = tid >> 6, lane = tid & 63, r32 = lane & 31, hi = lane >> 5;
  bf16_t* V_lds = (bf16_t*)lds; bf16_t* K_lds = (bf16_t*)(lds + 2 * SHM_V);
  float* ws = (float*)(lds + 2 * SHM_V + 2 * SHM_K) + wid * 64; float* li_l = ws; float* al_l = ws + 32;
  float m_reg = -1e30f, l_reg = 0; f32x16 o[4] = {}; bf16x8 qr[8];
  const bf16_t* Qw = Qb + (long)(wid * QBLK + r32) * LDQ + hi * 8;
#pragma unroll
  for (int d0 = 0; d0 < 8; ++d0) qr[d0] = *reinterpret_cast<const bf16x8*>(Qw + d0 * 16);
  const int sr = tid >> 4, sc = (tid & 15) * 8, vst0 = v_st(sr, sc), vst1 = v_st(32 + sr, sc);
  const int vb0 = (int)(uintptr_t)V_lds + v_rd_base(lane);
  struct { bf16x8 vs0, vs1, ks0, ks1; } sr_[ATT_SDEPTH];
  const unsigned vo0 = (unsigned)(sr * LDK + sc) * 2u, vo1 = (unsigned)((32 + sr) * LDK + sc) * 2u;
  const long vdelta = (const char*)Vh - (const char*)Kh;
#define SLOAD(i, k0) do { const char* kb_ = (const char*)Kh + (size_t)(k0) * (LDK * 2); const char* vb_ = kb_ + vdelta; \
    sr_[i].vs0 = *reinterpret_cast<const bf16x8*>(vb_ + vo0); sr_[i].vs1 = *reinterpret_cast<const bf16x8*>(vb_ + vo1); \
    sr_[i].ks0 = *reinterpret_cast<const bf16x8*>(kb_ + vo0); sr_[i].ks1 = *reinterpret_cast<const bf16x8*>(kb_ + vo1); } while (0)
#define SWRITE(b, i) do { *(bf16x8*)((char*)V_lds + (b) * SHM_V + vst0) = sr_[i].vs0;          \
    *(bf16x8*)((char*)V_lds + (b) * SHM_V + vst1) = sr_[i].vs1; int kc = sc * 2;               \
    *(bf16x8*)((char*)K_lds + (b) * SHM_K + KSWZ(sr, kc)) = sr_[i].ks0;                       \
    *(bf16x8*)((char*)K_lds + (b) * SHM_K + KSWZ(32 + sr, kc)) = sr_[i].ks1; } while (0)
#define SWAIT() do { if constexpr (ATT_SDEPTH == 2) asm volatile("s_waitcnt vmcnt(4)" ::: "memory"); else asm volatile("s_waitcnt vmcnt(0)" ::: "memory"); } while (0)
#define RESC(a) do { if (__any((a) < 1.f)) { if (hi == 0) al_l[r32] = (a); asm volatile("s_waitcnt lgkmcnt(0)" ::: "memory"); \
    _Pragma("unroll") for (int d = 0; d < 4; ++d) _Pragma("unroll") for (int r = 0; r < 16; ++r) o[d][r] *= al_l[crow(r, hi)]; } } while (0)
  f32x16 pA0, pA1, pB0, pB1; float mnA, mnB, alA, alB; bf16x8 pa0, pa1, pa2, pa3; const int NT = seq / KVBLK;
  constexpr int SE = 0, SO = ATT_SDEPTH - 1;
  SLOAD(SE, 0); asm volatile("s_waitcnt vmcnt(0)" ::: "memory"); SWRITE(0, SE); __syncthreads();
  qkt(pA0, pA1, K_lds, qr, r32, hi); partialSM(pA0, pA1, m_reg, mnA, alA);
  SLOAD(SO, KVBLK); if constexpr (ATT_SDEPTH == 2) { if (2 < NT) SLOAD(SE, 2 * KVBLK); }
  SWAIT(); SWRITE(1, SO); __syncthreads();
  for (int j = 1; j + 1 < NT; j += 2) {
    SBAR(); qkt(pB0, pB1, (bf16_t*)((char*)K_lds + SHM_K), qr, r32, hi);
    finishSM(pA0, pA1, alA, l_reg, pa0, pa1, pa2, pa3); SBAR();
    SLOAD(SO, (j + ATT_SDEPTH) * KVBLK); SBAR();
    pv_d0(o, vb0, pa0, pa1, pa2, pa3); partialSM(pB0, pB1, m_reg, mnB, alB);
    __syncthreads(); SWAIT(); SWRITE(0, SE);
    RESC(alB); __syncthreads();
    SBAR(); qkt(pA0, pA1, K_lds, qr, r32, hi);
    finishSM(pB0, pB1, alB, l_reg, pa0, pa1, pa2, pa3); SBAR();
    if (ATT_SDEPTH == 1 || j + 3 < NT) SLOAD(SE, (j + 1 + ATT_SDEPTH) * KVBLK); SBAR();
    pv_d0(o, vb0 + (int)SHM_V, pa0, pa1, pa2, pa3); partialSM(pA0, pA1, m_reg, mnA, alA);
    __syncthreads(); SWAIT(); SWRITE(1, SO);
    RESC(alA); __syncthreads();
  }
  SBAR(); qkt(pB0, pB1, (bf16_t*)((char*)K_lds + SHM_K), qr, r32, hi);
  finishSM(pA0, pA1, alA, l_reg, pa0, pa1, pa2, pa3); SBAR();
  pv_d0(o, vb0, pa0, pa1, pa2, pa3); partialSM(pB0, pB1, m_reg, mnB, alB);
  __syncthreads(); RESC(alB);
  finishSM(pB0, pB1, alB, l_reg, pa0, pa1, pa2, pa3); SBAR();
  pv_d0(o, vb0 + (int)SHM_V, pa0, pa1, pa2, pa3);
  if (hi == 0) li_l[r32] = l_reg; asm volatile("s_waitcnt lgkmcnt(0)" ::: "memory");
  float rli[16];
#pragma unroll
  for (int r = 0; r < 16; ++r) rli[r] = __builtin_amdgcn_rcpf(li_l[crow(r, hi)]);
  bf16_t* Ow = Ob + (long)(wid * QBLK) * LDO;
#pragma unroll
  for (int r = 0; r < 16; ++r) { int orow = crow(r, hi);
#pragma unroll
    for (int d0 = 0; d0 < 4; ++d0) Ow[(long)orow * LDO + d0 * 32 + r32] = (bf16_t)f2bf(o[d0][r] * rli[r]); }
#undef SLOAD
#undef SWRITE
#undef SWAIT
#undef RESC
}
}

#define XB_TMO      128
#define XB_XCNT(j)  (256  + 64 * (j))
#define XB_XSUB(j)  (1280 + 64 * (j))
#define XB_XGEN(j)  (2304 + 64 * (j))
#define XB_TOP      3328
#define XB_TOPGEN   3392
#define XB_SPIN_CAP (1u << 22)
__device__ __forceinline__ unsigned xb_ld(unsigned* p)              { return __hip_atomic_load(p, __ATOMIC_RELAXED, __HIP_MEMORY_SCOPE_AGENT); }
__device__ __forceinline__ unsigned xb_add(unsigned* p, unsigned v) { return __hip_atomic_fetch_add(p, v, __ATOMIC_RELAXED, __HIP_MEMORY_SCOPE_AGENT); }
__device__ __forceinline__ unsigned xb_xcc_id() { return (unsigned)__builtin_amdgcn_s_getreg((3 << 11) | 20) & 0xFu; }
#define XB_SPIN(cond, bar) do { unsigned _sp = 0; while (cond) { __builtin_amdgcn_s_sleep(1); \
    if ((++_sp & 255u) == 0u) { if (xb_ld(&(bar)[XB_TMO])) break; if (_sp > XB_SPIN_CAP) { atomicAdd(&(bar)[XB_TMO], 1u); break; } } } } while (0)
struct XcdBarrier { unsigned* bar; unsigned x; volatile LAS unsigned* st; };
__device__ __forceinline__ XcdBarrier xcd_barrier_post(unsigned* bar, volatile LAS unsigned* st) {
    XcdBarrier b; b.bar = bar; b.x = xb_xcc_id(); b.st = st;
    if (threadIdx.x == 0) (void)xb_add(&bar[XB_XCNT(b.x)], 1u);
    return b;
}
__device__ __forceinline__ void xcd_barrier_complete(unsigned* bar, unsigned x, unsigned& nloc, unsigned& nx) {
    const unsigned G = gridDim.x * gridDim.y * gridDim.z;
    unsigned sum, cnt, mine, sp = 0u;
    for (;;) {
        sum = 0u; cnt = 0u; mine = 0u;
#pragma unroll
        for (unsigned j = 0; j < 16; ++j) { const unsigned c = xb_ld(&bar[XB_XCNT(j)]); sum += c; cnt += (c > 0u) ? 1u : 0u; mine = (j == x) ? c : mine; }
        if (sum == G) break;
        __builtin_amdgcn_s_sleep(1);
        if ((++sp & 255u) == 0u) { if (xb_ld(&bar[XB_TMO])) break; if (sp > XB_SPIN_CAP) { atomicAdd(&bar[XB_TMO], 1u); break; } }
    }
    nloc = mine > 0u ? mine : 1u; nx = cnt > 0u ? cnt : 1u;
}
__device__ __forceinline__ void xcd_barrier(const XcdBarrier& b_) {
    XcdBarrier b; b.bar = b_.bar; b.st = b_.st; b.x = xb_xcc_id();
    asm volatile("s_waitcnt vmcnt(0)" ::: "memory");
    __syncthreads();
    if (threadIdx.x == 0) {
        unsigned* bar = b.bar;
        __builtin_amdgcn_s_waitcnt(0);
        unsigned nloc = b.st[0], nx = b.st[1];
        if (nloc == 0u) { xcd_barrier_complete(bar, b.x, nloc, nx); b.st[0] = nloc; b.st[1] = nx; }
        const unsigned old = xb_add(&bar[XB_XSUB(b.x)], 1u);
        const unsigned gen = old / nloc;
        if (old + 1u == (gen + 1u) * nloc) {
            __builtin_amdgcn_fence(__ATOMIC_RELEASE, "agent");
            asm volatile("s_waitcnt vmcnt(0)" ::: "memory");
            const unsigned og = xb_add(&bar[XB_TOP], 1u);
            const unsigned tg = og / nx;
            if (og + 1u == (tg + 1u) * nx) xb_add(&bar[XB_TOPGEN], 1u);
            else XB_SPIN(xb_ld(&bar[XB_TOPGEN]) == tg, bar);
            __builtin_amdgcn_fence(__ATOMIC_ACQUIRE, "agent");
            xb_add(&bar[XB_XGEN(b.x)], 1u);
            asm volatile("s_waitcnt vmcnt(0)" ::: "memory");
        } else {
            XB_SPIN(xb_ld(&bar[XB_XGEN(b.x)]) == gen, bar);
            __builtin_amdgcn_fence(__ATOMIC_ACQUIRE, "agent");
            asm volatile("s_waitcnt vmcnt(0)" ::: "memory");
        }
    }
    __syncthreads();
}

struct Args { const float* in[34]; float* out; uchar* ws; int ph_lo, ph_hi; };
enum { I_X = 0, I_C, I_CTX, I_CCTX, I_ADAW, I_ADAB, I_NMG, I_NFG, I_RGWIN, I_RGCW, I_RGCB, I_RGWA, I_RGBA, I_RGWI, I_RGBI, I_RGLAM, I_RGWOUT,
       I_ATQKV, I_ATQG, I_ATKG, I_ATWO, I_CMWIN, I_CMLNG, I_CMLNB, I_CMWS, I_CMBS, I_CMWOUT, I_MWG, I_MBG, I_MWR, I_MBR, I_MWGATE, I_MWUP, I_MWDOWN };

__device__ __forceinline__ const void* opaque_uniform_ptr(const void* p) { const unsigned long long v = (unsigned long long)p; unsigned lo = (unsigned)v, hi = (unsigned)(v >> 32); asm volatile("" : "+v"(lo), "+v"(hi));
    lo = __builtin_amdgcn_readfirstlane(lo); hi = __builtin_amdgcn_readfirstlane(hi); return (const void*)(const GAS char*)(((unsigned long long)hi << 32) | lo); }
__device__ __forceinline__ int opaque_uniform_int(int x) { asm volatile("" : "+v"(x)); return __builtin_amdgcn_readfirstlane(x); }
struct Frame {
    LAS uchar* lds; char* ldsg;
    int tid, lane, wave, G, bid;
    uchar* ws; float* out;
};
__device__ __forceinline__ const float* inp(const Frame& F, int i) { const unsigned long long v = *(const LAS unsigned long long*)(F.lds + LDSCTL_OFF + 576 + i * 8);
    const unsigned lo = __builtin_amdgcn_readfirstlane((unsigned)v), hi = __builtin_amdgcn_readfirstlane((unsigned)(v >> 32)); return (const float*)(const GAS float*)(((unsigned long long)hi << 32) | lo); }
__device__ __forceinline__ float wave16_sum(float v) {
    v += __int_as_float(__builtin_amdgcn_update_dpp(0, __float_as_int(v), 0xB1, 0xF, 0xF, true));
    v += __int_as_float(__builtin_amdgcn_update_dpp(0, __float_as_int(v), 0x4E, 0xF, 0xF, true));
    v += __int_as_float(__builtin_amdgcn_update_dpp(0, __float_as_int(v), 0x141, 0xF, 0xF, true));
    v += __int_as_float(__builtin_amdgcn_update_dpp(0, __float_as_int(v), 0x140, 0xF, 0xF, true));
    return v; }

struct ConvItem { const float* src; uchar* dst; int ldw, rowb; bool f8, perm; };
__device__ __forceinline__ void tr_load(const ConvItem& ci, f32x4 (&v)[16]) {
    if (ci.f8) {
#pragma unroll
        for (int i = 0; i < 8; ++i) { v[2 * i] = __builtin_nontemporal_load((const f32x4*)(ci.src + (size_t)(8 * i) * ci.ldw)); v[2 * i + 1] = __builtin_nontemporal_load((const f32x4*)(ci.src + (size_t)(8 * i + 1) * ci.ldw)); }
    } else {
#pragma unroll
        for (int i = 0; i < 16; ++i) v[i] = __builtin_nontemporal_load((const f32x4*)(ci.src + (size_t)(4 * i) * ci.ldw));
    }
}
__device__ __forceinline__ void tr_finish(const f32x4 (&v)[16], const ConvItem& ci, LAS uchar* scr, int lane, const int half) {
    LAS uchar* row2 = scr + 8192 + lane * 128; const int sw2 = lane & 7;
    const int kr = lane >> 4, nc = (lane & 15) * 4;
    const int g = lane >> 4, q = (lane >> 2) & 3, p = lane & 3;
    const int vb = (int)(uintptr_t)scr + q * 128 + g * 32 + p * 8;
    if (ci.f8) {
#pragma unroll
        for (int i = 0; i < 8; ++i) { const f32x4 a = v[2 * i] * 32.f, b = v[2 * i + 1] * 32.f;
            int r0 = __builtin_amdgcn_cvt_pk_fp8_f32(a.x, b.x, 0, false); r0 = __builtin_amdgcn_cvt_pk_fp8_f32(a.y, b.y, r0, true);
            int r1 = __builtin_amdgcn_cvt_pk_fp8_f32(a.z, b.z, 0, false); r1 = __builtin_amdgcn_cvt_pk_fp8_f32(a.w, b.w, r1, true);
            *(LAS u32x2*)(scr + (4 * i + kr) * 128 + nc * 2) = (u32x2){(unsigned)r0, (unsigned)r1}; }
        asm volatile("s_waitcnt lgkmcnt(0)" ::: "memory");
        s16x4 t[8];
#define TRR(r) t[r] = att::tr_read<(r) * 512>(vb)
        TRR(0); TRR(1); TRR(2); TRR(3); TRR(4); TRR(5); TRR(6); TRR(7);
#undef TRR
        asm volatile("s_waitcnt lgkmcnt(0)" ::: "memory"); __builtin_amdgcn_sched_barrier(0);
#pragma unroll
        for (int j = 0; j < 4; ++j) { const bf16x8 o = {t[2 * j][0], t[2 * j][1], t[2 * j][2], t[2 * j][3], t[2 * j + 1][0], t[2 * j + 1][1], t[2 * j + 1][2], t[2 * j + 1][3]}; *(LAS bf16x8*)(row2 + (((half * 4 + j) ^ sw2) * 16)) = o; }
    } else {
#pragma unroll
        for (int i = 0; i < 16; ++i) { u32x2 o; o.x = pk2(v[i].x, v[i].y); o.y = pk2(v[i].z, v[i].w); *(LAS u32x2*)(scr + (4 * i + kr) * 128 + nc * 2) = o; }
        asm volatile("s_waitcnt lgkmcnt(0)" ::: "memory");
        s16x4 t[16];
#define TRR(r) t[r] = att::tr_read<(r) * 512>(vb)
        TRR(0); TRR(1); TRR(2); TRR(3); TRR(4); TRR(5); TRR(6); TRR(7); TRR(8); TRR(9); TRR(10); TRR(11); TRR(12); TRR(13); TRR(14); TRR(15);
#undef TRR
        asm volatile("s_waitcnt lgkmcnt(0)" ::: "memory"); __builtin_amdgcn_sched_barrier(0);
#pragma unroll
        for (int j = 0; j < 8; ++j) { const bf16x8 o = {t[2 * j][0], t[2 * j][1], t[2 * j][2], t[2 * j][3], t[2 * j + 1][0], t[2 * j + 1][1], t[2 * j + 1][2], t[2 * j + 1][3]}; *(LAS bf16x8*)(row2 + ((j ^ sw2) * 16)) = o; }
    }
}
__device__ __forceinline__ void tr_flush(const ConvItem& ci, LAS uchar* scr, int lane) {
    const int r8 = lane >> 3, pc = lane & 7; const LAS uchar* p2 = scr + 8192 + r8 * 128 + ((pc ^ r8) * 16);
    u32x4 w[8];
#pragma unroll
    for (int j = 0; j < 8; ++j) w[j] = *(const LAS u32x4*)(p2 + j * 1024);
#pragma unroll
    for (int j = 0; j < 8; ++j) { int r = r8 + 8 * j;
        if (ci.perm) { const int hf = r >> 5, f = r & 31; r = 32 * (f >> 4) + 8 * ((f >> 2) & 3) + 4 * hf + (f & 3); }
        *(u32x4*)(ci.dst + (size_t)r * ci.rowb + pc * 16) = w[j]; }
}
struct Job { int g, lo, hi; };
__device__ __forceinline__ ConvItem conv_decode(Frame& F, int g, int it) {
    uchar* ws = F.ws; const float* W; int K = 1024, N = 1024, ldt = 1024, mode = 0; size_t dms = 0; bf16_t* WT;
    switch (g) {
        case 0:  W = inp(F, I_MWGATE); N = 512; WT = (bf16_t*)(ws + WS_W_E1); dms = (size_t)1024 * 1024; mode = 1; break;
        case 1:  W = inp(F, I_MWUP);   N = 512; WT = (bf16_t*)(ws + WS_W_E1); dms = (size_t)1024 * 1024; mode = 2; break;
        case 2:  W = inp(F, I_MWDOWN); K = 512; WT = (bf16_t*)(ws + WS_W_E2); ldt = 512; dms = (size_t)1024 * 512; break;
        case 3:  W = inp(F, I_RGWIN);  N = 2048; WT = (bf16_t*)(ws + WS_W_RGIN); dms = (size_t)2048 * 1024; break;
        case 4:  W = inp(F, I_CMWIN);  N = 4096; WT = (bf16_t*)(ws + WS_W_CMIN); break;
        case 5:  W = inp(F, I_RGWOUT); WT = (bf16_t*)(ws + WS_W_RGOUT); dms = (size_t)1024 * 1024; break;
        case 6:  W = inp(F, I_CMWOUT); K = 2048; WT = (bf16_t*)(ws + WS_W_CMOUT); ldt = 2048; break;
        case 7:  W = inp(F, I_ATQKV);  N = 1536; WT = (bf16_t*)(ws + WS_W_QKV); break;
        case 8:  W = inp(F, I_ATWO);   WT = (bf16_t*)(ws + WS_W_AO); break;
        case 9:  W = inp(F, I_RGWA);   K = 128; N = 128; WT = (bf16_t*)(ws + WS_W_RGG); ldt = 128; dms = (size_t)256 * 128; break;
        default: W = inp(F, I_RGWI);   K = 128; N = 128; WT = (bf16_t*)(ws + WS_W_RGG); ldt = 128; dms = (size_t)256 * 128; mode = 3; break;
    }
    const int nblk = N / 64, nkb = K / 64, per = nkb * nblk, mat = it / per, r = it - mat * per, kb = r % nkb, nb = r / nkb, n0 = nb * 64;
    int drow = n0;
    if (mode == 1) drow = (n0 >> 7) * 256 + (n0 & 127); else if (mode == 2) drow = (n0 >> 7) * 256 + 128 + (n0 & 127); else if (mode == 3) drow = 128 + n0;
    const int lane = F.lane;
    const bool f8 = (MOE_FP8 != 0) && g < 3; const int eb = f8 ? 1 : 2;
    ConvItem ci; ci.ldw = N; ci.f8 = f8; ci.src = W + (size_t)mat * K * N + (size_t)(kb * 64 + (f8 ? 2 : 1) * (lane >> 4)) * N + n0 + (lane & 15) * 4;
    ci.perm = (g == 7 && n0 < 1280);
    ci.rowb = ldt * eb;
    ci.dst = (uchar*)WT + ((size_t)mat * dms + (size_t)drow * ldt + (f8 ? (kb & ~1) : kb) * 64) * eb;
    return ci;
}
template <int NJ>
__device__ __forceinline__ ConvItem conv_find(Frame& F, int v, const Job (&jobs)[NJ]) { int r = v, g = jobs[0].g, it = 0; bool found = false;
#pragma unroll
    for (int q = 0; q < NJ; ++q) { const int n = jobs[q].hi - jobs[q].lo; if (!found) { if (r < n) { g = jobs[q].g; it = jobs[q].lo + r; found = true; } else r -= n; } }
    return conv_decode(F, g, it); }
template <int NJ>
__device__ __forceinline__ void conv_tail(Frame& F, int nblk0, const Job (&jobs)[NJ]) {
    if (nblk0 >= F.G) nblk0 = 0;
    if (F.bid < nblk0) return;
    LAS uchar* scr = F.lds + F.wave * 16384;
    int total = 0;
#pragma unroll
    for (int q = 0; q < NJ; ++q) total += jobs[q].hi - jobs[q].lo;
    const int npair = total >> 1, nw = (F.G - nblk0) * 8;
    int u = (F.bid - nblk0) * 8 + F.wave;
    f32x4 va[16], vb[16]; ConvItem c0, c1; c0.dst = nullptr; c1.dst = nullptr; c0.f8 = false; c1.f8 = false; c0.src = nullptr; c1.src = nullptr; c0.ldw = 0; c1.ldw = 0; c0.rowb = 0; c1.rowb = 0; c0.perm = false; c1.perm = false;
    if (u < npair) { c0 = conv_find(F, 2 * u, jobs); tr_load(c0, va); c1 = conv_find(F, 2 * u + 1, jobs); tr_load(c1, vb); }
    for (; u < npair; u += nw) {
        const int un = u + nw;
        tr_finish(va, c0, scr, F.lane, 0);
        if (!c0.f8) tr_flush(c0, scr, F.lane);
        if (un < npair) { c0 = conv_find(F, 2 * un, jobs); tr_load(c0, va); }
        tr_finish(vb, c1, scr, F.lane, 1);
        tr_flush(c1, scr, F.lane);
        if (un < npair) { c1 = conv_find(F, 2 * un + 1, jobs); tr_load(c1, vb); }
    }
}
__device__ __forceinline__ void p0_prologue(Frame& F) {
    uchar* ws = F.ws;
    {
        LAS float* act = (LAS float*)(F.lds);
        LAS float* red = (LAS float*)(F.lds + 5 * 1024 * 4);
        bool have = false; const float* pC = inp(F, I_C); const float* pCC = inp(F, I_CCTX); const float* pADAW = inp(F, I_ADAW); const float* pADAB = inp(F, I_ADAB);
        for (int it = F.bid; it < DEPTH * 32; it += F.G) {
            if (!have) { for (int i = F.tid; i < 5 * 1024; i += 512) { const int s = i >> 10, k = i & 1023; const float v = s < 4 ? pC[s * 1024 + k] : pCC[k]; act[i] = v / (1.f + __expf(-v)); } have = true; __syncthreads(); }
            const int l = it >> 5, cb = it & 31; const int ln = F.lane < 48 ? F.lane : 47;
            const float* W = pADAW + (size_t)l * 1024 * NMODV + cb * 192 + ln * 4;
            f32x4 a[5];
#pragma unroll
            for (int s = 0; s < 5; ++s) a[s] = (f32x4){0.f, 0.f, 0.f, 0.f};
            const int kbase = F.wave * 128;
#pragma unroll 8
            for (int k = 0; k < 128; ++k) { const f32x4 w = *(const f32x4*)(W + (size_t)(kbase + k) * NMODV);
#pragma unroll
                for (int s = 0; s < 5; ++s) a[s] += w * act[s * 1024 + kbase + k]; }
            if (F.lane < 48) {
#pragma unroll
                for (int s = 0; s < 5; ++s) *(LAS f32x4*)(red + (F.wave * 5 + s) * 192 + F.lane * 4) = a[s]; }
            __syncthreads();
            for (int i = F.tid; i < 5 * 192; i += 512) { const int s = i / 192, c = i - s * 192; float v = pADAB[l * NMODV + cb * 192 + c];
#pragma unroll
                for (int w = 0; w < 8; ++w) v += red[(w * 5 + s) * 192 + c];
                ((float*)(ws + WS_MOD))[(l * 5 + s) * NMODV + cb * 192 + c] = v; }
            __syncthreads();
        }
        __syncthreads();
    }
    { const Job jobsA[8] = {{3, 0, 1024}, {4, 0, 1024}, {5, 0, 512}, {6, 0, 512}, {7, 0, 384}, {8, 0, 256}, {9, 0, 128}, {10, 0, 128}}; conv_tail(F, DEPTH * 32, jobsA);
      const Job jobsB[3] = {{0, 0, 16384}, {1, 0, 16384}, {2, 0, 16384}}; conv_tail(F, 0, jobsB); }
    {
        const int gt = F.bid * 512 + F.tid, NGT = F.G * 512;
        for (int i = gt; i < 8 * 128 * 128 / 4; i += NGT) { const f32x4 v = ((const f32x4*)inp(F, I_CMWS))[i]; u32x2 o; o.x = pk2(v.x, v.y); o.y = pk2(v.z, v.w); ((u32x2*)(ws + WS_W_CMS))[i] = o; }
        for (int i = gt; i < 2 * 2 * D; i += NGT) { const float* plam = inp(F, I_RGLAM); ((float*)(ws + WS_SPL))[i] = -8.f * log1pf(expf(-plam[i])); }
        for (int i = gt; i < 64 * 32; i += NGT) { const int pos = i >> 5, f = i & 31; const float inv = powf(10000.f, -(float)f * 2.0f / 64.0f); const float ang = (float)pos * inv;
            ((f32x2*)(ws + WS_ROPE))[i] = (f32x2){cosf(ang), sinf(ang)}; }
    }
}

__device__ __forceinline__ void router_fill(Frame& F, int l) {
    LAS float* wr = (LAS float*)F.lds;
    const float* wg = inp(F, I_MWG) + (size_t)l * 1024 * 4; const float* wrt = inp(F, I_MWR) + (size_t)l * 1024 * 32;
    __syncthreads();
    for (int i0 = F.tid; i0 < 1024 * 9; i0 += 512 * 6) { f32x4 v[6];
#pragma unroll
        for (int u = 0; u < 6; ++u) { const int idx = i0 + u * 512; const int k = idx / 9, q = idx - k * 9; v[u] = q == 0 ? *(const f32x4*)(wg + k * 4) : *(const f32x4*)(wrt + k * 32 + (q - 1) * 4); }
#pragma unroll
        for (int u = 0; u < 6; ++u) { const int idx = i0 + u * 512; const int k = idx / 9, q = idx - k * 9;
            wr[(4 * q + 0) * 1024 + k] = v[u].x; wr[(4 * q + 1) * 1024 + k] = v[u].y; wr[(4 * q + 2) * 1024 + k] = v[u].z; wr[(4 * q + 3) * 1024 + k] = v[u].w; } }
    __syncthreads();
}
template <bool ROUTE, int NADD, bool SRCIN>
__device__ __forceinline__ void norm_phase(Frame& F, int l, const float* gvec, int shift_i, bool skip_ctx_route, bool dry) {
    uchar* ws = F.ws;
    float* X = (float*)(ws + WS_X); const bf16_t* YS = (const bf16_t*)(ws + WS_Y1); const bf16_t* YM = (const bf16_t*)(ws + WS_YM); bf16_t* H = (bf16_t*)(ws + WS_H);
    const float* MOD = (const float*)(ws + WS_MOD) + (size_t)l * 5 * NMODV;
    LAS float* wr = (LAS float*)F.lds;
    const int i16 = F.lane & 15, grp = F.lane >> 4;
    const float* bg = nullptr; const float* br = nullptr; if constexpr (ROUTE) { bg = inp(F, I_MBG) + l * 4; br = inp(F, I_MBR) + l * 32; }
    const float* pctx = nullptr; const float* px = nullptr; if constexpr (SRCIN) { pctx = inp(F, I_CTX); px = inp(F, I_X); }
    constexpr int NT = ROUTE ? 2 : 1;
    const int nunits = T / (4 * NT), nwv = F.G * 8, nfull = nunits / nwv, rem = nunits - nfull * nwv;
    for (int it = 0; it <= nfull; ++it) {
        int unit = it * nwv + F.bid * 8 + F.wave;
        if (it == nfull) { const int e = F.wave * F.G + F.bid; if (e >= rem) break; unit = nfull * nwv + e; }
        asm volatile("" ::: "memory");
        f32x4 x[NT][16];
#pragma unroll
        for (int q = 0; q < NT; ++q) { const int tok = unit * (4 * NT) + q * 4 + grp; const int sidx = sidx_of_row(tok);
            int c0 = 4 * i16; asm volatile("" : "+v"(c0));
            {
                u32x2 xr[16], yr[16];
                const float* xrow = X + (size_t)tok * D;
                if constexpr (SRCIN) { const int b_ = tok / SB, s_ = tok - b_ * SB; xrow = s_ < CTX ? pctx + ((size_t)(b_ * CTX + s_) << 10) : px + ((size_t)(b_ * SEQ + s_ - CTX) << 10); }
                xrow += c0; const bf16_t* xbrow = (const bf16_t*)X + (size_t)tok * D + c0; const bf16_t* yrow = YM + (size_t)tok * D + c0;
#pragma unroll
                for (int j = 0; j < 16; ++j) { if constexpr (X_BF16 && !SRCIN) xr[j] = *(const u32x2*)(xbrow + 64 * j);
                    else x[q][j] = *(const f32x4*)(xrow + 64 * j); }
                if constexpr (NADD >= 1) {
#pragma unroll
                    for (int j = 0; j < 16; ++j) yr[j] = *(const u32x2*)(yrow + 64 * j); }
                __builtin_amdgcn_sched_barrier(0);
#pragma unroll
                for (int j = 0; j < 16; ++j) {
                    if constexpr (X_BF16 && !SRCIN) x[q][j] = (f32x4){bflo(xr[j].x), bfhi(xr[j].x), bflo(xr[j].y), bfhi(xr[j].y)};
                    if constexpr (NADD >= 1) x[q][j] += (f32x4){bflo(yr[j].x), bfhi(yr[j].x), bflo(yr[j].y), bfhi(yr[j].y)}; }
            }
            if constexpr (NADD == 3) {
#pragma unroll
                for (int j = 0; j < 16; ++j) { const f32x4 g5 = *(const f32x4*)(MOD - (size_t)5 * NMODV + (size_t)sidx * NMODV + 5 * D + 64 * j + 4 * i16);
                    if constexpr (Y_FP8) { const unsigned y0 = *(const unsigned*)((const uchar*)YS + (size_t)tok * D + 64 * j + 4 * i16), y1 = *(const unsigned*)((const uchar*)YS + ((size_t)T + tok) * D + 64 * j + 4 * i16);
                        x[q][j] += g5 * ((fp8x4_to_f32(y0) + fp8x4_to_f32(y1)) * (1.f / 16.f)); }
                    else { const u32x2 y0 = *(const u32x2*)(YS + (size_t)tok * D + 64 * j + 4 * i16), y1 = *(const u32x2*)(YS + ((size_t)T + tok) * D + 64 * j + 4 * i16);
                        x[q][j] += g5 * (f32x4){bflo(y0.x) + bflo(y1.x), bfhi(y0.x) + bfhi(y1.x), bflo(y0.y) + bflo(y1.y), bfhi(y0.y) + bfhi(y1.y)}; } }
#pragma unroll
                for (int j = 0; j < 16; ++j) { if constexpr (X_BF16) { u32x2 o; o.x = pk2(x[q][j].x, x[q][j].y); o.y = pk2(x[q][j].z, x[q][j].w); *(u32x2*)((bf16_t*)X + (size_t)tok * D + 64 * j + 4 * i16) = o; }
                    else *(f32x4*)(X + (size_t)tok * D + 64 * j + 4 * i16) = x[q][j]; } }
            float ss = 0.f;
#pragma unroll
            for (int j = 0; j < 16; ++j) ss += x[q][j].x * x[q][j].x + x[q][j].y * x[q][j].y + x[q][j].z * x[q][j].z + x[q][j].w * x[q][j].w;
            ss = wave16_sum(ss);
            const float rstd = rsqrtf(ss * (1.f / D) + NORM_EPS);
            const float* shp = MOD + (size_t)sidx * NMODV + shift_i * D + c0; const float* scp = shp + D; const float* gvp = gvec + c0;
#pragma unroll
            for (int j = 0; j < 16; ++j) { const f32x4 g = *(const f32x4*)(gvp + 64 * j), sh = *(const f32x4*)(shp + 64 * j), sc = *(const f32x4*)(scp + 64 * j);
                x[q][j] = x[q][j] * rstd * g * (sc + 1.f) + sh; }
            uchar* h8row = (uchar*)H + (size_t)tok * D + c0; bf16_t* hrow = H + (size_t)tok * D + c0;
#pragma unroll
            for (int j = 0; j < 16; ++j) {
                if constexpr (ROUTE && MOE_FP8) { int r8 = __builtin_amdgcn_cvt_pk_fp8_f32(x[q][j].x, x[q][j].y, 0, false); r8 = __builtin_amdgcn_cvt_pk_fp8_f32(x[q][j].z, x[q][j].w, r8, true); *(int*)(h8row + 64 * j) = r8; }
                else { u32x2 o; o.x = pk2(x[q][j].x, x[q][j].y); o.y = pk2(x[q][j].z, x[q][j].w); *(u32x2*)(hrow + 64 * j) = o; } }
            if constexpr (NT > 1) __builtin_amdgcn_sched_barrier(0);
        }
        if constexpr (ROUTE) {
            LAS float* lgs = (LAS float*)(F.lds + LDSCTL_OFF + 1024) + (F.wave * 4 + grp) * (40 * NT);
#pragma unroll 1
            for (int o = 0; o < 36; ++o) { f32x4 w[8], acc[NT];
#pragma unroll
                for (int j = 0; j < 8; ++j) w[j] = *(const LAS f32x4*)(wr + o * 1024 + 64 * j + 4 * i16);
                __builtin_amdgcn_sched_barrier(0);
#pragma unroll
                for (int q = 0; q < NT; ++q) { f32x4 v0 = x[q][0] * w[0], v1 = x[q][1] * w[1];
#pragma unroll
                    for (int j = 2; j < 8; j += 2) { v0 += x[q][j] * w[j]; v1 += x[q][j + 1] * w[j + 1]; }
                    acc[q] = v0 + v1; }
                __builtin_amdgcn_sched_barrier(0);
#pragma unroll
                for (int j = 0; j < 8; ++j) w[j] = *(const LAS f32x4*)(wr + o * 1024 + 64 * (j + 8) + 4 * i16);
                __builtin_amdgcn_sched_barrier(0);
#pragma unroll
                for (int q = 0; q < NT; ++q) { f32x4 v0 = x[q][8] * w[0], v1 = x[q][9] * w[1];
#pragma unroll
                    for (int j = 2; j < 8; j += 2) { v0 += x[q][8 + j] * w[j]; v1 += x[q][9 + j] * w[j + 1]; }
                    v0 += v1; v0 += acc[q]; const float a0 = wave16_sum((v0.x + v0.y) + (v0.z + v0.w)); if (i16 == 0) lgs[q * 40 + o] = a0; } }
            asm volatile("s_waitcnt lgkmcnt(0)" ::: "memory");
#pragma unroll
            for (int q = 0; q < NT; ++q) { const int tok = unit * (4 * NT) + q * 4 + grp; const int sidx = sidx_of_row(tok); const LAS float* lq = lgs + q * 40;
                const float gl0 = lq[0] + bg[0], gl1 = lq[1] + bg[1], gl2 = lq[2] + bg[2], gl3 = lq[3] + bg[3];
                int gs = 0; float gm = gl0;
                if (gl1 > gm) { gm = gl1; gs = 1; }
                if (gl2 > gm) { gm = gl2; gs = 2; }
                if (gl3 > gm) { gm = gl3; gs = 3; }
                const float den = __expf(gl0 - gm) + __expf(gl1 - gm) + __expf(gl2 - gm) + __expf(gl3 - gm);
                const float pg = 1.f / den;
                float el[8];
#pragma unroll
                for (int e = 0; e < 8; ++e) el[e] = lq[4 + gs * 8 + e] + br[gs * 8 + e];
                int i0 = 0; float v0 = el[0];
#pragma unroll
                for (int e = 1; e < 8; ++e) if (el[e] > v0) { v0 = el[e]; i0 = e; }
                int i1 = -1; float v1 = -3.0e38f;
#pragma unroll
                for (int e = 0; e < 8; ++e) if (e != i0 && el[e] > v1) { v1 = el[e]; i1 = e; }
                const float p0 = 1.f / (1.f + __expf(v1 - v0));
                const float w0 = p0 * pg, w1 = (1.f - p0) * pg;
                const bool do_route = !(skip_ctx_route && sidx == 4) && !dry;
                if (i16 == 0 && do_route) {
                    const int e0 = gs * 8 + i0, e1 = gs * 8 + i1;
                    unsigned* cnt = (unsigned*)(ws + WS_CTL) + CW_CNT + l * 32 * 64;
                    const unsigned q0 = atomicAdd(cnt + e0 * 64, 1u), q1 = atomicAdd(cnt + e1 * 64, 1u);
                    u32x2* BK = (u32x2*)(ws + WS_BK2);
                    BK[(size_t)e0 * T + q0] = (u32x2){(unsigned)(tok * 2), __float_as_uint(w0)}; BK[(size_t)e1 * T + q1] = (u32x2){(unsigned)(tok * 2 + 1), __float_as_uint(w1)};
                }
            }
        }
    }
}

__device__ __forceinline__ void st8(bf16_t* p, f32x4 v0, f32x4 v1) { u32x4 w; w.x = cvt_pk_bf16(v0[0], v0[1]); w.y = cvt_pk_bf16(v0[2], v0[3]); w.z = cvt_pk_bf16(v1[0], v1[1]); w.w = cvt_pk_bf16(v1[2], v1[3]); *(u32x4*)p = w; }
#define EPI_ROWS(ai, m) (u.pm * 256 + (ai) * 128 + wr * 64 + (m) * 16 + fr)

struct EpiRgIn { static constexpr bool PERM = true, FP8 = false, PREFETCH = false; bf16_t* GG; bf16_t* XB;
    __device__ __forceinline__ void operator()(const f32x4 (&acc)[2][2][4][2], const pg8::Unit& u, int wr, int wc, int fr, int fq) const {
        const bool isg = u.pn < 4; bf16_t* base = isg ? GG : XB; const int ct = (u.pn & 3) * 256 + wc * 32 + 8 * fq;
#pragma unroll
        for (int ai = 0; ai < 2; ++ai)
#pragma unroll
            for (int m = 0; m < 4; ++m) { if (!((u.hm >> (2 * ai)) & 1)) continue; bf16_t* rowp = base + (size_t)EPI_ROWS(ai, m) * D + ct;
#pragma unroll
                for (int bj = 0; bj < 2; ++bj) { f32x4 v0 = acc[ai][bj][m][0], v1 = acc[ai][bj][m][1];
                    if (isg) {
#pragma unroll
                        for (int e = 0; e < 4; ++e) { v0[e] = gelu_tanh(v0[e]); v1[e] = gelu_tanh(v1[e]); } }
                    st8(rowp + bj * 128, v0, v1); } }
    } };
struct EpiBf16 { static constexpr bool PERM = true, FP8 = false, PREFETCH = false; bf16_t* O; int ldc;
    __device__ __forceinline__ void operator()(const f32x4 (&acc)[2][2][4][2], const pg8::Unit& u, int wr, int wc, int fr, int fq) const {
        const int ct = u.pn * 256 + wc * 32 + 8 * fq;
#pragma unroll
        for (int ai = 0; ai < 2; ++ai)
#pragma unroll
            for (int m = 0; m < 4; ++m) { if (!((u.hm >> (2 * ai)) & 1)) continue; bf16_t* rowp = O + (size_t)EPI_ROWS(ai, m) * ldc + ct;
#pragma unroll
                for (int bj = 0; bj < 2; ++bj) st8(rowp + bj * 128, acc[ai][bj][m][0], acc[ai][bj][m][1]); }
    } };
struct EpiQKV { static constexpr bool PERM = true, FP8 = false, PREFETCH = false; bf16_t* O; const float* qg; const float* kg; const float* rope; LAS float* xch;
    __device__ __forceinline__ void operator()(const f32x4 (&acc)[2][2][4][2], const pg8::Unit& u, int wr, int wc, int fr, int fq) const {
        if (u.pn == 5) {
            const int ct = u.pn * 256 + wc * 32 + 8 * fq;
#pragma unroll
            for (int ai = 0; ai < 2; ++ai)
#pragma unroll
                for (int m = 0; m < 4; ++m) { if (!((u.hm >> (2 * ai)) & 1)) continue; bf16_t* rowp = O + (size_t)EPI_ROWS(ai, m) * 1536 + ct;
#pragma unroll
                    for (int bj = 0; bj < 2; ++bj) st8(rowp + bj * 128, acc[ai][bj][m][0], acc[ai][bj][m][1]); }
            return; }
        const bool lat = (u.pm % 17) != 0; const float* gv = u.pn < 4 ? qg : kg; const int a = wc >> 1, f0 = 16 * (wc & 1) + 4 * fq;
        const f32x4 g1 = *(const f32x4*)(gv + 64 * a + f0), g2 = *(const f32x4*)(gv + 64 * a + 32 + f0);
        f32x4 cvs[4], svs[4];
        { const int t0 = ((u.pm % 17) - 1) * 256;
#pragma unroll
          for (int q = 0; q < 4; ++q) { cvs[q] = (f32x4){1.f, 1.f, 1.f, 1.f}; svs[q] = (f32x4){0.f, 0.f, 0.f, 0.f};
            if (lat) { const int pos = a ? (16 * q + fr) : ((t0 >> 6) + 2 * (q & 1) + wr); const f32x4 cs0 = *(const f32x4*)(rope + (pos * 32 + f0) * 2), cs1 = *(const f32x4*)(rope + (pos * 32 + f0) * 2 + 4);
                cvs[q] = (f32x4){cs0.x, cs0.z, cs1.x, cs1.z}; svs[q] = (f32x4){cs0.y, cs0.w, cs1.y, cs1.w}; } } }
#pragma unroll
        for (int ai = 0; ai < 2; ++ai)
#pragma unroll
            for (int m = 0; m < 4; ++m)
#pragma unroll
                for (int bj = 0; bj < 2; ++bj) { const f32x4 v0 = acc[ai][bj][m][0], v1 = acc[ai][bj][m][1];
                    float sq = ((v0.x * v0.x + v0.y * v0.y) + (v0.z * v0.z + v0.w * v0.w)) + ((v1.x * v1.x + v1.y * v1.y) + (v1.z * v1.z + v1.w * v1.w));
                    sq += __shfl_xor(sq, 16); sq += __shfl_xor(sq, 32);
                    if (fq == 0) xch[((ai * 128 + wr * 64 + m * 16 + fr) * 2 + bj) * 4 + wc] = sq; }
        asm volatile("s_waitcnt lgkmcnt(0)" ::: "memory"); __builtin_amdgcn_s_barrier(); asm volatile("" ::: "memory");
#pragma unroll
        for (int ai = 0; ai < 2; ++ai)
#pragma unroll
            for (int m = 0; m < 4; ++m) { if (!((u.hm >> (2 * ai)) & 1)) continue; const int row = EPI_ROWS(ai, m);
                const f32x4 cv = a ? cvs[m] : cvs[ai], sv = a ? svs[m] : svs[ai];
#pragma unroll
                for (int bj = 0; bj < 2; ++bj) { const f32x4 p4 = *(const LAS f32x4*)(xch + ((ai * 128 + wr * 64 + m * 16 + fr) * 2 + bj) * 4);
                    const float rstd = rsqrtf(((p4.x + p4.y) + (p4.z + p4.w)) * (1.f / 128.f) + NORM_EPS);
                    const f32x4 x1 = acc[ai][bj][m][0] * rstd * g1, x2 = acc[ai][bj][m][1] * rstd * g2;
                    const f32x4 o1 = x1 * cv - x2 * sv, o2 = x2 * cv + x1 * sv;
                    bf16_t* p = O + (size_t)row * 1536 + u.pn * 256 + bj * 128 + 64 * a + f0;
                    u32x2 w1, w2; w1.x = cvt_pk_bf16(o1.x, o1.y); w1.y = cvt_pk_bf16(o1.z, o1.w); w2.x = cvt_pk_bf16(o2.x, o2.y); w2.y = cvt_pk_bf16(o2.z, o2.w);
                    *(u32x2*)p = w1; *(u32x2*)(p + 32) = w2; } }
    } };
struct EpiCmIn { static constexpr bool PERM = true, FP8 = false, PREFETCH = false; bf16_t* O; f32x2* statp;
    __device__ __forceinline__ void operator()(const f32x4 (&acc)[2][2][4][2], const pg8::Unit& u, int wr, int wc, int fr, int fq) const {
        const int ct = u.pn * 256 + wc * 32 + 8 * fq; const bool isv = u.pn >= 8;
#pragma unroll
        for (int ai = 0; ai < 2; ++ai)
#pragma unroll
            for (int m = 0; m < 4; ++m) { if (!((u.hm >> (2 * ai)) & 1)) continue; const int row = EPI_ROWS(ai, m); bf16_t* rowp = O + (size_t)row * 4096 + ct; float s = 0.f, q = 0.f;
#pragma unroll
                for (int bj = 0; bj < 2; ++bj) { f32x4 v0 = acc[ai][bj][m][0], v1 = acc[ai][bj][m][1];
#pragma unroll
                    for (int e = 0; e < 4; ++e) { v0[e] = gelu_tanh(v0[e]); v1[e] = gelu_tanh(v1[e]); }
                    u32x4 w; w.x = cvt_pk_bf16(v0[0], v0[1]); w.y = cvt_pk_bf16(v0[2], v0[3]); w.z = cvt_pk_bf16(v1[0], v1[1]); w.w = cvt_pk_bf16(v1[2], v1[3]);
                    *(u32x4*)(rowp + bj * 128) = w;
                    const float r0 = bflo(w.x), r1 = bfhi(w.x), r2 = bflo(w.y), r3 = bfhi(w.y), r4 = bflo(w.z), r5 = bfhi(w.z), r6 = bflo(w.w), r7 = bfhi(w.w);
                    s += ((r0 + r1) + (r2 + r3)) + ((r4 + r5) + (r6 + r7)); q += ((r0 * r0 + r1 * r1) + (r2 * r2 + r3 * r3)) + ((r4 * r4 + r5 * r5) + (r6 * r6 + r7 * r7)); }
                if (isv) { s += __shfl_xor(s, 16); s += __shfl_xor(s, 32); q += __shfl_xor(q, 16); q += __shfl_xor(q, 32);
                    if (fq == 0) statp[(size_t)row * 32 + (u.pn - 8) * 4 + wc] = (f32x2){s, q}; } }
    } };
struct EpiResid { static constexpr bool PERM = true, FP8 = false, PREFETCH = false; bf16_t* YM; const float* gate  ;
    __device__ __forceinline__ void operator()(const f32x4 (&acc)[2][2][4][2], const pg8::Unit& u, int wr, int wc, int fr, int fq) const {
        const int sidx = sidx_of_row(u.pm * 256); const float* gp = gate + (size_t)sidx * NMODV; const int ct = u.pn * 256 + wc * 32 + 8 * fq;
        f32x4 gv[2][2];
#pragma unroll
        for (int bj = 0; bj < 2; ++bj)
#pragma unroll
            for (int n = 0; n < 2; ++n) gv[bj][n] = *(const f32x4*)(gp + ct + bj * 128 + n * 4);
#pragma unroll
        for (int ai = 0; ai < 2; ++ai)
#pragma unroll
            for (int m = 0; m < 4; ++m) { if (!((u.hm >> (2 * ai)) & 1)) continue; bf16_t* rowp = YM + (size_t)EPI_ROWS(ai, m) * D + ct;
#pragma unroll
                for (int bj = 0; bj < 2; ++bj) st8(rowp + bj * 128, gv[bj][0] * acc[ai][bj][m][0], gv[bj][1] * acc[ai][bj][m][1]); }
    } };
struct EpiRgGate { static constexpr bool PERM = true, FP8 = false, PREFETCH = false; const bf16_t* XC; bf16_t* LA; bf16_t* BB; const float* ba; const float* bi; const float* lam;
    __device__ __forceinline__ void operator()(const f32x4 (&acc)[2][2][4][2], const pg8::Unit& u, int wr, int wc, int fr, int fq) const {
        const int d = u.pn >> 3, blk = u.pn & 7;
        asm volatile("" : "+v"(fr), "+v"(fq));
        const int ch = blk * 128 + wc * 32 + 8 * fq;
        u32x4 xw[8];
#pragma unroll
        for (int r = 0; r < 8; ++r) xw[r] = *(const u32x4*)(XC + (size_t)EPI_ROWS(r >> 2, r & 3) * D + ch);
        f32x4 bav[2], biv[2], spv[2];
#pragma unroll
        for (int n = 0; n < 2; ++n) { bav[n] = *(const f32x4*)(ba + d * D + ch + 4 * n); biv[n] = *(const f32x4*)(bi + d * D + ch + 4 * n); spv[n] = *(const f32x4*)(lam + d * D + ch + 4 * n); }
#pragma unroll
        for (int r = 0; r < 8; ++r) { const int ai = r >> 2, m = r & 3; if (!((u.hm >> (2 * ai)) & 1)) continue;
            const size_t off = (size_t)EPI_ROWS(ai, m) * D + ch;
            const float xc[8] = {bflo(xw[r].x), bfhi(xw[r].x), bflo(xw[r].y), bfhi(xw[r].y), bflo(xw[r].z), bfhi(xw[r].z), bflo(xw[r].w), bfhi(xw[r].w)};
            float la[8], bb[8];
#pragma unroll
            for (int n = 0; n < 2; ++n)
#pragma unroll
                for (int e = 0; e < 4; ++e) { const float rg = fast_sigmoid(acc[ai][0][m][n][e] + bav[n][e]), ig = fast_sigmoid(acc[ai][1][m][n][e] + biv[n][e]);
                    const float lga = rg * spv[n][e]; la[4 * n + e] = lga; bb[4 * n + e] = __builtin_amdgcn_sqrtf(one_minus_exp(-2.f * lga)) * ig * xc[4 * n + e]; }
            u32x4 w; w.x = cvt_pk_bf16(la[0], la[1]); w.y = cvt_pk_bf16(la[2], la[3]); w.z = cvt_pk_bf16(la[4], la[5]); w.w = cvt_pk_bf16(la[6], la[7]);
            *(u32x4*)(LA + (size_t)d * T * D + off) = w;
            w.x = cvt_pk_bf16(bb[0], bb[1]); w.y = cvt_pk_bf16(bb[2], bb[3]); w.z = cvt_pk_bf16(bb[4], bb[5]); w.w = cvt_pk_bf16(bb[6], bb[7]);
            *(u32x4*)(BB + (size_t)d * T * D + off) = w; }
    } };

template <bool G1>
struct MoeOrder {
    static constexpr bool GATHER = G1;
    const LAS int* tab; const char* A; const char* B; const int* BK; int G, c, nunits; size_t bstride; int arow, brow;
    __device__ bool next(int i, pg8::Unit& u) const {
        int L, hm; if (!pg8::unit_slot(i, c, G, nunits, L, hm)) return false; u.hm = __builtin_amdgcn_readfirstlane(hm);
        const int wgid = __builtin_amdgcn_readfirstlane(pg8::xcd_remap(L, nunits)); const int tau = wgid >> 2, pn = wgid & 3;
        const int e = __builtin_amdgcn_readfirstlane(tab[192 + tau]);
        u.pm = tau; u.pn = pn; u.aux0 = e; u.aux1 = __builtin_amdgcn_readfirstlane((tau - tab[e]) * 256);
        u.a = pg8::uptr(G1 ? A : A + (size_t)tau * 256 * arow);
        u.b = pg8::uptr(B + (size_t)e * bstride + (size_t)pn * 256 * brow);
        return true; }
    __device__ unsigned goff(const pg8::Unit& u, int row) const {
        const int pos = u.aux1 + row; const int cnt = tab[40 + u.aux0];
        int tok = 0; if (pos < cnt) tok = __builtin_nontemporal_load(BK + ((size_t)u.aux0 * T + pos) * 2) >> 1;
        return (unsigned)tok * (unsigned)arow; }
};
struct EpiMoe1 { static constexpr bool PERM = true, FP8 = (MOE_FP8 != 0), PREFETCH = false; uchar* H1;
    __device__ __forceinline__ void operator()(const f32x4 (&acc)[2][2][4][2], const pg8::Unit& u, int wr, int wc, int fr, int fq) const {
        const int ct = u.pn * 128 + wc * 32 + 8 * fq;
#pragma unroll
        for (int ai = 0; ai < 2; ++ai)
#pragma unroll
            for (int m = 0; m < 4; ++m) { if (!((u.hm >> (2 * ai)) & 1)) continue; f32x4 h0, h1;
#pragma unroll
                for (int e = 0; e < 4; ++e) { constexpr float WS_ = FP8 ? (1.f / 32.f) : 1.f;
                    const float g0 = acc[ai][0][m][0][e] * WS_, g1 = acc[ai][0][m][1][e] * WS_; h0[e] = g0 * fast_sigmoid(g0) * (acc[ai][1][m][0][e] * WS_); h1[e] = g1 * fast_sigmoid(g1) * (acc[ai][1][m][1][e] * WS_); }
                if constexpr (FP8) { int r0 = __builtin_amdgcn_cvt_pk_fp8_f32(h0[0], h0[1], 0, false); r0 = __builtin_amdgcn_cvt_pk_fp8_f32(h0[2], h0[3], r0, true);
                    int r1 = __builtin_amdgcn_cvt_pk_fp8_f32(h1[0], h1[1], 0, false); r1 = __builtin_amdgcn_cvt_pk_fp8_f32(h1[2], h1[3], r1, true);
                    *(u32x2*)(H1 + (size_t)EPI_ROWS(ai, m) * DEXP + ct) = (u32x2){(unsigned)r0, (unsigned)r1}; }
                else st8((bf16_t*)H1 + (size_t)EPI_ROWS(ai, m) * DEXP + ct, h0, h1); }
    } };
struct EpiMoe2 { static constexpr bool PERM = true, FP8 = (MOE_FP8 != 0), PREFETCH = true; bf16_t* YS; const int* BK; const LAS int* tab;
    typedef int pre_t __attribute__((ext_vector_type(16)));
    __device__ __forceinline__ pre_t prefetch(const pg8::Unit& u, int wr, int fr) const { pre_t p; const int cnt = tab[40 + u.aux0];
#pragma unroll
        for (int r = 0; r < 8; ++r) { const int pos = u.aux1 + (r >> 2) * 128 + wr * 64 + (r & 3) * 16 + fr; u32x2 v = {0xffffffffu, 0u}; if (pos < cnt) v = __builtin_nontemporal_load((const u32x2*)BK + (size_t)u.aux0 * T + pos); p[2 * r] = (int)v.x; p[2 * r + 1] = (int)v.y; }
        return p; }
    __device__ __forceinline__ void operator()(const f32x4 (&acc)[2][2][4][2], const pg8::Unit& u, int wr, int wc, int fr, int fq, const pre_t& pre) const {
        const int ct = u.pn * 256 + wc * 32 + 8 * fq;
#pragma unroll
        for (int r = 0; r < 8; ++r) { const int e_ = pre[2 * r];
            if (e_ >= 0 && ((u.hm >> (2 * (r >> 2))) & 1)) { const int tok = e_ >> 1, slot = e_ & 1; const float w = __int_as_float(pre[2 * r + 1]) * (FP8 ? (1.f / 32.f) : 1.f);
                if constexpr (Y_FP8) { uchar* yp = (uchar*)YS + ((size_t)slot * T + tok) * D + ct; const float w16 = w * 16.f;
#pragma unroll
                    for (int bj = 0; bj < 2; ++bj) { const f32x4 a0 = acc[r >> 2][bj][r & 3][0] * w16, a1 = acc[r >> 2][bj][r & 3][1] * w16;
                        int r0 = __builtin_amdgcn_cvt_pk_fp8_f32(a0.x, a0.y, 0, false); r0 = __builtin_amdgcn_cvt_pk_fp8_f32(a0.z, a0.w, r0, true);
                        int r1 = __builtin_amdgcn_cvt_pk_fp8_f32(a1.x, a1.y, 0, false); r1 = __builtin_amdgcn_cvt_pk_fp8_f32(a1.z, a1.w, r1, true);
                        *(u32x2*)(yp + bj * 128) = (u32x2){(unsigned)r0, (unsigned)r1}; } }
                else { bf16_t* yp = YS + ((size_t)slot * T + tok) * D + ct;
#pragma unroll
                    for (int bj = 0; bj < 2; ++bj) st8(yp + bj * 128, acc[r >> 2][bj][r & 3][0] * w, acc[r >> 2][bj][r & 3][1] * w); } } }
    } };
__device__ __forceinline__ int moe_table(Frame& F, int l, LAS int* tab) {
    __syncthreads();
    if (F.tid < 32) { const unsigned c = __hip_atomic_load((unsigned*)(F.ws + WS_CTL) + CW_CNT + (l * 32 + F.tid) * 64, RLX_AGENT); tab[40 + F.tid] = (int)c; }
    __syncthreads();
    if (F.tid == 0) { int s = 0;
#pragma unroll 1
        for (int e = 0; e < 32; ++e) { tab[e] = s; s += (tab[40 + e] + 255) >> 8; } tab[32] = s; }
    __syncthreads();
    const int ntile_ = tab[32];
    for (int tau = F.tid; tau < ntile_; tau += 512) { int e = 0;
#pragma unroll 1
        for (int k = 1; k < 32; ++k) e = (tab[k] <= tau) ? k : e;
        tab[192 + tau] = e; }
    __syncthreads();
    return ntile_;
}

__device__ __forceinline__ void conv_phase(Frame& F, int j) {
    const bf16_t* XB = (const bf16_t*)(F.ws + WS_XB); bf16_t* XC = (bf16_t*)(F.ws + WS_XC);
    const float* cw = inp(F, I_RGCW) + (size_t)j * 4 * D; const float* cb = inp(F, I_RGCB) + (size_t)j * D;
    const int NGT = F.G * 512;
    for (int i0 = F.bid * 512 + F.tid; i0 < T * 128; i0 += 2 * NGT) {
        u32x4 xw[2][4];
#pragma unroll
        for (int q = 0; q < 2; ++q) { const int i = i0 + q * NGT; const int row = i >> 7, c = (i & 127) * 8; const int b = row / SB, s = row - b * SB; const int lo = s < CTX ? 0 : CTX, hi = s < CTX ? CTX : SB;
#pragma unroll
            for (int k = 0; k < 4; ++k) { const int ss = s + k - 2; xw[q][k] = (u32x4){0u, 0u, 0u, 0u}; if (i < T * 128 && ss >= lo && ss < hi) xw[q][k] = *(const u32x4*)(XB + (size_t)(b * SB + ss) * D + c); } }
#pragma unroll
        for (int q = 0; q < 2; ++q) { const int i = i0 + q * NGT; if (i < T * 128) { const int row = i >> 7, c = (i & 127) * 8;
            float a[8];
#pragma unroll
            for (int e = 0; e < 8; ++e) a[e] = cb[c + e];
#pragma unroll
            for (int k = 0; k < 4; ++k) { const f32x4 w0 = *(const f32x4*)(cw + k * D + c), w1 = *(const f32x4*)(cw + k * D + c + 4); const u32x4 x = xw[q][k];
                a[0] += w0.x * bflo(x.x); a[1] += w0.y * bfhi(x.x); a[2] += w0.z * bflo(x.y); a[3] += w0.w * bfhi(x.y);
                a[4] += w1.x * bflo(x.z); a[5] += w1.y * bfhi(x.z); a[6] += w1.z * bflo(x.w); a[7] += w1.w * bfhi(x.w); }
            u32x4 o; o.x = pk2(a[0], a[1]); o.y = pk2(a[2], a[3]); o.z = pk2(a[4], a[5]); o.w = pk2(a[6], a[7]);
            *(u32x4*)(XC + (size_t)row * D + c) = o; } }
    }
}
__device__ __forceinline__ void scan1_phase(Frame& F) {
    const bf16_t* LA = (const bf16_t*)(F.ws + WS_LA); const bf16_t* BB = (const bf16_t*)(F.ws + WS_BB); float* TS = (float*)(F.ws + WS_TOTS); float* TH = (float*)(F.ws + WS_TOTH);
    for (int it = F.bid * 8 + F.wave; it < NB * 2 * NCH * 4; it += F.G * 8) {
        const int cg = it & 3, rest = it >> 2, ck = rest % NCH, bd = rest / NCH, dir = bd & 1, b = bd >> 1;
        const int c = cg * 256 + F.lane * 4; const size_t base = (size_t)dir * T * D + (size_t)(b * SB + ck * 16) * D + c;
        u32x2 la[16], bb[16];
#pragma unroll
        for (int t = 0; t < 16; ++t) { const size_t o = base + (size_t)(dir ? 15 - t : t) * D; la[t] = *(const u32x2*)(LA + o); bb[t] = *(const u32x2*)(BB + o); }
        f32x4 sl = {0.f, 0.f, 0.f, 0.f}, h = {0.f, 0.f, 0.f, 0.f};
#pragma unroll
        for (int t = 0; t < 16; ++t) { const f32x4 l4 = {bflo(la[t].x), bfhi(la[t].x), bflo(la[t].y), bfhi(la[t].y)}, b4 = {bflo(bb[t].x), bfhi(bb[t].x), bflo(bb[t].y), bfhi(bb[t].y)};
            sl += l4; f32x4 a4 = {__expf(l4.x), __expf(l4.y), __expf(l4.z), __expf(l4.w)}; h = a4 * h + b4; }
        const size_t o = (size_t)(bd * NCH + ck) * D + c; *(f32x4*)(TS + o) = sl; *(f32x4*)(TH + o) = h;
    }
}
__device__ __forceinline__ void scan2_phase(Frame& F) {
    const float* TS = (const float*)(F.ws + WS_TOTS); const float* TH = (const float*)(F.ws + WS_TOTH); float* CY = (float*)(F.ws + WS_CARRY);
    LAS float* wt = (LAS float*)F.lds;
    for (int it = F.bid; it < NB * 2 * 16; it += F.G) {
        const int cg = it & 15, bd = it >> 4, dir = bd & 1; const int c = cg * 64 + F.lane; const size_t base = (size_t)bd * NCH * D + c;
        const int s0 = F.wave * 34;
        float P = 0.f, H = 0.f;
#pragma unroll 1
        for (int sb = 0; sb < 34; sb += 17) { float sl[17], hl[17];
#pragma unroll
            for (int q = 0; q < 17; ++q) { const int s = s0 + sb + q; const int ck = dir ? (s < 16 ? 15 - s : NCH + 15 - s) : s; sl[q] = TS[base + (size_t)ck * D]; hl[q] = TH[base + (size_t)ck * D]; }
#pragma unroll
            for (int q = 0; q < 17; ++q) { P += sl[q]; H = __expf(sl[q]) * H + hl[q]; } }
        __syncthreads();
        wt[(F.wave * 2 + 0) * 64 + F.lane] = P; wt[(F.wave * 2 + 1) * 64 + F.lane] = H;
        __syncthreads();
        float h = 0.f;
        for (int w = 0; w < F.wave; ++w) h = __expf(wt[(w * 2 + 0) * 64 + F.lane]) * h + wt[(w * 2 + 1) * 64 + F.lane];
#pragma unroll 1
        for (int sb = 0; sb < 34; sb += 17) { float sl[17], hl[17]; int ckk[17];
#pragma unroll
            for (int q = 0; q < 17; ++q) { const int s = s0 + sb + q; ckk[q] = dir ? (s < 16 ? 15 - s : NCH + 15 - s) : s; sl[q] = TS[base + (size_t)ckk[q] * D]; hl[q] = TH[base + (size_t)ckk[q] * D]; }
#pragma unroll
            for (int q = 0; q < 17; ++q) { CY[base + (size_t)ckk[q] * D] = h; h = __expf(sl[q]) * h + hl[q]; } }
    }
    __syncthreads();
}
__device__ __forceinline__ void scan3_phase(Frame& F) {
    const bf16_t* LA = (const bf16_t*)(F.ws + WS_LA); const bf16_t* BB = (const bf16_t*)(F.ws + WS_BB); const float* CY = (const float*)(F.ws + WS_CARRY);
    const bf16_t* GG = (const bf16_t*)(F.ws + WS_GG); bf16_t* SA = (bf16_t*)(F.ws + WS_SA);
    LAS f32x4* hb = (LAS f32x4*)(F.lds + F.wave * 16384);
    for (int it = F.bid * 8 + F.wave; it < NB * NCH * 4; it += F.G * 8) {
        const int cg = it & 3, rest = it >> 2, ck = rest % NCH, b = rest / NCH;
        const int c = cg * 256 + F.lane * 4;
        const size_t rbase = (size_t)(b * SB + ck * 16) * D + c, b1 = (size_t)T * D + rbase;
        f32x4 hbk = *(const f32x4*)(CY + (size_t)((b * 2 + 1) * NCH + ck) * D + c), hf = *(const f32x4*)(CY + (size_t)((b * 2 + 0) * NCH + ck) * D + c);
        { u32x2 la[16], bb[16];
#pragma unroll
          for (int t = 0; t < 16; ++t) { la[t] = *(const u32x2*)(LA + b1 + (size_t)(15 - t) * D); bb[t] = *(const u32x2*)(BB + b1 + (size_t)(15 - t) * D); }
#pragma unroll
          for (int t = 0; t < 16; ++t) { const f32x4 l4 = {bflo(la[t].x), bfhi(la[t].x), bflo(la[t].y), bfhi(la[t].y)}, b4 = {bflo(bb[t].x), bfhi(bb[t].x), bflo(bb[t].y), bfhi(bb[t].y)};
              const f32x4 a4 = {__expf(l4.x), __expf(l4.y), __expf(l4.z), __expf(l4.w)}; hbk = a4 * hbk + b4; hb[(15 - t) * 64 + F.lane] = hbk; } }
        { u32x2 la[16], bb[16], gg[16];
#pragma unroll
          for (int t = 0; t < 16; ++t) { la[t] = *(const u32x2*)(LA + rbase + (size_t)t * D); bb[t] = *(const u32x2*)(BB + rbase + (size_t)t * D); gg[t] = *(const u32x2*)(GG + rbase + (size_t)t * D); }
#pragma unroll
          for (int t = 0; t < 16; ++t) { const f32x4 l4 = {bflo(la[t].x), bfhi(la[t].x), bflo(la[t].y), bfhi(la[t].y)}, b4 = {bflo(bb[t].x), bfhi(bb[t].x), bflo(bb[t].y), bfhi(bb[t].y)};
              const f32x4 g4 = {bflo(gg[t].x), bfhi(gg[t].x), bflo(gg[t].y), bfhi(gg[t].y)};
              const f32x4 a4 = {__expf(l4.x), __expf(l4.y), __expf(l4.z), __expf(l4.w)}; hf = a4 * hf + b4; const f32x4 y = g4 * (hf + hb[t * 64 + F.lane]);
              u32x2 o; o.x = pk2(y.x, y.y); o.y = pk2(y.z, y.w); *(u32x2*)(SA + rbase + (size_t)t * D) = o; } }
    }
}

__device__ __forceinline__ void qknorm_phase(Frame& F) {
    bf16_t* QKV = (bf16_t*)(F.ws + WS_QKV); const f32x2* ROPE = (const f32x2*)(F.ws + WS_ROPE);
    const int i16 = F.lane & 15, grp = F.lane >> 4; const float* pqg = inp(F, I_ATQG); const float* pkg = inp(F, I_ATKG);
    const int ITS = F.G * 32;
    for (int it0 = (F.bid * 8 + F.wave) * 4 + grp; it0 < T * 10; it0 += 4 * ITS) {
        u32x4 xw4[4];
#pragma unroll
        for (int q = 0; q < 4; ++q) { const int it = it0 + q * ITS; xw4[q] = (u32x4){0u, 0u, 0u, 0u}; if (it < T * 10) { const int row = it / 10, hh = it - row * 10; xw4[q] = *(const u32x4*)(QKV + (size_t)row * 1536 + hh * 128 + i16 * 8); } }
#pragma unroll
        for (int q = 0; q < 4; ++q) { const int it = it0 + q * ITS; const bool valid = it < T * 10; const int itc = valid ? it : 0;
            const int row = itc / 10, hh = itc - row * 10; const int b = row / SB, s = row - b * SB;
            bf16_t* p = QKV + (size_t)row * 1536 + hh * 128 + i16 * 8;
            const u32x4 xw = xw4[q];
            float x[8] = {bflo(xw.x), bfhi(xw.x), bflo(xw.y), bfhi(xw.y), bflo(xw.z), bfhi(xw.z), bflo(xw.w), bfhi(xw.w)};
            float ss = 0.f;
#pragma unroll
            for (int e = 0; e < 8; ++e) ss += x[e] * x[e];
            ss = wave16_sum(ss);
            const float rstd = rsqrtf(ss * (1.f / 128.f) + NORM_EPS);
            const float* g = (hh < 8 ? pqg : pkg) + i16 * 8;
#pragma unroll
            for (int e = 0; e < 8; ++e) x[e] = x[e] * rstd * g[e];
            float y[8];
#pragma unroll
            for (int e = 0; e < 8; ++e) y[e] = __shfl_xor(x[e], 4);
            if (s >= CTX) { const int t = s - CTX; const int pos = (i16 >> 3) ? (t & 63) : (t >> 6); const bool half1 = (i16 >> 2) & 1;
#pragma unroll
                for (int e = 0; e < 8; ++e) { const f32x2 cs = ROPE[pos * 32 + (i16 & 3) * 8 + e];
                    x[e] = half1 ? (x[e] * cs.x + y[e] * cs.y) : (x[e] * cs.x - y[e] * cs.y); } }
            u32x4 o; o.x = pk2(x[0], x[1]); o.y = pk2(x[2], x[3]); o.z = pk2(x[4], x[5]); o.w = pk2(x[6], x[7]);
            if (valid) *(u32x4*)p = o;
        }
    }
}
__device__ __forceinline__ void attn_phase(Frame& F) {
    const bf16_t* QKV = (const bf16_t*)(F.ws + WS_QKV); bf16_t* AO = (bf16_t*)(F.ws + WS_AO);
    for (int u = F.bid; u < 544; u += F.G) {
        int b, h, q0, k0, seq;
        if (u < 512) { const int qb = u & 15, hg = (u >> 4) & 3, kvh = (u >> 6) & 1; b = u >> 7; h = kvh * 4 + hg; q0 = b * SB + CTX + qb * 256; k0 = b * SB; seq = SB; }
        else { const int v = u - 512; b = v >> 3; h = v & 7; q0 = b * SB; k0 = b * SB; seq = CTX; }
        const int kvh = h >> 2;
        const bf16_t* Kp = (const bf16_t*)pg8::uptr((const char*)(QKV + (size_t)k0 * 1536 + 1024 + kvh * 128));
        att::attn_dense_body((const bf16_t*)pg8::uptr((const char*)(QKV + (size_t)q0 * 1536 + h * 128)), Kp, Kp + 256, (bf16_t*)pg8::uptr((const char*)(AO + (size_t)q0 * D + h * 128)), seq, F.ldsg, F.tid);
        __syncthreads();
    }
}

__device__ __forceinline__ void spatial_phase(Frame& F) {
    const bf16_t* UVB = (const bf16_t*)(F.ws + WS_UVB); bf16_t* UV = (bf16_t*)(F.ws + WS_UV); const f32x2* statp = (const f32x2*)(F.ws + WS_STATP);
    const bf16_t* Ws = (const bf16_t*)(F.ws + WS_W_CMS); const float* lng = inp(F, I_CMLNG); const float* lnb = inp(F, I_CMLNB); const float* bs = inp(F, I_CMBS);
    LAS uchar* vl = F.lds;
    LAS f32x2* st = (LAS f32x2*)(F.lds + 65536);
    const int tid = F.tid, lane = F.lane, wid = F.wave, r32 = lane & 31, hi = lane >> 5, wm = wid & 3, wn = wid >> 2;
    const int sr = tid >> 4, sc = (tid & 15) * 8;
    for (int u = F.bid; u < 136 * 8; u += F.G) {
        const int chunk = u >> 3, g = u & 7; const int row0 = chunk * 128;
        float s_ = 0.f, q_ = 0.f;
        { const f32x2* sp = statp + (size_t)(row0 + (tid >> 2)) * 32 + (tid & 3) * 8; f32x2 pv[8];
#pragma unroll
          for (int k = 0; k < 8; ++k) pv[k] = sp[k];
#pragma unroll
          for (int k = 0; k < 8; ++k) { s_ += pv[k].x; q_ += pv[k].y; } }
        u32x4 xw[2][4]; f32x4 lg0[2], lg1[2], lb0[2], lb1[2];
#pragma unroll
        for (int ch = 0; ch < 2; ++ch) { const int cg = g * 256 + ch * 128 + sc;
            lg0[ch] = *(const f32x4*)(lng + cg); lg1[ch] = *(const f32x4*)(lng + cg + 4); lb0[ch] = *(const f32x4*)(lnb + cg); lb1[ch] = *(const f32x4*)(lnb + cg + 4);
#pragma unroll
            for (int i = 0; i < 4; ++i) xw[ch][i] = *(const u32x4*)(UVB + (size_t)(row0 + sr + 32 * i) * 4096 + 2048 + cg); }
        bf16x8 pa[2][4];
#pragma unroll
        for (int kt = 0; kt < 2; ++kt)
#pragma unroll
            for (int ks = 0; ks < 4; ++ks) pa[kt][ks] = *(const bf16x8*)(Ws + ((size_t)g * 128 + 32 * wm + r32) * 128 + 64 * kt + 16 * ks + 8 * hi);
        u32x4 uu[8];
#pragma unroll
        for (int i = 0; i < 8; ++i) { const int id = tid + 512 * i, row = id >> 5, ch = id & 31; uu[i] = *(const u32x4*)(UVB + (size_t)(row0 + row) * 4096 + g * 256 + ch * 8); }
        s_ += __int_as_float(__builtin_amdgcn_update_dpp(0, __float_as_int(s_), 0xB1, 0xF, 0xF, true)); s_ += __int_as_float(__builtin_amdgcn_update_dpp(0, __float_as_int(s_), 0x4E, 0xF, 0xF, true));
        q_ += __int_as_float(__builtin_amdgcn_update_dpp(0, __float_as_int(q_), 0xB1, 0xF, 0xF, true)); q_ += __int_as_float(__builtin_amdgcn_update_dpp(0, __float_as_int(q_), 0x4E, 0xF, 0xF, true));
        __syncthreads();
        if ((tid & 3) == 0) { const float mean = s_ * (1.f / 2048.f); const float var = fmaxf(q_ * (1.f / 2048.f) - mean * mean, 0.f); st[tid >> 2] = (f32x2){mean, rsqrtf(var + NORM_EPS)}; }
        __syncthreads();
#pragma unroll
        for (int ch = 0; ch < 2; ++ch) {
#pragma unroll
            for (int i = 0; i < 4; ++i) { const int q = sr + 32 * i; const u32x4 x_ = xw[ch][i]; const f32x2 ms = st[q];
                f32x4 v0 = {bflo(x_.x), bfhi(x_.x), bflo(x_.y), bfhi(x_.y)}, v1 = {bflo(x_.z), bfhi(x_.z), bflo(x_.w), bfhi(x_.w)};
                v0 = (v0 - ms.x) * ms.y * lg0[ch] + lb0[ch]; v1 = (v1 - ms.x) * ms.y * lg1[ch] + lb1[ch];
                u32x4 o; o.x = pk2(v0.x, v0.y); o.y = pk2(v0.z, v0.w); o.z = pk2(v1.x, v1.y); o.w = pk2(v1.z, v1.w);
                *(LAS u32x4*)(vl + ((q >> 6) * 2 + ch) * 16384 + att::v_st(q & 63, sc)) = o; } }
        __syncthreads();
        f32x16 o[4] = {};
        const int vb = (int)(uintptr_t)(F.ldsg) + att::v_rd_base(lane) + wn * 16384;
        att::pv_d0(o, vb, pa[0][0], pa[0][1], pa[0][2], pa[0][3]);
        att::pv_d0(o, vb + 32768, pa[1][0], pa[1][1], pa[1][2], pa[1][3]);
        __syncthreads();
#pragma unroll
        for (int r = 0; r < 16; ++r) { const int p = 32 * wm + att::crow(r, hi); const float bsv = bs[g * 128 + p];
#pragma unroll
            for (int d0 = 0; d0 < 4; ++d0) *(LAS bf16_t*)(vl + p * 512 + (128 * wn + 32 * d0 + r32) * 2) = (bf16_t)f2bf(o[d0][r] + bsv); }
        __syncthreads();
#pragma unroll
        for (int i = 0; i < 8; ++i) { const int id = tid + 512 * i, row = id >> 5, ch = id & 31; const u32x4 v = *(const LAS u32x4*)(vl + row * 512 + ch * 16); const u32x4 w = uu[i];
            u32x4 o4; o4.x = pk2(bflo(v.x) * bflo(w.x), bfhi(v.x) * bfhi(w.x)); o4.y = pk2(bflo(v.y) * bflo(w.y), bfhi(v.y) * bfhi(w.y)); o4.z = pk2(bflo(v.z) * bflo(w.z), bfhi(v.z) * bfhi(w.z)); o4.w = pk2(bflo(v.w) * bflo(w.w), bfhi(v.w) * bfhi(w.w));
            *(u32x4*)(UV + (size_t)(row0 + row) * 2048 + g * 256 + ch * 8) = o4; }
    }
    __syncthreads();
}

__device__ __forceinline__ void final_phase(Frame& F) {
    const uchar* Xb = F.ws + WS_X; const uchar* YSb = F.ws + WS_Y1; const u32x2* YM = (const u32x2*)(F.ws + WS_YM); f32x4* out = (f32x4*)F.out;
    const f32x4* G5 = (const f32x4*)((const float*)(F.ws + WS_MOD) + (size_t)(DEPTH - 1) * 5 * NMODV + 5 * D);
    const int NGT = F.G * 512;
    for (int i0 = F.bid * 512 + F.tid; i0 < NB * SEQ * 256; i0 += 4 * NGT) { f32x4 a[4], ysum[4]; u32x2 ym[4];
#pragma unroll
        for (int q = 0; q < 4; ++q) { const int i = i0 + q * NGT; if (i < NB * SEQ * 256) { const int r = i >> 8, c4 = i & 255, b = r >> 12, t = r & 4095; const size_t src = ((size_t)(b * SB + CTX + t) << 8) + c4;
            if constexpr (X_BF16) { const u32x2 xb = ((const u32x2*)Xb)[src]; a[q] = (f32x4){bflo(xb.x), bfhi(xb.x), bflo(xb.y), bfhi(xb.y)}; } else a[q] = ((const f32x4*)Xb)[src];
            if constexpr (Y_FP8) { const unsigned y0 = ((const unsigned*)YSb)[src], y1 = ((const unsigned*)YSb)[src + (size_t)T * 256]; ysum[q] = (fp8x4_to_f32(y0) + fp8x4_to_f32(y1)) * (1.f / 16.f); }
            else { const u32x2 y0 = ((const u32x2*)YSb)[src], y1 = ((const u32x2*)YSb)[src + (size_t)T * 256]; ysum[q] = (f32x4){bflo(y0.x) + bflo(y1.x), bfhi(y0.x) + bfhi(y1.x), bflo(y0.y) + bflo(y1.y), bfhi(y0.y) + bfhi(y1.y)}; }
            ym[q] = YM[src]; } }
#pragma unroll
        for (int q = 0; q < 4; ++q) { const int i = i0 + q * NGT; if (i < NB * SEQ * 256) { const int r = i >> 8, c4 = i & 255, b = r >> 12; const f32x4 g5 = G5[(size_t)b * (NMODV / 4) + c4];
            out[i] = a[q] + (f32x4){bflo(ym[q].x), bfhi(ym[q].x), bflo(ym[q].y), bfhi(ym[q].y)} + g5 * ysum[q]; } } }
}

constexpr int NPHASE = 38;
__global__ void __launch_bounds__(512, 2) mk_fwd(Args args) {
    extern __shared__ __attribute__((aligned(16))) uchar lds[];
    Frame F; F.lds = (LAS uchar*)lds; F.ldsg = (char*)lds; F.tid = threadIdx.x; F.lane = F.tid & 63; F.wave = __builtin_amdgcn_readfirstlane(F.tid >> 6); F.G = gridDim.x; F.bid = blockIdx.x;
    F.ws = args.ws; F.out = args.out;
    uchar* ws0 = args.ws;
    volatile LAS unsigned* MISC = (volatile LAS unsigned*)(F.lds + LDSCTL_OFF);
    LAS int* tab = (LAS int*)(F.lds + LDSCTL_OFF + 256);
    for (int u = F.tid; u < (LDS_BYTES - LDSCTL_OFF) / 4; u += 512) ((LAS unsigned*)(F.lds + LDSCTL_OFF))[u] = 0u;
    __syncthreads();
    if (F.tid == 0) {
#pragma unroll
        for (int i = 0; i < 34; ++i) *(LAS unsigned long long*)(F.lds + LDSCTL_OFF + 576 + i * 8) = (unsigned long long)args.in[i]; }
    __syncthreads();
    const int lo = args.ph_lo, hi = args.ph_hi;
    if (hi - lo > 1) (void)xcd_barrier_post((unsigned*)(ws0 + WS_CTL) + CW_BAR, MISC + 8);
    int ph = 0;
#define PH_BEGIN if (ph >= opaque_uniform_int(args.ph_lo) && ph < opaque_uniform_int(args.ph_hi)) { int t_ = threadIdx.x; F.G = opaque_uniform_int(gridDim.x); F.bid = opaque_uniform_int(blockIdx.x); const int cid = F.bid; (void)cid; \
        F.out = (float*)opaque_uniform_ptr(args.out); F.lds = (LAS uchar*)lds; F.ldsg = (char*)lds; \
        asm volatile("" : "+v"(t_)); F.tid = t_; F.lane = t_ & 63; F.wave = __builtin_amdgcn_readfirstlane(t_ >> 6); \
        uchar* ws = (uchar*)opaque_uniform_ptr(args.ws); F.ws = ws; \
        const float* MODl = (const float*)(ws + WS_MOD) + (size_t)l_ * 5 * NMODV; (void)MODl;
#define GRIDBAR  { XcdBarrier bb_; bb_.bar = (unsigned*)(ws + WS_CTL) + CW_BAR; bb_.x = 0; bb_.st = (volatile LAS unsigned*)(F.lds + LDSCTL_OFF) + 8; xcd_barrier(bb_); }
#define REPBAR   if (rep_ > 1) GRIDBAR
#define PH_END   if (ph + 1 < opaque_uniform_int(args.ph_hi)) GRIDBAR } ++ph;

    { const int l_ = 0; PH_BEGIN PM(0) { const bool dry = rep_ > 1; (void)dry;  p0_prologue(F);  REPBAR } PH_END }

#pragma unroll 1
    for (int l = 0; l < DEPTH; ++l) {
        const int kind = l % 3, j = l / 3; const bool lastl = (l == DEPTH - 1); const int l_ = l;
        PH_BEGIN PM(1) { const bool dry = rep_ > 1; (void)dry;  const float* gv_ = inp(F, I_NMG) + l * D;
            if (l == 0) norm_phase<false, 0, true>(F, l, gv_, 0, false, false);
            else if (rep_ != REPN(1)) norm_phase<false, 0, false>(F, l, gv_, 0, false, false);
            else if (l == 1) norm_phase<false, 3, true>(F, l, gv_, 0, false, false);
            else norm_phase<false, 3, false>(F, l, gv_, 0, false, false);  REPBAR } PH_END
        if (kind == 0) {
            PH_BEGIN PM(2) { const bool dry = rep_ > 1; (void)dry;  { pg8::DenseOrder S; S.init(ws + WS_H, D, ws + WS_W_RGIN + (size_t)j * 2048 * 1024 * 2, D, T, 2048, F.G, cid);
                EpiRgIn E{(bf16_t*)(ws + WS_GG), (bf16_t*)(ws + WS_XB)}; pg8::gemm_phase(F.lds, S, E, D, D, D); }  REPBAR } PH_END
            PH_BEGIN PM(3) { const bool dry = rep_ > 1; (void)dry;  conv_phase(F, j);  REPBAR } PH_END
            PH_BEGIN PM(4) { const bool dry = rep_ > 1; (void)dry;  { pg8::DenseOrder S; S.init(ws + WS_XC, D, ws + WS_W_RGG + (size_t)j * 16 * 256 * 128 * 2, 128, T, 16 * 256, F.G, cid, 7, 256);
                EpiRgGate E{(const bf16_t*)(ws + WS_XC), (bf16_t*)(ws + WS_LA), (bf16_t*)(ws + WS_BB), inp(F, I_RGBA) + (size_t)j * 2 * D, inp(F, I_RGBI) + (size_t)j * 2 * D, (const float*)(ws + WS_SPL) + (size_t)j * 2 * D};
                pg8::gemm_phase(F.lds, S, E, 128, D, 128); }  REPBAR } PH_END
            PH_BEGIN PM(5) { const bool dry = rep_ > 1; (void)dry;  scan1_phase(F);  REPBAR } PH_END
            PH_BEGIN PM(20) { const bool dry = rep_ > 1; (void)dry;  scan2_phase(F);  REPBAR } PH_END
            PH_BEGIN PM(6) { const bool dry = rep_ > 1; (void)dry;  scan3_phase(F);  REPBAR } PH_END
            PH_BEGIN PM(7) { const bool dry = rep_ > 1; (void)dry;  { EpiResid E{(bf16_t*)(ws + (dry ? WS_Y1 : WS_YM)), MODl + 2 * D};
                if (lastl) { pg8::DenseOrderT<true> S; S.init(ws + WS_SA, D, ws + WS_W_RGOUT + (size_t)j * 1024 * 1024 * 2, D, T, D, F.G, cid); pg8::gemm_phase(F.lds, S, E, D, D, D); }
                else { pg8::DenseOrder S; S.init(ws + WS_SA, D, ws + WS_W_RGOUT + (size_t)j * 1024 * 1024 * 2, D, T, D, F.G, cid); pg8::gemm_phase(F.lds, S, E, D, D, D); }
                router_fill(F, l); }  REPBAR } PH_END
        } else if (kind == 1) {
            PH_BEGIN PM(8) { const bool dry = rep_ > 1; (void)dry;  { pg8::DenseOrder S; S.init(ws + WS_H, D, ws + WS_W_QKV, D, T, 1536, F.G, cid);
                EpiQKV E{(bf16_t*)(ws + WS_QKV), inp(F, I_ATQG), inp(F, I_ATKG), (const float*)(ws + WS_ROPE), (LAS float*)(F.lds + RING_BYTES)}; pg8::gemm_phase(F.lds, S, E, D, D, D); }  REPBAR } PH_END
            PH_BEGIN PM(10) { const bool dry = rep_ > 1; (void)dry;  attn_phase(F);  REPBAR } PH_END
            PH_BEGIN PM(11) { const bool dry = rep_ > 1; (void)dry;  { pg8::DenseOrder S; S.init(ws + WS_AO, D, ws + WS_W_AO, D, T, D, F.G, cid);
                EpiResid E{(bf16_t*)(ws + (dry ? WS_Y1 : WS_YM)), MODl + 2 * D}; pg8::gemm_phase(F.lds, S, E, D, D, D); router_fill(F, l); }  REPBAR } PH_END
        } else {
            PH_BEGIN PM(12) { const bool dry = rep_ > 1; (void)dry;  { pg8::DenseOrder S; S.init(ws + WS_H, D, ws + WS_W_CMIN, D, T, 4096, F.G, cid);
                EpiCmIn E{(bf16_t*)(ws + WS_UVB), (f32x2*)(ws + WS_STATP)}; pg8::gemm_phase(F.lds, S, E, D, D, D); }  REPBAR } PH_END
            PH_BEGIN PM(13) { const bool dry = rep_ > 1; (void)dry;  spatial_phase(F);  REPBAR } PH_END
            PH_BEGIN PM(14) { const bool dry = rep_ > 1; (void)dry;  { pg8::DenseOrder S; S.init(ws + WS_UV, 2048, ws + WS_W_CMOUT, 2048, T, D, F.G, cid);
                EpiResid E{(bf16_t*)(ws + (dry ? WS_Y1 : WS_YM)), MODl + 2 * D}; pg8::gemm_phase(F.lds, S, E, 2048, 2048, 2048); router_fill(F, l); }  REPBAR } PH_END
        }
        PH_BEGIN PM(15) { const bool dry = rep_ > 1; (void)dry;  if (l == 0) norm_phase<true, 1, true>(F, l, inp(F, I_NFG) + l * D, 3, lastl, dry); else norm_phase<true, 1, false>(F, l, inp(F, I_NFG) + l * D, 3, lastl, dry);  REPBAR } PH_END
        PH_BEGIN PM(16) { const bool dry = rep_ > 1; (void)dry;  { const int ntile = moe_table(F, l, tab);
            const int units = ntile * 4, rounds = (units + F.G - 1) / F.G; int geff = F.G; if (false && rounds > 0) { geff = (((units + rounds - 1) / rounds) + 7) & ~7; if (geff > F.G) geff = F.G; }
            constexpr int EB = MOE_FP8 ? 1 : 2;
            MoeOrder<true> S{tab, (const char*)(ws + WS_H), (const char*)(ws + WS_W_E1 + (size_t)l * 32 * 1024 * 1024 * EB), (const int*)(ws + WS_BK2), geff, cid, units, (size_t)1024 * 1024 * EB, 1024 * EB, 1024 * EB};
            EpiMoe1 E{ws + WS_H1}; pg8::gemm_phase(F.lds, S, E, D * EB / 2, D * EB / 2, D * EB / 2); }  REPBAR } PH_END
        PH_BEGIN PM(17) { const bool dry = rep_ > 1; (void)dry;  { const int ntile = tab[32];
            const int units = ntile * 4, rounds = (units + F.G - 1) / F.G; int geff = F.G; if (false && rounds > 0) { geff = (((units + rounds - 1) / rounds) + 7) & ~7; if (geff > F.G) geff = F.G; }
            constexpr int EB = MOE_FP8 ? 1 : 2;
            MoeOrder<false> S{tab, (const char*)(ws + WS_H1), (const char*)(ws + WS_W_E2 + (size_t)l * 32 * 1024 * 512 * EB), (const int*)(ws + WS_BK2), geff, cid, units, (size_t)1024 * 512 * EB, 512 * EB, 512 * EB};
            EpiMoe2 E{(bf16_t*)(ws + (dry ? WS_SCR + 64 * MiB : WS_Y1)), (const int*)(ws + WS_BK2), tab}; pg8::gemm_phase(F.lds, S, E, DEXP * EB / 2, DEXP * EB / 2, DEXP * EB / 2); }  REPBAR } PH_END
    }
    { const int l_ = 0; PH_BEGIN PM(18) { const bool dry = rep_ > 1; (void)dry;  final_phase(F);  REPBAR if constexpr (((REP_MASK) >> 19) & 1u) { for (int k_ = 0; k_ < 20; ++k_) GRIDBAR } } PH_END }
#undef PH_BEGIN
#undef PH_END
}

extern "C" void kernel_launch(void* const* d_in, const int* in_sizes, int n_in, void* d_out, int out_size, void* d_ws, size_t ws_size, hipStream_t stream) {
    static int grid = 0;
    if (grid == 0) {
        if (n_in != 34 || out_size != NB * SEQ * D || ws_size < WS_END) { fprintf(stderr, "kernel_launch: bad shapes n_in %d out %d ws %zu (need %zu)\n", n_in, out_size, ws_size, (size_t)WS_END); grid = -1; return; }
        int dev = 0, cus = 0, per_cu = 0;
        if (hipGetDevice(&dev) != hipSuccess || hipDeviceGetAttribute(&cus, hipDeviceAttributeMultiprocessorCount, dev) != hipSuccess) { grid = -1; return; }
        if (hipFuncSetAttribute((const void*)mk_fwd, hipFuncAttributeMaxDynamicSharedMemorySize, LDS_BYTES) != hipSuccess) { fprintf(stderr, "kernel_launch: hipFuncSetAttribute failed\n"); grid = -1; return; }
        if (hipOccupancyMaxActiveBlocksPerMultiprocessor(&per_cu, (const void*)mk_fwd, 512, LDS_BYTES) != hipSuccess || per_cu < 1) { fprintf(stderr, "kernel_launch: occupancy query says %d\n", per_cu); (void)hipGetLastError(); grid = -1; return; }
        grid = cus;
    }
    if (grid < 0) return;
    (void)hipMemsetAsync((char*)d_ws + WS_CTL, 0, CTL_BYTES, stream);
    Args a{};
    for (int i = 0; i < 34; ++i) a.in[i] = (const float*)d_in[i];
    a.out = (float*)d_out; a.ws = (uchar*)d_ws;
#if MK_PER_PHASE
    for (int p = 0; p < NPHASE; ++p) { a.ph_lo = p; a.ph_hi = p + 1; hipLaunchKernelGGL(mk_fwd, dim3(grid), dim3(512), LDS_BYTES, stream, a); }
#else
    a.ph_lo = 0; a.ph_hi = NPHASE;
    void* kargs[] = {&a};
    hipError_t e = hipLaunchCooperativeKernel((const void*)mk_fwd, dim3(grid), dim3(512), kargs, LDS_BYTES, stream);
    if (e != hipSuccess) fprintf(stderr, "kernel_launch: cooperative launch failed: %s (grid %d)\n", hipGetErrorString(e), grid);
#endif
}
```

```cpp
#include <hip/hip_runtime.h>
#include <hip/hip_bf16.h>
#include <cstdio>
#include <cstdint>

#ifndef X_BF16
#define X_BF16 1
#endif
#ifndef Y_FP8
#define Y_FP8 1
#endif
#ifndef MOE_FP8
#define MOE_FP8 1
#endif
#ifndef MK_PER_PHASE
#define MK_PER_PHASE 0
#endif

#ifndef PHASE_MASK
#define PHASE_MASK 0xFFFFFFFFu
#endif
#ifndef REP_MASK
#define REP_MASK 0u
#endif
#define REPN(i) ((((REP_MASK) >> (i)) & 1u) ? 2 : 1)
#define PM(i) if constexpr ((PHASE_MASK >> (i)) & 1u) for (int rep_ = REPN(i); rep_ > 0; --rep_)
#define LAS __attribute__((address_space(3)))
#define GAS __attribute__((address_space(1)))
typedef unsigned char uchar;
typedef unsigned short bf16_t;
typedef short bf16x8 __attribute__((ext_vector_type(8)));
typedef short s16x4 __attribute__((ext_vector_type(4)));
typedef float f32x4 __attribute__((ext_vector_type(4)));
typedef float f32x2 __attribute__((ext_vector_type(2)));
typedef float f32x16 __attribute__((ext_vector_type(16)));
typedef unsigned u32x4 __attribute__((ext_vector_type(4)));
typedef unsigned u32x2 __attribute__((ext_vector_type(2)));
typedef GAS unsigned gu32;
#define RLX_AGENT __ATOMIC_RELAXED, __HIP_MEMORY_SCOPE_AGENT

constexpr int D = 1024, NB = 4, SEQ = 4096, CTX = 256, SB = SEQ + CTX, T = NB * SB, DEPTH = 4;
constexpr int NMODV = 6 * D;
constexpr int NEXP = 32, DEXP = 512;
constexpr int NCH = SB / 16;
constexpr float NORM_EPS = 1e-6f;

constexpr size_t MiB = 1u << 20;
constexpr size_t WS_CTL = 0, CTL_BYTES = 1 * MiB;
constexpr size_t WS_MOD = 1 * MiB;
constexpr size_t WS_ROPE = 2 * MiB;
constexpr size_t WS_SPL = 2 * MiB + 65536;
constexpr size_t WS_BK2 = 3 * MiB;
constexpr size_t WS_TOT = 3 * MiB;
constexpr size_t WS_STATP = 8 * MiB;
constexpr size_t WS_BK = 13 * MiB;
constexpr size_t WS_TW = 15 * MiB + 512 * 1024;
constexpr size_t WS_W_RGIN = 16 * MiB, WS_W_RGG = 24 * MiB, WS_W_RGOUT = 26 * MiB, WS_W_QKV = 30 * MiB, WS_W_AO = 33 * MiB;
constexpr size_t WS_W_CMIN = 35 * MiB, WS_W_CMS = 43 * MiB, WS_W_CMOUT = 44 * MiB, WS_W_E1 = 48 * MiB, WS_W_E2 = 304 * MiB;
constexpr size_t WS_X = 432 * MiB, WS_Y1 = 500 * MiB, WS_H = 568 * MiB, WS_SCR = 602 * MiB;
constexpr size_t WS_GG = WS_SCR, WS_XB = WS_SCR + 34 * MiB, WS_XC = WS_SCR + 68 * MiB, WS_LA = WS_SCR + 102 * MiB, WS_BB = WS_SCR + 170 * MiB, WS_SA = WS_SCR + 238 * MiB;
constexpr size_t WS_QKV = WS_SCR, WS_AO = WS_SCR + 51 * MiB;
constexpr size_t WS_UVB = WS_SCR, WS_UV = WS_SCR + 136 * MiB;
constexpr size_t WS_H1 = WS_SCR;
constexpr size_t WS_TOTS = WS_SCR + 272 * MiB, WS_TOTH = WS_TOTS + 9 * MiB, WS_CARRY = WS_TOTH + 9 * MiB;
constexpr size_t WS_YM = WS_CARRY + 9 * MiB;
constexpr size_t WS_END = WS_YM + 34 * MiB;
constexpr int CW_TMO = 0, CW_BAR = 4096, CW_CNT = 16384;

constexpr int RING_BYTES = 131072;
constexpr int ROUTER_LDS = 36 * 1024 * 4;
constexpr int LDSCTL_OFF = 147456;
constexpr int LDS_BYTES = LDSCTL_OFF + 1024 + 8 * 4 * 80 * 4;

typedef float f32x2_t_ __attribute__((ext_vector_type(2))); typedef __bf16 bf16x2_t_ __attribute__((ext_vector_type(2)));
__device__ __forceinline__ unsigned pk2(float lo, float hi) { const f32x2_t_ v = {lo, hi}; const bf16x2_t_ b = __builtin_convertvector(v, bf16x2_t_); return __builtin_bit_cast(unsigned, b); }
__device__ __forceinline__ unsigned f2bf(float f) { return pk2(f, 0.f) & 0xffffu; }
__device__ __forceinline__ float bf2f(unsigned short h) { return __builtin_bit_cast(float, (unsigned)h << 16); }
__device__ __forceinline__ float bflo(unsigned w) { return __builtin_bit_cast(float, w << 16); }
__device__ __forceinline__ float bfhi(unsigned w) { return __builtin_bit_cast(float, w & 0xffff0000u); }
__device__ __forceinline__ unsigned cvt_pk_bf16(float lo, float hi) { return pk2(lo, hi); }
__device__ __forceinline__ f32x4 fp8x4_to_f32(unsigned w) { const f32x2 lo = __builtin_amdgcn_cvt_pk_f32_fp8((int)w, false), hi = __builtin_amdgcn_cvt_pk_f32_fp8((int)w, true); return (f32x4){lo.x, lo.y, hi.x, hi.y}; }
__device__ __forceinline__ float gelu_tanh(float x) { const float u2 = (-2.f * 0.7978845608028654f) * (x + 0.044715f * x * x * x); return x * __builtin_amdgcn_rcpf(1.f + __expf(u2)); }
__device__ __forceinline__ float sigmoidf_(float x) { return 1.f / (1.f + __expf(-x)); }
__device__ __forceinline__ float fast_sigmoid(float x) { return __builtin_amdgcn_rcpf(1.f + __expf(-x)); }
__device__ __forceinline__ float one_minus_exp(float y) {   const float p = y * (1.f - y * (0.5f - y * (0.16666667f - y * 0.041666667f))); const float q = 1.f - __expf(-y); return y < 0.0625f ? p : q; }
__device__ __forceinline__ int sidx_of_row(int row) { const int b = row / SB; return (row - b * SB) < CTX ? 4 : b; }

namespace pg8 {
constexpr int BM = 256, BK = 64, HALF = 128, HTB = HALF * BK * 2, NXCD = 8, WGM = 8;
__device__ __forceinline__ int lds_byte(int r, int c) { const int st = (r >> 4) * 2 + (c >> 5), rr = r & 15, cc = c & 31, ob = rr * 64 + cc * 2; return st * 1024 + (ob ^ (((ob >> 9) & 1) << 5)); }
__device__ __forceinline__ void stage_rc(int b, int& R, int& C) { const int st = b / 1024, sb = b % 1024, swz = sb ^ (((sb >> 9) & 1) << 5); R = (st >> 1) * 16 + swz / 64; C = (st & 1) * 32 + (swz % 64) / 2; }
__device__ __forceinline__ int perm32(int rho) { const int n = rho >> 4, i = rho & 15; return 8 * (i >> 2) + 4 * n + (i & 3); }
struct Unit { const char* a; const char* b; int pm, pn, aux0, aux1, hm; };
__device__ __forceinline__ const char* uptr(const char* p) { const unsigned long long v = (unsigned long long)p; const unsigned lo = __builtin_amdgcn_readfirstlane((unsigned)v), hi = __builtin_amdgcn_readfirstlane((unsigned)(v >> 32)); return (const char*)(const GAS char*)(((unsigned long long)hi << 32) | lo); }
__device__ __forceinline__ bool unit_slot(int i, int c, int G, int nwg, int& L, int& hm) {
    if (c >= G) return false;
    const int nfull = nwg / G, rem = nwg - nfull * G;
    if (i < nfull) { L = i * G + c; hm = 0xF; return true; }
    if (i > nfull || rem == 0) return false;
    if (rem * 2 <= G) { if (c >= 2 * rem) return false; L = nfull * G + (c >> 1); hm = (c & 1) ? 0xC : 0x3; return true; }
    if (c >= rem) return false; L = nfull * G + c; hm = 0xF; return true; }
__device__ __forceinline__ int xcd_remap(int L, int nwg) { const int q = nwg / NXCD, r = nwg % NXCD, xcd = L % NXCD, off = L / NXCD; return (xcd < r ? xcd * (q + 1) : r * (q + 1) + (xcd - r) * q) + off; }

template <bool LATENT>
struct DenseOrderT {
    static constexpr bool GATHER = false;
    const char* A; const char* B; int nM, nN, nwg, G, c; size_t tA, tB; int amask, acol;
    __device__ void init(const void* A_, int lda, const void* B_, int ldb, int M, int N, int G_, int c_, int amask_ = 0, int acol_ = 0) {
        A = (const char*)A_; B = (const char*)B_; nM = LATENT ? 64 : M / BM; nN = N / BM; nwg = nM * nN; G = G_; c = c_; tA = (size_t)BM * lda * 2; tB = (size_t)BM * ldb * 2; amask = amask_; acol = acol_; }
    __device__ bool next(int i, Unit& u) const {
        int L, hm; if (!unit_slot(i, c, G, nwg, L, hm)) return false; u.hm = __builtin_amdgcn_readfirstlane(hm);
        const int wgid = xcd_remap(L, nwg);
        const int nig = WGM * nN, gid = wgid / nig, fm = gid * WGM, gsz = (nM - fm) < WGM ? (nM - fm) : WGM;
        int pm_ = fm + ((wgid % nig) % gsz); if constexpr (LATENT) pm_ = (pm_ >> 4) * 17 + 1 + (pm_ & 15);
        u.pm = __builtin_amdgcn_readfirstlane(pm_); u.pn = __builtin_amdgcn_readfirstlane((wgid % nig) / gsz); u.aux0 = 0; u.aux1 = 0;
        u.a = uptr(A + (size_t)u.pm * tA + (size_t)(u.pn & amask) * acol); u.b = uptr(B + (size_t)u.pn * tB); return true; }
    __device__ unsigned goff(const Unit&, int) const { return 0u; }
};
typedef DenseOrderT<false> DenseOrder;

#define PG8_SA(b, h) (((b) * 2 + (h)) * HTB)
#define PG8_SB(b, h) ((4 + (b) * 2 + (h)) * HTB)
__device__ __forceinline__ void glds16(const char* sbase, unsigned voff, unsigned ldsaddr) { unsigned keep;
    asm volatile("s_mov_b32 %0, m0\n\ts_mov_b32 m0, %3\n\ts_nop 0\n\tglobal_load_lds_dwordx4 %1, %2\n\ts_mov_b32 m0, %0" : "=&s"(keep) : "v"(voff), "s"(sbase), "s"(ldsaddr) : "memory"); }
#ifndef PG8_ASM_DMA
#define PG8_ASM_DMA 1
#endif
#if PG8_ASM_DMA
#define PG8_GLDS(gp, voff, ldsoff) glds16((const char*)(gp), (voff), ldsbase + (unsigned)(ldsoff))
#else
#define PG8_GLDS(gp, voff, ldsoff) __builtin_amdgcn_global_load_lds((const unsigned*)((const char*)(gp) + (voff)), (LAS unsigned*)(lds + (ldsoff)), 16, 0, 0)
#endif
#define PG8_STAGE_B(bufoff, gbase) do { PG8_GLDS(gbase, voffB[0], (bufoff) + ldsw); PG8_GLDS(gbase, voffB[1], (bufoff) + ldsw + 8192); } while (0)
#define PG8_STAGE_A(bufoff, gbase, h, NX) do { if constexpr (Sched::GATHER) { \
        PG8_GLDS(gbase, ((NX) ? vAn[h][0] : vAc[h][0]), (bufoff) + ldsw); PG8_GLDS(gbase, ((NX) ? vAn[h][1] : vAc[h][1]), (bufoff) + ldsw + 8192); \
    } else { PG8_GLDS((const char*)(gbase) + (h) * hstepA, voffA[0], (bufoff) + ldsw); PG8_GLDS((const char*)(gbase) + (h) * hstepA, voffA[1], (bufoff) + ldsw + 8192); } } while (0)
#define PG8_LDA(dst, b, h) do { _Pragma("unroll") for (int m = 0; m < 4; ++m) _Pragma("unroll") for (int k = 0; k < 2; ++k) dst[m][k] = *(const LAS bf16x8*)(lds + PG8_SA(b, h) + aoff + m * 2048 + k * 1024); } while (0)
#define PG8_LDB(dst, b, h) do { _Pragma("unroll") for (int n = 0; n < 2; ++n) _Pragma("unroll") for (int k = 0; k < 2; ++k) dst[n][k] = *(const LAS bf16x8*)(lds + PG8_SB(b, h) + boff + n * 2048 + k * 1024); } while (0)
typedef int i32x8 __attribute__((ext_vector_type(8))); typedef int i32x4v __attribute__((ext_vector_type(4)));
__device__ __forceinline__ i32x8 cat8(bf16x8 lo, bf16x8 hi) { return __builtin_shufflevector(__builtin_bit_cast(i32x4v, lo), __builtin_bit_cast(i32x4v, hi), 0, 1, 2, 3, 4, 5, 6, 7); }
#define PG8_MMA(ai, bj, At, Bt) do { __builtin_amdgcn_s_setprio(1); _Pragma("unroll") for (int m = 0; m < 4; ++m) _Pragma("unroll") for (int n = 0; n < 2; ++n) { \
        if constexpr (Epi::FP8) { asm volatile("v_mfma_scale_f32_16x16x128_f8f6f4 %0, %1, %2, %0, %3, %3 op_sel_hi:[0,0,0]" : "+v"(acc[ai][bj][m][n]) : "v"(cat8(Bt[n][0], Bt[n][1])), "v"(cat8(At[m][0], At[m][1])), "v"(0x7F7F7F7F)); } \
        else { _Pragma("unroll") for (int k = 0; k < 2; ++k) acc[ai][bj][m][n] = __builtin_amdgcn_mfma_f32_16x16x32_bf16(Bt[n][k], At[m][k], acc[ai][bj][m][n], 0, 0, 0); } } __builtin_amdgcn_s_setprio(0); } while (0)
#define PG8_WAIT_V(n) asm volatile("s_waitcnt vmcnt(" #n ")" ::: "memory")
#define PG8_WAIT_L(n) asm volatile("s_waitcnt lgkmcnt(" #n ")" ::: "memory")
#define PG8_BAR __builtin_amdgcn_s_barrier()
#define PG8_SCHED __builtin_amdgcn_sched_barrier(0)

template <class Epi, class Sched>
__device__ __forceinline__ void gemm_phase(LAS uchar* lds, const Sched& S, const Epi& E, const int K, const int lda, const int ldb) {
    int tid = threadIdx.x; asm volatile("" : "+v"(tid));
    const int wid = __builtin_amdgcn_readfirstlane(tid >> 6), lane = tid & 63, wr = wid >> 2, wc = wid & 3; int fr = lane & 15, fq = lane >> 4;
    int nt = K / BK; asm volatile("" : "+s"(nt));
    unsigned voffA[2], voffB[2];
#pragma unroll
    for (int i = 0; i < 2; ++i) { int R, C; stage_rc(tid * 16 + i * 8192, R, C); const int Rb = Epi::PERM ? ((R & ~31) + perm32(R & 31)) : R;
        voffA[i] = (unsigned)(R * lda + C) * 2u; voffB[i] = (unsigned)(Rb * ldb + C) * 2u; }
    const size_t kstep = (size_t)(BK * 2);
    const size_t hstepA = (size_t)HALF * lda * 2, hstepB = (size_t)HALF * ldb * 2;
    const unsigned ldsw = (unsigned)wid * 1024u;
    const unsigned ldsbase = (unsigned)(uintptr_t)lds;
    const int aoff = lds_byte(wr * 64 + fr, fq * 8), boff = lds_byte(wc * 32 + fr, fq * 8);
    Unit cur, nxt; int ui = 0;
    if (!S.next(0, cur)) return;
    unsigned vAc[2][2], vAn[2][2];
#pragma unroll
    for (int h = 0; h < 2; ++h)
#pragma unroll
        for (int i = 0; i < 2; ++i) { vAc[h][i] = 0u; vAn[h][i] = 0u; }
    if constexpr (Sched::GATHER) {
#pragma unroll
        for (int h = 0; h < 2; ++h)
#pragma unroll
            for (int i = 0; i < 2; ++i) { int R, C; stage_rc(tid * 16 + i * 8192, R, C); vAc[h][i] = S.goff(cur, h * HALF + R) + (unsigned)C * 2u; }
    }
    f32x4 acc[2][2][4][2];
#pragma unroll
    for (int a = 0; a < 2; ++a)
#pragma unroll
        for (int b = 0; b < 2; ++b)
#pragma unroll
            for (int m = 0; m < 4; ++m)
#pragma unroll
                for (int n = 0; n < 2; ++n) acc[a][b][m][n] = (f32x4){0.f, 0.f, 0.f, 0.f};
    bf16x8 At[4][2], B0[2][2], B1[2][2];
    typedef int pre_t __attribute__((ext_vector_type(16))); pre_t pre = {};
    if constexpr (Epi::PREFETCH) pre = E.prefetch(cur, wr, fr);
    const char* cA = cur.a; const char* cB = cur.b;
    PG8_STAGE_B(PG8_SB(0, 0), cB); PG8_STAGE_B(PG8_SB(0, 1), cB + hstepB); PG8_STAGE_A(PG8_SA(0, 0), cA, 0, false); PG8_STAGE_A(PG8_SA(0, 1), cA, 1, false);
    if (wr == 1) PG8_BAR;
    PG8_WAIT_V(2); PG8_BAR;
    PG8_STAGE_B(PG8_SB(1, 0), cB + kstep); PG8_STAGE_A(PG8_SA(1, 0), cA + kstep, 0, false); PG8_STAGE_B(PG8_SB(1, 1), cB + hstepB + kstep);
    PG8_WAIT_V(6); PG8_BAR;
    for (;;) {
        const bool has_next = S.next(ui + 1, nxt);
        if constexpr (Sched::GATHER) { if (has_next) {
#pragma unroll
            for (int h = 0; h < 2; ++h)
#pragma unroll
                for (int i = 0; i < 2; ++i) { int R, C; int t2 = tid; asm volatile("" : "+v"(t2)); stage_rc(t2 * 16 + i * 8192, R, C); vAn[h][i] = S.goff(nxt, h * HALF + R) + (unsigned)C * 2u; }
            *(LAS u32x4*)(lds + 131072 + tid * 16) = (u32x4){vAn[0][0], vAn[0][1], vAn[1][0], vAn[1][1]}; } }
        const char* nA = has_next ? nxt.a : cA; const char* nB = has_next ? nxt.b : cB;
        for (int t = 0; t < nt; t += 2) {
            const bool last = (t == nt - 2);
            const bool nx = last && has_next;
            if constexpr (Sched::GATHER) { if (nx) { const u32x4 pk_ = *(const LAS u32x4*)(lds + 131072 + tid * 16); vAn[0][0] = pk_.x; vAn[0][1] = pk_.y; vAn[1][0] = pk_.z; vAn[1][1] = pk_.w; } }
            const char* a1 = cA + (size_t)(t + 1) * kstep;
            const char* a2 = last ? nA : cA + (size_t)(t + 2) * kstep; const char* b2 = last ? nB : cB + (size_t)(t + 2) * kstep;
            const char* a3 = a2 + kstep; const char* b3 = b2 + kstep;
            PG8_LDB(B0, 0, 0); PG8_LDB(B1, 0, 1); PG8_SCHED; PG8_LDA(At, 0, 0); PG8_STAGE_A(PG8_SA(1, 1), a1, 1, false);
            PG8_WAIT_V(8); PG8_WAIT_L(0); PG8_BAR; if (cur.hm & 1) { PG8_MMA(0, 0, At, B0); PG8_MMA(0, 1, At, B1); } PG8_BAR; PG8_SCHED;
            PG8_LDA(At, 0, 1); PG8_STAGE_B(PG8_SB(0, 0), b2); PG8_STAGE_B(PG8_SB(0, 1), b2 + hstepB); PG8_STAGE_A(PG8_SA(0, 0), a2, 0, nx);
            PG8_WAIT_V(8); PG8_WAIT_L(0); PG8_BAR; if (cur.hm & 4) { PG8_MMA(1, 0, At, B0); PG8_MMA(1, 1, At, B1); } PG8_BAR; PG8_SCHED;
            PG8_LDB(B0, 1, 0); PG8_LDB(B1, 1, 1); PG8_SCHED; PG8_LDA(At, 1, 0); PG8_STAGE_A(PG8_SA(0, 1), a2, 1, nx);
            PG8_WAIT_V(8); PG8_WAIT_L(0); PG8_BAR; if (cur.hm & 1) { PG8_MMA(0, 0, At, B0); PG8_MMA(0, 1, At, B1); } PG8_BAR; PG8_SCHED;
            PG8_LDA(At, 1, 1); PG8_STAGE_B(PG8_SB(1, 0), b3); PG8_STAGE_B(PG8_SB(1, 1), b3 + hstepB); PG8_STAGE_A(PG8_SA(1, 0), a3, 0, nx);
            PG8_WAIT_V(8); PG8_WAIT_L(0); PG8_BAR; if (cur.hm & 4) { PG8_MMA(1, 0, At, B0); PG8_MMA(1, 1, At, B1); } PG8_BAR; PG8_SCHED;
        }
        if (wr == 0) PG8_BAR;
        if constexpr (Epi::FP8) asm volatile("s_nop 15\n\ts_nop 15" ::: "memory");
        if constexpr (Epi::PREFETCH) E(acc, cur, wr, wc, fr, fq, pre); else E(acc, cur, wr, wc, fr, fq);
        if (!has_next) break;
#pragma unroll
        for (int a = 0; a < 2; ++a)
#pragma unroll
            for (int b = 0; b < 2; ++b)
#pragma unroll
                for (int m = 0; m < 4; ++m)
#pragma unroll
                    for (int n = 0; n < 2; ++n) acc[a][b][m][n] = (f32x4){0.f, 0.f, 0.f, 0.f};
        cur = nxt; cA = nA; cB = nB; ++ui;
        if constexpr (Epi::PREFETCH) pre = E.prefetch(cur, wr, fr);
        if constexpr (Sched::GATHER) {
#pragma unroll
            for (int h = 0; h < 2; ++h)
#pragma unroll
                for (int i = 0; i < 2; ++i) vAc[h][i] = vAn[h][i]; }
        if (wr == 1) PG8_BAR;
    }
    PG8_WAIT_V(0);
    PG8_BAR;
}
}

#ifndef ATT_SDEPTH
#define ATT_SDEPTH 1
#endif
namespace att {
constexpr int NW = 8, QBLK = 32, KVBLK = 64;
constexpr float SCALE = 0.088388347648318440f;
constexpr float THR = 8.f;
constexpr int LDQ = 1536, LDK = 1536, LDO = 1024;
constexpr size_t SHM_V = KVBLK * 128 * 2, SHM_K = KVBLK * 128 * 2, SHM_ATTN = 2 * SHM_V + 2 * SHM_K + NW * 64 * 4;
#define KSWZ(row, colB) ((row) * 256 + ((colB) ^ (((row) & 7) << 4)))
#define SBAR() __builtin_amdgcn_sched_barrier(0)
__device__ __forceinline__ int crow(int r, int hi) { return (r & 3) + 8 * (r >> 2) + 4 * hi; }
__device__ __forceinline__ void partialSM(f32x16& p0, f32x16& p1, float& m_reg, float& mn, float& alpha) {
  constexpr float C = SCALE * 1.4426950408889634f;
  float pmax = p0[0];
#pragma unroll
  for (int r = 1; r < 16; ++r) pmax = fmaxf(pmax, p0[r]);
#pragma unroll
  for (int r = 0; r < 16; ++r) pmax = fmaxf(pmax, p1[r]);
  { auto rr = __builtin_amdgcn_permlane32_swap(__float_as_uint(pmax), __float_as_uint(pmax), false, false);
    pmax = fmaxf(__uint_as_float(rr[0]), __uint_as_float(rr[1])); }
  if (__builtin_expect(__all(pmax - m_reg <= THR / SCALE), 1)) { mn = m_reg; alpha = 1.f; }
  else { mn = fmaxf(m_reg, pmax); alpha = __builtin_amdgcn_exp2f((m_reg - mn) * C); m_reg = mn; }
  float mnC = -mn * C;
#pragma unroll
  for (int r = 0; r < 16; ++r) p0[r] = fmaf(p0[r], C, mnC);
#pragma unroll
  for (int r = 0; r < 16; ++r) p1[r] = fmaf(p1[r], C, mnC);
#pragma unroll
  for (int r = 0; r < 16; ++r) p0[r] = __builtin_amdgcn_exp2f(p0[r]);
}
__device__ __forceinline__ void finishSM(f32x16& p0, f32x16& p1, float alpha, float& l_reg, bf16x8& pa0, bf16x8& pa1, bf16x8& pa2, bf16x8& pa3) {
#pragma unroll
  for (int r = 0; r < 16; ++r) p1[r] = __builtin_amdgcn_exp2f(p1[r]);
  float ps = 0;
#pragma unroll
  for (int r = 0; r < 16; ++r) ps += p0[r];
#pragma unroll
  for (int r = 0; r < 16; ++r) ps += p1[r];
  { auto rr = __builtin_amdgcn_permlane32_swap(__float_as_uint(ps), __float_as_uint(ps), false, false);
    ps = __uint_as_float(rr[0]) + __uint_as_float(rr[1]); }
  l_reg = l_reg * alpha + ps;
#define PK4(P, BASE, OUT) do { unsigned a0 = cvt_pk_bf16(P[BASE + 0], P[BASE + 1]), a1 = cvt_pk_bf16(P[BASE + 2], P[BASE + 3]);   \
    unsigned b0 = cvt_pk_bf16(P[BASE + 4], P[BASE + 5]), b1 = cvt_pk_bf16(P[BASE + 6], P[BASE + 7]);                              \
    auto r0 = __builtin_amdgcn_permlane32_swap(a0, b0, false, false); auto r1 = __builtin_amdgcn_permlane32_swap(a1, b1, false, false); \
    u32x4 w = {r0[0], r1[0], r0[1], r1[1]}; OUT = __builtin_bit_cast(bf16x8, w); } while (0)
  PK4(p0, 0, pa0); PK4(p0, 8, pa1); PK4(p1, 0, pa2); PK4(p1, 8, pa3);
#undef PK4
}
__device__ __forceinline__ void qkt(f32x16& p0, f32x16& p1, const bf16_t* Ks, const bf16x8* qr, int r32, int hi) {
  p0 = f32x16{}; p1 = f32x16{};
#pragma unroll
  for (int d0 = 0; d0 < 8; ++d0) { int cb = (d0 * 16 + hi * 8) * 2;
    bf16x8 b0 = *reinterpret_cast<const bf16x8*>((const char*)Ks + KSWZ(r32, cb));
    bf16x8 b1 = *reinterpret_cast<const bf16x8*>((const char*)Ks + KSWZ(32 + r32, cb));
    p0 = __builtin_amdgcn_mfma_f32_32x32x16_bf16(b0, qr[d0], p0, 0, 0, 0);
    p1 = __builtin_amdgcn_mfma_f32_32x32x16_bf16(b1, qr[d0], p1, 0, 0, 0); }
}
__device__ __forceinline__ int v_st(int k, int c) { const int kk = (k & ~0xC) | ((k & 4) << 1) | ((k & 8) >> 1); return ((kk >> 3) * 4 + (c >> 5)) * 512 + ((kk & 7) * 32 + (c & 31)) * 2; }
__device__ __forceinline__ int v_rd_base(int lane) { return ((lane & 3) << 3) | (((lane >> 2) & 3) << 6) | (((lane >> 4) & 1) << 5) | (((lane >> 5) & 1) << 8); }
constexpr int v_rd_off(int d0, int ks, int half) { return d0 * 512 + ks * 4096 + half * 2048; }
template <int OFF> __device__ __forceinline__ s16x4 tr_read(int vb) {
  s16x4 r; asm volatile("ds_read_b64_tr_b16 %0, %1 offset:%2" : "=&v"(r) : "v"(vb), "i"(OFF) : "memory"); return r;
}
template <int D0> __device__ __forceinline__ void pv_one(f32x16& od, int vb, bf16x8 pa0, bf16x8 pa1, bf16x8 pa2, bf16x8 pa3) {
  const s16x4 l0 = tr_read<v_rd_off(D0, 0, 0)>(vb), h0 = tr_read<v_rd_off(D0, 0, 1)>(vb), l1 = tr_read<v_rd_off(D0, 1, 0)>(vb), h1 = tr_read<v_rd_off(D0, 1, 1)>(vb);
  const s16x4 l2 = tr_read<v_rd_off(D0, 2, 0)>(vb), h2 = tr_read<v_rd_off(D0, 2, 1)>(vb), l3 = tr_read<v_rd_off(D0, 3, 0)>(vb), h3 = tr_read<v_rd_off(D0, 3, 1)>(vb);
  asm volatile("s_waitcnt lgkmcnt(0)" ::: "memory"); SBAR();
#define PK(L, H) (bf16x8){L[0], L[1], L[2], L[3], H[0], H[1], H[2], H[3]}
  od = __builtin_amdgcn_mfma_f32_32x32x16_bf16(pa0, PK(l0, h0), od, 0, 0, 0);
  od = __builtin_amdgcn_mfma_f32_32x32x16_bf16(pa1, PK(l1, h1), od, 0, 0, 0);
  od = __builtin_amdgcn_mfma_f32_32x32x16_bf16(pa2, PK(l2, h2), od, 0, 0, 0);
  od = __builtin_amdgcn_mfma_f32_32x32x16_bf16(pa3, PK(l3, h3), od, 0, 0, 0);
#undef PK
}
__device__ __forceinline__ void pv_d0(f32x16* o, int vb, bf16x8 pa0, bf16x8 pa1, bf16x8 pa2, bf16x8 pa3) {
  pv_one<0>(o[0], vb, pa0, pa1, pa2, pa3); pv_one<1>(o[1], vb, pa0, pa1, pa2, pa3); pv_one<2>(o[2], vb, pa0, pa1, pa2, pa3); pv_one<3>(o[3], vb, pa0, pa1, pa2, pa3);
}
__device__ __forceinline__ void attn_dense_body(const bf16_t* Qb, const bf16_t* Kh, const bf16_t* Vh, bf16_t* Ob, int seq, char* lds, const int tid) {
  const int wid = tid >> 6, lane = tid & 63, r32 = lane & 31, hi = lane >> 5;
  bf16_t* V_lds = (bf16_t*)lds; bf16_t* K_lds = (bf16_t*)(lds + 2 * SHM_V);
  float* ws = (float*)(lds + 2 * SHM_V + 2 * SHM_K) + wid * 64; float* li_l = ws; float* al_l = ws + 32;
  float m_reg = -1e30f, l_reg = 0; f32x16 o[4] = {}; bf16x8 qr[8];
  const bf16_t* Qw = Qb + (long)(wid * QBLK + r32) * LDQ + hi * 8;
#pragma unroll
  for (int d0 = 0; d0 < 8; ++d0) qr[d0] = *reinterpret_cast<const bf16x8*>(Qw + d0 * 16);
  const int sr = tid >> 4, sc = (tid & 15) * 8, vst0 = v_st(sr, sc), vst1 = v_st(32 + sr, sc);
  const int vb0 = (int)(uintptr_t)V_lds + v_rd_base(lane);
  struct { bf16x8 vs0, vs1, ks0, ks1; } sr_[ATT_SDEPTH];
  const unsigned vo0 = (unsigned)(sr * LDK + sc) * 2u, vo1 = (unsigned)((32 + sr) * LDK + sc) * 2u;
  const long vdelta = (const char*)Vh - (const char*)Kh;
#define SLOAD(i, k0) do { const char* kb_ = (const char*)Kh + (size_t)(k0) * (LDK * 2); const char* vb_ = kb_ + vdelta; \
    sr_[i].vs0 = *reinterpret_cast<const bf16x8*>(vb_ + vo0); sr_[i].vs1 = *reinterpret_cast<const bf16x8*>(vb_ + vo1); \
    sr_[i].ks0 = *reinterpret_cast<const bf16x8*>(kb_ + vo0); sr_[i].ks1 = *reinterpret_cast<const bf16x8*>(kb_ + vo1); } while (0)
#define SWRITE(b, i) do { *(bf16x8*)((char*)V_lds + (b) * SHM_V + vst0) = sr_[i].vs0;          \
    *(bf16x8*)((char*)V_lds + (b) * SHM_V + vst1) = sr_[i].vs1; int kc = sc * 2;               \
    *(bf16x8*)((char*)K_lds + (b) * SHM_K + KSWZ(sr, kc)) = sr_[i].ks0;                       \
    *(bf16x8*)((char*)K_lds + (b) * SHM_K + KSWZ(32 + sr, kc)) = sr_[i].ks1; } while (0)
#define SWAIT() do { if constexpr (ATT_SDEPTH == 2) asm volatile("s_waitcnt vmcnt(4)" ::: "memory"); else asm volatile("s_waitcnt vmcnt(0)" ::: "memory"); } while (0)
#define RESC(a) do { if (__any((a) < 1.f)) { if (hi == 0) al_l[r32] = (a); asm volatile("s_waitcnt lgkmcnt(0)" ::: "memory"); \
    _Pragma("unroll") for (int d = 0; d < 4; ++d) _Pragma("unroll") for (int r = 0; r < 16; ++r) o[d][r] *= al_l[crow(r, hi)]; } } while (0)
  f32x16 pA0, pA1, pB0, pB1; float mnA, mnB, alA, alB; bf16x8 pa0, pa1, pa2, pa3; const int NT = seq / KVBLK;
  constexpr int SE = 0, SO = ATT_SDEPTH - 1;
  SLOAD(SE, 0); asm volatile("s_waitcnt vmcnt(0)" ::: "memory"); SWRITE(0, SE); __syncthreads();
  qkt(pA0, pA1, K_lds, qr, r32, hi); partialSM(pA0, pA1, m_reg, mnA, alA);
  SLOAD(SO, KVBLK); if constexpr (ATT_SDEPTH == 2) { if (2 < NT) SLOAD(SE, 2 * KVBLK); }
  SWAIT(); SWRITE(1, SO); __syncthreads();
  for (int j = 1; j + 1 < NT; j += 2) {
    SBAR(); qkt(pB0, pB1, (bf16_t*)((char*)K_lds + SHM_K), qr, r32, hi);
    finishSM(pA0, pA1, alA, l_reg, pa0, pa1, pa2, pa3); SBAR();
    SLOAD(SO, (j + ATT_SDEPTH) * KVBLK); SBAR();
    pv_d0(o, vb0, pa0, pa1, pa2, pa3); partialSM(pB0, pB1, m_reg, mnB, alB);
    __syncthreads(); SWAIT(); SWRITE(0, SE);
    RESC(alB); __syncthreads();
    SBAR(); qkt(pA0, pA1, K_lds, qr, r32, hi);
    finishSM(pB0, pB1, alB, l_reg, pa0, pa1, pa2, pa3); SBAR();
    if (ATT_SDEPTH == 1 || j + 3 < NT) SLOAD(SE, (j + 1 + ATT_SDEPTH) * KVBLK); SBAR();
    pv_d0(o, vb0 + (int)SHM_V, pa0, pa1, pa2, pa3); partialSM(pA0, pA1, m_reg, mnA, alA);
    __syncthreads(); SWAIT(); SWRITE(1, SO);
    RESC(alA); __syncthreads();
  }
  SBAR(); qkt(pB0, pB1, (bf16_t*)((char*)K_lds + SHM_K), qr, r32, hi);
  finishSM(pA0, pA1, alA, l_reg, pa0, pa1, pa2, pa3); SBAR();
  pv_d0(o, vb0, pa0, pa1, pa2, pa3); partialSM(pB0, pB1, m_reg, mnB, alB);
  __syncthreads(); RESC(alB);
  finishSM(pB0, pB1, alB, l_reg, pa0, pa1, pa2, pa3); SBAR();
  pv_d0(o, vb0 + (int)SHM_V, pa0, pa1, pa2, pa3);
  if (hi == 0) li_l[r32] = l_reg; asm volatile("s_waitcnt lgkmcnt(0)" ::: "memory");
  float rli[16];
#pragma unroll
  for (int r = 0; r < 16; ++r) rli[r] = __builtin_amdgcn_rcpf(li_l[crow(r, hi)]);
  bf16_t* Ow = Ob + (long)(wid * QBLK) * LDO;
#pragma unroll
  for (int r = 0; r < 16; ++r) { int orow = crow(r, hi);
#pragma unroll
    for (int d0 = 0; d0 < 4; ++d0) Ow[(long)orow * LDO + d0 * 32 + r32] = (bf16_t)f2bf(o[d0][r] * rli[r]); }
#undef SLOAD
#undef SWRITE
#undef SWAIT
#undef RESC
}
}

#define XB_TMO      128
#define XB_XCNT(j)  (256  + 64 * (j))
#define XB_XSUB(j)  (1280 + 64 * (j))
#define XB_XGEN(j)  (2304 + 64 * (j))
#define XB_TOP      3328
#define XB_TOPGEN   3392
#define XB_SPIN_CAP (1u << 22)
__device__ __forceinline__ unsigned xb_ld(unsigned* p)              { return __hip_atomic_load(p, __ATOMIC_RELAXED, __HIP_MEMORY_SCOPE_AGENT); }
__device__ __forceinline__ unsigned xb_add(unsigned* p, unsigned v) { return __hip_atomic_fetch_add(p, v, __ATOMIC_RELAXED, __HIP_MEMORY_SCOPE_AGENT); }
__device__ __forceinline__ unsigned xb_xcc_id() { return (unsigned)__builtin_amdgcn_s_getreg((3 << 11) | 20) & 0xFu; }
#define XB_SPIN(cond, bar) do { unsigned _sp = 0; while (cond) { __builtin_amdgcn_s_sleep(1); \
    if ((++_sp & 255u) == 0u) { if (xb_ld(&(bar)[XB_TMO])) break; if (_sp > XB_SPIN_CAP) { atomicAdd(&(bar)[XB_TMO], 1u); break; } } } } while (0)
struct XcdBarrier { unsigned* bar; unsigned x; volatile LAS unsigned* st; };
__device__ __forceinline__ XcdBarrier xcd_barrier_post(unsigned* bar, volatile LAS unsigned* st) {
    XcdBarrier b; b.bar = bar; b.x = xb_xcc_id(); b.st = st;
    if (threadIdx.x == 0) (void)xb_add(&bar[XB_XCNT(b.x)], 1u);
    return b;
}
__device__ __forceinline__ void xcd_barrier_complete(unsigned* bar, unsigned x, unsigned& nloc, unsigned& nx) {
    const unsigned G = gridDim.x * gridDim.y * gridDim.z;
    unsigned sum, cnt, mine, sp = 0u;
    for (;;) {
        sum = 0u; cnt = 0u; mine = 0u;
#pragma unroll
        for (unsigned j = 0; j < 16; ++j) { const unsigned c = xb_ld(&bar[XB_XCNT(j)]); sum += c; cnt += (c > 0u) ? 1u : 0u; mine = (j == x) ? c : mine; }
        if (sum == G) break;
        __builtin_amdgcn_s_sleep(1);
        if ((++sp & 255u) == 0u) { if (xb_ld(&bar[XB_TMO])) break; if (sp > XB_SPIN_CAP) { atomicAdd(&bar[XB_TMO], 1u); break; } }
    }
    nloc = mine > 0u ? mine : 1u; nx = cnt > 0u ? cnt : 1u;
}
__device__ __forceinline__ void xcd_barrier(const XcdBarrier& b_) {
    XcdBarrier b; b.bar = b_.bar; b.st = b_.st; b.x = xb_xcc_id();
    asm volatile("s_waitcnt vmcnt(0)" ::: "memory");
    __syncthreads();
    if (threadIdx.x == 0) {
        unsigned* bar = b.bar;
        __builtin_amdgcn_s_waitcnt(0);
        unsigned nloc = b.st[0], nx = b.st[1];
        if (nloc == 0u) { xcd_barrier_complete(bar, b.x, nloc, nx); b.st[0] = nloc; b.st[1] = nx; }
        const unsigned old = xb_add(&bar[XB_XSUB(b.x)], 1u);
        const unsigned gen = old / nloc;
        if (old + 1u == (gen + 1u) * nloc) {
            __builtin_amdgcn_fence(__ATOMIC_RELEASE, "agent");
            asm volatile("s_waitcnt vmcnt(0)" ::: "memory");
            const unsigned og = xb_add(&bar[XB_TOP], 1u);
            const unsigned tg = og / nx;
            if (og + 1u == (tg + 1u) * nx) xb_add(&bar[XB_TOPGEN], 1u);
            else XB_SPIN(xb_ld(&bar[XB_TOPGEN]) == tg, bar);
            __builtin_amdgcn_fence(__ATOMIC_ACQUIRE, "agent");
            xb_add(&bar[XB_XGEN(b.x)], 1u);
            asm volatile("s_waitcnt vmcnt(0)" ::: "memory");
        } else {
            XB_SPIN(xb_ld(&bar[XB_XGEN(b.x)]) == gen, bar);
            __builtin_amdgcn_fence(__ATOMIC_ACQUIRE, "agent");
            asm volatile("s_waitcnt vmcnt(0)" ::: "memory");
        }
    }
    __syncthreads();
}

struct Args { const float* in[34]; float* out; uchar* ws; int ph_lo, ph_hi; };
enum { I_X = 0, I_C, I_CTX, I_CCTX, I_ADAW, I_ADAB, I_NMG, I_NFG, I_RGWIN, I_RGCW, I_RGCB, I_RGWA, I_RGBA, I_RGWI, I_RGBI, I_RGLAM, I_RGWOUT,
       I_ATQKV, I_ATQG, I_ATKG, I_ATWO, I_CMWIN, I_CMLNG, I_CMLNB, I_CMWS, I_CMBS, I_CMWOUT, I_MWG, I_MBG, I_MWR, I_MBR, I_MWGATE, I_MWUP, I_MWDOWN };

__device__ __forceinline__ const void* opaque_uniform_ptr(const void* p) { const unsigned long long v = (unsigned long long)p; unsigned lo = (unsigned)v, hi = (unsigned)(v >> 32); asm volatile("" : "+v"(lo), "+v"(hi));
    lo = __builtin_amdgcn_readfirstlane(lo); hi = __builtin_amdgcn_readfirstlane(hi); return (const void*)(const GAS char*)(((unsigned long long)hi << 32) | lo); }
__device__ __forceinline__ int opaque_uniform_int(int x) { asm volatile("" : "+v"(x)); return __builtin_amdgcn_readfirstlane(x); }
struct Frame {
    LAS uchar* lds; char* ldsg;
    int tid, lane, wave, G, bid;
    uchar* ws; float* out;
};
__device__ __forceinline__ const float* inp(const Frame& F, int i) { const unsigned long long v = *(const LAS unsigned long long*)(F.lds + LDSCTL_OFF + 576 + i * 8);
    const unsigned lo = __builtin_amdgcn_readfirstlane((unsigned)v), hi = __builtin_amdgcn_readfirstlane((unsigned)(v >> 32)); return (const float*)(const GAS float*)(((unsigned long long)hi << 32) | lo); }
__device__ __forceinline__ float wave16_sum(float v) {
    v += __int_as_float(__builtin_amdgcn_update_dpp(0, __float_as_int(v), 0xB1, 0xF, 0xF, true));
    v += __int_as_float(__builtin_amdgcn_update_dpp(0, __float_as_int(v), 0x4E, 0xF, 0xF, true));
    v += __int_as_float(__builtin_amdgcn_update_dpp(0, __float_as_int(v), 0x141, 0xF, 0xF, true));
    v += __int_as_float(__builtin_amdgcn_update_dpp(0, __float_as_int(v), 0x140, 0xF, 0xF, true));
    return v; }

struct ConvItem { const float* src; uchar* dst; int ldw, rowb; bool f8, perm; };
__device__ __forceinline__ void tr_load(const ConvItem& ci, f32x4 (&v)[16]) {
    if (ci.f8) {
#pragma unroll
        for (int i = 0; i < 8; ++i) { v[2 * i] = __builtin_nontemporal_load((const f32x4*)(ci.src + (size_t)(8 * i) * ci.ldw)); v[2 * i + 1] = __builtin_nontemporal_load((const f32x4*)(ci.src + (size_t)(8 * i + 1) * ci.ldw)); }
    } else {
#pragma unroll
        for (int i = 0; i < 16; ++i) v[i] = __builtin_nontemporal_load((const f32x4*)(ci.src + (size_t)(4 * i) * ci.ldw));
    }
}
__device__ __forceinline__ void tr_finish(const f32x4 (&v)[16], const ConvItem& ci, LAS uchar* scr, int lane, const int half) {
    LAS uchar* row2 = scr + 8192 + lane * 128; const int sw2 = lane & 7;
    const int kr = lane >> 4, nc = (lane & 15) * 4;
    const int g = lane >> 4, q = (lane >> 2) & 3, p = lane & 3;
    const int vb = (int)(uintptr_t)scr + q * 128 + g * 32 + p * 8;
    if (ci.f8) {
#pragma unroll
        for (int i = 0; i < 8; ++i) { const f32x4 a = v[2 * i] * 32.f, b = v[2 * i + 1] * 32.f;
            int r0 = __builtin_amdgcn_cvt_pk_fp8_f32(a.x, b.x, 0, false); r0 = __builtin_amdgcn_cvt_pk_fp8_f32(a.y, b.y, r0, true);
            int r1 = __builtin_amdgcn_cvt_pk_fp8_f32(a.z, b.z, 0, false); r1 = __builtin_amdgcn_cvt_pk_fp8_f32(a.w, b.w, r1, true);
            *(LAS u32x2*)(scr + (4 * i + kr) * 128 + nc * 2) = (u32x2){(unsigned)r0, (unsigned)r1}; }
        asm volatile("s_waitcnt lgkmcnt(0)" ::: "memory");
        s16x4 t[8];
#define TRR(r) t[r] = att::tr_read<(r) * 512>(vb)
        TRR(0); TRR(1); TRR(2); TRR(3); TRR(4); TRR(5); TRR(6); TRR(7);
#undef TRR
        asm volatile("s_waitcnt lgkmcnt(0)" ::: "memory"); __builtin_amdgcn_sched_barrier(0);
#pragma unroll
        for (int j = 0; j < 4; ++j) { const bf16x8 o = {t[2 * j][0], t[2 * j][1], t[2 * j][2], t[2 * j][3], t[2 * j + 1][0], t[2 * j + 1][1], t[2 * j + 1][2], t[2 * j + 1][3]}; *(LAS bf16x8*)(row2 + (((half * 4 + j) ^ sw2) * 16)) = o; }
    } else {
#pragma unroll
        for (int i = 0; i < 16; ++i) { u32x2 o; o.x = pk2(v[i].x, v[i].y); o.y = pk2(v[i].z, v[i].w); *(LAS u32x2*)(scr + (4 * i + kr) * 128 + nc * 2) = o; }
        asm volatile("s_waitcnt lgkmcnt(0)" ::: "memory");
        s16x4 t[16];
#define TRR(r) t[r] = att::tr_read<(r) * 512>(vb)
        TRR(0); TRR(1); TRR(2); TRR(3); TRR(4); TRR(5); TRR(6); TRR(7); TRR(8); TRR(9); TRR(10); TRR(11); TRR(12); TRR(13); TRR(14); TRR(15);
#undef TRR
        asm volatile("s_waitcnt lgkmcnt(0)" ::: "memory"); __builtin_amdgcn_sched_barrier(0);
#pragma unroll
        for (int j = 0; j < 8; ++j) { const bf16x8 o = {t[2 * j][0], t[2 * j][1], t[2 * j][2], t[2 * j][3], t[2 * j + 1][0], t[2 * j + 1][1], t[2 * j + 1][2], t[2 * j + 1][3]}; *(LAS bf16x8*)(row2 + ((j ^ sw2) * 16)) = o; }
    }
}
__device__ __forceinline__ void tr_flush(const ConvItem& ci, LAS uchar* scr, int lane) {
    const int r8 = lane >> 3, pc = lane & 7; const LAS uchar* p2 = scr + 8192 + r8 * 128 + ((pc ^ r8) * 16);
    u32x4 w[8];
#pragma unroll
    for (int j = 0; j < 8; ++j) w[j] = *(const LAS u32x4*)(p2 + j * 1024);
#pragma unroll
    for (int j = 0; j < 8; ++j) { int r = r8 + 8 * j;
        if (ci.perm) { const int hf = r >> 5, f = r & 31; r = 32 * (f >> 4) + 8 * ((f >> 2) & 3) + 4 * hf + (f & 3); }
        *(u32x4*)(ci.dst + (size_t)r * ci.rowb + pc * 16) = w[j]; }
}
struct Job { int g, lo, hi; };
__device__ __forceinline__ ConvItem conv_decode(Frame& F, int g, int it) {
    uchar* ws = F.ws; const float* W; int K = 1024, N = 1024, ldt = 1024, mode = 0; size_t dms = 0; bf16_t* WT;
    switch (g) {
        case 0:  W = inp(F, I_MWGATE); N = 512; WT = (bf16_t*)(ws + WS_W_E1); dms = (size_t)1024 * 1024; mode = 1; break;
        case 1:  W = inp(F, I_MWUP);   N = 512; WT = (bf16_t*)(ws + WS_W_E1); dms = (size_t)1024 * 1024; mode = 2; break;
        case 2:  W = inp(F, I_MWDOWN); K = 512; WT = (bf16_t*)(ws + WS_W_E2); ldt = 512; dms = (size_t)1024 * 512; break;
        case 3:  W = inp(F, I_RGWIN);  N = 2048; WT = (bf16_t*)(ws + WS_W_RGIN); dms = (size_t)2048 * 1024; break;
        case 4:  W = inp(F, I_CMWIN);  N = 4096; WT = (bf16_t*)(ws + WS_W_CMIN); break;
        case 5:  W = inp(F, I_RGWOUT); WT = (bf16_t*)(ws + WS_W_RGOUT); dms = (size_t)1024 * 1024; break;
        case 6:  W = inp(F, I_CMWOUT); K = 2048; WT = (bf16_t*)(ws + WS_W_CMOUT); ldt = 2048; break;
        case 7:  W = inp(F, I_ATQKV);  N = 1536; WT = (bf16_t*)(ws + WS_W_QKV); break;
        case 8:  W = inp(F, I_ATWO);   WT = (bf16_t*)(ws + WS_W_AO); break;
        case 9:  W = inp(F, I_RGWA);   K = 128; N = 128; WT = (bf16_t*)(ws + WS_W_RGG); ldt = 128; dms = (size_t)256 * 128; break;
        default: W = inp(F, I_RGWI);   K = 128; N = 128; WT = (bf16_t*)(ws + WS_W_RGG); ldt = 128; dms = (size_t)256 * 128; mode = 3; break;
    }
    const int nblk = N / 64, nkb = K / 64, per = nkb * nblk, mat = it / per, r = it - mat * per, kb = r % nkb, nb = r / nkb, n0 = nb * 64;
    int drow = n0;
    if (mode == 1) drow = (n0 >> 7) * 256 + (n0 & 127); else if (mode == 2) drow = (n0 >> 7) * 256 + 128 + (n0 & 127); else if (mode == 3) drow = 128 + n0;
    const int lane = F.lane;
    const bool f8 = (MOE_FP8 != 0) && g < 3; const int eb = f8 ? 1 : 2;
    ConvItem ci; ci.ldw = N; ci.f8 = f8; ci.src = W + (size_t)mat * K * N + (size_t)(kb * 64 + (f8 ? 2 : 1) * (lane >> 4)) * N + n0 + (lane & 15) * 4;
    ci.perm = (g == 7 && n0 < 1280);
    ci.rowb = ldt * eb;
    ci.dst = (uchar*)WT + ((size_t)mat * dms + (size_t)drow * ldt + (f8 ? (kb & ~1) : kb) * 64) * eb;
    return ci;
}
template <int NJ>
__device__ __forceinline__ ConvItem conv_find(Frame& F, int v, const Job (&jobs)[NJ]) { int r = v, g = jobs[0].g, it = 0; bool found = false;
#pragma unroll
    for (int q = 0; q < NJ; ++q) { const int n = jobs[q].hi - jobs[q].lo; if (!found) { if (r < n) { g = jobs[q].g; it = jobs[q].lo + r; found = true; } else r -= n; } }
    return conv_decode(F, g, it); }
template <int NJ>
__device__ __forceinline__ void conv_tail(Frame& F, int nblk0, const Job (&jobs)[NJ]) {
    if (nblk0 >= F.G) nblk0 = 0;
    if (F.bid < nblk0) return;
    LAS uchar* scr = F.lds + F.wave * 16384;
    int total = 0;
#pragma unroll
    for (int q = 0; q < NJ; ++q) total += jobs[q].hi - jobs[q].lo;
    const int npair = total >> 1, nw = (F.G - nblk0) * 8;
    int u = (F.bid - nblk0) * 8 + F.wave;
    f32x4 va[16], vb[16]; ConvItem c0, c1; c0.dst = nullptr; c1.dst = nullptr; c0.f8 = false; c1.f8 = false; c0.src = nullptr; c1.src = nullptr; c0.ldw = 0; c1.ldw = 0; c0.rowb = 0; c1.rowb = 0; c0.perm = false; c1.perm = false;
    if (u < npair) { c0 = conv_find(F, 2 * u, jobs); tr_load(c0, va); c1 = conv_find(F, 2 * u + 1, jobs); tr_load(c1, vb); }
    for (; u < npair; u += nw) {
        const int un = u + nw;
        tr_finish(va, c0, scr, F.lane, 0);
        if (!c0.f8) tr_flush(c0, scr, F.lane);
        if (un < npair) { c0 = conv_find(F, 2 * un, jobs); tr_load(c0, va); }
        tr_finish(vb, c1, scr, F.lane, 1);
        tr_flush(c1, scr, F.lane);
        if (un < npair) { c1 = conv_find(F, 2 * un + 1, jobs); tr_load(c1, vb); }
    }
}
__device__ __forceinline__ void p0_prologue(Frame& F) {
    uchar* ws = F.ws;
    {
        LAS float* act = (LAS float*)(F.lds);
        LAS float* red = (LAS float*)(F.lds + 5 * 1024 * 4);
        bool have = false; const float* pC = inp(F, I_C); const float* pCC = inp(F, I_CCTX); const float* pADAW = inp(F, I_ADAW); const float* pADAB = inp(F, I_ADAB);
        for (int it = F.bid; it < DEPTH * 32; it += F.G) {
            if (!have) { for (int i = F.tid; i < 5 * 1024; i += 512) { const int s = i >> 10, k = i & 1023; const float v = s < 4 ? pC[s * 1024 + k] : pCC[k]; act[i] = v / (1.f + __expf(-v)); } have = true; __syncthreads(); }
            const int l = it >> 5, cb = it & 31; const int ln = F.lane < 48 ? F.lane : 47;
            const float* W = pADAW + (size_t)l * 1024 * NMODV + cb * 192 + ln * 4;
            f32x4 a[5];
#pragma unroll
            for (int s = 0; s < 5; ++s) a[s] = (f32x4){0.f, 0.f, 0.f, 0.f};
            const int kbase = F.wave * 128;
#pragma unroll 8
            for (int k = 0; k < 128; ++k) { const f32x4 w = *(const f32x4*)(W + (size_t)(kbase + k) * NMODV);
#pragma unroll
                for (int s = 0; s < 5; ++s) a[s] += w * act[s * 1024 + kbase + k]; }
            if (F.lane < 48) {
#pragma unroll
                for (int s = 0; s < 5; ++s) *(LAS f32x4*)(red + (F.wave * 5 + s) * 192 + F.lane * 4) = a[s]; }
            __syncthreads();
            for (int i = F.tid; i < 5 * 192; i += 512) { const int s = i / 192, c = i - s * 192; float v = pADAB[l * NMODV + cb * 192 + c];
#pragma unroll
                for (int w = 0; w < 8; ++w) v += red[(w * 5 + s) * 192 + c];
                ((float*)(ws + WS_MOD))[(l * 5 + s) * NMODV + cb * 192 + c] = v; }
            __syncthreads();
        }
        __syncthreads();
    }
    { const Job jobsA[8] = {{3, 0, 1024}, {4, 0, 1024}, {5, 0, 512}, {6, 0, 512}, {7, 0, 384}, {8, 0, 256}, {9, 0, 128}, {10, 0, 128}}; conv_tail(F, DEPTH * 32, jobsA);
      const Job jobsB[3] = {{0, 0, 16384}, {1, 0, 16384}, {2, 0, 16384}}; conv_tail(F, 0, jobsB); }
    {
        const int gt = F.bid * 512 + F.tid, NGT = F.G * 512;
        for (int i = gt; i < 8 * 128 * 128 / 4; i += NGT) { const f32x4 v = ((const f32x4*)inp(F, I_CMWS))[i]; u32x2 o; o.x = pk2(v.x, v.y); o.y = pk2(v.z, v.w); ((u32x2*)(ws + WS_W_CMS))[i] = o; }
        for (int i = gt; i < 2 * 2 * D; i += NGT) { const float* plam = inp(F, I_RGLAM); ((float*)(ws + WS_SPL))[i] = -8.f * log1pf(expf(-plam[i])); }
        for (int i = gt; i < 64 * 32; i += NGT) { const int pos = i >> 5, f = i & 31; const float inv = powf(10000.f, -(float)f * 2.0f / 64.0f); const float ang = (float)pos * inv;
            ((f32x2*)(ws + WS_ROPE))[i] = (f32x2){cosf(ang), sinf(ang)}; }
    }
}

__device__ __forceinline__ void router_fill(Frame& F, int l) {
    LAS float* wr = (LAS float*)F.lds;
    const float* wg = inp(F, I_MWG) + (size_t)l * 1024 * 4; const float* wrt = inp(F, I_MWR) + (size_t)l * 1024 * 32;
    __syncthreads();
    for (int i0 = F.tid; i0 < 1024 * 9; i0 += 512 * 6) { f32x4 v[6];
#pragma unroll
        for (int u = 0; u < 6; ++u) { const int idx = i0 + u * 512; const int k = idx / 9, q = idx - k * 9; v[u] = q == 0 ? *(const f32x4*)(wg + k * 4) : *(const f32x4*)(wrt + k * 32 + (q - 1) * 4); }
#pragma unroll
        for (int u = 0; u < 6; ++u) { const int idx = i0 + u * 512; const int k = idx / 9, q = idx - k * 9;
            wr[(4 * q + 0) * 1024 + k] = v[u].x; wr[(4 * q + 1) * 1024 + k] = v[u].y; wr[(4 * q + 2) * 1024 + k] = v[u].z; wr[(4 * q + 3) * 1024 + k] = v[u].w; } }
    __syncthreads();
}
template <bool ROUTE, int NADD, bool SRCIN>
__device__ __forceinline__ void norm_phase(Frame& F, int l, const float* gvec, int shift_i, bool skip_ctx_route, bool dry) {
    uchar* ws = F.ws;
    float* X = (float*)(ws + WS_X); const bf16_t* YS = (const bf16_t*)(ws + WS_Y1); const bf16_t* YM = (const bf16_t*)(ws + WS_YM); bf16_t* H = (bf16_t*)(ws + WS_H);
    const float* MOD = (const float*)(ws + WS_MOD) + (size_t)l * 5 * NMODV;
    LAS float* wr = (LAS float*)F.lds;
    const int i16 = F.lane & 15, grp = F.lane >> 4;
    const float* bg = nullptr; const float* br = nullptr; if constexpr (ROUTE) { bg = inp(F, I_MBG) + l * 4; br = inp(F, I_MBR) + l * 32; }
    const float* pctx = nullptr; const float* px = nullptr; if constexpr (SRCIN) { pctx = inp(F, I_CTX); px = inp(F, I_X); }
    constexpr int NT = ROUTE ? 2 : 1;
    const int nunits = T / (4 * NT), nwv = F.G * 8, nfull = nunits / nwv, rem = nunits - nfull * nwv;
    for (int it = 0; it <= nfull; ++it) {
        int unit = it * nwv + F.bid * 8 + F.wave;
        if (it == nfull) { const int e = F.wave * F.G + F.bid; if (e >= rem) break; unit = nfull * nwv + e; }
        asm volatile("" ::: "memory");
        f32x4 x[NT][16];
#pragma unroll
        for (int q = 0; q < NT; ++q) { const int tok = unit * (4 * NT) + q * 4 + grp; const int sidx = sidx_of_row(tok);
            int c0 = 4 * i16; asm volatile("" : "+v"(c0));
            {
                u32x2 xr[16], yr[16];
                const float* xrow = X + (size_t)tok * D;
                if constexpr (SRCIN) { const int b_ = tok / SB, s_ = tok - b_ * SB; xrow = s_ < CTX ? pctx + ((size_t)(b_ * CTX + s_) << 10) : px + ((size_t)(b_ * SEQ + s_ - CTX) << 10); }
                xrow += c0; const bf16_t* xbrow = (const bf16_t*)X + (size_t)tok * D + c0; const bf16_t* yrow = YM + (size_t)tok * D + c0;
#pragma unroll
                for (int j = 0; j < 16; ++j) { if constexpr (X_BF16 && !SRCIN) xr[j] = *(const u32x2*)(xbrow + 64 * j);
                    else x[q][j] = *(const f32x4*)(xrow + 64 * j); }
                if constexpr (NADD >= 1) {
#pragma unroll
                    for (int j = 0; j < 16; ++j) yr[j] = *(const u32x2*)(yrow + 64 * j); }
                __builtin_amdgcn_sched_barrier(0);
#pragma unroll
                for (int j = 0; j < 16; ++j) {
                    if constexpr (X_BF16 && !SRCIN) x[q][j] = (f32x4){bflo(xr[j].x), bfhi(xr[j].x), bflo(xr[j].y), bfhi(xr[j].y)};
                    if constexpr (NADD >= 1) x[q][j] += (f32x4){bflo(yr[j].x), bfhi(yr[j].x), bflo(yr[j].y), bfhi(yr[j].y)}; }
            }
            if constexpr (NADD == 3) {
#pragma unroll
                for (int j = 0; j < 16; ++j) { const f32x4 g5 = *(const f32x4*)(MOD - (size_t)5 * NMODV + (size_t)sidx * NMODV + 5 * D + 64 * j + 4 * i16);
                    if constexpr (Y_FP8) { const unsigned y0 = *(const unsigned*)((const uchar*)YS + (size_t)tok * D + 64 * j + 4 * i16), y1 = *(const unsigned*)((const uchar*)YS + ((size_t)T + tok) * D + 64 * j + 4 * i16);
                        x[q][j] += g5 * ((fp8x4_to_f32(y0) + fp8x4_to_f32(y1)) * (1.f / 16.f)); }
                    else { const u32x2 y0 = *(const u32x2*)(YS + (size_t)tok * D + 64 * j + 4 * i16), y1 = *(const u32x2*)(YS + ((size_t)T + tok) * D + 64 * j + 4 * i16);
                        x[q][j] += g5 * (f32x4){bflo(y0.x) + bflo(y1.x), bfhi(y0.x) + bfhi(y1.x), bflo(y0.y) + bflo(y1.y), bfhi(y0.y) + bfhi(y1.y)}; } }
#pragma unroll
                for (int j = 0; j < 16; ++j) { if constexpr (X_BF16) { u32x2 o; o.x = pk2(x[q][j].x, x[q][j].y); o.y = pk2(x[q][j].z, x[q][j].w); *(u32x2*)((bf16_t*)X + (size_t)tok * D + 64 * j + 4 * i16) = o; }
                    else *(f32x4*)(X + (size_t)tok * D + 64 * j + 4 * i16) = x[q][j]; } }
            float ss = 0.f;
#pragma unroll
            for (int j = 0; j < 16; ++j) ss += x[q][j].x * x[q][j].x + x[q][j].y * x[q][j].y + x[q][j].z * x[q][j].z + x[q][j].w * x[q][j].w;
            ss = wave16_sum(ss);
            const float rstd = rsqrtf(ss * (1.f / D) + NORM_EPS);
            const float* shp = MOD + (size_t)sidx * NMODV + shift_i * D + c0; const float* scp = shp + D; const float* gvp = gvec + c0;
#pragma unroll
            for (int j = 0; j < 16; ++j) { const f32x4 g = *(const f32x4*)(gvp + 64 * j), sh = *(const f32x4*)(shp + 64 * j), sc = *(const f32x4*)(scp + 64 * j);
                x[q][j] = x[q][j] * rstd * g * (sc + 1.f) + sh; }
            uchar* h8row = (uchar*)H + (size_t)tok * D + c0; bf16_t* hrow = H + (size_t)tok * D + c0;
#pragma unroll
            for (int j = 0; j < 16; ++j) {
                if constexpr (ROUTE && MOE_FP8) { int r8 = __builtin_amdgcn_cvt_pk_fp8_f32(x[q][j].x, x[q][j].y, 0, false); r8 = __builtin_amdgcn_cvt_pk_fp8_f32(x[q][j].z, x[q][j].w, r8, true); *(int*)(h8row + 64 * j) = r8; }
                else { u32x2 o; o.x = pk2(x[q][j].x, x[q][j].y); o.y = pk2(x[q][j].z, x[q][j].w); *(u32x2*)(hrow + 64 * j) = o; } }
            if constexpr (NT > 1) __builtin_amdgcn_sched_barrier(0);
        }
        if constexpr (ROUTE) {
            LAS float* lgs = (LAS float*)(F.lds + LDSCTL_OFF + 1024) + (F.wave * 4 + grp) * (40 * NT);
#pragma unroll 1
            for (int o = 0; o < 36; ++o) { f32x4 w[8], acc[NT];
#pragma unroll
                for (int j = 0; j < 8; ++j) w[j] = *(const LAS f32x4*)(wr + o * 1024 + 64 * j + 4 * i16);
                __builtin_amdgcn_sched_barrier(0);
#pragma unroll
                for (int q = 0; q < NT; ++q) { f32x4 v0 = x[q][0] * w[0], v1 = x[q][1] * w[1];
#pragma unroll
                    for (int j = 2; j < 8; j += 2) { v0 += x[q][j] * w[j]; v1 += x[q][j + 1] * w[j + 1]; }
                    acc[q] = v0 + v1; }
                __builtin_amdgcn_sched_barrier(0);
#pragma unroll
                for (int j = 0; j < 8; ++j) w[j] = *(const LAS f32x4*)(wr + o * 1024 + 64 * (j + 8) + 4 * i16);
                __builtin_amdgcn_sched_barrier(0);
#pragma unroll
                for (int q = 0; q < NT; ++q) { f32x4 v0 = x[q][8] * w[0], v1 = x[q][9] * w[1];
#pragma unroll
                    for (int j = 2; j < 8; j += 2) { v0 += x[q][8 + j] * w[j]; v1 += x[q][9 + j] * w[j + 1]; }
                    v0 += v1; v0 += acc[q]; const float a0 = wave16_sum((v0.x + v0.y) + (v0.z + v0.w)); if (i16 == 0) lgs[q * 40 + o] = a0; } }
            asm volatile("s_waitcnt lgkmcnt(0)" ::: "memory");
#pragma unroll
            for (int q = 0; q < NT; ++q) { const int tok = unit * (4 * NT) + q * 4 + grp; const int sidx = sidx_of_row(tok); const LAS float* lq = lgs + q * 40;
                const float gl0 = lq[0] + bg[0], gl1 = lq[1] + bg[1], gl2 = lq[2] + bg[2], gl3 = lq[3] + bg[3];
                int gs = 0; float gm = gl0;
                if (gl1 > gm) { gm = gl1; gs = 1; }
                if (gl2 > gm) { gm = gl2; gs = 2; }
                if (gl3 > gm) { gm = gl3; gs = 3; }
                const float den = __expf(gl0 - gm) + __expf(gl1 - gm) + __expf(gl2 - gm) + __expf(gl3 - gm);
                const float pg = 1.f / den;
                float el[8];
#pragma unroll
                for (int e = 0; e < 8; ++e) el[e] = lq[4 + gs * 8 + e] + br[gs * 8 + e];
                int i0 = 0; float v0 = el[0];
#pragma unroll
                for (int e = 1; e < 8; ++e) if (el[e] > v0) { v0 = el[e]; i0 = e; }
                int i1 = -1; float v1 = -3.0e38f;
#pragma unroll
                for (int e = 0; e < 8; ++e) if (e != i0 && el[e] > v1) { v1 = el[e]; i1 = e; }
                const float p0 = 1.f / (1.f + __expf(v1 - v0));
                const float w0 = p0 * pg, w1 = (1.f - p0) * pg;
                const bool do_route = !(skip_ctx_route && sidx == 4) && !dry;
                if (i16 == 0 && do_route) {
                    const int e0 = gs * 8 + i0, e1 = gs * 8 + i1;
                    unsigned* cnt = (unsigned*)(ws + WS_CTL) + CW_CNT + l * 32 * 64;
                    const unsigned q0 = atomicAdd(cnt + e0 * 64, 1u), q1 = atomicAdd(cnt + e1 * 64, 1u);
                    u32x2* BK = (u32x2*)(ws + WS_BK2);
                    BK[(size_t)e0 * T + q0] = (u32x2){(unsigned)(tok * 2), __float_as_uint(w0)}; BK[(size_t)e1 * T + q1] = (u32x2){(unsigned)(tok * 2 + 1), __float_as_uint(w1)};
                }
            }
        }
    }
}

__device__ __forceinline__ void st8(bf16_t* p, f32x4 v0, f32x4 v1) { u32x4 w; w.x = cvt_pk_bf16(v0[0], v0[1]); w.y = cvt_pk_bf16(v0[2], v0[3]); w.z = cvt_pk_bf16(v1[0], v1[1]); w.w = cvt_pk_bf16(v1[2], v1[3]); *(u32x4*)p = w; }
#define EPI_ROWS(ai, m) (u.pm * 256 + (ai) * 128 + wr * 64 + (m) * 16 + fr)

struct EpiRgIn { static constexpr bool PERM = true, FP8 = false, PREFETCH = false; bf16_t* GG; bf16_t* XB;
    __device__ __forceinline__ void operator()(const f32x4 (&acc)[2][2][4][2], const pg8::Unit& u, int wr, int wc, int fr, int fq) const {
        const bool isg = u.pn < 4; bf16_t* base = isg ? GG : XB; const int ct = (u.pn & 3) * 256 + wc * 32 + 8 * fq;
#pragma unroll
        for (int ai = 0; ai < 2; ++ai)
#pragma unroll
            for (int m = 0; m < 4; ++m) { if (!((u.hm >> (2 * ai)) & 1)) continue; bf16_t* rowp = base + (size_t)EPI_ROWS(ai, m) * D + ct;
#pragma unroll
                for (int bj = 0; bj < 2; ++bj) { f32x4 v0 = acc[ai][bj][m][0], v1 = acc[ai][bj][m][1];
                    if (isg) {
#pragma unroll
                        for (int e = 0; e < 4; ++e) { v0[e] = gelu_tanh(v0[e]); v1[e] = gelu_tanh(v1[e]); } }
                    st8(rowp + bj * 128, v0, v1); } }
    } };
struct EpiBf16 { static constexpr bool PERM = true, FP8 = false, PREFETCH = false; bf16_t* O; int ldc;
    __device__ __forceinline__ void operator()(const f32x4 (&acc)[2][2][4][2], const pg8::Unit& u, int wr, int wc, int fr, int fq) const {
        const int ct = u.pn * 256 + wc * 32 + 8 * fq;
#pragma unroll
        for (int ai = 0; ai < 2; ++ai)
#pragma unroll
            for (int m = 0; m < 4; ++m) { if (!((u.hm >> (2 * ai)) & 1)) continue; bf16_t* rowp = O + (size_t)EPI_ROWS(ai, m) * ldc + ct;
#pragma unroll
                for (int bj = 0; bj < 2; ++bj) st8(rowp + bj * 128, acc[ai][bj][m][0], acc[ai][bj][m][1]); }
    } };
struct EpiQKV { static constexpr bool PERM = true, FP8 = false, PREFETCH = false; bf16_t* O; const float* qg; const float* kg; const float* rope; LAS float* xch;
    __device__ __forceinline__ void operator()(const f32x4 (&acc)[2][2][4][2], const pg8::Unit& u, int wr, int wc, int fr, int fq) const {
        if (u.pn == 5) {
            const int ct = u.pn * 256 + wc * 32 + 8 * fq;
#pragma unroll
            for (int ai = 0; ai < 2; ++ai)
#pragma unroll
                for (int m = 0; m < 4; ++m) { if (!((u.hm >> (2 * ai)) & 1)) continue; bf16_t* rowp = O + (size_t)EPI_ROWS(ai, m) * 1536 + ct;
#pragma unroll
                    for (int bj = 0; bj < 2; ++bj) st8(rowp + bj * 128, acc[ai][bj][m][0], acc[ai][bj][m][1]); }
            return; }
        const bool lat = (u.pm % 17) != 0; const float* gv = u.pn < 4 ? qg : kg; const int a = wc >> 1, f0 = 16 * (wc & 1) + 4 * fq;
        const f32x4 g1 = *(const f32x4*)(gv + 64 * a + f0), g2 = *(const f32x4*)(gv + 64 * a + 32 + f0);
        f32x4 cvs[4], svs[4];
        { const int t0 = ((u.pm % 17) - 1) * 256;
#pragma unroll
          for (int q = 0; q < 4; ++q) { cvs[q] = (f32x4){1.f, 1.f, 1.f, 1.f}; svs[q] = (f32x4){0.f, 0.f, 0.f, 0.f};
            if (lat) { const int pos = a ? (16 * q + fr) : ((t0 >> 6) + 2 * (q & 1) + wr); const f32x4 cs0 = *(const f32x4*)(rope + (pos * 32 + f0) * 2), cs1 = *(const f32x4*)(rope + (pos * 32 + f0) * 2 + 4);
                cvs[q] = (f32x4){cs0.x, cs0.z, cs1.x, cs1.z}; svs[q] = (f32x4){cs0.y, cs0.w, cs1.y, cs1.w}; } } }
#pragma unroll
        for (int ai = 0; ai < 2; ++ai)
#pragma unroll
            for (int m = 0; m < 4; ++m)
#pragma unroll
                for (int bj = 0; bj < 2; ++bj) { const f32x4 v0 = acc[ai][bj][m][0], v1 = acc[ai][bj][m][1];
                    float sq = ((v0.x * v0.x + v0.y * v0.y) + (v0.z * v0.z + v0.w * v0.w)) + ((v1.x * v1.x + v1.y * v1.y) + (v1.z * v1.z + v1.w * v1.w));
                    sq += __shfl_xor(sq, 16); sq += __shfl_xor(sq, 32);
                    if (fq == 0) xch[((ai * 128 + wr * 64 + m * 16 + fr) * 2 + bj) * 4 + wc] = sq; }
        asm volatile("s_waitcnt lgkmcnt(0)" ::: "memory"); __builtin_amdgcn_s_barrier(); asm volatile("" ::: "memory");
#pragma unroll
        for (int ai = 0; ai < 2; ++ai)
#pragma unroll
            for (int m = 0; m < 4; ++m) { if (!((u.hm >> (2 * ai)) & 1)) continue; const int row = EPI_ROWS(ai, m);
                const f32x4 cv = a ? cvs[m] : cvs[ai], sv = a ? svs[m] : svs[ai];
#pragma unroll
                for (int bj = 0; bj < 2; ++bj) { const f32x4 p4 = *(const LAS f32x4*)(xch + ((ai * 128 + wr * 64 + m * 16 + fr) * 2 + bj) * 4);
                    const float rstd = rsqrtf(((p4.x + p4.y) + (p4.z + p4.w)) * (1.f / 128.f) + NORM_EPS);
                    const f32x4 x1 = acc[ai][bj][m][0] * rstd * g1, x2 = acc[ai][bj][m][1] * rstd * g2;
                    const f32x4 o1 = x1 * cv - x2 * sv, o2 = x2 * cv + x1 * sv;
                    bf16_t* p = O + (size_t)row * 1536 + u.pn * 256 + bj * 128 + 64 * a + f0;
                    u32x2 w1, w2; w1.x = cvt_pk_bf16(o1.x, o1.y); w1.y = cvt_pk_bf16(o1.z, o1.w); w2.x = cvt_pk_bf16(o2.x, o2.y); w2.y = cvt_pk_bf16(o2.z, o2.w);
                    *(u32x2*)p = w1; *(u32x2*)(p + 32) = w2; } }
    } };
struct EpiCmIn { static constexpr bool PERM = true, FP8 = false, PREFETCH = false; bf16_t* O; f32x2* statp;
    __device__ __forceinline__ void operator()(const f32x4 (&acc)[2][2][4][2], const pg8::Unit& u, int wr, int wc, int fr, int fq) const {
        const int ct = u.pn * 256 + wc * 32 + 8 * fq; const bool isv = u.pn >= 8;
#pragma unroll
        for (int ai = 0; ai < 2; ++ai)
#pragma unroll
            for (int m = 0; m < 4; ++m) { if (!((u.hm >> (2 * ai)) & 1)) continue; const int row = EPI_ROWS(ai, m); bf16_t* rowp = O + (size_t)row * 4096 + ct; float s = 0.f, q = 0.f;
#pragma unroll
                for (int bj = 0; bj < 2; ++bj) { f32x4 v0 = acc[ai][bj][m][0], v1 = acc[ai][bj][m][1];
#pragma unroll
                    for (int e = 0; e < 4; ++e) { v0[e] = gelu_tanh(v0[e]); v1[e] = gelu_tanh(v1[e]); }
                    u32x4 w; w.x = cvt_pk_bf16(v0[0], v0[1]); w.y = cvt_pk_bf16(v0[2], v0[3]); w.z = cvt_pk_bf16(v1[0], v1[1]); w.w = cvt_pk_bf16(v1[2], v1[3]);
                    *(u32x4*)(rowp + bj * 128) = w;
                    const float r0 = bflo(w.x), r1 = bfhi(w.x), r2 = bflo(w.y), r3 = bfhi(w.y), r4 = bflo(w.z), r5 = bfhi(w.z), r6 = bflo(w.w), r7 = bfhi(w.w);
                    s += ((r0 + r1) + (r2 + r3)) + ((r4 + r5) + (r6 + r7)); q += ((r0 * r0 + r1 * r1) + (r2 * r2 + r3 * r3)) + ((r4 * r4 + r5 * r5) + (r6 * r6 + r7 * r7)); }
                if (isv) { s += __shfl_xor(s, 16); s += __shfl_xor(s, 32); q += __shfl_xor(q, 16); q += __shfl_xor(q, 32);
                    if (fq == 0) statp[(size_t)row * 32 + (u.pn - 8) * 4 + wc] = (f32x2){s, q}; } }
    } };
struct EpiResid { static constexpr bool PERM = true, FP8 = false, PREFETCH = false; bf16_t* YM; const float* gate  ;
    __device__ __forceinline__ void operator()(const f32x4 (&acc)[2][2][4][2], const pg8::Unit& u, int wr, int wc, int fr, int fq) const {
        const int sidx = sidx_of_row(u.pm * 256); const float* gp = gate + (size_t)sidx * NMODV; const int ct = u.pn * 256 + wc * 32 + 8 * fq;
        f32x4 gv[2][2];
#pragma unroll
        for (int bj = 0; bj < 2; ++bj)
#pragma unroll
            for (int n = 0; n < 2; ++n) gv[bj][n] = *(const f32x4*)(gp + ct + bj * 128 + n * 4);
#pragma unroll
        for (int ai = 0; ai < 2; ++ai)
#pragma unroll
            for (int m = 0; m < 4; ++m) { if (!((u.hm >> (2 * ai)) & 1)) continue; bf16_t* rowp = YM + (size_t)EPI_ROWS(ai, m) * D + ct;
#pragma unroll
                for (int bj = 0; bj < 2; ++bj) st8(rowp + bj * 128, gv[bj][0] * acc[ai][bj][m][0], gv[bj][1] * acc[ai][bj][m][1]); }
    } };
struct EpiRgGate { static constexpr bool PERM = true, FP8 = false, PREFETCH = false; const bf16_t* XC; bf16_t* LA; bf16_t* BB; const float* ba; const float* bi; const float* lam;
    __device__ __forceinline__ void operator()(const f32x4 (&acc)[2][2][4][2], const pg8::Unit& u, int wr, int wc, int fr, int fq) const {
        const int d = u.pn >> 3, blk = u.pn & 7;
        asm volatile("" : "+v"(fr), "+v"(fq));
        const int ch = blk * 128 + wc * 32 + 8 * fq;
        u32x4 xw[8];
#pragma unroll
        for (int r = 0; r < 8; ++r) xw[r] = *(const u32x4*)(XC + (size_t)EPI_ROWS(r >> 2, r & 3) * D + ch);
        f32x4 bav[2], biv[2], spv[2];
#pragma unroll
        for (int n = 0; n < 2; ++n) { bav[n] = *(const f32x4*)(ba + d * D + ch + 4 * n); biv[n] = *(const f32x4*)(bi + d * D + ch + 4 * n); spv[n] = *(const f32x4*)(lam + d * D + ch + 4 * n); }
#pragma unroll
        for (int r = 0; r < 8; ++r) { const int ai = r >> 2, m = r & 3; if (!((u.hm >> (2 * ai)) & 1)) continue;
            const size_t off = (size_t)EPI_ROWS(ai, m) * D + ch;
            const float xc[8] = {bflo(xw[r].x), bfhi(xw[r].x), bflo(xw[r].y), bfhi(xw[r].y), bflo(xw[r].z), bfhi(xw[r].z), bflo(xw[r].w), bfhi(xw[r].w)};
            float la[8], bb[8];
#pragma unroll
            for (int n = 0; n < 2; ++n)
#pragma unroll
                for (int e = 0; e < 4; ++e) { const float rg = fast_sigmoid(acc[ai][0][m][n][e] + bav[n][e]), ig = fast_sigmoid(acc[ai][1][m][n][e] + biv[n][e]);
                    const float lga = rg * spv[n][e]; la[4 * n + e] = lga; bb[4 * n + e] = __builtin_amdgcn_sqrtf(one_minus_exp(-2.f * lga)) * ig * xc[4 * n + e]; }
            u32x4 w; w.x = cvt_pk_bf16(la[0], la[1]); w.y = cvt_pk_bf16(la[2], la[3]); w.z = cvt_pk_bf16(la[4], la[5]); w.w = cvt_pk_bf16(la[6], la[7]);
            *(u32x4*)(LA + (size_t)d * T * D + off) = w;
            w.x = cvt_pk_bf16(bb[0], bb[1]); w.y = cvt_pk_bf16(bb[2], bb[3]); w.z = cvt_pk_bf16(bb[4], bb[5]); w.w = cvt_pk_bf16(bb[6], bb[7]);
            *(u32x4*)(BB + (size_t)d * T * D + off) = w; }
    } };

template <bool G1>
struct MoeOrder {
    static constexpr bool GATHER = G1;
    const LAS int* tab; const char* A; const char* B; const int* BK; int G, c, nunits; size_t bstride; int arow, brow;
    __device__ bool next(int i, pg8::Unit& u) const {
        int L, hm; if (!pg8::unit_slot(i, c, G, nunits, L, hm)) return false; u.hm = __builtin_amdgcn_readfirstlane(hm);
        const int wgid = __builtin_amdgcn_readfirstlane(pg8::xcd_remap(L, nunits)); const int tau = wgid >> 2, pn = wgid & 3;
        const int e = __builtin_amdgcn_readfirstlane(tab[192 + tau]);
        u.pm = tau; u.pn = pn; u.aux0 = e; u.aux1 = __builtin_amdgcn_readfirstlane((tau - tab[e]) * 256);
        u.a = pg8::uptr(G1 ? A : A + (size_t)tau * 256 * arow);
        u.b = pg8::uptr(B + (size_t)e * bstride + (size_t)pn * 256 * brow);
        return true; }
    __device__ unsigned goff(const pg8::Unit& u, int row) const {
        const int pos = u.aux1 + row; const int cnt = tab[40 + u.aux0];
        int tok = 0; if (pos < cnt) tok = __builtin_nontemporal_load(BK + ((size_t)u.aux0 * T + pos) * 2) >> 1;
        return (unsigned)tok * (unsigned)arow; }
};
struct EpiMoe1 { static constexpr bool PERM = true, FP8 = (MOE_FP8 != 0), PREFETCH = false; uchar* H1;
    __device__ __forceinline__ void operator()(const f32x4 (&acc)[2][2][4][2], const pg8::Unit& u, int wr, int wc, int fr, int fq) const {
        const int ct = u.pn * 128 + wc * 32 + 8 * fq;
#pragma unroll
        for (int ai = 0; ai < 2; ++ai)
#pragma unroll
            for (int m = 0; m < 4; ++m) { if (!((u.hm >> (2 * ai)) & 1)) continue; f32x4 h0, h1;
#pragma unroll
                for (int e = 0; e < 4; ++e) { constexpr float WS_ = FP8 ? (1.f / 32.f) : 1.f;
                    const float g0 = acc[ai][0][m][0][e] * WS_, g1 = acc[ai][0][m][1][e] * WS_; h0[e] = g0 * fast_sigmoid(g0) * (acc[ai][1][m][0][e] * WS_); h1[e] = g1 * fast_sigmoid(g1) * (acc[ai][1][m][1][e] * WS_); }
                if constexpr (FP8) { int r0 = __builtin_amdgcn_cvt_pk_fp8_f32(h0[0], h0[1], 0, false); r0 = __builtin_amdgcn_cvt_pk_fp8_f32(h0[2], h0[3], r0, true);
                    int r1 = __builtin_amdgcn_cvt_pk_fp8_f32(h1[0], h1[1], 0, false); r1 = __builtin_amdgcn_cvt_pk_fp8_f32(h1[2], h1[3], r1, true);
                    *(u32x2*)(H1 + (size_t)EPI_ROWS(ai, m) * DEXP + ct) = (u32x2){(unsigned)r0, (unsigned)r1}; }
                else st8((bf16_t*)H1 + (size_t)EPI_ROWS(ai, m) * DEXP + ct, h0, h1); }
    } };
struct EpiMoe2 { static constexpr bool PERM = true, FP8 = (MOE_FP8 != 0), PREFETCH = true; bf16_t* YS; const int* BK; const LAS int* tab;
    typedef int pre_t __attribute__((ext_vector_type(16)));
    __device__ __forceinline__ pre_t prefetch(const pg8::Unit& u, int wr, int fr) const { pre_t p; const int cnt = tab[40 + u.aux0];
#pragma unroll
        for (int r = 0; r < 8; ++r) { const int pos = u.aux1 + (r >> 2) * 128 + wr * 64 + (r & 3) * 16 + fr; u32x2 v = {0xffffffffu, 0u}; if (pos < cnt) v = __builtin_nontemporal_load((const u32x2*)BK + (size_t)u.aux0 * T + pos); p[2 * r] = (int)v.x; p[2 * r + 1] = (int)v.y; }
        return p; }
    __device__ __forceinline__ void operator()(const f32x4 (&acc)[2][2][4][2], const pg8::Unit& u, int wr, int wc, int fr, int fq, const pre_t& pre) const {
        const int ct = u.pn * 256 + wc * 32 + 8 * fq;
#pragma unroll
        for (int r = 0; r < 8; ++r) { const int e_ = pre[2 * r];
            if (e_ >= 0 && ((u.hm >> (2 * (r >> 2))) & 1)) { const int tok = e_ >> 1, slot = e_ & 1; const float w = __int_as_float(pre[2 * r + 1]) * (FP8 ? (1.f / 32.f) : 1.f);
                if constexpr (Y_FP8) { uchar* yp = (uchar*)YS + ((size_t)slot * T + tok) * D + ct; const float w16 = w * 16.f;
#pragma unroll
                    for (int bj = 0; bj < 2; ++bj) { const f32x4 a0 = acc[r >> 2][bj][r & 3][0] * w16, a1 = acc[r >> 2][bj][r & 3][1] * w16;
                        int r0 = __builtin_amdgcn_cvt_pk_fp8_f32(a0.x, a0.y, 0, false); r0 = __builtin_amdgcn_cvt_pk_fp8_f32(a0.z, a0.w, r0, true);
                        int r1 = __builtin_amdgcn_cvt_pk_fp8_f32(a1.x, a1.y, 0, false); r1 = __builtin_amdgcn_cvt_pk_fp8_f32(a1.z, a1.w, r1, true);
                        *(u32x2*)(yp + bj * 128) = (u32x2){(unsigned)r0, (unsigned)r1}; } }
                else { bf16_t* yp = YS + ((size_t)slot * T + tok) * D + ct;
#pragma unroll
                    for (int bj = 0; bj < 2; ++bj) st8(yp + bj * 128, acc[r >> 2][bj][r & 3][0] * w, acc[r >> 2][bj][r & 3][1] * w); } } }
    } };
__device__ __forceinline__ int moe_table(Frame& F, int l, LAS int* tab) {
    __syncthreads();
    if (F.tid < 32) { const unsigned c = __hip_atomic_load((unsigned*)(F.ws + WS_CTL) + CW_CNT + (l * 32 + F.tid) * 64, RLX_AGENT); tab[40 + F.tid] = (int)c; }
    __syncthreads();
    if (F.tid == 0) { int s = 0;
#pragma unroll 1
        for (int e = 0; e < 32; ++e) { tab[e] = s; s += (tab[40 + e] + 255) >> 8; } tab[32] = s; }
    __syncthreads();
    const int ntile_ = tab[32];
    for (int tau = F.tid; tau < ntile_; tau += 512) { int e = 0;
#pragma unroll 1
        for (int k = 1; k < 32; ++k) e = (tab[k] <= tau) ? k : e;
        tab[192 + tau] = e; }
    __syncthreads();
    return ntile_;
}

__device__ __forceinline__ void conv_phase(Frame& F, int j) {
    const bf16_t* XB = (const bf16_t*)(F.ws + WS_XB); bf16_t* XC = (bf16_t*)(F.ws + WS_XC);
    const float* cw = inp(F, I_RGCW) + (size_t)j * 4 * D; const float* cb = inp(F, I_RGCB) + (size_t)j * D;
    const int NGT = F.G * 512;
    for (int i0 = F.bid * 512 + F.tid; i0 < T * 128; i0 += 2 * NGT) {
        u32x4 xw[2][4];
#pragma unroll
        for (int q = 0; q < 2; ++q) { const int i = i0 + q * NGT; const int row = i >> 7, c = (i & 127) * 8; const int b = row / SB, s = row - b * SB; const int lo = s < CTX ? 0 : CTX, hi = s < CTX ? CTX : SB;
#pragma unroll
            for (int k = 0; k < 4; ++k) { const int ss = s + k - 2; xw[q][k] = (u32x4){0u, 0u, 0u, 0u}; if (i < T * 128 && ss >= lo && ss < hi) xw[q][k] = *(const u32x4*)(XB + (size_t)(b * SB + ss) * D + c); } }
#pragma unroll
        for (int q = 0; q < 2; ++q) { const int i = i0 + q * NGT; if (i < T * 128) { const int row = i >> 7, c = (i & 127) * 8;
            float a[8];
#pragma unroll
            for (int e = 0; e < 8; ++e) a[e] = cb[c + e];
#pragma unroll
            for (int k = 0; k < 4; ++k) { const f32x4 w0 = *(const f32x4*)(cw + k * D + c), w1 = *(const f32x4*)(cw + k * D + c + 4); const u32x4 x = xw[q][k];
                a[0] += w0.x * bflo(x.x); a[1] += w0.y * bfhi(x.x); a[2] += w0.z * bflo(x.y); a[3] += w0.w * bfhi(x.y);
                a[4] += w1.x * bflo(x.z); a[5] += w1.y * bfhi(x.z); a[6] += w1.z * bflo(x.w); a[7] += w1.w * bfhi(x.w); }
            u32x4 o; o.x = pk2(a[0], a[1]); o.y = pk2(a[2], a[3]); o.z = pk2(a[4], a[5]); o.w = pk2(a[6], a[7]);
            *(u32x4*)(XC + (size_t)row * D + c) = o; } }
    }
}
__device__ __forceinline__ int deal_item(const Frame& F, int r, int nitems) { const int nw = F.G * 8, nfull = nitems / nw;
    if (r < nfull) return r * nw + F.bid * 8 + F.wave;
    if (r > nfull) return -1;
    const int e = F.wave * F.G + F.bid; return e < nitems - nfull * nw ? nfull * nw + e : -1; }
__device__ __forceinline__ void scan1_phase(Frame& F) {
    const bf16_t* LA = (const bf16_t*)(F.ws + WS_LA); const bf16_t* BB = (const bf16_t*)(F.ws + WS_BB); float* TS = (float*)(F.ws + WS_TOTS); float* TH = (float*)(F.ws + WS_TOTH);
    for (int r_ = 0, it; (it = deal_item(F, r_, NB * 2 * NCH * 4)) >= 0; ++r_) {
        const int cg = it & 3, rest = it >> 2, ck = rest % NCH, bd = rest / NCH, dir = bd & 1, b = bd >> 1;
        const int c = cg * 256 + F.lane * 4; const size_t base = (size_t)dir * T * D + (size_t)(b * SB + ck * 16) * D + c;
        u32x2 la[16], bb[16];
#pragma unroll
        for (int t = 0; t < 16; ++t) { const size_t o = base + (size_t)(dir ? 15 - t : t) * D; la[t] = *(const u32x2*)(LA + o); bb[t] = *(const u32x2*)(BB + o); }
        f32x4 sl = {0.f, 0.f, 0.f, 0.f}, h = {0.f, 0.f, 0.f, 0.f};
#pragma unroll
        for (int t = 0; t < 16; ++t) { const f32x4 l4 = {bflo(la[t].x), bfhi(la[t].x), bflo(la[t].y), bfhi(la[t].y)}, b4 = {bflo(bb[t].x), bfhi(bb[t].x), bflo(bb[t].y), bfhi(bb[t].y)};
            sl += l4; f32x4 a4 = {__expf(l4.x), __expf(l4.y), __expf(l4.z), __expf(l4.w)}; h = a4 * h + b4; }
        const size_t o = (size_t)(bd * NCH + ck) * D + c; *(f32x4*)(TS + o) = sl; *(f32x4*)(TH + o) = h;
    }
}
__device__ __forceinline__ void scan2_phase(Frame& F) {
    const float* TS = (const float*)(F.ws + WS_TOTS); const float* TH = (const float*)(F.ws + WS_TOTH); float* CY = (float*)(F.ws + WS_CARRY);
    LAS float* wt = (LAS float*)F.lds;
    for (int it = F.bid; it < NB * 2 * 16; it += F.G) {
        const int cg = it & 15, bd = it >> 4, dir = bd & 1; const int c = cg * 64 + F.lane; const size_t base = (size_t)bd * NCH * D + c;
        const int s0 = F.wave * 34;
        float P = 0.f, H = 0.f;
#pragma unroll 1
        for (int sb = 0; sb < 34; sb += 17) { float sl[17], hl[17];
#pragma unroll
            for (int q = 0; q < 17; ++q) { const int s = s0 + sb + q; const int ck = dir ? (s < 16 ? 15 - s : NCH + 15 - s) : s; sl[q] = TS[base + (size_t)ck * D]; hl[q] = TH[base + (size_t)ck * D]; }
#pragma unroll
            for (int q = 0; q < 17; ++q) { P += sl[q]; H = __expf(sl[q]) * H + hl[q]; } }
        __syncthreads();
        wt[(F.wave * 2 + 0) * 64 + F.lane] = P; wt[(F.wave * 2 + 1) * 64 + F.lane] = H;
        __syncthreads();
        float h = 0.f;
        for (int w = 0; w < F.wave; ++w) h = __expf(wt[(w * 2 + 0) * 64 + F.lane]) * h + wt[(w * 2 + 1) * 64 + F.lane];
#pragma unroll 1
        for (int sb = 0; sb < 34; sb += 17) { float sl[17], hl[17]; int ckk[17];
#pragma unroll
            for (int q = 0; q < 17; ++q) { const int s = s0 + sb + q; ckk[q] = dir ? (s < 16 ? 15 - s : NCH + 15 - s) : s; sl[q] = TS[base + (size_t)ckk[q] * D]; hl[q] = TH[base + (size_t)ckk[q] * D]; }
#pragma unroll
            for (int q = 0; q < 17; ++q) { CY[base + (size_t)ckk[q] * D] = h; h = __expf(sl[q]) * h + hl[q]; } }
    }
    __syncthreads();
}
__device__ __forceinline__ void scan3_phase(Frame& F) {
    const bf16_t* LA = (const bf16_t*)(F.ws + WS_LA); const bf16_t* BB = (const bf16_t*)(F.ws + WS_BB); const float* CY = (const float*)(F.ws + WS_CARRY);
    const bf16_t* GG = (const bf16_t*)(F.ws + WS_GG); bf16_t* SA = (bf16_t*)(F.ws + WS_SA);
    LAS f32x4* hb = (LAS f32x4*)(F.lds + F.wave * 16384);
    for (int r_ = 0, it; (it = deal_item(F, r_, NB * NCH * 4)) >= 0; ++r_) {
        const int cg = it & 3, rest = it >> 2, ck = rest % NCH, b = rest / NCH;
        const int c = cg * 256 + F.lane * 4;
        const size_t rbase = (size_t)(b * SB + ck * 16) * D + c, b1 = (size_t)T * D + rbase;
        f32x4 hbk = *(const f32x4*)(CY + (size_t)((b * 2 + 1) * NCH + ck) * D + c), hf = *(const f32x4*)(CY + (size_t)((b * 2 + 0) * NCH + ck) * D + c);
        { u32x2 la[16], bb[16];
#pragma unroll
          for (int t = 0; t < 16; ++t) { la[t] = *(const u32x2*)(LA + b1 + (size_t)(15 - t) * D); bb[t] = *(const u32x2*)(BB + b1 + (size_t)(15 - t) * D); }
#pragma unroll
          for (int t = 0; t < 16; ++t) { const f32x4 l4 = {bflo(la[t].x), bfhi(la[t].x), bflo(la[t].y), bfhi(la[t].y)}, b4 = {bflo(bb[t].x), bfhi(bb[t].x), bflo(bb[t].y), bfhi(bb[t].y)};
              const f32x4 a4 = {__expf(l4.x), __expf(l4.y), __expf(l4.z), __expf(l4.w)}; hbk = a4 * hbk + b4; hb[(15 - t) * 64 + F.lane] = hbk; } }
        { u32x2 la[16], bb[16], gg[16];
#pragma unroll
          for (int t = 0; t < 16; ++t) { la[t] = *(const u32x2*)(LA + rbase + (size_t)t * D); bb[t] = *(const u32x2*)(BB + rbase + (size_t)t * D); gg[t] = *(const u32x2*)(GG + rbase + (size_t)t * D); }
#pragma unroll
          for (int t = 0; t < 16; ++t) { const f32x4 l4 = {bflo(la[t].x), bfhi(la[t].x), bflo(la[t].y), bfhi(la[t].y)}, b4 = {bflo(bb[t].x), bfhi(bb[t].x), bflo(bb[t].y), bfhi(bb[t].y)};
              const f32x4 g4 = {bflo(gg[t].x), bfhi(gg[t].x), bflo(gg[t].y), bfhi(gg[t].y)};
              const f32x4 a4 = {__expf(l4.x), __expf(l4.y), __expf(l4.z), __expf(l4.w)}; hf = a4 * hf + b4; const f32x4 y = g4 * (hf + hb[t * 64 + F.lane]);
              u32x2 o; o.x = pk2(y.x, y.y); o.y = pk2(y.z, y.w); *(u32x2*)(SA + rbase + (size_t)t * D) = o; } }
    }
}

__device__ __forceinline__ void qknorm_phase(Frame& F) {
    bf16_t* QKV = (bf16_t*)(F.ws + WS_QKV); const f32x2* ROPE = (const f32x2*)(F.ws + WS_ROPE);
    const int i16 = F.lane & 15, grp = F.lane >> 4; const float* pqg = inp(F, I_ATQG); const float* pkg = inp(F, I_ATKG);
    const int ITS = F.G * 32;
    for (int it0 = (F.bid * 8 + F.wave) * 4 + grp; it0 < T * 10; it0 += 4 * ITS) {
        u32x4 xw4[4];
#pragma unroll
        for (int q = 0; q < 4; ++q) { const int it = it0 + q * ITS; xw4[q] = (u32x4){0u, 0u, 0u, 0u}; if (it < T * 10) { const int row = it / 10, hh = it - row * 10; xw4[q] = *(const u32x4*)(QKV + (size_t)row * 1536 + hh * 128 + i16 * 8); } }
#pragma unroll
        for (int q = 0; q < 4; ++q) { const int it = it0 + q * ITS; const bool valid = it < T * 10; const int itc = valid ? it : 0;
            const int row = itc / 10, hh = itc - row * 10; const int b = row / SB, s = row - b * SB;
            bf16_t* p = QKV + (size_t)row * 1536 + hh * 128 + i16 * 8;
            const u32x4 xw = xw4[q];
            float x[8] = {bflo(xw.x), bfhi(xw.x), bflo(xw.y), bfhi(xw.y), bflo(xw.z), bfhi(xw.z), bflo(xw.w), bfhi(xw.w)};
            float ss = 0.f;
#pragma unroll
            for (int e = 0; e < 8; ++e) ss += x[e] * x[e];
            ss = wave16_sum(ss);
            const float rstd = rsqrtf(ss * (1.f / 128.f) + NORM_EPS);
            const float* g = (hh < 8 ? pqg : pkg) + i16 * 8;
#pragma unroll
            for (int e = 0; e < 8; ++e) x[e] = x[e] * rstd * g[e];
            float y[8];
#pragma unroll
            for (int e = 0; e < 8; ++e) y[e] = __shfl_xor(x[e], 4);
            if (s >= CTX) { const int t = s - CTX; const int pos = (i16 >> 3) ? (t & 63) : (t >> 6); const bool half1 = (i16 >> 2) & 1;
#pragma unroll
                for (int e = 0; e < 8; ++e) { const f32x2 cs = ROPE[pos * 32 + (i16 & 3) * 8 + e];
                    x[e] = half1 ? (x[e] * cs.x + y[e] * cs.y) : (x[e] * cs.x - y[e] * cs.y); } }
            u32x4 o; o.x = pk2(x[0], x[1]); o.y = pk2(x[2], x[3]); o.z = pk2(x[4], x[5]); o.w = pk2(x[6], x[7]);
            if (valid) *(u32x4*)p = o;
        }
    }
}
__device__ __forceinline__ void attn_phase(Frame& F) {
    const bf16_t* QKV = (const bf16_t*)(F.ws + WS_QKV); bf16_t* AO = (bf16_t*)(F.ws + WS_AO);
    for (int u0 = F.bid; u0 < 544; u0 += F.G) {
        int b, h, q0, k0, seq;
        int u = u0; if (u0 < 512 && F.G == 256) { const int x = u0 & 7, rnd = u0 >> 8, i = (u0 & 255) >> 3; u = (((x >> 1) + 4 * rnd) << 6) + i + 32 * (x & 1); }
        if (u < 512) { const int qb = u & 15, hg = (u >> 4) & 3, kvh = (u >> 6) & 1; b = u >> 7; h = kvh * 4 + hg; q0 = b * SB + CTX + qb * 256; k0 = b * SB; seq = SB; }
        else { const int v = u - 512; b = v >> 3; h = v & 7; q0 = b * SB; k0 = b * SB; seq = CTX; }
        const int kvh = h >> 2;
        const bf16_t* Kp = (const bf16_t*)pg8::uptr((const char*)(QKV + (size_t)k0 * 1536 + 1024 + kvh * 128));
        att::attn_dense_body((const bf16_t*)pg8::uptr((const char*)(QKV + (size_t)q0 * 1536 + h * 128)), Kp, Kp + 256, (bf16_t*)pg8::uptr((const char*)(AO + (size_t)q0 * D + h * 128)), seq, F.ldsg, F.tid);
        __syncthreads();
    }
}

__device__ __forceinline__ void spatial_phase(Frame& F) {
    const bf16_t* UVB = (const bf16_t*)(F.ws + WS_UVB); bf16_t* UV = (bf16_t*)(F.ws + WS_UV); const f32x2* statp = (const f32x2*)(F.ws + WS_STATP);
    const bf16_t* Ws = (const bf16_t*)(F.ws + WS_W_CMS); const float* lng = inp(F, I_CMLNG); const float* lnb = inp(F, I_CMLNB); const float* bs = inp(F, I_CMBS);
    LAS uchar* vl = F.lds;
    LAS f32x2* st = (LAS f32x2*)(F.lds + 65536);
    const int tid = F.tid, lane = F.lane, wid = F.wave, r32 = lane & 31, hi = lane >> 5, wm = wid & 3, wn = wid >> 2;
    const int sr = tid >> 4, sc = (tid & 15) * 8;
    for (int u = F.bid; u < 136 * 8; u += F.G) {
        const int chunk = u >> 3, g = u & 7; const int row0 = chunk * 128;
        float s_ = 0.f, q_ = 0.f;
        { const f32x2* sp = statp + (size_t)(row0 + (tid >> 2)) * 32 + (tid & 3) * 8; f32x2 pv[8];
#pragma unroll
          for (int k = 0; k < 8; ++k) pv[k] = sp[k];
#pragma unroll
          for (int k = 0; k < 8; ++k) { s_ += pv[k].x; q_ += pv[k].y; } }
        u32x4 xw[2][4]; f32x4 lg0[2], lg1[2], lb0[2], lb1[2];
#pragma unroll
        for (int ch = 0; ch < 2; ++ch) { const int cg = g * 256 + ch * 128 + sc;
            lg0[ch] = *(const f32x4*)(lng + cg); lg1[ch] = *(const f32x4*)(lng + cg + 4); lb0[ch] = *(const f32x4*)(lnb + cg); lb1[ch] = *(const f32x4*)(lnb + cg + 4);
#pragma unroll
            for (int i = 0; i < 4; ++i) xw[ch][i] = *(const u32x4*)(UVB + (size_t)(row0 + sr + 32 * i) * 4096 + 2048 + cg); }
        bf16x8 pa[2][4];
#pragma unroll
        for (int kt = 0; kt < 2; ++kt)
#pragma unroll
            for (int ks = 0; ks < 4; ++ks) pa[kt][ks] = *(const bf16x8*)(Ws + ((size_t)g * 128 + 32 * wm + r32) * 128 + 64 * kt + 16 * ks + 8 * hi);
        u32x4 uu[8];
#pragma unroll
        for (int i = 0; i < 8; ++i) { const int id = tid + 512 * i, row = id >> 5, ch = id & 31; uu[i] = *(const u32x4*)(UVB + (size_t)(row0 + row) * 4096 + g * 256 + ch * 8); }
        s_ += __int_as_float(__builtin_amdgcn_update_dpp(0, __float_as_int(s_), 0xB1, 0xF, 0xF, true)); s_ += __int_as_float(__builtin_amdgcn_update_dpp(0, __float_as_int(s_), 0x4E, 0xF, 0xF, true));
        q_ += __int_as_float(__builtin_amdgcn_update_dpp(0, __float_as_int(q_), 0xB1, 0xF, 0xF, true)); q_ += __int_as_float(__builtin_amdgcn_update_dpp(0, __float_as_int(q_), 0x4E, 0xF, 0xF, true));
        __syncthreads();
        if ((tid & 3) == 0) { const float mean = s_ * (1.f / 2048.f); const float var = fmaxf(q_ * (1.f / 2048.f) - mean * mean, 0.f); st[tid >> 2] = (f32x2){mean, rsqrtf(var + NORM_EPS)}; }
        __syncthreads();
#pragma unroll
        for (int ch = 0; ch < 2; ++ch) {
#pragma unroll
            for (int i = 0; i < 4; ++i) { const int q = sr + 32 * i; const u32x4 x_ = xw[ch][i]; const f32x2 ms = st[q];
                f32x4 v0 = {bflo(x_.x), bfhi(x_.x), bflo(x_.y), bfhi(x_.y)}, v1 = {bflo(x_.z), bfhi(x_.z), bflo(x_.w), bfhi(x_.w)};
                v0 = (v0 - ms.x) * ms.y * lg0[ch] + lb0[ch]; v1 = (v1 - ms.x) * ms.y * lg1[ch] + lb1[ch];
                u32x4 o; o.x = pk2(v0.x, v0.y); o.y = pk2(v0.z, v0.w); o.z = pk2(v1.x, v1.y); o.w = pk2(v1.z, v1.w);
                *(LAS u32x4*)(vl + ((q >> 6) * 2 + ch) * 16384 + att::v_st(q & 63, sc)) = o; } }
        __syncthreads();
        f32x16 o[4] = {};
        const int vb = (int)(uintptr_t)(F.ldsg) + att::v_rd_base(lane) + wn * 16384;
        att::pv_d0(o, vb, pa[0][0], pa[0][1], pa[0][2], pa[0][3]);
        att::pv_d0(o, vb + 32768, pa[1][0], pa[1][1], pa[1][2], pa[1][3]);
        __syncthreads();
#pragma unroll
        for (int r = 0; r < 16; ++r) { const int p = 32 * wm + att::crow(r, hi); const float bsv = bs[g * 128 + p];
#pragma unroll
            for (int d0 = 0; d0 < 4; ++d0) *(LAS bf16_t*)(vl + p * 512 + (128 * wn + 32 * d0 + r32) * 2) = (bf16_t)f2bf(o[d0][r] + bsv); }
        __syncthreads();
#pragma unroll
        for (int i = 0; i < 8; ++i) { const int id = tid + 512 * i, row = id >> 5, ch = id & 31; const u32x4 v = *(const LAS u32x4*)(vl + row * 512 + ch * 16); const u32x4 w = uu[i];
            u32x4 o4; o4.x = pk2(bflo(v.x) * bflo(w.x), bfhi(v.x) * bfhi(w.x)); o4.y = pk2(bflo(v.y) * bflo(w.y), bfhi(v.y) * bfhi(w.y)); o4.z = pk2(bflo(v.z) * bflo(w.z), bfhi(v.z) * bfhi(w.z)); o4.w = pk2(bflo(v.w) * bflo(w.w), bfhi(v.w) * bfhi(w.w));
            *(u32x4*)(UV + (size_t)(row0 + row) * 2048 + g * 256 + ch * 8) = o4; }
    }
    __syncthreads();
}

__device__ __forceinline__ void final_phase(Frame& F) {
    const uchar* Xb = F.ws + WS_X; const uchar* YSb = F.ws + WS_Y1; const u32x2* YM = (const u32x2*)(F.ws + WS_YM); f32x4* out = (f32x4*)F.out;
    const f32x4* G5 = (const f32x4*)((const float*)(F.ws + WS_MOD) + (size_t)(DEPTH - 1) * 5 * NMODV + 5 * D);
    const int NGT = F.G * 512;
    for (int i0 = F.bid * 512 + F.tid; i0 < NB * SEQ * 256; i0 += 4 * NGT) { f32x4 a[4], ysum[4]; u32x2 ym[4];
#pragma unroll
        for (int q = 0; q < 4; ++q) { const int i = i0 + q * NGT; if (i < NB * SEQ * 256) { const int r = i >> 8, c4 = i & 255, b = r >> 12, t = r & 4095; const size_t src = ((size_t)(b * SB + CTX + t) << 8) + c4;
            if constexpr (X_BF16) { const u32x2 xb = ((const u32x2*)Xb)[src]; a[q] = (f32x4){bflo(xb.x), bfhi(xb.x), bflo(xb.y), bfhi(xb.y)}; } else a[q] = ((const f32x4*)Xb)[src];
            if constexpr (Y_FP8) { const unsigned y0 = ((const unsigned*)YSb)[src], y1 = ((const unsigned*)YSb)[src + (size_t)T * 256]; ysum[q] = (fp8x4_to_f32(y0) + fp8x4_to_f32(y1)) * (1.f / 16.f); }
            else { const u32x2 y0 = ((const u32x2*)YSb)[src], y1 = ((const u32x2*)YSb)[src + (size_t)T * 256]; ysum[q] = (f32x4){bflo(y0.x) + bflo(y1.x), bfhi(y0.x) + bfhi(y1.x), bflo(y0.y) + bflo(y1.y), bfhi(y0.y) + bfhi(y1.y)}; }
            ym[q] = YM[src]; } }
#pragma unroll
        for (int q = 0; q < 4; ++q) { const int i = i0 + q * NGT; if (i < NB * SEQ * 256) { const int r = i >> 8, c4 = i & 255, b = r >> 12; const f32x4 g5 = G5[(size_t)b * (NMODV / 4) + c4];
            out[i] = a[q] + (f32x4){bflo(ym[q].x), bfhi(ym[q].x), bflo(ym[q].y), bfhi(ym[q].y)} + g5 * ysum[q]; } } }
}

constexpr int NPHASE = 38;
__global__ void __launch_bounds__(512, 2) mk_fwd(Args args) {
    extern __shared__ __attribute__((aligned(16))) uchar lds[];
    Frame F; F.lds = (LAS uchar*)lds; F.ldsg = (char*)lds; F.tid = threadIdx.x; F.lane = F.tid & 63; F.wave = __builtin_amdgcn_readfirstlane(F.tid >> 6); F.G = gridDim.x; F.bid = blockIdx.x;
    F.ws = args.ws; F.out = args.out;
    uchar* ws0 = args.ws;
    volatile LAS unsigned* MISC = (volatile LAS unsigned*)(F.lds + LDSCTL_OFF);
    LAS int* tab = (LAS int*)(F.lds + LDSCTL_OFF + 256);
    for (int u = F.tid; u < (LDS_BYTES - LDSCTL_OFF) / 4; u += 512) ((LAS unsigned*)(F.lds + LDSCTL_OFF))[u] = 0u;
    __syncthreads();
    if (F.tid == 0) {
#pragma unroll
        for (int i = 0; i < 34; ++i) *(LAS unsigned long long*)(F.lds + LDSCTL_OFF + 576 + i * 8) = (unsigned long long)args.in[i]; }
    __syncthreads();
    const int lo = args.ph_lo, hi = args.ph_hi;
    if (hi - lo > 1) (void)xcd_barrier_post((unsigned*)(ws0 + WS_CTL) + CW_BAR, MISC + 8);
    int ph = 0;
#define PH_BEGIN if (ph >= opaque_uniform_int(args.ph_lo) && ph < opaque_uniform_int(args.ph_hi)) { int t_ = threadIdx.x; F.G = opaque_uniform_int(gridDim.x); F.bid = opaque_uniform_int(blockIdx.x); const int cid = F.bid; (void)cid; \
        F.out = (float*)opaque_uniform_ptr(args.out); F.lds = (LAS uchar*)lds; F.ldsg = (char*)lds; \
        asm volatile("" : "+v"(t_)); F.tid = t_; F.lane = t_ & 63; F.wave = __builtin_amdgcn_readfirstlane(t_ >> 6); \
        uchar* ws = (uchar*)opaque_uniform_ptr(args.ws); F.ws = ws; \
        const float* MODl = (const float*)(ws + WS_MOD) + (size_t)l_ * 5 * NMODV; (void)MODl;
#define GRIDBAR  { XcdBarrier bb_; bb_.bar = (unsigned*)(ws + WS_CTL) + CW_BAR; bb_.x = 0; bb_.st = (volatile LAS unsigned*)(F.lds + LDSCTL_OFF) + 8; xcd_barrier(bb_); }
#define REPBAR   if (rep_ > 1) GRIDBAR
#define PH_END   if (ph + 1 < opaque_uniform_int(args.ph_hi)) GRIDBAR } ++ph;

    { const int l_ = 0; PH_BEGIN PM(0) { const bool dry = rep_ > 1; (void)dry;  p0_prologue(F);  REPBAR } PH_END }

#pragma unroll 1
    for (int l = 0; l < DEPTH; ++l) {
        const int kind = l % 3, j = l / 3; const bool lastl = (l == DEPTH - 1); const int l_ = l;
        PH_BEGIN PM(1) { const bool dry = rep_ > 1; (void)dry;  const float* gv_ = inp(F, I_NMG) + l * D;
            if (l == 0) norm_phase<false, 0, true>(F, l, gv_, 0, false, false);
            else if (rep_ != REPN(1)) norm_phase<false, 0, false>(F, l, gv_, 0, false, false);
            else if (l == 1) norm_phase<false, 3, true>(F, l, gv_, 0, false, false);
            else norm_phase<false, 3, false>(F, l, gv_, 0, false, false);  REPBAR } PH_END
        if (kind == 0) {
            PH_BEGIN PM(2) { const bool dry = rep_ > 1; (void)dry;  { pg8::DenseOrder S; S.init(ws + WS_H, D, ws + WS_W_RGIN + (size_t)j * 2048 * 1024 * 2, D, T, 2048, F.G, cid);
                EpiRgIn E{(bf16_t*)(ws + WS_GG), (bf16_t*)(ws + WS_XB)}; pg8::gemm_phase(F.lds, S, E, D, D, D); }  REPBAR } PH_END
            PH_BEGIN PM(3) { const bool dry = rep_ > 1; (void)dry;  conv_phase(F, j);  REPBAR } PH_END
            PH_BEGIN PM(4) { const bool dry = rep_ > 1; (void)dry;  { pg8::DenseOrder S; S.init(ws + WS_XC, D, ws + WS_W_RGG + (size_t)j * 16 * 256 * 128 * 2, 128, T, 16 * 256, F.G, cid, 7, 256);
                EpiRgGate E{(const bf16_t*)(ws + WS_XC), (bf16_t*)(ws + WS_LA), (bf16_t*)(ws + WS_BB), inp(F, I_RGBA) + (size_t)j * 2 * D, inp(F, I_RGBI) + (size_t)j * 2 * D, (const float*)(ws + WS_SPL) + (size_t)j * 2 * D};
                pg8::gemm_phase(F.lds, S, E, 128, D, 128); }  REPBAR } PH_END
            PH_BEGIN PM(5) { const bool dry = rep_ > 1; (void)dry;  scan1_phase(F);  REPBAR } PH_END
            PH_BEGIN PM(20) { const bool dry = rep_ > 1; (void)dry;  scan2_phase(F);  REPBAR } PH_END
            PH_BEGIN PM(6) { const bool dry = rep_ > 1; (void)dry;  scan3_phase(F);  REPBAR } PH_END
            PH_BEGIN PM(7) { const bool dry = rep_ > 1; (void)dry;  { EpiResid E{(bf16_t*)(ws + (dry ? WS_Y1 : WS_YM)), MODl + 2 * D};
                if (lastl) { pg8::DenseOrderT<true> S; S.init(ws + WS_SA, D, ws + WS_W_RGOUT + (size_t)j * 1024 * 1024 * 2, D, T, D, F.G, cid); pg8::gemm_phase(F.lds, S, E, D, D, D); }
                else { pg8::DenseOrder S; S.init(ws + WS_SA, D, ws + WS_W_RGOUT + (size_t)j * 1024 * 1024 * 2, D, T, D, F.G, cid); pg8::gemm_phase(F.lds, S, E, D, D, D); }
                router_fill(F, l); }  REPBAR } PH_END
        } else if (kind == 1) {
            PH_BEGIN PM(8) { const bool dry = rep_ > 1; (void)dry;  { pg8::DenseOrder S; S.init(ws + WS_H, D, ws + WS_W_QKV, D, T, 1536, F.G, cid);
                EpiQKV E{(bf16_t*)(ws + WS_QKV), inp(F, I_ATQG), inp(F, I_ATKG), (const float*)(ws + WS_ROPE), (LAS float*)(F.lds + RING_BYTES)}; pg8::gemm_phase(F.lds, S, E, D, D, D); }  REPBAR } PH_END
            PH_BEGIN PM(10) { const bool dry = rep_ > 1; (void)dry;  attn_phase(F);  REPBAR } PH_END
            PH_BEGIN PM(11) { const bool dry = rep_ > 1; (void)dry;  { pg8::DenseOrder S; S.init(ws + WS_AO, D, ws + WS_W_AO, D, T, D, F.G, cid);
                EpiResid E{(bf16_t*)(ws + (dry ? WS_Y1 : WS_YM)), MODl + 2 * D}; pg8::gemm_phase(F.lds, S, E, D, D, D); router_fill(F, l); }  REPBAR } PH_END
        } else {
            PH_BEGIN PM(12) { const bool dry = rep_ > 1; (void)dry;  { pg8::DenseOrder S; S.init(ws + WS_H, D, ws + WS_W_CMIN, D, T, 4096, F.G, cid);
                EpiCmIn E{(bf16_t*)(ws + WS_UVB), (f32x2*)(ws + WS_STATP)}; pg8::gemm_phase(F.lds, S, E, D, D, D); }  REPBAR } PH_END
            PH_BEGIN PM(13) { const bool dry = rep_ > 1; (void)dry;  spatial_phase(F);  REPBAR } PH_END
            PH_BEGIN PM(14) { const bool dry = rep_ > 1; (void)dry;  { pg8::DenseOrder S; S.init(ws + WS_UV, 2048, ws + WS_W_CMOUT, 2048, T, D, F.G, cid);
                EpiResid E{(bf16_t*)(ws + (dry ? WS_Y1 : WS_YM)), MODl + 2 * D}; pg8::gemm_phase(F.lds, S, E, 2048, 2048, 2048); router_fill(F, l); }  REPBAR } PH_END
        }
        PH_BEGIN PM(15) { const bool dry = rep_ > 1; (void)dry;  if (l == 0) norm_phase<true, 1, true>(F, l, inp(F, I_NFG) + l * D, 3, lastl, dry); else norm_phase<true, 1, false>(F, l, inp(F, I_NFG) + l * D, 3, lastl, dry);  REPBAR } PH_END
        PH_BEGIN PM(16) { const bool dry = rep_ > 1; (void)dry;  { const int ntile = moe_table(F, l, tab);
            const int units = ntile * 4, rounds = (units + F.G - 1) / F.G; int geff = F.G; if (false && rounds > 0) { geff = (((units + rounds - 1) / rounds) + 7) & ~7; if (geff > F.G) geff = F.G; }
            constexpr int EB = MOE_FP8 ? 1 : 2;
            MoeOrder<true> S{tab, (const char*)(ws + WS_H), (const char*)(ws + WS_W_E1 + (size_t)l * 32 * 1024 * 1024 * EB), (const int*)(ws + WS_BK2), geff, cid, units, (size_t)1024 * 1024 * EB, 1024 * EB, 1024 * EB};
            EpiMoe1 E{ws + WS_H1}; pg8::gemm_phase(F.lds, S, E, D * EB / 2, D * EB / 2, D * EB / 2); }  REPBAR } PH_END
        PH_BEGIN PM(17) { const bool dry = rep_ > 1; (void)dry;  { const int ntile = tab[32];
            const int units = ntile * 4, rounds = (units + F.G - 1) / F.G; int geff = F.G; if (false && rounds > 0) { geff = (((units + rounds - 1) / rounds) + 7) & ~7; if (geff > F.G) geff = F.G; }
            constexpr int EB = MOE_FP8 ? 1 : 2;
            MoeOrder<false> S{tab, (const char*)(ws + WS_H1), (const char*)(ws + WS_W_E2 + (size_t)l * 32 * 1024 * 512 * EB), (const int*)(ws + WS_BK2), geff, cid, units, (size_t)1024 * 512 * EB, 512 * EB, 512 * EB};
            EpiMoe2 E{(bf16_t*)(ws + (dry ? WS_SCR + 64 * MiB : WS_Y1)), (const int*)(ws + WS_BK2), tab}; pg8::gemm_phase(F.lds, S, E, DEXP * EB / 2, DEXP * EB / 2, DEXP * EB / 2); }  REPBAR } PH_END
    }
    { const int l_ = 0; PH_BEGIN PM(18) { const bool dry = rep_ > 1; (void)dry;  final_phase(F);  REPBAR if constexpr (((REP_MASK) >> 19) & 1u) { for (int k_ = 0; k_ < 20; ++k_) GRIDBAR } } PH_END }
#undef PH_BEGIN
#undef PH_END
}

extern "C" void kernel_launch(void* const* d_in, const int* in_sizes, int n_in, void* d_out, int out_size, void* d_ws, size_t ws_size, hipStream_t stream) {
    static int grid = 0;
    if (grid == 0) {
        if (n_in != 34 || out_size != NB * SEQ * D || ws_size < WS_END) { fprintf(stderr, "kernel_launch: bad shapes n_in %d out %d ws %zu (need %zu)\n", n_in, out_size, ws_size, (size_t)WS_END); grid = -1; return; }
        int dev = 0, cus = 0, per_cu = 0;
        if (hipGetDevice(&dev) != hipSuccess || hipDeviceGetAttribute(&cus, hipDeviceAttributeMultiprocessorCount, dev) != hipSuccess) { grid = -1; return; }
        if (hipFuncSetAttribute((const void*)mk_fwd, hipFuncAttributeMaxDynamicSharedMemorySize, LDS_BYTES) != hipSuccess) { fprintf(stderr, "kernel_launch: hipFuncSetAttribute failed\n"); grid = -1; return; }
        if (hipOccupancyMaxActiveBlocksPerMultiprocessor(&per_cu, (const void*)mk_fwd, 512, LDS_BYTES) != hipSuccess || per_cu < 1) { fprintf(stderr, "kernel_launch: occupancy query says %d\n", per_cu); (void)hipGetLastError(); grid = -1; return; }
        grid = cus;
    }
    if (grid < 0) return;
    (void)hipMemsetAsync((char*)d_ws + WS_CTL, 0, CTL_BYTES, stream);
    Args a{};
    for (int i = 0; i < 34; ++i) a.in[i] = (const float*)d_in[i];
    a.out = (float*)d_out; a.ws = (uchar*)d_ws;
#if MK_PER_PHASE
    for (int p = 0; p < NPHASE; ++p) { a.ph_lo = p; a.ph_hi = p + 1; hipLaunchKernelGGL(mk_fwd, dim3(grid), dim3(512), LDS_BYTES, stream, a); }
#else
    a.ph_lo = 0; a.ph_hi = NPHASE;
    void* kargs[] = {&a};
    hipError_t e = hipLaunchCooperativeKernel((const void*)mk_fwd, dim3(grid), dim3(512), kargs, LDS_BYTES, stream);
    if (e != hipSuccess) fprintf(stderr, "kernel_launch: cooperative launch failed: %s (grid %d)\n", hipGetErrorString(e), grid);
#endif
}
```

```cpp
#include <hip/hip_runtime.h>
#include <hip/hip_bf16.h>
#include <cstdio>
#include <cstdint>

#ifndef X_BF16
#define X_BF16 1
#endif
#ifndef Y_FP8
#define Y_FP8 1
#endif
#ifndef MOE_FP8
#define MOE_FP8 1
#endif
#ifndef MK_PER_PHASE
#define MK_PER_PHASE 0
#endif

#ifndef PHASE_MASK
#define PHASE_MASK 0xFFFFFFFFu
#endif
#ifndef DENSE_FP8
#define DENSE_FP8 30
#endif
constexpr bool F8_CMOUT = MOE_FP8 && (DENSE_FP8 & 8), F8_ATO = MOE_FP8 && (DENSE_FP8 & 16), F8_RGOUT = MOE_FP8 && (DENSE_FP8 & 32);
constexpr int RGO_SC = 4;
constexpr int ATO_SC = 64;
#ifndef REP_MASK
#define REP_MASK 0u
#endif
#define REPN(i) ((((REP_MASK) >> (i)) & 1u) ? 2 : 1)
#define PM(i) if constexpr ((PHASE_MASK >> (i)) & 1u) for (int rep_ = REPN(i); rep_ > 0; --rep_)
#define LAS __attribute__((address_space(3)))
#define GAS __attribute__((address_space(1)))
typedef unsigned char uchar;
typedef unsigned short bf16_t;
typedef short bf16x8 __attribute__((ext_vector_type(8)));
typedef short s16x4 __attribute__((ext_vector_type(4)));
typedef float f32x4 __attribute__((ext_vector_type(4)));
typedef float f32x2 __attribute__((ext_vector_type(2)));
typedef float f32x16 __attribute__((ext_vector_type(16)));
typedef unsigned u32x4 __attribute__((ext_vector_type(4)));
typedef unsigned u32x2 __attribute__((ext_vector_type(2)));
typedef GAS unsigned gu32;
#define RLX_AGENT __ATOMIC_RELAXED, __HIP_MEMORY_SCOPE_AGENT

constexpr int D = 1024, NB = 4, SEQ = 4096, CTX = 256, SB = SEQ + CTX, T = NB * SB, DEPTH = 4;
constexpr int NMODV = 6 * D;
constexpr int NEXP = 32, DEXP = 512;
constexpr int NCH = SB / 16;
constexpr float NORM_EPS = 1e-6f;

constexpr size_t MiB = 1u << 20;
constexpr size_t WS_CTL = 0, CTL_BYTES = 1 * MiB;
constexpr size_t WS_MOD = 1 * MiB;
constexpr size_t WS_ROPE = 2 * MiB;
constexpr size_t WS_RTR = 2 * MiB + 131072;
constexpr size_t WS_SPL = 2 * MiB + 65536;
constexpr size_t WS_BK2 = 3 * MiB;
constexpr size_t WS_TOT = 3 * MiB;
constexpr size_t WS_STATP = 8 * MiB;
constexpr size_t WS_BK = 13 * MiB;
constexpr size_t WS_TW = 15 * MiB + 512 * 1024;
constexpr size_t WS_W_RGIN = 16 * MiB, WS_W_RGG = 24 * MiB, WS_W_RGOUT = 26 * MiB, WS_W_QKV = 30 * MiB, WS_W_AO = 33 * MiB;
constexpr size_t WS_W_CMIN = 35 * MiB, WS_W_CMS = 43 * MiB, WS_W_CMOUT = 44 * MiB, WS_W_E1 = 48 * MiB, WS_W_E2 = 304 * MiB;
constexpr size_t WS_X = 432 * MiB, WS_Y1 = 500 * MiB, WS_H = 568 * MiB, WS_SCR = 602 * MiB;
constexpr size_t WS_GG = WS_SCR, WS_XB = WS_SCR + 34 * MiB, WS_XC = WS_SCR + 68 * MiB, WS_LA = WS_SCR + 102 * MiB, WS_BB = WS_SCR + 170 * MiB, WS_SA = WS_SCR + 238 * MiB;
constexpr size_t WS_QKV = WS_SCR, WS_AO = WS_SCR + 51 * MiB;
constexpr size_t WS_UVB = WS_SCR, WS_UV = WS_SCR + 136 * MiB;
constexpr size_t WS_H1 = WS_SCR;
constexpr size_t WS_TOTS = WS_SCR + 272 * MiB, WS_TOTH = WS_TOTS + 9 * MiB, WS_CARRY = WS_TOTH + 9 * MiB;
constexpr size_t WS_YM = WS_CARRY + 9 * MiB;
constexpr size_t WS_END = WS_YM + 34 * MiB;
constexpr int CW_TMO = 0, CW_BAR = 4096, CW_CNT = 16384;

constexpr int RING_BYTES = 131072;
constexpr int ROUTER_LDS = 36 * 1024 * 4;
constexpr int LDSCTL_OFF = 147456;
constexpr int LDS_BYTES = LDSCTL_OFF + 1024 + 8 * 4 * 80 * 4;

typedef float f32x2_t_ __attribute__((ext_vector_type(2))); typedef __bf16 bf16x2_t_ __attribute__((ext_vector_type(2)));
__device__ __forceinline__ unsigned pk2(float lo, float hi) { const f32x2_t_ v = {lo, hi}; const bf16x2_t_ b = __builtin_convertvector(v, bf16x2_t_); return __builtin_bit_cast(unsigned, b); }
__device__ __forceinline__ unsigned f2bf(float f) { return pk2(f, 0.f) & 0xffffu; }
__device__ __forceinline__ float bf2f(unsigned short h) { return __builtin_bit_cast(float, (unsigned)h << 16); }
__device__ __forceinline__ float bflo(unsigned w) { return __builtin_bit_cast(float, w << 16); }
__device__ __forceinline__ float bfhi(unsigned w) { return __builtin_bit_cast(float, w & 0xffff0000u); }
__device__ __forceinline__ unsigned cvt_pk_bf16(float lo, float hi) { return pk2(lo, hi); }
__device__ __forceinline__ f32x4 fp8x4_to_f32(unsigned w) { const f32x2 lo = __builtin_amdgcn_cvt_pk_f32_fp8((int)w, false), hi = __builtin_amdgcn_cvt_pk_f32_fp8((int)w, true); return (f32x4){lo.x, lo.y, hi.x, hi.y}; }
__device__ __forceinline__ float gelu_tanh(float x) { const float x2 = x * x; const float u2 = x * __builtin_fmaf(x2, -0.1029432395800235f, -2.302208198144325f); return x * __builtin_amdgcn_rcpf(1.f + __builtin_amdgcn_exp2f(u2)); }
__device__ __forceinline__ float sigmoidf_(float x) { return 1.f / (1.f + __expf(-x)); }
__device__ __forceinline__ float clamp8(float v) { return __builtin_amdgcn_fmed3f(v, -448.f, 448.f); }
__device__ __forceinline__ f32x4 vexp2(f32x4 v) { return (f32x4){__builtin_amdgcn_exp2f(v.x), __builtin_amdgcn_exp2f(v.y), __builtin_amdgcn_exp2f(v.z), __builtin_amdgcn_exp2f(v.w)}; }
__device__ __forceinline__ f32x4 vrcp(f32x4 v) { return (f32x4){__builtin_amdgcn_rcpf(v.x), __builtin_amdgcn_rcpf(v.y), __builtin_amdgcn_rcpf(v.z), __builtin_amdgcn_rcpf(v.w)}; }
__device__ __forceinline__ f32x4 vsqrt(f32x4 v) { return (f32x4){__builtin_amdgcn_sqrtf(v.x), __builtin_amdgcn_sqrtf(v.y), __builtin_amdgcn_sqrtf(v.z), __builtin_amdgcn_sqrtf(v.w)}; }
__device__ __forceinline__ float fast_sigmoid(float x) { return __builtin_amdgcn_rcpf(1.f + __expf(-x)); }
__device__ __forceinline__ float one_minus_exp(float y) {   const float p = y * (1.f - y * (0.5f - y * (0.16666667f - y * 0.041666667f))); const float q = 1.f - __expf(-y); return y < 0.0625f ? p : q; }
__device__ __forceinline__ int sidx_of_row(int row) { const int b = row / SB; return (row - b * SB) < CTX ? 4 : b; }

namespace pg8 {
constexpr int BM = 256, BK = 64, HALF = 128, HTB = HALF * BK * 2, NXCD = 8, WGM = 8;
__device__ __forceinline__ int lds_byte(int r, int c) { const int st = (r >> 4) * 2 + (c >> 5), rr = r & 15, cc = c & 31, ob = rr * 64 + cc * 2; return st * 1024 + (ob ^ (((ob >> 9) & 1) << 5)); }
__device__ __forceinline__ void stage_rc(int b, int& R, int& C) { const int st = b / 1024, sb = b % 1024, swz = sb ^ (((sb >> 9) & 1) << 5); R = (st >> 1) * 16 + swz / 64; C = (st & 1) * 32 + (swz % 64) / 2; }
__device__ __forceinline__ int perm32(int rho) { const int n = rho >> 4, i = rho & 15; return 8 * (i >> 2) + 4 * n + (i & 3); }
struct Unit { const char* a; const char* b; int pm, pn, aux0, aux1, hm; };
__device__ __forceinline__ const char* uptr(const char* p) { const unsigned long long v = (unsigned long long)p; const unsigned lo = __builtin_amdgcn_readfirstlane((unsigned)v), hi = __builtin_amdgcn_readfirstlane((unsigned)(v >> 32)); return (const char*)(const GAS char*)(((unsigned long long)hi << 32) | lo); }
__device__ __forceinline__ bool unit_slot(int i, int c, int G, int nwg, int& L, int& hm) {
    if (c >= G) return false;
    const int nfull = nwg / G, rem = nwg - nfull * G;
    if (i < nfull) { L = i * G + c; hm = 0xF; return true; }
    if (i > nfull || rem == 0) return false;
    if (rem * 2 <= G) { if (c >= 2 * rem) return false; L = nfull * G + (c >> 1); hm = (c & 1) ? 0xC : 0x3; return true; }
    if (c >= rem) return false; L = nfull * G + c; hm = 0xF; return true; }
__device__ __forceinline__ int xcd_remap(int L, int nwg) { const int q = nwg / NXCD, r = nwg % NXCD, xcd = L % NXCD, off = L / NXCD; return (xcd < r ? xcd * (q + 1) : r * (q + 1) + (xcd - r) * q) + off; }

template <bool LATENT>
struct DenseOrderT {
    static constexpr bool GATHER = false;
    const char* A; const char* B; int nM, nN, nwg, G, c; size_t tA, tB; int amask, acol;
    __device__ void init(const void* A_, int lda, const void* B_, int ldb, int M, int N, int G_, int c_, int amask_ = 0, int acol_ = 0) {
        A = (const char*)A_; B = (const char*)B_; nM = LATENT ? 64 : M / BM; nN = N / BM; nwg = nM * nN; G = G_; c = c_; tA = (size_t)BM * lda * 2; tB = (size_t)BM * ldb * 2; amask = amask_; acol = acol_; }
    __device__ bool next(int i, Unit& u) const {
        int L, hm; if (!unit_slot(i, c, G, nwg, L, hm)) return false; u.hm = __builtin_amdgcn_readfirstlane(hm);
        const int wgid = xcd_remap(L, nwg);
        const int nig = WGM * nN, gid = wgid / nig, fm = gid * WGM, gsz = (nM - fm) < WGM ? (nM - fm) : WGM;
        int pm_ = fm + ((wgid % nig) % gsz); if constexpr (LATENT) pm_ = (pm_ >> 4) * 17 + 1 + (pm_ & 15);
        u.pm = __builtin_amdgcn_readfirstlane(pm_); u.pn = __builtin_amdgcn_readfirstlane((wgid % nig) / gsz); u.aux0 = 0; u.aux1 = 0;
        u.a = uptr(A + (size_t)u.pm * tA + (size_t)(u.pn & amask) * acol); u.b = uptr(B + (size_t)u.pn * tB); return true; }
    __device__ unsigned goff(const Unit&, int) const { return 0u; }
    __device__ const int* gaddr(const Unit&, int) const { return nullptr; }
    __device__ unsigned graw2off(unsigned) const { return 0u; }
};
typedef DenseOrderT<false> DenseOrder;

#define PG8_SA(b, h) (((b) * 2 + (h)) * HTB)
#define PG8_SB(b, h) ((4 + (b) * 2 + (h)) * HTB)
__device__ __forceinline__ void glds16(const char* sbase, unsigned voff, unsigned ldsaddr) { unsigned keep;
    asm volatile("s_mov_b32 %0, m0\n\ts_mov_b32 m0, %3\n\ts_nop 0\n\tglobal_load_lds_dwordx4 %1, %2\n\ts_mov_b32 m0, %0" : "=&s"(keep) : "v"(voff), "s"(sbase), "s"(ldsaddr) : "memory"); }
#ifndef PG8_ASM_DMA
#define PG8_ASM_DMA 1
#endif
#if PG8_ASM_DMA
#define PG8_GLDS(gp, voff, ldsoff) glds16((const char*)(gp), (voff), ldsbase + (unsigned)(ldsoff))
#else
#define PG8_GLDS(gp, voff, ldsoff) __builtin_amdgcn_global_load_lds((const unsigned*)((const char*)(gp) + (voff)), (LAS unsigned*)(lds + (ldsoff)), 16, 0, 0)
#endif
#define PG8_STAGE_B(bufoff, gbase) do { PG8_GLDS(gbase, voffB[0], (bufoff) + ldsw); PG8_GLDS(gbase, voffB[1], (bufoff) + ldsw + 8192); } while (0)
#define PG8_STAGE_A(bufoff, gbase, h, NX) do { if constexpr (Sched::GATHER) { \
        PG8_GLDS(gbase, ((NX) ? vAn[h][0] : vAc[h][0]), (bufoff) + ldsw); PG8_GLDS(gbase, ((NX) ? vAn[h][1] : vAc[h][1]), (bufoff) + ldsw + 8192); \
    } else { PG8_GLDS((const char*)(gbase) + (h) * hstepA, voffA[0], (bufoff) + ldsw); PG8_GLDS((const char*)(gbase) + (h) * hstepA, voffA[1], (bufoff) + ldsw + 8192); } } while (0)
#define PG8_LDA(dst, b, h) do { _Pragma("unroll") for (int m = 0; m < 4; ++m) _Pragma("unroll") for (int k = 0; k < 2; ++k) dst[m][k] = *(const LAS bf16x8*)(lds + PG8_SA(b, h) + aoff + m * 2048 + k * 1024); } while (0)
#define PG8_LDB(dst, b, h) do { _Pragma("unroll") for (int n = 0; n < 2; ++n) _Pragma("unroll") for (int k = 0; k < 2; ++k) dst[n][k] = *(const LAS bf16x8*)(lds + PG8_SB(b, h) + boff + n * 2048 + k * 1024); } while (0)
typedef int i32x8 __attribute__((ext_vector_type(8))); typedef int i32x4v __attribute__((ext_vector_type(4)));
__device__ __forceinline__ i32x8 cat8(bf16x8 lo, bf16x8 hi) { return __builtin_shufflevector(__builtin_bit_cast(i32x4v, lo), __builtin_bit_cast(i32x4v, hi), 0, 1, 2, 3, 4, 5, 6, 7); }
#define PG8_MMA(ai, bj, At, Bt) do { __builtin_amdgcn_s_setprio(1); _Pragma("unroll") for (int m = 0; m < 4; ++m) _Pragma("unroll") for (int n = 0; n < 2; ++n) { \
        if constexpr (Epi::FP8) { asm volatile("v_mfma_scale_f32_16x16x128_f8f6f4 %0, %1, %2, %0, %3, %3 op_sel_hi:[0,0,0]" : "+v"(acc[ai][bj][m][n]) : "v"(cat8(Bt[n][0], Bt[n][1])), "v"(cat8(At[m][0], At[m][1])), "v"(0x7F7F7F7F)); } \
        else { _Pragma("unroll") for (int k = 0; k < 2; ++k) acc[ai][bj][m][n] = __builtin_amdgcn_mfma_f32_16x16x32_bf16(Bt[n][k], At[m][k], acc[ai][bj][m][n], 0, 0, 0); } } __builtin_amdgcn_s_setprio(0); } while (0)
#define PG8_WAIT_V(n) asm volatile("s_waitcnt vmcnt(" #n ")" ::: "memory")
#define PG8_WAIT_L(n) asm volatile("s_waitcnt lgkmcnt(" #n ")" ::: "memory")
#define PG8_BAR __builtin_amdgcn_s_barrier()
#define PG8_SCHED __builtin_amdgcn_sched_barrier(0)

template <class Epi, class Sched>
__device__ __forceinline__ void gemm_phase(LAS uchar* lds, const Sched& S, const Epi& E, const int K, const int lda, const int ldb) {
    int tid = threadIdx.x; asm volatile("" : "+v"(tid));
    const int wid = __builtin_amdgcn_readfirstlane(tid >> 6), lane = tid & 63, wr = wid >> 2, wc = wid & 3; int fr = lane & 15, fq = lane >> 4;
    int nt = K / BK; asm volatile("" : "+s"(nt));
    unsigned voffA[2], voffB[2];
#pragma unroll
    for (int i = 0; i < 2; ++i) { int R, C; stage_rc(tid * 16 + i * 8192, R, C); const int Rb = Epi::PERM ? ((R & ~31) + perm32(R & 31)) : R;
        voffA[i] = (unsigned)(R * lda + C) * 2u; voffB[i] = (unsigned)(Rb * ldb + C) * 2u; }
    const size_t kstep = (size_t)(BK * 2);
    const size_t hstepA = (size_t)HALF * lda * 2, hstepB = (size_t)HALF * ldb * 2;
    const unsigned ldsw = (unsigned)wid * 1024u;
    const unsigned ldsbase = (unsigned)(uintptr_t)lds;
    const int aoff = lds_byte(wr * 64 + fr, fq * 8), boff = lds_byte(wc * 32 + fr, fq * 8);
    Unit cur, nxt; int ui = 0;
    if (!S.next(0, cur)) return;
    unsigned vAc[2][2], vAn[2][2];
#pragma unroll
    for (int h = 0; h < 2; ++h)
#pragma unroll
        for (int i = 0; i < 2; ++i) { vAc[h][i] = 0u; vAn[h][i] = 0u; }
    if constexpr (Sched::GATHER) {
#pragma unroll
        for (int h = 0; h < 2; ++h)
#pragma unroll
            for (int i = 0; i < 2; ++i) { int R, C; stage_rc(tid * 16 + i * 8192, R, C); vAc[h][i] = S.goff(cur, h * HALF + R) + (unsigned)C * 2u; }
    }
    f32x4 acc[2][2][4][2];
#pragma unroll
    for (int a = 0; a < 2; ++a)
#pragma unroll
        for (int b = 0; b < 2; ++b)
#pragma unroll
            for (int m = 0; m < 4; ++m)
#pragma unroll
                for (int n = 0; n < 2; ++n) acc[a][b][m][n] = (f32x4){0.f, 0.f, 0.f, 0.f};
    bf16x8 At[4][2], B0[2][2], B1[2][2];
    typedef int pre_t __attribute__((ext_vector_type(16))); pre_t pre = {};
    if constexpr (Epi::PREFETCH) pre = E.prefetch(cur, wr, fr);
    const char* cA = cur.a; const char* cB = cur.b;
    PG8_STAGE_B(PG8_SB(0, 0), cB); PG8_STAGE_B(PG8_SB(0, 1), cB + hstepB); PG8_STAGE_A(PG8_SA(0, 0), cA, 0, false); PG8_STAGE_A(PG8_SA(0, 1), cA, 1, false);
    if (wr == 1) PG8_BAR;
    PG8_WAIT_V(2); PG8_BAR;
    PG8_STAGE_B(PG8_SB(1, 0), cB + kstep); PG8_STAGE_A(PG8_SA(1, 0), cA + kstep, 0, false); PG8_STAGE_B(PG8_SB(1, 1), cB + hstepB + kstep);
    PG8_WAIT_V(6); PG8_BAR;
    for (;;) {
        const bool has_next = S.next(ui + 1, nxt);
        unsigned graw[4] = {0u, 0u, 0u, 0u};
        if constexpr (Sched::GATHER) { if (has_next) {
#pragma unroll
            for (int h = 0; h < 2; ++h)
#pragma unroll
                for (int i = 0; i < 2; ++i) { int R, C; int t2 = tid; asm volatile("" : "+v"(t2)); stage_rc(t2 * 16 + i * 8192, R, C); const int* ga = S.gaddr(nxt, h * HALF + R);
                    asm volatile("global_load_dword %0, %1, off nt" : "=v"(graw[h * 2 + i]) : "v"(ga) : "memory"); } } }
        const char* nA = has_next ? nxt.a : cA; const char* nB = has_next ? nxt.b : cB;
        for (int t = 0; t < nt; t += 2) {
            const bool last = (t == nt - 2);
            const bool nx = last && has_next;
            if constexpr (Sched::GATHER) { if (nx) { const u32x4 pk_ = *(const LAS u32x4*)(lds + 131072 + tid * 16); vAn[0][0] = pk_.x; vAn[0][1] = pk_.y; vAn[1][0] = pk_.z; vAn[1][1] = pk_.w; } }
            const char* a1 = cA + (size_t)(t + 1) * kstep;
            const char* a2 = last ? nA : cA + (size_t)(t + 2) * kstep; const char* b2 = last ? nB : cB + (size_t)(t + 2) * kstep;
            const char* a3 = a2 + kstep; const char* b3 = b2 + kstep;
            PG8_LDB(B0, 0, 0); PG8_LDB(B1, 0, 1); PG8_SCHED; PG8_LDA(At, 0, 0); PG8_STAGE_A(PG8_SA(1, 1), a1, 1, false);
            PG8_WAIT_V(8); PG8_WAIT_L(0); PG8_BAR; if (cur.hm & 1) { PG8_MMA(0, 0, At, B0); PG8_MMA(0, 1, At, B1); } PG8_BAR; PG8_SCHED;
            PG8_LDA(At, 0, 1); PG8_STAGE_B(PG8_SB(0, 0), b2); PG8_STAGE_B(PG8_SB(0, 1), b2 + hstepB); PG8_STAGE_A(PG8_SA(0, 0), a2, 0, nx);
            PG8_WAIT_V(8); PG8_WAIT_L(0); PG8_BAR; if (cur.hm & 4) { PG8_MMA(1, 0, At, B0); PG8_MMA(1, 1, At, B1); } PG8_BAR; PG8_SCHED;
            if constexpr (Sched::GATHER) { if (t == 0 && has_next) {
                asm volatile("" : "+v"(graw[0]), "+v"(graw[1]), "+v"(graw[2]), "+v"(graw[3]));
                u32x4 pk_;
#pragma unroll
                for (int q = 0; q < 4; ++q) { int R, C; int t2 = tid; asm volatile("" : "+v"(t2)); stage_rc(t2 * 16 + (q & 1) * 8192, R, C); pk_[q] = S.graw2off(graw[q]) + (unsigned)C * 2u; }
                *(LAS u32x4*)(lds + 131072 + tid * 16) = pk_; PG8_SCHED; } }
            PG8_LDB(B0, 1, 0); PG8_LDB(B1, 1, 1); PG8_SCHED; PG8_LDA(At, 1, 0); PG8_STAGE_A(PG8_SA(0, 1), a2, 1, nx);
            PG8_WAIT_V(8); PG8_WAIT_L(0); PG8_BAR; if (cur.hm & 1) { PG8_MMA(0, 0, At, B0); PG8_MMA(0, 1, At, B1); } PG8_BAR; PG8_SCHED;
            PG8_LDA(At, 1, 1); PG8_STAGE_B(PG8_SB(1, 0), b3); PG8_STAGE_B(PG8_SB(1, 1), b3 + hstepB); PG8_STAGE_A(PG8_SA(1, 0), a3, 0, nx);
            PG8_WAIT_V(8); PG8_WAIT_L(0); PG8_BAR; if (cur.hm & 4) { PG8_MMA(1, 0, At, B0); PG8_MMA(1, 1, At, B1); } PG8_BAR; PG8_SCHED;
        }
        if (wr == 0) PG8_BAR;
        if constexpr (Epi::FP8) asm volatile("s_nop 15\n\ts_nop 15" ::: "memory");
        if constexpr (Epi::PREFETCH) E(acc, cur, wr, wc, fr, fq, pre); else E(acc, cur, wr, wc, fr, fq);
        if (!has_next) break;
#pragma unroll
        for (int a = 0; a < 2; ++a)
#pragma unroll
            for (int b = 0; b < 2; ++b)
#pragma unroll
                for (int m = 0; m < 4; ++m)
#pragma unroll
                    for (int n = 0; n < 2; ++n) acc[a][b][m][n] = (f32x4){0.f, 0.f, 0.f, 0.f};
        cur = nxt; cA = nA; cB = nB; ++ui;
        if constexpr (Epi::PREFETCH) pre = E.prefetch(cur, wr, fr);
        if constexpr (Sched::GATHER) {
#pragma unroll
            for (int h = 0; h < 2; ++h)
#pragma unroll
                for (int i = 0; i < 2; ++i) vAc[h][i] = vAn[h][i]; }
        if (wr == 1) PG8_BAR;
    }
    PG8_WAIT_V(0);
    PG8_BAR;
}
}

#ifndef ATT_SDEPTH
#define ATT_SDEPTH 1
#endif
namespace att {
constexpr int NW = 8, QBLK = 32, KVBLK = 64;
constexpr float SCALE = 0.088388347648318440f;
constexpr float THR = 8.f;
constexpr int LDQ = 1536, LDK = 1536, LDO = 1024;
constexpr size_t SHM_V = KVBLK * 128 * 2, SHM_K = KVBLK * 128 * 2, SHM_ATTN = 2 * SHM_V + 2 * SHM_K + NW * 64 * 4;
#define KSWZ(row, colB) ((row) * 256 + ((colB) ^ (((row) & 7) << 4)))
#define SBAR() __builtin_amdgcn_sched_barrier(0)
__device__ __forceinline__ int crow(int r, int hi) { return (r & 3) + 8 * (r >> 2) + 4 * hi; }
__device__ __forceinline__ void partialSM(f32x16& p0, f32x16& p1, float& m_reg, float& mn, float& alpha) {
  constexpr float C = SCALE * 1.4426950408889634f;
  float pmax = p0[0];
#pragma unroll
  for (int r = 1; r < 16; ++r) pmax = fmaxf(pmax, p0[r]);
#pragma unroll
  for (int r = 0; r < 16; ++r) pmax = fmaxf(pmax, p1[r]);
  { auto rr = __builtin_amdgcn_permlane32_swap(__float_as_uint(pmax), __float_as_uint(pmax), false, false);
    pmax = fmaxf(__uint_as_float(rr[0]), __uint_as_float(rr[1])); }
  if (__builtin_expect(__all(pmax - m_reg <= THR / SCALE), 1)) { mn = m_reg; alpha = 1.f; }
  else { mn = fmaxf(m_reg, pmax); alpha = __builtin_amdgcn_exp2f((m_reg - mn) * C); m_reg = mn; }
  float mnC = -mn * C;
#pragma unroll
  for (int r = 0; r < 16; ++r) p0[r] = fmaf(p0[r], C, mnC);
#pragma unroll
  for (int r = 0; r < 16; ++r) p1[r] = fmaf(p1[r], C, mnC);
#pragma unroll
  for (int r = 0; r < 16; ++r) p0[r] = __builtin_amdgcn_exp2f(p0[r]);
}
__device__ __forceinline__ void finishSM(f32x16& p0, f32x16& p1, float alpha, float& l_reg, bf16x8& pa0, bf16x8& pa1, bf16x8& pa2, bf16x8& pa3) {
#pragma unroll
  for (int r = 0; r < 16; ++r) p1[r] = __builtin_amdgcn_exp2f(p1[r]);
  float ps = 0;
#pragma unroll
  for (int r = 0; r < 16; ++r) ps += p0[r];
#pragma unroll
  for (int r = 0; r < 16; ++r) ps += p1[r];
  { auto rr = __builtin_amdgcn_permlane32_swap(__float_as_uint(ps), __float_as_uint(ps), false, false);
    ps = __uint_as_float(rr[0]) + __uint_as_float(rr[1]); }
  l_reg = l_reg * alpha + ps;
#define PK4(P, BASE, OUT) do { unsigned a0 = cvt_pk_bf16(P[BASE + 0], P[BASE + 1]), a1 = cvt_pk_bf16(P[BASE + 2], P[BASE + 3]);   \
    unsigned b0 = cvt_pk_bf16(P[BASE + 4], P[BASE + 5]), b1 = cvt_pk_bf16(P[BASE + 6], P[BASE + 7]);                              \
    auto r0 = __builtin_amdgcn_permlane32_swap(a0, b0, false, false); auto r1 = __builtin_amdgcn_permlane32_swap(a1, b1, false, false); \
    u32x4 w = {r0[0], r1[0], r0[1], r1[1]}; OUT = __builtin_bit_cast(bf16x8, w); } while (0)
  PK4(p0, 0, pa0); PK4(p0, 8, pa1); PK4(p1, 0, pa2); PK4(p1, 8, pa3);
#undef PK4
}
__device__ __forceinline__ void qkt(f32x16& p0, f32x16& p1, const bf16_t* Ks, const bf16x8* qr, int r32, int hi) {
  p0 = f32x16{}; p1 = f32x16{};
#pragma unroll
  for (int d0 = 0; d0 < 8; ++d0) { int cb = (d0 * 16 + hi * 8) * 2;
    bf16x8 b0 = *reinterpret_cast<const bf16x8*>((const char*)Ks + KSWZ(r32, cb));
    bf16x8 b1 = *reinterpret_cast<const bf16x8*>((const char*)Ks + KSWZ(32 + r32, cb));
    p0 = __builtin_amdgcn_mfma_f32_32x32x16_bf16(b0, qr[d0], p0, 0, 0, 0);
    p1 = __builtin_amdgcn_mfma_f32_32x32x16_bf16(b1, qr[d0], p1, 0, 0, 0); }
}
__device__ __forceinline__ int v_st(int k, int c) { const int kk = (k & ~0xC) | ((k & 4) << 1) | ((k & 8) >> 1); return ((kk >> 3) * 4 + (c >> 5)) * 512 + ((kk & 7) * 32 + (c & 31)) * 2; }
__device__ __forceinline__ int v_rd_base(int lane) { return ((lane & 3) << 3) | (((lane >> 2) & 3) << 6) | (((lane >> 4) & 1) << 5) | (((lane >> 5) & 1) << 8); }
constexpr int v_rd_off(int d0, int ks, int half) { return d0 * 512 + ks * 4096 + half * 2048; }
template <int OFF> __device__ __forceinline__ s16x4 tr_read(int vb) {
  s16x4 r; asm volatile("ds_read_b64_tr_b16 %0, %1 offset:%2" : "=&v"(r) : "v"(vb), "i"(OFF) : "memory"); return r;
}
template <int D0> __device__ __forceinline__ void pv_one(f32x16& od, int vb, bf16x8 pa0, bf16x8 pa1, bf16x8 pa2, bf16x8 pa3) {
  const s16x4 l0 = tr_read<v_rd_off(D0, 0, 0)>(vb), h0 = tr_read<v_rd_off(D0, 0, 1)>(vb), l1 = tr_read<v_rd_off(D0, 1, 0)>(vb), h1 = tr_read<v_rd_off(D0, 1, 1)>(vb);
  const s16x4 l2 = tr_read<v_rd_off(D0, 2, 0)>(vb), h2 = tr_read<v_rd_off(D0, 2, 1)>(vb), l3 = tr_read<v_rd_off(D0, 3, 0)>(vb), h3 = tr_read<v_rd_off(D0, 3, 1)>(vb);
  asm volatile("s_waitcnt lgkmcnt(0)" ::: "memory"); SBAR();
#define PK(L, H) (bf16x8){L[0], L[1], L[2], L[3], H[0], H[1], H[2], H[3]}
  od = __builtin_amdgcn_mfma_f32_32x32x16_bf16(pa0, PK(l0, h0), od, 0, 0, 0);
  od = __builtin_amdgcn_mfma_f32_32x32x16_bf16(pa1, PK(l1, h1), od, 0, 0, 0);
  od = __builtin_amdgcn_mfma_f32_32x32x16_bf16(pa2, PK(l2, h2), od, 0, 0, 0);
  od = __builtin_amdgcn_mfma_f32_32x32x16_bf16(pa3, PK(l3, h3), od, 0, 0, 0);
#undef PK
}
__device__ __forceinline__ void pv_d0(f32x16* o, int vb, bf16x8 pa0, bf16x8 pa1, bf16x8 pa2, bf16x8 pa3) {
  pv_one<0>(o[0], vb, pa0, pa1, pa2, pa3); pv_one<1>(o[1], vb, pa0, pa1, pa2, pa3); pv_one<2>(o[2], vb, pa0, pa1, pa2, pa3); pv_one<3>(o[3], vb, pa0, pa1, pa2, pa3);
}
__device__ __forceinline__ void attn_dense_body(const bf16_t* Qb, const bf16_t* Kh, const bf16_t* Vh, bf16_t* Ob, int seq, char* lds, const int tid) {
  const int wid = tid >> 6, lane = tid & 63, r32 = lane & 31, hi = lane >> 5;
  bf16_t* V_lds = (bf16_t*)lds; bf16_t* K_lds = (bf16_t*)(lds + 2 * SHM_V);
  float* ws = (float*)(lds + 2 * SHM_V + 2 * SHM_K) + wid * 64; float* li_l = ws; float* al_l = ws + 32;
  float m_reg = -1e30f, l_reg = 0; f32x16 o[4] = {}; bf16x8 qr[8];
  const bf16_t* Qw = Qb + (long)(wid * QBLK + r32) * LDQ + hi * 8;
#pragma unroll
  for (int d0 = 0; d0 < 8; ++d0) qr[d0] = *reinterpret_cast<const bf16x8*>(Qw + d0 * 16);
  const int sr = tid >> 4, sc = (tid & 15) * 8, vst0 = v_st(sr, sc), vst1 = v_st(32 + sr, sc);
  const int vb0 = (int)(uintptr_t)V_lds + v_rd_base(lane);
  struct { bf16x8 vs0, vs1, ks0, ks1; } sr_[ATT_SDEPTH];
  const unsigned vo0 = (unsigned)(sr * LDK + sc) * 2u, vo1 = (unsigned)((32 + sr) * LDK + sc) * 2u;
  const long vdelta = (const char*)Vh - (const char*)Kh;
#define SLOAD(i, k0) do { const char* kb_ = (const char*)Kh + (size_t)(k0) * (LDK * 2); const char* vb_ = kb_ + vdelta; \
    sr_[i].vs0 = *reinterpret_cast<const bf16x8*>(vb_ + vo0); sr_[i].vs1 = *reinterpret_cast<const bf16x8*>(vb_ + vo1); \
    sr_[i].ks0 = *reinterpret_cast<const bf16x8*>(kb_ + vo0); sr_[i].ks1 = *reinterpret_cast<const bf16x8*>(kb_ + vo1); } while (0)
#define SWRITE(b, i) do { *(bf16x8*)((char*)V_lds + (b) * SHM_V + vst0) = sr_[i].vs0;          \
    *(bf16x8*)((char*)V_lds + (b) * SHM_V + vst1) = sr_[i].vs1; int kc = sc * 2;               \
    *(bf16x8*)((char*)K_lds + (b) * SHM_K + KSWZ(sr, kc)) = sr_[i].ks0;                       \
    *(bf16x8*)((char*)K_lds + (b) * SHM_K + KSWZ(32 + sr, kc)) = sr_[i].ks1; } while (0)
#define SWAIT() do { if constexpr (ATT_SDEPTH == 2) asm volatile("s_waitcnt vmcnt(4)" ::: "memory"); else asm volatile("s_waitcnt vmcnt(0)" ::: "memory"); } while (0)
#define RESC(a) do { if (__any((a) < 1.f)) { if (hi == 0) al_l[r32] = (a); asm volatile("s_waitcnt lgkmcnt(0)" ::: "memory"); \
    _Pragma("unroll") for (int d = 0; d < 4; ++d) _Pragma("unroll") for (int r = 0; r < 16; ++r) o[d][r] *= al_l[crow(r, hi)]; } } while (0)
  f32x16 pA0, pA1, pB0, pB1; float mnA, mnB, alA, alB; bf16x8 pa0, pa1, pa2, pa3; const int NT = seq / KVBLK;
  constexpr int SE = 0, SO = ATT_SDEPTH - 1;
  SLOAD(SE, 0); asm volatile("s_waitcnt vmcnt(0)" ::: "memory"); SWRITE(0, SE); __syncthreads();
  qkt(pA0, pA1, K_lds, qr, r32, hi); partialSM(pA0, pA1, m_reg, mnA, alA);
  SLOAD(SO, KVBLK); if constexpr (ATT_SDEPTH == 2) { if (2 < NT) SLOAD(SE, 2 * KVBLK); }
  SWAIT(); SWRITE(1, SO); __syncthreads();
  for (int j = 1; j + 1 < NT; j += 2) {
    SBAR(); qkt(pB0, pB1, (bf16_t*)((char*)K_lds + SHM_K), qr, r32, hi);
    finishSM(pA0, pA1, alA, l_reg, pa0, pa1, pa2, pa3); SBAR();
    SLOAD(SO, (j + ATT_SDEPTH) * KVBLK); SBAR();
    pv_d0(o, vb0, pa0, pa1, pa2, pa3); partialSM(pB0, pB1, m_reg, mnB, alB);
    __syncthreads(); SWAIT(); SWRITE(0, SE);
    RESC(alB); __syncthreads();
    SBAR(); qkt(pA0, pA1, K_lds, qr, r32, hi);
    finishSM(pB0, pB1, alB, l_reg, pa0, pa1, pa2, pa3); SBAR();
    if (ATT_SDEPTH == 1 || j + 3 < NT) SLOAD(SE, (j + 1 + ATT_SDEPTH) * KVBLK); SBAR();
    pv_d0(o, vb0 + (int)SHM_V, pa0, pa1, pa2, pa3); partialSM(pA0, pA1, m_reg, mnA, alA);
    __syncthreads(); SWAIT(); SWRITE(1, SO);
    RESC(alA); __syncthreads();
  }
  SBAR(); qkt(pB0, pB1, (bf16_t*)((char*)K_lds + SHM_K), qr, r32, hi);
  finishSM(pA0, pA1, alA, l_reg, pa0, pa1, pa2, pa3); SBAR();
  pv_d0(o, vb0, pa0, pa1, pa2, pa3); partialSM(pB0, pB1, m_reg, mnB, alB);
  __syncthreads(); RESC(alB);
  finishSM(pB0, pB1, alB, l_reg, pa0, pa1, pa2, pa3); SBAR();
  pv_d0(o, vb0 + (int)SHM_V, pa0, pa1, pa2, pa3);
  if (hi == 0) li_l[r32] = l_reg; asm volatile("s_waitcnt lgkmcnt(0)" ::: "memory");
  float rli[16];
#pragma unroll
  for (int r = 0; r < 16; ++r) rli[r] = __builtin_amdgcn_rcpf(li_l[crow(r, hi)]) * (F8_ATO ? (float)ATO_SC : 1.f);
  bf16_t* Ow = Ob + (long)(wid * QBLK) * LDO; uchar* Ow8 = (uchar*)Ob + (long)(wid * QBLK) * LDO + r32; (void)Ow; (void)Ow8;
#pragma unroll
  for (int r = 0; r < 16; ++r) { int orow = crow(r, hi);
#pragma unroll
    for (int d0 = 0; d0 < 4; ++d0) {
      if constexpr (F8_ATO) { const float v_ = clamp8(o[d0][r] * rli[r]); Ow8[(long)orow * LDO + d0 * 32] = (uchar)__builtin_amdgcn_cvt_pk_fp8_f32(v_, v_, 0, false); }
      else Ow[(long)orow * LDO + d0 * 32 + r32] = (bf16_t)f2bf(o[d0][r] * rli[r]); } }
#undef SLOAD
#undef SWRITE
#undef SWAIT
#undef RESC
}
}

#define XB_TMO      128
#define XB_XCNT(j)  (256  + 64 * (j))
#define XB_XSUB(j)  (1280 + 64 * (j))
#define XB_XGEN(j)  (2304 + 64 * (j))
#define XB_TOP      3328
#define XB_TOPGEN   3392
#define XB_SPIN_CAP (1u << 22)
__device__ __forceinline__ unsigned xb_ld(unsigned* p)              { return __hip_atomic_load(p, __ATOMIC_RELAXED, __HIP_MEMORY_SCOPE_AGENT); }
__device__ __forceinline__ unsigned xb_add(unsigned* p, unsigned v) { return __hip_atomic_fetch_add(p, v, __ATOMIC_RELAXED, __HIP_MEMORY_SCOPE_AGENT); }
__device__ __forceinline__ unsigned xb_xcc_id() { return (unsigned)__builtin_amdgcn_s_getreg((3 << 11) | 20) & 0xFu; }
#define XB_SPIN(cond, bar) do { unsigned _sp = 0; while (cond) { __builtin_amdgcn_s_sleep(1); \
    if ((++_sp & 255u) == 0u) { if (xb_ld(&(bar)[XB_TMO])) break; if (_sp > XB_SPIN_CAP) { atomicAdd(&(bar)[XB_TMO], 1u); break; } } } } while (0)
struct XcdBarrier { unsigned* bar; unsigned x; volatile LAS unsigned* st; };
__device__ __forceinline__ XcdBarrier xcd_barrier_post(unsigned* bar, volatile LAS unsigned* st) {
    XcdBarrier b; b.bar = bar; b.x = xb_xcc_id(); b.st = st;
    if (threadIdx.x == 0) (void)xb_add(&bar[XB_XCNT(b.x)], 1u);
    return b;
}
__device__ __forceinline__ void xcd_barrier_complete(unsigned* bar, unsigned x, unsigned& nloc, unsigned& nx) {
    const unsigned G = gridDim.x * gridDim.y * gridDim.z;
    unsigned sum, cnt, mine, sp = 0u;
    for (;;) {
        sum = 0u; cnt = 0u; mine = 0u;
#pragma unroll
        for (unsigned j = 0; j < 16; ++j) { const unsigned c = xb_ld(&bar[XB_XCNT(j)]); sum += c; cnt += (c > 0u) ? 1u : 0u; mine = (j == x) ? c : mine; }
        if (sum == G) break;
        __builtin_amdgcn_s_sleep(1);
        if ((++sp & 255u) == 0u) { if (xb_ld(&bar[XB_TMO])) break; if (sp > XB_SPIN_CAP) { atomicAdd(&bar[XB_TMO], 1u); break; } }
    }
    nloc = mine > 0u ? mine : 1u; nx = cnt > 0u ? cnt : 1u;
}
__device__ __forceinline__ void xcd_barrier(const XcdBarrier& b_) {
    XcdBarrier b; b.bar = b_.bar; b.st = b_.st; b.x = xb_xcc_id();
    asm volatile("s_waitcnt vmcnt(0)" ::: "memory");
    __syncthreads();
    if (threadIdx.x == 0) {
        unsigned* bar = b.bar;
        __builtin_amdgcn_s_waitcnt(0);
        unsigned nloc = b.st[0], nx = b.st[1];
        if (nloc == 0u) { xcd_barrier_complete(bar, b.x, nloc, nx); b.st[0] = nloc; b.st[1] = nx; }
        const unsigned old = xb_add(&bar[XB_XSUB(b.x)], 1u);
        const unsigned gen = old / nloc;
        if (old + 1u == (gen + 1u) * nloc) {
            __builtin_amdgcn_fence(__ATOMIC_RELEASE, "agent");
            asm volatile("s_waitcnt vmcnt(0)" ::: "memory");
            const unsigned og = xb_add(&bar[XB_TOP], 1u);
            const unsigned tg = og / nx, target = (tg + 1u) * nx;
            if (og + 1u != target) XB_SPIN(xb_ld(&bar[XB_TOP]) < target, bar);
            xb_add(&bar[XB_XGEN(b.x)], 1u);
            __builtin_amdgcn_fence(__ATOMIC_ACQUIRE, "agent");
            asm volatile("s_waitcnt vmcnt(0)" ::: "memory");
        } else {
            XB_SPIN(xb_ld(&bar[XB_XGEN(b.x)]) == gen, bar);
            __builtin_amdgcn_fence(__ATOMIC_ACQUIRE, "agent");
            asm volatile("s_waitcnt vmcnt(0)" ::: "memory");
        }
    }
    __syncthreads();
}

struct Args { const float* in[34]; float* out; uchar* ws; int ph_lo, ph_hi; };
enum { I_X = 0, I_C, I_CTX, I_CCTX, I_ADAW, I_ADAB, I_NMG, I_NFG, I_RGWIN, I_RGCW, I_RGCB, I_RGWA, I_RGBA, I_RGWI, I_RGBI, I_RGLAM, I_RGWOUT,
       I_ATQKV, I_ATQG, I_ATKG, I_ATWO, I_CMWIN, I_CMLNG, I_CMLNB, I_CMWS, I_CMBS, I_CMWOUT, I_MWG, I_MBG, I_MWR, I_MBR, I_MWGATE, I_MWUP, I_MWDOWN };

__device__ __forceinline__ const void* opaque_uniform_ptr(const void* p) { const unsigned long long v = (unsigned long long)p; unsigned lo = (unsigned)v, hi = (unsigned)(v >> 32); asm volatile("" : "+v"(lo), "+v"(hi));
    lo = __builtin_amdgcn_readfirstlane(lo); hi = __builtin_amdgcn_readfirstlane(hi); return (const void*)(const GAS char*)(((unsigned long long)hi << 32) | lo); }
__device__ __forceinline__ int opaque_uniform_int(int x) { asm volatile("" : "+v"(x)); return __builtin_amdgcn_readfirstlane(x); }
struct Frame {
    LAS uchar* lds; char* ldsg;
    int tid, lane, wave, G, bid;
    uchar* ws; float* out;
};
__device__ __forceinline__ const float* inp(const Frame& F, int i) { const unsigned long long v = *(const LAS unsigned long long*)(F.lds + LDSCTL_OFF + 576 + i * 8);
    const unsigned lo = __builtin_amdgcn_readfirstlane((unsigned)v), hi = __builtin_amdgcn_readfirstlane((unsigned)(v >> 32)); return (const float*)(const GAS float*)(((unsigned long long)hi << 32) | lo); }
__device__ __forceinline__ float wave16_sum(float v) {
    v += __int_as_float(__builtin_amdgcn_update_dpp(0, __float_as_int(v), 0xB1, 0xF, 0xF, true));
    v += __int_as_float(__builtin_amdgcn_update_dpp(0, __float_as_int(v), 0x4E, 0xF, 0xF, true));
    v += __int_as_float(__builtin_amdgcn_update_dpp(0, __float_as_int(v), 0x141, 0xF, 0xF, true));
    v += __int_as_float(__builtin_amdgcn_update_dpp(0, __float_as_int(v), 0x140, 0xF, 0xF, true));
    return v; }

struct ConvItem { const float* src; uchar* dst; int ldw, rowb; bool f8, perm; };
__device__ __forceinline__ void tr_load(const ConvItem& ci, f32x4 (&v)[16]) {
    if (ci.f8) {
#pragma unroll
        for (int i = 0; i < 8; ++i) { v[2 * i] = __builtin_nontemporal_load((const f32x4*)(ci.src + (size_t)(8 * i) * ci.ldw)); v[2 * i + 1] = __builtin_nontemporal_load((const f32x4*)(ci.src + (size_t)(8 * i + 1) * ci.ldw)); }
    } else {
#pragma unroll
        for (int i = 0; i < 16; ++i) v[i] = __builtin_nontemporal_load((const f32x4*)(ci.src + (size_t)(4 * i) * ci.ldw));
    }
}
__device__ __forceinline__ void tr_finish(const f32x4 (&v)[16], const ConvItem& ci, LAS uchar* scr, int lane, const int half) {
    LAS uchar* row2 = scr + 8192 + lane * 128; const int sw2 = lane & 7;
    const int kr = lane >> 4, nc = (lane & 15) * 4;
    const int g = lane >> 4, q = (lane >> 2) & 3, p = lane & 3;
    const int vb = (int)(uintptr_t)scr + q * 128 + g * 32 + p * 8;
    if (ci.f8) {
#pragma unroll
        for (int i = 0; i < 8; ++i) { const f32x4 a = v[2 * i] * 32.f, b = v[2 * i + 1] * 32.f;
            int r0 = __builtin_amdgcn_cvt_pk_fp8_f32(a.x, b.x, 0, false); r0 = __builtin_amdgcn_cvt_pk_fp8_f32(a.y, b.y, r0, true);
            int r1 = __builtin_amdgcn_cvt_pk_fp8_f32(a.z, b.z, 0, false); r1 = __builtin_amdgcn_cvt_pk_fp8_f32(a.w, b.w, r1, true);
            *(LAS u32x2*)(scr + (4 * i + kr) * 128 + nc * 2) = (u32x2){(unsigned)r0, (unsigned)r1}; }
        asm volatile("s_waitcnt lgkmcnt(0)" ::: "memory");
        s16x4 t[8];
#define TRR(r) t[r] = att::tr_read<(r) * 512>(vb)
        TRR(0); TRR(1); TRR(2); TRR(3); TRR(4); TRR(5); TRR(6); TRR(7);
#undef TRR
        asm volatile("s_waitcnt lgkmcnt(0)" ::: "memory"); __builtin_amdgcn_sched_barrier(0);
#pragma unroll
        for (int j = 0; j < 4; ++j) { const bf16x8 o = {t[2 * j][0], t[2 * j][1], t[2 * j][2], t[2 * j][3], t[2 * j + 1][0], t[2 * j + 1][1], t[2 * j + 1][2], t[2 * j + 1][3]}; *(LAS bf16x8*)(row2 + (((half * 4 + j) ^ sw2) * 16)) = o; }
    } else {
#pragma unroll
        for (int i = 0; i < 16; ++i) { u32x2 o; o.x = pk2(v[i].x, v[i].y); o.y = pk2(v[i].z, v[i].w); *(LAS u32x2*)(scr + (4 * i + kr) * 128 + nc * 2) = o; }
        asm volatile("s_waitcnt lgkmcnt(0)" ::: "memory");
        s16x4 t[16];
#define TRR(r) t[r] = att::tr_read<(r) * 512>(vb)
        TRR(0); TRR(1); TRR(2); TRR(3); TRR(4); TRR(5); TRR(6); TRR(7); TRR(8); TRR(9); TRR(10); TRR(11); TRR(12); TRR(13); TRR(14); TRR(15);
#undef TRR
        asm volatile("s_waitcnt lgkmcnt(0)" ::: "memory"); __builtin_amdgcn_sched_barrier(0);
#pragma unroll
        for (int j = 0; j < 8; ++j) { const bf16x8 o = {t[2 * j][0], t[2 * j][1], t[2 * j][2], t[2 * j][3], t[2 * j + 1][0], t[2 * j + 1][1], t[2 * j + 1][2], t[2 * j + 1][3]}; *(LAS bf16x8*)(row2 + ((j ^ sw2) * 16)) = o; }
    }
}
__device__ __forceinline__ void tr_flush(const ConvItem& ci, LAS uchar* scr, int lane) {
    const int r8 = lane >> 3, pc = lane & 7; const LAS uchar* p2 = scr + 8192 + r8 * 128 + ((pc ^ r8) * 16);
    u32x4 w[8];
#pragma unroll
    for (int j = 0; j < 8; ++j) w[j] = *(const LAS u32x4*)(p2 + j * 1024);
#pragma unroll
    for (int j = 0; j < 8; ++j) { int r = r8 + 8 * j;
        if (ci.perm) { const int hf = r >> 5, f = r & 31; r = 32 * (f >> 4) + 8 * ((f >> 2) & 3) + 4 * hf + (f & 3); }
        *(u32x4*)(ci.dst + (size_t)r * ci.rowb + pc * 16) = w[j]; }
}
struct Job { int g, lo, hi; };
__device__ __forceinline__ ConvItem conv_decode(Frame& F, int g, int it) {
    uchar* ws = F.ws; const float* W; int K = 1024, N = 1024, ldt = 1024, mode = 0; size_t dms = 0; bf16_t* WT;
    switch (g) {
        case 0:  W = inp(F, I_MWGATE); N = 512; WT = (bf16_t*)(ws + WS_W_E1); dms = (size_t)1024 * 1024; mode = 1; break;
        case 1:  W = inp(F, I_MWUP);   N = 512; WT = (bf16_t*)(ws + WS_W_E1); dms = (size_t)1024 * 1024; mode = 2; break;
        case 2:  W = inp(F, I_MWDOWN); K = 512; WT = (bf16_t*)(ws + WS_W_E2); ldt = 512; dms = (size_t)1024 * 512; break;
        case 3:  W = inp(F, I_RGWIN);  N = 2048; WT = (bf16_t*)(ws + WS_W_RGIN); dms = (size_t)2048 * 1024; break;
        case 4:  W = inp(F, I_CMWIN);  N = 4096; WT = (bf16_t*)(ws + WS_W_CMIN); break;
        case 5:  W = inp(F, I_RGWOUT); WT = (bf16_t*)(ws + WS_W_RGOUT); dms = (size_t)1024 * 1024; break;
        case 6:  W = inp(F, I_CMWOUT); K = 2048; WT = (bf16_t*)(ws + WS_W_CMOUT); ldt = 2048; break;
        case 7:  W = inp(F, I_ATQKV);  N = 1536; WT = (bf16_t*)(ws + WS_W_QKV); break;
        case 8:  W = inp(F, I_ATWO);   WT = (bf16_t*)(ws + WS_W_AO); break;
        case 9:  W = inp(F, I_RGWA);   K = 128; N = 128; WT = (bf16_t*)(ws + WS_W_RGG); ldt = 128; dms = (size_t)256 * 128; break;
        default: W = inp(F, I_RGWI);   K = 128; N = 128; WT = (bf16_t*)(ws + WS_W_RGG); ldt = 128; dms = (size_t)256 * 128; mode = 3; break;
    }
    const int nblk = N / 64, nkb = K / 64, per = nkb * nblk, mat = it / per, r = it - mat * per, kb = r % nkb, nb = r / nkb, n0 = nb * 64;
    int drow = n0;
    if (mode == 1) drow = (n0 >> 7) * 256 + (n0 & 127); else if (mode == 2) drow = (n0 >> 7) * 256 + 128 + (n0 & 127); else if (mode == 3) drow = 128 + n0;
    const int lane = F.lane;
    const bool f8 = (MOE_FP8 != 0) && (g < 3 || ((DENSE_FP8 & 1) && g == 3) || ((DENSE_FP8 & 4) && g == 4) || ((DENSE_FP8 & 2) && g == 7) || ((DENSE_FP8 & 8) && g == 6) || ((DENSE_FP8 & 16) && g == 8) || ((DENSE_FP8 & 32) && g == 5)); const int eb = f8 ? 1 : 2;
    ConvItem ci; ci.ldw = N; ci.f8 = f8; ci.src = W + (size_t)mat * K * N + (size_t)(kb * 64 + (f8 ? 2 : 1) * (lane >> 4)) * N + n0 + (lane & 15) * 4;
    ci.perm = (g == 7 && n0 < 1280);
    ci.rowb = ldt * eb;
    ci.dst = (uchar*)WT + ((size_t)mat * dms + (size_t)drow * ldt + (f8 ? (kb & ~1) : kb) * 64) * eb;
    return ci;
}
template <int NJ>
__device__ __forceinline__ ConvItem conv_find(Frame& F, int v, const Job (&jobs)[NJ]) { int r = v, g = jobs[0].g, it = 0; bool found = false;
#pragma unroll
    for (int q = 0; q < NJ; ++q) { const int n = jobs[q].hi - jobs[q].lo; if (!found) { if (r < n) { g = jobs[q].g; it = jobs[q].lo + r; found = true; } else r -= n; } }
    return conv_decode(F, g, it); }
template <int NJ>
__device__ __forceinline__ void conv_tail(Frame& F, int nblk0, const Job (&jobs)[NJ]) {
    if (nblk0 >= F.G) nblk0 = 0;
    if (F.bid < nblk0) return;
    LAS uchar* scr = F.lds + F.wave * 16384;
    int total = 0;
#pragma unroll
    for (int q = 0; q < NJ; ++q) total += jobs[q].hi - jobs[q].lo;
    const int npair = total >> 1, nw = (F.G - nblk0) * 8;
    int u = (F.bid - nblk0) * 8 + F.wave;
    f32x4 va[16], vb[16]; ConvItem c0, c1; c0.dst = nullptr; c1.dst = nullptr; c0.f8 = false; c1.f8 = false; c0.src = nullptr; c1.src = nullptr; c0.ldw = 0; c1.ldw = 0; c0.rowb = 0; c1.rowb = 0; c0.perm = false; c1.perm = false;
    if (u < npair) { c0 = conv_find(F, 2 * u, jobs); tr_load(c0, va); c1 = conv_find(F, 2 * u + 1, jobs); tr_load(c1, vb); }
    for (; u < npair; u += nw) {
        const int un = u + nw;
        tr_finish(va, c0, scr, F.lane, 0);
        if (!c0.f8) tr_flush(c0, scr, F.lane);
        if (un < npair) { c0 = conv_find(F, 2 * un, jobs); tr_load(c0, va); }
        tr_finish(vb, c1, scr, F.lane, 1);
        tr_flush(c1, scr, F.lane);
        if (un < npair) { c1 = conv_find(F, 2 * un + 1, jobs); tr_load(c1, vb); }
    }
}
__device__ __forceinline__ void p0_prologue(Frame& F) {
    uchar* ws = F.ws;
    {
        LAS float* act = (LAS float*)(F.lds);
        LAS float* red = (LAS float*)(F.lds + 5 * 1024 * 4);
        bool have = false; const float* pC = inp(F, I_C); const float* pCC = inp(F, I_CCTX); const float* pADAW = inp(F, I_ADAW); const float* pADAB = inp(F, I_ADAB); const float* pNMG = inp(F, I_NMG); const float* pNFG = inp(F, I_NFG);
        for (int it = F.bid; it < DEPTH * 32; it += F.G) {
            if (!have) { for (int i = F.tid; i < 5 * 1024; i += 512) { const int s = i >> 10, k = i & 1023; const float v = s < 4 ? pC[s * 1024 + k] : pCC[k]; act[i] = v / (1.f + __expf(-v)); } have = true; __syncthreads(); }
            const int l = it >> 5, cb = it & 31; const int ln = F.lane < 48 ? F.lane : 47;
            const float* W = pADAW + (size_t)l * 1024 * NMODV + cb * 192 + ln * 4;
            f32x4 a[5];
#pragma unroll
            for (int s = 0; s < 5; ++s) a[s] = (f32x4){0.f, 0.f, 0.f, 0.f};
            const int kbase = F.wave * 128;
#pragma unroll 8
            for (int k = 0; k < 128; ++k) { const f32x4 w = *(const f32x4*)(W + (size_t)(kbase + k) * NMODV);
#pragma unroll
                for (int s = 0; s < 5; ++s) a[s] += w * act[s * 1024 + kbase + k]; }
            if (F.lane < 48) {
#pragma unroll
                for (int s = 0; s < 5; ++s) *(LAS f32x4*)(red + (F.wave * 5 + s) * 192 + F.lane * 4) = a[s]; }
            __syncthreads();
            for (int i = F.tid; i < 5 * 192; i += 512) { const int s = i / 192, c = i - s * 192; float v = pADAB[l * NMODV + cb * 192 + c];
#pragma unroll
                for (int w = 0; w < 8; ++w) v += red[(w * 5 + s) * 192 + c];
                const int col = cb * 192 + c, slot = col >> 10;
                if (slot == 1) v = pNMG[l * D + (col & 1023)] * (1.f + v); else if (slot == 4) v = pNFG[l * D + (col & 1023)] * (1.f + v);
                ((float*)(ws + WS_MOD))[(l * 5 + s) * NMODV + col] = v; }
            __syncthreads();
        }
        __syncthreads();
    }
    { const Job jobsA[8] = {{3, 0, 1024}, {4, 0, 1024}, {5, 0, 512}, {6, 0, 512}, {7, 0, 384}, {8, 0, 256}, {9, 0, 128}, {10, 0, 128}}; conv_tail(F, DEPTH * 32, jobsA);
      const Job jobsB[3] = {{0, 0, 16384}, {1, 0, 16384}, {2, 0, 16384}}; conv_tail(F, 0, jobsB); }
    {
        const int gt = F.bid * 512 + F.tid, NGT = F.G * 512;
        for (int i = gt; i < 8 * 128 * 128 / 4; i += NGT) { const f32x4 v = ((const f32x4*)inp(F, I_CMWS))[i]; u32x2 o; o.x = pk2(v.x, v.y); o.y = pk2(v.z, v.w); ((u32x2*)(ws + WS_W_CMS))[i] = o; }
        { const float* pwg = inp(F, I_MWG); const float* pwr = inp(F, I_MWR);
          for (int i = gt; i < DEPTH * 36 * 1024; i += NGT) { const int l = i / 36864, r = i - l * 36864, o = r >> 10, k = r & 1023;
              const int jj = k >> 6, li = (k & 63) >> 2, le = k & 3, kc = 16 * li + 256 * (jj >> 2) + 4 * (jj & 3) + le;
              ((float*)(ws + WS_RTR))[i] = o < 4 ? pwg[(size_t)(l * 1024 + kc) * 4 + o] : pwr[(size_t)(l * 1024 + kc) * 32 + (o - 4)]; } }
        for (int i = gt; i < 2 * 2 * D; i += NGT) { const float* plam = inp(F, I_RGLAM); ((float*)(ws + WS_SPL))[i] = -8.f * log1pf(expf(-plam[i])); }
        for (int i = gt; i < 64 * 32; i += NGT) { const int pos = i >> 5, f = i & 31; const float inv = powf(10000.f, -(float)f * 2.0f / 64.0f); const float ang = (float)pos * inv;
            ((f32x2*)(ws + WS_ROPE))[i] = (f32x2){cosf(ang), sinf(ang)}; }
    }
}

__device__ __forceinline__ void router_fill(Frame& F, int l) {
    const char* src = pg8::uptr((const char*)(F.ws + WS_RTR) + (size_t)l * 147456);
    const unsigned ldsbase = (unsigned)(uintptr_t)F.lds; const unsigned vo = (unsigned)F.lane * 16u;
    __syncthreads();
#pragma unroll
    for (int i = 0; i < 18; ++i) { const unsigned chunk = (unsigned)(F.wave + 8 * i) * 1024u; pg8::glds16(src, chunk + vo, ldsbase + chunk); }
    asm volatile("s_waitcnt vmcnt(0)" ::: "memory");
    __syncthreads();
}
template <bool ROUTE, int NADD, bool SRCIN, bool H8, int NT>
__device__ __forceinline__ void norm_tokens(Frame& F, int l, const float* gvec, int shift_i, bool skip_ctx_route, bool dry, const int tokb, const int rslot = -1) {
    constexpr bool WIDE = true; constexpr int CW = WIDE ? 16 : 4;
#define NCOL(j) (WIDE ? (256 * ((j) >> 2) + 4 * ((j) & 3)) : 64 * (j))
    uchar* ws = F.ws;
    float* X = (float*)(ws + WS_X); const bf16_t* YS = (const bf16_t*)(ws + WS_Y1); const bf16_t* YM = (const bf16_t*)(ws + WS_YM); bf16_t* H = (bf16_t*)(ws + WS_H);
    const float* MOD = (const float*)(ws + WS_MOD) + (size_t)l * 5 * NMODV;
    LAS float* wr = (LAS float*)F.lds;
    const int i16 = F.lane & 15, grp = F.lane >> 4;
    const float* bg = nullptr; const float* br = nullptr; if constexpr (ROUTE) { bg = inp(F, I_MBG) + l * 4; br = inp(F, I_MBR) + l * 32; }
    const float* pctx = nullptr; const float* px = nullptr; if constexpr (SRCIN) { pctx = inp(F, I_CTX); px = inp(F, I_X); }
        asm volatile("" ::: "memory");
        f32x4 x[NT][16];
        constexpr bool PRE2 = (NT == 2) && X_BF16 && !SRCIN && (NADD == 1);
        u32x2 xr2[PRE2 ? 16 : 1], yr2[PRE2 ? 16 : 1];
        if constexpr (PRE2) { const int tok1 = tokb + 4 + grp; int c0 = CW * i16; asm volatile("" : "+v"(c0));
            const bf16_t* xbrow = (const bf16_t*)X + (size_t)tok1 * D + c0; const bf16_t* yrow = YM + (size_t)tok1 * D + c0;
#pragma unroll
            for (int j = 0; j < 16; ++j) xr2[j] = *(const u32x2*)(xbrow + NCOL(j));
#pragma unroll
            for (int j = 0; j < 16; ++j) yr2[j] = *(const u32x2*)(yrow + NCOL(j)); }
#pragma unroll
        for (int q = 0; q < NT; ++q) { const int tok = tokb + q * 4 + grp; const int sidx = sidx_of_row(tok);
            int c0 = CW * i16; asm volatile("" : "+v"(c0));
            if (PRE2 && q == 1) {
#pragma unroll
                for (int j = 0; j < 16; ++j) { x[q][j] = (f32x4){bflo(xr2[j].x), bfhi(xr2[j].x), bflo(xr2[j].y), bfhi(xr2[j].y)}; x[q][j] += (f32x4){bflo(yr2[j].x), bfhi(yr2[j].x), bflo(yr2[j].y), bfhi(yr2[j].y)}; }
            } else {
                u32x2 xr[16], yr[16];
                const float* xrow = X + (size_t)tok * D;
                if constexpr (SRCIN) { const int b_ = tok / SB, s_ = tok - b_ * SB; xrow = s_ < CTX ? pctx + ((size_t)(b_ * CTX + s_) << 10) : px + ((size_t)(b_ * SEQ + s_ - CTX) << 10); }
                xrow += c0; const bf16_t* xbrow = (const bf16_t*)X + (size_t)tok * D + c0; const bf16_t* yrow = YM + (size_t)tok * D + c0;
#pragma unroll
                for (int j = 0; j < 16; ++j) { if constexpr (X_BF16 && !SRCIN) xr[j] = *(const u32x2*)(xbrow + NCOL(j));
                    else x[q][j] = *(const f32x4*)(xrow + NCOL(j)); }
                if constexpr (NADD >= 1) {
#pragma unroll
                    for (int j = 0; j < 16; ++j) yr[j] = *(const u32x2*)(yrow + NCOL(j)); }
                __builtin_amdgcn_sched_barrier(0);
#pragma unroll
                for (int j = 0; j < 16; ++j) {
                    if constexpr (X_BF16 && !SRCIN) x[q][j] = (f32x4){bflo(xr[j].x), bfhi(xr[j].x), bflo(xr[j].y), bfhi(xr[j].y)};
                    if constexpr (NADD >= 1) x[q][j] += (f32x4){bflo(yr[j].x), bfhi(yr[j].x), bflo(yr[j].y), bfhi(yr[j].y)}; }
            }
            if constexpr (NADD == 3) {
#pragma unroll
                for (int j = 0; j < 16; ++j) { const f32x4 g5 = *(const f32x4*)(MOD - (size_t)5 * NMODV + (size_t)sidx * NMODV + 5 * D + NCOL(j) + CW * i16);
                    if constexpr (Y_FP8) { const unsigned y0 = *(const unsigned*)((const uchar*)YS + (size_t)tok * D + NCOL(j) + CW * i16), y1 = *(const unsigned*)((const uchar*)YS + ((size_t)T + tok) * D + NCOL(j) + CW * i16);
                        x[q][j] += g5 * ((fp8x4_to_f32(y0) + fp8x4_to_f32(y1)) * (1.f / 16.f)); }
                    else { const u32x2 y0 = *(const u32x2*)(YS + (size_t)tok * D + NCOL(j) + CW * i16), y1 = *(const u32x2*)(YS + ((size_t)T + tok) * D + NCOL(j) + CW * i16);
                        x[q][j] += g5 * (f32x4){bflo(y0.x) + bflo(y1.x), bfhi(y0.x) + bfhi(y1.x), bflo(y0.y) + bflo(y1.y), bfhi(y0.y) + bfhi(y1.y)}; } }
#pragma unroll
                for (int j = 0; j < 16; ++j) { if constexpr (X_BF16) { u32x2 o; o.x = pk2(x[q][j].x, x[q][j].y); o.y = pk2(x[q][j].z, x[q][j].w); *(u32x2*)((bf16_t*)X + (size_t)tok * D + NCOL(j) + CW * i16) = o; }
                    else *(f32x4*)(X + (size_t)tok * D + NCOL(j) + CW * i16) = x[q][j]; } }
            float ss = 0.f;
#pragma unroll
            for (int j = 0; j < 16; ++j) ss += x[q][j].x * x[q][j].x + x[q][j].y * x[q][j].y + x[q][j].z * x[q][j].z + x[q][j].w * x[q][j].w;
            ss = wave16_sum(ss);
            const float rstd = rsqrtf(ss * (1.f / D) + NORM_EPS);
            const float* shp = MOD + (size_t)sidx * NMODV + shift_i * D + c0; const float* scp = shp + D; (void)gvec;
#pragma unroll
            for (int j = 0; j < 16; ++j) { const f32x4 sh = *(const f32x4*)(shp + NCOL(j)), sc = *(const f32x4*)(scp + NCOL(j));
                x[q][j] = x[q][j] * rstd * sc + sh; }
            uchar* h8row = (uchar*)H + (size_t)tok * D + c0; bf16_t* hrow = H + (size_t)tok * D + c0;
#pragma unroll
            for (int j = 0; j < 16; ++j) {
                if constexpr ((ROUTE && MOE_FP8) || H8) { int r8 = __builtin_amdgcn_cvt_pk_fp8_f32(x[q][j].x, x[q][j].y, 0, false); r8 = __builtin_amdgcn_cvt_pk_fp8_f32(x[q][j].z, x[q][j].w, r8, true); *(int*)(h8row + NCOL(j)) = r8; }
                else { u32x2 o; o.x = pk2(x[q][j].x, x[q][j].y); o.y = pk2(x[q][j].z, x[q][j].w); *(u32x2*)(hrow + NCOL(j)) = o; } }
            if constexpr (NT > 1) __builtin_amdgcn_sched_barrier(0);
        }
        if constexpr (ROUTE) {
            LAS float* lgs = (LAS float*)(F.lds + LDSCTL_OFF + 1024) + (F.wave * 4 + grp) * (40 * NT);
#pragma unroll 1
            for (int o = 0; o < 4; ++o) { f32x4 w[8], acc[NT];
#pragma unroll
                for (int j = 0; j < 8; ++j) w[j] = *(const LAS f32x4*)(wr + o * 1024 + 64 * j + 4 * i16);
                __builtin_amdgcn_sched_barrier(0);
#pragma unroll
                for (int q = 0; q < NT; ++q) { f32x4 v0 = x[q][0] * w[0], v1 = x[q][1] * w[1];
#pragma unroll
                    for (int j = 2; j < 8; j += 2) { v0 += x[q][j] * w[j]; v1 += x[q][j + 1] * w[j + 1]; }
                    acc[q] = v0 + v1; }
                __builtin_amdgcn_sched_barrier(0);
#pragma unroll
                for (int j = 0; j < 8; ++j) w[j] = *(const LAS f32x4*)(wr + o * 1024 + 64 * (j + 8) + 4 * i16);
                __builtin_amdgcn_sched_barrier(0);
#pragma unroll
                for (int q = 0; q < NT; ++q) { f32x4 v0 = x[q][8] * w[0], v1 = x[q][9] * w[1];
#pragma unroll
                    for (int j = 2; j < 8; j += 2) { v0 += x[q][8 + j] * w[j]; v1 += x[q][9 + j] * w[j + 1]; }
                    v0 += v1; v0 += acc[q]; const float a0 = wave16_sum((v0.x + v0.y) + (v0.z + v0.w)); if (i16 == 0) lgs[q * 40 + o] = a0; } }
            asm volatile("s_waitcnt lgkmcnt(0)" ::: "memory");
            int gsq[NT]; float pgq[NT];
#pragma unroll
            for (int q = 0; q < NT; ++q) { const LAS float* lq = lgs + q * 40;
                const float gl0 = lq[0] + bg[0], gl1 = lq[1] + bg[1], gl2 = lq[2] + bg[2], gl3 = lq[3] + bg[3];
                int gs = 0; float gm = gl0;
                if (gl1 > gm) { gm = gl1; gs = 1; }
                if (gl2 > gm) { gm = gl2; gs = 2; }
                if (gl3 > gm) { gm = gl3; gs = 3; }
                const float den = __expf(gl0 - gm) + __expf(gl1 - gm) + __expf(gl2 - gm) + __expf(gl3 - gm);
                gsq[q] = gs; pgq[q] = 1.f / den; }
#pragma unroll 1
            for (int e = 0; e < 8; ++e) {
#pragma unroll
                for (int q = 0; q < NT; ++q) { const LAS float* wq = wr + (4 + gsq[q] * 8 + e) * 1024 + 4 * i16; f32x4 w[8];
#pragma unroll
                    for (int j = 0; j < 8; ++j) w[j] = *(const LAS f32x4*)(wq + 64 * j);
                    __builtin_amdgcn_sched_barrier(0);
                    f32x4 v0 = x[q][0] * w[0], v1 = x[q][1] * w[1];
#pragma unroll
                    for (int j = 2; j < 8; j += 2) { v0 += x[q][j] * w[j]; v1 += x[q][j + 1] * w[j + 1]; }
                    __builtin_amdgcn_sched_barrier(0);
#pragma unroll
                    for (int j = 0; j < 8; ++j) w[j] = *(const LAS f32x4*)(wq + 64 * (j + 8));
                    __builtin_amdgcn_sched_barrier(0);
#pragma unroll
                    for (int j = 0; j < 8; j += 2) { v0 += x[q][8 + j] * w[j]; v1 += x[q][9 + j] * w[j + 1]; }
                    v0 += v1; const float a0 = wave16_sum((v0.x + v0.y) + (v0.z + v0.w)); if (i16 == 0) lgs[q * 40 + 4 + e] = a0; } }
            asm volatile("s_waitcnt lgkmcnt(0)" ::: "memory");
#pragma unroll
            for (int q = 0; q < NT; ++q) { const int tok = tokb + q * 4 + grp; const int sidx = sidx_of_row(tok); const LAS float* lq = lgs + q * 40;
                const int gs = gsq[q]; const float pg = pgq[q];
                float el[8];
#pragma unroll
                for (int e = 0; e < 8; ++e) el[e] = lq[4 + e] + br[gs * 8 + e];
                int i0 = 0; float v0 = el[0];
#pragma unroll
                for (int e = 1; e < 8; ++e) if (el[e] > v0) { v0 = el[e]; i0 = e; }
                int i1 = -1; float v1 = -3.0e38f;
#pragma unroll
                for (int e = 0; e < 8; ++e) if (e != i0 && el[e] > v1) { v1 = el[e]; i1 = e; }
                const float p0 = 1.f / (1.f + __expf(v1 - v0));
                const float w0 = p0 * pg, w1 = (1.f - p0) * pg;
                const bool do_route = !(skip_ctx_route && sidx == 4) && !dry;
                if (i16 == 0) {
                    LAS unsigned* rec = (LAS unsigned*)(F.lds + LDSCTL_OFF + 1024) + (F.wave * 4 + grp) * 80 + 12 + (rslot + q) * 8;
                    if (do_route) { const int e0 = gs * 8 + i0, e1 = gs * 8 + i1; LAS unsigned* lc = (LAS unsigned*)(F.lds + LDSCTL_OFF + 256);
                        const unsigned o0 = __hip_atomic_fetch_add(lc + e0, 1u, __ATOMIC_RELAXED, __HIP_MEMORY_SCOPE_WORKGROUP), o1 = __hip_atomic_fetch_add(lc + e1, 1u, __ATOMIC_RELAXED, __HIP_MEMORY_SCOPE_WORKGROUP);
                        *(LAS u32x4*)rec = (u32x4){(unsigned)tok, (unsigned)e0, (unsigned)e1, o0}; *(LAS u32x4*)(rec + 4) = (u32x4){o1, __float_as_uint(w0), __float_as_uint(w1), 0u}; }
                    else rec[0] = 0xffffffffu; }
            }
        }
}
#undef NCOL
template <bool ROUTE, int NADD, bool SRCIN, bool H8 = false>
__device__ __forceinline__ void norm_phase(Frame& F, int l, const float* gvec, int shift_i, bool skip_ctx_route, bool dry) {
    constexpr int NT = ROUTE ? 2 : 1;
    const int nunits = T / (4 * NT), nwv = F.G * 8, nfull = nunits / nwv;
    if constexpr (!ROUTE) {
        for (int it = 0; it < nfull; ++it) norm_tokens<ROUTE, NADD, SRCIN, H8, NT>(F, l, gvec, shift_i, skip_ctx_route, dry, (it * nwv + F.bid * 8 + F.wave) * (4 * NT));
        const int t0 = nfull * nwv * (4 * NT), e = F.wave * F.G + F.bid;
        if (e * 4 < T - t0) norm_tokens<ROUTE, NADD, SRCIN, H8, 1>(F, l, gvec, shift_i, skip_ctx_route, dry, t0 + e * 4);
    } else {
        static_assert(NT == 2, "routing norm");
#pragma unroll 1
        for (int it = 0; it < nfull; ++it) {
            { LAS unsigned* lc = (LAS unsigned*)(F.lds + LDSCTL_OFF + 256);
              LAS unsigned* rec = (LAS unsigned*)(F.lds + LDSCTL_OFF + 1024) + (F.wave * 4 + (F.lane >> 4)) * 80 + 12;
              if (F.tid < 32) lc[F.tid] = 0u;
              if ((F.lane & 15) == 0) { rec[0] = 0xffffffffu; rec[8] = 0xffffffffu; rec[16] = 0xffffffffu; } }
            __syncthreads();
            norm_tokens<ROUTE, NADD, SRCIN, H8, NT>(F, l, gvec, shift_i, skip_ctx_route, dry, (it * nwv + F.bid * 8 + F.wave) * (4 * NT), 0);
            { const int t0 = nfull * nwv * (4 * NT), e = F.wave * F.G + F.bid;
              if (it + 1 == nfull && e * 4 < T - t0) norm_tokens<ROUTE, NADD, SRCIN, H8, 1>(F, l, gvec, shift_i, skip_ctx_route, dry, t0 + e * 4, 2); }
            __syncthreads();
            int t_ = threadIdx.x; asm volatile("" : "+v"(t_));
            LAS unsigned* lc = (LAS unsigned*)(F.lds + LDSCTL_OFF + 256);
            if (t_ < 32) { const unsigned n = lc[t_]; unsigned* cnt = (unsigned*)(F.ws + WS_CTL) + CW_CNT + (l * 32 + t_) * 64; lc[40 + t_] = n ? atomicAdd(cnt, n) : 0u; }
            __syncthreads();
            if ((t_ & 15) == 0) { LAS unsigned* rec = (LAS unsigned*)(F.lds + LDSCTL_OFF + 1024) + (t_ >> 4) * 80 + 12; u32x2* BK = (u32x2*)(F.ws + WS_BK2);
#pragma unroll
                for (int q = 0; q < 3; ++q) { const u32x4 r0 = *(const LAS u32x4*)(rec + q * 8), r1 = *(const LAS u32x4*)(rec + q * 8 + 4);
                    if ((int)r0.x >= 0) { BK[(size_t)r0.y * T + lc[40 + r0.y] + r0.w] = (u32x2){r0.x * 2u, r1.y}; BK[(size_t)r0.z * T + lc[40 + r0.z] + r1.x] = (u32x2){r0.x * 2u + 1u, r1.z}; } } }
            __syncthreads();
        }
    }
}

__device__ __forceinline__ void st8(bf16_t* p, f32x4 v0, f32x4 v1) { u32x4 w; w.x = cvt_pk_bf16(v0[0], v0[1]); w.y = cvt_pk_bf16(v0[2], v0[3]); w.z = cvt_pk_bf16(v1[0], v1[1]); w.w = cvt_pk_bf16(v1[2], v1[3]); *(u32x4*)p = w; }
#define EPI_ROWS(ai, m) (u.pm * 256 + (ai) * 128 + wr * 64 + (m) * 16 + fr)

template <bool F8> constexpr float dsc() { return F8 ? (1.f / 32.f) : 1.f; }
struct EpiRgIn { static constexpr bool PERM = true, FP8 = ((DENSE_FP8 & 1) && MOE_FP8), PREFETCH = false; static constexpr float DSC = dsc<FP8>(); bf16_t* GG; bf16_t* XB;
    __device__ __forceinline__ void operator()(const f32x4 (&acc)[2][2][4][2], const pg8::Unit& u, int wr, int wc, int fr, int fq) const {
        const bool isg = u.pn < 4; bf16_t* base = isg ? GG : XB; const int ct = (u.pn & 3) * 256 + wc * 32 + 8 * fq;
#pragma unroll
        for (int ai = 0; ai < 2; ++ai)
#pragma unroll
            for (int m = 0; m < 4; ++m) { if (!((u.hm >> (2 * ai)) & 1)) continue; bf16_t* rowp = base + (size_t)EPI_ROWS(ai, m) * D + ct;
#pragma unroll
                for (int bj = 0; bj < 2; ++bj) { f32x4 v0 = acc[ai][bj][m][0] * DSC, v1 = acc[ai][bj][m][1] * DSC;
                    if (isg) {
#pragma unroll
                        for (int e = 0; e < 4; ++e) { v0[e] = gelu_tanh(v0[e]); v1[e] = gelu_tanh(v1[e]); } }
                    st8(rowp + bj * 128, v0, v1); } }
    } };
struct EpiBf16 { static constexpr bool PERM = true, FP8 = false, PREFETCH = false; bf16_t* O; int ldc;
    __device__ __forceinline__ void operator()(const f32x4 (&acc)[2][2][4][2], const pg8::Unit& u, int wr, int wc, int fr, int fq) const {
        const int ct = u.pn * 256 + wc * 32 + 8 * fq;
#pragma unroll
        for (int ai = 0; ai < 2; ++ai)
#pragma unroll
            for (int m = 0; m < 4; ++m) { if (!((u.hm >> (2 * ai)) & 1)) continue; bf16_t* rowp = O + (size_t)EPI_ROWS(ai, m) * ldc + ct;
#pragma unroll
                for (int bj = 0; bj < 2; ++bj) st8(rowp + bj * 128, acc[ai][bj][m][0], acc[ai][bj][m][1]); }
    } };
struct EpiQKV { static constexpr bool PERM = true, FP8 = ((DENSE_FP8 & 2) && MOE_FP8), PREFETCH = false; static constexpr float DSC = dsc<FP8>(); bf16_t* O; const float* qg; const float* kg; const float* rope; LAS float* xch;
    __device__ __forceinline__ void operator()(const f32x4 (&acc)[2][2][4][2], const pg8::Unit& u, int wr, int wc, int fr, int fq) const {
        if (u.pn == 5) {
            const int ct = u.pn * 256 + wc * 32 + 8 * fq;
#pragma unroll
            for (int ai = 0; ai < 2; ++ai)
#pragma unroll
                for (int m = 0; m < 4; ++m) { if (!((u.hm >> (2 * ai)) & 1)) continue; bf16_t* rowp = O + (size_t)EPI_ROWS(ai, m) * 1536 + ct;
#pragma unroll
                    for (int bj = 0; bj < 2; ++bj) st8(rowp + bj * 128, acc[ai][bj][m][0] * DSC, acc[ai][bj][m][1] * DSC); }
            return; }
        const bool lat = (u.pm % 17) != 0; const float* gv = u.pn < 4 ? qg : kg; const int a = wc >> 1, f0 = 16 * (wc & 1) + 4 * fq;
        const f32x4 g1 = *(const f32x4*)(gv + 64 * a + f0), g2 = *(const f32x4*)(gv + 64 * a + 32 + f0);
        f32x4 cvs[4], svs[4];
        { const int t0 = ((u.pm % 17) - 1) * 256;
#pragma unroll
          for (int q = 0; q < 4; ++q) { cvs[q] = (f32x4){1.f, 1.f, 1.f, 1.f}; svs[q] = (f32x4){0.f, 0.f, 0.f, 0.f};
            if (lat) { const int pos = a ? (16 * q + fr) : ((t0 >> 6) + 2 * (q & 1) + wr); const f32x4 cs0 = *(const f32x4*)(rope + (pos * 32 + f0) * 2), cs1 = *(const f32x4*)(rope + (pos * 32 + f0) * 2 + 4);
                cvs[q] = (f32x4){cs0.x, cs0.z, cs1.x, cs1.z}; svs[q] = (f32x4){cs0.y, cs0.w, cs1.y, cs1.w}; } } }
#pragma unroll
        for (int ai = 0; ai < 2; ++ai)
#pragma unroll
            for (int m = 0; m < 4; ++m)
#pragma unroll
                for (int bj = 0; bj < 2; ++bj) { const f32x4 v0 = acc[ai][bj][m][0] * DSC, v1 = acc[ai][bj][m][1] * DSC;
                    float sq = ((v0.x * v0.x + v0.y * v0.y) + (v0.z * v0.z + v0.w * v0.w)) + ((v1.x * v1.x + v1.y * v1.y) + (v1.z * v1.z + v1.w * v1.w));
                    sq += __shfl_xor(sq, 16); sq += __shfl_xor(sq, 32);
                    if (fq == 0) xch[((ai * 128 + wr * 64 + m * 16 + fr) * 2 + bj) * 4 + wc] = sq; }
        asm volatile("s_waitcnt lgkmcnt(0)" ::: "memory"); __builtin_amdgcn_s_barrier(); asm volatile("" ::: "memory");
#pragma unroll
        for (int ai = 0; ai < 2; ++ai)
#pragma unroll
            for (int m = 0; m < 4; ++m) { if (!((u.hm >> (2 * ai)) & 1)) continue; const int row = EPI_ROWS(ai, m);
                const f32x4 cv = a ? cvs[m] : cvs[ai], sv = a ? svs[m] : svs[ai];
#pragma unroll
                for (int bj = 0; bj < 2; ++bj) { const f32x4 p4 = *(const LAS f32x4*)(xch + ((ai * 128 + wr * 64 + m * 16 + fr) * 2 + bj) * 4);
                    const float rstd = rsqrtf(((p4.x + p4.y) + (p4.z + p4.w)) * (1.f / 128.f) + NORM_EPS) * DSC;
                    const f32x4 x1 = acc[ai][bj][m][0] * rstd * g1, x2 = acc[ai][bj][m][1] * rstd * g2;
                    const f32x4 o1 = x1 * cv - x2 * sv, o2 = x2 * cv + x1 * sv;
                    bf16_t* p = O + (size_t)row * 1536 + u.pn * 256 + bj * 128 + 64 * a + f0;
                    u32x2 w1, w2; w1.x = cvt_pk_bf16(o1.x, o1.y); w1.y = cvt_pk_bf16(o1.z, o1.w); w2.x = cvt_pk_bf16(o2.x, o2.y); w2.y = cvt_pk_bf16(o2.z, o2.w);
                    *(u32x2*)p = w1; *(u32x2*)(p + 32) = w2; } }
    } };
struct EpiCmIn { static constexpr bool PERM = true, FP8 = ((DENSE_FP8 & 4) && MOE_FP8), PREFETCH = false; static constexpr float DSC = dsc<FP8>(); bf16_t* O; f32x2* statp;
    __device__ __forceinline__ void operator()(const f32x4 (&acc)[2][2][4][2], const pg8::Unit& u, int wr, int wc, int fr, int fq) const {
        const int ct = u.pn * 256 + wc * 32 + 8 * fq; const bool isv = u.pn >= 8;
#pragma unroll
        for (int ai = 0; ai < 2; ++ai)
#pragma unroll
            for (int m = 0; m < 4; ++m) { if (!((u.hm >> (2 * ai)) & 1)) continue; const int row = EPI_ROWS(ai, m); bf16_t* rowp = O + (size_t)row * 4096 + ct; float s = 0.f, q = 0.f;
#pragma unroll
                for (int bj = 0; bj < 2; ++bj) { f32x4 v0 = acc[ai][bj][m][0] * DSC, v1 = acc[ai][bj][m][1] * DSC;
#pragma unroll
                    for (int e = 0; e < 4; ++e) { v0[e] = gelu_tanh(v0[e]); v1[e] = gelu_tanh(v1[e]); }
                    u32x4 w; w.x = cvt_pk_bf16(v0[0], v0[1]); w.y = cvt_pk_bf16(v0[2], v0[3]); w.z = cvt_pk_bf16(v1[0], v1[1]); w.w = cvt_pk_bf16(v1[2], v1[3]);
                    *(u32x4*)(rowp + bj * 128) = w;
                    const float r0 = bflo(w.x), r1 = bfhi(w.x), r2 = bflo(w.y), r3 = bfhi(w.y), r4 = bflo(w.z), r5 = bfhi(w.z), r6 = bflo(w.w), r7 = bfhi(w.w);
                    s += ((r0 + r1) + (r2 + r3)) + ((r4 + r5) + (r6 + r7)); q += ((r0 * r0 + r1 * r1) + (r2 * r2 + r3 * r3)) + ((r4 * r4 + r5 * r5) + (r6 * r6 + r7 * r7)); }
                if (isv) { s += __shfl_xor(s, 16); s += __shfl_xor(s, 32); q += __shfl_xor(q, 16); q += __shfl_xor(q, 32);
                    if (fq == 0) statp[(size_t)row * 32 + (u.pn - 8) * 4 + wc] = (f32x2){s, q}; } }
    } };
template <bool F8, int ASC = 1>
struct EpiResidT { static constexpr bool PERM = true, FP8 = F8, PREFETCH = false; static constexpr float DSC = F8 ? 1.f / (32.f * ASC) : 1.f; bf16_t* YM; const float* gate  ;
    __device__ __forceinline__ void operator()(const f32x4 (&acc)[2][2][4][2], const pg8::Unit& u, int wr, int wc, int fr, int fq) const {
        const int sidx = sidx_of_row(u.pm * 256); const float* gp = gate + (size_t)sidx * NMODV; const int ct = u.pn * 256 + wc * 32 + 8 * fq;
        f32x4 gv[2][2];
#pragma unroll
        for (int bj = 0; bj < 2; ++bj)
#pragma unroll
            for (int n = 0; n < 2; ++n) gv[bj][n] = *(const f32x4*)(gp + ct + bj * 128 + n * 4) * DSC;
#pragma unroll
        for (int ai = 0; ai < 2; ++ai)
#pragma unroll
            for (int m = 0; m < 4; ++m) { if (!((u.hm >> (2 * ai)) & 1)) continue; bf16_t* rowp = YM + (size_t)EPI_ROWS(ai, m) * D + ct;
#pragma unroll
                for (int bj = 0; bj < 2; ++bj) st8(rowp + bj * 128, gv[bj][0] * acc[ai][bj][m][0], gv[bj][1] * acc[ai][bj][m][1]); }
    } };
typedef EpiResidT<false> EpiResid;
struct EpiRgGate { static constexpr bool PERM = true, FP8 = false, PREFETCH = false; const bf16_t* XC; bf16_t* LA; bf16_t* BB; const float* ba; const float* bi; const float* lam;
    __device__ __forceinline__ void operator()(const f32x4 (&acc)[2][2][4][2], const pg8::Unit& u, int wr, int wc, int fr, int fq) const {
        const int d = u.pn >> 3, blk = u.pn & 7;
        asm volatile("" : "+v"(fr), "+v"(fq));
        const int ch = blk * 128 + wc * 32 + 8 * fq;
        u32x4 xw[8];
#pragma unroll
        for (int r = 0; r < 8; ++r) xw[r] = *(const u32x4*)(XC + (size_t)EPI_ROWS(r >> 2, r & 3) * D + ch);
        f32x4 bav[2], biv[2], spv[2];
#pragma unroll
        for (int n = 0; n < 2; ++n) { bav[n] = *(const f32x4*)(ba + d * D + ch + 4 * n); biv[n] = *(const f32x4*)(bi + d * D + ch + 4 * n); spv[n] = *(const f32x4*)(lam + d * D + ch + 4 * n); }
        f32x4 bav2[2], biv2[2], spv2[2];
#pragma unroll
        for (int n = 0; n < 2; ++n) { bav2[n] = bav[n] * -1.4426950408889634f; biv2[n] = biv[n] * -1.4426950408889634f; spv2[n] = spv[n] * (2.f * 1.4426950408889634f); }
#pragma unroll
        for (int r = 0; r < 8; ++r) { const int ai = r >> 2, m = r & 3; if (!((u.hm >> (2 * ai)) & 1)) continue;
            const size_t off = (size_t)EPI_ROWS(ai, m) * D + ch;
            const float xc[8] = {bflo(xw[r].x), bfhi(xw[r].x), bflo(xw[r].y), bfhi(xw[r].y), bflo(xw[r].z), bfhi(xw[r].z), bflo(xw[r].w), bfhi(xw[r].w)};
            float la[8], bb[8];
#pragma unroll
            for (int n = 0; n < 2; ++n) { const f32x4 xc4 = {xc[4 * n], xc[4 * n + 1], xc[4 * n + 2], xc[4 * n + 3]};
                const f32x4 rg = vrcp(vexp2(acc[ai][0][m][n] * -1.4426950408889634f + bav2[n]) + 1.f), ig = vrcp(vexp2(acc[ai][1][m][n] * -1.4426950408889634f + biv2[n]) + 1.f);
                const f32x4 l4 = rg * spv[n], b4 = vsqrt(1.f - vexp2(rg * spv2[n])) * (ig * xc4);
#pragma unroll
                for (int e = 0; e < 4; ++e) { la[4 * n + e] = l4[e]; bb[4 * n + e] = b4[e]; } }
            u32x4 w; w.x = cvt_pk_bf16(la[0], la[1]); w.y = cvt_pk_bf16(la[2], la[3]); w.z = cvt_pk_bf16(la[4], la[5]); w.w = cvt_pk_bf16(la[6], la[7]);
            *(u32x4*)(LA + (size_t)d * T * D + off) = w;
            w.x = cvt_pk_bf16(bb[0], bb[1]); w.y = cvt_pk_bf16(bb[2], bb[3]); w.z = cvt_pk_bf16(bb[4], bb[5]); w.w = cvt_pk_bf16(bb[6], bb[7]);
            *(u32x4*)(BB + (size_t)d * T * D + off) = w; }
    } };

template <bool G1>
struct MoeOrder {
    static constexpr bool GATHER = G1;
    const LAS int* tab; const char* A; const char* B; const int* BK; int G, c, nunits; size_t bstride; int arow, brow;
    __device__ bool next(int i, pg8::Unit& u) const {
        int L, hm; if (!pg8::unit_slot(i, c, G, nunits, L, hm)) return false; u.hm = __builtin_amdgcn_readfirstlane(hm);
        const int wgid = __builtin_amdgcn_readfirstlane(pg8::xcd_remap(L, nunits)); const int tau = wgid >> 2, pn = wgid & 3;
        const int e = __builtin_amdgcn_readfirstlane(tab[192 + tau]);
        u.pm = tau; u.pn = pn; u.aux0 = e; u.aux1 = __builtin_amdgcn_readfirstlane((tau - tab[e]) * 256);
        u.a = pg8::uptr(G1 ? A : A + (size_t)tau * 256 * arow);
        u.b = pg8::uptr(B + (size_t)e * bstride + (size_t)pn * 256 * brow);
        return true; }
    __device__ const int* gaddr(const pg8::Unit& u, int row) const { const int cnt = tab[40 + u.aux0]; int pos = u.aux1 + row; pos = pos < cnt ? pos : cnt - 1; return BK + ((size_t)u.aux0 * T + pos) * 2; }
    __device__ unsigned graw2off(unsigned raw) const { return (raw >> 1) * (unsigned)arow; }
    __device__ unsigned goff(const pg8::Unit& u, int row) const {
        const int pos = u.aux1 + row; const int cnt = tab[40 + u.aux0];
        int tok = 0; if (pos < cnt) tok = __builtin_nontemporal_load(BK + ((size_t)u.aux0 * T + pos) * 2) >> 1;
        return (unsigned)tok * (unsigned)arow; }
};
struct EpiMoe1 { static constexpr bool PERM = true, FP8 = (MOE_FP8 != 0), PREFETCH = false; uchar* H1;
    __device__ __forceinline__ void operator()(const f32x4 (&acc)[2][2][4][2], const pg8::Unit& u, int wr, int wc, int fr, int fq) const {
        const int ct = u.pn * 128 + wc * 32 + 8 * fq;
#pragma unroll
        for (int ai = 0; ai < 2; ++ai)
#pragma unroll
            for (int m = 0; m < 4; ++m) { if (!((u.hm >> (2 * ai)) & 1)) continue; constexpr float WS_ = FP8 ? (1.f / 32.f) : 1.f;
                const f32x4 a0 = acc[ai][0][m][0], a1 = acc[ai][0][m][1];
                const f32x4 h0 = (a0 * acc[ai][1][m][0]) * (vrcp(vexp2(a0 * (-1.4426950408889634f * WS_)) + 1.f) * (WS_ * WS_));
                const f32x4 h1 = (a1 * acc[ai][1][m][1]) * (vrcp(vexp2(a1 * (-1.4426950408889634f * WS_)) + 1.f) * (WS_ * WS_));
                if constexpr (FP8) { int r0 = __builtin_amdgcn_cvt_pk_fp8_f32(clamp8(h0[0]), clamp8(h0[1]), 0, false); r0 = __builtin_amdgcn_cvt_pk_fp8_f32(clamp8(h0[2]), clamp8(h0[3]), r0, true);
                    int r1 = __builtin_amdgcn_cvt_pk_fp8_f32(clamp8(h1[0]), clamp8(h1[1]), 0, false); r1 = __builtin_amdgcn_cvt_pk_fp8_f32(clamp8(h1[2]), clamp8(h1[3]), r1, true);
                    *(u32x2*)(H1 + (size_t)EPI_ROWS(ai, m) * DEXP + ct) = (u32x2){(unsigned)r0, (unsigned)r1}; }
                else st8((bf16_t*)H1 + (size_t)EPI_ROWS(ai, m) * DEXP + ct, h0, h1); }
    } };
struct EpiMoe2 { static constexpr bool PERM = true, FP8 = (MOE_FP8 != 0), PREFETCH = true; bf16_t* YS; const int* BK; const LAS int* tab;
    typedef int pre_t __attribute__((ext_vector_type(16)));
    __device__ __forceinline__ pre_t prefetch(const pg8::Unit& u, int wr, int fr) const { pre_t p; const int cnt = tab[40 + u.aux0];
#pragma unroll
        for (int r = 0; r < 8; ++r) { const int pos = u.aux1 + (r >> 2) * 128 + wr * 64 + (r & 3) * 16 + fr; u32x2 v = {0xffffffffu, 0u}; if (pos < cnt) v = __builtin_nontemporal_load((const u32x2*)BK + (size_t)u.aux0 * T + pos); p[2 * r] = (int)v.x; p[2 * r + 1] = (int)v.y; }
        return p; }
    __device__ __forceinline__ void operator()(const f32x4 (&acc)[2][2][4][2], const pg8::Unit& u, int wr, int wc, int fr, int fq, const pre_t& pre) const {
        const int ct = u.pn * 256 + wc * 32 + 8 * fq;
#pragma unroll
        for (int r = 0; r < 8; ++r) { const int e_ = pre[2 * r];
            if (e_ >= 0 && ((u.hm >> (2 * (r >> 2))) & 1)) { const int tok = e_ >> 1, slot = e_ & 1; const float w = __int_as_float(pre[2 * r + 1]) * (FP8 ? (1.f / 32.f) : 1.f);
                if constexpr (Y_FP8) { uchar* yp = (uchar*)YS + ((size_t)slot * T + tok) * D + ct; const float w16 = w * 16.f;
#pragma unroll
                    for (int bj = 0; bj < 2; ++bj) { const f32x4 a0 = acc[r >> 2][bj][r & 3][0] * w16, a1 = acc[r >> 2][bj][r & 3][1] * w16;
                        int r0 = __builtin_amdgcn_cvt_pk_fp8_f32(clamp8(a0.x), clamp8(a0.y), 0, false); r0 = __builtin_amdgcn_cvt_pk_fp8_f32(clamp8(a0.z), clamp8(a0.w), r0, true);
                        int r1 = __builtin_amdgcn_cvt_pk_fp8_f32(clamp8(a1.x), clamp8(a1.y), 0, false); r1 = __builtin_amdgcn_cvt_pk_fp8_f32(clamp8(a1.z), clamp8(a1.w), r1, true);
                        *(u32x2*)(yp + bj * 128) = (u32x2){(unsigned)r0, (unsigned)r1}; } }
                else { bf16_t* yp = YS + ((size_t)slot * T + tok) * D + ct;
#pragma unroll
                    for (int bj = 0; bj < 2; ++bj) st8(yp + bj * 128, acc[r >> 2][bj][r & 3][0] * w, acc[r >> 2][bj][r & 3][1] * w); } } }
    } };
__device__ __forceinline__ int moe_table(Frame& F, int l, LAS int* tab) {
    __syncthreads();
    if (F.wave == 0) { const int lane = F.lane; int c = 0;
        if (lane < 32) c = (int)*(const unsigned*)((const unsigned*)(F.ws + WS_CTL) + CW_CNT + (l * 32 + lane) * 64);
        const int nt = (c + 255) >> 8; int incl = nt;
#pragma unroll
        for (int d = 1; d < 32; d <<= 1) { const int t_ = __shfl_up(incl, d); if (lane >= d) incl += t_; }
        if (lane < 32) { tab[40 + lane] = c; tab[lane] = incl - nt; }
        if (lane == 31) tab[32] = incl; }
    __syncthreads();
    const int ntile_ = tab[32];
    int ts[31];
#pragma unroll
    for (int k = 1; k < 32; ++k) ts[k - 1] = tab[k];
    for (int tau = F.tid; tau < ntile_; tau += 512) { int e = 0;
#pragma unroll
        for (int k = 1; k < 32; ++k) e = (ts[k - 1] <= tau) ? k : e;
        tab[192 + tau] = e; }
    __syncthreads();
    return ntile_;
}

__device__ __forceinline__ void conv_phase(Frame& F, int j) {
    const bf16_t* XB = (const bf16_t*)(F.ws + WS_XB); bf16_t* XC = (bf16_t*)(F.ws + WS_XC);
    const float* cw = inp(F, I_RGCW) + (size_t)j * 4 * D; const float* cb = inp(F, I_RGCB) + (size_t)j * D;
    const int NGT = F.G * 512;
    for (int item = F.bid * 512 + F.tid; item < (T / 17) * 128; item += NGT) {
        const int chunk = item >> 7, c = (item & 127) * 8, r0 = chunk * 17, b = r0 / SB, s0 = r0 - b * SB;
        u32x4 xr[20];
#pragma unroll
        for (int i = 0; i < 20; ++i) { int rr = r0 - 2 + i; rr = rr < 0 ? 0 : (rr > T - 1 ? T - 1 : rr); xr[i] = *(const u32x4*)(XB + (size_t)rr * D + c); }
        f32x4 w0[4], w1[4];
#pragma unroll
        for (int k = 0; k < 4; ++k) { w0[k] = *(const f32x4*)(cw + k * D + c); w1[k] = *(const f32x4*)(cw + k * D + c + 4); }
        const f32x4 bias0 = *(const f32x4*)(cb + c), bias1 = *(const f32x4*)(cb + c + 4);
#pragma unroll
        for (int o = 0; o < 17; ++o) { const int s = s0 + o; const int lo = s < CTX ? 0 : CTX, hi = s < CTX ? CTX : SB;
            f32x4 a0 = bias0, a1 = bias1;
#pragma unroll
            for (int k = 0; k < 4; ++k) { const int ss = s + k - 2; if (ss >= lo && ss < hi) { const u32x4 x = xr[o + k];
                a0 += w0[k] * (f32x4){bflo(x.x), bfhi(x.x), bflo(x.y), bfhi(x.y)}; a1 += w1[k] * (f32x4){bflo(x.z), bfhi(x.z), bflo(x.w), bfhi(x.w)}; } }
            u32x4 ov; ov.x = pk2(a0.x, a0.y); ov.y = pk2(a0.z, a0.w); ov.z = pk2(a1.x, a1.y); ov.w = pk2(a1.z, a1.w);
            *(u32x4*)(XC + (size_t)(r0 + o) * D + c) = ov; }
    }
}
__device__ __forceinline__ int deal_item(const Frame& F, int r, int nitems) { const int nw = F.G * 8, nfull = nitems / nw;
    if (r < nfull) return r * nw + F.bid * 8 + F.wave;
    if (r > nfull) return -1;
    const int e = F.wave * F.G + F.bid; return e < nitems - nfull * nw ? nfull * nw + e : -1; }
__device__ __forceinline__ void scan1_phase(Frame& F) {
    const bf16_t* LA = (const bf16_t*)(F.ws + WS_LA); const bf16_t* BB = (const bf16_t*)(F.ws + WS_BB); float* TS = (float*)(F.ws + WS_TOTS); float* TH = (float*)(F.ws + WS_TOTH);
    for (int r_ = 0, it; (it = deal_item(F, r_, NB * 2 * NCH * 4)) >= 0; ++r_) {
        const int cg = it & 3, rest = it >> 2, ck = rest % NCH, bd = rest / NCH, dir = bd & 1, b = bd >> 1;
        const int c = cg * 256 + F.lane * 4; const size_t base = (size_t)dir * T * D + (size_t)(b * SB + ck * 16) * D + c;
        u32x2 la[16], bb[16];
#pragma unroll
        for (int t = 0; t < 16; ++t) { const size_t o = base + (size_t)(dir ? 15 - t : t) * D; la[t] = *(const u32x2*)(LA + o); bb[t] = *(const u32x2*)(BB + o); }
        f32x4 sl = {0.f, 0.f, 0.f, 0.f}, h = {0.f, 0.f, 0.f, 0.f};
#pragma unroll
        for (int t = 0; t < 16; ++t) { const f32x4 l4 = {bflo(la[t].x), bfhi(la[t].x), bflo(la[t].y), bfhi(la[t].y)}, b4 = {bflo(bb[t].x), bfhi(bb[t].x), bflo(bb[t].y), bfhi(bb[t].y)};
            sl += l4; f32x4 a4 = {__expf(l4.x), __expf(l4.y), __expf(l4.z), __expf(l4.w)}; h = a4 * h + b4; }
        const size_t o = (size_t)(bd * NCH + ck) * D + c; *(f32x4*)(TS + o) = sl; *(f32x4*)(TH + o) = h;
    }
}
__device__ __forceinline__ void scan2_phase(Frame& F) {
    const float* TS = (const float*)(F.ws + WS_TOTS); const float* TH = (const float*)(F.ws + WS_TOTH); float* CY = (float*)(F.ws + WS_CARRY);
    LAS float* wt = (LAS float*)F.lds;
    for (int it = F.bid; it < NB * 2 * 16; it += F.G) {
        const int cg = it & 15, bd = it >> 4, dir = bd & 1; const int c = cg * 64 + F.lane; const size_t base = (size_t)bd * NCH * D + c;
        const int s0 = F.wave * 34;
        float P = 0.f, H = 0.f;
        float sl[34], hl[34];
#pragma unroll
        for (int q = 0; q < 34; ++q) { const int s = s0 + q; const int ck = dir ? (s < 16 ? 15 - s : NCH + 15 - s) : s; sl[q] = TS[base + (size_t)ck * D]; hl[q] = TH[base + (size_t)ck * D]; }
#pragma unroll
        for (int q = 0; q < 34; ++q) { P += sl[q]; H = __expf(sl[q]) * H + hl[q]; }
        __syncthreads();
        wt[(F.wave * 2 + 0) * 64 + F.lane] = P; wt[(F.wave * 2 + 1) * 64 + F.lane] = H;
        __syncthreads();
        float h = 0.f;
        for (int w = 0; w < F.wave; ++w) h = __expf(wt[(w * 2 + 0) * 64 + F.lane]) * h + wt[(w * 2 + 1) * 64 + F.lane];
#pragma unroll
        for (int q = 0; q < 34; ++q) { const int s = s0 + q; const int ck = dir ? (s < 16 ? 15 - s : NCH + 15 - s) : s; CY[base + (size_t)ck * D] = h; h = __expf(sl[q]) * h + hl[q]; }
    }
    __syncthreads();
}
__device__ __forceinline__ void scan3_phase(Frame& F) {
    const bf16_t* LA = (const bf16_t*)(F.ws + WS_LA); const bf16_t* BB = (const bf16_t*)(F.ws + WS_BB); const float* CY = (const float*)(F.ws + WS_CARRY);
    const bf16_t* GG = (const bf16_t*)(F.ws + WS_GG); bf16_t* SA = (bf16_t*)(F.ws + WS_SA);
    LAS f32x4* hb = (LAS f32x4*)(F.lds + F.wave * 16384);
    for (int r_ = 0, it; (it = deal_item(F, r_, NB * NCH * 4)) >= 0; ++r_) {
        const int cg = it & 3, rest = it >> 2, ck = rest % NCH, b = rest / NCH;
        const int c = cg * 256 + F.lane * 4;
        const size_t rbase = (size_t)(b * SB + ck * 16) * D + c, b1 = (size_t)T * D + rbase;
        f32x4 hbk = *(const f32x4*)(CY + (size_t)((b * 2 + 1) * NCH + ck) * D + c), hf = *(const f32x4*)(CY + (size_t)((b * 2 + 0) * NCH + ck) * D + c);
        { u32x2 la[16], bb[16];
#pragma unroll
          for (int t = 0; t < 16; ++t) { la[t] = *(const u32x2*)(LA + b1 + (size_t)(15 - t) * D); bb[t] = *(const u32x2*)(BB + b1 + (size_t)(15 - t) * D); }
#pragma unroll
          for (int t = 0; t < 16; ++t) { const f32x4 l4 = {bflo(la[t].x), bfhi(la[t].x), bflo(la[t].y), bfhi(la[t].y)}, b4 = {bflo(bb[t].x), bfhi(bb[t].x), bflo(bb[t].y), bfhi(bb[t].y)};
              const f32x4 a4 = {__expf(l4.x), __expf(l4.y), __expf(l4.z), __expf(l4.w)}; hbk = a4 * hbk + b4; hb[(15 - t) * 64 + F.lane] = hbk; } }
        { u32x2 la[16], bb[16], gg[16];
#pragma unroll
          for (int t = 0; t < 16; ++t) { la[t] = *(const u32x2*)(LA + rbase + (size_t)t * D); bb[t] = *(const u32x2*)(BB + rbase + (size_t)t * D); gg[t] = *(const u32x2*)(GG + rbase + (size_t)t * D); }
#pragma unroll
          for (int t = 0; t < 16; ++t) { const f32x4 l4 = {bflo(la[t].x), bfhi(la[t].x), bflo(la[t].y), bfhi(la[t].y)}, b4 = {bflo(bb[t].x), bfhi(bb[t].x), bflo(bb[t].y), bfhi(bb[t].y)};
              const f32x4 g4 = {bflo(gg[t].x), bfhi(gg[t].x), bflo(gg[t].y), bfhi(gg[t].y)};
              const f32x4 a4 = {__expf(l4.x), __expf(l4.y), __expf(l4.z), __expf(l4.w)}; hf = a4 * hf + b4; const f32x4 y = g4 * (hf + hb[t * 64 + F.lane]);
              if constexpr (F8_RGOUT) { int r8 = __builtin_amdgcn_cvt_pk_fp8_f32(clamp8(y.x * RGO_SC), clamp8(y.y * RGO_SC), 0, false); r8 = __builtin_amdgcn_cvt_pk_fp8_f32(clamp8(y.z * RGO_SC), clamp8(y.w * RGO_SC), r8, true); *(int*)((uchar*)SA + rbase + (size_t)t * D) = r8; }
              else { u32x2 o; o.x = pk2(y.x, y.y); o.y = pk2(y.z, y.w); *(u32x2*)(SA + rbase + (size_t)t * D) = o; } } }
    }
}

__device__ __forceinline__ void qknorm_phase(Frame& F) {
    bf16_t* QKV = (bf16_t*)(F.ws + WS_QKV); const f32x2* ROPE = (const f32x2*)(F.ws + WS_ROPE);
    const int i16 = F.lane & 15, grp = F.lane >> 4; const float* pqg = inp(F, I_ATQG); const float* pkg = inp(F, I_ATKG);
    const int ITS = F.G * 32;
    for (int it0 = (F.bid * 8 + F.wave) * 4 + grp; it0 < T * 10; it0 += 4 * ITS) {
        u32x4 xw4[4];
#pragma unroll
        for (int q = 0; q < 4; ++q) { const int it = it0 + q * ITS; xw4[q] = (u32x4){0u, 0u, 0u, 0u}; if (it < T * 10) { const int row = it / 10, hh = it - row * 10; xw4[q] = *(const u32x4*)(QKV + (size_t)row * 1536 + hh * 128 + i16 * 8); } }
#pragma unroll
        for (int q = 0; q < 4; ++q) { const int it = it0 + q * ITS; const bool valid = it < T * 10; const int itc = valid ? it : 0;
            const int row = itc / 10, hh = itc - row * 10; const int b = row / SB, s = row - b * SB;
            bf16_t* p = QKV + (size_t)row * 1536 + hh * 128 + i16 * 8;
            const u32x4 xw = xw4[q];
            float x[8] = {bflo(xw.x), bfhi(xw.x), bflo(xw.y), bfhi(xw.y), bflo(xw.z), bfhi(xw.z), bflo(xw.w), bfhi(xw.w)};
            float ss = 0.f;
#pragma unroll
            for (int e = 0; e < 8; ++e) ss += x[e] * x[e];
            ss = wave16_sum(ss);
            const float rstd = rsqrtf(ss * (1.f / 128.f) + NORM_EPS);
            const float* g = (hh < 8 ? pqg : pkg) + i16 * 8;
#pragma unroll
            for (int e = 0; e < 8; ++e) x[e] = x[e] * rstd * g[e];
            float y[8];
#pragma unroll
            for (int e = 0; e < 8; ++e) y[e] = __shfl_xor(x[e], 4);
            if (s >= CTX) { const int t = s - CTX; const int pos = (i16 >> 3) ? (t & 63) : (t >> 6); const bool half1 = (i16 >> 2) & 1;
#pragma unroll
                for (int e = 0; e < 8; ++e) { const f32x2 cs = ROPE[pos * 32 + (i16 & 3) * 8 + e];
                    x[e] = half1 ? (x[e] * cs.x + y[e] * cs.y) : (x[e] * cs.x - y[e] * cs.y); } }
            u32x4 o; o.x = pk2(x[0], x[1]); o.y = pk2(x[2], x[3]); o.z = pk2(x[4], x[5]); o.w = pk2(x[6], x[7]);
            if (valid) *(u32x4*)p = o;
        }
    }
}
__device__ __forceinline__ void attn_phase(Frame& F) {
    const bf16_t* QKV = (const bf16_t*)(F.ws + WS_QKV); bf16_t* AO = (bf16_t*)(F.ws + WS_AO);
    for (int u0 = F.bid; u0 < 544; u0 += F.G) {
        int b, h, q0, k0, seq;
        int u = u0; if (u0 < 512 && F.G == 256) { const int x = u0 & 7, rnd = u0 >> 8, i = (u0 & 255) >> 3; u = (((x >> 1) + 4 * rnd) << 6) + i + 32 * (x & 1); }
        if (u < 512) { const int qb = u & 15, hg = (u >> 4) & 3, kvh = (u >> 6) & 1; b = u >> 7; h = kvh * 4 + hg; q0 = b * SB + CTX + qb * 256; k0 = b * SB; seq = SB; }
        else { const int v = u - 512; b = v >> 3; h = v & 7; q0 = b * SB; k0 = b * SB; seq = CTX; }
        const int kvh = h >> 2;
        const bf16_t* Kp = (const bf16_t*)pg8::uptr((const char*)(QKV + (size_t)k0 * 1536 + 1024 + kvh * 128));
        att::attn_dense_body((const bf16_t*)pg8::uptr((const char*)(QKV + (size_t)q0 * 1536 + h * 128)), Kp, Kp + 256, (bf16_t*)pg8::uptr(F8_ATO ? (const char*)AO + (size_t)q0 * D + h * 128 : (const char*)(AO + (size_t)q0 * D + h * 128)), seq, F.ldsg, F.tid);
        __syncthreads();
    }
}

__device__ __forceinline__ void spatial_phase(Frame& F) {
    const bf16_t* UVB = (const bf16_t*)(F.ws + WS_UVB); bf16_t* UV = (bf16_t*)(F.ws + WS_UV); const f32x2* statp = (const f32x2*)(F.ws + WS_STATP);
    const bf16_t* Ws = (const bf16_t*)(F.ws + WS_W_CMS); const float* lng = inp(F, I_CMLNG); const float* lnb = inp(F, I_CMLNB); const float* bs = inp(F, I_CMBS);
    LAS uchar* vl = F.lds;
    LAS f32x2* st = (LAS f32x2*)(F.lds + 65536);
    const int tid = F.tid, lane = F.lane, wid = F.wave, r32 = lane & 31, hi = lane >> 5, wm = wid & 3, wn = wid >> 2;
    const int sr = tid >> 4, sc = (tid & 15) * 8;
    for (int u = F.bid; u < 136 * 8; u += F.G) {
        const int chunk = u >> 3, g = u & 7; const int row0 = chunk * 128;
        float s_ = 0.f, q_ = 0.f;
        { const f32x2* sp = statp + (size_t)(row0 + (tid >> 2)) * 32 + (tid & 3) * 8; f32x2 pv[8];
#pragma unroll
          for (int k = 0; k < 8; ++k) pv[k] = sp[k];
#pragma unroll
          for (int k = 0; k < 8; ++k) { s_ += pv[k].x; q_ += pv[k].y; } }
        u32x4 xw[2][4]; f32x4 lg0[2], lg1[2], lb0[2], lb1[2];
#pragma unroll
        for (int ch = 0; ch < 2; ++ch) { const int cg = g * 256 + ch * 128 + sc;
            lg0[ch] = *(const f32x4*)(lng + cg); lg1[ch] = *(const f32x4*)(lng + cg + 4); lb0[ch] = *(const f32x4*)(lnb + cg); lb1[ch] = *(const f32x4*)(lnb + cg + 4);
#pragma unroll
            for (int i = 0; i < 4; ++i) xw[ch][i] = *(const u32x4*)(UVB + (size_t)(row0 + sr + 32 * i) * 4096 + 2048 + cg); }
        bf16x8 pa[2][4];
#pragma unroll
        for (int kt = 0; kt < 2; ++kt)
#pragma unroll
            for (int ks = 0; ks < 4; ++ks) pa[kt][ks] = *(const bf16x8*)(Ws + ((size_t)g * 128 + 32 * wm + r32) * 128 + 64 * kt + 16 * ks + 8 * hi);
        u32x4 uu[8];
#pragma unroll
        for (int i = 0; i < 8; ++i) { const int id = tid + 512 * i, row = id >> 5, ch = id & 31; uu[i] = *(const u32x4*)(UVB + (size_t)(row0 + row) * 4096 + g * 256 + ch * 8); }
        s_ += __int_as_float(__builtin_amdgcn_update_dpp(0, __float_as_int(s_), 0xB1, 0xF, 0xF, true)); s_ += __int_as_float(__builtin_amdgcn_update_dpp(0, __float_as_int(s_), 0x4E, 0xF, 0xF, true));
        q_ += __int_as_float(__builtin_amdgcn_update_dpp(0, __float_as_int(q_), 0xB1, 0xF, 0xF, true)); q_ += __int_as_float(__builtin_amdgcn_update_dpp(0, __float_as_int(q_), 0x4E, 0xF, 0xF, true));
        __syncthreads();
        if ((tid & 3) == 0) { const float mean = s_ * (1.f / 2048.f); const float var = fmaxf(q_ * (1.f / 2048.f) - mean * mean, 0.f); st[tid >> 2] = (f32x2){mean, rsqrtf(var + NORM_EPS)}; }
        __syncthreads();
#pragma unroll
        for (int ch = 0; ch < 2; ++ch) {
#pragma unroll
            for (int i = 0; i < 4; ++i) { const int q = sr + 32 * i; const u32x4 x_ = xw[ch][i]; const f32x2 ms = st[q];
                f32x4 v0 = {bflo(x_.x), bfhi(x_.x), bflo(x_.y), bfhi(x_.y)}, v1 = {bflo(x_.z), bfhi(x_.z), bflo(x_.w), bfhi(x_.w)};
                v0 = (v0 - ms.x) * ms.y * lg0[ch] + lb0[ch]; v1 = (v1 - ms.x) * ms.y * lg1[ch] + lb1[ch];
                u32x4 o; o.x = pk2(v0.x, v0.y); o.y = pk2(v0.z, v0.w); o.z = pk2(v1.x, v1.y); o.w = pk2(v1.z, v1.w);
                *(LAS u32x4*)(vl + ((q >> 6) * 2 + ch) * 16384 + att::v_st(q & 63, sc)) = o; } }
        __syncthreads();
        f32x16 o[4] = {};
        const int vb = (int)(uintptr_t)(F.ldsg) + att::v_rd_base(lane) + wn * 16384;
        att::pv_d0(o, vb, pa[0][0], pa[0][1], pa[0][2], pa[0][3]);
        att::pv_d0(o, vb + 32768, pa[1][0], pa[1][1], pa[1][2], pa[1][3]);
        __syncthreads();
#pragma unroll
        for (int r = 0; r < 16; ++r) { const int p = 32 * wm + att::crow(r, hi); const float bsv = bs[g * 128 + p];
#pragma unroll
            for (int d0 = 0; d0 < 4; ++d0) *(LAS bf16_t*)(vl + p * 512 + (128 * wn + 32 * d0 + r32) * 2) = (bf16_t)f2bf(o[d0][r] + bsv); }
        __syncthreads();
#pragma unroll
        for (int i = 0; i < 8; ++i) { const int id = tid + 512 * i, row = id >> 5, ch = id & 31; const u32x4 v = *(const LAS u32x4*)(vl + row * 512 + ch * 16); const u32x4 w = uu[i];
            u32x4 o4; o4.x = pk2(bflo(v.x) * bflo(w.x), bfhi(v.x) * bfhi(w.x)); o4.y = pk2(bflo(v.y) * bflo(w.y), bfhi(v.y) * bfhi(w.y)); o4.z = pk2(bflo(v.z) * bflo(w.z), bfhi(v.z) * bfhi(w.z)); o4.w = pk2(bflo(v.w) * bflo(w.w), bfhi(v.w) * bfhi(w.w));
            if constexpr (F8_CMOUT) { int r0 = __builtin_amdgcn_cvt_pk_fp8_f32(clamp8(bflo(o4.x)), clamp8(bfhi(o4.x)), 0, false); r0 = __builtin_amdgcn_cvt_pk_fp8_f32(clamp8(bflo(o4.y)), clamp8(bfhi(o4.y)), r0, true);
                int r1 = __builtin_amdgcn_cvt_pk_fp8_f32(clamp8(bflo(o4.z)), clamp8(bfhi(o4.z)), 0, false); r1 = __builtin_amdgcn_cvt_pk_fp8_f32(clamp8(bflo(o4.w)), clamp8(bfhi(o4.w)), r1, true);
                *(u32x2*)((uchar*)UV + (size_t)(row0 + row) * 2048 + g * 256 + ch * 8) = (u32x2){(unsigned)r0, (unsigned)r1}; }
            else *(u32x4*)(UV + (size_t)(row0 + row) * 2048 + g * 256 + ch * 8) = o4; }
    }
    __syncthreads();
}

__device__ __forceinline__ void final_phase(Frame& F) {
    static_assert(X_BF16 && Y_FP8, "final_phase: bf16 residual stream and fp8 MoE slots");
    const u32x4* Xb = (const u32x4*)(F.ws + WS_X); const u32x2* YSb = (const u32x2*)(F.ws + WS_Y1); const u32x4* YM = (const u32x4*)(F.ws + WS_YM); f32x4* out = (f32x4*)F.out;
    const f32x4* G5 = (const f32x4*)((const float*)(F.ws + WS_MOD) + (size_t)(DEPTH - 1) * 5 * NMODV + 5 * D);
    const int NGT = F.G * 512;
    for (int i0 = F.bid * 512 + F.tid; i0 < NB * SEQ * 128; i0 += 4 * NGT) { u32x4 xb[4], ym[4]; u32x2 y0[4], y1[4];
#pragma unroll
        for (int q = 0; q < 4; ++q) { const int i = i0 + q * NGT; if (i < NB * SEQ * 128) { const int r = i >> 7, c8 = i & 127, b = r >> 12, t = r & 4095; const size_t src = ((size_t)(b * SB + CTX + t) << 7) + c8;
            xb[q] = Xb[src]; ym[q] = YM[src]; y0[q] = YSb[src]; y1[q] = YSb[src + (size_t)T * 128]; } }
#pragma unroll
        for (int q = 0; q < 4; ++q) { const int i = i0 + q * NGT; if (i < NB * SEQ * 128) { const int r = i >> 7, c8 = i & 127, b = r >> 12; const f32x4 ga = G5[(size_t)b * (NMODV / 4) + 2 * c8], gb = G5[(size_t)b * (NMODV / 4) + 2 * c8 + 1];
            const f32x4 xa = {bflo(xb[q].x), bfhi(xb[q].x), bflo(xb[q].y), bfhi(xb[q].y)}, xc = {bflo(xb[q].z), bfhi(xb[q].z), bflo(xb[q].w), bfhi(xb[q].w)};
            const f32x4 ma = {bflo(ym[q].x), bfhi(ym[q].x), bflo(ym[q].y), bfhi(ym[q].y)}, mc = {bflo(ym[q].z), bfhi(ym[q].z), bflo(ym[q].w), bfhi(ym[q].w)};
            const f32x4 sa = (fp8x4_to_f32(y0[q].x) + fp8x4_to_f32(y1[q].x)) * (1.f / 16.f), sc = (fp8x4_to_f32(y0[q].y) + fp8x4_to_f32(y1[q].y)) * (1.f / 16.f);
            out[2 * (size_t)i] = xa + ma + ga * sa; out[2 * (size_t)i + 1] = xc + mc + gb * sc; } } }
}

constexpr int NPHASE = 38;
constexpr bool H8K0 = MOE_FP8 && (DENSE_FP8 & 1), H8K1 = MOE_FP8 && (DENSE_FP8 & 2), H8K2 = MOE_FP8 && (DENSE_FP8 & 4);
constexpr int DK8_RG = EpiRgIn::FP8 ? D / 2 : D, DK8_AT = EpiQKV::FP8 ? D / 2 : D, DK8_CM = EpiCmIn::FP8 ? D / 2 : D;
__global__ void __launch_bounds__(512, 2) mk_fwd(Args args) {
    extern __shared__ __attribute__((aligned(16))) uchar lds[];
    Frame F; F.lds = (LAS uchar*)lds; F.ldsg = (char*)lds; F.tid = threadIdx.x; F.lane = F.tid & 63; F.wave = __builtin_amdgcn_readfirstlane(F.tid >> 6); F.G = gridDim.x; F.bid = blockIdx.x;
    F.ws = args.ws; F.out = args.out;
    uchar* ws0 = args.ws;
    volatile LAS unsigned* MISC = (volatile LAS unsigned*)(F.lds + LDSCTL_OFF);
    LAS int* tab = (LAS int*)(F.lds + LDSCTL_OFF + 256);
    for (int u = F.tid; u < (LDS_BYTES - LDSCTL_OFF) / 4; u += 512) ((LAS unsigned*)(F.lds + LDSCTL_OFF))[u] = 0u;
    __syncthreads();
    if (F.tid == 0) {
#pragma unroll
        for (int i = 0; i < 34; ++i) *(LAS unsigned long long*)(F.lds + LDSCTL_OFF + 576 + i * 8) = (unsigned long long)args.in[i]; }
    __syncthreads();
    const int lo = args.ph_lo, hi = args.ph_hi;
    if (hi - lo > 1) (void)xcd_barrier_post((unsigned*)(ws0 + WS_CTL) + CW_BAR, MISC + 8);
    int ph = 0;
#define PH_BEGIN if (ph >= opaque_uniform_int(args.ph_lo) && ph < opaque_uniform_int(args.ph_hi)) { int t_ = threadIdx.x; F.G = opaque_uniform_int(gridDim.x); F.bid = opaque_uniform_int(blockIdx.x); const int cid = F.bid; (void)cid; \
        F.out = (float*)opaque_uniform_ptr(args.out); F.lds = (LAS uchar*)lds; F.ldsg = (char*)lds; \
        asm volatile("" : "+v"(t_)); F.tid = t_; F.lane = t_ & 63; F.wave = __builtin_amdgcn_readfirstlane(t_ >> 6); \
        uchar* ws = (uchar*)opaque_uniform_ptr(args.ws); F.ws = ws; \
        const float* MODl = (const float*)(ws + WS_MOD) + (size_t)l_ * 5 * NMODV; (void)MODl;
#define GRIDBAR  { XcdBarrier bb_; bb_.bar = (unsigned*)(ws + WS_CTL) + CW_BAR; bb_.x = 0; bb_.st = (volatile LAS unsigned*)(F.lds + LDSCTL_OFF) + 8; xcd_barrier(bb_); }
#define REPBAR   if (rep_ > 1) GRIDBAR
#define PH_END   if (ph + 1 < opaque_uniform_int(args.ph_hi)) GRIDBAR } ++ph;

    { const int l_ = 0; PH_BEGIN PM(0) { const bool dry = rep_ > 1; (void)dry;  p0_prologue(F);  REPBAR } PH_END }

#pragma unroll 1
    for (int l = 0; l < DEPTH; ++l) {
        const int kind = l % 3, j = l / 3; const bool lastl = (l == DEPTH - 1); const int l_ = l;
        PH_BEGIN PM(1) { const bool dry = rep_ > 1; (void)dry;  const float* gv_ = inp(F, I_NMG) + l * D;
            if (l == 0) norm_phase<false, 0, true, H8K0>(F, l, gv_, 0, false, false);
            else if (rep_ != REPN(1)) norm_phase<false, 0, false, H8K0>(F, l, gv_, 0, false, false);
            else if (l == 1) norm_phase<false, 3, true, H8K1>(F, l, gv_, 0, false, false);
            else if (kind == 2) norm_phase<false, 3, false, H8K2>(F, l, gv_, 0, false, false); else norm_phase<false, 3, false, H8K0>(F, l, gv_, 0, false, false);  REPBAR } PH_END
        if (kind == 0) {
            PH_BEGIN PM(2) { const bool dry = rep_ > 1; (void)dry;  { pg8::DenseOrder S; S.init(ws + WS_H, DK8_RG, ws + WS_W_RGIN + (size_t)j * 2048 * DK8_RG * 2, DK8_RG, T, 2048, F.G, cid);
                EpiRgIn E{(bf16_t*)(ws + WS_GG), (bf16_t*)(ws + WS_XB)}; pg8::gemm_phase(F.lds, S, E, DK8_RG, DK8_RG, DK8_RG); }  REPBAR } PH_END
            PH_BEGIN PM(3) { const bool dry = rep_ > 1; (void)dry;  conv_phase(F, j);  REPBAR } PH_END
            PH_BEGIN PM(4) { const bool dry = rep_ > 1; (void)dry;  { pg8::DenseOrder S; S.init(ws + WS_XC, D, ws + WS_W_RGG + (size_t)j * 16 * 256 * 128 * 2, 128, T, 16 * 256, F.G, cid, 7, 256);
                EpiRgGate E{(const bf16_t*)(ws + WS_XC), (bf16_t*)(ws + WS_LA), (bf16_t*)(ws + WS_BB), inp(F, I_RGBA) + (size_t)j * 2 * D, inp(F, I_RGBI) + (size_t)j * 2 * D, (const float*)(ws + WS_SPL) + (size_t)j * 2 * D};
                pg8::gemm_phase(F.lds, S, E, 128, D, 128); }  REPBAR } PH_END
            PH_BEGIN PM(5) { const bool dry = rep_ > 1; (void)dry;  scan1_phase(F);  REPBAR } PH_END
            PH_BEGIN PM(20) { const bool dry = rep_ > 1; (void)dry;  scan2_phase(F);  REPBAR } PH_END
            PH_BEGIN PM(6) { const bool dry = rep_ > 1; (void)dry;  scan3_phase(F);  REPBAR } PH_END
            PH_BEGIN PM(7) { const bool dry = rep_ > 1; (void)dry;  { EpiResidT<F8_RGOUT, F8_RGOUT ? RGO_SC : 1> E{(bf16_t*)(ws + (dry ? WS_Y1 : WS_YM)), MODl + 2 * D}; constexpr int K3 = F8_RGOUT ? D / 2 : D;
                if (lastl) { pg8::DenseOrderT<true> S; S.init(ws + WS_SA, K3, ws + WS_W_RGOUT + (size_t)j * 1024 * K3 * 2, K3, T, D, F.G, cid); pg8::gemm_phase(F.lds, S, E, K3, K3, K3); }
                else { pg8::DenseOrder S; S.init(ws + WS_SA, K3, ws + WS_W_RGOUT + (size_t)j * 1024 * K3 * 2, K3, T, D, F.G, cid); pg8::gemm_phase(F.lds, S, E, K3, K3, K3); }
                router_fill(F, l); }  REPBAR } PH_END
        } else if (kind == 1) {
            PH_BEGIN PM(8) { const bool dry = rep_ > 1; (void)dry;  { pg8::DenseOrder S; S.init(ws + WS_H, DK8_AT, ws + WS_W_QKV, DK8_AT, T, 1536, F.G, cid);
                EpiQKV E{(bf16_t*)(ws + WS_QKV), inp(F, I_ATQG), inp(F, I_ATKG), (const float*)(ws + WS_ROPE), (LAS float*)(F.lds + RING_BYTES)}; pg8::gemm_phase(F.lds, S, E, DK8_AT, DK8_AT, DK8_AT); }  REPBAR } PH_END
            PH_BEGIN PM(10) { const bool dry = rep_ > 1; (void)dry;  attn_phase(F);  REPBAR } PH_END
            PH_BEGIN PM(11) { const bool dry = rep_ > 1; (void)dry;  { pg8::DenseOrder S; constexpr int KA = F8_ATO ? D / 2 : D; S.init(ws + WS_AO, KA, ws + WS_W_AO, KA, T, D, F.G, cid);
                EpiResidT<F8_ATO, F8_ATO ? ATO_SC : 1> E{(bf16_t*)(ws + (dry ? WS_Y1 : WS_YM)), MODl + 2 * D}; pg8::gemm_phase(F.lds, S, E, KA, KA, KA); router_fill(F, l); }  REPBAR } PH_END
        } else {
            PH_BEGIN PM(12) { const bool dry = rep_ > 1; (void)dry;  { pg8::DenseOrder S; S.init(ws + WS_H, DK8_CM, ws + WS_W_CMIN, DK8_CM, T, 4096, F.G, cid);
                EpiCmIn E{(bf16_t*)(ws + WS_UVB), (f32x2*)(ws + WS_STATP)}; pg8::gemm_phase(F.lds, S, E, DK8_CM, DK8_CM, DK8_CM); }  REPBAR } PH_END
            PH_BEGIN PM(13) { const bool dry = rep_ > 1; (void)dry;  spatial_phase(F);  REPBAR } PH_END
            PH_BEGIN PM(14) { const bool dry = rep_ > 1; (void)dry;  { pg8::DenseOrder S; constexpr int K7 = F8_CMOUT ? 1024 : 2048; S.init(ws + WS_UV, K7, ws + WS_W_CMOUT, K7, T, D, F.G, cid);
                EpiResidT<F8_CMOUT> E{(bf16_t*)(ws + (dry ? WS_Y1 : WS_YM)), MODl + 2 * D}; pg8::gemm_phase(F.lds, S, E, K7, K7, K7); router_fill(F, l); }  REPBAR } PH_END
        }
        PH_BEGIN PM(15) { const bool dry = rep_ > 1; (void)dry;  if (l == 0) norm_phase<true, 1, true>(F, l, inp(F, I_NFG) + l * D, 3, lastl, dry); else norm_phase<true, 1, false>(F, l, inp(F, I_NFG) + l * D, 3, lastl, dry);  REPBAR } PH_END
        PH_BEGIN PM(16) { const bool dry = rep_ > 1; (void)dry;  { const int ntile = moe_table(F, l, tab);
            const int units = ntile * 4, rounds = (units + F.G - 1) / F.G; int geff = F.G; if (false && rounds > 0) { geff = (((units + rounds - 1) / rounds) + 7) & ~7; if (geff > F.G) geff = F.G; }
            constexpr int EB = MOE_FP8 ? 1 : 2;
            MoeOrder<true> S{tab, (const char*)(ws + WS_H), (const char*)(ws + WS_W_E1 + (size_t)l * 32 * 1024 * 1024 * EB), (const int*)(ws + WS_BK2), geff, cid, units, (size_t)1024 * 1024 * EB, 1024 * EB, 1024 * EB};
            EpiMoe1 E{ws + WS_H1}; pg8::gemm_phase(F.lds, S, E, D * EB / 2, D * EB / 2, D * EB / 2); }  REPBAR } PH_END
        PH_BEGIN PM(17) { const bool dry = rep_ > 1; (void)dry;  { const int ntile = tab[32];
            const int units = ntile * 4, rounds = (units + F.G - 1) / F.G; int geff = F.G; if (false && rounds > 0) { geff = (((units + rounds - 1) / rounds) + 7) & ~7; if (geff > F.G) geff = F.G; }
            constexpr int EB = MOE_FP8 ? 1 : 2;
            MoeOrder<false> S{tab, (const char*)(ws + WS_H1), (const char*)(ws + WS_W_E2 + (size_t)l * 32 * 1024 * 512 * EB), (const int*)(ws + WS_BK2), geff, cid, units, (size_t)1024 * 512 * EB, 512 * EB, 512 * EB};
            EpiMoe2 E{(bf16_t*)(ws + (dry ? WS_SCR + 64 * MiB : WS_Y1)), (const int*)(ws + WS_BK2), tab}; pg8::gemm_phase(F.lds, S, E, DEXP * EB / 2, DEXP * EB / 2, DEXP * EB / 2); }  REPBAR } PH_END
    }
    { const int l_ = 0; PH_BEGIN PM(18) { const bool dry = rep_ > 1; (void)dry;  final_phase(F);  REPBAR if constexpr (((REP_MASK) >> 19) & 1u) { for (int k_ = 0; k_ < 20; ++k_) GRIDBAR } } PH_END }
#undef PH_BEGIN
#undef PH_END
}

extern "C" void kernel_launch(void* const* d_in, const int* in_sizes, int n_in, void* d_out, int out_size, void* d_ws, size_t ws_size, hipStream_t stream) {
    static int grid = 0;
    if (grid == 0) {
        if (n_in != 34 || out_size != NB * SEQ * D || ws_size < WS_END) { fprintf(stderr, "kernel_launch: bad shapes n_in %d out %d ws %zu (need %zu)\n", n_in, out_size, ws_size, (size_t)WS_END); grid = -1; return; }
        int dev = 0, cus = 0, per_cu = 0;
        if (hipGetDevice(&dev) != hipSuccess || hipDeviceGetAttribute(&cus, hipDeviceAttributeMultiprocessorCount, dev) != hipSuccess) { grid = -1; return; }
        if (hipFuncSetAttribute((const void*)mk_fwd, hipFuncAttributeMaxDynamicSharedMemorySize, LDS_BYTES) != hipSuccess) { fprintf(stderr, "kernel_launch: hipFuncSetAttribute failed\n"); grid = -1; return; }
        if (hipOccupancyMaxActiveBlocksPerMultiprocessor(&per_cu, (const void*)mk_fwd, 512, LDS_BYTES) != hipSuccess || per_cu < 1) { fprintf(stderr, "kernel_launch: occupancy query says %d\n", per_cu); (void)hipGetLastError(); grid = -1; return; }
        grid = cus;
    }
    if (grid < 0) return;
    (void)hipMemsetAsync((char*)d_ws + WS_CTL, 0, 128 * 1024, stream);
    Args a{};
    for (int i = 0; i < 34; ++i) a.in[i] = (const float*)d_in[i];
    a.out = (float*)d_out; a.ws = (uchar*)d_ws;
#if MK_PER_PHASE
    for (int p = 0; p < NPHASE; ++p) { a.ph_lo = p; a.ph_hi = p + 1; hipLaunchKernelGGL(mk_fwd, dim3(grid), dim3(512), LDS_BYTES, stream, a); }
#else
    a.ph_lo = 0; a.ph_hi = NPHASE;
    void* kargs[] = {&a};
    hipError_t e = hipLaunchCooperativeKernel((const void*)mk_fwd, dim3(grid), dim3(512), kargs, LDS_BYTES, stream);
    if (e != hipSuccess) fprintf(stderr, "kernel_launch: cooperative launch failed: %s (grid %d)\n", hipGetErrorString(e), grid);
#endif
}
```
